# Optimizing an MI355X kernel written in HIP

```python
import math
import jax, jax.numpy as jnp
from jax import lax
import numpy as np

D_MODEL = 1024
BATCH = 4
SEQ = 4096
DEPTH = 4

N_ATT_LAYERS = (DEPTH + 1) // 2
N_REC_LAYERS = DEPTH // 2
EPS = 1e-6

DA_HEADS = 8
DA_HEAD_DIM = 64
DA_PATTERNS = ((128, 1), (512, 4), (2048, 16))
DA_BLOCK = 128

MLA_HEADS = 8
MLA_Q_RANK = 256
MLA_KV_RANK = 128
MLA_NOPE = 64
MLA_ROPE = 32
MLA_V = 64
MLA_QK = MLA_NOPE + MLA_ROPE
ROPE_THETA = 10000.0
Q_BLOCK = 128

A_COLS = 3 * DA_HEADS * DA_HEAD_DIM
B_COLS = MLA_Q_RANK + MLA_KV_RANK + MLA_ROPE
MIX_IN = A_COLS + B_COLS
MIX_OUT = DA_HEADS * DA_HEAD_DIM + MLA_HEADS * MLA_V

LRU_WIDTH = D_MODEL
LRU_BLOCKS = 8
LRU_BLOCK_DIM = LRU_WIDTH // LRU_BLOCKS
CONV_WIDTH = 4
LRU_C = 8.0

N_EXPERTS = 32
TOP_K = 4
D_EXPERT = D_MODEL
SWIGLU_LIMIT = 7.0
SWIGLU_ALPHA = 1.702
MOE_BLOCK = 256

kernel_name = "hybrid_dilated_mla_rglru_moe_adaln"


def rms_norm(x, gain):
    xf = x.astype(jnp.float32)
    y = xf * lax.rsqrt(jnp.mean(xf * xf, axis=-1, keepdims=True) + EPS)
    return (y * gain.astype(jnp.float32)).astype(x.dtype)


def modulate(h, shift, scale):
    return h * (1 + scale[:, None, :]) + shift[:, None, :]


def rope_tables(positions):
    inv = ROPE_THETA ** (-jnp.arange(0, MLA_ROPE, 2, dtype=jnp.float32) / MLA_ROPE)
    ang = positions.astype(jnp.float32)[..., None] * inv
    return jnp.cos(ang), jnp.sin(ang)


def apply_rope(x, cos, sin):
    x1, x2 = jnp.split(x.astype(jnp.float32), 2, axis=-1)
    return jnp.concatenate([x1 * cos - x2 * sin, x1 * sin + x2 * cos], axis=-1).astype(x.dtype)


def dilated_window_attention(q, k, v, window, dilation):
    B, S, H, E = q.shape
    n_back = window // dilation
    L = S // dilation
    Lp = -(-L // DA_BLOCK) * DA_BLOCK
    nb = Lp // DA_BLOCK

    def to_sub(t):
        t = t.reshape(B, L, dilation, H, E).transpose(0, 2, 3, 1, 4)
        t = jnp.pad(t, ((0, 0), (0, 0), (0, 0), (0, Lp - L), (0, 0)))
        return t.reshape(B, dilation, H, nb, DA_BLOCK, E)

    def with_prev(t):
        prev = jnp.pad(t, ((0, 0), (0, 0), (0, 0), (1, 0), (0, 0), (0, 0)))[:, :, :, :-1]
        return jnp.concatenate([prev, t], axis=4)

    qs = to_sub(q)
    kk = with_prev(to_sub(k))
    vv = with_prev(to_sub(v))
    s = jnp.einsum('brhnqe,brhnke->brhnqk', qs, kk,
                   preferred_element_type=jnp.float32) * (E ** -0.5)
    dist = (jnp.arange(DA_BLOCK)[:, None] + DA_BLOCK) - jnp.arange(2 * DA_BLOCK)[None, :]
    key_sub = (jnp.arange(nb)[:, None, None] - 1) * DA_BLOCK + jnp.arange(2 * DA_BLOCK)[None, None, :]
    mask = (dist >= 0) & (dist <= n_back) & (key_sub >= 0)
    s = jnp.where(mask, s, -jnp.inf)
    m = jnp.max(s, axis=-1, keepdims=True)
    p = jnp.exp(s - m)
    l = jnp.sum(p, axis=-1, keepdims=True)
    o = jnp.einsum('brhnqk,brhnke->brhnqe', (p / l).astype(v.dtype), vv)
    lse = (m + jnp.log(l))[..., 0]

    def from_sub(t):
        rest = t.shape[5:]
        t = t.reshape((B, dilation, H, Lp) + rest)[:, :, :, :L]
        t = jnp.moveaxis(t, 3, 1)
        return t.reshape((B, S, H) + rest)

    return from_sub(o), from_sub(lse)


def causal_block_attention(q, k, v, scale):
    B, S, H, E = q.shape
    nq = S // Q_BLOCK
    qb = q.reshape(B, nq, Q_BLOCK, H, E).transpose(1, 0, 2, 3, 4)
    kpos = jnp.arange(S)

    def one_block(args):
        qi, i = args
        s = jnp.einsum('bqhe,bkhe->bhqk', qi, k, preferred_element_type=jnp.float32) * scale
        qpos = i * Q_BLOCK + jnp.arange(Q_BLOCK)
        s = jnp.where(kpos[None, :] <= qpos[:, None], s, -jnp.inf)
        p = jax.nn.softmax(s, axis=-1)
        return jnp.einsum('bhqk,bkhe->bqhe', p.astype(v.dtype), v)

    o = lax.map(one_block, (qb, jnp.arange(nq)))
    return o.transpose(1, 0, 2, 3, 4).reshape(B, S, H, v.shape[-1])


def attention_mixer(h, w_in, da_q_gain, da_k_gain, qa_gain, kva_gain, w_uq, w_ukv,
                    q_gain, k_gain, w_out, cos, sin):
    B, S, _ = h.shape
    proj = h @ w_in
    a_qkv, c_q, c_kv, k_rope = jnp.split(
        proj, [A_COLS, A_COLS + MLA_Q_RANK, A_COLS + MLA_Q_RANK + MLA_KV_RANK], axis=-1)

    a_qkv = a_qkv.reshape(B, S, 3, DA_HEADS, DA_HEAD_DIM)
    qa = rms_norm(a_qkv[:, :, 0], da_q_gain)
    ka = rms_norm(a_qkv[:, :, 1], da_k_gain)
    va = a_qkv[:, :, 2]
    outs, lses = [], []
    for window, dilation in DA_PATTERNS:
        o_i, lse_i = dilated_window_attention(qa, ka, va, window, dilation)
        outs.append(o_i)
        lses.append(lse_i)
    mix_w = jax.nn.softmax(jnp.stack(lses, axis=-1), axis=-1)
    o_a = jnp.einsum('bshp,pbshe->bshe', mix_w, jnp.stack(outs, axis=0).astype(jnp.float32))
    o_a = o_a.astype(h.dtype).reshape(B, S, DA_HEADS * DA_HEAD_DIM)

    q = (rms_norm(c_q, qa_gain) @ w_uq).reshape(B, S, MLA_HEADS, MLA_QK)
    kv = (rms_norm(c_kv, kva_gain) @ w_ukv).reshape(B, S, MLA_HEADS, MLA_NOPE + MLA_V)
    q_nope, q_pe = q[..., :MLA_NOPE], q[..., MLA_NOPE:]
    k_nope, v_b = kv[..., :MLA_NOPE], kv[..., MLA_NOPE:]
    q_nope = rms_norm(q_nope, q_gain[:MLA_NOPE])
    q_pe = apply_rope(rms_norm(q_pe, q_gain[MLA_NOPE:]), cos[:, :, None], sin[:, :, None])
    k_nope = rms_norm(k_nope, k_gain[:MLA_NOPE])
    k_pe = apply_rope(rms_norm(k_rope, k_gain[MLA_NOPE:]), cos, sin)
    qb = jnp.concatenate([q_nope, q_pe], axis=-1)
    kb = jnp.concatenate([k_nope, jnp.broadcast_to(k_pe[:, :, None], (B, S, MLA_HEADS, MLA_ROPE))], axis=-1)
    o_b = causal_block_attention(qb, kb, v_b, MLA_QK ** -0.5).reshape(B, S, MLA_HEADS * MLA_V)

    return jnp.concatenate([o_a, o_b], axis=-1) @ w_out


def rg_lru(x, w_a, b_a, w_x, b_x, lam):
    B, S, W = x.shape
    xb = x.reshape(B, S, LRU_BLOCKS, LRU_BLOCK_DIM)
    r = jax.nn.sigmoid(jnp.einsum('bsnd,nde->bsne', xb, w_a).reshape(B, S, W) + b_a)
    i = jax.nn.sigmoid(jnp.einsum('bsnd,nde->bsne', xb, w_x).reshape(B, S, W) + b_x)
    log_a = -LRU_C * r.astype(jnp.float32) * jax.nn.softplus(-lam.astype(jnp.float32))
    a = jnp.exp(log_a)
    mult = jnp.sqrt(-jnp.expm1(2.0 * log_a))
    bterm = mult * (i * x).astype(jnp.float32)

    def combine(left, right):
        a1, b1 = left
        a2, b2 = right
        return a1 * a2, a2 * b1 + b2

    _, hseq = lax.associative_scan(combine, (a, bterm), axis=1)
    return hseq.astype(x.dtype)


def recurrent_mixer(h, w_in, b_in, conv_w, conv_b, w_a, b_a, w_x, b_x, lam, w_out, b_out):
    gx = h @ w_in + b_in
    g, xr = gx[..., :LRU_WIDTH], gx[..., LRU_WIDTH:]
    g = jax.nn.gelu(g)
    xr = lax.conv_general_dilated(
        xr, conv_w[:, None, :], window_strides=(1,), padding=[(CONV_WIDTH - 1, 0)],
        dimension_numbers=('NWC', 'WIO', 'NWC'), feature_group_count=LRU_WIDTH) + conv_b
    y = rg_lru(xr, w_a, b_a, w_x, b_x, lam)
    return (g * y) @ w_out + b_out


def moe_ffn(h, w_router, b_router, w1, b1, w2, b2):
    B, S, D = h.shape
    T = B * S
    xt = h.reshape(T, D)
    logits = (xt @ w_router + b_router).astype(jnp.float32)
    top_vals, top_idx = lax.top_k(logits, TOP_K)
    gates = jax.nn.softmax(top_vals, axis=-1)

    M = T * TOP_K
    e_flat = top_idx.reshape(M)
    tok_flat = jnp.repeat(jnp.arange(T, dtype=jnp.int32), TOP_K)
    g_flat = gates.reshape(M)
    order = jnp.argsort(e_flat)
    e_sorted, tok_sorted, g_sorted = e_flat[order], tok_flat[order], g_flat[order]
    counts = jnp.bincount(e_flat, length=N_EXPERTS)
    starts = jnp.cumsum(counts) - counts
    padded = (counts + MOE_BLOCK - 1) // MOE_BLOCK * MOE_BLOCK
    pad_ends = jnp.cumsum(padded)
    pad_starts = pad_ends - padded
    dest = pad_starts[e_sorted] + (jnp.arange(M) - starts[e_sorted])
    n_blocks = M // MOE_BLOCK + N_EXPERTS
    P = n_blocks * MOE_BLOCK
    row_tok = jnp.zeros((P,), jnp.int32).at[dest].set(tok_sorted)
    row_gate = jnp.zeros((P,), jnp.float32).at[dest].set(g_sorted)
    block_expert = jnp.minimum(
        jnp.searchsorted(pad_ends, jnp.arange(n_blocks) * MOE_BLOCK, side='right'), N_EXPERTS - 1)

    def expert_block(args):
        toks, e = args
        hb = xt[toks] @ w1[e] + b1[e]
        gate = jnp.minimum(hb[:, ::2], SWIGLU_LIMIT)
        lin = jnp.clip(hb[:, 1::2], -SWIGLU_LIMIT, SWIGLU_LIMIT)
        act = gate * jax.nn.sigmoid(SWIGLU_ALPHA * gate) * (lin + 1)
        return act @ w2[e] + b2[e]

    rows = lax.map(expert_block, (row_tok.reshape(n_blocks, MOE_BLOCK), block_expert))
    rows = rows.reshape(P, D).astype(jnp.float32) * row_gate[:, None]
    y = jax.ops.segment_sum(rows, row_tok, num_segments=T)
    return y.reshape(B, S, D).astype(h.dtype)


def setup_inputs(seed: int = 0) -> dict:
    key = jax.random.key(seed)
    ks = iter(jax.random.split(key, 40))
    nrm = lambda shape, s: jax.random.normal(next(ks), shape, jnp.float32) * s
    gain = lambda shape: 1.0 + nrm(shape, 0.02)
    NA, NR, D = N_ATT_LAYERS, N_REC_LAYERS, D_MODEL

    x = nrm((BATCH, SEQ, D), 1.0)
    c = nrm((BATCH, D), 1.0)
    positions = (jnp.arange(SEQ, dtype=jnp.int32)[None, :]
                 + jax.random.randint(next(ks), (BATCH, 1), 0, 4096, dtype=jnp.int32))

    a0 = jax.random.uniform(next(ks), (NR, LRU_WIDTH), jnp.float32, 0.9, 0.999)
    p0 = a0 ** (1.0 / LRU_C)
    rec_lambda = jnp.log(p0) - jnp.log1p(-p0)

    return {
        "x": x,
        "c": c,
        "positions": positions,
        "ada_w": nrm((DEPTH, D, 6 * D), D ** -0.5),
        "ada_b": nrm((DEPTH, 6 * D), 0.02),
        "norm1_gain": gain((DEPTH, D)),
        "norm2_gain": gain((DEPTH, D)),
        "attn_w_in": nrm((NA, D, MIX_IN), D ** -0.5),
        "da_q_gain": gain((NA, DA_HEAD_DIM)),
        "da_k_gain": gain((NA, DA_HEAD_DIM)),
        "mla_qa_gain": gain((NA, MLA_Q_RANK)),
        "mla_kva_gain": gain((NA, MLA_KV_RANK)),
        "mla_w_uq": nrm((NA, MLA_Q_RANK, MLA_HEADS * MLA_QK), MLA_Q_RANK ** -0.5),
        "mla_w_ukv": nrm((NA, MLA_KV_RANK, MLA_HEADS * (MLA_NOPE + MLA_V)), MLA_KV_RANK ** -0.5),
        "mla_q_gain": gain((NA, MLA_QK)),
        "mla_k_gain": gain((NA, MLA_QK)),
        "attn_w_out": nrm((NA, MIX_OUT, D), MIX_OUT ** -0.5),
        "rec_w_in": nrm((NR, D, 2 * LRU_WIDTH), D ** -0.5),
        "rec_b_in": nrm((NR, 2 * LRU_WIDTH), 0.02),
        "rec_conv_w": nrm((NR, CONV_WIDTH, LRU_WIDTH), CONV_WIDTH ** -0.5),
        "rec_conv_b": nrm((NR, LRU_WIDTH), 0.02),
        "rec_wa": nrm((NR, LRU_BLOCKS, LRU_BLOCK_DIM, LRU_BLOCK_DIM), LRU_BLOCK_DIM ** -0.5),
        "rec_ba": nrm((NR, LRU_WIDTH), 0.02),
        "rec_wx": nrm((NR, LRU_BLOCKS, LRU_BLOCK_DIM, LRU_BLOCK_DIM), LRU_BLOCK_DIM ** -0.5),
        "rec_bx": nrm((NR, LRU_WIDTH), 0.02),
        "rec_lambda": rec_lambda,
        "rec_w_out": nrm((NR, LRU_WIDTH, D), LRU_WIDTH ** -0.5),
        "rec_b_out": nrm((NR, D), 0.02),
        "moe_w_router": nrm((DEPTH, D, N_EXPERTS), D ** -0.5),
        "moe_b_router": nrm((DEPTH, N_EXPERTS), 0.01),
        "moe_w1": nrm((DEPTH, N_EXPERTS, D, 2 * D_EXPERT), D ** -0.5),
        "moe_b1": nrm((DEPTH, N_EXPERTS, 2 * D_EXPERT), 0.01),
        "moe_w2": nrm((DEPTH, N_EXPERTS, D_EXPERT, D), D_EXPERT ** -0.5),
        "moe_b2": nrm((DEPTH, N_EXPERTS, D), 0.01),
    }


def reference(x, c, positions, ada_w, ada_b, norm1_gain, norm2_gain,
              attn_w_in, da_q_gain, da_k_gain, mla_qa_gain, mla_kva_gain,
              mla_w_uq, mla_w_ukv, mla_q_gain, mla_k_gain, attn_w_out,
              rec_w_in, rec_b_in, rec_conv_w, rec_conv_b, rec_wa, rec_ba,
              rec_wx, rec_bx, rec_lambda, rec_w_out, rec_b_out,
              moe_w_router, moe_b_router, moe_w1, moe_b1, moe_w2, moe_b2):
    cos, sin = rope_tables(positions)
    c_act = jax.nn.silu(c)
    for layer in range(DEPTH):
        mod = c_act @ ada_w[layer] + ada_b[layer]
        sh1, sc1, g1, sh2, sc2, g2 = jnp.split(mod, 6, axis=-1)
        hn = modulate(rms_norm(x, norm1_gain[layer]), sh1, sc1)
        j = layer // 2
        if layer % 2 == 0:
            y = attention_mixer(hn, attn_w_in[j], da_q_gain[j], da_k_gain[j],
                                mla_qa_gain[j], mla_kva_gain[j], mla_w_uq[j], mla_w_ukv[j],
                                mla_q_gain[j], mla_k_gain[j], attn_w_out[j], cos, sin)
        else:
            y = recurrent_mixer(hn, rec_w_in[j], rec_b_in[j], rec_conv_w[j], rec_conv_b[j],
                                rec_wa[j], rec_ba[j], rec_wx[j], rec_bx[j], rec_lambda[j],
                                rec_w_out[j], rec_b_out[j])
        x = x + g1[:, None, :] * y
        hn = modulate(rms_norm(x, norm2_gain[layer]), sh2, sc2)
        x = x + g2[:, None, :] * moe_ffn(hn, moe_w_router[layer], moe_b_router[layer],
                                         moe_w1[layer], moe_b1[layer], moe_w2[layer], moe_b2[layer])
    return x
```

```cpp
#define MODE 1
#include <string.h>
#include <hip/hip_runtime.h>
#include <stdint.h>
#include <math.h>

namespace cfg {
constexpr int D = 1024, NB = 4, S = 4096, T = NB * S, DEPTH = 4;
constexpr int MIXIN = 1952;
constexpr int NE = 32, TOPK = 4;
constexpr int MPAIR = T * TOPK;
constexpr int NBLK = MPAIR / 256 + NE;
constexpr int P = NBLK * 256;
}
using namespace cfg;

namespace nv {

__device__ __forceinline__ float wave_sum(float v) {
#pragma unroll
    for (int o = 1; o < 64; o <<= 1) v += __shfl_xor(v, o);
    return v;
}
__device__ __forceinline__ float wave_max(float v) {
#pragma unroll
    for (int o = 1; o < 64; o <<= 1) v = fmaxf(v, __shfl_xor(v, o));
    return v;
}
__device__ __forceinline__ float block_sum256(float v) {
    __shared__ float red[4];
    v = wave_sum(v);
    __syncthreads();
    if ((threadIdx.x & 63) == 0) red[threadIdx.x >> 6] = v;
    __syncthreads();
    return red[0] + red[1] + red[2] + red[3];
}
__device__ __forceinline__ float sigmoidf_(float x) { return 1.f / (1.f + expf(-x)); }
__device__ __forceinline__ float gelu_tanh(float x) { return 0.5f * x * (1.f + tanhf(0.7978845608028654f * (x + 0.044715f * x * x * x))); }

__global__ void k_mod(const float* __restrict__ c, const float* __restrict__ ada_w, const float* __restrict__ ada_b, float* __restrict__ mod) {
    const int n = blockIdx.x * 256 + threadIdx.x, l = blockIdx.y;
    float acc[4] = {0.f, 0.f, 0.f, 0.f};
    const float* w = ada_w + (size_t)l * 1024 * 6144 + n;
    for (int k = 0; k < 1024; ++k) {
        const float wv = w[(size_t)k * 6144];
#pragma unroll
        for (int b = 0; b < 4; ++b) { const float cv = c[b * 1024 + k]; acc[b] += (cv / (1.f + expf(-cv))) * wv; }
    }
#pragma unroll
    for (int b = 0; b < 4; ++b) mod[((size_t)l * 4 + b) * 6144 + n] = acc[b] + ada_b[l * 6144 + n];
}

__global__ void k_rmsmod(const float* __restrict__ x, const float* __restrict__ gain, const float* __restrict__ modl, int shoff, int scoff, float* __restrict__ out) {
    const int t = blockIdx.x, b = t / S;
    const float* xr = x + (size_t)t * D;
    float v[4]; float ss = 0.f;
#pragma unroll
    for (int i = 0; i < 4; ++i) { v[i] = xr[threadIdx.x + 256 * i]; ss += v[i] * v[i]; }
    ss = block_sum256(ss);
    const float rs = rsqrtf(ss * (1.f / D) + 1e-6f);
#pragma unroll
    for (int i = 0; i < 4; ++i) { const int col = threadIdx.x + 256 * i;
        out[(size_t)t * D + col] = v[i] * rs * gain[col] * (1.f + modl[b * 6144 + scoff + col]) + modl[b * 6144 + shoff + col]; }
}

template <class Epi>
__global__ void __launch_bounds__(256) k_gemm(const float* __restrict__ A, const int* __restrict__ rowidx, const float* __restrict__ Bw, const int* __restrict__ tile_e, size_t bstride,
                                             Epi epi, int lda, int ldb, int N, int K) {
    __shared__ float As[16][68];
    __shared__ float Bs[16][68];
    const int row0 = blockIdx.y * 64, col0 = blockIdx.x * 64;
    int e = 0;
    if (tile_e) { e = tile_e[row0 / 256]; if (e < 0) return; }
    const float* Bp = Bw + (size_t)e * bstride;
    const int tid = threadIdx.x, ty = tid >> 4, tx = tid & 15;
    const int ar = tid >> 2, ak = (tid & 3) * 4;
    const int bk = tid >> 4, bn = (tid & 15) * 4;
    const int arow = rowidx ? rowidx[row0 + ar] : (row0 + ar);
    const float* Ap = A + (size_t)arow * lda + ak;
    float acc[4][4];
#pragma unroll
    for (int i = 0; i < 4; ++i)
#pragma unroll
        for (int j = 0; j < 4; ++j) acc[i][j] = 0.f;
    for (int k0 = 0; k0 < K; k0 += 16) {
        const float4 av = *(const float4*)(Ap + k0);
        float4 bv = make_float4(0.f, 0.f, 0.f, 0.f);
        if (col0 + bn < N) bv = *(const float4*)(Bp + (size_t)(k0 + bk) * ldb + col0 + bn);
        __syncthreads();
        As[ak + 0][ar] = av.x; As[ak + 1][ar] = av.y; As[ak + 2][ar] = av.z; As[ak + 3][ar] = av.w;
        *(float4*)&Bs[bk][bn] = bv;
        __syncthreads();
#pragma unroll
        for (int kk = 0; kk < 16; ++kk) {
            const float4 a4 = *(const float4*)&As[kk][ty * 4];
            const float4 b4 = *(const float4*)&Bs[kk][tx * 4];
            const float a[4] = {a4.x, a4.y, a4.z, a4.w}, b[4] = {b4.x, b4.y, b4.z, b4.w};
#pragma unroll
            for (int i = 0; i < 4; ++i)
#pragma unroll
                for (int j = 0; j < 4; ++j) acc[i][j] += a[i] * b[j];
        }
    }
#pragma unroll
    for (int i = 0; i < 4; ++i)
#pragma unroll
        for (int j = 0; j < 4; ++j) { const int r = row0 + ty * 4 + i, cidx = col0 + tx * 4 + j; if (cidx < N) epi(r, cidx, acc[i][j], e); }
}
struct EpiStore { float* C; const float* bias; int ldc; int bias_estride;
    __device__ __forceinline__ void operator()(int r, int c, float v, int e) const { C[(size_t)r * ldc + c] = v + (bias ? bias[(size_t)e * bias_estride + c] : 0.f); } };
struct EpiResid { float* X; const float* g; const float* bias;
    __device__ __forceinline__ void operator()(int r, int c, float v, int) const { const int b = r / S; X[(size_t)r * D + c] += g[b * 6144 + c] * (v + (bias ? bias[c] : 0.f)); } };

__global__ void k_postproj(float* __restrict__ PROJ, const float* __restrict__ qg, const float* __restrict__ kg, const float* __restrict__ qag, const float* __restrict__ kvag,
                           const float* __restrict__ mkg  , const int* __restrict__ positions) {
    const int t = blockIdx.x; float* r = PROJ + (size_t)t * MIXIN; const int tid = threadIdx.x;
    if (tid < 16) { float* p = r + tid * 64; const float* g = tid < 8 ? qg : kg; float ss = 0.f; for (int i = 0; i < 64; ++i) ss += p[i] * p[i];
        const float rs = rsqrtf(ss / 64.f + 1e-6f); for (int i = 0; i < 64; ++i) p[i] = p[i] * rs * g[i]; }
    else if (tid == 16) { float* p = r + 1536; float ss = 0.f; for (int i = 0; i < 256; ++i) ss += p[i] * p[i];
        const float rs = rsqrtf(ss / 256.f + 1e-6f); for (int i = 0; i < 256; ++i) p[i] = p[i] * rs * qag[i]; }
    else if (tid == 17) { float* p = r + 1792; float ss = 0.f; for (int i = 0; i < 128; ++i) ss += p[i] * p[i];
        const float rs = rsqrtf(ss / 128.f + 1e-6f); for (int i = 0; i < 128; ++i) p[i] = p[i] * rs * kvag[i]; }
    else if (tid == 18) { float* p = r + 1920; float ss = 0.f; for (int i = 0; i < 32; ++i) ss += p[i] * p[i];
        const float rs = rsqrtf(ss / 32.f + 1e-6f);
        const float pos = (float)positions[t];
        for (int i = 0; i < 16; ++i) { const float inv = powf(10000.f, -(float)(2 * i) / 32.f); const float ang = pos * inv; const float cs = cosf(ang), sn = sinf(ang);
            const float v1 = p[i] * rs * mkg[64 + i], v2 = p[16 + i] * rs * mkg[80 + i];
            p[i] = v1 * cs - v2 * sn; p[16 + i] = v1 * sn + v2 * cs; } }
}
__global__ void k_postq(float* __restrict__ Q2, float* __restrict__ KV2, const float* __restrict__ mqg, const float* __restrict__ mkg, const int* __restrict__ positions) {
    const int t = blockIdx.x, tid = threadIdx.x;
    if (tid < 8) { float* p = Q2 + (size_t)t * 768 + tid * 96; float ss = 0.f; for (int i = 0; i < 64; ++i) ss += p[i] * p[i];
        float rs = rsqrtf(ss / 64.f + 1e-6f); for (int i = 0; i < 64; ++i) p[i] = p[i] * rs * mqg[i];
        float* q = p + 64; ss = 0.f; for (int i = 0; i < 32; ++i) ss += q[i] * q[i]; rs = rsqrtf(ss / 32.f + 1e-6f);
        const float pos = (float)positions[t];
        for (int i = 0; i < 16; ++i) { const float inv = powf(10000.f, -(float)(2 * i) / 32.f); const float ang = pos * inv; const float cs = cosf(ang), sn = sinf(ang);
            const float v1 = q[i] * rs * mqg[64 + i], v2 = q[16 + i] * rs * mqg[80 + i];
            q[i] = v1 * cs - v2 * sn; q[16 + i] = v1 * sn + v2 * cs; } }
    else if (tid < 16) { float* p = KV2 + (size_t)t * 1024 + (tid - 8) * 128; float ss = 0.f; for (int i = 0; i < 64; ++i) ss += p[i] * p[i];
        const float rs = rsqrtf(ss / 64.f + 1e-6f); for (int i = 0; i < 64; ++i) p[i] = p[i] * rs * mkg[i]; }
}
__global__ void __launch_bounds__(256) k_mla(const float* __restrict__ Q2, const float* __restrict__ KV2, const float* __restrict__ PROJ, float* __restrict__ ATT) {
    const int wave = threadIdx.x >> 6, lane = threadIdx.x & 63;
    const int q = blockIdx.x * 4 + wave, h = blockIdx.y, b = blockIdx.z;
    const float* qrow = Q2 + (size_t)(b * S + q) * 768 + h * 96;
    float qv[96];
#pragma unroll
    for (int d = 0; d < 96; ++d) qv[d] = qrow[d];
    const float scale = 0.10206207261596575f;
    float m = -INFINITY, l = 0.f, o = 0.f;
    for (int k0 = 0; k0 <= q; k0 += 64) {
        const int k = k0 + lane; float s = -INFINITY;
        if (k <= q) { const float* kn = KV2 + (size_t)(b * S + k) * 1024 + h * 128; const float* kp = PROJ + (size_t)(b * S + k) * MIXIN + 1920; float acc = 0.f;
#pragma unroll
            for (int d = 0; d < 64; ++d) acc += qv[d] * kn[d];
#pragma unroll
            for (int d = 0; d < 32; ++d) acc += qv[64 + d] * kp[d];
            s = acc * scale; }
        const float mn = fmaxf(m, wave_max(s));
        const float alpha = expf(m - mn); const float p = (k <= q) ? expf(s - mn) : 0.f;
        l = l * alpha + wave_sum(p); o *= alpha;
        const int kend = min(64, q - k0 + 1);
        for (int kk = 0; kk < kend; ++kk) { const float pk = __shfl(p, kk); o += pk * KV2[(size_t)(b * S + k0 + kk) * 1024 + h * 128 + 64 + lane]; }
        m = mn;
    }
    ATT[(size_t)(b * S + q) * 1024 + 512 + h * 64 + lane] = o / l;
}
__global__ void __launch_bounds__(256) k_dil(const float* __restrict__ PROJ, float* __restrict__ ATT) {
    const int wave = threadIdx.x >> 6, lane = threadIdx.x & 63;
    const int t = blockIdx.x * 4 + wave, h = blockIdx.y, b = blockIdx.z;
    const float* base = PROJ + (size_t)(b * S) * MIXIN;
    const float* qrow = base + (size_t)t * MIXIN + h * 64;
    float qv[64];
#pragma unroll
    for (int d = 0; d < 64; ++d) qv[d] = qrow[d];
    float s[7]; float mx = -INFINITY;
#pragma unroll
    for (int c = 0; c < 7; ++c) { const int slot = c * 64 + lane; s[c] = -INFINITY;
        if (slot < 387) { const int p = slot / 129, j = slot % 129; const int dd = (p == 0) ? 1 : (p == 1) ? 4 : 16; const int tk = t - j * dd;
            if (tk >= 0) { const float* kr = base + (size_t)tk * MIXIN + 512 + h * 64; float acc = 0.f;
#pragma unroll
                for (int d = 0; d < 64; ++d) acc += qv[d] * kr[d];
                s[c] = acc * 0.125f; } }
        mx = fmaxf(mx, s[c]); }
    mx = wave_max(mx);
    float ls = 0.f;
#pragma unroll
    for (int c = 0; c < 7; ++c) { s[c] = expf(s[c] - mx); ls += s[c]; }
    ls = wave_sum(ls);
    float o = 0.f;
#pragma unroll
    for (int c = 0; c < 7; ++c)
        for (int kk = 0; kk < 64; ++kk) { const int slot = c * 64 + kk; if (slot >= 387) break; const int p = slot / 129, j = slot % 129; const int dd = (p == 0) ? 1 : (p == 1) ? 4 : 16; const int tk = t - j * dd;
            const float pk = __shfl(s[c], kk);
            if (tk >= 0) o += pk * base[(size_t)tk * MIXIN + 1024 + h * 64 + lane]; }
    ATT[(size_t)(b * S + t) * 1024 + h * 64 + lane] = o / ls;
}

__global__ void k_conv(const float* __restrict__ GX, const float* __restrict__ cw, const float* __restrict__ cb, float* __restrict__ XC) {
    const int t = blockIdx.x, ts = t % S;
    for (int c = threadIdx.x; c < 1024; c += 256) { float acc = cb[c];
#pragma unroll
        for (int k = 0; k < 4; ++k) { const int dt = k - 3; if (ts + dt >= 0) acc += cw[k * 1024 + c] * GX[(size_t)(t + dt) * 2048 + 1024 + c]; }
        XC[(size_t)t * 1024 + c] = acc; }
}
__global__ void k_lru(const float* __restrict__ RPRE, const float* __restrict__ IPRE, const float* __restrict__ XC, const float* __restrict__ lam, float* __restrict__ Aa, float* __restrict__ Bb) {
    const size_t i = (size_t)blockIdx.x * 256 + threadIdx.x; const int c = (int)(i & 1023);
    const float r = sigmoidf_(RPRE[i]), ig = sigmoidf_(IPRE[i]);
    const float nl = -lam[c]; const float sp = (nl > 20.f) ? nl : log1pf(expf(nl));
    const float log_a = -8.f * r * sp; const float a = expf(log_a); const float mult = sqrtf(-expm1f(2.f * log_a));
    Aa[i] = a; Bb[i] = mult * (ig * XC[i]);
}
__global__ void k_scan(const float* __restrict__ Aa, const float* __restrict__ Bb, float* __restrict__ Y) {
    const int idx = blockIdx.x * 256 + threadIdx.x; const int b = idx / 1024, c = idx % 1024;
    float h = 0.f; size_t off = (size_t)b * S * 1024 + c;
    for (int t = 0; t < S; ++t, off += 1024) { h = Aa[off] * h + Bb[off]; Y[off] = h; }
}
__global__ void k_gy(const float* __restrict__ GX, const float* __restrict__ Y, float* __restrict__ GY) {
    const size_t i = (size_t)blockIdx.x * 256 + threadIdx.x; const size_t t = i >> 10; const int c = (int)(i & 1023);
    GY[i] = gelu_tanh(GX[t * 2048 + c]) * Y[i];
}

__global__ void k_router(const float* __restrict__ x, const float* __restrict__ gain, const float* __restrict__ modl, const float* __restrict__ wr, const float* __restrict__ br,
                         float* __restrict__ HN2, int* __restrict__ topi, float* __restrict__ topg, int* __restrict__ cnt) {
    __shared__ float hrow[1024]; __shared__ float part[8][32]; __shared__ float lg[32];
    const int t = blockIdx.x, b = t / S, tid = threadIdx.x;
    const float* xr = x + (size_t)t * D;
    float v[4]; float ss = 0.f;
#pragma unroll
    for (int i = 0; i < 4; ++i) { v[i] = xr[tid + 256 * i]; ss += v[i] * v[i]; }
    ss = block_sum256(ss);
    const float rs = rsqrtf(ss * (1.f / D) + 1e-6f);
#pragma unroll
    for (int i = 0; i < 4; ++i) { const int col = tid + 256 * i; const float hv = v[i] * rs * gain[col] * (1.f + modl[b * 6144 + 4096 + col]) + modl[b * 6144 + 3072 + col];
        hrow[col] = hv; HN2[(size_t)t * D + col] = hv; }
    __syncthreads();
    { const int e = tid & 31, kp = tid >> 5; float acc = 0.f; for (int k = kp * 128; k < kp * 128 + 128; ++k) acc += hrow[k] * wr[k * 32 + e]; part[kp][e] = acc; }
    __syncthreads();
    if (tid < 32) { float a = br[tid]; for (int i = 0; i < 8; ++i) a += part[i][tid]; lg[tid] = a; }
    __syncthreads();
    if (tid == 0) { int idx[4]; float val[4]; unsigned used = 0u;
        for (int k = 0; k < 4; ++k) { int bi = -1; float bv = -INFINITY; for (int e = 0; e < 32; ++e) if (!((used >> e) & 1u) && lg[e] > bv) { bv = lg[e]; bi = e; } used |= 1u << bi; idx[k] = bi; val[k] = bv; }
        float den = 0.f, ex[4]; for (int k = 0; k < 4; ++k) { ex[k] = expf(val[k] - val[0]); den += ex[k]; }
        for (int k = 0; k < 4; ++k) { topi[t * 4 + k] = idx[k]; topg[t * 4 + k] = ex[k] / den; atomicAdd(&cnt[idx[k]], 1); } }
}
__global__ void k_plan(const int* __restrict__ cnt, int* __restrict__ pstart, int* __restrict__ tile_e) {
    if (threadIdx.x == 0) { int acc = 0, ti = 0;
        for (int e = 0; e < NE; ++e) { pstart[e] = acc; const int nt = (cnt[e] + 255) / 256; for (int i = 0; i < nt; ++i) tile_e[ti++] = e; acc += nt * 256; }
        for (; ti < NBLK; ++ti) tile_e[ti] = -1; }
}
__global__ void k_scatter(const int* __restrict__ topi, const int* __restrict__ pstart, int* __restrict__ fill, int* __restrict__ rowtok, int* __restrict__ pos) {
    const int i = blockIdx.x * 256 + threadIdx.x; const int e = topi[i];
    const int p = pstart[e] + atomicAdd(&fill[e], 1); rowtok[p] = i >> 2; pos[i] = p;
}
__global__ void k_swiglu(const float* __restrict__ HB, const int* __restrict__ tile_e, float* __restrict__ ACT) {
    const int p = blockIdx.x; if (tile_e[p / 256] < 0) return;
    for (int j = threadIdx.x; j < 1024; j += 256) { float g = HB[(size_t)p * 2048 + 2 * j], li = HB[(size_t)p * 2048 + 2 * j + 1];
        g = fminf(g, 7.f); li = fminf(fmaxf(li, -7.f), 7.f);
        ACT[(size_t)p * 1024 + j] = g * sigmoidf_(1.702f * g) * (li + 1.f); }
}
__global__ void k_combine(float* __restrict__ X, const float* __restrict__ Y2, const int* __restrict__ pos, const float* __restrict__ topg, const float* __restrict__ modl) {
    const int t = blockIdx.x, b = t / S;
    int pp[4]; float gg[4];
#pragma unroll
    for (int k = 0; k < 4; ++k) { pp[k] = pos[t * 4 + k]; gg[k] = topg[t * 4 + k]; }
    for (int c = threadIdx.x; c < 1024; c += 256) { float y = 0.f;
#pragma unroll
        for (int k = 0; k < 4; ++k) y += gg[k] * Y2[(size_t)pp[k] * 1024 + c];
        X[(size_t)t * D + c] += modl[b * 6144 + 5120 + c] * y; }
}

struct Bump { char* base; size_t off; template <class Tp> Tp* get(size_t n) { off = (off + 255) & ~(size_t)255; Tp* p = (Tp*)(base + off); off += n * sizeof(Tp); return p; } };

static void forward(void* const* d_in, float* X, void* d_ws, hipStream_t st) {
    const float* x = (const float*)d_in[0]; const float* c = (const float*)d_in[1]; const int* positions = (const int*)d_in[2];
    const float* ada_w = (const float*)d_in[3]; const float* ada_b = (const float*)d_in[4];
    const float* n1g = (const float*)d_in[5]; const float* n2g = (const float*)d_in[6];
    const float* attn_w_in = (const float*)d_in[7]; const float* da_qg = (const float*)d_in[8]; const float* da_kg = (const float*)d_in[9];
    const float* qag = (const float*)d_in[10]; const float* kvag = (const float*)d_in[11]; const float* w_uq = (const float*)d_in[12]; const float* w_ukv = (const float*)d_in[13];
    const float* mqg = (const float*)d_in[14]; const float* mkg = (const float*)d_in[15]; const float* attn_w_out = (const float*)d_in[16];
    const float* rec_w_in = (const float*)d_in[17]; const float* rec_b_in = (const float*)d_in[18]; const float* conv_w = (const float*)d_in[19]; const float* conv_b = (const float*)d_in[20];
    const float* rec_wa = (const float*)d_in[21]; const float* rec_ba = (const float*)d_in[22]; const float* rec_wx = (const float*)d_in[23]; const float* rec_bx = (const float*)d_in[24];
    const float* rec_lam = (const float*)d_in[25]; const float* rec_w_out = (const float*)d_in[26]; const float* rec_b_out = (const float*)d_in[27];
    const float* w_router = (const float*)d_in[28]; const float* b_router = (const float*)d_in[29]; const float* w1 = (const float*)d_in[30]; const float* b1 = (const float*)d_in[31];
    const float* w2 = (const float*)d_in[32]; const float* b2 = (const float*)d_in[33];

    Bump bp{(char*)d_ws, 0};
    int* ictl = bp.get<int>(1024);
    int* cnt = ictl, *fill = ictl + 64, *pstart = ictl + 128, *tile_e = ictl + 256;
    float* mod = bp.get<float>((size_t)DEPTH * 4 * 6144);
    float* HN = bp.get<float>((size_t)T * D);
    float* PROJ = bp.get<float>((size_t)T * 2048);
    float* Q2 = bp.get<float>((size_t)T * 768);
    float* KV2 = bp.get<float>((size_t)T * 1024);
    float* ATT = bp.get<float>((size_t)T * 1024);
    float* XC = bp.get<float>((size_t)T * 1024);
    float* RPRE = bp.get<float>((size_t)T * 1024);
    float* IPRE = bp.get<float>((size_t)T * 1024);
    float* Aa = bp.get<float>((size_t)T * 1024);
    float* Bb = bp.get<float>((size_t)T * 1024);
    float* Yv = bp.get<float>((size_t)T * 1024);
    int* topi = bp.get<int>((size_t)T * 4); float* topg = bp.get<float>((size_t)T * 4); int* pos = bp.get<int>((size_t)T * 4); int* rowtok = bp.get<int>(P);
    float* HB = bp.get<float>((size_t)P * 2048);
    float* ACT = bp.get<float>((size_t)P * 1024);
    float* Y2 = bp.get<float>((size_t)P * 1024);

    (void)hipMemcpyAsync(X, x, (size_t)T * D * 4, hipMemcpyDeviceToDevice, st);
    k_mod<<<dim3(6144 / 256, DEPTH), 256, 0, st>>>(c, ada_w, ada_b, mod);
    for (int l = 0; l < DEPTH; ++l) {
        const float* modl = mod + (size_t)l * 4 * 6144; const int j = l / 2;
        k_rmsmod<<<T, 256, 0, st>>>(X, n1g + l * D, modl, 0, 1024, HN);
        if (l % 2 == 0) {
            k_gemm<EpiStore><<<dim3((MIXIN + 63) / 64, T / 64), 256, 0, st>>>(HN, nullptr, attn_w_in + (size_t)j * D * MIXIN, nullptr, 0, EpiStore{PROJ, nullptr, MIXIN, 0}, D, MIXIN, MIXIN, D);
            k_postproj<<<T, 64, 0, st>>>(PROJ, da_qg + j * 64, da_kg + j * 64, qag + j * 256, kvag + j * 128, mkg + j * 96, positions);
            k_gemm<EpiStore><<<dim3(768 / 64, T / 64), 256, 0, st>>>(PROJ + 1536, nullptr, w_uq + (size_t)j * 256 * 768, nullptr, 0, EpiStore{Q2, nullptr, 768, 0}, MIXIN, 768, 768, 256);
            k_gemm<EpiStore><<<dim3(1024 / 64, T / 64), 256, 0, st>>>(PROJ + 1792, nullptr, w_ukv + (size_t)j * 128 * 1024, nullptr, 0, EpiStore{KV2, nullptr, 1024, 0}, MIXIN, 1024, 1024, 128);
            k_postq<<<T, 64, 0, st>>>(Q2, KV2, mqg + j * 96, mkg + j * 96, positions);
            k_dil<<<dim3(S / 4, 8, 4), 256, 0, st>>>(PROJ, ATT);
            k_mla<<<dim3(S / 4, 8, 4), 256, 0, st>>>(Q2, KV2, PROJ, ATT);
            k_gemm<EpiResid><<<dim3(D / 64, T / 64), 256, 0, st>>>(ATT, nullptr, attn_w_out + (size_t)j * 1024 * D, nullptr, 0, EpiResid{X, modl + 2048, nullptr}, 1024, D, D, 1024);
        } else {
            k_gemm<EpiStore><<<dim3(2048 / 64, T / 64), 256, 0, st>>>(HN, nullptr, rec_w_in + (size_t)j * D * 2048, nullptr, 0, EpiStore{PROJ, rec_b_in + j * 2048, 2048, 0}, D, 2048, 2048, D);
            k_conv<<<T, 256, 0, st>>>(PROJ, conv_w + j * 4 * 1024, conv_b + j * 1024, XC);
            for (int n = 0; n < 8; ++n) {
                k_gemm<EpiStore><<<dim3(2, T / 64), 256, 0, st>>>(XC + n * 128, nullptr, rec_wa + ((size_t)j * 8 + n) * 128 * 128, nullptr, 0, EpiStore{RPRE + n * 128, rec_ba + j * 1024 + n * 128, 1024, 0}, 1024, 128, 128, 128);
                k_gemm<EpiStore><<<dim3(2, T / 64), 256, 0, st>>>(XC + n * 128, nullptr, rec_wx + ((size_t)j * 8 + n) * 128 * 128, nullptr, 0, EpiStore{IPRE + n * 128, rec_bx + j * 1024 + n * 128, 1024, 0}, 1024, 128, 128, 128);
            }
            k_lru<<<T * 1024 / 256, 256, 0, st>>>(RPRE, IPRE, XC, rec_lam + j * 1024, Aa, Bb);
            k_scan<<<4096 / 256, 256, 0, st>>>(Aa, Bb, Yv);
            k_gy<<<T * 1024 / 256, 256, 0, st>>>(PROJ, Yv, ATT);
            k_gemm<EpiResid><<<dim3(D / 64, T / 64), 256, 0, st>>>(ATT, nullptr, rec_w_out + (size_t)j * 1024 * D, nullptr, 0, EpiResid{X, modl + 2048, rec_b_out + j * D}, 1024, D, D, 1024);
        }
        (void)hipMemsetAsync(ictl, 0, 1024 * 4, st);
        (void)hipMemsetAsync(rowtok, 0, (size_t)P * 4, st);
        k_router<<<T, 256, 0, st>>>(X, n2g + l * D, modl, w_router + (size_t)l * D * NE, b_router + l * NE, HN, topi, topg, cnt);
        k_plan<<<1, 64, 0, st>>>(cnt, pstart, tile_e);
        k_scatter<<<MPAIR / 256, 256, 0, st>>>(topi, pstart, fill, rowtok, pos);
        k_gemm<EpiStore><<<dim3(2048 / 64, P / 64), 256, 0, st>>>(HN, rowtok, w1 + (size_t)l * NE * D * 2048, tile_e, (size_t)D * 2048, EpiStore{HB, b1 + (size_t)l * NE * 2048, 2048, 2048}, D, 2048, 2048, D);
        k_swiglu<<<P, 256, 0, st>>>(HB, tile_e, ACT);
        k_gemm<EpiStore><<<dim3(1024 / 64, P / 64), 256, 0, st>>>(ACT, nullptr, w2 + (size_t)l * NE * 1024 * D, tile_e, (size_t)1024 * D, EpiStore{Y2, b2 + (size_t)l * NE * D, 1024, D}, 1024, D, D, 1024);
        k_combine<<<T, 256, 0, st>>>(X, Y2, pos, topg, modl);
    }
}
}


namespace mk {
#define LAS __attribute__((address_space(3)))
#define GAS __attribute__((address_space(1)))
typedef unsigned short bf16_t;
typedef short bf16x8 __attribute__((ext_vector_type(8)));
typedef short s16x4 __attribute__((ext_vector_type(4)));
typedef float f32x2 __attribute__((ext_vector_type(2)));
typedef float f32x4 __attribute__((ext_vector_type(4)));
typedef float f32x16 __attribute__((ext_vector_type(16)));
typedef unsigned u32x2 __attribute__((ext_vector_type(2)));
typedef unsigned u32x4 __attribute__((ext_vector_type(4)));
typedef GAS unsigned gu32;
#define RLX_AGENT __ATOMIC_RELAXED, __HIP_MEMORY_SCOPE_AGENT

__device__ __forceinline__ unsigned cvt_pk_bf16(float lo, float hi) { unsigned r; asm volatile("v_cvt_pk_bf16_f32 %0, %1, %2" : "=v"(r) : "v"(lo), "v"(hi)); return r; }
__device__ __forceinline__ float bf_lo(unsigned u) { return __uint_as_float(u << 16); }
__device__ __forceinline__ float bf_hi(unsigned u) { return __uint_as_float(u & 0xffff0000u); }
template <int O> __device__ __forceinline__ float shx(float v) { static_assert(O >= 1 && O < 32, "shx"); return __int_as_float(__builtin_amdgcn_ds_swizzle(__float_as_int(v), (O << 10) | 0x1f)); }
__device__ __forceinline__ float xadd32(float v) { const auto r = __builtin_amdgcn_permlane32_swap(__float_as_uint(v), __float_as_uint(v), false, false); return __uint_as_float(r[0]) + __uint_as_float(r[1]); }
__device__ __forceinline__ float xmax32(float v) { const auto r = __builtin_amdgcn_permlane32_swap(__float_as_uint(v), __float_as_uint(v), false, false); return fmaxf(__uint_as_float(r[0]), __uint_as_float(r[1])); }
__device__ __forceinline__ float wsum(float v) { v += shx<1>(v); v += shx<2>(v); v += shx<4>(v); v += shx<8>(v); v += shx<16>(v); return xadd32(v); }
__device__ __forceinline__ float fexp2(float x) { return __builtin_amdgcn_exp2f(x); }
__device__ __forceinline__ float frcp(float x) { return __builtin_amdgcn_rcpf(x); }
__device__ __forceinline__ float fsigmoid(float z) { return frcp(1.f + fexp2(-1.4426950408889634f * z)); }
__device__ __forceinline__ float fgelu_tanh(float x) { const float u = 0.7978845608028654f * (x + 0.044715f * x * x * x); return x * frcp(1.f + fexp2(-2.8853900817779268f * u)); }

#define XB_TMO      128
#define XB_XCNT(j)  (256  + 64 * (j))
#define XB_XSUB(j)  (1280 + 64 * (j))
#define XB_XGEN(j)  (2304 + 64 * (j))
#define XB_TOP      3328
#define XB_TOPGEN   3392
#define XCD_BAR_WORDS 3456
#define XB_SPIN_CAP (1u << 18)
__device__ __forceinline__ unsigned xb_ld(unsigned* p)              { return __hip_atomic_load(p, __ATOMIC_RELAXED, __HIP_MEMORY_SCOPE_AGENT); }
__device__ __forceinline__ unsigned xb_add(unsigned* p, unsigned v) { return __hip_atomic_fetch_add(p, v, __ATOMIC_RELAXED, __HIP_MEMORY_SCOPE_AGENT); }
__device__ __forceinline__ unsigned xb_xcc_id() { return (unsigned)__builtin_amdgcn_s_getreg((3 << 11) | 20) & 0xFu; }
#define XB_SPIN(cond, bar) do { unsigned _sp = 0; while (cond) { __builtin_amdgcn_s_sleep(1); \
    if ((++_sp & 255u) == 0u) { if (xb_ld(&(bar)[XB_TMO])) break; if (_sp > XB_SPIN_CAP) { atomicAdd(&(bar)[XB_TMO], 1u); break; } } } } while (0)
struct XcdBarrier { unsigned* bar; unsigned x; volatile LAS unsigned* st; };
__device__ __forceinline__ XcdBarrier xcd_barrier_post(unsigned* bar, volatile LAS unsigned* st) {
    XcdBarrier b; b.bar = bar; b.x = xb_xcc_id(); b.st = st;
    if (threadIdx.x == 0) (void)xb_add(&bar[XB_XCNT(b.x)], 1u);
    return b;
}
__device__ __forceinline__ void xcd_barrier_complete(unsigned* bar, unsigned x, unsigned& nloc, unsigned& nx) {
    const unsigned G = gridDim.x * gridDim.y * gridDim.z;
    unsigned sum, cnt, mine, sp = 0u;
    for (;;) {
        sum = 0u; cnt = 0u; mine = 0u;
#pragma unroll
        for (unsigned j = 0; j < 16; ++j) { const unsigned c = xb_ld(&bar[XB_XCNT(j)]); sum += c; cnt += (c > 0u) ? 1u : 0u; mine = (j == x) ? c : mine; }
        if (sum == G) break;
        __builtin_amdgcn_s_sleep(1);
        if ((++sp & 255u) == 0u) { if (xb_ld(&bar[XB_TMO])) break; if (sp > XB_SPIN_CAP) { atomicAdd(&bar[XB_TMO], 1u); break; } }
    }
    nloc = mine > 0u ? mine : 1u; nx = cnt > 0u ? cnt : 1u;
}
__device__ __forceinline__ void xcd_barrier(const XcdBarrier& b) {
    asm volatile("s_waitcnt vmcnt(0)" ::: "memory");
    __syncthreads();
    if (threadIdx.x == 0) {
        unsigned* bar = b.bar;
        __builtin_amdgcn_s_waitcnt(0);
        unsigned nloc = b.st[0], nx = b.st[1];
        if (nloc == 0u) { xcd_barrier_complete(bar, b.x, nloc, nx); b.st[0] = nloc; b.st[1] = nx; }
        const unsigned old = xb_add(&bar[XB_XSUB(b.x)], 1u);
        const unsigned gen = old / nloc;
        if (old + 1u == (gen + 1u) * nloc) {
            __builtin_amdgcn_fence(__ATOMIC_RELEASE, "agent");
            asm volatile("s_waitcnt vmcnt(0)" ::: "memory");
            const unsigned og = xb_add(&bar[XB_TOP], 1u);
            const unsigned tg = og / nx;
            if (og + 1u == (tg + 1u) * nx) xb_add(&bar[XB_TOPGEN], 1u);
            else XB_SPIN(xb_ld(&bar[XB_TOPGEN]) == tg, bar);
            __builtin_amdgcn_fence(__ATOMIC_ACQUIRE, "agent");
            xb_add(&bar[XB_XGEN(b.x)], 1u);
            asm volatile("s_waitcnt vmcnt(0)" ::: "memory");
        } else {
            XB_SPIN(xb_ld(&bar[XB_XGEN(b.x)]) == gen, bar);
            __builtin_amdgcn_fence(__ATOMIC_ACQUIRE, "agent");
            asm volatile("s_waitcnt vmcnt(0)" ::: "memory");
        }
    }
    __syncthreads();
}

constexpr int BM = 256, BK = 64, HALF = 128, HTB = HALF * BK * 2, STAGE_BYTES = 8 * HTB;
__host__ __device__ __forceinline__ int lds_byte(int r, int c) { const int st = (r >> 4) * 2 + (c >> 5), rr = r & 15, cc = c & 31, ob = rr * 64 + cc * 2; return st * 1024 + (ob ^ (((ob >> 9) & 1) << 5)); }
__host__ __device__ __forceinline__ void stage_rc(int b, int& R, int& C) { const int st = b / 1024, sb = b % 1024, swz = sb ^ (((sb >> 9) & 1) << 5); R = (st >> 1) * 16 + swz / 64; C = (st & 1) * 32 + (swz % 64) / 2; }
__host__ __device__ __forceinline__ int perm32(int rho) { const int n = rho >> 4, i = rho & 15; return 8 * (i >> 2) + 4 * n + (i & 3); }

struct Unit { const char* a; const char* b; int row0, col0, e, pad; };
struct GemmDims { int K, lda, ldb; };
typedef f32x4 Acc[2][2][4][2];
__device__ __forceinline__ void zero_acc(Acc& acc) {
#pragma unroll
    for (int a = 0; a < 2; ++a)
#pragma unroll
        for (int b = 0; b < 2; ++b)
#pragma unroll
            for (int m = 0; m < 4; ++m)
#pragma unroll
                for (int n = 0; n < 2; ++n)
#pragma unroll
                    for (int j = 0; j < 4; ++j) { float z; asm volatile("v_mov_b32 %0, 0" : "=v"(z)); acc[a][b][m][n][j] = z; }
}

template <class CtxT, class Epi, class Sched>
__device__ __forceinline__ void gemm_phase(const CtxT& C, const GemmDims g, const Sched& S, const Epi& E) {
    LAS unsigned char* lds = C.lds;
    const int tid = C.tid, wid = __builtin_amdgcn_readfirstlane(tid >> 6), lane = tid & 63, wr = wid >> 2, wc = wid & 3, fr = lane & 15, fq = lane >> 4;
    int nt = g.K / BK; asm volatile("" : "+s"(nt));
    unsigned voffA[2], voffB[2];
#pragma unroll
    for (int i = 0; i < 2; ++i) { int R, C; stage_rc(tid * 16 + i * 8192, R, C); const int Rb = (R & ~31) + perm32(R & 31);
        voffA[i] = (unsigned)(R * g.lda + C) * 2u; voffB[i] = (unsigned)(Rb * g.ldb + C) * 2u; }
    const size_t kstep = (size_t)(BK * 2);
    const size_t hstepA = (size_t)HALF * g.lda * 2, hstepB = (size_t)HALF * g.ldb * 2;
    const unsigned ldsw = (unsigned)wid * 1024u;
    const int aoff = lds_byte(wr * 64 + fr, fq * 8), boff = lds_byte(wc * 32 + fr, fq * 8);
#define PG8_SA(b, h) (((b) * 2 + (h)) * HTB)
#define PG8_SB(b, h) ((4 + (b) * 2 + (h)) * HTB)
#define PG8_STAGE(bufoff, gbase, voff) do { _Pragma("unroll") for (int _i = 0; _i < 2; ++_i) \
        __builtin_amdgcn_global_load_lds((const unsigned*)((const char*)(gbase) + (voff)[_i]), (LAS unsigned*)(lds + (bufoff) + ldsw + _i * 8192), 16, 0, 0); } while (0)
#define PG8_LDA(dst, b, h) do { _Pragma("unroll") for (int m = 0; m < 4; ++m) _Pragma("unroll") for (int k = 0; k < 2; ++k) dst[m][k] = *(const LAS bf16x8*)(lds + PG8_SA(b, h) + aoff + m * 2048 + k * 1024); } while (0)
#define PG8_LDB(dst, b, h) do { _Pragma("unroll") for (int n = 0; n < 2; ++n) _Pragma("unroll") for (int k = 0; k < 2; ++k) dst[n][k] = *(const LAS bf16x8*)(lds + PG8_SB(b, h) + boff + n * 2048 + k * 1024); } while (0)
#define PG8_MMA(ai, bj, At, Bt) do { __builtin_amdgcn_s_setprio(1); _Pragma("unroll") for (int m = 0; m < 4; ++m) _Pragma("unroll") for (int n = 0; n < 2; ++n) _Pragma("unroll") for (int k = 0; k < 2; ++k) \
        acc[ai][bj][m][n] = __builtin_amdgcn_mfma_f32_16x16x32_bf16(Bt[n][k], At[m][k], acc[ai][bj][m][n], 0, 0, 0); __builtin_amdgcn_s_setprio(0); } while (0)
#define PG8_WAIT_V(n) asm volatile("s_waitcnt vmcnt(" #n ")" ::: "memory")
#define PG8_WAIT_L(n) asm volatile("s_waitcnt lgkmcnt(" #n ")" ::: "memory")
#define PG8_BAR __builtin_amdgcn_s_barrier()
#define PG8_SCHED __builtin_amdgcn_sched_barrier(0)
    Unit cur, nxt; int ui = 0;
    if (!S.next(0, cur)) return;
    Acc acc; zero_acc(acc);
    bf16x8 At[4][2], B0[2][2], B1[2][2];
    const char* cA = cur.a; const char* cB = cur.b;
    PG8_STAGE(PG8_SB(0, 0), cB, voffB); PG8_STAGE(PG8_SB(0, 1), cB + hstepB, voffB); PG8_STAGE(PG8_SA(0, 0), cA, voffA); PG8_STAGE(PG8_SA(0, 1), cA + hstepA, voffA);
    if (wr == 1) PG8_BAR;
    PG8_WAIT_V(2); PG8_BAR;
    PG8_STAGE(PG8_SB(1, 0), cB + kstep, voffB); PG8_STAGE(PG8_SA(1, 0), cA + kstep, voffA); PG8_STAGE(PG8_SB(1, 1), cB + hstepB + kstep, voffB);
    PG8_WAIT_V(6); PG8_BAR;
    for (;;) {
        const bool has_next = S.next(ui + 1, nxt);
        const char* nA = has_next ? nxt.a : cA; const char* nB = has_next ? nxt.b : cB;
        for (int t = 0; t < nt; t += 2) {
            const bool last = (t == nt - 2);
            const char* a1 = cA + (size_t)(t + 1) * kstep;
            const char* a2 = last ? nA : cA + (size_t)(t + 2) * kstep; const char* b2 = last ? nB : cB + (size_t)(t + 2) * kstep;
            const char* a3 = a2 + kstep; const char* b3 = b2 + kstep;
            PG8_LDB(B0, 0, 0); PG8_LDB(B1, 0, 1); PG8_SCHED; PG8_LDA(At, 0, 0); PG8_STAGE(PG8_SA(1, 1), a1 + hstepA, voffA);
            PG8_WAIT_V(8); PG8_WAIT_L(0); PG8_BAR; PG8_MMA(0, 0, At, B0); PG8_MMA(0, 1, At, B1); PG8_BAR; PG8_SCHED;
            PG8_LDA(At, 0, 1); PG8_STAGE(PG8_SB(0, 0), b2, voffB); PG8_STAGE(PG8_SB(0, 1), b2 + hstepB, voffB); PG8_STAGE(PG8_SA(0, 0), a2, voffA);
            PG8_WAIT_V(8); PG8_WAIT_L(0); PG8_BAR; PG8_MMA(1, 0, At, B0); PG8_MMA(1, 1, At, B1); PG8_BAR; PG8_SCHED;
            PG8_LDB(B0, 1, 0); PG8_LDB(B1, 1, 1); PG8_SCHED; PG8_LDA(At, 1, 0); PG8_STAGE(PG8_SA(0, 1), a2 + hstepA, voffA);
            PG8_WAIT_V(8); PG8_WAIT_L(0); PG8_BAR; PG8_MMA(0, 0, At, B0); PG8_MMA(0, 1, At, B1); PG8_BAR; PG8_SCHED;
            PG8_LDA(At, 1, 1); PG8_STAGE(PG8_SB(1, 0), b3, voffB); PG8_STAGE(PG8_SB(1, 1), b3 + hstepB, voffB); PG8_STAGE(PG8_SA(1, 0), a3, voffA);
            PG8_WAIT_V(8); PG8_WAIT_L(0); PG8_BAR; PG8_MMA(1, 0, At, B0); PG8_MMA(1, 1, At, B1); PG8_BAR; PG8_SCHED;
        }
        if (wr == 0) PG8_BAR;
        E(acc, cur, wr, wc, fr, fq);
        if (!has_next) break;
        zero_acc(acc);
        cur = nxt; cA = nA; cB = nB; ++ui;
        if (wr == 1) PG8_BAR;
    }
    PG8_WAIT_V(0);
    PG8_BAR;
#undef PG8_SA
#undef PG8_SB
#undef PG8_STAGE
#undef PG8_LDA
#undef PG8_LDB
#undef PG8_MMA
#undef PG8_WAIT_V
#undef PG8_WAIT_L
#undef PG8_BAR
#undef PG8_SCHED
}

struct DenseOrder {
    const char* A; const char* Bt; int lda, ldb, nM, nN, nwg, G, c;
    __device__ __forceinline__ void init(const void* A_, const void* Bt_, int lda_, int ldb_, int M, int N, int G_, int c_) { A = (const char*)A_; Bt = (const char*)Bt_; lda = lda_; ldb = ldb_; nM = M / BM; nN = N / BM; nwg = nM * nN; G = G_; c = c_; }
    __device__ __forceinline__ bool next(int i, Unit& u) const {
        const long L = (long)i * G + c; if (L >= nwg) return false;
        int wgid = (int)L; { const int q = nwg / 8, r = nwg % 8, xcd = wgid % 8, off = wgid / 8; wgid = (xcd < r ? xcd * (q + 1) : r * (q + 1) + (xcd - r) * q) + off; }
        const int nig = 8 * nN, gid = wgid / nig, fm = gid * 8, gsz = (nM - fm) < 8 ? (nM - fm) : 8;
        const int pm = fm + ((wgid % nig) % gsz), pn = (wgid % nig) / gsz;
        u.a = A + (size_t)pm * BM * lda * 2; u.b = Bt + (size_t)pn * BM * ldb * 2; u.row0 = pm * BM; u.col0 = pn * BM; u.e = 0; u.pad = 0; return true;
    }
};
struct LruOrder {
    const char* XC; const char* RG; int G, c;
    __device__ __forceinline__ bool next(int i, Unit& u) const {
        const int L = i * G + c; if (L >= 512) return false;
        const int pm = L >> 3, n = L & 7;
        u.a = XC + ((size_t)pm * BM * 1024 + n * 128) * 2; u.b = RG + (size_t)n * 256 * 128 * 2; u.row0 = pm * BM; u.col0 = n * 128; u.e = n; u.pad = 0; return true;
    }
};
struct MoeOrder {
    const char* A; const char* WT; size_t estride; const LAS int* tile_e; int NT, nN, G, c;
    __device__ __forceinline__ bool next(int i, Unit& u) const {
        int tile, pn;
        if ((G % (8 * nN)) == 0) { const int R = G / nN; tile = i * R + (c & 7) * (R >> 3) + (c >> 3) / nN; pn = (c >> 3) % nN; }
        else { const int L = i * G + c; tile = L / nN; pn = L % nN; }
        if (tile >= NT) return false;
        const int e = __builtin_amdgcn_readfirstlane(tile_e[tile]);
        u.a = A + (size_t)tile * BM * 1024 * 2; u.b = WT + (size_t)e * estride + (size_t)pn * BM * 1024 * 2; u.row0 = tile * BM; u.col0 = pn * BM; u.e = e; u.pad = 0; return true;
    }
};

#define EPI_ROW(ai, m) (u.row0 + (ai) * HALF + wr * 64 + (m) * 16 + fr)
#define EPI_COL(bj) (u.col0 + (bj) * HALF + wc * 32 + 8 * fq)
struct EpiBf16 {
    bf16_t* O; const float* bias; int ldc, bias_es;
    __device__ __forceinline__ void operator()(const Acc& acc, const Unit& u, int wr, int wc, int fr, int fq) const {
        f32x4 bv[2][2];
#pragma unroll
        for (int bj = 0; bj < 2; ++bj)
#pragma unroll
            for (int n = 0; n < 2; ++n) bv[bj][n] = bias ? *(const f32x4*)(bias + (size_t)u.e * bias_es + EPI_COL(bj) + 4 * n) : (f32x4){0.f, 0.f, 0.f, 0.f};
#pragma unroll
        for (int ai = 0; ai < 2; ++ai)
#pragma unroll
            for (int m = 0; m < 4; ++m) { bf16_t* rowp = O + (size_t)EPI_ROW(ai, m) * ldc;
#pragma unroll
                for (int bj = 0; bj < 2; ++bj) { const f32x4 v0 = acc[ai][bj][m][0] + bv[bj][0], v1 = acc[ai][bj][m][1] + bv[bj][1];
                    u32x4 w; w.x = cvt_pk_bf16(v0[0], v0[1]); w.y = cvt_pk_bf16(v0[2], v0[3]); w.z = cvt_pk_bf16(v1[0], v1[1]); w.w = cvt_pk_bf16(v1[2], v1[3]);
                    *(u32x4*)(rowp + EPI_COL(bj)) = w; } }
    }
};
struct EpiRecIn {
    bf16_t* O; const float* bias;
    __device__ __forceinline__ void operator()(const Acc& acc, const Unit& u, int wr, int wc, int fr, int fq) const {
        const bool act = u.col0 < 1024;
        f32x4 bv[2][2];
#pragma unroll
        for (int bj = 0; bj < 2; ++bj)
#pragma unroll
            for (int n = 0; n < 2; ++n) bv[bj][n] = *(const f32x4*)(bias + EPI_COL(bj) + 4 * n);
#pragma unroll
        for (int ai = 0; ai < 2; ++ai)
#pragma unroll
            for (int m = 0; m < 4; ++m) { bf16_t* rowp = O + (size_t)EPI_ROW(ai, m) * 2048;
#pragma unroll
                for (int bj = 0; bj < 2; ++bj) { f32x4 v0 = acc[ai][bj][m][0] + bv[bj][0], v1 = acc[ai][bj][m][1] + bv[bj][1];
                    if (act) {
#pragma unroll
                        for (int j = 0; j < 4; ++j) { v0[j] = fgelu_tanh(v0[j]); v1[j] = fgelu_tanh(v1[j]); } }
                    u32x4 w; w.x = cvt_pk_bf16(v0[0], v0[1]); w.y = cvt_pk_bf16(v0[2], v0[3]); w.z = cvt_pk_bf16(v1[0], v1[1]); w.w = cvt_pk_bf16(v1[2], v1[3]);
                    *(u32x4*)(rowp + EPI_COL(bj)) = w; } }
    }
};
struct EpiSwiglu {
    bf16_t* ACT; const float* b1;
    __device__ __forceinline__ float sw(float g, float l) const { g = fminf(g, 7.f); l = fminf(fmaxf(l, -7.f), 7.f); return g * fsigmoid(1.702f * g) * (l + 1.f); }
    __device__ __forceinline__ void operator()(const Acc& acc, const Unit& u, int wr, int wc, int fr, int fq) const {
        f32x4 bv[2][2];
#pragma unroll
        for (int bj = 0; bj < 2; ++bj)
#pragma unroll
            for (int n = 0; n < 2; ++n) bv[bj][n] = *(const f32x4*)(b1 + (size_t)u.e * 2048 + EPI_COL(bj) + 4 * n);
#pragma unroll
        for (int ai = 0; ai < 2; ++ai)
#pragma unroll
            for (int m = 0; m < 4; ++m) { bf16_t* rowp = ACT + (size_t)EPI_ROW(ai, m) * 1024;
#pragma unroll
                for (int bj = 0; bj < 2; ++bj) { const f32x4 v0 = acc[ai][bj][m][0] + bv[bj][0], v1 = acc[ai][bj][m][1] + bv[bj][1];
                    u32x2 w; w.x = cvt_pk_bf16(sw(v0[0], v0[1]), sw(v0[2], v0[3])); w.y = cvt_pk_bf16(sw(v1[0], v1[1]), sw(v1[2], v1[3]));
                    *(u32x2*)(rowp + (EPI_COL(bj) >> 1)) = w; } }
    }
};
struct EpiResid {
    float* X; const float* g; const float* bias;
    __device__ __forceinline__ void operator()(const Acc& acc, const Unit& u, int wr, int wc, int fr, int fq) const {
        const int b = u.row0 / cfg::S;
        f32x4 bv[2][2], gv[2][2];
#pragma unroll
        for (int bj = 0; bj < 2; ++bj)
#pragma unroll
            for (int n = 0; n < 2; ++n) { bv[bj][n] = bias ? *(const f32x4*)(bias + EPI_COL(bj) + 4 * n) : (f32x4){0.f, 0.f, 0.f, 0.f}; gv[bj][n] = *(const f32x4*)(g + b * 6144 + EPI_COL(bj) + 4 * n); }
#pragma unroll
        for (int ai = 0; ai < 2; ++ai)
#pragma unroll
            for (int m = 0; m < 4; ++m) { float* rowp = X + (size_t)EPI_ROW(ai, m) * 1024;
#pragma unroll
                for (int bj = 0; bj < 2; ++bj)
#pragma unroll
                    for (int n = 0; n < 2; ++n) { f32x4* p = (f32x4*)(rowp + EPI_COL(bj) + 4 * n); *p = *p + gv[bj][n] * (acc[ai][bj][m][n] + bv[bj][n]); }
                if (m & 1) asm volatile("" ::: "memory"); }
    }
};
struct EpiLru {
    const bf16_t* XC; const float* ba; const float* bx; const float* lam; float* Aa; float* Bb;
    __device__ __forceinline__ void operator()(const Acc& acc, const Unit& u, int wr, int wc, int fr, int fq) const {
        const int ch0 = u.col0 + wc * 32 + 8 * fq;
#pragma unroll
        for (int n = 0; n < 2; ++n) { const int ch = ch0 + 4 * n;
            const f32x4 bav = *(const f32x4*)(ba + ch), bxv = *(const f32x4*)(bx + ch), spv = *(const f32x4*)(lam + ch);
#pragma unroll
            for (int ai = 0; ai < 2; ++ai)
#pragma unroll
                for (int m = 0; m < 4; ++m) { const size_t ro = (size_t)EPI_ROW(ai, m) * 1024 + ch;
                    const u32x2 xr = *(const u32x2*)(XC + ro);
                    const float xcv[4] = {bf_lo(xr.x), bf_hi(xr.x), bf_lo(xr.y), bf_hi(xr.y)};
                    f32x4 av, bvv;
#pragma unroll
                    for (int j = 0; j < 4; ++j) { const float r = fsigmoid(acc[ai][0][m][n][j] + bav[j]), ig = fsigmoid(acc[ai][1][m][n][j] + bxv[j]);
                        const float a = fexp2(r * spv[j]); av[j] = a; bvv[j] = __builtin_amdgcn_sqrtf(fmaxf(1.f - a * a, 0.f)) * ig * xcv[j]; }
                    *(f32x4*)(Aa + ro) = av; *(f32x4*)(Bb + ro) = bvv; asm volatile("" ::: "memory"); } }
    }
};

constexpr size_t MiB = (size_t)1 << 20;
constexpr size_t al4k(size_t x) { return (x + 4095) & ~(size_t)4095; }
constexpr int T_ = cfg::T, S_ = cfg::S, P_ = cfg::P;
constexpr size_t O_CTL = 0, SZ_CTL = 1 * MiB;
constexpr size_t O_MOD = O_CTL + SZ_CTL, SZ_MOD = al4k((size_t)4 * 4 * 6144 * 4);
constexpr size_t O_CS = O_MOD + SZ_MOD, SZ_CS = (size_t)T_ * 32 * 4;
constexpr size_t O_HIST = O_CS + SZ_CS, SZ_HIST = 256 * 32 * 4;
constexpr size_t O_TOPI = O_HIST + SZ_HIST, SZ_TOP = (size_t)T_ * 4 * 4;
constexpr size_t O_TOPG = O_TOPI + SZ_TOP, O_POS = O_TOPG + SZ_TOP;
constexpr size_t O_SUMP = O_POS + SZ_TOP, SZ_SUM = (size_t)4 * 64 * 1024 * 4;
constexpr size_t O_SUMH = O_SUMP + SZ_SUM;
constexpr size_t O_LSE = O_SUMH + SZ_SUM, SZ_LSE = (size_t)3 * T_ * 8 * 4;
constexpr size_t O_SPV = al4k(O_LSE + SZ_LSE), SZ_SPV = 2 * 1024 * 4;
constexpr size_t O_WIN = al4k(O_SPV + SZ_SPV), SZ_WIN = (size_t)2048 * 1024 * 2;
constexpr size_t O_WUQ = O_WIN + 2 * SZ_WIN, SZ_WUQ = (size_t)768 * 256 * 2;
constexpr size_t O_WUKV = O_WUQ + 2 * SZ_WUQ, SZ_WUKV = (size_t)1024 * 128 * 2;
constexpr size_t O_WOUT = O_WUKV + 2 * SZ_WUKV, SZ_WOUT = (size_t)1024 * 1024 * 2;
constexpr size_t O_RWIN = O_WOUT + 2 * SZ_WOUT, SZ_RWIN = (size_t)2048 * 1024 * 2;
constexpr size_t O_RGATE = O_RWIN + 2 * SZ_RWIN, SZ_RGATE = (size_t)8 * 256 * 128 * 2;
constexpr size_t O_RWOUT = O_RGATE + 2 * SZ_RGATE, SZ_RWOUT = (size_t)1024 * 1024 * 2;
constexpr size_t O_W1 = O_RWOUT + 2 * SZ_RWOUT, SZ_W1E = (size_t)2048 * 1024 * 2;
constexpr size_t O_W2 = O_W1 + 128 * SZ_W1E, SZ_W2E = (size_t)1024 * 1024 * 2;
constexpr size_t O_HN = O_W2 + 128 * SZ_W2E, SZ_HN = (size_t)T_ * 1024 * 2;
constexpr size_t O_PROJ = O_HN + SZ_HN, SZ_PROJ = (size_t)T_ * 2048 * 2;
constexpr size_t O_Q2 = O_PROJ + SZ_PROJ, SZ_Q2 = (size_t)T_ * 768 * 2;
constexpr size_t O_KV2 = O_Q2 + SZ_Q2, SZ_KV2 = (size_t)T_ * 1024 * 2;
constexpr size_t O_OA = O_KV2 + SZ_KV2, SZ_OA = (size_t)3 * T_ * 512 * 2;
constexpr size_t O_ATT = O_OA + SZ_OA, SZ_ATT = (size_t)T_ * 1024 * 2;
constexpr size_t O_XC = O_ATT + SZ_ATT, SZ_XC = (size_t)T_ * 1024 * 2;
constexpr size_t O_AA = O_XC + SZ_XC, SZ_AA = (size_t)T_ * 1024 * 4;
constexpr size_t O_BB = O_AA + SZ_AA;
constexpr size_t O_XG = O_BB + SZ_AA, SZ_XG = (size_t)P_ * 1024 * 2;
constexpr size_t O_ACT = O_XG + SZ_XG, O_Y2 = O_ACT + SZ_XG;
constexpr size_t WS_MK_END = O_Y2 + SZ_XG;
constexpr size_t O_NAIVE = (size_t)2048 * MiB;
static_assert(WS_MK_END <= O_NAIVE, "mk workspace");
constexpr int CW_BAR = 4096;
constexpr int RING_BYTES = 131072, LDSX_OFF = RING_BYTES;
constexpr int LDS_BYTES = 147456;
constexpr int LX_TILE = LDSX_OFF + 64, LX_MISC = LDSX_OFF + 2048;

struct Args { const void* in[34]; float* out; unsigned char* ws; int ph_lo, ph_hi; };
struct Ctx { int tid, lane, wave, G, bid, vcu, gw, NGW; LAS unsigned char* lds; unsigned char* ws; };

__device__ __forceinline__ void conv_item(const float* __restrict__ W, int N, bf16_t* __restrict__ WT, int ldd, int n0, int k0, int nrows, int lane) {
    const int n = n0 + 4 * lane;
#pragma unroll 1
    for (int kk = 0; kk < 8; ++kk) {
        f32x4 v[8];
#pragma unroll
        for (int r = 0; r < 8; ++r) v[r] = (n < N) ? *(const f32x4*)(W + (size_t)(k0 + kk * 8 + r) * N + n) : (f32x4){0.f, 0.f, 0.f, 0.f};
#pragma unroll
        for (int jj = 0; jj < 4; ++jj) { u32x4 o; o.x = cvt_pk_bf16(v[0][jj], v[1][jj]); o.y = cvt_pk_bf16(v[2][jj], v[3][jj]); o.z = cvt_pk_bf16(v[4][jj], v[5][jj]); o.w = cvt_pk_bf16(v[6][jj], v[7][jj]);
            if (n + jj < nrows) *(u32x4*)(WT + (size_t)(n + jj) * ldd + k0 + kk * 8) = o; }
    }
}
template <class AP> __device__ __forceinline__ void p0_prologue(const Ctx& C, AP a) {
    unsigned char* ws = C.ws;
    { const float* c = (const float*)a->in[1]; const float* ada_w = (const float*)a->in[3]; const float* ada_b = (const float*)a->in[4]; float* mod = (float*)(ws + O_MOD);
      LAS float* part = (LAS float*)C.lds;
      for (int it = C.bid; it < 4 * 24; it += C.G) { const int l = it / 24, n0 = (it % 24) * 256;
          f32x4 acc[4];
#pragma unroll
          for (int b = 0; b < 4; ++b) acc[b] = (f32x4){0.f, 0.f, 0.f, 0.f};
          const float* w = ada_w + (size_t)l * 1024 * 6144 + n0 + 4 * C.lane;
          for (int k = C.wave * 128; k < C.wave * 128 + 128; ++k) { const f32x4 wv = *(const f32x4*)(w + (size_t)k * 6144);
#pragma unroll
              for (int b = 0; b < 4; ++b) { const float cv = c[b * 1024 + k]; const float sv = cv / (1.f + expf(-cv)); acc[b] = acc[b] + sv * wv; } }
#pragma unroll
          for (int b = 0; b < 4; ++b) *(LAS f32x4*)(part + (C.wave * 4 + b) * 256 + 4 * C.lane) = acc[b];
          __syncthreads();
          for (int o = C.tid; o < 1024; o += 512) { const int b = o >> 8, n = o & 255; float s = ada_b[l * 6144 + n0 + n];
#pragma unroll
              for (int w8 = 0; w8 < 8; ++w8) s += part[(w8 * 4 + b) * 256 + n];
              mod[((size_t)l * 4 + b) * 6144 + n0 + n] = s; }
          __syncthreads(); } }
    { const int* positions = (const int*)a->in[2]; float* cs = (float*)(ws + O_CS);
      for (int i = C.bid * 512 + C.tid; i < T_ * 16; i += C.G * 512) { const int t = i >> 4, f = i & 15; const float inv = powf(10000.f, -(float)(2 * f) / 32.f); const float ang = (float)positions[t] * inv;
          cs[t * 32 + f] = cosf(ang); cs[t * 32 + 16 + f] = sinf(ang); } }
    { const float* lam = (const float*)a->in[25]; float* spv = (float*)(ws + O_SPV);
      for (int i = C.bid * 512 + C.tid; i < 2048; i += C.G * 512) spv[i] = -8.f * 1.4426950408889634f * log1pf(expf(-lam[i])); }
    { const int lane = C.lane;
      const float* attn_w_in = (const float*)a->in[7]; const float* w_uq = (const float*)a->in[12]; const float* w_ukv = (const float*)a->in[13]; const float* attn_w_out = (const float*)a->in[16];
      const float* rec_w_in = (const float*)a->in[17]; const float* rec_wa = (const float*)a->in[21]; const float* rec_wx = (const float*)a->in[23]; const float* rec_w_out = (const float*)a->in[26];
      const float* w1 = (const float*)a->in[30]; const float* w2 = (const float*)a->in[32];
      constexpr int I_WIN = 8 * 16, I_WUQ = 3 * 4, I_WUKV = 4 * 2, I_WOUT = 4 * 16, I_RWIN = 8 * 16, I_RG = 1 * 2, I_RWOUT = 4 * 16, I_W1 = 8 * 16, I_W2 = 4 * 16;
      constexpr int NSMALL = 2 * (I_WIN + I_WUQ + I_WUKV + I_WOUT + I_RWIN + 16 * I_RG + I_RWOUT);
      constexpr int NITEMS = NSMALL + 128 * I_W1 + 128 * I_W2;
#define CONV_JOB(SRC, KK, NN, DST, NROWS, NMAT, SRC_MS, DST_MS) { constexpr int kc_ = (KK) / 64, per_ = (((NROWS) + 255) / 256) * kc_, tot_ = per_ * (NMAT); \
          if (r < tot_) { const int mat_ = r / per_, q_ = r % per_; conv_item((SRC) + (size_t)mat_ * (SRC_MS), (NN), (bf16_t*)(ws + (DST) + (size_t)mat_ * (DST_MS)), (KK), (q_ / kc_) * 256, (q_ % kc_) * 64, (NROWS), lane); continue; } r -= tot_; }
      for (int it = C.gw; it < NITEMS; it += C.NGW) { int r = it;
          CONV_JOB(attn_w_in, 1024, 1952, O_WIN, 2048, 2, (size_t)1024 * 1952, SZ_WIN)
          CONV_JOB(w_uq, 256, 768, O_WUQ, 768, 2, (size_t)256 * 768, SZ_WUQ)
          CONV_JOB(w_ukv, 128, 1024, O_WUKV, 1024, 2, (size_t)128 * 1024, SZ_WUKV)
          CONV_JOB(attn_w_out, 1024, 1024, O_WOUT, 1024, 2, (size_t)1024 * 1024, SZ_WOUT)
          CONV_JOB(rec_w_in, 1024, 2048, O_RWIN, 2048, 2, (size_t)1024 * 2048, SZ_RWIN)
          CONV_JOB(rec_wa, 128, 128, O_RGATE, 128, 16, (size_t)128 * 128, (size_t)256 * 128 * 2)
          CONV_JOB(rec_wx, 128, 128, O_RGATE + (size_t)128 * 128 * 2, 128, 16, (size_t)128 * 128, (size_t)256 * 128 * 2)
          CONV_JOB(rec_w_out, 1024, 1024, O_RWOUT, 1024, 2, (size_t)1024 * 1024, SZ_RWOUT)
          CONV_JOB(w1, 1024, 2048, O_W1, 2048, 128, (size_t)1024 * 2048, SZ_W1E)
          CONV_JOB(w2, 1024, 1024, O_W2, 1024, 128, (size_t)1024 * 1024, SZ_W2E)
      }
#undef CONV_JOB
    }
}

__device__ __forceinline__ void phase_norm(const Ctx& C, const float* xin, float* X, bool combine, bool do_norm, const float* gain, const float* modc  , const float* modl  , int shoff, int scoff) {
    const bf16_t* Y2 = (const bf16_t*)(C.ws + O_Y2); const int* pos = (const int*)(C.ws + O_POS); const float* topg = (const float*)(C.ws + O_TOPG); bf16_t* HN = (bf16_t*)(C.ws + O_HN);
    const int lane = C.lane;
    for (int t = C.gw; t < T_; t += C.NGW) { const int b = t / S_;
        f32x4 v[4];
#pragma unroll
        for (int j = 0; j < 4; ++j) v[j] = *(const f32x4*)(xin + (size_t)t * 1024 + 256 * j + 4 * lane);
        if (combine) { f32x4 y[4];
#pragma unroll
            for (int j = 0; j < 4; ++j) y[j] = (f32x4){0.f, 0.f, 0.f, 0.f};
#pragma unroll
            for (int k = 0; k < 4; ++k) { const int p = pos[t * 4 + k]; const float gk = topg[t * 4 + k];
#pragma unroll
                for (int j = 0; j < 4; ++j) { const u32x2 w = *(const u32x2*)(Y2 + (size_t)p * 1024 + 256 * j + 4 * lane);
                    y[j][0] += gk * bf_lo(w.x); y[j][1] += gk * bf_hi(w.x); y[j][2] += gk * bf_lo(w.y); y[j][3] += gk * bf_hi(w.y); } }
#pragma unroll
            for (int j = 0; j < 4; ++j) { const f32x4 g2 = *(const f32x4*)(modc + b * 6144 + 5120 + 256 * j + 4 * lane); v[j] = v[j] + g2 * y[j]; } }
        if (combine || xin != X) {
#pragma unroll
            for (int j = 0; j < 4; ++j) *(f32x4*)(X + (size_t)t * 1024 + 256 * j + 4 * lane) = v[j]; }
        if (do_norm) { float ss = 0.f;
#pragma unroll
            for (int j = 0; j < 4; ++j) ss += (v[j][0] * v[j][0] + v[j][1] * v[j][1]) + (v[j][2] * v[j][2] + v[j][3] * v[j][3]);
            const float rs = rsqrtf(wsum(ss) * (1.f / 1024.f) + 1e-6f);
#pragma unroll
            for (int j = 0; j < 4; ++j) { const int col = 256 * j + 4 * lane; const f32x4 gn = *(const f32x4*)(gain + col), sc = *(const f32x4*)(modl + b * 6144 + scoff + col), sh = *(const f32x4*)(modl + b * 6144 + shoff + col);
                const f32x4 h = v[j] * rs * gn * (1.f + sc) + sh;
                u32x2 w; w.x = cvt_pk_bf16(h[0], h[1]); w.y = cvt_pk_bf16(h[2], h[3]); *(u32x2*)(HN + (size_t)t * 1024 + col) = w; } }
    }
}

__device__ __forceinline__ void unpack8(const u32x4 w, float (&f)[8]) { f[0] = bf_lo(w.x); f[1] = bf_hi(w.x); f[2] = bf_lo(w.y); f[3] = bf_hi(w.y); f[4] = bf_lo(w.z); f[5] = bf_hi(w.z); f[6] = bf_lo(w.w); f[7] = bf_hi(w.w); }
__device__ __forceinline__ u32x4 pack8(const float (&f)[8]) { u32x4 w; w.x = cvt_pk_bf16(f[0], f[1]); w.y = cvt_pk_bf16(f[2], f[3]); w.z = cvt_pk_bf16(f[4], f[5]); w.w = cvt_pk_bf16(f[6], f[7]); return w; }

constexpr float LOG2E = 1.4426950408889634f;
__device__ __forceinline__ void phase_postproj(const Ctx& C, const float* qg, const float* kg, const float* qag, const float* kvag, const float* mkg) {
    bf16_t* PROJ = (bf16_t*)(C.ws + O_PROJ); const float* cs = (const float*)(C.ws + O_CS); const int lane = C.lane;
    for (int t = C.gw; t < T_; t += C.NGW) { bf16_t* row = PROJ + (size_t)t * 2048;
#pragma unroll
        for (int ps = 0; ps < 2; ++ps) { bf16_t* p = row + ps * 512 + 8 * lane; float f[8]; unpack8(*(const u32x4*)p, f); float ss = 0.f;
#pragma unroll
            for (int i = 0; i < 8; ++i) ss += f[i] * f[i];
            ss += shx<1>(ss); ss += shx<2>(ss); ss += shx<4>(ss);
            const float rs = rsqrtf(ss * (1.f / 64.f) + 1e-6f) * (ps == 0 ? 0.125f * LOG2E : 1.f); const float* g = (ps == 0 ? qg : kg) + 8 * (lane & 7);
#pragma unroll
            for (int i = 0; i < 8; ++i) f[i] = f[i] * rs * g[i];
            *(u32x4*)p = pack8(f); }
        { bf16_t* p = row + 1536 + 8 * lane; float f[8]; unpack8(*(const u32x4*)p, f); float ss = 0.f;
#pragma unroll
            for (int i = 0; i < 8; ++i) ss += f[i] * f[i];
            ss += shx<1>(ss); ss += shx<2>(ss);
            { const float o4 = shx<4>(ss); if (lane < 48) ss += o4; } { const float o8 = shx<8>(ss); if (lane < 48) ss += o8; } { const float o16 = shx<16>(ss); if (lane < 32) ss += o16; }
            const float nrm = lane < 32 ? 256.f : (lane < 48 ? 128.f : 32.f);
            const float rs = rsqrtf(ss / nrm + 1e-6f);
            const float* g = lane < 32 ? (qag + 8 * lane) : (lane < 48 ? (kvag + 8 * (lane - 32)) : (mkg + 64 + 8 * ((lane - 48) & 3)));
#pragma unroll
            for (int i = 0; i < 8; ++i) f[i] = f[i] * rs * g[i];
            float o[8];
#pragma unroll
            for (int i = 0; i < 8; ++i) { const float other = shx<2>(f[i]); const int fi = ((lane & 1) << 3) + i; const float cv = cs[t * 32 + fi], sv = cs[t * 32 + 16 + fi];
                o[i] = (lane & 2) ? (other * sv + f[i] * cv) : (f[i] * cv - other * sv); }
            if (lane >= 48 && lane < 52) {
#pragma unroll
                for (int i = 0; i < 8; ++i) f[i] = o[i]; }
            if (lane < 52) *(u32x4*)p = pack8(f); }
    }
}
__device__ __forceinline__ void phase_postq(const Ctx& C, const float* mqg, const float* mkg) {
    bf16_t* Q2 = (bf16_t*)(C.ws + O_Q2); bf16_t* KV2 = (bf16_t*)(C.ws + O_KV2); const float* cs = (const float*)(C.ws + O_CS); const int lane = C.lane;
    const float qscale = 0.10206207261596575f * LOG2E;
    for (int t = C.gw; t < T_; t += C.NGW) {
        { bf16_t* p = Q2 + (size_t)t * 768 + (lane >> 3) * 96 + 8 * (lane & 7); float f[8]; unpack8(*(const u32x4*)p, f); float ss = 0.f;
#pragma unroll
            for (int i = 0; i < 8; ++i) ss += f[i] * f[i];
            ss += shx<1>(ss); ss += shx<2>(ss); ss += shx<4>(ss);
            const float rs = rsqrtf(ss * (1.f / 64.f) + 1e-6f) * qscale; const float* g = mqg + 8 * (lane & 7);
#pragma unroll
            for (int i = 0; i < 8; ++i) f[i] = f[i] * rs * g[i];
            *(u32x4*)p = pack8(f); }
        { const int l2 = lane & 31; bf16_t* p = Q2 + (size_t)t * 768 + (l2 >> 2) * 96 + 64 + 8 * (l2 & 3); float f[8]; unpack8(*(const u32x4*)p, f); float ss = 0.f;
#pragma unroll
            for (int i = 0; i < 8; ++i) ss += f[i] * f[i];
            ss += shx<1>(ss); ss += shx<2>(ss);
            const float rs = rsqrtf(ss * (1.f / 32.f) + 1e-6f) * qscale; const float* g = mqg + 64 + 8 * (l2 & 3);
#pragma unroll
            for (int i = 0; i < 8; ++i) f[i] = f[i] * rs * g[i];
            float o[8];
#pragma unroll
            for (int i = 0; i < 8; ++i) { const float other = shx<2>(f[i]); const int fi = ((lane & 1) << 3) + i; const float cv = cs[t * 32 + fi], sv = cs[t * 32 + 16 + fi];
                o[i] = (lane & 2) ? (other * sv + f[i] * cv) : (f[i] * cv - other * sv); }
            if (lane < 32) *(u32x4*)p = pack8(o); }
        { bf16_t* p = KV2 + (size_t)t * 1024 + (lane >> 3) * 128 + 8 * (lane & 7); float f[8]; unpack8(*(const u32x4*)p, f); float ss = 0.f;
#pragma unroll
            for (int i = 0; i < 8; ++i) ss += f[i] * f[i];
            ss += shx<1>(ss); ss += shx<2>(ss); ss += shx<4>(ss);
            const float rs = rsqrtf(ss * (1.f / 64.f) + 1e-6f); const float* g = mkg + 8 * (lane & 7);
#pragma unroll
            for (int i = 0; i < 8; ++i) f[i] = f[i] * rs * g[i];
            *(u32x4*)p = pack8(f); }
    }
}
__device__ __forceinline__ void phase_mixcombine(const Ctx& C) {
    const bf16_t* OA = (const bf16_t*)(C.ws + O_OA); const float* LSE = (const float*)(C.ws + O_LSE); bf16_t* ATT = (bf16_t*)(C.ws + O_ATT); const int lane = C.lane;
    for (int t = C.gw; t < T_; t += C.NGW) { const int h = lane >> 3;
        float ls[3], mx = -INFINITY;
#pragma unroll
        for (int p = 0; p < 3; ++p) { ls[p] = LSE[((size_t)p * T_ + t) * 8 + h]; mx = fmaxf(mx, ls[p]); }
        float w[3], den = 0.f;
#pragma unroll
        for (int p = 0; p < 3; ++p) { w[p] = fexp2(ls[p] - mx); den += w[p]; }
        const float inv = 1.f / den; float o[8];
#pragma unroll
        for (int i = 0; i < 8; ++i) o[i] = 0.f;
#pragma unroll
        for (int p = 0; p < 3; ++p) { float f[8]; unpack8(*(const u32x4*)(OA + ((size_t)p * T_ + t) * 512 + 8 * lane), f); const float wp = w[p] * inv;
#pragma unroll
            for (int i = 0; i < 8; ++i) o[i] += wp * f[i]; }
        *(u32x4*)(ATT + (size_t)t * 1024 + 8 * lane) = pack8(o); }
}
__device__ __forceinline__ void phase_conv(const Ctx& C, const float* cw, const float* cb) {
    const bf16_t* PROJ = (const bf16_t*)(C.ws + O_PROJ); bf16_t* XC = (bf16_t*)(C.ws + O_XC); const int lane = C.lane;
    for (int t = C.gw; t < T_; t += C.NGW) { const int ts = t % S_;
#pragma unroll
        for (int ps = 0; ps < 2; ++ps) { const int c0 = ps * 512 + 8 * lane; float acc[8];
            { const f32x4 b0 = *(const f32x4*)(cb + c0), b1 = *(const f32x4*)(cb + c0 + 4); acc[0] = b0[0]; acc[1] = b0[1]; acc[2] = b0[2]; acc[3] = b0[3]; acc[4] = b1[0]; acc[5] = b1[1]; acc[6] = b1[2]; acc[7] = b1[3]; }
#pragma unroll
            for (int k = 0; k < 4; ++k) { const int dt = k - 3; if (ts + dt >= 0) { float f[8]; unpack8(*(const u32x4*)(PROJ + (size_t)(t + dt) * 2048 + 1024 + c0), f);
                    const f32x4 w0 = *(const f32x4*)(cw + k * 1024 + c0), w1 = *(const f32x4*)(cw + k * 1024 + c0 + 4);
                    acc[0] += w0[0] * f[0]; acc[1] += w0[1] * f[1]; acc[2] += w0[2] * f[2]; acc[3] += w0[3] * f[3]; acc[4] += w1[0] * f[4]; acc[5] += w1[1] * f[5]; acc[6] += w1[2] * f[6]; acc[7] += w1[3] * f[7]; } }
            *(u32x4*)(XC + (size_t)t * 1024 + c0) = pack8(acc); } }
}
__device__ __forceinline__ void phase_scan_sum(const Ctx& C) {
    const float* Aa = (const float*)(C.ws + O_AA); const float* Bb = (const float*)(C.ws + O_BB); float* SP = (float*)(C.ws + O_SUMP); float* SH = (float*)(C.ws + O_SUMH); const int lane = C.lane;
    for (int it = C.gw; it < 4 * 64 * 8; it += C.NGW) { const int cg = it & 7, ck = (it >> 3) & 63, b = it >> 9; const int ch = cg * 128 + 2 * lane;
        size_t off = ((size_t)b * S_ + ck * 64) * 1024 + ch; f32x2 Pp = (f32x2){1.f, 1.f}, Hh = (f32x2){0.f, 0.f};
#pragma unroll 8
        for (int s = 0; s < 64; ++s, off += 1024) { const f32x2 av = *(const f32x2*)(Aa + off), bv = *(const f32x2*)(Bb + off); Hh = av * Hh + bv; Pp = Pp * av; }
        *(f32x2*)(SP + ((size_t)b * 64 + ck) * 1024 + ch) = Pp; *(f32x2*)(SH + ((size_t)b * 64 + ck) * 1024 + ch) = Hh; }
}
__device__ __forceinline__ void phase_scan_apply(const Ctx& C) {
    const float* Aa = (const float*)(C.ws + O_AA); const float* Bb = (const float*)(C.ws + O_BB); const float* SP = (const float*)(C.ws + O_SUMP); const float* SH = (const float*)(C.ws + O_SUMH);
    const bf16_t* PROJ = (const bf16_t*)(C.ws + O_PROJ); bf16_t* ATT = (bf16_t*)(C.ws + O_ATT); const int lane = C.lane;
    for (int it = C.gw; it < 4 * 64 * 8; it += C.NGW) { const int cg = it & 7, ck = (it >> 3) & 63, b = it >> 9; const int ch = cg * 128 + 2 * lane;
        f32x2 h = (f32x2){0.f, 0.f};
        for (int c2 = 0; c2 < ck; ++c2) { const f32x2 pv = *(const f32x2*)(SP + ((size_t)b * 64 + c2) * 1024 + ch), hv = *(const f32x2*)(SH + ((size_t)b * 64 + c2) * 1024 + ch); h = pv * h + hv; }
        size_t row = (size_t)b * S_ + ck * 64;
#pragma unroll 8
        for (int s = 0; s < 64; ++s, ++row) { const f32x2 av = *(const f32x2*)(Aa + row * 1024 + ch), bv = *(const f32x2*)(Bb + row * 1024 + ch); h = av * h + bv;
            const unsigned gw2 = *(const unsigned*)(PROJ + row * 2048 + ch);
            *(unsigned*)(ATT + row * 1024 + ch) = cvt_pk_bf16(bf_lo(gw2) * h[0], bf_hi(gw2) * h[1]); } }
}

__device__ __forceinline__ void phase_router(const Ctx& C, const float* X, const float* gain, const float* modl, const float* wr, const float* br) {
    bf16_t* HN = (bf16_t*)(C.ws + O_HN); int* topi = (int*)(C.ws + O_TOPI); float* topg = (float*)(C.ws + O_TOPG); int* hist = (int*)(C.ws + O_HIST);
    LAS float* hrow = (LAS float*)C.lds;
    LAS float* part = (LAS float*)(C.lds + 65536);
    LAS int* hl = (LAS int*)(C.lds + LX_MISC);
    const int lane = C.lane, e = lane & 31, kh = lane >> 5, v = C.wave;
    float wreg[64];
#pragma unroll
    for (int i = 0; i < 64; ++i) wreg[i] = wr[(128 * v + 64 * kh + i) * 32 + e];
    const float bias_e = br[e];
    if (C.tid < 32) hl[C.tid] = 0;
    __syncthreads();
    for (int ck = C.bid; ck < 256; ck += C.G) {
#pragma unroll 1
        for (int pass = 0; pass < 4; ++pass) { const int tb = ck * 64 + pass * 16;
#pragma unroll
            for (int q = 0; q < 2; ++q) { const int tt = 2 * v + q, t = tb + tt, b = t / S_; f32x4 h[4]; float ss = 0.f;
#pragma unroll
                for (int j = 0; j < 4; ++j) { h[j] = *(const f32x4*)(X + (size_t)t * 1024 + 256 * j + 4 * lane); ss += (h[j][0] * h[j][0] + h[j][1] * h[j][1]) + (h[j][2] * h[j][2] + h[j][3] * h[j][3]); }
                const float rs = rsqrtf(wsum(ss) * (1.f / 1024.f) + 1e-6f);
#pragma unroll
                for (int j = 0; j < 4; ++j) { const int col = 256 * j + 4 * lane; const f32x4 gn = *(const f32x4*)(gain + col), sc = *(const f32x4*)(modl + b * 6144 + 4096 + col), sh = *(const f32x4*)(modl + b * 6144 + 3072 + col);
                    const f32x4 hv = h[j] * rs * gn * (1.f + sc) + sh;
                    u32x2 w; w.x = cvt_pk_bf16(hv[0], hv[1]); w.y = cvt_pk_bf16(hv[2], hv[3]); *(u32x2*)(HN + (size_t)t * 1024 + col) = w;
                    *(LAS f32x4*)(hrow + tt * 1024 + col) = hv; } }
            __syncthreads();
#pragma unroll 2
            for (int tt = 0; tt < 16; ++tt) { float s0 = 0.f, s1 = 0.f; const LAS float* hp = hrow + tt * 1024 + 128 * v + 64 * kh;
#pragma unroll
                for (int i4 = 0; i4 < 16; ++i4) { const f32x4 hv = *(const LAS f32x4*)(hp + 4 * i4); s0 += hv[0] * wreg[4 * i4] + hv[1] * wreg[4 * i4 + 1]; s1 += hv[2] * wreg[4 * i4 + 2] + hv[3] * wreg[4 * i4 + 3]; }
                float s = xadd32(s0 + s1);
                if (lane < 32) part[(tt * 8 + v) * 32 + e] = s; }
            __syncthreads();
            { const int tt = 2 * v + kh; float lg = bias_e;
#pragma unroll
              for (int w8 = 0; w8 < 8; ++w8) lg += part[(tt * 8 + w8) * 32 + e];
              int idx[4]; float val[4];
#pragma unroll
              for (int k = 0; k < 4; ++k) { float mx = lg;
                  mx = fmaxf(mx, shx<1>(mx)); mx = fmaxf(mx, shx<2>(mx)); mx = fmaxf(mx, shx<4>(mx)); mx = fmaxf(mx, shx<8>(mx)); mx = fmaxf(mx, shx<16>(mx));
                  const unsigned long long bal = __ballot(lg == mx); const unsigned bh = (unsigned)(bal >> (32 * kh)); const int sel = __ffs((int)bh) - 1;
                  idx[k] = sel; val[k] = mx; if (e == sel) lg = -INFINITY; }
              if (e == 0) { const int t = tb + tt; float ex[4], den = 0.f;
#pragma unroll
                  for (int k = 0; k < 4; ++k) { ex[k] = expf(val[k] - val[0]); den += ex[k]; }
#pragma unroll
                  for (int k = 0; k < 4; ++k) { topi[t * 4 + k] = idx[k]; topg[t * 4 + k] = ex[k] / den; __hip_atomic_fetch_add(hl + idx[k], 1, __ATOMIC_RELAXED, __HIP_MEMORY_SCOPE_WORKGROUP); } } }
        }
        __syncthreads();
        if (C.tid < 32) { hist[ck * 32 + C.tid] = hl[C.tid]; hl[C.tid] = 0; }
        __syncthreads();
    }
}
__device__ __forceinline__ void moe_plan_lds(const Ctx& C) {
    const int* hist = (const int*)(C.ws + O_HIST);
    LAS int* tot = (LAS int*)(C.lds + LX_MISC + 256); LAS int* pst = tot + 32; LAS int* tile_e = (LAS int*)(C.lds + LX_TILE); LAS int* ntp = (LAS int*)(C.lds + LX_MISC + 128);
    __syncthreads();
    if (C.tid < 32) { int s = 0; for (int c2 = 0; c2 < 256; ++c2) s += hist[c2 * 32 + C.tid]; tot[C.tid] = s; }
    __syncthreads();
    if (C.tid == 0) { int acc = 0, ti = 0; for (int e = 0; e < 32; ++e) { pst[e] = acc; const int nt = (tot[e] + 255) >> 8; for (int i = 0; i < nt; ++i) tile_e[ti++] = e; acc += nt << 8; } ntp[0] = ti; }
    __syncthreads();
}
__device__ __forceinline__ void phase_scatter(const Ctx& C) {
    const int* hist = (const int*)(C.ws + O_HIST); const int* topi = (const int*)(C.ws + O_TOPI); int* pos = (int*)(C.ws + O_POS);
    const bf16_t* HN = (const bf16_t*)(C.ws + O_HN); bf16_t* XG = (bf16_t*)(C.ws + O_XG);
    moe_plan_lds(C);
    LAS int* pst = (LAS int*)(C.lds + LX_MISC + 256) + 32; LAS int* base = (LAS int*)(C.lds + LX_MISC + 512); LAS int* ti = (LAS int*)C.lds; LAS int* pl = ti + 256;
    for (int ck = C.bid; ck < 256; ck += C.G) {
        if (C.tid < 32) { int s = pst[C.tid]; for (int c2 = 0; c2 < ck; ++c2) s += hist[c2 * 32 + C.tid]; base[C.tid] = s; }
        if (C.tid < 256) ti[C.tid] = topi[ck * 256 + C.tid];
        __syncthreads();
        if (C.tid < 32) { int r = base[C.tid]; for (int i = 0; i < 256; ++i) if (ti[i] == C.tid) pl[i] = r++; }
        __syncthreads();
        if (C.tid < 256) pos[ck * 256 + C.tid] = pl[C.tid];
        for (int pr = C.wave; pr < 256; pr += 8) { const int t = ck * 64 + (pr >> 2); const int p = pl[pr];
#pragma unroll
            for (int j = 0; j < 2; ++j) *(u32x4*)(XG + (size_t)p * 1024 + 512 * j + 8 * C.lane) = *(const u32x4*)(HN + (size_t)t * 1024 + 512 * j + 8 * C.lane); }
        __syncthreads();
    }
}

__device__ __forceinline__ s16x4 tr16(LAS const unsigned char* p) { typedef short v4i16_t __attribute__((ext_vector_type(4))); return __builtin_bit_cast(s16x4, __builtin_amdgcn_ds_read_tr16_b64_v4i16((LAS v4i16_t*)p)); }

template <int KS, bool DIL>
__device__ __forceinline__ void att_tile(LAS const unsigned char* kb, LAS const unsigned char* vb, const bf16x8 (&qf)[KS], f32x16& o0, f32x16& o1, float& m, float& l, int kidx0, int qidx, int lane) {
    constexpr int KROW = KS * 32 + 16, VROW = 144;
    const int i32 = lane & 31, hi = lane >> 5;
    const int pr = (i32 & 0x13) | ((i32 & 4) << 1) | ((i32 & 8) >> 1);
    f32x16 p0, p1;
#pragma unroll
    for (int r = 0; r < 16; ++r) { p0[r] = 0.f; p1[r] = 0.f; }
    LAS const unsigned char* kp = kb + pr * KROW + hi * 16;
#pragma unroll
    for (int ks = 0; ks < KS; ++ks) {
        const bf16x8 k0f = *(LAS const bf16x8*)(kp + ks * 32), k1f = *(LAS const bf16x8*)(kp + 32 * KROW + ks * 32);
        p0 = __builtin_amdgcn_mfma_f32_32x32x16_bf16(k0f, qf[ks], p0, 0, 0, 0);
        p1 = __builtin_amdgcn_mfma_f32_32x32x16_bf16(k1f, qf[ks], p1, 0, 0, 0);
    }
    float mx = -INFINITY;
#pragma unroll
    for (int r = 0; r < 16; ++r) { const int d0 = qidx - (kidx0 + 16 * (r >> 3) + 8 * hi + (r & 7)), d1 = d0 - 32;
        const bool v0 = DIL ? (d0 >= 0 && d0 <= 128) : (d0 >= 0), v1 = DIL ? (d1 >= 0 && d1 <= 128) : (d1 >= 0);
        p0[r] = v0 ? p0[r] : -INFINITY; p1[r] = v1 ? p1[r] : -INFINITY; mx = fmaxf(mx, fmaxf(p0[r], p1[r])); }
    mx = xmax32(mx);
    const float mn = fmaxf(m, mx), mu = (mn == -INFINITY) ? 0.f : mn;
    const float alpha = fexp2(m - mu);
    float ls = 0.f;
#pragma unroll
    for (int r = 0; r < 16; ++r) { p0[r] = fexp2(p0[r] - mu); p1[r] = fexp2(p1[r] - mu); ls += p0[r] + p1[r]; }
    l = l * alpha + ls; m = mn;
#pragma unroll
    for (int r = 0; r < 16; ++r) { o0[r] *= alpha; o1[r] *= alpha; }
    u32x4 pw[2][2];
#pragma unroll
    for (int s = 0; s < 2; ++s) {
        pw[0][s].x = cvt_pk_bf16(p0[8 * s + 0], p0[8 * s + 1]); pw[0][s].y = cvt_pk_bf16(p0[8 * s + 2], p0[8 * s + 3]); pw[0][s].z = cvt_pk_bf16(p0[8 * s + 4], p0[8 * s + 5]); pw[0][s].w = cvt_pk_bf16(p0[8 * s + 6], p0[8 * s + 7]);
        pw[1][s].x = cvt_pk_bf16(p1[8 * s + 0], p1[8 * s + 1]); pw[1][s].y = cvt_pk_bf16(p1[8 * s + 2], p1[8 * s + 3]); pw[1][s].z = cvt_pk_bf16(p1[8 * s + 4], p1[8 * s + 5]); pw[1][s].w = cvt_pk_bf16(p1[8 * s + 6], p1[8 * s + 7]); }
    const int g = lane >> 4, i16 = lane & 15;
    LAS const unsigned char* vp = vb + (8 * (g >> 1) + (i16 >> 2)) * VROW + (16 * (g & 1) + 4 * (i16 & 3)) * 2;
#pragma unroll
    for (int sub = 0; sub < 2; ++sub)
#pragma unroll
        for (int s = 0; s < 2; ++s) { const bf16x8 pf = __builtin_bit_cast(bf16x8, pw[sub][s]);
#pragma unroll
            for (int db = 0; db < 2; ++db) { LAS const unsigned char* a = vp + (32 * sub + 16 * s) * VROW + 64 * db;
                const s16x4 lo = tr16(a), hh = tr16(a + 4 * VROW);
                const bf16x8 vf = (bf16x8){lo[0], lo[1], lo[2], lo[3], hh[0], hh[1], hh[2], hh[3]};
                if (db == 0) o0 = __builtin_amdgcn_mfma_f32_32x32x16_bf16(vf, pf, o0, 0, 0, 0); else o1 = __builtin_amdgcn_mfma_f32_32x32x16_bf16(vf, pf, o1, 0, 0, 0); } }
}
__device__ __forceinline__ void att_store(bf16_t* orow  , const f32x16& o0, const f32x16& o1, float inv, int hi) {
#pragma unroll
    for (int rr = 0; rr < 4; ++rr) { u32x2 w0, w1;
        w0.x = cvt_pk_bf16(o0[4 * rr] * inv, o0[4 * rr + 1] * inv); w0.y = cvt_pk_bf16(o0[4 * rr + 2] * inv, o0[4 * rr + 3] * inv);
        w1.x = cvt_pk_bf16(o1[4 * rr] * inv, o1[4 * rr + 1] * inv); w1.y = cvt_pk_bf16(o1[4 * rr + 2] * inv, o1[4 * rr + 3] * inv);
        *(u32x2*)(orow + 8 * rr + 4 * hi) = w0; *(u32x2*)(orow + 32 + 8 * rr + 4 * hi) = w1; }
}

__device__ __forceinline__ void mla_unit(const Ctx& C, int b, int h, int qb) {
    constexpr int KROW = 208, VROW = 144, KB = 64 * KROW, BUF = KB + 64 * VROW;
    const bf16_t* Q2 = (const bf16_t*)(C.ws + O_Q2); const bf16_t* KV2 = (const bf16_t*)(C.ws + O_KV2); const bf16_t* PROJ = (const bf16_t*)(C.ws + O_PROJ); bf16_t* ATT = (bf16_t*)(C.ws + O_ATT);
    const int tid = C.tid, lane = C.lane, w = C.wave, i32 = lane & 31, hi = lane >> 5;
    const int q0 = qb * 256; const size_t rowb = (size_t)b * S_;
    bf16x8 qf[6];
    { const bf16_t* qrow = Q2 + (rowb + q0 + 32 * w + i32) * 768 + h * 96 + 8 * hi;
#pragma unroll
      for (int ks = 0; ks < 6; ++ks) qf[ks] = *(const bf16x8*)(qrow + 16 * ks); }
    f32x16 o0, o1;
#pragma unroll
    for (int r = 0; r < 16; ++r) { o0[r] = 0.f; o1[r] = 0.f; }
    float m = -INFINITY, l = 0.f;
    const int NT = 4 * qb + 4, wmax = 4 * qb + (w >> 1);
    const int r8 = tid >> 3, c8 = tid & 7, r4 = (tid & 255) >> 2, c4 = tid & 3;
    const bf16_t* knp = KV2 + (rowb + r8) * 1024 + h * 128 + 8 * c8; const bf16_t* kpp = PROJ + (rowb + r4) * 2048 + 1920 + 8 * c4;
    u32x4 rk, rv, rp;
#define MLA_LOAD(j) do { rk = *(const u32x4*)(knp + (size_t)(j) * 64 * 1024); rv = *(const u32x4*)(knp + (size_t)(j) * 64 * 1024 + 64); if (tid < 256) rp = *(const u32x4*)(kpp + (size_t)(j) * 64 * 2048); } while (0)
#define MLA_WRITE(bo) do { *(LAS u32x4*)(C.lds + (bo) + r8 * KROW + 16 * c8) = rk; *(LAS u32x4*)(C.lds + (bo) + KB + r8 * VROW + 16 * c8) = rv; if (tid < 256) *(LAS u32x4*)(C.lds + (bo) + r4 * KROW + 128 + 16 * c4) = rp; } while (0)
    MLA_LOAD(0); MLA_WRITE(0);
    __syncthreads();
    for (int j = 0; j < NT; ++j) { const int bo = (j & 1) * BUF;
        if (j + 1 < NT) MLA_LOAD(j + 1);
        if (j <= wmax) att_tile<6, false>(C.lds + bo, C.lds + bo + KB, qf, o0, o1, m, l, 64 * j, q0 + 32 * w + i32, lane);
        if (j + 1 < NT) MLA_WRITE(BUF - bo);
        __syncthreads(); }
#undef MLA_LOAD
#undef MLA_WRITE
    l = xadd32(l);
    att_store(ATT + (rowb + q0 + 32 * w + i32) * 1024 + 512 + h * 64, o0, o1, 1.f / l, hi);
}
__device__ __forceinline__ void dil_unit(const Ctx& C, int p, int dd, int b, int h, int res, int n) {
    constexpr int KROW = 144, VROW = 144, KB = 64 * KROW, BUF = KB + 64 * VROW;
    const bf16_t* PROJ = (const bf16_t*)(C.ws + O_PROJ); bf16_t* OA = (bf16_t*)(C.ws + O_OA) + (size_t)p * T_ * 512; float* LSE = (float*)(C.ws + O_LSE) + (size_t)p * T_ * 8;
    const int tid = C.tid, lane = C.lane, w = C.wave, i32 = lane & 31, hi = lane >> 5;
    const size_t rowb = (size_t)b * S_;
    const int qsub = 256 * n + 32 * w + i32; const size_t qtok = rowb + (size_t)qsub * dd + res;
    bf16x8 qf[4];
    { const bf16_t* qrow = PROJ + qtok * 2048 + h * 64 + 8 * hi;
#pragma unroll
      for (int ks = 0; ks < 4; ++ks) qf[ks] = *(const bf16x8*)(qrow + 16 * ks); }
    f32x16 o0, o1;
#pragma unroll
    for (int r = 0; r < 16; ++r) { o0[r] = 0.f; o1[r] = 0.f; }
    float m = -INFINITY, l = 0.f;
    const int jbeg = (n == 0) ? 2 : 0, wlo = w >> 1, whi = (32 * w + 159) >> 6;
    const int r8 = tid >> 3, c8 = tid & 7;
    u32x4 rk, rv;
#define DIL_LOAD(j) do { const size_t tok = rowb + (size_t)(256 * n - 128 + 64 * (j) + r8) * dd + res; const bf16_t* src = PROJ + tok * 2048 + 512 + h * 64 + 8 * c8; rk = *(const u32x4*)src; rv = *(const u32x4*)(src + 512); } while (0)
#define DIL_WRITE(bo) do { *(LAS u32x4*)(C.lds + (bo) + r8 * KROW + 16 * c8) = rk; *(LAS u32x4*)(C.lds + (bo) + KB + r8 * VROW + 16 * c8) = rv; } while (0)
    DIL_LOAD(jbeg); DIL_WRITE(0);
    __syncthreads();
    for (int j = jbeg; j < 6; ++j) { const int bo = ((j - jbeg) & 1) * BUF;
        if (j + 1 < 6) DIL_LOAD(j + 1);
        if (j >= wlo && j <= whi) att_tile<4, true>(C.lds + bo, C.lds + bo + KB, qf, o0, o1, m, l, 256 * n - 128 + 64 * j, qsub, lane);
        if (j + 1 < 6) DIL_WRITE(BUF - bo);
        __syncthreads(); }
#undef DIL_LOAD
#undef DIL_WRITE
    l = xadd32(l);
    att_store(OA + qtok * 512 + h * 64, o0, o1, 1.f / l, hi);
    if (hi == 0) LSE[qtok * 8 + h] = m + log2f(l);
}
__device__ __forceinline__ void phase_attention(const Ctx& C) {
    if (C.G == 256) { const int bh = C.vcu >> 3, s = C.vcu & 7; mla_unit(C, bh >> 3, bh & 7, s); mla_unit(C, bh >> 3, bh & 7, 15 - s); }
    else for (int u = C.bid; u < 512; u += C.G) mla_unit(C, u >> 7, (u >> 4) & 7, u & 15);
    for (int u = C.bid; u < 1536; u += C.G) { const int p = u >> 9, rem = u & 511, b = rem >> 7, h = (rem >> 4) & 7, blk = rem & 15;
        const int dd = (p == 0) ? 1 : (p == 1) ? 4 : 16, bpr = 16 / dd;
        dil_unit(C, p, dd, b, h, blk / bpr, blk % bpr); }
}

constexpr int N_PHASES = 48;
extern __shared__ __attribute__((aligned(16))) unsigned char lds_raw[];
typedef const __attribute__((address_space(4))) Args* ArgsP;
#define PHFN static __device__ __forceinline__ void
__device__ __forceinline__ ArgsP fresh_args() { unsigned long long p = (unsigned long long)__builtin_amdgcn_kernarg_segment_ptr(); asm volatile("" : "+s"(p)); return (ArgsP)p; }
__device__ __forceinline__ Ctx make_ctx(ArgsP ap, int wv) {
    Ctx C; C.lds = (LAS unsigned char*)lds_raw; C.ws = ap->ws;
    unsigned ones = ~0u; asm volatile("" : "+s"(ones)); const int lane = (int)__builtin_amdgcn_mbcnt_hi(ones, __builtin_amdgcn_mbcnt_lo(ones, 0u));
    int bid = blockIdx.x; asm volatile("" : "+s"(bid)); int G = gridDim.x; asm volatile("" : "+s"(G));
    C.wave = wv; C.lane = lane; C.tid = wv * 64 + lane;
    C.G = G; C.bid = bid; C.vcu = (C.G % 8 == 0) ? (C.bid % 8) * (C.G / 8) + C.bid / 8 : C.bid;
    C.gw = C.bid * 8 + C.wave; C.NGW = C.G * 8; return C;
}
#define IN(i) ((const float*)ap->in[i])
#define MODL(l) ((const float*)(C.ws + O_MOD) + (size_t)(l) * 4 * 6144)
PHFN ph_prologue(int wv) { const ArgsP ap = fresh_args(); const Ctx C = make_ctx(ap, wv); p0_prologue(C, ap); }
PHFN ph_norm(int wv, int l, int mode) { const ArgsP ap = fresh_args(); const Ctx C = make_ctx(ap, wv);
    if (mode == 0) phase_norm(C, IN(0), ap->out, false, true, IN(5), MODL(0), MODL(0), 0, 1024);
    else if (mode == 1) phase_norm(C, ap->out, ap->out, true, true, IN(5) + l * 1024, MODL(l - 1), MODL(l), 0, 1024);
    else phase_norm(C, ap->out, ap->out, true, false, IN(5), MODL(3), MODL(3), 0, 1024); }
PHFN ph_proj(int wv, int j) { const ArgsP ap = fresh_args(); const Ctx C = make_ctx(ap, wv); unsigned char* ws = C.ws;
    DenseOrder S; S.init(ws + O_HN, ws + O_WIN + j * SZ_WIN, 1024, 1024, T_, 2048, C.G, C.bid); EpiBf16 E{(bf16_t*)(ws + O_PROJ), nullptr, 2048, 0}; gemm_phase(C, GemmDims{1024, 1024, 1024}, S, E); }
PHFN ph_postproj(int wv, int j) { const ArgsP ap = fresh_args(); const Ctx C = make_ctx(ap, wv); phase_postproj(C, IN(8) + j * 64, IN(9) + j * 64, IN(10) + j * 256, IN(11) + j * 128, IN(15) + j * 96); }
PHFN ph_qkv(int wv, int j) { const ArgsP ap = fresh_args(); const Ctx C = make_ctx(ap, wv); unsigned char* ws = C.ws;
    { DenseOrder S; S.init(ws + O_PROJ + 1536 * 2, ws + O_WUQ + j * SZ_WUQ, 2048, 256, T_, 768, C.G, C.bid); EpiBf16 E{(bf16_t*)(ws + O_Q2), nullptr, 768, 0}; gemm_phase(C, GemmDims{256, 2048, 256}, S, E); }
    { const ArgsP ap2 = fresh_args(); const Ctx C = make_ctx(ap2, wv); unsigned char* ws = C.ws; DenseOrder S; S.init(ws + O_PROJ + 1792 * 2, ws + O_WUKV + j * SZ_WUKV, 2048, 128, T_, 1024, C.G, C.bid); EpiBf16 E{(bf16_t*)(ws + O_KV2), nullptr, 1024, 0}; gemm_phase(C, GemmDims{128, 2048, 128}, S, E); } }
PHFN ph_postq(int wv, int j) { const ArgsP ap = fresh_args(); const Ctx C = make_ctx(ap, wv); phase_postq(C, IN(14) + j * 96, IN(15) + j * 96); }
PHFN ph_attention(int wv) { const ArgsP ap = fresh_args(); const Ctx C = make_ctx(ap, wv); phase_attention(C); }
PHFN ph_mixcombine(int wv) { const ArgsP ap = fresh_args(); const Ctx C = make_ctx(ap, wv); phase_mixcombine(C); }
PHFN ph_outproj(int wv, int l, int which) { const ArgsP ap = fresh_args(); const Ctx C = make_ctx(ap, wv); unsigned char* ws = C.ws; const int j = l >> 1;
    DenseOrder S; S.init(ws + O_ATT, ws + (which ? O_RWOUT + j * SZ_RWOUT : O_WOUT + j * SZ_WOUT), 1024, 1024, T_, 1024, C.G, C.bid);
    EpiResid E{ap->out, MODL(l) + 2048, which ? IN(27) + j * 1024 : nullptr}; gemm_phase(C, GemmDims{1024, 1024, 1024}, S, E); }
PHFN ph_router(int wv, int l) { const ArgsP ap = fresh_args(); const Ctx C = make_ctx(ap, wv); phase_router(C, ap->out, IN(6) + l * 1024, MODL(l), IN(28) + (size_t)l * 1024 * 32, IN(29) + l * 32); }
PHFN ph_scatter(int wv) { const ArgsP ap = fresh_args(); const Ctx C = make_ctx(ap, wv); phase_scatter(C); }
PHFN ph_moe1(int wv, int l) { const ArgsP ap = fresh_args(); const Ctx C = make_ctx(ap, wv); unsigned char* ws = C.ws; moe_plan_lds(C);
    MoeOrder S; S.A = (const char*)(ws + O_XG); S.WT = (const char*)(ws + O_W1 + (size_t)l * 32 * SZ_W1E); S.estride = SZ_W1E; S.tile_e = (const LAS int*)(C.lds + LX_TILE);
    S.NT = *(const LAS int*)(C.lds + LX_MISC + 128); S.nN = 8; S.G = C.G; S.c = C.bid;
    EpiSwiglu E{(bf16_t*)(ws + O_ACT), IN(31) + (size_t)l * 32 * 2048}; gemm_phase(C, GemmDims{1024, 1024, 1024}, S, E); }
PHFN ph_moe2(int wv, int l) { const ArgsP ap = fresh_args(); const Ctx C = make_ctx(ap, wv); unsigned char* ws = C.ws; moe_plan_lds(C);
    MoeOrder S; S.A = (const char*)(ws + O_ACT); S.WT = (const char*)(ws + O_W2 + (size_t)l * 32 * SZ_W2E); S.estride = SZ_W2E; S.tile_e = (const LAS int*)(C.lds + LX_TILE);
    S.NT = *(const LAS int*)(C.lds + LX_MISC + 128); S.nN = 4; S.G = C.G; S.c = C.bid;
    EpiBf16 E{(bf16_t*)(ws + O_Y2), IN(33) + (size_t)l * 32 * 1024, 1024, 1024}; gemm_phase(C, GemmDims{1024, 1024, 1024}, S, E); }
PHFN ph_recin(int wv, int j) { const ArgsP ap = fresh_args(); const Ctx C = make_ctx(ap, wv); unsigned char* ws = C.ws;
    DenseOrder S; S.init(ws + O_HN, ws + O_RWIN + j * SZ_RWIN, 1024, 1024, T_, 2048, C.G, C.bid); EpiRecIn E{(bf16_t*)(ws + O_PROJ), IN(18) + j * 2048}; gemm_phase(C, GemmDims{1024, 1024, 1024}, S, E); }
PHFN ph_conv(int wv, int j) { const ArgsP ap = fresh_args(); const Ctx C = make_ctx(ap, wv); phase_conv(C, IN(19) + j * 4096, IN(20) + j * 1024); }
PHFN ph_lru(int wv, int j) { const ArgsP ap = fresh_args(); const Ctx C = make_ctx(ap, wv); unsigned char* ws = C.ws;
    LruOrder S; S.XC = (const char*)(ws + O_XC); S.RG = (const char*)(ws + O_RGATE + j * SZ_RGATE); S.G = C.G; S.c = C.bid;
    EpiLru E{(const bf16_t*)(ws + O_XC), IN(22) + j * 1024, IN(24) + j * 1024, (const float*)(ws + O_SPV) + j * 1024, (float*)(ws + O_AA), (float*)(ws + O_BB)};
    gemm_phase(C, GemmDims{128, 1024, 128}, S, E); }
PHFN ph_scan_sum(int wv) { const ArgsP ap = fresh_args(); const Ctx C = make_ctx(ap, wv); phase_scan_sum(C); }
PHFN ph_scan_apply(int wv) { const ArgsP ap = fresh_args(); const Ctx C = make_ctx(ap, wv); phase_scan_apply(C); }

#if MODE == 1
__device__ __forceinline__ void grid_barrier() { const ArgsP q = fresh_args(); XcdBarrier b; b.bar = (unsigned*)(q->ws + O_CTL) + CW_BAR; b.x = xb_xcc_id(); b.st = (volatile LAS unsigned*)((LAS unsigned char*)lds_raw + LDSX_OFF); xcd_barrier(b); }
__global__ void __launch_bounds__(512, 2) mk_fwd(Args a) {
    const int wv = __builtin_amdgcn_readfirstlane(threadIdx.x >> 6);
    { LAS unsigned char* lds = (LAS unsigned char*)lds_raw;
      for (int u = threadIdx.x; u < (LDS_BYTES - LDSX_OFF) / 4; u += 512) ((LAS unsigned*)(lds + LDSX_OFF))[u] = 0u;
      __syncthreads();
      if (a.ph_hi - a.ph_lo > 1) (void)xcd_barrier_post((unsigned*)(a.ws + O_CTL) + CW_BAR, (volatile LAS unsigned*)(lds + LDSX_OFF)); }
    int pid = 0;
#define PHASE(call) { const ArgsP q_ = fresh_args(); const int lo_ = q_->ph_lo, hi_ = q_->ph_hi; if (pid >= lo_ && pid < hi_) { call; if (pid + 1 < hi_) grid_barrier(); } ++pid; }
#define MOE_PHASES(l) PHASE(ph_router(wv, l)) PHASE(ph_scatter(wv)) PHASE(ph_moe1(wv, l)) PHASE(ph_moe2(wv, l))
    PHASE(ph_prologue(wv))
#define LAYER_PAIR(lp) \
        { const int l = 2 * (lp);         \
          PHASE(ph_norm(wv, l, (lp) == 0 ? 0 : 1)) PHASE(ph_proj(wv, lp)) PHASE(ph_postproj(wv, lp)) PHASE(ph_qkv(wv, lp)) PHASE(ph_postq(wv, lp)) PHASE(ph_attention(wv)) PHASE(ph_mixcombine(wv)) PHASE(ph_outproj(wv, l, 0)) \
          MOE_PHASES(l) } \
        { const int l = 2 * (lp) + 1;     \
          PHASE(ph_norm(wv, l, 1)) PHASE(ph_recin(wv, lp)) PHASE(ph_conv(wv, lp)) PHASE(ph_lru(wv, lp)) PHASE(ph_scan_sum(wv)) PHASE(ph_scan_apply(wv)) PHASE(ph_outproj(wv, l, 1)) \
          MOE_PHASES(l) }
    LAYER_PAIR(0)
    LAYER_PAIR(1)
#undef LAYER_PAIR
    PHASE(ph_norm(wv, 3, 2))
#undef PHASE
#undef MOE_PHASES
}
#else
template <int PH> __global__ void __launch_bounds__(512, 2) k_phase(Args a, int l, int x) {
    const int wv = __builtin_amdgcn_readfirstlane(threadIdx.x >> 6);
    LAS unsigned char* lds = (LAS unsigned char*)lds_raw;
    for (int u = threadIdx.x; u < (LDS_BYTES - LDSX_OFF) / 4; u += 512) ((LAS unsigned*)(lds + LDSX_OFF))[u] = 0u;
    __syncthreads();
    if constexpr (PH == 0) ph_prologue(wv);
    if constexpr (PH == 1) ph_norm(wv, l, x);
    if constexpr (PH == 2) ph_proj(wv, l);
    if constexpr (PH == 3) ph_postproj(wv, l);
    if constexpr (PH == 4) ph_qkv(wv, l);
    if constexpr (PH == 5) ph_postq(wv, l);
    if constexpr (PH == 6) ph_attention(wv);
    if constexpr (PH == 7) ph_mixcombine(wv);
    if constexpr (PH == 8) ph_outproj(wv, l, x);
    if constexpr (PH == 9) ph_router(wv, l);
    if constexpr (PH == 10) ph_scatter(wv);
    if constexpr (PH == 11) ph_moe1(wv, l);
    if constexpr (PH == 12) ph_moe2(wv, l);
    if constexpr (PH == 13) ph_recin(wv, l);
    if constexpr (PH == 14) ph_conv(wv, l);
    if constexpr (PH == 15) ph_lru(wv, l);
    if constexpr (PH == 16) ph_scan_sum(wv);
    if constexpr (PH == 17) ph_scan_apply(wv);
}
#endif
#undef IN
#undef MODL
}

#ifndef MODE
#define MODE 2
#endif
extern "C" void kernel_launch(void* const* d_in, const int* in_sizes, int n_in, void* d_out, int out_size, void* d_ws, size_t ws_size, hipStream_t stream) {
    (void)in_sizes; (void)n_in; (void)out_size; (void)ws_size;
#if MODE == 0
    nv::forward(d_in, (float*)d_out, d_ws, stream);
#else
    static int grid = 0;
    if (grid == 0) {
        int dev = 0, cus = 0;
        (void)hipGetDevice(&dev); (void)hipDeviceGetAttribute(&cus, hipDeviceAttributeMultiprocessorCount, dev);
#if MODE == 1
        (void)hipFuncSetAttribute((const void*)mk::mk_fwd, hipFuncAttributeMaxDynamicSharedMemorySize, mk::LDS_BYTES);
#else
#define SA(PH) (void)hipFuncSetAttribute((const void*)mk::k_phase<PH>, hipFuncAttributeMaxDynamicSharedMemorySize, mk::LDS_BYTES)
        SA(0); SA(1); SA(2); SA(3); SA(4); SA(5); SA(6); SA(7); SA(8); SA(9); SA(10); SA(11); SA(12); SA(13); SA(14); SA(15); SA(16); SA(17);
#undef SA
#endif
        grid = cus > 0 ? cus : 256;
    }
    (void)hipMemsetAsync((char*)d_ws + mk::O_CTL, 0, mk::SZ_CTL, stream);
    mk::Args a;
    memset(&a, 0, sizeof(a));
    for (int i = 0; i < 34; ++i) a.in[i] = d_in[i];
    a.out = (float*)d_out; a.ws = (unsigned char*)d_ws;
#if MODE == 1
    a.ph_lo = 0; a.ph_hi = mk::N_PHASES;
    hipLaunchKernelGGL(mk::mk_fwd, dim3(grid), dim3(512), mk::LDS_BYTES, stream, a);
#else
#define LP(PH, l, x) hipLaunchKernelGGL(mk::k_phase<PH>, dim3(grid), dim3(512), mk::LDS_BYTES, stream, a, l, x)
    LP(0, 0, 0);
    for (int lp = 0; lp < 2; ++lp) {
        { const int l = 2 * lp; LP(1, l, lp == 0 ? 0 : 1); LP(2, lp, 0); LP(3, lp, 0); LP(4, lp, 0); LP(5, lp, 0); LP(6, 0, 0); LP(7, 0, 0); LP(8, l, 0); LP(9, l, 0); LP(10, 0, 0); LP(11, l, 0); LP(12, l, 0); }
        { const int l = 2 * lp + 1; LP(1, l, 1); LP(13, lp, 0); LP(14, lp, 0); LP(15, lp, 0); LP(16, 0, 0); LP(17, 0, 0); LP(8, l, 1); LP(9, l, 0); LP(10, 0, 0); LP(11, l, 0); LP(12, l, 0); }
    }
    LP(1, 3, 2);
#undef LP
#endif
#endif
}
```

```cpp
#define MODE 1

#include <string.h>
#include <hip/hip_runtime.h>
#include <stdint.h>
#include <math.h>

namespace cfg {
constexpr int D = 1024, NB = 4, S = 4096, T = NB * S, DEPTH = 4;
constexpr int MIXIN = 1952;
constexpr int NE = 32, TOPK = 4;
constexpr int MPAIR = T * TOPK;
constexpr int NBLK = MPAIR / 256 + NE;
constexpr int P = NBLK * 256;
}
using namespace cfg;

namespace nv {

__device__ __forceinline__ float wave_sum(float v) {
#pragma unroll
    for (int o = 1; o < 64; o <<= 1) v += __shfl_xor(v, o);
    return v;
}
__device__ __forceinline__ float wave_max(float v) {
#pragma unroll
    for (int o = 1; o < 64; o <<= 1) v = fmaxf(v, __shfl_xor(v, o));
    return v;
}
__device__ __forceinline__ float block_sum256(float v) {
    __shared__ float red[4];
    v = wave_sum(v);
    __syncthreads();
    if ((threadIdx.x & 63) == 0) red[threadIdx.x >> 6] = v;
    __syncthreads();
    return red[0] + red[1] + red[2] + red[3];
}
__device__ __forceinline__ float sigmoidf_(float x) { return 1.f / (1.f + expf(-x)); }
__device__ __forceinline__ float gelu_tanh(float x) { return 0.5f * x * (1.f + tanhf(0.7978845608028654f * (x + 0.044715f * x * x * x))); }

__global__ void k_mod(const float* __restrict__ c, const float* __restrict__ ada_w, const float* __restrict__ ada_b, float* __restrict__ mod) {
    const int n = blockIdx.x * 256 + threadIdx.x, l = blockIdx.y;
    float acc[4] = {0.f, 0.f, 0.f, 0.f};
    const float* w = ada_w + (size_t)l * 1024 * 6144 + n;
    for (int k = 0; k < 1024; ++k) {
        const float wv = w[(size_t)k * 6144];
#pragma unroll
        for (int b = 0; b < 4; ++b) { const float cv = c[b * 1024 + k]; acc[b] += (cv / (1.f + expf(-cv))) * wv; }
    }
#pragma unroll
    for (int b = 0; b < 4; ++b) mod[((size_t)l * 4 + b) * 6144 + n] = acc[b] + ada_b[l * 6144 + n];
}

__global__ void k_rmsmod(const float* __restrict__ x, const float* __restrict__ gain, const float* __restrict__ modl, int shoff, int scoff, float* __restrict__ out) {
    const int t = blockIdx.x, b = t / S;
    const float* xr = x + (size_t)t * D;
    float v[4]; float ss = 0.f;
#pragma unroll
    for (int i = 0; i < 4; ++i) { v[i] = xr[threadIdx.x + 256 * i]; ss += v[i] * v[i]; }
    ss = block_sum256(ss);
    const float rs = rsqrtf(ss * (1.f / D) + 1e-6f);
#pragma unroll
    for (int i = 0; i < 4; ++i) { const int col = threadIdx.x + 256 * i;
        out[(size_t)t * D + col] = v[i] * rs * gain[col] * (1.f + modl[b * 6144 + scoff + col]) + modl[b * 6144 + shoff + col]; }
}

template <class Epi>
__global__ void __launch_bounds__(256) k_gemm(const float* __restrict__ A, const int* __restrict__ rowidx, const float* __restrict__ Bw, const int* __restrict__ tile_e, size_t bstride,
                                             Epi epi, int lda, int ldb, int N, int K) {
    __shared__ float As[16][68];
    __shared__ float Bs[16][68];
    const int row0 = blockIdx.y * 64, col0 = blockIdx.x * 64;
    int e = 0;
    if (tile_e) { e = tile_e[row0 / 256]; if (e < 0) return; }
    const float* Bp = Bw + (size_t)e * bstride;
    const int tid = threadIdx.x, ty = tid >> 4, tx = tid & 15;
    const int ar = tid >> 2, ak = (tid & 3) * 4;
    const int bk = tid >> 4, bn = (tid & 15) * 4;
    const int arow = rowidx ? rowidx[row0 + ar] : (row0 + ar);
    const float* Ap = A + (size_t)arow * lda + ak;
    float acc[4][4];
#pragma unroll
    for (int i = 0; i < 4; ++i)
#pragma unroll
        for (int j = 0; j < 4; ++j) acc[i][j] = 0.f;
    for (int k0 = 0; k0 < K; k0 += 16) {
        const float4 av = *(const float4*)(Ap + k0);
        float4 bv = make_float4(0.f, 0.f, 0.f, 0.f);
        if (col0 + bn < N) bv = *(const float4*)(Bp + (size_t)(k0 + bk) * ldb + col0 + bn);
        __syncthreads();
        As[ak + 0][ar] = av.x; As[ak + 1][ar] = av.y; As[ak + 2][ar] = av.z; As[ak + 3][ar] = av.w;
        *(float4*)&Bs[bk][bn] = bv;
        __syncthreads();
#pragma unroll
        for (int kk = 0; kk < 16; ++kk) {
            const float4 a4 = *(const float4*)&As[kk][ty * 4];
            const float4 b4 = *(const float4*)&Bs[kk][tx * 4];
            const float a[4] = {a4.x, a4.y, a4.z, a4.w}, b[4] = {b4.x, b4.y, b4.z, b4.w};
#pragma unroll
            for (int i = 0; i < 4; ++i)
#pragma unroll
                for (int j = 0; j < 4; ++j) acc[i][j] += a[i] * b[j];
        }
    }
#pragma unroll
    for (int i = 0; i < 4; ++i)
#pragma unroll
        for (int j = 0; j < 4; ++j) { const int r = row0 + ty * 4 + i, cidx = col0 + tx * 4 + j; if (cidx < N) epi(r, cidx, acc[i][j], e); }
}
struct EpiStore { float* C; const float* bias; int ldc; int bias_estride;
    __device__ __forceinline__ void operator()(int r, int c, float v, int e) const { C[(size_t)r * ldc + c] = v + (bias ? bias[(size_t)e * bias_estride + c] : 0.f); } };
struct EpiResid { float* X; const float* g; const float* bias;
    __device__ __forceinline__ void operator()(int r, int c, float v, int) const { const int b = r / S; X[(size_t)r * D + c] += g[b * 6144 + c] * (v + (bias ? bias[c] : 0.f)); } };

__global__ void k_postproj(float* __restrict__ PROJ, const float* __restrict__ qg, const float* __restrict__ kg, const float* __restrict__ qag, const float* __restrict__ kvag,
                           const float* __restrict__ mkg  , const int* __restrict__ positions) {
    const int t = blockIdx.x; float* r = PROJ + (size_t)t * MIXIN; const int tid = threadIdx.x;
    if (tid < 16) { float* p = r + tid * 64; const float* g = tid < 8 ? qg : kg; float ss = 0.f; for (int i = 0; i < 64; ++i) ss += p[i] * p[i];
        const float rs = rsqrtf(ss / 64.f + 1e-6f); for (int i = 0; i < 64; ++i) p[i] = p[i] * rs * g[i]; }
    else if (tid == 16) { float* p = r + 1536; float ss = 0.f; for (int i = 0; i < 256; ++i) ss += p[i] * p[i];
        const float rs = rsqrtf(ss / 256.f + 1e-6f); for (int i = 0; i < 256; ++i) p[i] = p[i] * rs * qag[i]; }
    else if (tid == 17) { float* p = r + 1792; float ss = 0.f; for (int i = 0; i < 128; ++i) ss += p[i] * p[i];
        const float rs = rsqrtf(ss / 128.f + 1e-6f); for (int i = 0; i < 128; ++i) p[i] = p[i] * rs * kvag[i]; }
    else if (tid == 18) { float* p = r + 1920; float ss = 0.f; for (int i = 0; i < 32; ++i) ss += p[i] * p[i];
        const float rs = rsqrtf(ss / 32.f + 1e-6f);
        const float pos = (float)positions[t];
        for (int i = 0; i < 16; ++i) { const float inv = powf(10000.f, -(float)(2 * i) / 32.f); const float ang = pos * inv; const float cs = cosf(ang), sn = sinf(ang);
            const float v1 = p[i] * rs * mkg[64 + i], v2 = p[16 + i] * rs * mkg[80 + i];
            p[i] = v1 * cs - v2 * sn; p[16 + i] = v1 * sn + v2 * cs; } }
}
__global__ void k_postq(float* __restrict__ Q2, float* __restrict__ KV2, const float* __restrict__ mqg, const float* __restrict__ mkg, const int* __restrict__ positions) {
    const int t = blockIdx.x, tid = threadIdx.x;
    if (tid < 8) { float* p = Q2 + (size_t)t * 768 + tid * 96; float ss = 0.f; for (int i = 0; i < 64; ++i) ss += p[i] * p[i];
        float rs = rsqrtf(ss / 64.f + 1e-6f); for (int i = 0; i < 64; ++i) p[i] = p[i] * rs * mqg[i];
        float* q = p + 64; ss = 0.f; for (int i = 0; i < 32; ++i) ss += q[i] * q[i]; rs = rsqrtf(ss / 32.f + 1e-6f);
        const float pos = (float)positions[t];
        for (int i = 0; i < 16; ++i) { const float inv = powf(10000.f, -(float)(2 * i) / 32.f); const float ang = pos * inv; const float cs = cosf(ang), sn = sinf(ang);
            const float v1 = q[i] * rs * mqg[64 + i], v2 = q[16 + i] * rs * mqg[80 + i];
            q[i] = v1 * cs - v2 * sn; q[16 + i] = v1 * sn + v2 * cs; } }
    else if (tid < 16) { float* p = KV2 + (size_t)t * 1024 + (tid - 8) * 128; float ss = 0.f; for (int i = 0; i < 64; ++i) ss += p[i] * p[i];
        const float rs = rsqrtf(ss / 64.f + 1e-6f); for (int i = 0; i < 64; ++i) p[i] = p[i] * rs * mkg[i]; }
}
__global__ void __launch_bounds__(256) k_mla(const float* __restrict__ Q2, const float* __restrict__ KV2, const float* __restrict__ PROJ, float* __restrict__ ATT) {
    const int wave = threadIdx.x >> 6, lane = threadIdx.x & 63;
    const int q = blockIdx.x * 4 + wave, h = blockIdx.y, b = blockIdx.z;
    const float* qrow = Q2 + (size_t)(b * S + q) * 768 + h * 96;
    float qv[96];
#pragma unroll
    for (int d = 0; d < 96; ++d) qv[d] = qrow[d];
    const float scale = 0.10206207261596575f;
    float m = -INFINITY, l = 0.f, o = 0.f;
    for (int k0 = 0; k0 <= q; k0 += 64) {
        const int k = k0 + lane; float s = -INFINITY;
        if (k <= q) { const float* kn = KV2 + (size_t)(b * S + k) * 1024 + h * 128; const float* kp = PROJ + (size_t)(b * S + k) * MIXIN + 1920; float acc = 0.f;
#pragma unroll
            for (int d = 0; d < 64; ++d) acc += qv[d] * kn[d];
#pragma unroll
            for (int d = 0; d < 32; ++d) acc += qv[64 + d] * kp[d];
            s = acc * scale; }
        const float mn = fmaxf(m, wave_max(s));
        const float alpha = expf(m - mn); const float p = (k <= q) ? expf(s - mn) : 0.f;
        l = l * alpha + wave_sum(p); o *= alpha;
        const int kend = min(64, q - k0 + 1);
        for (int kk = 0; kk < kend; ++kk) { const float pk = __shfl(p, kk); o += pk * KV2[(size_t)(b * S + k0 + kk) * 1024 + h * 128 + 64 + lane]; }
        m = mn;
    }
    ATT[(size_t)(b * S + q) * 1024 + 512 + h * 64 + lane] = o / l;
}
__global__ void __launch_bounds__(256) k_dil(const float* __restrict__ PROJ, float* __restrict__ ATT) {
    const int wave = threadIdx.x >> 6, lane = threadIdx.x & 63;
    const int t = blockIdx.x * 4 + wave, h = blockIdx.y, b = blockIdx.z;
    const float* base = PROJ + (size_t)(b * S) * MIXIN;
    const float* qrow = base + (size_t)t * MIXIN + h * 64;
    float qv[64];
#pragma unroll
    for (int d = 0; d < 64; ++d) qv[d] = qrow[d];
    float s[7]; float mx = -INFINITY;
#pragma unroll
    for (int c = 0; c < 7; ++c) { const int slot = c * 64 + lane; s[c] = -INFINITY;
        if (slot < 387) { const int p = slot / 129, j = slot % 129; const int dd = (p == 0) ? 1 : (p == 1) ? 4 : 16; const int tk = t - j * dd;
            if (tk >= 0) { const float* kr = base + (size_t)tk * MIXIN + 512 + h * 64; float acc = 0.f;
#pragma unroll
                for (int d = 0; d < 64; ++d) acc += qv[d] * kr[d];
                s[c] = acc * 0.125f; } }
        mx = fmaxf(mx, s[c]); }
    mx = wave_max(mx);
    float ls = 0.f;
#pragma unroll
    for (int c = 0; c < 7; ++c) { s[c] = expf(s[c] - mx); ls += s[c]; }
    ls = wave_sum(ls);
    float o = 0.f;
#pragma unroll
    for (int c = 0; c < 7; ++c)
        for (int kk = 0; kk < 64; ++kk) { const int slot = c * 64 + kk; if (slot >= 387) break; const int p = slot / 129, j = slot % 129; const int dd = (p == 0) ? 1 : (p == 1) ? 4 : 16; const int tk = t - j * dd;
            const float pk = __shfl(s[c], kk);
            if (tk >= 0) o += pk * base[(size_t)tk * MIXIN + 1024 + h * 64 + lane]; }
    ATT[(size_t)(b * S + t) * 1024 + h * 64 + lane] = o / ls;
}

__global__ void k_conv(const float* __restrict__ GX, const float* __restrict__ cw, const float* __restrict__ cb, float* __restrict__ XC) {
    const int t = blockIdx.x, ts = t % S;
    for (int c = threadIdx.x; c < 1024; c += 256) { float acc = cb[c];
#pragma unroll
        for (int k = 0; k < 4; ++k) { const int dt = k - 3; if (ts + dt >= 0) acc += cw[k * 1024 + c] * GX[(size_t)(t + dt) * 2048 + 1024 + c]; }
        XC[(size_t)t * 1024 + c] = acc; }
}
__global__ void k_lru(const float* __restrict__ RPRE, const float* __restrict__ IPRE, const float* __restrict__ XC, const float* __restrict__ lam, float* __restrict__ Aa, float* __restrict__ Bb) {
    const size_t i = (size_t)blockIdx.x * 256 + threadIdx.x; const int c = (int)(i & 1023);
    const float r = sigmoidf_(RPRE[i]), ig = sigmoidf_(IPRE[i]);
    const float nl = -lam[c]; const float sp = (nl > 20.f) ? nl : log1pf(expf(nl));
    const float log_a = -8.f * r * sp; const float a = expf(log_a); const float mult = sqrtf(-expm1f(2.f * log_a));
    Aa[i] = a; Bb[i] = mult * (ig * XC[i]);
}
__global__ void k_scan(const float* __restrict__ Aa, const float* __restrict__ Bb, float* __restrict__ Y) {
    const int idx = blockIdx.x * 256 + threadIdx.x; const int b = idx / 1024, c = idx % 1024;
    float h = 0.f; size_t off = (size_t)b * S * 1024 + c;
    for (int t = 0; t < S; ++t, off += 1024) { h = Aa[off] * h + Bb[off]; Y[off] = h; }
}
__global__ void k_gy(const float* __restrict__ GX, const float* __restrict__ Y, float* __restrict__ GY) {
    const size_t i = (size_t)blockIdx.x * 256 + threadIdx.x; const size_t t = i >> 10; const int c = (int)(i & 1023);
    GY[i] = gelu_tanh(GX[t * 2048 + c]) * Y[i];
}

__global__ void k_router(const float* __restrict__ x, const float* __restrict__ gain, const float* __restrict__ modl, const float* __restrict__ wr, const float* __restrict__ br,
                         float* __restrict__ HN2, int* __restrict__ topi, float* __restrict__ topg, int* __restrict__ cnt) {
    __shared__ float hrow[1024]; __shared__ float part[8][32]; __shared__ float lg[32];
    const int t = blockIdx.x, b = t / S, tid = threadIdx.x;
    const float* xr = x + (size_t)t * D;
    float v[4]; float ss = 0.f;
#pragma unroll
    for (int i = 0; i < 4; ++i) { v[i] = xr[tid + 256 * i]; ss += v[i] * v[i]; }
    ss = block_sum256(ss);
    const float rs = rsqrtf(ss * (1.f / D) + 1e-6f);
#pragma unroll
    for (int i = 0; i < 4; ++i) { const int col = tid + 256 * i; const float hv = v[i] * rs * gain[col] * (1.f + modl[b * 6144 + 4096 + col]) + modl[b * 6144 + 3072 + col];
        hrow[col] = hv; HN2[(size_t)t * D + col] = hv; }
    __syncthreads();
    { const int e = tid & 31, kp = tid >> 5; float acc = 0.f; for (int k = kp * 128; k < kp * 128 + 128; ++k) acc += hrow[k] * wr[k * 32 + e]; part[kp][e] = acc; }
    __syncthreads();
    if (tid < 32) { float a = br[tid]; for (int i = 0; i < 8; ++i) a += part[i][tid]; lg[tid] = a; }
    __syncthreads();
    if (tid == 0) { int idx[4]; float val[4]; unsigned used = 0u;
        for (int k = 0; k < 4; ++k) { int bi = -1; float bv = -INFINITY; for (int e = 0; e < 32; ++e) if (!((used >> e) & 1u) && lg[e] > bv) { bv = lg[e]; bi = e; } used |= 1u << bi; idx[k] = bi; val[k] = bv; }
        float den = 0.f, ex[4]; for (int k = 0; k < 4; ++k) { ex[k] = expf(val[k] - val[0]); den += ex[k]; }
        for (int k = 0; k < 4; ++k) { topi[t * 4 + k] = idx[k]; topg[t * 4 + k] = ex[k] / den; atomicAdd(&cnt[idx[k]], 1); } }
}
__global__ void k_plan(const int* __restrict__ cnt, int* __restrict__ pstart, int* __restrict__ tile_e) {
    if (threadIdx.x == 0) { int acc = 0, ti = 0;
        for (int e = 0; e < NE; ++e) { pstart[e] = acc; const int nt = (cnt[e] + 255) / 256; for (int i = 0; i < nt; ++i) tile_e[ti++] = e; acc += nt * 256; }
        for (; ti < NBLK; ++ti) tile_e[ti] = -1; }
}
__global__ void k_scatter(const int* __restrict__ topi, const int* __restrict__ pstart, int* __restrict__ fill, int* __restrict__ rowtok, int* __restrict__ pos) {
    const int i = blockIdx.x * 256 + threadIdx.x; const int e = topi[i];
    const int p = pstart[e] + atomicAdd(&fill[e], 1); rowtok[p] = i >> 2; pos[i] = p;
}
__global__ void k_swiglu(const float* __restrict__ HB, const int* __restrict__ tile_e, float* __restrict__ ACT) {
    const int p = blockIdx.x; if (tile_e[p / 256] < 0) return;
    for (int j = threadIdx.x; j < 1024; j += 256) { float g = HB[(size_t)p * 2048 + 2 * j], li = HB[(size_t)p * 2048 + 2 * j + 1];
        g = fminf(g, 7.f); li = fminf(fmaxf(li, -7.f), 7.f);
        ACT[(size_t)p * 1024 + j] = g * sigmoidf_(1.702f * g) * (li + 1.f); }
}
__global__ void k_combine(float* __restrict__ X, const float* __restrict__ Y2, const int* __restrict__ pos, const float* __restrict__ topg, const float* __restrict__ modl) {
    const int t = blockIdx.x, b = t / S;
    int pp[4]; float gg[4];
#pragma unroll
    for (int k = 0; k < 4; ++k) { pp[k] = pos[t * 4 + k]; gg[k] = topg[t * 4 + k]; }
    for (int c = threadIdx.x; c < 1024; c += 256) { float y = 0.f;
#pragma unroll
        for (int k = 0; k < 4; ++k) y += gg[k] * Y2[(size_t)pp[k] * 1024 + c];
        X[(size_t)t * D + c] += modl[b * 6144 + 5120 + c] * y; }
}

struct Bump { char* base; size_t off; template <class Tp> Tp* get(size_t n) { off = (off + 255) & ~(size_t)255; Tp* p = (Tp*)(base + off); off += n * sizeof(Tp); return p; } };

static void forward(void* const* d_in, float* X, void* d_ws, hipStream_t st) {
    const float* x = (const float*)d_in[0]; const float* c = (const float*)d_in[1]; const int* positions = (const int*)d_in[2];
    const float* ada_w = (const float*)d_in[3]; const float* ada_b = (const float*)d_in[4];
    const float* n1g = (const float*)d_in[5]; const float* n2g = (const float*)d_in[6];
    const float* attn_w_in = (const float*)d_in[7]; const float* da_qg = (const float*)d_in[8]; const float* da_kg = (const float*)d_in[9];
    const float* qag = (const float*)d_in[10]; const float* kvag = (const float*)d_in[11]; const float* w_uq = (const float*)d_in[12]; const float* w_ukv = (const float*)d_in[13];
    const float* mqg = (const float*)d_in[14]; const float* mkg = (const float*)d_in[15]; const float* attn_w_out = (const float*)d_in[16];
    const float* rec_w_in = (const float*)d_in[17]; const float* rec_b_in = (const float*)d_in[18]; const float* conv_w = (const float*)d_in[19]; const float* conv_b = (const float*)d_in[20];
    const float* rec_wa = (const float*)d_in[21]; const float* rec_ba = (const float*)d_in[22]; const float* rec_wx = (const float*)d_in[23]; const float* rec_bx = (const float*)d_in[24];
    const float* rec_lam = (const float*)d_in[25]; const float* rec_w_out = (const float*)d_in[26]; const float* rec_b_out = (const float*)d_in[27];
    const float* w_router = (const float*)d_in[28]; const float* b_router = (const float*)d_in[29]; const float* w1 = (const float*)d_in[30]; const float* b1 = (const float*)d_in[31];
    const float* w2 = (const float*)d_in[32]; const float* b2 = (const float*)d_in[33];

    Bump bp{(char*)d_ws, 0};
    int* ictl = bp.get<int>(1024);
    int* cnt = ictl, *fill = ictl + 64, *pstart = ictl + 128, *tile_e = ictl + 256;
    float* mod = bp.get<float>((size_t)DEPTH * 4 * 6144);
    float* HN = bp.get<float>((size_t)T * D);
    float* PROJ = bp.get<float>((size_t)T * 2048);
    float* Q2 = bp.get<float>((size_t)T * 768);
    float* KV2 = bp.get<float>((size_t)T * 1024);
    float* ATT = bp.get<float>((size_t)T * 1024);
    float* XC = bp.get<float>((size_t)T * 1024);
    float* RPRE = bp.get<float>((size_t)T * 1024);
    float* IPRE = bp.get<float>((size_t)T * 1024);
    float* Aa = bp.get<float>((size_t)T * 1024);
    float* Bb = bp.get<float>((size_t)T * 1024);
    float* Yv = bp.get<float>((size_t)T * 1024);
    int* topi = bp.get<int>((size_t)T * 4); float* topg = bp.get<float>((size_t)T * 4); int* pos = bp.get<int>((size_t)T * 4); int* rowtok = bp.get<int>(P);
    float* HB = bp.get<float>((size_t)P * 2048);
    float* ACT = bp.get<float>((size_t)P * 1024);
    float* Y2 = bp.get<float>((size_t)P * 1024);

    (void)hipMemcpyAsync(X, x, (size_t)T * D * 4, hipMemcpyDeviceToDevice, st);
    k_mod<<<dim3(6144 / 256, DEPTH), 256, 0, st>>>(c, ada_w, ada_b, mod);
    for (int l = 0; l < DEPTH; ++l) {
        const float* modl = mod + (size_t)l * 4 * 6144; const int j = l / 2;
        k_rmsmod<<<T, 256, 0, st>>>(X, n1g + l * D, modl, 0, 1024, HN);
        if (l % 2 == 0) {
            k_gemm<EpiStore><<<dim3((MIXIN + 63) / 64, T / 64), 256, 0, st>>>(HN, nullptr, attn_w_in + (size_t)j * D * MIXIN, nullptr, 0, EpiStore{PROJ, nullptr, MIXIN, 0}, D, MIXIN, MIXIN, D);
            k_postproj<<<T, 64, 0, st>>>(PROJ, da_qg + j * 64, da_kg + j * 64, qag + j * 256, kvag + j * 128, mkg + j * 96, positions);
            k_gemm<EpiStore><<<dim3(768 / 64, T / 64), 256, 0, st>>>(PROJ + 1536, nullptr, w_uq + (size_t)j * 256 * 768, nullptr, 0, EpiStore{Q2, nullptr, 768, 0}, MIXIN, 768, 768, 256);
            k_gemm<EpiStore><<<dim3(1024 / 64, T / 64), 256, 0, st>>>(PROJ + 1792, nullptr, w_ukv + (size_t)j * 128 * 1024, nullptr, 0, EpiStore{KV2, nullptr, 1024, 0}, MIXIN, 1024, 1024, 128);
            k_postq<<<T, 64, 0, st>>>(Q2, KV2, mqg + j * 96, mkg + j * 96, positions);
            k_dil<<<dim3(S / 4, 8, 4), 256, 0, st>>>(PROJ, ATT);
            k_mla<<<dim3(S / 4, 8, 4), 256, 0, st>>>(Q2, KV2, PROJ, ATT);
            k_gemm<EpiResid><<<dim3(D / 64, T / 64), 256, 0, st>>>(ATT, nullptr, attn_w_out + (size_t)j * 1024 * D, nullptr, 0, EpiResid{X, modl + 2048, nullptr}, 1024, D, D, 1024);
        } else {
            k_gemm<EpiStore><<<dim3(2048 / 64, T / 64), 256, 0, st>>>(HN, nullptr, rec_w_in + (size_t)j * D * 2048, nullptr, 0, EpiStore{PROJ, rec_b_in + j * 2048, 2048, 0}, D, 2048, 2048, D);
            k_conv<<<T, 256, 0, st>>>(PROJ, conv_w + j * 4 * 1024, conv_b + j * 1024, XC);
            for (int n = 0; n < 8; ++n) {
                k_gemm<EpiStore><<<dim3(2, T / 64), 256, 0, st>>>(XC + n * 128, nullptr, rec_wa + ((size_t)j * 8 + n) * 128 * 128, nullptr, 0, EpiStore{RPRE + n * 128, rec_ba + j * 1024 + n * 128, 1024, 0}, 1024, 128, 128, 128);
                k_gemm<EpiStore><<<dim3(2, T / 64), 256, 0, st>>>(XC + n * 128, nullptr, rec_wx + ((size_t)j * 8 + n) * 128 * 128, nullptr, 0, EpiStore{IPRE + n * 128, rec_bx + j * 1024 + n * 128, 1024, 0}, 1024, 128, 128, 128);
            }
            k_lru<<<T * 1024 / 256, 256, 0, st>>>(RPRE, IPRE, XC, rec_lam + j * 1024, Aa, Bb);
            k_scan<<<4096 / 256, 256, 0, st>>>(Aa, Bb, Yv);
            k_gy<<<T * 1024 / 256, 256, 0, st>>>(PROJ, Yv, ATT);
            k_gemm<EpiResid><<<dim3(D / 64, T / 64), 256, 0, st>>>(ATT, nullptr, rec_w_out + (size_t)j * 1024 * D, nullptr, 0, EpiResid{X, modl + 2048, rec_b_out + j * D}, 1024, D, D, 1024);
        }
        (void)hipMemsetAsync(ictl, 0, 1024 * 4, st);
        (void)hipMemsetAsync(rowtok, 0, (size_t)P * 4, st);
        k_router<<<T, 256, 0, st>>>(X, n2g + l * D, modl, w_router + (size_t)l * D * NE, b_router + l * NE, HN, topi, topg, cnt);
        k_plan<<<1, 64, 0, st>>>(cnt, pstart, tile_e);
        k_scatter<<<MPAIR / 256, 256, 0, st>>>(topi, pstart, fill, rowtok, pos);
        k_gemm<EpiStore><<<dim3(2048 / 64, P / 64), 256, 0, st>>>(HN, rowtok, w1 + (size_t)l * NE * D * 2048, tile_e, (size_t)D * 2048, EpiStore{HB, b1 + (size_t)l * NE * 2048, 2048, 2048}, D, 2048, 2048, D);
        k_swiglu<<<P, 256, 0, st>>>(HB, tile_e, ACT);
        k_gemm<EpiStore><<<dim3(1024 / 64, P / 64), 256, 0, st>>>(ACT, nullptr, w2 + (size_t)l * NE * 1024 * D, tile_e, (size_t)1024 * D, EpiStore{Y2, b2 + (size_t)l * NE * D, 1024, D}, 1024, D, D, 1024);
        k_combine<<<T, 256, 0, st>>>(X, Y2, pos, topg, modl);
    }
}
}


namespace mk {
#define LAS __attribute__((address_space(3)))
#define GAS __attribute__((address_space(1)))
typedef unsigned short bf16_t;
typedef short bf16x8 __attribute__((ext_vector_type(8)));
typedef short s16x4 __attribute__((ext_vector_type(4)));
typedef float f32x2 __attribute__((ext_vector_type(2)));
typedef float f32x4 __attribute__((ext_vector_type(4)));
typedef float f32x16 __attribute__((ext_vector_type(16)));
typedef unsigned u32x2 __attribute__((ext_vector_type(2)));
typedef unsigned u32x4 __attribute__((ext_vector_type(4)));
typedef GAS unsigned gu32;
#define RLX_AGENT __ATOMIC_RELAXED, __HIP_MEMORY_SCOPE_AGENT

__device__ __forceinline__ unsigned cvt_pk_bf16(float lo, float hi) { unsigned r; asm volatile("v_cvt_pk_bf16_f32 %0, %1, %2" : "=v"(r) : "v"(lo), "v"(hi)); return r; }
__device__ __forceinline__ float bf_lo(unsigned u) { return __uint_as_float(u << 16); }
__device__ __forceinline__ float bf_hi(unsigned u) { return __uint_as_float(u & 0xffff0000u); }
template <int O> __device__ __forceinline__ float shx(float v) { static_assert(O >= 1 && O < 32, "shx"); return __int_as_float(__builtin_amdgcn_ds_swizzle(__float_as_int(v), (O << 10) | 0x1f)); }
__device__ __forceinline__ float xadd32(float v) { const auto r = __builtin_amdgcn_permlane32_swap(__float_as_uint(v), __float_as_uint(v), false, false); return __uint_as_float(r[0]) + __uint_as_float(r[1]); }
__device__ __forceinline__ float xmax32(float v) { const auto r = __builtin_amdgcn_permlane32_swap(__float_as_uint(v), __float_as_uint(v), false, false); return fmaxf(__uint_as_float(r[0]), __uint_as_float(r[1])); }
__device__ __forceinline__ float wsum(float v) { v += shx<1>(v); v += shx<2>(v); v += shx<4>(v); v += shx<8>(v); v += shx<16>(v); return xadd32(v); }
__device__ __forceinline__ float fexp2(float x) { return __builtin_amdgcn_exp2f(x); }
__device__ __forceinline__ float frcp(float x) { return __builtin_amdgcn_rcpf(x); }
__device__ __forceinline__ float fsigmoid(float z) { return frcp(1.f + fexp2(-1.4426950408889634f * z)); }
__device__ __forceinline__ float fgelu_tanh(float x) { const float u = 0.7978845608028654f * (x + 0.044715f * x * x * x); return x * frcp(1.f + fexp2(-2.8853900817779268f * u)); }

#define XB_TMO      128
#define XB_XCNT(j)  (256  + 64 * (j))
#define XB_XSUB(j)  (1280 + 64 * (j))
#define XB_XGEN(j)  (2304 + 64 * (j))
#define XB_TOP      3328
#define XB_TOPGEN   3392
#define XCD_BAR_WORDS 3456
#define XB_SPIN_CAP (1u << 18)
__device__ __forceinline__ unsigned xb_ld(unsigned* p)              { return __hip_atomic_load(p, __ATOMIC_RELAXED, __HIP_MEMORY_SCOPE_AGENT); }
__device__ __forceinline__ unsigned xb_add(unsigned* p, unsigned v) { return __hip_atomic_fetch_add(p, v, __ATOMIC_RELAXED, __HIP_MEMORY_SCOPE_AGENT); }
__device__ __forceinline__ unsigned xb_xcc_id() { return (unsigned)__builtin_amdgcn_s_getreg((3 << 11) | 20) & 0xFu; }
#define XB_SPIN(cond, bar) do { unsigned _sp = 0; while (cond) { __builtin_amdgcn_s_sleep(1); \
    if ((++_sp & 255u) == 0u) { if (xb_ld(&(bar)[XB_TMO])) break; if (_sp > XB_SPIN_CAP) { atomicAdd(&(bar)[XB_TMO], 1u); break; } } } } while (0)
struct XcdBarrier { unsigned* bar; unsigned x; volatile LAS unsigned* st; };
__device__ __forceinline__ XcdBarrier xcd_barrier_post(unsigned* bar, volatile LAS unsigned* st, int tid) {
    XcdBarrier b; b.bar = bar; b.x = xb_xcc_id(); b.st = st;
    if (tid == 0) (void)xb_add(&bar[XB_XCNT(b.x)], 1u);
    return b;
}
__device__ __forceinline__ void xcd_barrier_complete(unsigned* bar, unsigned x, unsigned& nloc, unsigned& nx) {
    const unsigned G = gridDim.x * gridDim.y * gridDim.z;
    unsigned sum, cnt, mine, sp = 0u;
    for (;;) {
        sum = 0u; cnt = 0u; mine = 0u;
#pragma unroll
        for (unsigned j = 0; j < 16; ++j) { const unsigned c = xb_ld(&bar[XB_XCNT(j)]); sum += c; cnt += (c > 0u) ? 1u : 0u; mine = (j == x) ? c : mine; }
        if (sum == G) break;
        __builtin_amdgcn_s_sleep(1);
        if ((++sp & 255u) == 0u) { if (xb_ld(&bar[XB_TMO])) break; if (sp > XB_SPIN_CAP) { atomicAdd(&bar[XB_TMO], 1u); break; } }
    }
    nloc = mine > 0u ? mine : 1u; nx = cnt > 0u ? cnt : 1u;
}
__device__ __forceinline__ void xcd_barrier(const XcdBarrier& b, int tid) {
    asm volatile("s_waitcnt vmcnt(0)" ::: "memory");
    __syncthreads();
    if (tid == 0) {
        unsigned* bar = b.bar;
        __builtin_amdgcn_s_waitcnt(0);
        unsigned nloc = b.st[0], nx = b.st[1];
        if (nloc == 0u) { xcd_barrier_complete(bar, b.x, nloc, nx); b.st[0] = nloc; b.st[1] = nx; }
        const unsigned old = xb_add(&bar[XB_XSUB(b.x)], 1u);
        const unsigned gen = old / nloc;
        if (old + 1u == (gen + 1u) * nloc) {
            __builtin_amdgcn_fence(__ATOMIC_RELEASE, "agent");
            asm volatile("s_waitcnt vmcnt(0)" ::: "memory");
            const unsigned og = xb_add(&bar[XB_TOP], 1u);
            const unsigned tg = og / nx;
            if (og + 1u == (tg + 1u) * nx) xb_add(&bar[XB_TOPGEN], 1u);
            else XB_SPIN(xb_ld(&bar[XB_TOPGEN]) == tg, bar);
            __builtin_amdgcn_fence(__ATOMIC_ACQUIRE, "agent");
            xb_add(&bar[XB_XGEN(b.x)], 1u);
            asm volatile("s_waitcnt vmcnt(0)" ::: "memory");
        } else {
            XB_SPIN(xb_ld(&bar[XB_XGEN(b.x)]) == gen, bar);
            __builtin_amdgcn_fence(__ATOMIC_ACQUIRE, "agent");
            asm volatile("s_waitcnt vmcnt(0)" ::: "memory");
        }
    }
    __syncthreads();
}

constexpr int BM = 256, BK = 64, HALF = 128, HTB = HALF * BK * 2, STAGE_BYTES = 8 * HTB;
__host__ __device__ __forceinline__ int lds_byte(int r, int c) { const int st = (r >> 4) * 2 + (c >> 5), rr = r & 15, cc = c & 31, ob = rr * 64 + cc * 2; return st * 1024 + (ob ^ (((ob >> 9) & 1) << 5)); }
__host__ __device__ __forceinline__ void stage_rc(int b, int& R, int& C) { const int st = b / 1024, sb = b % 1024, swz = sb ^ (((sb >> 9) & 1) << 5); R = (st >> 1) * 16 + swz / 64; C = (st & 1) * 32 + (swz % 64) / 2; }
__host__ __device__ __forceinline__ int perm32(int rho) { const int n = rho >> 4, i = rho & 15; return 8 * (i >> 2) + 4 * n + (i & 3); }

struct Unit { const char* a; const char* b; int row0, col0, e, pad; };
struct GemmDims { int K, lda, ldb; };
typedef f32x4 Acc[2][2][4][2];
__device__ __forceinline__ void zero_acc(Acc& acc) {
#pragma unroll
    for (int a = 0; a < 2; ++a)
#pragma unroll
        for (int b = 0; b < 2; ++b)
#pragma unroll
            for (int m = 0; m < 4; ++m)
#pragma unroll
                for (int n = 0; n < 2; ++n)
#pragma unroll
                    for (int j = 0; j < 4; ++j) { float z; asm volatile("v_mov_b32 %0, 0" : "=v"(z)); acc[a][b][m][n][j] = z; }
}

typedef int v8i32 __attribute__((ext_vector_type(8)));
template <bool F8 = false, class CtxT, class Epi, class Sched>
__device__ __forceinline__ void gemm_phase(const CtxT& C, const GemmDims g, const Sched& S, const Epi& E) {
    LAS unsigned char* lds = C.lds;
    const int tid = C.tid, wid = __builtin_amdgcn_readfirstlane(tid >> 6), lane = tid & 63, wr = wid >> 2, wc = wid & 3, fr = lane & 15, fq = lane >> 4;
    constexpr int ESZ = F8 ? 1 : 2;
    int nt = g.K / (F8 ? 128 : BK); asm volatile("" : "+s"(nt));
    unsigned voffA[2], voffB[2];
#pragma unroll
    for (int i = 0; i < 2; ++i) { int R, C; stage_rc(tid * 16 + i * 8192, R, C); const int Rb = (R & ~31) + perm32(R & 31);
        voffA[i] = (unsigned)(R * g.lda * ESZ + C * 2); voffB[i] = (unsigned)(Rb * g.ldb * ESZ + C * 2); }
    const size_t kstep = (size_t)(BK * 2);
    const size_t hstepA = (size_t)HALF * g.lda * ESZ, hstepB = (size_t)HALF * g.ldb * ESZ;
    const unsigned ldsw = (unsigned)wid * 1024u;
    const unsigned ldsu = (unsigned)__builtin_amdgcn_readfirstlane((int)(unsigned)(unsigned long long)(lds));
    const int aoff = lds_byte(wr * 64 + fr, fq * 8), boff = lds_byte(wc * 32 + fr, fq * 8);
#define PG8_SA(b, h) (((b) * 2 + (h)) * HTB)
#define PG8_SB(b, h) ((4 + (b) * 2 + (h)) * HTB)
#define PG8_STAGE(bufoff, gbase, voff) do { _Pragma("unroll") for (int _i = 0; _i < 2; ++_i) { \
        asm volatile("s_mov_b32 m0, %2\n\ts_nop 3\n\tglobal_load_lds_dwordx4 %0, %1" :: "v"((voff)[_i]), "s"((const char*)(gbase)), "s"(ldsu + (unsigned)(bufoff) + ldsw + (unsigned)(_i * 8192)) : "memory"); } } while (0)
#define PG8_LDA(dst, b, h) do { _Pragma("unroll") for (int m = 0; m < 4; ++m) _Pragma("unroll") for (int k = 0; k < 2; ++k) dst[m][k] = *(const LAS bf16x8*)(lds + PG8_SA(b, h) + aoff + m * 2048 + k * 1024); } while (0)
#define PG8_LDB(dst, b, h) do { _Pragma("unroll") for (int n = 0; n < 2; ++n) _Pragma("unroll") for (int k = 0; k < 2; ++k) dst[n][k] = *(const LAS bf16x8*)(lds + PG8_SB(b, h) + boff + n * 2048 + k * 1024); } while (0)
#define PG8_CAT(x) __builtin_bit_cast(v8i32, (x))
#define PG8_MMA(ai, bj, At, Bt) do { __builtin_amdgcn_s_setprio(1); \
        if constexpr (F8) { _Pragma("unroll") for (int m = 0; m < 4; ++m) _Pragma("unroll") for (int n = 0; n < 2; ++n) \
            acc[ai][bj][m][n] = __builtin_amdgcn_mfma_scale_f32_16x16x128_f8f6f4(PG8_CAT(Bt[n]), PG8_CAT(At[m]), acc[ai][bj][m][n], 0, 0, 0, 0, 0, 0); } \
        else { _Pragma("unroll") for (int m = 0; m < 4; ++m) _Pragma("unroll") for (int n = 0; n < 2; ++n) _Pragma("unroll") for (int k = 0; k < 2; ++k) \
            acc[ai][bj][m][n] = __builtin_amdgcn_mfma_f32_16x16x32_bf16(Bt[n][k], At[m][k], acc[ai][bj][m][n], 0, 0, 0); } \
        __builtin_amdgcn_s_setprio(0); } while (0)
#define PG8_WAIT_V(n) asm volatile("s_waitcnt vmcnt(" #n ")" ::: "memory")
#define PG8_WAIT_L(n) asm volatile("s_waitcnt lgkmcnt(" #n ")" ::: "memory")
#define PG8_BAR __builtin_amdgcn_s_barrier()
#define PG8_SCHED __builtin_amdgcn_sched_barrier(0)
    Unit cur, nxt; int ui = 0;
    if (!S.next(0, cur)) return;
    Acc acc; zero_acc(acc);
    struct Frag2 { bf16x8 p[2]; __device__ __forceinline__ bf16x8& operator[](int k) { return p[k]; } __device__ __forceinline__ const bf16x8& operator[](int k) const { return p[k]; } };
    Frag2 At[4], B0[2], B1[2];
    const char* cA = cur.a; const char* cB = cur.b;
    PG8_STAGE(PG8_SB(0, 0), cB, voffB); PG8_STAGE(PG8_SB(0, 1), cB + hstepB, voffB); PG8_STAGE(PG8_SA(0, 0), cA, voffA); PG8_STAGE(PG8_SA(0, 1), cA + hstepA, voffA);
    if (wr == 1) PG8_BAR;
    PG8_WAIT_V(2); PG8_BAR;
    PG8_STAGE(PG8_SB(1, 0), cB + kstep, voffB); PG8_STAGE(PG8_SA(1, 0), cA + kstep, voffA); PG8_STAGE(PG8_SB(1, 1), cB + hstepB + kstep, voffB);
    PG8_WAIT_V(6); PG8_BAR;
    for (;;) {
        const bool has_next = S.next(ui + 1, nxt);
        const char* nA = has_next ? nxt.a : cA; const char* nB = has_next ? nxt.b : cB;
        for (int t = 0; t < nt; t += 2) {
            const bool last = (t == nt - 2);
            const char* a1 = cA + (size_t)(t + 1) * kstep;
            const char* a2 = last ? nA : cA + (size_t)(t + 2) * kstep; const char* b2 = last ? nB : cB + (size_t)(t + 2) * kstep;
            const char* a3 = a2 + kstep; const char* b3 = b2 + kstep;
            PG8_LDB(B0, 0, 0); PG8_LDB(B1, 0, 1); PG8_SCHED; PG8_LDA(At, 0, 0); PG8_STAGE(PG8_SA(1, 1), a1 + hstepA, voffA);
            PG8_WAIT_V(8); PG8_WAIT_L(0); PG8_BAR; PG8_MMA(0, 0, At, B0); PG8_MMA(0, 1, At, B1); PG8_BAR; PG8_SCHED;
            PG8_LDA(At, 0, 1); PG8_STAGE(PG8_SB(0, 0), b2, voffB); PG8_STAGE(PG8_SB(0, 1), b2 + hstepB, voffB); PG8_STAGE(PG8_SA(0, 0), a2, voffA);
            PG8_WAIT_V(8); PG8_WAIT_L(0); PG8_BAR; PG8_MMA(1, 0, At, B0); PG8_MMA(1, 1, At, B1); PG8_BAR; PG8_SCHED;
            PG8_LDB(B0, 1, 0); PG8_LDB(B1, 1, 1); PG8_SCHED; PG8_LDA(At, 1, 0); PG8_STAGE(PG8_SA(0, 1), a2 + hstepA, voffA);
            PG8_WAIT_V(8); PG8_WAIT_L(0); PG8_BAR; PG8_MMA(0, 0, At, B0); PG8_MMA(0, 1, At, B1); PG8_BAR; PG8_SCHED;
            PG8_LDA(At, 1, 1); PG8_STAGE(PG8_SB(1, 0), b3, voffB); PG8_STAGE(PG8_SB(1, 1), b3 + hstepB, voffB); PG8_STAGE(PG8_SA(1, 0), a3, voffA);
            PG8_WAIT_V(8); PG8_WAIT_L(0); PG8_BAR; PG8_MMA(1, 0, At, B0); PG8_MMA(1, 1, At, B1); PG8_BAR; PG8_SCHED;
        }
        if (wr == 0) PG8_BAR;
        E(acc, cur, wr, wc, fr, fq);
        if (!has_next) break;
        zero_acc(acc);
        cur = nxt; cA = nA; cB = nB; ++ui;
        if (wr == 1) PG8_BAR;
    }
    PG8_WAIT_V(0);
    PG8_BAR;
#undef PG8_SA
#undef PG8_SB
#undef PG8_STAGE
#undef PG8_LDA
#undef PG8_LDB
#undef PG8_MMA
#undef PG8_CAT
#undef PG8_WAIT_V
#undef PG8_WAIT_L
#undef PG8_BAR
#undef PG8_SCHED
}

struct DenseOrder {
    const char* A; const char* Bt; int lda, ldb, nM, nN, nwg, G, c;
    __device__ __forceinline__ void init(const void* A_, const void* Bt_, int lda_, int ldb_, int M, int N, int G_, int c_) { A = (const char*)A_; Bt = (const char*)Bt_; lda = lda_; ldb = ldb_; nM = M / BM; nN = N / BM; nwg = nM * nN; G = G_; c = c_; }
    __device__ __forceinline__ bool next(int i, Unit& u) const {
        const long L = (long)i * G + c; if (L >= nwg) return false;
        int wgid = (int)L; { const int q = nwg / 8, r = nwg % 8, xcd = wgid % 8, off = wgid / 8; wgid = (xcd < r ? xcd * (q + 1) : r * (q + 1) + (xcd - r) * q) + off; }
        const int nig = 8 * nN, gid = wgid / nig, fm = gid * 8, gsz = (nM - fm) < 8 ? (nM - fm) : 8;
        const int pm = fm + ((wgid % nig) % gsz), pn = (wgid % nig) / gsz;
        u.a = A + (size_t)pm * BM * lda * 2; u.b = Bt + (size_t)pn * BM * ldb * 2; u.row0 = pm * BM; u.col0 = pn * BM; u.e = 0; u.pad = 0; return true;
    }
};
struct LruOrder {
    const char* XC; const char* RG; int G, c;
    __device__ __forceinline__ bool next(int i, Unit& u) const {
        const int L = i * G + c; if (L >= 512) return false;
        const int pm = L >> 3, n = L & 7;
        u.a = XC + ((size_t)pm * BM * 1024 + n * 128) * 2; u.b = RG + (size_t)n * 256 * 128 * 2; u.row0 = pm * BM; u.col0 = n * 128; u.e = n; u.pad = 0; return true;
    }
};
struct MoeOrder {
    const char* A; const char* WT; size_t estride; const LAS int* tile_e; int NT, nN, G, c, esz;
    __device__ __forceinline__ bool next(int i, Unit& u) const {
        int tile, pn;
        if ((G % (8 * nN)) == 0) { const int R = G / nN; tile = i * R + (c & 7) * (R >> 3) + (c >> 3) / nN; pn = (c >> 3) % nN; }
        else { const int L = i * G + c; tile = L / nN; pn = L % nN; }
        if (tile >= NT) return false;
        const int e = __builtin_amdgcn_readfirstlane(tile_e[tile]);
        u.a = A + (size_t)tile * BM * 1024 * esz; u.b = WT + (size_t)e * estride + (size_t)pn * BM * 1024 * esz; u.row0 = tile * BM; u.col0 = pn * BM; u.e = e; u.pad = 0; return true;
    }
};

#define EPI_ROW(ai, m) (u.row0 + (ai) * HALF + wr * 64 + (m) * 16 + fr)
#define EPI_COL(bj) (u.col0 + (bj) * HALF + wc * 32 + 8 * fq)
struct EpiBf16 {
    bf16_t* O; const float* bias; int ldc, bias_es; float ascale;
    __device__ __forceinline__ void operator()(const Acc& acc, const Unit& u, int wr, int wc, int fr, int fq) const {
        f32x4 bv[2][2];
#pragma unroll
        for (int bj = 0; bj < 2; ++bj)
#pragma unroll
            for (int n = 0; n < 2; ++n) bv[bj][n] = bias ? *(const f32x4*)(bias + (size_t)u.e * bias_es + EPI_COL(bj) + 4 * n) : (f32x4){0.f, 0.f, 0.f, 0.f};
#pragma unroll
        for (int ai = 0; ai < 2; ++ai)
#pragma unroll
            for (int m = 0; m < 4; ++m) { bf16_t* rowp = O + (size_t)EPI_ROW(ai, m) * ldc;
#pragma unroll
                for (int bj = 0; bj < 2; ++bj) { const f32x4 v0 = acc[ai][bj][m][0] * ascale + bv[bj][0], v1 = acc[ai][bj][m][1] * ascale + bv[bj][1];
                    u32x4 w; w.x = cvt_pk_bf16(v0[0], v0[1]); w.y = cvt_pk_bf16(v0[2], v0[3]); w.z = cvt_pk_bf16(v1[0], v1[1]); w.w = cvt_pk_bf16(v1[2], v1[3]);
                    *(u32x4*)(rowp + EPI_COL(bj)) = w; } }
    }
};
struct EpiRecIn {
    bf16_t* O; const float* bias;
    __device__ __forceinline__ void operator()(const Acc& acc, const Unit& u, int wr, int wc, int fr, int fq) const {
        const bool act = u.col0 < 1024;
        f32x4 bv[2][2];
#pragma unroll
        for (int bj = 0; bj < 2; ++bj)
#pragma unroll
            for (int n = 0; n < 2; ++n) bv[bj][n] = *(const f32x4*)(bias + EPI_COL(bj) + 4 * n);
#pragma unroll
        for (int ai = 0; ai < 2; ++ai)
#pragma unroll
            for (int m = 0; m < 4; ++m) { bf16_t* rowp = O + (size_t)EPI_ROW(ai, m) * 2048;
#pragma unroll
                for (int bj = 0; bj < 2; ++bj) { f32x4 v0 = acc[ai][bj][m][0] + bv[bj][0], v1 = acc[ai][bj][m][1] + bv[bj][1];
                    if (act) {
#pragma unroll
                        for (int j = 0; j < 4; ++j) { v0[j] = fgelu_tanh(v0[j]); v1[j] = fgelu_tanh(v1[j]); } }
                    u32x4 w; w.x = cvt_pk_bf16(v0[0], v0[1]); w.y = cvt_pk_bf16(v0[2], v0[3]); w.z = cvt_pk_bf16(v1[0], v1[1]); w.w = cvt_pk_bf16(v1[2], v1[3]);
                    *(u32x4*)(rowp + EPI_COL(bj)) = w; } }
    }
};
__device__ __forceinline__ unsigned pk4_fp8(float a, float b, float c, float d) { int w = 0; w = __builtin_amdgcn_cvt_pk_fp8_f32(a, b, w, false); w = __builtin_amdgcn_cvt_pk_fp8_f32(c, d, w, true); return (unsigned)w; }
struct EpiSwiglu {
    unsigned char* ACT; const float* b1; float ascale;
    __device__ __forceinline__ float sw(float g, float l) const { g = fminf(g, 7.f); l = fminf(fmaxf(l, -7.f), 7.f); return g * fsigmoid(1.702f * g) * (l + 1.f); }
    __device__ __forceinline__ void operator()(const Acc& acc, const Unit& u, int wr, int wc, int fr, int fq) const {
        f32x4 bv[2][2];
#pragma unroll
        for (int bj = 0; bj < 2; ++bj)
#pragma unroll
            for (int n = 0; n < 2; ++n) bv[bj][n] = *(const f32x4*)(b1 + (size_t)u.e * 2048 + EPI_COL(bj) + 4 * n);
#pragma unroll
        for (int ai = 0; ai < 2; ++ai)
#pragma unroll
            for (int m = 0; m < 4; ++m) { unsigned char* rowp = ACT + (size_t)EPI_ROW(ai, m) * 1024;
#pragma unroll
                for (int bj = 0; bj < 2; ++bj) { const f32x4 v0 = acc[ai][bj][m][0] * ascale + bv[bj][0], v1 = acc[ai][bj][m][1] * ascale + bv[bj][1];
                    *(unsigned*)(rowp + (EPI_COL(bj) >> 1)) = pk4_fp8(sw(v0[0], v0[1]), sw(v0[2], v0[3]), sw(v1[0], v1[1]), sw(v1[2], v1[3])); } }
    }
};
struct EpiResid {
    float* X; const float* g; const float* bias;
    __device__ __forceinline__ void operator()(const Acc& acc, const Unit& u, int wr, int wc, int fr, int fq) const {
        const int b = u.row0 / cfg::S;
        f32x4 bv[2][2], gv[2][2];
#pragma unroll
        for (int bj = 0; bj < 2; ++bj)
#pragma unroll
            for (int n = 0; n < 2; ++n) { bv[bj][n] = bias ? *(const f32x4*)(bias + EPI_COL(bj) + 4 * n) : (f32x4){0.f, 0.f, 0.f, 0.f}; gv[bj][n] = *(const f32x4*)(g + b * 6144 + EPI_COL(bj) + 4 * n); }
#pragma unroll
        for (int ai = 0; ai < 2; ++ai)
#pragma unroll
            for (int m = 0; m < 4; ++m) { float* rowp = X + (size_t)EPI_ROW(ai, m) * 1024;
#pragma unroll
                for (int bj = 0; bj < 2; ++bj)
#pragma unroll
                    for (int n = 0; n < 2; ++n) { f32x4* p = (f32x4*)(rowp + EPI_COL(bj) + 4 * n); *p = *p + gv[bj][n] * (acc[ai][bj][m][n] + bv[bj][n]); }
                if (m & 1) asm volatile("" ::: "memory"); }
    }
};
struct EpiLru {
    const bf16_t* XC; const float* ba; const float* bx; const float* lam; float* Aa; float* Bb;
    __device__ __forceinline__ void operator()(const Acc& acc, const Unit& u, int wr, int wc, int fr, int fq) const {
        const int ch0 = u.col0 + wc * 32 + 8 * fq;
#pragma unroll
        for (int n = 0; n < 2; ++n) { const int ch = ch0 + 4 * n;
            const f32x4 bav = *(const f32x4*)(ba + ch), bxv = *(const f32x4*)(bx + ch), spv = *(const f32x4*)(lam + ch);
#pragma unroll
            for (int ai = 0; ai < 2; ++ai)
#pragma unroll
                for (int m = 0; m < 4; ++m) { const size_t ro = (size_t)EPI_ROW(ai, m) * 1024 + ch;
                    const u32x2 xr = *(const u32x2*)(XC + ro);
                    const float xcv[4] = {bf_lo(xr.x), bf_hi(xr.x), bf_lo(xr.y), bf_hi(xr.y)};
                    f32x4 av, bvv;
#pragma unroll
                    for (int j = 0; j < 4; ++j) { const float r = fsigmoid(acc[ai][0][m][n][j] + bav[j]), ig = fsigmoid(acc[ai][1][m][n][j] + bxv[j]);
                        const float a = fexp2(r * spv[j]); av[j] = a; bvv[j] = __builtin_amdgcn_sqrtf(fmaxf(1.f - a * a, 0.f)) * ig * xcv[j]; }
                    *(f32x4*)(Aa + ro) = av; *(f32x4*)(Bb + ro) = bvv; asm volatile("" ::: "memory"); } }
    }
};

constexpr size_t MiB = (size_t)1 << 20;
constexpr size_t al4k(size_t x) { return (x + 4095) & ~(size_t)4095; }
constexpr int T_ = cfg::T, S_ = cfg::S, P_ = cfg::P;
constexpr size_t O_CTL = 0, SZ_CTL = 1 * MiB;
constexpr size_t O_MOD = O_CTL + SZ_CTL, SZ_MOD = al4k((size_t)4 * 4 * 6144 * 4);
constexpr size_t O_CS = O_MOD + SZ_MOD, SZ_CS = (size_t)T_ * 32 * 4;
constexpr size_t O_HIST = O_CS + SZ_CS, SZ_HIST = 256 * 32 * 4;
constexpr size_t O_TOPI = O_HIST + SZ_HIST, SZ_TOP = (size_t)T_ * 4 * 4;
constexpr size_t O_TOPG = O_TOPI + SZ_TOP, O_POS = O_TOPG + SZ_TOP;
constexpr size_t O_SUMP = O_POS + SZ_TOP, SZ_SUM = (size_t)4 * 64 * 1024 * 4;
constexpr size_t O_SUMH = O_SUMP + SZ_SUM;
constexpr size_t O_LSE = O_SUMH + SZ_SUM, SZ_LSE = (size_t)3 * T_ * 8 * 4;
constexpr size_t O_SPV = al4k(O_LSE + SZ_LSE), SZ_SPV = 2 * 1024 * 4;
constexpr size_t O_WIN = al4k(O_SPV + SZ_SPV), SZ_WIN = (size_t)2048 * 1024 * 2;
constexpr size_t O_WUQ = O_WIN + 2 * SZ_WIN, SZ_WUQ = (size_t)768 * 256 * 2;
constexpr size_t O_WUKV = O_WUQ + 2 * SZ_WUQ, SZ_WUKV = (size_t)1024 * 128 * 2;
constexpr size_t O_WOUT = O_WUKV + 2 * SZ_WUKV, SZ_WOUT = (size_t)1024 * 1024 * 2;
constexpr size_t O_RWIN = O_WOUT + 2 * SZ_WOUT, SZ_RWIN = (size_t)2048 * 1024 * 2;
constexpr size_t O_RGATE = O_RWIN + 2 * SZ_RWIN, SZ_RGATE = (size_t)8 * 256 * 128 * 2;
constexpr size_t O_RWOUT = O_RGATE + 2 * SZ_RGATE, SZ_RWOUT = (size_t)1024 * 1024 * 2;
constexpr size_t O_W1 = O_RWOUT + 2 * SZ_RWOUT, SZ_W1E = (size_t)2048 * 1024;
constexpr size_t O_W2 = O_W1 + 128 * SZ_W1E, SZ_W2E = (size_t)1024 * 1024;
constexpr size_t O_HN = O_W2 + 128 * SZ_W2E, SZ_HN = (size_t)T_ * 1024 * 2;
constexpr size_t O_PROJ = O_HN + SZ_HN, SZ_PROJ = (size_t)T_ * 2048 * 2;
constexpr size_t O_Q2 = O_PROJ + SZ_PROJ, SZ_Q2 = (size_t)T_ * 768 * 2;
constexpr size_t O_KV2 = O_Q2 + SZ_Q2, SZ_KV2 = (size_t)T_ * 1024 * 2;
constexpr size_t O_OA = O_KV2 + SZ_KV2, SZ_OA = (size_t)3 * T_ * 512 * 2;
constexpr size_t O_ATT = O_OA + SZ_OA, SZ_ATT = (size_t)T_ * 1024 * 2;
constexpr size_t O_XC = O_ATT + SZ_ATT, SZ_XC = (size_t)T_ * 1024 * 2;
constexpr size_t O_AA = O_XC + SZ_XC, SZ_AA = (size_t)T_ * 1024 * 4;
constexpr size_t O_BB = O_AA + SZ_AA;
constexpr size_t O_XG = O_BB + SZ_AA, SZ_XG = (size_t)P_ * 1024 * 2;
constexpr size_t O_ACT = O_XG + SZ_XG, O_Y2 = O_ACT + SZ_XG;
constexpr size_t WS_MK_END = O_Y2 + SZ_XG;
constexpr size_t O_NAIVE = (size_t)2048 * MiB;
static_assert(WS_MK_END <= O_NAIVE, "mk workspace");
constexpr int CW_BAR = 4096;
constexpr int RING_BYTES = 131072, LDSX_OFF = RING_BYTES;
constexpr int LDS_BYTES = 147456;
constexpr int LX_TILE = LDSX_OFF + 64, LX_MISC = LDSX_OFF + 2048;

struct Args { const void* in[34]; float* out; unsigned char* ws; int ph_lo, ph_hi; };
struct Ctx { int tid, lane, wave, G, bid, vcu, gw, NGW; LAS unsigned char* lds; unsigned char* ws; };

__device__ __forceinline__ void conv_load(f32x4 (&v)[16], const float* __restrict__ W, int N, int n0, int k0, int lane) {
    const int n = n0 + 4 * (lane & 15); const float* p = W + (size_t)(k0 + 16 * (lane >> 4)) * N + n;
#pragma unroll
    for (int i = 0; i < 16; ++i) v[i] = (n < N) ? __builtin_nontemporal_load((const f32x4*)(p + (size_t)i * N)) : (f32x4){0.f, 0.f, 0.f, 0.f};
}
__device__ __forceinline__ void conv_emit(const f32x4 (&v)[16], LAS unsigned char* T  , bf16_t* __restrict__ WT, int ldd, int n0, int k0, int lane) {
    const int kq = lane >> 4, c4 = lane & 15;
#pragma unroll
    for (int jj = 0; jj < 4; ++jj) { u32x4 lo, hi;
        lo.x = cvt_pk_bf16(v[0][jj], v[1][jj]); lo.y = cvt_pk_bf16(v[2][jj], v[3][jj]); lo.z = cvt_pk_bf16(v[4][jj], v[5][jj]); lo.w = cvt_pk_bf16(v[6][jj], v[7][jj]);
        hi.x = cvt_pk_bf16(v[8][jj], v[9][jj]); hi.y = cvt_pk_bf16(v[10][jj], v[11][jj]); hi.z = cvt_pk_bf16(v[12][jj], v[13][jj]); hi.w = cvt_pk_bf16(v[14][jj], v[15][jj]);
        LAS unsigned char* q = T + (4 * c4 + jj) * 144 + 32 * kq; *(LAS u32x4*)q = lo; *(LAS u32x4*)(q + 16) = hi; }
    asm volatile("s_waitcnt lgkmcnt(0)" ::: "memory");
#pragma unroll
    for (int s8 = 0; s8 < 8; ++s8) { const int n = 8 * s8 + (lane >> 3), ch = lane & 7; const u32x4 w = *(const LAS u32x4*)(T + n * 144 + 16 * ch);
        *(u32x4*)(WT + (size_t)(n0 + n) * ldd + k0 + 8 * ch) = w; }
    asm volatile("s_waitcnt lgkmcnt(0)" ::: "memory");
}
__device__ __forceinline__ void conv8_tile(const float* __restrict__ W, int N, unsigned char* __restrict__ WT, int ldd, int n0, int k0, LAS unsigned char* T  , int lane) {
    const int kq = lane >> 4, c4 = lane & 15; const float* p = W + (size_t)(k0 + 32 * kq) * N + n0 + 4 * c4;
    f32x4 v[32];
#pragma unroll
    for (int i = 0; i < 32; ++i) v[i] = __builtin_nontemporal_load((const f32x4*)(p + (size_t)i * N));
#pragma unroll
    for (int jj = 0; jj < 4; ++jj) { u32x4 lo, hi;
        lo.x = pk4_fp8(32.f * v[0][jj], 32.f * v[1][jj], 32.f * v[2][jj], 32.f * v[3][jj]);     lo.y = pk4_fp8(32.f * v[4][jj], 32.f * v[5][jj], 32.f * v[6][jj], 32.f * v[7][jj]);
        lo.z = pk4_fp8(32.f * v[8][jj], 32.f * v[9][jj], 32.f * v[10][jj], 32.f * v[11][jj]);   lo.w = pk4_fp8(32.f * v[12][jj], 32.f * v[13][jj], 32.f * v[14][jj], 32.f * v[15][jj]);
        hi.x = pk4_fp8(32.f * v[16][jj], 32.f * v[17][jj], 32.f * v[18][jj], 32.f * v[19][jj]); hi.y = pk4_fp8(32.f * v[20][jj], 32.f * v[21][jj], 32.f * v[22][jj], 32.f * v[23][jj]);
        hi.z = pk4_fp8(32.f * v[24][jj], 32.f * v[25][jj], 32.f * v[26][jj], 32.f * v[27][jj]); hi.w = pk4_fp8(32.f * v[28][jj], 32.f * v[29][jj], 32.f * v[30][jj], 32.f * v[31][jj]);
        LAS unsigned char* q = T + (4 * c4 + jj) * 144 + 32 * kq; *(LAS u32x4*)q = lo; *(LAS u32x4*)(q + 16) = hi; }
    asm volatile("s_waitcnt lgkmcnt(0)" ::: "memory");
#pragma unroll
    for (int s8 = 0; s8 < 8; ++s8) { const int n = 8 * s8 + (lane >> 3), ch = lane & 7; const u32x4 w = *(const LAS u32x4*)(T + n * 144 + 16 * ch);
        *(u32x4*)(WT + (size_t)(n0 + n) * ldd + k0 + 16 * ch) = w; }
    asm volatile("s_waitcnt lgkmcnt(0)" ::: "memory");
}
template <class AP> __device__ __forceinline__ void p0_prologue(const Ctx& C, AP a) {
    unsigned char* ws = C.ws;
    { const float* c = (const float*)a->in[1]; const float* ada_w = (const float*)a->in[3]; const float* ada_b = (const float*)a->in[4]; float* mod = (float*)(ws + O_MOD);
      LAS float* part = (LAS float*)C.lds;
      LAS float* cact = (LAS float*)(C.lds + 32768);
      if (C.bid < 4 * 24) { for (int i = C.tid; i < 4096; i += 512) { const int b = i >> 10, k = i & 1023; const float cv = c[i]; cact[k * 4 + b] = cv / (1.f + expf(-cv)); } __syncthreads(); }
      for (int it = C.bid; it < 4 * 24; it += C.G) { const int l = it / 24, n0 = (it % 24) * 256;
          f32x4 acc[4];
#pragma unroll
          for (int b = 0; b < 4; ++b) acc[b] = (f32x4){0.f, 0.f, 0.f, 0.f};
          const float* w = ada_w + (size_t)l * 1024 * 6144 + n0 + 4 * C.lane;
#pragma unroll 1
          for (int k0 = C.wave * 128; k0 < C.wave * 128 + 128; k0 += 16) { f32x4 wv[16];
#pragma unroll
              for (int i = 0; i < 16; ++i) wv[i] = __builtin_nontemporal_load((const f32x4*)(w + (size_t)(k0 + i) * 6144));
#pragma unroll
              for (int i = 0; i < 16; ++i) { const f32x4 sv = *(const LAS f32x4*)(cact + (k0 + i) * 4);
#pragma unroll
                  for (int b = 0; b < 4; ++b) acc[b] = acc[b] + sv[b] * wv[i]; } }
#pragma unroll
          for (int b = 0; b < 4; ++b) *(LAS f32x4*)(part + (C.wave * 4 + b) * 256 + 4 * C.lane) = acc[b];
          __syncthreads();
          for (int o = C.tid; o < 1024; o += 512) { const int b = o >> 8, n = o & 255; float sacc = ada_b[l * 6144 + n0 + n];
#pragma unroll
              for (int w8 = 0; w8 < 8; ++w8) sacc += part[(w8 * 4 + b) * 256 + n];
              mod[((size_t)l * 4 + b) * 6144 + n0 + n] = sacc; }
          __syncthreads(); } }
    { const int* positions = (const int*)a->in[2]; float* cs = (float*)(ws + O_CS);
      for (int i = C.bid * 512 + C.tid; i < T_ * 16; i += C.G * 512) { const int t = i >> 4, f = i & 15; const float inv = powf(10000.f, -(float)(2 * f) / 32.f); const float ang = (float)positions[t] * inv;
          cs[t * 32 + f] = cosf(ang); cs[t * 32 + 16 + f] = sinf(ang); } }
    { const float* lam = (const float*)a->in[25]; float* spv = (float*)(ws + O_SPV);
      for (int i = C.bid * 512 + C.tid; i < 2048; i += C.G * 512) spv[i] = -8.f * 1.4426950408889634f * log1pf(expf(-lam[i])); }
    { const int lane = C.lane; LAS unsigned char* T = C.lds + 49152 + C.wave * 9216;
      const float* attn_w_in = (const float*)a->in[7]; const float* w_uq = (const float*)a->in[12]; const float* w_ukv = (const float*)a->in[13]; const float* attn_w_out = (const float*)a->in[16];
      const float* rec_w_in = (const float*)a->in[17]; const float* rec_wa = (const float*)a->in[21]; const float* rec_wx = (const float*)a->in[23]; const float* rec_w_out = (const float*)a->in[26];
      const float* w1 = (const float*)a->in[30]; const float* w2 = (const float*)a->in[32];
      constexpr int T_WIN = 32 * 16, T_WUQ = 12 * 4, T_WUKV = 16 * 2, T_WOUT = 16 * 16, T_RWIN = 32 * 16, T_RG = 2 * 2, T_RWOUT = 16 * 16, T_W1 = 32 * 16, T_W2 = 16 * 16;
      constexpr int NITEMS = 2 * (T_WIN + T_WUQ + T_WUKV + T_WOUT + T_RWIN + 16 * T_RG + T_RWOUT);
      struct Job { const float* W; bf16_t* WT; int N, ldd, n0, k0; };
      auto decode = [&](int r, Job& jb) {
#define CONV_JOB(SRC, KK, NN, DST, NROWS, NMAT, SRC_MS, DST_MS) { constexpr int kc_ = (KK) / 64, per_ = ((NROWS) / 64) * kc_, tot_ = per_ * (NMAT); \
          if (r < tot_) { const int mat_ = r / per_, q_ = r % per_; jb.W = (SRC) + (size_t)mat_ * (SRC_MS); jb.WT = (bf16_t*)(ws + (DST) + (size_t)mat_ * (DST_MS)); jb.N = (NN); jb.ldd = (KK); jb.n0 = (q_ / kc_) * 64; jb.k0 = (q_ % kc_) * 64; return; } r -= tot_; }
          CONV_JOB(attn_w_in, 1024, 1952, O_WIN, 2048, 2, (size_t)1024 * 1952, SZ_WIN)
          CONV_JOB(w_uq, 256, 768, O_WUQ, 768, 2, (size_t)256 * 768, SZ_WUQ)
          CONV_JOB(w_ukv, 128, 1024, O_WUKV, 1024, 2, (size_t)128 * 1024, SZ_WUKV)
          CONV_JOB(attn_w_out, 1024, 1024, O_WOUT, 1024, 2, (size_t)1024 * 1024, SZ_WOUT)
          CONV_JOB(rec_w_in, 1024, 2048, O_RWIN, 2048, 2, (size_t)1024 * 2048, SZ_RWIN)
          CONV_JOB(rec_wa, 128, 128, O_RGATE, 128, 16, (size_t)128 * 128, (size_t)256 * 128 * 2)
          CONV_JOB(rec_wx, 128, 128, O_RGATE + (size_t)128 * 128 * 2, 128, 16, (size_t)128 * 128, (size_t)256 * 128 * 2)
          CONV_JOB(rec_w_out, 1024, 1024, O_RWOUT, 1024, 2, (size_t)1024 * 1024, SZ_RWOUT)
#undef CONV_JOB
          jb.W = attn_w_in; jb.WT = (bf16_t*)(ws + O_WIN); jb.N = 1952; jb.ldd = 1024; jb.n0 = 0; jb.k0 = 0; };
      f32x4 va[16], vb[16]; Job ja, jn;
      int it = C.gw;
      if (it < NITEMS) { decode(it, ja); conv_load(va, ja.W, ja.N, ja.n0, ja.k0, lane); }
#pragma unroll 1
      for (; it < NITEMS; it += 2 * C.NGW) {
          const bool h1 = it + C.NGW < NITEMS;
          if (h1) { decode(it + C.NGW, jn); conv_load(vb, jn.W, jn.N, jn.n0, jn.k0, lane); }
          conv_emit(va, T, ja.WT, ja.ldd, ja.n0, ja.k0, lane);
          const bool h2 = it + 2 * C.NGW < NITEMS;
          if (h2) { decode(it + 2 * C.NGW, ja); conv_load(va, ja.W, ja.N, ja.n0, ja.k0, lane); }
          if (h1) conv_emit(vb, T, jn.WT, jn.ldd, jn.n0, jn.k0, lane);
      }
      { constexpr int I1 = 32 * 8, I2 = 16 * 8, N8 = 128 * I1 + 128 * I2;
#pragma unroll 1
        for (int i8 = C.gw; i8 < N8; i8 += C.NGW) {
            const float* W; unsigned char* WT; int N, q;
            if (i8 < 128 * I1) { const int mat = i8 / I1; q = i8 % I1; W = w1 + (size_t)mat * 1024 * 2048; WT = ws + O_W1 + (size_t)mat * SZ_W1E; N = 2048; }
            else { const int r = i8 - 128 * I1, mat = r / I2; q = r % I2; W = w2 + (size_t)mat * 1024 * 1024; WT = ws + O_W2 + (size_t)mat * SZ_W2E; N = 1024; }
            conv8_tile(W, N, WT, 1024, (q >> 3) * 64, (q & 7) * 128, T, lane); } }
    }
}

__device__ __forceinline__ void phase_norm(const Ctx& C, const float* xin, float* X, bool combine, bool do_norm, const float* gain, const float* modc  , const float* modl  , int shoff, int scoff) {
    const bf16_t* Y2 = (const bf16_t*)(C.ws + O_Y2); const int* pos = (const int*)(C.ws + O_POS); const float* topg = (const float*)(C.ws + O_TOPG); bf16_t* HN = (bf16_t*)(C.ws + O_HN);
    const int lane = C.lane;
    for (int t = C.gw; t < T_; t += C.NGW) { const int b = t / S_;
        f32x4 v[4];
#pragma unroll
        for (int j = 0; j < 4; ++j) v[j] = *(const f32x4*)(xin + (size_t)t * 1024 + 256 * j + 4 * lane);
        if (combine) { f32x4 y[4];
#pragma unroll
            for (int j = 0; j < 4; ++j) y[j] = (f32x4){0.f, 0.f, 0.f, 0.f};
#pragma unroll
            for (int k = 0; k < 4; ++k) { const int p = pos[t * 4 + k]; const float gk = topg[t * 4 + k];
#pragma unroll
                for (int j = 0; j < 4; ++j) { const u32x2 w = *(const u32x2*)(Y2 + (size_t)p * 1024 + 256 * j + 4 * lane);
                    y[j][0] += gk * bf_lo(w.x); y[j][1] += gk * bf_hi(w.x); y[j][2] += gk * bf_lo(w.y); y[j][3] += gk * bf_hi(w.y); } }
#pragma unroll
            for (int j = 0; j < 4; ++j) { const f32x4 g2 = *(const f32x4*)(modc + b * 6144 + 5120 + 256 * j + 4 * lane); v[j] = v[j] + g2 * y[j]; } }
        if (combine || xin != X) {
#pragma unroll
            for (int j = 0; j < 4; ++j) *(f32x4*)(X + (size_t)t * 1024 + 256 * j + 4 * lane) = v[j]; }
        if (do_norm) { float ss = 0.f;
#pragma unroll
            for (int j = 0; j < 4; ++j) ss += (v[j][0] * v[j][0] + v[j][1] * v[j][1]) + (v[j][2] * v[j][2] + v[j][3] * v[j][3]);
            const float rs = rsqrtf(wsum(ss) * (1.f / 1024.f) + 1e-6f);
#pragma unroll
            for (int j = 0; j < 4; ++j) { const int col = 256 * j + 4 * lane; const f32x4 gn = *(const f32x4*)(gain + col), sc = *(const f32x4*)(modl + b * 6144 + scoff + col), sh = *(const f32x4*)(modl + b * 6144 + shoff + col);
                const f32x4 h = v[j] * rs * gn * (1.f + sc) + sh;
                u32x2 w; w.x = cvt_pk_bf16(h[0], h[1]); w.y = cvt_pk_bf16(h[2], h[3]); *(u32x2*)(HN + (size_t)t * 1024 + col) = w; } }
    }
}

__device__ __forceinline__ void unpack8(const u32x4 w, float (&f)[8]) { f[0] = bf_lo(w.x); f[1] = bf_hi(w.x); f[2] = bf_lo(w.y); f[3] = bf_hi(w.y); f[4] = bf_lo(w.z); f[5] = bf_hi(w.z); f[6] = bf_lo(w.w); f[7] = bf_hi(w.w); }
__device__ __forceinline__ u32x4 pack8(const float (&f)[8]) { u32x4 w; w.x = cvt_pk_bf16(f[0], f[1]); w.y = cvt_pk_bf16(f[2], f[3]); w.z = cvt_pk_bf16(f[4], f[5]); w.w = cvt_pk_bf16(f[6], f[7]); return w; }

constexpr float LOG2E = 1.4426950408889634f;
__device__ __forceinline__ void phase_postproj(const Ctx& C, const float* qg, const float* kg, const float* qag, const float* kvag, const float* mkg) {
    bf16_t* PROJ = (bf16_t*)(C.ws + O_PROJ); const float* cs = (const float*)(C.ws + O_CS); const int lane = C.lane;
    for (int t = C.gw; t < T_; t += C.NGW) { bf16_t* row = PROJ + (size_t)t * 2048;
#pragma unroll
        for (int ps = 0; ps < 2; ++ps) { bf16_t* p = row + ps * 512 + 8 * lane; float f[8]; unpack8(*(const u32x4*)p, f); float ss = 0.f;
#pragma unroll
            for (int i = 0; i < 8; ++i) ss += f[i] * f[i];
            ss += shx<1>(ss); ss += shx<2>(ss); ss += shx<4>(ss);
            const float rs = rsqrtf(ss * (1.f / 64.f) + 1e-6f) * (ps == 0 ? 0.125f * LOG2E : 1.f); const float* g = (ps == 0 ? qg : kg) + 8 * (lane & 7);
#pragma unroll
            for (int i = 0; i < 8; ++i) f[i] = f[i] * rs * g[i];
            *(u32x4*)p = pack8(f); }
        { bf16_t* p = row + 1536 + 8 * lane; float f[8]; unpack8(*(const u32x4*)p, f); float ss = 0.f;
#pragma unroll
            for (int i = 0; i < 8; ++i) ss += f[i] * f[i];
            ss += shx<1>(ss); ss += shx<2>(ss);
            { const float o4 = shx<4>(ss); if (lane < 48) ss += o4; } { const float o8 = shx<8>(ss); if (lane < 48) ss += o8; } { const float o16 = shx<16>(ss); if (lane < 32) ss += o16; }
            const float nrm = lane < 32 ? 256.f : (lane < 48 ? 128.f : 32.f);
            const float rs = rsqrtf(ss / nrm + 1e-6f);
            const float* g = lane < 32 ? (qag + 8 * lane) : (lane < 48 ? (kvag + 8 * (lane - 32)) : (mkg + 64 + 8 * ((lane - 48) & 3)));
#pragma unroll
            for (int i = 0; i < 8; ++i) f[i] = f[i] * rs * g[i];
            float o[8];
#pragma unroll
            for (int i = 0; i < 8; ++i) { const float other = shx<2>(f[i]); const int fi = ((lane & 1) << 3) + i; const float cv = cs[t * 32 + fi], sv = cs[t * 32 + 16 + fi];
                o[i] = (lane & 2) ? (other * sv + f[i] * cv) : (f[i] * cv - other * sv); }
            if (lane >= 48 && lane < 52) {
#pragma unroll
                for (int i = 0; i < 8; ++i) f[i] = o[i]; }
            if (lane < 52) *(u32x4*)p = pack8(f); }
    }
}
__device__ __forceinline__ void phase_postq(const Ctx& C, const float* mqg, const float* mkg) {
    bf16_t* Q2 = (bf16_t*)(C.ws + O_Q2); bf16_t* KV2 = (bf16_t*)(C.ws + O_KV2); const float* cs = (const float*)(C.ws + O_CS); const int lane = C.lane;
    const float qscale = 0.10206207261596575f * LOG2E;
    for (int t = C.gw; t < T_; t += C.NGW) {
        { bf16_t* p = Q2 + (size_t)t * 768 + (lane >> 3) * 96 + 8 * (lane & 7); float f[8]; unpack8(*(const u32x4*)p, f); float ss = 0.f;
#pragma unroll
            for (int i = 0; i < 8; ++i) ss += f[i] * f[i];
            ss += shx<1>(ss); ss += shx<2>(ss); ss += shx<4>(ss);
            const float rs = rsqrtf(ss * (1.f / 64.f) + 1e-6f) * qscale; const float* g = mqg + 8 * (lane & 7);
#pragma unroll
            for (int i = 0; i < 8; ++i) f[i] = f[i] * rs * g[i];
            *(u32x4*)p = pack8(f); }
        { const int l2 = lane & 31; bf16_t* p = Q2 + (size_t)t * 768 + (l2 >> 2) * 96 + 64 + 8 * (l2 & 3); float f[8]; unpack8(*(const u32x4*)p, f); float ss = 0.f;
#pragma unroll
            for (int i = 0; i < 8; ++i) ss += f[i] * f[i];
            ss += shx<1>(ss); ss += shx<2>(ss);
            const float rs = rsqrtf(ss * (1.f / 32.f) + 1e-6f) * qscale; const float* g = mqg + 64 + 8 * (l2 & 3);
#pragma unroll
            for (int i = 0; i < 8; ++i) f[i] = f[i] * rs * g[i];
            float o[8];
#pragma unroll
            for (int i = 0; i < 8; ++i) { const float other = shx<2>(f[i]); const int fi = ((lane & 1) << 3) + i; const float cv = cs[t * 32 + fi], sv = cs[t * 32 + 16 + fi];
                o[i] = (lane & 2) ? (other * sv + f[i] * cv) : (f[i] * cv - other * sv); }
            if (lane < 32) *(u32x4*)p = pack8(o); }
        { bf16_t* p = KV2 + (size_t)t * 1024 + (lane >> 3) * 128 + 8 * (lane & 7); float f[8]; unpack8(*(const u32x4*)p, f); float ss = 0.f;
#pragma unroll
            for (int i = 0; i < 8; ++i) ss += f[i] * f[i];
            ss += shx<1>(ss); ss += shx<2>(ss); ss += shx<4>(ss);
            const float rs = rsqrtf(ss * (1.f / 64.f) + 1e-6f); const float* g = mkg + 8 * (lane & 7);
#pragma unroll
            for (int i = 0; i < 8; ++i) f[i] = f[i] * rs * g[i];
            *(u32x4*)p = pack8(f); }
    }
}
__device__ __forceinline__ void phase_mixcombine(const Ctx& C) {
    const bf16_t* OA = (const bf16_t*)(C.ws + O_OA); const float* LSE = (const float*)(C.ws + O_LSE); bf16_t* ATT = (bf16_t*)(C.ws + O_ATT); const int lane = C.lane;
    for (int t = C.gw; t < T_; t += C.NGW) { const int h = lane >> 3;
        float ls[3], mx = -INFINITY;
#pragma unroll
        for (int p = 0; p < 3; ++p) { ls[p] = LSE[((size_t)p * T_ + t) * 8 + h]; mx = fmaxf(mx, ls[p]); }
        float w[3], den = 0.f;
#pragma unroll
        for (int p = 0; p < 3; ++p) { w[p] = fexp2(ls[p] - mx); den += w[p]; }
        const float inv = 1.f / den; float o[8];
#pragma unroll
        for (int i = 0; i < 8; ++i) o[i] = 0.f;
#pragma unroll
        for (int p = 0; p < 3; ++p) { float f[8]; unpack8(*(const u32x4*)(OA + ((size_t)p * T_ + t) * 512 + 8 * lane), f); const float wp = w[p] * inv;
#pragma unroll
            for (int i = 0; i < 8; ++i) o[i] += wp * f[i]; }
        *(u32x4*)(ATT + (size_t)t * 1024 + 8 * lane) = pack8(o); }
}
__device__ __forceinline__ void phase_conv(const Ctx& C, const float* cw, const float* cb) {
    const bf16_t* PROJ = (const bf16_t*)(C.ws + O_PROJ); bf16_t* XC = (bf16_t*)(C.ws + O_XC); const int lane = C.lane;
    for (int t = C.gw; t < T_; t += C.NGW) { const int ts = t % S_;
#pragma unroll
        for (int ps = 0; ps < 2; ++ps) { const int c0 = ps * 512 + 8 * lane; float acc[8];
            { const f32x4 b0 = *(const f32x4*)(cb + c0), b1 = *(const f32x4*)(cb + c0 + 4); acc[0] = b0[0]; acc[1] = b0[1]; acc[2] = b0[2]; acc[3] = b0[3]; acc[4] = b1[0]; acc[5] = b1[1]; acc[6] = b1[2]; acc[7] = b1[3]; }
#pragma unroll
            for (int k = 0; k < 4; ++k) { const int dt = k - 3; if (ts + dt >= 0) { float f[8]; unpack8(*(const u32x4*)(PROJ + (size_t)(t + dt) * 2048 + 1024 + c0), f);
                    const f32x4 w0 = *(const f32x4*)(cw + k * 1024 + c0), w1 = *(const f32x4*)(cw + k * 1024 + c0 + 4);
                    acc[0] += w0[0] * f[0]; acc[1] += w0[1] * f[1]; acc[2] += w0[2] * f[2]; acc[3] += w0[3] * f[3]; acc[4] += w1[0] * f[4]; acc[5] += w1[1] * f[5]; acc[6] += w1[2] * f[6]; acc[7] += w1[3] * f[7]; } }
            *(u32x4*)(XC + (size_t)t * 1024 + c0) = pack8(acc); } }
}
__device__ __forceinline__ void phase_scan_sum(const Ctx& C) {
    const float* Aa = (const float*)(C.ws + O_AA); const float* Bb = (const float*)(C.ws + O_BB); float* SP = (float*)(C.ws + O_SUMP); float* SH = (float*)(C.ws + O_SUMH); const int lane = C.lane;
    for (int it = C.gw; it < 4 * 64 * 8; it += C.NGW) { const int cg = it & 7, ck = (it >> 3) & 63, b = it >> 9; const int ch = cg * 128 + 2 * lane;
        size_t off = ((size_t)b * S_ + ck * 64) * 1024 + ch; f32x2 Pp = (f32x2){1.f, 1.f}, Hh = (f32x2){0.f, 0.f};
#pragma unroll 8
        for (int s = 0; s < 64; ++s, off += 1024) { const f32x2 av = *(const f32x2*)(Aa + off), bv = *(const f32x2*)(Bb + off); Hh = av * Hh + bv; Pp = Pp * av; }
        *(f32x2*)(SP + ((size_t)b * 64 + ck) * 1024 + ch) = Pp; *(f32x2*)(SH + ((size_t)b * 64 + ck) * 1024 + ch) = Hh; }
}
__device__ __forceinline__ void phase_scan_apply(const Ctx& C) {
    const float* Aa = (const float*)(C.ws + O_AA); const float* Bb = (const float*)(C.ws + O_BB); const float* SP = (const float*)(C.ws + O_SUMP); const float* SH = (const float*)(C.ws + O_SUMH);
    const bf16_t* PROJ = (const bf16_t*)(C.ws + O_PROJ); bf16_t* ATT = (bf16_t*)(C.ws + O_ATT); const int lane = C.lane;
    for (int it = C.gw; it < 4 * 64 * 8; it += C.NGW) { const int cg = it & 7, ck = (it >> 3) & 63, b = it >> 9; const int ch = cg * 128 + 2 * lane;
        f32x2 h = (f32x2){0.f, 0.f};
        for (int c2 = 0; c2 < ck; ++c2) { const f32x2 pv = *(const f32x2*)(SP + ((size_t)b * 64 + c2) * 1024 + ch), hv = *(const f32x2*)(SH + ((size_t)b * 64 + c2) * 1024 + ch); h = pv * h + hv; }
        size_t row = (size_t)b * S_ + ck * 64;
#pragma unroll 8
        for (int s = 0; s < 64; ++s, ++row) { const f32x2 av = *(const f32x2*)(Aa + row * 1024 + ch), bv = *(const f32x2*)(Bb + row * 1024 + ch); h = av * h + bv;
            const unsigned gw2 = *(const unsigned*)(PROJ + row * 2048 + ch);
            *(unsigned*)(ATT + row * 1024 + ch) = cvt_pk_bf16(bf_lo(gw2) * h[0], bf_hi(gw2) * h[1]); } }
}

__device__ __forceinline__ void phase_router(const Ctx& C, const float* X, const float* gain, const float* modl, const float* wr, const float* br) {
    unsigned char* HN8 = C.ws + O_HN; int* topi = (int*)(C.ws + O_TOPI); float* topg = (float*)(C.ws + O_TOPG); int* hist = (int*)(C.ws + O_HIST);
    LAS float* hrow = (LAS float*)C.lds;
    LAS float* part = (LAS float*)(C.lds + 65536);
    LAS int* hl = (LAS int*)(C.lds + LX_MISC);
    const int lane = C.lane, e = lane & 31, kh = lane >> 5, v = C.wave;
    float wreg[64];
#pragma unroll
    for (int i = 0; i < 64; ++i) wreg[i] = wr[(128 * v + 64 * kh + i) * 32 + e];
    const float bias_e = br[e];
    if (C.tid < 32) hl[C.tid] = 0;
    __syncthreads();
    for (int ck = C.bid; ck < 256; ck += C.G) {
#pragma unroll 1
        for (int pass = 0; pass < 4; ++pass) { const int tb = ck * 64 + pass * 16;
#pragma unroll
            for (int q = 0; q < 2; ++q) { const int tt = 2 * v + q, t = tb + tt, b = t / S_; f32x4 h[4]; float ss = 0.f;
#pragma unroll
                for (int j = 0; j < 4; ++j) { h[j] = *(const f32x4*)(X + (size_t)t * 1024 + 256 * j + 4 * lane); ss += (h[j][0] * h[j][0] + h[j][1] * h[j][1]) + (h[j][2] * h[j][2] + h[j][3] * h[j][3]); }
                const float rs = rsqrtf(wsum(ss) * (1.f / 1024.f) + 1e-6f);
#pragma unroll
                for (int j = 0; j < 4; ++j) { const int col = 256 * j + 4 * lane; const f32x4 gn = *(const f32x4*)(gain + col), sc = *(const f32x4*)(modl + b * 6144 + 4096 + col), sh = *(const f32x4*)(modl + b * 6144 + 3072 + col);
                    const f32x4 hv = h[j] * rs * gn * (1.f + sc) + sh;
                    *(unsigned*)(HN8 + (size_t)t * 1024 + col) = pk4_fp8(hv[0], hv[1], hv[2], hv[3]);
                    *(LAS f32x4*)(hrow + tt * 1024 + col) = hv; } }
            __syncthreads();
#pragma unroll 2
            for (int tt = 0; tt < 16; ++tt) { float s0 = 0.f, s1 = 0.f; const LAS float* hp = hrow + tt * 1024 + 128 * v + 64 * kh;
#pragma unroll
                for (int i4 = 0; i4 < 16; ++i4) { const f32x4 hv = *(const LAS f32x4*)(hp + 4 * i4); s0 += hv[0] * wreg[4 * i4] + hv[1] * wreg[4 * i4 + 1]; s1 += hv[2] * wreg[4 * i4 + 2] + hv[3] * wreg[4 * i4 + 3]; }
                float s = xadd32(s0 + s1);
                if (lane < 32) part[(tt * 8 + v) * 32 + e] = s; }
            __syncthreads();
            { const int tt = 2 * v + kh; float lg = bias_e;
#pragma unroll
              for (int w8 = 0; w8 < 8; ++w8) lg += part[(tt * 8 + w8) * 32 + e];
              int idx[4]; float val[4];
#pragma unroll
              for (int k = 0; k < 4; ++k) { float mx = lg;
                  mx = fmaxf(mx, shx<1>(mx)); mx = fmaxf(mx, shx<2>(mx)); mx = fmaxf(mx, shx<4>(mx)); mx = fmaxf(mx, shx<8>(mx)); mx = fmaxf(mx, shx<16>(mx));
                  const unsigned long long bal = __ballot(lg == mx); const unsigned bh = (unsigned)(bal >> (32 * kh)); const int sel = __ffs((int)bh) - 1;
                  idx[k] = sel; val[k] = mx; if (e == sel) lg = -INFINITY; }
              if (e == 0) { const int t = tb + tt; float ex[4], den = 0.f;
#pragma unroll
                  for (int k = 0; k < 4; ++k) { ex[k] = expf(val[k] - val[0]); den += ex[k]; }
#pragma unroll
                  for (int k = 0; k < 4; ++k) { topi[t * 4 + k] = idx[k]; topg[t * 4 + k] = ex[k] / den; __hip_atomic_fetch_add(hl + idx[k], 1, __ATOMIC_RELAXED, __HIP_MEMORY_SCOPE_WORKGROUP); } } }
        }
        __syncthreads();
        if (C.tid < 32) { hist[ck * 32 + C.tid] = hl[C.tid]; hl[C.tid] = 0; }
        __syncthreads();
    }
}
__device__ __forceinline__ void moe_plan_lds(const Ctx& C) {
    const int* hist = (const int*)(C.ws + O_HIST);
    LAS int* tot = (LAS int*)(C.lds + LX_MISC + 256); LAS int* pst = tot + 32; LAS int* tile_e = (LAS int*)(C.lds + LX_TILE); LAS int* ntp = (LAS int*)(C.lds + LX_MISC + 128); LAS int* part = (LAS int*)(C.lds + LX_MISC + 1024);
    __syncthreads();
    { const int e = C.tid & 31, g = C.tid >> 5; int sacc = 0;
#pragma unroll
      for (int i = 0; i < 16; ++i) sacc += hist[(g * 16 + i) * 32 + e];
      part[g * 32 + e] = sacc; }
    __syncthreads();
    if (C.tid < 32) { int sacc = 0;
#pragma unroll
        for (int g = 0; g < 16; ++g) sacc += part[g * 32 + C.tid];
        tot[C.tid] = sacc; }
    __syncthreads();
    if (C.tid == 0) { int acc = 0, ti = 0; for (int e = 0; e < 32; ++e) { pst[e] = acc; const int nt = (tot[e] + 255) >> 8; for (int i = 0; i < nt; ++i) tile_e[ti++] = e; acc += nt << 8; } ntp[0] = ti; }
    __syncthreads();
}
__device__ __forceinline__ void phase_scatter(const Ctx& C) {
    const int* hist = (const int*)(C.ws + O_HIST); const int* topi = (const int*)(C.ws + O_TOPI); int* pos = (int*)(C.ws + O_POS);
    const unsigned char* HN8 = C.ws + O_HN; unsigned char* XG8 = C.ws + O_XG;
    moe_plan_lds(C);
    LAS int* pst = (LAS int*)(C.lds + LX_MISC + 384); LAS int* base = (LAS int*)(C.lds + LX_MISC + 512); LAS int* part = (LAS int*)(C.lds + LX_MISC + 1024); LAS int* pl = (LAS int*)C.lds;
    for (int ck = C.bid; ck < 256; ck += C.G) {
        if (C.tid < 32) { int sacc = pst[C.tid]; const int g = ck >> 4; for (int g2 = 0; g2 < g; ++g2) sacc += part[g2 * 32 + C.tid]; for (int c2 = g * 16; c2 < ck; ++c2) sacc += hist[c2 * 32 + C.tid]; base[C.tid] = sacc; }
        __syncthreads();
        if (C.wave == 0) { int cnt[32];
#pragma unroll
            for (int e = 0; e < 32; ++e) cnt[e] = 0;
#pragma unroll 1
            for (int g = 0; g < 4; ++g) { const int my = topi[ck * 256 + g * 64 + C.lane]; int rank = 0;
#pragma unroll
                for (int e = 0; e < 32; ++e) { const unsigned long long m = __ballot(my == e);
                    const int below = (int)__builtin_amdgcn_mbcnt_hi((unsigned)(m >> 32), __builtin_amdgcn_mbcnt_lo((unsigned)m, 0u));
                    if (my == e) rank = cnt[e] + below; cnt[e] += __popcll(m); }
                const int p = base[my] + rank; pl[g * 64 + C.lane] = p; pos[ck * 256 + g * 64 + C.lane] = p; } }
        __syncthreads();
        for (int pr = C.wave; pr < 256; pr += 8) { const int t = ck * 64 + (pr >> 2); const int p = pl[pr];
            *(u32x4*)(XG8 + (size_t)p * 1024 + 16 * C.lane) = *(const u32x4*)(HN8 + (size_t)t * 1024 + 16 * C.lane); }
        __syncthreads();
    }
}

__device__ __forceinline__ s16x4 tr16(LAS const unsigned char* p) { typedef short v4i16_t __attribute__((ext_vector_type(4))); return __builtin_bit_cast(s16x4, __builtin_amdgcn_ds_read_tr16_b64_v4i16((LAS v4i16_t*)p)); }

template <int KS, bool DIL>
__device__ __forceinline__ void att_tile(LAS const unsigned char* kb, LAS const unsigned char* vb, const bf16x8 (&qf)[KS], f32x16& o0, f32x16& o1, float& m, float& l, int kidx0, int qidx, int lane) {
    constexpr int KROW = KS * 32 + 16, VROW = 144;
    const int i32 = lane & 31, hi = lane >> 5;
    const int pr = (i32 & 0x13) | ((i32 & 4) << 1) | ((i32 & 8) >> 1);
    f32x16 p0, p1;
#pragma unroll
    for (int r = 0; r < 16; ++r) { p0[r] = 0.f; p1[r] = 0.f; }
    LAS const unsigned char* kp = kb + pr * KROW + hi * 16;
#pragma unroll
    for (int ks = 0; ks < KS; ++ks) {
        const bf16x8 k0f = *(LAS const bf16x8*)(kp + ks * 32), k1f = *(LAS const bf16x8*)(kp + 32 * KROW + ks * 32);
        p0 = __builtin_amdgcn_mfma_f32_32x32x16_bf16(k0f, qf[ks], p0, 0, 0, 0);
        p1 = __builtin_amdgcn_mfma_f32_32x32x16_bf16(k1f, qf[ks], p1, 0, 0, 0);
    }
    float mx = -INFINITY;
#pragma unroll
    for (int r = 0; r < 16; ++r) { const int d0 = qidx - (kidx0 + 16 * (r >> 3) + 8 * hi + (r & 7)), d1 = d0 - 32;
        const bool v0 = DIL ? (d0 >= 0 && d0 <= 128) : (d0 >= 0), v1 = DIL ? (d1 >= 0 && d1 <= 128) : (d1 >= 0);
        p0[r] = v0 ? p0[r] : -INFINITY; p1[r] = v1 ? p1[r] : -INFINITY; mx = fmaxf(mx, fmaxf(p0[r], p1[r])); }
    mx = xmax32(mx);
    const float mn = fmaxf(m, mx), mu = (mn == -INFINITY) ? 0.f : mn;
    const float alpha = fexp2(m - mu);
    float ls = 0.f;
#pragma unroll
    for (int r = 0; r < 16; ++r) { p0[r] = fexp2(p0[r] - mu); p1[r] = fexp2(p1[r] - mu); ls += p0[r] + p1[r]; }
    l = l * alpha + ls; m = mn;
#pragma unroll
    for (int r = 0; r < 16; ++r) { o0[r] *= alpha; o1[r] *= alpha; }
    u32x4 pw[2][2];
#pragma unroll
    for (int s = 0; s < 2; ++s) {
        pw[0][s].x = cvt_pk_bf16(p0[8 * s + 0], p0[8 * s + 1]); pw[0][s].y = cvt_pk_bf16(p0[8 * s + 2], p0[8 * s + 3]); pw[0][s].z = cvt_pk_bf16(p0[8 * s + 4], p0[8 * s + 5]); pw[0][s].w = cvt_pk_bf16(p0[8 * s + 6], p0[8 * s + 7]);
        pw[1][s].x = cvt_pk_bf16(p1[8 * s + 0], p1[8 * s + 1]); pw[1][s].y = cvt_pk_bf16(p1[8 * s + 2], p1[8 * s + 3]); pw[1][s].z = cvt_pk_bf16(p1[8 * s + 4], p1[8 * s + 5]); pw[1][s].w = cvt_pk_bf16(p1[8 * s + 6], p1[8 * s + 7]); }
    const int g = lane >> 4, i16 = lane & 15;
    LAS const unsigned char* vp = vb + (8 * (g >> 1) + (i16 >> 2)) * VROW + (16 * (g & 1) + 4 * (i16 & 3)) * 2;
#pragma unroll
    for (int sub = 0; sub < 2; ++sub)
#pragma unroll
        for (int s = 0; s < 2; ++s) { const bf16x8 pf = __builtin_bit_cast(bf16x8, pw[sub][s]);
#pragma unroll
            for (int db = 0; db < 2; ++db) { LAS const unsigned char* a = vp + (32 * sub + 16 * s) * VROW + 64 * db;
                const s16x4 lo = tr16(a), hh = tr16(a + 4 * VROW);
                const bf16x8 vf = (bf16x8){lo[0], lo[1], lo[2], lo[3], hh[0], hh[1], hh[2], hh[3]};
                if (db == 0) o0 = __builtin_amdgcn_mfma_f32_32x32x16_bf16(vf, pf, o0, 0, 0, 0); else o1 = __builtin_amdgcn_mfma_f32_32x32x16_bf16(vf, pf, o1, 0, 0, 0); } }
}
__device__ __forceinline__ void att_store(bf16_t* orow  , const f32x16& o0, const f32x16& o1, float inv, int hi) {
#pragma unroll
    for (int rr = 0; rr < 4; ++rr) { u32x2 w0, w1;
        w0.x = cvt_pk_bf16(o0[4 * rr] * inv, o0[4 * rr + 1] * inv); w0.y = cvt_pk_bf16(o0[4 * rr + 2] * inv, o0[4 * rr + 3] * inv);
        w1.x = cvt_pk_bf16(o1[4 * rr] * inv, o1[4 * rr + 1] * inv); w1.y = cvt_pk_bf16(o1[4 * rr + 2] * inv, o1[4 * rr + 3] * inv);
        *(u32x2*)(orow + 8 * rr + 4 * hi) = w0; *(u32x2*)(orow + 32 + 8 * rr + 4 * hi) = w1; }
}

__device__ __forceinline__ void mla_unit(const Ctx& C, int b, int h, int qb) {
    constexpr int KROW = 208, VROW = 144, KB = 64 * KROW, BUF = KB + 64 * VROW;
    const bf16_t* Q2 = (const bf16_t*)(C.ws + O_Q2); const bf16_t* KV2 = (const bf16_t*)(C.ws + O_KV2); const bf16_t* PROJ = (const bf16_t*)(C.ws + O_PROJ); bf16_t* ATT = (bf16_t*)(C.ws + O_ATT);
    const int tid = C.tid, lane = C.lane, w = C.wave, i32 = lane & 31, hi = lane >> 5;
    const int q0 = qb * 256; const size_t rowb = (size_t)b * S_;
    bf16x8 qf[6];
    { const bf16_t* qrow = Q2 + (rowb + q0 + 32 * w + i32) * 768 + h * 96 + 8 * hi;
#pragma unroll
      for (int ks = 0; ks < 6; ++ks) qf[ks] = *(const bf16x8*)(qrow + 16 * ks); }
    f32x16 o0, o1;
#pragma unroll
    for (int r = 0; r < 16; ++r) { o0[r] = 0.f; o1[r] = 0.f; }
    float m = -INFINITY, l = 0.f;
    const int NT = 4 * qb + 4, wmax = 4 * qb + (w >> 1);
    const int r8 = tid >> 3, c8 = tid & 7, r4 = (tid & 255) >> 2, c4 = tid & 3;
    const bf16_t* knp = KV2 + (rowb + r8) * 1024 + h * 128 + 8 * c8; const bf16_t* kpp = PROJ + (rowb + r4) * 2048 + 1920 + 8 * c4;
    u32x4 rk, rv, rp;
#define MLA_LOAD(j) do { rk = *(const u32x4*)(knp + (size_t)(j) * 64 * 1024); rv = *(const u32x4*)(knp + (size_t)(j) * 64 * 1024 + 64); if (tid < 256) rp = *(const u32x4*)(kpp + (size_t)(j) * 64 * 2048); } while (0)
#define MLA_WRITE(bo) do { *(LAS u32x4*)(C.lds + (bo) + r8 * KROW + 16 * c8) = rk; *(LAS u32x4*)(C.lds + (bo) + KB + r8 * VROW + 16 * c8) = rv; if (tid < 256) *(LAS u32x4*)(C.lds + (bo) + r4 * KROW + 128 + 16 * c4) = rp; } while (0)
    MLA_LOAD(0); MLA_WRITE(0);
    __syncthreads();
    for (int j = 0; j < NT; ++j) { const int bo = (j & 1) * BUF;
        if (j + 1 < NT) MLA_LOAD(j + 1);
        if (j <= wmax) att_tile<6, false>(C.lds + bo, C.lds + bo + KB, qf, o0, o1, m, l, 64 * j, q0 + 32 * w + i32, lane);
        if (j + 1 < NT) MLA_WRITE(BUF - bo);
        __syncthreads(); }
#undef MLA_LOAD
#undef MLA_WRITE
    l = xadd32(l);
    att_store(ATT + (rowb + q0 + 32 * w + i32) * 1024 + 512 + h * 64, o0, o1, 1.f / l, hi);
}
__device__ __forceinline__ void dil_unit(const Ctx& C, int p, int dd, int b, int h, int res, int n) {
    constexpr int KROW = 144, VROW = 144, KB = 64 * KROW, BUF = KB + 64 * VROW;
    const bf16_t* PROJ = (const bf16_t*)(C.ws + O_PROJ); bf16_t* OA = (bf16_t*)(C.ws + O_OA) + (size_t)p * T_ * 512; float* LSE = (float*)(C.ws + O_LSE) + (size_t)p * T_ * 8;
    const int tid = C.tid, lane = C.lane, w = C.wave, i32 = lane & 31, hi = lane >> 5;
    const size_t rowb = (size_t)b * S_;
    const int qsub = 256 * n + 32 * w + i32; const size_t qtok = rowb + (size_t)qsub * dd + res;
    bf16x8 qf[4];
    { const bf16_t* qrow = PROJ + qtok * 2048 + h * 64 + 8 * hi;
#pragma unroll
      for (int ks = 0; ks < 4; ++ks) qf[ks] = *(const bf16x8*)(qrow + 16 * ks); }
    f32x16 o0, o1;
#pragma unroll
    for (int r = 0; r < 16; ++r) { o0[r] = 0.f; o1[r] = 0.f; }
    float m = -INFINITY, l = 0.f;
    const int jbeg = (n == 0) ? 2 : 0, wlo = w >> 1, whi = (32 * w + 159) >> 6;
    const int r8 = tid >> 3, c8 = tid & 7;
    u32x4 rk, rv;
#define DIL_LOAD(j) do { const size_t tok = rowb + (size_t)(256 * n - 128 + 64 * (j) + r8) * dd + res; const bf16_t* src = PROJ + tok * 2048 + 512 + h * 64 + 8 * c8; rk = *(const u32x4*)src; rv = *(const u32x4*)(src + 512); } while (0)
#define DIL_WRITE(bo) do { *(LAS u32x4*)(C.lds + (bo) + r8 * KROW + 16 * c8) = rk; *(LAS u32x4*)(C.lds + (bo) + KB + r8 * VROW + 16 * c8) = rv; } while (0)
    DIL_LOAD(jbeg); DIL_WRITE(0);
    __syncthreads();
    for (int j = jbeg; j < 6; ++j) { const int bo = ((j - jbeg) & 1) * BUF;
        if (j + 1 < 6) DIL_LOAD(j + 1);
        if (j >= wlo && j <= whi) att_tile<4, true>(C.lds + bo, C.lds + bo + KB, qf, o0, o1, m, l, 256 * n - 128 + 64 * j, qsub, lane);
        if (j + 1 < 6) DIL_WRITE(BUF - bo);
        __syncthreads(); }
#undef DIL_LOAD
#undef DIL_WRITE
    l = xadd32(l);
    att_store(OA + qtok * 512 + h * 64, o0, o1, 1.f / l, hi);
    if (hi == 0) LSE[qtok * 8 + h] = m + log2f(l);
}
__device__ __forceinline__ void phase_attention(const Ctx& C) {
    if (C.G == 256) { const int bh = C.vcu >> 3, s = C.vcu & 7; mla_unit(C, bh >> 3, bh & 7, s); mla_unit(C, bh >> 3, bh & 7, 15 - s); }
    else for (int u = C.bid; u < 512; u += C.G) mla_unit(C, u >> 7, (u >> 4) & 7, u & 15);
    for (int u = C.bid; u < 1536; u += C.G) { const int p = u >> 9, rem = u & 511, b = rem >> 7, h = (rem >> 4) & 7, blk = rem & 15;
        const int dd = (p == 0) ? 1 : (p == 1) ? 4 : 16, bpr = 16 / dd;
        dil_unit(C, p, dd, b, h, blk / bpr, blk % bpr); }
}

constexpr int N_PHASES = 48;
extern __shared__ __attribute__((aligned(16))) unsigned char lds_raw[];
typedef const __attribute__((address_space(4))) Args* ArgsP;
#define PHFN static __device__ __forceinline__ void
__device__ __forceinline__ ArgsP fresh_args() { unsigned long long p = (unsigned long long)__builtin_amdgcn_kernarg_segment_ptr(); asm volatile("" : "+s"(p)); return (ArgsP)p; }
__device__ __forceinline__ Ctx make_ctx(ArgsP ap, int wv) {
    Ctx C; C.lds = (LAS unsigned char*)lds_raw; C.ws = ap->ws;
    unsigned ones = ~0u; asm volatile("" : "+s"(ones)); const int lane = (int)__builtin_amdgcn_mbcnt_hi(ones, __builtin_amdgcn_mbcnt_lo(ones, 0u));
    int bid = blockIdx.x; asm volatile("" : "+s"(bid)); int G = gridDim.x; asm volatile("" : "+s"(G));
    C.wave = wv; C.lane = lane; C.tid = wv * 64 + lane;
    C.G = G; C.bid = bid; C.vcu = (C.G % 8 == 0) ? (C.bid % 8) * (C.G / 8) + C.bid / 8 : C.bid;
    C.gw = C.bid * 8 + C.wave; C.NGW = C.G * 8; return C;
}
#define IN(i) ((const float*)ap->in[i])
#define MODL(l) ((const float*)(C.ws + O_MOD) + (size_t)(l) * 4 * 6144)
PHFN ph_prologue(int wv) { const ArgsP ap = fresh_args(); const Ctx C = make_ctx(ap, wv); p0_prologue(C, ap); }
PHFN ph_norm(int wv, int l, int mode) { const ArgsP ap = fresh_args(); const Ctx C = make_ctx(ap, wv);
    if (mode == 0) phase_norm(C, IN(0), ap->out, false, true, IN(5), MODL(0), MODL(0), 0, 1024);
    else if (mode == 1) phase_norm(C, ap->out, ap->out, true, true, IN(5) + l * 1024, MODL(l - 1), MODL(l), 0, 1024);
    else phase_norm(C, ap->out, ap->out, true, false, IN(5), MODL(3), MODL(3), 0, 1024); }
PHFN ph_proj(int wv, int j) { const ArgsP ap = fresh_args(); const Ctx C = make_ctx(ap, wv); unsigned char* ws = C.ws;
    DenseOrder S; S.init(ws + O_HN, ws + O_WIN + j * SZ_WIN, 1024, 1024, T_, 2048, C.G, C.bid); EpiBf16 E{(bf16_t*)(ws + O_PROJ), nullptr, 2048, 0, 1.f}; gemm_phase(C, GemmDims{1024, 1024, 1024}, S, E); }
PHFN ph_postproj(int wv, int j) { const ArgsP ap = fresh_args(); const Ctx C = make_ctx(ap, wv); phase_postproj(C, IN(8) + j * 64, IN(9) + j * 64, IN(10) + j * 256, IN(11) + j * 128, IN(15) + j * 96); }
PHFN ph_qkv(int wv, int j) { const ArgsP ap = fresh_args(); const Ctx C = make_ctx(ap, wv); unsigned char* ws = C.ws;
    { DenseOrder S; S.init(ws + O_PROJ + 1536 * 2, ws + O_WUQ + j * SZ_WUQ, 2048, 256, T_, 768, C.G, C.bid); EpiBf16 E{(bf16_t*)(ws + O_Q2), nullptr, 768, 0, 1.f}; gemm_phase(C, GemmDims{256, 2048, 256}, S, E); }
    { const ArgsP ap2 = fresh_args(); const Ctx C = make_ctx(ap2, wv); unsigned char* ws = C.ws; DenseOrder S; S.init(ws + O_PROJ + 1792 * 2, ws + O_WUKV + j * SZ_WUKV, 2048, 128, T_, 1024, C.G, C.bid); EpiBf16 E{(bf16_t*)(ws + O_KV2), nullptr, 1024, 0, 1.f}; gemm_phase(C, GemmDims{128, 2048, 128}, S, E); } }
PHFN ph_postq(int wv, int j) { const ArgsP ap = fresh_args(); const Ctx C = make_ctx(ap, wv); phase_postq(C, IN(14) + j * 96, IN(15) + j * 96); }
PHFN ph_attention(int wv) { const ArgsP ap = fresh_args(); const Ctx C = make_ctx(ap, wv); phase_attention(C); }
PHFN ph_mixcombine(int wv) { const ArgsP ap = fresh_args(); const Ctx C = make_ctx(ap, wv); phase_mixcombine(C); }
PHFN ph_outproj(int wv, int l, int which) { const ArgsP ap = fresh_args(); const Ctx C = make_ctx(ap, wv); unsigned char* ws = C.ws; const int j = l >> 1;
    DenseOrder S; S.init(ws + O_ATT, ws + (which ? O_RWOUT + j * SZ_RWOUT : O_WOUT + j * SZ_WOUT), 1024, 1024, T_, 1024, C.G, C.bid);
    EpiResid E{ap->out, MODL(l) + 2048, which ? IN(27) + j * 1024 : nullptr}; gemm_phase(C, GemmDims{1024, 1024, 1024}, S, E); }
PHFN ph_router(int wv, int l) { const ArgsP ap = fresh_args(); const Ctx C = make_ctx(ap, wv); phase_router(C, ap->out, IN(6) + l * 1024, MODL(l), IN(28) + (size_t)l * 1024 * 32, IN(29) + l * 32); }
PHFN ph_scatter(int wv) { const ArgsP ap = fresh_args(); const Ctx C = make_ctx(ap, wv); phase_scatter(C); }
PHFN ph_moe1(int wv, int l) { const ArgsP ap = fresh_args(); const Ctx C = make_ctx(ap, wv); unsigned char* ws = C.ws; moe_plan_lds(C);
    MoeOrder S; S.A = (const char*)(ws + O_XG); S.WT = (const char*)(ws + O_W1 + (size_t)l * 32 * SZ_W1E); S.estride = SZ_W1E; S.tile_e = (const LAS int*)(C.lds + LX_TILE);
    S.NT = *(const LAS int*)(C.lds + LX_MISC + 128); S.nN = 8; S.G = C.G; S.c = C.bid; S.esz = 1;
    EpiSwiglu E{(unsigned char*)(ws + O_ACT), IN(31) + (size_t)l * 32 * 2048, 1.f / 32.f}; gemm_phase<true>(C, GemmDims{1024, 1024, 1024}, S, E); }
PHFN ph_moe2(int wv, int l) { const ArgsP ap = fresh_args(); const Ctx C = make_ctx(ap, wv); unsigned char* ws = C.ws; moe_plan_lds(C);
    MoeOrder S; S.A = (const char*)(ws + O_ACT); S.WT = (const char*)(ws + O_W2 + (size_t)l * 32 * SZ_W2E); S.estride = SZ_W2E; S.tile_e = (const LAS int*)(C.lds + LX_TILE);
    S.NT = *(const LAS int*)(C.lds + LX_MISC + 128); S.nN = 4; S.G = C.G; S.c = C.bid; S.esz = 1;
    EpiBf16 E{(bf16_t*)(ws + O_Y2), IN(33) + (size_t)l * 32 * 1024, 1024, 1024, 1.f / 32.f}; gemm_phase<true>(C, GemmDims{1024, 1024, 1024}, S, E); }
PHFN ph_recin(int wv, int j) { const ArgsP ap = fresh_args(); const Ctx C = make_ctx(ap, wv); unsigned char* ws = C.ws;
    DenseOrder S; S.init(ws + O_HN, ws + O_RWIN + j * SZ_RWIN, 1024, 1024, T_, 2048, C.G, C.bid); EpiRecIn E{(bf16_t*)(ws + O_PROJ), IN(18) + j * 2048}; gemm_phase(C, GemmDims{1024, 1024, 1024}, S, E); }
PHFN ph_conv(int wv, int j) { const ArgsP ap = fresh_args(); const Ctx C = make_ctx(ap, wv); phase_conv(C, IN(19) + j * 4096, IN(20) + j * 1024); }
PHFN ph_lru(int wv, int j) { const ArgsP ap = fresh_args(); const Ctx C = make_ctx(ap, wv); unsigned char* ws = C.ws;
    LruOrder S; S.XC = (const char*)(ws + O_XC); S.RG = (const char*)(ws + O_RGATE + j * SZ_RGATE); S.G = C.G; S.c = C.bid;
    EpiLru E{(const bf16_t*)(ws + O_XC), IN(22) + j * 1024, IN(24) + j * 1024, (const float*)(ws + O_SPV) + j * 1024, (float*)(ws + O_AA), (float*)(ws + O_BB)};
    gemm_phase(C, GemmDims{128, 1024, 128}, S, E); }
PHFN ph_scan_sum(int wv) { const ArgsP ap = fresh_args(); const Ctx C = make_ctx(ap, wv); phase_scan_sum(C); }
PHFN ph_scan_apply(int wv) { const ArgsP ap = fresh_args(); const Ctx C = make_ctx(ap, wv); phase_scan_apply(C); }

#if MODE == 1
__device__ __forceinline__ int fresh_tid(int wv) { unsigned ones = ~0u; asm volatile("" : "+s"(ones)); return wv * 64 + (int)__builtin_amdgcn_mbcnt_hi(ones, __builtin_amdgcn_mbcnt_lo(ones, 0u)); }
__device__ __forceinline__ void grid_barrier(int wv) { const ArgsP q = fresh_args(); XcdBarrier b; b.bar = (unsigned*)(q->ws + O_CTL) + CW_BAR; b.x = xb_xcc_id(); b.st = (volatile LAS unsigned*)((LAS unsigned char*)lds_raw + LDSX_OFF); xcd_barrier(b, fresh_tid(wv)); }
__global__ void __launch_bounds__(512, 2) mk_fwd(Args a) {
    int wv = __builtin_amdgcn_readfirstlane(threadIdx.x >> 6); asm volatile("" : "+s"(wv));
    { LAS unsigned char* lds = (LAS unsigned char*)lds_raw;
      for (int u = threadIdx.x; u < (LDS_BYTES - LDSX_OFF) / 4; u += 512) ((LAS unsigned*)(lds + LDSX_OFF))[u] = 0u;
      __syncthreads();
      if (a.ph_hi - a.ph_lo > 1) (void)xcd_barrier_post((unsigned*)(a.ws + O_CTL) + CW_BAR, (volatile LAS unsigned*)(lds + LDSX_OFF), (int)threadIdx.x); }
    int pid = 0;
#define PHASE(call) { const ArgsP q_ = fresh_args(); const int lo_ = q_->ph_lo, hi_ = q_->ph_hi; if (pid >= lo_ && pid < hi_) { call; if (pid + 1 < hi_) grid_barrier(wv); } ++pid; }
#define PHASE_R(call, REP) { const ArgsP q_ = fresh_args(); const int lo_ = q_->ph_lo, hi_ = q_->ph_hi; if (pid >= lo_ && pid < hi_) { if ((REP) > 1) { call; grid_barrier(wv); } call; if (pid + 1 < hi_) grid_barrier(wv); } ++pid; }
#ifndef REP_PROLOGUE
#define REP_PROLOGUE 1
#endif
#ifndef REP_MOE
#define REP_MOE 1
#endif
#ifndef REP_ATTN
#define REP_ATTN 1
#endif
#ifndef REP_GEMMS
#define REP_GEMMS 1
#endif
#ifndef REP_ELEM
#define REP_ELEM 1
#endif
#define MOE_PHASES(l) PHASE_R(ph_router(wv, l), REP_ELEM) PHASE_R(ph_scatter(wv), REP_ELEM) PHASE_R(ph_moe1(wv, l), REP_MOE) PHASE_R(ph_moe2(wv, l), REP_MOE)
    PHASE_R(ph_prologue(wv), REP_PROLOGUE)
#define LAYER_PAIR(lp) \
        { const int l = 2 * (lp);         \
          PHASE(ph_norm(wv, l, (lp) == 0 ? 0 : 1)) PHASE_R(ph_proj(wv, lp), REP_GEMMS) PHASE(ph_postproj(wv, lp)) PHASE_R(ph_qkv(wv, lp), REP_GEMMS) PHASE(ph_postq(wv, lp)) PHASE_R(ph_attention(wv), REP_ATTN) PHASE_R(ph_mixcombine(wv), REP_ELEM) PHASE(ph_outproj(wv, l, 0)) \
          MOE_PHASES(l) } \
        { const int l = 2 * (lp) + 1;     \
          PHASE(ph_norm(wv, l, 1)) PHASE_R(ph_recin(wv, lp), REP_GEMMS) PHASE_R(ph_conv(wv, lp), REP_ELEM) PHASE_R(ph_lru(wv, lp), REP_GEMMS) PHASE_R(ph_scan_sum(wv), REP_ELEM) PHASE_R(ph_scan_apply(wv), REP_ELEM) PHASE(ph_outproj(wv, l, 1)) \
          MOE_PHASES(l) }
    LAYER_PAIR(0)
    LAYER_PAIR(1)
#undef LAYER_PAIR
    PHASE(ph_norm(wv, 3, 2))
#undef PHASE
#undef PHASE_R
#undef MOE_PHASES
}
#else
template <int PH> __global__ void __launch_bounds__(512, 2) k_phase(Args a, int l, int x) {
    int wv = __builtin_amdgcn_readfirstlane(threadIdx.x >> 6); asm volatile("" : "+s"(wv));
    LAS unsigned char* lds = (LAS unsigned char*)lds_raw;
    for (int u = threadIdx.x; u < (LDS_BYTES - LDSX_OFF) / 4; u += 512) ((LAS unsigned*)(lds + LDSX_OFF))[u] = 0u;
    __syncthreads();
    if constexpr (PH == 0) ph_prologue(wv);
    if constexpr (PH == 1) ph_norm(wv, l, x);
    if constexpr (PH == 2) ph_proj(wv, l);
    if constexpr (PH == 3) ph_postproj(wv, l);
    if constexpr (PH == 4) ph_qkv(wv, l);
    if constexpr (PH == 5) ph_postq(wv, l);
    if constexpr (PH == 6) ph_attention(wv);
    if constexpr (PH == 7) ph_mixcombine(wv);
    if constexpr (PH == 8) ph_outproj(wv, l, x);
    if constexpr (PH == 9) ph_router(wv, l);
    if constexpr (PH == 10) ph_scatter(wv);
    if constexpr (PH == 11) ph_moe1(wv, l);
    if constexpr (PH == 12) ph_moe2(wv, l);
    if constexpr (PH == 13) ph_recin(wv, l);
    if constexpr (PH == 14) ph_conv(wv, l);
    if constexpr (PH == 15) ph_lru(wv, l);
    if constexpr (PH == 16) ph_scan_sum(wv);
    if constexpr (PH == 17) ph_scan_apply(wv);
}
#endif
#undef IN
#undef MODL
}

#ifndef MODE
#define MODE 2
#endif
extern "C" void kernel_launch(void* const* d_in, const int* in_sizes, int n_in, void* d_out, int out_size, void* d_ws, size_t ws_size, hipStream_t stream) {
    (void)in_sizes; (void)n_in; (void)out_size; (void)ws_size;
#if MODE == 0
    nv::forward(d_in, (float*)d_out, d_ws, stream);
#else
    static int grid = 0;
    if (grid == 0) {
        int dev = 0, cus = 0;
        (void)hipGetDevice(&dev); (void)hipDeviceGetAttribute(&cus, hipDeviceAttributeMultiprocessorCount, dev);
#if MODE == 1
        (void)hipFuncSetAttribute((const void*)mk::mk_fwd, hipFuncAttributeMaxDynamicSharedMemorySize, mk::LDS_BYTES);
#else
#define SA(PH) (void)hipFuncSetAttribute((const void*)mk::k_phase<PH>, hipFuncAttributeMaxDynamicSharedMemorySize, mk::LDS_BYTES)
        SA(0); SA(1); SA(2); SA(3); SA(4); SA(5); SA(6); SA(7); SA(8); SA(9); SA(10); SA(11); SA(12); SA(13); SA(14); SA(15); SA(16); SA(17);
#undef SA
#endif
        grid = cus > 0 ? cus : 256;
    }
    (void)hipMemsetAsync((char*)d_ws + mk::O_CTL, 0, mk::SZ_CTL, stream);
    mk::Args a;
    memset(&a, 0, sizeof(a));
    for (int i = 0; i < 34; ++i) a.in[i] = d_in[i];
    a.out = (float*)d_out; a.ws = (unsigned char*)d_ws;
#if MODE == 1
    a.ph_lo = 0; a.ph_hi = mk::N_PHASES;
    hipLaunchKernelGGL(mk::mk_fwd, dim3(grid), dim3(512), mk::LDS_BYTES, stream, a);
#else
#define LP(PH, l, x) hipLaunchKernelGGL(mk::k_phase<PH>, dim3(grid), dim3(512), mk::LDS_BYTES, stream, a, l, x)
    LP(0, 0, 0);
    for (int lp = 0; lp < 2; ++lp) {
        { const int l = 2 * lp; LP(1, l, lp == 0 ? 0 : 1); LP(2, lp, 0); LP(3, lp, 0); LP(4, lp, 0); LP(5, lp, 0); LP(6, 0, 0); LP(7, 0, 0); LP(8, l, 0); LP(9, l, 0); LP(10, 0, 0); LP(11, l, 0); LP(12, l, 0); }
        { const int l = 2 * lp + 1; LP(1, l, 1); LP(13, lp, 0); LP(14, lp, 0); LP(15, lp, 0); LP(16, 0, 0); LP(17, 0, 0); LP(8, l, 1); LP(9, l, 0); LP(10, 0, 0); LP(11, l, 0); LP(12, l, 0); }
    }
    LP(1, 3, 2);
#undef LP
#endif
#endif
}
```

```cpp
#define MODE 1

#include <string.h>
#include <hip/hip_runtime.h>
#include <stdint.h>
#include <math.h>

namespace cfg {
constexpr int D = 1024, NB = 4, S = 4096, T = NB * S, DEPTH = 4;
constexpr int MIXIN = 1952;
constexpr int NE = 32, TOPK = 4;
constexpr int MPAIR = T * TOPK;
constexpr int NBLK = MPAIR / 256 + NE;
constexpr int P = NBLK * 256;
}
using namespace cfg;

namespace nv {

__device__ __forceinline__ float wave_sum(float v) {
#pragma unroll
    for (int o = 1; o < 64; o <<= 1) v += __shfl_xor(v, o);
    return v;
}
__device__ __forceinline__ float wave_max(float v) {
#pragma unroll
    for (int o = 1; o < 64; o <<= 1) v = fmaxf(v, __shfl_xor(v, o));
    return v;
}
__device__ __forceinline__ float block_sum256(float v) {
    __shared__ float red[4];
    v = wave_sum(v);
    __syncthreads();
    if ((threadIdx.x & 63) == 0) red[threadIdx.x >> 6] = v;
    __syncthreads();
    return red[0] + red[1] + red[2] + red[3];
}
__device__ __forceinline__ float sigmoidf_(float x) { return 1.f / (1.f + expf(-x)); }
__device__ __forceinline__ float gelu_tanh(float x) { return 0.5f * x * (1.f + tanhf(0.7978845608028654f * (x + 0.044715f * x * x * x))); }

__global__ void k_mod(const float* __restrict__ c, const float* __restrict__ ada_w, const float* __restrict__ ada_b, float* __restrict__ mod) {
    const int n = blockIdx.x * 256 + threadIdx.x, l = blockIdx.y;
    float acc[4] = {0.f, 0.f, 0.f, 0.f};
    const float* w = ada_w + (size_t)l * 1024 * 6144 + n;
    for (int k = 0; k < 1024; ++k) {
        const float wv = w[(size_t)k * 6144];
#pragma unroll
        for (int b = 0; b < 4; ++b) { const float cv = c[b * 1024 + k]; acc[b] += (cv / (1.f + expf(-cv))) * wv; }
    }
#pragma unroll
    for (int b = 0; b < 4; ++b) mod[((size_t)l * 4 + b) * 6144 + n] = acc[b] + ada_b[l * 6144 + n];
}

__global__ void k_rmsmod(const float* __restrict__ x, const float* __restrict__ gain, const float* __restrict__ modl, int shoff, int scoff, float* __restrict__ out) {
    const int t = blockIdx.x, b = t / S;
    const float* xr = x + (size_t)t * D;
    float v[4]; float ss = 0.f;
#pragma unroll
    for (int i = 0; i < 4; ++i) { v[i] = xr[threadIdx.x + 256 * i]; ss += v[i] * v[i]; }
    ss = block_sum256(ss);
    const float rs = rsqrtf(ss * (1.f / D) + 1e-6f);
#pragma unroll
    for (int i = 0; i < 4; ++i) { const int col = threadIdx.x + 256 * i;
        out[(size_t)t * D + col] = v[i] * rs * gain[col] * (1.f + modl[b * 6144 + scoff + col]) + modl[b * 6144 + shoff + col]; }
}

template <class Epi>
__global__ void __launch_bounds__(256) k_gemm(const float* __restrict__ A, const int* __restrict__ rowidx, const float* __restrict__ Bw, const int* __restrict__ tile_e, size_t bstride,
                                             Epi epi, int lda, int ldb, int N, int K) {
    __shared__ float As[16][68];
    __shared__ float Bs[16][68];
    const int row0 = blockIdx.y * 64, col0 = blockIdx.x * 64;
    int e = 0;
    if (tile_e) { e = tile_e[row0 / 256]; if (e < 0) return; }
    const float* Bp = Bw + (size_t)e * bstride;
    const int tid = threadIdx.x, ty = tid >> 4, tx = tid & 15;
    const int ar = tid >> 2, ak = (tid & 3) * 4;
    const int bk = tid >> 4, bn = (tid & 15) * 4;
    const int arow = rowidx ? rowidx[row0 + ar] : (row0 + ar);
    const float* Ap = A + (size_t)arow * lda + ak;
    float acc[4][4];
#pragma unroll
    for (int i = 0; i < 4; ++i)
#pragma unroll
        for (int j = 0; j < 4; ++j) acc[i][j] = 0.f;
    for (int k0 = 0; k0 < K; k0 += 16) {
        const float4 av = *(const float4*)(Ap + k0);
        float4 bv = make_float4(0.f, 0.f, 0.f, 0.f);
        if (col0 + bn < N) bv = *(const float4*)(Bp + (size_t)(k0 + bk) * ldb + col0 + bn);
        __syncthreads();
        As[ak + 0][ar] = av.x; As[ak + 1][ar] = av.y; As[ak + 2][ar] = av.z; As[ak + 3][ar] = av.w;
        *(float4*)&Bs[bk][bn] = bv;
        __syncthreads();
#pragma unroll
        for (int kk = 0; kk < 16; ++kk) {
            const float4 a4 = *(const float4*)&As[kk][ty * 4];
            const float4 b4 = *(const float4*)&Bs[kk][tx * 4];
            const float a[4] = {a4.x, a4.y, a4.z, a4.w}, b[4] = {b4.x, b4.y, b4.z, b4.w};
#pragma unroll
            for (int i = 0; i < 4; ++i)
#pragma unroll
                for (int j = 0; j < 4; ++j) acc[i][j] += a[i] * b[j];
        }
    }
#pragma unroll
    for (int i = 0; i < 4; ++i)
#pragma unroll
        for (int j = 0; j < 4; ++j) { const int r = row0 + ty * 4 + i, cidx = col0 + tx * 4 + j; if (cidx < N) epi(r, cidx, acc[i][j], e); }
}
struct EpiStore { float* C; const float* bias; int ldc; int bias_estride;
    __device__ __forceinline__ void operator()(int r, int c, float v, int e) const { C[(size_t)r * ldc + c] = v + (bias ? bias[(size_t)e * bias_estride + c] : 0.f); } };
struct EpiResid { float* X; const float* g; const float* bias;
    __device__ __forceinline__ void operator()(int r, int c, float v, int) const { const int b = r / S; X[(size_t)r * D + c] += g[b * 6144 + c] * (v + (bias ? bias[c] : 0.f)); } };

__global__ void k_postproj(float* __restrict__ PROJ, const float* __restrict__ qg, const float* __restrict__ kg, const float* __restrict__ qag, const float* __restrict__ kvag,
                           const float* __restrict__ mkg  , const int* __restrict__ positions) {
    const int t = blockIdx.x; float* r = PROJ + (size_t)t * MIXIN; const int tid = threadIdx.x;
    if (tid < 16) { float* p = r + tid * 64; const float* g = tid < 8 ? qg : kg; float ss = 0.f; for (int i = 0; i < 64; ++i) ss += p[i] * p[i];
        const float rs = rsqrtf(ss / 64.f + 1e-6f); for (int i = 0; i < 64; ++i) p[i] = p[i] * rs * g[i]; }
    else if (tid == 16) { float* p = r + 1536; float ss = 0.f; for (int i = 0; i < 256; ++i) ss += p[i] * p[i];
        const float rs = rsqrtf(ss / 256.f + 1e-6f); for (int i = 0; i < 256; ++i) p[i] = p[i] * rs * qag[i]; }
    else if (tid == 17) { float* p = r + 1792; float ss = 0.f; for (int i = 0; i < 128; ++i) ss += p[i] * p[i];
        const float rs = rsqrtf(ss / 128.f + 1e-6f); for (int i = 0; i < 128; ++i) p[i] = p[i] * rs * kvag[i]; }
    else if (tid == 18) { float* p = r + 1920; float ss = 0.f; for (int i = 0; i < 32; ++i) ss += p[i] * p[i];
        const float rs = rsqrtf(ss / 32.f + 1e-6f);
        const float pos = (float)positions[t];
        for (int i = 0; i < 16; ++i) { const float inv = powf(10000.f, -(float)(2 * i) / 32.f); const float ang = pos * inv; const float cs = cosf(ang), sn = sinf(ang);
            const float v1 = p[i] * rs * mkg[64 + i], v2 = p[16 + i] * rs * mkg[80 + i];
            p[i] = v1 * cs - v2 * sn; p[16 + i] = v1 * sn + v2 * cs; } }
}
__global__ void k_postq(float* __restrict__ Q2, float* __restrict__ KV2, const float* __restrict__ mqg, const float* __restrict__ mkg, const int* __restrict__ positions) {
    const int t = blockIdx.x, tid = threadIdx.x;
    if (tid < 8) { float* p = Q2 + (size_t)t * 768 + tid * 96; float ss = 0.f; for (int i = 0; i < 64; ++i) ss += p[i] * p[i];
        float rs = rsqrtf(ss / 64.f + 1e-6f); for (int i = 0; i < 64; ++i) p[i] = p[i] * rs * mqg[i];
        float* q = p + 64; ss = 0.f; for (int i = 0; i < 32; ++i) ss += q[i] * q[i]; rs = rsqrtf(ss / 32.f + 1e-6f);
        const float pos = (float)positions[t];
        for (int i = 0; i < 16; ++i) { const float inv = powf(10000.f, -(float)(2 * i) / 32.f); const float ang = pos * inv; const float cs = cosf(ang), sn = sinf(ang);
            const float v1 = q[i] * rs * mqg[64 + i], v2 = q[16 + i] * rs * mqg[80 + i];
            q[i] = v1 * cs - v2 * sn; q[16 + i] = v1 * sn + v2 * cs; } }
    else if (tid < 16) { float* p = KV2 + (size_t)t * 1024 + (tid - 8) * 128; float ss = 0.f; for (int i = 0; i < 64; ++i) ss += p[i] * p[i];
        const float rs = rsqrtf(ss / 64.f + 1e-6f); for (int i = 0; i < 64; ++i) p[i] = p[i] * rs * mkg[i]; }
}
__global__ void __launch_bounds__(256) k_mla(const float* __restrict__ Q2, const float* __restrict__ KV2, const float* __restrict__ PROJ, float* __restrict__ ATT) {
    const int wave = threadIdx.x >> 6, lane = threadIdx.x & 63;
    const int q = blockIdx.x * 4 + wave, h = blockIdx.y, b = blockIdx.z;
    const float* qrow = Q2 + (size_t)(b * S + q) * 768 + h * 96;
    float qv[96];
#pragma unroll
    for (int d = 0; d < 96; ++d) qv[d] = qrow[d];
    const float scale = 0.10206207261596575f;
    float m = -INFINITY, l = 0.f, o = 0.f;
    for (int k0 = 0; k0 <= q; k0 += 64) {
        const int k = k0 + lane; float s = -INFINITY;
        if (k <= q) { const float* kn = KV2 + (size_t)(b * S + k) * 1024 + h * 128; const float* kp = PROJ + (size_t)(b * S + k) * MIXIN + 1920; float acc = 0.f;
#pragma unroll
            for (int d = 0; d < 64; ++d) acc += qv[d] * kn[d];
#pragma unroll
            for (int d = 0; d < 32; ++d) acc += qv[64 + d] * kp[d];
            s = acc * scale; }
        const float mn = fmaxf(m, wave_max(s));
        const float alpha = expf(m - mn); const float p = (k <= q) ? expf(s - mn) : 0.f;
        l = l * alpha + wave_sum(p); o *= alpha;
        const int kend = min(64, q - k0 + 1);
        for (int kk = 0; kk < kend; ++kk) { const float pk = __shfl(p, kk); o += pk * KV2[(size_t)(b * S + k0 + kk) * 1024 + h * 128 + 64 + lane]; }
        m = mn;
    }
    ATT[(size_t)(b * S + q) * 1024 + 512 + h * 64 + lane] = o / l;
}
__global__ void __launch_bounds__(256) k_dil(const float* __restrict__ PROJ, float* __restrict__ ATT) {
    const int wave = threadIdx.x >> 6, lane = threadIdx.x & 63;
    const int t = blockIdx.x * 4 + wave, h = blockIdx.y, b = blockIdx.z;
    const float* base = PROJ + (size_t)(b * S) * MIXIN;
    const float* qrow = base + (size_t)t * MIXIN + h * 64;
    float qv[64];
#pragma unroll
    for (int d = 0; d < 64; ++d) qv[d] = qrow[d];
    float s[7]; float mx = -INFINITY;
#pragma unroll
    for (int c = 0; c < 7; ++c) { const int slot = c * 64 + lane; s[c] = -INFINITY;
        if (slot < 387) { const int p = slot / 129, j = slot % 129; const int dd = (p == 0) ? 1 : (p == 1) ? 4 : 16; const int tk = t - j * dd;
            if (tk >= 0) { const float* kr = base + (size_t)tk * MIXIN + 512 + h * 64; float acc = 0.f;
#pragma unroll
                for (int d = 0; d < 64; ++d) acc += qv[d] * kr[d];
                s[c] = acc * 0.125f; } }
        mx = fmaxf(mx, s[c]); }
    mx = wave_max(mx);
    float ls = 0.f;
#pragma unroll
    for (int c = 0; c < 7; ++c) { s[c] = expf(s[c] - mx); ls += s[c]; }
    ls = wave_sum(ls);
    float o = 0.f;
#pragma unroll
    for (int c = 0; c < 7; ++c)
        for (int kk = 0; kk < 64; ++kk) { const int slot = c * 64 + kk; if (slot >= 387) break; const int p = slot / 129, j = slot % 129; const int dd = (p == 0) ? 1 : (p == 1) ? 4 : 16; const int tk = t - j * dd;
            const float pk = __shfl(s[c], kk);
            if (tk >= 0) o += pk * base[(size_t)tk * MIXIN + 1024 + h * 64 + lane]; }
    ATT[(size_t)(b * S + t) * 1024 + h * 64 + lane] = o / ls;
}

__global__ void k_conv(const float* __restrict__ GX, const float* __restrict__ cw, const float* __restrict__ cb, float* __restrict__ XC) {
    const int t = blockIdx.x, ts = t % S;
    for (int c = threadIdx.x; c < 1024; c += 256) { float acc = cb[c];
#pragma unroll
        for (int k = 0; k < 4; ++k) { const int dt = k - 3; if (ts + dt >= 0) acc += cw[k * 1024 + c] * GX[(size_t)(t + dt) * 2048 + 1024 + c]; }
        XC[(size_t)t * 1024 + c] = acc; }
}
__global__ void k_lru(const float* __restrict__ RPRE, const float* __restrict__ IPRE, const float* __restrict__ XC, const float* __restrict__ lam, float* __restrict__ Aa, float* __restrict__ Bb) {
    const size_t i = (size_t)blockIdx.x * 256 + threadIdx.x; const int c = (int)(i & 1023);
    const float r = sigmoidf_(RPRE[i]), ig = sigmoidf_(IPRE[i]);
    const float nl = -lam[c]; const float sp = (nl > 20.f) ? nl : log1pf(expf(nl));
    const float log_a = -8.f * r * sp; const float a = expf(log_a); const float mult = sqrtf(-expm1f(2.f * log_a));
    Aa[i] = a; Bb[i] = mult * (ig * XC[i]);
}
__global__ void k_scan(const float* __restrict__ Aa, const float* __restrict__ Bb, float* __restrict__ Y) {
    const int idx = blockIdx.x * 256 + threadIdx.x; const int b = idx / 1024, c = idx % 1024;
    float h = 0.f; size_t off = (size_t)b * S * 1024 + c;
    for (int t = 0; t < S; ++t, off += 1024) { h = Aa[off] * h + Bb[off]; Y[off] = h; }
}
__global__ void k_gy(const float* __restrict__ GX, const float* __restrict__ Y, float* __restrict__ GY) {
    const size_t i = (size_t)blockIdx.x * 256 + threadIdx.x; const size_t t = i >> 10; const int c = (int)(i & 1023);
    GY[i] = gelu_tanh(GX[t * 2048 + c]) * Y[i];
}

__global__ void k_router(const float* __restrict__ x, const float* __restrict__ gain, const float* __restrict__ modl, const float* __restrict__ wr, const float* __restrict__ br,
                         float* __restrict__ HN2, int* __restrict__ topi, float* __restrict__ topg, int* __restrict__ cnt) {
    __shared__ float hrow[1024]; __shared__ float part[8][32]; __shared__ float lg[32];
    const int t = blockIdx.x, b = t / S, tid = threadIdx.x;
    const float* xr = x + (size_t)t * D;
    float v[4]; float ss = 0.f;
#pragma unroll
    for (int i = 0; i < 4; ++i) { v[i] = xr[tid + 256 * i]; ss += v[i] * v[i]; }
    ss = block_sum256(ss);
    const float rs = rsqrtf(ss * (1.f / D) + 1e-6f);
#pragma unroll
    for (int i = 0; i < 4; ++i) { const int col = tid + 256 * i; const float hv = v[i] * rs * gain[col] * (1.f + modl[b * 6144 + 4096 + col]) + modl[b * 6144 + 3072 + col];
        hrow[col] = hv; HN2[(size_t)t * D + col] = hv; }
    __syncthreads();
    { const int e = tid & 31, kp = tid >> 5; float acc = 0.f; for (int k = kp * 128; k < kp * 128 + 128; ++k) acc += hrow[k] * wr[k * 32 + e]; part[kp][e] = acc; }
    __syncthreads();
    if (tid < 32) { float a = br[tid]; for (int i = 0; i < 8; ++i) a += part[i][tid]; lg[tid] = a; }
    __syncthreads();
    if (tid == 0) { int idx[4]; float val[4]; unsigned used = 0u;
        for (int k = 0; k < 4; ++k) { int bi = -1; float bv = -INFINITY; for (int e = 0; e < 32; ++e) if (!((used >> e) & 1u) && lg[e] > bv) { bv = lg[e]; bi = e; } used |= 1u << bi; idx[k] = bi; val[k] = bv; }
        float den = 0.f, ex[4]; for (int k = 0; k < 4; ++k) { ex[k] = expf(val[k] - val[0]); den += ex[k]; }
        for (int k = 0; k < 4; ++k) { topi[t * 4 + k] = idx[k]; topg[t * 4 + k] = ex[k] / den; atomicAdd(&cnt[idx[k]], 1); } }
}
__global__ void k_plan(const int* __restrict__ cnt, int* __restrict__ pstart, int* __restrict__ tile_e) {
    if (threadIdx.x == 0) { int acc = 0, ti = 0;
        for (int e = 0; e < NE; ++e) { pstart[e] = acc; const int nt = (cnt[e] + 255) / 256; for (int i = 0; i < nt; ++i) tile_e[ti++] = e; acc += nt * 256; }
        for (; ti < NBLK; ++ti) tile_e[ti] = -1; }
}
__global__ void k_scatter(const int* __restrict__ topi, const int* __restrict__ pstart, int* __restrict__ fill, int* __restrict__ rowtok, int* __restrict__ pos) {
    const int i = blockIdx.x * 256 + threadIdx.x; const int e = topi[i];
    const int p = pstart[e] + atomicAdd(&fill[e], 1); rowtok[p] = i >> 2; pos[i] = p;
}
__global__ void k_swiglu(const float* __restrict__ HB, const int* __restrict__ tile_e, float* __restrict__ ACT) {
    const int p = blockIdx.x; if (tile_e[p / 256] < 0) return;
    for (int j = threadIdx.x; j < 1024; j += 256) { float g = HB[(size_t)p * 2048 + 2 * j], li = HB[(size_t)p * 2048 + 2 * j + 1];
        g = fminf(g, 7.f); li = fminf(fmaxf(li, -7.f), 7.f);
        ACT[(size_t)p * 1024 + j] = g * sigmoidf_(1.702f * g) * (li + 1.f); }
}
__global__ void k_combine(float* __restrict__ X, const float* __restrict__ Y2, const int* __restrict__ pos, const float* __restrict__ topg, const float* __restrict__ modl) {
    const int t = blockIdx.x, b = t / S;
    int pp[4]; float gg[4];
#pragma unroll
    for (int k = 0; k < 4; ++k) { pp[k] = pos[t * 4 + k]; gg[k] = topg[t * 4 + k]; }
    for (int c = threadIdx.x; c < 1024; c += 256) { float y = 0.f;
#pragma unroll
        for (int k = 0; k < 4; ++k) y += gg[k] * Y2[(size_t)pp[k] * 1024 + c];
        X[(size_t)t * D + c] += modl[b * 6144 + 5120 + c] * y; }
}

struct Bump { char* base; size_t off; template <class Tp> Tp* get(size_t n) { off = (off + 255) & ~(size_t)255; Tp* p = (Tp*)(base + off); off += n * sizeof(Tp); return p; } };

static void forward(void* const* d_in, float* X, void* d_ws, hipStream_t st) {
    const float* x = (const float*)d_in[0]; const float* c = (const float*)d_in[1]; const int* positions = (const int*)d_in[2];
    const float* ada_w = (const float*)d_in[3]; const float* ada_b = (const float*)d_in[4];
    const float* n1g = (const float*)d_in[5]; const float* n2g = (const float*)d_in[6];
    const float* attn_w_in = (const float*)d_in[7]; const float* da_qg = (const float*)d_in[8]; const float* da_kg = (const float*)d_in[9];
    const float* qag = (const float*)d_in[10]; const float* kvag = (const float*)d_in[11]; const float* w_uq = (const float*)d_in[12]; const float* w_ukv = (const float*)d_in[13];
    const float* mqg = (const float*)d_in[14]; const float* mkg = (const float*)d_in[15]; const float* attn_w_out = (const float*)d_in[16];
    const float* rec_w_in = (const float*)d_in[17]; const float* rec_b_in = (const float*)d_in[18]; const float* conv_w = (const float*)d_in[19]; const float* conv_b = (const float*)d_in[20];
    const float* rec_wa = (const float*)d_in[21]; const float* rec_ba = (const float*)d_in[22]; const float* rec_wx = (const float*)d_in[23]; const float* rec_bx = (const float*)d_in[24];
    const float* rec_lam = (const float*)d_in[25]; const float* rec_w_out = (const float*)d_in[26]; const float* rec_b_out = (const float*)d_in[27];
    const float* w_router = (const float*)d_in[28]; const float* b_router = (const float*)d_in[29]; const float* w1 = (const float*)d_in[30]; const float* b1 = (const float*)d_in[31];
    const float* w2 = (const float*)d_in[32]; const float* b2 = (const float*)d_in[33];

    Bump bp{(char*)d_ws, 0};
    int* ictl = bp.get<int>(1024);
    int* cnt = ictl, *fill = ictl + 64, *pstart = ictl + 128, *tile_e = ictl + 256;
    float* mod = bp.get<float>((size_t)DEPTH * 4 * 6144);
    float* HN = bp.get<float>((size_t)T * D);
    float* PROJ = bp.get<float>((size_t)T * 2048);
    float* Q2 = bp.get<float>((size_t)T * 768);
    float* KV2 = bp.get<float>((size_t)T * 1024);
    float* ATT = bp.get<float>((size_t)T * 1024);
    float* XC = bp.get<float>((size_t)T * 1024);
    float* RPRE = bp.get<float>((size_t)T * 1024);
    float* IPRE = bp.get<float>((size_t)T * 1024);
    float* Aa = bp.get<float>((size_t)T * 1024);
    float* Bb = bp.get<float>((size_t)T * 1024);
    float* Yv = bp.get<float>((size_t)T * 1024);
    int* topi = bp.get<int>((size_t)T * 4); float* topg = bp.get<float>((size_t)T * 4); int* pos = bp.get<int>((size_t)T * 4); int* rowtok = bp.get<int>(P);
    float* HB = bp.get<float>((size_t)P * 2048);
    float* ACT = bp.get<float>((size_t)P * 1024);
    float* Y2 = bp.get<float>((size_t)P * 1024);

    (void)hipMemcpyAsync(X, x, (size_t)T * D * 4, hipMemcpyDeviceToDevice, st);
    k_mod<<<dim3(6144 / 256, DEPTH), 256, 0, st>>>(c, ada_w, ada_b, mod);
    for (int l = 0; l < DEPTH; ++l) {
        const float* modl = mod + (size_t)l * 4 * 6144; const int j = l / 2;
        k_rmsmod<<<T, 256, 0, st>>>(X, n1g + l * D, modl, 0, 1024, HN);
        if (l % 2 == 0) {
            k_gemm<EpiStore><<<dim3((MIXIN + 63) / 64, T / 64), 256, 0, st>>>(HN, nullptr, attn_w_in + (size_t)j * D * MIXIN, nullptr, 0, EpiStore{PROJ, nullptr, MIXIN, 0}, D, MIXIN, MIXIN, D);
            k_postproj<<<T, 64, 0, st>>>(PROJ, da_qg + j * 64, da_kg + j * 64, qag + j * 256, kvag + j * 128, mkg + j * 96, positions);
            k_gemm<EpiStore><<<dim3(768 / 64, T / 64), 256, 0, st>>>(PROJ + 1536, nullptr, w_uq + (size_t)j * 256 * 768, nullptr, 0, EpiStore{Q2, nullptr, 768, 0}, MIXIN, 768, 768, 256);
            k_gemm<EpiStore><<<dim3(1024 / 64, T / 64), 256, 0, st>>>(PROJ + 1792, nullptr, w_ukv + (size_t)j * 128 * 1024, nullptr, 0, EpiStore{KV2, nullptr, 1024, 0}, MIXIN, 1024, 1024, 128);
            k_postq<<<T, 64, 0, st>>>(Q2, KV2, mqg + j * 96, mkg + j * 96, positions);
            k_dil<<<dim3(S / 4, 8, 4), 256, 0, st>>>(PROJ, ATT);
            k_mla<<<dim3(S / 4, 8, 4), 256, 0, st>>>(Q2, KV2, PROJ, ATT);
            k_gemm<EpiResid><<<dim3(D / 64, T / 64), 256, 0, st>>>(ATT, nullptr, attn_w_out + (size_t)j * 1024 * D, nullptr, 0, EpiResid{X, modl + 2048, nullptr}, 1024, D, D, 1024);
        } else {
            k_gemm<EpiStore><<<dim3(2048 / 64, T / 64), 256, 0, st>>>(HN, nullptr, rec_w_in + (size_t)j * D * 2048, nullptr, 0, EpiStore{PROJ, rec_b_in + j * 2048, 2048, 0}, D, 2048, 2048, D);
            k_conv<<<T, 256, 0, st>>>(PROJ, conv_w + j * 4 * 1024, conv_b + j * 1024, XC);
            for (int n = 0; n < 8; ++n) {
                k_gemm<EpiStore><<<dim3(2, T / 64), 256, 0, st>>>(XC + n * 128, nullptr, rec_wa + ((size_t)j * 8 + n) * 128 * 128, nullptr, 0, EpiStore{RPRE + n * 128, rec_ba + j * 1024 + n * 128, 1024, 0}, 1024, 128, 128, 128);
                k_gemm<EpiStore><<<dim3(2, T / 64), 256, 0, st>>>(XC + n * 128, nullptr, rec_wx + ((size_t)j * 8 + n) * 128 * 128, nullptr, 0, EpiStore{IPRE + n * 128, rec_bx + j * 1024 + n * 128, 1024, 0}, 1024, 128, 128, 128);
            }
            k_lru<<<T * 1024 / 256, 256, 0, st>>>(RPRE, IPRE, XC, rec_lam + j * 1024, Aa, Bb);
            k_scan<<<4096 / 256, 256, 0, st>>>(Aa, Bb, Yv);
            k_gy<<<T * 1024 / 256, 256, 0, st>>>(PROJ, Yv, ATT);
            k_gemm<EpiResid><<<dim3(D / 64, T / 64), 256, 0, st>>>(ATT, nullptr, rec_w_out + (size_t)j * 1024 * D, nullptr, 0, EpiResid{X, modl + 2048, rec_b_out + j * D}, 1024, D, D, 1024);
        }
        (void)hipMemsetAsync(ictl, 0, 1024 * 4, st);
        (void)hipMemsetAsync(rowtok, 0, (size_t)P * 4, st);
        k_router<<<T, 256, 0, st>>>(X, n2g + l * D, modl, w_router + (size_t)l * D * NE, b_router + l * NE, HN, topi, topg, cnt);
        k_plan<<<1, 64, 0, st>>>(cnt, pstart, tile_e);
        k_scatter<<<MPAIR / 256, 256, 0, st>>>(topi, pstart, fill, rowtok, pos);
        k_gemm<EpiStore><<<dim3(2048 / 64, P / 64), 256, 0, st>>>(HN, rowtok, w1 + (size_t)l * NE * D * 2048, tile_e, (size_t)D * 2048, EpiStore{HB, b1 + (size_t)l * NE * 2048, 2048, 2048}, D, 2048, 2048, D);
        k_swiglu<<<P, 256, 0, st>>>(HB, tile_e, ACT);
        k_gemm<EpiStore><<<dim3(1024 / 64, P / 64), 256, 0, st>>>(ACT, nullptr, w2 + (size_t)l * NE * 1024 * D, tile_e, (size_t)1024 * D, EpiStore{Y2, b2 + (size_t)l * NE * D, 1024, D}, 1024, D, D, 1024);
        k_combine<<<T, 256, 0, st>>>(X, Y2, pos, topg, modl);
    }
}
}


namespace mk {
#define LAS __attribute__((address_space(3)))
#define GAS __attribute__((address_space(1)))
typedef unsigned short bf16_t;
typedef short bf16x8 __attribute__((ext_vector_type(8)));
typedef short s16x4 __attribute__((ext_vector_type(4)));
typedef float f32x2 __attribute__((ext_vector_type(2)));
typedef float f32x4 __attribute__((ext_vector_type(4)));
typedef float f32x16 __attribute__((ext_vector_type(16)));
typedef unsigned u32x2 __attribute__((ext_vector_type(2)));
typedef unsigned u32x4 __attribute__((ext_vector_type(4)));
typedef GAS unsigned gu32;
#define RLX_AGENT __ATOMIC_RELAXED, __HIP_MEMORY_SCOPE_AGENT

__device__ __forceinline__ unsigned cvt_pk_bf16(float lo, float hi) { unsigned r; asm volatile("v_cvt_pk_bf16_f32 %0, %1, %2" : "=v"(r) : "v"(lo), "v"(hi)); return r; }
__device__ __forceinline__ float bf_lo(unsigned u) { return __uint_as_float(u << 16); }
__device__ __forceinline__ float bf_hi(unsigned u) { return __uint_as_float(u & 0xffff0000u); }
template <int O> __device__ __forceinline__ float shx(float v) { static_assert(O >= 1 && O < 32, "shx"); return __int_as_float(__builtin_amdgcn_ds_swizzle(__float_as_int(v), (O << 10) | 0x1f)); }
__device__ __forceinline__ float xadd32(float v) { const auto r = __builtin_amdgcn_permlane32_swap(__float_as_uint(v), __float_as_uint(v), false, false); return __uint_as_float(r[0]) + __uint_as_float(r[1]); }
__device__ __forceinline__ float xmax32(float v) { const auto r = __builtin_amdgcn_permlane32_swap(__float_as_uint(v), __float_as_uint(v), false, false); return fmaxf(__uint_as_float(r[0]), __uint_as_float(r[1])); }
__device__ __forceinline__ float wsum(float v) { v += shx<1>(v); v += shx<2>(v); v += shx<4>(v); v += shx<8>(v); v += shx<16>(v); return xadd32(v); }
__device__ __forceinline__ float fexp2(float x) { return __builtin_amdgcn_exp2f(x); }
__device__ __forceinline__ float frcp(float x) { return __builtin_amdgcn_rcpf(x); }
__device__ __forceinline__ float fsigmoid(float z) { return frcp(1.f + fexp2(-1.4426950408889634f * z)); }
__device__ __forceinline__ float fgelu_tanh(float x) { const float u = 0.7978845608028654f * (x + 0.044715f * x * x * x); return x * frcp(1.f + fexp2(-2.8853900817779268f * u)); }

#define XB_TMO      128
#define XB_XCNT(j)  (256  + 64 * (j))
#define XB_XSUB(j)  (1280 + 64 * (j))
#define XB_XGEN(j)  (2304 + 64 * (j))
#define XB_TOP      3328
#define XB_TOPGEN   3392
#define XCD_BAR_WORDS 3456
#define XB_SPIN_CAP (1u << 18)
__device__ __forceinline__ unsigned xb_ld(unsigned* p)              { return __hip_atomic_load(p, __ATOMIC_RELAXED, __HIP_MEMORY_SCOPE_AGENT); }
__device__ __forceinline__ unsigned xb_add(unsigned* p, unsigned v) { return __hip_atomic_fetch_add(p, v, __ATOMIC_RELAXED, __HIP_MEMORY_SCOPE_AGENT); }
__device__ __forceinline__ unsigned xb_xcc_id() { return (unsigned)__builtin_amdgcn_s_getreg((3 << 11) | 20) & 0xFu; }
#define XB_SPIN(cond, bar) do { unsigned _sp = 0; while (cond) { __builtin_amdgcn_s_sleep(1); \
    if ((++_sp & 255u) == 0u) { if (xb_ld(&(bar)[XB_TMO])) break; if (_sp > XB_SPIN_CAP) { atomicAdd(&(bar)[XB_TMO], 1u); break; } } } } while (0)
struct XcdBarrier { unsigned* bar; unsigned x; volatile LAS unsigned* st; };
__device__ __forceinline__ XcdBarrier xcd_barrier_post(unsigned* bar, volatile LAS unsigned* st, int tid) {
    XcdBarrier b; b.bar = bar; b.x = xb_xcc_id(); b.st = st;
    if (tid == 0) (void)xb_add(&bar[XB_XCNT(b.x)], 1u);
    return b;
}
__device__ __forceinline__ void xcd_barrier_complete(unsigned* bar, unsigned x, unsigned& nloc, unsigned& nx) {
    const unsigned G = gridDim.x * gridDim.y * gridDim.z;
    unsigned sum, cnt, mine, sp = 0u;
    for (;;) {
        sum = 0u; cnt = 0u; mine = 0u;
#pragma unroll
        for (unsigned j = 0; j < 16; ++j) { const unsigned c = xb_ld(&bar[XB_XCNT(j)]); sum += c; cnt += (c > 0u) ? 1u : 0u; mine = (j == x) ? c : mine; }
        if (sum == G) break;
        __builtin_amdgcn_s_sleep(1);
        if ((++sp & 255u) == 0u) { if (xb_ld(&bar[XB_TMO])) break; if (sp > XB_SPIN_CAP) { atomicAdd(&bar[XB_TMO], 1u); break; } }
    }
    nloc = mine > 0u ? mine : 1u; nx = cnt > 0u ? cnt : 1u;
}
__device__ __forceinline__ void xcd_barrier(const XcdBarrier& b, int tid) {
    asm volatile("s_waitcnt vmcnt(0)" ::: "memory");
    __syncthreads();
    if (tid == 0) {
        unsigned* bar = b.bar;
        __builtin_amdgcn_s_waitcnt(0);
        unsigned nloc = b.st[0], nx = b.st[1];
        if (nloc == 0u) { xcd_barrier_complete(bar, b.x, nloc, nx); b.st[0] = nloc; b.st[1] = nx; }
        const unsigned old = xb_add(&bar[XB_XSUB(b.x)], 1u);
        const unsigned gen = old / nloc;
        if (old + 1u == (gen + 1u) * nloc) {
            __builtin_amdgcn_fence(__ATOMIC_RELEASE, "agent");
            asm volatile("s_waitcnt vmcnt(0)" ::: "memory");
            const unsigned og = xb_add(&bar[XB_TOP], 1u);
            const unsigned tg = og / nx;
            if (og + 1u == (tg + 1u) * nx) xb_add(&bar[XB_TOPGEN], 1u);
            else XB_SPIN(xb_ld(&bar[XB_TOPGEN]) == tg, bar);
            __builtin_amdgcn_fence(__ATOMIC_ACQUIRE, "agent");
            xb_add(&bar[XB_XGEN(b.x)], 1u);
            asm volatile("s_waitcnt vmcnt(0)" ::: "memory");
        } else {
            XB_SPIN(xb_ld(&bar[XB_XGEN(b.x)]) == gen, bar);
            __builtin_amdgcn_fence(__ATOMIC_ACQUIRE, "agent");
            asm volatile("s_waitcnt vmcnt(0)" ::: "memory");
        }
    }
    __syncthreads();
}

constexpr int BM = 256, BK = 64, HALF = 128, HTB = HALF * BK * 2, STAGE_BYTES = 8 * HTB;
__host__ __device__ __forceinline__ int lds_byte(int r, int c) { const int st = (r >> 4) * 2 + (c >> 5), rr = r & 15, cc = c & 31, ob = rr * 64 + cc * 2; return st * 1024 + (ob ^ (((ob >> 9) & 1) << 5)); }
__host__ __device__ __forceinline__ void stage_rc(int b, int& R, int& C) { const int st = b / 1024, sb = b % 1024, swz = sb ^ (((sb >> 9) & 1) << 5); R = (st >> 1) * 16 + swz / 64; C = (st & 1) * 32 + (swz % 64) / 2; }
__host__ __device__ __forceinline__ int perm32(int rho) { const int n = rho >> 4, i = rho & 15; return 8 * (i >> 2) + 4 * n + (i & 3); }

struct Unit { const char* a; const char* b; int row0, col0, e, pad; };
struct GemmDims { int K, lda, ldb; };
typedef f32x4 Acc[2][2][4][2];
__device__ __forceinline__ void zero_acc(Acc& acc) {
#pragma unroll
    for (int a = 0; a < 2; ++a)
#pragma unroll
        for (int b = 0; b < 2; ++b)
#pragma unroll
            for (int m = 0; m < 4; ++m)
#pragma unroll
                for (int n = 0; n < 2; ++n)
#pragma unroll
                    for (int j = 0; j < 4; ++j) { float z; asm volatile("v_mov_b32 %0, 0" : "=v"(z)); acc[a][b][m][n][j] = z; }
}

typedef int v8i32 __attribute__((ext_vector_type(8)));
template <bool F8 = false, class CtxT, class Epi, class Sched>
__device__ __forceinline__ void gemm_phase(const CtxT& C, const GemmDims g, const Sched& S, const Epi& E) {
    LAS unsigned char* lds = C.lds;
    const int tid = C.tid, wid = __builtin_amdgcn_readfirstlane(tid >> 6), lane = tid & 63, wr = wid >> 2, wc = wid & 3, fr = lane & 15, fq = lane >> 4;
    constexpr int ESZ = F8 ? 1 : 2;
    int nt = g.K / (F8 ? 128 : BK); asm volatile("" : "+s"(nt));
    unsigned voffA[2], voffB[2];
#pragma unroll
    for (int i = 0; i < 2; ++i) { int R, C; stage_rc(tid * 16 + i * 8192, R, C); const int Rb = (R & ~31) + perm32(R & 31);
        voffA[i] = (unsigned)(R * g.lda * ESZ + C * 2); voffB[i] = (unsigned)(Rb * g.ldb * ESZ + C * 2); }
    const size_t kstep = (size_t)(BK * 2);
    const size_t hstepA = (size_t)HALF * g.lda * ESZ, hstepB = (size_t)HALF * g.ldb * ESZ;
    const unsigned ldsw = (unsigned)wid * 1024u;
    const unsigned ldsu = (unsigned)__builtin_amdgcn_readfirstlane((int)(unsigned)(unsigned long long)(lds));
    const int aoff = lds_byte(wr * 64 + fr, fq * 8), boff = lds_byte(wc * 32 + fr, fq * 8);
#define PG8_SA(b, h) (((b) * 2 + (h)) * HTB)
#define PG8_SB(b, h) ((4 + (b) * 2 + (h)) * HTB)
#define PG8_STAGE(bufoff, gbase, voff) do { _Pragma("unroll") for (int _i = 0; _i < 2; ++_i) { \
        asm volatile("s_mov_b32 m0, %2\n\ts_nop 3\n\tglobal_load_lds_dwordx4 %0, %1" :: "v"((voff)[_i]), "s"((const char*)(gbase)), "s"(ldsu + (unsigned)(bufoff) + ldsw + (unsigned)(_i * 8192)) : "memory"); } } while (0)
#define PG8_LDA(dst, b, h) do { _Pragma("unroll") for (int m = 0; m < 4; ++m) _Pragma("unroll") for (int k = 0; k < 2; ++k) dst[m][k] = *(const LAS bf16x8*)(lds + PG8_SA(b, h) + aoff + m * 2048 + k * 1024); } while (0)
#define PG8_LDB(dst, b, h) do { _Pragma("unroll") for (int n = 0; n < 2; ++n) _Pragma("unroll") for (int k = 0; k < 2; ++k) dst[n][k] = *(const LAS bf16x8*)(lds + PG8_SB(b, h) + boff + n * 2048 + k * 1024); } while (0)
#define PG8_CAT(x) __builtin_bit_cast(v8i32, (x))
#define PG8_MMA(ai, bj, At, Bt) do { __builtin_amdgcn_s_setprio(1); \
        if constexpr (F8) { _Pragma("unroll") for (int m = 0; m < 4; ++m) _Pragma("unroll") for (int n = 0; n < 2; ++n) \
            acc[ai][bj][m][n] = __builtin_amdgcn_mfma_scale_f32_16x16x128_f8f6f4(PG8_CAT(Bt[n]), PG8_CAT(At[m]), acc[ai][bj][m][n], 0, 0, 0, 0, 0, 0); } \
        else { _Pragma("unroll") for (int m = 0; m < 4; ++m) _Pragma("unroll") for (int n = 0; n < 2; ++n) _Pragma("unroll") for (int k = 0; k < 2; ++k) \
            acc[ai][bj][m][n] = __builtin_amdgcn_mfma_f32_16x16x32_bf16(Bt[n][k], At[m][k], acc[ai][bj][m][n], 0, 0, 0); } \
        __builtin_amdgcn_s_setprio(0); } while (0)
#define PG8_WAIT_V(n) asm volatile("s_waitcnt vmcnt(" #n ")" ::: "memory")
#define PG8_WAIT_L(n) asm volatile("s_waitcnt lgkmcnt(" #n ")" ::: "memory")
#define PG8_BAR __builtin_amdgcn_s_barrier()
#define PG8_SCHED __builtin_amdgcn_sched_barrier(0)
    Unit cur, nxt; int ui = 0;
    if (!S.next(0, cur)) return;
    Acc acc; zero_acc(acc);
    struct Frag2 { bf16x8 p[2]; __device__ __forceinline__ bf16x8& operator[](int k) { return p[k]; } __device__ __forceinline__ const bf16x8& operator[](int k) const { return p[k]; } };
    Frag2 At[4], B0[2], B1[2];
    const char* cA = cur.a; const char* cB = cur.b;
    PG8_STAGE(PG8_SB(0, 0), cB, voffB); PG8_STAGE(PG8_SB(0, 1), cB + hstepB, voffB); PG8_STAGE(PG8_SA(0, 0), cA, voffA); PG8_STAGE(PG8_SA(0, 1), cA + hstepA, voffA);
    if (wr == 1) PG8_BAR;
    PG8_WAIT_V(2); PG8_BAR;
    PG8_STAGE(PG8_SB(1, 0), cB + kstep, voffB); PG8_STAGE(PG8_SA(1, 0), cA + kstep, voffA); PG8_STAGE(PG8_SB(1, 1), cB + hstepB + kstep, voffB);
    PG8_WAIT_V(6); PG8_BAR;
    for (;;) {
        const bool has_next = S.next(ui + 1, nxt);
        const char* nA = has_next ? nxt.a : cA; const char* nB = has_next ? nxt.b : cB;
        for (int t = 0; t < nt; t += 2) {
            const bool last = (t == nt - 2);
            const char* a1 = cA + (size_t)(t + 1) * kstep;
            const char* a2 = last ? nA : cA + (size_t)(t + 2) * kstep; const char* b2 = last ? nB : cB + (size_t)(t + 2) * kstep;
            const char* a3 = a2 + kstep; const char* b3 = b2 + kstep;
            PG8_LDB(B0, 0, 0); PG8_LDB(B1, 0, 1); PG8_SCHED; PG8_LDA(At, 0, 0); PG8_STAGE(PG8_SA(1, 1), a1 + hstepA, voffA);
            PG8_WAIT_V(8); PG8_WAIT_L(0); PG8_BAR; PG8_MMA(0, 0, At, B0); PG8_MMA(0, 1, At, B1); PG8_BAR; PG8_SCHED;
            PG8_LDA(At, 0, 1); PG8_STAGE(PG8_SB(0, 0), b2, voffB); PG8_STAGE(PG8_SB(0, 1), b2 + hstepB, voffB); PG8_STAGE(PG8_SA(0, 0), a2, voffA);
            PG8_WAIT_V(8); PG8_WAIT_L(0); PG8_BAR; PG8_MMA(1, 0, At, B0); PG8_MMA(1, 1, At, B1); PG8_BAR; PG8_SCHED;
            PG8_LDB(B0, 1, 0); PG8_LDB(B1, 1, 1); PG8_SCHED; PG8_LDA(At, 1, 0); PG8_STAGE(PG8_SA(0, 1), a2 + hstepA, voffA);
            PG8_WAIT_V(8); PG8_WAIT_L(0); PG8_BAR; PG8_MMA(0, 0, At, B0); PG8_MMA(0, 1, At, B1); PG8_BAR; PG8_SCHED;
            PG8_LDA(At, 1, 1); PG8_STAGE(PG8_SB(1, 0), b3, voffB); PG8_STAGE(PG8_SB(1, 1), b3 + hstepB, voffB); PG8_STAGE(PG8_SA(1, 0), a3, voffA);
            PG8_WAIT_V(8); PG8_WAIT_L(0); PG8_BAR; PG8_MMA(1, 0, At, B0); PG8_MMA(1, 1, At, B1); PG8_BAR; PG8_SCHED;
        }
        if (wr == 0) PG8_BAR;
        E(acc, cur, wr, wc, fr, fq);
        if (!has_next) break;
        zero_acc(acc);
        cur = nxt; cA = nA; cB = nB; ++ui;
        if (wr == 1) PG8_BAR;
    }
    PG8_WAIT_V(0);
    PG8_BAR;
#undef PG8_SA
#undef PG8_SB
#undef PG8_STAGE
#undef PG8_LDA
#undef PG8_LDB
#undef PG8_MMA
#undef PG8_CAT
#undef PG8_WAIT_V
#undef PG8_WAIT_L
#undef PG8_BAR
#undef PG8_SCHED
}

struct DenseOrder {
    const char* A; const char* Bt; int lda, ldb, nM, nN, nwg, G, c;
    __device__ __forceinline__ void init(const void* A_, const void* Bt_, int lda_, int ldb_, int M, int N, int G_, int c_) { A = (const char*)A_; Bt = (const char*)Bt_; lda = lda_; ldb = ldb_; nM = M / BM; nN = N / BM; nwg = nM * nN; G = G_; c = c_; }
    __device__ __forceinline__ bool next(int i, Unit& u) const {
        const long L = (long)i * G + c; if (L >= nwg) return false;
        int wgid = (int)L; { const int q = nwg / 8, r = nwg % 8, xcd = wgid % 8, off = wgid / 8; wgid = (xcd < r ? xcd * (q + 1) : r * (q + 1) + (xcd - r) * q) + off; }
        const int nig = 8 * nN, gid = wgid / nig, fm = gid * 8, gsz = (nM - fm) < 8 ? (nM - fm) : 8;
        const int pm = fm + ((wgid % nig) % gsz), pn = (wgid % nig) / gsz;
        u.a = A + (size_t)pm * BM * lda * 2; u.b = Bt + (size_t)pn * BM * ldb * 2; u.row0 = pm * BM; u.col0 = pn * BM; u.e = 0; u.pad = 0; return true;
    }
};
struct LruOrder {
    const char* XC; const char* RG; int G, c;
    __device__ __forceinline__ bool next(int i, Unit& u) const {
        const int L = i * G + c; if (L >= 512) return false;
        const int pm = L >> 3, n = L & 7;
        u.a = XC + ((size_t)pm * BM * 1024 + n * 128) * 2; u.b = RG + (size_t)n * 256 * 128 * 2; u.row0 = pm * BM; u.col0 = n * 128; u.e = n; u.pad = 0; return true;
    }
};
struct MoeOrder {
    const char* A; const char* WT; size_t estride; const LAS int* tile_e; int NT, nN, G, c, esz;
    __device__ __forceinline__ bool next(int i, Unit& u) const {
        int tile, pn;
        if ((G % (8 * nN)) == 0) { const int R = G / nN; tile = i * R + (c & 7) * (R >> 3) + (c >> 3) / nN; pn = (c >> 3) % nN; }
        else { const int L = i * G + c; tile = L / nN; pn = L % nN; }
        if (tile >= NT) return false;
        const int e = __builtin_amdgcn_readfirstlane(tile_e[tile]);
        u.a = A + (size_t)tile * BM * 1024 * esz; u.b = WT + (size_t)e * estride + (size_t)pn * BM * 1024 * esz; u.row0 = tile * BM; u.col0 = pn * BM; u.e = e; u.pad = 0; return true;
    }
};

#define EPI_ROW(ai, m) (u.row0 + (ai) * HALF + wr * 64 + (m) * 16 + fr)
#define EPI_COL(bj) (u.col0 + (bj) * HALF + wc * 32 + 8 * fq)
struct EpiBf16 {
    bf16_t* O; const float* bias; int ldc, bias_es; float ascale;
    __device__ __forceinline__ void operator()(const Acc& acc, const Unit& u, int wr, int wc, int fr, int fq) const {
        f32x4 bv[2][2];
#pragma unroll
        for (int bj = 0; bj < 2; ++bj)
#pragma unroll
            for (int n = 0; n < 2; ++n) bv[bj][n] = bias ? *(const f32x4*)(bias + (size_t)u.e * bias_es + EPI_COL(bj) + 4 * n) : (f32x4){0.f, 0.f, 0.f, 0.f};
#pragma unroll
        for (int ai = 0; ai < 2; ++ai)
#pragma unroll
            for (int m = 0; m < 4; ++m) { bf16_t* rowp = O + (size_t)EPI_ROW(ai, m) * ldc;
#pragma unroll
                for (int bj = 0; bj < 2; ++bj) { const f32x4 v0 = acc[ai][bj][m][0] * ascale + bv[bj][0], v1 = acc[ai][bj][m][1] * ascale + bv[bj][1];
                    u32x4 w; w.x = cvt_pk_bf16(v0[0], v0[1]); w.y = cvt_pk_bf16(v0[2], v0[3]); w.z = cvt_pk_bf16(v1[0], v1[1]); w.w = cvt_pk_bf16(v1[2], v1[3]);
                    *(u32x4*)(rowp + EPI_COL(bj)) = w; } }
    }
};
template <int KIND> struct EpiNorm {
    bf16_t* O; int ldc; const float* ga; const float* gb; const float* gc; const float* gd; const float* ge; const float* cs; LAS float* S;
    __device__ __forceinline__ void operator()(const Acc& acc, const Unit& u, int wr, int wc, int fr, int fq) const {
        const int pn = u.col0 >> 8; const int lane = fr + 16 * fq;
        int mode = 0; const float* gp = ga; float scale = 1.f;
        if (KIND == 0) { if (pn < 2) { mode = 1; gp = ga; scale = 0.125f * 1.4426950408889634f; } else if (pn < 4) { mode = 1; gp = gb; } else if (pn < 6) mode = 0; else if (pn == 6) { mode = 2; gp = gc; } else { mode = 3; gp = gd; } }
        if (KIND == 1) { scale = 0.10206207261596575f * 1.4426950408889634f; if (pn < 2) { mode = 1; gp = ga; } else { mode = 4; gp = gb; } }
        if (KIND == 2) { if (pn < 2) { mode = 1; gp = ga; } else mode = 0; }
        float ss[2][4][2];
        if (mode != 0) {
#pragma unroll
            for (int ai = 0; ai < 2; ++ai)
#pragma unroll
                for (int m = 0; m < 4; ++m)
#pragma unroll
                    for (int bj = 0; bj < 2; ++bj) { const f32x4 a = acc[ai][bj][m][0], b = acc[ai][bj][m][1];
                        float s = (a[0] * a[0] + a[1] * a[1]) + (a[2] * a[2] + a[3] * a[3]) + (b[0] * b[0] + b[1] * b[1]) + (b[2] * b[2] + b[3] * b[3]);
                        s += shx<16>(s); ss[ai][m][bj] = xadd32(s); } }
        if (mode == 1 || mode == 2 || mode == 3) {
            if (fq == 0) {
#pragma unroll
                for (int ai = 0; ai < 2; ++ai)
#pragma unroll
                    for (int m = 0; m < 4; ++m)
#pragma unroll
                        for (int bj = 0; bj < 2; ++bj) S[(ai * HALF + wr * 64 + m * 16 + fr) * 8 + bj * 4 + wc] = ss[ai][m][bj]; }
            asm volatile("s_waitcnt lgkmcnt(0)" ::: "memory"); __builtin_amdgcn_s_barrier(); asm volatile("" ::: "memory");
#pragma unroll
            for (int ai = 0; ai < 2; ++ai)
#pragma unroll
                for (int m = 0; m < 4; ++m) { const LAS float* sr = S + (ai * HALF + wr * 64 + m * 16 + fr) * 8;
#pragma unroll
                    for (int bj = 0; bj < 2; ++bj) {
                        if (mode == 1) { const f32x2 t = *(const LAS f32x2*)(sr + bj * 4 + (wc & 2)); ss[ai][m][bj] = t[0] + t[1]; }
                        else if (mode == 2) { const f32x4 t0 = *(const LAS f32x4*)sr, t1 = *(const LAS f32x4*)(sr + 4); ss[ai][m][bj] = (t0[0] + t0[1]) + (t0[2] + t0[3]) + (t1[0] + t1[1]) + (t1[2] + t1[3]); }
                        else if (bj == 0) { const f32x4 t0 = *(const LAS f32x4*)sr; ss[ai][m][bj] = (t0[0] + t0[1]) + (t0[2] + t0[3]); } } }
        }
        const float inv_n = (mode == 1) ? (1.f / 64.f) : (mode == 2) ? (1.f / 256.f) : (1.f / 32.f);
        const bool rope_tile = (mode == 4) || (mode == 3);
#pragma unroll
        for (int bj = 0; bj < 2; ++bj) {
            f32x4 g0 = (f32x4){1.f, 1.f, 1.f, 1.f}, g1 = g0; bool rope = false, zero = false; float invn = inv_n;
            const int c8 = 8 * fq;
            if (mode == 1) { const int c = 32 * (wc & 1) + c8; g0 = *(const f32x4*)(gp + c); g1 = *(const f32x4*)(gp + c + 4); }
            else if (mode == 2) { const int c = bj * HALF + wc * 32 + c8; g0 = *(const f32x4*)(gp + c); g1 = *(const f32x4*)(gp + c + 4); }
            else if (mode == 3) { if (bj == 0) { const int c = wc * 32 + c8; g0 = *(const f32x4*)(gp + c); g1 = *(const f32x4*)(gp + c + 4); invn = 1.f / 128.f; }
                                  else if (wc == 0) { g0 = *(const f32x4*)(ge + c8); g1 = *(const f32x4*)(ge + c8 + 4); rope = true; } else zero = true; }
            else if (mode == 4) { g0 = *(const f32x4*)(gp + c8); g1 = *(const f32x4*)(gp + c8 + 4); rope = true; }
            (void)rope_tile;
#pragma unroll
            for (int ai = 0; ai < 2; ++ai)
#pragma unroll
                for (int m = 0; m < 4; ++m) { const int row = EPI_ROW(ai, m);
                    f32x4 v0 = acc[ai][bj][m][0], v1 = acc[ai][bj][m][1];
                    if (mode != 0) { const float rs = rsqrtf(ss[ai][m][bj] * invn + 1e-6f) * scale; v0 = v0 * rs * g0; v1 = v1 * rs * g1; }
                    if (rope) {
                        const float* cr = cs + (size_t)row * 32 + 8 * (fq & 1); const f32x4 c0 = *(const f32x4*)cr, c1 = *(const f32x4*)(cr + 4), s0 = *(const f32x4*)(cr + 16), s1 = *(const f32x4*)(cr + 20);
                        f32x4 o0, o1;
#pragma unroll
                        for (int j = 0; j < 4; ++j) { const auto r0 = __builtin_amdgcn_permlane32_swap(__float_as_uint(v0[j]), __float_as_uint(v0[j]), false, false), r1 = __builtin_amdgcn_permlane32_swap(__float_as_uint(v1[j]), __float_as_uint(v1[j]), false, false);
                            const float ot0 = __uint_as_float(lane < 32 ? r0[1] : r0[0]), ot1 = __uint_as_float(lane < 32 ? r1[1] : r1[0]);
                            o0[j] = (lane < 32) ? (v0[j] * c0[j] - ot0 * s0[j]) : (ot0 * s0[j] + v0[j] * c0[j]);
                            o1[j] = (lane < 32) ? (v1[j] * c1[j] - ot1 * s1[j]) : (ot1 * s1[j] + v1[j] * c1[j]); }
                        v0 = o0; v1 = o1; }
                    if (zero) { v0 = (f32x4){0.f, 0.f, 0.f, 0.f}; v1 = v0; }
                    u32x4 w; w.x = cvt_pk_bf16(v0[0], v0[1]); w.y = cvt_pk_bf16(v0[2], v0[3]); w.z = cvt_pk_bf16(v1[0], v1[1]); w.w = cvt_pk_bf16(v1[2], v1[3]);
                    *(u32x4*)(O + (size_t)row * ldc + EPI_COL(bj)) = w; } }
    }
};
struct EpiRecIn {
    bf16_t* O; const float* bias;
    __device__ __forceinline__ void operator()(const Acc& acc, const Unit& u, int wr, int wc, int fr, int fq) const {
        const bool act = u.col0 < 1024;
        f32x4 bv[2][2];
#pragma unroll
        for (int bj = 0; bj < 2; ++bj)
#pragma unroll
            for (int n = 0; n < 2; ++n) bv[bj][n] = *(const f32x4*)(bias + EPI_COL(bj) + 4 * n);
#pragma unroll
        for (int ai = 0; ai < 2; ++ai)
#pragma unroll
            for (int m = 0; m < 4; ++m) { bf16_t* rowp = O + (size_t)EPI_ROW(ai, m) * 2048;
#pragma unroll
                for (int bj = 0; bj < 2; ++bj) { f32x4 v0 = acc[ai][bj][m][0] + bv[bj][0], v1 = acc[ai][bj][m][1] + bv[bj][1];
                    if (act) {
#pragma unroll
                        for (int j = 0; j < 4; ++j) { v0[j] = fgelu_tanh(v0[j]); v1[j] = fgelu_tanh(v1[j]); } }
                    u32x4 w; w.x = cvt_pk_bf16(v0[0], v0[1]); w.y = cvt_pk_bf16(v0[2], v0[3]); w.z = cvt_pk_bf16(v1[0], v1[1]); w.w = cvt_pk_bf16(v1[2], v1[3]);
                    *(u32x4*)(rowp + EPI_COL(bj)) = w; } }
    }
};
__device__ __forceinline__ unsigned pk4_fp8(float a, float b, float c, float d) { int w = 0; w = __builtin_amdgcn_cvt_pk_fp8_f32(a, b, w, false); w = __builtin_amdgcn_cvt_pk_fp8_f32(c, d, w, true); return (unsigned)w; }
struct EpiSwiglu {
    unsigned char* ACT; const float* b1; float ascale;
    __device__ __forceinline__ float sw(float g, float l) const { g = fminf(g, 7.f); l = fminf(fmaxf(l, -7.f), 7.f); return g * fsigmoid(1.702f * g) * (l + 1.f); }
    __device__ __forceinline__ void operator()(const Acc& acc, const Unit& u, int wr, int wc, int fr, int fq) const {
        f32x4 bv[2][2];
#pragma unroll
        for (int bj = 0; bj < 2; ++bj)
#pragma unroll
            for (int n = 0; n < 2; ++n) bv[bj][n] = *(const f32x4*)(b1 + (size_t)u.e * 2048 + EPI_COL(bj) + 4 * n);
#pragma unroll
        for (int ai = 0; ai < 2; ++ai)
#pragma unroll
            for (int m = 0; m < 4; ++m) { unsigned char* rowp = ACT + (size_t)EPI_ROW(ai, m) * 1024;
#pragma unroll
                for (int bj = 0; bj < 2; ++bj) { const f32x4 v0 = acc[ai][bj][m][0] * ascale + bv[bj][0], v1 = acc[ai][bj][m][1] * ascale + bv[bj][1];
                    *(unsigned*)(rowp + (EPI_COL(bj) >> 1)) = pk4_fp8(sw(v0[0], v0[1]), sw(v0[2], v0[3]), sw(v1[0], v1[1]), sw(v1[2], v1[3])); } }
    }
};
struct EpiResid {
    bf16_t* X; const float* g; const float* bias;
    __device__ __forceinline__ void operator()(const Acc& acc, const Unit& u, int wr, int wc, int fr, int fq) const {
        const int b = u.row0 / cfg::S;
        f32x4 bv[2][2], gv[2][2];
#pragma unroll
        for (int bj = 0; bj < 2; ++bj)
#pragma unroll
            for (int n = 0; n < 2; ++n) { bv[bj][n] = bias ? *(const f32x4*)(bias + EPI_COL(bj) + 4 * n) : (f32x4){0.f, 0.f, 0.f, 0.f}; gv[bj][n] = *(const f32x4*)(g + b * 6144 + EPI_COL(bj) + 4 * n); }
#pragma unroll
        for (int ai = 0; ai < 2; ++ai)
#pragma unroll
            for (int m = 0; m < 4; ++m) { bf16_t* rowp = X + (size_t)EPI_ROW(ai, m) * 1024;
#pragma unroll
                for (int bj = 0; bj < 2; ++bj) { u32x4* p = (u32x4*)(rowp + EPI_COL(bj)); const u32x4 xw = *p;
                    const f32x4 x0 = (f32x4){bf_lo(xw.x), bf_hi(xw.x), bf_lo(xw.y), bf_hi(xw.y)} + gv[bj][0] * (acc[ai][bj][m][0] + bv[bj][0]);
                    const f32x4 x1 = (f32x4){bf_lo(xw.z), bf_hi(xw.z), bf_lo(xw.w), bf_hi(xw.w)} + gv[bj][1] * (acc[ai][bj][m][1] + bv[bj][1]);
                    u32x4 w; w.x = cvt_pk_bf16(x0[0], x0[1]); w.y = cvt_pk_bf16(x0[2], x0[3]); w.z = cvt_pk_bf16(x1[0], x1[1]); w.w = cvt_pk_bf16(x1[2], x1[3]); *p = w; }
                if (m & 1) asm volatile("" ::: "memory"); }
    }
};
struct EpiLru {
    const bf16_t* XC; const float* ba; const float* bx; const float* lam; bf16_t* LA; bf16_t* Bb;
    __device__ __forceinline__ void operator()(const Acc& acc, const Unit& u, int wr, int wc, int fr, int fq) const {
        const int ch0 = u.col0 + wc * 32 + 8 * fq;
#pragma unroll
        for (int n = 0; n < 2; ++n) { const int ch = ch0 + 4 * n;
            const f32x4 bav = *(const f32x4*)(ba + ch), bxv = *(const f32x4*)(bx + ch), spv = *(const f32x4*)(lam + ch);
#pragma unroll
            for (int ai = 0; ai < 2; ++ai)
#pragma unroll
                for (int m = 0; m < 4; ++m) { const size_t ro = (size_t)EPI_ROW(ai, m) * 1024 + ch;
                    const u32x2 xr = *(const u32x2*)(XC + ro);
                    const float xcv[4] = {bf_lo(xr.x), bf_hi(xr.x), bf_lo(xr.y), bf_hi(xr.y)};
                    float lav[4], bvv[4];
#pragma unroll
                    for (int j = 0; j < 4; ++j) { const float r = fsigmoid(acc[ai][0][m][n][j] + bav[j]), ig = fsigmoid(acc[ai][1][m][n][j] + bxv[j]);
                        const float la = r * spv[j], a = fexp2(la); lav[j] = la; bvv[j] = __builtin_amdgcn_sqrtf(fmaxf(1.f - a * a, 0.f)) * ig * xcv[j]; }
                    u32x2 wa, wb; wa.x = cvt_pk_bf16(lav[0], lav[1]); wa.y = cvt_pk_bf16(lav[2], lav[3]); wb.x = cvt_pk_bf16(bvv[0], bvv[1]); wb.y = cvt_pk_bf16(bvv[2], bvv[3]);
                    *(u32x2*)(LA + ro) = wa; *(u32x2*)(Bb + ro) = wb; asm volatile("" ::: "memory"); } }
    }
};

constexpr size_t MiB = (size_t)1 << 20;
constexpr size_t al4k(size_t x) { return (x + 4095) & ~(size_t)4095; }
constexpr int T_ = cfg::T, S_ = cfg::S, P_ = cfg::P;
constexpr size_t O_CTL = 0, SZ_CTL = 1 * MiB;
constexpr size_t O_MOD = O_CTL + SZ_CTL, SZ_MOD = al4k((size_t)4 * 4 * 6144 * 4);
constexpr size_t O_CS = O_MOD + SZ_MOD, SZ_CS = (size_t)T_ * 32 * 4;
constexpr size_t O_HIST = O_CS + SZ_CS, SZ_HIST = 256 * 32 * 4;
constexpr size_t O_TOPI = O_HIST + SZ_HIST, SZ_TOP = (size_t)T_ * 4 * 4;
constexpr size_t O_TOPG = O_TOPI + SZ_TOP, O_POS = O_TOPG + SZ_TOP;
constexpr size_t O_SUMP = O_POS + SZ_TOP, SZ_SUM = (size_t)4 * 64 * 1024 * 4;
constexpr size_t O_SUMH = O_SUMP + SZ_SUM;
constexpr size_t O_LSE = O_SUMH + SZ_SUM, SZ_LSE = (size_t)3 * T_ * 8 * 4;
constexpr size_t O_SPV = al4k(O_LSE + SZ_LSE), SZ_SPV = 2 * 1024 * 4;
constexpr size_t O_WIN = al4k(O_SPV + SZ_SPV), SZ_WIN = (size_t)2048 * 1024 * 2;
constexpr size_t O_WUQ = O_WIN + 2 * SZ_WIN, SZ_WUQ = (size_t)768 * 256 * 2;
constexpr size_t O_WUKV = O_WUQ + 2 * SZ_WUQ, SZ_WUKV = (size_t)1024 * 128 * 2;
constexpr size_t O_WOUT = O_WUKV + 2 * SZ_WUKV, SZ_WOUT = (size_t)1024 * 1024 * 2;
constexpr size_t O_RWIN = O_WOUT + 2 * SZ_WOUT, SZ_RWIN = (size_t)2048 * 1024 * 2;
constexpr size_t O_RGATE = O_RWIN + 2 * SZ_RWIN, SZ_RGATE = (size_t)8 * 256 * 128 * 2;
constexpr size_t O_RWOUT = O_RGATE + 2 * SZ_RGATE, SZ_RWOUT = (size_t)1024 * 1024 * 2;
constexpr size_t O_W1 = O_RWOUT + 2 * SZ_RWOUT, SZ_W1E = (size_t)2048 * 1024;
constexpr size_t O_W2 = O_W1 + 128 * SZ_W1E, SZ_W2E = (size_t)1024 * 1024;
constexpr size_t O_HN = O_W2 + 128 * SZ_W2E, SZ_HN = (size_t)T_ * 1024 * 2;
constexpr size_t O_PROJ = O_HN + SZ_HN, SZ_PROJ = (size_t)T_ * 2048 * 2;
constexpr size_t O_Q2 = O_PROJ + SZ_PROJ, SZ_Q2 = (size_t)T_ * 768 * 2;
constexpr size_t O_KV2 = O_Q2 + SZ_Q2, SZ_KV2 = (size_t)T_ * 1024 * 2;
constexpr size_t O_OA = O_KV2 + SZ_KV2, SZ_OA = (size_t)3 * T_ * 512 * 2;
constexpr size_t O_ATT = O_OA + SZ_OA, SZ_ATT = (size_t)T_ * 1024 * 2;
constexpr size_t O_XC = O_ATT + SZ_ATT, SZ_XC = (size_t)T_ * 1024 * 2;
constexpr size_t O_AA = O_XC + SZ_XC, SZ_AA = (size_t)T_ * 1024 * 4;
constexpr size_t O_BB = O_AA + SZ_AA;
constexpr size_t O_XG = O_BB + SZ_AA, SZ_XG = (size_t)P_ * 1024 * 2;
constexpr size_t O_ACT = O_XG + SZ_XG, O_Y2 = O_ACT + SZ_XG;
constexpr size_t O_X = O_Y2 + SZ_XG, SZ_X = (size_t)T_ * 1024 * 2;
constexpr size_t O_DUMMY = O_X + SZ_X, SZ_DUMMY = (size_t)96 * MiB;
constexpr size_t WS_MK_END = O_DUMMY + SZ_DUMMY;
constexpr size_t O_NAIVE = (size_t)2048 * MiB;
static_assert(WS_MK_END <= O_NAIVE, "mk workspace");
constexpr int CW_BAR = 4096;
constexpr int RING_BYTES = 131072, LDSX_OFF = RING_BYTES;
constexpr int LDS_BYTES = 147456;
constexpr int LX_TILE = LDSX_OFF + 64, LX_MISC = LDSX_OFF + 2048, LX_EXCH = LDSX_OFF + 6144;

struct Args { const void* in[34]; float* out; unsigned char* ws; int ph_lo, ph_hi; };
struct Ctx { int tid, lane, wave, G, bid, vcu, gw, NGW; LAS unsigned char* lds; unsigned char* ws; };

__device__ __forceinline__ void conv_load(f32x4 (&v)[16], const float* __restrict__ W, int N, int n0, int k0, int lane) {
    const int n = n0 + 4 * (lane & 15); const float* p = W + (size_t)(k0 + 16 * (lane >> 4)) * N + n;
#pragma unroll
    for (int i = 0; i < 16; ++i) v[i] = (n < N) ? __builtin_nontemporal_load((const f32x4*)(p + (size_t)i * N)) : (f32x4){0.f, 0.f, 0.f, 0.f};
}
__device__ __forceinline__ int conv_row(int c, int perm) { if (perm == 1) { const int h = c / 96, d = c % 96; return d < 64 ? 64 * h + d : 512 + 32 * h + d - 64; } if (perm == 2) { const int h = c >> 7, d = c & 127; return d < 64 ? 64 * h + d : 512 + 64 * h + d - 64; } return c; }
__device__ __forceinline__ void conv_emit(const f32x4 (&v)[16], LAS unsigned char* T  , bf16_t* __restrict__ WT, int ldd, int n0, int k0, int lane, int perm) {
    const int kq = lane >> 4, c4 = lane & 15;
#pragma unroll
    for (int jj = 0; jj < 4; ++jj) { u32x4 lo, hi;
        lo.x = cvt_pk_bf16(v[0][jj], v[1][jj]); lo.y = cvt_pk_bf16(v[2][jj], v[3][jj]); lo.z = cvt_pk_bf16(v[4][jj], v[5][jj]); lo.w = cvt_pk_bf16(v[6][jj], v[7][jj]);
        hi.x = cvt_pk_bf16(v[8][jj], v[9][jj]); hi.y = cvt_pk_bf16(v[10][jj], v[11][jj]); hi.z = cvt_pk_bf16(v[12][jj], v[13][jj]); hi.w = cvt_pk_bf16(v[14][jj], v[15][jj]);
        LAS unsigned char* q = T + (4 * c4 + jj) * 144 + 32 * kq; *(LAS u32x4*)q = lo; *(LAS u32x4*)(q + 16) = hi; }
    asm volatile("s_waitcnt lgkmcnt(0)" ::: "memory");
#pragma unroll
    for (int s8 = 0; s8 < 8; ++s8) { const int n = 8 * s8 + (lane >> 3), ch = lane & 7; const u32x4 w = *(const LAS u32x4*)(T + n * 144 + 16 * ch);
        *(u32x4*)(WT + (size_t)conv_row(n0 + n, perm) * ldd + k0 + 8 * ch) = w; }
    asm volatile("s_waitcnt lgkmcnt(0)" ::: "memory");
}
__device__ __forceinline__ void conv8_tile(const float* __restrict__ W, int N, unsigned char* __restrict__ WT, int ldd, int n0, int k0, LAS unsigned char* T  , int lane) {
    const int kq = lane >> 4, c4 = lane & 15; const float* p = W + (size_t)(k0 + 32 * kq) * N + n0 + 4 * c4;
    f32x4 v[32];
#pragma unroll
    for (int i = 0; i < 32; ++i) v[i] = __builtin_nontemporal_load((const f32x4*)(p + (size_t)i * N));
#pragma unroll
    for (int jj = 0; jj < 4; ++jj) { u32x4 lo, hi;
        lo.x = pk4_fp8(32.f * v[0][jj], 32.f * v[1][jj], 32.f * v[2][jj], 32.f * v[3][jj]);     lo.y = pk4_fp8(32.f * v[4][jj], 32.f * v[5][jj], 32.f * v[6][jj], 32.f * v[7][jj]);
        lo.z = pk4_fp8(32.f * v[8][jj], 32.f * v[9][jj], 32.f * v[10][jj], 32.f * v[11][jj]);   lo.w = pk4_fp8(32.f * v[12][jj], 32.f * v[13][jj], 32.f * v[14][jj], 32.f * v[15][jj]);
        hi.x = pk4_fp8(32.f * v[16][jj], 32.f * v[17][jj], 32.f * v[18][jj], 32.f * v[19][jj]); hi.y = pk4_fp8(32.f * v[20][jj], 32.f * v[21][jj], 32.f * v[22][jj], 32.f * v[23][jj]);
        hi.z = pk4_fp8(32.f * v[24][jj], 32.f * v[25][jj], 32.f * v[26][jj], 32.f * v[27][jj]); hi.w = pk4_fp8(32.f * v[28][jj], 32.f * v[29][jj], 32.f * v[30][jj], 32.f * v[31][jj]);
        LAS unsigned char* q = T + (4 * c4 + jj) * 144 + 32 * kq; *(LAS u32x4*)q = lo; *(LAS u32x4*)(q + 16) = hi; }
    asm volatile("s_waitcnt lgkmcnt(0)" ::: "memory");
#pragma unroll
    for (int s8 = 0; s8 < 8; ++s8) { const int n = 8 * s8 + (lane >> 3), ch = lane & 7; const u32x4 w = *(const LAS u32x4*)(T + n * 144 + 16 * ch);
        *(u32x4*)(WT + (size_t)(n0 + n) * ldd + k0 + 16 * ch) = w; }
    asm volatile("s_waitcnt lgkmcnt(0)" ::: "memory");
}
template <class AP> __device__ __forceinline__ void p0_prologue(const Ctx& C, AP a) {
    unsigned char* ws = C.ws;
    { const float* c = (const float*)a->in[1]; const float* ada_w = (const float*)a->in[3]; const float* ada_b = (const float*)a->in[4]; float* mod = (float*)(ws + O_MOD);
      LAS float* part = (LAS float*)C.lds;
      LAS float* cact = (LAS float*)(C.lds + 32768);
      if (C.bid < 4 * 24) { for (int i = C.tid; i < 4096; i += 512) { const int b = i >> 10, k = i & 1023; const float cv = c[i]; cact[k * 4 + b] = cv / (1.f + expf(-cv)); } __syncthreads(); }
      for (int it = C.bid; it < 4 * 24; it += C.G) { const int l = it / 24, n0 = (it % 24) * 256;
          f32x4 acc[4];
#pragma unroll
          for (int b = 0; b < 4; ++b) acc[b] = (f32x4){0.f, 0.f, 0.f, 0.f};
          const float* w = ada_w + (size_t)l * 1024 * 6144 + n0 + 4 * C.lane;
#pragma unroll 1
          for (int k0 = C.wave * 128; k0 < C.wave * 128 + 128; k0 += 16) { f32x4 wv[16];
#pragma unroll
              for (int i = 0; i < 16; ++i) wv[i] = __builtin_nontemporal_load((const f32x4*)(w + (size_t)(k0 + i) * 6144));
#pragma unroll
              for (int i = 0; i < 16; ++i) { const f32x4 sv = *(const LAS f32x4*)(cact + (k0 + i) * 4);
#pragma unroll
                  for (int b = 0; b < 4; ++b) acc[b] = acc[b] + sv[b] * wv[i]; } }
#pragma unroll
          for (int b = 0; b < 4; ++b) *(LAS f32x4*)(part + (C.wave * 4 + b) * 256 + 4 * C.lane) = acc[b];
          __syncthreads();
          for (int o = C.tid; o < 1024; o += 512) { const int b = o >> 8, n = o & 255; float sacc = ada_b[l * 6144 + n0 + n];
#pragma unroll
              for (int w8 = 0; w8 < 8; ++w8) sacc += part[(w8 * 4 + b) * 256 + n];
              mod[((size_t)l * 4 + b) * 6144 + n0 + n] = sacc; }
          __syncthreads(); } }
    { const int* positions = (const int*)a->in[2]; float* cs = (float*)(ws + O_CS);
      for (int i = C.bid * 512 + C.tid; i < T_ * 16; i += C.G * 512) { const int t = i >> 4, f = i & 15; const float inv = powf(10000.f, -(float)(2 * f) / 32.f); const float ang = (float)positions[t] * inv;
          cs[t * 32 + f] = cosf(ang); cs[t * 32 + 16 + f] = sinf(ang); } }
    { const float* lam = (const float*)a->in[25]; float* spv = (float*)(ws + O_SPV);
      for (int i = C.bid * 512 + C.tid; i < 2048; i += C.G * 512) spv[i] = -8.f * 1.4426950408889634f * log1pf(expf(-lam[i])); }
    { const int lane = C.lane; LAS unsigned char* T = C.lds + 49152 + C.wave * 9216;
      const float* attn_w_in = (const float*)a->in[7]; const float* w_uq = (const float*)a->in[12]; const float* w_ukv = (const float*)a->in[13]; const float* attn_w_out = (const float*)a->in[16];
      const float* rec_w_in = (const float*)a->in[17]; const float* rec_wa = (const float*)a->in[21]; const float* rec_wx = (const float*)a->in[23]; const float* rec_w_out = (const float*)a->in[26];
      const float* w1 = (const float*)a->in[30]; const float* w2 = (const float*)a->in[32];
      constexpr int T_WIN = 32 * 16, T_WUQ = 12 * 4, T_WUKV = 16 * 2, T_WOUT = 16 * 16, T_RWIN = 32 * 16, T_RG = 2 * 2, T_RWOUT = 16 * 16, T_W1 = 32 * 16, T_W2 = 16 * 16;
      constexpr int NITEMS = 2 * (T_WIN + T_WUQ + T_WUKV + T_WOUT + T_RWIN + 16 * T_RG + T_RWOUT);
      struct Job { const float* W; bf16_t* WT; int N, ldd, n0, k0, perm; };
      auto decode = [&](int r, Job& jb) {
#define CONV_JOB(SRC, KK, NN, DST, NROWS, NMAT, SRC_MS, DST_MS, PERM) { constexpr int kc_ = (KK) / 64, per_ = ((NROWS) / 64) * kc_, tot_ = per_ * (NMAT); \
          if (r < tot_) { const int mat_ = r / per_, q_ = r % per_; jb.W = (SRC) + (size_t)mat_ * (SRC_MS); jb.WT = (bf16_t*)(ws + (DST) + (size_t)mat_ * (DST_MS)); jb.N = (NN); jb.ldd = (KK); jb.n0 = (q_ / kc_) * 64; jb.k0 = (q_ % kc_) * 64; jb.perm = (PERM); return; } r -= tot_; }
          CONV_JOB(attn_w_in, 1024, 1952, O_WIN, 2048, 2, (size_t)1024 * 1952, SZ_WIN, 0)
          CONV_JOB(w_uq, 256, 768, O_WUQ, 768, 2, (size_t)256 * 768, SZ_WUQ, 1)
          CONV_JOB(w_ukv, 128, 1024, O_WUKV, 1024, 2, (size_t)128 * 1024, SZ_WUKV, 2)
          CONV_JOB(attn_w_out, 1024, 1024, O_WOUT, 1024, 2, (size_t)1024 * 1024, SZ_WOUT, 0)
          CONV_JOB(rec_w_in, 1024, 2048, O_RWIN, 2048, 2, (size_t)1024 * 2048, SZ_RWIN, 0)
          CONV_JOB(rec_wa, 128, 128, O_RGATE, 128, 16, (size_t)128 * 128, (size_t)256 * 128 * 2, 0)
          CONV_JOB(rec_wx, 128, 128, O_RGATE + (size_t)128 * 128 * 2, 128, 16, (size_t)128 * 128, (size_t)256 * 128 * 2, 0)
          CONV_JOB(rec_w_out, 1024, 1024, O_RWOUT, 1024, 2, (size_t)1024 * 1024, SZ_RWOUT, 0)
#undef CONV_JOB
          jb.W = attn_w_in; jb.WT = (bf16_t*)(ws + O_WIN); jb.N = 1952; jb.ldd = 1024; jb.n0 = 0; jb.k0 = 0; jb.perm = 0; };
      f32x4 va[16], vb[16]; Job ja, jn;
      int it = C.gw;
      if (it < NITEMS) { decode(it, ja); conv_load(va, ja.W, ja.N, ja.n0, ja.k0, lane); }
#pragma unroll 1
      for (; it < NITEMS; it += 2 * C.NGW) {
          const bool h1 = it + C.NGW < NITEMS;
          if (h1) { decode(it + C.NGW, jn); conv_load(vb, jn.W, jn.N, jn.n0, jn.k0, lane); }
          conv_emit(va, T, ja.WT, ja.ldd, ja.n0, ja.k0, lane, ja.perm);
          const bool h2 = it + 2 * C.NGW < NITEMS;
          if (h2) { decode(it + 2 * C.NGW, ja); conv_load(va, ja.W, ja.N, ja.n0, ja.k0, lane); }
          if (h1) conv_emit(vb, T, jn.WT, jn.ldd, jn.n0, jn.k0, lane, jn.perm);
      }
      { constexpr int I1 = 32 * 8, I2 = 16 * 8, N8 = 128 * I1 + 128 * I2;
#pragma unroll 1
        for (int i8 = C.gw; i8 < N8; i8 += C.NGW) {
            const float* W; unsigned char* WT; int N, q;
            if (i8 < 128 * I1) { const int mat = i8 / I1; q = i8 % I1; W = w1 + (size_t)mat * 1024 * 2048; WT = ws + O_W1 + (size_t)mat * SZ_W1E; N = 2048; }
            else { const int r = i8 - 128 * I1, mat = r / I2; q = r % I2; W = w2 + (size_t)mat * 1024 * 1024; WT = ws + O_W2 + (size_t)mat * SZ_W2E; N = 1024; }
            conv8_tile(W, N, WT, 1024, (q >> 3) * 64, (q & 7) * 128, T, lane); } }
    }
}

__device__ __forceinline__ void phase_norm(const Ctx& C, const float* xin  , float* out  , bool combine, bool do_norm, const float* gain, const float* modc  , const float* modl  , int shoff, int scoff, bool dummy = false) {
    const bf16_t* Y2 = (const bf16_t*)(C.ws + O_Y2); const int* pos = (const int*)(C.ws + O_POS); const float* topg = (const float*)(C.ws + O_TOPG); bf16_t* HN = (bf16_t*)(C.ws + (dummy ? O_DUMMY : O_HN)); const bf16_t* X = (const bf16_t*)(C.ws + O_X); bf16_t* Xo = (bf16_t*)(C.ws + (dummy ? O_DUMMY + 32 * MiB : O_X));
    const int lane = C.lane;
    for (int t = C.gw; t < T_; t += C.NGW) { const int b = t / S_;
        f32x4 v[4];
        if (xin) {
#pragma unroll
            for (int j = 0; j < 4; ++j) v[j] = *(const f32x4*)(xin + (size_t)t * 1024 + 256 * j + 4 * lane); }
        else {
#pragma unroll
            for (int j = 0; j < 4; ++j) { const u32x2 w = *(const u32x2*)(X + (size_t)t * 1024 + 256 * j + 4 * lane); v[j] = (f32x4){bf_lo(w.x), bf_hi(w.x), bf_lo(w.y), bf_hi(w.y)}; } }
        if (combine) { f32x4 y[4];
#pragma unroll
            for (int j = 0; j < 4; ++j) y[j] = (f32x4){0.f, 0.f, 0.f, 0.f};
#pragma unroll
            for (int k = 0; k < 4; ++k) { const int p = pos[t * 4 + k]; const float gk = topg[t * 4 + k];
#pragma unroll
                for (int j = 0; j < 4; ++j) { const u32x2 w = *(const u32x2*)(Y2 + (size_t)p * 1024 + 256 * j + 4 * lane);
                    y[j][0] += gk * bf_lo(w.x); y[j][1] += gk * bf_hi(w.x); y[j][2] += gk * bf_lo(w.y); y[j][3] += gk * bf_hi(w.y); } }
#pragma unroll
            for (int j = 0; j < 4; ++j) { const f32x4 g2 = *(const f32x4*)(modc + b * 6144 + 5120 + 256 * j + 4 * lane); v[j] = v[j] + g2 * y[j]; } }
        if (out) {
#pragma unroll
            for (int j = 0; j < 4; ++j) *(f32x4*)(out + (size_t)t * 1024 + 256 * j + 4 * lane) = v[j]; }
        else {
#pragma unroll
            for (int j = 0; j < 4; ++j) { u32x2 w; w.x = cvt_pk_bf16(v[j][0], v[j][1]); w.y = cvt_pk_bf16(v[j][2], v[j][3]); *(u32x2*)(Xo + (size_t)t * 1024 + 256 * j + 4 * lane) = w; } }
        if (do_norm) { float ss = 0.f;
#pragma unroll
            for (int j = 0; j < 4; ++j) ss += (v[j][0] * v[j][0] + v[j][1] * v[j][1]) + (v[j][2] * v[j][2] + v[j][3] * v[j][3]);
            const float rs = rsqrtf(wsum(ss) * (1.f / 1024.f) + 1e-6f);
#pragma unroll
            for (int j = 0; j < 4; ++j) { const int col = 256 * j + 4 * lane; const f32x4 gn = *(const f32x4*)(gain + col), sc = *(const f32x4*)(modl + b * 6144 + scoff + col), sh = *(const f32x4*)(modl + b * 6144 + shoff + col);
                const f32x4 h = v[j] * rs * gn * (1.f + sc) + sh;
                u32x2 w; w.x = cvt_pk_bf16(h[0], h[1]); w.y = cvt_pk_bf16(h[2], h[3]); *(u32x2*)(HN + (size_t)t * 1024 + col) = w; } }
    }
}

__device__ __forceinline__ void unpack8(const u32x4 w, float (&f)[8]) { f[0] = bf_lo(w.x); f[1] = bf_hi(w.x); f[2] = bf_lo(w.y); f[3] = bf_hi(w.y); f[4] = bf_lo(w.z); f[5] = bf_hi(w.z); f[6] = bf_lo(w.w); f[7] = bf_hi(w.w); }
__device__ __forceinline__ u32x4 pack8(const float (&f)[8]) { u32x4 w; w.x = cvt_pk_bf16(f[0], f[1]); w.y = cvt_pk_bf16(f[2], f[3]); w.z = cvt_pk_bf16(f[4], f[5]); w.w = cvt_pk_bf16(f[6], f[7]); return w; }

constexpr float LOG2E = 1.4426950408889634f;
__device__ __forceinline__ void phase_postproj(const Ctx& C, const float* qg, const float* kg, const float* qag, const float* kvag, const float* mkg) {
    bf16_t* PROJ = (bf16_t*)(C.ws + O_PROJ); const float* cs = (const float*)(C.ws + O_CS); const int lane = C.lane;
    for (int t = C.gw; t < T_; t += C.NGW) { bf16_t* row = PROJ + (size_t)t * 2048;
#pragma unroll
        for (int ps = 0; ps < 2; ++ps) { bf16_t* p = row + ps * 512 + 8 * lane; float f[8]; unpack8(*(const u32x4*)p, f); float ss = 0.f;
#pragma unroll
            for (int i = 0; i < 8; ++i) ss += f[i] * f[i];
            ss += shx<1>(ss); ss += shx<2>(ss); ss += shx<4>(ss);
            const float rs = rsqrtf(ss * (1.f / 64.f) + 1e-6f) * (ps == 0 ? 0.125f * LOG2E : 1.f); const float* g = (ps == 0 ? qg : kg) + 8 * (lane & 7);
#pragma unroll
            for (int i = 0; i < 8; ++i) f[i] = f[i] * rs * g[i];
            *(u32x4*)p = pack8(f); }
        { bf16_t* p = row + 1536 + 8 * lane; float f[8]; unpack8(*(const u32x4*)p, f); float ss = 0.f;
#pragma unroll
            for (int i = 0; i < 8; ++i) ss += f[i] * f[i];
            ss += shx<1>(ss); ss += shx<2>(ss);
            { const float o4 = shx<4>(ss); if (lane < 48) ss += o4; } { const float o8 = shx<8>(ss); if (lane < 48) ss += o8; } { const float o16 = shx<16>(ss); if (lane < 32) ss += o16; }
            const float nrm = lane < 32 ? 256.f : (lane < 48 ? 128.f : 32.f);
            const float rs = rsqrtf(ss / nrm + 1e-6f);
            const float* g = lane < 32 ? (qag + 8 * lane) : (lane < 48 ? (kvag + 8 * (lane - 32)) : (mkg + 64 + 8 * ((lane - 48) & 3)));
#pragma unroll
            for (int i = 0; i < 8; ++i) f[i] = f[i] * rs * g[i];
            float o[8];
#pragma unroll
            for (int i = 0; i < 8; ++i) { const float other = shx<2>(f[i]); const int fi = ((lane & 1) << 3) + i; const float cv = cs[t * 32 + fi], sv = cs[t * 32 + 16 + fi];
                o[i] = (lane & 2) ? (other * sv + f[i] * cv) : (f[i] * cv - other * sv); }
            if (lane >= 48 && lane < 52) {
#pragma unroll
                for (int i = 0; i < 8; ++i) f[i] = o[i]; }
            if (lane < 52) *(u32x4*)p = pack8(f); }
    }
}
__device__ __forceinline__ void phase_postq(const Ctx& C, const float* mqg, const float* mkg) {
    bf16_t* Q2 = (bf16_t*)(C.ws + O_Q2); bf16_t* KV2 = (bf16_t*)(C.ws + O_KV2); const float* cs = (const float*)(C.ws + O_CS); const int lane = C.lane;
    const float qscale = 0.10206207261596575f * LOG2E;
    for (int t = C.gw; t < T_; t += C.NGW) {
        { bf16_t* p = Q2 + (size_t)t * 768 + (lane >> 3) * 96 + 8 * (lane & 7); float f[8]; unpack8(*(const u32x4*)p, f); float ss = 0.f;
#pragma unroll
            for (int i = 0; i < 8; ++i) ss += f[i] * f[i];
            ss += shx<1>(ss); ss += shx<2>(ss); ss += shx<4>(ss);
            const float rs = rsqrtf(ss * (1.f / 64.f) + 1e-6f) * qscale; const float* g = mqg + 8 * (lane & 7);
#pragma unroll
            for (int i = 0; i < 8; ++i) f[i] = f[i] * rs * g[i];
            *(u32x4*)p = pack8(f); }
        { const int l2 = lane & 31; bf16_t* p = Q2 + (size_t)t * 768 + (l2 >> 2) * 96 + 64 + 8 * (l2 & 3); float f[8]; unpack8(*(const u32x4*)p, f); float ss = 0.f;
#pragma unroll
            for (int i = 0; i < 8; ++i) ss += f[i] * f[i];
            ss += shx<1>(ss); ss += shx<2>(ss);
            const float rs = rsqrtf(ss * (1.f / 32.f) + 1e-6f) * qscale; const float* g = mqg + 64 + 8 * (l2 & 3);
#pragma unroll
            for (int i = 0; i < 8; ++i) f[i] = f[i] * rs * g[i];
            float o[8];
#pragma unroll
            for (int i = 0; i < 8; ++i) { const float other = shx<2>(f[i]); const int fi = ((lane & 1) << 3) + i; const float cv = cs[t * 32 + fi], sv = cs[t * 32 + 16 + fi];
                o[i] = (lane & 2) ? (other * sv + f[i] * cv) : (f[i] * cv - other * sv); }
            if (lane < 32) *(u32x4*)p = pack8(o); }
        { bf16_t* p = KV2 + (size_t)t * 1024 + (lane >> 3) * 128 + 8 * (lane & 7); float f[8]; unpack8(*(const u32x4*)p, f); float ss = 0.f;
#pragma unroll
            for (int i = 0; i < 8; ++i) ss += f[i] * f[i];
            ss += shx<1>(ss); ss += shx<2>(ss); ss += shx<4>(ss);
            const float rs = rsqrtf(ss * (1.f / 64.f) + 1e-6f); const float* g = mkg + 8 * (lane & 7);
#pragma unroll
            for (int i = 0; i < 8; ++i) f[i] = f[i] * rs * g[i];
            *(u32x4*)p = pack8(f); }
    }
}
__device__ __forceinline__ void phase_mixcombine(const Ctx& C) {
    const bf16_t* OA = (const bf16_t*)(C.ws + O_OA); const float* LSE = (const float*)(C.ws + O_LSE); bf16_t* ATT = (bf16_t*)(C.ws + O_ATT); const int lane = C.lane;
    for (int t = C.gw; t < T_; t += C.NGW) { const int h = lane >> 3;
        float ls[3], mx = -INFINITY;
#pragma unroll
        for (int p = 0; p < 3; ++p) { ls[p] = LSE[((size_t)p * T_ + t) * 8 + h]; mx = fmaxf(mx, ls[p]); }
        float w[3], den = 0.f;
#pragma unroll
        for (int p = 0; p < 3; ++p) { w[p] = fexp2(ls[p] - mx); den += w[p]; }
        const float inv = 1.f / den; float o[8];
#pragma unroll
        for (int i = 0; i < 8; ++i) o[i] = 0.f;
#pragma unroll
        for (int p = 0; p < 3; ++p) { float f[8]; unpack8(*(const u32x4*)(OA + ((size_t)p * T_ + t) * 512 + 8 * lane), f); const float wp = w[p] * inv;
#pragma unroll
            for (int i = 0; i < 8; ++i) o[i] += wp * f[i]; }
        *(u32x4*)(ATT + (size_t)t * 1024 + 8 * lane) = pack8(o); }
}
__device__ __forceinline__ void phase_conv(const Ctx& C, const float* cw, const float* cb) {
    const bf16_t* PROJ = (const bf16_t*)(C.ws + O_PROJ); bf16_t* XC = (bf16_t*)(C.ws + O_XC); const int lane = C.lane;
    for (int t = C.gw; t < T_; t += C.NGW) { const int ts = t % S_;
#pragma unroll
        for (int ps = 0; ps < 2; ++ps) { const int c0 = ps * 512 + 8 * lane; float acc[8];
            { const f32x4 b0 = *(const f32x4*)(cb + c0), b1 = *(const f32x4*)(cb + c0 + 4); acc[0] = b0[0]; acc[1] = b0[1]; acc[2] = b0[2]; acc[3] = b0[3]; acc[4] = b1[0]; acc[5] = b1[1]; acc[6] = b1[2]; acc[7] = b1[3]; }
#pragma unroll
            for (int k = 0; k < 4; ++k) { const int dt = k - 3; if (ts + dt >= 0) { float f[8]; unpack8(*(const u32x4*)(PROJ + (size_t)(t + dt) * 2048 + 1024 + c0), f);
                    const f32x4 w0 = *(const f32x4*)(cw + k * 1024 + c0), w1 = *(const f32x4*)(cw + k * 1024 + c0 + 4);
                    acc[0] += w0[0] * f[0]; acc[1] += w0[1] * f[1]; acc[2] += w0[2] * f[2]; acc[3] += w0[3] * f[3]; acc[4] += w1[0] * f[4]; acc[5] += w1[1] * f[5]; acc[6] += w1[2] * f[6]; acc[7] += w1[3] * f[7]; } }
            *(u32x4*)(XC + (size_t)t * 1024 + c0) = pack8(acc); } }
}
__device__ __forceinline__ void scan_sum_item(const Ctx& C, int b, int ck, int cg) {
    const bf16_t* LA = (const bf16_t*)(C.ws + O_AA); const bf16_t* Bb = (const bf16_t*)(C.ws + O_BB); float* SP = (float*)(C.ws + O_SUMP); float* SH = (float*)(C.ws + O_SUMH);
    const int ch = cg * 128 + 2 * C.lane;
    size_t off = ((size_t)b * S_ + ck * 64) * 1024 + ch; f32x2 Pl = (f32x2){0.f, 0.f}, Hh = (f32x2){0.f, 0.f};
#pragma unroll 8
    for (int s = 0; s < 64; ++s, off += 1024) { const unsigned lw = *(const unsigned*)(LA + off), bw = *(const unsigned*)(Bb + off);
        const f32x2 lv = (f32x2){bf_lo(lw), bf_hi(lw)}, av = (f32x2){fexp2(lv[0]), fexp2(lv[1])}, bv = (f32x2){bf_lo(bw), bf_hi(bw)}; Hh = av * Hh + bv; Pl = Pl + lv; }
    *(f32x2*)(SP + ((size_t)b * 64 + ck) * 1024 + ch) = (f32x2){fexp2(Pl[0]), fexp2(Pl[1])}; *(f32x2*)(SH + ((size_t)b * 64 + ck) * 1024 + ch) = Hh;
}
__device__ __forceinline__ void phase_scan_sum_own(const Ctx& C) {
    asm volatile("s_waitcnt vmcnt(0)" ::: "memory"); __syncthreads();
    for (int i = 0; ; ++i) { const int L = i * C.G + C.bid; if (L >= 512) break; const int pm = L >> 3, n = L & 7;
        if (C.wave < 4) { const int row0 = pm * 256 + C.wave * 64; scan_sum_item(C, row0 / S_, (row0 % S_) >> 6, n); } }
}
__device__ __forceinline__ void phase_scan_apply(const Ctx& C) {
    const bf16_t* LA = (const bf16_t*)(C.ws + O_AA); const bf16_t* Bb = (const bf16_t*)(C.ws + O_BB); const float* SP = (const float*)(C.ws + O_SUMP); const float* SH = (const float*)(C.ws + O_SUMH);
    const bf16_t* PROJ = (const bf16_t*)(C.ws + O_PROJ); bf16_t* ATT = (bf16_t*)(C.ws + O_ATT); const int lane = C.lane;
    for (int it = C.gw; it < 4 * 64 * 8; it += C.NGW) { const int cg = it & 7, ck = (it >> 3) & 63, b = it >> 9; const int ch = cg * 128 + 2 * lane;
        f32x2 h = (f32x2){0.f, 0.f};
#pragma unroll 8
        for (int c2 = 0; c2 < ck; ++c2) { const f32x2 pv = *(const f32x2*)(SP + ((size_t)b * 64 + c2) * 1024 + ch), hv = *(const f32x2*)(SH + ((size_t)b * 64 + c2) * 1024 + ch); h = pv * h + hv; }
        size_t row = (size_t)b * S_ + ck * 64;
#pragma unroll 8
        for (int s = 0; s < 64; ++s, ++row) { const unsigned lw = *(const unsigned*)(LA + row * 1024 + ch), bw = *(const unsigned*)(Bb + row * 1024 + ch);
            const f32x2 av = (f32x2){fexp2(bf_lo(lw)), fexp2(bf_hi(lw))}, bv = (f32x2){bf_lo(bw), bf_hi(bw)}; h = av * h + bv;
            const unsigned gw2 = *(const unsigned*)(PROJ + row * 2048 + ch);
            *(unsigned*)(ATT + row * 1024 + ch) = cvt_pk_bf16(bf_lo(gw2) * h[0], bf_hi(gw2) * h[1]); } }
}

__device__ __forceinline__ void phase_router(const Ctx& C, const bf16_t* X, const float* gain, const float* modl, const float* wr, const float* br) {
    unsigned char* HN8 = C.ws + O_HN; int* topi = (int*)(C.ws + O_TOPI); float* topg = (float*)(C.ws + O_TOPG); int* hist = (int*)(C.ws + O_HIST);
    LAS float* hrow = (LAS float*)C.lds;
    LAS float* part = (LAS float*)(C.lds + 65536);
    LAS int* hl = (LAS int*)(C.lds + LX_MISC);
    const int lane = C.lane, e = lane & 31, kh = lane >> 5, v = C.wave;
    float wreg[64];
#pragma unroll
    for (int i = 0; i < 64; ++i) wreg[i] = wr[(128 * v + 64 * kh + i) * 32 + e];
    const float bias_e = br[e];
    if (C.tid < 32) hl[C.tid] = 0;
    __syncthreads();
    for (int ck = C.bid; ck < 256; ck += C.G) {
        const int b = (ck * 64) / S_;
        f32x4 gn[4], sc1[4], shv[4];
#pragma unroll
        for (int j = 0; j < 4; ++j) { const int col = 256 * j + 4 * lane; gn[j] = *(const f32x4*)(gain + col); sc1[j] = 1.f + *(const f32x4*)(modl + b * 6144 + 4096 + col); shv[j] = *(const f32x4*)(modl + b * 6144 + 3072 + col); gn[j] = gn[j] * sc1[j]; }
        u32x2 xr[2][4];
#pragma unroll
        for (int q = 0; q < 2; ++q)
#pragma unroll
            for (int j = 0; j < 4; ++j) xr[q][j] = *(const u32x2*)(X + (size_t)(ck * 64 + 2 * v + q) * 1024 + 256 * j + 4 * lane);
#pragma unroll 1
        for (int pass = 0; pass < 4; ++pass) { const int tb = ck * 64 + pass * 16;
#pragma unroll
            for (int q = 0; q < 2; ++q) { const int tt = 2 * v + q, t = tb + tt; f32x4 h[4]; float ss = 0.f;
#pragma unroll
                for (int j = 0; j < 4; ++j) { const u32x2 xw = xr[q][j]; h[j] = (f32x4){bf_lo(xw.x), bf_hi(xw.x), bf_lo(xw.y), bf_hi(xw.y)}; ss += (h[j][0] * h[j][0] + h[j][1] * h[j][1]) + (h[j][2] * h[j][2] + h[j][3] * h[j][3]); }
                const float rs = rsqrtf(wsum(ss) * (1.f / 1024.f) + 1e-6f);
#pragma unroll
                for (int j = 0; j < 4; ++j) { const int col = 256 * j + 4 * lane;
                    const f32x4 hv = h[j] * rs * gn[j] + shv[j];
                    *(unsigned*)(HN8 + (size_t)t * 1024 + col) = pk4_fp8(hv[0], hv[1], hv[2], hv[3]);
                    *(LAS f32x4*)(hrow + tt * 1024 + col) = hv; } }
            if (pass < 3) {
#pragma unroll
                for (int q = 0; q < 2; ++q)
#pragma unroll
                    for (int j = 0; j < 4; ++j) xr[q][j] = *(const u32x2*)(X + (size_t)(tb + 16 + 2 * v + q) * 1024 + 256 * j + 4 * lane); }
            __syncthreads();
#pragma unroll 2
            for (int tt = 0; tt < 16; ++tt) { float s0 = 0.f, s1 = 0.f; const LAS float* hp = hrow + tt * 1024 + 128 * v + 64 * kh;
#pragma unroll
                for (int i4 = 0; i4 < 16; ++i4) { const f32x4 hv = *(const LAS f32x4*)(hp + 4 * i4); s0 += hv[0] * wreg[4 * i4] + hv[1] * wreg[4 * i4 + 1]; s1 += hv[2] * wreg[4 * i4 + 2] + hv[3] * wreg[4 * i4 + 3]; }
                float s = xadd32(s0 + s1);
                if (lane < 32) part[(tt * 8 + v) * 32 + e] = s; }
            __syncthreads();
            { const int tt = 2 * v + kh; float lg = bias_e;
#pragma unroll
              for (int w8 = 0; w8 < 8; ++w8) lg += part[(tt * 8 + w8) * 32 + e];
              int idx[4]; float val[4];
#pragma unroll
              for (int k = 0; k < 4; ++k) { float mx = lg;
                  mx = fmaxf(mx, shx<1>(mx)); mx = fmaxf(mx, shx<2>(mx)); mx = fmaxf(mx, shx<4>(mx)); mx = fmaxf(mx, shx<8>(mx)); mx = fmaxf(mx, shx<16>(mx));
                  const unsigned long long bal = __ballot(lg == mx); const unsigned bh = (unsigned)(bal >> (32 * kh)); const int sel = __ffs((int)bh) - 1;
                  idx[k] = sel; val[k] = mx; if (e == sel) lg = -INFINITY; }
              if (e == 0) { const int t = tb + tt; float ex[4], den = 0.f;
#pragma unroll
                  for (int k = 0; k < 4; ++k) { ex[k] = expf(val[k] - val[0]); den += ex[k]; }
#pragma unroll
                  for (int k = 0; k < 4; ++k) { topi[t * 4 + k] = idx[k]; topg[t * 4 + k] = ex[k] / den; __hip_atomic_fetch_add(hl + idx[k], 1, __ATOMIC_RELAXED, __HIP_MEMORY_SCOPE_WORKGROUP); } } }
        }
        __syncthreads();
        if (C.tid < 32) { hist[ck * 32 + C.tid] = hl[C.tid]; hl[C.tid] = 0; }
        __syncthreads();
    }
}
__device__ __forceinline__ void moe_plan_lds(const Ctx& C) {
    const int* hist = (const int*)(C.ws + O_HIST);
    LAS int* tot = (LAS int*)(C.lds + LX_MISC + 256); LAS int* pst = tot + 32; LAS int* tile_e = (LAS int*)(C.lds + LX_TILE); LAS int* ntp = (LAS int*)(C.lds + LX_MISC + 128); LAS int* part = (LAS int*)(C.lds + LX_MISC + 1024);
    __syncthreads();
    { const int e = C.tid & 31, g = C.tid >> 5; int sacc = 0;
#pragma unroll
      for (int i = 0; i < 16; ++i) sacc += hist[(g * 16 + i) * 32 + e];
      part[g * 32 + e] = sacc; }
    __syncthreads();
    if (C.tid < 32) { int sacc = 0;
#pragma unroll
        for (int g = 0; g < 16; ++g) sacc += part[g * 32 + C.tid];
        tot[C.tid] = sacc; }
    __syncthreads();
    if (C.tid == 0) { int acc = 0, ti = 0; for (int e = 0; e < 32; ++e) { pst[e] = acc; const int nt = (tot[e] + 255) >> 8; for (int i = 0; i < nt; ++i) tile_e[ti++] = e; acc += nt << 8; } ntp[0] = ti; }
    __syncthreads();
}
__device__ __forceinline__ void phase_scatter(const Ctx& C) {
    const int* hist = (const int*)(C.ws + O_HIST); const int* topi = (const int*)(C.ws + O_TOPI); int* pos = (int*)(C.ws + O_POS);
    const unsigned char* HN8 = C.ws + O_HN; unsigned char* XG8 = C.ws + O_XG;
    moe_plan_lds(C);
    LAS int* pst = (LAS int*)(C.lds + LX_MISC + 384); LAS int* base = (LAS int*)(C.lds + LX_MISC + 512); LAS int* part = (LAS int*)(C.lds + LX_MISC + 1024); LAS int* pl = (LAS int*)C.lds;
    for (int ck = C.bid; ck < 256; ck += C.G) {
        if (C.tid < 32) { int sacc = pst[C.tid]; const int g = ck >> 4; for (int g2 = 0; g2 < g; ++g2) sacc += part[g2 * 32 + C.tid]; for (int c2 = g * 16; c2 < ck; ++c2) sacc += hist[c2 * 32 + C.tid]; base[C.tid] = sacc; }
        __syncthreads();
        if (C.wave == 0) { int cnt[32];
#pragma unroll
            for (int e = 0; e < 32; ++e) cnt[e] = 0;
#pragma unroll 1
            for (int g = 0; g < 4; ++g) { const int my = topi[ck * 256 + g * 64 + C.lane]; int rank = 0;
#pragma unroll
                for (int e = 0; e < 32; ++e) { const unsigned long long m = __ballot(my == e);
                    const int below = (int)__builtin_amdgcn_mbcnt_hi((unsigned)(m >> 32), __builtin_amdgcn_mbcnt_lo((unsigned)m, 0u));
                    if (my == e) rank = cnt[e] + below; cnt[e] += __popcll(m); }
                const int p = base[my] + rank; pl[g * 64 + C.lane] = p; pos[ck * 256 + g * 64 + C.lane] = p; } }
        __syncthreads();
#pragma unroll 8
        for (int i = 0; i < 32; ++i) { const int pr = C.wave + 8 * i; const int t = ck * 64 + (pr >> 2); const int p = pl[pr];
            *(u32x4*)(XG8 + (size_t)p * 1024 + 16 * C.lane) = *(const u32x4*)(HN8 + (size_t)t * 1024 + 16 * C.lane); }
        __syncthreads();
    }
}
#ifndef ATT_DUP
#define ATT_DUP 1
#endif

__device__ __forceinline__ s16x4 tr16(LAS const unsigned char* p) { typedef short v4i16_t __attribute__((ext_vector_type(4))); return __builtin_bit_cast(s16x4, __builtin_amdgcn_ds_read_tr16_b64_v4i16((LAS v4i16_t*)p)); }

__device__ __forceinline__ float max3f(float a, float b, float c) { return fmaxf(fmaxf(a, b), c); }
#ifndef ATT_THR_V
#define ATT_THR_V 10.f
#endif
constexpr float ATT_THR = ATT_THR_V;
template <int KS, bool DIL>
__device__ __forceinline__ void att_tile(LAS const unsigned char* kb, LAS const unsigned char* vb, const bf16x8 (&qf)[KS], f32x16& o0, f32x16& o1, f32x16& negm, float& mref, float& l, int kidx0, int qidx, bool need_mask, int lane) {
    constexpr int KROW = KS * 32 + 16, VROW = 144;
    const int i32 = lane & 31, hi = lane >> 5;
    const int pr = (i32 & 0x13) | ((i32 & 4) << 1) | ((i32 & 8) >> 1);
    f32x16 p0, p1;
    LAS const unsigned char* kp = kb + pr * KROW + hi * 16;
#ifndef QK_DUP
#define QK_DUP 1
#endif
#pragma unroll 1
    for (int qd_ = 0; qd_ < QK_DUP; ++qd_) {
#pragma unroll
    for (int ks = 0; ks < KS; ++ks) {
        const bf16x8 k0f = *(LAS const bf16x8*)(kp + ks * 32), k1f = *(LAS const bf16x8*)(kp + 32 * KROW + ks * 32);
        if (ks == 0) { p0 = __builtin_amdgcn_mfma_f32_32x32x16_bf16(k0f, qf[0], negm, 0, 0, 0); p1 = __builtin_amdgcn_mfma_f32_32x32x16_bf16(k1f, qf[0], negm, 0, 0, 0); }
        else { p0 = __builtin_amdgcn_mfma_f32_32x32x16_bf16(k0f, qf[ks], p0, 0, 0, 0); p1 = __builtin_amdgcn_mfma_f32_32x32x16_bf16(k1f, qf[ks], p1, 0, 0, 0); }
    }
    asm volatile("" : "+v"(p0), "+v"(p1));
    }
    if (need_mask) {
#pragma unroll
        for (int r = 0; r < 16; ++r) { const int d0 = qidx - (kidx0 + 16 * (r >> 3) + 8 * hi + (r & 7)), d1 = d0 - 32;
            const bool v0 = DIL ? (d0 >= 0 && d0 <= 128) : (d0 >= 0), v1 = DIL ? (d1 >= 0 && d1 <= 128) : (d1 >= 0);
            p0[r] = v0 ? p0[r] : -INFINITY; p1[r] = v1 ? p1[r] : -INFINITY; } }
    float mx = max3f(p0[0], p0[1], p1[0]), mb = max3f(p0[2], p0[3], p1[1]); mx = max3f(mx, p1[2], p1[3]);
#pragma unroll
    for (int r = 4; r < 16; r += 4) { mx = max3f(mx, p0[r], p0[r + 1]); mb = max3f(mb, p0[r + 2], p0[r + 3]); mx = max3f(mx, p1[r], p1[r + 1]); mb = max3f(mb, p1[r + 2], p1[r + 3]); }
    mx = xmax32(fmaxf(mx, mb));
    if (__builtin_expect(__any(mx > ATT_THR), 0)) {
        const float dl = fmaxf(mx, 0.f), f = fexp2(-dl);
        mref += dl; l *= f;
#pragma unroll
        for (int r = 0; r < 16; ++r) { o0[r] *= f; o1[r] *= f; p0[r] -= dl; p1[r] -= dl; negm[r] = -mref; } }
    float ls0 = 0.f, ls1 = 0.f;
#pragma unroll
    for (int r = 0; r < 16; ++r) { p0[r] = fexp2(p0[r]); p1[r] = fexp2(p1[r]); ls0 += p0[r]; ls1 += p1[r]; }
    l += ls0 + ls1;
    u32x4 pw[2][2];
#pragma unroll
    for (int s = 0; s < 2; ++s) {
        pw[0][s].x = cvt_pk_bf16(p0[8 * s + 0], p0[8 * s + 1]); pw[0][s].y = cvt_pk_bf16(p0[8 * s + 2], p0[8 * s + 3]); pw[0][s].z = cvt_pk_bf16(p0[8 * s + 4], p0[8 * s + 5]); pw[0][s].w = cvt_pk_bf16(p0[8 * s + 6], p0[8 * s + 7]);
        pw[1][s].x = cvt_pk_bf16(p1[8 * s + 0], p1[8 * s + 1]); pw[1][s].y = cvt_pk_bf16(p1[8 * s + 2], p1[8 * s + 3]); pw[1][s].z = cvt_pk_bf16(p1[8 * s + 4], p1[8 * s + 5]); pw[1][s].w = cvt_pk_bf16(p1[8 * s + 6], p1[8 * s + 7]); }
    const int g = lane >> 4, i16 = lane & 15;
    LAS const unsigned char* vp = vb + (8 * (g >> 1) + (i16 >> 2)) * VROW + (16 * (g & 1) + 4 * (i16 & 3)) * 2;
#pragma unroll
    for (int sub = 0; sub < 2; ++sub)
#pragma unroll
        for (int s = 0; s < 2; ++s) { const bf16x8 pf = __builtin_bit_cast(bf16x8, pw[sub][s]);
#pragma unroll
            for (int db = 0; db < 2; ++db) { LAS const unsigned char* av = vp + (32 * sub + 16 * s) * VROW + 64 * db;
                const s16x4 lo = tr16(av), hh = tr16(av + 4 * VROW);
                const bf16x8 vf = (bf16x8){lo[0], lo[1], lo[2], lo[3], hh[0], hh[1], hh[2], hh[3]};
                if (db == 0) o0 = __builtin_amdgcn_mfma_f32_32x32x16_bf16(vf, pf, o0, 0, 0, 0); else o1 = __builtin_amdgcn_mfma_f32_32x32x16_bf16(vf, pf, o1, 0, 0, 0); } }
}
__device__ __forceinline__ void att_store(bf16_t* orow  , const f32x16& o0, const f32x16& o1, float inv, int hi) {
#pragma unroll
    for (int rr = 0; rr < 4; ++rr) { u32x2 w0, w1;
        w0.x = cvt_pk_bf16(o0[4 * rr] * inv, o0[4 * rr + 1] * inv); w0.y = cvt_pk_bf16(o0[4 * rr + 2] * inv, o0[4 * rr + 3] * inv);
        w1.x = cvt_pk_bf16(o1[4 * rr] * inv, o1[4 * rr + 1] * inv); w1.y = cvt_pk_bf16(o1[4 * rr + 2] * inv, o1[4 * rr + 3] * inv);
        *(u32x2*)(orow + 8 * rr + 4 * hi) = w0; *(u32x2*)(orow + 32 + 8 * rr + 4 * hi) = w1; }
}

__device__ __forceinline__ void mla_unit(const Ctx& C, int b, int h, int qb) {
    constexpr int KROW = 208, VROW = 144, KB = 64 * KROW, BUF = KB + 64 * VROW;
    const bf16_t* Q2 = (const bf16_t*)(C.ws + O_Q2); const bf16_t* KV2 = (const bf16_t*)(C.ws + O_KV2); const bf16_t* PROJ = (const bf16_t*)(C.ws + O_PROJ); bf16_t* ATT = (bf16_t*)(C.ws + O_ATT);
    const int tid = C.tid, lane = C.lane, w = C.wave, i32 = lane & 31, hi = lane >> 5;
    const int q0 = qb * 256; const size_t rowb = (size_t)b * S_;
    bf16x8 qf[6];
    { const bf16_t* qrow = Q2 + (rowb + q0 + 32 * w + i32) * 768 + 8 * hi;
#pragma unroll
      for (int ks = 0; ks < 4; ++ks) qf[ks] = *(const bf16x8*)(qrow + h * 64 + 16 * ks);
      qf[4] = *(const bf16x8*)(qrow + 512 + h * 32); qf[5] = *(const bf16x8*)(qrow + 512 + h * 32 + 16); }
    f32x16 o0, o1;
#pragma unroll
    for (int r = 0; r < 16; ++r) { o0[r] = 0.f; o1[r] = 0.f; }
    float m = 0.f, l = 0.f; f32x16 negm;
#pragma unroll
    for (int r = 0; r < 16; ++r) negm[r] = 0.f;
    const int NT = 4 * qb + 4, wmax = 4 * qb + (w >> 1);
    const int r8 = tid >> 3, c8 = tid & 7, r4 = (tid & 255) >> 2, c4 = tid & 3;
    const bf16_t* knp = KV2 + (rowb + r8) * 1024 + h * 64 + 8 * c8; const bf16_t* kpp = PROJ + (rowb + r4) * 2048 + 1920 + 8 * c4;
    u32x4 kA, vA, pA, kB, vB, pB, kC, vC, pC, kD, vD, pD, kE, vE, pE, kF, vF, pF;
#define MLA_LOAD(j, K, V, P) do { const int jc_ = ((j) < NT) ? (j) : NT - 1; K = *(const u32x4*)(knp + (size_t)jc_ * 64 * 1024); V = *(const u32x4*)(knp + (size_t)jc_ * 64 * 1024 + 512); P = *(const u32x4*)(kpp + (size_t)jc_ * 64 * 2048); } while (0)
#define MLA_WRITE(bo, K, V, P) do { *(LAS u32x4*)(C.lds + (bo) + r8 * KROW + 16 * c8) = K; *(LAS u32x4*)(C.lds + (bo) + KB + r8 * VROW + 16 * c8) = V; *(LAS u32x4*)(C.lds + (bo) + r4 * KROW + 128 + 16 * c4) = P; } while (0)
#define MLA_STEP(j, KF, VF, PF, KN, VN, PN) do { const int j_ = (j); const int bo_ = (j_ & 1) * BUF; \
        MLA_LOAD(j_ + 6, KF, VF, PF); \
        if (j_ <= wmax) { _Pragma("unroll 1") for (int dup_ = 0; dup_ < ATT_DUP; ++dup_) att_tile<6, false>(C.lds + bo_, C.lds + bo_ + KB, qf, o0, o1, negm, m, l, 64 * j_, q0 + 32 * w + i32, j_ == wmax, lane); } \
        MLA_WRITE(BUF - bo_, KN, VN, PN); \
        __syncthreads(); } while (0)
    MLA_LOAD(0, kA, vA, pA); MLA_LOAD(1, kB, vB, pB); MLA_LOAD(2, kC, vC, pC); MLA_LOAD(3, kD, vD, pD); MLA_LOAD(4, kE, vE, pE); MLA_LOAD(5, kF, vF, pF);
    MLA_WRITE(0, kA, vA, pA);
    __syncthreads();
#pragma unroll 1
    for (int j = 0; j < NT; j += 6) {
        MLA_STEP(j, kA, vA, pA, kB, vB, pB); MLA_STEP(j + 1, kB, vB, pB, kC, vC, pC); MLA_STEP(j + 2, kC, vC, pC, kD, vD, pD);
        MLA_STEP(j + 3, kD, vD, pD, kE, vE, pE); MLA_STEP(j + 4, kE, vE, pE, kF, vF, pF); MLA_STEP(j + 5, kF, vF, pF, kA, vA, pA); }
#undef MLA_STEP
#undef MLA_LOAD
#undef MLA_WRITE
    l = xadd32(l);
    att_store(ATT + (rowb + q0 + 32 * w + i32) * 1024 + 512 + h * 64, o0, o1, 1.f / l, hi);
}
__device__ __forceinline__ void dil_unit(const Ctx& C, int p, int dd, int b, int h, int res, int n) {
    constexpr int KROW = 144, VROW = 144, KB = 64 * KROW, BUF = KB + 64 * VROW;
    const bf16_t* PROJ = (const bf16_t*)(C.ws + O_PROJ); bf16_t* OA = (bf16_t*)(C.ws + O_OA) + (size_t)p * T_ * 512; float* LSE = (float*)(C.ws + O_LSE) + (size_t)p * T_ * 8;
    const int tid = C.tid, lane = C.lane, w = C.wave, i32 = lane & 31, hi = lane >> 5;
    const size_t rowb = (size_t)b * S_;
    const int qsub = 256 * n + 32 * w + i32; const size_t qtok = rowb + (size_t)qsub * dd + res;
    bf16x8 qf[4];
    { const bf16_t* qrow = PROJ + qtok * 2048 + h * 64 + 8 * hi;
#pragma unroll
      for (int ks = 0; ks < 4; ++ks) qf[ks] = *(const bf16x8*)(qrow + 16 * ks); }
    f32x16 o0, o1;
#pragma unroll
    for (int r = 0; r < 16; ++r) { o0[r] = 0.f; o1[r] = 0.f; }
    float m = 0.f, l = 0.f; f32x16 negm;
#pragma unroll
    for (int r = 0; r < 16; ++r) negm[r] = 0.f;
    const int jbeg = (n == 0) ? 2 : 0, wlo = w >> 1, whi = (32 * w + 159) >> 6;
    const int r8 = tid >> 3, c8 = tid & 7;
    u32x4 kA, vA, kB, vB, kC, vC, kD, vD, kE, vE, kF, vF;
    const int cnt = 6 - jbeg;
#define DIL_LOAD(i, K, V) do { const int jc_ = jbeg + (((i) < cnt) ? (i) : cnt - 1); const size_t tok = rowb + (size_t)(256 * n - 128 + 64 * jc_ + r8) * dd + res; const bf16_t* src = PROJ + tok * 2048 + 512 + h * 64 + 8 * c8; K = *(const u32x4*)src; V = *(const u32x4*)(src + 512); } while (0)
#define DIL_WRITE(bo, K, V) do { *(LAS u32x4*)(C.lds + (bo) + r8 * KROW + 16 * c8) = K; *(LAS u32x4*)(C.lds + (bo) + KB + r8 * VROW + 16 * c8) = V; } while (0)
#define DIL_STEP(i, KN, VN) do { const int i_ = (i); const int bo_ = (i_ & 1) * BUF, j_ = jbeg + i_; \
        if (i_ < cnt && j_ >= wlo && j_ <= whi) { const int kb0_ = 256 * n - 128 + 64 * j_, qlo_ = 256 * n + 32 * w; _Pragma("unroll 1") for (int dup_ = 0; dup_ < ATT_DUP; ++dup_) att_tile<4, true>(C.lds + bo_, C.lds + bo_ + KB, qf, o0, o1, negm, m, l, kb0_, qsub, !(kb0_ + 63 <= qlo_ && qlo_ + 31 - kb0_ <= 128), lane); } \
        DIL_WRITE(BUF - bo_, KN, VN); \
        __syncthreads(); } while (0)
    DIL_LOAD(0, kA, vA); DIL_LOAD(1, kB, vB); DIL_LOAD(2, kC, vC); DIL_LOAD(3, kD, vD); DIL_LOAD(4, kE, vE); DIL_LOAD(5, kF, vF);
    DIL_WRITE(0, kA, vA);
    __syncthreads();
    DIL_STEP(0, kB, vB); DIL_STEP(1, kC, vC); DIL_STEP(2, kD, vD); DIL_STEP(3, kE, vE);
    if (cnt == 6) { DIL_STEP(4, kF, vF); DIL_STEP(5, kF, vF); }
#undef DIL_STEP
#undef DIL_LOAD
#undef DIL_WRITE
    l = xadd32(l);
    att_store(OA + qtok * 512 + h * 64, o0, o1, 1.f / l, hi);
    if (hi == 0) LSE[qtok * 8 + h] = m + log2f(l);
}
#ifndef REP_MLA
#define REP_MLA 1
#endif
#ifndef REP_DIL
#define REP_DIL 1
#endif
__device__ __forceinline__ void phase_attention(const Ctx& C) {
#pragma unroll 1
    for (int rep = 0; rep < REP_MLA; ++rep) {
    if (C.G == 256) { const int bh = C.vcu >> 3, s = C.vcu & 7; mla_unit(C, bh >> 3, bh & 7, s); mla_unit(C, bh >> 3, bh & 7, 15 - s); }
    else for (int u = C.bid; u < 512; u += C.G) mla_unit(C, u >> 7, (u >> 4) & 7, u & 15);
    }
#pragma unroll 1
    for (int rep = 0; rep < REP_DIL; ++rep)
    for (int u = C.bid; u < 1536; u += C.G) { const int p = u >> 9, rem = u & 511, b = rem >> 7, h = (rem >> 4) & 7, blk = rem & 15;
        const int dd = (p == 0) ? 1 : (p == 1) ? 4 : 16, bpr = 16 / dd;
        dil_unit(C, p, dd, b, h, blk / bpr, blk % bpr); }
}

#ifdef TIME_NORM
constexpr int N_PHASES = 44;
#else
constexpr int N_PHASES = 42;
#endif
extern __shared__ __attribute__((aligned(16))) unsigned char lds_raw[];
typedef const __attribute__((address_space(4))) Args* ArgsP;
#define PHFN static __device__ __forceinline__ void
__device__ __forceinline__ ArgsP fresh_args() { unsigned long long p = (unsigned long long)__builtin_amdgcn_kernarg_segment_ptr(); asm volatile("" : "+s"(p)); return (ArgsP)p; }
__device__ __forceinline__ Ctx make_ctx(ArgsP ap, int wv) {
    Ctx C; C.lds = (LAS unsigned char*)lds_raw; C.ws = ap->ws;
    unsigned ones = ~0u; asm volatile("" : "+s"(ones)); const int lane = (int)__builtin_amdgcn_mbcnt_hi(ones, __builtin_amdgcn_mbcnt_lo(ones, 0u));
    int bid = blockIdx.x; asm volatile("" : "+s"(bid)); int G = gridDim.x; asm volatile("" : "+s"(G));
    C.wave = wv; C.lane = lane; C.tid = wv * 64 + lane;
    C.G = G; C.bid = bid; C.vcu = (C.G % 8 == 0) ? (C.bid % 8) * (C.G / 8) + C.bid / 8 : C.bid;
    C.gw = C.bid * 8 + C.wave; C.NGW = C.G * 8; return C;
}
#define IN(i) ((const float*)ap->in[i])
#define MODL(l) ((const float*)(C.ws + O_MOD) + (size_t)(l) * 4 * 6144)
PHFN ph_prologue(int wv) { const ArgsP ap = fresh_args(); const Ctx C = make_ctx(ap, wv); p0_prologue(C, ap); }
PHFN ph_norm(int wv, int l, int mode) { const ArgsP ap = fresh_args(); const Ctx C = make_ctx(ap, wv);
    if (mode == 0) phase_norm(C, IN(0), nullptr, false, true, IN(5), MODL(0), MODL(0), 0, 1024);
    else if (mode == 1) phase_norm(C, nullptr, nullptr, true, true, IN(5) + l * 1024, MODL(l - 1), MODL(l), 0, 1024);
    else if (mode == 3) phase_norm(C, nullptr, nullptr, true, true, IN(5) + l * 1024, MODL(l - 1), MODL(l), 0, 1024, true);
    else phase_norm(C, nullptr, ap->out, true, false, IN(5), MODL(3), MODL(3), 0, 1024); }
PHFN ph_proj(int wv, int j) { const ArgsP ap = fresh_args(); const Ctx C = make_ctx(ap, wv); unsigned char* ws = C.ws;
    DenseOrder S; S.init(ws + O_HN, ws + O_WIN + j * SZ_WIN, 1024, 1024, T_, 2048, C.G, C.bid); EpiNorm<0> E{(bf16_t*)(ws + O_PROJ), 2048, IN(8) + j * 64, IN(9) + j * 64, IN(10) + j * 256, IN(11) + j * 128, IN(15) + j * 96 + 64, (const float*)(ws + O_CS), (LAS float*)(C.lds + LX_EXCH)}; gemm_phase(C, GemmDims{1024, 1024, 1024}, S, E); }
PHFN ph_postproj(int wv, int j) { const ArgsP ap = fresh_args(); const Ctx C = make_ctx(ap, wv); phase_postproj(C, IN(8) + j * 64, IN(9) + j * 64, IN(10) + j * 256, IN(11) + j * 128, IN(15) + j * 96); }
PHFN ph_qkv(int wv, int j) { const ArgsP ap = fresh_args(); const Ctx C = make_ctx(ap, wv); unsigned char* ws = C.ws;
    { DenseOrder S; S.init(ws + O_PROJ + 1536 * 2, ws + O_WUQ + j * SZ_WUQ, 2048, 256, T_, 768, C.G, C.bid); EpiNorm<1> E{(bf16_t*)(ws + O_Q2), 768, IN(14) + j * 96, IN(14) + j * 96 + 64, nullptr, nullptr, nullptr, (const float*)(ws + O_CS), (LAS float*)(C.lds + LX_EXCH)}; gemm_phase(C, GemmDims{256, 2048, 256}, S, E); }
    { const ArgsP ap2 = fresh_args(); const Ctx C = make_ctx(ap2, wv); unsigned char* ws = C.ws; DenseOrder S; S.init(ws + O_PROJ + 1792 * 2, ws + O_WUKV + j * SZ_WUKV, 2048, 128, T_, 1024, C.G, C.bid); EpiNorm<2> E{(bf16_t*)(ws + O_KV2), 1024, IN(15) + j * 96, nullptr, nullptr, nullptr, nullptr, (const float*)(ws + O_CS), (LAS float*)(C.lds + LX_EXCH)}; gemm_phase(C, GemmDims{128, 2048, 128}, S, E); } }
PHFN ph_postq(int wv, int j) { const ArgsP ap = fresh_args(); const Ctx C = make_ctx(ap, wv); phase_postq(C, IN(14) + j * 96, IN(15) + j * 96); }
PHFN ph_attention(int wv) { const ArgsP ap = fresh_args(); const Ctx C = make_ctx(ap, wv); phase_attention(C); }
PHFN ph_mixcombine(int wv) { const ArgsP ap = fresh_args(); const Ctx C = make_ctx(ap, wv); phase_mixcombine(C); }
PHFN ph_outproj(int wv, int l, int which) { const ArgsP ap = fresh_args(); const Ctx C = make_ctx(ap, wv); unsigned char* ws = C.ws; const int j = l >> 1;
    DenseOrder S; S.init(ws + O_ATT, ws + (which ? O_RWOUT + j * SZ_RWOUT : O_WOUT + j * SZ_WOUT), 1024, 1024, T_, 1024, C.G, C.bid);
    EpiResid E{(bf16_t*)(ws + O_X), MODL(l) + 2048, which ? IN(27) + j * 1024 : nullptr}; gemm_phase(C, GemmDims{1024, 1024, 1024}, S, E); }
PHFN ph_router(int wv, int l) { const ArgsP ap = fresh_args(); const Ctx C = make_ctx(ap, wv); phase_router(C, (const bf16_t*)(C.ws + O_X), IN(6) + l * 1024, MODL(l), IN(28) + (size_t)l * 1024 * 32, IN(29) + l * 32); }
PHFN ph_scatter(int wv) { const ArgsP ap = fresh_args(); const Ctx C = make_ctx(ap, wv); phase_scatter(C); }
PHFN ph_moe1(int wv, int l) { const ArgsP ap = fresh_args(); const Ctx C = make_ctx(ap, wv); unsigned char* ws = C.ws; moe_plan_lds(C);
    MoeOrder S; S.A = (const char*)(ws + O_XG); S.WT = (const char*)(ws + O_W1 + (size_t)l * 32 * SZ_W1E); S.estride = SZ_W1E; S.tile_e = (const LAS int*)(C.lds + LX_TILE);
    S.NT = *(const LAS int*)(C.lds + LX_MISC + 128); S.nN = 8; S.G = C.G; S.c = C.bid; S.esz = 1;
    EpiSwiglu E{(unsigned char*)(ws + O_ACT), IN(31) + (size_t)l * 32 * 2048, 1.f / 32.f}; gemm_phase<true>(C, GemmDims{1024, 1024, 1024}, S, E); }
PHFN ph_moe2(int wv, int l) { const ArgsP ap = fresh_args(); const Ctx C = make_ctx(ap, wv); unsigned char* ws = C.ws; moe_plan_lds(C);
    MoeOrder S; S.A = (const char*)(ws + O_ACT); S.WT = (const char*)(ws + O_W2 + (size_t)l * 32 * SZ_W2E); S.estride = SZ_W2E; S.tile_e = (const LAS int*)(C.lds + LX_TILE);
    S.NT = *(const LAS int*)(C.lds + LX_MISC + 128); S.nN = 4; S.G = C.G; S.c = C.bid; S.esz = 1;
    EpiBf16 E{(bf16_t*)(ws + O_Y2), IN(33) + (size_t)l * 32 * 1024, 1024, 1024, 1.f / 32.f}; gemm_phase<true>(C, GemmDims{1024, 1024, 1024}, S, E); }
PHFN ph_recin(int wv, int j) { const ArgsP ap = fresh_args(); const Ctx C = make_ctx(ap, wv); unsigned char* ws = C.ws;
    DenseOrder S; S.init(ws + O_HN, ws + O_RWIN + j * SZ_RWIN, 1024, 1024, T_, 2048, C.G, C.bid); EpiRecIn E{(bf16_t*)(ws + O_PROJ), IN(18) + j * 2048}; gemm_phase(C, GemmDims{1024, 1024, 1024}, S, E); }
PHFN ph_conv(int wv, int j) { const ArgsP ap = fresh_args(); const Ctx C = make_ctx(ap, wv); phase_conv(C, IN(19) + j * 4096, IN(20) + j * 1024); }
PHFN ph_lru(int wv, int j) { const ArgsP ap = fresh_args(); const Ctx C = make_ctx(ap, wv); unsigned char* ws = C.ws;
    LruOrder S; S.XC = (const char*)(ws + O_XC); S.RG = (const char*)(ws + O_RGATE + j * SZ_RGATE); S.G = C.G; S.c = C.bid;
    EpiLru E{(const bf16_t*)(ws + O_XC), IN(22) + j * 1024, IN(24) + j * 1024, (const float*)(ws + O_SPV) + j * 1024, (bf16_t*)(ws + O_AA), (bf16_t*)(ws + O_BB)};
    gemm_phase(C, GemmDims{128, 1024, 128}, S, E);
    phase_scan_sum_own(C); }
PHFN ph_scan_apply(int wv) { const ArgsP ap = fresh_args(); const Ctx C = make_ctx(ap, wv); phase_scan_apply(C); }

#if MODE == 1
__device__ __forceinline__ int fresh_tid(int wv) { unsigned ones = ~0u; asm volatile("" : "+s"(ones)); return wv * 64 + (int)__builtin_amdgcn_mbcnt_hi(ones, __builtin_amdgcn_mbcnt_lo(ones, 0u)); }
__device__ __forceinline__ void grid_barrier(int wv) { const ArgsP q = fresh_args(); XcdBarrier b; b.bar = (unsigned*)(q->ws + O_CTL) + CW_BAR; b.x = xb_xcc_id(); b.st = (volatile LAS unsigned*)((LAS unsigned char*)lds_raw + LDSX_OFF); xcd_barrier(b, fresh_tid(wv)); }
__global__ void __launch_bounds__(512, 2) mk_fwd(Args a) {
    int wv = __builtin_amdgcn_readfirstlane(threadIdx.x >> 6); asm volatile("" : "+s"(wv));
    { LAS unsigned char* lds = (LAS unsigned char*)lds_raw;
      for (int u = threadIdx.x; u < (LDS_BYTES - LDSX_OFF) / 4; u += 512) ((LAS unsigned*)(lds + LDSX_OFF))[u] = 0u;
      __syncthreads();
      if (a.ph_hi - a.ph_lo > 1) (void)xcd_barrier_post((unsigned*)(a.ws + O_CTL) + CW_BAR, (volatile LAS unsigned*)(lds + LDSX_OFF), (int)threadIdx.x); }
    int pid = 0;
#define PHASE(call) { const ArgsP q_ = fresh_args(); const int lo_ = q_->ph_lo, hi_ = q_->ph_hi; if (pid >= lo_ && pid < hi_) { call; if (pid + 1 < hi_) grid_barrier(wv); } ++pid; }
#define PHASE_R(call, REP) { const ArgsP q_ = fresh_args(); const int lo_ = q_->ph_lo, hi_ = q_->ph_hi; if (pid >= lo_ && pid < hi_) { if ((REP) > 1) { call; grid_barrier(wv); } call; if (pid + 1 < hi_) grid_barrier(wv); } ++pid; }
#ifndef REP_PROLOGUE
#define REP_PROLOGUE 1
#endif
#ifndef REP_MOE
#define REP_MOE 1
#endif
#ifndef REP_ATTN
#define REP_ATTN 1
#endif
#ifndef REP_GEMMS
#define REP_GEMMS 1
#endif
#ifdef TIME_NORM
#define NORM_EXTRA(l) PHASE(ph_norm(wv, l, 3))
#else
#define NORM_EXTRA(l)
#endif
#ifndef REP_ELEM
#define REP_ELEM 1
#endif
#ifndef REP_ROUTER
#define REP_ROUTER REP_ELEM
#endif
#ifndef REP_SCATTER
#define REP_SCATTER REP_ELEM
#endif
#ifndef REP_MIX
#define REP_MIX REP_ELEM
#endif
#ifndef REP_CONV
#define REP_CONV REP_ELEM
#endif
#ifndef REP_SCANA
#define REP_SCANA REP_ELEM
#endif
#define MOE_PHASES(l) PHASE_R(ph_router(wv, l), REP_ROUTER) PHASE_R(ph_scatter(wv), REP_SCATTER) PHASE_R(ph_moe1(wv, l), REP_MOE) PHASE_R(ph_moe2(wv, l), REP_MOE)
    PHASE_R(ph_prologue(wv), REP_PROLOGUE)
#define LAYER_PAIR(lp) \
        { const int l = 2 * (lp);         \
          PHASE(ph_norm(wv, l, (lp) == 0 ? 0 : 1)) PHASE_R(ph_proj(wv, lp), REP_GEMMS) PHASE_R(ph_qkv(wv, lp), REP_GEMMS) PHASE_R(ph_attention(wv), REP_ATTN) PHASE_R(ph_mixcombine(wv), REP_MIX) PHASE(ph_outproj(wv, l, 0)) \
          MOE_PHASES(l) } \
        { const int l = 2 * (lp) + 1;     \
          NORM_EXTRA(l) PHASE(ph_norm(wv, l, 1)) PHASE_R(ph_recin(wv, lp), REP_GEMMS) PHASE_R(ph_conv(wv, lp), REP_CONV) PHASE_R(ph_lru(wv, lp), REP_GEMMS) PHASE_R(ph_scan_apply(wv), REP_SCANA) PHASE(ph_outproj(wv, l, 1)) \
          MOE_PHASES(l) }
    LAYER_PAIR(0)
    LAYER_PAIR(1)
#undef LAYER_PAIR
#ifdef EXTRA_BARRIERS
    { const ArgsP q_ = fresh_args(); if (q_->ph_hi - q_->ph_lo > 1) { _Pragma("unroll 1") for (int xb = 0; xb < EXTRA_BARRIERS; ++xb) grid_barrier(wv); } }
#endif
    PHASE(ph_norm(wv, 3, 2))
#undef PHASE
#undef PHASE_R
#undef MOE_PHASES
}
#else
template <int PH> __global__ void __launch_bounds__(512, 2) k_phase(Args a, int l, int x) {
    int wv = __builtin_amdgcn_readfirstlane(threadIdx.x >> 6); asm volatile("" : "+s"(wv));
    LAS unsigned char* lds = (LAS unsigned char*)lds_raw;
    for (int u = threadIdx.x; u < (LDS_BYTES - LDSX_OFF) / 4; u += 512) ((LAS unsigned*)(lds + LDSX_OFF))[u] = 0u;
    __syncthreads();
    if constexpr (PH == 0) ph_prologue(wv);
    if constexpr (PH == 1) ph_norm(wv, l, x);
    if constexpr (PH == 2) ph_proj(wv, l);
    if constexpr (PH == 4) ph_qkv(wv, l);
    if constexpr (PH == 6) ph_attention(wv);
    if constexpr (PH == 7) ph_mixcombine(wv);
    if constexpr (PH == 8) ph_outproj(wv, l, x);
    if constexpr (PH == 9) ph_router(wv, l);
    if constexpr (PH == 10) ph_scatter(wv);
    if constexpr (PH == 11) ph_moe1(wv, l);
    if constexpr (PH == 12) ph_moe2(wv, l);
    if constexpr (PH == 13) ph_recin(wv, l);
    if constexpr (PH == 14) ph_conv(wv, l);
    if constexpr (PH == 15) ph_lru(wv, l);
    if constexpr (PH == 17) ph_scan_apply(wv);
}
#endif
#undef IN
#undef MODL
}

#ifndef MODE
#define MODE 2
#endif
extern "C" void kernel_launch(void* const* d_in, const int* in_sizes, int n_in, void* d_out, int out_size, void* d_ws, size_t ws_size, hipStream_t stream) {
    (void)in_sizes; (void)n_in; (void)out_size; (void)ws_size;
#if MODE == 0
    nv::forward(d_in, (float*)d_out, d_ws, stream);
#else
    static int grid = 0;
    if (grid == 0) {
        int dev = 0, cus = 0;
        (void)hipGetDevice(&dev); (void)hipDeviceGetAttribute(&cus, hipDeviceAttributeMultiprocessorCount, dev);
#if MODE == 1
        (void)hipFuncSetAttribute((const void*)mk::mk_fwd, hipFuncAttributeMaxDynamicSharedMemorySize, mk::LDS_BYTES);
#else
#define SA(PH) (void)hipFuncSetAttribute((const void*)mk::k_phase<PH>, hipFuncAttributeMaxDynamicSharedMemorySize, mk::LDS_BYTES)
        SA(0); SA(1); SA(2); SA(4); SA(6); SA(7); SA(8); SA(9); SA(10); SA(11); SA(12); SA(13); SA(14); SA(15); SA(17);
#undef SA
#endif
        grid = cus > 0 ? cus : 256;
    }
    (void)hipMemsetAsync((char*)d_ws + mk::O_CTL, 0, mk::SZ_CTL, stream);
    mk::Args a;
    memset(&a, 0, sizeof(a));
    for (int i = 0; i < 34; ++i) a.in[i] = d_in[i];
    a.out = (float*)d_out; a.ws = (unsigned char*)d_ws;
#if MODE == 1
    a.ph_lo = 0; a.ph_hi = mk::N_PHASES;
    hipLaunchKernelGGL(mk::mk_fwd, dim3(grid), dim3(512), mk::LDS_BYTES, stream, a);
#else
#define LP(PH, l, x) hipLaunchKernelGGL(mk::k_phase<PH>, dim3(grid), dim3(512), mk::LDS_BYTES, stream, a, l, x)
    LP(0, 0, 0);
    for (int lp = 0; lp < 2; ++lp) {
        { const int l = 2 * lp; LP(1, l, lp == 0 ? 0 : 1); LP(2, lp, 0); LP(4, lp, 0); LP(6, 0, 0); LP(7, 0, 0); LP(8, l, 0); LP(9, l, 0); LP(10, 0, 0); LP(11, l, 0); LP(12, l, 0); }
        { const int l = 2 * lp + 1; LP(1, l, 1); LP(13, lp, 0); LP(14, lp, 0); LP(15, lp, 0); LP(17, 0, 0); LP(8, l, 1); LP(9, l, 0); LP(10, 0, 0); LP(11, l, 0); LP(12, l, 0); }
    }
    LP(1, 3, 2);
#undef LP
#endif
#endif
}
```

```cpp
#define MODE 1

#include <string.h>
#include <hip/hip_runtime.h>
#include <stdint.h>
#include <math.h>

namespace cfg {
constexpr int D = 1024, NB = 4, S = 4096, T = NB * S, DEPTH = 4;
constexpr int MIXIN = 1952;
constexpr int NE = 32, TOPK = 4;
constexpr int MPAIR = T * TOPK;
constexpr int NBLK = MPAIR / 256 + NE;
constexpr int P = NBLK * 256;
}
using namespace cfg;

namespace nv {

__device__ __forceinline__ float wave_sum(float v) {
#pragma unroll
    for (int o = 1; o < 64; o <<= 1) v += __shfl_xor(v, o);
    return v;
}
__device__ __forceinline__ float wave_max(float v) {
#pragma unroll
    for (int o = 1; o < 64; o <<= 1) v = fmaxf(v, __shfl_xor(v, o));
    return v;
}
__device__ __forceinline__ float block_sum256(float v) {
    __shared__ float red[4];
    v = wave_sum(v);
    __syncthreads();
    if ((threadIdx.x & 63) == 0) red[threadIdx.x >> 6] = v;
    __syncthreads();
    return red[0] + red[1] + red[2] + red[3];
}
__device__ __forceinline__ float sigmoidf_(float x) { return 1.f / (1.f + expf(-x)); }
__device__ __forceinline__ float gelu_tanh(float x) { return 0.5f * x * (1.f + tanhf(0.7978845608028654f * (x + 0.044715f * x * x * x))); }

__global__ void k_mod(const float* __restrict__ c, const float* __restrict__ ada_w, const float* __restrict__ ada_b, float* __restrict__ mod) {
    const int n = blockIdx.x * 256 + threadIdx.x, l = blockIdx.y;
    float acc[4] = {0.f, 0.f, 0.f, 0.f};
    const float* w = ada_w + (size_t)l * 1024 * 6144 + n;
    for (int k = 0; k < 1024; ++k) {
        const float wv = w[(size_t)k * 6144];
#pragma unroll
        for (int b = 0; b < 4; ++b) { const float cv = c[b * 1024 + k]; acc[b] += (cv / (1.f + expf(-cv))) * wv; }
    }
#pragma unroll
    for (int b = 0; b < 4; ++b) mod[((size_t)l * 4 + b) * 6144 + n] = acc[b] + ada_b[l * 6144 + n];
}

__global__ void k_rmsmod(const float* __restrict__ x, const float* __restrict__ gain, const float* __restrict__ modl, int shoff, int scoff, float* __restrict__ out) {
    const int t = blockIdx.x, b = t / S;
    const float* xr = x + (size_t)t * D;
    float v[4]; float ss = 0.f;
#pragma unroll
    for (int i = 0; i < 4; ++i) { v[i] = xr[threadIdx.x + 256 * i]; ss += v[i] * v[i]; }
    ss = block_sum256(ss);
    const float rs = rsqrtf(ss * (1.f / D) + 1e-6f);
#pragma unroll
    for (int i = 0; i < 4; ++i) { const int col = threadIdx.x + 256 * i;
        out[(size_t)t * D + col] = v[i] * rs * gain[col] * (1.f + modl[b * 6144 + scoff + col]) + modl[b * 6144 + shoff + col]; }
}

template <class Epi>
__global__ void __launch_bounds__(256) k_gemm(const float* __restrict__ A, const int* __restrict__ rowidx, const float* __restrict__ Bw, const int* __restrict__ tile_e, size_t bstride,
                                             Epi epi, int lda, int ldb, int N, int K) {
    __shared__ float As[16][68];
    __shared__ float Bs[16][68];
    const int row0 = blockIdx.y * 64, col0 = blockIdx.x * 64;
    int e = 0;
    if (tile_e) { e = tile_e[row0 / 256]; if (e < 0) return; }
    const float* Bp = Bw + (size_t)e * bstride;
    const int tid = threadIdx.x, ty = tid >> 4, tx = tid & 15;
    const int ar = tid >> 2, ak = (tid & 3) * 4;
    const int bk = tid >> 4, bn = (tid & 15) * 4;
    const int arow = rowidx ? rowidx[row0 + ar] : (row0 + ar);
    const float* Ap = A + (size_t)arow * lda + ak;
    float acc[4][4];
#pragma unroll
    for (int i = 0; i < 4; ++i)
#pragma unroll
        for (int j = 0; j < 4; ++j) acc[i][j] = 0.f;
    for (int k0 = 0; k0 < K; k0 += 16) {
        const float4 av = *(const float4*)(Ap + k0);
        float4 bv = make_float4(0.f, 0.f, 0.f, 0.f);
        if (col0 + bn < N) bv = *(const float4*)(Bp + (size_t)(k0 + bk) * ldb + col0 + bn);
        __syncthreads();
        As[ak + 0][ar] = av.x; As[ak + 1][ar] = av.y; As[ak + 2][ar] = av.z; As[ak + 3][ar] = av.w;
        *(float4*)&Bs[bk][bn] = bv;
        __syncthreads();
#pragma unroll
        for (int kk = 0; kk < 16; ++kk) {
            const float4 a4 = *(const float4*)&As[kk][ty * 4];
            const float4 b4 = *(const float4*)&Bs[kk][tx * 4];
            const float a[4] = {a4.x, a4.y, a4.z, a4.w}, b[4] = {b4.x, b4.y, b4.z, b4.w};
#pragma unroll
            for (int i = 0; i < 4; ++i)
#pragma unroll
                for (int j = 0; j < 4; ++j) acc[i][j] += a[i] * b[j];
        }
    }
#pragma unroll
    for (int i = 0; i < 4; ++i)
#pragma unroll
        for (int j = 0; j < 4; ++j) { const int r = row0 + ty * 4 + i, cidx = col0 + tx * 4 + j; if (cidx < N) epi(r, cidx, acc[i][j], e); }
}
struct EpiStore { float* C; const float* bias; int ldc; int bias_estride;
    __device__ __forceinline__ void operator()(int r, int c, float v, int e) const { C[(size_t)r * ldc + c] = v + (bias ? bias[(size_t)e * bias_estride + c] : 0.f); } };
struct EpiResid { float* X; const float* g; const float* bias;
    __device__ __forceinline__ void operator()(int r, int c, float v, int) const { const int b = r / S; X[(size_t)r * D + c] += g[b * 6144 + c] * (v + (bias ? bias[c] : 0.f)); } };

__global__ void k_postproj(float* __restrict__ PROJ, const float* __restrict__ qg, const float* __restrict__ kg, const float* __restrict__ qag, const float* __restrict__ kvag,
                           const float* __restrict__ mkg  , const int* __restrict__ positions) {
    const int t = blockIdx.x; float* r = PROJ + (size_t)t * MIXIN; const int tid = threadIdx.x;
    if (tid < 16) { float* p = r + tid * 64; const float* g = tid < 8 ? qg : kg; float ss = 0.f; for (int i = 0; i < 64; ++i) ss += p[i] * p[i];
        const float rs = rsqrtf(ss / 64.f + 1e-6f); for (int i = 0; i < 64; ++i) p[i] = p[i] * rs * g[i]; }
    else if (tid == 16) { float* p = r + 1536; float ss = 0.f; for (int i = 0; i < 256; ++i) ss += p[i] * p[i];
        const float rs = rsqrtf(ss / 256.f + 1e-6f); for (int i = 0; i < 256; ++i) p[i] = p[i] * rs * qag[i]; }
    else if (tid == 17) { float* p = r + 1792; float ss = 0.f; for (int i = 0; i < 128; ++i) ss += p[i] * p[i];
        const float rs = rsqrtf(ss / 128.f + 1e-6f); for (int i = 0; i < 128; ++i) p[i] = p[i] * rs * kvag[i]; }
    else if (tid == 18) { float* p = r + 1920; float ss = 0.f; for (int i = 0; i < 32; ++i) ss += p[i] * p[i];
        const float rs = rsqrtf(ss / 32.f + 1e-6f);
        const float pos = (float)positions[t];
        for (int i = 0; i < 16; ++i) { const float inv = powf(10000.f, -(float)(2 * i) / 32.f); const float ang = pos * inv; const float cs = cosf(ang), sn = sinf(ang);
            const float v1 = p[i] * rs * mkg[64 + i], v2 = p[16 + i] * rs * mkg[80 + i];
            p[i] = v1 * cs - v2 * sn; p[16 + i] = v1 * sn + v2 * cs; } }
}
__global__ void k_postq(float* __restrict__ Q2, float* __restrict__ KV2, const float* __restrict__ mqg, const float* __restrict__ mkg, const int* __restrict__ positions) {
    const int t = blockIdx.x, tid = threadIdx.x;
    if (tid < 8) { float* p = Q2 + (size_t)t * 768 + tid * 96; float ss = 0.f; for (int i = 0; i < 64; ++i) ss += p[i] * p[i];
        float rs = rsqrtf(ss / 64.f + 1e-6f); for (int i = 0; i < 64; ++i) p[i] = p[i] * rs * mqg[i];
        float* q = p + 64; ss = 0.f; for (int i = 0; i < 32; ++i) ss += q[i] * q[i]; rs = rsqrtf(ss / 32.f + 1e-6f);
        const float pos = (float)positions[t];
        for (int i = 0; i < 16; ++i) { const float inv = powf(10000.f, -(float)(2 * i) / 32.f); const float ang = pos * inv; const float cs = cosf(ang), sn = sinf(ang);
            const float v1 = q[i] * rs * mqg[64 + i], v2 = q[16 + i] * rs * mqg[80 + i];
            q[i] = v1 * cs - v2 * sn; q[16 + i] = v1 * sn + v2 * cs; } }
    else if (tid < 16) { float* p = KV2 + (size_t)t * 1024 + (tid - 8) * 128; float ss = 0.f; for (int i = 0; i < 64; ++i) ss += p[i] * p[i];
        const float rs = rsqrtf(ss / 64.f + 1e-6f); for (int i = 0; i < 64; ++i) p[i] = p[i] * rs * mkg[i]; }
}
__global__ void __launch_bounds__(256) k_mla(const float* __restrict__ Q2, const float* __restrict__ KV2, const float* __restrict__ PROJ, float* __restrict__ ATT) {
    const int wave = threadIdx.x >> 6, lane = threadIdx.x & 63;
    const int q = blockIdx.x * 4 + wave, h = blockIdx.y, b = blockIdx.z;
    const float* qrow = Q2 + (size_t)(b * S + q) * 768 + h * 96;
    float qv[96];
#pragma unroll
    for (int d = 0; d < 96; ++d) qv[d] = qrow[d];
    const float scale = 0.10206207261596575f;
    float m = -INFINITY, l = 0.f, o = 0.f;
    for (int k0 = 0; k0 <= q; k0 += 64) {
        const int k = k0 + lane; float s = -INFINITY;
        if (k <= q) { const float* kn = KV2 + (size_t)(b * S + k) * 1024 + h * 128; const float* kp = PROJ + (size_t)(b * S + k) * MIXIN + 1920; float acc = 0.f;
#pragma unroll
            for (int d = 0; d < 64; ++d) acc += qv[d] * kn[d];
#pragma unroll
            for (int d = 0; d < 32; ++d) acc += qv[64 + d] * kp[d];
            s = acc * scale; }
        const float mn = fmaxf(m, wave_max(s));
        const float alpha = expf(m - mn); const float p = (k <= q) ? expf(s - mn) : 0.f;
        l = l * alpha + wave_sum(p); o *= alpha;
        const int kend = min(64, q - k0 + 1);
        for (int kk = 0; kk < kend; ++kk) { const float pk = __shfl(p, kk); o += pk * KV2[(size_t)(b * S + k0 + kk) * 1024 + h * 128 + 64 + lane]; }
        m = mn;
    }
    ATT[(size_t)(b * S + q) * 1024 + 512 + h * 64 + lane] = o / l;
}
__global__ void __launch_bounds__(256) k_dil(const float* __restrict__ PROJ, float* __restrict__ ATT) {
    const int wave = threadIdx.x >> 6, lane = threadIdx.x & 63;
    const int t = blockIdx.x * 4 + wave, h = blockIdx.y, b = blockIdx.z;
    const float* base = PROJ + (size_t)(b * S) * MIXIN;
    const float* qrow = base + (size_t)t * MIXIN + h * 64;
    float qv[64];
#pragma unroll
    for (int d = 0; d < 64; ++d) qv[d] = qrow[d];
    float s[7]; float mx = -INFINITY;
#pragma unroll
    for (int c = 0; c < 7; ++c) { const int slot = c * 64 + lane; s[c] = -INFINITY;
        if (slot < 387) { const int p = slot / 129, j = slot % 129; const int dd = (p == 0) ? 1 : (p == 1) ? 4 : 16; const int tk = t - j * dd;
            if (tk >= 0) { const float* kr = base + (size_t)tk * MIXIN + 512 + h * 64; float acc = 0.f;
#pragma unroll
                for (int d = 0; d < 64; ++d) acc += qv[d] * kr[d];
                s[c] = acc * 0.125f; } }
        mx = fmaxf(mx, s[c]); }
    mx = wave_max(mx);
    float ls = 0.f;
#pragma unroll
    for (int c = 0; c < 7; ++c) { s[c] = expf(s[c] - mx); ls += s[c]; }
    ls = wave_sum(ls);
    float o = 0.f;
#pragma unroll
    for (int c = 0; c < 7; ++c)
        for (int kk = 0; kk < 64; ++kk) { const int slot = c * 64 + kk; if (slot >= 387) break; const int p = slot / 129, j = slot % 129; const int dd = (p == 0) ? 1 : (p == 1) ? 4 : 16; const int tk = t - j * dd;
            const float pk = __shfl(s[c], kk);
            if (tk >= 0) o += pk * base[(size_t)tk * MIXIN + 1024 + h * 64 + lane]; }
    ATT[(size_t)(b * S + t) * 1024 + h * 64 + lane] = o / ls;
}

__global__ void k_conv(const float* __restrict__ GX, const float* __restrict__ cw, const float* __restrict__ cb, float* __restrict__ XC) {
    const int t = blockIdx.x, ts = t % S;
    for (int c = threadIdx.x; c < 1024; c += 256) { float acc = cb[c];
#pragma unroll
        for (int k = 0; k < 4; ++k) { const int dt = k - 3; if (ts + dt >= 0) acc += cw[k * 1024 + c] * GX[(size_t)(t + dt) * 2048 + 1024 + c]; }
        XC[(size_t)t * 1024 + c] = acc; }
}
__global__ void k_lru(const float* __restrict__ RPRE, const float* __restrict__ IPRE, const float* __restrict__ XC, const float* __restrict__ lam, float* __restrict__ Aa, float* __restrict__ Bb) {
    const size_t i = (size_t)blockIdx.x * 256 + threadIdx.x; const int c = (int)(i & 1023);
    const float r = sigmoidf_(RPRE[i]), ig = sigmoidf_(IPRE[i]);
    const float nl = -lam[c]; const float sp = (nl > 20.f) ? nl : log1pf(expf(nl));
    const float log_a = -8.f * r * sp; const float a = expf(log_a); const float mult = sqrtf(-expm1f(2.f * log_a));
    Aa[i] = a; Bb[i] = mult * (ig * XC[i]);
}
__global__ void k_scan(const float* __restrict__ Aa, const float* __restrict__ Bb, float* __restrict__ Y) {
    const int idx = blockIdx.x * 256 + threadIdx.x; const int b = idx / 1024, c = idx % 1024;
    float h = 0.f; size_t off = (size_t)b * S * 1024 + c;
    for (int t = 0; t < S; ++t, off += 1024) { h = Aa[off] * h + Bb[off]; Y[off] = h; }
}
__global__ void k_gy(const float* __restrict__ GX, const float* __restrict__ Y, float* __restrict__ GY) {
    const size_t i = (size_t)blockIdx.x * 256 + threadIdx.x; const size_t t = i >> 10; const int c = (int)(i & 1023);
    GY[i] = gelu_tanh(GX[t * 2048 + c]) * Y[i];
}

__global__ void k_router(const float* __restrict__ x, const float* __restrict__ gain, const float* __restrict__ modl, const float* __restrict__ wr, const float* __restrict__ br,
                         float* __restrict__ HN2, int* __restrict__ topi, float* __restrict__ topg, int* __restrict__ cnt) {
    __shared__ float hrow[1024]; __shared__ float part[8][32]; __shared__ float lg[32];
    const int t = blockIdx.x, b = t / S, tid = threadIdx.x;
    const float* xr = x + (size_t)t * D;
    float v[4]; float ss = 0.f;
#pragma unroll
    for (int i = 0; i < 4; ++i) { v[i] = xr[tid + 256 * i]; ss += v[i] * v[i]; }
    ss = block_sum256(ss);
    const float rs = rsqrtf(ss * (1.f / D) + 1e-6f);
#pragma unroll
    for (int i = 0; i < 4; ++i) { const int col = tid + 256 * i; const float hv = v[i] * rs * gain[col] * (1.f + modl[b * 6144 + 4096 + col]) + modl[b * 6144 + 3072 + col];
        hrow[col] = hv; HN2[(size_t)t * D + col] = hv; }
    __syncthreads();
    { const int e = tid & 31, kp = tid >> 5; float acc = 0.f; for (int k = kp * 128; k < kp * 128 + 128; ++k) acc += hrow[k] * wr[k * 32 + e]; part[kp][e] = acc; }
    __syncthreads();
    if (tid < 32) { float a = br[tid]; for (int i = 0; i < 8; ++i) a += part[i][tid]; lg[tid] = a; }
    __syncthreads();
    if (tid == 0) { int idx[4]; float val[4]; unsigned used = 0u;
        for (int k = 0; k < 4; ++k) { int bi = -1; float bv = -INFINITY; for (int e = 0; e < 32; ++e) if (!((used >> e) & 1u) && lg[e] > bv) { bv = lg[e]; bi = e; } used |= 1u << bi; idx[k] = bi; val[k] = bv; }
        float den = 0.f, ex[4]; for (int k = 0; k < 4; ++k) { ex[k] = expf(val[k] - val[0]); den += ex[k]; }
        for (int k = 0; k < 4; ++k) { topi[t * 4 + k] = idx[k]; topg[t * 4 + k] = ex[k] / den; atomicAdd(&cnt[idx[k]], 1); } }
}
__global__ void k_plan(const int* __restrict__ cnt, int* __restrict__ pstart, int* __restrict__ tile_e) {
    if (threadIdx.x == 0) { int acc = 0, ti = 0;
        for (int e = 0; e < NE; ++e) { pstart[e] = acc; const int nt = (cnt[e] + 255) / 256; for (int i = 0; i < nt; ++i) tile_e[ti++] = e; acc += nt * 256; }
        for (; ti < NBLK; ++ti) tile_e[ti] = -1; }
}
__global__ void k_scatter(const int* __restrict__ topi, const int* __restrict__ pstart, int* __restrict__ fill, int* __restrict__ rowtok, int* __restrict__ pos) {
    const int i = blockIdx.x * 256 + threadIdx.x; const int e = topi[i];
    const int p = pstart[e] + atomicAdd(&fill[e], 1); rowtok[p] = i >> 2; pos[i] = p;
}
__global__ void k_swiglu(const float* __restrict__ HB, const int* __restrict__ tile_e, float* __restrict__ ACT) {
    const int p = blockIdx.x; if (tile_e[p / 256] < 0) return;
    for (int j = threadIdx.x; j < 1024; j += 256) { float g = HB[(size_t)p * 2048 + 2 * j], li = HB[(size_t)p * 2048 + 2 * j + 1];
        g = fminf(g, 7.f); li = fminf(fmaxf(li, -7.f), 7.f);
        ACT[(size_t)p * 1024 + j] = g * sigmoidf_(1.702f * g) * (li + 1.f); }
}
__global__ void k_combine(float* __restrict__ X, const float* __restrict__ Y2, const int* __restrict__ pos, const float* __restrict__ topg, const float* __restrict__ modl) {
    const int t = blockIdx.x, b = t / S;
    int pp[4]; float gg[4];
#pragma unroll
    for (int k = 0; k < 4; ++k) { pp[k] = pos[t * 4 + k]; gg[k] = topg[t * 4 + k]; }
    for (int c = threadIdx.x; c < 1024; c += 256) { float y = 0.f;
#pragma unroll
        for (int k = 0; k < 4; ++k) y += gg[k] * Y2[(size_t)pp[k] * 1024 + c];
        X[(size_t)t * D + c] += modl[b * 6144 + 5120 + c] * y; }
}

struct Bump { char* base; size_t off; template <class Tp> Tp* get(size_t n) { off = (off + 255) & ~(size_t)255; Tp* p = (Tp*)(base + off); off += n * sizeof(Tp); return p; } };

static void forward(void* const* d_in, float* X, void* d_ws, hipStream_t st) {
    const float* x = (const float*)d_in[0]; const float* c = (const float*)d_in[1]; const int* positions = (const int*)d_in[2];
    const float* ada_w = (const float*)d_in[3]; const float* ada_b = (const float*)d_in[4];
    const float* n1g = (const float*)d_in[5]; const float* n2g = (const float*)d_in[6];
    const float* attn_w_in = (const float*)d_in[7]; const float* da_qg = (const float*)d_in[8]; const float* da_kg = (const float*)d_in[9];
    const float* qag = (const float*)d_in[10]; const float* kvag = (const float*)d_in[11]; const float* w_uq = (const float*)d_in[12]; const float* w_ukv = (const float*)d_in[13];
    const float* mqg = (const float*)d_in[14]; const float* mkg = (const float*)d_in[15]; const float* attn_w_out = (const float*)d_in[16];
    const float* rec_w_in = (const float*)d_in[17]; const float* rec_b_in = (const float*)d_in[18]; const float* conv_w = (const float*)d_in[19]; const float* conv_b = (const float*)d_in[20];
    const float* rec_wa = (const float*)d_in[21]; const float* rec_ba = (const float*)d_in[22]; const float* rec_wx = (const float*)d_in[23]; const float* rec_bx = (const float*)d_in[24];
    const float* rec_lam = (const float*)d_in[25]; const float* rec_w_out = (const float*)d_in[26]; const float* rec_b_out = (const float*)d_in[27];
    const float* w_router = (const float*)d_in[28]; const float* b_router = (const float*)d_in[29]; const float* w1 = (const float*)d_in[30]; const float* b1 = (const float*)d_in[31];
    const float* w2 = (const float*)d_in[32]; const float* b2 = (const float*)d_in[33];

    Bump bp{(char*)d_ws, 0};
    int* ictl = bp.get<int>(1024);
    int* cnt = ictl, *fill = ictl + 64, *pstart = ictl + 128, *tile_e = ictl + 256;
    float* mod = bp.get<float>((size_t)DEPTH * 4 * 6144);
    float* HN = bp.get<float>((size_t)T * D);
    float* PROJ = bp.get<float>((size_t)T * 2048);
    float* Q2 = bp.get<float>((size_t)T * 768);
    float* KV2 = bp.get<float>((size_t)T * 1024);
    float* ATT = bp.get<float>((size_t)T * 1024);
    float* XC = bp.get<float>((size_t)T * 1024);
    float* RPRE = bp.get<float>((size_t)T * 1024);
    float* IPRE = bp.get<float>((size_t)T * 1024);
    float* Aa = bp.get<float>((size_t)T * 1024);
    float* Bb = bp.get<float>((size_t)T * 1024);
    float* Yv = bp.get<float>((size_t)T * 1024);
    int* topi = bp.get<int>((size_t)T * 4); float* topg = bp.get<float>((size_t)T * 4); int* pos = bp.get<int>((size_t)T * 4); int* rowtok = bp.get<int>(P);
    float* HB = bp.get<float>((size_t)P * 2048);
    float* ACT = bp.get<float>((size_t)P * 1024);
    float* Y2 = bp.get<float>((size_t)P * 1024);

    (void)hipMemcpyAsync(X, x, (size_t)T * D * 4, hipMemcpyDeviceToDevice, st);
    k_mod<<<dim3(6144 / 256, DEPTH), 256, 0, st>>>(c, ada_w, ada_b, mod);
    for (int l = 0; l < DEPTH; ++l) {
        const float* modl = mod + (size_t)l * 4 * 6144; const int j = l / 2;
        k_rmsmod<<<T, 256, 0, st>>>(X, n1g + l * D, modl, 0, 1024, HN);
        if (l % 2 == 0) {
            k_gemm<EpiStore><<<dim3((MIXIN + 63) / 64, T / 64), 256, 0, st>>>(HN, nullptr, attn_w_in + (size_t)j * D * MIXIN, nullptr, 0, EpiStore{PROJ, nullptr, MIXIN, 0}, D, MIXIN, MIXIN, D);
            k_postproj<<<T, 64, 0, st>>>(PROJ, da_qg + j * 64, da_kg + j * 64, qag + j * 256, kvag + j * 128, mkg + j * 96, positions);
            k_gemm<EpiStore><<<dim3(768 / 64, T / 64), 256, 0, st>>>(PROJ + 1536, nullptr, w_uq + (size_t)j * 256 * 768, nullptr, 0, EpiStore{Q2, nullptr, 768, 0}, MIXIN, 768, 768, 256);
            k_gemm<EpiStore><<<dim3(1024 / 64, T / 64), 256, 0, st>>>(PROJ + 1792, nullptr, w_ukv + (size_t)j * 128 * 1024, nullptr, 0, EpiStore{KV2, nullptr, 1024, 0}, MIXIN, 1024, 1024, 128);
            k_postq<<<T, 64, 0, st>>>(Q2, KV2, mqg + j * 96, mkg + j * 96, positions);
            k_dil<<<dim3(S / 4, 8, 4), 256, 0, st>>>(PROJ, ATT);
            k_mla<<<dim3(S / 4, 8, 4), 256, 0, st>>>(Q2, KV2, PROJ, ATT);
            k_gemm<EpiResid><<<dim3(D / 64, T / 64), 256, 0, st>>>(ATT, nullptr, attn_w_out + (size_t)j * 1024 * D, nullptr, 0, EpiResid{X, modl + 2048, nullptr}, 1024, D, D, 1024);
        } else {
            k_gemm<EpiStore><<<dim3(2048 / 64, T / 64), 256, 0, st>>>(HN, nullptr, rec_w_in + (size_t)j * D * 2048, nullptr, 0, EpiStore{PROJ, rec_b_in + j * 2048, 2048, 0}, D, 2048, 2048, D);
            k_conv<<<T, 256, 0, st>>>(PROJ, conv_w + j * 4 * 1024, conv_b + j * 1024, XC);
            for (int n = 0; n < 8; ++n) {
                k_gemm<EpiStore><<<dim3(2, T / 64), 256, 0, st>>>(XC + n * 128, nullptr, rec_wa + ((size_t)j * 8 + n) * 128 * 128, nullptr, 0, EpiStore{RPRE + n * 128, rec_ba + j * 1024 + n * 128, 1024, 0}, 1024, 128, 128, 128);
                k_gemm<EpiStore><<<dim3(2, T / 64), 256, 0, st>>>(XC + n * 128, nullptr, rec_wx + ((size_t)j * 8 + n) * 128 * 128, nullptr, 0, EpiStore{IPRE + n * 128, rec_bx + j * 1024 + n * 128, 1024, 0}, 1024, 128, 128, 128);
            }
            k_lru<<<T * 1024 / 256, 256, 0, st>>>(RPRE, IPRE, XC, rec_lam + j * 1024, Aa, Bb);
            k_scan<<<4096 / 256, 256, 0, st>>>(Aa, Bb, Yv);
            k_gy<<<T * 1024 / 256, 256, 0, st>>>(PROJ, Yv, ATT);
            k_gemm<EpiResid><<<dim3(D / 64, T / 64), 256, 0, st>>>(ATT, nullptr, rec_w_out + (size_t)j * 1024 * D, nullptr, 0, EpiResid{X, modl + 2048, rec_b_out + j * D}, 1024, D, D, 1024);
        }
        (void)hipMemsetAsync(ictl, 0, 1024 * 4, st);
        (void)hipMemsetAsync(rowtok, 0, (size_t)P * 4, st);
        k_router<<<T, 256, 0, st>>>(X, n2g + l * D, modl, w_router + (size_t)l * D * NE, b_router + l * NE, HN, topi, topg, cnt);
        k_plan<<<1, 64, 0, st>>>(cnt, pstart, tile_e);
        k_scatter<<<MPAIR / 256, 256, 0, st>>>(topi, pstart, fill, rowtok, pos);
        k_gemm<EpiStore><<<dim3(2048 / 64, P / 64), 256, 0, st>>>(HN, rowtok, w1 + (size_t)l * NE * D * 2048, tile_e, (size_t)D * 2048, EpiStore{HB, b1 + (size_t)l * NE * 2048, 2048, 2048}, D, 2048, 2048, D);
        k_swiglu<<<P, 256, 0, st>>>(HB, tile_e, ACT);
        k_gemm<EpiStore><<<dim3(1024 / 64, P / 64), 256, 0, st>>>(ACT, nullptr, w2 + (size_t)l * NE * 1024 * D, tile_e, (size_t)1024 * D, EpiStore{Y2, b2 + (size_t)l * NE * D, 1024, D}, 1024, D, D, 1024);
        k_combine<<<T, 256, 0, st>>>(X, Y2, pos, topg, modl);
    }
}
}


namespace mk {
#define LAS __attribute__((address_space(3)))
#define GAS __attribute__((address_space(1)))
typedef unsigned short bf16_t;
typedef short bf16x8 __attribute__((ext_vector_type(8)));
typedef short s16x4 __attribute__((ext_vector_type(4)));
typedef float f32x2 __attribute__((ext_vector_type(2)));
typedef float f32x4 __attribute__((ext_vector_type(4)));
typedef float f32x16 __attribute__((ext_vector_type(16)));
typedef unsigned u32x2 __attribute__((ext_vector_type(2)));
typedef unsigned u32x4 __attribute__((ext_vector_type(4)));
typedef GAS unsigned gu32;
#define RLX_AGENT __ATOMIC_RELAXED, __HIP_MEMORY_SCOPE_AGENT

__device__ __forceinline__ unsigned cvt_pk_bf16(float lo, float hi) { unsigned r; asm volatile("v_cvt_pk_bf16_f32 %0, %1, %2" : "=v"(r) : "v"(lo), "v"(hi)); return r; }
__device__ __forceinline__ float bf_lo(unsigned u) { return __uint_as_float(u << 16); }
__device__ __forceinline__ float bf_hi(unsigned u) { return __uint_as_float(u & 0xffff0000u); }
template <int O> __device__ __forceinline__ float shx(float v) { static_assert(O >= 1 && O < 32, "shx"); return __int_as_float(__builtin_amdgcn_ds_swizzle(__float_as_int(v), (O << 10) | 0x1f)); }
__device__ __forceinline__ float xadd32(float v) { const auto r = __builtin_amdgcn_permlane32_swap(__float_as_uint(v), __float_as_uint(v), false, false); return __uint_as_float(r[0]) + __uint_as_float(r[1]); }
__device__ __forceinline__ float xmax32(float v) { const auto r = __builtin_amdgcn_permlane32_swap(__float_as_uint(v), __float_as_uint(v), false, false); return fmaxf(__uint_as_float(r[0]), __uint_as_float(r[1])); }
__device__ __forceinline__ float wsum(float v) { v += shx<1>(v); v += shx<2>(v); v += shx<4>(v); v += shx<8>(v); v += shx<16>(v); return xadd32(v); }
__device__ __forceinline__ float fexp2(float x) { return __builtin_amdgcn_exp2f(x); }
__device__ __forceinline__ float frcp(float x) { return __builtin_amdgcn_rcpf(x); }
__device__ __forceinline__ float fsigmoid(float z) { return frcp(1.f + fexp2(-1.4426950408889634f * z)); }
__device__ __forceinline__ float fgelu_tanh(float x) { const float u = 0.7978845608028654f * (x + 0.044715f * x * x * x); return x * frcp(1.f + fexp2(-2.8853900817779268f * u)); }

#define XB_TMO      128
#define XB_XCNT(j)  (256  + 64 * (j))
#define XB_XSUB(j)  (1280 + 64 * (j))
#define XB_XGEN(j)  (2304 + 64 * (j))
#define XB_TOP      3328
#define XB_TOPGEN   3392
#define XCD_BAR_WORDS 3456
#define XB_SPIN_CAP (1u << 18)
__device__ __forceinline__ unsigned xb_ld(unsigned* p)              { return __hip_atomic_load(p, __ATOMIC_RELAXED, __HIP_MEMORY_SCOPE_AGENT); }
__device__ __forceinline__ unsigned xb_add(unsigned* p, unsigned v) { return __hip_atomic_fetch_add(p, v, __ATOMIC_RELAXED, __HIP_MEMORY_SCOPE_AGENT); }
__device__ __forceinline__ unsigned xb_xcc_id() { return (unsigned)__builtin_amdgcn_s_getreg((3 << 11) | 20) & 0xFu; }
#define XB_SPIN(cond, bar) do { unsigned _sp = 0; while (cond) { __builtin_amdgcn_s_sleep(1); \
    if ((++_sp & 255u) == 0u) { if (xb_ld(&(bar)[XB_TMO])) break; if (_sp > XB_SPIN_CAP) { atomicAdd(&(bar)[XB_TMO], 1u); break; } } } } while (0)
struct XcdBarrier { unsigned* bar; unsigned x; volatile LAS unsigned* st; };
__device__ __forceinline__ XcdBarrier xcd_barrier_post(unsigned* bar, volatile LAS unsigned* st, int tid) {
    XcdBarrier b; b.bar = bar; b.x = xb_xcc_id(); b.st = st;
    if (tid == 0) (void)xb_add(&bar[XB_XCNT(b.x)], 1u);
    return b;
}
__device__ __forceinline__ void xcd_barrier_complete(unsigned* bar, unsigned x, unsigned& nloc, unsigned& nx) {
    const unsigned G = gridDim.x * gridDim.y * gridDim.z;
    unsigned sum, cnt, mine, sp = 0u;
    for (;;) {
        sum = 0u; cnt = 0u; mine = 0u;
#pragma unroll
        for (unsigned j = 0; j < 16; ++j) { const unsigned c = xb_ld(&bar[XB_XCNT(j)]); sum += c; cnt += (c > 0u) ? 1u : 0u; mine = (j == x) ? c : mine; }
        if (sum == G) break;
        __builtin_amdgcn_s_sleep(1);
        if ((++sp & 255u) == 0u) { if (xb_ld(&bar[XB_TMO])) break; if (sp > XB_SPIN_CAP) { atomicAdd(&bar[XB_TMO], 1u); break; } }
    }
    nloc = mine > 0u ? mine : 1u; nx = cnt > 0u ? cnt : 1u;
}
__device__ __forceinline__ void xcd_barrier(const XcdBarrier& b, int tid) {
    asm volatile("s_waitcnt vmcnt(0)" ::: "memory");
    __syncthreads();
    if (tid == 0) {
        unsigned* bar = b.bar;
        __builtin_amdgcn_s_waitcnt(0);
        unsigned nloc = b.st[0], nx = b.st[1];
        if (nloc == 0u) { xcd_barrier_complete(bar, b.x, nloc, nx); b.st[0] = nloc; b.st[1] = nx; }
        const unsigned old = xb_add(&bar[XB_XSUB(b.x)], 1u);
        const unsigned gen = old / nloc;
        if (old + 1u == (gen + 1u) * nloc) {
            __builtin_amdgcn_fence(__ATOMIC_RELEASE, "agent");
            asm volatile("s_waitcnt vmcnt(0)" ::: "memory");
            const unsigned og = xb_add(&bar[XB_TOP], 1u);
            const unsigned tg = og / nx;
            if (og + 1u == (tg + 1u) * nx) xb_add(&bar[XB_TOPGEN], 1u);
            else XB_SPIN(xb_ld(&bar[XB_TOPGEN]) == tg, bar);
            __builtin_amdgcn_fence(__ATOMIC_ACQUIRE, "agent");
            xb_add(&bar[XB_XGEN(b.x)], 1u);
            asm volatile("s_waitcnt vmcnt(0)" ::: "memory");
        } else {
            XB_SPIN(xb_ld(&bar[XB_XGEN(b.x)]) == gen, bar);
            __builtin_amdgcn_fence(__ATOMIC_ACQUIRE, "agent");
            asm volatile("s_waitcnt vmcnt(0)" ::: "memory");
        }
    }
    __syncthreads();
}

constexpr int BM = 256, BK = 64, HALF = 128, HTB = HALF * BK * 2, STAGE_BYTES = 8 * HTB;
__host__ __device__ __forceinline__ int lds_byte(int r, int c) { const int st = (r >> 4) * 2 + (c >> 5), rr = r & 15, cc = c & 31, ob = rr * 64 + cc * 2; return st * 1024 + (ob ^ (((ob >> 9) & 1) << 5)); }
__host__ __device__ __forceinline__ void stage_rc(int b, int& R, int& C) { const int st = b / 1024, sb = b % 1024, swz = sb ^ (((sb >> 9) & 1) << 5); R = (st >> 1) * 16 + swz / 64; C = (st & 1) * 32 + (swz % 64) / 2; }
__host__ __device__ __forceinline__ int perm32(int rho) { const int n = rho >> 4, i = rho & 15; return 8 * (i >> 2) + 4 * n + (i & 3); }

struct Unit { const char* a; const char* b; int row0, col0, e, pad; };
struct GemmDims { int K, lda, ldb; };
typedef f32x4 Acc[2][2][4][2];
__device__ __forceinline__ void zero_acc(Acc& acc) {
#pragma unroll
    for (int a = 0; a < 2; ++a)
#pragma unroll
        for (int b = 0; b < 2; ++b)
#pragma unroll
            for (int m = 0; m < 4; ++m)
#pragma unroll
                for (int n = 0; n < 2; ++n)
#pragma unroll
                    for (int j = 0; j < 4; ++j) { float z; asm volatile("v_mov_b32 %0, 0" : "=v"(z)); acc[a][b][m][n][j] = z; }
}

typedef int v8i32 __attribute__((ext_vector_type(8)));
template <bool F8 = false, class CtxT, class Epi, class Sched>
__device__ __forceinline__ void gemm_phase(const CtxT& C, const GemmDims g, const Sched& S, const Epi& E) {
    LAS unsigned char* lds = C.lds;
    const int tid = C.tid, wid = __builtin_amdgcn_readfirstlane(tid >> 6), lane = tid & 63, wr = wid >> 2, wc = wid & 3, fr = lane & 15, fq = lane >> 4;
    constexpr int ESZ = F8 ? 1 : 2;
    int nt = g.K / (F8 ? 128 : BK); asm volatile("" : "+s"(nt));
    unsigned voffA[2], voffB[2];
#pragma unroll
    for (int i = 0; i < 2; ++i) { int R, C; stage_rc(tid * 16 + i * 8192, R, C); const int Rb = (R & ~31) + perm32(R & 31);
        voffA[i] = (unsigned)(R * g.lda * ESZ + C * 2); voffB[i] = (unsigned)(Rb * g.ldb * ESZ + C * 2); }
    const size_t kstep = (size_t)(BK * 2);
    const size_t hstepA = (size_t)HALF * g.lda * ESZ, hstepB = (size_t)HALF * g.ldb * ESZ;
    const unsigned ldsw = (unsigned)wid * 1024u;
    const unsigned ldsu = (unsigned)__builtin_amdgcn_readfirstlane((int)(unsigned)(unsigned long long)(lds));
    const int aoff = lds_byte(wr * 64 + fr, fq * 8), boff = lds_byte(wc * 32 + fr, fq * 8);
#define PG8_SA(b, h) (((b) * 2 + (h)) * HTB)
#define PG8_SB(b, h) ((4 + (b) * 2 + (h)) * HTB)
#define PG8_STAGE(bufoff, gbase, voff) do { _Pragma("unroll") for (int _i = 0; _i < 2; ++_i) { \
        asm volatile("s_mov_b32 m0, %2\n\ts_nop 3\n\tglobal_load_lds_dwordx4 %0, %1" :: "v"((voff)[_i]), "s"((const char*)(gbase)), "s"(ldsu + (unsigned)(bufoff) + ldsw + (unsigned)(_i * 8192)) : "memory"); } } while (0)
#define PG8_LDA(dst, b, h) do { _Pragma("unroll") for (int m = 0; m < 4; ++m) _Pragma("unroll") for (int k = 0; k < 2; ++k) dst[m][k] = *(const LAS bf16x8*)(lds + PG8_SA(b, h) + aoff + m * 2048 + k * 1024); } while (0)
#define PG8_LDB(dst, b, h) do { _Pragma("unroll") for (int n = 0; n < 2; ++n) _Pragma("unroll") for (int k = 0; k < 2; ++k) dst[n][k] = *(const LAS bf16x8*)(lds + PG8_SB(b, h) + boff + n * 2048 + k * 1024); } while (0)
#define PG8_CAT(x) __builtin_bit_cast(v8i32, (x))
#define PG8_MMA(ai, bj, At, Bt) do { __builtin_amdgcn_s_setprio(1); \
        if constexpr (F8) { _Pragma("unroll") for (int m = 0; m < 4; ++m) _Pragma("unroll") for (int n = 0; n < 2; ++n) \
            acc[ai][bj][m][n] = __builtin_amdgcn_mfma_scale_f32_16x16x128_f8f6f4(PG8_CAT(Bt[n]), PG8_CAT(At[m]), acc[ai][bj][m][n], 0, 0, 0, 0, 0, 0); } \
        else { _Pragma("unroll") for (int m = 0; m < 4; ++m) _Pragma("unroll") for (int n = 0; n < 2; ++n) _Pragma("unroll") for (int k = 0; k < 2; ++k) \
            acc[ai][bj][m][n] = __builtin_amdgcn_mfma_f32_16x16x32_bf16(Bt[n][k], At[m][k], acc[ai][bj][m][n], 0, 0, 0); } \
        __builtin_amdgcn_s_setprio(0); } while (0)
#define PG8_WAIT_V(n) asm volatile("s_waitcnt vmcnt(" #n ")" ::: "memory")
#define PG8_WAIT_L(n) asm volatile("s_waitcnt lgkmcnt(" #n ")" ::: "memory")
#define PG8_BAR __builtin_amdgcn_s_barrier()
#define PG8_SCHED __builtin_amdgcn_sched_barrier(0)
    Unit cur, nxt; int ui = 0;
    if (!S.next(0, cur)) return;
    Acc acc; zero_acc(acc);
    struct Frag2 { bf16x8 p[2]; __device__ __forceinline__ bf16x8& operator[](int k) { return p[k]; } __device__ __forceinline__ const bf16x8& operator[](int k) const { return p[k]; } };
    Frag2 At[4], B0[2], B1[2];
    const char* cA = cur.a; const char* cB = cur.b;
    PG8_STAGE(PG8_SB(0, 0), cB, voffB); PG8_STAGE(PG8_SB(0, 1), cB + hstepB, voffB); PG8_STAGE(PG8_SA(0, 0), cA, voffA); PG8_STAGE(PG8_SA(0, 1), cA + hstepA, voffA);
    if (wr == 1) PG8_BAR;
    PG8_WAIT_V(2); PG8_BAR;
    PG8_STAGE(PG8_SB(1, 0), cB + kstep, voffB); PG8_STAGE(PG8_SA(1, 0), cA + kstep, voffA); PG8_STAGE(PG8_SB(1, 1), cB + hstepB + kstep, voffB);
    PG8_WAIT_V(6); PG8_BAR;
    for (;;) {
        const bool has_next = S.next(ui + 1, nxt);
        const char* nA = has_next ? nxt.a : cA; const char* nB = has_next ? nxt.b : cB;
        for (int t = 0; t < nt; t += 2) {
            const bool last = (t == nt - 2);
            const char* a1 = cA + (size_t)(t + 1) * kstep;
            const char* a2 = last ? nA : cA + (size_t)(t + 2) * kstep; const char* b2 = last ? nB : cB + (size_t)(t + 2) * kstep;
            const char* a3 = a2 + kstep; const char* b3 = b2 + kstep;
            PG8_LDB(B0, 0, 0); PG8_LDB(B1, 0, 1); PG8_SCHED; PG8_LDA(At, 0, 0); PG8_STAGE(PG8_SA(1, 1), a1 + hstepA, voffA);
            PG8_WAIT_V(8); PG8_WAIT_L(0); PG8_BAR; PG8_MMA(0, 0, At, B0); PG8_MMA(0, 1, At, B1); PG8_BAR; PG8_SCHED;
            PG8_LDA(At, 0, 1); PG8_STAGE(PG8_SB(0, 0), b2, voffB); PG8_STAGE(PG8_SB(0, 1), b2 + hstepB, voffB); PG8_STAGE(PG8_SA(0, 0), a2, voffA);
            PG8_WAIT_V(8); PG8_WAIT_L(0); PG8_BAR; PG8_MMA(1, 0, At, B0); PG8_MMA(1, 1, At, B1); PG8_BAR; PG8_SCHED;
            PG8_LDB(B0, 1, 0); PG8_LDB(B1, 1, 1); PG8_SCHED; PG8_LDA(At, 1, 0); PG8_STAGE(PG8_SA(0, 1), a2 + hstepA, voffA);
            PG8_WAIT_V(8); PG8_WAIT_L(0); PG8_BAR; PG8_MMA(0, 0, At, B0); PG8_MMA(0, 1, At, B1); PG8_BAR; PG8_SCHED;
            PG8_LDA(At, 1, 1); PG8_STAGE(PG8_SB(1, 0), b3, voffB); PG8_STAGE(PG8_SB(1, 1), b3 + hstepB, voffB); PG8_STAGE(PG8_SA(1, 0), a3, voffA);
            PG8_WAIT_V(8); PG8_WAIT_L(0); PG8_BAR; PG8_MMA(1, 0, At, B0); PG8_MMA(1, 1, At, B1); PG8_BAR; PG8_SCHED;
        }
        if (wr == 0) PG8_BAR;
        E(acc, cur, wr, wc, fr, fq);
        if (!has_next) break;
        zero_acc(acc);
        cur = nxt; cA = nA; cB = nB; ++ui;
        if (wr == 1) PG8_BAR;
    }
    PG8_WAIT_V(0);
    PG8_BAR;
#undef PG8_SA
#undef PG8_SB
#undef PG8_STAGE
#undef PG8_LDA
#undef PG8_LDB
#undef PG8_MMA
#undef PG8_CAT
#undef PG8_WAIT_V
#undef PG8_WAIT_L
#undef PG8_BAR
#undef PG8_SCHED
}

struct DenseOrder {
    const char* A; const char* Bt; int lda, ldb, nM, nN, nwg, G, c;
    __device__ __forceinline__ void init(const void* A_, const void* Bt_, int lda_, int ldb_, int M, int N, int G_, int c_) { A = (const char*)A_; Bt = (const char*)Bt_; lda = lda_; ldb = ldb_; nM = M / BM; nN = N / BM; nwg = nM * nN; G = G_; c = c_; }
    __device__ __forceinline__ bool next(int i, Unit& u) const {
        const long L = (long)i * G + c; if (L >= nwg) return false;
        int wgid = (int)L; { const int q = nwg / 8, r = nwg % 8, xcd = wgid % 8, off = wgid / 8; wgid = (xcd < r ? xcd * (q + 1) : r * (q + 1) + (xcd - r) * q) + off; }
        const int nig = 8 * nN, gid = wgid / nig, fm = gid * 8, gsz = (nM - fm) < 8 ? (nM - fm) : 8;
        const int pm = fm + ((wgid % nig) % gsz), pn = (wgid % nig) / gsz;
        u.a = A + (size_t)pm * BM * lda * 2; u.b = Bt + (size_t)pn * BM * ldb * 2; u.row0 = pm * BM; u.col0 = pn * BM; u.e = 0; u.pad = 0; return true;
    }
};
struct LruOrder {
    const char* XC; const char* RG; int G, c;
    __device__ __forceinline__ bool next(int i, Unit& u) const {
        const int L = i * G + c; if (L >= 512) return false;
        const int pm = L >> 3, n = L & 7;
        u.a = XC + ((size_t)pm * BM * 1024 + n * 128) * 2; u.b = RG + (size_t)n * 256 * 128 * 2; u.row0 = pm * BM; u.col0 = n * 128; u.e = n; u.pad = 0; return true;
    }
};
struct MoeOrder {
    const char* A; const char* WT; size_t estride; const LAS int* tile_e; int NT, nN, G, c, esz;
    __device__ __forceinline__ bool next(int i, Unit& u) const {
        int tile, pn;
        if ((G % (8 * nN)) == 0) { const int R = G / nN; tile = i * R + (c & 7) * (R >> 3) + (c >> 3) / nN; pn = (c >> 3) % nN; }
        else { const int L = i * G + c; tile = L / nN; pn = L % nN; }
        if (tile >= NT) return false;
        const int e = __builtin_amdgcn_readfirstlane(tile_e[tile]);
        u.a = A + (size_t)tile * BM * 1024 * esz; u.b = WT + (size_t)e * estride + (size_t)pn * BM * 1024 * esz; u.row0 = tile * BM; u.col0 = pn * BM; u.e = e; u.pad = 0; return true;
    }
};

#define EPI_ROW(ai, m) (u.row0 + (ai) * HALF + wr * 64 + (m) * 16 + fr)
#define EPI_COL(bj) (u.col0 + (bj) * HALF + wc * 32 + 8 * fq)
struct EpiBf16 {
    bf16_t* O; const float* bias; int ldc, bias_es; float ascale;
    __device__ __forceinline__ void operator()(const Acc& acc, const Unit& u, int wr, int wc, int fr, int fq) const {
        f32x4 bv[2][2];
#pragma unroll
        for (int bj = 0; bj < 2; ++bj)
#pragma unroll
            for (int n = 0; n < 2; ++n) bv[bj][n] = bias ? *(const f32x4*)(bias + (size_t)u.e * bias_es + EPI_COL(bj) + 4 * n) : (f32x4){0.f, 0.f, 0.f, 0.f};
#pragma unroll
        for (int ai = 0; ai < 2; ++ai)
#pragma unroll
            for (int m = 0; m < 4; ++m) { bf16_t* rowp = O + (size_t)EPI_ROW(ai, m) * ldc;
#pragma unroll
                for (int bj = 0; bj < 2; ++bj) { const f32x4 v0 = acc[ai][bj][m][0] * ascale + bv[bj][0], v1 = acc[ai][bj][m][1] * ascale + bv[bj][1];
                    u32x4 w; w.x = cvt_pk_bf16(v0[0], v0[1]); w.y = cvt_pk_bf16(v0[2], v0[3]); w.z = cvt_pk_bf16(v1[0], v1[1]); w.w = cvt_pk_bf16(v1[2], v1[3]);
                    *(u32x4*)(rowp + EPI_COL(bj)) = w; } }
    }
};
template <int KIND> struct EpiNorm {
    bf16_t* O; int ldc; const float* ga; const float* gb; const float* gc; const float* gd; const float* ge; const float* cs; LAS float* S;
    __device__ __forceinline__ void operator()(const Acc& acc, const Unit& u, int wr, int wc, int fr, int fq) const {
        const int pn = u.col0 >> 8; const int lane = fr + 16 * fq;
        int mode = 0; const float* gp = ga; float scale = 1.f;
        if (KIND == 0) { if (pn < 2) { mode = 1; gp = ga; scale = 0.125f * 1.4426950408889634f; } else if (pn < 4) { mode = 1; gp = gb; } else if (pn < 6) mode = 0; else if (pn == 6) { mode = 2; gp = gc; } else { mode = 3; gp = gd; } }
        if (KIND == 1) { scale = 0.10206207261596575f * 1.4426950408889634f; if (pn < 2) { mode = 1; gp = ga; } else { mode = 4; gp = gb; } }
        if (KIND == 2) { if (pn < 2) { mode = 1; gp = ga; } else mode = 0; }
        float ss[2][4][2];
        if (mode != 0) {
#pragma unroll
            for (int ai = 0; ai < 2; ++ai)
#pragma unroll
                for (int m = 0; m < 4; ++m)
#pragma unroll
                    for (int bj = 0; bj < 2; ++bj) { const f32x4 a = acc[ai][bj][m][0], b = acc[ai][bj][m][1];
                        float s = (a[0] * a[0] + a[1] * a[1]) + (a[2] * a[2] + a[3] * a[3]) + (b[0] * b[0] + b[1] * b[1]) + (b[2] * b[2] + b[3] * b[3]);
                        s += shx<16>(s); ss[ai][m][bj] = xadd32(s); } }
        if (mode == 1 || mode == 2 || mode == 3) {
            if (fq == 0) {
#pragma unroll
                for (int ai = 0; ai < 2; ++ai)
#pragma unroll
                    for (int m = 0; m < 4; ++m)
#pragma unroll
                        for (int bj = 0; bj < 2; ++bj) S[(ai * HALF + wr * 64 + m * 16 + fr) * 8 + bj * 4 + wc] = ss[ai][m][bj]; }
            asm volatile("s_waitcnt lgkmcnt(0)" ::: "memory"); __builtin_amdgcn_s_barrier(); asm volatile("" ::: "memory");
#pragma unroll
            for (int ai = 0; ai < 2; ++ai)
#pragma unroll
                for (int m = 0; m < 4; ++m) { const LAS float* sr = S + (ai * HALF + wr * 64 + m * 16 + fr) * 8;
#pragma unroll
                    for (int bj = 0; bj < 2; ++bj) {
                        if (mode == 1) { const f32x2 t = *(const LAS f32x2*)(sr + bj * 4 + (wc & 2)); ss[ai][m][bj] = t[0] + t[1]; }
                        else if (mode == 2) { const f32x4 t0 = *(const LAS f32x4*)sr, t1 = *(const LAS f32x4*)(sr + 4); ss[ai][m][bj] = (t0[0] + t0[1]) + (t0[2] + t0[3]) + (t1[0] + t1[1]) + (t1[2] + t1[3]); }
                        else if (bj == 0) { const f32x4 t0 = *(const LAS f32x4*)sr; ss[ai][m][bj] = (t0[0] + t0[1]) + (t0[2] + t0[3]); } } }
        }
        const float inv_n = (mode == 1) ? (1.f / 64.f) : (mode == 2) ? (1.f / 256.f) : (1.f / 32.f);
        const bool rope_tile = (mode == 4) || (mode == 3);
#pragma unroll
        for (int bj = 0; bj < 2; ++bj) {
            f32x4 g0 = (f32x4){1.f, 1.f, 1.f, 1.f}, g1 = g0; bool rope = false, zero = false; float invn = inv_n;
            const int c8 = 8 * fq;
            if (mode == 1) { const int c = 32 * (wc & 1) + c8; g0 = *(const f32x4*)(gp + c); g1 = *(const f32x4*)(gp + c + 4); }
            else if (mode == 2) { const int c = bj * HALF + wc * 32 + c8; g0 = *(const f32x4*)(gp + c); g1 = *(const f32x4*)(gp + c + 4); }
            else if (mode == 3) { if (bj == 0) { const int c = wc * 32 + c8; g0 = *(const f32x4*)(gp + c); g1 = *(const f32x4*)(gp + c + 4); invn = 1.f / 128.f; }
                                  else if (wc == 0) { g0 = *(const f32x4*)(ge + c8); g1 = *(const f32x4*)(ge + c8 + 4); rope = true; } else zero = true; }
            else if (mode == 4) { g0 = *(const f32x4*)(gp + c8); g1 = *(const f32x4*)(gp + c8 + 4); rope = true; }
            (void)rope_tile;
#pragma unroll
            for (int ai = 0; ai < 2; ++ai)
#pragma unroll
                for (int m = 0; m < 4; ++m) { const int row = EPI_ROW(ai, m);
                    f32x4 v0 = acc[ai][bj][m][0], v1 = acc[ai][bj][m][1];
                    if (mode != 0) { const float rs = rsqrtf(ss[ai][m][bj] * invn + 1e-6f) * scale; v0 = v0 * rs * g0; v1 = v1 * rs * g1; }
                    if (rope) {
                        const float* cr = cs + (size_t)row * 32 + 8 * (fq & 1); const f32x4 c0 = *(const f32x4*)cr, c1 = *(const f32x4*)(cr + 4), s0 = *(const f32x4*)(cr + 16), s1 = *(const f32x4*)(cr + 20);
                        f32x4 o0, o1;
#pragma unroll
                        for (int j = 0; j < 4; ++j) { const auto r0 = __builtin_amdgcn_permlane32_swap(__float_as_uint(v0[j]), __float_as_uint(v0[j]), false, false), r1 = __builtin_amdgcn_permlane32_swap(__float_as_uint(v1[j]), __float_as_uint(v1[j]), false, false);
                            const float ot0 = __uint_as_float(lane < 32 ? r0[1] : r0[0]), ot1 = __uint_as_float(lane < 32 ? r1[1] : r1[0]);
                            o0[j] = (lane < 32) ? (v0[j] * c0[j] - ot0 * s0[j]) : (ot0 * s0[j] + v0[j] * c0[j]);
                            o1[j] = (lane < 32) ? (v1[j] * c1[j] - ot1 * s1[j]) : (ot1 * s1[j] + v1[j] * c1[j]); }
                        v0 = o0; v1 = o1; }
                    if (zero) { v0 = (f32x4){0.f, 0.f, 0.f, 0.f}; v1 = v0; }
                    u32x4 w; w.x = cvt_pk_bf16(v0[0], v0[1]); w.y = cvt_pk_bf16(v0[2], v0[3]); w.z = cvt_pk_bf16(v1[0], v1[1]); w.w = cvt_pk_bf16(v1[2], v1[3]);
                    *(u32x4*)(O + (size_t)row * ldc + EPI_COL(bj)) = w; } }
    }
};
struct EpiRecIn {
    bf16_t* O; const float* bias;
    __device__ __forceinline__ void operator()(const Acc& acc, const Unit& u, int wr, int wc, int fr, int fq) const {
        const bool act = u.col0 < 1024;
        f32x4 bv[2][2];
#pragma unroll
        for (int bj = 0; bj < 2; ++bj)
#pragma unroll
            for (int n = 0; n < 2; ++n) bv[bj][n] = *(const f32x4*)(bias + EPI_COL(bj) + 4 * n);
#pragma unroll
        for (int ai = 0; ai < 2; ++ai)
#pragma unroll
            for (int m = 0; m < 4; ++m) { bf16_t* rowp = O + (size_t)EPI_ROW(ai, m) * 2048;
#pragma unroll
                for (int bj = 0; bj < 2; ++bj) { f32x4 v0 = acc[ai][bj][m][0] + bv[bj][0], v1 = acc[ai][bj][m][1] + bv[bj][1];
                    if (act) {
#pragma unroll
                        for (int j = 0; j < 4; ++j) { v0[j] = fgelu_tanh(v0[j]); v1[j] = fgelu_tanh(v1[j]); } }
                    u32x4 w; w.x = cvt_pk_bf16(v0[0], v0[1]); w.y = cvt_pk_bf16(v0[2], v0[3]); w.z = cvt_pk_bf16(v1[0], v1[1]); w.w = cvt_pk_bf16(v1[2], v1[3]);
                    *(u32x4*)(rowp + EPI_COL(bj)) = w; } }
    }
};
__device__ __forceinline__ unsigned pk4_fp8(float a, float b, float c, float d) { int w = 0; w = __builtin_amdgcn_cvt_pk_fp8_f32(a, b, w, false); w = __builtin_amdgcn_cvt_pk_fp8_f32(c, d, w, true); return (unsigned)w; }
struct EpiSwiglu {
    unsigned char* ACT; const float* b1; float ascale;
    __device__ __forceinline__ float sw(float g, float l) const { g = fminf(g, 7.f); l = fminf(fmaxf(l, -7.f), 7.f); return g * fsigmoid(1.702f * g) * (l + 1.f); }
    __device__ __forceinline__ void operator()(const Acc& acc, const Unit& u, int wr, int wc, int fr, int fq) const {
        f32x4 bv[2][2];
#pragma unroll
        for (int bj = 0; bj < 2; ++bj)
#pragma unroll
            for (int n = 0; n < 2; ++n) bv[bj][n] = *(const f32x4*)(b1 + (size_t)u.e * 2048 + EPI_COL(bj) + 4 * n);
#pragma unroll
        for (int ai = 0; ai < 2; ++ai)
#pragma unroll
            for (int m = 0; m < 4; ++m) { unsigned char* rowp = ACT + (size_t)EPI_ROW(ai, m) * 1024;
#pragma unroll
                for (int bj = 0; bj < 2; ++bj) { const f32x4 v0 = acc[ai][bj][m][0] * ascale + bv[bj][0], v1 = acc[ai][bj][m][1] * ascale + bv[bj][1];
                    *(unsigned*)(rowp + (EPI_COL(bj) >> 1)) = pk4_fp8(sw(v0[0], v0[1]), sw(v0[2], v0[3]), sw(v1[0], v1[1]), sw(v1[2], v1[3])); } }
    }
};
struct EpiResid {
    bf16_t* X; const float* g; const float* bias;
    __device__ __forceinline__ void operator()(const Acc& acc, const Unit& u, int wr, int wc, int fr, int fq) const {
        const int b = u.row0 / cfg::S;
        f32x4 bv[2][2], gv[2][2];
#pragma unroll
        for (int bj = 0; bj < 2; ++bj)
#pragma unroll
            for (int n = 0; n < 2; ++n) { bv[bj][n] = bias ? *(const f32x4*)(bias + EPI_COL(bj) + 4 * n) : (f32x4){0.f, 0.f, 0.f, 0.f}; gv[bj][n] = *(const f32x4*)(g + b * 6144 + EPI_COL(bj) + 4 * n); }
#pragma unroll
        for (int ai = 0; ai < 2; ++ai)
#pragma unroll
            for (int m = 0; m < 4; ++m) { bf16_t* rowp = X + (size_t)EPI_ROW(ai, m) * 1024;
#pragma unroll
                for (int bj = 0; bj < 2; ++bj) { u32x4* p = (u32x4*)(rowp + EPI_COL(bj)); const u32x4 xw = *p;
                    const f32x4 x0 = (f32x4){bf_lo(xw.x), bf_hi(xw.x), bf_lo(xw.y), bf_hi(xw.y)} + gv[bj][0] * (acc[ai][bj][m][0] + bv[bj][0]);
                    const f32x4 x1 = (f32x4){bf_lo(xw.z), bf_hi(xw.z), bf_lo(xw.w), bf_hi(xw.w)} + gv[bj][1] * (acc[ai][bj][m][1] + bv[bj][1]);
                    u32x4 w; w.x = cvt_pk_bf16(x0[0], x0[1]); w.y = cvt_pk_bf16(x0[2], x0[3]); w.z = cvt_pk_bf16(x1[0], x1[1]); w.w = cvt_pk_bf16(x1[2], x1[3]); *p = w; }
                if (m & 1) asm volatile("" ::: "memory"); }
    }
};
struct EpiLru {
    const bf16_t* XC; const float* ba; const float* bx; const float* lam; bf16_t* LA; bf16_t* Bb;
    __device__ __forceinline__ void operator()(const Acc& acc, const Unit& u, int wr, int wc, int fr, int fq) const {
        const int ch0 = u.col0 + wc * 32 + 8 * fq;
#pragma unroll
        for (int n = 0; n < 2; ++n) { const int ch = ch0 + 4 * n;
            const f32x4 bav = *(const f32x4*)(ba + ch), bxv = *(const f32x4*)(bx + ch), spv = *(const f32x4*)(lam + ch);
#pragma unroll
            for (int ai = 0; ai < 2; ++ai)
#pragma unroll
                for (int m = 0; m < 4; ++m) { const size_t ro = (size_t)EPI_ROW(ai, m) * 1024 + ch;
                    const u32x2 xr = *(const u32x2*)(XC + ro);
                    const float xcv[4] = {bf_lo(xr.x), bf_hi(xr.x), bf_lo(xr.y), bf_hi(xr.y)};
                    float lav[4], bvv[4];
#pragma unroll
                    for (int j = 0; j < 4; ++j) { const float r = fsigmoid(acc[ai][0][m][n][j] + bav[j]), ig = fsigmoid(acc[ai][1][m][n][j] + bxv[j]);
                        const float la = r * spv[j], a = fexp2(la); lav[j] = la; bvv[j] = __builtin_amdgcn_sqrtf(fmaxf(1.f - a * a, 0.f)) * ig * xcv[j]; }
                    u32x2 wa, wb; wa.x = cvt_pk_bf16(lav[0], lav[1]); wa.y = cvt_pk_bf16(lav[2], lav[3]); wb.x = cvt_pk_bf16(bvv[0], bvv[1]); wb.y = cvt_pk_bf16(bvv[2], bvv[3]);
                    *(u32x2*)(LA + ro) = wa; *(u32x2*)(Bb + ro) = wb; asm volatile("" ::: "memory"); } }
    }
};

constexpr size_t MiB = (size_t)1 << 20;
constexpr size_t al4k(size_t x) { return (x + 4095) & ~(size_t)4095; }
constexpr int T_ = cfg::T, S_ = cfg::S, P_ = cfg::P;
constexpr size_t O_CTL = 0, SZ_CTL = 1 * MiB;
constexpr size_t O_MOD = O_CTL + SZ_CTL, SZ_MOD = al4k((size_t)4 * 4 * 6144 * 4);
constexpr size_t O_CS = O_MOD + SZ_MOD, SZ_CS = (size_t)T_ * 32 * 4;
constexpr size_t O_HIST = O_CS + SZ_CS, SZ_HIST = 256 * 32 * 4;
constexpr size_t O_TOPI = O_HIST + SZ_HIST, SZ_TOP = (size_t)T_ * 4 * 4;
constexpr size_t O_TOPG = O_TOPI + SZ_TOP, O_POS = O_TOPG + SZ_TOP;
constexpr size_t O_SUMP = O_POS + SZ_TOP, SZ_SUM = (size_t)4 * 64 * 1024 * 4;
constexpr size_t O_SUMH = O_SUMP + SZ_SUM;
constexpr size_t O_LSE = O_SUMH + SZ_SUM, SZ_LSE = (size_t)3 * T_ * 8 * 4;
constexpr size_t O_SPV = al4k(O_LSE + SZ_LSE), SZ_SPV = 2 * 1024 * 4;
constexpr size_t O_WIN = al4k(O_SPV + SZ_SPV), SZ_WIN = (size_t)2048 * 1024 * 2;
constexpr size_t O_WUQ = O_WIN + 2 * SZ_WIN, SZ_WUQ = (size_t)768 * 256 * 2;
constexpr size_t O_WUKV = O_WUQ + 2 * SZ_WUQ, SZ_WUKV = (size_t)1024 * 128 * 2;
constexpr size_t O_WOUT = O_WUKV + 2 * SZ_WUKV, SZ_WOUT = (size_t)1024 * 1024 * 2;
constexpr size_t O_RWIN = O_WOUT + 2 * SZ_WOUT, SZ_RWIN = (size_t)2048 * 1024 * 2;
constexpr size_t O_RGATE = O_RWIN + 2 * SZ_RWIN, SZ_RGATE = (size_t)8 * 256 * 128 * 2;
constexpr size_t O_RWOUT = O_RGATE + 2 * SZ_RGATE, SZ_RWOUT = (size_t)1024 * 1024 * 2;
constexpr size_t O_W1 = O_RWOUT + 2 * SZ_RWOUT, SZ_W1E = (size_t)2048 * 1024;
constexpr size_t O_W2 = O_W1 + 128 * SZ_W1E, SZ_W2E = (size_t)1024 * 1024;
constexpr size_t O_HN = O_W2 + 128 * SZ_W2E, SZ_HN = (size_t)T_ * 1024 * 2;
constexpr size_t O_PROJ = O_HN + SZ_HN, SZ_PROJ = (size_t)T_ * 2048 * 2;
constexpr size_t O_Q2 = O_PROJ + SZ_PROJ, SZ_Q2 = (size_t)T_ * 768 * 2;
constexpr size_t O_KV2 = O_Q2 + SZ_Q2, SZ_KV2 = (size_t)T_ * 1024 * 2;
constexpr size_t O_OA = O_KV2 + SZ_KV2, SZ_OA = (size_t)3 * T_ * 512 * 2;
constexpr size_t O_ATT = O_OA + SZ_OA, SZ_ATT = (size_t)T_ * 1024 * 2;
constexpr size_t O_XC = O_ATT + SZ_ATT, SZ_XC = (size_t)T_ * 1024 * 2;
constexpr size_t O_AA = O_XC + SZ_XC, SZ_AA = (size_t)T_ * 1024 * 4;
constexpr size_t O_BB = O_AA + SZ_AA;
constexpr size_t O_XG = O_BB + SZ_AA, SZ_XG = (size_t)P_ * 1024 * 2;
constexpr size_t O_ACT = O_XG + SZ_XG, O_Y2 = O_ACT + SZ_XG;
constexpr size_t O_X = O_Y2 + SZ_XG, SZ_X = (size_t)T_ * 1024 * 2;
constexpr size_t O_DUMMY = O_X + SZ_X, SZ_DUMMY = (size_t)96 * MiB;
constexpr size_t WS_MK_END = O_DUMMY + SZ_DUMMY;
constexpr size_t O_NAIVE = (size_t)2048 * MiB;
static_assert(WS_MK_END <= O_NAIVE, "mk workspace");
constexpr int CW_BAR = 4096;
constexpr int RING_BYTES = 131072, LDSX_OFF = RING_BYTES;
constexpr int LDS_BYTES = 147456;
constexpr int LX_TILE = LDSX_OFF + 64, LX_MISC = LDSX_OFF + 2048, LX_EXCH = LDSX_OFF + 6144;

struct Args { const void* in[34]; float* out; unsigned char* ws; int ph_lo, ph_hi; };
struct Ctx { int tid, lane, wave, G, bid, vcu, gw, NGW; LAS unsigned char* lds; unsigned char* ws; };

__device__ __forceinline__ void conv_load(f32x4 (&v)[16], const float* __restrict__ W, int N, int n0, int k0, int lane) {
    const int n = n0 + 4 * (lane & 15); const float* p = W + (size_t)(k0 + 16 * (lane >> 4)) * N + n;
#pragma unroll
    for (int i = 0; i < 16; ++i) v[i] = (n < N) ? __builtin_nontemporal_load((const f32x4*)(p + (size_t)i * N)) : (f32x4){0.f, 0.f, 0.f, 0.f};
}
__device__ __forceinline__ int conv_row(int c, int perm) { if (perm == 1) { const int h = c / 96, d = c % 96; return d < 64 ? 64 * h + d : 512 + 32 * h + d - 64; } if (perm == 2) { const int h = c >> 7, d = c & 127; return d < 64 ? 64 * h + d : 512 + 64 * h + d - 64; } return c; }
__device__ __forceinline__ void conv_emit(const f32x4 (&v)[16], LAS unsigned char* T  , bf16_t* __restrict__ WT, int ldd, int n0, int k0, int lane, int perm) {
    const int kq = lane >> 4, c4 = lane & 15;
#pragma unroll
    for (int jj = 0; jj < 4; ++jj) { u32x4 lo, hi;
        lo.x = cvt_pk_bf16(v[0][jj], v[1][jj]); lo.y = cvt_pk_bf16(v[2][jj], v[3][jj]); lo.z = cvt_pk_bf16(v[4][jj], v[5][jj]); lo.w = cvt_pk_bf16(v[6][jj], v[7][jj]);
        hi.x = cvt_pk_bf16(v[8][jj], v[9][jj]); hi.y = cvt_pk_bf16(v[10][jj], v[11][jj]); hi.z = cvt_pk_bf16(v[12][jj], v[13][jj]); hi.w = cvt_pk_bf16(v[14][jj], v[15][jj]);
        LAS unsigned char* q = T + (4 * c4 + jj) * 144 + 32 * kq; *(LAS u32x4*)q = lo; *(LAS u32x4*)(q + 16) = hi; }
    asm volatile("s_waitcnt lgkmcnt(0)" ::: "memory");
#pragma unroll
    for (int s8 = 0; s8 < 8; ++s8) { const int n = 8 * s8 + (lane >> 3), ch = lane & 7; const u32x4 w = *(const LAS u32x4*)(T + n * 144 + 16 * ch);
        *(u32x4*)(WT + (size_t)conv_row(n0 + n, perm) * ldd + k0 + 8 * ch) = w; }
    asm volatile("s_waitcnt lgkmcnt(0)" ::: "memory");
}
__device__ __forceinline__ void conv8_tile(const float* __restrict__ W, int N, unsigned char* __restrict__ WT, int ldd, int n0, int k0, LAS unsigned char* T  , int lane) {
    const int kq = lane >> 4, c4 = lane & 15; const float* p = W + (size_t)(k0 + 32 * kq) * N + n0 + 4 * c4;
    f32x4 v[32];
#pragma unroll
    for (int i = 0; i < 32; ++i) v[i] = __builtin_nontemporal_load((const f32x4*)(p + (size_t)i * N));
#pragma unroll
    for (int jj = 0; jj < 4; ++jj) { u32x4 lo, hi;
        lo.x = pk4_fp8(32.f * v[0][jj], 32.f * v[1][jj], 32.f * v[2][jj], 32.f * v[3][jj]);     lo.y = pk4_fp8(32.f * v[4][jj], 32.f * v[5][jj], 32.f * v[6][jj], 32.f * v[7][jj]);
        lo.z = pk4_fp8(32.f * v[8][jj], 32.f * v[9][jj], 32.f * v[10][jj], 32.f * v[11][jj]);   lo.w = pk4_fp8(32.f * v[12][jj], 32.f * v[13][jj], 32.f * v[14][jj], 32.f * v[15][jj]);
        hi.x = pk4_fp8(32.f * v[16][jj], 32.f * v[17][jj], 32.f * v[18][jj], 32.f * v[19][jj]); hi.y = pk4_fp8(32.f * v[20][jj], 32.f * v[21][jj], 32.f * v[22][jj], 32.f * v[23][jj]);
        hi.z = pk4_fp8(32.f * v[24][jj], 32.f * v[25][jj], 32.f * v[26][jj], 32.f * v[27][jj]); hi.w = pk4_fp8(32.f * v[28][jj], 32.f * v[29][jj], 32.f * v[30][jj], 32.f * v[31][jj]);
        LAS unsigned char* q = T + (4 * c4 + jj) * 144 + 32 * kq; *(LAS u32x4*)q = lo; *(LAS u32x4*)(q + 16) = hi; }
    asm volatile("s_waitcnt lgkmcnt(0)" ::: "memory");
#pragma unroll
    for (int s8 = 0; s8 < 8; ++s8) { const int n = 8 * s8 + (lane >> 3), ch = lane & 7; const u32x4 w = *(const LAS u32x4*)(T + n * 144 + 16 * ch);
        *(u32x4*)(WT + (size_t)(n0 + n) * ldd + k0 + 16 * ch) = w; }
    asm volatile("s_waitcnt lgkmcnt(0)" ::: "memory");
}
template <class AP> __device__ __forceinline__ void p0_prologue(const Ctx& C, AP a) {
    unsigned char* ws = C.ws;
    { const float* c = (const float*)a->in[1]; const float* ada_w = (const float*)a->in[3]; const float* ada_b = (const float*)a->in[4]; float* mod = (float*)(ws + O_MOD);
      LAS float* part = (LAS float*)C.lds;
      LAS float* cact = (LAS float*)(C.lds + 32768);
      if (C.bid < 4 * 24) { for (int i = C.tid; i < 4096; i += 512) { const int b = i >> 10, k = i & 1023; const float cv = c[i]; cact[k * 4 + b] = cv / (1.f + expf(-cv)); } __syncthreads(); }
      for (int it = C.bid; it < 4 * 24; it += C.G) { const int l = it / 24, n0 = (it % 24) * 256;
          f32x4 acc[4];
#pragma unroll
          for (int b = 0; b < 4; ++b) acc[b] = (f32x4){0.f, 0.f, 0.f, 0.f};
          const float* w = ada_w + (size_t)l * 1024 * 6144 + n0 + 4 * C.lane;
#pragma unroll 1
          for (int k0 = C.wave * 128; k0 < C.wave * 128 + 128; k0 += 16) { f32x4 wv[16];
#pragma unroll
              for (int i = 0; i < 16; ++i) wv[i] = __builtin_nontemporal_load((const f32x4*)(w + (size_t)(k0 + i) * 6144));
#pragma unroll
              for (int i = 0; i < 16; ++i) { const f32x4 sv = *(const LAS f32x4*)(cact + (k0 + i) * 4);
#pragma unroll
                  for (int b = 0; b < 4; ++b) acc[b] = acc[b] + sv[b] * wv[i]; } }
#pragma unroll
          for (int b = 0; b < 4; ++b) *(LAS f32x4*)(part + (C.wave * 4 + b) * 256 + 4 * C.lane) = acc[b];
          __syncthreads();
          for (int o = C.tid; o < 1024; o += 512) { const int b = o >> 8, n = o & 255; float sacc = ada_b[l * 6144 + n0 + n];
#pragma unroll
              for (int w8 = 0; w8 < 8; ++w8) sacc += part[(w8 * 4 + b) * 256 + n];
              mod[((size_t)l * 4 + b) * 6144 + n0 + n] = sacc; }
          __syncthreads(); } }
    { const int* positions = (const int*)a->in[2]; float* cs = (float*)(ws + O_CS);
      for (int i = C.bid * 512 + C.tid; i < T_ * 16; i += C.G * 512) { const int t = i >> 4, f = i & 15; const float inv = powf(10000.f, -(float)(2 * f) / 32.f); const float ang = (float)positions[t] * inv;
          cs[t * 32 + f] = cosf(ang); cs[t * 32 + 16 + f] = sinf(ang); } }
    { const float* lam = (const float*)a->in[25]; float* spv = (float*)(ws + O_SPV);
      for (int i = C.bid * 512 + C.tid; i < 2048; i += C.G * 512) spv[i] = -8.f * 1.4426950408889634f * log1pf(expf(-lam[i])); }
    { const int lane = C.lane; LAS unsigned char* T = C.lds + 49152 + C.wave * 9216;
      const float* attn_w_in = (const float*)a->in[7]; const float* w_uq = (const float*)a->in[12]; const float* w_ukv = (const float*)a->in[13]; const float* attn_w_out = (const float*)a->in[16];
      const float* rec_w_in = (const float*)a->in[17]; const float* rec_wa = (const float*)a->in[21]; const float* rec_wx = (const float*)a->in[23]; const float* rec_w_out = (const float*)a->in[26];
      const float* w1 = (const float*)a->in[30]; const float* w2 = (const float*)a->in[32];
      constexpr int T_WIN = 32 * 16, T_WUQ = 12 * 4, T_WUKV = 16 * 2, T_WOUT = 16 * 16, T_RWIN = 32 * 16, T_RG = 2 * 2, T_RWOUT = 16 * 16, T_W1 = 32 * 16, T_W2 = 16 * 16;
      constexpr int NITEMS = 2 * (T_WIN + T_WUQ + T_WUKV + T_WOUT + T_RWIN + 16 * T_RG + T_RWOUT);
      struct Job { const float* W; bf16_t* WT; int N, ldd, n0, k0, perm; };
      auto decode = [&](int r, Job& jb) {
#define CONV_JOB(SRC, KK, NN, DST, NROWS, NMAT, SRC_MS, DST_MS, PERM) { constexpr int kc_ = (KK) / 64, per_ = ((NROWS) / 64) * kc_, tot_ = per_ * (NMAT); \
          if (r < tot_) { const int mat_ = r / per_, q_ = r % per_; jb.W = (SRC) + (size_t)mat_ * (SRC_MS); jb.WT = (bf16_t*)(ws + (DST) + (size_t)mat_ * (DST_MS)); jb.N = (NN); jb.ldd = (KK); jb.n0 = (q_ / kc_) * 64; jb.k0 = (q_ % kc_) * 64; jb.perm = (PERM); return; } r -= tot_; }
          CONV_JOB(attn_w_in, 1024, 1952, O_WIN, 2048, 2, (size_t)1024 * 1952, SZ_WIN, 0)
          CONV_JOB(w_uq, 256, 768, O_WUQ, 768, 2, (size_t)256 * 768, SZ_WUQ, 1)
          CONV_JOB(w_ukv, 128, 1024, O_WUKV, 1024, 2, (size_t)128 * 1024, SZ_WUKV, 2)
          CONV_JOB(attn_w_out, 1024, 1024, O_WOUT, 1024, 2, (size_t)1024 * 1024, SZ_WOUT, 0)
          CONV_JOB(rec_w_in, 1024, 2048, O_RWIN, 2048, 2, (size_t)1024 * 2048, SZ_RWIN, 0)
          CONV_JOB(rec_wa, 128, 128, O_RGATE, 128, 16, (size_t)128 * 128, (size_t)256 * 128 * 2, 0)
          CONV_JOB(rec_wx, 128, 128, O_RGATE + (size_t)128 * 128 * 2, 128, 16, (size_t)128 * 128, (size_t)256 * 128 * 2, 0)
          CONV_JOB(rec_w_out, 1024, 1024, O_RWOUT, 1024, 2, (size_t)1024 * 1024, SZ_RWOUT, 0)
#undef CONV_JOB
          jb.W = attn_w_in; jb.WT = (bf16_t*)(ws + O_WIN); jb.N = 1952; jb.ldd = 1024; jb.n0 = 0; jb.k0 = 0; jb.perm = 0; };
      f32x4 va[16], vb[16]; Job ja, jn;
      int it = C.gw;
      if (it < NITEMS) { decode(it, ja); conv_load(va, ja.W, ja.N, ja.n0, ja.k0, lane); }
#pragma unroll 1
      for (; it < NITEMS; it += 2 * C.NGW) {
          const bool h1 = it + C.NGW < NITEMS;
          if (h1) { decode(it + C.NGW, jn); conv_load(vb, jn.W, jn.N, jn.n0, jn.k0, lane); }
          conv_emit(va, T, ja.WT, ja.ldd, ja.n0, ja.k0, lane, ja.perm);
          const bool h2 = it + 2 * C.NGW < NITEMS;
          if (h2) { decode(it + 2 * C.NGW, ja); conv_load(va, ja.W, ja.N, ja.n0, ja.k0, lane); }
          if (h1) conv_emit(vb, T, jn.WT, jn.ldd, jn.n0, jn.k0, lane, jn.perm);
      }
    }
}

__device__ __forceinline__ void phase_norm(const Ctx& C, const float* xin  , float* out  , bool combine, bool do_norm, const float* gain, const float* modc  , const float* modl  , int shoff, int scoff, bool dummy = false) {
    const bf16_t* Y2 = (const bf16_t*)(C.ws + O_Y2); const int* pos = (const int*)(C.ws + O_POS); const float* topg = (const float*)(C.ws + O_TOPG); bf16_t* HN = (bf16_t*)(C.ws + (dummy ? O_DUMMY : O_HN)); const bf16_t* X = (const bf16_t*)(C.ws + O_X); bf16_t* Xo = (bf16_t*)(C.ws + (dummy ? O_DUMMY + 32 * MiB : O_X));
    const int lane = C.lane;
    for (int t = C.gw; t < T_; t += C.NGW) { const int b = t / S_;
        f32x4 v[4];
        if (xin) {
#pragma unroll
            for (int j = 0; j < 4; ++j) v[j] = *(const f32x4*)(xin + (size_t)t * 1024 + 256 * j + 4 * lane); }
        else {
#pragma unroll
            for (int j = 0; j < 4; ++j) { const u32x2 w = *(const u32x2*)(X + (size_t)t * 1024 + 256 * j + 4 * lane); v[j] = (f32x4){bf_lo(w.x), bf_hi(w.x), bf_lo(w.y), bf_hi(w.y)}; } }
        if (combine) { f32x4 y[4];
#pragma unroll
            for (int j = 0; j < 4; ++j) y[j] = (f32x4){0.f, 0.f, 0.f, 0.f};
#pragma unroll
            for (int k = 0; k < 4; ++k) { const int p = pos[t * 4 + k]; const float gk = topg[t * 4 + k];
#pragma unroll
                for (int j = 0; j < 4; ++j) { const u32x2 w = *(const u32x2*)(Y2 + (size_t)p * 1024 + 256 * j + 4 * lane);
                    y[j][0] += gk * bf_lo(w.x); y[j][1] += gk * bf_hi(w.x); y[j][2] += gk * bf_lo(w.y); y[j][3] += gk * bf_hi(w.y); } }
#pragma unroll
            for (int j = 0; j < 4; ++j) { const f32x4 g2 = *(const f32x4*)(modc + b * 6144 + 5120 + 256 * j + 4 * lane); v[j] = v[j] + g2 * y[j]; } }
        if (out) {
#pragma unroll
            for (int j = 0; j < 4; ++j) *(f32x4*)(out + (size_t)t * 1024 + 256 * j + 4 * lane) = v[j]; }
        else {
#pragma unroll
            for (int j = 0; j < 4; ++j) { u32x2 w; w.x = cvt_pk_bf16(v[j][0], v[j][1]); w.y = cvt_pk_bf16(v[j][2], v[j][3]); *(u32x2*)(Xo + (size_t)t * 1024 + 256 * j + 4 * lane) = w; } }
        if (do_norm) { float ss = 0.f;
#pragma unroll
            for (int j = 0; j < 4; ++j) ss += (v[j][0] * v[j][0] + v[j][1] * v[j][1]) + (v[j][2] * v[j][2] + v[j][3] * v[j][3]);
            const float rs = rsqrtf(wsum(ss) * (1.f / 1024.f) + 1e-6f);
#pragma unroll
            for (int j = 0; j < 4; ++j) { const int col = 256 * j + 4 * lane; const f32x4 gn = *(const f32x4*)(gain + col), sc = *(const f32x4*)(modl + b * 6144 + scoff + col), sh = *(const f32x4*)(modl + b * 6144 + shoff + col);
                const f32x4 h = v[j] * rs * gn * (1.f + sc) + sh;
                u32x2 w; w.x = cvt_pk_bf16(h[0], h[1]); w.y = cvt_pk_bf16(h[2], h[3]); *(u32x2*)(HN + (size_t)t * 1024 + col) = w; } }
    }
}

__device__ __forceinline__ void unpack8(const u32x4 w, float (&f)[8]) { f[0] = bf_lo(w.x); f[1] = bf_hi(w.x); f[2] = bf_lo(w.y); f[3] = bf_hi(w.y); f[4] = bf_lo(w.z); f[5] = bf_hi(w.z); f[6] = bf_lo(w.w); f[7] = bf_hi(w.w); }
__device__ __forceinline__ u32x4 pack8(const float (&f)[8]) { u32x4 w; w.x = cvt_pk_bf16(f[0], f[1]); w.y = cvt_pk_bf16(f[2], f[3]); w.z = cvt_pk_bf16(f[4], f[5]); w.w = cvt_pk_bf16(f[6], f[7]); return w; }

constexpr float LOG2E = 1.4426950408889634f;
__device__ __forceinline__ void phase_postproj(const Ctx& C, const float* qg, const float* kg, const float* qag, const float* kvag, const float* mkg) {
    bf16_t* PROJ = (bf16_t*)(C.ws + O_PROJ); const float* cs = (const float*)(C.ws + O_CS); const int lane = C.lane;
    for (int t = C.gw; t < T_; t += C.NGW) { bf16_t* row = PROJ + (size_t)t * 2048;
#pragma unroll
        for (int ps = 0; ps < 2; ++ps) { bf16_t* p = row + ps * 512 + 8 * lane; float f[8]; unpack8(*(const u32x4*)p, f); float ss = 0.f;
#pragma unroll
            for (int i = 0; i < 8; ++i) ss += f[i] * f[i];
            ss += shx<1>(ss); ss += shx<2>(ss); ss += shx<4>(ss);
            const float rs = rsqrtf(ss * (1.f / 64.f) + 1e-6f) * (ps == 0 ? 0.125f * LOG2E : 1.f); const float* g = (ps == 0 ? qg : kg) + 8 * (lane & 7);
#pragma unroll
            for (int i = 0; i < 8; ++i) f[i] = f[i] * rs * g[i];
            *(u32x4*)p = pack8(f); }
        { bf16_t* p = row + 1536 + 8 * lane; float f[8]; unpack8(*(const u32x4*)p, f); float ss = 0.f;
#pragma unroll
            for (int i = 0; i < 8; ++i) ss += f[i] * f[i];
            ss += shx<1>(ss); ss += shx<2>(ss);
            { const float o4 = shx<4>(ss); if (lane < 48) ss += o4; } { const float o8 = shx<8>(ss); if (lane < 48) ss += o8; } { const float o16 = shx<16>(ss); if (lane < 32) ss += o16; }
            const float nrm = lane < 32 ? 256.f : (lane < 48 ? 128.f : 32.f);
            const float rs = rsqrtf(ss / nrm + 1e-6f);
            const float* g = lane < 32 ? (qag + 8 * lane) : (lane < 48 ? (kvag + 8 * (lane - 32)) : (mkg + 64 + 8 * ((lane - 48) & 3)));
#pragma unroll
            for (int i = 0; i < 8; ++i) f[i] = f[i] * rs * g[i];
            float o[8];
#pragma unroll
            for (int i = 0; i < 8; ++i) { const float other = shx<2>(f[i]); const int fi = ((lane & 1) << 3) + i; const float cv = cs[t * 32 + fi], sv = cs[t * 32 + 16 + fi];
                o[i] = (lane & 2) ? (other * sv + f[i] * cv) : (f[i] * cv - other * sv); }
            if (lane >= 48 && lane < 52) {
#pragma unroll
                for (int i = 0; i < 8; ++i) f[i] = o[i]; }
            if (lane < 52) *(u32x4*)p = pack8(f); }
    }
}
__device__ __forceinline__ void phase_postq(const Ctx& C, const float* mqg, const float* mkg) {
    bf16_t* Q2 = (bf16_t*)(C.ws + O_Q2); bf16_t* KV2 = (bf16_t*)(C.ws + O_KV2); const float* cs = (const float*)(C.ws + O_CS); const int lane = C.lane;
    const float qscale = 0.10206207261596575f * LOG2E;
    for (int t = C.gw; t < T_; t += C.NGW) {
        { bf16_t* p = Q2 + (size_t)t * 768 + (lane >> 3) * 96 + 8 * (lane & 7); float f[8]; unpack8(*(const u32x4*)p, f); float ss = 0.f;
#pragma unroll
            for (int i = 0; i < 8; ++i) ss += f[i] * f[i];
            ss += shx<1>(ss); ss += shx<2>(ss); ss += shx<4>(ss);
            const float rs = rsqrtf(ss * (1.f / 64.f) + 1e-6f) * qscale; const float* g = mqg + 8 * (lane & 7);
#pragma unroll
            for (int i = 0; i < 8; ++i) f[i] = f[i] * rs * g[i];
            *(u32x4*)p = pack8(f); }
        { const int l2 = lane & 31; bf16_t* p = Q2 + (size_t)t * 768 + (l2 >> 2) * 96 + 64 + 8 * (l2 & 3); float f[8]; unpack8(*(const u32x4*)p, f); float ss = 0.f;
#pragma unroll
            for (int i = 0; i < 8; ++i) ss += f[i] * f[i];
            ss += shx<1>(ss); ss += shx<2>(ss);
            const float rs = rsqrtf(ss * (1.f / 32.f) + 1e-6f) * qscale; const float* g = mqg + 64 + 8 * (l2 & 3);
#pragma unroll
            for (int i = 0; i < 8; ++i) f[i] = f[i] * rs * g[i];
            float o[8];
#pragma unroll
            for (int i = 0; i < 8; ++i) { const float other = shx<2>(f[i]); const int fi = ((lane & 1) << 3) + i; const float cv = cs[t * 32 + fi], sv = cs[t * 32 + 16 + fi];
                o[i] = (lane & 2) ? (other * sv + f[i] * cv) : (f[i] * cv - other * sv); }
            if (lane < 32) *(u32x4*)p = pack8(o); }
        { bf16_t* p = KV2 + (size_t)t * 1024 + (lane >> 3) * 128 + 8 * (lane & 7); float f[8]; unpack8(*(const u32x4*)p, f); float ss = 0.f;
#pragma unroll
            for (int i = 0; i < 8; ++i) ss += f[i] * f[i];
            ss += shx<1>(ss); ss += shx<2>(ss); ss += shx<4>(ss);
            const float rs = rsqrtf(ss * (1.f / 64.f) + 1e-6f); const float* g = mkg + 8 * (lane & 7);
#pragma unroll
            for (int i = 0; i < 8; ++i) f[i] = f[i] * rs * g[i];
            *(u32x4*)p = pack8(f); }
    }
}
__device__ __forceinline__ void phase_mixcombine(const Ctx& C) {
    const bf16_t* OA = (const bf16_t*)(C.ws + O_OA); const float* LSE = (const float*)(C.ws + O_LSE); bf16_t* ATT = (bf16_t*)(C.ws + O_ATT); const int lane = C.lane;
    for (int t = C.gw; t < T_; t += C.NGW) { const int h = lane >> 3;
        float ls[3], mx = -INFINITY;
#pragma unroll
        for (int p = 0; p < 3; ++p) { ls[p] = LSE[((size_t)p * T_ + t) * 8 + h]; mx = fmaxf(mx, ls[p]); }
        float w[3], den = 0.f;
#pragma unroll
        for (int p = 0; p < 3; ++p) { w[p] = fexp2(ls[p] - mx); den += w[p]; }
        const float inv = 1.f / den; float o[8];
#pragma unroll
        for (int i = 0; i < 8; ++i) o[i] = 0.f;
#pragma unroll
        for (int p = 0; p < 3; ++p) { float f[8]; unpack8(*(const u32x4*)(OA + ((size_t)p * T_ + t) * 512 + 8 * lane), f); const float wp = w[p] * inv;
#pragma unroll
            for (int i = 0; i < 8; ++i) o[i] += wp * f[i]; }
        *(u32x4*)(ATT + (size_t)t * 1024 + 8 * lane) = pack8(o); }
}
__device__ __forceinline__ void phase_rgate(const Ctx& C, int j, const float* cw, const float* cb, const float* ba, const float* bx) {
    const bf16_t* PROJ = (const bf16_t*)(C.ws + O_PROJ); const bf16_t* RG = (const bf16_t*)(C.ws + O_RGATE + (size_t)j * SZ_RGATE); const float* spvg = (const float*)(C.ws + O_SPV) + j * 1024;
    bf16_t* LA = (bf16_t*)(C.ws + O_AA); bf16_t* Bb = (bf16_t*)(C.ws + O_BB); float* SP = (float*)(C.ws + O_SUMP); float* SH = (float*)(C.ws + O_SUMH);
    constexpr int WROW = 272;
    LAS unsigned char* Wl = C.lds;
    LAS unsigned char* Xl = C.lds + 256 * WROW;
    LAS unsigned char* Al = Xl + 64 * WROW;
    LAS unsigned char* Bl = Al + 64 * WROW;
    const int tid = C.tid, lane = C.lane, w = C.wave;
    if (C.G % 8 != 0) return;
    const int n = C.bid & 7, g = C.bid >> 3, ng = C.G >> 3;
    for (int i = tid; i < 256 * 16; i += 512) { const int r = i >> 4, c = i & 15; *(LAS u32x4*)(Wl + r * WROW + 16 * c) = *(const u32x4*)(RG + ((size_t)n * 256 + r) * 128 + 8 * c); }
    const int crow = tid >> 3, cg = tid & 7, cch = n * 128 + 16 * cg;
    float cwv[4][16], cbv[16];
#pragma unroll
    for (int q = 0; q < 4; ++q) { const f32x4 b4 = *(const f32x4*)(cb + cch + 4 * q); cbv[4 * q] = b4[0]; cbv[4 * q + 1] = b4[1]; cbv[4 * q + 2] = b4[2]; cbv[4 * q + 3] = b4[3];
#pragma unroll
        for (int k = 0; k < 4; ++k) { const f32x4 w4 = *(const f32x4*)(cw + k * 1024 + cch + 4 * q); cwv[k][4 * q] = w4[0]; cwv[k][4 * q + 1] = w4[1]; cwv[k][4 * q + 2] = w4[2]; cwv[k][4 * q + 3] = w4[3]; } }
    const int mt = w & 3, h = w >> 2, l15 = lane & 15, kg = lane >> 4;
    float bav[4], bxv[4], spv[4];
#pragma unroll
    for (int jj = 0; jj < 4; ++jj) { const int ch = n * 128 + 16 * (4 * h + jj) + l15; bav[jj] = ba[ch]; bxv[jj] = bx[ch]; spv[jj] = spvg[ch]; }
    __syncthreads();
    for (int c = g; c < 256; c += ng) { const size_t row0 = (size_t)c * 64; const int ts0 = (int)(row0 % S_);
        { float acc[16];
#pragma unroll
          for (int i = 0; i < 16; ++i) acc[i] = cbv[i];
#pragma unroll
          for (int k = 0; k < 4; ++k) { const int dt = k - 3; if (ts0 + crow + dt >= 0) { const bf16_t* src = PROJ + (row0 + crow + dt) * 2048 + 1024 + cch; float f0[8], f1[8]; unpack8(*(const u32x4*)src, f0); unpack8(*(const u32x4*)(src + 8), f1);
#pragma unroll
                  for (int i = 0; i < 8; ++i) { acc[i] += cwv[k][i] * f0[i]; acc[8 + i] += cwv[k][8 + i] * f1[i]; } } }
          float lo[8], hi8[8];
#pragma unroll
          for (int i = 0; i < 8; ++i) { lo[i] = acc[i]; hi8[i] = acc[8 + i]; }
          *(LAS u32x4*)(Xl + crow * WROW + 32 * cg) = pack8(lo); *(LAS u32x4*)(Xl + crow * WROW + 32 * cg + 16) = pack8(hi8); }
        __syncthreads();
        f32x4 acc[8];
#pragma unroll
        for (int t = 0; t < 8; ++t) acc[t] = (f32x4){0.f, 0.f, 0.f, 0.f};
#pragma unroll
        for (int ks = 0; ks < 4; ++ks) { const bf16x8 af = *(const LAS bf16x8*)(Xl + (16 * mt + l15) * WROW + 64 * ks + 16 * kg);
#pragma unroll
            for (int t = 0; t < 8; ++t) { const int nt = (t < 4) ? (4 * h + t) : (8 + 4 * h + (t - 4)); const bf16x8 bfr = *(const LAS bf16x8*)(Wl + (16 * nt + l15) * WROW + 64 * ks + 16 * kg);
                acc[t] = __builtin_amdgcn_mfma_f32_16x16x32_bf16(af, bfr, acc[t], 0, 0, 0); } }
#pragma unroll
        for (int jj = 0; jj < 4; ++jj) { const int e = 16 * (4 * h + jj) + l15;
#pragma unroll
            for (int r = 0; r < 4; ++r) { const int row = 16 * mt + 4 * kg + r; const float xc = bf_lo((unsigned)*(const LAS unsigned short*)(Xl + row * WROW + 2 * e));
                const float rr = fsigmoid(acc[jj][r] + bav[jj]), ig = fsigmoid(acc[4 + jj][r] + bxv[jj]); const float la = rr * spv[jj], av = fexp2(la);
                const float bv = __builtin_amdgcn_sqrtf(fmaxf(1.f - av * av, 0.f)) * ig * xc;
                *(LAS unsigned short*)(Al + row * WROW + 2 * e) = (unsigned short)(cvt_pk_bf16(la, la) & 0xffffu); *(LAS unsigned short*)(Bl + row * WROW + 2 * e) = (unsigned short)(cvt_pk_bf16(bv, bv) & 0xffffu); } }
        __syncthreads();
        { const size_t go = (row0 + crow) * 1024 + cch;
          *(u32x4*)(LA + go) = *(const LAS u32x4*)(Al + crow * WROW + 32 * cg); *(u32x4*)(LA + go + 8) = *(const LAS u32x4*)(Al + crow * WROW + 32 * cg + 16);
          *(u32x4*)(Bb + go) = *(const LAS u32x4*)(Bl + crow * WROW + 32 * cg); *(u32x4*)(Bb + go + 8) = *(const LAS u32x4*)(Bl + crow * WROW + 32 * cg + 16); }
        if (tid < 128) { float Pl = 0.f, Hh = 0.f;
#pragma unroll 8
            for (int r = 0; r < 64; ++r) { const float la = bf_lo((unsigned)*(const LAS unsigned short*)(Al + r * WROW + 2 * tid)), bv = bf_lo((unsigned)*(const LAS unsigned short*)(Bl + r * WROW + 2 * tid)); Hh = fexp2(la) * Hh + bv; Pl += la; }
            const int b = (int)(row0 / S_), ck = (int)((row0 % S_) >> 6); SP[((size_t)b * 64 + ck) * 1024 + n * 128 + tid] = fexp2(Pl); SH[((size_t)b * 64 + ck) * 1024 + n * 128 + tid] = Hh; }
        __syncthreads();
    }
}

__device__ __forceinline__ void scan_sum_item(const Ctx& C, int b, int ck, int cg) {
    const bf16_t* LA = (const bf16_t*)(C.ws + O_AA); const bf16_t* Bb = (const bf16_t*)(C.ws + O_BB); float* SP = (float*)(C.ws + O_SUMP); float* SH = (float*)(C.ws + O_SUMH);
    const int ch = cg * 128 + 2 * C.lane;
    size_t off = ((size_t)b * S_ + ck * 64) * 1024 + ch; f32x2 Pl = (f32x2){0.f, 0.f}, Hh = (f32x2){0.f, 0.f};
#pragma unroll 8
    for (int s = 0; s < 64; ++s, off += 1024) { const unsigned lw = *(const unsigned*)(LA + off), bw = *(const unsigned*)(Bb + off);
        const f32x2 lv = (f32x2){bf_lo(lw), bf_hi(lw)}, av = (f32x2){fexp2(lv[0]), fexp2(lv[1])}, bv = (f32x2){bf_lo(bw), bf_hi(bw)}; Hh = av * Hh + bv; Pl = Pl + lv; }
    *(f32x2*)(SP + ((size_t)b * 64 + ck) * 1024 + ch) = (f32x2){fexp2(Pl[0]), fexp2(Pl[1])}; *(f32x2*)(SH + ((size_t)b * 64 + ck) * 1024 + ch) = Hh;
}
__device__ __forceinline__ void phase_scan_sum_own(const Ctx& C) {
    asm volatile("s_waitcnt vmcnt(0)" ::: "memory"); __syncthreads();
    for (int i = 0; ; ++i) { const int L = i * C.G + C.bid; if (L >= 512) break; const int pm = L >> 3, n = L & 7;
        if (C.wave < 4) { const int row0 = pm * 256 + C.wave * 64; scan_sum_item(C, row0 / S_, (row0 % S_) >> 6, n); } }
}
__device__ __forceinline__ void phase_scan_apply(const Ctx& C) {
    const bf16_t* LA = (const bf16_t*)(C.ws + O_AA); const bf16_t* Bb = (const bf16_t*)(C.ws + O_BB); const float* SP = (const float*)(C.ws + O_SUMP); const float* SH = (const float*)(C.ws + O_SUMH);
    const bf16_t* PROJ = (const bf16_t*)(C.ws + O_PROJ); bf16_t* ATT = (bf16_t*)(C.ws + O_ATT); const int lane = C.lane;
    for (int it = C.gw; it < 4 * 64 * 8; it += C.NGW) { const int cg = it & 7, ck = (it >> 3) & 63, b = it >> 9; const int ch = cg * 128 + 2 * lane;
        f32x2 h = (f32x2){0.f, 0.f};
#pragma unroll 8
        for (int c2 = 0; c2 < ck; ++c2) { const f32x2 pv = *(const f32x2*)(SP + ((size_t)b * 64 + c2) * 1024 + ch), hv = *(const f32x2*)(SH + ((size_t)b * 64 + c2) * 1024 + ch); h = pv * h + hv; }
        size_t row = (size_t)b * S_ + ck * 64;
#pragma unroll 8
        for (int s = 0; s < 64; ++s, ++row) { const unsigned lw = *(const unsigned*)(LA + row * 1024 + ch), bw = *(const unsigned*)(Bb + row * 1024 + ch);
            const f32x2 av = (f32x2){fexp2(bf_lo(lw)), fexp2(bf_hi(lw))}, bv = (f32x2){bf_lo(bw), bf_hi(bw)}; h = av * h + bv;
            const unsigned gw2 = *(const unsigned*)(PROJ + row * 2048 + ch);
            *(unsigned*)(ATT + row * 1024 + ch) = cvt_pk_bf16(bf_lo(gw2) * h[0], bf_hi(gw2) * h[1]); } }
}

__device__ __forceinline__ void phase_router(const Ctx& C, const bf16_t* X, const float* gain, const float* modl, const float* wr, const float* br) {
    unsigned char* HN8 = C.ws + O_HN; int* topi = (int*)(C.ws + O_TOPI); float* topg = (float*)(C.ws + O_TOPG); int* hist = (int*)(C.ws + O_HIST);
    LAS float* hrow = (LAS float*)C.lds;
    LAS float* part = (LAS float*)(C.lds + 65536);
    LAS int* hl = (LAS int*)(C.lds + LX_MISC);
    const int lane = C.lane, e = lane & 31, kh = lane >> 5, v = C.wave;
    float wreg[64];
#pragma unroll
    for (int i = 0; i < 64; ++i) wreg[i] = wr[(128 * v + 64 * kh + i) * 32 + e];
    const float bias_e = br[e];
    if (C.tid < 32) hl[C.tid] = 0;
    __syncthreads();
    for (int ck = C.bid; ck < 256; ck += C.G) {
        const int b = (ck * 64) / S_;
        f32x4 gn[4], sc1[4], shv[4];
#pragma unroll
        for (int j = 0; j < 4; ++j) { const int col = 256 * j + 4 * lane; gn[j] = *(const f32x4*)(gain + col); sc1[j] = 1.f + *(const f32x4*)(modl + b * 6144 + 4096 + col); shv[j] = *(const f32x4*)(modl + b * 6144 + 3072 + col); gn[j] = gn[j] * sc1[j]; }
        u32x2 xr[2][4];
#pragma unroll
        for (int q = 0; q < 2; ++q)
#pragma unroll
            for (int j = 0; j < 4; ++j) xr[q][j] = *(const u32x2*)(X + (size_t)(ck * 64 + 2 * v + q) * 1024 + 256 * j + 4 * lane);
#pragma unroll 1
        for (int pass = 0; pass < 4; ++pass) { const int tb = ck * 64 + pass * 16;
#pragma unroll
            for (int q = 0; q < 2; ++q) { const int tt = 2 * v + q, t = tb + tt; f32x4 h[4]; float ss = 0.f;
#pragma unroll
                for (int j = 0; j < 4; ++j) { const u32x2 xw = xr[q][j]; h[j] = (f32x4){bf_lo(xw.x), bf_hi(xw.x), bf_lo(xw.y), bf_hi(xw.y)}; ss += (h[j][0] * h[j][0] + h[j][1] * h[j][1]) + (h[j][2] * h[j][2] + h[j][3] * h[j][3]); }
                const float rs = rsqrtf(wsum(ss) * (1.f / 1024.f) + 1e-6f);
#pragma unroll
                for (int j = 0; j < 4; ++j) { const int col = 256 * j + 4 * lane;
                    const f32x4 hv = h[j] * rs * gn[j] + shv[j];
                    *(unsigned*)(HN8 + (size_t)t * 1024 + col) = pk4_fp8(hv[0], hv[1], hv[2], hv[3]);
                    *(LAS f32x4*)(hrow + tt * 1024 + col) = hv; } }
            if (pass < 3) {
#pragma unroll
                for (int q = 0; q < 2; ++q)
#pragma unroll
                    for (int j = 0; j < 4; ++j) xr[q][j] = *(const u32x2*)(X + (size_t)(tb + 16 + 2 * v + q) * 1024 + 256 * j + 4 * lane); }
            __syncthreads();
#pragma unroll 2
            for (int tt = 0; tt < 16; ++tt) { float s0 = 0.f, s1 = 0.f; const LAS float* hp = hrow + tt * 1024 + 128 * v + 64 * kh;
#pragma unroll
                for (int i4 = 0; i4 < 16; ++i4) { const f32x4 hv = *(const LAS f32x4*)(hp + 4 * i4); s0 += hv[0] * wreg[4 * i4] + hv[1] * wreg[4 * i4 + 1]; s1 += hv[2] * wreg[4 * i4 + 2] + hv[3] * wreg[4 * i4 + 3]; }
                float s = xadd32(s0 + s1);
                if (lane < 32) part[(tt * 8 + v) * 32 + e] = s; }
            __syncthreads();
            { const int tt = 2 * v + kh; float lg = bias_e;
#pragma unroll
              for (int w8 = 0; w8 < 8; ++w8) lg += part[(tt * 8 + w8) * 32 + e];
              int idx[4]; float val[4];
#pragma unroll
              for (int k = 0; k < 4; ++k) { float mx = lg;
                  mx = fmaxf(mx, shx<1>(mx)); mx = fmaxf(mx, shx<2>(mx)); mx = fmaxf(mx, shx<4>(mx)); mx = fmaxf(mx, shx<8>(mx)); mx = fmaxf(mx, shx<16>(mx));
                  const unsigned long long bal = __ballot(lg == mx); const unsigned bh = (unsigned)(bal >> (32 * kh)); const int sel = __ffs((int)bh) - 1;
                  idx[k] = sel; val[k] = mx; if (e == sel) lg = -INFINITY; }
              if (e == 0) { const int t = tb + tt; float ex[4], den = 0.f;
#pragma unroll
                  for (int k = 0; k < 4; ++k) { ex[k] = expf(val[k] - val[0]); den += ex[k]; }
#pragma unroll
                  for (int k = 0; k < 4; ++k) { topi[t * 4 + k] = idx[k]; topg[t * 4 + k] = ex[k] / den; __hip_atomic_fetch_add(hl + idx[k], 1, __ATOMIC_RELAXED, __HIP_MEMORY_SCOPE_WORKGROUP); } } }
        }
        __syncthreads();
        if (C.tid < 32) { hist[ck * 32 + C.tid] = hl[C.tid]; hl[C.tid] = 0; }
        __syncthreads();
    }
}
__device__ __forceinline__ void moe_plan_lds(const Ctx& C) {
    const int* hist = (const int*)(C.ws + O_HIST);
    LAS int* tot = (LAS int*)(C.lds + LX_MISC + 256); LAS int* pst = tot + 32; LAS int* tile_e = (LAS int*)(C.lds + LX_TILE); LAS int* ntp = (LAS int*)(C.lds + LX_MISC + 128); LAS int* part = (LAS int*)(C.lds + LX_MISC + 1024);
    __syncthreads();
    { const int e = C.tid & 31, g = C.tid >> 5; int sacc = 0;
#pragma unroll
      for (int i = 0; i < 16; ++i) sacc += hist[(g * 16 + i) * 32 + e];
      part[g * 32 + e] = sacc; }
    __syncthreads();
    if (C.tid < 32) { int sacc = 0;
#pragma unroll
        for (int g = 0; g < 16; ++g) sacc += part[g * 32 + C.tid];
        tot[C.tid] = sacc; }
    __syncthreads();
    if (C.tid == 0) { int acc = 0, ti = 0; for (int e = 0; e < 32; ++e) { pst[e] = acc; const int nt = (tot[e] + 255) >> 8; for (int i = 0; i < nt; ++i) tile_e[ti++] = e; acc += nt << 8; } ntp[0] = ti; }
    __syncthreads();
}
__device__ __forceinline__ void phase_scatter(const Ctx& C) {
    const int* hist = (const int*)(C.ws + O_HIST); const int* topi = (const int*)(C.ws + O_TOPI); int* pos = (int*)(C.ws + O_POS);
    const unsigned char* HN8 = C.ws + O_HN; unsigned char* XG8 = C.ws + O_XG;
    moe_plan_lds(C);
    LAS int* pst = (LAS int*)(C.lds + LX_MISC + 384); LAS int* base = (LAS int*)(C.lds + LX_MISC + 512); LAS int* part = (LAS int*)(C.lds + LX_MISC + 1024); LAS int* pl = (LAS int*)C.lds;
    for (int ck = C.bid; ck < 256; ck += C.G) {
        if (C.tid < 32) { int sacc = pst[C.tid]; const int g = ck >> 4; for (int g2 = 0; g2 < g; ++g2) sacc += part[g2 * 32 + C.tid]; for (int c2 = g * 16; c2 < ck; ++c2) sacc += hist[c2 * 32 + C.tid]; base[C.tid] = sacc; }
        __syncthreads();
        if (C.wave == 0) { int cnt[32];
#pragma unroll
            for (int e = 0; e < 32; ++e) cnt[e] = 0;
#pragma unroll 1
            for (int g = 0; g < 4; ++g) { const int my = topi[ck * 256 + g * 64 + C.lane]; int rank = 0;
#pragma unroll
                for (int e = 0; e < 32; ++e) { const unsigned long long m = __ballot(my == e);
                    const int below = (int)__builtin_amdgcn_mbcnt_hi((unsigned)(m >> 32), __builtin_amdgcn_mbcnt_lo((unsigned)m, 0u));
                    if (my == e) rank = cnt[e] + below; cnt[e] += __popcll(m); }
                const int p = base[my] + rank; pl[g * 64 + C.lane] = p; pos[ck * 256 + g * 64 + C.lane] = p; } }
        __syncthreads();
#pragma unroll 8
        for (int i = 0; i < 32; ++i) { const int pr = C.wave + 8 * i; const int t = ck * 64 + (pr >> 2); const int p = pl[pr];
            *(u32x4*)(XG8 + (size_t)p * 1024 + 16 * C.lane) = *(const u32x4*)(HN8 + (size_t)t * 1024 + 16 * C.lane); }
        __syncthreads();
    }
}
#ifndef ATT_DUP
#define ATT_DUP 1
#endif

__device__ __forceinline__ s16x4 tr16(LAS const unsigned char* p) { typedef short v4i16_t __attribute__((ext_vector_type(4))); return __builtin_bit_cast(s16x4, __builtin_amdgcn_ds_read_tr16_b64_v4i16((LAS v4i16_t*)p)); }

__device__ __forceinline__ float max3f(float a, float b, float c) { return fmaxf(fmaxf(a, b), c); }
#ifndef ATT_THR_V
#define ATT_THR_V 10.f
#endif
constexpr float ATT_THR = ATT_THR_V;
template <int KS, bool DIL>
__device__ __forceinline__ void att_tile(LAS const unsigned char* kb, LAS const unsigned char* vb, const bf16x8 (&qf)[KS], f32x16& o0, f32x16& o1, f32x16& negm, float& mref, float& l, int kidx0, int qidx, bool need_mask, int lane) {
    constexpr int KROW = KS * 32 + 16, VROW = 144;
    const int i32 = lane & 31, hi = lane >> 5;
    const int pr = (i32 & 0x13) | ((i32 & 4) << 1) | ((i32 & 8) >> 1);
    f32x16 p0, p1;
    LAS const unsigned char* kp = kb + pr * KROW + hi * 16;
#ifndef QK_DUP
#define QK_DUP 1
#endif
#pragma unroll 1
    for (int qd_ = 0; qd_ < QK_DUP; ++qd_) {
#pragma unroll
    for (int ks = 0; ks < KS; ++ks) {
        const bf16x8 k0f = *(LAS const bf16x8*)(kp + ks * 32), k1f = *(LAS const bf16x8*)(kp + 32 * KROW + ks * 32);
        if (ks == 0) { p0 = __builtin_amdgcn_mfma_f32_32x32x16_bf16(k0f, qf[0], negm, 0, 0, 0); p1 = __builtin_amdgcn_mfma_f32_32x32x16_bf16(k1f, qf[0], negm, 0, 0, 0); }
        else { p0 = __builtin_amdgcn_mfma_f32_32x32x16_bf16(k0f, qf[ks], p0, 0, 0, 0); p1 = __builtin_amdgcn_mfma_f32_32x32x16_bf16(k1f, qf[ks], p1, 0, 0, 0); }
    }
    asm volatile("" : "+v"(p0), "+v"(p1));
    }
    if (need_mask) {
#pragma unroll
        for (int r = 0; r < 16; ++r) { const int d0 = qidx - (kidx0 + 16 * (r >> 3) + 8 * hi + (r & 7)), d1 = d0 - 32;
            const bool v0 = DIL ? (d0 >= 0 && d0 <= 128) : (d0 >= 0), v1 = DIL ? (d1 >= 0 && d1 <= 128) : (d1 >= 0);
            p0[r] = v0 ? p0[r] : -INFINITY; p1[r] = v1 ? p1[r] : -INFINITY; } }
    float mx = max3f(p0[0], p0[1], p1[0]), mb = max3f(p0[2], p0[3], p1[1]); mx = max3f(mx, p1[2], p1[3]);
#pragma unroll
    for (int r = 4; r < 16; r += 4) { mx = max3f(mx, p0[r], p0[r + 1]); mb = max3f(mb, p0[r + 2], p0[r + 3]); mx = max3f(mx, p1[r], p1[r + 1]); mb = max3f(mb, p1[r + 2], p1[r + 3]); }
    mx = xmax32(fmaxf(mx, mb));
    if (__builtin_expect(__any(mx > ATT_THR), 0)) {
        const float dl = fmaxf(mx, 0.f), f = fexp2(-dl);
        mref += dl; l *= f;
#pragma unroll
        for (int r = 0; r < 16; ++r) { o0[r] *= f; o1[r] *= f; p0[r] -= dl; p1[r] -= dl; negm[r] = -mref; } }
    float ls0 = 0.f, ls1 = 0.f;
#pragma unroll
    for (int r = 0; r < 16; ++r) { p0[r] = fexp2(p0[r]); p1[r] = fexp2(p1[r]); ls0 += p0[r]; ls1 += p1[r]; }
    l += ls0 + ls1;
    u32x4 pw[2][2];
#pragma unroll
    for (int s = 0; s < 2; ++s) {
        pw[0][s].x = cvt_pk_bf16(p0[8 * s + 0], p0[8 * s + 1]); pw[0][s].y = cvt_pk_bf16(p0[8 * s + 2], p0[8 * s + 3]); pw[0][s].z = cvt_pk_bf16(p0[8 * s + 4], p0[8 * s + 5]); pw[0][s].w = cvt_pk_bf16(p0[8 * s + 6], p0[8 * s + 7]);
        pw[1][s].x = cvt_pk_bf16(p1[8 * s + 0], p1[8 * s + 1]); pw[1][s].y = cvt_pk_bf16(p1[8 * s + 2], p1[8 * s + 3]); pw[1][s].z = cvt_pk_bf16(p1[8 * s + 4], p1[8 * s + 5]); pw[1][s].w = cvt_pk_bf16(p1[8 * s + 6], p1[8 * s + 7]); }
    const int g = lane >> 4, i16 = lane & 15;
    LAS const unsigned char* vp = vb + (8 * (g >> 1) + (i16 >> 2)) * VROW + (16 * (g & 1) + 4 * (i16 & 3)) * 2;
#pragma unroll
    for (int sub = 0; sub < 2; ++sub)
#pragma unroll
        for (int s = 0; s < 2; ++s) { const bf16x8 pf = __builtin_bit_cast(bf16x8, pw[sub][s]);
#pragma unroll
            for (int db = 0; db < 2; ++db) { LAS const unsigned char* av = vp + (32 * sub + 16 * s) * VROW + 64 * db;
                const s16x4 lo = tr16(av), hh = tr16(av + 4 * VROW);
                const bf16x8 vf = (bf16x8){lo[0], lo[1], lo[2], lo[3], hh[0], hh[1], hh[2], hh[3]};
                if (db == 0) o0 = __builtin_amdgcn_mfma_f32_32x32x16_bf16(vf, pf, o0, 0, 0, 0); else o1 = __builtin_amdgcn_mfma_f32_32x32x16_bf16(vf, pf, o1, 0, 0, 0); } }
}
__device__ __forceinline__ void att_store(bf16_t* orow  , const f32x16& o0, const f32x16& o1, float inv, int hi) {
#pragma unroll
    for (int rr = 0; rr < 4; ++rr) { u32x2 w0, w1;
        w0.x = cvt_pk_bf16(o0[4 * rr] * inv, o0[4 * rr + 1] * inv); w0.y = cvt_pk_bf16(o0[4 * rr + 2] * inv, o0[4 * rr + 3] * inv);
        w1.x = cvt_pk_bf16(o1[4 * rr] * inv, o1[4 * rr + 1] * inv); w1.y = cvt_pk_bf16(o1[4 * rr + 2] * inv, o1[4 * rr + 3] * inv);
        *(u32x2*)(orow + 8 * rr + 4 * hi) = w0; *(u32x2*)(orow + 32 + 8 * rr + 4 * hi) = w1; }
}


struct BgConv {
    const float* w1; const float* w2; unsigned char* ws; LAS unsigned char* T;
    int pair, it, nit, step, sub;
    bool pendA, pendB; int psubA, psubB; unsigned char* pWTA; unsigned char* pWTB;
    f32x4 vA[4], vB[4];
};
__device__ __forceinline__ void bg_tile(const BgConv& S, int it, const float*& W, int& N, unsigned char*& WT, int& n0, int& k0) {
    constexpr int I1 = 32 * 8, I2 = 16 * 8, N1 = 64 * I1;
    if (it < N1) { const int mat = S.pair * 64 + it / I1, q = it % I1; W = S.w1 + (size_t)mat * 1024 * 2048; WT = S.ws + O_W1 + (size_t)mat * SZ_W1E; N = 2048; n0 = (q >> 3) * 64; k0 = (q & 7) * 128; }
    else { const int r = it - N1, mat = S.pair * 64 + r / I2, q = r % I2; W = S.w2 + (size_t)mat * 1024 * 1024; WT = S.ws + O_W2 + (size_t)mat * SZ_W2E; N = 1024; n0 = (q >> 3) * 64; k0 = (q & 7) * 128; }
}
__device__ __forceinline__ void bg_init(BgConv& S, const Ctx& C, const float* w1, const float* w2, int pair) {
    S.w1 = w1; S.w2 = w2; S.ws = C.ws; S.T = C.lds + 49152 + C.wave * 9216; S.pair = pair; S.it = C.gw; S.nit = 64 * 256 + 64 * 128; S.step = C.NGW; S.sub = 0;
    S.pendA = false; S.pendB = false; S.psubA = 0; S.psubB = 0; S.pWTA = C.ws; S.pWTB = C.ws;
}
__device__ __forceinline__ bool bg_done(const BgConv& S) { return !S.pendA && !S.pendB && S.it >= S.nit; }
__device__ __forceinline__ void bg_half(BgConv& S, f32x4 (&v)[4], bool& pend, int& psub, unsigned char*& pWT, int lane) {
    const int kq = lane >> 4, c4 = lane & 15;
    if (pend) {
#pragma unroll
        for (int jj = 0; jj < 4; ++jj) *(LAS unsigned*)(S.T + (4 * c4 + jj) * 144 + 32 * kq + 4 * psub) = pk4_fp8(32.f * v[0][jj], 32.f * v[1][jj], 32.f * v[2][jj], 32.f * v[3][jj]);
        if (psub == 7) {
            asm volatile("s_waitcnt lgkmcnt(0)" ::: "memory");
#pragma unroll
            for (int s8 = 0; s8 < 8; ++s8) { const int n = 8 * s8 + (lane >> 3), ch = lane & 7; const u32x4 w = *(const LAS u32x4*)(S.T + n * 144 + 16 * ch);
                *(u32x4*)(pWT + (size_t)n * 1024 + 16 * ch) = w; }
            asm volatile("s_waitcnt lgkmcnt(0)" ::: "memory"); }
        pend = false; }
    if (S.it < S.nit) { const float* W; int N, n0, k0; unsigned char* WT; bg_tile(S, S.it, W, N, WT, n0, k0);
        const float* p = W + (size_t)(k0 + 32 * kq + 4 * S.sub) * N + n0 + 4 * c4;
#pragma unroll
        for (int i = 0; i < 4; ++i) v[i] = __builtin_nontemporal_load((const f32x4*)(p + (size_t)i * N));
        pend = true; psub = S.sub; pWT = WT + (size_t)n0 * 1024 + k0;
        if (++S.sub == 8) { S.sub = 0; S.it += S.step; } }
}
#define BG_STEP_A() bg_half(BG, BG.vA, BG.pendA, BG.psubA, BG.pWTA, lane)
#define BG_STEP_B() bg_half(BG, BG.vB, BG.pendB, BG.psubB, BG.pWTB, lane)

__device__ __forceinline__ void mla_unit(const Ctx& C, BgConv& BG, int b, int h, int qb) {
    constexpr int KROW = 208, VROW = 144, KB = 64 * KROW, BUF = KB + 64 * VROW;
    const bf16_t* Q2 = (const bf16_t*)(C.ws + O_Q2); const bf16_t* KV2 = (const bf16_t*)(C.ws + O_KV2); const bf16_t* PROJ = (const bf16_t*)(C.ws + O_PROJ); bf16_t* ATT = (bf16_t*)(C.ws + O_ATT);
    const int tid = C.tid, lane = C.lane, w = C.wave, i32 = lane & 31, hi = lane >> 5;
    const int q0 = qb * 256; const size_t rowb = (size_t)b * S_;
    bf16x8 qf[6];
    { const bf16_t* qrow = Q2 + (rowb + q0 + 32 * w + i32) * 768 + 8 * hi;
#pragma unroll
      for (int ks = 0; ks < 4; ++ks) qf[ks] = *(const bf16x8*)(qrow + h * 64 + 16 * ks);
      qf[4] = *(const bf16x8*)(qrow + 512 + h * 32); qf[5] = *(const bf16x8*)(qrow + 512 + h * 32 + 16); }
    f32x16 o0, o1;
#pragma unroll
    for (int r = 0; r < 16; ++r) { o0[r] = 0.f; o1[r] = 0.f; }
    float m = 0.f, l = 0.f; f32x16 negm;
#pragma unroll
    for (int r = 0; r < 16; ++r) negm[r] = 0.f;
    const int NT = 4 * qb + 4, wmax = 4 * qb + (w >> 1);
    const int r8 = tid >> 3, c8 = tid & 7, r4 = (tid & 255) >> 2, c4 = tid & 3;
    const bf16_t* knp = KV2 + (rowb + r8) * 1024 + h * 64 + 8 * c8; const bf16_t* kpp = PROJ + (rowb + r4) * 2048 + 1920 + 8 * c4;
    u32x4 kA, vA, pA, kB, vB, pB;
#define MLA_LOAD(j, K, V, P) do { const int jc_ = ((j) < NT) ? (j) : NT - 1; K = *(const u32x4*)(knp + (size_t)jc_ * 64 * 1024); V = *(const u32x4*)(knp + (size_t)jc_ * 64 * 1024 + 512); P = *(const u32x4*)(kpp + (size_t)jc_ * 64 * 2048); } while (0)
#define MLA_WRITE(bo, K, V, P) do { *(LAS u32x4*)(C.lds + (bo) + r8 * KROW + 16 * c8) = K; *(LAS u32x4*)(C.lds + (bo) + KB + r8 * VROW + 16 * c8) = V; *(LAS u32x4*)(C.lds + (bo) + r4 * KROW + 128 + 16 * c4) = P; } while (0)
#define MLA_STEP(j, KF, VF, PF, KN, VN, PN, BGS) do { const int j_ = (j); const int bo_ = (j_ & 1) * BUF; \
        MLA_LOAD(j_ + 2, KF, VF, PF); BGS(); \
        if (j_ <= wmax) { _Pragma("unroll 1") for (int dup_ = 0; dup_ < ATT_DUP; ++dup_) att_tile<6, false>(C.lds + bo_, C.lds + bo_ + KB, qf, o0, o1, negm, m, l, 64 * j_, q0 + 32 * w + i32, j_ == wmax, lane); } \
        MLA_WRITE(BUF - bo_, KN, VN, PN); \
        __syncthreads(); } while (0)
    MLA_LOAD(0, kA, vA, pA); MLA_LOAD(1, kB, vB, pB);
    MLA_WRITE(0, kA, vA, pA);
    __syncthreads();
#pragma unroll 1
    for (int j = 0; j < NT; j += 2) { MLA_STEP(j, kA, vA, pA, kB, vB, pB, BG_STEP_A); MLA_STEP(j + 1, kB, vB, pB, kA, vA, pA, BG_STEP_B); }
#undef MLA_STEP
#undef MLA_LOAD
#undef MLA_WRITE
    l = xadd32(l);
    att_store(ATT + (rowb + q0 + 32 * w + i32) * 1024 + 512 + h * 64, o0, o1, 1.f / l, hi);
}
__device__ __forceinline__ void dil_unit(const Ctx& C, BgConv& BG, int p, int dd, int b, int h, int res, int n) {
    constexpr int KROW = 144, VROW = 144, KB = 64 * KROW, BUF = KB + 64 * VROW;
    const bf16_t* PROJ = (const bf16_t*)(C.ws + O_PROJ); bf16_t* OA = (bf16_t*)(C.ws + O_OA) + (size_t)p * T_ * 512; float* LSE = (float*)(C.ws + O_LSE) + (size_t)p * T_ * 8;
    const int tid = C.tid, lane = C.lane, w = C.wave, i32 = lane & 31, hi = lane >> 5;
    const size_t rowb = (size_t)b * S_;
    const int qsub = 256 * n + 32 * w + i32; const size_t qtok = rowb + (size_t)qsub * dd + res;
    bf16x8 qf[4];
    { const bf16_t* qrow = PROJ + qtok * 2048 + h * 64 + 8 * hi;
#pragma unroll
      for (int ks = 0; ks < 4; ++ks) qf[ks] = *(const bf16x8*)(qrow + 16 * ks); }
    f32x16 o0, o1;
#pragma unroll
    for (int r = 0; r < 16; ++r) { o0[r] = 0.f; o1[r] = 0.f; }
    float m = 0.f, l = 0.f; f32x16 negm;
#pragma unroll
    for (int r = 0; r < 16; ++r) negm[r] = 0.f;
    const int jbeg = (n == 0) ? 2 : 0, wlo = w >> 1, whi = (32 * w + 159) >> 6;
    const int r8 = tid >> 3, c8 = tid & 7;
    u32x4 kA, vA, kB, vB;
    const int cnt = 6 - jbeg;
#define DIL_LOAD(i, K, V) do { const int jc_ = jbeg + (((i) < cnt) ? (i) : cnt - 1); const size_t tok = rowb + (size_t)(256 * n - 128 + 64 * jc_ + r8) * dd + res; const bf16_t* src = PROJ + tok * 2048 + 512 + h * 64 + 8 * c8; K = *(const u32x4*)src; V = *(const u32x4*)(src + 512); } while (0)
#define DIL_WRITE(bo, K, V) do { *(LAS u32x4*)(C.lds + (bo) + r8 * KROW + 16 * c8) = K; *(LAS u32x4*)(C.lds + (bo) + KB + r8 * VROW + 16 * c8) = V; } while (0)
#define DIL_STEP(i, KF, VF, KN, VN, BGS) do { const int i_ = (i); const int bo_ = (i_ & 1) * BUF, j_ = jbeg + i_; \
        DIL_LOAD(i_ + 2, KF, VF); BGS(); \
        if (i_ < cnt && j_ >= wlo && j_ <= whi) { const int kb0_ = 256 * n - 128 + 64 * j_, qlo_ = 256 * n + 32 * w; _Pragma("unroll 1") for (int dup_ = 0; dup_ < ATT_DUP; ++dup_) att_tile<4, true>(C.lds + bo_, C.lds + bo_ + KB, qf, o0, o1, negm, m, l, kb0_, qsub, !(kb0_ + 63 <= qlo_ && qlo_ + 31 - kb0_ <= 128), lane); } \
        DIL_WRITE(BUF - bo_, KN, VN); \
        __syncthreads(); } while (0)
    DIL_LOAD(0, kA, vA); DIL_LOAD(1, kB, vB);
    DIL_WRITE(0, kA, vA);
    __syncthreads();
    DIL_STEP(0, kA, vA, kB, vB, BG_STEP_A); DIL_STEP(1, kB, vB, kA, vA, BG_STEP_B); DIL_STEP(2, kA, vA, kB, vB, BG_STEP_A); DIL_STEP(3, kB, vB, kA, vA, BG_STEP_B);
    if (cnt == 6) { DIL_STEP(4, kA, vA, kB, vB, BG_STEP_A); DIL_STEP(5, kB, vB, kA, vA, BG_STEP_B); }
#undef DIL_STEP
#undef DIL_LOAD
#undef DIL_WRITE
    l = xadd32(l);
    att_store(OA + qtok * 512 + h * 64, o0, o1, 1.f / l, hi);
    if (hi == 0) LSE[qtok * 8 + h] = m + log2f(l);
}
#ifndef REP_MLA
#define REP_MLA 1
#endif
#ifndef REP_DIL
#define REP_DIL 1
#endif
__device__ __forceinline__ void phase_attention(const Ctx& C, const float* w1, const float* w2, int pair) {
    BgConv BG; bg_init(BG, C, w1, w2, pair);
#pragma unroll 1
    for (int rep = 0; rep < REP_MLA; ++rep) {
    if (C.G == 256) { const int bh = C.vcu >> 3, s = C.vcu & 7; mla_unit(C, BG, bh >> 3, bh & 7, s); mla_unit(C, BG, bh >> 3, bh & 7, 15 - s); }
    else for (int u = C.bid; u < 512; u += C.G) mla_unit(C, BG, u >> 7, (u >> 4) & 7, u & 15);
    }
#pragma unroll 1
    for (int rep = 0; rep < REP_DIL; ++rep)
    for (int u = C.bid; u < 1536; u += C.G) { const int p = u >> 9, rem = u & 511, b = rem >> 7, h = (rem >> 4) & 7, blk = rem & 15;
        const int dd = (p == 0) ? 1 : (p == 1) ? 4 : 16, bpr = 16 / dd;
        dil_unit(C, BG, p, dd, b, h, blk / bpr, blk % bpr); }
    { const int lane = C.lane;
#pragma unroll 1
      while (!bg_done(BG)) { BG_STEP_A(); BG_STEP_B(); } }
}
#undef BG_STEP_A
#undef BG_STEP_B

#ifdef TIME_NORM
constexpr int N_PHASES = 42;
#else
constexpr int N_PHASES = 40;
#endif
extern __shared__ __attribute__((aligned(16))) unsigned char lds_raw[];
typedef const __attribute__((address_space(4))) Args* ArgsP;
#define PHFN static __device__ __forceinline__ void
__device__ __forceinline__ ArgsP fresh_args() { unsigned long long p = (unsigned long long)__builtin_amdgcn_kernarg_segment_ptr(); asm volatile("" : "+s"(p)); return (ArgsP)p; }
__device__ __forceinline__ Ctx make_ctx(ArgsP ap, int wv) {
    Ctx C; C.lds = (LAS unsigned char*)lds_raw; C.ws = ap->ws;
    unsigned ones = ~0u; asm volatile("" : "+s"(ones)); const int lane = (int)__builtin_amdgcn_mbcnt_hi(ones, __builtin_amdgcn_mbcnt_lo(ones, 0u));
    int bid = blockIdx.x; asm volatile("" : "+s"(bid)); int G = gridDim.x; asm volatile("" : "+s"(G));
    C.wave = wv; C.lane = lane; C.tid = wv * 64 + lane;
    C.G = G; C.bid = bid; C.vcu = (C.G % 8 == 0) ? (C.bid % 8) * (C.G / 8) + C.bid / 8 : C.bid;
    C.gw = C.bid * 8 + C.wave; C.NGW = C.G * 8; return C;
}
#define IN(i) ((const float*)ap->in[i])
#define MODL(l) ((const float*)(C.ws + O_MOD) + (size_t)(l) * 4 * 6144)
PHFN ph_prologue(int wv) { const ArgsP ap = fresh_args(); const Ctx C = make_ctx(ap, wv); p0_prologue(C, ap); }
PHFN ph_norm(int wv, int l, int mode) { const ArgsP ap = fresh_args(); const Ctx C = make_ctx(ap, wv);
    if (mode == 0) phase_norm(C, IN(0), nullptr, false, true, IN(5), MODL(0), MODL(0), 0, 1024);
    else if (mode == 1) phase_norm(C, nullptr, nullptr, true, true, IN(5) + l * 1024, MODL(l - 1), MODL(l), 0, 1024);
    else if (mode == 3) phase_norm(C, nullptr, nullptr, true, true, IN(5) + l * 1024, MODL(l - 1), MODL(l), 0, 1024, true);
    else phase_norm(C, nullptr, ap->out, true, false, IN(5), MODL(3), MODL(3), 0, 1024); }
PHFN ph_proj(int wv, int j) { const ArgsP ap = fresh_args(); const Ctx C = make_ctx(ap, wv); unsigned char* ws = C.ws;
    DenseOrder S; S.init(ws + O_HN, ws + O_WIN + j * SZ_WIN, 1024, 1024, T_, 2048, C.G, C.bid); EpiNorm<0> E{(bf16_t*)(ws + O_PROJ), 2048, IN(8) + j * 64, IN(9) + j * 64, IN(10) + j * 256, IN(11) + j * 128, IN(15) + j * 96 + 64, (const float*)(ws + O_CS), (LAS float*)(C.lds + LX_EXCH)}; gemm_phase(C, GemmDims{1024, 1024, 1024}, S, E); }
PHFN ph_postproj(int wv, int j) { const ArgsP ap = fresh_args(); const Ctx C = make_ctx(ap, wv); phase_postproj(C, IN(8) + j * 64, IN(9) + j * 64, IN(10) + j * 256, IN(11) + j * 128, IN(15) + j * 96); }
PHFN ph_qkv(int wv, int j) { const ArgsP ap = fresh_args(); const Ctx C = make_ctx(ap, wv); unsigned char* ws = C.ws;
    { DenseOrder S; S.init(ws + O_PROJ + 1536 * 2, ws + O_WUQ + j * SZ_WUQ, 2048, 256, T_, 768, C.G, C.bid); EpiNorm<1> E{(bf16_t*)(ws + O_Q2), 768, IN(14) + j * 96, IN(14) + j * 96 + 64, nullptr, nullptr, nullptr, (const float*)(ws + O_CS), (LAS float*)(C.lds + LX_EXCH)}; gemm_phase(C, GemmDims{256, 2048, 256}, S, E); }
    { const ArgsP ap2 = fresh_args(); const Ctx C = make_ctx(ap2, wv); unsigned char* ws = C.ws; DenseOrder S; S.init(ws + O_PROJ + 1792 * 2, ws + O_WUKV + j * SZ_WUKV, 2048, 128, T_, 1024, C.G, C.bid); EpiNorm<2> E{(bf16_t*)(ws + O_KV2), 1024, IN(15) + j * 96, nullptr, nullptr, nullptr, nullptr, (const float*)(ws + O_CS), (LAS float*)(C.lds + LX_EXCH)}; gemm_phase(C, GemmDims{128, 2048, 128}, S, E); } }
PHFN ph_postq(int wv, int j) { const ArgsP ap = fresh_args(); const Ctx C = make_ctx(ap, wv); phase_postq(C, IN(14) + j * 96, IN(15) + j * 96); }
PHFN ph_attention(int wv, int pair) { const ArgsP ap = fresh_args(); const Ctx C = make_ctx(ap, wv); phase_attention(C, IN(30), IN(32), pair); }
PHFN ph_mixcombine(int wv) { const ArgsP ap = fresh_args(); const Ctx C = make_ctx(ap, wv); phase_mixcombine(C); }
PHFN ph_outproj(int wv, int l, int which) { const ArgsP ap = fresh_args(); const Ctx C = make_ctx(ap, wv); unsigned char* ws = C.ws; const int j = l >> 1;
    DenseOrder S; S.init(ws + O_ATT, ws + (which ? O_RWOUT + j * SZ_RWOUT : O_WOUT + j * SZ_WOUT), 1024, 1024, T_, 1024, C.G, C.bid);
    EpiResid E{(bf16_t*)(ws + O_X), MODL(l) + 2048, which ? IN(27) + j * 1024 : nullptr}; gemm_phase(C, GemmDims{1024, 1024, 1024}, S, E); }
PHFN ph_router(int wv, int l) { const ArgsP ap = fresh_args(); const Ctx C = make_ctx(ap, wv); phase_router(C, (const bf16_t*)(C.ws + O_X), IN(6) + l * 1024, MODL(l), IN(28) + (size_t)l * 1024 * 32, IN(29) + l * 32); }
PHFN ph_scatter(int wv) { const ArgsP ap = fresh_args(); const Ctx C = make_ctx(ap, wv); phase_scatter(C); }
PHFN ph_moe1(int wv, int l) { const ArgsP ap = fresh_args(); const Ctx C = make_ctx(ap, wv); unsigned char* ws = C.ws; moe_plan_lds(C);
    MoeOrder S; S.A = (const char*)(ws + O_XG); S.WT = (const char*)(ws + O_W1 + (size_t)l * 32 * SZ_W1E); S.estride = SZ_W1E; S.tile_e = (const LAS int*)(C.lds + LX_TILE);
    S.NT = *(const LAS int*)(C.lds + LX_MISC + 128); S.nN = 8; S.G = C.G; S.c = C.bid; S.esz = 1;
    EpiSwiglu E{(unsigned char*)(ws + O_ACT), IN(31) + (size_t)l * 32 * 2048, 1.f / 32.f}; gemm_phase<true>(C, GemmDims{1024, 1024, 1024}, S, E); }
PHFN ph_moe2(int wv, int l) { const ArgsP ap = fresh_args(); const Ctx C = make_ctx(ap, wv); unsigned char* ws = C.ws; moe_plan_lds(C);
    MoeOrder S; S.A = (const char*)(ws + O_ACT); S.WT = (const char*)(ws + O_W2 + (size_t)l * 32 * SZ_W2E); S.estride = SZ_W2E; S.tile_e = (const LAS int*)(C.lds + LX_TILE);
    S.NT = *(const LAS int*)(C.lds + LX_MISC + 128); S.nN = 4; S.G = C.G; S.c = C.bid; S.esz = 1;
    EpiBf16 E{(bf16_t*)(ws + O_Y2), IN(33) + (size_t)l * 32 * 1024, 1024, 1024, 1.f / 32.f}; gemm_phase<true>(C, GemmDims{1024, 1024, 1024}, S, E); }
PHFN ph_recin(int wv, int j) { const ArgsP ap = fresh_args(); const Ctx C = make_ctx(ap, wv); unsigned char* ws = C.ws;
    DenseOrder S; S.init(ws + O_HN, ws + O_RWIN + j * SZ_RWIN, 1024, 1024, T_, 2048, C.G, C.bid); EpiRecIn E{(bf16_t*)(ws + O_PROJ), IN(18) + j * 2048}; gemm_phase(C, GemmDims{1024, 1024, 1024}, S, E); }
PHFN ph_rgate(int wv, int j) { const ArgsP ap = fresh_args(); const Ctx C = make_ctx(ap, wv); phase_rgate(C, j, IN(19) + j * 4096, IN(20) + j * 1024, IN(22) + j * 1024, IN(24) + j * 1024); }
PHFN ph_scan_apply(int wv) { const ArgsP ap = fresh_args(); const Ctx C = make_ctx(ap, wv); phase_scan_apply(C); }

#if MODE == 1
__device__ __forceinline__ int fresh_tid(int wv) { unsigned ones = ~0u; asm volatile("" : "+s"(ones)); return wv * 64 + (int)__builtin_amdgcn_mbcnt_hi(ones, __builtin_amdgcn_mbcnt_lo(ones, 0u)); }
__device__ __forceinline__ void grid_barrier(int wv) { const ArgsP q = fresh_args(); XcdBarrier b; b.bar = (unsigned*)(q->ws + O_CTL) + CW_BAR; b.x = xb_xcc_id(); b.st = (volatile LAS unsigned*)((LAS unsigned char*)lds_raw + LDSX_OFF); xcd_barrier(b, fresh_tid(wv)); }
__global__ void __launch_bounds__(512, 2) mk_fwd(Args a) {
    int wv = __builtin_amdgcn_readfirstlane(threadIdx.x >> 6); asm volatile("" : "+s"(wv));
    { LAS unsigned char* lds = (LAS unsigned char*)lds_raw;
      for (int u = threadIdx.x; u < (LDS_BYTES - LDSX_OFF) / 4; u += 512) ((LAS unsigned*)(lds + LDSX_OFF))[u] = 0u;
      __syncthreads();
      if (a.ph_hi - a.ph_lo > 1) (void)xcd_barrier_post((unsigned*)(a.ws + O_CTL) + CW_BAR, (volatile LAS unsigned*)(lds + LDSX_OFF), (int)threadIdx.x); }
    int pid = 0;
#define PHASE(call) { const ArgsP q_ = fresh_args(); const int lo_ = q_->ph_lo, hi_ = q_->ph_hi; if (pid >= lo_ && pid < hi_) { call; if (pid + 1 < hi_) grid_barrier(wv); } ++pid; }
#define PHASE_R(call, REP) { const ArgsP q_ = fresh_args(); const int lo_ = q_->ph_lo, hi_ = q_->ph_hi; if (pid >= lo_ && pid < hi_) { if ((REP) > 1) { call; grid_barrier(wv); } call; if (pid + 1 < hi_) grid_barrier(wv); } ++pid; }
#ifndef REP_PROLOGUE
#define REP_PROLOGUE 1
#endif
#ifndef REP_MOE
#define REP_MOE 1
#endif
#ifndef REP_ATTN
#define REP_ATTN 1
#endif
#ifndef REP_GEMMS
#define REP_GEMMS 1
#endif
#ifdef TIME_NORM
#define NORM_EXTRA(l) PHASE(ph_norm(wv, l, 3))
#else
#define NORM_EXTRA(l)
#endif
#ifndef REP_ELEM
#define REP_ELEM 1
#endif
#ifndef REP_ROUTER
#define REP_ROUTER REP_ELEM
#endif
#ifndef REP_SCATTER
#define REP_SCATTER REP_ELEM
#endif
#ifndef REP_MIX
#define REP_MIX REP_ELEM
#endif
#ifndef REP_CONV
#define REP_CONV REP_ELEM
#endif
#ifndef REP_SCANA
#define REP_SCANA REP_ELEM
#endif
#define MOE_PHASES(l) PHASE_R(ph_router(wv, l), REP_ROUTER) PHASE_R(ph_scatter(wv), REP_SCATTER) PHASE_R(ph_moe1(wv, l), REP_MOE) PHASE_R(ph_moe2(wv, l), REP_MOE)
    PHASE_R(ph_prologue(wv), REP_PROLOGUE)
#define LAYER_PAIR(lp) \
        { const int l = 2 * (lp);         \
          PHASE(ph_norm(wv, l, (lp) == 0 ? 0 : 1)) PHASE_R(ph_proj(wv, lp), REP_GEMMS) PHASE_R(ph_qkv(wv, lp), REP_GEMMS) PHASE_R(ph_attention(wv, lp), REP_ATTN) PHASE_R(ph_mixcombine(wv), REP_MIX) PHASE(ph_outproj(wv, l, 0)) \
          MOE_PHASES(l) } \
        { const int l = 2 * (lp) + 1;     \
          NORM_EXTRA(l) PHASE(ph_norm(wv, l, 1)) PHASE_R(ph_recin(wv, lp), REP_GEMMS) PHASE_R(ph_rgate(wv, lp), REP_CONV) PHASE_R(ph_scan_apply(wv), REP_SCANA) PHASE(ph_outproj(wv, l, 1)) \
          MOE_PHASES(l) }
    LAYER_PAIR(0)
    LAYER_PAIR(1)
#undef LAYER_PAIR
#ifdef EXTRA_BARRIERS
    { const ArgsP q_ = fresh_args(); if (q_->ph_hi - q_->ph_lo > 1) { _Pragma("unroll 1") for (int xb = 0; xb < EXTRA_BARRIERS; ++xb) grid_barrier(wv); } }
#endif
    PHASE(ph_norm(wv, 3, 2))
#undef PHASE
#undef PHASE_R
#undef MOE_PHASES
}
#else
template <int PH> __global__ void __launch_bounds__(512, 2) k_phase(Args a, int l, int x) {
    int wv = __builtin_amdgcn_readfirstlane(threadIdx.x >> 6); asm volatile("" : "+s"(wv));
    LAS unsigned char* lds = (LAS unsigned char*)lds_raw;
    for (int u = threadIdx.x; u < (LDS_BYTES - LDSX_OFF) / 4; u += 512) ((LAS unsigned*)(lds + LDSX_OFF))[u] = 0u;
    __syncthreads();
    if constexpr (PH == 0) ph_prologue(wv);
    if constexpr (PH == 1) ph_norm(wv, l, x);
    if constexpr (PH == 2) ph_proj(wv, l);
    if constexpr (PH == 4) ph_qkv(wv, l);
    if constexpr (PH == 6) ph_attention(wv, l);
    if constexpr (PH == 7) ph_mixcombine(wv);
    if constexpr (PH == 8) ph_outproj(wv, l, x);
    if constexpr (PH == 9) ph_router(wv, l);
    if constexpr (PH == 10) ph_scatter(wv);
    if constexpr (PH == 11) ph_moe1(wv, l);
    if constexpr (PH == 12) ph_moe2(wv, l);
    if constexpr (PH == 13) ph_recin(wv, l);
    if constexpr (PH == 14) ph_rgate(wv, l);
    if constexpr (PH == 17) ph_scan_apply(wv);
}
#endif
#undef IN
#undef MODL
}

#ifndef MODE
#define MODE 2
#endif
extern "C" void kernel_launch(void* const* d_in, const int* in_sizes, int n_in, void* d_out, int out_size, void* d_ws, size_t ws_size, hipStream_t stream) {
    (void)in_sizes; (void)n_in; (void)out_size; (void)ws_size;
#if MODE == 0
    nv::forward(d_in, (float*)d_out, d_ws, stream);
#else
    static int grid = 0;
    if (grid == 0) {
        int dev = 0, cus = 0;
        (void)hipGetDevice(&dev); (void)hipDeviceGetAttribute(&cus, hipDeviceAttributeMultiprocessorCount, dev);
#if MODE == 1
        (void)hipFuncSetAttribute((const void*)mk::mk_fwd, hipFuncAttributeMaxDynamicSharedMemorySize, mk::LDS_BYTES);
#else
#define SA(PH) (void)hipFuncSetAttribute((const void*)mk::k_phase<PH>, hipFuncAttributeMaxDynamicSharedMemorySize, mk::LDS_BYTES)
        SA(0); SA(1); SA(2); SA(4); SA(6); SA(7); SA(8); SA(9); SA(10); SA(11); SA(12); SA(13); SA(14); SA(17);
#undef SA
#endif
        grid = cus > 0 ? cus : 256;
    }
    (void)hipMemsetAsync((char*)d_ws + mk::O_CTL, 0, mk::SZ_CTL, stream);
    mk::Args a;
    memset(&a, 0, sizeof(a));
    for (int i = 0; i < 34; ++i) a.in[i] = d_in[i];
    a.out = (float*)d_out; a.ws = (unsigned char*)d_ws;
#if MODE == 1
    a.ph_lo = 0; a.ph_hi = mk::N_PHASES;
    hipLaunchKernelGGL(mk::mk_fwd, dim3(grid), dim3(512), mk::LDS_BYTES, stream, a);
#else
#define LP(PH, l, x) hipLaunchKernelGGL(mk::k_phase<PH>, dim3(grid), dim3(512), mk::LDS_BYTES, stream, a, l, x)
    LP(0, 0, 0);
    for (int lp = 0; lp < 2; ++lp) {
        { const int l = 2 * lp; LP(1, l, lp == 0 ? 0 : 1); LP(2, lp, 0); LP(4, lp, 0); LP(6, lp, 0); LP(7, 0, 0); LP(8, l, 0); LP(9, l, 0); LP(10, 0, 0); LP(11, l, 0); LP(12, l, 0); }
        { const int l = 2 * lp + 1; LP(1, l, 1); LP(13, lp, 0); LP(14, lp, 0); LP(17, 0, 0); LP(8, l, 1); LP(9, l, 0); LP(10, 0, 0); LP(11, l, 0); LP(12, l, 0); }
    }
    LP(1, 3, 2);
#undef LP
#endif
#endif
}
```

```cpp
#define MODE 1

#include <string.h>
#include <hip/hip_runtime.h>
#include <stdint.h>
#include <math.h>

namespace cfg {
constexpr int D = 1024, NB = 4, S = 4096, T = NB * S, DEPTH = 4;
constexpr int MIXIN = 1952;
constexpr int NE = 32, TOPK = 4;
constexpr int MPAIR = T * TOPK;
constexpr int NBLK = MPAIR / 256 + NE;
constexpr int P = NBLK * 256;
}
using namespace cfg;

namespace nv {

__device__ __forceinline__ float wave_sum(float v) {
#pragma unroll
    for (int o = 1; o < 64; o <<= 1) v += __shfl_xor(v, o);
    return v;
}
__device__ __forceinline__ float wave_max(float v) {
#pragma unroll
    for (int o = 1; o < 64; o <<= 1) v = fmaxf(v, __shfl_xor(v, o));
    return v;
}
__device__ __forceinline__ float block_sum256(float v) {
    __shared__ float red[4];
    v = wave_sum(v);
    __syncthreads();
    if ((threadIdx.x & 63) == 0) red[threadIdx.x >> 6] = v;
    __syncthreads();
    return red[0] + red[1] + red[2] + red[3];
}
__device__ __forceinline__ float sigmoidf_(float x) { return 1.f / (1.f + expf(-x)); }
__device__ __forceinline__ float gelu_tanh(float x) { return 0.5f * x * (1.f + tanhf(0.7978845608028654f * (x + 0.044715f * x * x * x))); }

__global__ void k_mod(const float* __restrict__ c, const float* __restrict__ ada_w, const float* __restrict__ ada_b, float* __restrict__ mod) {
    const int n = blockIdx.x * 256 + threadIdx.x, l = blockIdx.y;
    float acc[4] = {0.f, 0.f, 0.f, 0.f};
    const float* w = ada_w + (size_t)l * 1024 * 6144 + n;
    for (int k = 0; k < 1024; ++k) {
        const float wv = w[(size_t)k * 6144];
#pragma unroll
        for (int b = 0; b < 4; ++b) { const float cv = c[b * 1024 + k]; acc[b] += (cv / (1.f + expf(-cv))) * wv; }
    }
#pragma unroll
    for (int b = 0; b < 4; ++b) mod[((size_t)l * 4 + b) * 6144 + n] = acc[b] + ada_b[l * 6144 + n];
}

__global__ void k_rmsmod(const float* __restrict__ x, const float* __restrict__ gain, const float* __restrict__ modl, int shoff, int scoff, float* __restrict__ out) {
    const int t = blockIdx.x, b = t / S;
    const float* xr = x + (size_t)t * D;
    float v[4]; float ss = 0.f;
#pragma unroll
    for (int i = 0; i < 4; ++i) { v[i] = xr[threadIdx.x + 256 * i]; ss += v[i] * v[i]; }
    ss = block_sum256(ss);
    const float rs = rsqrtf(ss * (1.f / D) + 1e-6f);
#pragma unroll
    for (int i = 0; i < 4; ++i) { const int col = threadIdx.x + 256 * i;
        out[(size_t)t * D + col] = v[i] * rs * gain[col] * (1.f + modl[b * 6144 + scoff + col]) + modl[b * 6144 + shoff + col]; }
}

template <class Epi>
__global__ void __launch_bounds__(256) k_gemm(const float* __restrict__ A, const int* __restrict__ rowidx, const float* __restrict__ Bw, const int* __restrict__ tile_e, size_t bstride,
                                             Epi epi, int lda, int ldb, int N, int K) {
    __shared__ float As[16][68];
    __shared__ float Bs[16][68];
    const int row0 = blockIdx.y * 64, col0 = blockIdx.x * 64;
    int e = 0;
    if (tile_e) { e = tile_e[row0 / 256]; if (e < 0) return; }
    const float* Bp = Bw + (size_t)e * bstride;
    const int tid = threadIdx.x, ty = tid >> 4, tx = tid & 15;
    const int ar = tid >> 2, ak = (tid & 3) * 4;
    const int bk = tid >> 4, bn = (tid & 15) * 4;
    const int arow = rowidx ? rowidx[row0 + ar] : (row0 + ar);
    const float* Ap = A + (size_t)arow * lda + ak;
    float acc[4][4];
#pragma unroll
    for (int i = 0; i < 4; ++i)
#pragma unroll
        for (int j = 0; j < 4; ++j) acc[i][j] = 0.f;
    for (int k0 = 0; k0 < K; k0 += 16) {
        const float4 av = *(const float4*)(Ap + k0);
        float4 bv = make_float4(0.f, 0.f, 0.f, 0.f);
        if (col0 + bn < N) bv = *(const float4*)(Bp + (size_t)(k0 + bk) * ldb + col0 + bn);
        __syncthreads();
        As[ak + 0][ar] = av.x; As[ak + 1][ar] = av.y; As[ak + 2][ar] = av.z; As[ak + 3][ar] = av.w;
        *(float4*)&Bs[bk][bn] = bv;
        __syncthreads();
#pragma unroll
        for (int kk = 0; kk < 16; ++kk) {
            const float4 a4 = *(const float4*)&As[kk][ty * 4];
            const float4 b4 = *(const float4*)&Bs[kk][tx * 4];
            const float a[4] = {a4.x, a4.y, a4.z, a4.w}, b[4] = {b4.x, b4.y, b4.z, b4.w};
#pragma unroll
            for (int i = 0; i < 4; ++i)
#pragma unroll
                for (int j = 0; j < 4; ++j) acc[i][j] += a[i] * b[j];
        }
    }
#pragma unroll
    for (int i = 0; i < 4; ++i)
#pragma unroll
        for (int j = 0; j < 4; ++j) { const int r = row0 + ty * 4 + i, cidx = col0 + tx * 4 + j; if (cidx < N) epi(r, cidx, acc[i][j], e); }
}
struct EpiStore { float* C; const float* bias; int ldc; int bias_estride;
    __device__ __forceinline__ void operator()(int r, int c, float v, int e) const { C[(size_t)r * ldc + c] = v + (bias ? bias[(size_t)e * bias_estride + c] : 0.f); } };
struct EpiResid { float* X; const float* g; const float* bias;
    __device__ __forceinline__ void operator()(int r, int c, float v, int) const { const int b = r / S; X[(size_t)r * D + c] += g[b * 6144 + c] * (v + (bias ? bias[c] : 0.f)); } };

__global__ void k_postproj(float* __restrict__ PROJ, const float* __restrict__ qg, const float* __restrict__ kg, const float* __restrict__ qag, const float* __restrict__ kvag,
                           const float* __restrict__ mkg  , const int* __restrict__ positions) {
    const int t = blockIdx.x; float* r = PROJ + (size_t)t * MIXIN; const int tid = threadIdx.x;
    if (tid < 16) { float* p = r + tid * 64; const float* g = tid < 8 ? qg : kg; float ss = 0.f; for (int i = 0; i < 64; ++i) ss += p[i] * p[i];
        const float rs = rsqrtf(ss / 64.f + 1e-6f); for (int i = 0; i < 64; ++i) p[i] = p[i] * rs * g[i]; }
    else if (tid == 16) { float* p = r + 1536; float ss = 0.f; for (int i = 0; i < 256; ++i) ss += p[i] * p[i];
        const float rs = rsqrtf(ss / 256.f + 1e-6f); for (int i = 0; i < 256; ++i) p[i] = p[i] * rs * qag[i]; }
    else if (tid == 17) { float* p = r + 1792; float ss = 0.f; for (int i = 0; i < 128; ++i) ss += p[i] * p[i];
        const float rs = rsqrtf(ss / 128.f + 1e-6f); for (int i = 0; i < 128; ++i) p[i] = p[i] * rs * kvag[i]; }
    else if (tid == 18) { float* p = r + 1920; float ss = 0.f; for (int i = 0; i < 32; ++i) ss += p[i] * p[i];
        const float rs = rsqrtf(ss / 32.f + 1e-6f);
        const float pos = (float)positions[t];
        for (int i = 0; i < 16; ++i) { const float inv = powf(10000.f, -(float)(2 * i) / 32.f); const float ang = pos * inv; const float cs = cosf(ang), sn = sinf(ang);
            const float v1 = p[i] * rs * mkg[64 + i], v2 = p[16 + i] * rs * mkg[80 + i];
            p[i] = v1 * cs - v2 * sn; p[16 + i] = v1 * sn + v2 * cs; } }
}
__global__ void k_postq(float* __restrict__ Q2, float* __restrict__ KV2, const float* __restrict__ mqg, const float* __restrict__ mkg, const int* __restrict__ positions) {
    const int t = blockIdx.x, tid = threadIdx.x;
    if (tid < 8) { float* p = Q2 + (size_t)t * 768 + tid * 96; float ss = 0.f; for (int i = 0; i < 64; ++i) ss += p[i] * p[i];
        float rs = rsqrtf(ss / 64.f + 1e-6f); for (int i = 0; i < 64; ++i) p[i] = p[i] * rs * mqg[i];
        float* q = p + 64; ss = 0.f; for (int i = 0; i < 32; ++i) ss += q[i] * q[i]; rs = rsqrtf(ss / 32.f + 1e-6f);
        const float pos = (float)positions[t];
        for (int i = 0; i < 16; ++i) { const float inv = powf(10000.f, -(float)(2 * i) / 32.f); const float ang = pos * inv; const float cs = cosf(ang), sn = sinf(ang);
            const float v1 = q[i] * rs * mqg[64 + i], v2 = q[16 + i] * rs * mqg[80 + i];
            q[i] = v1 * cs - v2 * sn; q[16 + i] = v1 * sn + v2 * cs; } }
    else if (tid < 16) { float* p = KV2 + (size_t)t * 1024 + (tid - 8) * 128; float ss = 0.f; for (int i = 0; i < 64; ++i) ss += p[i] * p[i];
        const float rs = rsqrtf(ss / 64.f + 1e-6f); for (int i = 0; i < 64; ++i) p[i] = p[i] * rs * mkg[i]; }
}
__global__ void __launch_bounds__(256) k_mla(const float* __restrict__ Q2, const float* __restrict__ KV2, const float* __restrict__ PROJ, float* __restrict__ ATT) {
    const int wave = threadIdx.x >> 6, lane = threadIdx.x & 63;
    const int q = blockIdx.x * 4 + wave, h = blockIdx.y, b = blockIdx.z;
    const float* qrow = Q2 + (size_t)(b * S + q) * 768 + h * 96;
    float qv[96];
#pragma unroll
    for (int d = 0; d < 96; ++d) qv[d] = qrow[d];
    const float scale = 0.10206207261596575f;
    float m = -INFINITY, l = 0.f, o = 0.f;
    for (int k0 = 0; k0 <= q; k0 += 64) {
        const int k = k0 + lane; float s = -INFINITY;
        if (k <= q) { const float* kn = KV2 + (size_t)(b * S + k) * 1024 + h * 128; const float* kp = PROJ + (size_t)(b * S + k) * MIXIN + 1920; float acc = 0.f;
#pragma unroll
            for (int d = 0; d < 64; ++d) acc += qv[d] * kn[d];
#pragma unroll
            for (int d = 0; d < 32; ++d) acc += qv[64 + d] * kp[d];
            s = acc * scale; }
        const float mn = fmaxf(m, wave_max(s));
        const float alpha = expf(m - mn); const float p = (k <= q) ? expf(s - mn) : 0.f;
        l = l * alpha + wave_sum(p); o *= alpha;
        const int kend = min(64, q - k0 + 1);
        for (int kk = 0; kk < kend; ++kk) { const float pk = __shfl(p, kk); o += pk * KV2[(size_t)(b * S + k0 + kk) * 1024 + h * 128 + 64 + lane]; }
        m = mn;
    }
    ATT[(size_t)(b * S + q) * 1024 + 512 + h * 64 + lane] = o / l;
}
__global__ void __launch_bounds__(256) k_dil(const float* __restrict__ PROJ, float* __restrict__ ATT) {
    const int wave = threadIdx.x >> 6, lane = threadIdx.x & 63;
    const int t = blockIdx.x * 4 + wave, h = blockIdx.y, b = blockIdx.z;
    const float* base = PROJ + (size_t)(b * S) * MIXIN;
    const float* qrow = base + (size_t)t * MIXIN + h * 64;
    float qv[64];
#pragma unroll
    for (int d = 0; d < 64; ++d) qv[d] = qrow[d];
    float s[7]; float mx = -INFINITY;
#pragma unroll
    for (int c = 0; c < 7; ++c) { const int slot = c * 64 + lane; s[c] = -INFINITY;
        if (slot < 387) { const int p = slot / 129, j = slot % 129; const int dd = (p == 0) ? 1 : (p == 1) ? 4 : 16; const int tk = t - j * dd;
            if (tk >= 0) { const float* kr = base + (size_t)tk * MIXIN + 512 + h * 64; float acc = 0.f;
#pragma unroll
                for (int d = 0; d < 64; ++d) acc += qv[d] * kr[d];
                s[c] = acc * 0.125f; } }
        mx = fmaxf(mx, s[c]); }
    mx = wave_max(mx);
    float ls = 0.f;
#pragma unroll
    for (int c = 0; c < 7; ++c) { s[c] = expf(s[c] - mx); ls += s[c]; }
    ls = wave_sum(ls);
    float o = 0.f;
#pragma unroll
    for (int c = 0; c < 7; ++c)
        for (int kk = 0; kk < 64; ++kk) { const int slot = c * 64 + kk; if (slot >= 387) break; const int p = slot / 129, j = slot % 129; const int dd = (p == 0) ? 1 : (p == 1) ? 4 : 16; const int tk = t - j * dd;
            const float pk = __shfl(s[c], kk);
            if (tk >= 0) o += pk * base[(size_t)tk * MIXIN + 1024 + h * 64 + lane]; }
    ATT[(size_t)(b * S + t) * 1024 + h * 64 + lane] = o / ls;
}

__global__ void k_conv(const float* __restrict__ GX, const float* __restrict__ cw, const float* __restrict__ cb, float* __restrict__ XC) {
    const int t = blockIdx.x, ts = t % S;
    for (int c = threadIdx.x; c < 1024; c += 256) { float acc = cb[c];
#pragma unroll
        for (int k = 0; k < 4; ++k) { const int dt = k - 3; if (ts + dt >= 0) acc += cw[k * 1024 + c] * GX[(size_t)(t + dt) * 2048 + 1024 + c]; }
        XC[(size_t)t * 1024 + c] = acc; }
}
__global__ void k_lru(const float* __restrict__ RPRE, const float* __restrict__ IPRE, const float* __restrict__ XC, const float* __restrict__ lam, float* __restrict__ Aa, float* __restrict__ Bb) {
    const size_t i = (size_t)blockIdx.x * 256 + threadIdx.x; const int c = (int)(i & 1023);
    const float r = sigmoidf_(RPRE[i]), ig = sigmoidf_(IPRE[i]);
    const float nl = -lam[c]; const float sp = (nl > 20.f) ? nl : log1pf(expf(nl));
    const float log_a = -8.f * r * sp; const float a = expf(log_a); const float mult = sqrtf(-expm1f(2.f * log_a));
    Aa[i] = a; Bb[i] = mult * (ig * XC[i]);
}
__global__ void k_scan(const float* __restrict__ Aa, const float* __restrict__ Bb, float* __restrict__ Y) {
    const int idx = blockIdx.x * 256 + threadIdx.x; const int b = idx / 1024, c = idx % 1024;
    float h = 0.f; size_t off = (size_t)b * S * 1024 + c;
    for (int t = 0; t < S; ++t, off += 1024) { h = Aa[off] * h + Bb[off]; Y[off] = h; }
}
__global__ void k_gy(const float* __restrict__ GX, const float* __restrict__ Y, float* __restrict__ GY) {
    const size_t i = (size_t)blockIdx.x * 256 + threadIdx.x; const size_t t = i >> 10; const int c = (int)(i & 1023);
    GY[i] = gelu_tanh(GX[t * 2048 + c]) * Y[i];
}

__global__ void k_router(const float* __restrict__ x, const float* __restrict__ gain, const float* __restrict__ modl, const float* __restrict__ wr, const float* __restrict__ br,
                         float* __restrict__ HN2, int* __restrict__ topi, float* __restrict__ topg, int* __restrict__ cnt) {
    __shared__ float hrow[1024]; __shared__ float part[8][32]; __shared__ float lg[32];
    const int t = blockIdx.x, b = t / S, tid = threadIdx.x;
    const float* xr = x + (size_t)t * D;
    float v[4]; float ss = 0.f;
#pragma unroll
    for (int i = 0; i < 4; ++i) { v[i] = xr[tid + 256 * i]; ss += v[i] * v[i]; }
    ss = block_sum256(ss);
    const float rs = rsqrtf(ss * (1.f / D) + 1e-6f);
#pragma unroll
    for (int i = 0; i < 4; ++i) { const int col = tid + 256 * i; const float hv = v[i] * rs * gain[col] * (1.f + modl[b * 6144 + 4096 + col]) + modl[b * 6144 + 3072 + col];
        hrow[col] = hv; HN2[(size_t)t * D + col] = hv; }
    __syncthreads();
    { const int e = tid & 31, kp = tid >> 5; float acc = 0.f; for (int k = kp * 128; k < kp * 128 + 128; ++k) acc += hrow[k] * wr[k * 32 + e]; part[kp][e] = acc; }
    __syncthreads();
    if (tid < 32) { float a = br[tid]; for (int i = 0; i < 8; ++i) a += part[i][tid]; lg[tid] = a; }
    __syncthreads();
    if (tid == 0) { int idx[4]; float val[4]; unsigned used = 0u;
        for (int k = 0; k < 4; ++k) { int bi = -1; float bv = -INFINITY; for (int e = 0; e < 32; ++e) if (!((used >> e) & 1u) && lg[e] > bv) { bv = lg[e]; bi = e; } used |= 1u << bi; idx[k] = bi; val[k] = bv; }
        float den = 0.f, ex[4]; for (int k = 0; k < 4; ++k) { ex[k] = expf(val[k] - val[0]); den += ex[k]; }
        for (int k = 0; k < 4; ++k) { topi[t * 4 + k] = idx[k]; topg[t * 4 + k] = ex[k] / den; atomicAdd(&cnt[idx[k]], 1); } }
}
__global__ void k_plan(const int* __restrict__ cnt, int* __restrict__ pstart, int* __restrict__ tile_e) {
    if (threadIdx.x == 0) { int acc = 0, ti = 0;
        for (int e = 0; e < NE; ++e) { pstart[e] = acc; const int nt = (cnt[e] + 255) / 256; for (int i = 0; i < nt; ++i) tile_e[ti++] = e; acc += nt * 256; }
        for (; ti < NBLK; ++ti) tile_e[ti] = -1; }
}
__global__ void k_scatter(const int* __restrict__ topi, const int* __restrict__ pstart, int* __restrict__ fill, int* __restrict__ rowtok, int* __restrict__ pos) {
    const int i = blockIdx.x * 256 + threadIdx.x; const int e = topi[i];
    const int p = pstart[e] + atomicAdd(&fill[e], 1); rowtok[p] = i >> 2; pos[i] = p;
}
__global__ void k_swiglu(const float* __restrict__ HB, const int* __restrict__ tile_e, float* __restrict__ ACT) {
    const int p = blockIdx.x; if (tile_e[p / 256] < 0) return;
    for (int j = threadIdx.x; j < 1024; j += 256) { float g = HB[(size_t)p * 2048 + 2 * j], li = HB[(size_t)p * 2048 + 2 * j + 1];
        g = fminf(g, 7.f); li = fminf(fmaxf(li, -7.f), 7.f);
        ACT[(size_t)p * 1024 + j] = g * sigmoidf_(1.702f * g) * (li + 1.f); }
}
__global__ void k_combine(float* __restrict__ X, const float* __restrict__ Y2, const int* __restrict__ pos, const float* __restrict__ topg, const float* __restrict__ modl) {
    const int t = blockIdx.x, b = t / S;
    int pp[4]; float gg[4];
#pragma unroll
    for (int k = 0; k < 4; ++k) { pp[k] = pos[t * 4 + k]; gg[k] = topg[t * 4 + k]; }
    for (int c = threadIdx.x; c < 1024; c += 256) { float y = 0.f;
#pragma unroll
        for (int k = 0; k < 4; ++k) y += gg[k] * Y2[(size_t)pp[k] * 1024 + c];
        X[(size_t)t * D + c] += modl[b * 6144 + 5120 + c] * y; }
}

struct Bump { char* base; size_t off; template <class Tp> Tp* get(size_t n) { off = (off + 255) & ~(size_t)255; Tp* p = (Tp*)(base + off); off += n * sizeof(Tp); return p; } };

static void forward(void* const* d_in, float* X, void* d_ws, hipStream_t st) {
    const float* x = (const float*)d_in[0]; const float* c = (const float*)d_in[1]; const int* positions = (const int*)d_in[2];
    const float* ada_w = (const float*)d_in[3]; const float* ada_b = (const float*)d_in[4];
    const float* n1g = (const float*)d_in[5]; const float* n2g = (const float*)d_in[6];
    const float* attn_w_in = (const float*)d_in[7]; const float* da_qg = (const float*)d_in[8]; const float* da_kg = (const float*)d_in[9];
    const float* qag = (const float*)d_in[10]; const float* kvag = (const float*)d_in[11]; const float* w_uq = (const float*)d_in[12]; const float* w_ukv = (const float*)d_in[13];
    const float* mqg = (const float*)d_in[14]; const float* mkg = (const float*)d_in[15]; const float* attn_w_out = (const float*)d_in[16];
    const float* rec_w_in = (const float*)d_in[17]; const float* rec_b_in = (const float*)d_in[18]; const float* conv_w = (const float*)d_in[19]; const float* conv_b = (const float*)d_in[20];
    const float* rec_wa = (const float*)d_in[21]; const float* rec_ba = (const float*)d_in[22]; const float* rec_wx = (const float*)d_in[23]; const float* rec_bx = (const float*)d_in[24];
    const float* rec_lam = (const float*)d_in[25]; const float* rec_w_out = (const float*)d_in[26]; const float* rec_b_out = (const float*)d_in[27];
    const float* w_router = (const float*)d_in[28]; const float* b_router = (const float*)d_in[29]; const float* w1 = (const float*)d_in[30]; const float* b1 = (const float*)d_in[31];
    const float* w2 = (const float*)d_in[32]; const float* b2 = (const float*)d_in[33];

    Bump bp{(char*)d_ws, 0};
    int* ictl = bp.get<int>(1024);
    int* cnt = ictl, *fill = ictl + 64, *pstart = ictl + 128, *tile_e = ictl + 256;
    float* mod = bp.get<float>((size_t)DEPTH * 4 * 6144);
    float* HN = bp.get<float>((size_t)T * D);
    float* PROJ = bp.get<float>((size_t)T * 2048);
    float* Q2 = bp.get<float>((size_t)T * 768);
    float* KV2 = bp.get<float>((size_t)T * 1024);
    float* ATT = bp.get<float>((size_t)T * 1024);
    float* XC = bp.get<float>((size_t)T * 1024);
    float* RPRE = bp.get<float>((size_t)T * 1024);
    float* IPRE = bp.get<float>((size_t)T * 1024);
    float* Aa = bp.get<float>((size_t)T * 1024);
    float* Bb = bp.get<float>((size_t)T * 1024);
    float* Yv = bp.get<float>((size_t)T * 1024);
    int* topi = bp.get<int>((size_t)T * 4); float* topg = bp.get<float>((size_t)T * 4); int* pos = bp.get<int>((size_t)T * 4); int* rowtok = bp.get<int>(P);
    float* HB = bp.get<float>((size_t)P * 2048);
    float* ACT = bp.get<float>((size_t)P * 1024);
    float* Y2 = bp.get<float>((size_t)P * 1024);

    (void)hipMemcpyAsync(X, x, (size_t)T * D * 4, hipMemcpyDeviceToDevice, st);
    k_mod<<<dim3(6144 / 256, DEPTH), 256, 0, st>>>(c, ada_w, ada_b, mod);
    for (int l = 0; l < DEPTH; ++l) {
        const float* modl = mod + (size_t)l * 4 * 6144; const int j = l / 2;
        k_rmsmod<<<T, 256, 0, st>>>(X, n1g + l * D, modl, 0, 1024, HN);
        if (l % 2 == 0) {
            k_gemm<EpiStore><<<dim3((MIXIN + 63) / 64, T / 64), 256, 0, st>>>(HN, nullptr, attn_w_in + (size_t)j * D * MIXIN, nullptr, 0, EpiStore{PROJ, nullptr, MIXIN, 0}, D, MIXIN, MIXIN, D);
            k_postproj<<<T, 64, 0, st>>>(PROJ, da_qg + j * 64, da_kg + j * 64, qag + j * 256, kvag + j * 128, mkg + j * 96, positions);
            k_gemm<EpiStore><<<dim3(768 / 64, T / 64), 256, 0, st>>>(PROJ + 1536, nullptr, w_uq + (size_t)j * 256 * 768, nullptr, 0, EpiStore{Q2, nullptr, 768, 0}, MIXIN, 768, 768, 256);
            k_gemm<EpiStore><<<dim3(1024 / 64, T / 64), 256, 0, st>>>(PROJ + 1792, nullptr, w_ukv + (size_t)j * 128 * 1024, nullptr, 0, EpiStore{KV2, nullptr, 1024, 0}, MIXIN, 1024, 1024, 128);
            k_postq<<<T, 64, 0, st>>>(Q2, KV2, mqg + j * 96, mkg + j * 96, positions);
            k_dil<<<dim3(S / 4, 8, 4), 256, 0, st>>>(PROJ, ATT);
            k_mla<<<dim3(S / 4, 8, 4), 256, 0, st>>>(Q2, KV2, PROJ, ATT);
            k_gemm<EpiResid><<<dim3(D / 64, T / 64), 256, 0, st>>>(ATT, nullptr, attn_w_out + (size_t)j * 1024 * D, nullptr, 0, EpiResid{X, modl + 2048, nullptr}, 1024, D, D, 1024);
        } else {
            k_gemm<EpiStore><<<dim3(2048 / 64, T / 64), 256, 0, st>>>(HN, nullptr, rec_w_in + (size_t)j * D * 2048, nullptr, 0, EpiStore{PROJ, rec_b_in + j * 2048, 2048, 0}, D, 2048, 2048, D);
            k_conv<<<T, 256, 0, st>>>(PROJ, conv_w + j * 4 * 1024, conv_b + j * 1024, XC);
            for (int n = 0; n < 8; ++n) {
                k_gemm<EpiStore><<<dim3(2, T / 64), 256, 0, st>>>(XC + n * 128, nullptr, rec_wa + ((size_t)j * 8 + n) * 128 * 128, nullptr, 0, EpiStore{RPRE + n * 128, rec_ba + j * 1024 + n * 128, 1024, 0}, 1024, 128, 128, 128);
                k_gemm<EpiStore><<<dim3(2, T / 64), 256, 0, st>>>(XC + n * 128, nullptr, rec_wx + ((size_t)j * 8 + n) * 128 * 128, nullptr, 0, EpiStore{IPRE + n * 128, rec_bx + j * 1024 + n * 128, 1024, 0}, 1024, 128, 128, 128);
            }
            k_lru<<<T * 1024 / 256, 256, 0, st>>>(RPRE, IPRE, XC, rec_lam + j * 1024, Aa, Bb);
            k_scan<<<4096 / 256, 256, 0, st>>>(Aa, Bb, Yv);
            k_gy<<<T * 1024 / 256, 256, 0, st>>>(PROJ, Yv, ATT);
            k_gemm<EpiResid><<<dim3(D / 64, T / 64), 256, 0, st>>>(ATT, nullptr, rec_w_out + (size_t)j * 1024 * D, nullptr, 0, EpiResid{X, modl + 2048, rec_b_out + j * D}, 1024, D, D, 1024);
        }
        (void)hipMemsetAsync(ictl, 0, 1024 * 4, st);
        (void)hipMemsetAsync(rowtok, 0, (size_t)P * 4, st);
        k_router<<<T, 256, 0, st>>>(X, n2g + l * D, modl, w_router + (size_t)l * D * NE, b_router + l * NE, HN, topi, topg, cnt);
        k_plan<<<1, 64, 0, st>>>(cnt, pstart, tile_e);
        k_scatter<<<MPAIR / 256, 256, 0, st>>>(topi, pstart, fill, rowtok, pos);
        k_gemm<EpiStore><<<dim3(2048 / 64, P / 64), 256, 0, st>>>(HN, rowtok, w1 + (size_t)l * NE * D * 2048, tile_e, (size_t)D * 2048, EpiStore{HB, b1 + (size_t)l * NE * 2048, 2048, 2048}, D, 2048, 2048, D);
        k_swiglu<<<P, 256, 0, st>>>(HB, tile_e, ACT);
        k_gemm<EpiStore><<<dim3(1024 / 64, P / 64), 256, 0, st>>>(ACT, nullptr, w2 + (size_t)l * NE * 1024 * D, tile_e, (size_t)1024 * D, EpiStore{Y2, b2 + (size_t)l * NE * D, 1024, D}, 1024, D, D, 1024);
        k_combine<<<T, 256, 0, st>>>(X, Y2, pos, topg, modl);
    }
}
}


namespace mk {
#define LAS __attribute__((address_space(3)))
#define GAS __attribute__((address_space(1)))
typedef unsigned short bf16_t;
typedef short bf16x8 __attribute__((ext_vector_type(8)));
typedef short s16x4 __attribute__((ext_vector_type(4)));
typedef float f32x2 __attribute__((ext_vector_type(2)));
typedef float f32x4 __attribute__((ext_vector_type(4)));
typedef float f32x16 __attribute__((ext_vector_type(16)));
typedef unsigned u32x2 __attribute__((ext_vector_type(2)));
typedef unsigned u32x4 __attribute__((ext_vector_type(4)));
typedef GAS unsigned gu32;
#define RLX_AGENT __ATOMIC_RELAXED, __HIP_MEMORY_SCOPE_AGENT

__device__ __forceinline__ unsigned cvt_pk_bf16(float lo, float hi) { unsigned r; asm volatile("v_cvt_pk_bf16_f32 %0, %1, %2" : "=v"(r) : "v"(lo), "v"(hi)); return r; }
__device__ __forceinline__ float bf_lo(unsigned u) { return __uint_as_float(u << 16); }
__device__ __forceinline__ float bf_hi(unsigned u) { return __uint_as_float(u & 0xffff0000u); }
template <int O> __device__ __forceinline__ float shx(float v) { static_assert(O >= 1 && O < 32, "shx"); return __int_as_float(__builtin_amdgcn_ds_swizzle(__float_as_int(v), (O << 10) | 0x1f)); }
__device__ __forceinline__ float xadd32(float v) { const auto r = __builtin_amdgcn_permlane32_swap(__float_as_uint(v), __float_as_uint(v), false, false); return __uint_as_float(r[0]) + __uint_as_float(r[1]); }
__device__ __forceinline__ float xmax32(float v) { const auto r = __builtin_amdgcn_permlane32_swap(__float_as_uint(v), __float_as_uint(v), false, false); return fmaxf(__uint_as_float(r[0]), __uint_as_float(r[1])); }
__device__ __forceinline__ float wsum(float v) { v += shx<1>(v); v += shx<2>(v); v += shx<4>(v); v += shx<8>(v); v += shx<16>(v); return xadd32(v); }
__device__ __forceinline__ float fexp2(float x) { return __builtin_amdgcn_exp2f(x); }
__device__ __forceinline__ float frcp(float x) { return __builtin_amdgcn_rcpf(x); }
__device__ __forceinline__ float fsigmoid(float z) { return frcp(1.f + fexp2(-1.4426950408889634f * z)); }
__device__ __forceinline__ float fgelu_tanh(float x) { const float u = 0.7978845608028654f * (x + 0.044715f * x * x * x); return x * frcp(1.f + fexp2(-2.8853900817779268f * u)); }

#define XB_TMO      128
#define XB_XCNT(j)  (256  + 64 * (j))
#define XB_XSUB(j)  (1280 + 64 * (j))
#define XB_XGEN(j)  (2304 + 64 * (j))
#define XB_TOP      3328
#define XB_TOPGEN   3392
#define XCD_BAR_WORDS 3456
#define XB_SPIN_CAP (1u << 18)
__device__ __forceinline__ unsigned xb_ld(unsigned* p)              { return __hip_atomic_load(p, __ATOMIC_RELAXED, __HIP_MEMORY_SCOPE_AGENT); }
__device__ __forceinline__ unsigned xb_add(unsigned* p, unsigned v) { return __hip_atomic_fetch_add(p, v, __ATOMIC_RELAXED, __HIP_MEMORY_SCOPE_AGENT); }
__device__ __forceinline__ unsigned xb_xcc_id() { return (unsigned)__builtin_amdgcn_s_getreg((3 << 11) | 20) & 0xFu; }
#define XB_SPIN(cond, bar) do { unsigned _sp = 0; while (cond) { __builtin_amdgcn_s_sleep(1); \
    if ((++_sp & 255u) == 0u) { if (xb_ld(&(bar)[XB_TMO])) break; if (_sp > XB_SPIN_CAP) { atomicAdd(&(bar)[XB_TMO], 1u); break; } } } } while (0)
struct XcdBarrier { unsigned* bar; unsigned x; volatile LAS unsigned* st; };
__device__ __forceinline__ XcdBarrier xcd_barrier_post(unsigned* bar, volatile LAS unsigned* st, int tid) {
    XcdBarrier b; b.bar = bar; b.x = xb_xcc_id(); b.st = st;
    if (tid == 0) (void)xb_add(&bar[XB_XCNT(b.x)], 1u);
    return b;
}
__device__ __forceinline__ void xcd_barrier_complete(unsigned* bar, unsigned x, unsigned& nloc, unsigned& nx) {
    const unsigned G = gridDim.x * gridDim.y * gridDim.z;
    unsigned sum, cnt, mine, sp = 0u;
    for (;;) {
        sum = 0u; cnt = 0u; mine = 0u;
#pragma unroll
        for (unsigned j = 0; j < 16; ++j) { const unsigned c = xb_ld(&bar[XB_XCNT(j)]); sum += c; cnt += (c > 0u) ? 1u : 0u; mine = (j == x) ? c : mine; }
        if (sum == G) break;
        __builtin_amdgcn_s_sleep(1);
        if ((++sp & 255u) == 0u) { if (xb_ld(&bar[XB_TMO])) break; if (sp > XB_SPIN_CAP) { atomicAdd(&bar[XB_TMO], 1u); break; } }
    }
    nloc = mine > 0u ? mine : 1u; nx = cnt > 0u ? cnt : 1u;
}
__device__ __forceinline__ void xcd_barrier(const XcdBarrier& b, int tid) {
    asm volatile("s_waitcnt vmcnt(0)" ::: "memory");
    __syncthreads();
    if (tid == 0) {
        unsigned* bar = b.bar;
        __builtin_amdgcn_s_waitcnt(0);
        unsigned nloc = b.st[0], nx = b.st[1];
        if (nloc == 0u) { xcd_barrier_complete(bar, b.x, nloc, nx); b.st[0] = nloc; b.st[1] = nx; }
        const unsigned old = xb_add(&bar[XB_XSUB(b.x)], 1u);
        const unsigned gen = old / nloc;
        if (old + 1u == (gen + 1u) * nloc) {
            __builtin_amdgcn_fence(__ATOMIC_RELEASE, "agent");
            asm volatile("s_waitcnt vmcnt(0)" ::: "memory");
            const unsigned og = xb_add(&bar[XB_TOP], 1u);
            const unsigned tg = og / nx;
            if (og + 1u == (tg + 1u) * nx) xb_add(&bar[XB_TOPGEN], 1u);
            else XB_SPIN(xb_ld(&bar[XB_TOPGEN]) == tg, bar);
            __builtin_amdgcn_fence(__ATOMIC_ACQUIRE, "agent");
            xb_add(&bar[XB_XGEN(b.x)], 1u);
            asm volatile("s_waitcnt vmcnt(0)" ::: "memory");
        } else {
            XB_SPIN(xb_ld(&bar[XB_XGEN(b.x)]) == gen, bar);
            __builtin_amdgcn_fence(__ATOMIC_ACQUIRE, "agent");
            asm volatile("s_waitcnt vmcnt(0)" ::: "memory");
        }
    }
    __syncthreads();
}

constexpr int BM = 256, BK = 64, HALF = 128, HTB = HALF * BK * 2, STAGE_BYTES = 8 * HTB;
__host__ __device__ __forceinline__ int lds_byte(int r, int c) { const int st = (r >> 4) * 2 + (c >> 5), rr = r & 15, cc = c & 31, ob = rr * 64 + cc * 2; return st * 1024 + (ob ^ (((ob >> 9) & 1) << 5)); }
__host__ __device__ __forceinline__ void stage_rc(int b, int& R, int& C) { const int st = b / 1024, sb = b % 1024, swz = sb ^ (((sb >> 9) & 1) << 5); R = (st >> 1) * 16 + swz / 64; C = (st & 1) * 32 + (swz % 64) / 2; }
__host__ __device__ __forceinline__ int perm32(int rho) { const int n = rho >> 4, i = rho & 15; return 8 * (i >> 2) + 4 * n + (i & 3); }

struct Unit { const char* a; const char* b; int row0, col0, e, pad; };
struct GemmDims { int K, lda, ldb; };
typedef f32x4 Acc[2][2][4][2];
__device__ __forceinline__ void zero_acc(Acc& acc) {
#pragma unroll
    for (int a = 0; a < 2; ++a)
#pragma unroll
        for (int b = 0; b < 2; ++b)
#pragma unroll
            for (int m = 0; m < 4; ++m)
#pragma unroll
                for (int n = 0; n < 2; ++n)
#pragma unroll
                    for (int j = 0; j < 4; ++j) { float z; asm volatile("v_mov_b32 %0, 0" : "=v"(z)); acc[a][b][m][n][j] = z; }
}

typedef int v8i32 __attribute__((ext_vector_type(8)));
template <bool F8 = false, class CtxT, class Epi, class Sched>
__device__ __forceinline__ void gemm_phase(const CtxT& C, const GemmDims g, const Sched& S, const Epi& E) {
    LAS unsigned char* lds = C.lds;
    const int tid = C.tid, wid = __builtin_amdgcn_readfirstlane(tid >> 6), lane = tid & 63, wr = wid >> 2, wc = wid & 3, fr = lane & 15, fq = lane >> 4;
    constexpr int ESZ = F8 ? 1 : 2;
    int nt = g.K / (F8 ? 128 : BK); asm volatile("" : "+s"(nt));
    unsigned voffA[2], voffB[2];
#pragma unroll
    for (int i = 0; i < 2; ++i) { int R, C; stage_rc(tid * 16 + i * 8192, R, C); const int Rb = (R & ~31) + perm32(R & 31);
        voffA[i] = (unsigned)(R * g.lda * ESZ + C * 2); voffB[i] = (unsigned)(Rb * g.ldb * ESZ + C * 2); }
    const size_t kstep = (size_t)(BK * 2);
    const size_t hstepA = (size_t)HALF * g.lda * ESZ, hstepB = (size_t)HALF * g.ldb * ESZ;
    const unsigned ldsw = (unsigned)wid * 1024u;
    const unsigned ldsu = (unsigned)__builtin_amdgcn_readfirstlane((int)(unsigned)(unsigned long long)(lds));
    const int aoff = lds_byte(wr * 64 + fr, fq * 8), boff = lds_byte(wc * 32 + fr, fq * 8);
#define PG8_SA(b, h) (((b) * 2 + (h)) * HTB)
#define PG8_SB(b, h) ((4 + (b) * 2 + (h)) * HTB)
#define PG8_STAGE(bufoff, gbase, voff) do { _Pragma("unroll") for (int _i = 0; _i < 2; ++_i) { \
        asm volatile("s_mov_b32 m0, %2\n\ts_nop 3\n\tglobal_load_lds_dwordx4 %0, %1" :: "v"((voff)[_i]), "s"((const char*)(gbase)), "s"(ldsu + (unsigned)(bufoff) + ldsw + (unsigned)(_i * 8192)) : "memory"); } } while (0)
#define PG8_LDA(dst, b, h) do { _Pragma("unroll") for (int m = 0; m < 4; ++m) _Pragma("unroll") for (int k = 0; k < 2; ++k) dst[m][k] = *(const LAS bf16x8*)(lds + PG8_SA(b, h) + aoff + m * 2048 + k * 1024); } while (0)
#define PG8_LDB(dst, b, h) do { _Pragma("unroll") for (int n = 0; n < 2; ++n) _Pragma("unroll") for (int k = 0; k < 2; ++k) dst[n][k] = *(const LAS bf16x8*)(lds + PG8_SB(b, h) + boff + n * 2048 + k * 1024); } while (0)
#define PG8_CAT(x) __builtin_bit_cast(v8i32, (x))
#define PG8_MMA(ai, bj, At, Bt) do { __builtin_amdgcn_s_setprio(1); \
        if constexpr (F8) { _Pragma("unroll") for (int m = 0; m < 4; ++m) _Pragma("unroll") for (int n = 0; n < 2; ++n) \
            acc[ai][bj][m][n] = __builtin_amdgcn_mfma_scale_f32_16x16x128_f8f6f4(PG8_CAT(Bt[n]), PG8_CAT(At[m]), acc[ai][bj][m][n], 0, 0, 0, 0, 0, 0); } \
        else { _Pragma("unroll") for (int m = 0; m < 4; ++m) _Pragma("unroll") for (int n = 0; n < 2; ++n) _Pragma("unroll") for (int k = 0; k < 2; ++k) \
            acc[ai][bj][m][n] = __builtin_amdgcn_mfma_f32_16x16x32_bf16(Bt[n][k], At[m][k], acc[ai][bj][m][n], 0, 0, 0); } \
        __builtin_amdgcn_s_setprio(0); } while (0)
#define PG8_WAIT_V(n) asm volatile("s_waitcnt vmcnt(" #n ")" ::: "memory")
#define PG8_WAIT_L(n) asm volatile("s_waitcnt lgkmcnt(" #n ")" ::: "memory")
#define PG8_BAR __builtin_amdgcn_s_barrier()
#define PG8_SCHED __builtin_amdgcn_sched_barrier(0)
    Unit cur, nxt; int ui = 0;
    if (!S.next(0, cur)) return;
    Acc acc; zero_acc(acc);
    struct Frag2 { bf16x8 p[2]; __device__ __forceinline__ bf16x8& operator[](int k) { return p[k]; } __device__ __forceinline__ const bf16x8& operator[](int k) const { return p[k]; } };
    Frag2 At[4], B0[2], B1[2];
    const char* cA = cur.a; const char* cB = cur.b;
    PG8_STAGE(PG8_SB(0, 0), cB, voffB); PG8_STAGE(PG8_SB(0, 1), cB + hstepB, voffB); PG8_STAGE(PG8_SA(0, 0), cA, voffA); PG8_STAGE(PG8_SA(0, 1), cA + hstepA, voffA);
    if (wr == 1) PG8_BAR;
    PG8_WAIT_V(2); PG8_BAR;
    PG8_STAGE(PG8_SB(1, 0), cB + kstep, voffB); PG8_STAGE(PG8_SA(1, 0), cA + kstep, voffA); PG8_STAGE(PG8_SB(1, 1), cB + hstepB + kstep, voffB);
    PG8_WAIT_V(6); PG8_BAR;
    for (;;) {
        const bool has_next = S.next(ui + 1, nxt);
        const char* nA = has_next ? nxt.a : cA; const char* nB = has_next ? nxt.b : cB;
        for (int t = 0; t < nt; t += 2) {
            const bool last = (t == nt - 2);
            const char* a1 = cA + (size_t)(t + 1) * kstep;
            const char* a2 = last ? nA : cA + (size_t)(t + 2) * kstep; const char* b2 = last ? nB : cB + (size_t)(t + 2) * kstep;
            const char* a3 = a2 + kstep; const char* b3 = b2 + kstep;
            PG8_LDB(B0, 0, 0); PG8_LDB(B1, 0, 1); PG8_SCHED; PG8_LDA(At, 0, 0); PG8_STAGE(PG8_SA(1, 1), a1 + hstepA, voffA);
            PG8_WAIT_V(8); PG8_WAIT_L(0); PG8_BAR; PG8_MMA(0, 0, At, B0); PG8_MMA(0, 1, At, B1); PG8_BAR; PG8_SCHED;
            PG8_LDA(At, 0, 1); PG8_STAGE(PG8_SB(0, 0), b2, voffB); PG8_STAGE(PG8_SB(0, 1), b2 + hstepB, voffB); PG8_STAGE(PG8_SA(0, 0), a2, voffA);
            PG8_WAIT_V(8); PG8_WAIT_L(0); PG8_BAR; PG8_MMA(1, 0, At, B0); PG8_MMA(1, 1, At, B1); PG8_BAR; PG8_SCHED;
            PG8_LDB(B0, 1, 0); PG8_LDB(B1, 1, 1); PG8_SCHED; PG8_LDA(At, 1, 0); PG8_STAGE(PG8_SA(0, 1), a2 + hstepA, voffA);
            PG8_WAIT_V(8); PG8_WAIT_L(0); PG8_BAR; PG8_MMA(0, 0, At, B0); PG8_MMA(0, 1, At, B1); PG8_BAR; PG8_SCHED;
            PG8_LDA(At, 1, 1); PG8_STAGE(PG8_SB(1, 0), b3, voffB); PG8_STAGE(PG8_SB(1, 1), b3 + hstepB, voffB); PG8_STAGE(PG8_SA(1, 0), a3, voffA);
            PG8_WAIT_V(8); PG8_WAIT_L(0); PG8_BAR; PG8_MMA(1, 0, At, B0); PG8_MMA(1, 1, At, B1); PG8_BAR; PG8_SCHED;
        }
        if (wr == 0) PG8_BAR;
        E(acc, cur, wr, wc, fr, fq);
        if (!has_next) break;
        zero_acc(acc);
        cur = nxt; cA = nA; cB = nB; ++ui;
        if (wr == 1) PG8_BAR;
    }
    PG8_WAIT_V(0);
    PG8_BAR;
#undef PG8_SA
#undef PG8_SB
#undef PG8_STAGE
#undef PG8_LDA
#undef PG8_LDB
#undef PG8_MMA
#undef PG8_CAT
#undef PG8_WAIT_V
#undef PG8_WAIT_L
#undef PG8_BAR
#undef PG8_SCHED
}

struct DenseOrder {
    const char* A; const char* Bt; int lda, ldb, nM, nN, nwg, G, c;
    __device__ __forceinline__ void init(const void* A_, const void* Bt_, int lda_, int ldb_, int M, int N, int G_, int c_) { A = (const char*)A_; Bt = (const char*)Bt_; lda = lda_; ldb = ldb_; nM = M / BM; nN = N / BM; nwg = nM * nN; G = G_; c = c_; }
    __device__ __forceinline__ bool next(int i, Unit& u) const {
        const long L = (long)i * G + c; if (L >= nwg) return false;
        int wgid = (int)L; { const int q = nwg / 8, r = nwg % 8, xcd = wgid % 8, off = wgid / 8; wgid = (xcd < r ? xcd * (q + 1) : r * (q + 1) + (xcd - r) * q) + off; }
        const int nig = 8 * nN, gid = wgid / nig, fm = gid * 8, gsz = (nM - fm) < 8 ? (nM - fm) : 8;
        const int pm = fm + ((wgid % nig) % gsz), pn = (wgid % nig) / gsz;
        u.a = A + (size_t)pm * BM * lda * 2; u.b = Bt + (size_t)pn * BM * ldb * 2; u.row0 = pm * BM; u.col0 = pn * BM; u.e = 0; u.pad = 0; return true;
    }
};
struct LruOrder {
    const char* XC; const char* RG; int G, c;
    __device__ __forceinline__ bool next(int i, Unit& u) const {
        const int L = i * G + c; if (L >= 512) return false;
        const int pm = L >> 3, n = L & 7;
        u.a = XC + ((size_t)pm * BM * 1024 + n * 128) * 2; u.b = RG + (size_t)n * 256 * 128 * 2; u.row0 = pm * BM; u.col0 = n * 128; u.e = n; u.pad = 0; return true;
    }
};
struct MoeOrder {
    const char* A; const char* WT; size_t estride; const LAS int* tile_e; int NT, nN, G, c, esz;
    __device__ __forceinline__ bool next(int i, Unit& u) const {
        int tile, pn;
#ifndef MOE_ORDER_ALT
#define MOE_ORDER_ALT 0
#endif
        if (!MOE_ORDER_ALT && (G % (8 * nN)) == 0) { const int R = G / nN; tile = i * R + (c & 7) * (R >> 3) + (c >> 3) / nN; pn = (c >> 3) % nN; }
        else { const int L = i * G + c; tile = L / nN; pn = L % nN; }
        if (tile >= NT) return false;
        const int e = __builtin_amdgcn_readfirstlane(tile_e[tile]);
        u.a = A + (size_t)tile * BM * 1024 * esz; u.b = WT + (size_t)e * estride + (size_t)pn * BM * 1024 * esz; u.row0 = tile * BM; u.col0 = pn * BM; u.e = e; u.pad = 0; return true;
    }
};

#define EPI_ROW(ai, m) (u.row0 + (ai) * HALF + wr * 64 + (m) * 16 + fr)
#define EPI_COL(bj) (u.col0 + (bj) * HALF + wc * 32 + 8 * fq)
struct EpiBf16 {
    bf16_t* O; const float* bias; int ldc, bias_es; float ascale;
    __device__ __forceinline__ void operator()(const Acc& acc, const Unit& u, int wr, int wc, int fr, int fq) const {
        f32x4 bv[2][2];
#pragma unroll
        for (int bj = 0; bj < 2; ++bj)
#pragma unroll
            for (int n = 0; n < 2; ++n) bv[bj][n] = bias ? *(const f32x4*)(bias + (size_t)u.e * bias_es + EPI_COL(bj) + 4 * n) : (f32x4){0.f, 0.f, 0.f, 0.f};
#pragma unroll
        for (int ai = 0; ai < 2; ++ai)
#pragma unroll
            for (int m = 0; m < 4; ++m) { bf16_t* rowp = O + (size_t)EPI_ROW(ai, m) * ldc;
#pragma unroll
                for (int bj = 0; bj < 2; ++bj) { const f32x4 v0 = acc[ai][bj][m][0] * ascale + bv[bj][0], v1 = acc[ai][bj][m][1] * ascale + bv[bj][1];
                    u32x4 w; w.x = cvt_pk_bf16(v0[0], v0[1]); w.y = cvt_pk_bf16(v0[2], v0[3]); w.z = cvt_pk_bf16(v1[0], v1[1]); w.w = cvt_pk_bf16(v1[2], v1[3]);
                    *(u32x4*)(rowp + EPI_COL(bj)) = w; } }
    }
};
template <int KIND> struct EpiNorm {
    bf16_t* O; int ldc; const float* ga; const float* gb; const float* gc; const float* gd; const float* ge; const float* cs; LAS float* S;
    __device__ __forceinline__ void operator()(const Acc& acc, const Unit& u, int wr, int wc, int fr, int fq) const {
        const int pn = u.col0 >> 8; const int lane = fr + 16 * fq;
        int mode = 0; const float* gp = ga; float scale = 1.f;
        if (KIND == 0) { if (pn < 2) { mode = 1; gp = ga; scale = 0.125f * 1.4426950408889634f; } else if (pn < 4) { mode = 1; gp = gb; } else if (pn < 6) mode = 0; else if (pn == 6) { mode = 2; gp = gc; } else { mode = 3; gp = gd; } }
        if (KIND == 1) { scale = 0.10206207261596575f * 1.4426950408889634f; if (pn < 2) { mode = 1; gp = ga; } else { mode = 4; gp = gb; } }
        if (KIND == 2) { if (pn < 2) { mode = 1; gp = ga; } else mode = 0; }
        float ss[2][4][2];
        if (mode != 0) {
#pragma unroll
            for (int ai = 0; ai < 2; ++ai)
#pragma unroll
                for (int m = 0; m < 4; ++m)
#pragma unroll
                    for (int bj = 0; bj < 2; ++bj) { const f32x4 a = acc[ai][bj][m][0], b = acc[ai][bj][m][1];
                        float s = (a[0] * a[0] + a[1] * a[1]) + (a[2] * a[2] + a[3] * a[3]) + (b[0] * b[0] + b[1] * b[1]) + (b[2] * b[2] + b[3] * b[3]);
                        s += shx<16>(s); ss[ai][m][bj] = xadd32(s); } }
        if (mode == 1 || mode == 2 || mode == 3) {
            if (fq == 0) {
#pragma unroll
                for (int ai = 0; ai < 2; ++ai)
#pragma unroll
                    for (int m = 0; m < 4; ++m)
#pragma unroll
                        for (int bj = 0; bj < 2; ++bj) S[(ai * HALF + wr * 64 + m * 16 + fr) * 8 + bj * 4 + wc] = ss[ai][m][bj]; }
            asm volatile("s_waitcnt lgkmcnt(0)" ::: "memory"); __builtin_amdgcn_s_barrier(); asm volatile("" ::: "memory");
#pragma unroll
            for (int ai = 0; ai < 2; ++ai)
#pragma unroll
                for (int m = 0; m < 4; ++m) { const LAS float* sr = S + (ai * HALF + wr * 64 + m * 16 + fr) * 8;
#pragma unroll
                    for (int bj = 0; bj < 2; ++bj) {
                        if (mode == 1) { const f32x2 t = *(const LAS f32x2*)(sr + bj * 4 + (wc & 2)); ss[ai][m][bj] = t[0] + t[1]; }
                        else if (mode == 2) { const f32x4 t0 = *(const LAS f32x4*)sr, t1 = *(const LAS f32x4*)(sr + 4); ss[ai][m][bj] = (t0[0] + t0[1]) + (t0[2] + t0[3]) + (t1[0] + t1[1]) + (t1[2] + t1[3]); }
                        else if (bj == 0) { const f32x4 t0 = *(const LAS f32x4*)sr; ss[ai][m][bj] = (t0[0] + t0[1]) + (t0[2] + t0[3]); } } }
        }
        const float inv_n = (mode == 1) ? (1.f / 64.f) : (mode == 2) ? (1.f / 256.f) : (1.f / 32.f);
        const bool rope_tile = (mode == 4) || (mode == 3);
#pragma unroll
        for (int bj = 0; bj < 2; ++bj) {
            f32x4 g0 = (f32x4){1.f, 1.f, 1.f, 1.f}, g1 = g0; bool rope = false, zero = false; float invn = inv_n;
            const int c8 = 8 * fq;
            if (mode == 1) { const int c = 32 * (wc & 1) + c8; g0 = *(const f32x4*)(gp + c); g1 = *(const f32x4*)(gp + c + 4); }
            else if (mode == 2) { const int c = bj * HALF + wc * 32 + c8; g0 = *(const f32x4*)(gp + c); g1 = *(const f32x4*)(gp + c + 4); }
            else if (mode == 3) { if (bj == 0) { const int c = wc * 32 + c8; g0 = *(const f32x4*)(gp + c); g1 = *(const f32x4*)(gp + c + 4); invn = 1.f / 128.f; }
                                  else if (wc == 0) { g0 = *(const f32x4*)(ge + c8); g1 = *(const f32x4*)(ge + c8 + 4); rope = true; } else zero = true; }
            else if (mode == 4) { g0 = *(const f32x4*)(gp + c8); g1 = *(const f32x4*)(gp + c8 + 4); rope = true; }
            (void)rope_tile;
#pragma unroll
            for (int ai = 0; ai < 2; ++ai)
#pragma unroll
                for (int m = 0; m < 4; ++m) { const int row = EPI_ROW(ai, m);
                    f32x4 v0 = acc[ai][bj][m][0], v1 = acc[ai][bj][m][1];
                    if (mode != 0) { const float rs = rsqrtf(ss[ai][m][bj] * invn + 1e-6f) * scale; v0 = v0 * rs * g0; v1 = v1 * rs * g1; }
                    if (rope) {
                        const float* cr = cs + (size_t)row * 32 + 8 * (fq & 1); const f32x4 c0 = *(const f32x4*)cr, c1 = *(const f32x4*)(cr + 4), s0 = *(const f32x4*)(cr + 16), s1 = *(const f32x4*)(cr + 20);
                        f32x4 o0, o1;
#pragma unroll
                        for (int j = 0; j < 4; ++j) { const auto r0 = __builtin_amdgcn_permlane32_swap(__float_as_uint(v0[j]), __float_as_uint(v0[j]), false, false), r1 = __builtin_amdgcn_permlane32_swap(__float_as_uint(v1[j]), __float_as_uint(v1[j]), false, false);
                            const float ot0 = __uint_as_float(lane < 32 ? r0[1] : r0[0]), ot1 = __uint_as_float(lane < 32 ? r1[1] : r1[0]);
                            o0[j] = (lane < 32) ? (v0[j] * c0[j] - ot0 * s0[j]) : (ot0 * s0[j] + v0[j] * c0[j]);
                            o1[j] = (lane < 32) ? (v1[j] * c1[j] - ot1 * s1[j]) : (ot1 * s1[j] + v1[j] * c1[j]); }
                        v0 = o0; v1 = o1; }
                    if (zero) { v0 = (f32x4){0.f, 0.f, 0.f, 0.f}; v1 = v0; }
                    u32x4 w; w.x = cvt_pk_bf16(v0[0], v0[1]); w.y = cvt_pk_bf16(v0[2], v0[3]); w.z = cvt_pk_bf16(v1[0], v1[1]); w.w = cvt_pk_bf16(v1[2], v1[3]);
                    *(u32x4*)(O + (size_t)row * ldc + EPI_COL(bj)) = w; } }
    }
};
struct EpiRecIn {
    bf16_t* O; const float* bias;
    __device__ __forceinline__ void operator()(const Acc& acc, const Unit& u, int wr, int wc, int fr, int fq) const {
        const bool act = u.col0 < 1024;
        f32x4 bv[2][2];
#pragma unroll
        for (int bj = 0; bj < 2; ++bj)
#pragma unroll
            for (int n = 0; n < 2; ++n) bv[bj][n] = *(const f32x4*)(bias + EPI_COL(bj) + 4 * n);
#pragma unroll
        for (int ai = 0; ai < 2; ++ai)
#pragma unroll
            for (int m = 0; m < 4; ++m) { bf16_t* rowp = O + (size_t)EPI_ROW(ai, m) * 2048;
#pragma unroll
                for (int bj = 0; bj < 2; ++bj) { f32x4 v0 = acc[ai][bj][m][0] + bv[bj][0], v1 = acc[ai][bj][m][1] + bv[bj][1];
                    if (act) {
#pragma unroll
                        for (int j = 0; j < 4; ++j) { v0[j] = fgelu_tanh(v0[j]); v1[j] = fgelu_tanh(v1[j]); } }
                    u32x4 w; w.x = cvt_pk_bf16(v0[0], v0[1]); w.y = cvt_pk_bf16(v0[2], v0[3]); w.z = cvt_pk_bf16(v1[0], v1[1]); w.w = cvt_pk_bf16(v1[2], v1[3]);
                    *(u32x4*)(rowp + EPI_COL(bj)) = w; } }
    }
};
__device__ __forceinline__ unsigned pk4_fp8(float a, float b, float c, float d) { int w = 0; w = __builtin_amdgcn_cvt_pk_fp8_f32(a, b, w, false); w = __builtin_amdgcn_cvt_pk_fp8_f32(c, d, w, true); return (unsigned)w; }
struct EpiSwiglu {
    unsigned char* ACT; const float* b1; float ascale;
    __device__ __forceinline__ float sw(float g, float l) const { g = fminf(g, 7.f); l = fminf(fmaxf(l, -7.f), 7.f); return g * fsigmoid(1.702f * g) * (l + 1.f); }
    __device__ __forceinline__ void operator()(const Acc& acc, const Unit& u, int wr, int wc, int fr, int fq) const {
        f32x4 bv[2][2];
#pragma unroll
        for (int bj = 0; bj < 2; ++bj)
#pragma unroll
            for (int n = 0; n < 2; ++n) bv[bj][n] = *(const f32x4*)(b1 + (size_t)u.e * 2048 + EPI_COL(bj) + 4 * n);
#pragma unroll
        for (int ai = 0; ai < 2; ++ai)
#pragma unroll
            for (int m = 0; m < 4; ++m) { unsigned char* rowp = ACT + (size_t)EPI_ROW(ai, m) * 1024;
#pragma unroll
                for (int bj = 0; bj < 2; ++bj) { const f32x4 v0 = acc[ai][bj][m][0] * ascale + bv[bj][0], v1 = acc[ai][bj][m][1] * ascale + bv[bj][1];
                    *(unsigned*)(rowp + (EPI_COL(bj) >> 1)) = pk4_fp8(sw(v0[0], v0[1]), sw(v0[2], v0[3]), sw(v1[0], v1[1]), sw(v1[2], v1[3])); } }
    }
};
struct EpiResid {
    bf16_t* X; const float* g; const float* bias;
    __device__ __forceinline__ void operator()(const Acc& acc, const Unit& u, int wr, int wc, int fr, int fq) const {
        const int b = u.row0 / cfg::S;
        f32x4 bv[2][2], gv[2][2];
#pragma unroll
        for (int bj = 0; bj < 2; ++bj)
#pragma unroll
            for (int n = 0; n < 2; ++n) { bv[bj][n] = bias ? *(const f32x4*)(bias + EPI_COL(bj) + 4 * n) : (f32x4){0.f, 0.f, 0.f, 0.f}; gv[bj][n] = *(const f32x4*)(g + b * 6144 + EPI_COL(bj) + 4 * n); }
#pragma unroll
        for (int ai = 0; ai < 2; ++ai)
#pragma unroll
            for (int m = 0; m < 4; ++m) { bf16_t* rowp = X + (size_t)EPI_ROW(ai, m) * 1024;
#pragma unroll
                for (int bj = 0; bj < 2; ++bj) { u32x4* p = (u32x4*)(rowp + EPI_COL(bj)); const u32x4 xw = *p;
                    const f32x4 x0 = (f32x4){bf_lo(xw.x), bf_hi(xw.x), bf_lo(xw.y), bf_hi(xw.y)} + gv[bj][0] * (acc[ai][bj][m][0] + bv[bj][0]);
                    const f32x4 x1 = (f32x4){bf_lo(xw.z), bf_hi(xw.z), bf_lo(xw.w), bf_hi(xw.w)} + gv[bj][1] * (acc[ai][bj][m][1] + bv[bj][1]);
                    u32x4 w; w.x = cvt_pk_bf16(x0[0], x0[1]); w.y = cvt_pk_bf16(x0[2], x0[3]); w.z = cvt_pk_bf16(x1[0], x1[1]); w.w = cvt_pk_bf16(x1[2], x1[3]); *p = w; }
                if (m & 1) asm volatile("" ::: "memory"); }
    }
};
struct EpiLru {
    const bf16_t* XC; const float* ba; const float* bx; const float* lam; bf16_t* LA; bf16_t* Bb;
    __device__ __forceinline__ void operator()(const Acc& acc, const Unit& u, int wr, int wc, int fr, int fq) const {
        const int ch0 = u.col0 + wc * 32 + 8 * fq;
#pragma unroll
        for (int n = 0; n < 2; ++n) { const int ch = ch0 + 4 * n;
            const f32x4 bav = *(const f32x4*)(ba + ch), bxv = *(const f32x4*)(bx + ch), spv = *(const f32x4*)(lam + ch);
#pragma unroll
            for (int ai = 0; ai < 2; ++ai)
#pragma unroll
                for (int m = 0; m < 4; ++m) { const size_t ro = (size_t)EPI_ROW(ai, m) * 1024 + ch;
                    const u32x2 xr = *(const u32x2*)(XC + ro);
                    const float xcv[4] = {bf_lo(xr.x), bf_hi(xr.x), bf_lo(xr.y), bf_hi(xr.y)};
                    float lav[4], bvv[4];
#pragma unroll
                    for (int j = 0; j < 4; ++j) { const float r = fsigmoid(acc[ai][0][m][n][j] + bav[j]), ig = fsigmoid(acc[ai][1][m][n][j] + bxv[j]);
                        const float la = r * spv[j], a = fexp2(la); lav[j] = la; bvv[j] = __builtin_amdgcn_sqrtf(fmaxf(1.f - a * a, 0.f)) * ig * xcv[j]; }
                    u32x2 wa, wb; wa.x = cvt_pk_bf16(lav[0], lav[1]); wa.y = cvt_pk_bf16(lav[2], lav[3]); wb.x = cvt_pk_bf16(bvv[0], bvv[1]); wb.y = cvt_pk_bf16(bvv[2], bvv[3]);
                    *(u32x2*)(LA + ro) = wa; *(u32x2*)(Bb + ro) = wb; asm volatile("" ::: "memory"); } }
    }
};

constexpr size_t MiB = (size_t)1 << 20;
constexpr size_t al4k(size_t x) { return (x + 4095) & ~(size_t)4095; }
constexpr int T_ = cfg::T, S_ = cfg::S, P_ = cfg::P;
constexpr size_t O_CTL = 0, SZ_CTL = 1 * MiB;
constexpr size_t O_MOD = O_CTL + SZ_CTL, SZ_MOD = al4k((size_t)4 * 4 * 6144 * 4);
constexpr size_t O_CS = O_MOD + SZ_MOD, SZ_CS = (size_t)T_ * 32 * 4;
constexpr size_t O_HIST = O_CS + SZ_CS, SZ_HIST = 256 * 32 * 4;
constexpr size_t O_TOPI = O_HIST + SZ_HIST, SZ_TOP = (size_t)T_ * 4 * 4;
constexpr size_t O_TOPG = O_TOPI + SZ_TOP, O_POS = O_TOPG + SZ_TOP;
constexpr size_t O_SUMP = O_POS + SZ_TOP, SZ_SUM = (size_t)4 * 64 * 1024 * 4;
constexpr size_t O_SUMH = O_SUMP + SZ_SUM;
constexpr size_t O_LSE = O_SUMH + SZ_SUM, SZ_LSE = (size_t)3 * T_ * 8 * 4;
constexpr size_t O_SPV = al4k(O_LSE + SZ_LSE), SZ_SPV = 2 * 1024 * 4;
constexpr size_t O_WIN = al4k(O_SPV + SZ_SPV), SZ_WIN = (size_t)2048 * 1024 * 2;
constexpr size_t O_WUQ = O_WIN + 2 * SZ_WIN, SZ_WUQ = (size_t)768 * 256 * 2;
constexpr size_t O_WUKV = O_WUQ + 2 * SZ_WUQ, SZ_WUKV = (size_t)1024 * 128 * 2;
constexpr size_t O_WOUT = O_WUKV + 2 * SZ_WUKV, SZ_WOUT = (size_t)1024 * 1024 * 2;
constexpr size_t O_RWIN = O_WOUT + 2 * SZ_WOUT, SZ_RWIN = (size_t)2048 * 1024 * 2;
constexpr size_t O_RGATE = O_RWIN + 2 * SZ_RWIN, SZ_RGATE = (size_t)8 * 256 * 128 * 2;
constexpr size_t O_RWOUT = O_RGATE + 2 * SZ_RGATE, SZ_RWOUT = (size_t)1024 * 1024 * 2;
constexpr size_t O_W1 = O_RWOUT + 2 * SZ_RWOUT, SZ_W1E = (size_t)2048 * 1024;
constexpr size_t O_W2 = O_W1 + 128 * SZ_W1E, SZ_W2E = (size_t)1024 * 1024;
constexpr size_t O_HN = O_W2 + 128 * SZ_W2E, SZ_HN = (size_t)T_ * 1024 * 2;
constexpr size_t O_PROJ = O_HN + SZ_HN, SZ_PROJ = (size_t)T_ * 2048 * 2;
constexpr size_t O_Q2 = O_PROJ + SZ_PROJ, SZ_Q2 = (size_t)T_ * 768 * 2;
constexpr size_t O_KV2 = O_Q2 + SZ_Q2, SZ_KV2 = (size_t)T_ * 1024 * 2;
constexpr size_t O_OA = O_KV2 + SZ_KV2, SZ_OA = (size_t)3 * T_ * 512 * 2;
constexpr size_t O_ATT = O_OA + SZ_OA, SZ_ATT = (size_t)T_ * 1024 * 2;
constexpr size_t O_XC = O_ATT + SZ_ATT, SZ_XC = (size_t)T_ * 1024 * 2;
constexpr size_t O_AA = O_XC + SZ_XC, SZ_AA = (size_t)T_ * 1024 * 4;
constexpr size_t O_BB = O_AA + SZ_AA;
constexpr size_t O_XG = O_BB + SZ_AA, SZ_XG = (size_t)P_ * 1024 * 2;
constexpr size_t O_ACT = O_XG + SZ_XG, O_Y2 = O_ACT + SZ_XG;
constexpr size_t O_X = O_Y2 + SZ_XG, SZ_X = (size_t)T_ * 1024 * 2;
constexpr size_t O_DUMMY = O_X + SZ_X, SZ_DUMMY = (size_t)96 * MiB;
constexpr size_t WS_MK_END = O_DUMMY + SZ_DUMMY;
constexpr size_t O_NAIVE = (size_t)2048 * MiB;
static_assert(WS_MK_END <= O_NAIVE, "mk workspace");
constexpr int CW_BAR = 4096;
constexpr int RING_BYTES = 131072, LDSX_OFF = RING_BYTES;
constexpr int LDS_BYTES = 147456;
constexpr int LX_TILE = LDSX_OFF + 64, LX_MISC = LDSX_OFF + 2048, LX_EXCH = LDSX_OFF + 6144;

struct Args { const void* in[34]; float* out; unsigned char* ws; int ph_lo, ph_hi; };
struct Ctx { int tid, lane, wave, G, bid, vcu, gw, NGW; LAS unsigned char* lds; unsigned char* ws; };

__device__ __forceinline__ void conv_load(f32x4 (&v)[16], const float* __restrict__ W, int N, int n0, int k0, int lane) {
    const int n = n0 + 4 * (lane & 15); const float* p = W + (size_t)(k0 + 16 * (lane >> 4)) * N + n;
#pragma unroll
    for (int i = 0; i < 16; ++i) v[i] = (n < N) ? __builtin_nontemporal_load((const f32x4*)(p + (size_t)i * N)) : (f32x4){0.f, 0.f, 0.f, 0.f};
}
__device__ __forceinline__ int conv_row(int c, int perm) { if (perm == 1) { const int h = c / 96, d = c % 96; return d < 64 ? 64 * h + d : 512 + 32 * h + d - 64; } if (perm == 2) { const int h = c >> 7, d = c & 127; return d < 64 ? 64 * h + d : 512 + 64 * h + d - 64; } return c; }
__device__ __forceinline__ void conv_emit(const f32x4 (&v)[16], LAS unsigned char* T  , bf16_t* __restrict__ WT, int ldd, int n0, int k0, int lane, int perm) {
    const int kq = lane >> 4, c4 = lane & 15;
#pragma unroll
    for (int jj = 0; jj < 4; ++jj) { u32x4 lo, hi;
        lo.x = cvt_pk_bf16(v[0][jj], v[1][jj]); lo.y = cvt_pk_bf16(v[2][jj], v[3][jj]); lo.z = cvt_pk_bf16(v[4][jj], v[5][jj]); lo.w = cvt_pk_bf16(v[6][jj], v[7][jj]);
        hi.x = cvt_pk_bf16(v[8][jj], v[9][jj]); hi.y = cvt_pk_bf16(v[10][jj], v[11][jj]); hi.z = cvt_pk_bf16(v[12][jj], v[13][jj]); hi.w = cvt_pk_bf16(v[14][jj], v[15][jj]);
        LAS unsigned char* q = T + (4 * c4 + jj) * 144 + 32 * kq; *(LAS u32x4*)q = lo; *(LAS u32x4*)(q + 16) = hi; }
    asm volatile("s_waitcnt lgkmcnt(0)" ::: "memory");
#pragma unroll
    for (int s8 = 0; s8 < 8; ++s8) { const int n = 8 * s8 + (lane >> 3), ch = lane & 7; const u32x4 w = *(const LAS u32x4*)(T + n * 144 + 16 * ch);
        *(u32x4*)(WT + (size_t)conv_row(n0 + n, perm) * ldd + k0 + 8 * ch) = w; }
    asm volatile("s_waitcnt lgkmcnt(0)" ::: "memory");
}
__device__ __forceinline__ void conv8_tile(const float* __restrict__ W, int N, unsigned char* __restrict__ WT, int ldd, int n0, int k0, LAS unsigned char* T  , int lane) {
    const int kq = lane >> 4, c4 = lane & 15; const float* p = W + (size_t)(k0 + 32 * kq) * N + n0 + 4 * c4;
    f32x4 v[32];
#pragma unroll
    for (int i = 0; i < 32; ++i) v[i] = __builtin_nontemporal_load((const f32x4*)(p + (size_t)i * N));
#pragma unroll
    for (int jj = 0; jj < 4; ++jj) { u32x4 lo, hi;
        lo.x = pk4_fp8(32.f * v[0][jj], 32.f * v[1][jj], 32.f * v[2][jj], 32.f * v[3][jj]);     lo.y = pk4_fp8(32.f * v[4][jj], 32.f * v[5][jj], 32.f * v[6][jj], 32.f * v[7][jj]);
        lo.z = pk4_fp8(32.f * v[8][jj], 32.f * v[9][jj], 32.f * v[10][jj], 32.f * v[11][jj]);   lo.w = pk4_fp8(32.f * v[12][jj], 32.f * v[13][jj], 32.f * v[14][jj], 32.f * v[15][jj]);
        hi.x = pk4_fp8(32.f * v[16][jj], 32.f * v[17][jj], 32.f * v[18][jj], 32.f * v[19][jj]); hi.y = pk4_fp8(32.f * v[20][jj], 32.f * v[21][jj], 32.f * v[22][jj], 32.f * v[23][jj]);
        hi.z = pk4_fp8(32.f * v[24][jj], 32.f * v[25][jj], 32.f * v[26][jj], 32.f * v[27][jj]); hi.w = pk4_fp8(32.f * v[28][jj], 32.f * v[29][jj], 32.f * v[30][jj], 32.f * v[31][jj]);
        LAS unsigned char* q = T + (4 * c4 + jj) * 144 + 32 * kq; *(LAS u32x4*)q = lo; *(LAS u32x4*)(q + 16) = hi; }
    asm volatile("s_waitcnt lgkmcnt(0)" ::: "memory");
#pragma unroll
    for (int s8 = 0; s8 < 8; ++s8) { const int n = 8 * s8 + (lane >> 3), ch = lane & 7; const u32x4 w = *(const LAS u32x4*)(T + n * 144 + 16 * ch);
        *(u32x4*)(WT + (size_t)(n0 + n) * ldd + k0 + 16 * ch) = w; }
    asm volatile("s_waitcnt lgkmcnt(0)" ::: "memory");
}
template <class AP> __device__ __forceinline__ void p0_prologue(const Ctx& C, AP a) {
    unsigned char* ws = C.ws;
    { const float* c = (const float*)a->in[1]; const float* ada_w = (const float*)a->in[3]; const float* ada_b = (const float*)a->in[4]; float* mod = (float*)(ws + O_MOD);
      LAS float* part = (LAS float*)C.lds;
      LAS float* cact = (LAS float*)(C.lds + 32768);
      if (C.bid < 4 * 24) { for (int i = C.tid; i < 4096; i += 512) { const int b = i >> 10, k = i & 1023; const float cv = c[i]; cact[k * 4 + b] = cv / (1.f + expf(-cv)); } __syncthreads(); }
      for (int it = C.bid; it < 4 * 24; it += C.G) { const int l = it / 24, n0 = (it % 24) * 256;
          f32x4 acc[4];
#pragma unroll
          for (int b = 0; b < 4; ++b) acc[b] = (f32x4){0.f, 0.f, 0.f, 0.f};
          const float* w = ada_w + (size_t)l * 1024 * 6144 + n0 + 4 * C.lane;
#pragma unroll 1
          for (int k0 = C.wave * 128; k0 < C.wave * 128 + 128; k0 += 16) { f32x4 wv[16];
#pragma unroll
              for (int i = 0; i < 16; ++i) wv[i] = __builtin_nontemporal_load((const f32x4*)(w + (size_t)(k0 + i) * 6144));
#pragma unroll
              for (int i = 0; i < 16; ++i) { const f32x4 sv = *(const LAS f32x4*)(cact + (k0 + i) * 4);
#pragma unroll
                  for (int b = 0; b < 4; ++b) acc[b] = acc[b] + sv[b] * wv[i]; } }
#pragma unroll
          for (int b = 0; b < 4; ++b) *(LAS f32x4*)(part + (C.wave * 4 + b) * 256 + 4 * C.lane) = acc[b];
          __syncthreads();
          for (int o = C.tid; o < 1024; o += 512) { const int b = o >> 8, n = o & 255; float sacc = ada_b[l * 6144 + n0 + n];
#pragma unroll
              for (int w8 = 0; w8 < 8; ++w8) sacc += part[(w8 * 4 + b) * 256 + n];
              mod[((size_t)l * 4 + b) * 6144 + n0 + n] = sacc; }
          __syncthreads(); } }
    { const int* positions = (const int*)a->in[2]; float* cs = (float*)(ws + O_CS);
      for (int i = C.bid * 512 + C.tid; i < T_ * 16; i += C.G * 512) { const int t = i >> 4, f = i & 15; const float inv = powf(10000.f, -(float)(2 * f) / 32.f); const float ang = (float)positions[t] * inv;
          cs[t * 32 + f] = cosf(ang); cs[t * 32 + 16 + f] = sinf(ang); } }
    { const float* lam = (const float*)a->in[25]; float* spv = (float*)(ws + O_SPV);
      for (int i = C.bid * 512 + C.tid; i < 2048; i += C.G * 512) spv[i] = -8.f * 1.4426950408889634f * log1pf(expf(-lam[i])); }
    { const int lane = C.lane; LAS unsigned char* T = C.lds + 49152 + C.wave * 9216;
      const float* attn_w_in = (const float*)a->in[7]; const float* w_uq = (const float*)a->in[12]; const float* w_ukv = (const float*)a->in[13]; const float* attn_w_out = (const float*)a->in[16];
      const float* rec_w_in = (const float*)a->in[17]; const float* rec_wa = (const float*)a->in[21]; const float* rec_wx = (const float*)a->in[23]; const float* rec_w_out = (const float*)a->in[26];
      const float* w1 = (const float*)a->in[30]; const float* w2 = (const float*)a->in[32];
      constexpr int T_WIN = 32 * 16, T_WUQ = 12 * 4, T_WUKV = 16 * 2, T_WOUT = 16 * 16, T_RWIN = 32 * 16, T_RG = 2 * 2, T_RWOUT = 16 * 16, T_W1 = 32 * 16, T_W2 = 16 * 16;
      constexpr int NITEMS = 2 * (T_WIN + T_WUQ + T_WUKV + T_WOUT + T_RWIN + 16 * T_RG + T_RWOUT);
      struct Job { const float* W; bf16_t* WT; int N, ldd, n0, k0, perm; };
      auto decode = [&](int r, Job& jb) {
#define CONV_JOB(SRC, KK, NN, DST, NROWS, NMAT, SRC_MS, DST_MS, PERM) { constexpr int kc_ = (KK) / 64, per_ = ((NROWS) / 64) * kc_, tot_ = per_ * (NMAT); \
          if (r < tot_) { const int mat_ = r / per_, q_ = r % per_; jb.W = (SRC) + (size_t)mat_ * (SRC_MS); jb.WT = (bf16_t*)(ws + (DST) + (size_t)mat_ * (DST_MS)); jb.N = (NN); jb.ldd = (KK); jb.n0 = (q_ / kc_) * 64; jb.k0 = (q_ % kc_) * 64; jb.perm = (PERM); return; } r -= tot_; }
          CONV_JOB(attn_w_in, 1024, 1952, O_WIN, 2048, 2, (size_t)1024 * 1952, SZ_WIN, 0)
          CONV_JOB(w_uq, 256, 768, O_WUQ, 768, 2, (size_t)256 * 768, SZ_WUQ, 1)
          CONV_JOB(w_ukv, 128, 1024, O_WUKV, 1024, 2, (size_t)128 * 1024, SZ_WUKV, 2)
          CONV_JOB(attn_w_out, 1024, 1024, O_WOUT, 1024, 2, (size_t)1024 * 1024, SZ_WOUT, 0)
          CONV_JOB(rec_w_in, 1024, 2048, O_RWIN, 2048, 2, (size_t)1024 * 2048, SZ_RWIN, 0)
          CONV_JOB(rec_wa, 128, 128, O_RGATE, 128, 16, (size_t)128 * 128, (size_t)256 * 128 * 2, 0)
          CONV_JOB(rec_wx, 128, 128, O_RGATE + (size_t)128 * 128 * 2, 128, 16, (size_t)128 * 128, (size_t)256 * 128 * 2, 0)
          CONV_JOB(rec_w_out, 1024, 1024, O_RWOUT, 1024, 2, (size_t)1024 * 1024, SZ_RWOUT, 0)
#undef CONV_JOB
          jb.W = attn_w_in; jb.WT = (bf16_t*)(ws + O_WIN); jb.N = 1952; jb.ldd = 1024; jb.n0 = 0; jb.k0 = 0; jb.perm = 0; };
      f32x4 va[16], vb[16]; Job ja, jn;
      int it = C.gw;
      if (it < NITEMS) { decode(it, ja); conv_load(va, ja.W, ja.N, ja.n0, ja.k0, lane); }
#pragma unroll 1
      for (; it < NITEMS; it += 2 * C.NGW) {
          const bool h1 = it + C.NGW < NITEMS;
          if (h1) { decode(it + C.NGW, jn); conv_load(vb, jn.W, jn.N, jn.n0, jn.k0, lane); }
          conv_emit(va, T, ja.WT, ja.ldd, ja.n0, ja.k0, lane, ja.perm);
          const bool h2 = it + 2 * C.NGW < NITEMS;
          if (h2) { decode(it + 2 * C.NGW, ja); conv_load(va, ja.W, ja.N, ja.n0, ja.k0, lane); }
          if (h1) conv_emit(vb, T, jn.WT, jn.ldd, jn.n0, jn.k0, lane, jn.perm);
      }
    }
}

__device__ __forceinline__ void phase_norm(const Ctx& C, const float* xin  , float* out  , bool combine, bool do_norm, const float* gain, const float* modc  , const float* modl  , int shoff, int scoff, bool dummy = false) {
    const bf16_t* Y2 = (const bf16_t*)(C.ws + O_Y2); const int* pos = (const int*)(C.ws + O_POS); const float* topg = (const float*)(C.ws + O_TOPG); bf16_t* HN = (bf16_t*)(C.ws + (dummy ? O_DUMMY : O_HN)); const bf16_t* X = (const bf16_t*)(C.ws + O_X); bf16_t* Xo = (bf16_t*)(C.ws + (dummy ? O_DUMMY + 32 * MiB : O_X));
    const int lane = C.lane;
    for (int t = C.gw; t < T_; t += C.NGW) { const int b = t / S_;
        f32x4 v[4];
        if (xin) {
#pragma unroll
            for (int j = 0; j < 4; ++j) v[j] = *(const f32x4*)(xin + (size_t)t * 1024 + 256 * j + 4 * lane); }
        else {
#pragma unroll
            for (int j = 0; j < 4; ++j) { const u32x2 w = *(const u32x2*)(X + (size_t)t * 1024 + 256 * j + 4 * lane); v[j] = (f32x4){bf_lo(w.x), bf_hi(w.x), bf_lo(w.y), bf_hi(w.y)}; } }
        if (combine) { f32x4 y[4];
#pragma unroll
            for (int j = 0; j < 4; ++j) y[j] = (f32x4){0.f, 0.f, 0.f, 0.f};
#pragma unroll
            for (int k = 0; k < 4; ++k) { const int p = pos[t * 4 + k]; const float gk = topg[t * 4 + k];
#pragma unroll
                for (int j = 0; j < 4; ++j) { const u32x2 w = *(const u32x2*)(Y2 + (size_t)p * 1024 + 256 * j + 4 * lane);
                    y[j][0] += gk * bf_lo(w.x); y[j][1] += gk * bf_hi(w.x); y[j][2] += gk * bf_lo(w.y); y[j][3] += gk * bf_hi(w.y); } }
#pragma unroll
            for (int j = 0; j < 4; ++j) { const f32x4 g2 = *(const f32x4*)(modc + b * 6144 + 5120 + 256 * j + 4 * lane); v[j] = v[j] + g2 * y[j]; } }
        if (out) {
#pragma unroll
            for (int j = 0; j < 4; ++j) *(f32x4*)(out + (size_t)t * 1024 + 256 * j + 4 * lane) = v[j]; }
        else {
#pragma unroll
            for (int j = 0; j < 4; ++j) { u32x2 w; w.x = cvt_pk_bf16(v[j][0], v[j][1]); w.y = cvt_pk_bf16(v[j][2], v[j][3]); *(u32x2*)(Xo + (size_t)t * 1024 + 256 * j + 4 * lane) = w; } }
        if (do_norm) { float ss = 0.f;
#pragma unroll
            for (int j = 0; j < 4; ++j) ss += (v[j][0] * v[j][0] + v[j][1] * v[j][1]) + (v[j][2] * v[j][2] + v[j][3] * v[j][3]);
            const float rs = rsqrtf(wsum(ss) * (1.f / 1024.f) + 1e-6f);
#pragma unroll
            for (int j = 0; j < 4; ++j) { const int col = 256 * j + 4 * lane; const f32x4 gn = *(const f32x4*)(gain + col), sc = *(const f32x4*)(modl + b * 6144 + scoff + col), sh = *(const f32x4*)(modl + b * 6144 + shoff + col);
                const f32x4 h = v[j] * rs * gn * (1.f + sc) + sh;
                u32x2 w; w.x = cvt_pk_bf16(h[0], h[1]); w.y = cvt_pk_bf16(h[2], h[3]); *(u32x2*)(HN + (size_t)t * 1024 + col) = w; } }
    }
}

__device__ __forceinline__ void unpack8(const u32x4 w, float (&f)[8]) { f[0] = bf_lo(w.x); f[1] = bf_hi(w.x); f[2] = bf_lo(w.y); f[3] = bf_hi(w.y); f[4] = bf_lo(w.z); f[5] = bf_hi(w.z); f[6] = bf_lo(w.w); f[7] = bf_hi(w.w); }
__device__ __forceinline__ u32x4 pack8(const float (&f)[8]) { u32x4 w; w.x = cvt_pk_bf16(f[0], f[1]); w.y = cvt_pk_bf16(f[2], f[3]); w.z = cvt_pk_bf16(f[4], f[5]); w.w = cvt_pk_bf16(f[6], f[7]); return w; }

constexpr float LOG2E = 1.4426950408889634f;
__device__ __forceinline__ void phase_postproj(const Ctx& C, const float* qg, const float* kg, const float* qag, const float* kvag, const float* mkg) {
    bf16_t* PROJ = (bf16_t*)(C.ws + O_PROJ); const float* cs = (const float*)(C.ws + O_CS); const int lane = C.lane;
    for (int t = C.gw; t < T_; t += C.NGW) { bf16_t* row = PROJ + (size_t)t * 2048;
#pragma unroll
        for (int ps = 0; ps < 2; ++ps) { bf16_t* p = row + ps * 512 + 8 * lane; float f[8]; unpack8(*(const u32x4*)p, f); float ss = 0.f;
#pragma unroll
            for (int i = 0; i < 8; ++i) ss += f[i] * f[i];
            ss += shx<1>(ss); ss += shx<2>(ss); ss += shx<4>(ss);
            const float rs = rsqrtf(ss * (1.f / 64.f) + 1e-6f) * (ps == 0 ? 0.125f * LOG2E : 1.f); const float* g = (ps == 0 ? qg : kg) + 8 * (lane & 7);
#pragma unroll
            for (int i = 0; i < 8; ++i) f[i] = f[i] * rs * g[i];
            *(u32x4*)p = pack8(f); }
        { bf16_t* p = row + 1536 + 8 * lane; float f[8]; unpack8(*(const u32x4*)p, f); float ss = 0.f;
#pragma unroll
            for (int i = 0; i < 8; ++i) ss += f[i] * f[i];
            ss += shx<1>(ss); ss += shx<2>(ss);
            { const float o4 = shx<4>(ss); if (lane < 48) ss += o4; } { const float o8 = shx<8>(ss); if (lane < 48) ss += o8; } { const float o16 = shx<16>(ss); if (lane < 32) ss += o16; }
            const float nrm = lane < 32 ? 256.f : (lane < 48 ? 128.f : 32.f);
            const float rs = rsqrtf(ss / nrm + 1e-6f);
            const float* g = lane < 32 ? (qag + 8 * lane) : (lane < 48 ? (kvag + 8 * (lane - 32)) : (mkg + 64 + 8 * ((lane - 48) & 3)));
#pragma unroll
            for (int i = 0; i < 8; ++i) f[i] = f[i] * rs * g[i];
            float o[8];
#pragma unroll
            for (int i = 0; i < 8; ++i) { const float other = shx<2>(f[i]); const int fi = ((lane & 1) << 3) + i; const float cv = cs[t * 32 + fi], sv = cs[t * 32 + 16 + fi];
                o[i] = (lane & 2) ? (other * sv + f[i] * cv) : (f[i] * cv - other * sv); }
            if (lane >= 48 && lane < 52) {
#pragma unroll
                for (int i = 0; i < 8; ++i) f[i] = o[i]; }
            if (lane < 52) *(u32x4*)p = pack8(f); }
    }
}
__device__ __forceinline__ void phase_postq(const Ctx& C, const float* mqg, const float* mkg) {
    bf16_t* Q2 = (bf16_t*)(C.ws + O_Q2); bf16_t* KV2 = (bf16_t*)(C.ws + O_KV2); const float* cs = (const float*)(C.ws + O_CS); const int lane = C.lane;
    const float qscale = 0.10206207261596575f * LOG2E;
    for (int t = C.gw; t < T_; t += C.NGW) {
        { bf16_t* p = Q2 + (size_t)t * 768 + (lane >> 3) * 96 + 8 * (lane & 7); float f[8]; unpack8(*(const u32x4*)p, f); float ss = 0.f;
#pragma unroll
            for (int i = 0; i < 8; ++i) ss += f[i] * f[i];
            ss += shx<1>(ss); ss += shx<2>(ss); ss += shx<4>(ss);
            const float rs = rsqrtf(ss * (1.f / 64.f) + 1e-6f) * qscale; const float* g = mqg + 8 * (lane & 7);
#pragma unroll
            for (int i = 0; i < 8; ++i) f[i] = f[i] * rs * g[i];
            *(u32x4*)p = pack8(f); }
        { const int l2 = lane & 31; bf16_t* p = Q2 + (size_t)t * 768 + (l2 >> 2) * 96 + 64 + 8 * (l2 & 3); float f[8]; unpack8(*(const u32x4*)p, f); float ss = 0.f;
#pragma unroll
            for (int i = 0; i < 8; ++i) ss += f[i] * f[i];
            ss += shx<1>(ss); ss += shx<2>(ss);
            const float rs = rsqrtf(ss * (1.f / 32.f) + 1e-6f) * qscale; const float* g = mqg + 64 + 8 * (l2 & 3);
#pragma unroll
            for (int i = 0; i < 8; ++i) f[i] = f[i] * rs * g[i];
            float o[8];
#pragma unroll
            for (int i = 0; i < 8; ++i) { const float other = shx<2>(f[i]); const int fi = ((lane & 1) << 3) + i; const float cv = cs[t * 32 + fi], sv = cs[t * 32 + 16 + fi];
                o[i] = (lane & 2) ? (other * sv + f[i] * cv) : (f[i] * cv - other * sv); }
            if (lane < 32) *(u32x4*)p = pack8(o); }
        { bf16_t* p = KV2 + (size_t)t * 1024 + (lane >> 3) * 128 + 8 * (lane & 7); float f[8]; unpack8(*(const u32x4*)p, f); float ss = 0.f;
#pragma unroll
            for (int i = 0; i < 8; ++i) ss += f[i] * f[i];
            ss += shx<1>(ss); ss += shx<2>(ss); ss += shx<4>(ss);
            const float rs = rsqrtf(ss * (1.f / 64.f) + 1e-6f); const float* g = mkg + 8 * (lane & 7);
#pragma unroll
            for (int i = 0; i < 8; ++i) f[i] = f[i] * rs * g[i];
            *(u32x4*)p = pack8(f); }
    }
}
__device__ __forceinline__ void phase_mixcombine(const Ctx& C) {
    const bf16_t* OA = (const bf16_t*)(C.ws + O_OA); const float* LSE = (const float*)(C.ws + O_LSE); bf16_t* ATT = (bf16_t*)(C.ws + O_ATT); const int lane = C.lane;
    for (int t = C.gw; t < T_; t += C.NGW) { const int h = lane >> 3;
        float ls[3], mx = -INFINITY;
#pragma unroll
        for (int p = 0; p < 3; ++p) { ls[p] = LSE[((size_t)p * T_ + t) * 8 + h]; mx = fmaxf(mx, ls[p]); }
        float w[3], den = 0.f;
#pragma unroll
        for (int p = 0; p < 3; ++p) { w[p] = fexp2(ls[p] - mx); den += w[p]; }
        const float inv = 1.f / den; float o[8];
#pragma unroll
        for (int i = 0; i < 8; ++i) o[i] = 0.f;
#pragma unroll
        for (int p = 0; p < 3; ++p) { float f[8]; unpack8(*(const u32x4*)(OA + ((size_t)p * T_ + t) * 512 + 8 * lane), f); const float wp = w[p] * inv;
#pragma unroll
            for (int i = 0; i < 8; ++i) o[i] += wp * f[i]; }
        *(u32x4*)(ATT + (size_t)t * 1024 + 8 * lane) = pack8(o); }
}
__device__ __forceinline__ void phase_rgate(const Ctx& C, int j, const float* cw, const float* cb, const float* ba, const float* bx) {
    const bf16_t* PROJ = (const bf16_t*)(C.ws + O_PROJ); const bf16_t* RG = (const bf16_t*)(C.ws + O_RGATE + (size_t)j * SZ_RGATE); const float* spvg = (const float*)(C.ws + O_SPV) + j * 1024;
    bf16_t* LA = (bf16_t*)(C.ws + O_AA); bf16_t* Bb = (bf16_t*)(C.ws + O_BB); float* SP = (float*)(C.ws + O_SUMP); float* SH = (float*)(C.ws + O_SUMH);
    constexpr int WROW = 272;
    LAS unsigned char* Wl = C.lds;
    LAS unsigned char* Xl = C.lds + 256 * WROW;
    LAS unsigned char* Al = Xl + 64 * WROW;
    LAS unsigned char* Bl = Al + 64 * WROW;
    const int tid = C.tid, lane = C.lane, w = C.wave;
    if (C.G % 8 != 0) return;
    const int n = C.bid & 7, g = C.bid >> 3, ng = C.G >> 3;
    for (int i = tid; i < 256 * 16; i += 512) { const int r = i >> 4, c = i & 15; *(LAS u32x4*)(Wl + r * WROW + 16 * c) = *(const u32x4*)(RG + ((size_t)n * 256 + r) * 128 + 8 * c); }
    const int crow = tid >> 3, cg = tid & 7, cch = n * 128 + 16 * cg;
    float cwv[4][16], cbv[16];
#pragma unroll
    for (int q = 0; q < 4; ++q) { const f32x4 b4 = *(const f32x4*)(cb + cch + 4 * q); cbv[4 * q] = b4[0]; cbv[4 * q + 1] = b4[1]; cbv[4 * q + 2] = b4[2]; cbv[4 * q + 3] = b4[3];
#pragma unroll
        for (int k = 0; k < 4; ++k) { const f32x4 w4 = *(const f32x4*)(cw + k * 1024 + cch + 4 * q); cwv[k][4 * q] = w4[0]; cwv[k][4 * q + 1] = w4[1]; cwv[k][4 * q + 2] = w4[2]; cwv[k][4 * q + 3] = w4[3]; } }
    const int mt = w & 3, h = w >> 2, l15 = lane & 15, kg = lane >> 4;
    float bav[4], bxv[4], spv[4];
#pragma unroll
    for (int jj = 0; jj < 4; ++jj) { const int ch = n * 128 + 16 * (4 * h + jj) + l15; bav[jj] = ba[ch]; bxv[jj] = bx[ch]; spv[jj] = spvg[ch]; }
    __syncthreads();
    for (int c = g; c < 256; c += ng) { const size_t row0 = (size_t)c * 64; const int ts0 = (int)(row0 % S_);
        { float acc[16];
#pragma unroll
          for (int i = 0; i < 16; ++i) acc[i] = cbv[i];
#pragma unroll
          for (int k = 0; k < 4; ++k) { const int dt = k - 3; if (ts0 + crow + dt >= 0) { const bf16_t* src = PROJ + (row0 + crow + dt) * 2048 + 1024 + cch; float f0[8], f1[8]; unpack8(*(const u32x4*)src, f0); unpack8(*(const u32x4*)(src + 8), f1);
#pragma unroll
                  for (int i = 0; i < 8; ++i) { acc[i] += cwv[k][i] * f0[i]; acc[8 + i] += cwv[k][8 + i] * f1[i]; } } }
          float lo[8], hi8[8];
#pragma unroll
          for (int i = 0; i < 8; ++i) { lo[i] = acc[i]; hi8[i] = acc[8 + i]; }
          *(LAS u32x4*)(Xl + crow * WROW + 32 * cg) = pack8(lo); *(LAS u32x4*)(Xl + crow * WROW + 32 * cg + 16) = pack8(hi8); }
        __syncthreads();
        f32x4 acc[8];
#pragma unroll
        for (int t = 0; t < 8; ++t) acc[t] = (f32x4){0.f, 0.f, 0.f, 0.f};
#pragma unroll
        for (int ks = 0; ks < 4; ++ks) { const bf16x8 af = *(const LAS bf16x8*)(Xl + (16 * mt + l15) * WROW + 64 * ks + 16 * kg);
#pragma unroll
            for (int t = 0; t < 8; ++t) { const int nt = (t < 4) ? (4 * h + t) : (8 + 4 * h + (t - 4)); const bf16x8 bfr = *(const LAS bf16x8*)(Wl + (16 * nt + l15) * WROW + 64 * ks + 16 * kg);
                acc[t] = __builtin_amdgcn_mfma_f32_16x16x32_bf16(af, bfr, acc[t], 0, 0, 0); } }
#pragma unroll
        for (int jj = 0; jj < 4; ++jj) { const int e = 16 * (4 * h + jj) + l15;
#pragma unroll
            for (int r = 0; r < 4; ++r) { const int row = 16 * mt + 4 * kg + r; const float xc = bf_lo((unsigned)*(const LAS unsigned short*)(Xl + row * WROW + 2 * e));
                const float rr = fsigmoid(acc[jj][r] + bav[jj]), ig = fsigmoid(acc[4 + jj][r] + bxv[jj]); const float la = rr * spv[jj], av = fexp2(la);
                const float bv = __builtin_amdgcn_sqrtf(fmaxf(1.f - av * av, 0.f)) * ig * xc;
                *(LAS unsigned short*)(Al + row * WROW + 2 * e) = (unsigned short)(cvt_pk_bf16(la, la) & 0xffffu); *(LAS unsigned short*)(Bl + row * WROW + 2 * e) = (unsigned short)(cvt_pk_bf16(bv, bv) & 0xffffu); } }
        __syncthreads();
        { const size_t go = (row0 + crow) * 1024 + cch;
          *(u32x4*)(LA + go) = *(const LAS u32x4*)(Al + crow * WROW + 32 * cg); *(u32x4*)(LA + go + 8) = *(const LAS u32x4*)(Al + crow * WROW + 32 * cg + 16);
          *(u32x4*)(Bb + go) = *(const LAS u32x4*)(Bl + crow * WROW + 32 * cg); *(u32x4*)(Bb + go + 8) = *(const LAS u32x4*)(Bl + crow * WROW + 32 * cg + 16); }
        if (tid < 128) { float Pl = 0.f, Hh = 0.f;
#pragma unroll 8
            for (int r = 0; r < 64; ++r) { const float la = bf_lo((unsigned)*(const LAS unsigned short*)(Al + r * WROW + 2 * tid)), bv = bf_lo((unsigned)*(const LAS unsigned short*)(Bl + r * WROW + 2 * tid)); Hh = fexp2(la) * Hh + bv; Pl += la; }
            const int b = (int)(row0 / S_), ck = (int)((row0 % S_) >> 6); SP[((size_t)b * 64 + ck) * 1024 + n * 128 + tid] = fexp2(Pl); SH[((size_t)b * 64 + ck) * 1024 + n * 128 + tid] = Hh; }
        __syncthreads();
    }
}

__device__ __forceinline__ void scan_sum_item(const Ctx& C, int b, int ck, int cg) {
    const bf16_t* LA = (const bf16_t*)(C.ws + O_AA); const bf16_t* Bb = (const bf16_t*)(C.ws + O_BB); float* SP = (float*)(C.ws + O_SUMP); float* SH = (float*)(C.ws + O_SUMH);
    const int ch = cg * 128 + 2 * C.lane;
    size_t off = ((size_t)b * S_ + ck * 64) * 1024 + ch; f32x2 Pl = (f32x2){0.f, 0.f}, Hh = (f32x2){0.f, 0.f};
#pragma unroll 8
    for (int s = 0; s < 64; ++s, off += 1024) { const unsigned lw = *(const unsigned*)(LA + off), bw = *(const unsigned*)(Bb + off);
        const f32x2 lv = (f32x2){bf_lo(lw), bf_hi(lw)}, av = (f32x2){fexp2(lv[0]), fexp2(lv[1])}, bv = (f32x2){bf_lo(bw), bf_hi(bw)}; Hh = av * Hh + bv; Pl = Pl + lv; }
    *(f32x2*)(SP + ((size_t)b * 64 + ck) * 1024 + ch) = (f32x2){fexp2(Pl[0]), fexp2(Pl[1])}; *(f32x2*)(SH + ((size_t)b * 64 + ck) * 1024 + ch) = Hh;
}
__device__ __forceinline__ void phase_scan_sum_own(const Ctx& C) {
    asm volatile("s_waitcnt vmcnt(0)" ::: "memory"); __syncthreads();
    for (int i = 0; ; ++i) { const int L = i * C.G + C.bid; if (L >= 512) break; const int pm = L >> 3, n = L & 7;
        if (C.wave < 4) { const int row0 = pm * 256 + C.wave * 64; scan_sum_item(C, row0 / S_, (row0 % S_) >> 6, n); } }
}
__device__ __forceinline__ void phase_scan_apply(const Ctx& C) {
    const bf16_t* LA = (const bf16_t*)(C.ws + O_AA); const bf16_t* Bb = (const bf16_t*)(C.ws + O_BB); const float* SP = (const float*)(C.ws + O_SUMP); const float* SH = (const float*)(C.ws + O_SUMH);
    const bf16_t* PROJ = (const bf16_t*)(C.ws + O_PROJ); bf16_t* ATT = (bf16_t*)(C.ws + O_ATT); const int lane = C.lane;
    for (int it = C.gw; it < 4 * 64 * 8; it += C.NGW) { const int cg = it & 7, ck = (it >> 3) & 63, b = it >> 9; const int ch = cg * 128 + 2 * lane;
        f32x2 h = (f32x2){0.f, 0.f};
#pragma unroll 8
        for (int c2 = 0; c2 < ck; ++c2) { const f32x2 pv = *(const f32x2*)(SP + ((size_t)b * 64 + c2) * 1024 + ch), hv = *(const f32x2*)(SH + ((size_t)b * 64 + c2) * 1024 + ch); h = pv * h + hv; }
        size_t row = (size_t)b * S_ + ck * 64;
#pragma unroll 8
        for (int s = 0; s < 64; ++s, ++row) { const unsigned lw = *(const unsigned*)(LA + row * 1024 + ch), bw = *(const unsigned*)(Bb + row * 1024 + ch);
            const f32x2 av = (f32x2){fexp2(bf_lo(lw)), fexp2(bf_hi(lw))}, bv = (f32x2){bf_lo(bw), bf_hi(bw)}; h = av * h + bv;
            const unsigned gw2 = *(const unsigned*)(PROJ + row * 2048 + ch);
            *(unsigned*)(ATT + row * 1024 + ch) = cvt_pk_bf16(bf_lo(gw2) * h[0], bf_hi(gw2) * h[1]); } }
}

__device__ __forceinline__ void split_bf16(const f32x4 a, const f32x4 b, bf16x8& hi, bf16x8& lo) {
    u32x4 h; h.x = cvt_pk_bf16(a[0], a[1]); h.y = cvt_pk_bf16(a[2], a[3]); h.z = cvt_pk_bf16(b[0], b[1]); h.w = cvt_pk_bf16(b[2], b[3]);
    u32x4 l; l.x = cvt_pk_bf16(a[0] - bf_lo(h.x), a[1] - bf_hi(h.x)); l.y = cvt_pk_bf16(a[2] - bf_lo(h.y), a[3] - bf_hi(h.y)); l.z = cvt_pk_bf16(b[0] - bf_lo(h.z), b[1] - bf_hi(h.z)); l.w = cvt_pk_bf16(b[2] - bf_lo(h.w), b[3] - bf_hi(h.w));
    hi = __builtin_bit_cast(bf16x8, h); lo = __builtin_bit_cast(bf16x8, l);
}
__device__ __forceinline__ void phase_router(const Ctx& C, const bf16_t* X, const float* gain, const float* modl, const float* wr, const float* br) {
    unsigned char* HN8 = C.ws + O_HN; int* topi = (int*)(C.ws + O_TOPI); float* topg = (float*)(C.ws + O_TOPG); int* hist = (int*)(C.ws + O_HIST);
    constexpr int HROW = 1028;
    LAS float* hrow = (LAS float*)C.lds;
    LAS float* part = (LAS float*)(C.lds + 16 * HROW * 4);
    LAS int* hl = (LAS int*)(C.lds + LX_MISC);
    const int lane = C.lane, e = lane & 31, kh = lane >> 5, v = C.wave, l15 = lane & 15, kg = lane >> 4;
    bf16x8 whi[2][4], wlo[2][4];
#pragma unroll
    for (int nt = 0; nt < 2; ++nt)
#pragma unroll
        for (int ks = 0; ks < 4; ++ks) { const float* p = wr + (size_t)(128 * v + 32 * ks + 8 * kg) * 32 + 16 * nt + l15;
            const f32x4 a = (f32x4){p[0], p[32], p[64], p[96]}, b = (f32x4){p[128], p[160], p[192], p[224]}; split_bf16(a, b, whi[nt][ks], wlo[nt][ks]); }
    const float bias_e = br[e];
    if (C.tid < 32) hl[C.tid] = 0;
    __syncthreads();
    for (int ck = C.bid; ck < 256; ck += C.G) {
        const int b = (ck * 64) / S_;
        f32x4 gn[4], shv[4];
#pragma unroll
        for (int j = 0; j < 4; ++j) { const int col = 256 * j + 4 * lane; gn[j] = *(const f32x4*)(gain + col) * (1.f + *(const f32x4*)(modl + b * 6144 + 4096 + col)); shv[j] = *(const f32x4*)(modl + b * 6144 + 3072 + col); }
        u32x2 xr[2][4];
#pragma unroll
        for (int q = 0; q < 2; ++q)
#pragma unroll
            for (int j = 0; j < 4; ++j) xr[q][j] = *(const u32x2*)(X + (size_t)(ck * 64 + 2 * v + q) * 1024 + 256 * j + 4 * lane);
#pragma unroll 1
        for (int pass = 0; pass < 4; ++pass) { const int tb = ck * 64 + pass * 16;
#pragma unroll
            for (int q = 0; q < 2; ++q) { const int tt = 2 * v + q, t = tb + tt; f32x4 h[4]; float ss = 0.f;
#pragma unroll
                for (int j = 0; j < 4; ++j) { const u32x2 xw = xr[q][j]; h[j] = (f32x4){bf_lo(xw.x), bf_hi(xw.x), bf_lo(xw.y), bf_hi(xw.y)}; ss += (h[j][0] * h[j][0] + h[j][1] * h[j][1]) + (h[j][2] * h[j][2] + h[j][3] * h[j][3]); }
                const float rs = rsqrtf(wsum(ss) * (1.f / 1024.f) + 1e-6f);
#pragma unroll
                for (int j = 0; j < 4; ++j) { const int col = 256 * j + 4 * lane;
                    const f32x4 hv = h[j] * rs * gn[j] + shv[j];
                    *(unsigned*)(HN8 + (size_t)t * 1024 + col) = pk4_fp8(hv[0], hv[1], hv[2], hv[3]);
                    *(LAS f32x4*)(hrow + tt * HROW + col) = hv; } }
            if (pass < 3) {
#pragma unroll
                for (int q = 0; q < 2; ++q)
#pragma unroll
                    for (int j = 0; j < 4; ++j) xr[q][j] = *(const u32x2*)(X + (size_t)(tb + 16 + 2 * v + q) * 1024 + 256 * j + 4 * lane); }
            __syncthreads();
            { f32x4 acc0 = (f32x4){0.f, 0.f, 0.f, 0.f}, acc1 = acc0;
#pragma unroll
              for (int ks = 0; ks < 4; ++ks) { const LAS float* hp = hrow + l15 * HROW + 128 * v + 32 * ks + 8 * kg; bf16x8 ahi, alo; split_bf16(*(const LAS f32x4*)hp, *(const LAS f32x4*)(hp + 4), ahi, alo);
                  acc0 = __builtin_amdgcn_mfma_f32_16x16x32_bf16(ahi, whi[0][ks], acc0, 0, 0, 0); acc1 = __builtin_amdgcn_mfma_f32_16x16x32_bf16(ahi, whi[1][ks], acc1, 0, 0, 0);
                  acc0 = __builtin_amdgcn_mfma_f32_16x16x32_bf16(ahi, wlo[0][ks], acc0, 0, 0, 0); acc1 = __builtin_amdgcn_mfma_f32_16x16x32_bf16(ahi, wlo[1][ks], acc1, 0, 0, 0);
                  acc0 = __builtin_amdgcn_mfma_f32_16x16x32_bf16(alo, whi[0][ks], acc0, 0, 0, 0); acc1 = __builtin_amdgcn_mfma_f32_16x16x32_bf16(alo, whi[1][ks], acc1, 0, 0, 0); }
#pragma unroll
              for (int r = 0; r < 4; ++r) { part[((4 * kg + r) * 8 + v) * 32 + l15] = acc0[r]; part[((4 * kg + r) * 8 + v) * 32 + 16 + l15] = acc1[r]; } }
            __syncthreads();
            { const int tt = 2 * v + kh; float lg = bias_e;
#pragma unroll
              for (int w8 = 0; w8 < 8; ++w8) lg += part[(tt * 8 + w8) * 32 + e];
              int idx[4]; float val[4];
#pragma unroll
              for (int k = 0; k < 4; ++k) { float mx = lg;
                  mx = fmaxf(mx, shx<1>(mx)); mx = fmaxf(mx, shx<2>(mx)); mx = fmaxf(mx, shx<4>(mx)); mx = fmaxf(mx, shx<8>(mx)); mx = fmaxf(mx, shx<16>(mx));
                  const unsigned long long bal = __ballot(lg == mx); const unsigned bh = (unsigned)(bal >> (32 * kh)); const int sel = __ffs((int)bh) - 1;
                  idx[k] = sel; val[k] = mx; if (e == sel) lg = -INFINITY; }
              if (e == 0) { const int t = tb + tt; float ex[4], den = 0.f;
#pragma unroll
                  for (int k = 0; k < 4; ++k) { ex[k] = expf(val[k] - val[0]); den += ex[k]; }
#pragma unroll
                  for (int k = 0; k < 4; ++k) { topi[t * 4 + k] = idx[k]; topg[t * 4 + k] = ex[k] / den; __hip_atomic_fetch_add(hl + idx[k], 1, __ATOMIC_RELAXED, __HIP_MEMORY_SCOPE_WORKGROUP); } } }
        }
        __syncthreads();
        if (C.tid < 32) { hist[ck * 32 + C.tid] = hl[C.tid]; hl[C.tid] = 0; }
        __syncthreads();
    }
}
__device__ __forceinline__ void moe_plan_lds(const Ctx& C) {
    const int* hist = (const int*)(C.ws + O_HIST);
    LAS int* tot = (LAS int*)(C.lds + LX_MISC + 256); LAS int* pst = tot + 32; LAS int* tile_e = (LAS int*)(C.lds + LX_TILE); LAS int* ntp = (LAS int*)(C.lds + LX_MISC + 128); LAS int* part = (LAS int*)(C.lds + LX_MISC + 1024);
    __syncthreads();
    { const int e = C.tid & 31, g = C.tid >> 5; int sacc = 0;
#pragma unroll
      for (int i = 0; i < 16; ++i) sacc += hist[(g * 16 + i) * 32 + e];
      part[g * 32 + e] = sacc; }
    __syncthreads();
    if (C.tid < 32) { int sacc = 0;
#pragma unroll
        for (int g = 0; g < 16; ++g) sacc += part[g * 32 + C.tid];
        tot[C.tid] = sacc; }
    __syncthreads();
    if (C.tid == 0) { int acc = 0, ti = 0; for (int e = 0; e < 32; ++e) { pst[e] = acc; const int nt = (tot[e] + 255) >> 8; for (int i = 0; i < nt; ++i) tile_e[ti++] = e; acc += nt << 8; } ntp[0] = ti; }
    __syncthreads();
}
__device__ __forceinline__ void phase_scatter(const Ctx& C) {
    const int* hist = (const int*)(C.ws + O_HIST); const int* topi = (const int*)(C.ws + O_TOPI); int* pos = (int*)(C.ws + O_POS);
    const unsigned char* HN8 = C.ws + O_HN; unsigned char* XG8 = C.ws + O_XG;
    moe_plan_lds(C);
    LAS int* pst = (LAS int*)(C.lds + LX_MISC + 384); LAS int* base = (LAS int*)(C.lds + LX_MISC + 512); LAS int* part = (LAS int*)(C.lds + LX_MISC + 1024); LAS int* pl = (LAS int*)C.lds;
    for (int ck = C.bid; ck < 256; ck += C.G) {
        if (C.tid < 32) { int sacc = pst[C.tid]; const int g = ck >> 4; for (int g2 = 0; g2 < g; ++g2) sacc += part[g2 * 32 + C.tid]; for (int c2 = g * 16; c2 < ck; ++c2) sacc += hist[c2 * 32 + C.tid]; base[C.tid] = sacc; }
        __syncthreads();
        if (C.wave == 0) { int cnt[32];
#pragma unroll
            for (int e = 0; e < 32; ++e) cnt[e] = 0;
#pragma unroll 1
            for (int g = 0; g < 4; ++g) { const int my = topi[ck * 256 + g * 64 + C.lane]; int rank = 0;
#pragma unroll
                for (int e = 0; e < 32; ++e) { const unsigned long long m = __ballot(my == e);
                    const int below = (int)__builtin_amdgcn_mbcnt_hi((unsigned)(m >> 32), __builtin_amdgcn_mbcnt_lo((unsigned)m, 0u));
                    if (my == e) rank = cnt[e] + below; cnt[e] += __popcll(m); }
                const int p = base[my] + rank; pl[g * 64 + C.lane] = p; pos[ck * 256 + g * 64 + C.lane] = p; } }
        __syncthreads();
#pragma unroll 8
        for (int i = 0; i < 32; ++i) { const int pr = C.wave + 8 * i; const int t = ck * 64 + (pr >> 2); const int p = pl[pr];
            *(u32x4*)(XG8 + (size_t)p * 1024 + 16 * C.lane) = *(const u32x4*)(HN8 + (size_t)t * 1024 + 16 * C.lane); }
        __syncthreads();
    }
}
#ifndef ATT_DUP
#define ATT_DUP 1
#endif

__device__ __forceinline__ s16x4 tr16(LAS const unsigned char* p) { typedef short v4i16_t __attribute__((ext_vector_type(4))); return __builtin_bit_cast(s16x4, __builtin_amdgcn_ds_read_tr16_b64_v4i16((LAS v4i16_t*)p)); }

__device__ __forceinline__ float max3f(float a, float b, float c) { return fmaxf(fmaxf(a, b), c); }
#ifndef ATT_THR_V
#define ATT_THR_V 10.f
#endif
constexpr float ATT_THR = ATT_THR_V;
template <int KS, bool DIL>
__device__ __forceinline__ void att_tile(LAS const unsigned char* kb, LAS const unsigned char* vb, const bf16x8 (&qf)[KS], f32x16& o0, f32x16& o1, f32x16& negm, float& mref, float& l, int kidx0, int qidx, bool need_mask, int lane) {
    constexpr int KROW = KS * 32 + 16, VROW = 144;
    const int i32 = lane & 31, hi = lane >> 5;
    const int pr = (i32 & 0x13) | ((i32 & 4) << 1) | ((i32 & 8) >> 1);
    f32x16 p0, p1;
    LAS const unsigned char* kp = kb + pr * KROW + hi * 16;
#ifndef QK_DUP
#define QK_DUP 1
#endif
#pragma unroll 1
    for (int qd_ = 0; qd_ < QK_DUP; ++qd_) {
#pragma unroll
    for (int ks = 0; ks < KS; ++ks) {
        const bf16x8 k0f = *(LAS const bf16x8*)(kp + ks * 32), k1f = *(LAS const bf16x8*)(kp + 32 * KROW + ks * 32);
        if (ks == 0) { p0 = __builtin_amdgcn_mfma_f32_32x32x16_bf16(k0f, qf[0], negm, 0, 0, 0); p1 = __builtin_amdgcn_mfma_f32_32x32x16_bf16(k1f, qf[0], negm, 0, 0, 0); }
        else { p0 = __builtin_amdgcn_mfma_f32_32x32x16_bf16(k0f, qf[ks], p0, 0, 0, 0); p1 = __builtin_amdgcn_mfma_f32_32x32x16_bf16(k1f, qf[ks], p1, 0, 0, 0); }
    }
    asm volatile("" : "+v"(p0), "+v"(p1));
    }
    if (need_mask) {
#pragma unroll
        for (int r = 0; r < 16; ++r) { const int d0 = qidx - (kidx0 + 16 * (r >> 3) + 8 * hi + (r & 7)), d1 = d0 - 32;
            const bool v0 = DIL ? (d0 >= 0 && d0 <= 128) : (d0 >= 0), v1 = DIL ? (d1 >= 0 && d1 <= 128) : (d1 >= 0);
            p0[r] = v0 ? p0[r] : -INFINITY; p1[r] = v1 ? p1[r] : -INFINITY; } }
    float mx = max3f(p0[0], p0[1], p1[0]), mb = max3f(p0[2], p0[3], p1[1]); mx = max3f(mx, p1[2], p1[3]);
#pragma unroll
    for (int r = 4; r < 16; r += 4) { mx = max3f(mx, p0[r], p0[r + 1]); mb = max3f(mb, p0[r + 2], p0[r + 3]); mx = max3f(mx, p1[r], p1[r + 1]); mb = max3f(mb, p1[r + 2], p1[r + 3]); }
    mx = xmax32(fmaxf(mx, mb));
    if (__builtin_expect(__any(mx > ATT_THR), 0)) {
        const float dl = fmaxf(mx, 0.f), f = fexp2(-dl);
        mref += dl; l *= f;
#pragma unroll
        for (int r = 0; r < 16; ++r) { o0[r] *= f; o1[r] *= f; p0[r] -= dl; p1[r] -= dl; negm[r] = -mref; } }
    float ls0 = 0.f, ls1 = 0.f;
#pragma unroll
    for (int r = 0; r < 16; ++r) { p0[r] = fexp2(p0[r]); p1[r] = fexp2(p1[r]); ls0 += p0[r]; ls1 += p1[r]; }
    l += ls0 + ls1;
    u32x4 pw[2][2];
#pragma unroll
    for (int s = 0; s < 2; ++s) {
        pw[0][s].x = cvt_pk_bf16(p0[8 * s + 0], p0[8 * s + 1]); pw[0][s].y = cvt_pk_bf16(p0[8 * s + 2], p0[8 * s + 3]); pw[0][s].z = cvt_pk_bf16(p0[8 * s + 4], p0[8 * s + 5]); pw[0][s].w = cvt_pk_bf16(p0[8 * s + 6], p0[8 * s + 7]);
        pw[1][s].x = cvt_pk_bf16(p1[8 * s + 0], p1[8 * s + 1]); pw[1][s].y = cvt_pk_bf16(p1[8 * s + 2], p1[8 * s + 3]); pw[1][s].z = cvt_pk_bf16(p1[8 * s + 4], p1[8 * s + 5]); pw[1][s].w = cvt_pk_bf16(p1[8 * s + 6], p1[8 * s + 7]); }
    const int g = lane >> 4, i16 = lane & 15;
    LAS const unsigned char* vp = vb + (8 * (g >> 1) + (i16 >> 2)) * VROW + (16 * (g & 1) + 4 * (i16 & 3)) * 2;
#pragma unroll
    for (int sub = 0; sub < 2; ++sub)
#pragma unroll
        for (int s = 0; s < 2; ++s) { const bf16x8 pf = __builtin_bit_cast(bf16x8, pw[sub][s]);
#pragma unroll
            for (int db = 0; db < 2; ++db) { LAS const unsigned char* av = vp + (32 * sub + 16 * s) * VROW + 64 * db;
                const s16x4 lo = tr16(av), hh = tr16(av + 4 * VROW);
                const bf16x8 vf = (bf16x8){lo[0], lo[1], lo[2], lo[3], hh[0], hh[1], hh[2], hh[3]};
                if (db == 0) o0 = __builtin_amdgcn_mfma_f32_32x32x16_bf16(vf, pf, o0, 0, 0, 0); else o1 = __builtin_amdgcn_mfma_f32_32x32x16_bf16(vf, pf, o1, 0, 0, 0); } }
}
__device__ __forceinline__ void att_store(bf16_t* orow  , const f32x16& o0, const f32x16& o1, float inv, int hi) {
#pragma unroll
    for (int rr = 0; rr < 4; ++rr) { u32x2 w0, w1;
        w0.x = cvt_pk_bf16(o0[4 * rr] * inv, o0[4 * rr + 1] * inv); w0.y = cvt_pk_bf16(o0[4 * rr + 2] * inv, o0[4 * rr + 3] * inv);
        w1.x = cvt_pk_bf16(o1[4 * rr] * inv, o1[4 * rr + 1] * inv); w1.y = cvt_pk_bf16(o1[4 * rr + 2] * inv, o1[4 * rr + 3] * inv);
        *(u32x2*)(orow + 8 * rr + 4 * hi) = w0; *(u32x2*)(orow + 32 + 8 * rr + 4 * hi) = w1; }
}


struct BgConv {
    const float* w1; const float* w2; unsigned char* ws; LAS unsigned char* T;
    int pair, it, nit, step, sub;
    bool pendA, pendB; int psubA, psubB; unsigned char* pWTA; unsigned char* pWTB;
    f32x4 vA[4], vB[4];
};
__device__ __forceinline__ void bg_tile(const BgConv& S, int it, const float*& W, int& N, unsigned char*& WT, int& n0, int& k0) {
    constexpr int I1 = 32 * 8, I2 = 16 * 8, N1 = 64 * I1;
    if (it < N1) { const int mat = S.pair * 64 + it / I1, q = it % I1; W = S.w1 + (size_t)mat * 1024 * 2048; WT = S.ws + O_W1 + (size_t)mat * SZ_W1E; N = 2048; n0 = (q >> 3) * 64; k0 = (q & 7) * 128; }
    else { const int r = it - N1, mat = S.pair * 64 + r / I2, q = r % I2; W = S.w2 + (size_t)mat * 1024 * 1024; WT = S.ws + O_W2 + (size_t)mat * SZ_W2E; N = 1024; n0 = (q >> 3) * 64; k0 = (q & 7) * 128; }
}
__device__ __forceinline__ void bg_init(BgConv& S, const Ctx& C, const float* w1, const float* w2, int pair) {
    S.w1 = w1; S.w2 = w2; S.ws = C.ws; S.T = C.lds + 49152 + C.wave * 9216; S.pair = pair; S.it = C.gw; S.nit = 64 * 256 + 64 * 128; S.step = C.NGW; S.sub = 0;
    S.pendA = false; S.pendB = false; S.psubA = 0; S.psubB = 0; S.pWTA = C.ws; S.pWTB = C.ws;
}
__device__ __forceinline__ bool bg_done(const BgConv& S) { return !S.pendA && !S.pendB && S.it >= S.nit; }
__device__ __forceinline__ void bg_half(BgConv& S, f32x4 (&v)[4], bool& pend, int& psub, unsigned char*& pWT, int lane) {
    const int kq = lane >> 4, c4 = lane & 15;
    if (pend) {
#pragma unroll
        for (int jj = 0; jj < 4; ++jj) *(LAS unsigned*)(S.T + (4 * c4 + jj) * 144 + 32 * kq + 4 * psub) = pk4_fp8(32.f * v[0][jj], 32.f * v[1][jj], 32.f * v[2][jj], 32.f * v[3][jj]);
        if (psub == 7) {
            asm volatile("s_waitcnt lgkmcnt(0)" ::: "memory");
#pragma unroll
            for (int s8 = 0; s8 < 8; ++s8) { const int n = 8 * s8 + (lane >> 3), ch = lane & 7; const u32x4 w = *(const LAS u32x4*)(S.T + n * 144 + 16 * ch);
                *(u32x4*)(pWT + (size_t)n * 1024 + 16 * ch) = w; }
            asm volatile("s_waitcnt lgkmcnt(0)" ::: "memory"); }
        pend = false; }
    if (S.it < S.nit) { const float* W; int N, n0, k0; unsigned char* WT; bg_tile(S, S.it, W, N, WT, n0, k0);
        const float* p = W + (size_t)(k0 + 32 * kq + 4 * S.sub) * N + n0 + 4 * c4;
#pragma unroll
        for (int i = 0; i < 4; ++i) v[i] = __builtin_nontemporal_load((const f32x4*)(p + (size_t)i * N));
        pend = true; psub = S.sub; pWT = WT + (size_t)n0 * 1024 + k0;
        if (++S.sub == 8) { S.sub = 0; S.it += S.step; } }
}
#define BG_STEP_A() bg_half(BG, BG.vA, BG.pendA, BG.psubA, BG.pWTA, lane)
#define BG_STEP_B() bg_half(BG, BG.vB, BG.pendB, BG.psubB, BG.pWTB, lane)

__device__ __forceinline__ void mla_unit(const Ctx& C, BgConv& BG, int b, int h, int qb) {
    constexpr int KROW = 208, VROW = 144, KB = 64 * KROW, BUF = KB + 64 * VROW;
    const bf16_t* Q2 = (const bf16_t*)(C.ws + O_Q2); const bf16_t* KV2 = (const bf16_t*)(C.ws + O_KV2); const bf16_t* PROJ = (const bf16_t*)(C.ws + O_PROJ); bf16_t* ATT = (bf16_t*)(C.ws + O_ATT);
    const int tid = C.tid, lane = C.lane, w = C.wave, i32 = lane & 31, hi = lane >> 5;
    const int q0 = qb * 256; const size_t rowb = (size_t)b * S_;
    bf16x8 qf[6];
    { const bf16_t* qrow = Q2 + (rowb + q0 + 32 * w + i32) * 768 + 8 * hi;
#pragma unroll
      for (int ks = 0; ks < 4; ++ks) qf[ks] = *(const bf16x8*)(qrow + h * 64 + 16 * ks);
      qf[4] = *(const bf16x8*)(qrow + 512 + h * 32); qf[5] = *(const bf16x8*)(qrow + 512 + h * 32 + 16); }
    f32x16 o0, o1;
#pragma unroll
    for (int r = 0; r < 16; ++r) { o0[r] = 0.f; o1[r] = 0.f; }
    float m = 0.f, l = 0.f; f32x16 negm;
#pragma unroll
    for (int r = 0; r < 16; ++r) negm[r] = 0.f;
    const int NT = 4 * qb + 4, wmax = 4 * qb + (w >> 1);
    const int r8 = tid >> 3, c8 = tid & 7, r4 = (tid & 255) >> 2, c4 = tid & 3;
    const bf16_t* knp = KV2 + (rowb + r8) * 1024 + h * 64 + 8 * c8; const bf16_t* kpp = PROJ + (rowb + r4) * 2048 + 1920 + 8 * c4;
    u32x4 kA, vA, pA, kB, vB, pB;
#define MLA_LOAD(j, K, V, P) do { const int jc_ = ((j) < NT) ? (j) : NT - 1; K = *(const u32x4*)(knp + (size_t)jc_ * 64 * 1024); V = *(const u32x4*)(knp + (size_t)jc_ * 64 * 1024 + 512); P = *(const u32x4*)(kpp + (size_t)jc_ * 64 * 2048); } while (0)
#define MLA_WRITE(bo, K, V, P) do { *(LAS u32x4*)(C.lds + (bo) + r8 * KROW + 16 * c8) = K; *(LAS u32x4*)(C.lds + (bo) + KB + r8 * VROW + 16 * c8) = V; *(LAS u32x4*)(C.lds + (bo) + r4 * KROW + 128 + 16 * c4) = P; } while (0)
#define MLA_STEP(j, KF, VF, PF, KN, VN, PN, BGS) do { const int j_ = (j); const int bo_ = (j_ & 1) * BUF; \
        MLA_LOAD(j_ + 2, KF, VF, PF); BGS(); \
        if (j_ <= wmax) { _Pragma("unroll 1") for (int dup_ = 0; dup_ < ATT_DUP; ++dup_) att_tile<6, false>(C.lds + bo_, C.lds + bo_ + KB, qf, o0, o1, negm, m, l, 64 * j_, q0 + 32 * w + i32, j_ == wmax, lane); } \
        MLA_WRITE(BUF - bo_, KN, VN, PN); \
        __syncthreads(); } while (0)
    MLA_LOAD(0, kA, vA, pA); MLA_LOAD(1, kB, vB, pB);
    MLA_WRITE(0, kA, vA, pA);
    __syncthreads();
#pragma unroll 1
    for (int j = 0; j < NT; j += 2) { MLA_STEP(j, kA, vA, pA, kB, vB, pB, BG_STEP_A); MLA_STEP(j + 1, kB, vB, pB, kA, vA, pA, BG_STEP_B); }
#undef MLA_STEP
#undef MLA_LOAD
#undef MLA_WRITE
    l = xadd32(l);
    att_store(ATT + (rowb + q0 + 32 * w + i32) * 1024 + 512 + h * 64, o0, o1, 1.f / l, hi);
}
__device__ __forceinline__ void dil_unit(const Ctx& C, BgConv& BG, int p, int dd, int b, int h, int res, int n) {
    constexpr int KROW = 144, VROW = 144, KB = 64 * KROW, BUF = KB + 64 * VROW;
    const bf16_t* PROJ = (const bf16_t*)(C.ws + O_PROJ); bf16_t* OA = (bf16_t*)(C.ws + O_OA) + (size_t)p * T_ * 512; float* LSE = (float*)(C.ws + O_LSE) + (size_t)p * T_ * 8;
    const int tid = C.tid, lane = C.lane, w = C.wave, i32 = lane & 31, hi = lane >> 5;
    const size_t rowb = (size_t)b * S_;
    const int qsub = 256 * n + 32 * w + i32; const size_t qtok = rowb + (size_t)qsub * dd + res;
    bf16x8 qf[4];
    { const bf16_t* qrow = PROJ + qtok * 2048 + h * 64 + 8 * hi;
#pragma unroll
      for (int ks = 0; ks < 4; ++ks) qf[ks] = *(const bf16x8*)(qrow + 16 * ks); }
    f32x16 o0, o1;
#pragma unroll
    for (int r = 0; r < 16; ++r) { o0[r] = 0.f; o1[r] = 0.f; }
    float m = 0.f, l = 0.f; f32x16 negm;
#pragma unroll
    for (int r = 0; r < 16; ++r) negm[r] = 0.f;
    const int jbeg = (n == 0) ? 2 : 0, wlo = w >> 1, whi = (32 * w + 159) >> 6;
    const int r8 = tid >> 3, c8 = tid & 7;
    u32x4 kA, vA, kB, vB;
    const int cnt = 6 - jbeg;
#define DIL_LOAD(i, K, V) do { const int jc_ = jbeg + (((i) < cnt) ? (i) : cnt - 1); const size_t tok = rowb + (size_t)(256 * n - 128 + 64 * jc_ + r8) * dd + res; const bf16_t* src = PROJ + tok * 2048 + 512 + h * 64 + 8 * c8; K = *(const u32x4*)src; V = *(const u32x4*)(src + 512); } while (0)
#define DIL_WRITE(bo, K, V) do { *(LAS u32x4*)(C.lds + (bo) + r8 * KROW + 16 * c8) = K; *(LAS u32x4*)(C.lds + (bo) + KB + r8 * VROW + 16 * c8) = V; } while (0)
#define DIL_STEP(i, KF, VF, KN, VN, BGS) do { const int i_ = (i); const int bo_ = (i_ & 1) * BUF, j_ = jbeg + i_; \
        DIL_LOAD(i_ + 2, KF, VF); BGS(); \
        if (i_ < cnt && j_ >= wlo && j_ <= whi) { const int kb0_ = 256 * n - 128 + 64 * j_, qlo_ = 256 * n + 32 * w; _Pragma("unroll 1") for (int dup_ = 0; dup_ < ATT_DUP; ++dup_) att_tile<4, true>(C.lds + bo_, C.lds + bo_ + KB, qf, o0, o1, negm, m, l, kb0_, qsub, !(kb0_ + 63 <= qlo_ && qlo_ + 31 - kb0_ <= 128), lane); } \
        DIL_WRITE(BUF - bo_, KN, VN); \
        __syncthreads(); } while (0)
    DIL_LOAD(0, kA, vA); DIL_LOAD(1, kB, vB);
    DIL_WRITE(0, kA, vA);
    __syncthreads();
    DIL_STEP(0, kA, vA, kB, vB, BG_STEP_A); DIL_STEP(1, kB, vB, kA, vA, BG_STEP_B); DIL_STEP(2, kA, vA, kB, vB, BG_STEP_A); DIL_STEP(3, kB, vB, kA, vA, BG_STEP_B);
    if (cnt == 6) { DIL_STEP(4, kA, vA, kB, vB, BG_STEP_A); DIL_STEP(5, kB, vB, kA, vA, BG_STEP_B); }
#undef DIL_STEP
#undef DIL_LOAD
#undef DIL_WRITE
    l = xadd32(l);
    att_store(OA + qtok * 512 + h * 64, o0, o1, 1.f / l, hi);
    if (hi == 0) LSE[qtok * 8 + h] = m + log2f(l);
}
#ifndef REP_MLA
#define REP_MLA 1
#endif
#ifndef REP_DIL
#define REP_DIL 1
#endif
__device__ __forceinline__ void phase_attention(const Ctx& C, const float* w1, const float* w2, int pair) {
    BgConv BG; bg_init(BG, C, w1, w2, pair);
#pragma unroll 1
    for (int rep = 0; rep < REP_MLA; ++rep) {
    if (C.G == 256) { const int bh = C.vcu >> 3, s = C.vcu & 7; mla_unit(C, BG, bh >> 3, bh & 7, s); mla_unit(C, BG, bh >> 3, bh & 7, 15 - s); }
    else for (int u = C.bid; u < 512; u += C.G) mla_unit(C, BG, u >> 7, (u >> 4) & 7, u & 15);
    }
#pragma unroll 1
    for (int rep = 0; rep < REP_DIL; ++rep)
    for (int u = C.bid; u < 1536; u += C.G) { const int p = u >> 9, rem = u & 511, b = rem >> 7, h = (rem >> 4) & 7, blk = rem & 15;
        const int dd = (p == 0) ? 1 : (p == 1) ? 4 : 16, bpr = 16 / dd;
        dil_unit(C, BG, p, dd, b, h, blk / bpr, blk % bpr); }
    { const int lane = C.lane;
#pragma unroll 1
      while (!bg_done(BG)) { BG_STEP_A(); BG_STEP_B(); } }
}
#undef BG_STEP_A
#undef BG_STEP_B

#ifdef TIME_NORM
constexpr int N_PHASES = 42;
#else
constexpr int N_PHASES = 40;
#endif
extern __shared__ __attribute__((aligned(16))) unsigned char lds_raw[];
typedef const __attribute__((address_space(4))) Args* ArgsP;
#define PHFN static __device__ __forceinline__ void
__device__ __forceinline__ ArgsP fresh_args() { unsigned long long p = (unsigned long long)__builtin_amdgcn_kernarg_segment_ptr(); asm volatile("" : "+s"(p)); return (ArgsP)p; }
__device__ __forceinline__ Ctx make_ctx(ArgsP ap, int wv) {
    Ctx C; C.lds = (LAS unsigned char*)lds_raw; C.ws = ap->ws;
    unsigned ones = ~0u; asm volatile("" : "+s"(ones)); const int lane = (int)__builtin_amdgcn_mbcnt_hi(ones, __builtin_amdgcn_mbcnt_lo(ones, 0u));
    int bid = blockIdx.x; asm volatile("" : "+s"(bid)); int G = gridDim.x; asm volatile("" : "+s"(G));
    C.wave = wv; C.lane = lane; C.tid = wv * 64 + lane;
    C.G = G; C.bid = bid; C.vcu = (C.G % 8 == 0) ? (C.bid % 8) * (C.G / 8) + C.bid / 8 : C.bid;
    C.gw = C.bid * 8 + C.wave; C.NGW = C.G * 8; return C;
}
#define IN(i) ((const float*)ap->in[i])
#define MODL(l) ((const float*)(C.ws + O_MOD) + (size_t)(l) * 4 * 6144)
PHFN ph_prologue(int wv) { const ArgsP ap = fresh_args(); const Ctx C = make_ctx(ap, wv); p0_prologue(C, ap); }
PHFN ph_norm(int wv, int l, int mode) { const ArgsP ap = fresh_args(); const Ctx C = make_ctx(ap, wv);
    if (mode == 0) phase_norm(C, IN(0), nullptr, false, true, IN(5), MODL(0), MODL(0), 0, 1024);
    else if (mode == 1) phase_norm(C, nullptr, nullptr, true, true, IN(5) + l * 1024, MODL(l - 1), MODL(l), 0, 1024);
    else if (mode == 3) phase_norm(C, nullptr, nullptr, true, true, IN(5) + l * 1024, MODL(l - 1), MODL(l), 0, 1024, true);
    else phase_norm(C, nullptr, ap->out, true, false, IN(5), MODL(3), MODL(3), 0, 1024); }
PHFN ph_proj(int wv, int j) { const ArgsP ap = fresh_args(); const Ctx C = make_ctx(ap, wv); unsigned char* ws = C.ws;
    DenseOrder S; S.init(ws + O_HN, ws + O_WIN + j * SZ_WIN, 1024, 1024, T_, 2048, C.G, C.bid); EpiNorm<0> E{(bf16_t*)(ws + O_PROJ), 2048, IN(8) + j * 64, IN(9) + j * 64, IN(10) + j * 256, IN(11) + j * 128, IN(15) + j * 96 + 64, (const float*)(ws + O_CS), (LAS float*)(C.lds + LX_EXCH)}; gemm_phase(C, GemmDims{1024, 1024, 1024}, S, E); }
PHFN ph_postproj(int wv, int j) { const ArgsP ap = fresh_args(); const Ctx C = make_ctx(ap, wv); phase_postproj(C, IN(8) + j * 64, IN(9) + j * 64, IN(10) + j * 256, IN(11) + j * 128, IN(15) + j * 96); }
PHFN ph_qkv(int wv, int j) { const ArgsP ap = fresh_args(); const Ctx C = make_ctx(ap, wv); unsigned char* ws = C.ws;
    { DenseOrder S; S.init(ws + O_PROJ + 1536 * 2, ws + O_WUQ + j * SZ_WUQ, 2048, 256, T_, 768, C.G, C.bid); EpiNorm<1> E{(bf16_t*)(ws + O_Q2), 768, IN(14) + j * 96, IN(14) + j * 96 + 64, nullptr, nullptr, nullptr, (const float*)(ws + O_CS), (LAS float*)(C.lds + LX_EXCH)}; gemm_phase(C, GemmDims{256, 2048, 256}, S, E); }
    { const ArgsP ap2 = fresh_args(); const Ctx C = make_ctx(ap2, wv); unsigned char* ws = C.ws; DenseOrder S; S.init(ws + O_PROJ + 1792 * 2, ws + O_WUKV + j * SZ_WUKV, 2048, 128, T_, 1024, C.G, C.bid); EpiNorm<2> E{(bf16_t*)(ws + O_KV2), 1024, IN(15) + j * 96, nullptr, nullptr, nullptr, nullptr, (const float*)(ws + O_CS), (LAS float*)(C.lds + LX_EXCH)}; gemm_phase(C, GemmDims{128, 2048, 128}, S, E); } }
PHFN ph_postq(int wv, int j) { const ArgsP ap = fresh_args(); const Ctx C = make_ctx(ap, wv); phase_postq(C, IN(14) + j * 96, IN(15) + j * 96); }
PHFN ph_attention(int wv, int pair) { const ArgsP ap = fresh_args(); const Ctx C = make_ctx(ap, wv); phase_attention(C, IN(30), IN(32), pair); }
PHFN ph_mixcombine(int wv) { const ArgsP ap = fresh_args(); const Ctx C = make_ctx(ap, wv); phase_mixcombine(C); }
PHFN ph_outproj(int wv, int l, int which) { const ArgsP ap = fresh_args(); const Ctx C = make_ctx(ap, wv); unsigned char* ws = C.ws; const int j = l >> 1;
    DenseOrder S; S.init(ws + O_ATT, ws + (which ? O_RWOUT + j * SZ_RWOUT : O_WOUT + j * SZ_WOUT), 1024, 1024, T_, 1024, C.G, C.bid);
    EpiResid E{(bf16_t*)(ws + O_X), MODL(l) + 2048, which ? IN(27) + j * 1024 : nullptr}; gemm_phase(C, GemmDims{1024, 1024, 1024}, S, E); }
PHFN ph_router(int wv, int l) { const ArgsP ap = fresh_args(); const Ctx C = make_ctx(ap, wv); phase_router(C, (const bf16_t*)(C.ws + O_X), IN(6) + l * 1024, MODL(l), IN(28) + (size_t)l * 1024 * 32, IN(29) + l * 32); }
PHFN ph_scatter(int wv) { const ArgsP ap = fresh_args(); const Ctx C = make_ctx(ap, wv); phase_scatter(C); }
PHFN ph_moe1(int wv, int l) { const ArgsP ap = fresh_args(); const Ctx C = make_ctx(ap, wv); unsigned char* ws = C.ws; moe_plan_lds(C);
    MoeOrder S; S.A = (const char*)(ws + O_XG); S.WT = (const char*)(ws + O_W1 + (size_t)l * 32 * SZ_W1E); S.estride = SZ_W1E; S.tile_e = (const LAS int*)(C.lds + LX_TILE);
    S.NT = *(const LAS int*)(C.lds + LX_MISC + 128); S.nN = 8; S.G = C.G; S.c = C.bid; S.esz = 1;
    EpiSwiglu E{(unsigned char*)(ws + O_ACT), IN(31) + (size_t)l * 32 * 2048, 1.f / 32.f}; gemm_phase<true>(C, GemmDims{1024, 1024, 1024}, S, E); }
PHFN ph_moe2(int wv, int l) { const ArgsP ap = fresh_args(); const Ctx C = make_ctx(ap, wv); unsigned char* ws = C.ws; moe_plan_lds(C);
    MoeOrder S; S.A = (const char*)(ws + O_ACT); S.WT = (const char*)(ws + O_W2 + (size_t)l * 32 * SZ_W2E); S.estride = SZ_W2E; S.tile_e = (const LAS int*)(C.lds + LX_TILE);
    S.NT = *(const LAS int*)(C.lds + LX_MISC + 128); S.nN = 4; S.G = C.G; S.c = C.bid; S.esz = 1;
    EpiBf16 E{(bf16_t*)(ws + O_Y2), IN(33) + (size_t)l * 32 * 1024, 1024, 1024, 1.f / 32.f}; gemm_phase<true>(C, GemmDims{1024, 1024, 1024}, S, E); }
PHFN ph_recin(int wv, int j) { const ArgsP ap = fresh_args(); const Ctx C = make_ctx(ap, wv); unsigned char* ws = C.ws;
    DenseOrder S; S.init(ws + O_HN, ws + O_RWIN + j * SZ_RWIN, 1024, 1024, T_, 2048, C.G, C.bid); EpiRecIn E{(bf16_t*)(ws + O_PROJ), IN(18) + j * 2048}; gemm_phase(C, GemmDims{1024, 1024, 1024}, S, E); }
PHFN ph_rgate(int wv, int j) { const ArgsP ap = fresh_args(); const Ctx C = make_ctx(ap, wv); phase_rgate(C, j, IN(19) + j * 4096, IN(20) + j * 1024, IN(22) + j * 1024, IN(24) + j * 1024); }
PHFN ph_scan_apply(int wv) { const ArgsP ap = fresh_args(); const Ctx C = make_ctx(ap, wv); phase_scan_apply(C); }

#if MODE == 1
__device__ __forceinline__ int fresh_tid(int wv) { unsigned ones = ~0u; asm volatile("" : "+s"(ones)); return wv * 64 + (int)__builtin_amdgcn_mbcnt_hi(ones, __builtin_amdgcn_mbcnt_lo(ones, 0u)); }
__device__ __forceinline__ void grid_barrier(int wv) { const ArgsP q = fresh_args(); XcdBarrier b; b.bar = (unsigned*)(q->ws + O_CTL) + CW_BAR; b.x = xb_xcc_id(); b.st = (volatile LAS unsigned*)((LAS unsigned char*)lds_raw + LDSX_OFF); xcd_barrier(b, fresh_tid(wv)); }
__global__ void __launch_bounds__(512, 2) mk_fwd(Args a) {
    int wv = __builtin_amdgcn_readfirstlane(threadIdx.x >> 6); asm volatile("" : "+s"(wv));
    { LAS unsigned char* lds = (LAS unsigned char*)lds_raw;
      for (int u = threadIdx.x; u < (LDS_BYTES - LDSX_OFF) / 4; u += 512) ((LAS unsigned*)(lds + LDSX_OFF))[u] = 0u;
      __syncthreads();
      if (a.ph_hi - a.ph_lo > 1) (void)xcd_barrier_post((unsigned*)(a.ws + O_CTL) + CW_BAR, (volatile LAS unsigned*)(lds + LDSX_OFF), (int)threadIdx.x); }
    int pid = 0;
#define PHASE(call) { const ArgsP q_ = fresh_args(); const int lo_ = q_->ph_lo, hi_ = q_->ph_hi; if (pid >= lo_ && pid < hi_) { call; if (pid + 1 < hi_) grid_barrier(wv); } ++pid; }
#define PHASE_R(call, REP) { const ArgsP q_ = fresh_args(); const int lo_ = q_->ph_lo, hi_ = q_->ph_hi; if (pid >= lo_ && pid < hi_) { if ((REP) > 1) { call; grid_barrier(wv); } call; if (pid + 1 < hi_) grid_barrier(wv); } ++pid; }
#ifndef REP_PROLOGUE
#define REP_PROLOGUE 1
#endif
#ifndef REP_MOE
#define REP_MOE 1
#endif
#ifndef REP_ATTN
#define REP_ATTN 1
#endif
#ifndef REP_GEMMS
#define REP_GEMMS 1
#endif
#ifdef TIME_NORM
#define NORM_EXTRA(l) PHASE(ph_norm(wv, l, 3))
#else
#define NORM_EXTRA(l)
#endif
#ifndef REP_ELEM
#define REP_ELEM 1
#endif
#ifndef REP_ROUTER
#define REP_ROUTER REP_ELEM
#endif
#ifndef REP_SCATTER
#define REP_SCATTER REP_ELEM
#endif
#ifndef REP_MIX
#define REP_MIX REP_ELEM
#endif
#ifndef REP_CONV
#define REP_CONV REP_ELEM
#endif
#ifndef REP_SCANA
#define REP_SCANA REP_ELEM
#endif
#define MOE_PHASES(l) PHASE_R(ph_router(wv, l), REP_ROUTER) PHASE_R(ph_scatter(wv), REP_SCATTER) PHASE_R(ph_moe1(wv, l), REP_MOE) PHASE_R(ph_moe2(wv, l), REP_MOE)
    PHASE_R(ph_prologue(wv), REP_PROLOGUE)
#define LAYER_PAIR(lp) \
        { const int l = 2 * (lp);         \
          PHASE(ph_norm(wv, l, (lp) == 0 ? 0 : 1)) PHASE_R(ph_proj(wv, lp), REP_GEMMS) PHASE_R(ph_qkv(wv, lp), REP_GEMMS) PHASE_R(ph_attention(wv, lp), REP_ATTN) PHASE_R(ph_mixcombine(wv), REP_MIX) PHASE(ph_outproj(wv, l, 0)) \
          MOE_PHASES(l) } \
        { const int l = 2 * (lp) + 1;     \
          NORM_EXTRA(l) PHASE(ph_norm(wv, l, 1)) PHASE_R(ph_recin(wv, lp), REP_GEMMS) PHASE_R(ph_rgate(wv, lp), REP_CONV) PHASE_R(ph_scan_apply(wv), REP_SCANA) PHASE(ph_outproj(wv, l, 1)) \
          MOE_PHASES(l) }
    LAYER_PAIR(0)
    LAYER_PAIR(1)
#undef LAYER_PAIR
#ifdef EXTRA_BARRIERS
    { const ArgsP q_ = fresh_args(); if (q_->ph_hi - q_->ph_lo > 1) { _Pragma("unroll 1") for (int xb = 0; xb < EXTRA_BARRIERS; ++xb) grid_barrier(wv); } }
#endif
    PHASE(ph_norm(wv, 3, 2))
#undef PHASE
#undef PHASE_R
#undef MOE_PHASES
}
#else
template <int PH> __global__ void __launch_bounds__(512, 2) k_phase(Args a, int l, int x) {
    int wv = __builtin_amdgcn_readfirstlane(threadIdx.x >> 6); asm volatile("" : "+s"(wv));
    LAS unsigned char* lds = (LAS unsigned char*)lds_raw;
    for (int u = threadIdx.x; u < (LDS_BYTES - LDSX_OFF) / 4; u += 512) ((LAS unsigned*)(lds + LDSX_OFF))[u] = 0u;
    __syncthreads();
    if constexpr (PH == 0) ph_prologue(wv);
    if constexpr (PH == 1) ph_norm(wv, l, x);
    if constexpr (PH == 2) ph_proj(wv, l);
    if constexpr (PH == 4) ph_qkv(wv, l);
    if constexpr (PH == 6) ph_attention(wv, l);
    if constexpr (PH == 7) ph_mixcombine(wv);
    if constexpr (PH == 8) ph_outproj(wv, l, x);
    if constexpr (PH == 9) ph_router(wv, l);
    if constexpr (PH == 10) ph_scatter(wv);
    if constexpr (PH == 11) ph_moe1(wv, l);
    if constexpr (PH == 12) ph_moe2(wv, l);
    if constexpr (PH == 13) ph_recin(wv, l);
    if constexpr (PH == 14) ph_rgate(wv, l);
    if constexpr (PH == 17) ph_scan_apply(wv);
}
#endif
#undef IN
#undef MODL
}

#ifndef MODE
#define MODE 2
#endif
extern "C" void kernel_launch(void* const* d_in, const int* in_sizes, int n_in, void* d_out, int out_size, void* d_ws, size_t ws_size, hipStream_t stream) {
    (void)in_sizes; (void)n_in; (void)out_size; (void)ws_size;
#if MODE == 0
    nv::forward(d_in, (float*)d_out, d_ws, stream);
#else
    static int grid = 0;
    if (grid == 0) {
        int dev = 0, cus = 0;
        (void)hipGetDevice(&dev); (void)hipDeviceGetAttribute(&cus, hipDeviceAttributeMultiprocessorCount, dev);
#if MODE == 1
        (void)hipFuncSetAttribute((const void*)mk::mk_fwd, hipFuncAttributeMaxDynamicSharedMemorySize, mk::LDS_BYTES);
#else
#define SA(PH) (void)hipFuncSetAttribute((const void*)mk::k_phase<PH>, hipFuncAttributeMaxDynamicSharedMemorySize, mk::LDS_BYTES)
        SA(0); SA(1); SA(2); SA(4); SA(6); SA(7); SA(8); SA(9); SA(10); SA(11); SA(12); SA(13); SA(14); SA(17);
#undef SA
#endif
        grid = cus > 0 ? cus : 256;
    }
    (void)hipMemsetAsync((char*)d_ws + mk::O_CTL, 0, mk::SZ_CTL, stream);
    mk::Args a;
    memset(&a, 0, sizeof(a));
    for (int i = 0; i < 34; ++i) a.in[i] = d_in[i];
    a.out = (float*)d_out; a.ws = (unsigned char*)d_ws;
#if MODE == 1
    a.ph_lo = 0; a.ph_hi = mk::N_PHASES;
    hipLaunchKernelGGL(mk::mk_fwd, dim3(grid), dim3(512), mk::LDS_BYTES, stream, a);
#else
#define LP(PH, l, x) hipLaunchKernelGGL(mk::k_phase<PH>, dim3(grid), dim3(512), mk::LDS_BYTES, stream, a, l, x)
    LP(0, 0, 0);
    for (int lp = 0; lp < 2; ++lp) {
        { const int l = 2 * lp; LP(1, l, lp == 0 ? 0 : 1); LP(2, lp, 0); LP(4, lp, 0); LP(6, lp, 0); LP(7, 0, 0); LP(8, l, 0); LP(9, l, 0); LP(10, 0, 0); LP(11, l, 0); LP(12, l, 0); }
        { const int l = 2 * lp + 1; LP(1, l, 1); LP(13, lp, 0); LP(14, lp, 0); LP(17, 0, 0); LP(8, l, 1); LP(9, l, 0); LP(10, 0, 0); LP(11, l, 0); LP(12, l, 0); }
    }
    LP(1, 3, 2);
#undef LP
#endif
#endif
}
```

```cpp
#define MODE 1

#include <string.h>
#include <hip/hip_runtime.h>
#include <stdint.h>
#include <math.h>

namespace cfg {
constexpr int D = 1024, NB = 4, S = 4096, T = NB * S, DEPTH = 4;
constexpr int MIXIN = 1952;
constexpr int NE = 32, TOPK = 4;
constexpr int MPAIR = T * TOPK;
constexpr int NBLK = MPAIR / 256 + NE;
constexpr int P = NBLK * 256;
}
using namespace cfg;


namespace mk {
#define LAS __attribute__((address_space(3)))
#define GAS __attribute__((address_space(1)))
typedef unsigned short bf16_t;
typedef short bf16x8 __attribute__((ext_vector_type(8)));
typedef short s16x4 __attribute__((ext_vector_type(4)));
typedef float f32x2 __attribute__((ext_vector_type(2)));
typedef float f32x4 __attribute__((ext_vector_type(4)));
typedef float f32x16 __attribute__((ext_vector_type(16)));
typedef unsigned u32x2 __attribute__((ext_vector_type(2)));
typedef unsigned u32x4 __attribute__((ext_vector_type(4)));
typedef GAS unsigned gu32;
#define RLX_AGENT __ATOMIC_RELAXED, __HIP_MEMORY_SCOPE_AGENT

__device__ __forceinline__ unsigned cvt_pk_bf16(float lo, float hi) { unsigned r; asm volatile("v_cvt_pk_bf16_f32 %0, %1, %2" : "=v"(r) : "v"(lo), "v"(hi)); return r; }
__device__ __forceinline__ float bf_lo(unsigned u) { return __uint_as_float(u << 16); }
__device__ __forceinline__ float bf_hi(unsigned u) { return __uint_as_float(u & 0xffff0000u); }
template <int O> __device__ __forceinline__ float shx(float v) { static_assert(O >= 1 && O < 32, "shx"); return __int_as_float(__builtin_amdgcn_ds_swizzle(__float_as_int(v), (O << 10) | 0x1f)); }
__device__ __forceinline__ float xadd32(float v) { const auto r = __builtin_amdgcn_permlane32_swap(__float_as_uint(v), __float_as_uint(v), false, false); return __uint_as_float(r[0]) + __uint_as_float(r[1]); }
__device__ __forceinline__ float xmax32(float v) { const auto r = __builtin_amdgcn_permlane32_swap(__float_as_uint(v), __float_as_uint(v), false, false); return fmaxf(__uint_as_float(r[0]), __uint_as_float(r[1])); }
__device__ __forceinline__ float wsum(float v) { v += shx<1>(v); v += shx<2>(v); v += shx<4>(v); v += shx<8>(v); v += shx<16>(v); return xadd32(v); }
__device__ __forceinline__ float fexp2(float x) { return __builtin_amdgcn_exp2f(x); }
__device__ __forceinline__ float frcp(float x) { return __builtin_amdgcn_rcpf(x); }
__device__ __forceinline__ float fsigmoid(float z) { return frcp(1.f + fexp2(-1.4426950408889634f * z)); }
__device__ __forceinline__ float fgelu_tanh(float x) { const float u = 0.7978845608028654f * (x + 0.044715f * x * x * x); return x * frcp(1.f + fexp2(-2.8853900817779268f * u)); }

#define XB_TMO      128
#define XB_XCNT(j)  (256  + 64 * (j))
#define XB_XSUB(j)  (1280 + 64 * (j))
#define XB_XGEN(j)  (2304 + 64 * (j))
#define XB_TOP      3328
#define XB_TOPGEN   3392
#define XCD_BAR_WORDS 3456
#define XB_SPIN_CAP (1u << 18)
__device__ __forceinline__ unsigned xb_ld(unsigned* p)              { return __hip_atomic_load(p, __ATOMIC_RELAXED, __HIP_MEMORY_SCOPE_AGENT); }
__device__ __forceinline__ unsigned xb_add(unsigned* p, unsigned v) { return __hip_atomic_fetch_add(p, v, __ATOMIC_RELAXED, __HIP_MEMORY_SCOPE_AGENT); }
__device__ __forceinline__ unsigned xb_xcc_id() { return (unsigned)__builtin_amdgcn_s_getreg((3 << 11) | 20) & 0xFu; }
#define XB_SPIN(cond, bar) do { unsigned _sp = 0; while (cond) { __builtin_amdgcn_s_sleep(1); \
    if ((++_sp & 255u) == 0u) { if (xb_ld(&(bar)[XB_TMO])) break; if (_sp > XB_SPIN_CAP) { atomicAdd(&(bar)[XB_TMO], 1u); break; } } } } while (0)
struct XcdBarrier { unsigned* bar; unsigned x; volatile LAS unsigned* st; };
__device__ __forceinline__ XcdBarrier xcd_barrier_post(unsigned* bar, volatile LAS unsigned* st, int tid) {
    XcdBarrier b; b.bar = bar; b.x = xb_xcc_id(); b.st = st;
    if (tid == 0) (void)xb_add(&bar[XB_XCNT(b.x)], 1u);
    return b;
}
__device__ __forceinline__ void xcd_barrier_complete(unsigned* bar, unsigned x, unsigned& nloc, unsigned& nx) {
    const unsigned G = gridDim.x * gridDim.y * gridDim.z;
    unsigned sum, cnt, mine, sp = 0u;
    for (;;) {
        sum = 0u; cnt = 0u; mine = 0u;
#pragma unroll
        for (unsigned j = 0; j < 16; ++j) { const unsigned c = xb_ld(&bar[XB_XCNT(j)]); sum += c; cnt += (c > 0u) ? 1u : 0u; mine = (j == x) ? c : mine; }
        if (sum == G) break;
        __builtin_amdgcn_s_sleep(1);
        if ((++sp & 255u) == 0u) { if (xb_ld(&bar[XB_TMO])) break; if (sp > XB_SPIN_CAP) { atomicAdd(&bar[XB_TMO], 1u); break; } }
    }
    nloc = mine > 0u ? mine : 1u; nx = cnt > 0u ? cnt : 1u;
}
__device__ __forceinline__ void xcd_barrier(const XcdBarrier& b, int tid) {
    asm volatile("s_waitcnt vmcnt(0)" ::: "memory");
    __syncthreads();
    if (tid == 0) {
        unsigned* bar = b.bar;
        __builtin_amdgcn_s_waitcnt(0);
        unsigned nloc = b.st[0], nx = b.st[1];
        if (nloc == 0u) { xcd_barrier_complete(bar, b.x, nloc, nx); b.st[0] = nloc; b.st[1] = nx; }
        const unsigned old = xb_add(&bar[XB_XSUB(b.x)], 1u);
        const unsigned gen = old / nloc;
        if (old + 1u == (gen + 1u) * nloc) {
            __builtin_amdgcn_fence(__ATOMIC_RELEASE, "agent");
            asm volatile("s_waitcnt vmcnt(0)" ::: "memory");
            const unsigned og = xb_add(&bar[XB_TOP], 1u);
            const unsigned tg = og / nx;
            if (og + 1u == (tg + 1u) * nx) xb_add(&bar[XB_TOPGEN], 1u);
            else XB_SPIN(xb_ld(&bar[XB_TOPGEN]) == tg, bar);
            __builtin_amdgcn_fence(__ATOMIC_ACQUIRE, "agent");
            xb_add(&bar[XB_XGEN(b.x)], 1u);
            asm volatile("s_waitcnt vmcnt(0)" ::: "memory");
        } else {
            XB_SPIN(xb_ld(&bar[XB_XGEN(b.x)]) == gen, bar);
            __builtin_amdgcn_fence(__ATOMIC_ACQUIRE, "agent");
            asm volatile("s_waitcnt vmcnt(0)" ::: "memory");
        }
    }
    __syncthreads();
}

constexpr int BM = 256, BK = 64, HALF = 128, HTB = HALF * BK * 2, STAGE_BYTES = 8 * HTB;
__host__ __device__ __forceinline__ int lds_byte(int r, int c) { const int st = (r >> 4) * 2 + (c >> 5), rr = r & 15, cc = c & 31, ob = rr * 64 + cc * 2; return st * 1024 + (ob ^ (((ob >> 9) & 1) << 5)); }
__host__ __device__ __forceinline__ void stage_rc(int b, int& R, int& C) { const int st = b / 1024, sb = b % 1024, swz = sb ^ (((sb >> 9) & 1) << 5); R = (st >> 1) * 16 + swz / 64; C = (st & 1) * 32 + (swz % 64) / 2; }
__host__ __device__ __forceinline__ int perm32(int rho) { const int n = rho >> 4, i = rho & 15; return 8 * (i >> 2) + 4 * n + (i & 3); }

struct Unit { const char* a; const char* b; int row0, col0, e, pad; };
struct GemmDims { int K, lda, ldb; };
typedef f32x4 Acc[2][2][4][2];
__device__ __forceinline__ void zero_acc(Acc& acc) {
#pragma unroll
    for (int a = 0; a < 2; ++a)
#pragma unroll
        for (int b = 0; b < 2; ++b)
#pragma unroll
            for (int m = 0; m < 4; ++m)
#pragma unroll
                for (int n = 0; n < 2; ++n)
#pragma unroll
                    for (int j = 0; j < 4; ++j) { float z; asm volatile("v_mov_b32 %0, 0" : "=v"(z)); acc[a][b][m][n][j] = z; }
}

typedef int v8i32 __attribute__((ext_vector_type(8)));
template <bool F8 = false, class CtxT, class Epi, class Sched>
__device__ __forceinline__ void gemm_phase(const CtxT& C, const GemmDims g, const Sched& S, const Epi& E) {
    LAS unsigned char* lds = C.lds;
    const int tid = C.tid, wid = __builtin_amdgcn_readfirstlane(tid >> 6), lane = tid & 63, wr = wid >> 2, wc = wid & 3, fr = lane & 15, fq = lane >> 4;
    constexpr int ESZ = F8 ? 1 : 2;
    int nt = g.K / (F8 ? 128 : BK); asm volatile("" : "+s"(nt));
    unsigned voffA[2], voffB[2];
#pragma unroll
    for (int i = 0; i < 2; ++i) { int R, C; stage_rc(tid * 16 + i * 8192, R, C); const int Rb = (R & ~31) + perm32(R & 31);
        voffA[i] = (unsigned)(R * g.lda * ESZ + C * 2); voffB[i] = (unsigned)(Rb * g.ldb * ESZ + C * 2); }
    const size_t kstep = (size_t)(BK * 2);
    const size_t hstepA = (size_t)HALF * g.lda * ESZ, hstepB = (size_t)HALF * g.ldb * ESZ;
    const unsigned ldsw = (unsigned)wid * 1024u;
    const unsigned ldsu = (unsigned)__builtin_amdgcn_readfirstlane((int)(unsigned)(unsigned long long)(lds));
    const int aoff = lds_byte(wr * 64 + fr, fq * 8), boff = lds_byte(wc * 32 + fr, fq * 8);
#define PG8_SA(b, h) (((b) * 2 + (h)) * HTB)
#define PG8_SB(b, h) ((4 + (b) * 2 + (h)) * HTB)
#define PG8_STAGE(bufoff, gbase, voff) do { _Pragma("unroll") for (int _i = 0; _i < 2; ++_i) { \
        asm volatile("s_mov_b32 m0, %2\n\ts_nop 3\n\tglobal_load_lds_dwordx4 %0, %1" :: "v"((voff)[_i]), "s"((const char*)(gbase)), "s"(ldsu + (unsigned)(bufoff) + ldsw + (unsigned)(_i * 8192)) : "memory"); } } while (0)
#define PG8_LDA(dst, b, h) do { _Pragma("unroll") for (int m = 0; m < 4; ++m) _Pragma("unroll") for (int k = 0; k < 2; ++k) dst[m][k] = *(const LAS bf16x8*)(lds + PG8_SA(b, h) + aoff + m * 2048 + k * 1024); } while (0)
#define PG8_LDB(dst, b, h) do { _Pragma("unroll") for (int n = 0; n < 2; ++n) _Pragma("unroll") for (int k = 0; k < 2; ++k) dst[n][k] = *(const LAS bf16x8*)(lds + PG8_SB(b, h) + boff + n * 2048 + k * 1024); } while (0)
#define PG8_CAT(x) __builtin_bit_cast(v8i32, (x))
#define PG8_MMA(ai, bj, At, Bt) do { __builtin_amdgcn_s_setprio(1); \
        if constexpr (F8) { _Pragma("unroll") for (int m = 0; m < 4; ++m) _Pragma("unroll") for (int n = 0; n < 2; ++n) \
            acc[ai][bj][m][n] = __builtin_amdgcn_mfma_scale_f32_16x16x128_f8f6f4(PG8_CAT(Bt[n]), PG8_CAT(At[m]), acc[ai][bj][m][n], 0, 0, 0, 0, 0, 0); } \
        else { _Pragma("unroll") for (int m = 0; m < 4; ++m) _Pragma("unroll") for (int n = 0; n < 2; ++n) _Pragma("unroll") for (int k = 0; k < 2; ++k) \
            acc[ai][bj][m][n] = __builtin_amdgcn_mfma_f32_16x16x32_bf16(Bt[n][k], At[m][k], acc[ai][bj][m][n], 0, 0, 0); } \
        __builtin_amdgcn_s_setprio(0); } while (0)
#define PG8_WAIT_V(n) asm volatile("s_waitcnt vmcnt(" #n ")" ::: "memory")
#define PG8_WAIT_L(n) asm volatile("s_waitcnt lgkmcnt(" #n ")" ::: "memory")
#define PG8_BAR __builtin_amdgcn_s_barrier()
#define PG8_SCHED __builtin_amdgcn_sched_barrier(0)
    Unit cur, nxt; int ui = 0;
    if (!S.next(0, cur)) return;
    Acc acc; zero_acc(acc);
    struct Frag2 { bf16x8 p[2]; __device__ __forceinline__ bf16x8& operator[](int k) { return p[k]; } __device__ __forceinline__ const bf16x8& operator[](int k) const { return p[k]; } };
    Frag2 At[4], B0[2], B1[2];
    const char* cA = cur.a; const char* cB = cur.b;
    PG8_STAGE(PG8_SB(0, 0), cB, voffB); PG8_STAGE(PG8_SB(0, 1), cB + hstepB, voffB); PG8_STAGE(PG8_SA(0, 0), cA, voffA); PG8_STAGE(PG8_SA(0, 1), cA + hstepA, voffA);
    if (wr == 1) PG8_BAR;
    PG8_WAIT_V(2); PG8_BAR;
    PG8_STAGE(PG8_SB(1, 0), cB + kstep, voffB); PG8_STAGE(PG8_SA(1, 0), cA + kstep, voffA); PG8_STAGE(PG8_SB(1, 1), cB + hstepB + kstep, voffB);
    PG8_WAIT_V(6); PG8_BAR;
    for (;;) {
        const bool has_next = S.next(ui + 1, nxt);
        const char* nA = has_next ? nxt.a : cA; const char* nB = has_next ? nxt.b : cB;
        for (int t = 0; t < nt; t += 2) {
            const bool last = (t == nt - 2);
            const char* a1 = cA + (size_t)(t + 1) * kstep;
            const char* a2 = last ? nA : cA + (size_t)(t + 2) * kstep; const char* b2 = last ? nB : cB + (size_t)(t + 2) * kstep;
            const char* a3 = a2 + kstep; const char* b3 = b2 + kstep;
            PG8_LDB(B0, 0, 0); PG8_LDB(B1, 0, 1); PG8_SCHED; PG8_LDA(At, 0, 0); PG8_STAGE(PG8_SA(1, 1), a1 + hstepA, voffA);
            PG8_WAIT_V(8); PG8_WAIT_L(0); PG8_BAR; PG8_MMA(0, 0, At, B0); PG8_MMA(0, 1, At, B1); PG8_BAR; PG8_SCHED;
            PG8_LDA(At, 0, 1); PG8_STAGE(PG8_SB(0, 0), b2, voffB); PG8_STAGE(PG8_SB(0, 1), b2 + hstepB, voffB); PG8_STAGE(PG8_SA(0, 0), a2, voffA);
            PG8_WAIT_V(8); PG8_WAIT_L(0); PG8_BAR; PG8_MMA(1, 0, At, B0); PG8_MMA(1, 1, At, B1); PG8_BAR; PG8_SCHED;
            PG8_LDB(B0, 1, 0); PG8_LDB(B1, 1, 1); PG8_SCHED; PG8_LDA(At, 1, 0); PG8_STAGE(PG8_SA(0, 1), a2 + hstepA, voffA);
            PG8_WAIT_V(8); PG8_WAIT_L(0); PG8_BAR; PG8_MMA(0, 0, At, B0); PG8_MMA(0, 1, At, B1); PG8_BAR; PG8_SCHED;
            PG8_LDA(At, 1, 1); PG8_STAGE(PG8_SB(1, 0), b3, voffB); PG8_STAGE(PG8_SB(1, 1), b3 + hstepB, voffB); PG8_STAGE(PG8_SA(1, 0), a3, voffA);
            PG8_WAIT_V(8); PG8_WAIT_L(0); PG8_BAR; PG8_MMA(1, 0, At, B0); PG8_MMA(1, 1, At, B1); PG8_BAR; PG8_SCHED;
        }
        if (wr == 0) PG8_BAR;
        E(acc, cur, wr, wc, fr, fq);
        if (!has_next) break;
        zero_acc(acc);
        cur = nxt; cA = nA; cB = nB; ++ui;
        if (wr == 1) PG8_BAR;
    }
    PG8_WAIT_V(0);
    PG8_BAR;
#undef PG8_SA
#undef PG8_SB
#undef PG8_STAGE
#undef PG8_LDA
#undef PG8_LDB
#undef PG8_MMA
#undef PG8_CAT
#undef PG8_WAIT_V
#undef PG8_WAIT_L
#undef PG8_BAR
#undef PG8_SCHED
}

struct DenseOrder {
    const char* A; const char* Bt; int lda, ldb, nM, nN, nwg, G, c;
    __device__ __forceinline__ void init(const void* A_, const void* Bt_, int lda_, int ldb_, int M, int N, int G_, int c_) { A = (const char*)A_; Bt = (const char*)Bt_; lda = lda_; ldb = ldb_; nM = M / BM; nN = N / BM; nwg = nM * nN; G = G_; c = c_; }
    __device__ __forceinline__ bool next(int i, Unit& u) const {
        const long L = (long)i * G + c; if (L >= nwg) return false;
        int wgid = (int)L; { const int q = nwg / 8, r = nwg % 8, xcd = wgid % 8, off = wgid / 8; wgid = (xcd < r ? xcd * (q + 1) : r * (q + 1) + (xcd - r) * q) + off; }
        const int nig = 8 * nN, gid = wgid / nig, fm = gid * 8, gsz = (nM - fm) < 8 ? (nM - fm) : 8;
        const int pm = fm + ((wgid % nig) % gsz), pn = (wgid % nig) / gsz;
        u.a = A + (size_t)pm * BM * lda * 2; u.b = Bt + (size_t)pn * BM * ldb * 2; u.row0 = pm * BM; u.col0 = pn * BM; u.e = 0; u.pad = 0; return true;
    }
};
struct LruOrder {
    const char* XC; const char* RG; int G, c;
    __device__ __forceinline__ bool next(int i, Unit& u) const {
        const int L = i * G + c; if (L >= 512) return false;
        const int pm = L >> 3, n = L & 7;
        u.a = XC + ((size_t)pm * BM * 1024 + n * 128) * 2; u.b = RG + (size_t)n * 256 * 128 * 2; u.row0 = pm * BM; u.col0 = n * 128; u.e = n; u.pad = 0; return true;
    }
};
struct MoeOrder {
    const char* A; const char* WT; size_t estride; const LAS int* tile_e; int NT, nN, G, c, esz;
    __device__ __forceinline__ bool next(int i, Unit& u) const {
        int tile, pn;
#ifndef MOE_ORDER_ALT
#define MOE_ORDER_ALT 0
#endif
        if (!MOE_ORDER_ALT && (G % (8 * nN)) == 0) { const int R = G / nN; tile = i * R + (c & 7) * (R >> 3) + (c >> 3) / nN; pn = (c >> 3) % nN; }
        else { const int L = i * G + c; tile = L / nN; pn = L % nN; }
        if (tile >= NT) return false;
        const int e = __builtin_amdgcn_readfirstlane(tile_e[tile]);
        u.a = A + (size_t)tile * BM * 1024 * esz; u.b = WT + (size_t)e * estride + (size_t)pn * BM * 1024 * esz; u.row0 = tile * BM; u.col0 = pn * BM; u.e = e; u.pad = 0; return true;
    }
};

#define EPI_ROW(ai, m) (u.row0 + (ai) * HALF + wr * 64 + (m) * 16 + fr)
#define EPI_COL(bj) (u.col0 + (bj) * HALF + wc * 32 + 8 * fq)
struct EpiBf16 {
    bf16_t* O; const float* bias; int ldc, bias_es; float ascale;
    __device__ __forceinline__ void operator()(const Acc& acc, const Unit& u, int wr, int wc, int fr, int fq) const {
        f32x4 bv[2][2];
#pragma unroll
        for (int bj = 0; bj < 2; ++bj)
#pragma unroll
            for (int n = 0; n < 2; ++n) bv[bj][n] = bias ? *(const f32x4*)(bias + (size_t)u.e * bias_es + EPI_COL(bj) + 4 * n) : (f32x4){0.f, 0.f, 0.f, 0.f};
#pragma unroll
        for (int ai = 0; ai < 2; ++ai)
#pragma unroll
            for (int m = 0; m < 4; ++m) { bf16_t* rowp = O + (size_t)EPI_ROW(ai, m) * ldc;
#pragma unroll
                for (int bj = 0; bj < 2; ++bj) { const f32x4 v0 = acc[ai][bj][m][0] * ascale + bv[bj][0], v1 = acc[ai][bj][m][1] * ascale + bv[bj][1];
                    u32x4 w; w.x = cvt_pk_bf16(v0[0], v0[1]); w.y = cvt_pk_bf16(v0[2], v0[3]); w.z = cvt_pk_bf16(v1[0], v1[1]); w.w = cvt_pk_bf16(v1[2], v1[3]);
                    *(u32x4*)(rowp + EPI_COL(bj)) = w; } }
    }
};
template <int KIND> struct EpiNorm {
    bf16_t* O; int ldc; const float* ga; const float* gb; const float* gc; const float* gd; const float* ge; const float* cs; LAS float* S;
    __device__ __forceinline__ void operator()(const Acc& acc, const Unit& u, int wr, int wc, int fr, int fq) const {
        const int pn = u.col0 >> 8; const int lane = fr + 16 * fq;
        int mode = 0; const float* gp = ga; float scale = 1.f;
        if (KIND == 0) { if (pn < 2) { mode = 1; gp = ga; scale = 0.125f * 1.4426950408889634f; } else if (pn < 4) { mode = 1; gp = gb; } else if (pn < 6) mode = 0; else if (pn == 6) { mode = 2; gp = gc; } else { mode = 3; gp = gd; } }
        if (KIND == 1) { scale = 0.10206207261596575f * 1.4426950408889634f; if (pn < 2) { mode = 1; gp = ga; } else { mode = 4; gp = gb; } }
        if (KIND == 2) { if (pn < 2) { mode = 1; gp = ga; } else mode = 0; }
        float ss[2][4][2];
        if (mode != 0) {
#pragma unroll
            for (int ai = 0; ai < 2; ++ai)
#pragma unroll
                for (int m = 0; m < 4; ++m)
#pragma unroll
                    for (int bj = 0; bj < 2; ++bj) { const f32x4 a = acc[ai][bj][m][0], b = acc[ai][bj][m][1];
                        float s = (a[0] * a[0] + a[1] * a[1]) + (a[2] * a[2] + a[3] * a[3]) + (b[0] * b[0] + b[1] * b[1]) + (b[2] * b[2] + b[3] * b[3]);
                        s += shx<16>(s); ss[ai][m][bj] = xadd32(s); } }
        if (mode == 1 || mode == 2 || mode == 3) {
            if (fq == 0) {
#pragma unroll
                for (int ai = 0; ai < 2; ++ai)
#pragma unroll
                    for (int m = 0; m < 4; ++m)
#pragma unroll
                        for (int bj = 0; bj < 2; ++bj) S[(ai * HALF + wr * 64 + m * 16 + fr) * 8 + bj * 4 + wc] = ss[ai][m][bj]; }
            asm volatile("s_waitcnt lgkmcnt(0)" ::: "memory"); __builtin_amdgcn_s_barrier(); asm volatile("" ::: "memory");
#pragma unroll
            for (int ai = 0; ai < 2; ++ai)
#pragma unroll
                for (int m = 0; m < 4; ++m) { const LAS float* sr = S + (ai * HALF + wr * 64 + m * 16 + fr) * 8;
#pragma unroll
                    for (int bj = 0; bj < 2; ++bj) {
                        if (mode == 1) { const f32x2 t = *(const LAS f32x2*)(sr + bj * 4 + (wc & 2)); ss[ai][m][bj] = t[0] + t[1]; }
                        else if (mode == 2) { const f32x4 t0 = *(const LAS f32x4*)sr, t1 = *(const LAS f32x4*)(sr + 4); ss[ai][m][bj] = (t0[0] + t0[1]) + (t0[2] + t0[3]) + (t1[0] + t1[1]) + (t1[2] + t1[3]); }
                        else if (bj == 0) { const f32x4 t0 = *(const LAS f32x4*)sr; ss[ai][m][bj] = (t0[0] + t0[1]) + (t0[2] + t0[3]); } } }
        }
        const float inv_n = (mode == 1) ? (1.f / 64.f) : (mode == 2) ? (1.f / 256.f) : (1.f / 32.f);
        const bool rope_tile = (mode == 4) || (mode == 3);
#pragma unroll
        for (int bj = 0; bj < 2; ++bj) {
            f32x4 g0 = (f32x4){1.f, 1.f, 1.f, 1.f}, g1 = g0; bool rope = false, zero = false; float invn = inv_n;
            const int c8 = 8 * fq;
            if (mode == 1) { const int c = 32 * (wc & 1) + c8; g0 = *(const f32x4*)(gp + c); g1 = *(const f32x4*)(gp + c + 4); }
            else if (mode == 2) { const int c = bj * HALF + wc * 32 + c8; g0 = *(const f32x4*)(gp + c); g1 = *(const f32x4*)(gp + c + 4); }
            else if (mode == 3) { if (bj == 0) { const int c = wc * 32 + c8; g0 = *(const f32x4*)(gp + c); g1 = *(const f32x4*)(gp + c + 4); invn = 1.f / 128.f; }
                                  else if (wc == 0) { g0 = *(const f32x4*)(ge + c8); g1 = *(const f32x4*)(ge + c8 + 4); rope = true; } else zero = true; }
            else if (mode == 4) { g0 = *(const f32x4*)(gp + c8); g1 = *(const f32x4*)(gp + c8 + 4); rope = true; }
            (void)rope_tile;
#pragma unroll
            for (int ai = 0; ai < 2; ++ai)
#pragma unroll
                for (int m = 0; m < 4; ++m) { const int row = EPI_ROW(ai, m);
                    f32x4 v0 = acc[ai][bj][m][0], v1 = acc[ai][bj][m][1];
                    if (mode != 0) { const float rs = rsqrtf(ss[ai][m][bj] * invn + 1e-6f) * scale; v0 = v0 * rs * g0; v1 = v1 * rs * g1; }
                    if (rope) {
                        const float* cr = cs + (size_t)row * 32 + 8 * (fq & 1); const f32x4 c0 = *(const f32x4*)cr, c1 = *(const f32x4*)(cr + 4), s0 = *(const f32x4*)(cr + 16), s1 = *(const f32x4*)(cr + 20);
                        f32x4 o0, o1;
#pragma unroll
                        for (int j = 0; j < 4; ++j) { const auto r0 = __builtin_amdgcn_permlane32_swap(__float_as_uint(v0[j]), __float_as_uint(v0[j]), false, false), r1 = __builtin_amdgcn_permlane32_swap(__float_as_uint(v1[j]), __float_as_uint(v1[j]), false, false);
                            const float ot0 = __uint_as_float(lane < 32 ? r0[1] : r0[0]), ot1 = __uint_as_float(lane < 32 ? r1[1] : r1[0]);
                            o0[j] = (lane < 32) ? (v0[j] * c0[j] - ot0 * s0[j]) : (ot0 * s0[j] + v0[j] * c0[j]);
                            o1[j] = (lane < 32) ? (v1[j] * c1[j] - ot1 * s1[j]) : (ot1 * s1[j] + v1[j] * c1[j]); }
                        v0 = o0; v1 = o1; }
                    if (zero) { v0 = (f32x4){0.f, 0.f, 0.f, 0.f}; v1 = v0; }
                    u32x4 w; w.x = cvt_pk_bf16(v0[0], v0[1]); w.y = cvt_pk_bf16(v0[2], v0[3]); w.z = cvt_pk_bf16(v1[0], v1[1]); w.w = cvt_pk_bf16(v1[2], v1[3]);
                    *(u32x4*)(O + (size_t)row * ldc + EPI_COL(bj)) = w; } }
    }
};
struct EpiRecIn {
    bf16_t* O; const float* bias;
    __device__ __forceinline__ void operator()(const Acc& acc, const Unit& u, int wr, int wc, int fr, int fq) const {
        const bool act = u.col0 < 1024;
        f32x4 bv[2][2];
#pragma unroll
        for (int bj = 0; bj < 2; ++bj)
#pragma unroll
            for (int n = 0; n < 2; ++n) bv[bj][n] = *(const f32x4*)(bias + EPI_COL(bj) + 4 * n);
#pragma unroll
        for (int ai = 0; ai < 2; ++ai)
#pragma unroll
            for (int m = 0; m < 4; ++m) { bf16_t* rowp = O + (size_t)EPI_ROW(ai, m) * 2048;
#pragma unroll
                for (int bj = 0; bj < 2; ++bj) { f32x4 v0 = acc[ai][bj][m][0] + bv[bj][0], v1 = acc[ai][bj][m][1] + bv[bj][1];
                    if (act) {
#pragma unroll
                        for (int j = 0; j < 4; ++j) { v0[j] = fgelu_tanh(v0[j]); v1[j] = fgelu_tanh(v1[j]); } }
                    u32x4 w; w.x = cvt_pk_bf16(v0[0], v0[1]); w.y = cvt_pk_bf16(v0[2], v0[3]); w.z = cvt_pk_bf16(v1[0], v1[1]); w.w = cvt_pk_bf16(v1[2], v1[3]);
                    *(u32x4*)(rowp + EPI_COL(bj)) = w; } }
    }
};
__device__ __forceinline__ unsigned pk4_fp8(float a, float b, float c, float d) { int w = 0; w = __builtin_amdgcn_cvt_pk_fp8_f32(a, b, w, false); w = __builtin_amdgcn_cvt_pk_fp8_f32(c, d, w, true); return (unsigned)w; }
struct EpiSwiglu {
    unsigned char* ACT; const float* b1; float ascale;
    __device__ __forceinline__ float sw(float g, float l) const { g = fminf(g, 7.f); l = fminf(fmaxf(l, -7.f), 7.f); return g * fsigmoid(1.702f * g) * (l + 1.f); }
    __device__ __forceinline__ void operator()(const Acc& acc, const Unit& u, int wr, int wc, int fr, int fq) const {
        f32x4 bv[2][2];
#pragma unroll
        for (int bj = 0; bj < 2; ++bj)
#pragma unroll
            for (int n = 0; n < 2; ++n) bv[bj][n] = *(const f32x4*)(b1 + (size_t)u.e * 2048 + EPI_COL(bj) + 4 * n);
#pragma unroll
        for (int ai = 0; ai < 2; ++ai)
#pragma unroll
            for (int m = 0; m < 4; ++m) { unsigned char* rowp = ACT + (size_t)EPI_ROW(ai, m) * 1024;
#pragma unroll
                for (int bj = 0; bj < 2; ++bj) { const f32x4 v0 = acc[ai][bj][m][0] * ascale + bv[bj][0], v1 = acc[ai][bj][m][1] * ascale + bv[bj][1];
                    *(unsigned*)(rowp + (EPI_COL(bj) >> 1)) = pk4_fp8(sw(v0[0], v0[1]), sw(v0[2], v0[3]), sw(v1[0], v1[1]), sw(v1[2], v1[3])); } }
    }
};
struct EpiResid {
    bf16_t* X; const float* g; const float* bias;
    __device__ __forceinline__ void operator()(const Acc& acc, const Unit& u, int wr, int wc, int fr, int fq) const {
        const int b = u.row0 / cfg::S;
        f32x4 bv[2][2], gv[2][2];
#pragma unroll
        for (int bj = 0; bj < 2; ++bj)
#pragma unroll
            for (int n = 0; n < 2; ++n) { bv[bj][n] = bias ? *(const f32x4*)(bias + EPI_COL(bj) + 4 * n) : (f32x4){0.f, 0.f, 0.f, 0.f}; gv[bj][n] = *(const f32x4*)(g + b * 6144 + EPI_COL(bj) + 4 * n); }
#pragma unroll
        for (int ai = 0; ai < 2; ++ai)
#pragma unroll
            for (int m = 0; m < 4; ++m) { bf16_t* rowp = X + (size_t)EPI_ROW(ai, m) * 1024;
#pragma unroll
                for (int bj = 0; bj < 2; ++bj) { u32x4* p = (u32x4*)(rowp + EPI_COL(bj)); const u32x4 xw = *p;
                    const f32x4 x0 = (f32x4){bf_lo(xw.x), bf_hi(xw.x), bf_lo(xw.y), bf_hi(xw.y)} + gv[bj][0] * (acc[ai][bj][m][0] + bv[bj][0]);
                    const f32x4 x1 = (f32x4){bf_lo(xw.z), bf_hi(xw.z), bf_lo(xw.w), bf_hi(xw.w)} + gv[bj][1] * (acc[ai][bj][m][1] + bv[bj][1]);
                    u32x4 w; w.x = cvt_pk_bf16(x0[0], x0[1]); w.y = cvt_pk_bf16(x0[2], x0[3]); w.z = cvt_pk_bf16(x1[0], x1[1]); w.w = cvt_pk_bf16(x1[2], x1[3]); *p = w; }
                if (m & 1) asm volatile("" ::: "memory"); }
    }
};
struct EpiLru {
    const bf16_t* XC; const float* ba; const float* bx; const float* lam; bf16_t* LA; bf16_t* Bb;
    __device__ __forceinline__ void operator()(const Acc& acc, const Unit& u, int wr, int wc, int fr, int fq) const {
        const int ch0 = u.col0 + wc * 32 + 8 * fq;
#pragma unroll
        for (int n = 0; n < 2; ++n) { const int ch = ch0 + 4 * n;
            const f32x4 bav = *(const f32x4*)(ba + ch), bxv = *(const f32x4*)(bx + ch), spv = *(const f32x4*)(lam + ch);
#pragma unroll
            for (int ai = 0; ai < 2; ++ai)
#pragma unroll
                for (int m = 0; m < 4; ++m) { const size_t ro = (size_t)EPI_ROW(ai, m) * 1024 + ch;
                    const u32x2 xr = *(const u32x2*)(XC + ro);
                    const float xcv[4] = {bf_lo(xr.x), bf_hi(xr.x), bf_lo(xr.y), bf_hi(xr.y)};
                    float lav[4], bvv[4];
#pragma unroll
                    for (int j = 0; j < 4; ++j) { const float r = fsigmoid(acc[ai][0][m][n][j] + bav[j]), ig = fsigmoid(acc[ai][1][m][n][j] + bxv[j]);
                        const float la = r * spv[j], a = fexp2(la); lav[j] = la; bvv[j] = __builtin_amdgcn_sqrtf(fmaxf(1.f - a * a, 0.f)) * ig * xcv[j]; }
                    u32x2 wa, wb; wa.x = cvt_pk_bf16(lav[0], lav[1]); wa.y = cvt_pk_bf16(lav[2], lav[3]); wb.x = cvt_pk_bf16(bvv[0], bvv[1]); wb.y = cvt_pk_bf16(bvv[2], bvv[3]);
                    *(u32x2*)(LA + ro) = wa; *(u32x2*)(Bb + ro) = wb; asm volatile("" ::: "memory"); } }
    }
};

constexpr size_t MiB = (size_t)1 << 20;
constexpr size_t al4k(size_t x) { return (x + 4095) & ~(size_t)4095; }
constexpr int T_ = cfg::T, S_ = cfg::S, P_ = cfg::P;
constexpr size_t O_CTL = 0, SZ_CTL = 1 * MiB;
constexpr size_t O_MOD = O_CTL + SZ_CTL, SZ_MOD = al4k((size_t)4 * 4 * 6144 * 4);
constexpr size_t O_CS = O_MOD + SZ_MOD, SZ_CS = (size_t)T_ * 32 * 4;
constexpr size_t O_HIST = O_CS + SZ_CS, SZ_HIST = 256 * 32 * 4;
constexpr size_t O_TOPI = O_HIST + SZ_HIST, SZ_TOP = (size_t)T_ * 4 * 4;
constexpr size_t O_TOPG = O_TOPI + SZ_TOP, O_POS = O_TOPG + SZ_TOP;
constexpr size_t O_SUMP = O_POS + SZ_TOP, SZ_SUM = (size_t)4 * 64 * 1024 * 4;
constexpr size_t O_SUMH = O_SUMP + SZ_SUM;
constexpr size_t O_LSE = O_SUMH + SZ_SUM, SZ_LSE = (size_t)3 * T_ * 8 * 4;
constexpr size_t O_SPV = al4k(O_LSE + SZ_LSE), SZ_SPV = 2 * 1024 * 4;
constexpr size_t O_WIN = al4k(O_SPV + SZ_SPV), SZ_WIN = (size_t)2048 * 1024 * 2;
constexpr size_t O_WUQ = O_WIN + 2 * SZ_WIN, SZ_WUQ = (size_t)768 * 256 * 2;
constexpr size_t O_WUKV = O_WUQ + 2 * SZ_WUQ, SZ_WUKV = (size_t)1024 * 128 * 2;
constexpr size_t O_WOUT = O_WUKV + 2 * SZ_WUKV, SZ_WOUT = (size_t)1024 * 1024 * 2;
constexpr size_t O_RWIN = O_WOUT + 2 * SZ_WOUT, SZ_RWIN = (size_t)2048 * 1024 * 2;
constexpr size_t O_RGATE = O_RWIN + 2 * SZ_RWIN, SZ_RGATE = (size_t)8 * 256 * 128 * 2;
constexpr size_t O_RWOUT = O_RGATE + 2 * SZ_RGATE, SZ_RWOUT = (size_t)1024 * 1024 * 2;
constexpr size_t O_W1 = O_RWOUT + 2 * SZ_RWOUT, SZ_W1E = (size_t)2048 * 1024;
constexpr size_t O_W2 = O_W1 + 128 * SZ_W1E, SZ_W2E = (size_t)1024 * 1024;
constexpr size_t O_HN = O_W2 + 128 * SZ_W2E, SZ_HN = (size_t)T_ * 1024 * 2;
constexpr size_t O_PROJ = O_HN + SZ_HN, SZ_PROJ = (size_t)T_ * 2048 * 2;
constexpr size_t O_Q2 = O_PROJ + SZ_PROJ, SZ_Q2 = (size_t)T_ * 768 * 2;
constexpr size_t O_KV2 = O_Q2 + SZ_Q2, SZ_KV2 = (size_t)T_ * 1024 * 2;
constexpr size_t O_OA = O_KV2 + SZ_KV2, SZ_OA = (size_t)3 * T_ * 512 * 2;
constexpr size_t O_ATT = O_OA + SZ_OA, SZ_ATT = (size_t)T_ * 1024 * 2;
constexpr size_t O_XC = O_ATT + SZ_ATT, SZ_XC = (size_t)T_ * 1024 * 2;
constexpr size_t O_AA = O_XC + SZ_XC, SZ_AA = (size_t)T_ * 1024 * 4;
constexpr size_t O_BB = O_AA + SZ_AA;
constexpr size_t O_XG = O_BB + SZ_AA, SZ_XG = (size_t)P_ * 1024 * 2;
constexpr size_t O_ACT = O_XG + SZ_XG, O_Y2 = O_ACT + SZ_XG;
constexpr size_t O_X = O_Y2 + SZ_XG, SZ_X = (size_t)T_ * 1024 * 2;
constexpr size_t O_DUMMY = O_X + SZ_X, SZ_DUMMY = (size_t)96 * MiB;
constexpr size_t WS_MK_END = O_DUMMY + SZ_DUMMY;
constexpr size_t O_NAIVE = (size_t)2048 * MiB;
static_assert(WS_MK_END <= O_NAIVE, "mk workspace");
constexpr int CW_BAR = 4096;
constexpr int RING_BYTES = 131072, LDSX_OFF = RING_BYTES;
constexpr int LDS_BYTES = 147456;
constexpr int LX_TILE = LDSX_OFF + 64, LX_MISC = LDSX_OFF + 2048, LX_EXCH = LDSX_OFF + 6144;

struct Args { const void* in[34]; float* out; unsigned char* ws; int ph_lo, ph_hi; };
struct Ctx { int tid, lane, wave, G, bid, vcu, gw, NGW; LAS unsigned char* lds; unsigned char* ws; };

__device__ __forceinline__ void conv_load(f32x4 (&v)[16], const float* __restrict__ W, int N, int n0, int k0, int lane) {
    const int n = n0 + 4 * (lane & 15); const float* p = W + (size_t)(k0 + 16 * (lane >> 4)) * N + n;
#pragma unroll
    for (int i = 0; i < 16; ++i) v[i] = (n < N) ? __builtin_nontemporal_load((const f32x4*)(p + (size_t)i * N)) : (f32x4){0.f, 0.f, 0.f, 0.f};
}
__device__ __forceinline__ int conv_row(int c, int perm) { if (perm == 1) { const int h = c / 96, d = c % 96; return d < 64 ? 64 * h + d : 512 + 32 * h + d - 64; } if (perm == 2) { const int h = c >> 7, d = c & 127; return d < 64 ? 64 * h + d : 512 + 64 * h + d - 64; } return c; }
__device__ __forceinline__ void conv_emit(const f32x4 (&v)[16], LAS unsigned char* T  , bf16_t* __restrict__ WT, int ldd, int n0, int k0, int lane, int perm) {
    const int kq = lane >> 4, c4 = lane & 15;
#pragma unroll
    for (int jj = 0; jj < 4; ++jj) { u32x4 lo, hi;
        lo.x = cvt_pk_bf16(v[0][jj], v[1][jj]); lo.y = cvt_pk_bf16(v[2][jj], v[3][jj]); lo.z = cvt_pk_bf16(v[4][jj], v[5][jj]); lo.w = cvt_pk_bf16(v[6][jj], v[7][jj]);
        hi.x = cvt_pk_bf16(v[8][jj], v[9][jj]); hi.y = cvt_pk_bf16(v[10][jj], v[11][jj]); hi.z = cvt_pk_bf16(v[12][jj], v[13][jj]); hi.w = cvt_pk_bf16(v[14][jj], v[15][jj]);
        LAS unsigned char* q = T + (4 * c4 + jj) * 144 + 32 * kq; *(LAS u32x4*)q = lo; *(LAS u32x4*)(q + 16) = hi; }
    asm volatile("s_waitcnt lgkmcnt(0)" ::: "memory");
#pragma unroll
    for (int s8 = 0; s8 < 8; ++s8) { const int n = 8 * s8 + (lane >> 3), ch = lane & 7; const u32x4 w = *(const LAS u32x4*)(T + n * 144 + 16 * ch);
        *(u32x4*)(WT + (size_t)conv_row(n0 + n, perm) * ldd + k0 + 8 * ch) = w; }
    asm volatile("s_waitcnt lgkmcnt(0)" ::: "memory");
}
__device__ __forceinline__ void conv8_tile(const float* __restrict__ W, int N, unsigned char* __restrict__ WT, int ldd, int n0, int k0, LAS unsigned char* T  , int lane) {
    const int kq = lane >> 4, c4 = lane & 15; const float* p = W + (size_t)(k0 + 32 * kq) * N + n0 + 4 * c4;
    f32x4 v[32];
#pragma unroll
    for (int i = 0; i < 32; ++i) v[i] = __builtin_nontemporal_load((const f32x4*)(p + (size_t)i * N));
#pragma unroll
    for (int jj = 0; jj < 4; ++jj) { u32x4 lo, hi;
        lo.x = pk4_fp8(32.f * v[0][jj], 32.f * v[1][jj], 32.f * v[2][jj], 32.f * v[3][jj]);     lo.y = pk4_fp8(32.f * v[4][jj], 32.f * v[5][jj], 32.f * v[6][jj], 32.f * v[7][jj]);
        lo.z = pk4_fp8(32.f * v[8][jj], 32.f * v[9][jj], 32.f * v[10][jj], 32.f * v[11][jj]);   lo.w = pk4_fp8(32.f * v[12][jj], 32.f * v[13][jj], 32.f * v[14][jj], 32.f * v[15][jj]);
        hi.x = pk4_fp8(32.f * v[16][jj], 32.f * v[17][jj], 32.f * v[18][jj], 32.f * v[19][jj]); hi.y = pk4_fp8(32.f * v[20][jj], 32.f * v[21][jj], 32.f * v[22][jj], 32.f * v[23][jj]);
        hi.z = pk4_fp8(32.f * v[24][jj], 32.f * v[25][jj], 32.f * v[26][jj], 32.f * v[27][jj]); hi.w = pk4_fp8(32.f * v[28][jj], 32.f * v[29][jj], 32.f * v[30][jj], 32.f * v[31][jj]);
        LAS unsigned char* q = T + (4 * c4 + jj) * 144 + 32 * kq; *(LAS u32x4*)q = lo; *(LAS u32x4*)(q + 16) = hi; }
    asm volatile("s_waitcnt lgkmcnt(0)" ::: "memory");
#pragma unroll
    for (int s8 = 0; s8 < 8; ++s8) { const int n = 8 * s8 + (lane >> 3), ch = lane & 7; const u32x4 w = *(const LAS u32x4*)(T + n * 144 + 16 * ch);
        *(u32x4*)(WT + (size_t)(n0 + n) * ldd + k0 + 16 * ch) = w; }
    asm volatile("s_waitcnt lgkmcnt(0)" ::: "memory");
}
template <class AP> __device__ __forceinline__ void p0_prologue(const Ctx& C, AP a) {
    unsigned char* ws = C.ws;
    { const float* c = (const float*)a->in[1]; const float* ada_w = (const float*)a->in[3]; const float* ada_b = (const float*)a->in[4]; float* mod = (float*)(ws + O_MOD);
      LAS float* part = (LAS float*)C.lds;
      LAS float* cact = (LAS float*)(C.lds + 32768);
      if (C.bid < 4 * 24) { for (int i = C.tid; i < 4096; i += 512) { const int b = i >> 10, k = i & 1023; const float cv = c[i]; cact[k * 4 + b] = cv / (1.f + expf(-cv)); } __syncthreads(); }
      for (int it = C.bid; it < 4 * 24; it += C.G) { const int l = it / 24, n0 = (it % 24) * 256;
          f32x4 acc[4];
#pragma unroll
          for (int b = 0; b < 4; ++b) acc[b] = (f32x4){0.f, 0.f, 0.f, 0.f};
          const float* w = ada_w + (size_t)l * 1024 * 6144 + n0 + 4 * C.lane;
#pragma unroll 1
          for (int k0 = C.wave * 128; k0 < C.wave * 128 + 128; k0 += 16) { f32x4 wv[16];
#pragma unroll
              for (int i = 0; i < 16; ++i) wv[i] = __builtin_nontemporal_load((const f32x4*)(w + (size_t)(k0 + i) * 6144));
#pragma unroll
              for (int i = 0; i < 16; ++i) { const f32x4 sv = *(const LAS f32x4*)(cact + (k0 + i) * 4);
#pragma unroll
                  for (int b = 0; b < 4; ++b) acc[b] = acc[b] + sv[b] * wv[i]; } }
#pragma unroll
          for (int b = 0; b < 4; ++b) *(LAS f32x4*)(part + (C.wave * 4 + b) * 256 + 4 * C.lane) = acc[b];
          __syncthreads();
          for (int o = C.tid; o < 1024; o += 512) { const int b = o >> 8, n = o & 255; float sacc = ada_b[l * 6144 + n0 + n];
#pragma unroll
              for (int w8 = 0; w8 < 8; ++w8) sacc += part[(w8 * 4 + b) * 256 + n];
              mod[((size_t)l * 4 + b) * 6144 + n0 + n] = sacc; }
          __syncthreads(); } }
    { const int* positions = (const int*)a->in[2]; float* cs = (float*)(ws + O_CS);
      for (int i = C.bid * 512 + C.tid; i < T_ * 16; i += C.G * 512) { const int t = i >> 4, f = i & 15; const float inv = powf(10000.f, -(float)(2 * f) / 32.f); const float ang = (float)positions[t] * inv;
          cs[t * 32 + f] = cosf(ang); cs[t * 32 + 16 + f] = sinf(ang); } }
    { const float* lam = (const float*)a->in[25]; float* spv = (float*)(ws + O_SPV);
      for (int i = C.bid * 512 + C.tid; i < 2048; i += C.G * 512) spv[i] = -8.f * 1.4426950408889634f * log1pf(expf(-lam[i])); }
    { const int lane = C.lane; LAS unsigned char* T = C.lds + 49152 + C.wave * 9216;
      const float* attn_w_in = (const float*)a->in[7]; const float* w_uq = (const float*)a->in[12]; const float* w_ukv = (const float*)a->in[13]; const float* attn_w_out = (const float*)a->in[16];
      const float* rec_w_in = (const float*)a->in[17]; const float* rec_wa = (const float*)a->in[21]; const float* rec_wx = (const float*)a->in[23]; const float* rec_w_out = (const float*)a->in[26];
      const float* w1 = (const float*)a->in[30]; const float* w2 = (const float*)a->in[32];
      constexpr int T_WIN = 32 * 16, T_WUQ = 12 * 4, T_WUKV = 16 * 2, T_WOUT = 16 * 16, T_RWIN = 32 * 16, T_RG = 2 * 2, T_RWOUT = 16 * 16, T_W1 = 32 * 16, T_W2 = 16 * 16;
      constexpr int NITEMS = 2 * (T_WIN + T_WUQ + T_WUKV + T_WOUT + T_RWIN + 16 * T_RG + T_RWOUT);
      struct Job { const float* W; bf16_t* WT; int N, ldd, n0, k0, perm; };
      auto decode = [&](int r, Job& jb) {
#define CONV_JOB(SRC, KK, NN, DST, NROWS, NMAT, SRC_MS, DST_MS, PERM) { constexpr int kc_ = (KK) / 64, per_ = ((NROWS) / 64) * kc_, tot_ = per_ * (NMAT); \
          if (r < tot_) { const int mat_ = r / per_, q_ = r % per_; jb.W = (SRC) + (size_t)mat_ * (SRC_MS); jb.WT = (bf16_t*)(ws + (DST) + (size_t)mat_ * (DST_MS)); jb.N = (NN); jb.ldd = (KK); jb.n0 = (q_ / kc_) * 64; jb.k0 = (q_ % kc_) * 64; jb.perm = (PERM); return; } r -= tot_; }
          CONV_JOB(attn_w_in, 1024, 1952, O_WIN, 2048, 2, (size_t)1024 * 1952, SZ_WIN, 0)
          CONV_JOB(w_uq, 256, 768, O_WUQ, 768, 2, (size_t)256 * 768, SZ_WUQ, 1)
          CONV_JOB(w_ukv, 128, 1024, O_WUKV, 1024, 2, (size_t)128 * 1024, SZ_WUKV, 2)
          CONV_JOB(attn_w_out, 1024, 1024, O_WOUT, 1024, 2, (size_t)1024 * 1024, SZ_WOUT, 0)
          CONV_JOB(rec_w_in, 1024, 2048, O_RWIN, 2048, 2, (size_t)1024 * 2048, SZ_RWIN, 0)
          CONV_JOB(rec_wa, 128, 128, O_RGATE, 128, 16, (size_t)128 * 128, (size_t)256 * 128 * 2, 0)
          CONV_JOB(rec_wx, 128, 128, O_RGATE + (size_t)128 * 128 * 2, 128, 16, (size_t)128 * 128, (size_t)256 * 128 * 2, 0)
          CONV_JOB(rec_w_out, 1024, 1024, O_RWOUT, 1024, 2, (size_t)1024 * 1024, SZ_RWOUT, 0)
#undef CONV_JOB
          jb.W = attn_w_in; jb.WT = (bf16_t*)(ws + O_WIN); jb.N = 1952; jb.ldd = 1024; jb.n0 = 0; jb.k0 = 0; jb.perm = 0; };
      f32x4 va[16], vb[16]; Job ja, jn;
      int it = C.gw;
      if (it < NITEMS) { decode(it, ja); conv_load(va, ja.W, ja.N, ja.n0, ja.k0, lane); }
#pragma unroll 1
      for (; it < NITEMS; it += 2 * C.NGW) {
          const bool h1 = it + C.NGW < NITEMS;
          if (h1) { decode(it + C.NGW, jn); conv_load(vb, jn.W, jn.N, jn.n0, jn.k0, lane); }
          conv_emit(va, T, ja.WT, ja.ldd, ja.n0, ja.k0, lane, ja.perm);
          const bool h2 = it + 2 * C.NGW < NITEMS;
          if (h2) { decode(it + 2 * C.NGW, ja); conv_load(va, ja.W, ja.N, ja.n0, ja.k0, lane); }
          if (h1) conv_emit(vb, T, jn.WT, jn.ldd, jn.n0, jn.k0, lane, jn.perm);
      }
    }
}

__device__ __forceinline__ void phase_norm(const Ctx& C, const float* xin  , float* out  , bool combine, bool do_norm, const float* gain, const float* modc  , const float* modl  , int shoff, int scoff, bool dummy = false) {
    const bf16_t* Y2 = (const bf16_t*)(C.ws + O_Y2); const int* pos = (const int*)(C.ws + O_POS); const float* topg = (const float*)(C.ws + O_TOPG); bf16_t* HN = (bf16_t*)(C.ws + (dummy ? O_DUMMY : O_HN)); const bf16_t* X = (const bf16_t*)(C.ws + O_X); bf16_t* Xo = (bf16_t*)(C.ws + (dummy ? O_DUMMY + 32 * MiB : O_X));
    const int lane = C.lane;
    for (int t = C.gw; t < T_; t += C.NGW) { const int b = t / S_;
        f32x4 v[4];
        if (xin) {
#pragma unroll
            for (int j = 0; j < 4; ++j) v[j] = *(const f32x4*)(xin + (size_t)t * 1024 + 256 * j + 4 * lane); }
        else {
#pragma unroll
            for (int j = 0; j < 4; ++j) { const u32x2 w = *(const u32x2*)(X + (size_t)t * 1024 + 256 * j + 4 * lane); v[j] = (f32x4){bf_lo(w.x), bf_hi(w.x), bf_lo(w.y), bf_hi(w.y)}; } }
        if (combine) { f32x4 y[4];
#pragma unroll
            for (int j = 0; j < 4; ++j) y[j] = (f32x4){0.f, 0.f, 0.f, 0.f};
#pragma unroll
            for (int k = 0; k < 4; ++k) { const int p = pos[t * 4 + k]; const float gk = topg[t * 4 + k];
#pragma unroll
                for (int j = 0; j < 4; ++j) { const u32x2 w = *(const u32x2*)(Y2 + (size_t)p * 1024 + 256 * j + 4 * lane);
                    y[j][0] += gk * bf_lo(w.x); y[j][1] += gk * bf_hi(w.x); y[j][2] += gk * bf_lo(w.y); y[j][3] += gk * bf_hi(w.y); } }
#pragma unroll
            for (int j = 0; j < 4; ++j) { const f32x4 g2 = *(const f32x4*)(modc + b * 6144 + 5120 + 256 * j + 4 * lane); v[j] = v[j] + g2 * y[j]; } }
        if (out) {
#pragma unroll
            for (int j = 0; j < 4; ++j) *(f32x4*)(out + (size_t)t * 1024 + 256 * j + 4 * lane) = v[j]; }
        else {
#pragma unroll
            for (int j = 0; j < 4; ++j) { u32x2 w; w.x = cvt_pk_bf16(v[j][0], v[j][1]); w.y = cvt_pk_bf16(v[j][2], v[j][3]); *(u32x2*)(Xo + (size_t)t * 1024 + 256 * j + 4 * lane) = w; } }
        if (do_norm) { float ss = 0.f;
#pragma unroll
            for (int j = 0; j < 4; ++j) ss += (v[j][0] * v[j][0] + v[j][1] * v[j][1]) + (v[j][2] * v[j][2] + v[j][3] * v[j][3]);
            const float rs = rsqrtf(wsum(ss) * (1.f / 1024.f) + 1e-6f);
#pragma unroll
            for (int j = 0; j < 4; ++j) { const int col = 256 * j + 4 * lane; const f32x4 gn = *(const f32x4*)(gain + col), sc = *(const f32x4*)(modl + b * 6144 + scoff + col), sh = *(const f32x4*)(modl + b * 6144 + shoff + col);
                const f32x4 h = v[j] * rs * gn * (1.f + sc) + sh;
                u32x2 w; w.x = cvt_pk_bf16(h[0], h[1]); w.y = cvt_pk_bf16(h[2], h[3]); *(u32x2*)(HN + (size_t)t * 1024 + col) = w; } }
    }
}

__device__ __forceinline__ void unpack8(const u32x4 w, float (&f)[8]) { f[0] = bf_lo(w.x); f[1] = bf_hi(w.x); f[2] = bf_lo(w.y); f[3] = bf_hi(w.y); f[4] = bf_lo(w.z); f[5] = bf_hi(w.z); f[6] = bf_lo(w.w); f[7] = bf_hi(w.w); }
__device__ __forceinline__ u32x4 pack8(const float (&f)[8]) { u32x4 w; w.x = cvt_pk_bf16(f[0], f[1]); w.y = cvt_pk_bf16(f[2], f[3]); w.z = cvt_pk_bf16(f[4], f[5]); w.w = cvt_pk_bf16(f[6], f[7]); return w; }

constexpr float LOG2E = 1.4426950408889634f;
__device__ __forceinline__ void phase_postproj(const Ctx& C, const float* qg, const float* kg, const float* qag, const float* kvag, const float* mkg) {
    bf16_t* PROJ = (bf16_t*)(C.ws + O_PROJ); const float* cs = (const float*)(C.ws + O_CS); const int lane = C.lane;
    for (int t = C.gw; t < T_; t += C.NGW) { bf16_t* row = PROJ + (size_t)t * 2048;
#pragma unroll
        for (int ps = 0; ps < 2; ++ps) { bf16_t* p = row + ps * 512 + 8 * lane; float f[8]; unpack8(*(const u32x4*)p, f); float ss = 0.f;
#pragma unroll
            for (int i = 0; i < 8; ++i) ss += f[i] * f[i];
            ss += shx<1>(ss); ss += shx<2>(ss); ss += shx<4>(ss);
            const float rs = rsqrtf(ss * (1.f / 64.f) + 1e-6f) * (ps == 0 ? 0.125f * LOG2E : 1.f); const float* g = (ps == 0 ? qg : kg) + 8 * (lane & 7);
#pragma unroll
            for (int i = 0; i < 8; ++i) f[i] = f[i] * rs * g[i];
            *(u32x4*)p = pack8(f); }
        { bf16_t* p = row + 1536 + 8 * lane; float f[8]; unpack8(*(const u32x4*)p, f); float ss = 0.f;
#pragma unroll
            for (int i = 0; i < 8; ++i) ss += f[i] * f[i];
            ss += shx<1>(ss); ss += shx<2>(ss);
            { const float o4 = shx<4>(ss); if (lane < 48) ss += o4; } { const float o8 = shx<8>(ss); if (lane < 48) ss += o8; } { const float o16 = shx<16>(ss); if (lane < 32) ss += o16; }
            const float nrm = lane < 32 ? 256.f : (lane < 48 ? 128.f : 32.f);
            const float rs = rsqrtf(ss / nrm + 1e-6f);
            const float* g = lane < 32 ? (qag + 8 * lane) : (lane < 48 ? (kvag + 8 * (lane - 32)) : (mkg + 64 + 8 * ((lane - 48) & 3)));
#pragma unroll
            for (int i = 0; i < 8; ++i) f[i] = f[i] * rs * g[i];
            float o[8];
#pragma unroll
            for (int i = 0; i < 8; ++i) { const float other = shx<2>(f[i]); const int fi = ((lane & 1) << 3) + i; const float cv = cs[t * 32 + fi], sv = cs[t * 32 + 16 + fi];
                o[i] = (lane & 2) ? (other * sv + f[i] * cv) : (f[i] * cv - other * sv); }
            if (lane >= 48 && lane < 52) {
#pragma unroll
                for (int i = 0; i < 8; ++i) f[i] = o[i]; }
            if (lane < 52) *(u32x4*)p = pack8(f); }
    }
}
__device__ __forceinline__ void phase_postq(const Ctx& C, const float* mqg, const float* mkg) {
    bf16_t* Q2 = (bf16_t*)(C.ws + O_Q2); bf16_t* KV2 = (bf16_t*)(C.ws + O_KV2); const float* cs = (const float*)(C.ws + O_CS); const int lane = C.lane;
    const float qscale = 0.10206207261596575f * LOG2E;
    for (int t = C.gw; t < T_; t += C.NGW) {
        { bf16_t* p = Q2 + (size_t)t * 768 + (lane >> 3) * 96 + 8 * (lane & 7); float f[8]; unpack8(*(const u32x4*)p, f); float ss = 0.f;
#pragma unroll
            for (int i = 0; i < 8; ++i) ss += f[i] * f[i];
            ss += shx<1>(ss); ss += shx<2>(ss); ss += shx<4>(ss);
            const float rs = rsqrtf(ss * (1.f / 64.f) + 1e-6f) * qscale; const float* g = mqg + 8 * (lane & 7);
#pragma unroll
            for (int i = 0; i < 8; ++i) f[i] = f[i] * rs * g[i];
            *(u32x4*)p = pack8(f); }
        { const int l2 = lane & 31; bf16_t* p = Q2 + (size_t)t * 768 + (l2 >> 2) * 96 + 64 + 8 * (l2 & 3); float f[8]; unpack8(*(const u32x4*)p, f); float ss = 0.f;
#pragma unroll
            for (int i = 0; i < 8; ++i) ss += f[i] * f[i];
            ss += shx<1>(ss); ss += shx<2>(ss);
            const float rs = rsqrtf(ss * (1.f / 32.f) + 1e-6f) * qscale; const float* g = mqg + 64 + 8 * (l2 & 3);
#pragma unroll
            for (int i = 0; i < 8; ++i) f[i] = f[i] * rs * g[i];
            float o[8];
#pragma unroll
            for (int i = 0; i < 8; ++i) { const float other = shx<2>(f[i]); const int fi = ((lane & 1) << 3) + i; const float cv = cs[t * 32 + fi], sv = cs[t * 32 + 16 + fi];
                o[i] = (lane & 2) ? (other * sv + f[i] * cv) : (f[i] * cv - other * sv); }
            if (lane < 32) *(u32x4*)p = pack8(o); }
        { bf16_t* p = KV2 + (size_t)t * 1024 + (lane >> 3) * 128 + 8 * (lane & 7); float f[8]; unpack8(*(const u32x4*)p, f); float ss = 0.f;
#pragma unroll
            for (int i = 0; i < 8; ++i) ss += f[i] * f[i];
            ss += shx<1>(ss); ss += shx<2>(ss); ss += shx<4>(ss);
            const float rs = rsqrtf(ss * (1.f / 64.f) + 1e-6f); const float* g = mkg + 8 * (lane & 7);
#pragma unroll
            for (int i = 0; i < 8; ++i) f[i] = f[i] * rs * g[i];
            *(u32x4*)p = pack8(f); }
    }
}
__device__ __forceinline__ void phase_mixcombine(const Ctx& C) {
    const bf16_t* OA = (const bf16_t*)(C.ws + O_OA); const float* LSE = (const float*)(C.ws + O_LSE); bf16_t* ATT = (bf16_t*)(C.ws + O_ATT); const int lane = C.lane;
    for (int t = C.gw; t < T_; t += C.NGW) { const int h = lane >> 3;
        float ls[3], mx = -INFINITY;
#pragma unroll
        for (int p = 0; p < 3; ++p) { ls[p] = LSE[((size_t)p * T_ + t) * 8 + h]; mx = fmaxf(mx, ls[p]); }
        float w[3], den = 0.f;
#pragma unroll
        for (int p = 0; p < 3; ++p) { w[p] = fexp2(ls[p] - mx); den += w[p]; }
        const float inv = 1.f / den; float o[8];
#pragma unroll
        for (int i = 0; i < 8; ++i) o[i] = 0.f;
#pragma unroll
        for (int p = 0; p < 3; ++p) { float f[8]; unpack8(*(const u32x4*)(OA + ((size_t)p * T_ + t) * 512 + 8 * lane), f); const float wp = w[p] * inv;
#pragma unroll
            for (int i = 0; i < 8; ++i) o[i] += wp * f[i]; }
        *(u32x4*)(ATT + (size_t)t * 1024 + 8 * lane) = pack8(o); }
}
__device__ __forceinline__ void phase_rgate(const Ctx& C, int j, const float* cw, const float* cb, const float* ba, const float* bx) {
    const bf16_t* PROJ = (const bf16_t*)(C.ws + O_PROJ); const bf16_t* RG = (const bf16_t*)(C.ws + O_RGATE + (size_t)j * SZ_RGATE); const float* spvg = (const float*)(C.ws + O_SPV) + j * 1024;
    bf16_t* LA = (bf16_t*)(C.ws + O_AA); bf16_t* Bb = (bf16_t*)(C.ws + O_BB); float* SP = (float*)(C.ws + O_SUMP); float* SH = (float*)(C.ws + O_SUMH);
    constexpr int WROW = 272;
    LAS unsigned char* Wl = C.lds;
    LAS unsigned char* Xl = C.lds + 256 * WROW;
    LAS unsigned char* Al = Xl + 64 * WROW;
    LAS unsigned char* Bl = Al + 64 * WROW;
    const int tid = C.tid, lane = C.lane, w = C.wave;
    if (C.G % 8 != 0) return;
    const int n = C.bid & 7, g = C.bid >> 3, ng = C.G >> 3;
    for (int i = tid; i < 256 * 16; i += 512) { const int r = i >> 4, c = i & 15; *(LAS u32x4*)(Wl + r * WROW + 16 * c) = *(const u32x4*)(RG + ((size_t)n * 256 + r) * 128 + 8 * c); }
    const int crow = tid >> 3, cg = tid & 7, cch = n * 128 + 16 * cg;
    float cwv[4][16], cbv[16];
#pragma unroll
    for (int q = 0; q < 4; ++q) { const f32x4 b4 = *(const f32x4*)(cb + cch + 4 * q); cbv[4 * q] = b4[0]; cbv[4 * q + 1] = b4[1]; cbv[4 * q + 2] = b4[2]; cbv[4 * q + 3] = b4[3];
#pragma unroll
        for (int k = 0; k < 4; ++k) { const f32x4 w4 = *(const f32x4*)(cw + k * 1024 + cch + 4 * q); cwv[k][4 * q] = w4[0]; cwv[k][4 * q + 1] = w4[1]; cwv[k][4 * q + 2] = w4[2]; cwv[k][4 * q + 3] = w4[3]; } }
    const int mt = w & 3, h = w >> 2, l15 = lane & 15, kg = lane >> 4;
    float bav[4], bxv[4], spv[4];
#pragma unroll
    for (int jj = 0; jj < 4; ++jj) { const int ch = n * 128 + 16 * (4 * h + jj) + l15; bav[jj] = ba[ch]; bxv[jj] = bx[ch]; spv[jj] = spvg[ch]; }
    __syncthreads();
    for (int c = g; c < 256; c += ng) { const size_t row0 = (size_t)c * 64; const int ts0 = (int)(row0 % S_);
        { float acc[16];
#pragma unroll
          for (int i = 0; i < 16; ++i) acc[i] = cbv[i];
#pragma unroll
          for (int k = 0; k < 4; ++k) { const int dt = k - 3; if (ts0 + crow + dt >= 0) { const bf16_t* src = PROJ + (row0 + crow + dt) * 2048 + 1024 + cch; float f0[8], f1[8]; unpack8(*(const u32x4*)src, f0); unpack8(*(const u32x4*)(src + 8), f1);
#pragma unroll
                  for (int i = 0; i < 8; ++i) { acc[i] += cwv[k][i] * f0[i]; acc[8 + i] += cwv[k][8 + i] * f1[i]; } } }
          float lo[8], hi8[8];
#pragma unroll
          for (int i = 0; i < 8; ++i) { lo[i] = acc[i]; hi8[i] = acc[8 + i]; }
          *(LAS u32x4*)(Xl + crow * WROW + 32 * cg) = pack8(lo); *(LAS u32x4*)(Xl + crow * WROW + 32 * cg + 16) = pack8(hi8); }
        __syncthreads();
        f32x4 acc[8];
#pragma unroll
        for (int t = 0; t < 8; ++t) acc[t] = (f32x4){0.f, 0.f, 0.f, 0.f};
#pragma unroll
        for (int ks = 0; ks < 4; ++ks) { const bf16x8 af = *(const LAS bf16x8*)(Xl + (16 * mt + l15) * WROW + 64 * ks + 16 * kg);
#pragma unroll
            for (int t = 0; t < 8; ++t) { const int nt = (t < 4) ? (4 * h + t) : (8 + 4 * h + (t - 4)); const bf16x8 bfr = *(const LAS bf16x8*)(Wl + (16 * nt + l15) * WROW + 64 * ks + 16 * kg);
                acc[t] = __builtin_amdgcn_mfma_f32_16x16x32_bf16(af, bfr, acc[t], 0, 0, 0); } }
#pragma unroll
        for (int jj = 0; jj < 4; ++jj) { const int e = 16 * (4 * h + jj) + l15;
#pragma unroll
            for (int r = 0; r < 4; ++r) { const int row = 16 * mt + 4 * kg + r; const float xc = bf_lo((unsigned)*(const LAS unsigned short*)(Xl + row * WROW + 2 * e));
                const float rr = fsigmoid(acc[jj][r] + bav[jj]), ig = fsigmoid(acc[4 + jj][r] + bxv[jj]); const float la = rr * spv[jj], av = fexp2(la);
                const float bv = __builtin_amdgcn_sqrtf(fmaxf(1.f - av * av, 0.f)) * ig * xc;
                *(LAS unsigned short*)(Al + row * WROW + 2 * e) = (unsigned short)(cvt_pk_bf16(la, la) & 0xffffu); *(LAS unsigned short*)(Bl + row * WROW + 2 * e) = (unsigned short)(cvt_pk_bf16(bv, bv) & 0xffffu); } }
        __syncthreads();
        { const size_t go = (row0 + crow) * 1024 + cch;
          *(u32x4*)(LA + go) = *(const LAS u32x4*)(Al + crow * WROW + 32 * cg); *(u32x4*)(LA + go + 8) = *(const LAS u32x4*)(Al + crow * WROW + 32 * cg + 16);
          *(u32x4*)(Bb + go) = *(const LAS u32x4*)(Bl + crow * WROW + 32 * cg); *(u32x4*)(Bb + go + 8) = *(const LAS u32x4*)(Bl + crow * WROW + 32 * cg + 16); }
        if (tid < 128) { float Pl = 0.f, Hh = 0.f;
#pragma unroll 8
            for (int r = 0; r < 64; ++r) { const float la = bf_lo((unsigned)*(const LAS unsigned short*)(Al + r * WROW + 2 * tid)), bv = bf_lo((unsigned)*(const LAS unsigned short*)(Bl + r * WROW + 2 * tid)); Hh = fexp2(la) * Hh + bv; Pl += la; }
            const int b = (int)(row0 / S_), ck = (int)((row0 % S_) >> 6); SP[((size_t)b * 64 + ck) * 1024 + n * 128 + tid] = fexp2(Pl); SH[((size_t)b * 64 + ck) * 1024 + n * 128 + tid] = Hh; }
        __syncthreads();
    }
}

__device__ __forceinline__ void scan_sum_item(const Ctx& C, int b, int ck, int cg) {
    const bf16_t* LA = (const bf16_t*)(C.ws + O_AA); const bf16_t* Bb = (const bf16_t*)(C.ws + O_BB); float* SP = (float*)(C.ws + O_SUMP); float* SH = (float*)(C.ws + O_SUMH);
    const int ch = cg * 128 + 2 * C.lane;
    size_t off = ((size_t)b * S_ + ck * 64) * 1024 + ch; f32x2 Pl = (f32x2){0.f, 0.f}, Hh = (f32x2){0.f, 0.f};
#pragma unroll 8
    for (int s = 0; s < 64; ++s, off += 1024) { const unsigned lw = *(const unsigned*)(LA + off), bw = *(const unsigned*)(Bb + off);
        const f32x2 lv = (f32x2){bf_lo(lw), bf_hi(lw)}, av = (f32x2){fexp2(lv[0]), fexp2(lv[1])}, bv = (f32x2){bf_lo(bw), bf_hi(bw)}; Hh = av * Hh + bv; Pl = Pl + lv; }
    *(f32x2*)(SP + ((size_t)b * 64 + ck) * 1024 + ch) = (f32x2){fexp2(Pl[0]), fexp2(Pl[1])}; *(f32x2*)(SH + ((size_t)b * 64 + ck) * 1024 + ch) = Hh;
}
__device__ __forceinline__ void phase_scan_sum_own(const Ctx& C) {
    asm volatile("s_waitcnt vmcnt(0)" ::: "memory"); __syncthreads();
    for (int i = 0; ; ++i) { const int L = i * C.G + C.bid; if (L >= 512) break; const int pm = L >> 3, n = L & 7;
        if (C.wave < 4) { const int row0 = pm * 256 + C.wave * 64; scan_sum_item(C, row0 / S_, (row0 % S_) >> 6, n); } }
}
__device__ __forceinline__ void phase_scan_apply(const Ctx& C) {
    const bf16_t* LA = (const bf16_t*)(C.ws + O_AA); const bf16_t* Bb = (const bf16_t*)(C.ws + O_BB); const float* SP = (const float*)(C.ws + O_SUMP); const float* SH = (const float*)(C.ws + O_SUMH);
    const bf16_t* PROJ = (const bf16_t*)(C.ws + O_PROJ); bf16_t* ATT = (bf16_t*)(C.ws + O_ATT); const int lane = C.lane;
    for (int it = C.gw; it < 4 * 64 * 8; it += C.NGW) { const int cg = it & 7, ck = (it >> 3) & 63, b = it >> 9; const int ch = cg * 128 + 2 * lane;
        f32x2 h = (f32x2){0.f, 0.f};
#pragma unroll 8
        for (int c2 = 0; c2 < ck; ++c2) { const f32x2 pv = *(const f32x2*)(SP + ((size_t)b * 64 + c2) * 1024 + ch), hv = *(const f32x2*)(SH + ((size_t)b * 64 + c2) * 1024 + ch); h = pv * h + hv; }
        size_t row = (size_t)b * S_ + ck * 64;
#pragma unroll 8
        for (int s = 0; s < 64; ++s, ++row) { const unsigned lw = *(const unsigned*)(LA + row * 1024 + ch), bw = *(const unsigned*)(Bb + row * 1024 + ch);
            const f32x2 av = (f32x2){fexp2(bf_lo(lw)), fexp2(bf_hi(lw))}, bv = (f32x2){bf_lo(bw), bf_hi(bw)}; h = av * h + bv;
            const unsigned gw2 = *(const unsigned*)(PROJ + row * 2048 + ch);
            *(unsigned*)(ATT + row * 1024 + ch) = cvt_pk_bf16(bf_lo(gw2) * h[0], bf_hi(gw2) * h[1]); } }
}

__device__ __forceinline__ void split_bf16(const f32x4 a, const f32x4 b, bf16x8& hi, bf16x8& lo) {
    u32x4 h; h.x = cvt_pk_bf16(a[0], a[1]); h.y = cvt_pk_bf16(a[2], a[3]); h.z = cvt_pk_bf16(b[0], b[1]); h.w = cvt_pk_bf16(b[2], b[3]);
    u32x4 l; l.x = cvt_pk_bf16(a[0] - bf_lo(h.x), a[1] - bf_hi(h.x)); l.y = cvt_pk_bf16(a[2] - bf_lo(h.y), a[3] - bf_hi(h.y)); l.z = cvt_pk_bf16(b[0] - bf_lo(h.z), b[1] - bf_hi(h.z)); l.w = cvt_pk_bf16(b[2] - bf_lo(h.w), b[3] - bf_hi(h.w));
    hi = __builtin_bit_cast(bf16x8, h); lo = __builtin_bit_cast(bf16x8, l);
}
__device__ __forceinline__ void phase_router(const Ctx& C, const bf16_t* X, const float* gain, const float* modl, const float* wr, const float* br) {
    unsigned char* HN8 = C.ws + O_HN; int* topi = (int*)(C.ws + O_TOPI); float* topg = (float*)(C.ws + O_TOPG); int* hist = (int*)(C.ws + O_HIST);
    constexpr int HROW = 1028;
    LAS float* hrow = (LAS float*)C.lds;
    LAS float* part = (LAS float*)(C.lds + 16 * HROW * 4);
    LAS int* hl = (LAS int*)(C.lds + LX_MISC);
    const int lane = C.lane, e = lane & 31, kh = lane >> 5, v = C.wave, l15 = lane & 15, kg = lane >> 4;
    bf16x8 whi[2][4], wlo[2][4];
#pragma unroll
    for (int nt = 0; nt < 2; ++nt)
#pragma unroll
        for (int ks = 0; ks < 4; ++ks) { const float* p = wr + (size_t)(128 * v + 32 * ks + 8 * kg) * 32 + 16 * nt + l15;
            const f32x4 a = (f32x4){p[0], p[32], p[64], p[96]}, b = (f32x4){p[128], p[160], p[192], p[224]}; split_bf16(a, b, whi[nt][ks], wlo[nt][ks]); }
    const float bias_e = br[e];
    if (C.tid < 32) hl[C.tid] = 0;
    __syncthreads();
    for (int ck = C.bid; ck < 256; ck += C.G) {
        const int b = (ck * 64) / S_;
        f32x4 gn[4], shv[4];
#pragma unroll
        for (int j = 0; j < 4; ++j) { const int col = 256 * j + 4 * lane; gn[j] = *(const f32x4*)(gain + col) * (1.f + *(const f32x4*)(modl + b * 6144 + 4096 + col)); shv[j] = *(const f32x4*)(modl + b * 6144 + 3072 + col); }
        u32x2 xr[2][4];
#pragma unroll
        for (int q = 0; q < 2; ++q)
#pragma unroll
            for (int j = 0; j < 4; ++j) xr[q][j] = *(const u32x2*)(X + (size_t)(ck * 64 + 2 * v + q) * 1024 + 256 * j + 4 * lane);
#pragma unroll 1
        for (int pass = 0; pass < 4; ++pass) { const int tb = ck * 64 + pass * 16;
#pragma unroll
            for (int q = 0; q < 2; ++q) { const int tt = 2 * v + q, t = tb + tt; f32x4 h[4]; float ss = 0.f;
#pragma unroll
                for (int j = 0; j < 4; ++j) { const u32x2 xw = xr[q][j]; h[j] = (f32x4){bf_lo(xw.x), bf_hi(xw.x), bf_lo(xw.y), bf_hi(xw.y)}; ss += (h[j][0] * h[j][0] + h[j][1] * h[j][1]) + (h[j][2] * h[j][2] + h[j][3] * h[j][3]); }
                const float rs = rsqrtf(wsum(ss) * (1.f / 1024.f) + 1e-6f);
#pragma unroll
                for (int j = 0; j < 4; ++j) { const int col = 256 * j + 4 * lane;
                    const f32x4 hv = h[j] * rs * gn[j] + shv[j];
                    *(unsigned*)(HN8 + (size_t)t * 1024 + col) = pk4_fp8(hv[0], hv[1], hv[2], hv[3]);
                    *(LAS f32x4*)(hrow + tt * HROW + col) = hv; } }
            if (pass < 3) {
#pragma unroll
                for (int q = 0; q < 2; ++q)
#pragma unroll
                    for (int j = 0; j < 4; ++j) xr[q][j] = *(const u32x2*)(X + (size_t)(tb + 16 + 2 * v + q) * 1024 + 256 * j + 4 * lane); }
            __syncthreads();
            { f32x4 acc0 = (f32x4){0.f, 0.f, 0.f, 0.f}, acc1 = acc0;
#pragma unroll
              for (int ks = 0; ks < 4; ++ks) { const LAS float* hp = hrow + l15 * HROW + 128 * v + 32 * ks + 8 * kg; bf16x8 ahi, alo; split_bf16(*(const LAS f32x4*)hp, *(const LAS f32x4*)(hp + 4), ahi, alo);
                  acc0 = __builtin_amdgcn_mfma_f32_16x16x32_bf16(ahi, whi[0][ks], acc0, 0, 0, 0); acc1 = __builtin_amdgcn_mfma_f32_16x16x32_bf16(ahi, whi[1][ks], acc1, 0, 0, 0);
                  acc0 = __builtin_amdgcn_mfma_f32_16x16x32_bf16(ahi, wlo[0][ks], acc0, 0, 0, 0); acc1 = __builtin_amdgcn_mfma_f32_16x16x32_bf16(ahi, wlo[1][ks], acc1, 0, 0, 0);
                  acc0 = __builtin_amdgcn_mfma_f32_16x16x32_bf16(alo, whi[0][ks], acc0, 0, 0, 0); acc1 = __builtin_amdgcn_mfma_f32_16x16x32_bf16(alo, whi[1][ks], acc1, 0, 0, 0); }
#pragma unroll
              for (int r = 0; r < 4; ++r) { part[((4 * kg + r) * 8 + v) * 32 + l15] = acc0[r]; part[((4 * kg + r) * 8 + v) * 32 + 16 + l15] = acc1[r]; } }
            __syncthreads();
            { const int tt = 2 * v + kh; float lg = bias_e;
#pragma unroll
              for (int w8 = 0; w8 < 8; ++w8) lg += part[(tt * 8 + w8) * 32 + e];
              int idx[4]; float val[4];
#pragma unroll
              for (int k = 0; k < 4; ++k) { float mx = lg;
                  mx = fmaxf(mx, shx<1>(mx)); mx = fmaxf(mx, shx<2>(mx)); mx = fmaxf(mx, shx<4>(mx)); mx = fmaxf(mx, shx<8>(mx)); mx = fmaxf(mx, shx<16>(mx));
                  const unsigned long long bal = __ballot(lg == mx); const unsigned bh = (unsigned)(bal >> (32 * kh)); const int sel = __ffs((int)bh) - 1;
                  idx[k] = sel; val[k] = mx; if (e == sel) lg = -INFINITY; }
              if (e == 0) { const int t = tb + tt; float ex[4], den = 0.f;
#pragma unroll
                  for (int k = 0; k < 4; ++k) { ex[k] = expf(val[k] - val[0]); den += ex[k]; }
#pragma unroll
                  for (int k = 0; k < 4; ++k) { topi[t * 4 + k] = idx[k]; topg[t * 4 + k] = ex[k] / den; __hip_atomic_fetch_add(hl + idx[k], 1, __ATOMIC_RELAXED, __HIP_MEMORY_SCOPE_WORKGROUP); } } }
        }
        __syncthreads();
        if (C.tid < 32) { hist[ck * 32 + C.tid] = hl[C.tid]; hl[C.tid] = 0; }
        __syncthreads();
    }
}
__device__ __forceinline__ void moe_plan_lds(const Ctx& C) {
    const int* hist = (const int*)(C.ws + O_HIST);
    LAS int* tot = (LAS int*)(C.lds + LX_MISC + 256); LAS int* pst = tot + 32; LAS int* tile_e = (LAS int*)(C.lds + LX_TILE); LAS int* ntp = (LAS int*)(C.lds + LX_MISC + 128); LAS int* part = (LAS int*)(C.lds + LX_MISC + 1024);
    __syncthreads();
    { const int e = C.tid & 31, g = C.tid >> 5; int sacc = 0;
#pragma unroll
      for (int i = 0; i < 16; ++i) sacc += hist[(g * 16 + i) * 32 + e];
      part[g * 32 + e] = sacc; }
    __syncthreads();
    if (C.tid < 32) { int sacc = 0;
#pragma unroll
        for (int g = 0; g < 16; ++g) sacc += part[g * 32 + C.tid];
        tot[C.tid] = sacc; }
    __syncthreads();
    if (C.tid == 0) { int acc = 0, ti = 0; for (int e = 0; e < 32; ++e) { pst[e] = acc; const int nt = (tot[e] + 255) >> 8; for (int i = 0; i < nt; ++i) tile_e[ti++] = e; acc += nt << 8; } ntp[0] = ti; }
    __syncthreads();
}
__device__ __forceinline__ void phase_scatter(const Ctx& C) {
    const int* hist = (const int*)(C.ws + O_HIST); const int* topi = (const int*)(C.ws + O_TOPI); int* pos = (int*)(C.ws + O_POS);
    const unsigned char* HN8 = C.ws + O_HN; unsigned char* XG8 = C.ws + O_XG;
    moe_plan_lds(C);
    LAS int* pst = (LAS int*)(C.lds + LX_MISC + 384); LAS int* base = (LAS int*)(C.lds + LX_MISC + 512); LAS int* part = (LAS int*)(C.lds + LX_MISC + 1024); LAS int* pl = (LAS int*)C.lds;
    for (int ck = C.bid; ck < 256; ck += C.G) {
        if (C.tid < 32) { int sacc = pst[C.tid]; const int g = ck >> 4; for (int g2 = 0; g2 < g; ++g2) sacc += part[g2 * 32 + C.tid]; for (int c2 = g * 16; c2 < ck; ++c2) sacc += hist[c2 * 32 + C.tid]; base[C.tid] = sacc; }
        __syncthreads();
        if (C.wave == 0) { int cnt[32];
#pragma unroll
            for (int e = 0; e < 32; ++e) cnt[e] = 0;
#pragma unroll 1
            for (int g = 0; g < 4; ++g) { const int my = topi[ck * 256 + g * 64 + C.lane]; int rank = 0;
#pragma unroll
                for (int e = 0; e < 32; ++e) { const unsigned long long m = __ballot(my == e);
                    const int below = (int)__builtin_amdgcn_mbcnt_hi((unsigned)(m >> 32), __builtin_amdgcn_mbcnt_lo((unsigned)m, 0u));
                    if (my == e) rank = cnt[e] + below; cnt[e] += __popcll(m); }
                const int p = base[my] + rank; pl[g * 64 + C.lane] = p; pos[ck * 256 + g * 64 + C.lane] = p; } }
        __syncthreads();
#pragma unroll 8
        for (int i = 0; i < 32; ++i) { const int pr = C.wave + 8 * i; const int t = ck * 64 + (pr >> 2); const int p = pl[pr];
            *(u32x4*)(XG8 + (size_t)p * 1024 + 16 * C.lane) = *(const u32x4*)(HN8 + (size_t)t * 1024 + 16 * C.lane); }
        __syncthreads();
    }
}
#ifndef ATT_DUP
#define ATT_DUP 1
#endif

__device__ __forceinline__ s16x4 tr16(LAS const unsigned char* p) { typedef short v4i16_t __attribute__((ext_vector_type(4))); return __builtin_bit_cast(s16x4, __builtin_amdgcn_ds_read_tr16_b64_v4i16((LAS v4i16_t*)p)); }

__device__ __forceinline__ float max3f(float a, float b, float c) { return fmaxf(fmaxf(a, b), c); }
#ifndef ATT_THR_V
#define ATT_THR_V 10.f
#endif
constexpr float ATT_THR = ATT_THR_V;
template <int KS, bool DIL>
__device__ __forceinline__ void att_tile(LAS const unsigned char* kb, LAS const unsigned char* vb, const bf16x8 (&qf)[KS], f32x16& o0, f32x16& o1, f32x16& negm, float& mref, float& l, int kidx0, int qidx, bool need_mask, int lane) {
    constexpr int KROW = KS * 32 + 16, VROW = 144;
    const int i32 = lane & 31, hi = lane >> 5;
    const int pr = (i32 & 0x13) | ((i32 & 4) << 1) | ((i32 & 8) >> 1);
    f32x16 p0, p1;
    LAS const unsigned char* kp = kb + pr * KROW + hi * 16;
#ifndef QK_DUP
#define QK_DUP 1
#endif
#pragma unroll 1
    for (int qd_ = 0; qd_ < QK_DUP; ++qd_) {
#pragma unroll
    for (int ks = 0; ks < KS; ++ks) {
        const bf16x8 k0f = *(LAS const bf16x8*)(kp + ks * 32), k1f = *(LAS const bf16x8*)(kp + 32 * KROW + ks * 32);
        if (ks == 0) { p0 = __builtin_amdgcn_mfma_f32_32x32x16_bf16(k0f, qf[0], negm, 0, 0, 0); p1 = __builtin_amdgcn_mfma_f32_32x32x16_bf16(k1f, qf[0], negm, 0, 0, 0); }
        else { p0 = __builtin_amdgcn_mfma_f32_32x32x16_bf16(k0f, qf[ks], p0, 0, 0, 0); p1 = __builtin_amdgcn_mfma_f32_32x32x16_bf16(k1f, qf[ks], p1, 0, 0, 0); }
    }
    asm volatile("" : "+v"(p0), "+v"(p1));
    }
    if (need_mask) {
#pragma unroll
        for (int r = 0; r < 16; ++r) { const int d0 = qidx - (kidx0 + 16 * (r >> 3) + 8 * hi + (r & 7)), d1 = d0 - 32;
            const bool v0 = DIL ? (d0 >= 0 && d0 <= 128) : (d0 >= 0), v1 = DIL ? (d1 >= 0 && d1 <= 128) : (d1 >= 0);
            p0[r] = v0 ? p0[r] : -INFINITY; p1[r] = v1 ? p1[r] : -INFINITY; } }
    float mx = max3f(p0[0], p0[1], p1[0]), mb = max3f(p0[2], p0[3], p1[1]); mx = max3f(mx, p1[2], p1[3]);
#pragma unroll
    for (int r = 4; r < 16; r += 4) { mx = max3f(mx, p0[r], p0[r + 1]); mb = max3f(mb, p0[r + 2], p0[r + 3]); mx = max3f(mx, p1[r], p1[r + 1]); mb = max3f(mb, p1[r + 2], p1[r + 3]); }
    mx = xmax32(fmaxf(mx, mb));
    if (__builtin_expect(__any(mx > ATT_THR), 0)) {
        const float dl = fmaxf(mx, 0.f), f = fexp2(-dl);
        mref += dl; l *= f;
#pragma unroll
        for (int r = 0; r < 16; ++r) { o0[r] *= f; o1[r] *= f; p0[r] -= dl; p1[r] -= dl; negm[r] = -mref; } }
    float ls0 = 0.f, ls1 = 0.f;
#pragma unroll
    for (int r = 0; r < 16; ++r) { p0[r] = fexp2(p0[r]); p1[r] = fexp2(p1[r]); ls0 += p0[r]; ls1 += p1[r]; }
    l += ls0 + ls1;
    u32x4 pw[2][2];
#pragma unroll
    for (int s = 0; s < 2; ++s) {
        pw[0][s].x = cvt_pk_bf16(p0[8 * s + 0], p0[8 * s + 1]); pw[0][s].y = cvt_pk_bf16(p0[8 * s + 2], p0[8 * s + 3]); pw[0][s].z = cvt_pk_bf16(p0[8 * s + 4], p0[8 * s + 5]); pw[0][s].w = cvt_pk_bf16(p0[8 * s + 6], p0[8 * s + 7]);
        pw[1][s].x = cvt_pk_bf16(p1[8 * s + 0], p1[8 * s + 1]); pw[1][s].y = cvt_pk_bf16(p1[8 * s + 2], p1[8 * s + 3]); pw[1][s].z = cvt_pk_bf16(p1[8 * s + 4], p1[8 * s + 5]); pw[1][s].w = cvt_pk_bf16(p1[8 * s + 6], p1[8 * s + 7]); }
    const int g = lane >> 4, i16 = lane & 15;
    LAS const unsigned char* vp = vb + (8 * (g >> 1) + (i16 >> 2)) * VROW + (16 * (g & 1) + 4 * (i16 & 3)) * 2;
#pragma unroll
    for (int sub = 0; sub < 2; ++sub)
#pragma unroll
        for (int s = 0; s < 2; ++s) { const bf16x8 pf = __builtin_bit_cast(bf16x8, pw[sub][s]);
#pragma unroll
            for (int db = 0; db < 2; ++db) { LAS const unsigned char* av = vp + (32 * sub + 16 * s) * VROW + 64 * db;
                const s16x4 lo = tr16(av), hh = tr16(av + 4 * VROW);
                const bf16x8 vf = (bf16x8){lo[0], lo[1], lo[2], lo[3], hh[0], hh[1], hh[2], hh[3]};
                if (db == 0) o0 = __builtin_amdgcn_mfma_f32_32x32x16_bf16(vf, pf, o0, 0, 0, 0); else o1 = __builtin_amdgcn_mfma_f32_32x32x16_bf16(vf, pf, o1, 0, 0, 0); } }
}
__device__ __forceinline__ void att_store(bf16_t* orow  , const f32x16& o0, const f32x16& o1, float inv, int hi) {
#pragma unroll
    for (int rr = 0; rr < 4; ++rr) { u32x2 w0, w1;
        w0.x = cvt_pk_bf16(o0[4 * rr] * inv, o0[4 * rr + 1] * inv); w0.y = cvt_pk_bf16(o0[4 * rr + 2] * inv, o0[4 * rr + 3] * inv);
        w1.x = cvt_pk_bf16(o1[4 * rr] * inv, o1[4 * rr + 1] * inv); w1.y = cvt_pk_bf16(o1[4 * rr + 2] * inv, o1[4 * rr + 3] * inv);
        *(u32x2*)(orow + 8 * rr + 4 * hi) = w0; *(u32x2*)(orow + 32 + 8 * rr + 4 * hi) = w1; }
}


struct BgConv {
    const float* w1; const float* w2; unsigned char* ws; LAS unsigned char* T;
    int pair, it, nit, step, sub;
    bool pendA, pendB; int psubA, psubB; unsigned char* pWTA; unsigned char* pWTB;
    f32x4 vA[4], vB[4];
};
__device__ __forceinline__ void bg_tile(const BgConv& S, int it, const float*& W, int& N, unsigned char*& WT, int& n0, int& k0) {
    constexpr int I1 = 32 * 8, I2 = 16 * 8, N1 = 64 * I1;
    if (it < N1) { const int mat = S.pair * 64 + it / I1, q = it % I1; W = S.w1 + (size_t)mat * 1024 * 2048; WT = S.ws + O_W1 + (size_t)mat * SZ_W1E; N = 2048; n0 = (q >> 3) * 64; k0 = (q & 7) * 128; }
    else { const int r = it - N1, mat = S.pair * 64 + r / I2, q = r % I2; W = S.w2 + (size_t)mat * 1024 * 1024; WT = S.ws + O_W2 + (size_t)mat * SZ_W2E; N = 1024; n0 = (q >> 3) * 64; k0 = (q & 7) * 128; }
}
__device__ __forceinline__ void bg_init(BgConv& S, const Ctx& C, const float* w1, const float* w2, int pair) {
    S.w1 = w1; S.w2 = w2; S.ws = C.ws; S.T = C.lds + 49152 + C.wave * 9216; S.pair = pair; S.it = C.gw; S.nit = 64 * 256 + 64 * 128; S.step = C.NGW; S.sub = 0;
    S.pendA = false; S.pendB = false; S.psubA = 0; S.psubB = 0; S.pWTA = C.ws; S.pWTB = C.ws;
}
__device__ __forceinline__ bool bg_done(const BgConv& S) { return !S.pendA && !S.pendB && S.it >= S.nit; }
__device__ __forceinline__ void bg_half(BgConv& S, f32x4 (&v)[4], bool& pend, int& psub, unsigned char*& pWT, int lane) {
    const int kq = lane >> 4, c4 = lane & 15;
    if (pend) {
#pragma unroll
        for (int jj = 0; jj < 4; ++jj) *(LAS unsigned*)(S.T + (4 * c4 + jj) * 144 + 32 * kq + 4 * psub) = pk4_fp8(32.f * v[0][jj], 32.f * v[1][jj], 32.f * v[2][jj], 32.f * v[3][jj]);
        if (psub == 7) {
            asm volatile("s_waitcnt lgkmcnt(0)" ::: "memory");
#pragma unroll
            for (int s8 = 0; s8 < 8; ++s8) { const int n = 8 * s8 + (lane >> 3), ch = lane & 7; const u32x4 w = *(const LAS u32x4*)(S.T + n * 144 + 16 * ch);
                *(u32x4*)(pWT + (size_t)n * 1024 + 16 * ch) = w; }
            asm volatile("s_waitcnt lgkmcnt(0)" ::: "memory"); }
        pend = false; }
    if (S.it < S.nit) { const float* W; int N, n0, k0; unsigned char* WT; bg_tile(S, S.it, W, N, WT, n0, k0);
        const float* p = W + (size_t)(k0 + 32 * kq + 4 * S.sub) * N + n0 + 4 * c4;
#pragma unroll
        for (int i = 0; i < 4; ++i) v[i] = __builtin_nontemporal_load((const f32x4*)(p + (size_t)i * N));
        pend = true; psub = S.sub; pWT = WT + (size_t)n0 * 1024 + k0;
        if (++S.sub == 8) { S.sub = 0; S.it += S.step; } }
}
#define BG_STEP_A() bg_half(BG, BG.vA, BG.pendA, BG.psubA, BG.pWTA, lane)
#define BG_STEP_B() bg_half(BG, BG.vB, BG.pendB, BG.psubB, BG.pWTB, lane)

__device__ __forceinline__ void mla_unit(const Ctx& C, BgConv& BG, int b, int h, int qb) {
    constexpr int KROW = 208, VROW = 144, KB = 64 * KROW, BUF = KB + 64 * VROW;
    const bf16_t* Q2 = (const bf16_t*)(C.ws + O_Q2); const bf16_t* KV2 = (const bf16_t*)(C.ws + O_KV2); const bf16_t* PROJ = (const bf16_t*)(C.ws + O_PROJ); bf16_t* ATT = (bf16_t*)(C.ws + O_ATT);
    const int tid = C.tid, lane = C.lane, w = C.wave, i32 = lane & 31, hi = lane >> 5;
    const int q0 = qb * 256; const size_t rowb = (size_t)b * S_;
    bf16x8 qf[6];
    { const bf16_t* qrow = Q2 + (rowb + q0 + 32 * w + i32) * 768 + 8 * hi;
#pragma unroll
      for (int ks = 0; ks < 4; ++ks) qf[ks] = *(const bf16x8*)(qrow + h * 64 + 16 * ks);
      qf[4] = *(const bf16x8*)(qrow + 512 + h * 32); qf[5] = *(const bf16x8*)(qrow + 512 + h * 32 + 16); }
    f32x16 o0, o1;
#pragma unroll
    for (int r = 0; r < 16; ++r) { o0[r] = 0.f; o1[r] = 0.f; }
    float m = 0.f, l = 0.f; f32x16 negm;
#pragma unroll
    for (int r = 0; r < 16; ++r) negm[r] = 0.f;
    const int NT = 4 * qb + 4, wmax = 4 * qb + (w >> 1);
    const int r8 = tid >> 3, c8 = tid & 7, r4 = (tid & 255) >> 2, c4 = tid & 3;
    const bf16_t* knp = KV2 + (rowb + r8) * 1024 + h * 64 + 8 * c8; const bf16_t* kpp = PROJ + (rowb + r4) * 2048 + 1920 + 8 * c4;
    u32x4 kA, vA, pA, kB, vB, pB;
#define MLA_LOAD(j, K, V, P) do { const int jc_ = ((j) < NT) ? (j) : NT - 1; K = *(const u32x4*)(knp + (size_t)jc_ * 64 * 1024); V = *(const u32x4*)(knp + (size_t)jc_ * 64 * 1024 + 512); P = *(const u32x4*)(kpp + (size_t)jc_ * 64 * 2048); } while (0)
#define MLA_WRITE(bo, K, V, P) do { *(LAS u32x4*)(C.lds + (bo) + r8 * KROW + 16 * c8) = K; *(LAS u32x4*)(C.lds + (bo) + KB + r8 * VROW + 16 * c8) = V; *(LAS u32x4*)(C.lds + (bo) + r4 * KROW + 128 + 16 * c4) = P; } while (0)
#define MLA_STEP(j, KF, VF, PF, KN, VN, PN, BGS) do { const int j_ = (j); const int bo_ = (j_ & 1) * BUF; \
        MLA_LOAD(j_ + 2, KF, VF, PF); BGS(); \
        if (j_ <= wmax) { _Pragma("unroll 1") for (int dup_ = 0; dup_ < ATT_DUP; ++dup_) att_tile<6, false>(C.lds + bo_, C.lds + bo_ + KB, qf, o0, o1, negm, m, l, 64 * j_, q0 + 32 * w + i32, j_ == wmax, lane); } \
        MLA_WRITE(BUF - bo_, KN, VN, PN); \
        __syncthreads(); } while (0)
    MLA_LOAD(0, kA, vA, pA); MLA_LOAD(1, kB, vB, pB);
    MLA_WRITE(0, kA, vA, pA);
    __syncthreads();
#pragma unroll 1
    for (int j = 0; j < NT; j += 2) { MLA_STEP(j, kA, vA, pA, kB, vB, pB, BG_STEP_A); MLA_STEP(j + 1, kB, vB, pB, kA, vA, pA, BG_STEP_B); }
#undef MLA_STEP
#undef MLA_LOAD
#undef MLA_WRITE
    l = xadd32(l);
    att_store(ATT + (rowb + q0 + 32 * w + i32) * 1024 + 512 + h * 64, o0, o1, 1.f / l, hi);
}
__device__ __forceinline__ void dil_unit(const Ctx& C, BgConv& BG, int p, int dd, int b, int h, int res, int n) {
    constexpr int KROW = 144, VROW = 144, KB = 64 * KROW, BUF = KB + 64 * VROW;
    const bf16_t* PROJ = (const bf16_t*)(C.ws + O_PROJ); bf16_t* OA = (bf16_t*)(C.ws + O_OA) + (size_t)p * T_ * 512; float* LSE = (float*)(C.ws + O_LSE) + (size_t)p * T_ * 8;
    const int tid = C.tid, lane = C.lane, w = C.wave, i32 = lane & 31, hi = lane >> 5;
    const size_t rowb = (size_t)b * S_;
    const int qsub = 256 * n + 32 * w + i32; const size_t qtok = rowb + (size_t)qsub * dd + res;
    bf16x8 qf[4];
    { const bf16_t* qrow = PROJ + qtok * 2048 + h * 64 + 8 * hi;
#pragma unroll
      for (int ks = 0; ks < 4; ++ks) qf[ks] = *(const bf16x8*)(qrow + 16 * ks); }
    f32x16 o0, o1;
#pragma unroll
    for (int r = 0; r < 16; ++r) { o0[r] = 0.f; o1[r] = 0.f; }
    float m = 0.f, l = 0.f; f32x16 negm;
#pragma unroll
    for (int r = 0; r < 16; ++r) negm[r] = 0.f;
    const int jbeg = (n == 0) ? 2 : 0, wlo = w >> 1, whi = (32 * w + 159) >> 6;
    const int r8 = tid >> 3, c8 = tid & 7;
    u32x4 kA, vA, kB, vB;
    const int cnt = 6 - jbeg;
#define DIL_LOAD(i, K, V) do { const int jc_ = jbeg + (((i) < cnt) ? (i) : cnt - 1); const size_t tok = rowb + (size_t)(256 * n - 128 + 64 * jc_ + r8) * dd + res; const bf16_t* src = PROJ + tok * 2048 + 512 + h * 64 + 8 * c8; K = *(const u32x4*)src; V = *(const u32x4*)(src + 512); } while (0)
#define DIL_WRITE(bo, K, V) do { *(LAS u32x4*)(C.lds + (bo) + r8 * KROW + 16 * c8) = K; *(LAS u32x4*)(C.lds + (bo) + KB + r8 * VROW + 16 * c8) = V; } while (0)
#define DIL_STEP(i, KF, VF, KN, VN, BGS) do { const int i_ = (i); const int bo_ = (i_ & 1) * BUF, j_ = jbeg + i_; \
        DIL_LOAD(i_ + 2, KF, VF); BGS(); \
        if (i_ < cnt && j_ >= wlo && j_ <= whi) { const int kb0_ = 256 * n - 128 + 64 * j_, qlo_ = 256 * n + 32 * w; _Pragma("unroll 1") for (int dup_ = 0; dup_ < ATT_DUP; ++dup_) att_tile<4, true>(C.lds + bo_, C.lds + bo_ + KB, qf, o0, o1, negm, m, l, kb0_, qsub, !(kb0_ + 63 <= qlo_ && qlo_ + 31 - kb0_ <= 128), lane); } \
        DIL_WRITE(BUF - bo_, KN, VN); \
        __syncthreads(); } while (0)
    DIL_LOAD(0, kA, vA); DIL_LOAD(1, kB, vB);
    DIL_WRITE(0, kA, vA);
    __syncthreads();
    DIL_STEP(0, kA, vA, kB, vB, BG_STEP_A); DIL_STEP(1, kB, vB, kA, vA, BG_STEP_B); DIL_STEP(2, kA, vA, kB, vB, BG_STEP_A); DIL_STEP(3, kB, vB, kA, vA, BG_STEP_B);
    if (cnt == 6) { DIL_STEP(4, kA, vA, kB, vB, BG_STEP_A); DIL_STEP(5, kB, vB, kA, vA, BG_STEP_B); }
#undef DIL_STEP
#undef DIL_LOAD
#undef DIL_WRITE
    l = xadd32(l);
    att_store(OA + qtok * 512 + h * 64, o0, o1, 1.f / l, hi);
    if (hi == 0) LSE[qtok * 8 + h] = m + log2f(l);
}
#ifndef REP_MLA
#define REP_MLA 1
#endif
#ifndef REP_DIL
#define REP_DIL 1
#endif
__device__ __forceinline__ void phase_attention(const Ctx& C, const float* w1, const float* w2, int pair) {
    BgConv BG; bg_init(BG, C, w1, w2, pair);
#pragma unroll 1
    for (int rep = 0; rep < REP_MLA; ++rep) {
    if (C.G == 256) { const int bh = C.vcu >> 3, s = C.vcu & 7; mla_unit(C, BG, bh >> 3, bh & 7, s); mla_unit(C, BG, bh >> 3, bh & 7, 15 - s); }
    else for (int u = C.bid; u < 512; u += C.G) mla_unit(C, BG, u >> 7, (u >> 4) & 7, u & 15);
    }
#pragma unroll 1
    for (int rep = 0; rep < REP_DIL; ++rep)
    for (int u = C.bid; u < 1536; u += C.G) { const int p = u >> 9, rem = u & 511, b = rem >> 7, h = (rem >> 4) & 7, blk = rem & 15;
        const int dd = (p == 0) ? 1 : (p == 1) ? 4 : 16, bpr = 16 / dd;
        dil_unit(C, BG, p, dd, b, h, blk / bpr, blk % bpr); }
    { const int lane = C.lane;
#pragma unroll 1
      while (!bg_done(BG)) { BG_STEP_A(); BG_STEP_B(); } }
}
#undef BG_STEP_A
#undef BG_STEP_B

#ifdef TIME_NORM
constexpr int N_PHASES = 42;
#else
constexpr int N_PHASES = 40;
#endif
extern __shared__ __attribute__((aligned(16))) unsigned char lds_raw[];
typedef const __attribute__((address_space(4))) Args* ArgsP;
#define PHFN static __device__ __forceinline__ void
__device__ __forceinline__ ArgsP fresh_args() { unsigned long long p = (unsigned long long)__builtin_amdgcn_kernarg_segment_ptr(); asm volatile("" : "+s"(p)); return (ArgsP)p; }
__device__ __forceinline__ Ctx make_ctx(ArgsP ap, int wv) {
    Ctx C; C.lds = (LAS unsigned char*)lds_raw; C.ws = ap->ws;
    unsigned ones = ~0u; asm volatile("" : "+s"(ones)); const int lane = (int)__builtin_amdgcn_mbcnt_hi(ones, __builtin_amdgcn_mbcnt_lo(ones, 0u));
    int bid = blockIdx.x; asm volatile("" : "+s"(bid)); int G = gridDim.x; asm volatile("" : "+s"(G));
    C.wave = wv; C.lane = lane; C.tid = wv * 64 + lane;
    C.G = G; C.bid = bid; C.vcu = (C.G % 8 == 0) ? (C.bid % 8) * (C.G / 8) + C.bid / 8 : C.bid;
    C.gw = C.bid * 8 + C.wave; C.NGW = C.G * 8; return C;
}
#define IN(i) ((const float*)ap->in[i])
#define MODL(l) ((const float*)(C.ws + O_MOD) + (size_t)(l) * 4 * 6144)
PHFN ph_prologue(int wv) { const ArgsP ap = fresh_args(); const Ctx C = make_ctx(ap, wv); p0_prologue(C, ap); }
PHFN ph_norm(int wv, int l, int mode) { const ArgsP ap = fresh_args(); const Ctx C = make_ctx(ap, wv);
    if (mode == 0) phase_norm(C, IN(0), nullptr, false, true, IN(5), MODL(0), MODL(0), 0, 1024);
    else if (mode == 1) phase_norm(C, nullptr, nullptr, true, true, IN(5) + l * 1024, MODL(l - 1), MODL(l), 0, 1024);
    else if (mode == 3) phase_norm(C, nullptr, nullptr, true, true, IN(5) + l * 1024, MODL(l - 1), MODL(l), 0, 1024, true);
    else phase_norm(C, nullptr, ap->out, true, false, IN(5), MODL(3), MODL(3), 0, 1024); }
PHFN ph_proj(int wv, int j) { const ArgsP ap = fresh_args(); const Ctx C = make_ctx(ap, wv); unsigned char* ws = C.ws;
    DenseOrder S; S.init(ws + O_HN, ws + O_WIN + j * SZ_WIN, 1024, 1024, T_, 2048, C.G, C.bid); EpiNorm<0> E{(bf16_t*)(ws + O_PROJ), 2048, IN(8) + j * 64, IN(9) + j * 64, IN(10) + j * 256, IN(11) + j * 128, IN(15) + j * 96 + 64, (const float*)(ws + O_CS), (LAS float*)(C.lds + LX_EXCH)}; gemm_phase(C, GemmDims{1024, 1024, 1024}, S, E); }
PHFN ph_postproj(int wv, int j) { const ArgsP ap = fresh_args(); const Ctx C = make_ctx(ap, wv); phase_postproj(C, IN(8) + j * 64, IN(9) + j * 64, IN(10) + j * 256, IN(11) + j * 128, IN(15) + j * 96); }
PHFN ph_qkv(int wv, int j) { const ArgsP ap = fresh_args(); const Ctx C = make_ctx(ap, wv); unsigned char* ws = C.ws;
    { DenseOrder S; S.init(ws + O_PROJ + 1536 * 2, ws + O_WUQ + j * SZ_WUQ, 2048, 256, T_, 768, C.G, C.bid); EpiNorm<1> E{(bf16_t*)(ws + O_Q2), 768, IN(14) + j * 96, IN(14) + j * 96 + 64, nullptr, nullptr, nullptr, (const float*)(ws + O_CS), (LAS float*)(C.lds + LX_EXCH)}; gemm_phase(C, GemmDims{256, 2048, 256}, S, E); }
    { const ArgsP ap2 = fresh_args(); const Ctx C = make_ctx(ap2, wv); unsigned char* ws = C.ws; DenseOrder S; S.init(ws + O_PROJ + 1792 * 2, ws + O_WUKV + j * SZ_WUKV, 2048, 128, T_, 1024, C.G, C.bid); EpiNorm<2> E{(bf16_t*)(ws + O_KV2), 1024, IN(15) + j * 96, nullptr, nullptr, nullptr, nullptr, (const float*)(ws + O_CS), (LAS float*)(C.lds + LX_EXCH)}; gemm_phase(C, GemmDims{128, 2048, 128}, S, E); } }
PHFN ph_postq(int wv, int j) { const ArgsP ap = fresh_args(); const Ctx C = make_ctx(ap, wv); phase_postq(C, IN(14) + j * 96, IN(15) + j * 96); }
PHFN ph_attention(int wv, int pair) { const ArgsP ap = fresh_args(); const Ctx C = make_ctx(ap, wv); phase_attention(C, IN(30), IN(32), pair); }
PHFN ph_mixcombine(int wv) { const ArgsP ap = fresh_args(); const Ctx C = make_ctx(ap, wv); phase_mixcombine(C); }
PHFN ph_outproj(int wv, int l, int which) { const ArgsP ap = fresh_args(); const Ctx C = make_ctx(ap, wv); unsigned char* ws = C.ws; const int j = l >> 1;
    DenseOrder S; S.init(ws + O_ATT, ws + (which ? O_RWOUT + j * SZ_RWOUT : O_WOUT + j * SZ_WOUT), 1024, 1024, T_, 1024, C.G, C.bid);
    EpiResid E{(bf16_t*)(ws + O_X), MODL(l) + 2048, which ? IN(27) + j * 1024 : nullptr}; gemm_phase(C, GemmDims{1024, 1024, 1024}, S, E); }
PHFN ph_router(int wv, int l) { const ArgsP ap = fresh_args(); const Ctx C = make_ctx(ap, wv); phase_router(C, (const bf16_t*)(C.ws + O_X), IN(6) + l * 1024, MODL(l), IN(28) + (size_t)l * 1024 * 32, IN(29) + l * 32); }
PHFN ph_scatter(int wv) { const ArgsP ap = fresh_args(); const Ctx C = make_ctx(ap, wv); phase_scatter(C); }
PHFN ph_moe1(int wv, int l) { const ArgsP ap = fresh_args(); const Ctx C = make_ctx(ap, wv); unsigned char* ws = C.ws; moe_plan_lds(C);
    MoeOrder S; S.A = (const char*)(ws + O_XG); S.WT = (const char*)(ws + O_W1 + (size_t)l * 32 * SZ_W1E); S.estride = SZ_W1E; S.tile_e = (const LAS int*)(C.lds + LX_TILE);
    S.NT = *(const LAS int*)(C.lds + LX_MISC + 128); S.nN = 8; S.G = C.G; S.c = C.bid; S.esz = 1;
    EpiSwiglu E{(unsigned char*)(ws + O_ACT), IN(31) + (size_t)l * 32 * 2048, 1.f / 32.f}; gemm_phase<true>(C, GemmDims{1024, 1024, 1024}, S, E); }
PHFN ph_moe2(int wv, int l) { const ArgsP ap = fresh_args(); const Ctx C = make_ctx(ap, wv); unsigned char* ws = C.ws; moe_plan_lds(C);
    MoeOrder S; S.A = (const char*)(ws + O_ACT); S.WT = (const char*)(ws + O_W2 + (size_t)l * 32 * SZ_W2E); S.estride = SZ_W2E; S.tile_e = (const LAS int*)(C.lds + LX_TILE);
    S.NT = *(const LAS int*)(C.lds + LX_MISC + 128); S.nN = 4; S.G = C.G; S.c = C.bid; S.esz = 1;
    EpiBf16 E{(bf16_t*)(ws + O_Y2), IN(33) + (size_t)l * 32 * 1024, 1024, 1024, 1.f / 32.f}; gemm_phase<true>(C, GemmDims{1024, 1024, 1024}, S, E); }
PHFN ph_recin(int wv, int j) { const ArgsP ap = fresh_args(); const Ctx C = make_ctx(ap, wv); unsigned char* ws = C.ws;
    DenseOrder S; S.init(ws + O_HN, ws + O_RWIN + j * SZ_RWIN, 1024, 1024, T_, 2048, C.G, C.bid); EpiRecIn E{(bf16_t*)(ws + O_PROJ), IN(18) + j * 2048}; gemm_phase(C, GemmDims{1024, 1024, 1024}, S, E); }
PHFN ph_rgate(int wv, int j) { const ArgsP ap = fresh_args(); const Ctx C = make_ctx(ap, wv); phase_rgate(C, j, IN(19) + j * 4096, IN(20) + j * 1024, IN(22) + j * 1024, IN(24) + j * 1024); }
PHFN ph_scan_apply(int wv) { const ArgsP ap = fresh_args(); const Ctx C = make_ctx(ap, wv); phase_scan_apply(C); }

#if MODE == 1
__device__ __forceinline__ int fresh_tid(int wv) { unsigned ones = ~0u; asm volatile("" : "+s"(ones)); return wv * 64 + (int)__builtin_amdgcn_mbcnt_hi(ones, __builtin_amdgcn_mbcnt_lo(ones, 0u)); }
__device__ __forceinline__ void grid_barrier(int wv) { const ArgsP q = fresh_args(); XcdBarrier b; b.bar = (unsigned*)(q->ws + O_CTL) + CW_BAR; b.x = xb_xcc_id(); b.st = (volatile LAS unsigned*)((LAS unsigned char*)lds_raw + LDSX_OFF); xcd_barrier(b, fresh_tid(wv)); }
__global__ void __launch_bounds__(512, 2) mk_fwd(Args a) {
    int wv = __builtin_amdgcn_readfirstlane(threadIdx.x >> 6); asm volatile("" : "+s"(wv));
    { LAS unsigned char* lds = (LAS unsigned char*)lds_raw;
      for (int u = threadIdx.x; u < (LDS_BYTES - LDSX_OFF) / 4; u += 512) ((LAS unsigned*)(lds + LDSX_OFF))[u] = 0u;
      __syncthreads();
      if (a.ph_hi - a.ph_lo > 1) (void)xcd_barrier_post((unsigned*)(a.ws + O_CTL) + CW_BAR, (volatile LAS unsigned*)(lds + LDSX_OFF), (int)threadIdx.x); }
    int pid = 0;
#define PHASE(call) { const ArgsP q_ = fresh_args(); const int lo_ = q_->ph_lo, hi_ = q_->ph_hi; if (pid >= lo_ && pid < hi_) { call; if (pid + 1 < hi_) grid_barrier(wv); } ++pid; }
#define PHASE_R(call, REP) { const ArgsP q_ = fresh_args(); const int lo_ = q_->ph_lo, hi_ = q_->ph_hi; if (pid >= lo_ && pid < hi_) { if ((REP) > 1) { call; grid_barrier(wv); } call; if (pid + 1 < hi_) grid_barrier(wv); } ++pid; }
#ifndef REP_PROLOGUE
#define REP_PROLOGUE 1
#endif
#ifndef REP_MOE
#define REP_MOE 1
#endif
#ifndef REP_ATTN
#define REP_ATTN 1
#endif
#ifndef REP_GEMMS
#define REP_GEMMS 1
#endif
#ifdef TIME_NORM
#define NORM_EXTRA(l) PHASE(ph_norm(wv, l, 3))
#else
#define NORM_EXTRA(l)
#endif
#ifndef REP_ELEM
#define REP_ELEM 1
#endif
#ifndef REP_ROUTER
#define REP_ROUTER REP_ELEM
#endif
#ifndef REP_SCATTER
#define REP_SCATTER REP_ELEM
#endif
#ifndef REP_MIX
#define REP_MIX REP_ELEM
#endif
#ifndef REP_CONV
#define REP_CONV REP_ELEM
#endif
#ifndef REP_SCANA
#define REP_SCANA REP_ELEM
#endif
#define MOE_PHASES(l) PHASE_R(ph_router(wv, l), REP_ROUTER) PHASE_R(ph_scatter(wv), REP_SCATTER) PHASE_R(ph_moe1(wv, l), REP_MOE) PHASE_R(ph_moe2(wv, l), REP_MOE)
    PHASE_R(ph_prologue(wv), REP_PROLOGUE)
#define LAYER_PAIR(lp) \
        { const int l = 2 * (lp);         \
          PHASE(ph_norm(wv, l, (lp) == 0 ? 0 : 1)) PHASE_R(ph_proj(wv, lp), REP_GEMMS) PHASE_R(ph_qkv(wv, lp), REP_GEMMS) PHASE_R(ph_attention(wv, lp), REP_ATTN) PHASE_R(ph_mixcombine(wv), REP_MIX) PHASE(ph_outproj(wv, l, 0)) \
          MOE_PHASES(l) } \
        { const int l = 2 * (lp) + 1;     \
          NORM_EXTRA(l) PHASE(ph_norm(wv, l, 1)) PHASE_R(ph_recin(wv, lp), REP_GEMMS) PHASE_R(ph_rgate(wv, lp), REP_CONV) PHASE_R(ph_scan_apply(wv), REP_SCANA) PHASE(ph_outproj(wv, l, 1)) \
          MOE_PHASES(l) }
    LAYER_PAIR(0)
    LAYER_PAIR(1)
#undef LAYER_PAIR
#ifdef EXTRA_BARRIERS
    { const ArgsP q_ = fresh_args(); if (q_->ph_hi - q_->ph_lo > 1) { _Pragma("unroll 1") for (int xb = 0; xb < EXTRA_BARRIERS; ++xb) grid_barrier(wv); } }
#endif
    PHASE(ph_norm(wv, 3, 2))
#undef PHASE
#undef PHASE_R
#undef MOE_PHASES
}
#else
template <int PH> __global__ void __launch_bounds__(512, 2) k_phase(Args a, int l, int x) {
    int wv = __builtin_amdgcn_readfirstlane(threadIdx.x >> 6); asm volatile("" : "+s"(wv));
    LAS unsigned char* lds = (LAS unsigned char*)lds_raw;
    for (int u = threadIdx.x; u < (LDS_BYTES - LDSX_OFF) / 4; u += 512) ((LAS unsigned*)(lds + LDSX_OFF))[u] = 0u;
    __syncthreads();
    if constexpr (PH == 0) ph_prologue(wv);
    if constexpr (PH == 1) ph_norm(wv, l, x);
    if constexpr (PH == 2) ph_proj(wv, l);
    if constexpr (PH == 4) ph_qkv(wv, l);
    if constexpr (PH == 6) ph_attention(wv, l);
    if constexpr (PH == 7) ph_mixcombine(wv);
    if constexpr (PH == 8) ph_outproj(wv, l, x);
    if constexpr (PH == 9) ph_router(wv, l);
    if constexpr (PH == 10) ph_scatter(wv);
    if constexpr (PH == 11) ph_moe1(wv, l);
    if constexpr (PH == 12) ph_moe2(wv, l);
    if constexpr (PH == 13) ph_recin(wv, l);
    if constexpr (PH == 14) ph_rgate(wv, l);
    if constexpr (PH == 17) ph_scan_apply(wv);
}
#endif
#undef IN
#undef MODL
}

#ifndef MODE
#define MODE 2
#endif
extern "C" void kernel_launch(void* const* d_in, const int* in_sizes, int n_in, void* d_out, int out_size, void* d_ws, size_t ws_size, hipStream_t stream) {
    (void)in_sizes; (void)n_in; (void)out_size; (void)ws_size;
#if MODE == 0
    nv::forward(d_in, (float*)d_out, d_ws, stream);
#else
    static int grid = 0;
    if (grid == 0) {
        int dev = 0, cus = 0;
        (void)hipGetDevice(&dev); (void)hipDeviceGetAttribute(&cus, hipDeviceAttributeMultiprocessorCount, dev);
#if MODE == 1
        (void)hipFuncSetAttribute((const void*)mk::mk_fwd, hipFuncAttributeMaxDynamicSharedMemorySize, mk::LDS_BYTES);
#else
#define SA(PH) (void)hipFuncSetAttribute((const void*)mk::k_phase<PH>, hipFuncAttributeMaxDynamicSharedMemorySize, mk::LDS_BYTES)
        SA(0); SA(1); SA(2); SA(4); SA(6); SA(7); SA(8); SA(9); SA(10); SA(11); SA(12); SA(13); SA(14); SA(17);
#undef SA
#endif
        grid = cus > 0 ? cus : 256;
    }
    (void)hipMemsetAsync((char*)d_ws + mk::O_CTL, 0, mk::SZ_CTL, stream);
    mk::Args a;
    memset(&a, 0, sizeof(a));
    for (int i = 0; i < 34; ++i) a.in[i] = d_in[i];
    a.out = (float*)d_out; a.ws = (unsigned char*)d_ws;
#if MODE == 1
    a.ph_lo = 0; a.ph_hi = mk::N_PHASES;
    hipLaunchKernelGGL(mk::mk_fwd, dim3(grid), dim3(512), mk::LDS_BYTES, stream, a);
#else
#define LP(PH, l, x) hipLaunchKernelGGL(mk::k_phase<PH>, dim3(grid), dim3(512), mk::LDS_BYTES, stream, a, l, x)
    LP(0, 0, 0);
    for (int lp = 0; lp < 2; ++lp) {
        { const int l = 2 * lp; LP(1, l, lp == 0 ? 0 : 1); LP(2, lp, 0); LP(4, lp, 0); LP(6, lp, 0); LP(7, 0, 0); LP(8, l, 0); LP(9, l, 0); LP(10, 0, 0); LP(11, l, 0); LP(12, l, 0); }
        { const int l = 2 * lp + 1; LP(1, l, 1); LP(13, lp, 0); LP(14, lp, 0); LP(17, 0, 0); LP(8, l, 1); LP(9, l, 0); LP(10, 0, 0); LP(11, l, 0); LP(12, l, 0); }
    }
    LP(1, 3, 2);
#undef LP
#endif
#endif
}
```

```cpp
#define MODE 1

#include <string.h>
#include <hip/hip_runtime.h>
#include <stdint.h>
#include <math.h>

namespace cfg {
constexpr int D = 1024, NB = 4, S = 4096, T = NB * S, DEPTH = 4;
constexpr int MIXIN = 1952;
constexpr int NE = 32, TOPK = 4;
constexpr int MPAIR = T * TOPK;
constexpr int NBLK = MPAIR / 256 + NE;
constexpr int P = NBLK * 256;
}
using namespace cfg;


namespace mk {
#define LAS __attribute__((address_space(3)))
#define GAS __attribute__((address_space(1)))
typedef unsigned short bf16_t;
typedef short bf16x8 __attribute__((ext_vector_type(8)));
typedef short s16x4 __attribute__((ext_vector_type(4)));
typedef float f32x2 __attribute__((ext_vector_type(2)));
typedef float f32x4 __attribute__((ext_vector_type(4)));
typedef float f32x16 __attribute__((ext_vector_type(16)));
typedef unsigned u32x2 __attribute__((ext_vector_type(2)));
typedef unsigned u32x4 __attribute__((ext_vector_type(4)));
typedef GAS unsigned gu32;
#define RLX_AGENT __ATOMIC_RELAXED, __HIP_MEMORY_SCOPE_AGENT

__device__ __forceinline__ unsigned cvt_pk_bf16(float lo, float hi) { unsigned r; asm volatile("v_cvt_pk_bf16_f32 %0, %1, %2" : "=v"(r) : "v"(lo), "v"(hi)); return r; }
__device__ __forceinline__ float bf_lo(unsigned u) { return __uint_as_float(u << 16); }
__device__ __forceinline__ float bf_hi(unsigned u) { return __uint_as_float(u & 0xffff0000u); }
template <int O> __device__ __forceinline__ float shx(float v) { static_assert(O >= 1 && O < 32, "shx"); return __int_as_float(__builtin_amdgcn_ds_swizzle(__float_as_int(v), (O << 10) | 0x1f)); }
__device__ __forceinline__ float xadd32(float v) { const auto r = __builtin_amdgcn_permlane32_swap(__float_as_uint(v), __float_as_uint(v), false, false); return __uint_as_float(r[0]) + __uint_as_float(r[1]); }
__device__ __forceinline__ float xmax32(float v) { const auto r = __builtin_amdgcn_permlane32_swap(__float_as_uint(v), __float_as_uint(v), false, false); return fmaxf(__uint_as_float(r[0]), __uint_as_float(r[1])); }
__device__ __forceinline__ float wsum(float v) { v += shx<1>(v); v += shx<2>(v); v += shx<4>(v); v += shx<8>(v); v += shx<16>(v); return xadd32(v); }
__device__ __forceinline__ float fexp2(float x) { return __builtin_amdgcn_exp2f(x); }
__device__ __forceinline__ float frcp(float x) { return __builtin_amdgcn_rcpf(x); }
__device__ __forceinline__ float fsigmoid(float z) { return frcp(1.f + fexp2(-1.4426950408889634f * z)); }
__device__ __forceinline__ float fgelu_tanh(float x) { const float u = 0.7978845608028654f * (x + 0.044715f * x * x * x); return x * frcp(1.f + fexp2(-2.8853900817779268f * u)); }

#define XB_TMO      128
#define XB_XCNT(j)  (256  + 64 * (j))
#define XB_XSUB(j)  (1280 + 64 * (j))
#define XB_XGEN(j)  (2304 + 64 * (j))
#define XB_TOP      3328
#define XB_TOPGEN   3392
#define XCD_BAR_WORDS 3456
#define XB_SPIN_CAP (1u << 18)
__device__ __forceinline__ unsigned xb_ld(unsigned* p)              { return __hip_atomic_load(p, __ATOMIC_RELAXED, __HIP_MEMORY_SCOPE_AGENT); }
__device__ __forceinline__ unsigned xb_add(unsigned* p, unsigned v) { return __hip_atomic_fetch_add(p, v, __ATOMIC_RELAXED, __HIP_MEMORY_SCOPE_AGENT); }
__device__ __forceinline__ unsigned xb_xcc_id() { return (unsigned)__builtin_amdgcn_s_getreg((3 << 11) | 20) & 0xFu; }
#define XB_SPIN(cond, bar) do { unsigned _sp = 0; while (cond) { __builtin_amdgcn_s_sleep(1); \
    if ((++_sp & 255u) == 0u) { if (xb_ld(&(bar)[XB_TMO])) break; if (_sp > XB_SPIN_CAP) { atomicAdd(&(bar)[XB_TMO], 1u); break; } } } } while (0)
struct XcdBarrier { unsigned* bar; unsigned x; volatile LAS unsigned* st; };
__device__ __forceinline__ XcdBarrier xcd_barrier_post(unsigned* bar, volatile LAS unsigned* st, int tid) {
    XcdBarrier b; b.bar = bar; b.x = xb_xcc_id(); b.st = st;
    if (tid == 0) (void)xb_add(&bar[XB_XCNT(b.x)], 1u);
    return b;
}
__device__ __forceinline__ void xcd_barrier_complete(unsigned* bar, unsigned x, unsigned& nloc, unsigned& nx) {
    const unsigned G = gridDim.x * gridDim.y * gridDim.z;
    unsigned sum, cnt, mine, sp = 0u;
    for (;;) {
        sum = 0u; cnt = 0u; mine = 0u;
#pragma unroll
        for (unsigned j = 0; j < 16; ++j) { const unsigned c = xb_ld(&bar[XB_XCNT(j)]); sum += c; cnt += (c > 0u) ? 1u : 0u; mine = (j == x) ? c : mine; }
        if (sum == G) break;
        __builtin_amdgcn_s_sleep(1);
        if ((++sp & 255u) == 0u) { if (xb_ld(&bar[XB_TMO])) break; if (sp > XB_SPIN_CAP) { atomicAdd(&bar[XB_TMO], 1u); break; } }
    }
    nloc = mine > 0u ? mine : 1u; nx = cnt > 0u ? cnt : 1u;
}
__device__ __forceinline__ void xcd_barrier(const XcdBarrier& b, int tid) {
    asm volatile("s_waitcnt vmcnt(0)" ::: "memory");
    __syncthreads();
    if (tid == 0) {
        unsigned* bar = b.bar;
        __builtin_amdgcn_s_waitcnt(0);
        unsigned nloc = b.st[0], nx = b.st[1];
        if (nloc == 0u) { xcd_barrier_complete(bar, b.x, nloc, nx); b.st[0] = nloc; b.st[1] = nx; }
        const unsigned old = xb_add(&bar[XB_XSUB(b.x)], 1u);
        const unsigned gen = old / nloc;
        if (old + 1u == (gen + 1u) * nloc) {
            __builtin_amdgcn_fence(__ATOMIC_RELEASE, "agent");
            asm volatile("s_waitcnt vmcnt(0)" ::: "memory");
            const unsigned og = xb_add(&bar[XB_TOP], 1u);
            const unsigned tg = og / nx;
            if (og + 1u == (tg + 1u) * nx) xb_add(&bar[XB_TOPGEN], 1u);
            else XB_SPIN(xb_ld(&bar[XB_TOPGEN]) == tg, bar);
            __builtin_amdgcn_fence(__ATOMIC_ACQUIRE, "agent");
            xb_add(&bar[XB_XGEN(b.x)], 1u);
            asm volatile("s_waitcnt vmcnt(0)" ::: "memory");
        } else {
            XB_SPIN(xb_ld(&bar[XB_XGEN(b.x)]) == gen, bar);
            __builtin_amdgcn_fence(__ATOMIC_ACQUIRE, "agent");
            asm volatile("s_waitcnt vmcnt(0)" ::: "memory");
        }
    }
    __syncthreads();
}

constexpr int BM = 256, BK = 64, HALF = 128, HTB = HALF * BK * 2, STAGE_BYTES = 8 * HTB;
__host__ __device__ __forceinline__ int lds_byte(int r, int c) { const int st = (r >> 4) * 2 + (c >> 5), rr = r & 15, cc = c & 31, ob = rr * 64 + cc * 2; return st * 1024 + (ob ^ (((ob >> 9) & 1) << 5)); }
__host__ __device__ __forceinline__ void stage_rc(int b, int& R, int& C) { const int st = b / 1024, sb = b % 1024, swz = sb ^ (((sb >> 9) & 1) << 5); R = (st >> 1) * 16 + swz / 64; C = (st & 1) * 32 + (swz % 64) / 2; }
__host__ __device__ __forceinline__ int perm32(int rho) { const int n = rho >> 4, i = rho & 15; return 8 * (i >> 2) + 4 * n + (i & 3); }

struct Unit { const char* a; const char* b; int row0, col0, e, pad; };
struct GemmDims { int K, lda, ldb; };
typedef f32x4 Acc[2][2][4][2];
__device__ __forceinline__ void zero_acc(Acc& acc) {
#pragma unroll
    for (int a = 0; a < 2; ++a)
#pragma unroll
        for (int b = 0; b < 2; ++b)
#pragma unroll
            for (int m = 0; m < 4; ++m)
#pragma unroll
                for (int n = 0; n < 2; ++n)
#pragma unroll
                    for (int j = 0; j < 4; ++j) { float z; asm volatile("v_mov_b32 %0, 0" : "=v"(z)); acc[a][b][m][n][j] = z; }
}

typedef int v8i32 __attribute__((ext_vector_type(8)));
template <bool F8 = false, class CtxT, class Epi, class Sched>
__device__ __forceinline__ void gemm_phase(const CtxT& C, const GemmDims g, const Sched& S, const Epi& E) {
    LAS unsigned char* lds = C.lds;
    const int tid = C.tid, wid = __builtin_amdgcn_readfirstlane(tid >> 6), lane = tid & 63, wr = wid >> 2, wc = wid & 3, fr = lane & 15, fq = lane >> 4;
    constexpr int ESZ = F8 ? 1 : 2;
    constexpr bool GA = Sched::GATHER;
    int nt = g.K / (F8 ? 128 : BK); asm volatile("" : "+s"(nt));
    unsigned voffA[2], voffB[2];
#pragma unroll
    for (int i = 0; i < 2; ++i) { int R, C; stage_rc(tid * 16 + i * 8192, R, C); const int Rb = (R & ~31) + perm32(R & 31);
        voffA[i] = (unsigned)(R * g.lda * ESZ + C * 2); voffB[i] = (unsigned)(Rb * g.ldb * ESZ + C * 2); }
    unsigned voffG[2][2];
    auto load_goffs = [&](int uidx) { if constexpr (GA) { int R, Cc; stage_rc(tid * 16, R, Cc); const LAS int* tp = S.gtab + uidx * 256 + R;
#pragma unroll
        for (int h = 0; h < 2; ++h)
#pragma unroll
            for (int i = 0; i < 2; ++i) voffG[h][i] = (unsigned)tp[h * 128 + i * 64] * (unsigned)(g.lda * ESZ) + (unsigned)(Cc * 2); } };
    const size_t kstep = (size_t)(BK * 2);
    const size_t hstepA = (size_t)HALF * g.lda * ESZ, hstepB = (size_t)HALF * g.ldb * ESZ;
    const unsigned ldsw = (unsigned)wid * 1024u;
    const unsigned ldsu = (unsigned)__builtin_amdgcn_readfirstlane((int)(unsigned)(unsigned long long)(lds));
    const int aoff = lds_byte(wr * 64 + fr, fq * 8), boff = lds_byte(wc * 32 + fr, fq * 8);
#define PG8_SA(b, h) (((b) * 2 + (h)) * HTB)
#define PG8_SB(b, h) ((4 + (b) * 2 + (h)) * HTB)
#define PG8_STAGE(bufoff, gbase, voff) do { _Pragma("unroll") for (int _i = 0; _i < 2; ++_i) { \
        asm volatile("s_mov_b32 m0, %2\n\ts_nop 3\n\tglobal_load_lds_dwordx4 %0, %1" :: "v"((voff)[_i]), "s"((const char*)(gbase)), "s"(ldsu + (unsigned)(bufoff) + ldsw + (unsigned)(_i * 8192)) : "memory"); } } while (0)
#define PG8_STAGE_A(bufoff, gbase, h) do { if constexpr (GA) PG8_STAGE(bufoff, gbase, voffG[h]); else PG8_STAGE(bufoff, (gbase) + (h) * hstepA, voffA); } while (0)
#define PG8_LDA(dst, b, h) do { _Pragma("unroll") for (int m = 0; m < 4; ++m) _Pragma("unroll") for (int k = 0; k < 2; ++k) dst[m][k] = *(const LAS bf16x8*)(lds + PG8_SA(b, h) + aoff + m * 2048 + k * 1024); } while (0)
#define PG8_LDB(dst, b, h) do { _Pragma("unroll") for (int n = 0; n < 2; ++n) _Pragma("unroll") for (int k = 0; k < 2; ++k) dst[n][k] = *(const LAS bf16x8*)(lds + PG8_SB(b, h) + boff + n * 2048 + k * 1024); } while (0)
#define PG8_CAT(x) __builtin_bit_cast(v8i32, (x))
#define PG8_MMA(ai, bj, At, Bt) do { __builtin_amdgcn_s_setprio(1); \
        if constexpr (F8) { _Pragma("unroll") for (int m = 0; m < 4; ++m) _Pragma("unroll") for (int n = 0; n < 2; ++n) \
            acc[ai][bj][m][n] = __builtin_amdgcn_mfma_scale_f32_16x16x128_f8f6f4(PG8_CAT(Bt[n]), PG8_CAT(At[m]), acc[ai][bj][m][n], 0, 0, 0, 0, 0, 0); } \
        else { _Pragma("unroll") for (int m = 0; m < 4; ++m) _Pragma("unroll") for (int n = 0; n < 2; ++n) _Pragma("unroll") for (int k = 0; k < 2; ++k) \
            acc[ai][bj][m][n] = __builtin_amdgcn_mfma_f32_16x16x32_bf16(Bt[n][k], At[m][k], acc[ai][bj][m][n], 0, 0, 0); } \
        __builtin_amdgcn_s_setprio(0); } while (0)
#define PG8_WAIT_V(n) asm volatile("s_waitcnt vmcnt(" #n ")" ::: "memory")
#define PG8_WAIT_L(n) asm volatile("s_waitcnt lgkmcnt(" #n ")" ::: "memory")
#define PG8_BAR __builtin_amdgcn_s_barrier()
#define PG8_SCHED __builtin_amdgcn_sched_barrier(0)
    Unit cur, nxt; int ui = 0;
    if (!S.next(0, cur)) return;
    Acc acc; zero_acc(acc);
    struct Frag2 { bf16x8 p[2]; __device__ __forceinline__ bf16x8& operator[](int k) { return p[k]; } __device__ __forceinline__ const bf16x8& operator[](int k) const { return p[k]; } };
    Frag2 At[4], B0[2], B1[2];
    const char* cA = cur.a; const char* cB = cur.b;
    load_goffs(0);
    PG8_STAGE(PG8_SB(0, 0), cB, voffB); PG8_STAGE(PG8_SB(0, 1), cB + hstepB, voffB); PG8_STAGE_A(PG8_SA(0, 0), cA, 0); PG8_STAGE_A(PG8_SA(0, 1), cA, 1);
    if (wr == 1) PG8_BAR;
    PG8_WAIT_V(2); PG8_BAR;
    PG8_STAGE(PG8_SB(1, 0), cB + kstep, voffB); PG8_STAGE_A(PG8_SA(1, 0), cA + kstep, 0); PG8_STAGE(PG8_SB(1, 1), cB + hstepB + kstep, voffB);
    PG8_WAIT_V(6); PG8_BAR;
    for (;;) {
        const bool has_next = S.next(ui + 1, nxt);
        const char* nA = has_next ? nxt.a : cA; const char* nB = has_next ? nxt.b : cB;
        for (int t = 0; t < nt; t += 2) {
            const bool last = (t == nt - 2);
            const char* a1 = cA + (size_t)(t + 1) * kstep;
            const char* a2 = last ? nA : cA + (size_t)(t + 2) * kstep; const char* b2 = last ? nB : cB + (size_t)(t + 2) * kstep;
            const char* a3 = a2 + kstep; const char* b3 = b2 + kstep;
            PG8_LDB(B0, 0, 0); PG8_LDB(B1, 0, 1); PG8_SCHED; PG8_LDA(At, 0, 0); PG8_STAGE_A(PG8_SA(1, 1), a1, 1);
            if (GA && last && has_next) load_goffs(ui + 1);
            PG8_WAIT_V(8); PG8_WAIT_L(0); PG8_BAR; PG8_MMA(0, 0, At, B0); PG8_MMA(0, 1, At, B1); PG8_BAR; PG8_SCHED;
            PG8_LDA(At, 0, 1); PG8_STAGE(PG8_SB(0, 0), b2, voffB); PG8_STAGE(PG8_SB(0, 1), b2 + hstepB, voffB); PG8_STAGE_A(PG8_SA(0, 0), a2, 0);
            PG8_WAIT_V(8); PG8_WAIT_L(0); PG8_BAR; PG8_MMA(1, 0, At, B0); PG8_MMA(1, 1, At, B1); PG8_BAR; PG8_SCHED;
            PG8_LDB(B0, 1, 0); PG8_LDB(B1, 1, 1); PG8_SCHED; PG8_LDA(At, 1, 0); PG8_STAGE_A(PG8_SA(0, 1), a2, 1);
            PG8_WAIT_V(8); PG8_WAIT_L(0); PG8_BAR; PG8_MMA(0, 0, At, B0); PG8_MMA(0, 1, At, B1); PG8_BAR; PG8_SCHED;
            PG8_LDA(At, 1, 1); PG8_STAGE(PG8_SB(1, 0), b3, voffB); PG8_STAGE(PG8_SB(1, 1), b3 + hstepB, voffB); PG8_STAGE_A(PG8_SA(1, 0), a3, 0);
            PG8_WAIT_V(8); PG8_WAIT_L(0); PG8_BAR; PG8_MMA(1, 0, At, B0); PG8_MMA(1, 1, At, B1); PG8_BAR; PG8_SCHED;
        }
        if (wr == 0) PG8_BAR;
        E(acc, cur, wr, wc, fr, fq);
        if (!has_next) break;
        zero_acc(acc);
        cur = nxt; cA = nA; cB = nB; ++ui;
        if (wr == 1) PG8_BAR;
    }
    PG8_WAIT_V(0);
    PG8_BAR;
#undef PG8_SA
#undef PG8_SB
#undef PG8_STAGE
#undef PG8_STAGE_A
#undef PG8_LDA
#undef PG8_LDB
#undef PG8_MMA
#undef PG8_CAT
#undef PG8_WAIT_V
#undef PG8_WAIT_L
#undef PG8_BAR
#undef PG8_SCHED
}

struct DenseOrder {
    static constexpr bool GATHER = false;
    const char* A; const char* Bt; int lda, ldb, nM, nN, nwg, G, c;
    __device__ __forceinline__ void init(const void* A_, const void* Bt_, int lda_, int ldb_, int M, int N, int G_, int c_) { A = (const char*)A_; Bt = (const char*)Bt_; lda = lda_; ldb = ldb_; nM = M / BM; nN = N / BM; nwg = nM * nN; G = G_; c = c_; }
    __device__ __forceinline__ bool next(int i, Unit& u) const {
        const long L = (long)i * G + c; if (L >= nwg) return false;
        int wgid = (int)L; { const int q = nwg / 8, r = nwg % 8, xcd = wgid % 8, off = wgid / 8; wgid = (xcd < r ? xcd * (q + 1) : r * (q + 1) + (xcd - r) * q) + off; }
        const int nig = 8 * nN, gid = wgid / nig, fm = gid * 8, gsz = (nM - fm) < 8 ? (nM - fm) : 8;
        const int pm = fm + ((wgid % nig) % gsz), pn = (wgid % nig) / gsz;
        u.a = A + (size_t)pm * BM * lda * 2; u.b = Bt + (size_t)pn * BM * ldb * 2; u.row0 = pm * BM; u.col0 = pn * BM; u.e = 0; u.pad = 0; return true;
    }
};
struct LruOrder {
    static constexpr bool GATHER = false;
    const char* XC; const char* RG; int G, c;
    __device__ __forceinline__ bool next(int i, Unit& u) const {
        const int L = i * G + c; if (L >= 512) return false;
        const int pm = L >> 3, n = L & 7;
        u.a = XC + ((size_t)pm * BM * 1024 + n * 128) * 2; u.b = RG + (size_t)n * 256 * 128 * 2; u.row0 = pm * BM; u.col0 = n * 128; u.e = n; u.pad = 0; return true;
    }
};
template <bool GATHER_ = false> struct MoeOrderT {
    static constexpr bool GATHER = GATHER_; const LAS int* gtab;
    const char* A; const char* WT; size_t estride; const LAS int* tile_e; int NT, nN, G, c, esz;
    __device__ __forceinline__ bool next(int i, Unit& u) const {
        int tile, pn;
#ifndef MOE_ORDER_ALT
#define MOE_ORDER_ALT 0
#endif
        if (!MOE_ORDER_ALT && (G % (8 * nN)) == 0) { const int R = G / nN; tile = i * R + (c & 7) * (R >> 3) + (c >> 3) / nN; pn = (c >> 3) % nN; }
        else { const int L = i * G + c; tile = L / nN; pn = L % nN; }
        if (tile >= NT) return false;
        const int e = __builtin_amdgcn_readfirstlane(tile_e[tile]);
        u.a = GATHER ? A : A + (size_t)tile * BM * 1024 * esz; u.b = WT + (size_t)e * estride + (size_t)pn * BM * 1024 * esz; u.row0 = tile * BM; u.col0 = pn * BM; u.e = e; u.pad = 0; return true;
    }
};
typedef MoeOrderT<false> MoeOrder;

#define EPI_ROW(ai, m) (u.row0 + (ai) * HALF + wr * 64 + (m) * 16 + fr)
#define EPI_COL(bj) (u.col0 + (bj) * HALF + wc * 32 + 8 * fq)
struct EpiBf16 {
    bf16_t* O; const float* bias; int ldc, bias_es; float ascale;
    __device__ __forceinline__ void operator()(const Acc& acc, const Unit& u, int wr, int wc, int fr, int fq) const {
        f32x4 bv[2][2];
#pragma unroll
        for (int bj = 0; bj < 2; ++bj)
#pragma unroll
            for (int n = 0; n < 2; ++n) bv[bj][n] = bias ? *(const f32x4*)(bias + (size_t)u.e * bias_es + EPI_COL(bj) + 4 * n) : (f32x4){0.f, 0.f, 0.f, 0.f};
#pragma unroll
        for (int ai = 0; ai < 2; ++ai)
#pragma unroll
            for (int m = 0; m < 4; ++m) { bf16_t* rowp = O + (size_t)EPI_ROW(ai, m) * ldc;
#pragma unroll
                for (int bj = 0; bj < 2; ++bj) { const f32x4 v0 = acc[ai][bj][m][0] * ascale + bv[bj][0], v1 = acc[ai][bj][m][1] * ascale + bv[bj][1];
                    u32x4 w; w.x = cvt_pk_bf16(v0[0], v0[1]); w.y = cvt_pk_bf16(v0[2], v0[3]); w.z = cvt_pk_bf16(v1[0], v1[1]); w.w = cvt_pk_bf16(v1[2], v1[3]);
                    *(u32x4*)(rowp + EPI_COL(bj)) = w; } }
    }
};
template <int KIND> struct EpiNorm {
    bf16_t* O; int ldc; const float* ga; const float* gb; const float* gc; const float* gd; const float* ge; const float* cs; LAS float* S;
    __device__ __forceinline__ void operator()(const Acc& acc, const Unit& u, int wr, int wc, int fr, int fq) const {
        const int pn = u.col0 >> 8; const int lane = fr + 16 * fq;
        int mode = 0; const float* gp = ga; float scale = 1.f;
        if (KIND == 0) { if (pn < 2) { mode = 1; gp = ga; scale = 0.125f * 1.4426950408889634f; } else if (pn < 4) { mode = 1; gp = gb; } else if (pn < 6) mode = 0; else if (pn == 6) { mode = 2; gp = gc; } else { mode = 3; gp = gd; } }
        if (KIND == 1) { scale = 0.10206207261596575f * 1.4426950408889634f; if (pn < 2) { mode = 1; gp = ga; } else { mode = 4; gp = gb; } }
        if (KIND == 2) { if (pn < 2) { mode = 1; gp = ga; } else mode = 0; }
        float ss[2][4][2];
        if (mode != 0) {
#pragma unroll
            for (int ai = 0; ai < 2; ++ai)
#pragma unroll
                for (int m = 0; m < 4; ++m)
#pragma unroll
                    for (int bj = 0; bj < 2; ++bj) { const f32x4 a = acc[ai][bj][m][0], b = acc[ai][bj][m][1];
                        float s = (a[0] * a[0] + a[1] * a[1]) + (a[2] * a[2] + a[3] * a[3]) + (b[0] * b[0] + b[1] * b[1]) + (b[2] * b[2] + b[3] * b[3]);
                        s += shx<16>(s); ss[ai][m][bj] = xadd32(s); } }
        if (mode == 1 || mode == 2 || mode == 3) {
            if (fq == 0) {
#pragma unroll
                for (int ai = 0; ai < 2; ++ai)
#pragma unroll
                    for (int m = 0; m < 4; ++m)
#pragma unroll
                        for (int bj = 0; bj < 2; ++bj) S[(ai * HALF + wr * 64 + m * 16 + fr) * 8 + bj * 4 + wc] = ss[ai][m][bj]; }
            asm volatile("s_waitcnt lgkmcnt(0)" ::: "memory"); __builtin_amdgcn_s_barrier(); asm volatile("" ::: "memory");
#pragma unroll
            for (int ai = 0; ai < 2; ++ai)
#pragma unroll
                for (int m = 0; m < 4; ++m) { const LAS float* sr = S + (ai * HALF + wr * 64 + m * 16 + fr) * 8;
#pragma unroll
                    for (int bj = 0; bj < 2; ++bj) {
                        if (mode == 1) { const f32x2 t = *(const LAS f32x2*)(sr + bj * 4 + (wc & 2)); ss[ai][m][bj] = t[0] + t[1]; }
                        else if (mode == 2) { const f32x4 t0 = *(const LAS f32x4*)sr, t1 = *(const LAS f32x4*)(sr + 4); ss[ai][m][bj] = (t0[0] + t0[1]) + (t0[2] + t0[3]) + (t1[0] + t1[1]) + (t1[2] + t1[3]); }
                        else if (bj == 0) { const f32x4 t0 = *(const LAS f32x4*)sr; ss[ai][m][bj] = (t0[0] + t0[1]) + (t0[2] + t0[3]); } } }
        }
        const float inv_n = (mode == 1) ? (1.f / 64.f) : (mode == 2) ? (1.f / 256.f) : (1.f / 32.f);
        const bool rope_tile = (mode == 4) || (mode == 3);
#pragma unroll
        for (int bj = 0; bj < 2; ++bj) {
            f32x4 g0 = (f32x4){1.f, 1.f, 1.f, 1.f}, g1 = g0; bool rope = false, zero = false; float invn = inv_n;
            const int c8 = 8 * fq;
            if (mode == 1) { const int c = 32 * (wc & 1) + c8; g0 = *(const f32x4*)(gp + c); g1 = *(const f32x4*)(gp + c + 4); }
            else if (mode == 2) { const int c = bj * HALF + wc * 32 + c8; g0 = *(const f32x4*)(gp + c); g1 = *(const f32x4*)(gp + c + 4); }
            else if (mode == 3) { if (bj == 0) { const int c = wc * 32 + c8; g0 = *(const f32x4*)(gp + c); g1 = *(const f32x4*)(gp + c + 4); invn = 1.f / 128.f; }
                                  else if (wc == 0) { g0 = *(const f32x4*)(ge + c8); g1 = *(const f32x4*)(ge + c8 + 4); rope = true; } else zero = true; }
            else if (mode == 4) { g0 = *(const f32x4*)(gp + c8); g1 = *(const f32x4*)(gp + c8 + 4); rope = true; }
            (void)rope_tile;
#pragma unroll
            for (int ai = 0; ai < 2; ++ai)
#pragma unroll
                for (int m = 0; m < 4; ++m) { const int row = EPI_ROW(ai, m);
                    f32x4 v0 = acc[ai][bj][m][0], v1 = acc[ai][bj][m][1];
                    if (mode != 0) { const float rs = rsqrtf(ss[ai][m][bj] * invn + 1e-6f) * scale; v0 = v0 * rs * g0; v1 = v1 * rs * g1; }
                    if (rope) {
                        const float* cr = cs + (size_t)row * 32 + 8 * (fq & 1); const f32x4 c0 = *(const f32x4*)cr, c1 = *(const f32x4*)(cr + 4), s0 = *(const f32x4*)(cr + 16), s1 = *(const f32x4*)(cr + 20);
                        f32x4 o0, o1;
#pragma unroll
                        for (int j = 0; j < 4; ++j) { const auto r0 = __builtin_amdgcn_permlane32_swap(__float_as_uint(v0[j]), __float_as_uint(v0[j]), false, false), r1 = __builtin_amdgcn_permlane32_swap(__float_as_uint(v1[j]), __float_as_uint(v1[j]), false, false);
                            const float ot0 = __uint_as_float(lane < 32 ? r0[1] : r0[0]), ot1 = __uint_as_float(lane < 32 ? r1[1] : r1[0]);
                            o0[j] = (lane < 32) ? (v0[j] * c0[j] - ot0 * s0[j]) : (ot0 * s0[j] + v0[j] * c0[j]);
                            o1[j] = (lane < 32) ? (v1[j] * c1[j] - ot1 * s1[j]) : (ot1 * s1[j] + v1[j] * c1[j]); }
                        v0 = o0; v1 = o1; }
                    if (zero) { v0 = (f32x4){0.f, 0.f, 0.f, 0.f}; v1 = v0; }
                    u32x4 w; w.x = cvt_pk_bf16(v0[0], v0[1]); w.y = cvt_pk_bf16(v0[2], v0[3]); w.z = cvt_pk_bf16(v1[0], v1[1]); w.w = cvt_pk_bf16(v1[2], v1[3]);
                    *(u32x4*)(O + (size_t)row * ldc + EPI_COL(bj)) = w; } }
    }
};
struct EpiRecIn {
    bf16_t* O; const float* bias;
    __device__ __forceinline__ void operator()(const Acc& acc, const Unit& u, int wr, int wc, int fr, int fq) const {
        const bool act = u.col0 < 1024;
        f32x4 bv[2][2];
#pragma unroll
        for (int bj = 0; bj < 2; ++bj)
#pragma unroll
            for (int n = 0; n < 2; ++n) bv[bj][n] = *(const f32x4*)(bias + EPI_COL(bj) + 4 * n);
#pragma unroll
        for (int ai = 0; ai < 2; ++ai)
#pragma unroll
            for (int m = 0; m < 4; ++m) { bf16_t* rowp = O + (size_t)EPI_ROW(ai, m) * 2048;
#pragma unroll
                for (int bj = 0; bj < 2; ++bj) { f32x4 v0 = acc[ai][bj][m][0] + bv[bj][0], v1 = acc[ai][bj][m][1] + bv[bj][1];
                    if (act) {
#pragma unroll
                        for (int j = 0; j < 4; ++j) { v0[j] = fgelu_tanh(v0[j]); v1[j] = fgelu_tanh(v1[j]); } }
                    u32x4 w; w.x = cvt_pk_bf16(v0[0], v0[1]); w.y = cvt_pk_bf16(v0[2], v0[3]); w.z = cvt_pk_bf16(v1[0], v1[1]); w.w = cvt_pk_bf16(v1[2], v1[3]);
                    *(u32x4*)(rowp + EPI_COL(bj)) = w; } }
    }
};
__device__ __forceinline__ unsigned pk4_fp8(float a, float b, float c, float d) { int w = 0; w = __builtin_amdgcn_cvt_pk_fp8_f32(a, b, w, false); w = __builtin_amdgcn_cvt_pk_fp8_f32(c, d, w, true); return (unsigned)w; }
struct EpiSwiglu {
    unsigned char* ACT; const float* b1; float ascale;
    __device__ __forceinline__ float sw(float g, float l) const { g = fminf(g, 7.f); l = fminf(fmaxf(l, -7.f), 7.f); return g * fsigmoid(1.702f * g) * (l + 1.f); }
    __device__ __forceinline__ void operator()(const Acc& acc, const Unit& u, int wr, int wc, int fr, int fq) const {
        f32x4 bv[2][2];
#pragma unroll
        for (int bj = 0; bj < 2; ++bj)
#pragma unroll
            for (int n = 0; n < 2; ++n) bv[bj][n] = *(const f32x4*)(b1 + (size_t)u.e * 2048 + EPI_COL(bj) + 4 * n);
#pragma unroll
        for (int ai = 0; ai < 2; ++ai)
#pragma unroll
            for (int m = 0; m < 4; ++m) { unsigned char* rowp = ACT + (size_t)EPI_ROW(ai, m) * 1024;
#pragma unroll
                for (int bj = 0; bj < 2; ++bj) { const f32x4 v0 = acc[ai][bj][m][0] * ascale + bv[bj][0], v1 = acc[ai][bj][m][1] * ascale + bv[bj][1];
                    *(unsigned*)(rowp + (EPI_COL(bj) >> 1)) = pk4_fp8(sw(v0[0], v0[1]), sw(v0[2], v0[3]), sw(v1[0], v1[1]), sw(v1[2], v1[3])); } }
    }
};
struct EpiResid {
    bf16_t* X; const float* g; const float* bias;
    __device__ __forceinline__ void operator()(const Acc& acc, const Unit& u, int wr, int wc, int fr, int fq) const {
        const int b = u.row0 / cfg::S;
        f32x4 bv[2][2], gv[2][2];
#pragma unroll
        for (int bj = 0; bj < 2; ++bj)
#pragma unroll
            for (int n = 0; n < 2; ++n) { bv[bj][n] = bias ? *(const f32x4*)(bias + EPI_COL(bj) + 4 * n) : (f32x4){0.f, 0.f, 0.f, 0.f}; gv[bj][n] = *(const f32x4*)(g + b * 6144 + EPI_COL(bj) + 4 * n); }
#pragma unroll
        for (int ai = 0; ai < 2; ++ai)
#pragma unroll
            for (int m = 0; m < 4; ++m) { bf16_t* rowp = X + (size_t)EPI_ROW(ai, m) * 1024;
#pragma unroll
                for (int bj = 0; bj < 2; ++bj) { u32x4* p = (u32x4*)(rowp + EPI_COL(bj)); const u32x4 xw = *p;
                    const f32x4 x0 = (f32x4){bf_lo(xw.x), bf_hi(xw.x), bf_lo(xw.y), bf_hi(xw.y)} + gv[bj][0] * (acc[ai][bj][m][0] + bv[bj][0]);
                    const f32x4 x1 = (f32x4){bf_lo(xw.z), bf_hi(xw.z), bf_lo(xw.w), bf_hi(xw.w)} + gv[bj][1] * (acc[ai][bj][m][1] + bv[bj][1]);
                    u32x4 w; w.x = cvt_pk_bf16(x0[0], x0[1]); w.y = cvt_pk_bf16(x0[2], x0[3]); w.z = cvt_pk_bf16(x1[0], x1[1]); w.w = cvt_pk_bf16(x1[2], x1[3]); *p = w; }
                if (m & 1) asm volatile("" ::: "memory"); }
    }
};
struct EpiLru {
    const bf16_t* XC; const float* ba; const float* bx; const float* lam; bf16_t* LA; bf16_t* Bb;
    __device__ __forceinline__ void operator()(const Acc& acc, const Unit& u, int wr, int wc, int fr, int fq) const {
        const int ch0 = u.col0 + wc * 32 + 8 * fq;
#pragma unroll
        for (int n = 0; n < 2; ++n) { const int ch = ch0 + 4 * n;
            const f32x4 bav = *(const f32x4*)(ba + ch), bxv = *(const f32x4*)(bx + ch), spv = *(const f32x4*)(lam + ch);
#pragma unroll
            for (int ai = 0; ai < 2; ++ai)
#pragma unroll
                for (int m = 0; m < 4; ++m) { const size_t ro = (size_t)EPI_ROW(ai, m) * 1024 + ch;
                    const u32x2 xr = *(const u32x2*)(XC + ro);
                    const float xcv[4] = {bf_lo(xr.x), bf_hi(xr.x), bf_lo(xr.y), bf_hi(xr.y)};
                    float lav[4], bvv[4];
#pragma unroll
                    for (int j = 0; j < 4; ++j) { const float r = fsigmoid(acc[ai][0][m][n][j] + bav[j]), ig = fsigmoid(acc[ai][1][m][n][j] + bxv[j]);
                        const float la = r * spv[j], a = fexp2(la); lav[j] = la; bvv[j] = __builtin_amdgcn_sqrtf(fmaxf(1.f - a * a, 0.f)) * ig * xcv[j]; }
                    u32x2 wa, wb; wa.x = cvt_pk_bf16(lav[0], lav[1]); wa.y = cvt_pk_bf16(lav[2], lav[3]); wb.x = cvt_pk_bf16(bvv[0], bvv[1]); wb.y = cvt_pk_bf16(bvv[2], bvv[3]);
                    *(u32x2*)(LA + ro) = wa; *(u32x2*)(Bb + ro) = wb; asm volatile("" ::: "memory"); } }
    }
};

constexpr size_t MiB = (size_t)1 << 20;
constexpr size_t al4k(size_t x) { return (x + 4095) & ~(size_t)4095; }
constexpr int T_ = cfg::T, S_ = cfg::S, P_ = cfg::P;
constexpr size_t O_CTL = 0, SZ_CTL = 1 * MiB;
constexpr size_t O_MOD = O_CTL + SZ_CTL, SZ_MOD = al4k((size_t)4 * 4 * 6144 * 4);
constexpr size_t O_CS = O_MOD + SZ_MOD, SZ_CS = (size_t)T_ * 32 * 4;
constexpr size_t O_HIST = O_CS + SZ_CS, SZ_HIST = 256 * 32 * 4;
constexpr size_t O_TOPI = O_HIST + SZ_HIST, SZ_TOP = (size_t)T_ * 4 * 4;
constexpr size_t O_TOPG = O_TOPI + SZ_TOP, O_POS = O_TOPG + SZ_TOP;
constexpr size_t O_SUMP = O_POS + SZ_TOP, SZ_SUM = (size_t)4 * 64 * 1024 * 4;
constexpr size_t O_SUMH = O_SUMP + SZ_SUM;
constexpr size_t O_LSE = O_SUMH + SZ_SUM, SZ_LSE = (size_t)3 * T_ * 8 * 4;
constexpr size_t O_SPV = al4k(O_LSE + SZ_LSE), SZ_SPV = 2 * 1024 * 4;
constexpr size_t O_WIN = al4k(O_SPV + SZ_SPV), SZ_WIN = (size_t)2048 * 1024 * 2;
constexpr size_t O_WUQ = O_WIN + 2 * SZ_WIN, SZ_WUQ = (size_t)768 * 256 * 2;
constexpr size_t O_WUKV = O_WUQ + 2 * SZ_WUQ, SZ_WUKV = (size_t)1024 * 128 * 2;
constexpr size_t O_WOUT = O_WUKV + 2 * SZ_WUKV, SZ_WOUT = (size_t)1024 * 1024 * 2;
constexpr size_t O_RWIN = O_WOUT + 2 * SZ_WOUT, SZ_RWIN = (size_t)2048 * 1024 * 2;
constexpr size_t O_RGATE = O_RWIN + 2 * SZ_RWIN, SZ_RGATE = (size_t)8 * 256 * 128 * 2;
constexpr size_t O_RWOUT = O_RGATE + 2 * SZ_RGATE, SZ_RWOUT = (size_t)1024 * 1024 * 2;
constexpr size_t O_W1 = O_RWOUT + 2 * SZ_RWOUT, SZ_W1E = (size_t)2048 * 1024;
constexpr size_t O_W2 = O_W1 + 128 * SZ_W1E, SZ_W2E = (size_t)1024 * 1024;
constexpr size_t O_HN = O_W2 + 128 * SZ_W2E, SZ_HN = (size_t)T_ * 1024 * 2;
constexpr size_t O_PROJ = O_HN + SZ_HN, SZ_PROJ = (size_t)T_ * 2048 * 2;
constexpr size_t O_Q2 = O_PROJ + SZ_PROJ, SZ_Q2 = (size_t)T_ * 768 * 2;
constexpr size_t O_KV2 = O_Q2 + SZ_Q2, SZ_KV2 = (size_t)T_ * 1024 * 2;
constexpr size_t O_OA = O_KV2 + SZ_KV2, SZ_OA = (size_t)3 * T_ * 512 * 2;
constexpr size_t O_ATT = O_OA + SZ_OA, SZ_ATT = (size_t)T_ * 1024 * 2;
constexpr size_t O_XC = O_ATT + SZ_ATT, SZ_XC = (size_t)T_ * 1024 * 2;
constexpr size_t O_AA = O_XC + SZ_XC, SZ_AA = (size_t)T_ * 1024 * 4;
constexpr size_t O_BB = O_AA + SZ_AA;
constexpr size_t O_XG = O_BB + SZ_AA, SZ_XG = (size_t)P_ * 1024 * 2, O_INV = O_XG;
constexpr size_t O_ACT = O_XG + SZ_XG, O_Y2 = O_ACT + SZ_XG;
constexpr size_t O_X = O_Y2 + SZ_XG, SZ_X = (size_t)T_ * 1024 * 2;
constexpr size_t O_DUMMY = O_X + SZ_X, SZ_DUMMY = (size_t)96 * MiB;
constexpr size_t WS_MK_END = O_DUMMY + SZ_DUMMY;
constexpr size_t O_NAIVE = (size_t)2048 * MiB;
static_assert(WS_MK_END <= O_NAIVE, "mk workspace");
constexpr int CW_BAR = 4096;
constexpr int RING_BYTES = 131072, LDSX_OFF = RING_BYTES;
constexpr int LDS_BYTES = 147456;
constexpr int LX_TILE = LDSX_OFF + 64, LX_MISC = LDSX_OFF + 2048, LX_EXCH = LDSX_OFF + 6144, LX_GTAB = LX_EXCH, GTAB_UNITS = 10;

struct Args { const void* in[34]; float* out; unsigned char* ws; int ph_lo, ph_hi; };
struct Ctx { int tid, lane, wave, G, bid, vcu, gw, NGW; LAS unsigned char* lds; unsigned char* ws; };

__device__ __forceinline__ void conv_load(f32x4 (&v)[16], const float* __restrict__ W, int N, int n0, int k0, int lane) {
    const int n = n0 + 4 * (lane & 15); const float* p = W + (size_t)(k0 + 16 * (lane >> 4)) * N + n;
#pragma unroll
    for (int i = 0; i < 16; ++i) v[i] = (n < N) ? __builtin_nontemporal_load((const f32x4*)(p + (size_t)i * N)) : (f32x4){0.f, 0.f, 0.f, 0.f};
}
__device__ __forceinline__ int conv_row(int c, int perm) { if (perm == 1) { const int h = c / 96, d = c % 96; return d < 64 ? 64 * h + d : 512 + 32 * h + d - 64; } if (perm == 2) { const int h = c >> 7, d = c & 127; return d < 64 ? 64 * h + d : 512 + 64 * h + d - 64; } return c; }
__device__ __forceinline__ void conv_emit(const f32x4 (&v)[16], LAS unsigned char* T  , bf16_t* __restrict__ WT, int ldd, int n0, int k0, int lane, int perm) {
    const int kq = lane >> 4, c4 = lane & 15;
#pragma unroll
    for (int jj = 0; jj < 4; ++jj) { u32x4 lo, hi;
        lo.x = cvt_pk_bf16(v[0][jj], v[1][jj]); lo.y = cvt_pk_bf16(v[2][jj], v[3][jj]); lo.z = cvt_pk_bf16(v[4][jj], v[5][jj]); lo.w = cvt_pk_bf16(v[6][jj], v[7][jj]);
        hi.x = cvt_pk_bf16(v[8][jj], v[9][jj]); hi.y = cvt_pk_bf16(v[10][jj], v[11][jj]); hi.z = cvt_pk_bf16(v[12][jj], v[13][jj]); hi.w = cvt_pk_bf16(v[14][jj], v[15][jj]);
        LAS unsigned char* q = T + (4 * c4 + jj) * 144 + 32 * kq; *(LAS u32x4*)q = lo; *(LAS u32x4*)(q + 16) = hi; }
    asm volatile("s_waitcnt lgkmcnt(0)" ::: "memory");
#pragma unroll
    for (int s8 = 0; s8 < 8; ++s8) { const int n = 8 * s8 + (lane >> 3), ch = lane & 7; const u32x4 w = *(const LAS u32x4*)(T + n * 144 + 16 * ch);
        *(u32x4*)(WT + (size_t)conv_row(n0 + n, perm) * ldd + k0 + 8 * ch) = w; }
    asm volatile("s_waitcnt lgkmcnt(0)" ::: "memory");
}
__device__ __forceinline__ void conv8_tile(const float* __restrict__ W, int N, unsigned char* __restrict__ WT, int ldd, int n0, int k0, LAS unsigned char* T  , int lane) {
    const int kq = lane >> 4, c4 = lane & 15; const float* p = W + (size_t)(k0 + 32 * kq) * N + n0 + 4 * c4;
    f32x4 v[32];
#pragma unroll
    for (int i = 0; i < 32; ++i) v[i] = __builtin_nontemporal_load((const f32x4*)(p + (size_t)i * N));
#pragma unroll
    for (int jj = 0; jj < 4; ++jj) { u32x4 lo, hi;
        lo.x = pk4_fp8(32.f * v[0][jj], 32.f * v[1][jj], 32.f * v[2][jj], 32.f * v[3][jj]);     lo.y = pk4_fp8(32.f * v[4][jj], 32.f * v[5][jj], 32.f * v[6][jj], 32.f * v[7][jj]);
        lo.z = pk4_fp8(32.f * v[8][jj], 32.f * v[9][jj], 32.f * v[10][jj], 32.f * v[11][jj]);   lo.w = pk4_fp8(32.f * v[12][jj], 32.f * v[13][jj], 32.f * v[14][jj], 32.f * v[15][jj]);
        hi.x = pk4_fp8(32.f * v[16][jj], 32.f * v[17][jj], 32.f * v[18][jj], 32.f * v[19][jj]); hi.y = pk4_fp8(32.f * v[20][jj], 32.f * v[21][jj], 32.f * v[22][jj], 32.f * v[23][jj]);
        hi.z = pk4_fp8(32.f * v[24][jj], 32.f * v[25][jj], 32.f * v[26][jj], 32.f * v[27][jj]); hi.w = pk4_fp8(32.f * v[28][jj], 32.f * v[29][jj], 32.f * v[30][jj], 32.f * v[31][jj]);
        LAS unsigned char* q = T + (4 * c4 + jj) * 144 + 32 * kq; *(LAS u32x4*)q = lo; *(LAS u32x4*)(q + 16) = hi; }
    asm volatile("s_waitcnt lgkmcnt(0)" ::: "memory");
#pragma unroll
    for (int s8 = 0; s8 < 8; ++s8) { const int n = 8 * s8 + (lane >> 3), ch = lane & 7; const u32x4 w = *(const LAS u32x4*)(T + n * 144 + 16 * ch);
        *(u32x4*)(WT + (size_t)(n0 + n) * ldd + k0 + 16 * ch) = w; }
    asm volatile("s_waitcnt lgkmcnt(0)" ::: "memory");
}
template <class AP> __device__ __forceinline__ void p0_prologue(const Ctx& C, AP a) {
    unsigned char* ws = C.ws;
    { const float* c = (const float*)a->in[1]; const float* ada_w = (const float*)a->in[3]; const float* ada_b = (const float*)a->in[4]; float* mod = (float*)(ws + O_MOD);
      LAS float* part = (LAS float*)C.lds;
      LAS float* cact = (LAS float*)(C.lds + 32768);
      if (C.bid < 4 * 24) { for (int i = C.tid; i < 4096; i += 512) { const int b = i >> 10, k = i & 1023; const float cv = c[i]; cact[k * 4 + b] = cv / (1.f + expf(-cv)); } __syncthreads(); }
      for (int it = C.bid; it < 4 * 24; it += C.G) { const int l = it / 24, n0 = (it % 24) * 256;
          f32x4 acc[4];
#pragma unroll
          for (int b = 0; b < 4; ++b) acc[b] = (f32x4){0.f, 0.f, 0.f, 0.f};
          const float* w = ada_w + (size_t)l * 1024 * 6144 + n0 + 4 * C.lane;
#pragma unroll 1
          for (int k0 = C.wave * 128; k0 < C.wave * 128 + 128; k0 += 16) { f32x4 wv[16];
#pragma unroll
              for (int i = 0; i < 16; ++i) wv[i] = __builtin_nontemporal_load((const f32x4*)(w + (size_t)(k0 + i) * 6144));
#pragma unroll
              for (int i = 0; i < 16; ++i) { const f32x4 sv = *(const LAS f32x4*)(cact + (k0 + i) * 4);
#pragma unroll
                  for (int b = 0; b < 4; ++b) acc[b] = acc[b] + sv[b] * wv[i]; } }
#pragma unroll
          for (int b = 0; b < 4; ++b) *(LAS f32x4*)(part + (C.wave * 4 + b) * 256 + 4 * C.lane) = acc[b];
          __syncthreads();
          for (int o = C.tid; o < 1024; o += 512) { const int b = o >> 8, n = o & 255; float sacc = ada_b[l * 6144 + n0 + n];
#pragma unroll
              for (int w8 = 0; w8 < 8; ++w8) sacc += part[(w8 * 4 + b) * 256 + n];
              mod[((size_t)l * 4 + b) * 6144 + n0 + n] = sacc; }
          __syncthreads(); } }
    { const int* positions = (const int*)a->in[2]; float* cs = (float*)(ws + O_CS);
      for (int i = C.bid * 512 + C.tid; i < T_ * 16; i += C.G * 512) { const int t = i >> 4, f = i & 15; const float inv = powf(10000.f, -(float)(2 * f) / 32.f); const float ang = (float)positions[t] * inv;
          cs[t * 32 + f] = cosf(ang); cs[t * 32 + 16 + f] = sinf(ang); } }
    { const float* lam = (const float*)a->in[25]; float* spv = (float*)(ws + O_SPV);
      for (int i = C.bid * 512 + C.tid; i < 2048; i += C.G * 512) spv[i] = -8.f * 1.4426950408889634f * log1pf(expf(-lam[i])); }
    { const int lane = C.lane; LAS unsigned char* T = C.lds + 49152 + C.wave * 9216;
      const float* attn_w_in = (const float*)a->in[7]; const float* w_uq = (const float*)a->in[12]; const float* w_ukv = (const float*)a->in[13]; const float* attn_w_out = (const float*)a->in[16];
      const float* rec_w_in = (const float*)a->in[17]; const float* rec_wa = (const float*)a->in[21]; const float* rec_wx = (const float*)a->in[23]; const float* rec_w_out = (const float*)a->in[26];
      const float* w1 = (const float*)a->in[30]; const float* w2 = (const float*)a->in[32];
      constexpr int T_WIN = 32 * 16, T_WUQ = 12 * 4, T_WUKV = 16 * 2, T_WOUT = 16 * 16, T_RWIN = 32 * 16, T_RG = 2 * 2, T_RWOUT = 16 * 16, T_W1 = 32 * 16, T_W2 = 16 * 16;
      constexpr int NITEMS = 2 * (T_WIN + T_WUQ + T_WUKV + T_WOUT + T_RWIN + 16 * T_RG + T_RWOUT);
      struct Job { const float* W; bf16_t* WT; int N, ldd, n0, k0, perm; };
      auto decode = [&](int r, Job& jb) {
#define CONV_JOB(SRC, KK, NN, DST, NROWS, NMAT, SRC_MS, DST_MS, PERM) { constexpr int kc_ = (KK) / 64, per_ = ((NROWS) / 64) * kc_, tot_ = per_ * (NMAT); \
          if (r < tot_) { const int mat_ = r / per_, q_ = r % per_; jb.W = (SRC) + (size_t)mat_ * (SRC_MS); jb.WT = (bf16_t*)(ws + (DST) + (size_t)mat_ * (DST_MS)); jb.N = (NN); jb.ldd = (KK); jb.n0 = (q_ / kc_) * 64; jb.k0 = (q_ % kc_) * 64; jb.perm = (PERM); return; } r -= tot_; }
          CONV_JOB(attn_w_in, 1024, 1952, O_WIN, 2048, 2, (size_t)1024 * 1952, SZ_WIN, 0)
          CONV_JOB(w_uq, 256, 768, O_WUQ, 768, 2, (size_t)256 * 768, SZ_WUQ, 1)
          CONV_JOB(w_ukv, 128, 1024, O_WUKV, 1024, 2, (size_t)128 * 1024, SZ_WUKV, 2)
          CONV_JOB(attn_w_out, 1024, 1024, O_WOUT, 1024, 2, (size_t)1024 * 1024, SZ_WOUT, 0)
          CONV_JOB(rec_w_in, 1024, 2048, O_RWIN, 2048, 2, (size_t)1024 * 2048, SZ_RWIN, 0)
          CONV_JOB(rec_wa, 128, 128, O_RGATE, 128, 16, (size_t)128 * 128, (size_t)256 * 128 * 2, 0)
          CONV_JOB(rec_wx, 128, 128, O_RGATE + (size_t)128 * 128 * 2, 128, 16, (size_t)128 * 128, (size_t)256 * 128 * 2, 0)
          CONV_JOB(rec_w_out, 1024, 1024, O_RWOUT, 1024, 2, (size_t)1024 * 1024, SZ_RWOUT, 0)
#undef CONV_JOB
          jb.W = attn_w_in; jb.WT = (bf16_t*)(ws + O_WIN); jb.N = 1952; jb.ldd = 1024; jb.n0 = 0; jb.k0 = 0; jb.perm = 0; };
      f32x4 va[16], vb[16]; Job ja, jn;
      int it = C.gw;
      if (it < NITEMS) { decode(it, ja); conv_load(va, ja.W, ja.N, ja.n0, ja.k0, lane); }
#pragma unroll 1
      for (; it < NITEMS; it += 2 * C.NGW) {
          const bool h1 = it + C.NGW < NITEMS;
          if (h1) { decode(it + C.NGW, jn); conv_load(vb, jn.W, jn.N, jn.n0, jn.k0, lane); }
          conv_emit(va, T, ja.WT, ja.ldd, ja.n0, ja.k0, lane, ja.perm);
          const bool h2 = it + 2 * C.NGW < NITEMS;
          if (h2) { decode(it + 2 * C.NGW, ja); conv_load(va, ja.W, ja.N, ja.n0, ja.k0, lane); }
          if (h1) conv_emit(vb, T, jn.WT, jn.ldd, jn.n0, jn.k0, lane, jn.perm);
      }
    }
}

__device__ __forceinline__ void phase_norm(const Ctx& C, const float* xin  , float* out  , bool combine, bool do_norm, const float* gain, const float* modc  , const float* modl  , int shoff, int scoff, bool dummy = false) {
    const bf16_t* Y2 = (const bf16_t*)(C.ws + O_Y2); const int* pos = (const int*)(C.ws + O_POS); const float* topg = (const float*)(C.ws + O_TOPG); bf16_t* HN = (bf16_t*)(C.ws + (dummy ? O_DUMMY : O_HN)); const bf16_t* X = (const bf16_t*)(C.ws + O_X); bf16_t* Xo = (bf16_t*)(C.ws + (dummy ? O_DUMMY + 32 * MiB : O_X));
    const int lane = C.lane;
    for (int t = C.gw; t < T_; t += C.NGW) { const int b = t / S_;
        f32x4 v[4];
        if (xin) {
#pragma unroll
            for (int j = 0; j < 4; ++j) v[j] = *(const f32x4*)(xin + (size_t)t * 1024 + 256 * j + 4 * lane); }
        else {
#pragma unroll
            for (int j = 0; j < 4; ++j) { const u32x2 w = *(const u32x2*)(X + (size_t)t * 1024 + 256 * j + 4 * lane); v[j] = (f32x4){bf_lo(w.x), bf_hi(w.x), bf_lo(w.y), bf_hi(w.y)}; } }
        if (combine) { f32x4 y[4];
#pragma unroll
            for (int j = 0; j < 4; ++j) y[j] = (f32x4){0.f, 0.f, 0.f, 0.f};
#pragma unroll
            for (int k = 0; k < 4; ++k) { const int p = pos[t * 4 + k]; const float gk = topg[t * 4 + k];
#pragma unroll
                for (int j = 0; j < 4; ++j) { const u32x2 w = *(const u32x2*)(Y2 + (size_t)p * 1024 + 256 * j + 4 * lane);
                    y[j][0] += gk * bf_lo(w.x); y[j][1] += gk * bf_hi(w.x); y[j][2] += gk * bf_lo(w.y); y[j][3] += gk * bf_hi(w.y); } }
#pragma unroll
            for (int j = 0; j < 4; ++j) { const f32x4 g2 = *(const f32x4*)(modc + b * 6144 + 5120 + 256 * j + 4 * lane); v[j] = v[j] + g2 * y[j]; } }
        if (out) {
#pragma unroll
            for (int j = 0; j < 4; ++j) *(f32x4*)(out + (size_t)t * 1024 + 256 * j + 4 * lane) = v[j]; }
        else {
#pragma unroll
            for (int j = 0; j < 4; ++j) { u32x2 w; w.x = cvt_pk_bf16(v[j][0], v[j][1]); w.y = cvt_pk_bf16(v[j][2], v[j][3]); *(u32x2*)(Xo + (size_t)t * 1024 + 256 * j + 4 * lane) = w; } }
        if (do_norm) { float ss = 0.f;
#pragma unroll
            for (int j = 0; j < 4; ++j) ss += (v[j][0] * v[j][0] + v[j][1] * v[j][1]) + (v[j][2] * v[j][2] + v[j][3] * v[j][3]);
            const float rs = rsqrtf(wsum(ss) * (1.f / 1024.f) + 1e-6f);
#pragma unroll
            for (int j = 0; j < 4; ++j) { const int col = 256 * j + 4 * lane; const f32x4 gn = *(const f32x4*)(gain + col), sc = *(const f32x4*)(modl + b * 6144 + scoff + col), sh = *(const f32x4*)(modl + b * 6144 + shoff + col);
                const f32x4 h = v[j] * rs * gn * (1.f + sc) + sh;
                u32x2 w; w.x = cvt_pk_bf16(h[0], h[1]); w.y = cvt_pk_bf16(h[2], h[3]); *(u32x2*)(HN + (size_t)t * 1024 + col) = w; } }
    }
}

__device__ __forceinline__ void unpack8(const u32x4 w, float (&f)[8]) { f[0] = bf_lo(w.x); f[1] = bf_hi(w.x); f[2] = bf_lo(w.y); f[3] = bf_hi(w.y); f[4] = bf_lo(w.z); f[5] = bf_hi(w.z); f[6] = bf_lo(w.w); f[7] = bf_hi(w.w); }
__device__ __forceinline__ u32x4 pack8(const float (&f)[8]) { u32x4 w; w.x = cvt_pk_bf16(f[0], f[1]); w.y = cvt_pk_bf16(f[2], f[3]); w.z = cvt_pk_bf16(f[4], f[5]); w.w = cvt_pk_bf16(f[6], f[7]); return w; }

constexpr float LOG2E = 1.4426950408889634f;
__device__ __forceinline__ void phase_postproj(const Ctx& C, const float* qg, const float* kg, const float* qag, const float* kvag, const float* mkg) {
    bf16_t* PROJ = (bf16_t*)(C.ws + O_PROJ); const float* cs = (const float*)(C.ws + O_CS); const int lane = C.lane;
    for (int t = C.gw; t < T_; t += C.NGW) { bf16_t* row = PROJ + (size_t)t * 2048;
#pragma unroll
        for (int ps = 0; ps < 2; ++ps) { bf16_t* p = row + ps * 512 + 8 * lane; float f[8]; unpack8(*(const u32x4*)p, f); float ss = 0.f;
#pragma unroll
            for (int i = 0; i < 8; ++i) ss += f[i] * f[i];
            ss += shx<1>(ss); ss += shx<2>(ss); ss += shx<4>(ss);
            const float rs = rsqrtf(ss * (1.f / 64.f) + 1e-6f) * (ps == 0 ? 0.125f * LOG2E : 1.f); const float* g = (ps == 0 ? qg : kg) + 8 * (lane & 7);
#pragma unroll
            for (int i = 0; i < 8; ++i) f[i] = f[i] * rs * g[i];
            *(u32x4*)p = pack8(f); }
        { bf16_t* p = row + 1536 + 8 * lane; float f[8]; unpack8(*(const u32x4*)p, f); float ss = 0.f;
#pragma unroll
            for (int i = 0; i < 8; ++i) ss += f[i] * f[i];
            ss += shx<1>(ss); ss += shx<2>(ss);
            { const float o4 = shx<4>(ss); if (lane < 48) ss += o4; } { const float o8 = shx<8>(ss); if (lane < 48) ss += o8; } { const float o16 = shx<16>(ss); if (lane < 32) ss += o16; }
            const float nrm = lane < 32 ? 256.f : (lane < 48 ? 128.f : 32.f);
            const float rs = rsqrtf(ss / nrm + 1e-6f);
            const float* g = lane < 32 ? (qag + 8 * lane) : (lane < 48 ? (kvag + 8 * (lane - 32)) : (mkg + 64 + 8 * ((lane - 48) & 3)));
#pragma unroll
            for (int i = 0; i < 8; ++i) f[i] = f[i] * rs * g[i];
            float o[8];
#pragma unroll
            for (int i = 0; i < 8; ++i) { const float other = shx<2>(f[i]); const int fi = ((lane & 1) << 3) + i; const float cv = cs[t * 32 + fi], sv = cs[t * 32 + 16 + fi];
                o[i] = (lane & 2) ? (other * sv + f[i] * cv) : (f[i] * cv - other * sv); }
            if (lane >= 48 && lane < 52) {
#pragma unroll
                for (int i = 0; i < 8; ++i) f[i] = o[i]; }
            if (lane < 52) *(u32x4*)p = pack8(f); }
    }
}
__device__ __forceinline__ void phase_postq(const Ctx& C, const float* mqg, const float* mkg) {
    bf16_t* Q2 = (bf16_t*)(C.ws + O_Q2); bf16_t* KV2 = (bf16_t*)(C.ws + O_KV2); const float* cs = (const float*)(C.ws + O_CS); const int lane = C.lane;
    const float qscale = 0.10206207261596575f * LOG2E;
    for (int t = C.gw; t < T_; t += C.NGW) {
        { bf16_t* p = Q2 + (size_t)t * 768 + (lane >> 3) * 96 + 8 * (lane & 7); float f[8]; unpack8(*(const u32x4*)p, f); float ss = 0.f;
#pragma unroll
            for (int i = 0; i < 8; ++i) ss += f[i] * f[i];
            ss += shx<1>(ss); ss += shx<2>(ss); ss += shx<4>(ss);
            const float rs = rsqrtf(ss * (1.f / 64.f) + 1e-6f) * qscale; const float* g = mqg + 8 * (lane & 7);
#pragma unroll
            for (int i = 0; i < 8; ++i) f[i] = f[i] * rs * g[i];
            *(u32x4*)p = pack8(f); }
        { const int l2 = lane & 31; bf16_t* p = Q2 + (size_t)t * 768 + (l2 >> 2) * 96 + 64 + 8 * (l2 & 3); float f[8]; unpack8(*(const u32x4*)p, f); float ss = 0.f;
#pragma unroll
            for (int i = 0; i < 8; ++i) ss += f[i] * f[i];
            ss += shx<1>(ss); ss += shx<2>(ss);
            const float rs = rsqrtf(ss * (1.f / 32.f) + 1e-6f) * qscale; const float* g = mqg + 64 + 8 * (l2 & 3);
#pragma unroll
            for (int i = 0; i < 8; ++i) f[i] = f[i] * rs * g[i];
            float o[8];
#pragma unroll
            for (int i = 0; i < 8; ++i) { const float other = shx<2>(f[i]); const int fi = ((lane & 1) << 3) + i; const float cv = cs[t * 32 + fi], sv = cs[t * 32 + 16 + fi];
                o[i] = (lane & 2) ? (other * sv + f[i] * cv) : (f[i] * cv - other * sv); }
            if (lane < 32) *(u32x4*)p = pack8(o); }
        { bf16_t* p = KV2 + (size_t)t * 1024 + (lane >> 3) * 128 + 8 * (lane & 7); float f[8]; unpack8(*(const u32x4*)p, f); float ss = 0.f;
#pragma unroll
            for (int i = 0; i < 8; ++i) ss += f[i] * f[i];
            ss += shx<1>(ss); ss += shx<2>(ss); ss += shx<4>(ss);
            const float rs = rsqrtf(ss * (1.f / 64.f) + 1e-6f); const float* g = mkg + 8 * (lane & 7);
#pragma unroll
            for (int i = 0; i < 8; ++i) f[i] = f[i] * rs * g[i];
            *(u32x4*)p = pack8(f); }
    }
}
__device__ __forceinline__ void phase_mixcombine(const Ctx& C) {
    const bf16_t* OA = (const bf16_t*)(C.ws + O_OA); const float* LSE = (const float*)(C.ws + O_LSE); bf16_t* ATT = (bf16_t*)(C.ws + O_ATT); const int lane = C.lane;
    for (int t = C.gw; t < T_; t += C.NGW) { const int h = lane >> 3;
        float ls[3], mx = -INFINITY;
#pragma unroll
        for (int p = 0; p < 3; ++p) { ls[p] = LSE[((size_t)p * T_ + t) * 8 + h]; mx = fmaxf(mx, ls[p]); }
        float w[3], den = 0.f;
#pragma unroll
        for (int p = 0; p < 3; ++p) { w[p] = fexp2(ls[p] - mx); den += w[p]; }
        const float inv = 1.f / den; float o[8];
#pragma unroll
        for (int i = 0; i < 8; ++i) o[i] = 0.f;
#pragma unroll
        for (int p = 0; p < 3; ++p) { float f[8]; unpack8(*(const u32x4*)(OA + ((size_t)p * T_ + t) * 512 + 8 * lane), f); const float wp = w[p] * inv;
#pragma unroll
            for (int i = 0; i < 8; ++i) o[i] += wp * f[i]; }
        *(u32x4*)(ATT + (size_t)t * 1024 + 8 * lane) = pack8(o); }
}
__device__ __forceinline__ void phase_rgate(const Ctx& C, int j, const float* cw, const float* cb, const float* ba, const float* bx) {
    const bf16_t* PROJ = (const bf16_t*)(C.ws + O_PROJ); const bf16_t* RG = (const bf16_t*)(C.ws + O_RGATE + (size_t)j * SZ_RGATE); const float* spvg = (const float*)(C.ws + O_SPV) + j * 1024;
    bf16_t* LA = (bf16_t*)(C.ws + O_AA); bf16_t* Bb = (bf16_t*)(C.ws + O_BB); float* SP = (float*)(C.ws + O_SUMP); float* SH = (float*)(C.ws + O_SUMH);
    constexpr int WROW = 272;
    LAS unsigned char* Wl = C.lds;
    LAS unsigned char* Xl = C.lds + 256 * WROW;
    LAS unsigned char* Al = Xl + 64 * WROW;
    LAS unsigned char* Bl = Al + 64 * WROW;
    const int tid = C.tid, lane = C.lane, w = C.wave;
    if (C.G % 8 != 0) return;
    const int n = C.bid & 7, g = C.bid >> 3, ng = C.G >> 3;
    for (int i = tid; i < 256 * 16; i += 512) { const int r = i >> 4, c = i & 15; *(LAS u32x4*)(Wl + r * WROW + 16 * c) = *(const u32x4*)(RG + ((size_t)n * 256 + r) * 128 + 8 * c); }
    const int crow = tid >> 3, cg = tid & 7, cch = n * 128 + 16 * cg;
    float cwv[4][16], cbv[16];
#pragma unroll
    for (int q = 0; q < 4; ++q) { const f32x4 b4 = *(const f32x4*)(cb + cch + 4 * q); cbv[4 * q] = b4[0]; cbv[4 * q + 1] = b4[1]; cbv[4 * q + 2] = b4[2]; cbv[4 * q + 3] = b4[3];
#pragma unroll
        for (int k = 0; k < 4; ++k) { const f32x4 w4 = *(const f32x4*)(cw + k * 1024 + cch + 4 * q); cwv[k][4 * q] = w4[0]; cwv[k][4 * q + 1] = w4[1]; cwv[k][4 * q + 2] = w4[2]; cwv[k][4 * q + 3] = w4[3]; } }
    const int mt = w & 3, h = w >> 2, l15 = lane & 15, kg = lane >> 4;
    float bav[4], bxv[4], spv[4];
#pragma unroll
    for (int jj = 0; jj < 4; ++jj) { const int ch = n * 128 + 16 * (4 * h + jj) + l15; bav[jj] = ba[ch]; bxv[jj] = bx[ch]; spv[jj] = spvg[ch]; }
    __syncthreads();
    for (int c = g; c < 256; c += ng) { const size_t row0 = (size_t)c * 64; const int ts0 = (int)(row0 % S_);
        { float acc[16];
#pragma unroll
          for (int i = 0; i < 16; ++i) acc[i] = cbv[i];
#pragma unroll
          for (int k = 0; k < 4; ++k) { const int dt = k - 3; if (ts0 + crow + dt >= 0) { const bf16_t* src = PROJ + (row0 + crow + dt) * 2048 + 1024 + cch; float f0[8], f1[8]; unpack8(*(const u32x4*)src, f0); unpack8(*(const u32x4*)(src + 8), f1);
#pragma unroll
                  for (int i = 0; i < 8; ++i) { acc[i] += cwv[k][i] * f0[i]; acc[8 + i] += cwv[k][8 + i] * f1[i]; } } }
          float lo[8], hi8[8];
#pragma unroll
          for (int i = 0; i < 8; ++i) { lo[i] = acc[i]; hi8[i] = acc[8 + i]; }
          *(LAS u32x4*)(Xl + crow * WROW + 32 * cg) = pack8(lo); *(LAS u32x4*)(Xl + crow * WROW + 32 * cg + 16) = pack8(hi8); }
        __syncthreads();
        f32x4 acc[8];
#pragma unroll
        for (int t = 0; t < 8; ++t) acc[t] = (f32x4){0.f, 0.f, 0.f, 0.f};
#pragma unroll
        for (int ks = 0; ks < 4; ++ks) { const bf16x8 af = *(const LAS bf16x8*)(Xl + (16 * mt + l15) * WROW + 64 * ks + 16 * kg);
#pragma unroll
            for (int t = 0; t < 8; ++t) { const int nt = (t < 4) ? (4 * h + t) : (8 + 4 * h + (t - 4)); const bf16x8 bfr = *(const LAS bf16x8*)(Wl + (16 * nt + l15) * WROW + 64 * ks + 16 * kg);
                acc[t] = __builtin_amdgcn_mfma_f32_16x16x32_bf16(af, bfr, acc[t], 0, 0, 0); } }
#pragma unroll
        for (int jj = 0; jj < 4; ++jj) { const int e = 16 * (4 * h + jj) + l15;
#pragma unroll
            for (int r = 0; r < 4; ++r) { const int row = 16 * mt + 4 * kg + r; const float xc = bf_lo((unsigned)*(const LAS unsigned short*)(Xl + row * WROW + 2 * e));
                const float rr = fsigmoid(acc[jj][r] + bav[jj]), ig = fsigmoid(acc[4 + jj][r] + bxv[jj]); const float la = rr * spv[jj], av = fexp2(la);
                const float bv = __builtin_amdgcn_sqrtf(fmaxf(1.f - av * av, 0.f)) * ig * xc;
                *(LAS unsigned short*)(Al + row * WROW + 2 * e) = (unsigned short)(cvt_pk_bf16(la, la) & 0xffffu); *(LAS unsigned short*)(Bl + row * WROW + 2 * e) = (unsigned short)(cvt_pk_bf16(bv, bv) & 0xffffu); } }
        __syncthreads();
        { const size_t go = (row0 + crow) * 1024 + cch;
          *(u32x4*)(LA + go) = *(const LAS u32x4*)(Al + crow * WROW + 32 * cg); *(u32x4*)(LA + go + 8) = *(const LAS u32x4*)(Al + crow * WROW + 32 * cg + 16);
          *(u32x4*)(Bb + go) = *(const LAS u32x4*)(Bl + crow * WROW + 32 * cg); *(u32x4*)(Bb + go + 8) = *(const LAS u32x4*)(Bl + crow * WROW + 32 * cg + 16); }
        if (tid < 128) { float Pl = 0.f, Hh = 0.f;
#pragma unroll 8
            for (int r = 0; r < 64; ++r) { const float la = bf_lo((unsigned)*(const LAS unsigned short*)(Al + r * WROW + 2 * tid)), bv = bf_lo((unsigned)*(const LAS unsigned short*)(Bl + r * WROW + 2 * tid)); Hh = fexp2(la) * Hh + bv; Pl += la; }
            const int b = (int)(row0 / S_), ck = (int)((row0 % S_) >> 6); SP[((size_t)b * 64 + ck) * 1024 + n * 128 + tid] = fexp2(Pl); SH[((size_t)b * 64 + ck) * 1024 + n * 128 + tid] = Hh; }
        __syncthreads();
    }
}

__device__ __forceinline__ void scan_sum_item(const Ctx& C, int b, int ck, int cg) {
    const bf16_t* LA = (const bf16_t*)(C.ws + O_AA); const bf16_t* Bb = (const bf16_t*)(C.ws + O_BB); float* SP = (float*)(C.ws + O_SUMP); float* SH = (float*)(C.ws + O_SUMH);
    const int ch = cg * 128 + 2 * C.lane;
    size_t off = ((size_t)b * S_ + ck * 64) * 1024 + ch; f32x2 Pl = (f32x2){0.f, 0.f}, Hh = (f32x2){0.f, 0.f};
#pragma unroll 8
    for (int s = 0; s < 64; ++s, off += 1024) { const unsigned lw = *(const unsigned*)(LA + off), bw = *(const unsigned*)(Bb + off);
        const f32x2 lv = (f32x2){bf_lo(lw), bf_hi(lw)}, av = (f32x2){fexp2(lv[0]), fexp2(lv[1])}, bv = (f32x2){bf_lo(bw), bf_hi(bw)}; Hh = av * Hh + bv; Pl = Pl + lv; }
    *(f32x2*)(SP + ((size_t)b * 64 + ck) * 1024 + ch) = (f32x2){fexp2(Pl[0]), fexp2(Pl[1])}; *(f32x2*)(SH + ((size_t)b * 64 + ck) * 1024 + ch) = Hh;
}
__device__ __forceinline__ void phase_scan_sum_own(const Ctx& C) {
    asm volatile("s_waitcnt vmcnt(0)" ::: "memory"); __syncthreads();
    for (int i = 0; ; ++i) { const int L = i * C.G + C.bid; if (L >= 512) break; const int pm = L >> 3, n = L & 7;
        if (C.wave < 4) { const int row0 = pm * 256 + C.wave * 64; scan_sum_item(C, row0 / S_, (row0 % S_) >> 6, n); } }
}
__device__ __forceinline__ void phase_scan_apply(const Ctx& C) {
    const bf16_t* LA = (const bf16_t*)(C.ws + O_AA); const bf16_t* Bb = (const bf16_t*)(C.ws + O_BB); const float* SP = (const float*)(C.ws + O_SUMP); const float* SH = (const float*)(C.ws + O_SUMH);
    const bf16_t* PROJ = (const bf16_t*)(C.ws + O_PROJ); bf16_t* ATT = (bf16_t*)(C.ws + O_ATT); const int lane = C.lane;
    for (int it = C.gw; it < 4 * 64 * 8; it += C.NGW) { const int cg = it & 7, ck = (it >> 3) & 63, b = it >> 9; const int ch = cg * 128 + 2 * lane;
        f32x2 h = (f32x2){0.f, 0.f};
#pragma unroll 8
        for (int c2 = 0; c2 < ck; ++c2) { const f32x2 pv = *(const f32x2*)(SP + ((size_t)b * 64 + c2) * 1024 + ch), hv = *(const f32x2*)(SH + ((size_t)b * 64 + c2) * 1024 + ch); h = pv * h + hv; }
        size_t row = (size_t)b * S_ + ck * 64;
#pragma unroll 8
        for (int s = 0; s < 64; ++s, ++row) { const unsigned lw = *(const unsigned*)(LA + row * 1024 + ch), bw = *(const unsigned*)(Bb + row * 1024 + ch);
            const f32x2 av = (f32x2){fexp2(bf_lo(lw)), fexp2(bf_hi(lw))}, bv = (f32x2){bf_lo(bw), bf_hi(bw)}; h = av * h + bv;
            const unsigned gw2 = *(const unsigned*)(PROJ + row * 2048 + ch);
            *(unsigned*)(ATT + row * 1024 + ch) = cvt_pk_bf16(bf_lo(gw2) * h[0], bf_hi(gw2) * h[1]); } }
}

__device__ __forceinline__ void split_bf16(const f32x4 a, const f32x4 b, bf16x8& hi, bf16x8& lo) {
    u32x4 h; h.x = cvt_pk_bf16(a[0], a[1]); h.y = cvt_pk_bf16(a[2], a[3]); h.z = cvt_pk_bf16(b[0], b[1]); h.w = cvt_pk_bf16(b[2], b[3]);
    u32x4 l; l.x = cvt_pk_bf16(a[0] - bf_lo(h.x), a[1] - bf_hi(h.x)); l.y = cvt_pk_bf16(a[2] - bf_lo(h.y), a[3] - bf_hi(h.y)); l.z = cvt_pk_bf16(b[0] - bf_lo(h.z), b[1] - bf_hi(h.z)); l.w = cvt_pk_bf16(b[2] - bf_lo(h.w), b[3] - bf_hi(h.w));
    hi = __builtin_bit_cast(bf16x8, h); lo = __builtin_bit_cast(bf16x8, l);
}
__device__ __forceinline__ void phase_router(const Ctx& C, const bf16_t* X, const float* gain, const float* modl, const float* wr, const float* br) {
    unsigned char* HN8 = C.ws + O_HN; int* topi = (int*)(C.ws + O_TOPI); float* topg = (float*)(C.ws + O_TOPG); int* hist = (int*)(C.ws + O_HIST);
    constexpr int HROW = 1028;
    LAS float* hrow = (LAS float*)C.lds;
    LAS float* part = (LAS float*)(C.lds + 16 * HROW * 4);
    LAS int* hl = (LAS int*)(C.lds + LX_MISC);
    const int lane = C.lane, e = lane & 31, kh = lane >> 5, v = C.wave, l15 = lane & 15, kg = lane >> 4;
    bf16x8 whi[2][4], wlo[2][4];
#pragma unroll
    for (int nt = 0; nt < 2; ++nt)
#pragma unroll
        for (int ks = 0; ks < 4; ++ks) { const float* p = wr + (size_t)(128 * v + 32 * ks + 8 * kg) * 32 + 16 * nt + l15;
            const f32x4 a = (f32x4){p[0], p[32], p[64], p[96]}, b = (f32x4){p[128], p[160], p[192], p[224]}; split_bf16(a, b, whi[nt][ks], wlo[nt][ks]); }
    const float bias_e = br[e];
    if (C.tid < 32) hl[C.tid] = 0;
    __syncthreads();
    for (int ck = C.bid; ck < 256; ck += C.G) {
        const int b = (ck * 64) / S_;
        f32x4 gn[4], shv[4];
#pragma unroll
        for (int j = 0; j < 4; ++j) { const int col = 256 * j + 4 * lane; gn[j] = *(const f32x4*)(gain + col) * (1.f + *(const f32x4*)(modl + b * 6144 + 4096 + col)); shv[j] = *(const f32x4*)(modl + b * 6144 + 3072 + col); }
        u32x2 xr[2][4];
#pragma unroll
        for (int q = 0; q < 2; ++q)
#pragma unroll
            for (int j = 0; j < 4; ++j) xr[q][j] = *(const u32x2*)(X + (size_t)(ck * 64 + 2 * v + q) * 1024 + 256 * j + 4 * lane);
#pragma unroll 1
        for (int pass = 0; pass < 4; ++pass) { const int tb = ck * 64 + pass * 16;
#pragma unroll
            for (int q = 0; q < 2; ++q) { const int tt = 2 * v + q, t = tb + tt; f32x4 h[4]; float ss = 0.f;
#pragma unroll
                for (int j = 0; j < 4; ++j) { const u32x2 xw = xr[q][j]; h[j] = (f32x4){bf_lo(xw.x), bf_hi(xw.x), bf_lo(xw.y), bf_hi(xw.y)}; ss += (h[j][0] * h[j][0] + h[j][1] * h[j][1]) + (h[j][2] * h[j][2] + h[j][3] * h[j][3]); }
                const float rs = rsqrtf(wsum(ss) * (1.f / 1024.f) + 1e-6f);
#pragma unroll
                for (int j = 0; j < 4; ++j) { const int col = 256 * j + 4 * lane;
                    const f32x4 hv = h[j] * rs * gn[j] + shv[j];
                    *(unsigned*)(HN8 + (size_t)t * 1024 + col) = pk4_fp8(hv[0], hv[1], hv[2], hv[3]);
                    *(LAS f32x4*)(hrow + tt * HROW + col) = hv; } }
            if (pass < 3) {
#pragma unroll
                for (int q = 0; q < 2; ++q)
#pragma unroll
                    for (int j = 0; j < 4; ++j) xr[q][j] = *(const u32x2*)(X + (size_t)(tb + 16 + 2 * v + q) * 1024 + 256 * j + 4 * lane); }
            __syncthreads();
            { f32x4 acc0 = (f32x4){0.f, 0.f, 0.f, 0.f}, acc1 = acc0;
#pragma unroll
              for (int ks = 0; ks < 4; ++ks) { const LAS float* hp = hrow + l15 * HROW + 128 * v + 32 * ks + 8 * kg; bf16x8 ahi, alo; split_bf16(*(const LAS f32x4*)hp, *(const LAS f32x4*)(hp + 4), ahi, alo);
                  acc0 = __builtin_amdgcn_mfma_f32_16x16x32_bf16(ahi, whi[0][ks], acc0, 0, 0, 0); acc1 = __builtin_amdgcn_mfma_f32_16x16x32_bf16(ahi, whi[1][ks], acc1, 0, 0, 0);
                  acc0 = __builtin_amdgcn_mfma_f32_16x16x32_bf16(ahi, wlo[0][ks], acc0, 0, 0, 0); acc1 = __builtin_amdgcn_mfma_f32_16x16x32_bf16(ahi, wlo[1][ks], acc1, 0, 0, 0);
                  acc0 = __builtin_amdgcn_mfma_f32_16x16x32_bf16(alo, whi[0][ks], acc0, 0, 0, 0); acc1 = __builtin_amdgcn_mfma_f32_16x16x32_bf16(alo, whi[1][ks], acc1, 0, 0, 0); }
#pragma unroll
              for (int r = 0; r < 4; ++r) { part[((4 * kg + r) * 8 + v) * 32 + l15] = acc0[r]; part[((4 * kg + r) * 8 + v) * 32 + 16 + l15] = acc1[r]; } }
            __syncthreads();
            { const int tt = 2 * v + kh; float lg = bias_e;
#pragma unroll
              for (int w8 = 0; w8 < 8; ++w8) lg += part[(tt * 8 + w8) * 32 + e];
              int idx[4]; float val[4];
#pragma unroll
              for (int k = 0; k < 4; ++k) { float mx = lg;
                  mx = fmaxf(mx, shx<1>(mx)); mx = fmaxf(mx, shx<2>(mx)); mx = fmaxf(mx, shx<4>(mx)); mx = fmaxf(mx, shx<8>(mx)); mx = fmaxf(mx, shx<16>(mx));
                  const unsigned long long bal = __ballot(lg == mx); const unsigned bh = (unsigned)(bal >> (32 * kh)); const int sel = __ffs((int)bh) - 1;
                  idx[k] = sel; val[k] = mx; if (e == sel) lg = -INFINITY; }
              if (e == 0) { const int t = tb + tt; float ex[4], den = 0.f;
#pragma unroll
                  for (int k = 0; k < 4; ++k) { ex[k] = expf(val[k] - val[0]); den += ex[k]; }
#pragma unroll
                  for (int k = 0; k < 4; ++k) { topi[t * 4 + k] = idx[k]; topg[t * 4 + k] = ex[k] / den; __hip_atomic_fetch_add(hl + idx[k], 1, __ATOMIC_RELAXED, __HIP_MEMORY_SCOPE_WORKGROUP); } } }
        }
        __syncthreads();
        if (C.tid < 32) { hist[ck * 32 + C.tid] = hl[C.tid]; hl[C.tid] = 0; }
        __syncthreads();
    }
}
__device__ __forceinline__ void moe_plan_lds(const Ctx& C) {
    const int* hist = (const int*)(C.ws + O_HIST);
    LAS int* tot = (LAS int*)(C.lds + LX_MISC + 256); LAS int* pst = tot + 32; LAS int* tile_e = (LAS int*)(C.lds + LX_TILE); LAS int* ntp = (LAS int*)(C.lds + LX_MISC + 128); LAS int* part = (LAS int*)(C.lds + LX_MISC + 1024);
    __syncthreads();
    { const int e = C.tid & 31, g = C.tid >> 5; int sacc = 0;
#pragma unroll
      for (int i = 0; i < 16; ++i) sacc += hist[(g * 16 + i) * 32 + e];
      part[g * 32 + e] = sacc; }
    __syncthreads();
    if (C.tid < 32) { int sacc = 0;
#pragma unroll
        for (int g = 0; g < 16; ++g) sacc += part[g * 32 + C.tid];
        tot[C.tid] = sacc; }
    __syncthreads();
    if (C.tid == 0) { int acc = 0, ti = 0; for (int e = 0; e < 32; ++e) { pst[e] = acc; const int nt = (tot[e] + 255) >> 8; for (int i = 0; i < nt; ++i) tile_e[ti++] = e; acc += nt << 8; } ntp[0] = ti; }
    __syncthreads();
}
__device__ __forceinline__ void phase_scatter(const Ctx& C) {
    const int* hist = (const int*)(C.ws + O_HIST); const int* topi = (const int*)(C.ws + O_TOPI); int* pos = (int*)(C.ws + O_POS); int* inv = (int*)(C.ws + O_INV);
    moe_plan_lds(C);
    LAS int* tot = (LAS int*)(C.lds + LX_MISC + 256); LAS int* pst = (LAS int*)(C.lds + LX_MISC + 384); LAS int* base = (LAS int*)(C.lds + LX_MISC + 512); LAS int* part = (LAS int*)(C.lds + LX_MISC + 1024);
    for (int e = C.bid; e < 32; e += C.G) { const int n = tot[e], p0 = pst[e] + n, np = ((n + 255) & ~255) - n; if (C.tid < np) inv[p0 + C.tid] = 0; }
    for (int ck = C.bid; ck < 256; ck += C.G) {
        if (C.tid < 32) { int sacc = pst[C.tid]; const int g = ck >> 4; for (int g2 = 0; g2 < g; ++g2) sacc += part[g2 * 32 + C.tid]; for (int c2 = g * 16; c2 < ck; ++c2) sacc += hist[c2 * 32 + C.tid]; base[C.tid] = sacc; }
        __syncthreads();
        if (C.wave == 0) { int cnt[32];
#pragma unroll
            for (int e = 0; e < 32; ++e) cnt[e] = 0;
#pragma unroll 1
            for (int g = 0; g < 4; ++g) { const int my = topi[ck * 256 + g * 64 + C.lane]; int rank = 0;
#pragma unroll
                for (int e = 0; e < 32; ++e) { const unsigned long long m = __ballot(my == e);
                    const int below = (int)__builtin_amdgcn_mbcnt_hi((unsigned)(m >> 32), __builtin_amdgcn_mbcnt_lo((unsigned)m, 0u));
                    if (my == e) rank = cnt[e] + below; cnt[e] += __popcll(m); }
                const int p = base[my] + rank; pos[ck * 256 + g * 64 + C.lane] = p; inv[p] = ck * 64 + ((g * 64 + C.lane) >> 2); } }
        __syncthreads();
    }
}
#ifndef ATT_DUP
#define ATT_DUP 1
#endif

__device__ __forceinline__ s16x4 tr16(LAS const unsigned char* p) { typedef short v4i16_t __attribute__((ext_vector_type(4))); return __builtin_bit_cast(s16x4, __builtin_amdgcn_ds_read_tr16_b64_v4i16((LAS v4i16_t*)p)); }

__device__ __forceinline__ float max3f(float a, float b, float c) { return fmaxf(fmaxf(a, b), c); }
#ifndef ATT_THR_V
#define ATT_THR_V 10.f
#endif
constexpr float ATT_THR = ATT_THR_V;
template <int KS, bool DIL>
__device__ __forceinline__ void att_tile(LAS const unsigned char* kb, LAS const unsigned char* vb, const bf16x8 (&qf)[KS], f32x16& o0, f32x16& o1, f32x16& negm, float& mref, float& l, int kidx0, int qidx, bool need_mask, int lane) {
    constexpr int KROW = KS * 32 + 16, VROW = 144;
    const int i32 = lane & 31, hi = lane >> 5;
    const int pr = (i32 & 0x13) | ((i32 & 4) << 1) | ((i32 & 8) >> 1);
    f32x16 p0, p1;
    LAS const unsigned char* kp = kb + pr * KROW + hi * 16;
#ifndef QK_DUP
#define QK_DUP 1
#endif
#pragma unroll 1
    for (int qd_ = 0; qd_ < QK_DUP; ++qd_) {
#pragma unroll
    for (int ks = 0; ks < KS; ++ks) {
        const bf16x8 k0f = *(LAS const bf16x8*)(kp + ks * 32), k1f = *(LAS const bf16x8*)(kp + 32 * KROW + ks * 32);
        if (ks == 0) { p0 = __builtin_amdgcn_mfma_f32_32x32x16_bf16(k0f, qf[0], negm, 0, 0, 0); p1 = __builtin_amdgcn_mfma_f32_32x32x16_bf16(k1f, qf[0], negm, 0, 0, 0); }
        else { p0 = __builtin_amdgcn_mfma_f32_32x32x16_bf16(k0f, qf[ks], p0, 0, 0, 0); p1 = __builtin_amdgcn_mfma_f32_32x32x16_bf16(k1f, qf[ks], p1, 0, 0, 0); }
    }
    asm volatile("" : "+v"(p0), "+v"(p1));
    }
    if (need_mask) {
#pragma unroll
        for (int r = 0; r < 16; ++r) { const int d0 = qidx - (kidx0 + 16 * (r >> 3) + 8 * hi + (r & 7)), d1 = d0 - 32;
            const bool v0 = DIL ? (d0 >= 0 && d0 <= 128) : (d0 >= 0), v1 = DIL ? (d1 >= 0 && d1 <= 128) : (d1 >= 0);
            p0[r] = v0 ? p0[r] : -INFINITY; p1[r] = v1 ? p1[r] : -INFINITY; } }
    float mx = max3f(p0[0], p0[1], p1[0]), mb = max3f(p0[2], p0[3], p1[1]); mx = max3f(mx, p1[2], p1[3]);
#pragma unroll
    for (int r = 4; r < 16; r += 4) { mx = max3f(mx, p0[r], p0[r + 1]); mb = max3f(mb, p0[r + 2], p0[r + 3]); mx = max3f(mx, p1[r], p1[r + 1]); mb = max3f(mb, p1[r + 2], p1[r + 3]); }
    mx = xmax32(fmaxf(mx, mb));
    if (__builtin_expect(__any(mx > ATT_THR), 0)) {
        const float dl = fmaxf(mx, 0.f), f = fexp2(-dl);
        mref += dl; l *= f;
#pragma unroll
        for (int r = 0; r < 16; ++r) { o0[r] *= f; o1[r] *= f; p0[r] -= dl; p1[r] -= dl; negm[r] = -mref; } }
    float ls0 = 0.f, ls1 = 0.f;
#pragma unroll
    for (int r = 0; r < 16; ++r) { p0[r] = fexp2(p0[r]); p1[r] = fexp2(p1[r]); ls0 += p0[r]; ls1 += p1[r]; }
    l += ls0 + ls1;
    u32x4 pw[2][2];
#pragma unroll
    for (int s = 0; s < 2; ++s) {
        pw[0][s].x = cvt_pk_bf16(p0[8 * s + 0], p0[8 * s + 1]); pw[0][s].y = cvt_pk_bf16(p0[8 * s + 2], p0[8 * s + 3]); pw[0][s].z = cvt_pk_bf16(p0[8 * s + 4], p0[8 * s + 5]); pw[0][s].w = cvt_pk_bf16(p0[8 * s + 6], p0[8 * s + 7]);
        pw[1][s].x = cvt_pk_bf16(p1[8 * s + 0], p1[8 * s + 1]); pw[1][s].y = cvt_pk_bf16(p1[8 * s + 2], p1[8 * s + 3]); pw[1][s].z = cvt_pk_bf16(p1[8 * s + 4], p1[8 * s + 5]); pw[1][s].w = cvt_pk_bf16(p1[8 * s + 6], p1[8 * s + 7]); }
    const int g = lane >> 4, i16 = lane & 15;
    LAS const unsigned char* vp = vb + (8 * (g >> 1) + (i16 >> 2)) * VROW + (16 * (g & 1) + 4 * (i16 & 3)) * 2;
#pragma unroll
    for (int sub = 0; sub < 2; ++sub)
#pragma unroll
        for (int s = 0; s < 2; ++s) { const bf16x8 pf = __builtin_bit_cast(bf16x8, pw[sub][s]);
#pragma unroll
            for (int db = 0; db < 2; ++db) { LAS const unsigned char* av = vp + (32 * sub + 16 * s) * VROW + 64 * db;
                const s16x4 lo = tr16(av), hh = tr16(av + 4 * VROW);
                const bf16x8 vf = (bf16x8){lo[0], lo[1], lo[2], lo[3], hh[0], hh[1], hh[2], hh[3]};
                if (db == 0) o0 = __builtin_amdgcn_mfma_f32_32x32x16_bf16(vf, pf, o0, 0, 0, 0); else o1 = __builtin_amdgcn_mfma_f32_32x32x16_bf16(vf, pf, o1, 0, 0, 0); } }
}
__device__ __forceinline__ void att_store(bf16_t* orow  , const f32x16& o0, const f32x16& o1, float inv, int hi) {
#pragma unroll
    for (int rr = 0; rr < 4; ++rr) { u32x2 w0, w1;
        w0.x = cvt_pk_bf16(o0[4 * rr] * inv, o0[4 * rr + 1] * inv); w0.y = cvt_pk_bf16(o0[4 * rr + 2] * inv, o0[4 * rr + 3] * inv);
        w1.x = cvt_pk_bf16(o1[4 * rr] * inv, o1[4 * rr + 1] * inv); w1.y = cvt_pk_bf16(o1[4 * rr + 2] * inv, o1[4 * rr + 3] * inv);
        *(u32x2*)(orow + 8 * rr + 4 * hi) = w0; *(u32x2*)(orow + 32 + 8 * rr + 4 * hi) = w1; }
}


struct BgConv {
    const float* w1; const float* w2; unsigned char* ws; LAS unsigned char* T;
    int pair, it, nit, step, sub;
    bool pendA, pendB; int psubA, psubB; unsigned char* pWTA; unsigned char* pWTB;
    f32x4 vA[4], vB[4];
};
__device__ __forceinline__ void bg_tile(const BgConv& S, int it, const float*& W, int& N, unsigned char*& WT, int& n0, int& k0) {
    constexpr int I1 = 32 * 8, I2 = 16 * 8, N1 = 64 * I1;
    if (it < N1) { const int mat = S.pair * 64 + it / I1, q = it % I1; W = S.w1 + (size_t)mat * 1024 * 2048; WT = S.ws + O_W1 + (size_t)mat * SZ_W1E; N = 2048; n0 = (q >> 3) * 64; k0 = (q & 7) * 128; }
    else { const int r = it - N1, mat = S.pair * 64 + r / I2, q = r % I2; W = S.w2 + (size_t)mat * 1024 * 1024; WT = S.ws + O_W2 + (size_t)mat * SZ_W2E; N = 1024; n0 = (q >> 3) * 64; k0 = (q & 7) * 128; }
}
__device__ __forceinline__ void bg_init(BgConv& S, const Ctx& C, const float* w1, const float* w2, int pair) {
    S.w1 = w1; S.w2 = w2; S.ws = C.ws; S.T = C.lds + 49152 + C.wave * 9216; S.pair = pair; S.it = C.gw; S.nit = 64 * 256 + 64 * 128; S.step = C.NGW; S.sub = 0;
    S.pendA = false; S.pendB = false; S.psubA = 0; S.psubB = 0; S.pWTA = C.ws; S.pWTB = C.ws;
}
__device__ __forceinline__ bool bg_done(const BgConv& S) { return !S.pendA && !S.pendB && S.it >= S.nit; }
__device__ __forceinline__ void bg_half(BgConv& S, f32x4 (&v)[4], bool& pend, int& psub, unsigned char*& pWT, int lane) {
    const int kq = lane >> 4, c4 = lane & 15;
    if (pend) {
#pragma unroll
        for (int jj = 0; jj < 4; ++jj) *(LAS unsigned*)(S.T + (4 * c4 + jj) * 144 + 32 * kq + 4 * psub) = pk4_fp8(32.f * v[0][jj], 32.f * v[1][jj], 32.f * v[2][jj], 32.f * v[3][jj]);
        if (psub == 7) {
            asm volatile("s_waitcnt lgkmcnt(0)" ::: "memory");
#pragma unroll
            for (int s8 = 0; s8 < 8; ++s8) { const int n = 8 * s8 + (lane >> 3), ch = lane & 7; const u32x4 w = *(const LAS u32x4*)(S.T + n * 144 + 16 * ch);
                *(u32x4*)(pWT + (size_t)n * 1024 + 16 * ch) = w; }
            asm volatile("s_waitcnt lgkmcnt(0)" ::: "memory"); }
        pend = false; }
    if (S.it < S.nit) { const float* W; int N, n0, k0; unsigned char* WT; bg_tile(S, S.it, W, N, WT, n0, k0);
        const float* p = W + (size_t)(k0 + 32 * kq + 4 * S.sub) * N + n0 + 4 * c4;
#pragma unroll
        for (int i = 0; i < 4; ++i) v[i] = __builtin_nontemporal_load((const f32x4*)(p + (size_t)i * N));
        pend = true; psub = S.sub; pWT = WT + (size_t)n0 * 1024 + k0;
        if (++S.sub == 8) { S.sub = 0; S.it += S.step; } }
}
#define BG_STEP_A() bg_half(BG, BG.vA, BG.pendA, BG.psubA, BG.pWTA, lane)
#define BG_STEP_B() bg_half(BG, BG.vB, BG.pendB, BG.psubB, BG.pWTB, lane)

__device__ __forceinline__ void mla_unit(const Ctx& C, BgConv& BG, int b, int h, int qb) {
    constexpr int KROW = 208, VROW = 144, KB = 64 * KROW, BUF = KB + 64 * VROW;
    const bf16_t* Q2 = (const bf16_t*)(C.ws + O_Q2); const bf16_t* KV2 = (const bf16_t*)(C.ws + O_KV2); const bf16_t* PROJ = (const bf16_t*)(C.ws + O_PROJ); bf16_t* ATT = (bf16_t*)(C.ws + O_ATT);
    const int tid = C.tid, lane = C.lane, w = C.wave, i32 = lane & 31, hi = lane >> 5;
    const int q0 = qb * 256; const size_t rowb = (size_t)b * S_;
    bf16x8 qf[6];
    { const bf16_t* qrow = Q2 + (rowb + q0 + 32 * w + i32) * 768 + 8 * hi;
#pragma unroll
      for (int ks = 0; ks < 4; ++ks) qf[ks] = *(const bf16x8*)(qrow + h * 64 + 16 * ks);
      qf[4] = *(const bf16x8*)(qrow + 512 + h * 32); qf[5] = *(const bf16x8*)(qrow + 512 + h * 32 + 16); }
    f32x16 o0, o1;
#pragma unroll
    for (int r = 0; r < 16; ++r) { o0[r] = 0.f; o1[r] = 0.f; }
    float m = 0.f, l = 0.f; f32x16 negm;
#pragma unroll
    for (int r = 0; r < 16; ++r) negm[r] = 0.f;
    const int NT = 4 * qb + 4, wmax = 4 * qb + (w >> 1);
    const int r8 = tid >> 3, c8 = tid & 7, r4 = (tid & 255) >> 2, c4 = tid & 3;
    const bf16_t* knp = KV2 + (rowb + r8) * 1024 + h * 64 + 8 * c8; const bf16_t* kpp = PROJ + (rowb + r4) * 2048 + 1920 + 8 * c4;
    u32x4 kA, vA, pA, kB, vB, pB;
#define MLA_LOAD(j, K, V, P) do { const int jc_ = ((j) < NT) ? (j) : NT - 1; K = *(const u32x4*)(knp + (size_t)jc_ * 64 * 1024); V = *(const u32x4*)(knp + (size_t)jc_ * 64 * 1024 + 512); P = *(const u32x4*)(kpp + (size_t)jc_ * 64 * 2048); } while (0)
#define MLA_WRITE(bo, K, V, P) do { *(LAS u32x4*)(C.lds + (bo) + r8 * KROW + 16 * c8) = K; *(LAS u32x4*)(C.lds + (bo) + KB + r8 * VROW + 16 * c8) = V; *(LAS u32x4*)(C.lds + (bo) + r4 * KROW + 128 + 16 * c4) = P; } while (0)
#define MLA_STEP(j, KF, VF, PF, KN, VN, PN, BGS) do { const int j_ = (j); const int bo_ = (j_ & 1) * BUF; \
        MLA_LOAD(j_ + 2, KF, VF, PF); BGS(); \
        if (j_ <= wmax) { _Pragma("unroll 1") for (int dup_ = 0; dup_ < ATT_DUP; ++dup_) att_tile<6, false>(C.lds + bo_, C.lds + bo_ + KB, qf, o0, o1, negm, m, l, 64 * j_, q0 + 32 * w + i32, j_ == wmax, lane); } \
        MLA_WRITE(BUF - bo_, KN, VN, PN); \
        __syncthreads(); } while (0)
    MLA_LOAD(0, kA, vA, pA); MLA_LOAD(1, kB, vB, pB);
    MLA_WRITE(0, kA, vA, pA);
    __syncthreads();
#pragma unroll 1
    for (int j = 0; j < NT; j += 2) { MLA_STEP(j, kA, vA, pA, kB, vB, pB, BG_STEP_A); MLA_STEP(j + 1, kB, vB, pB, kA, vA, pA, BG_STEP_B); }
#undef MLA_STEP
#undef MLA_LOAD
#undef MLA_WRITE
    l = xadd32(l);
    att_store(ATT + (rowb + q0 + 32 * w + i32) * 1024 + 512 + h * 64, o0, o1, 1.f / l, hi);
}
__device__ __forceinline__ void dil_unit(const Ctx& C, BgConv& BG, int p, int dd, int b, int h, int res, int n) {
    constexpr int KROW = 144, VROW = 144, KB = 64 * KROW, BUF = KB + 64 * VROW;
    const bf16_t* PROJ = (const bf16_t*)(C.ws + O_PROJ); bf16_t* OA = (bf16_t*)(C.ws + O_OA) + (size_t)p * T_ * 512; float* LSE = (float*)(C.ws + O_LSE) + (size_t)p * T_ * 8;
    const int tid = C.tid, lane = C.lane, w = C.wave, i32 = lane & 31, hi = lane >> 5;
    const size_t rowb = (size_t)b * S_;
    const int qsub = 256 * n + 32 * w + i32; const size_t qtok = rowb + (size_t)qsub * dd + res;
    bf16x8 qf[4];
    { const bf16_t* qrow = PROJ + qtok * 2048 + h * 64 + 8 * hi;
#pragma unroll
      for (int ks = 0; ks < 4; ++ks) qf[ks] = *(const bf16x8*)(qrow + 16 * ks); }
    f32x16 o0, o1;
#pragma unroll
    for (int r = 0; r < 16; ++r) { o0[r] = 0.f; o1[r] = 0.f; }
    float m = 0.f, l = 0.f; f32x16 negm;
#pragma unroll
    for (int r = 0; r < 16; ++r) negm[r] = 0.f;
    const int jbeg = (n == 0) ? 2 : 0, wlo = w >> 1, whi = (32 * w + 159) >> 6;
    const int r8 = tid >> 3, c8 = tid & 7;
    u32x4 kA, vA, kB, vB;
    const int cnt = 6 - jbeg;
#define DIL_LOAD(i, K, V) do { const int jc_ = jbeg + (((i) < cnt) ? (i) : cnt - 1); const size_t tok = rowb + (size_t)(256 * n - 128 + 64 * jc_ + r8) * dd + res; const bf16_t* src = PROJ + tok * 2048 + 512 + h * 64 + 8 * c8; K = *(const u32x4*)src; V = *(const u32x4*)(src + 512); } while (0)
#define DIL_WRITE(bo, K, V) do { *(LAS u32x4*)(C.lds + (bo) + r8 * KROW + 16 * c8) = K; *(LAS u32x4*)(C.lds + (bo) + KB + r8 * VROW + 16 * c8) = V; } while (0)
#define DIL_STEP(i, KF, VF, KN, VN, BGS) do { const int i_ = (i); const int bo_ = (i_ & 1) * BUF, j_ = jbeg + i_; \
        DIL_LOAD(i_ + 2, KF, VF); BGS(); \
        if (i_ < cnt && j_ >= wlo && j_ <= whi) { const int kb0_ = 256 * n - 128 + 64 * j_, qlo_ = 256 * n + 32 * w; _Pragma("unroll 1") for (int dup_ = 0; dup_ < ATT_DUP; ++dup_) att_tile<4, true>(C.lds + bo_, C.lds + bo_ + KB, qf, o0, o1, negm, m, l, kb0_, qsub, !(kb0_ + 63 <= qlo_ && qlo_ + 31 - kb0_ <= 128), lane); } \
        DIL_WRITE(BUF - bo_, KN, VN); \
        __syncthreads(); } while (0)
    DIL_LOAD(0, kA, vA); DIL_LOAD(1, kB, vB);
    DIL_WRITE(0, kA, vA);
    __syncthreads();
    DIL_STEP(0, kA, vA, kB, vB, BG_STEP_A); DIL_STEP(1, kB, vB, kA, vA, BG_STEP_B); DIL_STEP(2, kA, vA, kB, vB, BG_STEP_A); DIL_STEP(3, kB, vB, kA, vA, BG_STEP_B);
    if (cnt == 6) { DIL_STEP(4, kA, vA, kB, vB, BG_STEP_A); DIL_STEP(5, kB, vB, kA, vA, BG_STEP_B); }
#undef DIL_STEP
#undef DIL_LOAD
#undef DIL_WRITE
    l = xadd32(l);
    att_store(OA + qtok * 512 + h * 64, o0, o1, 1.f / l, hi);
    if (hi == 0) LSE[qtok * 8 + h] = m + log2f(l);
}
#ifndef REP_MLA
#define REP_MLA 1
#endif
#ifndef REP_DIL
#define REP_DIL 1
#endif
__device__ __forceinline__ void phase_attention(const Ctx& C, const float* w1, const float* w2, int pair) {
    BgConv BG; bg_init(BG, C, w1, w2, pair);
#pragma unroll 1
    for (int rep = 0; rep < REP_MLA; ++rep) {
    if (C.G == 256) { const int bh = C.vcu >> 3, s = C.vcu & 7; mla_unit(C, BG, bh >> 3, bh & 7, s); mla_unit(C, BG, bh >> 3, bh & 7, 15 - s); }
    else for (int u = C.bid; u < 512; u += C.G) mla_unit(C, BG, u >> 7, (u >> 4) & 7, u & 15);
    }
#pragma unroll 1
    for (int rep = 0; rep < REP_DIL; ++rep)
    for (int u = C.bid; u < 1536; u += C.G) { const int p = u >> 9, rem = u & 511, b = rem >> 7, h = (rem >> 4) & 7, blk = rem & 15;
        const int dd = (p == 0) ? 1 : (p == 1) ? 4 : 16, bpr = 16 / dd;
        dil_unit(C, BG, p, dd, b, h, blk / bpr, blk % bpr); }
    { const int lane = C.lane;
#pragma unroll 1
      while (!bg_done(BG)) { BG_STEP_A(); BG_STEP_B(); } }
}
#undef BG_STEP_A
#undef BG_STEP_B

#ifdef TIME_NORM
constexpr int N_PHASES = 42;
#else
constexpr int N_PHASES = 40;
#endif
extern __shared__ __attribute__((aligned(16))) unsigned char lds_raw[];
typedef const __attribute__((address_space(4))) Args* ArgsP;
#define PHFN static __device__ __forceinline__ void
__device__ __forceinline__ ArgsP fresh_args() { unsigned long long p = (unsigned long long)__builtin_amdgcn_kernarg_segment_ptr(); asm volatile("" : "+s"(p)); return (ArgsP)p; }
__device__ __forceinline__ Ctx make_ctx(ArgsP ap, int wv) {
    Ctx C; C.lds = (LAS unsigned char*)lds_raw; C.ws = ap->ws;
    unsigned ones = ~0u; asm volatile("" : "+s"(ones)); const int lane = (int)__builtin_amdgcn_mbcnt_hi(ones, __builtin_amdgcn_mbcnt_lo(ones, 0u));
    int bid = blockIdx.x; asm volatile("" : "+s"(bid)); int G = gridDim.x; asm volatile("" : "+s"(G));
    C.wave = wv; C.lane = lane; C.tid = wv * 64 + lane;
    C.G = G; C.bid = bid; C.vcu = (C.G % 8 == 0) ? (C.bid % 8) * (C.G / 8) + C.bid / 8 : C.bid;
    C.gw = C.bid * 8 + C.wave; C.NGW = C.G * 8; return C;
}
#define IN(i) ((const float*)ap->in[i])
#define MODL(l) ((const float*)(C.ws + O_MOD) + (size_t)(l) * 4 * 6144)
PHFN ph_prologue(int wv) { const ArgsP ap = fresh_args(); const Ctx C = make_ctx(ap, wv); p0_prologue(C, ap); }
PHFN ph_norm(int wv, int l, int mode) { const ArgsP ap = fresh_args(); const Ctx C = make_ctx(ap, wv);
    if (mode == 0) phase_norm(C, IN(0), nullptr, false, true, IN(5), MODL(0), MODL(0), 0, 1024);
    else if (mode == 1) phase_norm(C, nullptr, nullptr, true, true, IN(5) + l * 1024, MODL(l - 1), MODL(l), 0, 1024);
    else if (mode == 3) phase_norm(C, nullptr, nullptr, true, true, IN(5) + l * 1024, MODL(l - 1), MODL(l), 0, 1024, true);
    else phase_norm(C, nullptr, ap->out, true, false, IN(5), MODL(3), MODL(3), 0, 1024); }
PHFN ph_proj(int wv, int j) { const ArgsP ap = fresh_args(); const Ctx C = make_ctx(ap, wv); unsigned char* ws = C.ws;
    DenseOrder S; S.init(ws + O_HN, ws + O_WIN + j * SZ_WIN, 1024, 1024, T_, 2048, C.G, C.bid); EpiNorm<0> E{(bf16_t*)(ws + O_PROJ), 2048, IN(8) + j * 64, IN(9) + j * 64, IN(10) + j * 256, IN(11) + j * 128, IN(15) + j * 96 + 64, (const float*)(ws + O_CS), (LAS float*)(C.lds + LX_EXCH)}; gemm_phase(C, GemmDims{1024, 1024, 1024}, S, E); }
PHFN ph_postproj(int wv, int j) { const ArgsP ap = fresh_args(); const Ctx C = make_ctx(ap, wv); phase_postproj(C, IN(8) + j * 64, IN(9) + j * 64, IN(10) + j * 256, IN(11) + j * 128, IN(15) + j * 96); }
PHFN ph_qkv(int wv, int j) { const ArgsP ap = fresh_args(); const Ctx C = make_ctx(ap, wv); unsigned char* ws = C.ws;
    { DenseOrder S; S.init(ws + O_PROJ + 1536 * 2, ws + O_WUQ + j * SZ_WUQ, 2048, 256, T_, 768, C.G, C.bid); EpiNorm<1> E{(bf16_t*)(ws + O_Q2), 768, IN(14) + j * 96, IN(14) + j * 96 + 64, nullptr, nullptr, nullptr, (const float*)(ws + O_CS), (LAS float*)(C.lds + LX_EXCH)}; gemm_phase(C, GemmDims{256, 2048, 256}, S, E); }
    { const ArgsP ap2 = fresh_args(); const Ctx C = make_ctx(ap2, wv); unsigned char* ws = C.ws; DenseOrder S; S.init(ws + O_PROJ + 1792 * 2, ws + O_WUKV + j * SZ_WUKV, 2048, 128, T_, 1024, C.G, C.bid); EpiNorm<2> E{(bf16_t*)(ws + O_KV2), 1024, IN(15) + j * 96, nullptr, nullptr, nullptr, nullptr, (const float*)(ws + O_CS), (LAS float*)(C.lds + LX_EXCH)}; gemm_phase(C, GemmDims{128, 2048, 128}, S, E); } }
PHFN ph_postq(int wv, int j) { const ArgsP ap = fresh_args(); const Ctx C = make_ctx(ap, wv); phase_postq(C, IN(14) + j * 96, IN(15) + j * 96); }
PHFN ph_attention(int wv, int pair) { const ArgsP ap = fresh_args(); const Ctx C = make_ctx(ap, wv); phase_attention(C, IN(30), IN(32), pair); }
PHFN ph_mixcombine(int wv) { const ArgsP ap = fresh_args(); const Ctx C = make_ctx(ap, wv); phase_mixcombine(C); }
PHFN ph_outproj(int wv, int l, int which) { const ArgsP ap = fresh_args(); const Ctx C = make_ctx(ap, wv); unsigned char* ws = C.ws; const int j = l >> 1;
    DenseOrder S; S.init(ws + O_ATT, ws + (which ? O_RWOUT + j * SZ_RWOUT : O_WOUT + j * SZ_WOUT), 1024, 1024, T_, 1024, C.G, C.bid);
    EpiResid E{(bf16_t*)(ws + O_X), MODL(l) + 2048, which ? IN(27) + j * 1024 : nullptr}; gemm_phase(C, GemmDims{1024, 1024, 1024}, S, E); }
PHFN ph_router(int wv, int l) { const ArgsP ap = fresh_args(); const Ctx C = make_ctx(ap, wv); phase_router(C, (const bf16_t*)(C.ws + O_X), IN(6) + l * 1024, MODL(l), IN(28) + (size_t)l * 1024 * 32, IN(29) + l * 32); }
PHFN ph_scatter(int wv) { const ArgsP ap = fresh_args(); const Ctx C = make_ctx(ap, wv); phase_scatter(C); }
PHFN ph_moe1(int wv, int l) { const ArgsP ap = fresh_args(); const Ctx C = make_ctx(ap, wv); unsigned char* ws = C.ws; moe_plan_lds(C);
    MoeOrderT<true> S; S.A = (const char*)(ws + O_HN); S.WT = (const char*)(ws + O_W1 + (size_t)l * 32 * SZ_W1E); S.estride = SZ_W1E; S.tile_e = (const LAS int*)(C.lds + LX_TILE);
    S.NT = *(const LAS int*)(C.lds + LX_MISC + 128); S.nN = 8; S.G = C.G; S.c = C.bid; S.esz = 1; S.gtab = (const LAS int*)(C.lds + LX_GTAB);
    { const int* inv = (const int*)(ws + O_INV); LAS int* gt = (LAS int*)(C.lds + LX_GTAB);
#pragma unroll 1
      for (int i = 0; i < GTAB_UNITS; ++i) { Unit u; if (!S.next(i, u)) break; if (C.tid < 256) gt[i * 256 + C.tid] = inv[u.row0 + C.tid]; }
      __syncthreads(); }
    EpiSwiglu E{(unsigned char*)(ws + O_ACT), IN(31) + (size_t)l * 32 * 2048, 1.f / 32.f}; gemm_phase<true>(C, GemmDims{1024, 1024, 1024}, S, E); }
PHFN ph_moe2(int wv, int l) { const ArgsP ap = fresh_args(); const Ctx C = make_ctx(ap, wv); unsigned char* ws = C.ws; moe_plan_lds(C);
    MoeOrder S; S.A = (const char*)(ws + O_ACT); S.WT = (const char*)(ws + O_W2 + (size_t)l * 32 * SZ_W2E); S.estride = SZ_W2E; S.tile_e = (const LAS int*)(C.lds + LX_TILE);
    S.NT = *(const LAS int*)(C.lds + LX_MISC + 128); S.nN = 4; S.G = C.G; S.c = C.bid; S.esz = 1;
    EpiBf16 E{(bf16_t*)(ws + O_Y2), IN(33) + (size_t)l * 32 * 1024, 1024, 1024, 1.f / 32.f}; gemm_phase<true>(C, GemmDims{1024, 1024, 1024}, S, E); }
PHFN ph_recin(int wv, int j) { const ArgsP ap = fresh_args(); const Ctx C = make_ctx(ap, wv); unsigned char* ws = C.ws;
    DenseOrder S; S.init(ws + O_HN, ws + O_RWIN + j * SZ_RWIN, 1024, 1024, T_, 2048, C.G, C.bid); EpiRecIn E{(bf16_t*)(ws + O_PROJ), IN(18) + j * 2048}; gemm_phase(C, GemmDims{1024, 1024, 1024}, S, E); }
PHFN ph_rgate(int wv, int j) { const ArgsP ap = fresh_args(); const Ctx C = make_ctx(ap, wv); phase_rgate(C, j, IN(19) + j * 4096, IN(20) + j * 1024, IN(22) + j * 1024, IN(24) + j * 1024); }
PHFN ph_scan_apply(int wv) { const ArgsP ap = fresh_args(); const Ctx C = make_ctx(ap, wv); phase_scan_apply(C); }

#if MODE == 1
__device__ __forceinline__ int fresh_tid(int wv) { unsigned ones = ~0u; asm volatile("" : "+s"(ones)); return wv * 64 + (int)__builtin_amdgcn_mbcnt_hi(ones, __builtin_amdgcn_mbcnt_lo(ones, 0u)); }
__device__ __forceinline__ void grid_barrier(int wv) { const ArgsP q = fresh_args(); XcdBarrier b; b.bar = (unsigned*)(q->ws + O_CTL) + CW_BAR; b.x = xb_xcc_id(); b.st = (volatile LAS unsigned*)((LAS unsigned char*)lds_raw + LDSX_OFF); xcd_barrier(b, fresh_tid(wv)); }
__global__ void __launch_bounds__(512, 2) mk_fwd(Args a) {
    int wv = __builtin_amdgcn_readfirstlane(threadIdx.x >> 6); asm volatile("" : "+s"(wv));
    { LAS unsigned char* lds = (LAS unsigned char*)lds_raw;
      for (int u = threadIdx.x; u < (LDS_BYTES - LDSX_OFF) / 4; u += 512) ((LAS unsigned*)(lds + LDSX_OFF))[u] = 0u;
      __syncthreads();
      if (a.ph_hi - a.ph_lo > 1) (void)xcd_barrier_post((unsigned*)(a.ws + O_CTL) + CW_BAR, (volatile LAS unsigned*)(lds + LDSX_OFF), (int)threadIdx.x); }
    int pid = 0;
#define PHASE(call) { const ArgsP q_ = fresh_args(); const int lo_ = q_->ph_lo, hi_ = q_->ph_hi; if (pid >= lo_ && pid < hi_) { call; if (pid + 1 < hi_) grid_barrier(wv); } ++pid; }
#define PHASE_R(call, REP) { const ArgsP q_ = fresh_args(); const int lo_ = q_->ph_lo, hi_ = q_->ph_hi; if (pid >= lo_ && pid < hi_) { if ((REP) > 1) { call; grid_barrier(wv); } call; if (pid + 1 < hi_) grid_barrier(wv); } ++pid; }
#ifndef REP_PROLOGUE
#define REP_PROLOGUE 1
#endif
#ifndef REP_MOE
#define REP_MOE 1
#endif
#ifndef REP_ATTN
#define REP_ATTN 1
#endif
#ifndef REP_GEMMS
#define REP_GEMMS 1
#endif
#ifdef TIME_NORM
#define NORM_EXTRA(l) PHASE(ph_norm(wv, l, 3))
#else
#define NORM_EXTRA(l)
#endif
#ifndef REP_ELEM
#define REP_ELEM 1
#endif
#ifndef REP_ROUTER
#define REP_ROUTER REP_ELEM
#endif
#ifndef REP_SCATTER
#define REP_SCATTER REP_ELEM
#endif
#ifndef REP_MIX
#define REP_MIX REP_ELEM
#endif
#ifndef REP_CONV
#define REP_CONV REP_ELEM
#endif
#ifndef REP_SCANA
#define REP_SCANA REP_ELEM
#endif
#define MOE_PHASES(l) PHASE_R(ph_router(wv, l), REP_ROUTER) PHASE_R(ph_scatter(wv), REP_SCATTER) PHASE_R(ph_moe1(wv, l), REP_MOE) PHASE_R(ph_moe2(wv, l), REP_MOE)
    PHASE_R(ph_prologue(wv), REP_PROLOGUE)
#define LAYER_PAIR(lp) \
        { const int l = 2 * (lp);         \
          PHASE(ph_norm(wv, l, (lp) == 0 ? 0 : 1)) PHASE_R(ph_proj(wv, lp), REP_GEMMS) PHASE_R(ph_qkv(wv, lp), REP_GEMMS) PHASE_R(ph_attention(wv, lp), REP_ATTN) PHASE_R(ph_mixcombine(wv), REP_MIX) PHASE(ph_outproj(wv, l, 0)) \
          MOE_PHASES(l) } \
        { const int l = 2 * (lp) + 1;     \
          NORM_EXTRA(l) PHASE(ph_norm(wv, l, 1)) PHASE_R(ph_recin(wv, lp), REP_GEMMS) PHASE_R(ph_rgate(wv, lp), REP_CONV) PHASE_R(ph_scan_apply(wv), REP_SCANA) PHASE(ph_outproj(wv, l, 1)) \
          MOE_PHASES(l) }
    LAYER_PAIR(0)
    LAYER_PAIR(1)
#undef LAYER_PAIR
#ifdef EXTRA_BARRIERS
    { const ArgsP q_ = fresh_args(); if (q_->ph_hi - q_->ph_lo > 1) { _Pragma("unroll 1") for (int xb = 0; xb < EXTRA_BARRIERS; ++xb) grid_barrier(wv); } }
#endif
    PHASE(ph_norm(wv, 3, 2))
#undef PHASE
#undef PHASE_R
#undef MOE_PHASES
}
#else
template <int PH> __global__ void __launch_bounds__(512, 2) k_phase(Args a, int l, int x) {
    int wv = __builtin_amdgcn_readfirstlane(threadIdx.x >> 6); asm volatile("" : "+s"(wv));
    LAS unsigned char* lds = (LAS unsigned char*)lds_raw;
    for (int u = threadIdx.x; u < (LDS_BYTES - LDSX_OFF) / 4; u += 512) ((LAS unsigned*)(lds + LDSX_OFF))[u] = 0u;
    __syncthreads();
    if constexpr (PH == 0) ph_prologue(wv);
    if constexpr (PH == 1) ph_norm(wv, l, x);
    if constexpr (PH == 2) ph_proj(wv, l);
    if constexpr (PH == 4) ph_qkv(wv, l);
    if constexpr (PH == 6) ph_attention(wv, l);
    if constexpr (PH == 7) ph_mixcombine(wv);
    if constexpr (PH == 8) ph_outproj(wv, l, x);
    if constexpr (PH == 9) ph_router(wv, l);
    if constexpr (PH == 10) ph_scatter(wv);
    if constexpr (PH == 11) ph_moe1(wv, l);
    if constexpr (PH == 12) ph_moe2(wv, l);
    if constexpr (PH == 13) ph_recin(wv, l);
    if constexpr (PH == 14) ph_rgate(wv, l);
    if constexpr (PH == 17) ph_scan_apply(wv);
}
#endif
#undef IN
#undef MODL
}

#ifndef MODE
#define MODE 2
#endif
extern "C" void kernel_launch(void* const* d_in, const int* in_sizes, int n_in, void* d_out, int out_size, void* d_ws, size_t ws_size, hipStream_t stream) {
    (void)in_sizes; (void)n_in; (void)out_size; (void)ws_size;
#if MODE == 0
    nv::forward(d_in, (float*)d_out, d_ws, stream);
#else
    static int grid = 0;
    if (grid == 0) {
        int dev = 0, cus = 0;
        (void)hipGetDevice(&dev); (void)hipDeviceGetAttribute(&cus, hipDeviceAttributeMultiprocessorCount, dev);
#if MODE == 1
        (void)hipFuncSetAttribute((const void*)mk::mk_fwd, hipFuncAttributeMaxDynamicSharedMemorySize, mk::LDS_BYTES);
#else
#define SA(PH) (void)hipFuncSetAttribute((const void*)mk::k_phase<PH>, hipFuncAttributeMaxDynamicSharedMemorySize, mk::LDS_BYTES)
        SA(0); SA(1); SA(2); SA(4); SA(6); SA(7); SA(8); SA(9); SA(10); SA(11); SA(12); SA(13); SA(14); SA(17);
#undef SA
#endif
        grid = cus > 0 ? cus : 256;
    }
    (void)hipMemsetAsync((char*)d_ws + mk::O_CTL, 0, mk::SZ_CTL, stream);
    mk::Args a;
    memset(&a, 0, sizeof(a));
    for (int i = 0; i < 34; ++i) a.in[i] = d_in[i];
    a.out = (float*)d_out; a.ws = (unsigned char*)d_ws;
#if MODE == 1
    a.ph_lo = 0; a.ph_hi = mk::N_PHASES;
    hipLaunchKernelGGL(mk::mk_fwd, dim3(grid), dim3(512), mk::LDS_BYTES, stream, a);
#else
#define LP(PH, l, x) hipLaunchKernelGGL(mk::k_phase<PH>, dim3(grid), dim3(512), mk::LDS_BYTES, stream, a, l, x)
    LP(0, 0, 0);
    for (int lp = 0; lp < 2; ++lp) {
        { const int l = 2 * lp; LP(1, l, lp == 0 ? 0 : 1); LP(2, lp, 0); LP(4, lp, 0); LP(6, lp, 0); LP(7, 0, 0); LP(8, l, 0); LP(9, l, 0); LP(10, 0, 0); LP(11, l, 0); LP(12, l, 0); }
        { const int l = 2 * lp + 1; LP(1, l, 1); LP(13, lp, 0); LP(14, lp, 0); LP(17, 0, 0); LP(8, l, 1); LP(9, l, 0); LP(10, 0, 0); LP(11, l, 0); LP(12, l, 0); }
    }
    LP(1, 3, 2);
#undef LP
#endif
#endif
}
```

```cpp
#define MODE 1

#include <string.h>
#include <hip/hip_runtime.h>
#include <stdint.h>
#include <math.h>

namespace cfg {
constexpr int D = 1024, NB = 4, S = 4096, T = NB * S, DEPTH = 4;
constexpr int MIXIN = 1952;
constexpr int NE = 32, TOPK = 4;
constexpr int MPAIR = T * TOPK;
constexpr int NBLK = MPAIR / 256 + NE;
constexpr int P = NBLK * 256;
}
using namespace cfg;


namespace mk {
#define LAS __attribute__((address_space(3)))
#define GAS __attribute__((address_space(1)))
typedef unsigned short bf16_t;
typedef short bf16x8 __attribute__((ext_vector_type(8)));
typedef short s16x4 __attribute__((ext_vector_type(4)));
typedef float f32x2 __attribute__((ext_vector_type(2)));
typedef float f32x4 __attribute__((ext_vector_type(4)));
typedef float f32x16 __attribute__((ext_vector_type(16)));
typedef unsigned u32x2 __attribute__((ext_vector_type(2)));
typedef unsigned u32x4 __attribute__((ext_vector_type(4)));
typedef GAS unsigned gu32;
#define RLX_AGENT __ATOMIC_RELAXED, __HIP_MEMORY_SCOPE_AGENT

__device__ __forceinline__ unsigned cvt_pk_bf16(float lo, float hi) { unsigned r; asm volatile("v_cvt_pk_bf16_f32 %0, %1, %2" : "=v"(r) : "v"(lo), "v"(hi)); return r; }
__device__ __forceinline__ float bf_lo(unsigned u) { return __uint_as_float(u << 16); }
__device__ __forceinline__ float bf_hi(unsigned u) { return __uint_as_float(u & 0xffff0000u); }
template <int O> __device__ __forceinline__ float shx(float v) { static_assert(O >= 1 && O < 32, "shx"); return __int_as_float(__builtin_amdgcn_ds_swizzle(__float_as_int(v), (O << 10) | 0x1f)); }
__device__ __forceinline__ float xadd32(float v) { const auto r = __builtin_amdgcn_permlane32_swap(__float_as_uint(v), __float_as_uint(v), false, false); return __uint_as_float(r[0]) + __uint_as_float(r[1]); }
__device__ __forceinline__ float xmax32(float v) { const auto r = __builtin_amdgcn_permlane32_swap(__float_as_uint(v), __float_as_uint(v), false, false); return fmaxf(__uint_as_float(r[0]), __uint_as_float(r[1])); }
__device__ __forceinline__ float wsum(float v) { v += shx<1>(v); v += shx<2>(v); v += shx<4>(v); v += shx<8>(v); v += shx<16>(v); return xadd32(v); }
__device__ __forceinline__ float fexp2(float x) { return __builtin_amdgcn_exp2f(x); }
__device__ __forceinline__ float frcp(float x) { return __builtin_amdgcn_rcpf(x); }
__device__ __forceinline__ float fsigmoid(float z) { return frcp(1.f + fexp2(-1.4426950408889634f * z)); }
__device__ __forceinline__ float fgelu_tanh(float x) { const float u = 0.7978845608028654f * (x + 0.044715f * x * x * x); return x * frcp(1.f + fexp2(-2.8853900817779268f * u)); }

#define XB_TMO      128
#define XB_XCNT(j)  (256  + 64 * (j))
#define XB_XSUB(j)  (1280 + 64 * (j))
#define XB_XGEN(j)  (2304 + 64 * (j))
#define XB_TOP      3328
#define XB_TOPGEN   3392
#define XCD_BAR_WORDS 3456
#define XB_SPIN_CAP (1u << 18)
__device__ __forceinline__ unsigned xb_ld(unsigned* p)              { return __hip_atomic_load(p, __ATOMIC_RELAXED, __HIP_MEMORY_SCOPE_AGENT); }
__device__ __forceinline__ unsigned xb_add(unsigned* p, unsigned v) { return __hip_atomic_fetch_add(p, v, __ATOMIC_RELAXED, __HIP_MEMORY_SCOPE_AGENT); }
__device__ __forceinline__ unsigned xb_xcc_id() { return (unsigned)__builtin_amdgcn_s_getreg((3 << 11) | 20) & 0xFu; }
#define XB_SPIN(cond, bar) do { unsigned _sp = 0; while (cond) { __builtin_amdgcn_s_sleep(1); \
    if ((++_sp & 255u) == 0u) { if (xb_ld(&(bar)[XB_TMO])) break; if (_sp > XB_SPIN_CAP) { atomicAdd(&(bar)[XB_TMO], 1u); break; } } } } while (0)
struct XcdBarrier { unsigned* bar; unsigned x; volatile LAS unsigned* st; };
__device__ __forceinline__ XcdBarrier xcd_barrier_post(unsigned* bar, volatile LAS unsigned* st, int tid) {
    XcdBarrier b; b.bar = bar; b.x = xb_xcc_id(); b.st = st;
    if (tid == 0) (void)xb_add(&bar[XB_XCNT(b.x)], 1u);
    return b;
}
__device__ __forceinline__ void xcd_barrier_complete(unsigned* bar, unsigned x, unsigned& nloc, unsigned& nx) {
    const unsigned G = gridDim.x * gridDim.y * gridDim.z;
    unsigned sum, cnt, mine, sp = 0u;
    for (;;) {
        sum = 0u; cnt = 0u; mine = 0u;
#pragma unroll
        for (unsigned j = 0; j < 16; ++j) { const unsigned c = xb_ld(&bar[XB_XCNT(j)]); sum += c; cnt += (c > 0u) ? 1u : 0u; mine = (j == x) ? c : mine; }
        if (sum == G) break;
        __builtin_amdgcn_s_sleep(1);
        if ((++sp & 255u) == 0u) { if (xb_ld(&bar[XB_TMO])) break; if (sp > XB_SPIN_CAP) { atomicAdd(&bar[XB_TMO], 1u); break; } }
    }
    nloc = mine > 0u ? mine : 1u; nx = cnt > 0u ? cnt : 1u;
}
__device__ __forceinline__ void xcd_barrier(const XcdBarrier& b, int tid) {
    asm volatile("s_waitcnt vmcnt(0)" ::: "memory");
    __syncthreads();
    if (tid == 0) {
        unsigned* bar = b.bar;
        __builtin_amdgcn_s_waitcnt(0);
        unsigned nloc = b.st[0], nx = b.st[1];
        if (nloc == 0u) { xcd_barrier_complete(bar, b.x, nloc, nx); b.st[0] = nloc; b.st[1] = nx; }
        const unsigned old = xb_add(&bar[XB_XSUB(b.x)], 1u);
        const unsigned gen = old / nloc;
        if (old + 1u == (gen + 1u) * nloc) {
            __builtin_amdgcn_fence(__ATOMIC_RELEASE, "agent");
            asm volatile("s_waitcnt vmcnt(0)" ::: "memory");
            const unsigned og = xb_add(&bar[XB_TOP], 1u);
            const unsigned tg = og / nx;
            if (og + 1u == (tg + 1u) * nx) xb_add(&bar[XB_TOPGEN], 1u);
            else XB_SPIN(xb_ld(&bar[XB_TOPGEN]) == tg, bar);
            __builtin_amdgcn_fence(__ATOMIC_ACQUIRE, "agent");
            xb_add(&bar[XB_XGEN(b.x)], 1u);
            asm volatile("s_waitcnt vmcnt(0)" ::: "memory");
        } else {
            XB_SPIN(xb_ld(&bar[XB_XGEN(b.x)]) == gen, bar);
            __builtin_amdgcn_fence(__ATOMIC_ACQUIRE, "agent");
            asm volatile("s_waitcnt vmcnt(0)" ::: "memory");
        }
    }
    __syncthreads();
}

constexpr int BM = 256, BK = 64, HALF = 128, HTB = HALF * BK * 2, STAGE_BYTES = 8 * HTB;
__host__ __device__ __forceinline__ int lds_byte(int r, int c) { const int st = (r >> 4) * 2 + (c >> 5), rr = r & 15, cc = c & 31, ob = rr * 64 + cc * 2; return st * 1024 + (ob ^ (((ob >> 9) & 1) << 5)); }
__host__ __device__ __forceinline__ void stage_rc(int b, int& R, int& C) { const int st = b / 1024, sb = b % 1024, swz = sb ^ (((sb >> 9) & 1) << 5); R = (st >> 1) * 16 + swz / 64; C = (st & 1) * 32 + (swz % 64) / 2; }
__host__ __device__ __forceinline__ int perm32(int rho) { const int n = rho >> 4, i = rho & 15; return 8 * (i >> 2) + 4 * n + (i & 3); }

struct Unit { const char* a; const char* b; int row0, col0, e, pad; };
struct GemmDims { int K, lda, ldb; };
typedef f32x4 Acc[2][2][4][2];
__device__ __forceinline__ void zero_acc(Acc& acc) {
#pragma unroll
    for (int a = 0; a < 2; ++a)
#pragma unroll
        for (int b = 0; b < 2; ++b)
#pragma unroll
            for (int m = 0; m < 4; ++m)
#pragma unroll
                for (int n = 0; n < 2; ++n)
#pragma unroll
                    for (int j = 0; j < 4; ++j) { float z; asm volatile("v_mov_b32 %0, 0" : "=v"(z)); acc[a][b][m][n][j] = z; }
}

typedef int v8i32 __attribute__((ext_vector_type(8)));
template <bool F8 = false, class CtxT, class Epi, class Sched>
__device__ __forceinline__ void gemm_phase(const CtxT& C, const GemmDims g, const Sched& S, const Epi& E) {
    LAS unsigned char* lds = C.lds;
    const int tid = C.tid, wid = __builtin_amdgcn_readfirstlane(tid >> 6), lane = tid & 63, wr = wid >> 2, wc = wid & 3, fr = lane & 15, fq = lane >> 4;
    constexpr int ESZ = F8 ? 1 : 2;
    constexpr bool GA = Sched::GATHER;
    int nt = g.K / (F8 ? 128 : BK); asm volatile("" : "+s"(nt));
    unsigned voffA[2], voffB[2];
#pragma unroll
    for (int i = 0; i < 2; ++i) { int R, C; stage_rc(tid * 16 + i * 8192, R, C); const int Rb = (R & ~31) + perm32(R & 31);
        voffA[i] = (unsigned)(R * g.lda * ESZ + C * 2); voffB[i] = (unsigned)(Rb * g.ldb * ESZ + C * 2); }
    unsigned voffG[2][2];
    auto load_goffs = [&](int uidx) { if constexpr (GA) { int R, Cc; stage_rc(tid * 16, R, Cc); const LAS int* tp = S.gtab + uidx * 256 + R;
#pragma unroll
        for (int h = 0; h < 2; ++h)
#pragma unroll
            for (int i = 0; i < 2; ++i) voffG[h][i] = (unsigned)tp[h * 128 + i * 64] * (unsigned)(g.lda * ESZ) + (unsigned)(Cc * 2); } };
    const size_t kstep = (size_t)(BK * 2);
    const size_t hstepA = (size_t)HALF * g.lda * ESZ, hstepB = (size_t)HALF * g.ldb * ESZ;
    const unsigned ldsw = (unsigned)wid * 1024u;
    const unsigned ldsu = (unsigned)__builtin_amdgcn_readfirstlane((int)(unsigned)(unsigned long long)(lds));
    const int aoff = lds_byte(wr * 64 + fr, fq * 8), boff = lds_byte(wc * 32 + fr, fq * 8);
#define PG8_SA(b, h) (((b) * 2 + (h)) * HTB)
#define PG8_SB(b, h) ((4 + (b) * 2 + (h)) * HTB)
#define PG8_STAGE(bufoff, gbase, voff) do { _Pragma("unroll") for (int _i = 0; _i < 2; ++_i) { \
        asm volatile("s_mov_b32 m0, %2\n\ts_nop 3\n\tglobal_load_lds_dwordx4 %0, %1" :: "v"((voff)[_i]), "s"((const char*)(gbase)), "s"(ldsu + (unsigned)(bufoff) + ldsw + (unsigned)(_i * 8192)) : "memory"); } } while (0)
#define PG8_STAGE_A(bufoff, gbase, h) do { if constexpr (GA) PG8_STAGE(bufoff, gbase, voffG[h]); else PG8_STAGE(bufoff, (gbase) + (h) * hstepA, voffA); } while (0)
#define PG8_LDA(dst, b, h) do { _Pragma("unroll") for (int m = 0; m < 4; ++m) _Pragma("unroll") for (int k = 0; k < 2; ++k) dst[m][k] = *(const LAS bf16x8*)(lds + PG8_SA(b, h) + aoff + m * 2048 + k * 1024); } while (0)
#define PG8_LDB(dst, b, h) do { _Pragma("unroll") for (int n = 0; n < 2; ++n) _Pragma("unroll") for (int k = 0; k < 2; ++k) dst[n][k] = *(const LAS bf16x8*)(lds + PG8_SB(b, h) + boff + n * 2048 + k * 1024); } while (0)
#define PG8_CAT(x) __builtin_bit_cast(v8i32, (x))
#define PG8_MMA(ai, bj, At, Bt) do { __builtin_amdgcn_s_setprio(1); \
        if constexpr (F8) { _Pragma("unroll") for (int m = 0; m < 4; ++m) _Pragma("unroll") for (int n = 0; n < 2; ++n) \
            acc[ai][bj][m][n] = __builtin_amdgcn_mfma_scale_f32_16x16x128_f8f6f4(PG8_CAT(Bt[n]), PG8_CAT(At[m]), acc[ai][bj][m][n], 0, 0, 0, 0, 0, 0); } \
        else { _Pragma("unroll") for (int m = 0; m < 4; ++m) _Pragma("unroll") for (int n = 0; n < 2; ++n) _Pragma("unroll") for (int k = 0; k < 2; ++k) \
            acc[ai][bj][m][n] = __builtin_amdgcn_mfma_f32_16x16x32_bf16(Bt[n][k], At[m][k], acc[ai][bj][m][n], 0, 0, 0); } \
        __builtin_amdgcn_s_setprio(0); } while (0)
#define PG8_WAIT_V(n) asm volatile("s_waitcnt vmcnt(" #n ")" ::: "memory")
#define PG8_WAIT_L(n) asm volatile("s_waitcnt lgkmcnt(" #n ")" ::: "memory")
#define PG8_BAR __builtin_amdgcn_s_barrier()
#define PG8_SCHED __builtin_amdgcn_sched_barrier(0)
    Unit cur, nxt; int ui = 0;
    if (!S.next(0, cur)) return;
    Acc acc; zero_acc(acc);
    struct Frag2 { bf16x8 p[2]; __device__ __forceinline__ bf16x8& operator[](int k) { return p[k]; } __device__ __forceinline__ const bf16x8& operator[](int k) const { return p[k]; } };
    Frag2 At[4], B0[2], B1[2];
    const char* cA = cur.a; const char* cB = cur.b;
    load_goffs(0);
    PG8_STAGE(PG8_SB(0, 0), cB, voffB); PG8_STAGE(PG8_SB(0, 1), cB + hstepB, voffB); PG8_STAGE_A(PG8_SA(0, 0), cA, 0); PG8_STAGE_A(PG8_SA(0, 1), cA, 1);
    if (wr == 1) PG8_BAR;
    PG8_WAIT_V(2); PG8_BAR;
    PG8_STAGE(PG8_SB(1, 0), cB + kstep, voffB); PG8_STAGE_A(PG8_SA(1, 0), cA + kstep, 0); PG8_STAGE(PG8_SB(1, 1), cB + hstepB + kstep, voffB);
    PG8_WAIT_V(6); PG8_BAR;
    for (;;) {
        const bool has_next = S.next(ui + 1, nxt);
        const char* nA = has_next ? nxt.a : cA; const char* nB = has_next ? nxt.b : cB;
        for (int t = 0; t < nt; t += 2) {
            const bool last = (t == nt - 2);
            const char* a1 = cA + (size_t)(t + 1) * kstep;
            const char* a2 = last ? nA : cA + (size_t)(t + 2) * kstep; const char* b2 = last ? nB : cB + (size_t)(t + 2) * kstep;
            const char* a3 = a2 + kstep; const char* b3 = b2 + kstep;
            PG8_LDB(B0, 0, 0); PG8_LDB(B1, 0, 1); PG8_SCHED; PG8_LDA(At, 0, 0); PG8_STAGE_A(PG8_SA(1, 1), a1, 1);
            if (GA && last && has_next) load_goffs(ui + 1);
            PG8_WAIT_V(8); PG8_WAIT_L(0); PG8_BAR; PG8_MMA(0, 0, At, B0); PG8_MMA(0, 1, At, B1); PG8_BAR; PG8_SCHED;
            PG8_LDA(At, 0, 1); PG8_STAGE(PG8_SB(0, 0), b2, voffB); PG8_STAGE(PG8_SB(0, 1), b2 + hstepB, voffB); PG8_STAGE_A(PG8_SA(0, 0), a2, 0);
            PG8_WAIT_V(8); PG8_WAIT_L(0); PG8_BAR; PG8_MMA(1, 0, At, B0); PG8_MMA(1, 1, At, B1); PG8_BAR; PG8_SCHED;
            PG8_LDB(B0, 1, 0); PG8_LDB(B1, 1, 1); PG8_SCHED; PG8_LDA(At, 1, 0); PG8_STAGE_A(PG8_SA(0, 1), a2, 1);
            PG8_WAIT_V(8); PG8_WAIT_L(0); PG8_BAR; PG8_MMA(0, 0, At, B0); PG8_MMA(0, 1, At, B1); PG8_BAR; PG8_SCHED;
            PG8_LDA(At, 1, 1); PG8_STAGE(PG8_SB(1, 0), b3, voffB); PG8_STAGE(PG8_SB(1, 1), b3 + hstepB, voffB); PG8_STAGE_A(PG8_SA(1, 0), a3, 0);
            PG8_WAIT_V(8); PG8_WAIT_L(0); PG8_BAR; PG8_MMA(1, 0, At, B0); PG8_MMA(1, 1, At, B1); PG8_BAR; PG8_SCHED;
        }
        if (wr == 0) PG8_BAR;
        E(acc, cur, wr, wc, fr, fq);
        if (!has_next) break;
        zero_acc(acc);
        cur = nxt; cA = nA; cB = nB; ++ui;
        if (wr == 1) PG8_BAR;
    }
    PG8_WAIT_V(0);
    PG8_BAR;
#undef PG8_SA
#undef PG8_SB
#undef PG8_STAGE
#undef PG8_STAGE_A
#undef PG8_LDA
#undef PG8_LDB
#undef PG8_MMA
#undef PG8_CAT
#undef PG8_WAIT_V
#undef PG8_WAIT_L
#undef PG8_BAR
#undef PG8_SCHED
}

struct DenseOrder {
    static constexpr bool GATHER = false;
    const char* A; const char* Bt; int lda, ldb, nM, nN, nwg, G, c;
    __device__ __forceinline__ void init(const void* A_, const void* Bt_, int lda_, int ldb_, int M, int N, int G_, int c_) { A = (const char*)A_; Bt = (const char*)Bt_; lda = lda_; ldb = ldb_; nM = M / BM; nN = N / BM; nwg = nM * nN; G = G_; c = c_; }
    __device__ __forceinline__ bool next(int i, Unit& u) const {
        const long L = (long)i * G + c; if (L >= nwg) return false;
        int wgid = (int)L; { const int q = nwg / 8, r = nwg % 8, xcd = wgid % 8, off = wgid / 8; wgid = (xcd < r ? xcd * (q + 1) : r * (q + 1) + (xcd - r) * q) + off; }
        const int nig = 8 * nN, gid = wgid / nig, fm = gid * 8, gsz = (nM - fm) < 8 ? (nM - fm) : 8;
        const int pm = fm + ((wgid % nig) % gsz), pn = (wgid % nig) / gsz;
        u.a = A + (size_t)pm * BM * lda * 2; u.b = Bt + (size_t)pn * BM * ldb * 2; u.row0 = pm * BM; u.col0 = pn * BM; u.e = 0; u.pad = 0; return true;
    }
};
struct LruOrder {
    static constexpr bool GATHER = false;
    const char* XC; const char* RG; int G, c;
    __device__ __forceinline__ bool next(int i, Unit& u) const {
        const int L = i * G + c; if (L >= 512) return false;
        const int pm = L >> 3, n = L & 7;
        u.a = XC + ((size_t)pm * BM * 1024 + n * 128) * 2; u.b = RG + (size_t)n * 256 * 128 * 2; u.row0 = pm * BM; u.col0 = n * 128; u.e = n; u.pad = 0; return true;
    }
};
template <bool GATHER_ = false> struct MoeOrderT {
    static constexpr bool GATHER = GATHER_; const LAS int* gtab;
    const char* A; const char* WT; size_t estride; const LAS int* tile_e; int NT, nN, G, c, esz;
    __device__ __forceinline__ bool next(int i, Unit& u) const {
        int tile, pn;
#ifndef MOE_ORDER_ALT
#define MOE_ORDER_ALT 0
#endif
        if (!MOE_ORDER_ALT && (G % (8 * nN)) == 0) { const int R = G / nN; tile = i * R + (c & 7) * (R >> 3) + (c >> 3) / nN; pn = (c >> 3) % nN; }
        else { const int L = i * G + c; tile = L / nN; pn = L % nN; }
        if (tile >= NT) return false;
        const int e = __builtin_amdgcn_readfirstlane(tile_e[tile]);
        u.a = GATHER ? A : A + (size_t)tile * BM * 1024 * esz; u.b = WT + (size_t)e * estride + (size_t)pn * BM * 1024 * esz; u.row0 = tile * BM; u.col0 = pn * BM; u.e = e; u.pad = 0; return true;
    }
};
typedef MoeOrderT<false> MoeOrder;

#define EPI_ROW(ai, m) (u.row0 + (ai) * HALF + wr * 64 + (m) * 16 + fr)
#define EPI_COL(bj) (u.col0 + (bj) * HALF + wc * 32 + 8 * fq)
struct EpiBf16 {
    bf16_t* O; const float* bias; int ldc, bias_es; float ascale;
    __device__ __forceinline__ void operator()(const Acc& acc, const Unit& u, int wr, int wc, int fr, int fq) const {
        f32x4 bv[2][2];
#pragma unroll
        for (int bj = 0; bj < 2; ++bj)
#pragma unroll
            for (int n = 0; n < 2; ++n) bv[bj][n] = bias ? *(const f32x4*)(bias + (size_t)u.e * bias_es + EPI_COL(bj) + 4 * n) : (f32x4){0.f, 0.f, 0.f, 0.f};
#pragma unroll
        for (int ai = 0; ai < 2; ++ai)
#pragma unroll
            for (int m = 0; m < 4; ++m) { bf16_t* rowp = O + (size_t)EPI_ROW(ai, m) * ldc;
#pragma unroll
                for (int bj = 0; bj < 2; ++bj) { const f32x4 v0 = acc[ai][bj][m][0] * ascale + bv[bj][0], v1 = acc[ai][bj][m][1] * ascale + bv[bj][1];
                    u32x4 w; w.x = cvt_pk_bf16(v0[0], v0[1]); w.y = cvt_pk_bf16(v0[2], v0[3]); w.z = cvt_pk_bf16(v1[0], v1[1]); w.w = cvt_pk_bf16(v1[2], v1[3]);
                    *(u32x4*)(rowp + EPI_COL(bj)) = w; } }
    }
};
template <int KIND> struct EpiNorm {
    bf16_t* O; int ldc; const float* ga; const float* gb; const float* gc; const float* gd; const float* ge; const float* cs; LAS float* S;
    __device__ __forceinline__ void operator()(const Acc& acc, const Unit& u, int wr, int wc, int fr, int fq) const {
        const int pn = u.col0 >> 8; const int lane = fr + 16 * fq;
        int mode = 0; const float* gp = ga; float scale = 1.f;
        if (KIND == 0) { if (pn < 2) { mode = 1; gp = ga; scale = 0.125f * 1.4426950408889634f; } else if (pn < 4) { mode = 1; gp = gb; } else if (pn < 6) mode = 0; else if (pn == 6) { mode = 2; gp = gc; } else { mode = 3; gp = gd; } }
        if (KIND == 1) { scale = 0.10206207261596575f * 1.4426950408889634f; if (pn < 2) { mode = 1; gp = ga; } else { mode = 4; gp = gb; } }
        if (KIND == 2) { if (pn < 2) { mode = 1; gp = ga; } else mode = 0; }
        float ss[2][4][2];
        if (mode != 0) {
#pragma unroll
            for (int ai = 0; ai < 2; ++ai)
#pragma unroll
                for (int m = 0; m < 4; ++m)
#pragma unroll
                    for (int bj = 0; bj < 2; ++bj) { const f32x4 a = acc[ai][bj][m][0], b = acc[ai][bj][m][1];
                        float s = (a[0] * a[0] + a[1] * a[1]) + (a[2] * a[2] + a[3] * a[3]) + (b[0] * b[0] + b[1] * b[1]) + (b[2] * b[2] + b[3] * b[3]);
                        s += shx<16>(s); ss[ai][m][bj] = xadd32(s); } }
        if (mode == 1 || mode == 2 || mode == 3) {
            if (fq == 0) {
#pragma unroll
                for (int ai = 0; ai < 2; ++ai)
#pragma unroll
                    for (int m = 0; m < 4; ++m)
#pragma unroll
                        for (int bj = 0; bj < 2; ++bj) S[(ai * HALF + wr * 64 + m * 16 + fr) * 8 + bj * 4 + wc] = ss[ai][m][bj]; }
            asm volatile("s_waitcnt lgkmcnt(0)" ::: "memory"); __builtin_amdgcn_s_barrier(); asm volatile("" ::: "memory");
#pragma unroll
            for (int ai = 0; ai < 2; ++ai)
#pragma unroll
                for (int m = 0; m < 4; ++m) { const LAS float* sr = S + (ai * HALF + wr * 64 + m * 16 + fr) * 8;
#pragma unroll
                    for (int bj = 0; bj < 2; ++bj) {
                        if (mode == 1) { const f32x2 t = *(const LAS f32x2*)(sr + bj * 4 + (wc & 2)); ss[ai][m][bj] = t[0] + t[1]; }
                        else if (mode == 2) { const f32x4 t0 = *(const LAS f32x4*)sr, t1 = *(const LAS f32x4*)(sr + 4); ss[ai][m][bj] = (t0[0] + t0[1]) + (t0[2] + t0[3]) + (t1[0] + t1[1]) + (t1[2] + t1[3]); }
                        else if (bj == 0) { const f32x4 t0 = *(const LAS f32x4*)sr; ss[ai][m][bj] = (t0[0] + t0[1]) + (t0[2] + t0[3]); } } }
        }
        const float inv_n = (mode == 1) ? (1.f / 64.f) : (mode == 2) ? (1.f / 256.f) : (1.f / 32.f);
        const bool rope_tile = (mode == 4) || (mode == 3);
#pragma unroll
        for (int bj = 0; bj < 2; ++bj) {
            f32x4 g0 = (f32x4){1.f, 1.f, 1.f, 1.f}, g1 = g0; bool rope = false, zero = false; float invn = inv_n;
            const int c8 = 8 * fq;
            if (mode == 1) { const int c = 32 * (wc & 1) + c8; g0 = *(const f32x4*)(gp + c); g1 = *(const f32x4*)(gp + c + 4); }
            else if (mode == 2) { const int c = bj * HALF + wc * 32 + c8; g0 = *(const f32x4*)(gp + c); g1 = *(const f32x4*)(gp + c + 4); }
            else if (mode == 3) { if (bj == 0) { const int c = wc * 32 + c8; g0 = *(const f32x4*)(gp + c); g1 = *(const f32x4*)(gp + c + 4); invn = 1.f / 128.f; }
                                  else if (wc == 0) { g0 = *(const f32x4*)(ge + c8); g1 = *(const f32x4*)(ge + c8 + 4); rope = true; } else zero = true; }
            else if (mode == 4) { g0 = *(const f32x4*)(gp + c8); g1 = *(const f32x4*)(gp + c8 + 4); rope = true; }
            (void)rope_tile;
#pragma unroll
            for (int ai = 0; ai < 2; ++ai)
#pragma unroll
                for (int m = 0; m < 4; ++m) { const int row = EPI_ROW(ai, m);
                    f32x4 v0 = acc[ai][bj][m][0], v1 = acc[ai][bj][m][1];
                    if (mode != 0) { const float rs = rsqrtf(ss[ai][m][bj] * invn + 1e-6f) * scale; v0 = v0 * rs * g0; v1 = v1 * rs * g1; }
                    if (rope) {
                        const float* cr = cs + (size_t)row * 32 + 8 * (fq & 1); const f32x4 c0 = *(const f32x4*)cr, c1 = *(const f32x4*)(cr + 4), s0 = *(const f32x4*)(cr + 16), s1 = *(const f32x4*)(cr + 20);
                        f32x4 o0, o1;
#pragma unroll
                        for (int j = 0; j < 4; ++j) { const auto r0 = __builtin_amdgcn_permlane32_swap(__float_as_uint(v0[j]), __float_as_uint(v0[j]), false, false), r1 = __builtin_amdgcn_permlane32_swap(__float_as_uint(v1[j]), __float_as_uint(v1[j]), false, false);
                            const float ot0 = __uint_as_float(lane < 32 ? r0[1] : r0[0]), ot1 = __uint_as_float(lane < 32 ? r1[1] : r1[0]);
                            o0[j] = (lane < 32) ? (v0[j] * c0[j] - ot0 * s0[j]) : (ot0 * s0[j] + v0[j] * c0[j]);
                            o1[j] = (lane < 32) ? (v1[j] * c1[j] - ot1 * s1[j]) : (ot1 * s1[j] + v1[j] * c1[j]); }
                        v0 = o0; v1 = o1; }
                    if (zero) { v0 = (f32x4){0.f, 0.f, 0.f, 0.f}; v1 = v0; }
                    u32x4 w; w.x = cvt_pk_bf16(v0[0], v0[1]); w.y = cvt_pk_bf16(v0[2], v0[3]); w.z = cvt_pk_bf16(v1[0], v1[1]); w.w = cvt_pk_bf16(v1[2], v1[3]);
                    *(u32x4*)(O + (size_t)row * ldc + EPI_COL(bj)) = w; } }
    }
};
struct EpiRecIn {
    bf16_t* O; const float* bias;
    __device__ __forceinline__ void operator()(const Acc& acc, const Unit& u, int wr, int wc, int fr, int fq) const {
        const bool act = u.col0 < 1024;
        f32x4 bv[2][2];
#pragma unroll
        for (int bj = 0; bj < 2; ++bj)
#pragma unroll
            for (int n = 0; n < 2; ++n) bv[bj][n] = *(const f32x4*)(bias + EPI_COL(bj) + 4 * n);
#pragma unroll
        for (int ai = 0; ai < 2; ++ai)
#pragma unroll
            for (int m = 0; m < 4; ++m) { bf16_t* rowp = O + (size_t)EPI_ROW(ai, m) * 2048;
#pragma unroll
                for (int bj = 0; bj < 2; ++bj) { f32x4 v0 = acc[ai][bj][m][0] + bv[bj][0], v1 = acc[ai][bj][m][1] + bv[bj][1];
                    if (act) {
#pragma unroll
                        for (int j = 0; j < 4; ++j) { v0[j] = fgelu_tanh(v0[j]); v1[j] = fgelu_tanh(v1[j]); } }
                    u32x4 w; w.x = cvt_pk_bf16(v0[0], v0[1]); w.y = cvt_pk_bf16(v0[2], v0[3]); w.z = cvt_pk_bf16(v1[0], v1[1]); w.w = cvt_pk_bf16(v1[2], v1[3]);
                    *(u32x4*)(rowp + EPI_COL(bj)) = w; } }
    }
};
__device__ __forceinline__ unsigned pk4_fp8(float a, float b, float c, float d) { int w = 0; w = __builtin_amdgcn_cvt_pk_fp8_f32(a, b, w, false); w = __builtin_amdgcn_cvt_pk_fp8_f32(c, d, w, true); return (unsigned)w; }
struct EpiSwiglu {
    unsigned char* ACT; const float* b1; float ascale;
    __device__ __forceinline__ float sw(float g, float l) const { g = fminf(g, 7.f); l = fminf(fmaxf(l, -7.f), 7.f); return g * fsigmoid(1.702f * g) * (l + 1.f); }
    __device__ __forceinline__ void operator()(const Acc& acc, const Unit& u, int wr, int wc, int fr, int fq) const {
        f32x4 bv[2][2];
#pragma unroll
        for (int bj = 0; bj < 2; ++bj)
#pragma unroll
            for (int n = 0; n < 2; ++n) bv[bj][n] = *(const f32x4*)(b1 + (size_t)u.e * 2048 + EPI_COL(bj) + 4 * n);
#pragma unroll
        for (int ai = 0; ai < 2; ++ai)
#pragma unroll
            for (int m = 0; m < 4; ++m) { unsigned char* rowp = ACT + (size_t)EPI_ROW(ai, m) * 1024;
#pragma unroll
                for (int bj = 0; bj < 2; ++bj) { const f32x4 v0 = acc[ai][bj][m][0] * ascale + bv[bj][0], v1 = acc[ai][bj][m][1] * ascale + bv[bj][1];
                    *(unsigned*)(rowp + (EPI_COL(bj) >> 1)) = pk4_fp8(sw(v0[0], v0[1]), sw(v0[2], v0[3]), sw(v1[0], v1[1]), sw(v1[2], v1[3])); } }
    }
};
struct EpiResid {
    bf16_t* X; const float* g; const float* bias;
    __device__ __forceinline__ void operator()(const Acc& acc, const Unit& u, int wr, int wc, int fr, int fq) const {
        const int b = u.row0 / cfg::S;
        f32x4 bv[2][2], gv[2][2];
#pragma unroll
        for (int bj = 0; bj < 2; ++bj)
#pragma unroll
            for (int n = 0; n < 2; ++n) { bv[bj][n] = bias ? *(const f32x4*)(bias + EPI_COL(bj) + 4 * n) : (f32x4){0.f, 0.f, 0.f, 0.f}; gv[bj][n] = *(const f32x4*)(g + b * 6144 + EPI_COL(bj) + 4 * n); }
#pragma unroll
        for (int ai = 0; ai < 2; ++ai)
#pragma unroll
            for (int m = 0; m < 4; ++m) { bf16_t* rowp = X + (size_t)EPI_ROW(ai, m) * 1024;
#pragma unroll
                for (int bj = 0; bj < 2; ++bj) { u32x4* p = (u32x4*)(rowp + EPI_COL(bj)); const u32x4 xw = *p;
                    const f32x4 x0 = (f32x4){bf_lo(xw.x), bf_hi(xw.x), bf_lo(xw.y), bf_hi(xw.y)} + gv[bj][0] * (acc[ai][bj][m][0] + bv[bj][0]);
                    const f32x4 x1 = (f32x4){bf_lo(xw.z), bf_hi(xw.z), bf_lo(xw.w), bf_hi(xw.w)} + gv[bj][1] * (acc[ai][bj][m][1] + bv[bj][1]);
                    u32x4 w; w.x = cvt_pk_bf16(x0[0], x0[1]); w.y = cvt_pk_bf16(x0[2], x0[3]); w.z = cvt_pk_bf16(x1[0], x1[1]); w.w = cvt_pk_bf16(x1[2], x1[3]); *p = w; }
                if (m & 1) asm volatile("" ::: "memory"); }
    }
};
struct EpiLru {
    const bf16_t* XC; const float* ba; const float* bx; const float* lam; bf16_t* LA; bf16_t* Bb;
    __device__ __forceinline__ void operator()(const Acc& acc, const Unit& u, int wr, int wc, int fr, int fq) const {
        const int ch0 = u.col0 + wc * 32 + 8 * fq;
#pragma unroll
        for (int n = 0; n < 2; ++n) { const int ch = ch0 + 4 * n;
            const f32x4 bav = *(const f32x4*)(ba + ch), bxv = *(const f32x4*)(bx + ch), spv = *(const f32x4*)(lam + ch);
#pragma unroll
            for (int ai = 0; ai < 2; ++ai)
#pragma unroll
                for (int m = 0; m < 4; ++m) { const size_t ro = (size_t)EPI_ROW(ai, m) * 1024 + ch;
                    const u32x2 xr = *(const u32x2*)(XC + ro);
                    const float xcv[4] = {bf_lo(xr.x), bf_hi(xr.x), bf_lo(xr.y), bf_hi(xr.y)};
                    float lav[4], bvv[4];
#pragma unroll
                    for (int j = 0; j < 4; ++j) { const float r = fsigmoid(acc[ai][0][m][n][j] + bav[j]), ig = fsigmoid(acc[ai][1][m][n][j] + bxv[j]);
                        const float la = r * spv[j], a = fexp2(la); lav[j] = la; bvv[j] = __builtin_amdgcn_sqrtf(fmaxf(1.f - a * a, 0.f)) * ig * xcv[j]; }
                    u32x2 wa, wb; wa.x = cvt_pk_bf16(lav[0], lav[1]); wa.y = cvt_pk_bf16(lav[2], lav[3]); wb.x = cvt_pk_bf16(bvv[0], bvv[1]); wb.y = cvt_pk_bf16(bvv[2], bvv[3]);
                    *(u32x2*)(LA + ro) = wa; *(u32x2*)(Bb + ro) = wb; asm volatile("" ::: "memory"); } }
    }
};

constexpr size_t MiB = (size_t)1 << 20;
constexpr size_t al4k(size_t x) { return (x + 4095) & ~(size_t)4095; }
constexpr int T_ = cfg::T, S_ = cfg::S, P_ = cfg::P;
constexpr size_t O_CTL = 0, SZ_CTL = 1 * MiB;
constexpr size_t O_MOD = O_CTL + SZ_CTL, SZ_MOD = al4k((size_t)4 * 4 * 6144 * 4);
constexpr size_t O_CS = O_MOD + SZ_MOD, SZ_CS = (size_t)T_ * 32 * 4;
constexpr size_t O_HIST = O_CS + SZ_CS, SZ_HIST = 256 * 32 * 4;
constexpr size_t O_TOPI = O_HIST + SZ_HIST, SZ_TOP = (size_t)T_ * 4 * 4;
constexpr size_t O_TOPG = O_TOPI + SZ_TOP, O_POS = O_TOPG + SZ_TOP;
constexpr size_t O_SUMP = O_POS + SZ_TOP, SZ_SUM = (size_t)4 * 64 * 1024 * 4;
constexpr size_t O_SUMH = O_SUMP + SZ_SUM;
constexpr size_t O_LSE = O_SUMH + SZ_SUM, SZ_LSE = (size_t)3 * T_ * 8 * 4;
constexpr size_t O_SPV = al4k(O_LSE + SZ_LSE), SZ_SPV = 2 * 1024 * 4;
constexpr size_t O_WIN = al4k(O_SPV + SZ_SPV), SZ_WIN = (size_t)2048 * 1024 * 2;
constexpr size_t O_WUQ = O_WIN + 2 * SZ_WIN, SZ_WUQ = (size_t)768 * 256 * 2;
constexpr size_t O_WUKV = O_WUQ + 2 * SZ_WUQ, SZ_WUKV = (size_t)1024 * 128 * 2;
constexpr size_t O_WOUT = O_WUKV + 2 * SZ_WUKV, SZ_WOUT = (size_t)1024 * 1024 * 2;
constexpr size_t O_RWIN = O_WOUT + 2 * SZ_WOUT, SZ_RWIN = (size_t)2048 * 1024 * 2;
constexpr size_t O_RGATE = O_RWIN + 2 * SZ_RWIN, SZ_RGATE = (size_t)8 * 256 * 128 * 2;
constexpr size_t O_RWOUT = O_RGATE + 2 * SZ_RGATE, SZ_RWOUT = (size_t)1024 * 1024 * 2;
constexpr size_t O_W1 = O_RWOUT + 2 * SZ_RWOUT, SZ_W1E = (size_t)2048 * 1024;
constexpr size_t O_W2 = O_W1 + 128 * SZ_W1E, SZ_W2E = (size_t)1024 * 1024;
constexpr size_t O_HN = O_W2 + 128 * SZ_W2E, SZ_HN = (size_t)T_ * 1024 * 2;
constexpr size_t O_PROJ = O_HN + SZ_HN, SZ_PROJ = (size_t)T_ * 2048 * 2;
constexpr size_t O_Q2 = O_PROJ + SZ_PROJ, SZ_Q2 = (size_t)T_ * 768 * 2;
constexpr size_t O_KV2 = O_Q2 + SZ_Q2, SZ_KV2 = (size_t)T_ * 1024 * 2;
constexpr size_t O_OA = O_KV2 + SZ_KV2, SZ_OA = (size_t)3 * T_ * 512 * 2;
constexpr size_t O_ATT = O_OA + SZ_OA, SZ_ATT = (size_t)T_ * 1024 * 2;
constexpr size_t O_XC = O_ATT + SZ_ATT, SZ_XC = (size_t)T_ * 1024 * 2;
constexpr size_t O_AA = O_XC + SZ_XC, SZ_AA = (size_t)T_ * 1024 * 4;
constexpr size_t O_BB = O_AA + SZ_AA;
constexpr size_t O_XG = O_BB + SZ_AA, SZ_XG = (size_t)P_ * 1024 * 2, O_INV = O_XG, O_POSJ = O_XG + 4 * MiB;
constexpr size_t O_ACT = O_XG + SZ_XG, O_Y2 = O_ACT + SZ_XG;
constexpr size_t O_X = O_Y2 + SZ_XG, SZ_X = (size_t)T_ * 1024 * 2;
constexpr size_t O_DUMMY = O_X + SZ_X, SZ_DUMMY = (size_t)96 * MiB;
constexpr size_t WS_MK_END = O_DUMMY + SZ_DUMMY;
constexpr size_t O_NAIVE = (size_t)2048 * MiB;
static_assert(WS_MK_END <= O_NAIVE, "mk workspace");
constexpr int CW_BAR = 4096;
constexpr size_t O_ECNT = O_CTL + 512 * 1024;
constexpr int RING_BYTES = 131072, LDSX_OFF = RING_BYTES;
constexpr int LDS_BYTES = 147456;
constexpr int LX_TILE = LDSX_OFF + 64, LX_MISC = LDSX_OFF + 2048, LX_EXCH = LDSX_OFF + 6144, LX_GTAB = LX_EXCH, GTAB_UNITS = 10;

struct Args { const void* in[34]; float* out; unsigned char* ws; int ph_lo, ph_hi; };
struct Ctx { int tid, lane, wave, G, bid, vcu, gw, NGW; LAS unsigned char* lds; unsigned char* ws; };

__device__ __forceinline__ void conv_load(f32x4 (&v)[16], const float* __restrict__ W, int N, int n0, int k0, int lane) {
    const int n = n0 + 4 * (lane & 15); const float* p = W + (size_t)(k0 + 16 * (lane >> 4)) * N + n;
#pragma unroll
    for (int i = 0; i < 16; ++i) v[i] = (n < N) ? __builtin_nontemporal_load((const f32x4*)(p + (size_t)i * N)) : (f32x4){0.f, 0.f, 0.f, 0.f};
}
__device__ __forceinline__ int conv_row(int c, int perm) { if (perm == 1) { const int h = c / 96, d = c % 96; return d < 64 ? 64 * h + d : 512 + 32 * h + d - 64; } if (perm == 2) { const int h = c >> 7, d = c & 127; return d < 64 ? 64 * h + d : 512 + 64 * h + d - 64; } return c; }
__device__ __forceinline__ void conv_emit(const f32x4 (&v)[16], LAS unsigned char* T  , bf16_t* __restrict__ WT, int ldd, int n0, int k0, int lane, int perm) {
    const int kq = lane >> 4, c4 = lane & 15;
#pragma unroll
    for (int jj = 0; jj < 4; ++jj) { u32x4 lo, hi;
        lo.x = cvt_pk_bf16(v[0][jj], v[1][jj]); lo.y = cvt_pk_bf16(v[2][jj], v[3][jj]); lo.z = cvt_pk_bf16(v[4][jj], v[5][jj]); lo.w = cvt_pk_bf16(v[6][jj], v[7][jj]);
        hi.x = cvt_pk_bf16(v[8][jj], v[9][jj]); hi.y = cvt_pk_bf16(v[10][jj], v[11][jj]); hi.z = cvt_pk_bf16(v[12][jj], v[13][jj]); hi.w = cvt_pk_bf16(v[14][jj], v[15][jj]);
        LAS unsigned char* q = T + (4 * c4 + jj) * 144 + 32 * kq; *(LAS u32x4*)q = lo; *(LAS u32x4*)(q + 16) = hi; }
    asm volatile("s_waitcnt lgkmcnt(0)" ::: "memory");
#pragma unroll
    for (int s8 = 0; s8 < 8; ++s8) { const int n = 8 * s8 + (lane >> 3), ch = lane & 7; const u32x4 w = *(const LAS u32x4*)(T + n * 144 + 16 * ch);
        *(u32x4*)(WT + (size_t)conv_row(n0 + n, perm) * ldd + k0 + 8 * ch) = w; }
    asm volatile("s_waitcnt lgkmcnt(0)" ::: "memory");
}
__device__ __forceinline__ void conv8_tile(const float* __restrict__ W, int N, unsigned char* __restrict__ WT, int ldd, int n0, int k0, LAS unsigned char* T  , int lane) {
    const int kq = lane >> 4, c4 = lane & 15; const float* p = W + (size_t)(k0 + 32 * kq) * N + n0 + 4 * c4;
    f32x4 v[32];
#pragma unroll
    for (int i = 0; i < 32; ++i) v[i] = __builtin_nontemporal_load((const f32x4*)(p + (size_t)i * N));
#pragma unroll
    for (int jj = 0; jj < 4; ++jj) { u32x4 lo, hi;
        lo.x = pk4_fp8(32.f * v[0][jj], 32.f * v[1][jj], 32.f * v[2][jj], 32.f * v[3][jj]);     lo.y = pk4_fp8(32.f * v[4][jj], 32.f * v[5][jj], 32.f * v[6][jj], 32.f * v[7][jj]);
        lo.z = pk4_fp8(32.f * v[8][jj], 32.f * v[9][jj], 32.f * v[10][jj], 32.f * v[11][jj]);   lo.w = pk4_fp8(32.f * v[12][jj], 32.f * v[13][jj], 32.f * v[14][jj], 32.f * v[15][jj]);
        hi.x = pk4_fp8(32.f * v[16][jj], 32.f * v[17][jj], 32.f * v[18][jj], 32.f * v[19][jj]); hi.y = pk4_fp8(32.f * v[20][jj], 32.f * v[21][jj], 32.f * v[22][jj], 32.f * v[23][jj]);
        hi.z = pk4_fp8(32.f * v[24][jj], 32.f * v[25][jj], 32.f * v[26][jj], 32.f * v[27][jj]); hi.w = pk4_fp8(32.f * v[28][jj], 32.f * v[29][jj], 32.f * v[30][jj], 32.f * v[31][jj]);
        LAS unsigned char* q = T + (4 * c4 + jj) * 144 + 32 * kq; *(LAS u32x4*)q = lo; *(LAS u32x4*)(q + 16) = hi; }
    asm volatile("s_waitcnt lgkmcnt(0)" ::: "memory");
#pragma unroll
    for (int s8 = 0; s8 < 8; ++s8) { const int n = 8 * s8 + (lane >> 3), ch = lane & 7; const u32x4 w = *(const LAS u32x4*)(T + n * 144 + 16 * ch);
        *(u32x4*)(WT + (size_t)(n0 + n) * ldd + k0 + 16 * ch) = w; }
    asm volatile("s_waitcnt lgkmcnt(0)" ::: "memory");
}
template <class AP> __device__ __forceinline__ void p0_prologue(const Ctx& C, AP a) {
    unsigned char* ws = C.ws;
    { const float* c = (const float*)a->in[1]; const float* ada_w = (const float*)a->in[3]; const float* ada_b = (const float*)a->in[4]; float* mod = (float*)(ws + O_MOD);
      LAS float* part = (LAS float*)C.lds;
      LAS float* cact = (LAS float*)(C.lds + 32768);
      if (C.bid < 4 * 24) { for (int i = C.tid; i < 4096; i += 512) { const int b = i >> 10, k = i & 1023; const float cv = c[i]; cact[k * 4 + b] = cv / (1.f + expf(-cv)); } __syncthreads(); }
      for (int it = C.bid; it < 4 * 24; it += C.G) { const int l = it / 24, n0 = (it % 24) * 256;
          f32x4 acc[4];
#pragma unroll
          for (int b = 0; b < 4; ++b) acc[b] = (f32x4){0.f, 0.f, 0.f, 0.f};
          const float* w = ada_w + (size_t)l * 1024 * 6144 + n0 + 4 * C.lane;
#pragma unroll 1
          for (int k0 = C.wave * 128; k0 < C.wave * 128 + 128; k0 += 16) { f32x4 wv[16];
#pragma unroll
              for (int i = 0; i < 16; ++i) wv[i] = __builtin_nontemporal_load((const f32x4*)(w + (size_t)(k0 + i) * 6144));
#pragma unroll
              for (int i = 0; i < 16; ++i) { const f32x4 sv = *(const LAS f32x4*)(cact + (k0 + i) * 4);
#pragma unroll
                  for (int b = 0; b < 4; ++b) acc[b] = acc[b] + sv[b] * wv[i]; } }
#pragma unroll
          for (int b = 0; b < 4; ++b) *(LAS f32x4*)(part + (C.wave * 4 + b) * 256 + 4 * C.lane) = acc[b];
          __syncthreads();
          for (int o = C.tid; o < 1024; o += 512) { const int b = o >> 8, n = o & 255; float sacc = ada_b[l * 6144 + n0 + n];
#pragma unroll
              for (int w8 = 0; w8 < 8; ++w8) sacc += part[(w8 * 4 + b) * 256 + n];
              mod[((size_t)l * 4 + b) * 6144 + n0 + n] = sacc; }
          __syncthreads(); } }
    { const int* positions = (const int*)a->in[2]; float* cs = (float*)(ws + O_CS);
      for (int i = C.bid * 512 + C.tid; i < T_ * 16; i += C.G * 512) { const int t = i >> 4, f = i & 15; const float inv = powf(10000.f, -(float)(2 * f) / 32.f); const float ang = (float)positions[t] * inv;
          cs[t * 32 + f] = cosf(ang); cs[t * 32 + 16 + f] = sinf(ang); } }
    { const float* lam = (const float*)a->in[25]; float* spv = (float*)(ws + O_SPV);
      for (int i = C.bid * 512 + C.tid; i < 2048; i += C.G * 512) spv[i] = -8.f * 1.4426950408889634f * log1pf(expf(-lam[i])); }
    { const int lane = C.lane; LAS unsigned char* T = C.lds + 49152 + C.wave * 9216;
      const float* attn_w_in = (const float*)a->in[7]; const float* w_uq = (const float*)a->in[12]; const float* w_ukv = (const float*)a->in[13]; const float* attn_w_out = (const float*)a->in[16];
      const float* rec_w_in = (const float*)a->in[17]; const float* rec_wa = (const float*)a->in[21]; const float* rec_wx = (const float*)a->in[23]; const float* rec_w_out = (const float*)a->in[26];
      const float* w1 = (const float*)a->in[30]; const float* w2 = (const float*)a->in[32];
      constexpr int T_WIN = 32 * 16, T_WUQ = 12 * 4, T_WUKV = 16 * 2, T_WOUT = 16 * 16, T_RWIN = 32 * 16, T_RG = 2 * 2, T_RWOUT = 16 * 16, T_W1 = 32 * 16, T_W2 = 16 * 16;
      constexpr int NITEMS = 2 * (T_WIN + T_WUQ + T_WUKV + T_WOUT + T_RWIN + 16 * T_RG + T_RWOUT);
      struct Job { const float* W; bf16_t* WT; int N, ldd, n0, k0, perm; };
      auto decode = [&](int r, Job& jb) {
#define CONV_JOB(SRC, KK, NN, DST, NROWS, NMAT, SRC_MS, DST_MS, PERM) { constexpr int kc_ = (KK) / 64, per_ = ((NROWS) / 64) * kc_, tot_ = per_ * (NMAT); \
          if (r < tot_) { const int mat_ = r / per_, q_ = r % per_; jb.W = (SRC) + (size_t)mat_ * (SRC_MS); jb.WT = (bf16_t*)(ws + (DST) + (size_t)mat_ * (DST_MS)); jb.N = (NN); jb.ldd = (KK); jb.n0 = (q_ / kc_) * 64; jb.k0 = (q_ % kc_) * 64; jb.perm = (PERM); return; } r -= tot_; }
          CONV_JOB(attn_w_in, 1024, 1952, O_WIN, 2048, 2, (size_t)1024 * 1952, SZ_WIN, 0)
          CONV_JOB(w_uq, 256, 768, O_WUQ, 768, 2, (size_t)256 * 768, SZ_WUQ, 1)
          CONV_JOB(w_ukv, 128, 1024, O_WUKV, 1024, 2, (size_t)128 * 1024, SZ_WUKV, 2)
          CONV_JOB(attn_w_out, 1024, 1024, O_WOUT, 1024, 2, (size_t)1024 * 1024, SZ_WOUT, 0)
          CONV_JOB(rec_w_in, 1024, 2048, O_RWIN, 2048, 2, (size_t)1024 * 2048, SZ_RWIN, 0)
          CONV_JOB(rec_wa, 128, 128, O_RGATE, 128, 16, (size_t)128 * 128, (size_t)256 * 128 * 2, 0)
          CONV_JOB(rec_wx, 128, 128, O_RGATE + (size_t)128 * 128 * 2, 128, 16, (size_t)128 * 128, (size_t)256 * 128 * 2, 0)
          CONV_JOB(rec_w_out, 1024, 1024, O_RWOUT, 1024, 2, (size_t)1024 * 1024, SZ_RWOUT, 0)
#undef CONV_JOB
          jb.W = attn_w_in; jb.WT = (bf16_t*)(ws + O_WIN); jb.N = 1952; jb.ldd = 1024; jb.n0 = 0; jb.k0 = 0; jb.perm = 0; };
      f32x4 va[16], vb[16]; Job ja, jn;
      int it = C.gw;
      if (it < NITEMS) { decode(it, ja); conv_load(va, ja.W, ja.N, ja.n0, ja.k0, lane); }
#pragma unroll 1
      for (; it < NITEMS; it += 2 * C.NGW) {
          const bool h1 = it + C.NGW < NITEMS;
          if (h1) { decode(it + C.NGW, jn); conv_load(vb, jn.W, jn.N, jn.n0, jn.k0, lane); }
          conv_emit(va, T, ja.WT, ja.ldd, ja.n0, ja.k0, lane, ja.perm);
          const bool h2 = it + 2 * C.NGW < NITEMS;
          if (h2) { decode(it + 2 * C.NGW, ja); conv_load(va, ja.W, ja.N, ja.n0, ja.k0, lane); }
          if (h1) conv_emit(vb, T, jn.WT, jn.ldd, jn.n0, jn.k0, lane, jn.perm);
      }
    }
}

__device__ __forceinline__ void phase_norm(const Ctx& C, const float* xin  , float* out  , bool combine, bool do_norm, const float* gain, const float* modc  , const float* modl  , int shoff, int scoff, bool dummy = false) {
    const bf16_t* Y2 = (const bf16_t*)(C.ws + O_Y2); const int* pos = (const int*)(C.ws + O_POS); const float* topg = (const float*)(C.ws + O_TOPG); bf16_t* HN = (bf16_t*)(C.ws + (dummy ? O_DUMMY : O_HN)); const bf16_t* X = (const bf16_t*)(C.ws + O_X); bf16_t* Xo = (bf16_t*)(C.ws + (dummy ? O_DUMMY + 32 * MiB : O_X));
    const int lane = C.lane;
    for (int t = C.gw; t < T_; t += C.NGW) { const int b = t / S_;
        f32x4 v[4];
        if (xin) {
#pragma unroll
            for (int j = 0; j < 4; ++j) v[j] = *(const f32x4*)(xin + (size_t)t * 1024 + 256 * j + 4 * lane); }
        else {
#pragma unroll
            for (int j = 0; j < 4; ++j) { const u32x2 w = *(const u32x2*)(X + (size_t)t * 1024 + 256 * j + 4 * lane); v[j] = (f32x4){bf_lo(w.x), bf_hi(w.x), bf_lo(w.y), bf_hi(w.y)}; } }
        if (combine) { f32x4 y[4];
#pragma unroll
            for (int j = 0; j < 4; ++j) y[j] = (f32x4){0.f, 0.f, 0.f, 0.f};
#pragma unroll
            for (int k = 0; k < 4; ++k) { const int p = pos[t * 4 + k]; const float gk = topg[t * 4 + k];
#pragma unroll
                for (int j = 0; j < 4; ++j) { const u32x2 w = *(const u32x2*)(Y2 + (size_t)p * 1024 + 256 * j + 4 * lane);
                    y[j][0] += gk * bf_lo(w.x); y[j][1] += gk * bf_hi(w.x); y[j][2] += gk * bf_lo(w.y); y[j][3] += gk * bf_hi(w.y); } }
#pragma unroll
            for (int j = 0; j < 4; ++j) { const f32x4 g2 = *(const f32x4*)(modc + b * 6144 + 5120 + 256 * j + 4 * lane); v[j] = v[j] + g2 * y[j]; } }
        if (out) {
#pragma unroll
            for (int j = 0; j < 4; ++j) *(f32x4*)(out + (size_t)t * 1024 + 256 * j + 4 * lane) = v[j]; }
        else {
#pragma unroll
            for (int j = 0; j < 4; ++j) { u32x2 w; w.x = cvt_pk_bf16(v[j][0], v[j][1]); w.y = cvt_pk_bf16(v[j][2], v[j][3]); *(u32x2*)(Xo + (size_t)t * 1024 + 256 * j + 4 * lane) = w; } }
        if (do_norm) { float ss = 0.f;
#pragma unroll
            for (int j = 0; j < 4; ++j) ss += (v[j][0] * v[j][0] + v[j][1] * v[j][1]) + (v[j][2] * v[j][2] + v[j][3] * v[j][3]);
            const float rs = rsqrtf(wsum(ss) * (1.f / 1024.f) + 1e-6f);
#pragma unroll
            for (int j = 0; j < 4; ++j) { const int col = 256 * j + 4 * lane; const f32x4 gn = *(const f32x4*)(gain + col), sc = *(const f32x4*)(modl + b * 6144 + scoff + col), sh = *(const f32x4*)(modl + b * 6144 + shoff + col);
                const f32x4 h = v[j] * rs * gn * (1.f + sc) + sh;
                u32x2 w; w.x = cvt_pk_bf16(h[0], h[1]); w.y = cvt_pk_bf16(h[2], h[3]); *(u32x2*)(HN + (size_t)t * 1024 + col) = w; } }
    }
}

__device__ __forceinline__ void unpack8(const u32x4 w, float (&f)[8]) { f[0] = bf_lo(w.x); f[1] = bf_hi(w.x); f[2] = bf_lo(w.y); f[3] = bf_hi(w.y); f[4] = bf_lo(w.z); f[5] = bf_hi(w.z); f[6] = bf_lo(w.w); f[7] = bf_hi(w.w); }
__device__ __forceinline__ u32x4 pack8(const float (&f)[8]) { u32x4 w; w.x = cvt_pk_bf16(f[0], f[1]); w.y = cvt_pk_bf16(f[2], f[3]); w.z = cvt_pk_bf16(f[4], f[5]); w.w = cvt_pk_bf16(f[6], f[7]); return w; }

constexpr float LOG2E = 1.4426950408889634f;
__device__ __forceinline__ void phase_postproj(const Ctx& C, const float* qg, const float* kg, const float* qag, const float* kvag, const float* mkg) {
    bf16_t* PROJ = (bf16_t*)(C.ws + O_PROJ); const float* cs = (const float*)(C.ws + O_CS); const int lane = C.lane;
    for (int t = C.gw; t < T_; t += C.NGW) { bf16_t* row = PROJ + (size_t)t * 2048;
#pragma unroll
        for (int ps = 0; ps < 2; ++ps) { bf16_t* p = row + ps * 512 + 8 * lane; float f[8]; unpack8(*(const u32x4*)p, f); float ss = 0.f;
#pragma unroll
            for (int i = 0; i < 8; ++i) ss += f[i] * f[i];
            ss += shx<1>(ss); ss += shx<2>(ss); ss += shx<4>(ss);
            const float rs = rsqrtf(ss * (1.f / 64.f) + 1e-6f) * (ps == 0 ? 0.125f * LOG2E : 1.f); const float* g = (ps == 0 ? qg : kg) + 8 * (lane & 7);
#pragma unroll
            for (int i = 0; i < 8; ++i) f[i] = f[i] * rs * g[i];
            *(u32x4*)p = pack8(f); }
        { bf16_t* p = row + 1536 + 8 * lane; float f[8]; unpack8(*(const u32x4*)p, f); float ss = 0.f;
#pragma unroll
            for (int i = 0; i < 8; ++i) ss += f[i] * f[i];
            ss += shx<1>(ss); ss += shx<2>(ss);
            { const float o4 = shx<4>(ss); if (lane < 48) ss += o4; } { const float o8 = shx<8>(ss); if (lane < 48) ss += o8; } { const float o16 = shx<16>(ss); if (lane < 32) ss += o16; }
            const float nrm = lane < 32 ? 256.f : (lane < 48 ? 128.f : 32.f);
            const float rs = rsqrtf(ss / nrm + 1e-6f);
            const float* g = lane < 32 ? (qag + 8 * lane) : (lane < 48 ? (kvag + 8 * (lane - 32)) : (mkg + 64 + 8 * ((lane - 48) & 3)));
#pragma unroll
            for (int i = 0; i < 8; ++i) f[i] = f[i] * rs * g[i];
            float o[8];
#pragma unroll
            for (int i = 0; i < 8; ++i) { const float other = shx<2>(f[i]); const int fi = ((lane & 1) << 3) + i; const float cv = cs[t * 32 + fi], sv = cs[t * 32 + 16 + fi];
                o[i] = (lane & 2) ? (other * sv + f[i] * cv) : (f[i] * cv - other * sv); }
            if (lane >= 48 && lane < 52) {
#pragma unroll
                for (int i = 0; i < 8; ++i) f[i] = o[i]; }
            if (lane < 52) *(u32x4*)p = pack8(f); }
    }
}
__device__ __forceinline__ void phase_postq(const Ctx& C, const float* mqg, const float* mkg) {
    bf16_t* Q2 = (bf16_t*)(C.ws + O_Q2); bf16_t* KV2 = (bf16_t*)(C.ws + O_KV2); const float* cs = (const float*)(C.ws + O_CS); const int lane = C.lane;
    const float qscale = 0.10206207261596575f * LOG2E;
    for (int t = C.gw; t < T_; t += C.NGW) {
        { bf16_t* p = Q2 + (size_t)t * 768 + (lane >> 3) * 96 + 8 * (lane & 7); float f[8]; unpack8(*(const u32x4*)p, f); float ss = 0.f;
#pragma unroll
            for (int i = 0; i < 8; ++i) ss += f[i] * f[i];
            ss += shx<1>(ss); ss += shx<2>(ss); ss += shx<4>(ss);
            const float rs = rsqrtf(ss * (1.f / 64.f) + 1e-6f) * qscale; const float* g = mqg + 8 * (lane & 7);
#pragma unroll
            for (int i = 0; i < 8; ++i) f[i] = f[i] * rs * g[i];
            *(u32x4*)p = pack8(f); }
        { const int l2 = lane & 31; bf16_t* p = Q2 + (size_t)t * 768 + (l2 >> 2) * 96 + 64 + 8 * (l2 & 3); float f[8]; unpack8(*(const u32x4*)p, f); float ss = 0.f;
#pragma unroll
            for (int i = 0; i < 8; ++i) ss += f[i] * f[i];
            ss += shx<1>(ss); ss += shx<2>(ss);
            const float rs = rsqrtf(ss * (1.f / 32.f) + 1e-6f) * qscale; const float* g = mqg + 64 + 8 * (l2 & 3);
#pragma unroll
            for (int i = 0; i < 8; ++i) f[i] = f[i] * rs * g[i];
            float o[8];
#pragma unroll
            for (int i = 0; i < 8; ++i) { const float other = shx<2>(f[i]); const int fi = ((lane & 1) << 3) + i; const float cv = cs[t * 32 + fi], sv = cs[t * 32 + 16 + fi];
                o[i] = (lane & 2) ? (other * sv + f[i] * cv) : (f[i] * cv - other * sv); }
            if (lane < 32) *(u32x4*)p = pack8(o); }
        { bf16_t* p = KV2 + (size_t)t * 1024 + (lane >> 3) * 128 + 8 * (lane & 7); float f[8]; unpack8(*(const u32x4*)p, f); float ss = 0.f;
#pragma unroll
            for (int i = 0; i < 8; ++i) ss += f[i] * f[i];
            ss += shx<1>(ss); ss += shx<2>(ss); ss += shx<4>(ss);
            const float rs = rsqrtf(ss * (1.f / 64.f) + 1e-6f); const float* g = mkg + 8 * (lane & 7);
#pragma unroll
            for (int i = 0; i < 8; ++i) f[i] = f[i] * rs * g[i];
            *(u32x4*)p = pack8(f); }
    }
}
__device__ __forceinline__ void phase_mixcombine(const Ctx& C) {
    const bf16_t* OA = (const bf16_t*)(C.ws + O_OA); const float* LSE = (const float*)(C.ws + O_LSE); bf16_t* ATT = (bf16_t*)(C.ws + O_ATT); const int lane = C.lane;
    for (int t = C.gw; t < T_; t += C.NGW) { const int h = lane >> 3;
        float ls[3], mx = -INFINITY;
#pragma unroll
        for (int p = 0; p < 3; ++p) { ls[p] = LSE[((size_t)p * T_ + t) * 8 + h]; mx = fmaxf(mx, ls[p]); }
        float w[3], den = 0.f;
#pragma unroll
        for (int p = 0; p < 3; ++p) { w[p] = fexp2(ls[p] - mx); den += w[p]; }
        const float inv = 1.f / den; float o[8];
#pragma unroll
        for (int i = 0; i < 8; ++i) o[i] = 0.f;
#pragma unroll
        for (int p = 0; p < 3; ++p) { float f[8]; unpack8(*(const u32x4*)(OA + ((size_t)p * T_ + t) * 512 + 8 * lane), f); const float wp = w[p] * inv;
#pragma unroll
            for (int i = 0; i < 8; ++i) o[i] += wp * f[i]; }
        *(u32x4*)(ATT + (size_t)t * 1024 + 8 * lane) = pack8(o); }
}
__device__ __forceinline__ void phase_rgate(const Ctx& C, int j, const float* cw, const float* cb, const float* ba, const float* bx) {
    const bf16_t* PROJ = (const bf16_t*)(C.ws + O_PROJ); const bf16_t* RG = (const bf16_t*)(C.ws + O_RGATE + (size_t)j * SZ_RGATE); const float* spvg = (const float*)(C.ws + O_SPV) + j * 1024;
    bf16_t* LA = (bf16_t*)(C.ws + O_AA); bf16_t* Bb = (bf16_t*)(C.ws + O_BB); float* SP = (float*)(C.ws + O_SUMP); float* SH = (float*)(C.ws + O_SUMH);
    constexpr int WROW = 272;
    LAS unsigned char* Wl = C.lds;
    LAS unsigned char* Xl = C.lds + 256 * WROW;
    LAS unsigned char* Al = Xl + 64 * WROW;
    LAS unsigned char* Bl = Al + 64 * WROW;
    const int tid = C.tid, lane = C.lane, w = C.wave;
    if (C.G % 8 != 0) return;
    const int n = C.bid & 7, g = C.bid >> 3, ng = C.G >> 3;
    for (int i = tid; i < 256 * 16; i += 512) { const int r = i >> 4, c = i & 15; *(LAS u32x4*)(Wl + r * WROW + 16 * c) = *(const u32x4*)(RG + ((size_t)n * 256 + r) * 128 + 8 * c); }
    const int crow = tid >> 3, cg = tid & 7, cch = n * 128 + 16 * cg;
    float cwv[4][16], cbv[16];
#pragma unroll
    for (int q = 0; q < 4; ++q) { const f32x4 b4 = *(const f32x4*)(cb + cch + 4 * q); cbv[4 * q] = b4[0]; cbv[4 * q + 1] = b4[1]; cbv[4 * q + 2] = b4[2]; cbv[4 * q + 3] = b4[3];
#pragma unroll
        for (int k = 0; k < 4; ++k) { const f32x4 w4 = *(const f32x4*)(cw + k * 1024 + cch + 4 * q); cwv[k][4 * q] = w4[0]; cwv[k][4 * q + 1] = w4[1]; cwv[k][4 * q + 2] = w4[2]; cwv[k][4 * q + 3] = w4[3]; } }
    const int mt = w & 3, h = w >> 2, l15 = lane & 15, kg = lane >> 4;
    float bav[4], bxv[4], spv[4];
#pragma unroll
    for (int jj = 0; jj < 4; ++jj) { const int ch = n * 128 + 16 * (4 * h + jj) + l15; bav[jj] = ba[ch]; bxv[jj] = bx[ch]; spv[jj] = spvg[ch]; }
    __syncthreads();
    for (int c = g; c < 256; c += ng) { const size_t row0 = (size_t)c * 64; const int ts0 = (int)(row0 % S_);
        { float acc[16];
#pragma unroll
          for (int i = 0; i < 16; ++i) acc[i] = cbv[i];
#pragma unroll
          for (int k = 0; k < 4; ++k) { const int dt = k - 3; if (ts0 + crow + dt >= 0) { const bf16_t* src = PROJ + (row0 + crow + dt) * 2048 + 1024 + cch; float f0[8], f1[8]; unpack8(*(const u32x4*)src, f0); unpack8(*(const u32x4*)(src + 8), f1);
#pragma unroll
                  for (int i = 0; i < 8; ++i) { acc[i] += cwv[k][i] * f0[i]; acc[8 + i] += cwv[k][8 + i] * f1[i]; } } }
          float lo[8], hi8[8];
#pragma unroll
          for (int i = 0; i < 8; ++i) { lo[i] = acc[i]; hi8[i] = acc[8 + i]; }
          *(LAS u32x4*)(Xl + crow * WROW + 32 * cg) = pack8(lo); *(LAS u32x4*)(Xl + crow * WROW + 32 * cg + 16) = pack8(hi8); }
        __syncthreads();
        f32x4 acc[8];
#pragma unroll
        for (int t = 0; t < 8; ++t) acc[t] = (f32x4){0.f, 0.f, 0.f, 0.f};
#pragma unroll
        for (int ks = 0; ks < 4; ++ks) { const bf16x8 af = *(const LAS bf16x8*)(Xl + (16 * mt + l15) * WROW + 64 * ks + 16 * kg);
#pragma unroll
            for (int t = 0; t < 8; ++t) { const int nt = (t < 4) ? (4 * h + t) : (8 + 4 * h + (t - 4)); const bf16x8 bfr = *(const LAS bf16x8*)(Wl + (16 * nt + l15) * WROW + 64 * ks + 16 * kg);
                acc[t] = __builtin_amdgcn_mfma_f32_16x16x32_bf16(af, bfr, acc[t], 0, 0, 0); } }
#pragma unroll
        for (int jj = 0; jj < 4; ++jj) { const int e = 16 * (4 * h + jj) + l15;
#pragma unroll
            for (int r = 0; r < 4; ++r) { const int row = 16 * mt + 4 * kg + r; const float xc = bf_lo((unsigned)*(const LAS unsigned short*)(Xl + row * WROW + 2 * e));
                const float rr = fsigmoid(acc[jj][r] + bav[jj]), ig = fsigmoid(acc[4 + jj][r] + bxv[jj]); const float la = rr * spv[jj], av = fexp2(la);
                const float bv = __builtin_amdgcn_sqrtf(fmaxf(1.f - av * av, 0.f)) * ig * xc;
                *(LAS unsigned short*)(Al + row * WROW + 2 * e) = (unsigned short)(cvt_pk_bf16(la, la) & 0xffffu); *(LAS unsigned short*)(Bl + row * WROW + 2 * e) = (unsigned short)(cvt_pk_bf16(bv, bv) & 0xffffu); } }
        __syncthreads();
        { const size_t go = (row0 + crow) * 1024 + cch;
          *(u32x4*)(LA + go) = *(const LAS u32x4*)(Al + crow * WROW + 32 * cg); *(u32x4*)(LA + go + 8) = *(const LAS u32x4*)(Al + crow * WROW + 32 * cg + 16);
          *(u32x4*)(Bb + go) = *(const LAS u32x4*)(Bl + crow * WROW + 32 * cg); *(u32x4*)(Bb + go + 8) = *(const LAS u32x4*)(Bl + crow * WROW + 32 * cg + 16); }
        if (tid < 128) { float Pl = 0.f, Hh = 0.f;
#pragma unroll 8
            for (int r = 0; r < 64; ++r) { const float la = bf_lo((unsigned)*(const LAS unsigned short*)(Al + r * WROW + 2 * tid)), bv = bf_lo((unsigned)*(const LAS unsigned short*)(Bl + r * WROW + 2 * tid)); Hh = fexp2(la) * Hh + bv; Pl += la; }
            const int b = (int)(row0 / S_), ck = (int)((row0 % S_) >> 6); SP[((size_t)b * 64 + ck) * 1024 + n * 128 + tid] = fexp2(Pl); SH[((size_t)b * 64 + ck) * 1024 + n * 128 + tid] = Hh; }
        __syncthreads();
    }
}

__device__ __forceinline__ void scan_sum_item(const Ctx& C, int b, int ck, int cg) {
    const bf16_t* LA = (const bf16_t*)(C.ws + O_AA); const bf16_t* Bb = (const bf16_t*)(C.ws + O_BB); float* SP = (float*)(C.ws + O_SUMP); float* SH = (float*)(C.ws + O_SUMH);
    const int ch = cg * 128 + 2 * C.lane;
    size_t off = ((size_t)b * S_ + ck * 64) * 1024 + ch; f32x2 Pl = (f32x2){0.f, 0.f}, Hh = (f32x2){0.f, 0.f};
#pragma unroll 8
    for (int s = 0; s < 64; ++s, off += 1024) { const unsigned lw = *(const unsigned*)(LA + off), bw = *(const unsigned*)(Bb + off);
        const f32x2 lv = (f32x2){bf_lo(lw), bf_hi(lw)}, av = (f32x2){fexp2(lv[0]), fexp2(lv[1])}, bv = (f32x2){bf_lo(bw), bf_hi(bw)}; Hh = av * Hh + bv; Pl = Pl + lv; }
    *(f32x2*)(SP + ((size_t)b * 64 + ck) * 1024 + ch) = (f32x2){fexp2(Pl[0]), fexp2(Pl[1])}; *(f32x2*)(SH + ((size_t)b * 64 + ck) * 1024 + ch) = Hh;
}
__device__ __forceinline__ void phase_scan_sum_own(const Ctx& C) {
    asm volatile("s_waitcnt vmcnt(0)" ::: "memory"); __syncthreads();
    for (int i = 0; ; ++i) { const int L = i * C.G + C.bid; if (L >= 512) break; const int pm = L >> 3, n = L & 7;
        if (C.wave < 4) { const int row0 = pm * 256 + C.wave * 64; scan_sum_item(C, row0 / S_, (row0 % S_) >> 6, n); } }
}
__device__ __forceinline__ void phase_scan_apply(const Ctx& C) {
    const bf16_t* LA = (const bf16_t*)(C.ws + O_AA); const bf16_t* Bb = (const bf16_t*)(C.ws + O_BB); const float* SP = (const float*)(C.ws + O_SUMP); const float* SH = (const float*)(C.ws + O_SUMH);
    const bf16_t* PROJ = (const bf16_t*)(C.ws + O_PROJ); bf16_t* ATT = (bf16_t*)(C.ws + O_ATT); const int lane = C.lane;
    for (int it = C.gw; it < 4 * 64 * 8; it += C.NGW) { const int cg = it & 7, ck = (it >> 3) & 63, b = it >> 9; const int ch = cg * 128 + 2 * lane;
        f32x2 h = (f32x2){0.f, 0.f};
#pragma unroll 8
        for (int c2 = 0; c2 < ck; ++c2) { const f32x2 pv = *(const f32x2*)(SP + ((size_t)b * 64 + c2) * 1024 + ch), hv = *(const f32x2*)(SH + ((size_t)b * 64 + c2) * 1024 + ch); h = pv * h + hv; }
        size_t row = (size_t)b * S_ + ck * 64;
#pragma unroll 8
        for (int s = 0; s < 64; ++s, ++row) { const unsigned lw = *(const unsigned*)(LA + row * 1024 + ch), bw = *(const unsigned*)(Bb + row * 1024 + ch);
            const f32x2 av = (f32x2){fexp2(bf_lo(lw)), fexp2(bf_hi(lw))}, bv = (f32x2){bf_lo(bw), bf_hi(bw)}; h = av * h + bv;
            const unsigned gw2 = *(const unsigned*)(PROJ + row * 2048 + ch);
            *(unsigned*)(ATT + row * 1024 + ch) = cvt_pk_bf16(bf_lo(gw2) * h[0], bf_hi(gw2) * h[1]); } }
}

__device__ __forceinline__ void split_bf16(const f32x4 a, const f32x4 b, bf16x8& hi, bf16x8& lo) {
    u32x4 h; h.x = cvt_pk_bf16(a[0], a[1]); h.y = cvt_pk_bf16(a[2], a[3]); h.z = cvt_pk_bf16(b[0], b[1]); h.w = cvt_pk_bf16(b[2], b[3]);
    u32x4 l; l.x = cvt_pk_bf16(a[0] - bf_lo(h.x), a[1] - bf_hi(h.x)); l.y = cvt_pk_bf16(a[2] - bf_lo(h.y), a[3] - bf_hi(h.y)); l.z = cvt_pk_bf16(b[0] - bf_lo(h.z), b[1] - bf_hi(h.z)); l.w = cvt_pk_bf16(b[2] - bf_lo(h.w), b[3] - bf_hi(h.w));
    hi = __builtin_bit_cast(bf16x8, h); lo = __builtin_bit_cast(bf16x8, l);
}
__device__ __forceinline__ void phase_router(const Ctx& C, const bf16_t* X, const float* gain, const float* modl, const float* wr, const float* br, int layer) {
    unsigned char* HN8 = C.ws + O_HN; int* topi = (int*)(C.ws + O_TOPI); float* topg = (float*)(C.ws + O_TOPG); int* ecnt = (int*)(C.ws + O_ECNT) + layer * 32; int* inv = (int*)(C.ws + O_INV); int* posj = (int*)(C.ws + O_POSJ);
    LAS int* rk = (LAS int*)(C.lds + LX_MISC + 3072); LAS int* base = (LAS int*)(C.lds + LX_MISC + 512);
    constexpr int HROW = 1028;
    LAS float* hrow = (LAS float*)C.lds;
    LAS float* part = (LAS float*)(C.lds + 16 * HROW * 4);
    LAS int* hl = (LAS int*)(C.lds + LX_MISC);
    const int lane = C.lane, e = lane & 31, kh = lane >> 5, v = C.wave, l15 = lane & 15, kg = lane >> 4;
    bf16x8 whi[2][4], wlo[2][4];
#pragma unroll
    for (int nt = 0; nt < 2; ++nt)
#pragma unroll
        for (int ks = 0; ks < 4; ++ks) { const float* p = wr + (size_t)(128 * v + 32 * ks + 8 * kg) * 32 + 16 * nt + l15;
            const f32x4 a = (f32x4){p[0], p[32], p[64], p[96]}, b = (f32x4){p[128], p[160], p[192], p[224]}; split_bf16(a, b, whi[nt][ks], wlo[nt][ks]); }
    const float bias_e = br[e];
    if (C.tid < 32) hl[C.tid] = 0;
    __syncthreads();
    for (int ck = C.bid; ck < 256; ck += C.G) {
        const int b = (ck * 64) / S_;
        f32x4 gn[4], shv[4];
#pragma unroll
        for (int j = 0; j < 4; ++j) { const int col = 256 * j + 4 * lane; gn[j] = *(const f32x4*)(gain + col) * (1.f + *(const f32x4*)(modl + b * 6144 + 4096 + col)); shv[j] = *(const f32x4*)(modl + b * 6144 + 3072 + col); }
        u32x2 xr[2][4];
#pragma unroll
        for (int q = 0; q < 2; ++q)
#pragma unroll
            for (int j = 0; j < 4; ++j) xr[q][j] = *(const u32x2*)(X + (size_t)(ck * 64 + 2 * v + q) * 1024 + 256 * j + 4 * lane);
#pragma unroll 1
        for (int pass = 0; pass < 4; ++pass) { const int tb = ck * 64 + pass * 16;
#pragma unroll
            for (int q = 0; q < 2; ++q) { const int tt = 2 * v + q, t = tb + tt; f32x4 h[4]; float ss = 0.f;
#pragma unroll
                for (int j = 0; j < 4; ++j) { const u32x2 xw = xr[q][j]; h[j] = (f32x4){bf_lo(xw.x), bf_hi(xw.x), bf_lo(xw.y), bf_hi(xw.y)}; ss += (h[j][0] * h[j][0] + h[j][1] * h[j][1]) + (h[j][2] * h[j][2] + h[j][3] * h[j][3]); }
                const float rs = rsqrtf(wsum(ss) * (1.f / 1024.f) + 1e-6f);
#pragma unroll
                for (int j = 0; j < 4; ++j) { const int col = 256 * j + 4 * lane;
                    const f32x4 hv = h[j] * rs * gn[j] + shv[j];
                    *(unsigned*)(HN8 + (size_t)t * 1024 + col) = pk4_fp8(hv[0], hv[1], hv[2], hv[3]);
                    *(LAS f32x4*)(hrow + tt * HROW + col) = hv; } }
            if (pass < 3) {
#pragma unroll
                for (int q = 0; q < 2; ++q)
#pragma unroll
                    for (int j = 0; j < 4; ++j) xr[q][j] = *(const u32x2*)(X + (size_t)(tb + 16 + 2 * v + q) * 1024 + 256 * j + 4 * lane); }
            __syncthreads();
            { f32x4 acc0 = (f32x4){0.f, 0.f, 0.f, 0.f}, acc1 = acc0;
#pragma unroll
              for (int ks = 0; ks < 4; ++ks) { const LAS float* hp = hrow + l15 * HROW + 128 * v + 32 * ks + 8 * kg; bf16x8 ahi, alo; split_bf16(*(const LAS f32x4*)hp, *(const LAS f32x4*)(hp + 4), ahi, alo);
                  acc0 = __builtin_amdgcn_mfma_f32_16x16x32_bf16(ahi, whi[0][ks], acc0, 0, 0, 0); acc1 = __builtin_amdgcn_mfma_f32_16x16x32_bf16(ahi, whi[1][ks], acc1, 0, 0, 0);
                  acc0 = __builtin_amdgcn_mfma_f32_16x16x32_bf16(ahi, wlo[0][ks], acc0, 0, 0, 0); acc1 = __builtin_amdgcn_mfma_f32_16x16x32_bf16(ahi, wlo[1][ks], acc1, 0, 0, 0);
                  acc0 = __builtin_amdgcn_mfma_f32_16x16x32_bf16(alo, whi[0][ks], acc0, 0, 0, 0); acc1 = __builtin_amdgcn_mfma_f32_16x16x32_bf16(alo, whi[1][ks], acc1, 0, 0, 0); }
#pragma unroll
              for (int r = 0; r < 4; ++r) { part[((4 * kg + r) * 8 + v) * 32 + l15] = acc0[r]; part[((4 * kg + r) * 8 + v) * 32 + 16 + l15] = acc1[r]; } }
            __syncthreads();
            { const int tt = 2 * v + kh; float lg = bias_e;
#pragma unroll
              for (int w8 = 0; w8 < 8; ++w8) lg += part[(tt * 8 + w8) * 32 + e];
              int idx[4]; float val[4];
#pragma unroll
              for (int k = 0; k < 4; ++k) { float mx = lg;
                  mx = fmaxf(mx, shx<1>(mx)); mx = fmaxf(mx, shx<2>(mx)); mx = fmaxf(mx, shx<4>(mx)); mx = fmaxf(mx, shx<8>(mx)); mx = fmaxf(mx, shx<16>(mx));
                  const unsigned long long bal = __ballot(lg == mx); const unsigned bh = (unsigned)(bal >> (32 * kh)); const int sel = __ffs((int)bh) - 1;
                  idx[k] = sel; val[k] = mx; if (e == sel) lg = -INFINITY; }
              if (e == 0) { const int t = tb + tt; float ex[4], den = 0.f;
#pragma unroll
                  for (int k = 0; k < 4; ++k) { ex[k] = expf(val[k] - val[0]); den += ex[k]; }
#pragma unroll
                  for (int k = 0; k < 4; ++k) { topi[t * 4 + k] = idx[k]; topg[t * 4 + k] = ex[k] / den; const int r = __hip_atomic_fetch_add(hl + idx[k], 1, __ATOMIC_RELAXED, __HIP_MEMORY_SCOPE_WORKGROUP); rk[(pass * 16 + tt) * 4 + k] = (idx[k] << 8) | r; } } }
        }
        __syncthreads();
        if (C.tid < 32) { base[C.tid] = __hip_atomic_fetch_add(ecnt + C.tid, hl[C.tid], __ATOMIC_RELAXED, __HIP_MEMORY_SCOPE_AGENT); hl[C.tid] = 0; }
        __syncthreads();
        if (C.tid < 256) { const int pk = rk[C.tid], ex = pk >> 8, j = base[ex] + (pk & 255); inv[ex * 16384 + j] = ck * 64 + (C.tid >> 2); posj[ck * 256 + C.tid] = j; }
        __syncthreads();
    }
}
__device__ __forceinline__ void moe_plan_lds(const Ctx& C, int layer) {
    const int* ecnt = (const int*)(C.ws + O_ECNT) + layer * 32;
    LAS int* tot = (LAS int*)(C.lds + LX_MISC + 256); LAS int* pst = tot + 32; LAS int* tile_e = (LAS int*)(C.lds + LX_TILE); LAS int* ntp = (LAS int*)(C.lds + LX_MISC + 128);
    __syncthreads();
    if (C.tid < 32) tot[C.tid] = __hip_atomic_load(ecnt + C.tid, __ATOMIC_RELAXED, __HIP_MEMORY_SCOPE_AGENT);
    __syncthreads();
    if (C.tid == 0) { int acc = 0; for (int e = 0; e < 32; ++e) { pst[e] = acc; acc += (tot[e] + 255) & ~255; } ntp[0] = acc >> 8; }
    __syncthreads();
    { const int nt = ntp[0]; for (int ti = C.tid; ti < nt; ti += 512) { int e = 0;
#pragma unroll 1
        for (int x = 1; x < 32; ++x) e += (pst[x] <= ti * 256) ? 1 : 0;
        tile_e[ti] = e; } }
    __syncthreads();
}
#ifndef ATT_DUP
#define ATT_DUP 1
#endif

__device__ __forceinline__ s16x4 tr16(LAS const unsigned char* p) { typedef short v4i16_t __attribute__((ext_vector_type(4))); return __builtin_bit_cast(s16x4, __builtin_amdgcn_ds_read_tr16_b64_v4i16((LAS v4i16_t*)p)); }

__device__ __forceinline__ float max3f(float a, float b, float c) { return fmaxf(fmaxf(a, b), c); }
#ifndef ATT_THR_V
#define ATT_THR_V 10.f
#endif
constexpr float ATT_THR = ATT_THR_V;
template <int KS, bool DIL>
__device__ __forceinline__ void att_tile(LAS const unsigned char* kb, LAS const unsigned char* vb, const bf16x8 (&qf)[KS], f32x16& o0, f32x16& o1, f32x16& negm, float& mref, float& l, int kidx0, int qidx, bool need_mask, int lane) {
    constexpr int KROW = KS * 32 + 16, VROW = 144;
    const int i32 = lane & 31, hi = lane >> 5;
    const int pr = (i32 & 0x13) | ((i32 & 4) << 1) | ((i32 & 8) >> 1);
    f32x16 p0, p1;
    LAS const unsigned char* kp = kb + pr * KROW + hi * 16;
#ifndef QK_DUP
#define QK_DUP 1
#endif
#pragma unroll 1
    for (int qd_ = 0; qd_ < QK_DUP; ++qd_) {
#pragma unroll
    for (int ks = 0; ks < KS; ++ks) {
        const bf16x8 k0f = *(LAS const bf16x8*)(kp + ks * 32), k1f = *(LAS const bf16x8*)(kp + 32 * KROW + ks * 32);
        if (ks == 0) { p0 = __builtin_amdgcn_mfma_f32_32x32x16_bf16(k0f, qf[0], negm, 0, 0, 0); p1 = __builtin_amdgcn_mfma_f32_32x32x16_bf16(k1f, qf[0], negm, 0, 0, 0); }
        else { p0 = __builtin_amdgcn_mfma_f32_32x32x16_bf16(k0f, qf[ks], p0, 0, 0, 0); p1 = __builtin_amdgcn_mfma_f32_32x32x16_bf16(k1f, qf[ks], p1, 0, 0, 0); }
    }
    asm volatile("" : "+v"(p0), "+v"(p1));
    }
    if (need_mask) {
#pragma unroll
        for (int r = 0; r < 16; ++r) { const int d0 = qidx - (kidx0 + 16 * (r >> 3) + 8 * hi + (r & 7)), d1 = d0 - 32;
            const bool v0 = DIL ? (d0 >= 0 && d0 <= 128) : (d0 >= 0), v1 = DIL ? (d1 >= 0 && d1 <= 128) : (d1 >= 0);
            p0[r] = v0 ? p0[r] : -INFINITY; p1[r] = v1 ? p1[r] : -INFINITY; } }
    float mx = max3f(p0[0], p0[1], p1[0]), mb = max3f(p0[2], p0[3], p1[1]); mx = max3f(mx, p1[2], p1[3]);
#pragma unroll
    for (int r = 4; r < 16; r += 4) { mx = max3f(mx, p0[r], p0[r + 1]); mb = max3f(mb, p0[r + 2], p0[r + 3]); mx = max3f(mx, p1[r], p1[r + 1]); mb = max3f(mb, p1[r + 2], p1[r + 3]); }
    mx = xmax32(fmaxf(mx, mb));
    if (__builtin_expect(__any(mx > ATT_THR), 0)) {
        const float dl = fmaxf(mx, 0.f), f = fexp2(-dl);
        mref += dl; l *= f;
#pragma unroll
        for (int r = 0; r < 16; ++r) { o0[r] *= f; o1[r] *= f; p0[r] -= dl; p1[r] -= dl; negm[r] = -mref; } }
    float ls0 = 0.f, ls1 = 0.f;
#pragma unroll
    for (int r = 0; r < 16; ++r) { p0[r] = fexp2(p0[r]); p1[r] = fexp2(p1[r]); ls0 += p0[r]; ls1 += p1[r]; }
    l += ls0 + ls1;
    u32x4 pw[2][2];
#pragma unroll
    for (int s = 0; s < 2; ++s) {
        pw[0][s].x = cvt_pk_bf16(p0[8 * s + 0], p0[8 * s + 1]); pw[0][s].y = cvt_pk_bf16(p0[8 * s + 2], p0[8 * s + 3]); pw[0][s].z = cvt_pk_bf16(p0[8 * s + 4], p0[8 * s + 5]); pw[0][s].w = cvt_pk_bf16(p0[8 * s + 6], p0[8 * s + 7]);
        pw[1][s].x = cvt_pk_bf16(p1[8 * s + 0], p1[8 * s + 1]); pw[1][s].y = cvt_pk_bf16(p1[8 * s + 2], p1[8 * s + 3]); pw[1][s].z = cvt_pk_bf16(p1[8 * s + 4], p1[8 * s + 5]); pw[1][s].w = cvt_pk_bf16(p1[8 * s + 6], p1[8 * s + 7]); }
    const int g = lane >> 4, i16 = lane & 15;
    LAS const unsigned char* vp = vb + (8 * (g >> 1) + (i16 >> 2)) * VROW + (16 * (g & 1) + 4 * (i16 & 3)) * 2;
#pragma unroll
    for (int sub = 0; sub < 2; ++sub)
#pragma unroll
        for (int s = 0; s < 2; ++s) { const bf16x8 pf = __builtin_bit_cast(bf16x8, pw[sub][s]);
#pragma unroll
            for (int db = 0; db < 2; ++db) { LAS const unsigned char* av = vp + (32 * sub + 16 * s) * VROW + 64 * db;
                const s16x4 lo = tr16(av), hh = tr16(av + 4 * VROW);
                const bf16x8 vf = (bf16x8){lo[0], lo[1], lo[2], lo[3], hh[0], hh[1], hh[2], hh[3]};
                if (db == 0) o0 = __builtin_amdgcn_mfma_f32_32x32x16_bf16(vf, pf, o0, 0, 0, 0); else o1 = __builtin_amdgcn_mfma_f32_32x32x16_bf16(vf, pf, o1, 0, 0, 0); } }
}
__device__ __forceinline__ void att_store(bf16_t* orow  , const f32x16& o0, const f32x16& o1, float inv, int hi) {
#pragma unroll
    for (int rr = 0; rr < 4; ++rr) { u32x2 w0, w1;
        w0.x = cvt_pk_bf16(o0[4 * rr] * inv, o0[4 * rr + 1] * inv); w0.y = cvt_pk_bf16(o0[4 * rr + 2] * inv, o0[4 * rr + 3] * inv);
        w1.x = cvt_pk_bf16(o1[4 * rr] * inv, o1[4 * rr + 1] * inv); w1.y = cvt_pk_bf16(o1[4 * rr + 2] * inv, o1[4 * rr + 3] * inv);
        *(u32x2*)(orow + 8 * rr + 4 * hi) = w0; *(u32x2*)(orow + 32 + 8 * rr + 4 * hi) = w1; }
}


struct BgConv {
    const float* w1; const float* w2; unsigned char* ws; LAS unsigned char* T;
    int pair, it, nit, step, sub;
    bool pendA, pendB; int psubA, psubB; unsigned char* pWTA; unsigned char* pWTB;
    f32x4 vA[4], vB[4];
};
__device__ __forceinline__ void bg_tile(const BgConv& S, int it, const float*& W, int& N, unsigned char*& WT, int& n0, int& k0) {
    constexpr int I1 = 32 * 8, I2 = 16 * 8, N1 = 64 * I1;
    if (it < N1) { const int mat = S.pair * 64 + it / I1, q = it % I1; W = S.w1 + (size_t)mat * 1024 * 2048; WT = S.ws + O_W1 + (size_t)mat * SZ_W1E; N = 2048; n0 = (q >> 3) * 64; k0 = (q & 7) * 128; }
    else { const int r = it - N1, mat = S.pair * 64 + r / I2, q = r % I2; W = S.w2 + (size_t)mat * 1024 * 1024; WT = S.ws + O_W2 + (size_t)mat * SZ_W2E; N = 1024; n0 = (q >> 3) * 64; k0 = (q & 7) * 128; }
}
__device__ __forceinline__ void bg_init(BgConv& S, const Ctx& C, const float* w1, const float* w2, int pair) {
    S.w1 = w1; S.w2 = w2; S.ws = C.ws; S.T = C.lds + 49152 + C.wave * 9216; S.pair = pair; S.it = C.gw; S.nit = 64 * 256 + 64 * 128; S.step = C.NGW; S.sub = 0;
    S.pendA = false; S.pendB = false; S.psubA = 0; S.psubB = 0; S.pWTA = C.ws; S.pWTB = C.ws;
}
__device__ __forceinline__ bool bg_done(const BgConv& S) { return !S.pendA && !S.pendB && S.it >= S.nit; }
__device__ __forceinline__ void bg_half(BgConv& S, f32x4 (&v)[4], bool& pend, int& psub, unsigned char*& pWT, int lane) {
    const int kq = lane >> 4, c4 = lane & 15;
    if (pend) {
#pragma unroll
        for (int jj = 0; jj < 4; ++jj) *(LAS unsigned*)(S.T + (4 * c4 + jj) * 144 + 32 * kq + 4 * psub) = pk4_fp8(32.f * v[0][jj], 32.f * v[1][jj], 32.f * v[2][jj], 32.f * v[3][jj]);
        if (psub == 7) {
            asm volatile("s_waitcnt lgkmcnt(0)" ::: "memory");
#pragma unroll
            for (int s8 = 0; s8 < 8; ++s8) { const int n = 8 * s8 + (lane >> 3), ch = lane & 7; const u32x4 w = *(const LAS u32x4*)(S.T + n * 144 + 16 * ch);
                *(u32x4*)(pWT + (size_t)n * 1024 + 16 * ch) = w; }
            asm volatile("s_waitcnt lgkmcnt(0)" ::: "memory"); }
        pend = false; }
    if (S.it < S.nit) { const float* W; int N, n0, k0; unsigned char* WT; bg_tile(S, S.it, W, N, WT, n0, k0);
        const float* p = W + (size_t)(k0 + 32 * kq + 4 * S.sub) * N + n0 + 4 * c4;
#pragma unroll
        for (int i = 0; i < 4; ++i) v[i] = __builtin_nontemporal_load((const f32x4*)(p + (size_t)i * N));
        pend = true; psub = S.sub; pWT = WT + (size_t)n0 * 1024 + k0;
        if (++S.sub == 8) { S.sub = 0; S.it += S.step; } }
}
#define BG_STEP_A() bg_half(BG, BG.vA, BG.pendA, BG.psubA, BG.pWTA, lane)
#define BG_STEP_B() bg_half(BG, BG.vB, BG.pendB, BG.psubB, BG.pWTB, lane)

__device__ __forceinline__ void mla_unit(const Ctx& C, BgConv& BG, int b, int h, int qb) {
    constexpr int KROW = 208, VROW = 144, KB = 64 * KROW, BUF = KB + 64 * VROW;
    const bf16_t* Q2 = (const bf16_t*)(C.ws + O_Q2); const bf16_t* KV2 = (const bf16_t*)(C.ws + O_KV2); const bf16_t* PROJ = (const bf16_t*)(C.ws + O_PROJ); bf16_t* ATT = (bf16_t*)(C.ws + O_ATT);
    const int tid = C.tid, lane = C.lane, w = C.wave, i32 = lane & 31, hi = lane >> 5;
    const int q0 = qb * 256; const size_t rowb = (size_t)b * S_;
    bf16x8 qf[6];
    { const bf16_t* qrow = Q2 + (rowb + q0 + 32 * w + i32) * 768 + 8 * hi;
#pragma unroll
      for (int ks = 0; ks < 4; ++ks) qf[ks] = *(const bf16x8*)(qrow + h * 64 + 16 * ks);
      qf[4] = *(const bf16x8*)(qrow + 512 + h * 32); qf[5] = *(const bf16x8*)(qrow + 512 + h * 32 + 16); }
    f32x16 o0, o1;
#pragma unroll
    for (int r = 0; r < 16; ++r) { o0[r] = 0.f; o1[r] = 0.f; }
    float m = 0.f, l = 0.f; f32x16 negm;
#pragma unroll
    for (int r = 0; r < 16; ++r) negm[r] = 0.f;
    const int NT = 4 * qb + 4, wmax = 4 * qb + (w >> 1);
    const int r8 = tid >> 3, c8 = tid & 7, r4 = (tid & 255) >> 2, c4 = tid & 3;
    const bf16_t* knp = KV2 + (rowb + r8) * 1024 + h * 64 + 8 * c8; const bf16_t* kpp = PROJ + (rowb + r4) * 2048 + 1920 + 8 * c4;
    u32x4 kA, vA, pA, kB, vB, pB;
#define MLA_LOAD(j, K, V, P) do { const int jc_ = ((j) < NT) ? (j) : NT - 1; K = *(const u32x4*)(knp + (size_t)jc_ * 64 * 1024); V = *(const u32x4*)(knp + (size_t)jc_ * 64 * 1024 + 512); P = *(const u32x4*)(kpp + (size_t)jc_ * 64 * 2048); } while (0)
#define MLA_WRITE(bo, K, V, P) do { *(LAS u32x4*)(C.lds + (bo) + r8 * KROW + 16 * c8) = K; *(LAS u32x4*)(C.lds + (bo) + KB + r8 * VROW + 16 * c8) = V; *(LAS u32x4*)(C.lds + (bo) + r4 * KROW + 128 + 16 * c4) = P; } while (0)
#define MLA_STEP(j, KF, VF, PF, KN, VN, PN, BGS) do { const int j_ = (j); const int bo_ = (j_ & 1) * BUF; \
        MLA_LOAD(j_ + 2, KF, VF, PF); BGS(); \
        if (j_ <= wmax) { _Pragma("unroll 1") for (int dup_ = 0; dup_ < ATT_DUP; ++dup_) att_tile<6, false>(C.lds + bo_, C.lds + bo_ + KB, qf, o0, o1, negm, m, l, 64 * j_, q0 + 32 * w + i32, j_ == wmax, lane); } \
        MLA_WRITE(BUF - bo_, KN, VN, PN); \
        __syncthreads(); } while (0)
    MLA_LOAD(0, kA, vA, pA); MLA_LOAD(1, kB, vB, pB);
    MLA_WRITE(0, kA, vA, pA);
    __syncthreads();
#pragma unroll 1
    for (int j = 0; j < NT; j += 2) { MLA_STEP(j, kA, vA, pA, kB, vB, pB, BG_STEP_A); MLA_STEP(j + 1, kB, vB, pB, kA, vA, pA, BG_STEP_B); }
#undef MLA_STEP
#undef MLA_LOAD
#undef MLA_WRITE
    l = xadd32(l);
    att_store(ATT + (rowb + q0 + 32 * w + i32) * 1024 + 512 + h * 64, o0, o1, 1.f / l, hi);
}
__device__ __forceinline__ void dil_unit(const Ctx& C, BgConv& BG, int p, int dd, int b, int h, int res, int n) {
    constexpr int KROW = 144, VROW = 144, KB = 64 * KROW, BUF = KB + 64 * VROW;
    const bf16_t* PROJ = (const bf16_t*)(C.ws + O_PROJ); bf16_t* OA = (bf16_t*)(C.ws + O_OA) + (size_t)p * T_ * 512; float* LSE = (float*)(C.ws + O_LSE) + (size_t)p * T_ * 8;
    const int tid = C.tid, lane = C.lane, w = C.wave, i32 = lane & 31, hi = lane >> 5;
    const size_t rowb = (size_t)b * S_;
    const int qsub = 256 * n + 32 * w + i32; const size_t qtok = rowb + (size_t)qsub * dd + res;
    bf16x8 qf[4];
    { const bf16_t* qrow = PROJ + qtok * 2048 + h * 64 + 8 * hi;
#pragma unroll
      for (int ks = 0; ks < 4; ++ks) qf[ks] = *(const bf16x8*)(qrow + 16 * ks); }
    f32x16 o0, o1;
#pragma unroll
    for (int r = 0; r < 16; ++r) { o0[r] = 0.f; o1[r] = 0.f; }
    float m = 0.f, l = 0.f; f32x16 negm;
#pragma unroll
    for (int r = 0; r < 16; ++r) negm[r] = 0.f;
    const int jbeg = (n == 0) ? 2 : 0, wlo = w >> 1, whi = (32 * w + 159) >> 6;
    const int r8 = tid >> 3, c8 = tid & 7;
    u32x4 kA, vA, kB, vB;
    const int cnt = 6 - jbeg;
#define DIL_LOAD(i, K, V) do { const int jc_ = jbeg + (((i) < cnt) ? (i) : cnt - 1); const size_t tok = rowb + (size_t)(256 * n - 128 + 64 * jc_ + r8) * dd + res; const bf16_t* src = PROJ + tok * 2048 + 512 + h * 64 + 8 * c8; K = *(const u32x4*)src; V = *(const u32x4*)(src + 512); } while (0)
#define DIL_WRITE(bo, K, V) do { *(LAS u32x4*)(C.lds + (bo) + r8 * KROW + 16 * c8) = K; *(LAS u32x4*)(C.lds + (bo) + KB + r8 * VROW + 16 * c8) = V; } while (0)
#define DIL_STEP(i, KF, VF, KN, VN, BGS) do { const int i_ = (i); const int bo_ = (i_ & 1) * BUF, j_ = jbeg + i_; \
        DIL_LOAD(i_ + 2, KF, VF); BGS(); \
        if (i_ < cnt && j_ >= wlo && j_ <= whi) { const int kb0_ = 256 * n - 128 + 64 * j_, qlo_ = 256 * n + 32 * w; _Pragma("unroll 1") for (int dup_ = 0; dup_ < ATT_DUP; ++dup_) att_tile<4, true>(C.lds + bo_, C.lds + bo_ + KB, qf, o0, o1, negm, m, l, kb0_, qsub, !(kb0_ + 63 <= qlo_ && qlo_ + 31 - kb0_ <= 128), lane); } \
        DIL_WRITE(BUF - bo_, KN, VN); \
        __syncthreads(); } while (0)
    DIL_LOAD(0, kA, vA); DIL_LOAD(1, kB, vB);
    DIL_WRITE(0, kA, vA);
    __syncthreads();
    DIL_STEP(0, kA, vA, kB, vB, BG_STEP_A); DIL_STEP(1, kB, vB, kA, vA, BG_STEP_B); DIL_STEP(2, kA, vA, kB, vB, BG_STEP_A); DIL_STEP(3, kB, vB, kA, vA, BG_STEP_B);
    if (cnt == 6) { DIL_STEP(4, kA, vA, kB, vB, BG_STEP_A); DIL_STEP(5, kB, vB, kA, vA, BG_STEP_B); }
#undef DIL_STEP
#undef DIL_LOAD
#undef DIL_WRITE
    l = xadd32(l);
    att_store(OA + qtok * 512 + h * 64, o0, o1, 1.f / l, hi);
    if (hi == 0) LSE[qtok * 8 + h] = m + log2f(l);
}
#ifndef REP_MLA
#define REP_MLA 1
#endif
#ifndef REP_DIL
#define REP_DIL 1
#endif
__device__ __forceinline__ void phase_attention(const Ctx& C, const float* w1, const float* w2, int pair) {
    BgConv BG; bg_init(BG, C, w1, w2, pair);
#pragma unroll 1
    for (int rep = 0; rep < REP_MLA; ++rep) {
    if (C.G == 256) { const int bh = C.vcu >> 3, s = C.vcu & 7; mla_unit(C, BG, bh >> 3, bh & 7, s); mla_unit(C, BG, bh >> 3, bh & 7, 15 - s); }
    else for (int u = C.bid; u < 512; u += C.G) mla_unit(C, BG, u >> 7, (u >> 4) & 7, u & 15);
    }
#pragma unroll 1
    for (int rep = 0; rep < REP_DIL; ++rep)
    for (int u = C.bid; u < 1536; u += C.G) { const int p = u >> 9, rem = u & 511, b = rem >> 7, h = (rem >> 4) & 7, blk = rem & 15;
        const int dd = (p == 0) ? 1 : (p == 1) ? 4 : 16, bpr = 16 / dd;
        dil_unit(C, BG, p, dd, b, h, blk / bpr, blk % bpr); }
    { const int lane = C.lane;
#pragma unroll 1
      while (!bg_done(BG)) { BG_STEP_A(); BG_STEP_B(); } }
}
#undef BG_STEP_A
#undef BG_STEP_B

#ifdef TIME_NORM
constexpr int N_PHASES = 42;
#else
constexpr int N_PHASES = 36;
#endif
extern __shared__ __attribute__((aligned(16))) unsigned char lds_raw[];
typedef const __attribute__((address_space(4))) Args* ArgsP;
#define PHFN static __device__ __forceinline__ void
__device__ __forceinline__ ArgsP fresh_args() { unsigned long long p = (unsigned long long)__builtin_amdgcn_kernarg_segment_ptr(); asm volatile("" : "+s"(p)); return (ArgsP)p; }
__device__ __forceinline__ Ctx make_ctx(ArgsP ap, int wv) {
    Ctx C; C.lds = (LAS unsigned char*)lds_raw; C.ws = ap->ws;
    unsigned ones = ~0u; asm volatile("" : "+s"(ones)); const int lane = (int)__builtin_amdgcn_mbcnt_hi(ones, __builtin_amdgcn_mbcnt_lo(ones, 0u));
    int bid = blockIdx.x; asm volatile("" : "+s"(bid)); int G = gridDim.x; asm volatile("" : "+s"(G));
    C.wave = wv; C.lane = lane; C.tid = wv * 64 + lane;
    C.G = G; C.bid = bid; C.vcu = (C.G % 8 == 0) ? (C.bid % 8) * (C.G / 8) + C.bid / 8 : C.bid;
    C.gw = C.bid * 8 + C.wave; C.NGW = C.G * 8; return C;
}
#define IN(i) ((const float*)ap->in[i])
#define MODL(l) ((const float*)(C.ws + O_MOD) + (size_t)(l) * 4 * 6144)
PHFN ph_prologue(int wv) { const ArgsP ap = fresh_args(); const Ctx C = make_ctx(ap, wv); p0_prologue(C, ap); }
PHFN ph_norm(int wv, int l, int mode) { const ArgsP ap = fresh_args(); const Ctx C = make_ctx(ap, wv);
    if (mode == 0) phase_norm(C, IN(0), nullptr, false, true, IN(5), MODL(0), MODL(0), 0, 1024);
    else if (mode == 1) phase_norm(C, nullptr, nullptr, true, true, IN(5) + l * 1024, MODL(l - 1), MODL(l), 0, 1024);
    else if (mode == 3) phase_norm(C, nullptr, nullptr, true, true, IN(5) + l * 1024, MODL(l - 1), MODL(l), 0, 1024, true);
    else phase_norm(C, nullptr, ap->out, true, false, IN(5), MODL(3), MODL(3), 0, 1024); }
PHFN ph_proj(int wv, int j) { const ArgsP ap = fresh_args(); const Ctx C = make_ctx(ap, wv); unsigned char* ws = C.ws;
    DenseOrder S; S.init(ws + O_HN, ws + O_WIN + j * SZ_WIN, 1024, 1024, T_, 2048, C.G, C.bid); EpiNorm<0> E{(bf16_t*)(ws + O_PROJ), 2048, IN(8) + j * 64, IN(9) + j * 64, IN(10) + j * 256, IN(11) + j * 128, IN(15) + j * 96 + 64, (const float*)(ws + O_CS), (LAS float*)(C.lds + LX_EXCH)}; gemm_phase(C, GemmDims{1024, 1024, 1024}, S, E); }
PHFN ph_postproj(int wv, int j) { const ArgsP ap = fresh_args(); const Ctx C = make_ctx(ap, wv); phase_postproj(C, IN(8) + j * 64, IN(9) + j * 64, IN(10) + j * 256, IN(11) + j * 128, IN(15) + j * 96); }
PHFN ph_qkv(int wv, int j) { const ArgsP ap = fresh_args(); const Ctx C = make_ctx(ap, wv); unsigned char* ws = C.ws;
    { DenseOrder S; S.init(ws + O_PROJ + 1536 * 2, ws + O_WUQ + j * SZ_WUQ, 2048, 256, T_, 768, C.G, C.bid); EpiNorm<1> E{(bf16_t*)(ws + O_Q2), 768, IN(14) + j * 96, IN(14) + j * 96 + 64, nullptr, nullptr, nullptr, (const float*)(ws + O_CS), (LAS float*)(C.lds + LX_EXCH)}; gemm_phase(C, GemmDims{256, 2048, 256}, S, E); }
    { const ArgsP ap2 = fresh_args(); const Ctx C = make_ctx(ap2, wv); unsigned char* ws = C.ws; DenseOrder S; S.init(ws + O_PROJ + 1792 * 2, ws + O_WUKV + j * SZ_WUKV, 2048, 128, T_, 1024, C.G, C.bid); EpiNorm<2> E{(bf16_t*)(ws + O_KV2), 1024, IN(15) + j * 96, nullptr, nullptr, nullptr, nullptr, (const float*)(ws + O_CS), (LAS float*)(C.lds + LX_EXCH)}; gemm_phase(C, GemmDims{128, 2048, 128}, S, E); } }
PHFN ph_postq(int wv, int j) { const ArgsP ap = fresh_args(); const Ctx C = make_ctx(ap, wv); phase_postq(C, IN(14) + j * 96, IN(15) + j * 96); }
PHFN ph_attention(int wv, int pair) { const ArgsP ap = fresh_args(); const Ctx C = make_ctx(ap, wv); phase_attention(C, IN(30), IN(32), pair); }
PHFN ph_mixcombine(int wv) { const ArgsP ap = fresh_args(); const Ctx C = make_ctx(ap, wv); phase_mixcombine(C); }
PHFN ph_outproj(int wv, int l, int which) { const ArgsP ap = fresh_args(); const Ctx C = make_ctx(ap, wv); unsigned char* ws = C.ws; const int j = l >> 1;
    DenseOrder S; S.init(ws + O_ATT, ws + (which ? O_RWOUT + j * SZ_RWOUT : O_WOUT + j * SZ_WOUT), 1024, 1024, T_, 1024, C.G, C.bid);
    EpiResid E{(bf16_t*)(ws + O_X), MODL(l) + 2048, which ? IN(27) + j * 1024 : nullptr}; gemm_phase(C, GemmDims{1024, 1024, 1024}, S, E); }
PHFN ph_router(int wv, int l) { const ArgsP ap = fresh_args(); const Ctx C = make_ctx(ap, wv); phase_router(C, (const bf16_t*)(C.ws + O_X), IN(6) + l * 1024, MODL(l), IN(28) + (size_t)l * 1024 * 32, IN(29) + l * 32, l); }
PHFN ph_moe1(int wv, int l) { const ArgsP ap = fresh_args(); const Ctx C = make_ctx(ap, wv); unsigned char* ws = C.ws; moe_plan_lds(C, l);
    MoeOrderT<true> S; S.A = (const char*)(ws + O_HN); S.WT = (const char*)(ws + O_W1 + (size_t)l * 32 * SZ_W1E); S.estride = SZ_W1E; S.tile_e = (const LAS int*)(C.lds + LX_TILE);
    S.NT = *(const LAS int*)(C.lds + LX_MISC + 128); S.nN = 8; S.G = C.G; S.c = C.bid; S.esz = 1; S.gtab = (const LAS int*)(C.lds + LX_GTAB);
    { const int* inv = (const int*)(ws + O_INV); LAS int* gt = (LAS int*)(C.lds + LX_GTAB); const LAS int* tot = (const LAS int*)(C.lds + LX_MISC + 256); const LAS int* pst = tot + 32;
#pragma unroll 1
      for (int i = 0; i < GTAB_UNITS; ++i) { Unit u; if (!S.next(i, u)) break;
          if (C.tid < 256) { const int j = u.row0 - pst[u.e] + C.tid; gt[i * 256 + C.tid] = (j < tot[u.e]) ? inv[u.e * 16384 + j] : 0; } }
      { const int* topi = (const int*)(ws + O_TOPI); const int* posj = (const int*)(ws + O_POSJ); int* pos = (int*)(ws + O_POS);
        for (int ck = C.bid; ck < 256; ck += C.G) if (C.tid < 256) pos[ck * 256 + C.tid] = pst[topi[ck * 256 + C.tid]] + posj[ck * 256 + C.tid]; }
      __syncthreads(); }
    EpiSwiglu E{(unsigned char*)(ws + O_ACT), IN(31) + (size_t)l * 32 * 2048, 1.f / 32.f}; gemm_phase<true>(C, GemmDims{1024, 1024, 1024}, S, E); }
PHFN ph_moe2(int wv, int l) { const ArgsP ap = fresh_args(); const Ctx C = make_ctx(ap, wv); unsigned char* ws = C.ws; moe_plan_lds(C, l);
    MoeOrder S; S.A = (const char*)(ws + O_ACT); S.WT = (const char*)(ws + O_W2 + (size_t)l * 32 * SZ_W2E); S.estride = SZ_W2E; S.tile_e = (const LAS int*)(C.lds + LX_TILE);
    S.NT = *(const LAS int*)(C.lds + LX_MISC + 128); S.nN = 4; S.G = C.G; S.c = C.bid; S.esz = 1;
    EpiBf16 E{(bf16_t*)(ws + O_Y2), IN(33) + (size_t)l * 32 * 1024, 1024, 1024, 1.f / 32.f}; gemm_phase<true>(C, GemmDims{1024, 1024, 1024}, S, E); }
PHFN ph_recin(int wv, int j) { const ArgsP ap = fresh_args(); const Ctx C = make_ctx(ap, wv); unsigned char* ws = C.ws;
    DenseOrder S; S.init(ws + O_HN, ws + O_RWIN + j * SZ_RWIN, 1024, 1024, T_, 2048, C.G, C.bid); EpiRecIn E{(bf16_t*)(ws + O_PROJ), IN(18) + j * 2048}; gemm_phase(C, GemmDims{1024, 1024, 1024}, S, E); }
PHFN ph_rgate(int wv, int j) { const ArgsP ap = fresh_args(); const Ctx C = make_ctx(ap, wv); phase_rgate(C, j, IN(19) + j * 4096, IN(20) + j * 1024, IN(22) + j * 1024, IN(24) + j * 1024); }
PHFN ph_scan_apply(int wv) { const ArgsP ap = fresh_args(); const Ctx C = make_ctx(ap, wv); phase_scan_apply(C); }

#if MODE == 1
__device__ __forceinline__ int fresh_tid(int wv) { unsigned ones = ~0u; asm volatile("" : "+s"(ones)); return wv * 64 + (int)__builtin_amdgcn_mbcnt_hi(ones, __builtin_amdgcn_mbcnt_lo(ones, 0u)); }
__device__ __forceinline__ void grid_barrier(int wv) { const ArgsP q = fresh_args(); XcdBarrier b; b.bar = (unsigned*)(q->ws + O_CTL) + CW_BAR; b.x = xb_xcc_id(); b.st = (volatile LAS unsigned*)((LAS unsigned char*)lds_raw + LDSX_OFF); xcd_barrier(b, fresh_tid(wv)); }
__global__ void __launch_bounds__(512, 2) mk_fwd(Args a) {
    int wv = __builtin_amdgcn_readfirstlane(threadIdx.x >> 6); asm volatile("" : "+s"(wv));
    { LAS unsigned char* lds = (LAS unsigned char*)lds_raw;
      for (int u = threadIdx.x; u < (LDS_BYTES - LDSX_OFF) / 4; u += 512) ((LAS unsigned*)(lds + LDSX_OFF))[u] = 0u;
      __syncthreads();
      if (a.ph_hi - a.ph_lo > 1) (void)xcd_barrier_post((unsigned*)(a.ws + O_CTL) + CW_BAR, (volatile LAS unsigned*)(lds + LDSX_OFF), (int)threadIdx.x); }
    int pid = 0;
#define PHASE(call) { const ArgsP q_ = fresh_args(); const int lo_ = q_->ph_lo, hi_ = q_->ph_hi; if (pid >= lo_ && pid < hi_) { call; if (pid + 1 < hi_) grid_barrier(wv); } ++pid; }
#define PHASE_R(call, REP) { const ArgsP q_ = fresh_args(); const int lo_ = q_->ph_lo, hi_ = q_->ph_hi; if (pid >= lo_ && pid < hi_) { if ((REP) > 1) { call; grid_barrier(wv); } call; if (pid + 1 < hi_) grid_barrier(wv); } ++pid; }
#ifndef REP_PROLOGUE
#define REP_PROLOGUE 1
#endif
#ifndef REP_MOE
#define REP_MOE 1
#endif
#ifndef REP_ATTN
#define REP_ATTN 1
#endif
#ifndef REP_GEMMS
#define REP_GEMMS 1
#endif
#ifdef TIME_NORM
#define NORM_EXTRA(l) PHASE(ph_norm(wv, l, 3))
#else
#define NORM_EXTRA(l)
#endif
#ifndef REP_ELEM
#define REP_ELEM 1
#endif
#ifndef REP_ROUTER
#define REP_ROUTER REP_ELEM
#endif
#ifndef REP_SCATTER
#define REP_SCATTER REP_ELEM
#endif
#ifndef REP_MIX
#define REP_MIX REP_ELEM
#endif
#ifndef REP_CONV
#define REP_CONV REP_ELEM
#endif
#ifndef REP_SCANA
#define REP_SCANA REP_ELEM
#endif
#define MOE_PHASES(l) PHASE_R(ph_router(wv, l), REP_ROUTER) PHASE_R(ph_moe1(wv, l), REP_MOE) PHASE_R(ph_moe2(wv, l), REP_MOE)
    PHASE_R(ph_prologue(wv), REP_PROLOGUE)
#define LAYER_PAIR(lp) \
        { const int l = 2 * (lp);         \
          PHASE(ph_norm(wv, l, (lp) == 0 ? 0 : 1)) PHASE_R(ph_proj(wv, lp), REP_GEMMS) PHASE_R(ph_qkv(wv, lp), REP_GEMMS) PHASE_R(ph_attention(wv, lp), REP_ATTN) PHASE_R(ph_mixcombine(wv), REP_MIX) PHASE(ph_outproj(wv, l, 0)) \
          MOE_PHASES(l) } \
        { const int l = 2 * (lp) + 1;     \
          NORM_EXTRA(l) PHASE(ph_norm(wv, l, 1)) PHASE_R(ph_recin(wv, lp), REP_GEMMS) PHASE_R(ph_rgate(wv, lp), REP_CONV) PHASE_R(ph_scan_apply(wv), REP_SCANA) PHASE(ph_outproj(wv, l, 1)) \
          MOE_PHASES(l) }
    LAYER_PAIR(0)
    LAYER_PAIR(1)
#undef LAYER_PAIR
#ifdef EXTRA_BARRIERS
    { const ArgsP q_ = fresh_args(); if (q_->ph_hi - q_->ph_lo > 1) { _Pragma("unroll 1") for (int xb = 0; xb < EXTRA_BARRIERS; ++xb) grid_barrier(wv); } }
#endif
    PHASE(ph_norm(wv, 3, 2))
#undef PHASE
#undef PHASE_R
#undef MOE_PHASES
}
#else
template <int PH> __global__ void __launch_bounds__(512, 2) k_phase(Args a, int l, int x) {
    int wv = __builtin_amdgcn_readfirstlane(threadIdx.x >> 6); asm volatile("" : "+s"(wv));
    LAS unsigned char* lds = (LAS unsigned char*)lds_raw;
    for (int u = threadIdx.x; u < (LDS_BYTES - LDSX_OFF) / 4; u += 512) ((LAS unsigned*)(lds + LDSX_OFF))[u] = 0u;
    __syncthreads();
    if constexpr (PH == 0) ph_prologue(wv);
    if constexpr (PH == 1) ph_norm(wv, l, x);
    if constexpr (PH == 2) ph_proj(wv, l);
    if constexpr (PH == 4) ph_qkv(wv, l);
    if constexpr (PH == 6) ph_attention(wv, l);
    if constexpr (PH == 7) ph_mixcombine(wv);
    if constexpr (PH == 8) ph_outproj(wv, l, x);
    if constexpr (PH == 9) ph_router(wv, l);
    if constexpr (PH == 11) ph_moe1(wv, l);
    if constexpr (PH == 12) ph_moe2(wv, l);
    if constexpr (PH == 13) ph_recin(wv, l);
    if constexpr (PH == 14) ph_rgate(wv, l);
    if constexpr (PH == 17) ph_scan_apply(wv);
}
#endif
#undef IN
#undef MODL
}

#ifndef MODE
#define MODE 2
#endif
extern "C" void kernel_launch(void* const* d_in, const int* in_sizes, int n_in, void* d_out, int out_size, void* d_ws, size_t ws_size, hipStream_t stream) {
    (void)in_sizes; (void)n_in; (void)out_size; (void)ws_size;
#if MODE == 0
    nv::forward(d_in, (float*)d_out, d_ws, stream);
#else
    static int grid = 0;
    if (grid == 0) {
        int dev = 0, cus = 0;
        (void)hipGetDevice(&dev); (void)hipDeviceGetAttribute(&cus, hipDeviceAttributeMultiprocessorCount, dev);
#if MODE == 1
        (void)hipFuncSetAttribute((const void*)mk::mk_fwd, hipFuncAttributeMaxDynamicSharedMemorySize, mk::LDS_BYTES);
#else
#define SA(PH) (void)hipFuncSetAttribute((const void*)mk::k_phase<PH>, hipFuncAttributeMaxDynamicSharedMemorySize, mk::LDS_BYTES)
        SA(0); SA(1); SA(2); SA(4); SA(6); SA(7); SA(8); SA(9); SA(10); SA(11); SA(12); SA(13); SA(14); SA(17);
#undef SA
#endif
        grid = cus > 0 ? cus : 256;
    }
    (void)hipMemsetAsync((char*)d_ws + mk::O_CTL, 0, mk::SZ_CTL, stream);
    mk::Args a;
    memset(&a, 0, sizeof(a));
    for (int i = 0; i < 34; ++i) a.in[i] = d_in[i];
    a.out = (float*)d_out; a.ws = (unsigned char*)d_ws;
#if MODE == 1
    a.ph_lo = 0; a.ph_hi = mk::N_PHASES;
    hipLaunchKernelGGL(mk::mk_fwd, dim3(grid), dim3(512), mk::LDS_BYTES, stream, a);
#else
#define LP(PH, l, x) hipLaunchKernelGGL(mk::k_phase<PH>, dim3(grid), dim3(512), mk::LDS_BYTES, stream, a, l, x)
    LP(0, 0, 0);
    for (int lp = 0; lp < 2; ++lp) {
        { const int l = 2 * lp; LP(1, l, lp == 0 ? 0 : 1); LP(2, lp, 0); LP(4, lp, 0); LP(6, lp, 0); LP(7, 0, 0); LP(8, l, 0); LP(9, l, 0); LP(10, 0, 0); LP(11, l, 0); LP(12, l, 0); }
        { const int l = 2 * lp + 1; LP(1, l, 1); LP(13, lp, 0); LP(14, lp, 0); LP(17, 0, 0); LP(8, l, 1); LP(9, l, 0); LP(10, 0, 0); LP(11, l, 0); LP(12, l, 0); }
    }
    LP(1, 3, 2);
#undef LP
#endif
#endif
}
```

```cpp
#define MODE 1

#include <string.h>
#include <hip/hip_runtime.h>
#include <stdint.h>
#include <math.h>

namespace cfg {
constexpr int D = 1024, NB = 4, S = 4096, T = NB * S, DEPTH = 4;
constexpr int MIXIN = 1952;
constexpr int NE = 32, TOPK = 4;
constexpr int MPAIR = T * TOPK;
constexpr int NBLK = MPAIR / 256 + NE;
constexpr int P = NBLK * 256;
}
using namespace cfg;


namespace mk {
#define LAS __attribute__((address_space(3)))
#define GAS __attribute__((address_space(1)))
typedef unsigned short bf16_t;
typedef short bf16x8 __attribute__((ext_vector_type(8)));
typedef short s16x4 __attribute__((ext_vector_type(4)));
typedef float f32x2 __attribute__((ext_vector_type(2)));
typedef float f32x4 __attribute__((ext_vector_type(4)));
typedef float f32x16 __attribute__((ext_vector_type(16)));
typedef unsigned u32x2 __attribute__((ext_vector_type(2)));
typedef unsigned u32x4 __attribute__((ext_vector_type(4)));
typedef GAS unsigned gu32;
#define RLX_AGENT __ATOMIC_RELAXED, __HIP_MEMORY_SCOPE_AGENT

__device__ __forceinline__ unsigned cvt_pk_bf16(float lo, float hi) { unsigned r; asm volatile("v_cvt_pk_bf16_f32 %0, %1, %2" : "=v"(r) : "v"(lo), "v"(hi)); return r; }
__device__ __forceinline__ float bf_lo(unsigned u) { return __uint_as_float(u << 16); }
__device__ __forceinline__ float bf_hi(unsigned u) { return __uint_as_float(u & 0xffff0000u); }
template <int O> __device__ __forceinline__ float shx(float v) { static_assert(O >= 1 && O < 32, "shx"); return __int_as_float(__builtin_amdgcn_ds_swizzle(__float_as_int(v), (O << 10) | 0x1f)); }
__device__ __forceinline__ float xadd32(float v) { const auto r = __builtin_amdgcn_permlane32_swap(__float_as_uint(v), __float_as_uint(v), false, false); return __uint_as_float(r[0]) + __uint_as_float(r[1]); }
__device__ __forceinline__ float xmax32(float v) { const auto r = __builtin_amdgcn_permlane32_swap(__float_as_uint(v), __float_as_uint(v), false, false); return fmaxf(__uint_as_float(r[0]), __uint_as_float(r[1])); }
__device__ __forceinline__ float wsum(float v) { v += shx<1>(v); v += shx<2>(v); v += shx<4>(v); v += shx<8>(v); v += shx<16>(v); return xadd32(v); }
__device__ __forceinline__ float fexp2(float x) { return __builtin_amdgcn_exp2f(x); }
__device__ __forceinline__ float frcp(float x) { return __builtin_amdgcn_rcpf(x); }
__device__ __forceinline__ float fsigmoid(float z) { return frcp(1.f + fexp2(-1.4426950408889634f * z)); }
__device__ __forceinline__ float fgelu_tanh(float x) { const float u = 0.7978845608028654f * (x + 0.044715f * x * x * x); return x * frcp(1.f + fexp2(-2.8853900817779268f * u)); }

#define XB_TMO      128
#define XB_XCNT(j)  (256  + 64 * (j))
#define XB_XSUB(j)  (1280 + 64 * (j))
#define XB_XGEN(j)  (2304 + 64 * (j))
#define XB_TOP      3328
#define XB_TOPGEN   3392
#define XCD_BAR_WORDS 3456
#define XB_SPIN_CAP (1u << 18)
__device__ __forceinline__ unsigned xb_ld(unsigned* p)              { return __hip_atomic_load(p, __ATOMIC_RELAXED, __HIP_MEMORY_SCOPE_AGENT); }
__device__ __forceinline__ unsigned xb_add(unsigned* p, unsigned v) { return __hip_atomic_fetch_add(p, v, __ATOMIC_RELAXED, __HIP_MEMORY_SCOPE_AGENT); }
__device__ __forceinline__ unsigned xb_xcc_id() { return (unsigned)__builtin_amdgcn_s_getreg((3 << 11) | 20) & 0xFu; }
#define XB_SPIN(cond, bar) do { unsigned _sp = 0; while (cond) { __builtin_amdgcn_s_sleep(1); \
    if ((++_sp & 255u) == 0u) { if (xb_ld(&(bar)[XB_TMO])) break; if (_sp > XB_SPIN_CAP) { atomicAdd(&(bar)[XB_TMO], 1u); break; } } } } while (0)
struct XcdBarrier { unsigned* bar; unsigned x; volatile LAS unsigned* st; };
__device__ __forceinline__ XcdBarrier xcd_barrier_post(unsigned* bar, volatile LAS unsigned* st, int tid) {
    XcdBarrier b; b.bar = bar; b.x = xb_xcc_id(); b.st = st;
    if (tid == 0) (void)xb_add(&bar[XB_XCNT(b.x)], 1u);
    return b;
}
__device__ __forceinline__ void xcd_barrier_complete(unsigned* bar, unsigned x, unsigned& nloc, unsigned& nx) {
    const unsigned G = gridDim.x * gridDim.y * gridDim.z;
    unsigned sum, cnt, mine, sp = 0u;
    for (;;) {
        sum = 0u; cnt = 0u; mine = 0u;
#pragma unroll
        for (unsigned j = 0; j < 16; ++j) { const unsigned c = xb_ld(&bar[XB_XCNT(j)]); sum += c; cnt += (c > 0u) ? 1u : 0u; mine = (j == x) ? c : mine; }
        if (sum == G) break;
        __builtin_amdgcn_s_sleep(1);
        if ((++sp & 255u) == 0u) { if (xb_ld(&bar[XB_TMO])) break; if (sp > XB_SPIN_CAP) { atomicAdd(&bar[XB_TMO], 1u); break; } }
    }
    nloc = mine > 0u ? mine : 1u; nx = cnt > 0u ? cnt : 1u;
}
__device__ __forceinline__ void xcd_barrier(const XcdBarrier& b, int tid) {
    asm volatile("s_waitcnt vmcnt(0)" ::: "memory");
    __syncthreads();
    if (tid == 0) {
        unsigned* bar = b.bar;
        __builtin_amdgcn_s_waitcnt(0);
        unsigned nloc = b.st[0], nx = b.st[1];
        if (nloc == 0u) { xcd_barrier_complete(bar, b.x, nloc, nx); b.st[0] = nloc; b.st[1] = nx; }
        const unsigned old = xb_add(&bar[XB_XSUB(b.x)], 1u);
        const unsigned gen = old / nloc;
        if (old + 1u == (gen + 1u) * nloc) {
            __builtin_amdgcn_fence(__ATOMIC_RELEASE, "agent");
            asm volatile("s_waitcnt vmcnt(0)" ::: "memory");
            const unsigned og = xb_add(&bar[XB_TOP], 1u);
            const unsigned tg = og / nx;
            if (og + 1u == (tg + 1u) * nx) xb_add(&bar[XB_TOPGEN], 1u);
            else XB_SPIN(xb_ld(&bar[XB_TOPGEN]) == tg, bar);
            __builtin_amdgcn_fence(__ATOMIC_ACQUIRE, "agent");
            xb_add(&bar[XB_XGEN(b.x)], 1u);
            asm volatile("s_waitcnt vmcnt(0)" ::: "memory");
        } else {
            XB_SPIN(xb_ld(&bar[XB_XGEN(b.x)]) == gen, bar);
            __builtin_amdgcn_fence(__ATOMIC_ACQUIRE, "agent");
            asm volatile("s_waitcnt vmcnt(0)" ::: "memory");
        }
    }
    __syncthreads();
}

constexpr int BM = 256, BK = 64, HALF = 128, HTB = HALF * BK * 2, STAGE_BYTES = 8 * HTB;
__host__ __device__ __forceinline__ int lds_byte(int r, int c) { const int st = (r >> 4) * 2 + (c >> 5), rr = r & 15, cc = c & 31, ob = rr * 64 + cc * 2; return st * 1024 + (ob ^ (((ob >> 9) & 1) << 5)); }
__host__ __device__ __forceinline__ void stage_rc(int b, int& R, int& C) { const int st = b / 1024, sb = b % 1024, swz = sb ^ (((sb >> 9) & 1) << 5); R = (st >> 1) * 16 + swz / 64; C = (st & 1) * 32 + (swz % 64) / 2; }
__host__ __device__ __forceinline__ int perm32(int rho) { const int n = rho >> 4, i = rho & 15; return 8 * (i >> 2) + 4 * n + (i & 3); }

struct Unit { const char* a; const char* b; int row0, col0, e, pad; };
struct GemmDims { int K, lda, ldb; };
typedef f32x4 Acc[2][2][4][2];
__device__ __forceinline__ void zero_acc(Acc& acc) {
#pragma unroll
    for (int a = 0; a < 2; ++a)
#pragma unroll
        for (int b = 0; b < 2; ++b)
#pragma unroll
            for (int m = 0; m < 4; ++m)
#pragma unroll
                for (int n = 0; n < 2; ++n)
#pragma unroll
                    for (int j = 0; j < 4; ++j) { float z; asm volatile("v_mov_b32 %0, 0" : "=v"(z)); acc[a][b][m][n][j] = z; }
}

typedef int v8i32 __attribute__((ext_vector_type(8)));
template <bool F8 = false, class CtxT, class Epi, class Sched>
__device__ __forceinline__ void gemm_phase(const CtxT& C, const GemmDims g, const Sched& S, const Epi& E) {
    LAS unsigned char* lds = C.lds;
    const int tid = C.tid, wid = __builtin_amdgcn_readfirstlane(tid >> 6), lane = tid & 63, wr = wid >> 2, wc = wid & 3, fr = lane & 15, fq = lane >> 4;
    constexpr int ESZ = F8 ? 1 : 2;
    constexpr bool GA = Sched::GATHER;
    int nt = g.K / (F8 ? 128 : BK); asm volatile("" : "+s"(nt));
    unsigned voffA[2], voffB[2];
#pragma unroll
    for (int i = 0; i < 2; ++i) { int R, C; stage_rc(tid * 16 + i * 8192, R, C); const int Rb = (R & ~31) + perm32(R & 31);
        voffA[i] = (unsigned)(R * g.lda * ESZ + C * 2); voffB[i] = (unsigned)(Rb * g.ldb * ESZ + C * 2); }
    unsigned voffG[2][2];
    auto load_goffs = [&](int uidx) { if constexpr (GA) { int R, Cc; stage_rc(tid * 16, R, Cc); const LAS int* tp = S.gtab + uidx * 256 + R;
#pragma unroll
        for (int h = 0; h < 2; ++h)
#pragma unroll
            for (int i = 0; i < 2; ++i) voffG[h][i] = (unsigned)tp[h * 128 + i * 64] * (unsigned)(g.lda * ESZ) + (unsigned)(Cc * 2); } };
    const size_t kstep = (size_t)(BK * 2);
    const size_t hstepA = (size_t)HALF * g.lda * ESZ, hstepB = (size_t)HALF * g.ldb * ESZ;
    const unsigned ldsw = (unsigned)wid * 1024u;
    const unsigned ldsu = (unsigned)__builtin_amdgcn_readfirstlane((int)(unsigned)(unsigned long long)(lds));
    const int aoff = lds_byte(wr * 64 + fr, fq * 8), boff = lds_byte(wc * 32 + fr, fq * 8);
#define PG8_SA(b, h) (((b) * 2 + (h)) * HTB)
#define PG8_SB(b, h) ((4 + (b) * 2 + (h)) * HTB)
#define PG8_STAGE(bufoff, gbase, voff) do { _Pragma("unroll") for (int _i = 0; _i < 2; ++_i) { \
        asm volatile("s_mov_b32 m0, %2\n\ts_nop 3\n\tglobal_load_lds_dwordx4 %0, %1" :: "v"((voff)[_i]), "s"((const char*)(gbase)), "s"(ldsu + (unsigned)(bufoff) + ldsw + (unsigned)(_i * 8192)) : "memory"); } } while (0)
#define PG8_STAGE_A(bufoff, gbase, h) do { if constexpr (GA) PG8_STAGE(bufoff, gbase, voffG[h]); else PG8_STAGE(bufoff, (gbase) + (h) * hstepA, voffA); } while (0)
#define PG8_LDA(dst, b, h) do { _Pragma("unroll") for (int m = 0; m < 4; ++m) _Pragma("unroll") for (int k = 0; k < 2; ++k) dst[m][k] = *(const LAS bf16x8*)(lds + PG8_SA(b, h) + aoff + m * 2048 + k * 1024); } while (0)
#define PG8_LDB(dst, b, h) do { _Pragma("unroll") for (int n = 0; n < 2; ++n) _Pragma("unroll") for (int k = 0; k < 2; ++k) dst[n][k] = *(const LAS bf16x8*)(lds + PG8_SB(b, h) + boff + n * 2048 + k * 1024); } while (0)
#define PG8_CAT(x) __builtin_bit_cast(v8i32, (x))
#define PG8_MMA(ai, bj, At, Bt) do { __builtin_amdgcn_s_setprio(1); \
        if constexpr (F8) { _Pragma("unroll") for (int m = 0; m < 4; ++m) _Pragma("unroll") for (int n = 0; n < 2; ++n) \
            acc[ai][bj][m][n] = __builtin_amdgcn_mfma_scale_f32_16x16x128_f8f6f4(PG8_CAT(Bt[n]), PG8_CAT(At[m]), acc[ai][bj][m][n], 0, 0, 0, 0, 0, 0); } \
        else { _Pragma("unroll") for (int m = 0; m < 4; ++m) _Pragma("unroll") for (int n = 0; n < 2; ++n) _Pragma("unroll") for (int k = 0; k < 2; ++k) \
            acc[ai][bj][m][n] = __builtin_amdgcn_mfma_f32_16x16x32_bf16(Bt[n][k], At[m][k], acc[ai][bj][m][n], 0, 0, 0); } \
        __builtin_amdgcn_s_setprio(0); } while (0)
#define PG8_WAIT_V(n) asm volatile("s_waitcnt vmcnt(" #n ")" ::: "memory")
#define PG8_WAIT_L(n) asm volatile("s_waitcnt lgkmcnt(" #n ")" ::: "memory")
#define PG8_BAR __builtin_amdgcn_s_barrier()
#define PG8_SCHED __builtin_amdgcn_sched_barrier(0)
    Unit cur, nxt; int ui = 0;
    if (!S.next(0, cur)) return;
    Acc acc; zero_acc(acc);
    struct Frag2 { bf16x8 p[2]; __device__ __forceinline__ bf16x8& operator[](int k) { return p[k]; } __device__ __forceinline__ const bf16x8& operator[](int k) const { return p[k]; } };
    Frag2 At[4], B0[2], B1[2];
    const char* cA = cur.a; const char* cB = cur.b;
    load_goffs(0);
    PG8_STAGE(PG8_SB(0, 0), cB, voffB); PG8_STAGE(PG8_SB(0, 1), cB + hstepB, voffB); PG8_STAGE_A(PG8_SA(0, 0), cA, 0); PG8_STAGE_A(PG8_SA(0, 1), cA, 1);
    if (wr == 1) PG8_BAR;
    PG8_WAIT_V(2); PG8_BAR;
    PG8_STAGE(PG8_SB(1, 0), cB + kstep, voffB); PG8_STAGE_A(PG8_SA(1, 0), cA + kstep, 0); PG8_STAGE(PG8_SB(1, 1), cB + hstepB + kstep, voffB);
    PG8_WAIT_V(6); PG8_BAR;
    for (;;) {
        const bool has_next = S.next(ui + 1, nxt);
        const char* nA = has_next ? nxt.a : cA; const char* nB = has_next ? nxt.b : cB;
        for (int t = 0; t < nt; t += 2) {
            const bool last = (t == nt - 2);
            const char* a1 = cA + (size_t)(t + 1) * kstep;
            const char* a2 = last ? nA : cA + (size_t)(t + 2) * kstep; const char* b2 = last ? nB : cB + (size_t)(t + 2) * kstep;
            const char* a3 = a2 + kstep; const char* b3 = b2 + kstep;
            PG8_LDB(B0, 0, 0); PG8_LDB(B1, 0, 1); PG8_SCHED; PG8_LDA(At, 0, 0); PG8_STAGE_A(PG8_SA(1, 1), a1, 1);
            if (GA && last && has_next) load_goffs(ui + 1);
            PG8_WAIT_V(8); PG8_WAIT_L(0); PG8_BAR; PG8_MMA(0, 0, At, B0); PG8_MMA(0, 1, At, B1); PG8_BAR; PG8_SCHED;
            PG8_LDA(At, 0, 1); PG8_STAGE(PG8_SB(0, 0), b2, voffB); PG8_STAGE(PG8_SB(0, 1), b2 + hstepB, voffB); PG8_STAGE_A(PG8_SA(0, 0), a2, 0);
            PG8_WAIT_V(8); PG8_WAIT_L(0); PG8_BAR; PG8_MMA(1, 0, At, B0); PG8_MMA(1, 1, At, B1); PG8_BAR; PG8_SCHED;
            PG8_LDB(B0, 1, 0); PG8_LDB(B1, 1, 1); PG8_SCHED; PG8_LDA(At, 1, 0); PG8_STAGE_A(PG8_SA(0, 1), a2, 1);
            PG8_WAIT_V(8); PG8_WAIT_L(0); PG8_BAR; PG8_MMA(0, 0, At, B0); PG8_MMA(0, 1, At, B1); PG8_BAR; PG8_SCHED;
            PG8_LDA(At, 1, 1); PG8_STAGE(PG8_SB(1, 0), b3, voffB); PG8_STAGE(PG8_SB(1, 1), b3 + hstepB, voffB); PG8_STAGE_A(PG8_SA(1, 0), a3, 0);
            PG8_WAIT_V(8); PG8_WAIT_L(0); PG8_BAR; PG8_MMA(1, 0, At, B0); PG8_MMA(1, 1, At, B1); PG8_BAR; PG8_SCHED;
        }
        if (wr == 0) PG8_BAR;
        E(acc, cur, wr, wc, fr, fq);
        if (!has_next) break;
        zero_acc(acc);
        cur = nxt; cA = nA; cB = nB; ++ui;
        if (wr == 1) PG8_BAR;
    }
    PG8_WAIT_V(0);
    PG8_BAR;
#undef PG8_SA
#undef PG8_SB
#undef PG8_STAGE
#undef PG8_STAGE_A
#undef PG8_LDA
#undef PG8_LDB
#undef PG8_MMA
#undef PG8_CAT
#undef PG8_WAIT_V
#undef PG8_WAIT_L
#undef PG8_BAR
#undef PG8_SCHED
}

struct DenseOrder {
    static constexpr bool GATHER = false;
    const char* A; const char* Bt; int lda, ldb, nM, nN, nwg, G, c;
    __device__ __forceinline__ void init(const void* A_, const void* Bt_, int lda_, int ldb_, int M, int N, int G_, int c_) { A = (const char*)A_; Bt = (const char*)Bt_; lda = lda_; ldb = ldb_; nM = M / BM; nN = N / BM; nwg = nM * nN; G = G_; c = c_; }
    __device__ __forceinline__ bool next(int i, Unit& u) const {
        const long L = (long)i * G + c; if (L >= nwg) return false;
        int wgid = (int)L; { const int q = nwg / 8, r = nwg % 8, xcd = wgid % 8, off = wgid / 8; wgid = (xcd < r ? xcd * (q + 1) : r * (q + 1) + (xcd - r) * q) + off; }
        const int nig = 8 * nN, gid = wgid / nig, fm = gid * 8, gsz = (nM - fm) < 8 ? (nM - fm) : 8;
        const int pm = fm + ((wgid % nig) % gsz), pn = (wgid % nig) / gsz;
        u.a = A + (size_t)pm * BM * lda * 2; u.b = Bt + (size_t)pn * BM * ldb * 2; u.row0 = pm * BM; u.col0 = pn * BM; u.e = 0; u.pad = 0; return true;
    }
};
struct LruOrder {
    static constexpr bool GATHER = false;
    const char* XC; const char* RG; int G, c;
    __device__ __forceinline__ bool next(int i, Unit& u) const {
        const int L = i * G + c; if (L >= 512) return false;
        const int pm = L >> 3, n = L & 7;
        u.a = XC + ((size_t)pm * BM * 1024 + n * 128) * 2; u.b = RG + (size_t)n * 256 * 128 * 2; u.row0 = pm * BM; u.col0 = n * 128; u.e = n; u.pad = 0; return true;
    }
};
template <bool GATHER_ = false> struct MoeOrderT {
    static constexpr bool GATHER = GATHER_; const LAS int* gtab;
    const char* A; const char* WT; size_t estride; const LAS int* tile_e; int NT, nN, G, c, esz;
    __device__ __forceinline__ bool next(int i, Unit& u) const {
        int tile, pn;
#ifndef MOE_ORDER_ALT
#define MOE_ORDER_ALT 0
#endif
        if (!MOE_ORDER_ALT && (G % (8 * nN)) == 0) { const int R = G / nN; tile = i * R + (c & 7) * (R >> 3) + (c >> 3) / nN; pn = (c >> 3) % nN; }
        else { const int L = i * G + c; tile = L / nN; pn = L % nN; }
        if (tile >= NT) return false;
        const int e = __builtin_amdgcn_readfirstlane(tile_e[tile]);
        u.a = GATHER ? A : A + (size_t)tile * BM * 1024 * esz; u.b = WT + (size_t)e * estride + (size_t)pn * BM * 1024 * esz; u.row0 = tile * BM; u.col0 = pn * BM; u.e = e; u.pad = 0; return true;
    }
};
typedef MoeOrderT<false> MoeOrder;

#define EPI_ROW(ai, m) (u.row0 + (ai) * HALF + wr * 64 + (m) * 16 + fr)
#define EPI_COL(bj) (u.col0 + (bj) * HALF + wc * 32 + 8 * fq)
struct EpiBf16 {
    bf16_t* O; const float* bias; int ldc, bias_es; float ascale;
    __device__ __forceinline__ void operator()(const Acc& acc, const Unit& u, int wr, int wc, int fr, int fq) const {
        f32x4 bv[2][2];
#pragma unroll
        for (int bj = 0; bj < 2; ++bj)
#pragma unroll
            for (int n = 0; n < 2; ++n) bv[bj][n] = bias ? *(const f32x4*)(bias + (size_t)u.e * bias_es + EPI_COL(bj) + 4 * n) : (f32x4){0.f, 0.f, 0.f, 0.f};
#pragma unroll
        for (int ai = 0; ai < 2; ++ai)
#pragma unroll
            for (int m = 0; m < 4; ++m) { bf16_t* rowp = O + (size_t)EPI_ROW(ai, m) * ldc;
#pragma unroll
                for (int bj = 0; bj < 2; ++bj) { const f32x4 v0 = acc[ai][bj][m][0] * ascale + bv[bj][0], v1 = acc[ai][bj][m][1] * ascale + bv[bj][1];
                    u32x4 w; w.x = cvt_pk_bf16(v0[0], v0[1]); w.y = cvt_pk_bf16(v0[2], v0[3]); w.z = cvt_pk_bf16(v1[0], v1[1]); w.w = cvt_pk_bf16(v1[2], v1[3]);
                    *(u32x4*)(rowp + EPI_COL(bj)) = w; } }
    }
};
template <int KIND> struct EpiNorm {
    bf16_t* O; int ldc; const float* ga; const float* gb; const float* gc; const float* gd; const float* ge; const float* cs; LAS float* S;
    __device__ __forceinline__ void operator()(const Acc& acc, const Unit& u, int wr, int wc, int fr, int fq) const {
        const int pn = u.col0 >> 8; const int lane = fr + 16 * fq;
        int mode = 0; const float* gp = ga; float scale = 1.f;
        if (KIND == 0) { if (pn < 2) { mode = 1; gp = ga; scale = 0.125f * 1.4426950408889634f; } else if (pn < 4) { mode = 1; gp = gb; } else if (pn < 6) mode = 0; else if (pn == 6) { mode = 2; gp = gc; } else { mode = 3; gp = gd; } }
        if (KIND == 1) { scale = 0.10206207261596575f * 1.4426950408889634f; if (pn < 2) { mode = 1; gp = ga; } else { mode = 4; gp = gb; } }
        if (KIND == 2) { if (pn < 2) { mode = 1; gp = ga; } else mode = 0; }
        float ss[2][4][2];
        if (mode != 0) {
#pragma unroll
            for (int ai = 0; ai < 2; ++ai)
#pragma unroll
                for (int m = 0; m < 4; ++m)
#pragma unroll
                    for (int bj = 0; bj < 2; ++bj) { const f32x4 a = acc[ai][bj][m][0], b = acc[ai][bj][m][1];
                        float s = (a[0] * a[0] + a[1] * a[1]) + (a[2] * a[2] + a[3] * a[3]) + (b[0] * b[0] + b[1] * b[1]) + (b[2] * b[2] + b[3] * b[3]);
                        s += shx<16>(s); ss[ai][m][bj] = xadd32(s); } }
        if (mode == 1 || mode == 2 || mode == 3) {
            if (fq == 0) {
#pragma unroll
                for (int ai = 0; ai < 2; ++ai)
#pragma unroll
                    for (int m = 0; m < 4; ++m)
#pragma unroll
                        for (int bj = 0; bj < 2; ++bj) S[(ai * HALF + wr * 64 + m * 16 + fr) * 8 + bj * 4 + wc] = ss[ai][m][bj]; }
            asm volatile("s_waitcnt lgkmcnt(0)" ::: "memory"); __builtin_amdgcn_s_barrier(); asm volatile("" ::: "memory");
#pragma unroll
            for (int ai = 0; ai < 2; ++ai)
#pragma unroll
                for (int m = 0; m < 4; ++m) { const LAS float* sr = S + (ai * HALF + wr * 64 + m * 16 + fr) * 8;
#pragma unroll
                    for (int bj = 0; bj < 2; ++bj) {
                        if (mode == 1) { const f32x2 t = *(const LAS f32x2*)(sr + bj * 4 + (wc & 2)); ss[ai][m][bj] = t[0] + t[1]; }
                        else if (mode == 2) { const f32x4 t0 = *(const LAS f32x4*)sr, t1 = *(const LAS f32x4*)(sr + 4); ss[ai][m][bj] = (t0[0] + t0[1]) + (t0[2] + t0[3]) + (t1[0] + t1[1]) + (t1[2] + t1[3]); }
                        else if (bj == 0) { const f32x4 t0 = *(const LAS f32x4*)sr; ss[ai][m][bj] = (t0[0] + t0[1]) + (t0[2] + t0[3]); } } }
        }
        const float inv_n = (mode == 1) ? (1.f / 64.f) : (mode == 2) ? (1.f / 256.f) : (1.f / 32.f);
        const bool rope_tile = (mode == 4) || (mode == 3);
#pragma unroll
        for (int bj = 0; bj < 2; ++bj) {
            f32x4 g0 = (f32x4){1.f, 1.f, 1.f, 1.f}, g1 = g0; bool rope = false, zero = false; float invn = inv_n;
            const int c8 = 8 * fq;
            if (mode == 1) { const int c = 32 * (wc & 1) + c8; g0 = *(const f32x4*)(gp + c); g1 = *(const f32x4*)(gp + c + 4); }
            else if (mode == 2) { const int c = bj * HALF + wc * 32 + c8; g0 = *(const f32x4*)(gp + c); g1 = *(const f32x4*)(gp + c + 4); }
            else if (mode == 3) { if (bj == 0) { const int c = wc * 32 + c8; g0 = *(const f32x4*)(gp + c); g1 = *(const f32x4*)(gp + c + 4); invn = 1.f / 128.f; }
                                  else if (wc == 0) { g0 = *(const f32x4*)(ge + c8); g1 = *(const f32x4*)(ge + c8 + 4); rope = true; } else zero = true; }
            else if (mode == 4) { g0 = *(const f32x4*)(gp + c8); g1 = *(const f32x4*)(gp + c8 + 4); rope = true; }
            (void)rope_tile;
#pragma unroll
            for (int ai = 0; ai < 2; ++ai)
#pragma unroll
                for (int m = 0; m < 4; ++m) { const int row = EPI_ROW(ai, m);
                    f32x4 v0 = acc[ai][bj][m][0], v1 = acc[ai][bj][m][1];
                    if (mode != 0) { const float rs = rsqrtf(ss[ai][m][bj] * invn + 1e-6f) * scale; v0 = v0 * rs * g0; v1 = v1 * rs * g1; }
                    if (rope) {
                        const float* cr = cs + (size_t)row * 32 + 8 * (fq & 1); const f32x4 c0 = *(const f32x4*)cr, c1 = *(const f32x4*)(cr + 4), s0 = *(const f32x4*)(cr + 16), s1 = *(const f32x4*)(cr + 20);
                        f32x4 o0, o1;
#pragma unroll
                        for (int j = 0; j < 4; ++j) { const auto r0 = __builtin_amdgcn_permlane32_swap(__float_as_uint(v0[j]), __float_as_uint(v0[j]), false, false), r1 = __builtin_amdgcn_permlane32_swap(__float_as_uint(v1[j]), __float_as_uint(v1[j]), false, false);
                            const float ot0 = __uint_as_float(lane < 32 ? r0[1] : r0[0]), ot1 = __uint_as_float(lane < 32 ? r1[1] : r1[0]);
                            o0[j] = (lane < 32) ? (v0[j] * c0[j] - ot0 * s0[j]) : (ot0 * s0[j] + v0[j] * c0[j]);
                            o1[j] = (lane < 32) ? (v1[j] * c1[j] - ot1 * s1[j]) : (ot1 * s1[j] + v1[j] * c1[j]); }
                        v0 = o0; v1 = o1; }
                    if (zero) { v0 = (f32x4){0.f, 0.f, 0.f, 0.f}; v1 = v0; }
                    u32x4 w; w.x = cvt_pk_bf16(v0[0], v0[1]); w.y = cvt_pk_bf16(v0[2], v0[3]); w.z = cvt_pk_bf16(v1[0], v1[1]); w.w = cvt_pk_bf16(v1[2], v1[3]);
                    *(u32x4*)(O + (size_t)row * ldc + EPI_COL(bj)) = w; } }
    }
};
struct EpiRecIn {
    bf16_t* O; const float* bias;
    __device__ __forceinline__ void operator()(const Acc& acc, const Unit& u, int wr, int wc, int fr, int fq) const {
        const bool act = u.col0 < 1024;
        f32x4 bv[2][2];
#pragma unroll
        for (int bj = 0; bj < 2; ++bj)
#pragma unroll
            for (int n = 0; n < 2; ++n) bv[bj][n] = *(const f32x4*)(bias + EPI_COL(bj) + 4 * n);
#pragma unroll
        for (int ai = 0; ai < 2; ++ai)
#pragma unroll
            for (int m = 0; m < 4; ++m) { bf16_t* rowp = O + (size_t)EPI_ROW(ai, m) * 2048;
#pragma unroll
                for (int bj = 0; bj < 2; ++bj) { f32x4 v0 = acc[ai][bj][m][0] + bv[bj][0], v1 = acc[ai][bj][m][1] + bv[bj][1];
                    if (act) {
#pragma unroll
                        for (int j = 0; j < 4; ++j) { v0[j] = fgelu_tanh(v0[j]); v1[j] = fgelu_tanh(v1[j]); } }
                    u32x4 w; w.x = cvt_pk_bf16(v0[0], v0[1]); w.y = cvt_pk_bf16(v0[2], v0[3]); w.z = cvt_pk_bf16(v1[0], v1[1]); w.w = cvt_pk_bf16(v1[2], v1[3]);
                    *(u32x4*)(rowp + EPI_COL(bj)) = w; } }
    }
};
__device__ __forceinline__ unsigned pk4_fp8(float a, float b, float c, float d) { int w = 0; w = __builtin_amdgcn_cvt_pk_fp8_f32(a, b, w, false); w = __builtin_amdgcn_cvt_pk_fp8_f32(c, d, w, true); return (unsigned)w; }
struct EpiSwiglu {
    unsigned char* ACT; const float* b1; float ascale;
    __device__ __forceinline__ float sw(float g, float l) const { g = fminf(g, 7.f); l = fminf(fmaxf(l, -7.f), 7.f); return g * fsigmoid(1.702f * g) * (l + 1.f); }
    __device__ __forceinline__ void operator()(const Acc& acc, const Unit& u, int wr, int wc, int fr, int fq) const {
        f32x4 bv[2][2];
#pragma unroll
        for (int bj = 0; bj < 2; ++bj)
#pragma unroll
            for (int n = 0; n < 2; ++n) bv[bj][n] = *(const f32x4*)(b1 + (size_t)u.e * 2048 + EPI_COL(bj) + 4 * n);
#pragma unroll
        for (int ai = 0; ai < 2; ++ai)
#pragma unroll
            for (int m = 0; m < 4; ++m) { unsigned char* rowp = ACT + (size_t)EPI_ROW(ai, m) * 1024;
#pragma unroll
                for (int bj = 0; bj < 2; ++bj) { const f32x4 v0 = acc[ai][bj][m][0] * ascale + bv[bj][0], v1 = acc[ai][bj][m][1] * ascale + bv[bj][1];
                    *(unsigned*)(rowp + (EPI_COL(bj) >> 1)) = pk4_fp8(sw(v0[0], v0[1]), sw(v0[2], v0[3]), sw(v1[0], v1[1]), sw(v1[2], v1[3])); } }
    }
};
struct EpiResid {
    bf16_t* X; const float* g; const float* bias;
    __device__ __forceinline__ void operator()(const Acc& acc, const Unit& u, int wr, int wc, int fr, int fq) const {
        const int b = u.row0 / cfg::S;
        f32x4 bv[2][2], gv[2][2];
#pragma unroll
        for (int bj = 0; bj < 2; ++bj)
#pragma unroll
            for (int n = 0; n < 2; ++n) { bv[bj][n] = bias ? *(const f32x4*)(bias + EPI_COL(bj) + 4 * n) : (f32x4){0.f, 0.f, 0.f, 0.f}; gv[bj][n] = *(const f32x4*)(g + b * 6144 + EPI_COL(bj) + 4 * n); }
#pragma unroll
        for (int ai = 0; ai < 2; ++ai)
#pragma unroll
            for (int m = 0; m < 4; ++m) { bf16_t* rowp = X + (size_t)EPI_ROW(ai, m) * 1024;
#pragma unroll
                for (int bj = 0; bj < 2; ++bj) { u32x4* p = (u32x4*)(rowp + EPI_COL(bj)); const u32x4 xw = *p;
                    const f32x4 x0 = (f32x4){bf_lo(xw.x), bf_hi(xw.x), bf_lo(xw.y), bf_hi(xw.y)} + gv[bj][0] * (acc[ai][bj][m][0] + bv[bj][0]);
                    const f32x4 x1 = (f32x4){bf_lo(xw.z), bf_hi(xw.z), bf_lo(xw.w), bf_hi(xw.w)} + gv[bj][1] * (acc[ai][bj][m][1] + bv[bj][1]);
                    u32x4 w; w.x = cvt_pk_bf16(x0[0], x0[1]); w.y = cvt_pk_bf16(x0[2], x0[3]); w.z = cvt_pk_bf16(x1[0], x1[1]); w.w = cvt_pk_bf16(x1[2], x1[3]); *p = w; }
                if (m & 1) asm volatile("" ::: "memory"); }
    }
};
struct EpiLru {
    const bf16_t* XC; const float* ba; const float* bx; const float* lam; bf16_t* LA; bf16_t* Bb;
    __device__ __forceinline__ void operator()(const Acc& acc, const Unit& u, int wr, int wc, int fr, int fq) const {
        const int ch0 = u.col0 + wc * 32 + 8 * fq;
#pragma unroll
        for (int n = 0; n < 2; ++n) { const int ch = ch0 + 4 * n;
            const f32x4 bav = *(const f32x4*)(ba + ch), bxv = *(const f32x4*)(bx + ch), spv = *(const f32x4*)(lam + ch);
#pragma unroll
            for (int ai = 0; ai < 2; ++ai)
#pragma unroll
                for (int m = 0; m < 4; ++m) { const size_t ro = (size_t)EPI_ROW(ai, m) * 1024 + ch;
                    const u32x2 xr = *(const u32x2*)(XC + ro);
                    const float xcv[4] = {bf_lo(xr.x), bf_hi(xr.x), bf_lo(xr.y), bf_hi(xr.y)};
                    float lav[4], bvv[4];
#pragma unroll
                    for (int j = 0; j < 4; ++j) { const float r = fsigmoid(acc[ai][0][m][n][j] + bav[j]), ig = fsigmoid(acc[ai][1][m][n][j] + bxv[j]);
                        const float la = r * spv[j], a = fexp2(la); lav[j] = la; bvv[j] = __builtin_amdgcn_sqrtf(fmaxf(1.f - a * a, 0.f)) * ig * xcv[j]; }
                    u32x2 wa, wb; wa.x = cvt_pk_bf16(lav[0], lav[1]); wa.y = cvt_pk_bf16(lav[2], lav[3]); wb.x = cvt_pk_bf16(bvv[0], bvv[1]); wb.y = cvt_pk_bf16(bvv[2], bvv[3]);
                    *(u32x2*)(LA + ro) = wa; *(u32x2*)(Bb + ro) = wb; asm volatile("" ::: "memory"); } }
    }
};

constexpr size_t MiB = (size_t)1 << 20;
constexpr size_t al4k(size_t x) { return (x + 4095) & ~(size_t)4095; }
constexpr int T_ = cfg::T, S_ = cfg::S, P_ = cfg::P;
constexpr size_t O_CTL = 0, SZ_CTL = 1 * MiB;
constexpr size_t O_MOD = O_CTL + SZ_CTL, SZ_MOD = al4k((size_t)4 * 4 * 6144 * 4);
constexpr size_t O_CS = O_MOD + SZ_MOD, SZ_CS = (size_t)T_ * 32 * 4;
constexpr size_t O_HIST = O_CS + SZ_CS, SZ_HIST = 256 * 32 * 4;
constexpr size_t O_TOPI = O_HIST + SZ_HIST, SZ_TOP = (size_t)T_ * 4 * 4;
constexpr size_t O_TOPG = O_TOPI + SZ_TOP, O_POS = O_TOPG + SZ_TOP;
constexpr size_t O_SUMP = O_POS + SZ_TOP, SZ_SUM = (size_t)4 * 64 * 1024 * 4;
constexpr size_t O_SUMH = O_SUMP + SZ_SUM;
constexpr size_t O_LSE = O_SUMH + SZ_SUM, SZ_LSE = (size_t)3 * T_ * 8 * 4;
constexpr size_t O_SPV = al4k(O_LSE + SZ_LSE), SZ_SPV = 2 * 1024 * 4;
constexpr size_t O_WIN = al4k(O_SPV + SZ_SPV), SZ_WIN = (size_t)2048 * 1024 * 2;
constexpr size_t O_WUQ = O_WIN + 2 * SZ_WIN, SZ_WUQ = (size_t)768 * 256 * 2;
constexpr size_t O_WUKV = O_WUQ + 2 * SZ_WUQ, SZ_WUKV = (size_t)1024 * 128 * 2;
constexpr size_t O_WOUT = O_WUKV + 2 * SZ_WUKV, SZ_WOUT = (size_t)1024 * 1024 * 2;
constexpr size_t O_RWIN = O_WOUT + 2 * SZ_WOUT, SZ_RWIN = (size_t)2048 * 1024 * 2;
constexpr size_t O_RGATE = O_RWIN + 2 * SZ_RWIN, SZ_RGATE = (size_t)8 * 256 * 128 * 2;
constexpr size_t O_RWOUT = O_RGATE + 2 * SZ_RGATE, SZ_RWOUT = (size_t)1024 * 1024 * 2;
constexpr size_t O_W1 = O_RWOUT + 2 * SZ_RWOUT, SZ_W1E = (size_t)2048 * 1024;
constexpr size_t O_W2 = O_W1 + 128 * SZ_W1E, SZ_W2E = (size_t)1024 * 1024;
constexpr size_t O_HN = O_W2 + 128 * SZ_W2E, SZ_HN = (size_t)T_ * 1024 * 2;
constexpr size_t O_PROJ = O_HN + SZ_HN, SZ_PROJ = (size_t)T_ * 2048 * 2;
constexpr size_t O_Q2 = O_PROJ + SZ_PROJ, SZ_Q2 = (size_t)T_ * 768 * 2;
constexpr size_t O_KV2 = O_Q2 + SZ_Q2, SZ_KV2 = (size_t)T_ * 1024 * 2;
constexpr size_t O_OA = O_KV2 + SZ_KV2, SZ_OA = (size_t)3 * T_ * 512 * 2;
constexpr size_t O_ATT = O_OA + SZ_OA, SZ_ATT = (size_t)T_ * 1024 * 2;
constexpr size_t O_XC = O_ATT + SZ_ATT, SZ_XC = (size_t)T_ * 1024 * 2;
constexpr size_t O_AA = O_XC + SZ_XC, SZ_AA = (size_t)T_ * 1024 * 4;
constexpr size_t O_BB = O_AA + SZ_AA;
constexpr size_t O_XG = O_BB + SZ_AA, SZ_XG = (size_t)P_ * 1024 * 2, O_INV = O_XG, O_POSJ = O_XG + 4 * MiB;
constexpr size_t O_ACT = O_XG + SZ_XG, O_Y2 = O_ACT + SZ_XG;
constexpr size_t O_X = O_Y2 + SZ_XG, SZ_X = (size_t)T_ * 1024 * 2;
constexpr size_t O_DUMMY = O_X + SZ_X, SZ_DUMMY = (size_t)96 * MiB;
constexpr size_t WS_MK_END = O_DUMMY + SZ_DUMMY;
constexpr size_t O_NAIVE = (size_t)2048 * MiB;
static_assert(WS_MK_END <= O_NAIVE, "mk workspace");
constexpr int CW_BAR = 4096;
constexpr size_t O_ECNT = O_CTL + 512 * 1024;
constexpr int RING_BYTES = 131072, LDSX_OFF = RING_BYTES;
constexpr int LDS_BYTES = 147456;
constexpr int LX_TILE = LDSX_OFF + 64, LX_MISC = LDSX_OFF + 2048, LX_EXCH = LDSX_OFF + 6144, LX_GTAB = LX_EXCH, GTAB_UNITS = 10;

struct Args { const void* in[34]; float* out; unsigned char* ws; int ph_lo, ph_hi; };
struct Ctx { int tid, lane, wave, G, bid, vcu, gw, NGW; LAS unsigned char* lds; unsigned char* ws; };

__device__ __forceinline__ void conv_load(f32x4 (&v)[16], const float* __restrict__ W, int N, int n0, int k0, int lane) {
    const int n = n0 + 4 * (lane & 15); const float* p = W + (size_t)(k0 + 16 * (lane >> 4)) * N + n;
#pragma unroll
    for (int i = 0; i < 16; ++i) v[i] = (n < N) ? __builtin_nontemporal_load((const f32x4*)(p + (size_t)i * N)) : (f32x4){0.f, 0.f, 0.f, 0.f};
}
__device__ __forceinline__ int conv_row(int c, int perm) { if (perm == 1) { const int h = c / 96, d = c % 96; return d < 64 ? 64 * h + d : 512 + 32 * h + d - 64; } if (perm == 2) { const int h = c >> 7, d = c & 127; return d < 64 ? 64 * h + d : 512 + 64 * h + d - 64; } return c; }
__device__ __forceinline__ void conv_emit(const f32x4 (&v)[16], LAS unsigned char* T  , bf16_t* __restrict__ WT, int ldd, int n0, int k0, int lane, int perm) {
    const int kq = lane >> 4, c4 = lane & 15;
#pragma unroll
    for (int jj = 0; jj < 4; ++jj) { u32x4 lo, hi;
        lo.x = cvt_pk_bf16(v[0][jj], v[1][jj]); lo.y = cvt_pk_bf16(v[2][jj], v[3][jj]); lo.z = cvt_pk_bf16(v[4][jj], v[5][jj]); lo.w = cvt_pk_bf16(v[6][jj], v[7][jj]);
        hi.x = cvt_pk_bf16(v[8][jj], v[9][jj]); hi.y = cvt_pk_bf16(v[10][jj], v[11][jj]); hi.z = cvt_pk_bf16(v[12][jj], v[13][jj]); hi.w = cvt_pk_bf16(v[14][jj], v[15][jj]);
        LAS unsigned char* q = T + (4 * c4 + jj) * 144 + 32 * kq; *(LAS u32x4*)q = lo; *(LAS u32x4*)(q + 16) = hi; }
    asm volatile("s_waitcnt lgkmcnt(0)" ::: "memory");
#pragma unroll
    for (int s8 = 0; s8 < 8; ++s8) { const int n = 8 * s8 + (lane >> 3), ch = lane & 7; const u32x4 w = *(const LAS u32x4*)(T + n * 144 + 16 * ch);
        *(u32x4*)(WT + (size_t)conv_row(n0 + n, perm) * ldd + k0 + 8 * ch) = w; }
    asm volatile("s_waitcnt lgkmcnt(0)" ::: "memory");
}
__device__ __forceinline__ void conv8_tile(const float* __restrict__ W, int N, unsigned char* __restrict__ WT, int ldd, int n0, int k0, LAS unsigned char* T  , int lane) {
    const int kq = lane >> 4, c4 = lane & 15; const float* p = W + (size_t)(k0 + 32 * kq) * N + n0 + 4 * c4;
    f32x4 v[32];
#pragma unroll
    for (int i = 0; i < 32; ++i) v[i] = __builtin_nontemporal_load((const f32x4*)(p + (size_t)i * N));
#pragma unroll
    for (int jj = 0; jj < 4; ++jj) { u32x4 lo, hi;
        lo.x = pk4_fp8(32.f * v[0][jj], 32.f * v[1][jj], 32.f * v[2][jj], 32.f * v[3][jj]);     lo.y = pk4_fp8(32.f * v[4][jj], 32.f * v[5][jj], 32.f * v[6][jj], 32.f * v[7][jj]);
        lo.z = pk4_fp8(32.f * v[8][jj], 32.f * v[9][jj], 32.f * v[10][jj], 32.f * v[11][jj]);   lo.w = pk4_fp8(32.f * v[12][jj], 32.f * v[13][jj], 32.f * v[14][jj], 32.f * v[15][jj]);
        hi.x = pk4_fp8(32.f * v[16][jj], 32.f * v[17][jj], 32.f * v[18][jj], 32.f * v[19][jj]); hi.y = pk4_fp8(32.f * v[20][jj], 32.f * v[21][jj], 32.f * v[22][jj], 32.f * v[23][jj]);
        hi.z = pk4_fp8(32.f * v[24][jj], 32.f * v[25][jj], 32.f * v[26][jj], 32.f * v[27][jj]); hi.w = pk4_fp8(32.f * v[28][jj], 32.f * v[29][jj], 32.f * v[30][jj], 32.f * v[31][jj]);
        LAS unsigned char* q = T + (4 * c4 + jj) * 144 + 32 * kq; *(LAS u32x4*)q = lo; *(LAS u32x4*)(q + 16) = hi; }
    asm volatile("s_waitcnt lgkmcnt(0)" ::: "memory");
#pragma unroll
    for (int s8 = 0; s8 < 8; ++s8) { const int n = 8 * s8 + (lane >> 3), ch = lane & 7; const u32x4 w = *(const LAS u32x4*)(T + n * 144 + 16 * ch);
        *(u32x4*)(WT + (size_t)(n0 + n) * ldd + k0 + 16 * ch) = w; }
    asm volatile("s_waitcnt lgkmcnt(0)" ::: "memory");
}
template <class AP> __device__ __forceinline__ void p0_prologue(const Ctx& C, AP a) {
    unsigned char* ws = C.ws;
    { const float* c = (const float*)a->in[1]; const float* ada_w = (const float*)a->in[3]; const float* ada_b = (const float*)a->in[4]; float* mod = (float*)(ws + O_MOD);
      LAS float* part = (LAS float*)C.lds;
      LAS float* cact = (LAS float*)(C.lds + 32768);
      if (C.bid < 4 * 24) { for (int i = C.tid; i < 4096; i += 512) { const int b = i >> 10, k = i & 1023; const float cv = c[i]; cact[k * 4 + b] = cv / (1.f + expf(-cv)); } __syncthreads(); }
      for (int it = C.bid; it < 4 * 24; it += C.G) { const int l = it / 24, n0 = (it % 24) * 256;
          f32x4 acc[4];
#pragma unroll
          for (int b = 0; b < 4; ++b) acc[b] = (f32x4){0.f, 0.f, 0.f, 0.f};
          const float* w = ada_w + (size_t)l * 1024 * 6144 + n0 + 4 * C.lane;
#pragma unroll 1
          for (int k0 = C.wave * 128; k0 < C.wave * 128 + 128; k0 += 16) { f32x4 wv[16];
#pragma unroll
              for (int i = 0; i < 16; ++i) wv[i] = __builtin_nontemporal_load((const f32x4*)(w + (size_t)(k0 + i) * 6144));
#pragma unroll
              for (int i = 0; i < 16; ++i) { const f32x4 sv = *(const LAS f32x4*)(cact + (k0 + i) * 4);
#pragma unroll
                  for (int b = 0; b < 4; ++b) acc[b] = acc[b] + sv[b] * wv[i]; } }
#pragma unroll
          for (int b = 0; b < 4; ++b) *(LAS f32x4*)(part + (C.wave * 4 + b) * 256 + 4 * C.lane) = acc[b];
          __syncthreads();
          for (int o = C.tid; o < 1024; o += 512) { const int b = o >> 8, n = o & 255; float sacc = ada_b[l * 6144 + n0 + n];
#pragma unroll
              for (int w8 = 0; w8 < 8; ++w8) sacc += part[(w8 * 4 + b) * 256 + n];
              mod[((size_t)l * 4 + b) * 6144 + n0 + n] = sacc; }
          __syncthreads(); } }
    { const int* positions = (const int*)a->in[2]; float* cs = (float*)(ws + O_CS);
      for (int i = C.bid * 512 + C.tid; i < T_ * 16; i += C.G * 512) { const int t = i >> 4, f = i & 15; const float inv = powf(10000.f, -(float)(2 * f) / 32.f); const float ang = (float)positions[t] * inv;
          cs[t * 32 + f] = cosf(ang); cs[t * 32 + 16 + f] = sinf(ang); } }
    { const float* lam = (const float*)a->in[25]; float* spv = (float*)(ws + O_SPV);
      for (int i = C.bid * 512 + C.tid; i < 2048; i += C.G * 512) spv[i] = -8.f * 1.4426950408889634f * log1pf(expf(-lam[i])); }
    { const int lane = C.lane; LAS unsigned char* T = C.lds + 49152 + C.wave * 9216;
      const float* attn_w_in = (const float*)a->in[7]; const float* w_uq = (const float*)a->in[12]; const float* w_ukv = (const float*)a->in[13]; const float* attn_w_out = (const float*)a->in[16];
      const float* rec_w_in = (const float*)a->in[17]; const float* rec_wa = (const float*)a->in[21]; const float* rec_wx = (const float*)a->in[23]; const float* rec_w_out = (const float*)a->in[26];
      const float* w1 = (const float*)a->in[30]; const float* w2 = (const float*)a->in[32];
      constexpr int T_WIN = 32 * 16, T_WUQ = 12 * 4, T_WUKV = 16 * 2, T_WOUT = 16 * 16, T_RWIN = 32 * 16, T_RG = 2 * 2, T_RWOUT = 16 * 16, T_W1 = 32 * 16, T_W2 = 16 * 16;
      constexpr int NITEMS = 2 * (T_WIN + T_WUQ + T_WUKV + T_WOUT + T_RWIN + 16 * T_RG + T_RWOUT);
      struct Job { const float* W; bf16_t* WT; int N, ldd, n0, k0, perm; };
      auto decode = [&](int r, Job& jb) {
#define CONV_JOB(SRC, KK, NN, DST, NROWS, NMAT, SRC_MS, DST_MS, PERM) { constexpr int kc_ = (KK) / 64, per_ = ((NROWS) / 64) * kc_, tot_ = per_ * (NMAT); \
          if (r < tot_) { const int mat_ = r / per_, q_ = r % per_; jb.W = (SRC) + (size_t)mat_ * (SRC_MS); jb.WT = (bf16_t*)(ws + (DST) + (size_t)mat_ * (DST_MS)); jb.N = (NN); jb.ldd = (KK); jb.n0 = (q_ / kc_) * 64; jb.k0 = (q_ % kc_) * 64; jb.perm = (PERM); return; } r -= tot_; }
          CONV_JOB(attn_w_in, 1024, 1952, O_WIN, 2048, 2, (size_t)1024 * 1952, SZ_WIN, 0)
          CONV_JOB(w_uq, 256, 768, O_WUQ, 768, 2, (size_t)256 * 768, SZ_WUQ, 1)
          CONV_JOB(w_ukv, 128, 1024, O_WUKV, 1024, 2, (size_t)128 * 1024, SZ_WUKV, 2)
          CONV_JOB(attn_w_out, 1024, 1024, O_WOUT, 1024, 2, (size_t)1024 * 1024, SZ_WOUT, 0)
          CONV_JOB(rec_w_in, 1024, 2048, O_RWIN, 2048, 2, (size_t)1024 * 2048, SZ_RWIN, 0)
          CONV_JOB(rec_wa, 128, 128, O_RGATE, 128, 16, (size_t)128 * 128, (size_t)256 * 128 * 2, 0)
          CONV_JOB(rec_wx, 128, 128, O_RGATE + (size_t)128 * 128 * 2, 128, 16, (size_t)128 * 128, (size_t)256 * 128 * 2, 0)
          CONV_JOB(rec_w_out, 1024, 1024, O_RWOUT, 1024, 2, (size_t)1024 * 1024, SZ_RWOUT, 0)
#undef CONV_JOB
          jb.W = attn_w_in; jb.WT = (bf16_t*)(ws + O_WIN); jb.N = 1952; jb.ldd = 1024; jb.n0 = 0; jb.k0 = 0; jb.perm = 0; };
      f32x4 va[16], vb[16]; Job ja, jn;
      int it = C.gw;
      if (it < NITEMS) { decode(it, ja); conv_load(va, ja.W, ja.N, ja.n0, ja.k0, lane); }
#pragma unroll 1
      for (; it < NITEMS; it += 2 * C.NGW) {
          const bool h1 = it + C.NGW < NITEMS;
          if (h1) { decode(it + C.NGW, jn); conv_load(vb, jn.W, jn.N, jn.n0, jn.k0, lane); }
          conv_emit(va, T, ja.WT, ja.ldd, ja.n0, ja.k0, lane, ja.perm);
          const bool h2 = it + 2 * C.NGW < NITEMS;
          if (h2) { decode(it + 2 * C.NGW, ja); conv_load(va, ja.W, ja.N, ja.n0, ja.k0, lane); }
          if (h1) conv_emit(vb, T, jn.WT, jn.ldd, jn.n0, jn.k0, lane, jn.perm);
      }
    }
}

__device__ __forceinline__ void phase_norm(const Ctx& C, const float* xin  , float* out  , bool combine, bool do_norm, const float* gain, const float* modc  , const float* modl  , int shoff, int scoff, bool dummy = false) {
    const bf16_t* Y2 = (const bf16_t*)(C.ws + O_Y2); const int* pos = (const int*)(C.ws + O_POS); const float* topg = (const float*)(C.ws + O_TOPG); bf16_t* HN = (bf16_t*)(C.ws + (dummy ? O_DUMMY : O_HN)); const bf16_t* X = (const bf16_t*)(C.ws + O_X); bf16_t* Xo = (bf16_t*)(C.ws + (dummy ? O_DUMMY + 32 * MiB : O_X));
    const int lane = C.lane;
    for (int t = C.gw; t < T_; t += C.NGW) { const int b = t / S_;
        f32x4 v[4];
        if (xin) {
#pragma unroll
            for (int j = 0; j < 4; ++j) v[j] = *(const f32x4*)(xin + (size_t)t * 1024 + 256 * j + 4 * lane); }
        else {
#pragma unroll
            for (int j = 0; j < 4; ++j) { const u32x2 w = *(const u32x2*)(X + (size_t)t * 1024 + 256 * j + 4 * lane); v[j] = (f32x4){bf_lo(w.x), bf_hi(w.x), bf_lo(w.y), bf_hi(w.y)}; } }
        if (combine) { f32x4 y[4];
#pragma unroll
            for (int j = 0; j < 4; ++j) y[j] = (f32x4){0.f, 0.f, 0.f, 0.f};
#pragma unroll
            for (int k = 0; k < 4; ++k) { const int p = pos[t * 4 + k]; const float gk = topg[t * 4 + k];
#pragma unroll
                for (int j = 0; j < 4; ++j) { const u32x2 w = *(const u32x2*)(Y2 + (size_t)p * 1024 + 256 * j + 4 * lane);
                    y[j][0] += gk * bf_lo(w.x); y[j][1] += gk * bf_hi(w.x); y[j][2] += gk * bf_lo(w.y); y[j][3] += gk * bf_hi(w.y); } }
#pragma unroll
            for (int j = 0; j < 4; ++j) { const f32x4 g2 = *(const f32x4*)(modc + b * 6144 + 5120 + 256 * j + 4 * lane); v[j] = v[j] + g2 * y[j]; } }
        if (out) {
#pragma unroll
            for (int j = 0; j < 4; ++j) *(f32x4*)(out + (size_t)t * 1024 + 256 * j + 4 * lane) = v[j]; }
        else {
#pragma unroll
            for (int j = 0; j < 4; ++j) { u32x2 w; w.x = cvt_pk_bf16(v[j][0], v[j][1]); w.y = cvt_pk_bf16(v[j][2], v[j][3]); *(u32x2*)(Xo + (size_t)t * 1024 + 256 * j + 4 * lane) = w; } }
        if (do_norm) { float ss = 0.f;
#pragma unroll
            for (int j = 0; j < 4; ++j) ss += (v[j][0] * v[j][0] + v[j][1] * v[j][1]) + (v[j][2] * v[j][2] + v[j][3] * v[j][3]);
            const float rs = rsqrtf(wsum(ss) * (1.f / 1024.f) + 1e-6f);
#pragma unroll
            for (int j = 0; j < 4; ++j) { const int col = 256 * j + 4 * lane; const f32x4 gn = *(const f32x4*)(gain + col), sc = *(const f32x4*)(modl + b * 6144 + scoff + col), sh = *(const f32x4*)(modl + b * 6144 + shoff + col);
                const f32x4 h = v[j] * rs * gn * (1.f + sc) + sh;
                u32x2 w; w.x = cvt_pk_bf16(h[0], h[1]); w.y = cvt_pk_bf16(h[2], h[3]); *(u32x2*)(HN + (size_t)t * 1024 + col) = w; } }
    }
}

__device__ __forceinline__ void unpack8(const u32x4 w, float (&f)[8]) { f[0] = bf_lo(w.x); f[1] = bf_hi(w.x); f[2] = bf_lo(w.y); f[3] = bf_hi(w.y); f[4] = bf_lo(w.z); f[5] = bf_hi(w.z); f[6] = bf_lo(w.w); f[7] = bf_hi(w.w); }
__device__ __forceinline__ u32x4 pack8(const float (&f)[8]) { u32x4 w; w.x = cvt_pk_bf16(f[0], f[1]); w.y = cvt_pk_bf16(f[2], f[3]); w.z = cvt_pk_bf16(f[4], f[5]); w.w = cvt_pk_bf16(f[6], f[7]); return w; }

constexpr float LOG2E = 1.4426950408889634f;
__device__ __forceinline__ void phase_postproj(const Ctx& C, const float* qg, const float* kg, const float* qag, const float* kvag, const float* mkg) {
    bf16_t* PROJ = (bf16_t*)(C.ws + O_PROJ); const float* cs = (const float*)(C.ws + O_CS); const int lane = C.lane;
    for (int t = C.gw; t < T_; t += C.NGW) { bf16_t* row = PROJ + (size_t)t * 2048;
#pragma unroll
        for (int ps = 0; ps < 2; ++ps) { bf16_t* p = row + ps * 512 + 8 * lane; float f[8]; unpack8(*(const u32x4*)p, f); float ss = 0.f;
#pragma unroll
            for (int i = 0; i < 8; ++i) ss += f[i] * f[i];
            ss += shx<1>(ss); ss += shx<2>(ss); ss += shx<4>(ss);
            const float rs = rsqrtf(ss * (1.f / 64.f) + 1e-6f) * (ps == 0 ? 0.125f * LOG2E : 1.f); const float* g = (ps == 0 ? qg : kg) + 8 * (lane & 7);
#pragma unroll
            for (int i = 0; i < 8; ++i) f[i] = f[i] * rs * g[i];
            *(u32x4*)p = pack8(f); }
        { bf16_t* p = row + 1536 + 8 * lane; float f[8]; unpack8(*(const u32x4*)p, f); float ss = 0.f;
#pragma unroll
            for (int i = 0; i < 8; ++i) ss += f[i] * f[i];
            ss += shx<1>(ss); ss += shx<2>(ss);
            { const float o4 = shx<4>(ss); if (lane < 48) ss += o4; } { const float o8 = shx<8>(ss); if (lane < 48) ss += o8; } { const float o16 = shx<16>(ss); if (lane < 32) ss += o16; }
            const float nrm = lane < 32 ? 256.f : (lane < 48 ? 128.f : 32.f);
            const float rs = rsqrtf(ss / nrm + 1e-6f);
            const float* g = lane < 32 ? (qag + 8 * lane) : (lane < 48 ? (kvag + 8 * (lane - 32)) : (mkg + 64 + 8 * ((lane - 48) & 3)));
#pragma unroll
            for (int i = 0; i < 8; ++i) f[i] = f[i] * rs * g[i];
            float o[8];
#pragma unroll
            for (int i = 0; i < 8; ++i) { const float other = shx<2>(f[i]); const int fi = ((lane & 1) << 3) + i; const float cv = cs[t * 32 + fi], sv = cs[t * 32 + 16 + fi];
                o[i] = (lane & 2) ? (other * sv + f[i] * cv) : (f[i] * cv - other * sv); }
            if (lane >= 48 && lane < 52) {
#pragma unroll
                for (int i = 0; i < 8; ++i) f[i] = o[i]; }
            if (lane < 52) *(u32x4*)p = pack8(f); }
    }
}
__device__ __forceinline__ void phase_postq(const Ctx& C, const float* mqg, const float* mkg) {
    bf16_t* Q2 = (bf16_t*)(C.ws + O_Q2); bf16_t* KV2 = (bf16_t*)(C.ws + O_KV2); const float* cs = (const float*)(C.ws + O_CS); const int lane = C.lane;
    const float qscale = 0.10206207261596575f * LOG2E;
    for (int t = C.gw; t < T_; t += C.NGW) {
        { bf16_t* p = Q2 + (size_t)t * 768 + (lane >> 3) * 96 + 8 * (lane & 7); float f[8]; unpack8(*(const u32x4*)p, f); float ss = 0.f;
#pragma unroll
            for (int i = 0; i < 8; ++i) ss += f[i] * f[i];
            ss += shx<1>(ss); ss += shx<2>(ss); ss += shx<4>(ss);
            const float rs = rsqrtf(ss * (1.f / 64.f) + 1e-6f) * qscale; const float* g = mqg + 8 * (lane & 7);
#pragma unroll
            for (int i = 0; i < 8; ++i) f[i] = f[i] * rs * g[i];
            *(u32x4*)p = pack8(f); }
        { const int l2 = lane & 31; bf16_t* p = Q2 + (size_t)t * 768 + (l2 >> 2) * 96 + 64 + 8 * (l2 & 3); float f[8]; unpack8(*(const u32x4*)p, f); float ss = 0.f;
#pragma unroll
            for (int i = 0; i < 8; ++i) ss += f[i] * f[i];
            ss += shx<1>(ss); ss += shx<2>(ss);
            const float rs = rsqrtf(ss * (1.f / 32.f) + 1e-6f) * qscale; const float* g = mqg + 64 + 8 * (l2 & 3);
#pragma unroll
            for (int i = 0; i < 8; ++i) f[i] = f[i] * rs * g[i];
            float o[8];
#pragma unroll
            for (int i = 0; i < 8; ++i) { const float other = shx<2>(f[i]); const int fi = ((lane & 1) << 3) + i; const float cv = cs[t * 32 + fi], sv = cs[t * 32 + 16 + fi];
                o[i] = (lane & 2) ? (other * sv + f[i] * cv) : (f[i] * cv - other * sv); }
            if (lane < 32) *(u32x4*)p = pack8(o); }
        { bf16_t* p = KV2 + (size_t)t * 1024 + (lane >> 3) * 128 + 8 * (lane & 7); float f[8]; unpack8(*(const u32x4*)p, f); float ss = 0.f;
#pragma unroll
            for (int i = 0; i < 8; ++i) ss += f[i] * f[i];
            ss += shx<1>(ss); ss += shx<2>(ss); ss += shx<4>(ss);
            const float rs = rsqrtf(ss * (1.f / 64.f) + 1e-6f); const float* g = mkg + 8 * (lane & 7);
#pragma unroll
            for (int i = 0; i < 8; ++i) f[i] = f[i] * rs * g[i];
            *(u32x4*)p = pack8(f); }
    }
}
__device__ __forceinline__ void phase_mixcombine(const Ctx& C) {
    const bf16_t* OA = (const bf16_t*)(C.ws + O_OA); const float* LSE = (const float*)(C.ws + O_LSE); bf16_t* ATT = (bf16_t*)(C.ws + O_ATT); const int lane = C.lane;
    for (int t = C.gw; t < T_; t += C.NGW) { const int h = lane >> 3;
        float ls[3], mx = -INFINITY;
#pragma unroll
        for (int p = 0; p < 3; ++p) { ls[p] = LSE[((size_t)p * T_ + t) * 8 + h]; mx = fmaxf(mx, ls[p]); }
        float w[3], den = 0.f;
#pragma unroll
        for (int p = 0; p < 3; ++p) { w[p] = fexp2(ls[p] - mx); den += w[p]; }
        const float inv = 1.f / den; float o[8];
#pragma unroll
        for (int i = 0; i < 8; ++i) o[i] = 0.f;
#pragma unroll
        for (int p = 0; p < 3; ++p) { float f[8]; unpack8(*(const u32x4*)(OA + ((size_t)p * T_ + t) * 512 + 8 * lane), f); const float wp = w[p] * inv;
#pragma unroll
            for (int i = 0; i < 8; ++i) o[i] += wp * f[i]; }
        *(u32x4*)(ATT + (size_t)t * 1024 + 8 * lane) = pack8(o); }
}
__device__ __forceinline__ void phase_rgate(const Ctx& C, int j, const float* cw, const float* cb, const float* ba, const float* bx) {
    const bf16_t* PROJ = (const bf16_t*)(C.ws + O_PROJ); const bf16_t* RG = (const bf16_t*)(C.ws + O_RGATE + (size_t)j * SZ_RGATE); const float* spvg = (const float*)(C.ws + O_SPV) + j * 1024;
    bf16_t* LA = (bf16_t*)(C.ws + O_AA); bf16_t* Bb = (bf16_t*)(C.ws + O_BB); float* SP = (float*)(C.ws + O_SUMP); float* SH = (float*)(C.ws + O_SUMH);
    constexpr int WROW = 272;
    LAS unsigned char* Wl = C.lds;
    LAS unsigned char* Xl = C.lds + 256 * WROW;
    LAS unsigned char* Al = Xl + 64 * WROW;
    LAS unsigned char* Bl = Al + 64 * WROW;
    const int tid = C.tid, lane = C.lane, w = C.wave;
    if (C.G % 8 != 0) return;
    const int n = C.bid & 7, g = C.bid >> 3, ng = C.G >> 3;
    for (int i = tid; i < 256 * 16; i += 512) { const int r = i >> 4, c = i & 15; *(LAS u32x4*)(Wl + r * WROW + 16 * c) = *(const u32x4*)(RG + ((size_t)n * 256 + r) * 128 + 8 * c); }
    const int crow = tid >> 3, cg = tid & 7, cch = n * 128 + 16 * cg;
    float cwv[4][16], cbv[16];
#pragma unroll
    for (int q = 0; q < 4; ++q) { const f32x4 b4 = *(const f32x4*)(cb + cch + 4 * q); cbv[4 * q] = b4[0]; cbv[4 * q + 1] = b4[1]; cbv[4 * q + 2] = b4[2]; cbv[4 * q + 3] = b4[3];
#pragma unroll
        for (int k = 0; k < 4; ++k) { const f32x4 w4 = *(const f32x4*)(cw + k * 1024 + cch + 4 * q); cwv[k][4 * q] = w4[0]; cwv[k][4 * q + 1] = w4[1]; cwv[k][4 * q + 2] = w4[2]; cwv[k][4 * q + 3] = w4[3]; } }
    const int mt = w & 3, h = w >> 2, l15 = lane & 15, kg = lane >> 4;
    float bav[4], bxv[4], spv[4];
#pragma unroll
    for (int jj = 0; jj < 4; ++jj) { const int ch = n * 128 + 16 * (4 * h + jj) + l15; bav[jj] = ba[ch]; bxv[jj] = bx[ch]; spv[jj] = spvg[ch]; }
    __syncthreads();
    for (int c = g; c < 256; c += ng) { const size_t row0 = (size_t)c * 64; const int ts0 = (int)(row0 % S_);
        { float acc[16];
#pragma unroll
          for (int i = 0; i < 16; ++i) acc[i] = cbv[i];
#pragma unroll
          for (int k = 0; k < 4; ++k) { const int dt = k - 3; if (ts0 + crow + dt >= 0) { const bf16_t* src = PROJ + (row0 + crow + dt) * 2048 + 1024 + cch; float f0[8], f1[8]; unpack8(*(const u32x4*)src, f0); unpack8(*(const u32x4*)(src + 8), f1);
#pragma unroll
                  for (int i = 0; i < 8; ++i) { acc[i] += cwv[k][i] * f0[i]; acc[8 + i] += cwv[k][8 + i] * f1[i]; } } }
          float lo[8], hi8[8];
#pragma unroll
          for (int i = 0; i < 8; ++i) { lo[i] = acc[i]; hi8[i] = acc[8 + i]; }
          *(LAS u32x4*)(Xl + crow * WROW + 32 * cg) = pack8(lo); *(LAS u32x4*)(Xl + crow * WROW + 32 * cg + 16) = pack8(hi8); }
        __syncthreads();
        f32x4 acc[8];
#pragma unroll
        for (int t = 0; t < 8; ++t) acc[t] = (f32x4){0.f, 0.f, 0.f, 0.f};
#pragma unroll
        for (int ks = 0; ks < 4; ++ks) { const bf16x8 af = *(const LAS bf16x8*)(Xl + (16 * mt + l15) * WROW + 64 * ks + 16 * kg);
#pragma unroll
            for (int t = 0; t < 8; ++t) { const int nt = (t < 4) ? (4 * h + t) : (8 + 4 * h + (t - 4)); const bf16x8 bfr = *(const LAS bf16x8*)(Wl + (16 * nt + l15) * WROW + 64 * ks + 16 * kg);
                acc[t] = __builtin_amdgcn_mfma_f32_16x16x32_bf16(af, bfr, acc[t], 0, 0, 0); } }
#pragma unroll
        for (int jj = 0; jj < 4; ++jj) { const int e = 16 * (4 * h + jj) + l15;
#pragma unroll
            for (int r = 0; r < 4; ++r) { const int row = 16 * mt + 4 * kg + r; const float xc = bf_lo((unsigned)*(const LAS unsigned short*)(Xl + row * WROW + 2 * e));
                const float rr = fsigmoid(acc[jj][r] + bav[jj]), ig = fsigmoid(acc[4 + jj][r] + bxv[jj]); const float la = rr * spv[jj], av = fexp2(la);
                const float bv = __builtin_amdgcn_sqrtf(fmaxf(1.f - av * av, 0.f)) * ig * xc;
                *(LAS unsigned short*)(Al + row * WROW + 2 * e) = (unsigned short)(cvt_pk_bf16(la, la) & 0xffffu); *(LAS unsigned short*)(Bl + row * WROW + 2 * e) = (unsigned short)(cvt_pk_bf16(bv, bv) & 0xffffu); } }
        __syncthreads();
        { const size_t go = (row0 + crow) * 1024 + cch;
          *(u32x4*)(LA + go) = *(const LAS u32x4*)(Al + crow * WROW + 32 * cg); *(u32x4*)(LA + go + 8) = *(const LAS u32x4*)(Al + crow * WROW + 32 * cg + 16);
          *(u32x4*)(Bb + go) = *(const LAS u32x4*)(Bl + crow * WROW + 32 * cg); *(u32x4*)(Bb + go + 8) = *(const LAS u32x4*)(Bl + crow * WROW + 32 * cg + 16); }
        if (tid < 128) { float Pl = 0.f, Hh = 0.f;
#pragma unroll 8
            for (int r = 0; r < 64; ++r) { const float la = bf_lo((unsigned)*(const LAS unsigned short*)(Al + r * WROW + 2 * tid)), bv = bf_lo((unsigned)*(const LAS unsigned short*)(Bl + r * WROW + 2 * tid)); Hh = fexp2(la) * Hh + bv; Pl += la; }
            const int b = (int)(row0 / S_), ck = (int)((row0 % S_) >> 6); SP[((size_t)b * 64 + ck) * 1024 + n * 128 + tid] = fexp2(Pl); SH[((size_t)b * 64 + ck) * 1024 + n * 128 + tid] = Hh; }
        __syncthreads();
    }
}

__device__ __forceinline__ void scan_sum_item(const Ctx& C, int b, int ck, int cg) {
    const bf16_t* LA = (const bf16_t*)(C.ws + O_AA); const bf16_t* Bb = (const bf16_t*)(C.ws + O_BB); float* SP = (float*)(C.ws + O_SUMP); float* SH = (float*)(C.ws + O_SUMH);
    const int ch = cg * 128 + 2 * C.lane;
    size_t off = ((size_t)b * S_ + ck * 64) * 1024 + ch; f32x2 Pl = (f32x2){0.f, 0.f}, Hh = (f32x2){0.f, 0.f};
#pragma unroll 8
    for (int s = 0; s < 64; ++s, off += 1024) { const unsigned lw = *(const unsigned*)(LA + off), bw = *(const unsigned*)(Bb + off);
        const f32x2 lv = (f32x2){bf_lo(lw), bf_hi(lw)}, av = (f32x2){fexp2(lv[0]), fexp2(lv[1])}, bv = (f32x2){bf_lo(bw), bf_hi(bw)}; Hh = av * Hh + bv; Pl = Pl + lv; }
    *(f32x2*)(SP + ((size_t)b * 64 + ck) * 1024 + ch) = (f32x2){fexp2(Pl[0]), fexp2(Pl[1])}; *(f32x2*)(SH + ((size_t)b * 64 + ck) * 1024 + ch) = Hh;
}
__device__ __forceinline__ void phase_scan_sum_own(const Ctx& C) {
    asm volatile("s_waitcnt vmcnt(0)" ::: "memory"); __syncthreads();
    for (int i = 0; ; ++i) { const int L = i * C.G + C.bid; if (L >= 512) break; const int pm = L >> 3, n = L & 7;
        if (C.wave < 4) { const int row0 = pm * 256 + C.wave * 64; scan_sum_item(C, row0 / S_, (row0 % S_) >> 6, n); } }
}
__device__ __forceinline__ void phase_scan_apply(const Ctx& C) {
    const bf16_t* LA = (const bf16_t*)(C.ws + O_AA); const bf16_t* Bb = (const bf16_t*)(C.ws + O_BB); const float* SP = (const float*)(C.ws + O_SUMP); const float* SH = (const float*)(C.ws + O_SUMH);
    const bf16_t* PROJ = (const bf16_t*)(C.ws + O_PROJ); bf16_t* ATT = (bf16_t*)(C.ws + O_ATT); const int lane = C.lane;
    for (int it = C.gw; it < 4 * 64 * 8; it += C.NGW) { const int cg = it & 7, ck = (it >> 3) & 63, b = it >> 9; const int ch = cg * 128 + 2 * lane;
        f32x2 h = (f32x2){0.f, 0.f};
#pragma unroll 8
        for (int c2 = 0; c2 < ck; ++c2) { const f32x2 pv = *(const f32x2*)(SP + ((size_t)b * 64 + c2) * 1024 + ch), hv = *(const f32x2*)(SH + ((size_t)b * 64 + c2) * 1024 + ch); h = pv * h + hv; }
        size_t row = (size_t)b * S_ + ck * 64;
#pragma unroll 8
        for (int s = 0; s < 64; ++s, ++row) { const unsigned lw = *(const unsigned*)(LA + row * 1024 + ch), bw = *(const unsigned*)(Bb + row * 1024 + ch);
            const f32x2 av = (f32x2){fexp2(bf_lo(lw)), fexp2(bf_hi(lw))}, bv = (f32x2){bf_lo(bw), bf_hi(bw)}; h = av * h + bv;
            const unsigned gw2 = *(const unsigned*)(PROJ + row * 2048 + ch);
            *(unsigned*)(ATT + row * 1024 + ch) = cvt_pk_bf16(bf_lo(gw2) * h[0], bf_hi(gw2) * h[1]); } }
}

__device__ __forceinline__ void split_bf16(const f32x4 a, const f32x4 b, bf16x8& hi, bf16x8& lo) {
    u32x4 h; h.x = cvt_pk_bf16(a[0], a[1]); h.y = cvt_pk_bf16(a[2], a[3]); h.z = cvt_pk_bf16(b[0], b[1]); h.w = cvt_pk_bf16(b[2], b[3]);
    u32x4 l; l.x = cvt_pk_bf16(a[0] - bf_lo(h.x), a[1] - bf_hi(h.x)); l.y = cvt_pk_bf16(a[2] - bf_lo(h.y), a[3] - bf_hi(h.y)); l.z = cvt_pk_bf16(b[0] - bf_lo(h.z), b[1] - bf_hi(h.z)); l.w = cvt_pk_bf16(b[2] - bf_lo(h.w), b[3] - bf_hi(h.w));
    hi = __builtin_bit_cast(bf16x8, h); lo = __builtin_bit_cast(bf16x8, l);
}
__device__ __forceinline__ void phase_router(const Ctx& C, const bf16_t* X, const float* gain, const float* modl, const float* wr, const float* br, int layer) {
    unsigned char* HN8 = C.ws + O_HN; int* topi = (int*)(C.ws + O_TOPI); float* topg = (float*)(C.ws + O_TOPG); int* ecnt = (int*)(C.ws + O_ECNT) + layer * 32; int* inv = (int*)(C.ws + O_INV); int* posj = (int*)(C.ws + O_POSJ);
    LAS int* rk = (LAS int*)(C.lds + LX_MISC + 3072); LAS int* base = (LAS int*)(C.lds + LX_MISC + 512);
    constexpr int HROW = 1028;
    LAS float* hrow = (LAS float*)C.lds;
    LAS float* part = (LAS float*)(C.lds + 16 * HROW * 4);
    LAS int* hl = (LAS int*)(C.lds + LX_MISC);
    const int lane = C.lane, e = lane & 31, kh = lane >> 5, v = C.wave, l15 = lane & 15, kg = lane >> 4;
    bf16x8 whi[2][4], wlo[2][4];
#pragma unroll
    for (int nt = 0; nt < 2; ++nt)
#pragma unroll
        for (int ks = 0; ks < 4; ++ks) { const float* p = wr + (size_t)(128 * v + 32 * ks + 8 * kg) * 32 + 16 * nt + l15;
            const f32x4 a = (f32x4){p[0], p[32], p[64], p[96]}, b = (f32x4){p[128], p[160], p[192], p[224]}; split_bf16(a, b, whi[nt][ks], wlo[nt][ks]); }
    const float bias_e = br[e];
    if (C.tid < 32) hl[C.tid] = 0;
    __syncthreads();
    for (int ck = C.bid; ck < 256; ck += C.G) {
        const int b = (ck * 64) / S_;
        f32x4 gn[4], shv[4];
#pragma unroll
        for (int j = 0; j < 4; ++j) { const int col = 256 * j + 4 * lane; gn[j] = *(const f32x4*)(gain + col) * (1.f + *(const f32x4*)(modl + b * 6144 + 4096 + col)); shv[j] = *(const f32x4*)(modl + b * 6144 + 3072 + col); }
        u32x2 xr[2][4];
#pragma unroll
        for (int q = 0; q < 2; ++q)
#pragma unroll
            for (int j = 0; j < 4; ++j) xr[q][j] = *(const u32x2*)(X + (size_t)(ck * 64 + 2 * v + q) * 1024 + 256 * j + 4 * lane);
#pragma unroll 1
        for (int pass = 0; pass < 4; ++pass) { const int tb = ck * 64 + pass * 16;
#pragma unroll
            for (int q = 0; q < 2; ++q) { const int tt = 2 * v + q, t = tb + tt; f32x4 h[4]; float ss = 0.f;
#pragma unroll
                for (int j = 0; j < 4; ++j) { const u32x2 xw = xr[q][j]; h[j] = (f32x4){bf_lo(xw.x), bf_hi(xw.x), bf_lo(xw.y), bf_hi(xw.y)}; ss += (h[j][0] * h[j][0] + h[j][1] * h[j][1]) + (h[j][2] * h[j][2] + h[j][3] * h[j][3]); }
                const float rs = rsqrtf(wsum(ss) * (1.f / 1024.f) + 1e-6f);
#pragma unroll
                for (int j = 0; j < 4; ++j) { const int col = 256 * j + 4 * lane;
                    const f32x4 hv = h[j] * rs * gn[j] + shv[j];
                    *(unsigned*)(HN8 + (size_t)t * 1024 + col) = pk4_fp8(hv[0], hv[1], hv[2], hv[3]);
                    *(LAS f32x4*)(hrow + tt * HROW + col) = hv; } }
            if (pass < 3) {
#pragma unroll
                for (int q = 0; q < 2; ++q)
#pragma unroll
                    for (int j = 0; j < 4; ++j) xr[q][j] = *(const u32x2*)(X + (size_t)(tb + 16 + 2 * v + q) * 1024 + 256 * j + 4 * lane); }
            __syncthreads();
            { f32x4 acc0 = (f32x4){0.f, 0.f, 0.f, 0.f}, acc1 = acc0;
#pragma unroll
              for (int ks = 0; ks < 4; ++ks) { const LAS float* hp = hrow + l15 * HROW + 128 * v + 32 * ks + 8 * kg; bf16x8 ahi, alo; split_bf16(*(const LAS f32x4*)hp, *(const LAS f32x4*)(hp + 4), ahi, alo);
                  acc0 = __builtin_amdgcn_mfma_f32_16x16x32_bf16(ahi, whi[0][ks], acc0, 0, 0, 0); acc1 = __builtin_amdgcn_mfma_f32_16x16x32_bf16(ahi, whi[1][ks], acc1, 0, 0, 0);
                  acc0 = __builtin_amdgcn_mfma_f32_16x16x32_bf16(ahi, wlo[0][ks], acc0, 0, 0, 0); acc1 = __builtin_amdgcn_mfma_f32_16x16x32_bf16(ahi, wlo[1][ks], acc1, 0, 0, 0);
                  acc0 = __builtin_amdgcn_mfma_f32_16x16x32_bf16(alo, whi[0][ks], acc0, 0, 0, 0); acc1 = __builtin_amdgcn_mfma_f32_16x16x32_bf16(alo, whi[1][ks], acc1, 0, 0, 0); }
#pragma unroll
              for (int r = 0; r < 4; ++r) { part[((4 * kg + r) * 8 + v) * 32 + l15] = acc0[r]; part[((4 * kg + r) * 8 + v) * 32 + 16 + l15] = acc1[r]; } }
            __syncthreads();
            { const int tt = 2 * v + kh; float lg = bias_e;
#pragma unroll
              for (int w8 = 0; w8 < 8; ++w8) lg += part[(tt * 8 + w8) * 32 + e];
              int idx[4]; float val[4];
#pragma unroll
              for (int k = 0; k < 4; ++k) { float mx = lg;
                  mx = fmaxf(mx, shx<1>(mx)); mx = fmaxf(mx, shx<2>(mx)); mx = fmaxf(mx, shx<4>(mx)); mx = fmaxf(mx, shx<8>(mx)); mx = fmaxf(mx, shx<16>(mx));
                  const unsigned long long bal = __ballot(lg == mx); const unsigned bh = (unsigned)(bal >> (32 * kh)); const int sel = __ffs((int)bh) - 1;
                  idx[k] = sel; val[k] = mx; if (e == sel) lg = -INFINITY; }
              if (e == 0) { const int t = tb + tt; float ex[4], den = 0.f;
#pragma unroll
                  for (int k = 0; k < 4; ++k) { ex[k] = expf(val[k] - val[0]); den += ex[k]; }
#pragma unroll
                  for (int k = 0; k < 4; ++k) { topi[t * 4 + k] = idx[k]; topg[t * 4 + k] = ex[k] / den; const int r = __hip_atomic_fetch_add(hl + idx[k], 1, __ATOMIC_RELAXED, __HIP_MEMORY_SCOPE_WORKGROUP); rk[(pass * 16 + tt) * 4 + k] = (idx[k] << 8) | r; } } }
        }
        __syncthreads();
        if (C.tid < 32) { base[C.tid] = __hip_atomic_fetch_add(ecnt + C.tid, hl[C.tid], __ATOMIC_RELAXED, __HIP_MEMORY_SCOPE_AGENT); hl[C.tid] = 0; }
        __syncthreads();
        if (C.tid < 256) { const int pk = rk[C.tid], ex = pk >> 8, j = base[ex] + (pk & 255); inv[ex * 16384 + j] = ck * 64 + (C.tid >> 2); posj[ck * 256 + C.tid] = j; }
        __syncthreads();
    }
}
__device__ __forceinline__ void moe_plan_lds(const Ctx& C, int layer) {
    const int* ecnt = (const int*)(C.ws + O_ECNT) + layer * 32;
    LAS int* tot = (LAS int*)(C.lds + LX_MISC + 256); LAS int* pst = tot + 32; LAS int* tile_e = (LAS int*)(C.lds + LX_TILE); LAS int* ntp = (LAS int*)(C.lds + LX_MISC + 128);
    __syncthreads();
    if (C.tid < 32) tot[C.tid] = __hip_atomic_load(ecnt + C.tid, __ATOMIC_RELAXED, __HIP_MEMORY_SCOPE_AGENT);
    __syncthreads();
    { const int e = C.tid & 31, sub = C.tid >> 5; int acc = 0;
#pragma unroll
      for (int x = 0; x < 32; x += 4) { const LAS int* tp = tot + x; const int t0 = tp[0], t1 = tp[1], t2 = tp[2], t3 = tp[3];
          acc += (x < e ? ((t0 + 255) & ~255) : 0) + (x + 1 < e ? ((t1 + 255) & ~255) : 0) + (x + 2 < e ? ((t2 + 255) & ~255) : 0) + (x + 3 < e ? ((t3 + 255) & ~255) : 0); }
      const int mine = (tot[e] + 255) >> 8, first = acc >> 8;
      if (sub == 0) { pst[e] = acc; if (e == 31) ntp[0] = first + mine; }
      for (int i = sub; i < mine; i += 16) tile_e[first + i] = e; }
    __syncthreads();
}
#ifndef ATT_DUP
#define ATT_DUP 1
#endif

__device__ __forceinline__ s16x4 tr16(LAS const unsigned char* p) { typedef short v4i16_t __attribute__((ext_vector_type(4))); return __builtin_bit_cast(s16x4, __builtin_amdgcn_ds_read_tr16_b64_v4i16((LAS v4i16_t*)p)); }

__device__ __forceinline__ float max3f(float a, float b, float c) { return fmaxf(fmaxf(a, b), c); }
#ifndef ATT_THR_V
#define ATT_THR_V 10.f
#endif
constexpr float ATT_THR = ATT_THR_V;
template <int KS, bool DIL>
__device__ __forceinline__ void att_tile(LAS const unsigned char* kb, LAS const unsigned char* vb, const bf16x8 (&qf)[KS], f32x16& o0, f32x16& o1, f32x16& negm, float& mref, float& l, int kidx0, int qidx, bool need_mask, int lane) {
    constexpr int KROW = KS * 32 + 16, VROW = 144;
    const int i32 = lane & 31, hi = lane >> 5;
    const int pr = (i32 & 0x13) | ((i32 & 4) << 1) | ((i32 & 8) >> 1);
    f32x16 p0, p1;
    LAS const unsigned char* kp = kb + pr * KROW + hi * 16;
#ifndef QK_DUP
#define QK_DUP 1
#endif
#pragma unroll 1
    for (int qd_ = 0; qd_ < QK_DUP; ++qd_) {
#pragma unroll
    for (int ks = 0; ks < KS; ++ks) {
        const bf16x8 k0f = *(LAS const bf16x8*)(kp + ks * 32), k1f = *(LAS const bf16x8*)(kp + 32 * KROW + ks * 32);
        if (ks == 0) { p0 = __builtin_amdgcn_mfma_f32_32x32x16_bf16(k0f, qf[0], negm, 0, 0, 0); p1 = __builtin_amdgcn_mfma_f32_32x32x16_bf16(k1f, qf[0], negm, 0, 0, 0); }
        else { p0 = __builtin_amdgcn_mfma_f32_32x32x16_bf16(k0f, qf[ks], p0, 0, 0, 0); p1 = __builtin_amdgcn_mfma_f32_32x32x16_bf16(k1f, qf[ks], p1, 0, 0, 0); }
    }
    asm volatile("" : "+v"(p0), "+v"(p1));
    }
    if (need_mask) {
#pragma unroll
        for (int r = 0; r < 16; ++r) { const int d0 = qidx - (kidx0 + 16 * (r >> 3) + 8 * hi + (r & 7)), d1 = d0 - 32;
            const bool v0 = DIL ? (d0 >= 0 && d0 <= 128) : (d0 >= 0), v1 = DIL ? (d1 >= 0 && d1 <= 128) : (d1 >= 0);
            p0[r] = v0 ? p0[r] : -INFINITY; p1[r] = v1 ? p1[r] : -INFINITY; } }
    float mx = max3f(p0[0], p0[1], p1[0]), mb = max3f(p0[2], p0[3], p1[1]); mx = max3f(mx, p1[2], p1[3]);
#pragma unroll
    for (int r = 4; r < 16; r += 4) { mx = max3f(mx, p0[r], p0[r + 1]); mb = max3f(mb, p0[r + 2], p0[r + 3]); mx = max3f(mx, p1[r], p1[r + 1]); mb = max3f(mb, p1[r + 2], p1[r + 3]); }
    mx = xmax32(fmaxf(mx, mb));
    if (__builtin_expect(__any(mx > ATT_THR), 0)) {
        const float dl = fmaxf(mx, 0.f), f = fexp2(-dl);
        mref += dl; l *= f;
#pragma unroll
        for (int r = 0; r < 16; ++r) { o0[r] *= f; o1[r] *= f; p0[r] -= dl; p1[r] -= dl; negm[r] = -mref; } }
    float ls0 = 0.f, ls1 = 0.f;
#pragma unroll
    for (int r = 0; r < 16; ++r) { p0[r] = fexp2(p0[r]); p1[r] = fexp2(p1[r]); ls0 += p0[r]; ls1 += p1[r]; }
    l += ls0 + ls1;
    u32x4 pw[2][2];
#pragma unroll
    for (int s = 0; s < 2; ++s) {
        pw[0][s].x = cvt_pk_bf16(p0[8 * s + 0], p0[8 * s + 1]); pw[0][s].y = cvt_pk_bf16(p0[8 * s + 2], p0[8 * s + 3]); pw[0][s].z = cvt_pk_bf16(p0[8 * s + 4], p0[8 * s + 5]); pw[0][s].w = cvt_pk_bf16(p0[8 * s + 6], p0[8 * s + 7]);
        pw[1][s].x = cvt_pk_bf16(p1[8 * s + 0], p1[8 * s + 1]); pw[1][s].y = cvt_pk_bf16(p1[8 * s + 2], p1[8 * s + 3]); pw[1][s].z = cvt_pk_bf16(p1[8 * s + 4], p1[8 * s + 5]); pw[1][s].w = cvt_pk_bf16(p1[8 * s + 6], p1[8 * s + 7]); }
    const int g = lane >> 4, i16 = lane & 15;
    LAS const unsigned char* vp = vb + (8 * (g >> 1) + (i16 >> 2)) * VROW + (16 * (g & 1) + 4 * (i16 & 3)) * 2;
#pragma unroll
    for (int sub = 0; sub < 2; ++sub)
#pragma unroll
        for (int s = 0; s < 2; ++s) { const bf16x8 pf = __builtin_bit_cast(bf16x8, pw[sub][s]);
#pragma unroll
            for (int db = 0; db < 2; ++db) { LAS const unsigned char* av = vp + (32 * sub + 16 * s) * VROW + 64 * db;
                const s16x4 lo = tr16(av), hh = tr16(av + 4 * VROW);
                const bf16x8 vf = (bf16x8){lo[0], lo[1], lo[2], lo[3], hh[0], hh[1], hh[2], hh[3]};
                if (db == 0) o0 = __builtin_amdgcn_mfma_f32_32x32x16_bf16(vf, pf, o0, 0, 0, 0); else o1 = __builtin_amdgcn_mfma_f32_32x32x16_bf16(vf, pf, o1, 0, 0, 0); } }
}
__device__ __forceinline__ void att_store(bf16_t* orow  , const f32x16& o0, const f32x16& o1, float inv, int hi) {
#pragma unroll
    for (int rr = 0; rr < 4; ++rr) { u32x2 w0, w1;
        w0.x = cvt_pk_bf16(o0[4 * rr] * inv, o0[4 * rr + 1] * inv); w0.y = cvt_pk_bf16(o0[4 * rr + 2] * inv, o0[4 * rr + 3] * inv);
        w1.x = cvt_pk_bf16(o1[4 * rr] * inv, o1[4 * rr + 1] * inv); w1.y = cvt_pk_bf16(o1[4 * rr + 2] * inv, o1[4 * rr + 3] * inv);
        *(u32x2*)(orow + 8 * rr + 4 * hi) = w0; *(u32x2*)(orow + 32 + 8 * rr + 4 * hi) = w1; }
}


struct BgConv {
    const float* w1; const float* w2; unsigned char* ws; LAS unsigned char* T;
    int pair, it, nit, step, sub;
    bool pendA, pendB; int psubA, psubB; unsigned char* pWTA; unsigned char* pWTB;
    f32x4 vA[4], vB[4];
};
__device__ __forceinline__ void bg_tile(const BgConv& S, int it, const float*& W, int& N, unsigned char*& WT, int& n0, int& k0) {
    constexpr int I1 = 32 * 8, I2 = 16 * 8, N1 = 64 * I1;
    if (it < N1) { const int mat = S.pair * 64 + it / I1, q = it % I1; W = S.w1 + (size_t)mat * 1024 * 2048; WT = S.ws + O_W1 + (size_t)mat * SZ_W1E; N = 2048; n0 = (q >> 3) * 64; k0 = (q & 7) * 128; }
    else { const int r = it - N1, mat = S.pair * 64 + r / I2, q = r % I2; W = S.w2 + (size_t)mat * 1024 * 1024; WT = S.ws + O_W2 + (size_t)mat * SZ_W2E; N = 1024; n0 = (q >> 3) * 64; k0 = (q & 7) * 128; }
}
__device__ __forceinline__ void bg_init(BgConv& S, const Ctx& C, const float* w1, const float* w2, int pair) {
    S.w1 = w1; S.w2 = w2; S.ws = C.ws; S.T = C.lds + 49152 + C.wave * 9216; S.pair = pair; S.it = C.gw; S.nit = 64 * 256 + 64 * 128; S.step = C.NGW; S.sub = 0;
    S.pendA = false; S.pendB = false; S.psubA = 0; S.psubB = 0; S.pWTA = C.ws; S.pWTB = C.ws;
}
__device__ __forceinline__ bool bg_done(const BgConv& S) { return !S.pendA && !S.pendB && S.it >= S.nit; }
__device__ __forceinline__ void bg_half(BgConv& S, f32x4 (&v)[4], bool& pend, int& psub, unsigned char*& pWT, int lane) {
    const int kq = lane >> 4, c4 = lane & 15;
    if (pend) {
#pragma unroll
        for (int jj = 0; jj < 4; ++jj) *(LAS unsigned*)(S.T + (4 * c4 + jj) * 144 + 32 * kq + 4 * psub) = pk4_fp8(32.f * v[0][jj], 32.f * v[1][jj], 32.f * v[2][jj], 32.f * v[3][jj]);
        if (psub == 7) {
            asm volatile("s_waitcnt lgkmcnt(0)" ::: "memory");
#pragma unroll
            for (int s8 = 0; s8 < 8; ++s8) { const int n = 8 * s8 + (lane >> 3), ch = lane & 7; const u32x4 w = *(const LAS u32x4*)(S.T + n * 144 + 16 * ch);
                *(u32x4*)(pWT + (size_t)n * 1024 + 16 * ch) = w; }
            asm volatile("s_waitcnt lgkmcnt(0)" ::: "memory"); }
        pend = false; }
    if (S.it < S.nit) { const float* W; int N, n0, k0; unsigned char* WT; bg_tile(S, S.it, W, N, WT, n0, k0);
        const float* p = W + (size_t)(k0 + 32 * kq + 4 * S.sub) * N + n0 + 4 * c4;
#pragma unroll
        for (int i = 0; i < 4; ++i) v[i] = __builtin_nontemporal_load((const f32x4*)(p + (size_t)i * N));
        pend = true; psub = S.sub; pWT = WT + (size_t)n0 * 1024 + k0;
        if (++S.sub == 8) { S.sub = 0; S.it += S.step; } }
}
#define BG_STEP_A() bg_half(BG, BG.vA, BG.pendA, BG.psubA, BG.pWTA, lane)
#define BG_STEP_B() bg_half(BG, BG.vB, BG.pendB, BG.psubB, BG.pWTB, lane)

__device__ __forceinline__ void mla_unit(const Ctx& C, BgConv& BG, int b, int h, int qb) {
    constexpr int KROW = 208, VROW = 144, KB = 64 * KROW, BUF = KB + 64 * VROW;
    const bf16_t* Q2 = (const bf16_t*)(C.ws + O_Q2); const bf16_t* KV2 = (const bf16_t*)(C.ws + O_KV2); const bf16_t* PROJ = (const bf16_t*)(C.ws + O_PROJ); bf16_t* ATT = (bf16_t*)(C.ws + O_ATT);
    const int tid = C.tid, lane = C.lane, w = C.wave, i32 = lane & 31, hi = lane >> 5;
    const int q0 = qb * 256; const size_t rowb = (size_t)b * S_;
    bf16x8 qf[6];
    { const bf16_t* qrow = Q2 + (rowb + q0 + 32 * w + i32) * 768 + 8 * hi;
#pragma unroll
      for (int ks = 0; ks < 4; ++ks) qf[ks] = *(const bf16x8*)(qrow + h * 64 + 16 * ks);
      qf[4] = *(const bf16x8*)(qrow + 512 + h * 32); qf[5] = *(const bf16x8*)(qrow + 512 + h * 32 + 16); }
    f32x16 o0, o1;
#pragma unroll
    for (int r = 0; r < 16; ++r) { o0[r] = 0.f; o1[r] = 0.f; }
    float m = 0.f, l = 0.f; f32x16 negm;
#pragma unroll
    for (int r = 0; r < 16; ++r) negm[r] = 0.f;
    const int NT = 4 * qb + 4, wmax = 4 * qb + (w >> 1);
    const int r8 = tid >> 3, c8 = tid & 7, r4 = (tid & 255) >> 2, c4 = tid & 3;
    const bf16_t* knp = KV2 + (rowb + r8) * 1024 + h * 64 + 8 * c8; const bf16_t* kpp = PROJ + (rowb + r4) * 2048 + 1920 + 8 * c4;
    u32x4 kA, vA, pA, kB, vB, pB;
#define MLA_LOAD(j, K, V, P) do { const int jc_ = ((j) < NT) ? (j) : NT - 1; K = *(const u32x4*)(knp + (size_t)jc_ * 64 * 1024); V = *(const u32x4*)(knp + (size_t)jc_ * 64 * 1024 + 512); P = *(const u32x4*)(kpp + (size_t)jc_ * 64 * 2048); } while (0)
#define MLA_WRITE(bo, K, V, P) do { *(LAS u32x4*)(C.lds + (bo) + r8 * KROW + 16 * c8) = K; *(LAS u32x4*)(C.lds + (bo) + KB + r8 * VROW + 16 * c8) = V; *(LAS u32x4*)(C.lds + (bo) + r4 * KROW + 128 + 16 * c4) = P; } while (0)
#define MLA_STEP(j, KF, VF, PF, KN, VN, PN, BGS) do { const int j_ = (j); const int bo_ = (j_ & 1) * BUF; \
        MLA_LOAD(j_ + 2, KF, VF, PF); BGS(); \
        if (j_ <= wmax) { _Pragma("unroll 1") for (int dup_ = 0; dup_ < ATT_DUP; ++dup_) att_tile<6, false>(C.lds + bo_, C.lds + bo_ + KB, qf, o0, o1, negm, m, l, 64 * j_, q0 + 32 * w + i32, j_ == wmax, lane); } \
        MLA_WRITE(BUF - bo_, KN, VN, PN); \
        __syncthreads(); } while (0)
    MLA_LOAD(0, kA, vA, pA); MLA_LOAD(1, kB, vB, pB);
    MLA_WRITE(0, kA, vA, pA);
    __syncthreads();
#pragma unroll 1
    for (int j = 0; j < NT; j += 2) { MLA_STEP(j, kA, vA, pA, kB, vB, pB, BG_STEP_A); MLA_STEP(j + 1, kB, vB, pB, kA, vA, pA, BG_STEP_B); }
#undef MLA_STEP
#undef MLA_LOAD
#undef MLA_WRITE
    l = xadd32(l);
    att_store(ATT + (rowb + q0 + 32 * w + i32) * 1024 + 512 + h * 64, o0, o1, 1.f / l, hi);
}
__device__ __forceinline__ void dil_unit(const Ctx& C, BgConv& BG, int p, int dd, int b, int h, int res, int n) {
    constexpr int KROW = 144, VROW = 144, KB = 64 * KROW, BUF = KB + 64 * VROW;
    const bf16_t* PROJ = (const bf16_t*)(C.ws + O_PROJ); bf16_t* OA = (bf16_t*)(C.ws + O_OA) + (size_t)p * T_ * 512; float* LSE = (float*)(C.ws + O_LSE) + (size_t)p * T_ * 8;
    const int tid = C.tid, lane = C.lane, w = C.wave, i32 = lane & 31, hi = lane >> 5;
    const size_t rowb = (size_t)b * S_;
    const int qsub = 256 * n + 32 * w + i32; const size_t qtok = rowb + (size_t)qsub * dd + res;
    bf16x8 qf[4];
    { const bf16_t* qrow = PROJ + qtok * 2048 + h * 64 + 8 * hi;
#pragma unroll
      for (int ks = 0; ks < 4; ++ks) qf[ks] = *(const bf16x8*)(qrow + 16 * ks); }
    f32x16 o0, o1;
#pragma unroll
    for (int r = 0; r < 16; ++r) { o0[r] = 0.f; o1[r] = 0.f; }
    float m = 0.f, l = 0.f; f32x16 negm;
#pragma unroll
    for (int r = 0; r < 16; ++r) negm[r] = 0.f;
    const int jbeg = (n == 0) ? 2 : 0, wlo = w >> 1, whi = (32 * w + 159) >> 6;
    const int r8 = tid >> 3, c8 = tid & 7;
    u32x4 kA, vA, kB, vB;
    const int cnt = 6 - jbeg;
#define DIL_LOAD(i, K, V) do { const int jc_ = jbeg + (((i) < cnt) ? (i) : cnt - 1); const size_t tok = rowb + (size_t)(256 * n - 128 + 64 * jc_ + r8) * dd + res; const bf16_t* src = PROJ + tok * 2048 + 512 + h * 64 + 8 * c8; K = *(const u32x4*)src; V = *(const u32x4*)(src + 512); } while (0)
#define DIL_WRITE(bo, K, V) do { *(LAS u32x4*)(C.lds + (bo) + r8 * KROW + 16 * c8) = K; *(LAS u32x4*)(C.lds + (bo) + KB + r8 * VROW + 16 * c8) = V; } while (0)
#define DIL_STEP(i, KF, VF, KN, VN, BGS) do { const int i_ = (i); const int bo_ = (i_ & 1) * BUF, j_ = jbeg + i_; \
        DIL_LOAD(i_ + 2, KF, VF); BGS(); \
        if (i_ < cnt && j_ >= wlo && j_ <= whi) { const int kb0_ = 256 * n - 128 + 64 * j_, qlo_ = 256 * n + 32 * w; _Pragma("unroll 1") for (int dup_ = 0; dup_ < ATT_DUP; ++dup_) att_tile<4, true>(C.lds + bo_, C.lds + bo_ + KB, qf, o0, o1, negm, m, l, kb0_, qsub, !(kb0_ + 63 <= qlo_ && qlo_ + 31 - kb0_ <= 128), lane); } \
        DIL_WRITE(BUF - bo_, KN, VN); \
        __syncthreads(); } while (0)
    DIL_LOAD(0, kA, vA); DIL_LOAD(1, kB, vB);
    DIL_WRITE(0, kA, vA);
    __syncthreads();
    DIL_STEP(0, kA, vA, kB, vB, BG_STEP_A); DIL_STEP(1, kB, vB, kA, vA, BG_STEP_B); DIL_STEP(2, kA, vA, kB, vB, BG_STEP_A); DIL_STEP(3, kB, vB, kA, vA, BG_STEP_B);
    if (cnt == 6) { DIL_STEP(4, kA, vA, kB, vB, BG_STEP_A); DIL_STEP(5, kB, vB, kA, vA, BG_STEP_B); }
#undef DIL_STEP
#undef DIL_LOAD
#undef DIL_WRITE
    l = xadd32(l);
    att_store(OA + qtok * 512 + h * 64, o0, o1, 1.f / l, hi);
    if (hi == 0) LSE[qtok * 8 + h] = m + log2f(l);
}
#ifndef REP_MLA
#define REP_MLA 1
#endif
#ifndef REP_DIL
#define REP_DIL 1
#endif
__device__ __forceinline__ void phase_attention(const Ctx& C, const float* w1, const float* w2, int pair) {
    BgConv BG; bg_init(BG, C, w1, w2, pair);
#pragma unroll 1
    for (int rep = 0; rep < REP_MLA; ++rep) {
    if (C.G == 256) { const int bh = C.vcu >> 3, s = C.vcu & 7; mla_unit(C, BG, bh >> 3, bh & 7, s); mla_unit(C, BG, bh >> 3, bh & 7, 15 - s); }
    else for (int u = C.bid; u < 512; u += C.G) mla_unit(C, BG, u >> 7, (u >> 4) & 7, u & 15);
    }
#pragma unroll 1
    for (int rep = 0; rep < REP_DIL; ++rep)
    for (int u = C.bid; u < 1536; u += C.G) { const int p = u >> 9, rem = u & 511, b = rem >> 7, h = (rem >> 4) & 7, blk = rem & 15;
        const int dd = (p == 0) ? 1 : (p == 1) ? 4 : 16, bpr = 16 / dd;
        dil_unit(C, BG, p, dd, b, h, blk / bpr, blk % bpr); }
    { const int lane = C.lane;
#pragma unroll 1
      while (!bg_done(BG)) { BG_STEP_A(); BG_STEP_B(); } }
}
#undef BG_STEP_A
#undef BG_STEP_B

#ifdef TIME_NORM
constexpr int N_PHASES = 42;
#else
constexpr int N_PHASES = 36;
#endif
extern __shared__ __attribute__((aligned(16))) unsigned char lds_raw[];
typedef const __attribute__((address_space(4))) Args* ArgsP;
#define PHFN static __device__ __forceinline__ void
__device__ __forceinline__ ArgsP fresh_args() { unsigned long long p = (unsigned long long)__builtin_amdgcn_kernarg_segment_ptr(); asm volatile("" : "+s"(p)); return (ArgsP)p; }
__device__ __forceinline__ Ctx make_ctx(ArgsP ap, int wv) {
    Ctx C; C.lds = (LAS unsigned char*)lds_raw; C.ws = ap->ws;
    unsigned ones = ~0u; asm volatile("" : "+s"(ones)); const int lane = (int)__builtin_amdgcn_mbcnt_hi(ones, __builtin_amdgcn_mbcnt_lo(ones, 0u));
    int bid = blockIdx.x; asm volatile("" : "+s"(bid)); int G = gridDim.x; asm volatile("" : "+s"(G));
    C.wave = wv; C.lane = lane; C.tid = wv * 64 + lane;
    C.G = G; C.bid = bid; C.vcu = (C.G % 8 == 0) ? (C.bid % 8) * (C.G / 8) + C.bid / 8 : C.bid;
    C.gw = C.bid * 8 + C.wave; C.NGW = C.G * 8; return C;
}
#define IN(i) ((const float*)ap->in[i])
#define MODL(l) ((const float*)(C.ws + O_MOD) + (size_t)(l) * 4 * 6144)
PHFN ph_prologue(int wv) { const ArgsP ap = fresh_args(); const Ctx C = make_ctx(ap, wv); p0_prologue(C, ap); }
PHFN ph_norm(int wv, int l, int mode) { const ArgsP ap = fresh_args(); const Ctx C = make_ctx(ap, wv);
    if (mode == 0) phase_norm(C, IN(0), nullptr, false, true, IN(5), MODL(0), MODL(0), 0, 1024);
    else if (mode == 1) phase_norm(C, nullptr, nullptr, true, true, IN(5) + l * 1024, MODL(l - 1), MODL(l), 0, 1024);
    else if (mode == 3) phase_norm(C, nullptr, nullptr, true, true, IN(5) + l * 1024, MODL(l - 1), MODL(l), 0, 1024, true);
    else phase_norm(C, nullptr, ap->out, true, false, IN(5), MODL(3), MODL(3), 0, 1024); }
PHFN ph_proj(int wv, int j) { const ArgsP ap = fresh_args(); const Ctx C = make_ctx(ap, wv); unsigned char* ws = C.ws;
    DenseOrder S; S.init(ws + O_HN, ws + O_WIN + j * SZ_WIN, 1024, 1024, T_, 2048, C.G, C.bid); EpiNorm<0> E{(bf16_t*)(ws + O_PROJ), 2048, IN(8) + j * 64, IN(9) + j * 64, IN(10) + j * 256, IN(11) + j * 128, IN(15) + j * 96 + 64, (const float*)(ws + O_CS), (LAS float*)(C.lds + LX_EXCH)}; gemm_phase(C, GemmDims{1024, 1024, 1024}, S, E); }
PHFN ph_postproj(int wv, int j) { const ArgsP ap = fresh_args(); const Ctx C = make_ctx(ap, wv); phase_postproj(C, IN(8) + j * 64, IN(9) + j * 64, IN(10) + j * 256, IN(11) + j * 128, IN(15) + j * 96); }
PHFN ph_qkv(int wv, int j) { const ArgsP ap = fresh_args(); const Ctx C = make_ctx(ap, wv); unsigned char* ws = C.ws;
    { DenseOrder S; S.init(ws + O_PROJ + 1536 * 2, ws + O_WUQ + j * SZ_WUQ, 2048, 256, T_, 768, C.G, C.bid); EpiNorm<1> E{(bf16_t*)(ws + O_Q2), 768, IN(14) + j * 96, IN(14) + j * 96 + 64, nullptr, nullptr, nullptr, (const float*)(ws + O_CS), (LAS float*)(C.lds + LX_EXCH)}; gemm_phase(C, GemmDims{256, 2048, 256}, S, E); }
    { const ArgsP ap2 = fresh_args(); const Ctx C = make_ctx(ap2, wv); unsigned char* ws = C.ws; DenseOrder S; S.init(ws + O_PROJ + 1792 * 2, ws + O_WUKV + j * SZ_WUKV, 2048, 128, T_, 1024, C.G, C.bid); EpiNorm<2> E{(bf16_t*)(ws + O_KV2), 1024, IN(15) + j * 96, nullptr, nullptr, nullptr, nullptr, (const float*)(ws + O_CS), (LAS float*)(C.lds + LX_EXCH)}; gemm_phase(C, GemmDims{128, 2048, 128}, S, E); } }
PHFN ph_postq(int wv, int j) { const ArgsP ap = fresh_args(); const Ctx C = make_ctx(ap, wv); phase_postq(C, IN(14) + j * 96, IN(15) + j * 96); }
PHFN ph_attention(int wv, int pair) { const ArgsP ap = fresh_args(); const Ctx C = make_ctx(ap, wv); phase_attention(C, IN(30), IN(32), pair); }
PHFN ph_mixcombine(int wv) { const ArgsP ap = fresh_args(); const Ctx C = make_ctx(ap, wv); phase_mixcombine(C); }
PHFN ph_outproj(int wv, int l, int which) { const ArgsP ap = fresh_args(); const Ctx C = make_ctx(ap, wv); unsigned char* ws = C.ws; const int j = l >> 1;
    DenseOrder S; S.init(ws + O_ATT, ws + (which ? O_RWOUT + j * SZ_RWOUT : O_WOUT + j * SZ_WOUT), 1024, 1024, T_, 1024, C.G, C.bid);
    EpiResid E{(bf16_t*)(ws + O_X), MODL(l) + 2048, which ? IN(27) + j * 1024 : nullptr}; gemm_phase(C, GemmDims{1024, 1024, 1024}, S, E); }
PHFN ph_router(int wv, int l) { const ArgsP ap = fresh_args(); const Ctx C = make_ctx(ap, wv); phase_router(C, (const bf16_t*)(C.ws + O_X), IN(6) + l * 1024, MODL(l), IN(28) + (size_t)l * 1024 * 32, IN(29) + l * 32, l); }
PHFN ph_moe1(int wv, int l) { const ArgsP ap = fresh_args(); const Ctx C = make_ctx(ap, wv); unsigned char* ws = C.ws; moe_plan_lds(C, l);
    MoeOrderT<true> S; S.A = (const char*)(ws + O_HN); S.WT = (const char*)(ws + O_W1 + (size_t)l * 32 * SZ_W1E); S.estride = SZ_W1E; S.tile_e = (const LAS int*)(C.lds + LX_TILE);
    S.NT = *(const LAS int*)(C.lds + LX_MISC + 128); S.nN = 8; S.G = C.G; S.c = C.bid; S.esz = 1; S.gtab = (const LAS int*)(C.lds + LX_GTAB);
    { const int* inv = (const int*)(ws + O_INV); LAS int* gt = (LAS int*)(C.lds + LX_GTAB); const LAS int* tot = (const LAS int*)(C.lds + LX_MISC + 256); const LAS int* pst = tot + 32;
      const int r = C.tid & 255, i0 = __builtin_amdgcn_readfirstlane(C.tid >> 8); int val[GTAB_UNITS / 2];
#pragma unroll
      for (int k = 0; k < GTAB_UNITS / 2; ++k) { Unit u; const bool ok = S.next(2 * k + i0, u); const int e = ok ? u.e : 0, j = (ok ? u.row0 - pst[e] : 0) + r; val[k] = (ok && j < tot[e]) ? inv[e * 16384 + j] : 0; }
      { const int* topi = (const int*)(ws + O_TOPI); const int* posj = (const int*)(ws + O_POSJ); int* pos = (int*)(ws + O_POS);
        for (int ck = C.bid; ck < 256; ck += C.G) if (C.tid < 256) pos[ck * 256 + C.tid] = pst[topi[ck * 256 + C.tid]] + posj[ck * 256 + C.tid]; }
#pragma unroll
      for (int k = 0; k < GTAB_UNITS / 2; ++k) gt[(2 * k + i0) * 256 + r] = val[k];
      __syncthreads(); }
    EpiSwiglu E{(unsigned char*)(ws + O_ACT), IN(31) + (size_t)l * 32 * 2048, 1.f / 32.f}; gemm_phase<true>(C, GemmDims{1024, 1024, 1024}, S, E); }
PHFN ph_moe2(int wv, int l) { const ArgsP ap = fresh_args(); const Ctx C = make_ctx(ap, wv); unsigned char* ws = C.ws;
#if MODE != 1
    moe_plan_lds(C, l);
#endif

    MoeOrder S; S.A = (const char*)(ws + O_ACT); S.WT = (const char*)(ws + O_W2 + (size_t)l * 32 * SZ_W2E); S.estride = SZ_W2E; S.tile_e = (const LAS int*)(C.lds + LX_TILE);
    S.NT = *(const LAS int*)(C.lds + LX_MISC + 128); S.nN = 4; S.G = C.G; S.c = C.bid; S.esz = 1;
    EpiBf16 E{(bf16_t*)(ws + O_Y2), IN(33) + (size_t)l * 32 * 1024, 1024, 1024, 1.f / 32.f}; gemm_phase<true>(C, GemmDims{1024, 1024, 1024}, S, E); }
PHFN ph_recin(int wv, int j) { const ArgsP ap = fresh_args(); const Ctx C = make_ctx(ap, wv); unsigned char* ws = C.ws;
    DenseOrder S; S.init(ws + O_HN, ws + O_RWIN + j * SZ_RWIN, 1024, 1024, T_, 2048, C.G, C.bid); EpiRecIn E{(bf16_t*)(ws + O_PROJ), IN(18) + j * 2048}; gemm_phase(C, GemmDims{1024, 1024, 1024}, S, E); }
PHFN ph_rgate(int wv, int j) { const ArgsP ap = fresh_args(); const Ctx C = make_ctx(ap, wv); phase_rgate(C, j, IN(19) + j * 4096, IN(20) + j * 1024, IN(22) + j * 1024, IN(24) + j * 1024); }
PHFN ph_scan_apply(int wv) { const ArgsP ap = fresh_args(); const Ctx C = make_ctx(ap, wv); phase_scan_apply(C); }

#if MODE == 1
__device__ __forceinline__ int fresh_tid(int wv) { unsigned ones = ~0u; asm volatile("" : "+s"(ones)); return wv * 64 + (int)__builtin_amdgcn_mbcnt_hi(ones, __builtin_amdgcn_mbcnt_lo(ones, 0u)); }
__device__ __forceinline__ void grid_barrier(int wv) { const ArgsP q = fresh_args(); XcdBarrier b; b.bar = (unsigned*)(q->ws + O_CTL) + CW_BAR; b.x = xb_xcc_id(); b.st = (volatile LAS unsigned*)((LAS unsigned char*)lds_raw + LDSX_OFF); xcd_barrier(b, fresh_tid(wv)); }
__global__ void __launch_bounds__(512, 2) mk_fwd(Args a) {
    int wv = __builtin_amdgcn_readfirstlane(threadIdx.x >> 6); asm volatile("" : "+s"(wv));
    { LAS unsigned char* lds = (LAS unsigned char*)lds_raw;
      for (int u = threadIdx.x; u < (LDS_BYTES - LDSX_OFF) / 4; u += 512) ((LAS unsigned*)(lds + LDSX_OFF))[u] = 0u;
      __syncthreads();
      if (a.ph_hi - a.ph_lo > 1) (void)xcd_barrier_post((unsigned*)(a.ws + O_CTL) + CW_BAR, (volatile LAS unsigned*)(lds + LDSX_OFF), (int)threadIdx.x); }
    int pid = 0;
#define PHASE(call) { const ArgsP q_ = fresh_args(); const int lo_ = q_->ph_lo, hi_ = q_->ph_hi; if (pid >= lo_ && pid < hi_) { call; if (pid + 1 < hi_) grid_barrier(wv); } ++pid; }
#define PHASE_R(call, REP) { const ArgsP q_ = fresh_args(); const int lo_ = q_->ph_lo, hi_ = q_->ph_hi; if (pid >= lo_ && pid < hi_) { if ((REP) > 1) { call; grid_barrier(wv); } call; if (pid + 1 < hi_) grid_barrier(wv); } ++pid; }
#ifndef REP_PROLOGUE
#define REP_PROLOGUE 1
#endif
#ifndef REP_MOE
#define REP_MOE 1
#endif
#ifndef REP_ATTN
#define REP_ATTN 1
#endif
#ifndef REP_GEMMS
#define REP_GEMMS 1
#endif
#ifdef TIME_NORM
#define NORM_EXTRA(l) PHASE(ph_norm(wv, l, 3))
#else
#define NORM_EXTRA(l)
#endif
#ifndef REP_ELEM
#define REP_ELEM 1
#endif
#ifndef REP_ROUTER
#define REP_ROUTER REP_ELEM
#endif
#ifndef REP_SCATTER
#define REP_SCATTER REP_ELEM
#endif
#ifndef REP_MIX
#define REP_MIX REP_ELEM
#endif
#ifndef REP_CONV
#define REP_CONV REP_ELEM
#endif
#ifndef REP_SCANA
#define REP_SCANA REP_ELEM
#endif
#define MOE_PHASES(l) PHASE_R(ph_router(wv, l), REP_ROUTER) PHASE_R(ph_moe1(wv, l), REP_MOE) PHASE_R(ph_moe2(wv, l), REP_MOE)
    PHASE_R(ph_prologue(wv), REP_PROLOGUE)
#define LAYER_PAIR(lp) \
        { const int l = 2 * (lp);         \
          PHASE(ph_norm(wv, l, (lp) == 0 ? 0 : 1)) PHASE_R(ph_proj(wv, lp), REP_GEMMS) PHASE_R(ph_qkv(wv, lp), REP_GEMMS) PHASE_R(ph_attention(wv, lp), REP_ATTN) PHASE_R(ph_mixcombine(wv), REP_MIX) PHASE(ph_outproj(wv, l, 0)) \
          MOE_PHASES(l) } \
        { const int l = 2 * (lp) + 1;     \
          NORM_EXTRA(l) PHASE(ph_norm(wv, l, 1)) PHASE_R(ph_recin(wv, lp), REP_GEMMS) PHASE_R(ph_rgate(wv, lp), REP_CONV) PHASE_R(ph_scan_apply(wv), REP_SCANA) PHASE(ph_outproj(wv, l, 1)) \
          MOE_PHASES(l) }
    LAYER_PAIR(0)
    LAYER_PAIR(1)
#undef LAYER_PAIR
#ifdef EXTRA_BARRIERS
    { const ArgsP q_ = fresh_args(); if (q_->ph_hi - q_->ph_lo > 1) { _Pragma("unroll 1") for (int xb = 0; xb < EXTRA_BARRIERS; ++xb) grid_barrier(wv); } }
#endif
    PHASE(ph_norm(wv, 3, 2))
#undef PHASE
#undef PHASE_R
#undef MOE_PHASES
}
#else
template <int PH> __global__ void __launch_bounds__(512, 2) k_phase(Args a, int l, int x) {
    int wv = __builtin_amdgcn_readfirstlane(threadIdx.x >> 6); asm volatile("" : "+s"(wv));
    LAS unsigned char* lds = (LAS unsigned char*)lds_raw;
    for (int u = threadIdx.x; u < (LDS_BYTES - LDSX_OFF) / 4; u += 512) ((LAS unsigned*)(lds + LDSX_OFF))[u] = 0u;
    __syncthreads();
    if constexpr (PH == 0) ph_prologue(wv);
    if constexpr (PH == 1) ph_norm(wv, l, x);
    if constexpr (PH == 2) ph_proj(wv, l);
    if constexpr (PH == 4) ph_qkv(wv, l);
    if constexpr (PH == 6) ph_attention(wv, l);
    if constexpr (PH == 7) ph_mixcombine(wv);
    if constexpr (PH == 8) ph_outproj(wv, l, x);
    if constexpr (PH == 9) ph_router(wv, l);
    if constexpr (PH == 11) ph_moe1(wv, l);
    if constexpr (PH == 12) ph_moe2(wv, l);
    if constexpr (PH == 13) ph_recin(wv, l);
    if constexpr (PH == 14) ph_rgate(wv, l);
    if constexpr (PH == 17) ph_scan_apply(wv);
}
#endif
#undef IN
#undef MODL
}

#ifndef MODE
#define MODE 2
#endif
extern "C" void kernel_launch(void* const* d_in, const int* in_sizes, int n_in, void* d_out, int out_size, void* d_ws, size_t ws_size, hipStream_t stream) {
    (void)in_sizes; (void)n_in; (void)out_size; (void)ws_size;
#if MODE == 0
    nv::forward(d_in, (float*)d_out, d_ws, stream);
#else
    static int grid = 0;
    if (grid == 0) {
        int dev = 0, cus = 0;
        (void)hipGetDevice(&dev); (void)hipDeviceGetAttribute(&cus, hipDeviceAttributeMultiprocessorCount, dev);
#if MODE == 1
        (void)hipFuncSetAttribute((const void*)mk::mk_fwd, hipFuncAttributeMaxDynamicSharedMemorySize, mk::LDS_BYTES);
#else
#define SA(PH) (void)hipFuncSetAttribute((const void*)mk::k_phase<PH>, hipFuncAttributeMaxDynamicSharedMemorySize, mk::LDS_BYTES)
        SA(0); SA(1); SA(2); SA(4); SA(6); SA(7); SA(8); SA(9); SA(10); SA(11); SA(12); SA(13); SA(14); SA(17);
#undef SA
#endif
        grid = cus > 0 ? cus : 256;
    }
    (void)hipMemsetAsync((char*)d_ws + mk::O_CTL, 0, mk::SZ_CTL, stream);
    mk::Args a;
    memset(&a, 0, sizeof(a));
    for (int i = 0; i < 34; ++i) a.in[i] = d_in[i];
    a.out = (float*)d_out; a.ws = (unsigned char*)d_ws;
#if MODE == 1
    a.ph_lo = 0; a.ph_hi = mk::N_PHASES;
    hipLaunchKernelGGL(mk::mk_fwd, dim3(grid), dim3(512), mk::LDS_BYTES, stream, a);
#else
#define LP(PH, l, x) hipLaunchKernelGGL(mk::k_phase<PH>, dim3(grid), dim3(512), mk::LDS_BYTES, stream, a, l, x)
    LP(0, 0, 0);
    for (int lp = 0; lp < 2; ++lp) {
        { const int l = 2 * lp; LP(1, l, lp == 0 ? 0 : 1); LP(2, lp, 0); LP(4, lp, 0); LP(6, lp, 0); LP(7, 0, 0); LP(8, l, 0); LP(9, l, 0); LP(10, 0, 0); LP(11, l, 0); LP(12, l, 0); }
        { const int l = 2 * lp + 1; LP(1, l, 1); LP(13, lp, 0); LP(14, lp, 0); LP(17, 0, 0); LP(8, l, 1); LP(9, l, 0); LP(10, 0, 0); LP(11, l, 0); LP(12, l, 0); }
    }
    LP(1, 3, 2);
#undef LP
#endif
#endif
}
```

```cpp
#define MODE 1

#include <string.h>
#include <hip/hip_runtime.h>
#include <stdint.h>
#include <math.h>

namespace cfg {
constexpr int D = 1024, NB = 4, S = 4096, T = NB * S, DEPTH = 4;
constexpr int MIXIN = 1952;
constexpr int NE = 32, TOPK = 4;
constexpr int MPAIR = T * TOPK;
constexpr int NBLK = MPAIR / 256 + NE;
constexpr int P = NBLK * 256;
}
using namespace cfg;


namespace mk {
#define LAS __attribute__((address_space(3)))
#define GAS __attribute__((address_space(1)))
typedef unsigned short bf16_t;
typedef short bf16x8 __attribute__((ext_vector_type(8)));
typedef short s16x4 __attribute__((ext_vector_type(4)));
typedef float f32x2 __attribute__((ext_vector_type(2)));
typedef float f32x4 __attribute__((ext_vector_type(4)));
typedef float f32x16 __attribute__((ext_vector_type(16)));
typedef unsigned u32x2 __attribute__((ext_vector_type(2)));
typedef unsigned u32x4 __attribute__((ext_vector_type(4)));
typedef GAS unsigned gu32;
#define RLX_AGENT __ATOMIC_RELAXED, __HIP_MEMORY_SCOPE_AGENT

__device__ __forceinline__ unsigned cvt_pk_bf16(float lo, float hi) { unsigned r; asm volatile("v_cvt_pk_bf16_f32 %0, %1, %2" : "=v"(r) : "v"(lo), "v"(hi)); return r; }
__device__ __forceinline__ float bf_lo(unsigned u) { return __uint_as_float(u << 16); }
__device__ __forceinline__ float bf_hi(unsigned u) { return __uint_as_float(u & 0xffff0000u); }
template <int O> __device__ __forceinline__ float shx(float v) { static_assert(O >= 1 && O < 32, "shx"); return __int_as_float(__builtin_amdgcn_ds_swizzle(__float_as_int(v), (O << 10) | 0x1f)); }
__device__ __forceinline__ float xadd32(float v) { const auto r = __builtin_amdgcn_permlane32_swap(__float_as_uint(v), __float_as_uint(v), false, false); return __uint_as_float(r[0]) + __uint_as_float(r[1]); }
__device__ __forceinline__ float xmax32(float v) { const auto r = __builtin_amdgcn_permlane32_swap(__float_as_uint(v), __float_as_uint(v), false, false); return fmaxf(__uint_as_float(r[0]), __uint_as_float(r[1])); }
__device__ __forceinline__ float wsum(float v) { v += shx<1>(v); v += shx<2>(v); v += shx<4>(v); v += shx<8>(v); v += shx<16>(v); return xadd32(v); }
__device__ __forceinline__ float fexp2(float x) { return __builtin_amdgcn_exp2f(x); }
__device__ __forceinline__ float frcp(float x) { return __builtin_amdgcn_rcpf(x); }
__device__ __forceinline__ float fsigmoid(float z) { return frcp(1.f + fexp2(-1.4426950408889634f * z)); }
__device__ __forceinline__ float fgelu_tanh(float x) { const float u = 0.7978845608028654f * (x + 0.044715f * x * x * x); return x * frcp(1.f + fexp2(-2.8853900817779268f * u)); }

#define XB_TMO      128
#define XB_XCNT(j)  (256  + 64 * (j))
#define XB_XSUB(j)  (1280 + 64 * (j))
#define XB_XGEN(j)  (2304 + 64 * (j))
#define XB_TOP      3328
#define XB_TOPGEN   3392
#define XCD_BAR_WORDS 3456
#define XB_SPIN_CAP (1u << 18)
__device__ __forceinline__ unsigned xb_ld(unsigned* p)              { return __hip_atomic_load(p, __ATOMIC_RELAXED, __HIP_MEMORY_SCOPE_AGENT); }
__device__ __forceinline__ unsigned xb_add(unsigned* p, unsigned v) { return __hip_atomic_fetch_add(p, v, __ATOMIC_RELAXED, __HIP_MEMORY_SCOPE_AGENT); }
__device__ __forceinline__ unsigned xb_xcc_id() { return (unsigned)__builtin_amdgcn_s_getreg((3 << 11) | 20) & 0xFu; }
#define XB_SPIN(cond, bar) do { unsigned _sp = 0; while (cond) { __builtin_amdgcn_s_sleep(1); \
    if ((++_sp & 255u) == 0u) { if (xb_ld(&(bar)[XB_TMO])) break; if (_sp > XB_SPIN_CAP) { atomicAdd(&(bar)[XB_TMO], 1u); break; } } } } while (0)
struct XcdBarrier { unsigned* bar; unsigned x; volatile LAS unsigned* st; };
__device__ __forceinline__ XcdBarrier xcd_barrier_post(unsigned* bar, volatile LAS unsigned* st, int tid) {
    XcdBarrier b; b.bar = bar; b.x = xb_xcc_id(); b.st = st;
    if (tid == 0) (void)xb_add(&bar[XB_XCNT(b.x)], 1u);
    return b;
}
__device__ __forceinline__ void xcd_barrier_complete(unsigned* bar, unsigned x, unsigned& nloc, unsigned& nx) {
    const unsigned G = gridDim.x * gridDim.y * gridDim.z;
    unsigned sum, cnt, mine, sp = 0u;
    for (;;) {
        sum = 0u; cnt = 0u; mine = 0u;
#pragma unroll
        for (unsigned j = 0; j < 16; ++j) { const unsigned c = xb_ld(&bar[XB_XCNT(j)]); sum += c; cnt += (c > 0u) ? 1u : 0u; mine = (j == x) ? c : mine; }
        if (sum == G) break;
        __builtin_amdgcn_s_sleep(1);
        if ((++sp & 255u) == 0u) { if (xb_ld(&bar[XB_TMO])) break; if (sp > XB_SPIN_CAP) { atomicAdd(&bar[XB_TMO], 1u); break; } }
    }
    nloc = mine > 0u ? mine : 1u; nx = cnt > 0u ? cnt : 1u;
}
__device__ __forceinline__ void xcd_barrier(const XcdBarrier& b, int tid) {
    asm volatile("s_waitcnt vmcnt(0)" ::: "memory");
    __syncthreads();
    if (tid == 0) {
        unsigned* bar = b.bar;
        __builtin_amdgcn_s_waitcnt(0);
        unsigned nloc = b.st[0], nx = b.st[1];
        if (nloc == 0u) { xcd_barrier_complete(bar, b.x, nloc, nx); b.st[0] = nloc; b.st[1] = nx; }
        const unsigned old = xb_add(&bar[XB_XSUB(b.x)], 1u);
        const unsigned gen = old / nloc;
        if (old + 1u == (gen + 1u) * nloc) {
            __builtin_amdgcn_fence(__ATOMIC_RELEASE, "agent");
            asm volatile("s_waitcnt vmcnt(0)" ::: "memory");
            const unsigned og = xb_add(&bar[XB_TOP], 1u);
            const unsigned tg = og / nx;
            if (og + 1u == (tg + 1u) * nx) xb_add(&bar[XB_TOPGEN], 1u);
            else XB_SPIN(xb_ld(&bar[XB_TOPGEN]) == tg, bar);
            __builtin_amdgcn_fence(__ATOMIC_ACQUIRE, "agent");
            xb_add(&bar[XB_XGEN(b.x)], 1u);
            asm volatile("s_waitcnt vmcnt(0)" ::: "memory");
        } else {
            XB_SPIN(xb_ld(&bar[XB_XGEN(b.x)]) == gen, bar);
            __builtin_amdgcn_fence(__ATOMIC_ACQUIRE, "agent");
            asm volatile("s_waitcnt vmcnt(0)" ::: "memory");
        }
    }
    __syncthreads();
}

constexpr int BM = 256, BK = 64, HALF = 128, HTB = HALF * BK * 2, STAGE_BYTES = 8 * HTB;
__host__ __device__ __forceinline__ int lds_byte(int r, int c) { const int st = (r >> 4) * 2 + (c >> 5), rr = r & 15, cc = c & 31, ob = rr * 64 + cc * 2; return st * 1024 + (ob ^ (((ob >> 9) & 1) << 5)); }
__host__ __device__ __forceinline__ void stage_rc(int b, int& R, int& C) { const int st = b / 1024, sb = b % 1024, swz = sb ^ (((sb >> 9) & 1) << 5); R = (st >> 1) * 16 + swz / 64; C = (st & 1) * 32 + (swz % 64) / 2; }
__host__ __device__ __forceinline__ int perm32(int rho) { const int n = rho >> 4, i = rho & 15; return 8 * (i >> 2) + 4 * n + (i & 3); }

struct Unit { const char* a; const char* b; int row0, col0, e, pad; };
struct GemmDims { int K, lda, ldb; };
typedef f32x4 Acc[2][2][4][2];
__device__ __forceinline__ void zero_acc(Acc& acc) {
#pragma unroll
    for (int a = 0; a < 2; ++a)
#pragma unroll
        for (int b = 0; b < 2; ++b)
#pragma unroll
            for (int m = 0; m < 4; ++m)
#pragma unroll
                for (int n = 0; n < 2; ++n)
#pragma unroll
                    for (int j = 0; j < 4; ++j) { float z; asm volatile("v_mov_b32 %0, 0" : "=v"(z)); acc[a][b][m][n][j] = z; }
}

typedef int v8i32 __attribute__((ext_vector_type(8)));
template <bool F8 = false, class CtxT, class Epi, class Sched>
__device__ __forceinline__ void gemm_phase(const CtxT& C, const GemmDims g, const Sched& S, const Epi& E) {
    LAS unsigned char* lds = C.lds;
    const int tid = C.tid, wid = __builtin_amdgcn_readfirstlane(tid >> 6), lane = tid & 63, wr = wid >> 2, wc = wid & 3, fr = lane & 15, fq = lane >> 4;
    constexpr int ESZ = F8 ? 1 : 2;
    constexpr bool GA = Sched::GATHER;
    int nt = g.K / (F8 ? 128 : BK); asm volatile("" : "+s"(nt));
    unsigned voffA[2], voffB[2];
#pragma unroll
    for (int i = 0; i < 2; ++i) { int R, C; stage_rc(tid * 16 + i * 8192, R, C); const int Rb = (R & ~31) + perm32(R & 31);
        voffA[i] = (unsigned)(R * g.lda * ESZ + C * 2); voffB[i] = (unsigned)(Rb * g.ldb * ESZ + C * 2); }
    unsigned voffG[2][2];
    auto load_goffs = [&](int uidx) { if constexpr (GA) { int R, Cc; stage_rc(tid * 16, R, Cc); const LAS int* tp = S.gtab + uidx * 256 + R;
#pragma unroll
        for (int h = 0; h < 2; ++h)
#pragma unroll
            for (int i = 0; i < 2; ++i) voffG[h][i] = (unsigned)tp[h * 128 + i * 64] * (unsigned)(g.lda * ESZ) + (unsigned)(Cc * 2); } };
    const size_t kstep = (size_t)(BK * 2);
    const size_t hstepA = (size_t)HALF * g.lda * ESZ, hstepB = (size_t)HALF * g.ldb * ESZ;
    const unsigned ldsw = (unsigned)wid * 1024u;
    const unsigned ldsu = (unsigned)__builtin_amdgcn_readfirstlane((int)(unsigned)(unsigned long long)(lds));
    const int aoff = lds_byte(wr * 64 + fr, fq * 8), boff = lds_byte(wc * 32 + fr, fq * 8);
#define PG8_SA(b, h) (((b) * 2 + (h)) * HTB)
#define PG8_SB(b, h) ((4 + (b) * 2 + (h)) * HTB)
#define PG8_STAGE(bufoff, gbase, voff) do { _Pragma("unroll") for (int _i = 0; _i < 2; ++_i) { \
        asm volatile("s_mov_b32 m0, %2\n\ts_nop 3\n\tglobal_load_lds_dwordx4 %0, %1" :: "v"((voff)[_i]), "s"((const char*)(gbase)), "s"(ldsu + (unsigned)(bufoff) + ldsw + (unsigned)(_i * 8192)) : "memory"); } } while (0)
#define PG8_STAGE_A(bufoff, gbase, h) do { if constexpr (GA) PG8_STAGE(bufoff, gbase, voffG[h]); else PG8_STAGE(bufoff, (gbase) + (h) * hstepA, voffA); } while (0)
#define PG8_LDA(dst, b, h) do { _Pragma("unroll") for (int m = 0; m < 4; ++m) _Pragma("unroll") for (int k = 0; k < 2; ++k) dst[m][k] = *(const LAS bf16x8*)(lds + PG8_SA(b, h) + aoff + m * 2048 + k * 1024); } while (0)
#define PG8_LDB(dst, b, h) do { _Pragma("unroll") for (int n = 0; n < 2; ++n) _Pragma("unroll") for (int k = 0; k < 2; ++k) dst[n][k] = *(const LAS bf16x8*)(lds + PG8_SB(b, h) + boff + n * 2048 + k * 1024); } while (0)
#define PG8_CAT(x) __builtin_bit_cast(v8i32, (x))
#define PG8_MMA(ai, bj, At, Bt) do { __builtin_amdgcn_s_setprio(1); \
        if constexpr (F8) { _Pragma("unroll") for (int m = 0; m < 4; ++m) _Pragma("unroll") for (int n = 0; n < 2; ++n) \
            acc[ai][bj][m][n] = __builtin_amdgcn_mfma_scale_f32_16x16x128_f8f6f4(PG8_CAT(Bt[n]), PG8_CAT(At[m]), acc[ai][bj][m][n], 0, 0, 0, 0, 0, 0); } \
        else { _Pragma("unroll") for (int m = 0; m < 4; ++m) _Pragma("unroll") for (int n = 0; n < 2; ++n) _Pragma("unroll") for (int k = 0; k < 2; ++k) \
            acc[ai][bj][m][n] = __builtin_amdgcn_mfma_f32_16x16x32_bf16(Bt[n][k], At[m][k], acc[ai][bj][m][n], 0, 0, 0); } \
        __builtin_amdgcn_s_setprio(0); } while (0)
#define PG8_WAIT_V(n) asm volatile("s_waitcnt vmcnt(" #n ")" ::: "memory")
#define PG8_WAIT_L(n) asm volatile("s_waitcnt lgkmcnt(" #n ")" ::: "memory")
#define PG8_BAR __builtin_amdgcn_s_barrier()
#define PG8_SCHED __builtin_amdgcn_sched_barrier(0)
    Unit cur, nxt; int ui = 0;
    if (!S.next(0, cur)) return;
    Acc acc; zero_acc(acc);
    struct Frag2 { bf16x8 p[2]; __device__ __forceinline__ bf16x8& operator[](int k) { return p[k]; } __device__ __forceinline__ const bf16x8& operator[](int k) const { return p[k]; } };
    Frag2 At[4], B0[2], B1[2];
    const char* cA = cur.a; const char* cB = cur.b;
    load_goffs(0);
    PG8_STAGE(PG8_SB(0, 0), cB, voffB); PG8_STAGE(PG8_SB(0, 1), cB + hstepB, voffB); PG8_STAGE_A(PG8_SA(0, 0), cA, 0); PG8_STAGE_A(PG8_SA(0, 1), cA, 1);
    if (wr == 1) PG8_BAR;
    PG8_WAIT_V(2); PG8_BAR;
    PG8_STAGE(PG8_SB(1, 0), cB + kstep, voffB); PG8_STAGE_A(PG8_SA(1, 0), cA + kstep, 0); PG8_STAGE(PG8_SB(1, 1), cB + hstepB + kstep, voffB);
    PG8_WAIT_V(6); PG8_BAR;
    for (;;) {
        const bool has_next = S.next(ui + 1, nxt);
        const char* nA = has_next ? nxt.a : cA; const char* nB = has_next ? nxt.b : cB;
        for (int t = 0; t < nt; t += 2) {
            const bool last = (t == nt - 2);
            const char* a1 = cA + (size_t)(t + 1) * kstep;
            const char* a2 = last ? nA : cA + (size_t)(t + 2) * kstep; const char* b2 = last ? nB : cB + (size_t)(t + 2) * kstep;
            const char* a3 = a2 + kstep; const char* b3 = b2 + kstep;
            PG8_LDB(B0, 0, 0); PG8_LDB(B1, 0, 1); PG8_SCHED; PG8_LDA(At, 0, 0); PG8_STAGE_A(PG8_SA(1, 1), a1, 1);
            if (GA && last && has_next) load_goffs(ui + 1);
            PG8_WAIT_V(8); PG8_WAIT_L(0); PG8_BAR; PG8_MMA(0, 0, At, B0); PG8_MMA(0, 1, At, B1); PG8_BAR; PG8_SCHED;
            PG8_LDA(At, 0, 1); PG8_STAGE(PG8_SB(0, 0), b2, voffB); PG8_STAGE(PG8_SB(0, 1), b2 + hstepB, voffB); PG8_STAGE_A(PG8_SA(0, 0), a2, 0);
            PG8_WAIT_V(8); PG8_WAIT_L(0); PG8_BAR; PG8_MMA(1, 0, At, B0); PG8_MMA(1, 1, At, B1); PG8_BAR; PG8_SCHED;
            PG8_LDB(B0, 1, 0); PG8_LDB(B1, 1, 1); PG8_SCHED; PG8_LDA(At, 1, 0); PG8_STAGE_A(PG8_SA(0, 1), a2, 1);
            PG8_WAIT_V(8); PG8_WAIT_L(0); PG8_BAR; PG8_MMA(0, 0, At, B0); PG8_MMA(0, 1, At, B1); PG8_BAR; PG8_SCHED;
            PG8_LDA(At, 1, 1); PG8_STAGE(PG8_SB(1, 0), b3, voffB); PG8_STAGE(PG8_SB(1, 1), b3 + hstepB, voffB); PG8_STAGE_A(PG8_SA(1, 0), a3, 0);
            PG8_WAIT_V(8); PG8_WAIT_L(0); PG8_BAR; PG8_MMA(1, 0, At, B0); PG8_MMA(1, 1, At, B1); PG8_BAR; PG8_SCHED;
        }
        if (wr == 0) PG8_BAR;
        E(acc, cur, wr, wc, fr, fq);
        if (!has_next) break;
        zero_acc(acc);
        cur = nxt; cA = nA; cB = nB; ++ui;
        if (wr == 1) PG8_BAR;
    }
    PG8_WAIT_V(0);
    PG8_BAR;
#undef PG8_SA
#undef PG8_SB
#undef PG8_STAGE
#undef PG8_STAGE_A
#undef PG8_LDA
#undef PG8_LDB
#undef PG8_MMA
#undef PG8_CAT
#undef PG8_WAIT_V
#undef PG8_WAIT_L
#undef PG8_BAR
#undef PG8_SCHED
}

struct DenseOrder {
    static constexpr bool GATHER = false;
    const char* A; const char* Bt; int lda, ldb, nM, nN, nwg, G, c, esz;
    __device__ __forceinline__ void init(const void* A_, const void* Bt_, int lda_, int ldb_, int M, int N, int G_, int c_, int esz_ = 2) { A = (const char*)A_; Bt = (const char*)Bt_; lda = lda_; ldb = ldb_; nM = M / BM; nN = N / BM; nwg = nM * nN; G = G_; c = c_; esz = esz_; }
    __device__ __forceinline__ bool next(int i, Unit& u) const {
        const long L = (long)i * G + c; if (L >= nwg) return false;
        int wgid = (int)L; { const int q = nwg / 8, r = nwg % 8, xcd = wgid % 8, off = wgid / 8; wgid = (xcd < r ? xcd * (q + 1) : r * (q + 1) + (xcd - r) * q) + off; }
        const int nig = 8 * nN, gid = wgid / nig, fm = gid * 8, gsz = (nM - fm) < 8 ? (nM - fm) : 8;
        const int pm = fm + ((wgid % nig) % gsz), pn = (wgid % nig) / gsz;
        u.a = A + (size_t)pm * BM * lda * esz; u.b = Bt + (size_t)pn * BM * ldb * esz; u.row0 = pm * BM; u.col0 = pn * BM; u.e = 0; u.pad = 0; return true;
    }
};
struct LruOrder {
    static constexpr bool GATHER = false;
    const char* XC; const char* RG; int G, c;
    __device__ __forceinline__ bool next(int i, Unit& u) const {
        const int L = i * G + c; if (L >= 512) return false;
        const int pm = L >> 3, n = L & 7;
        u.a = XC + ((size_t)pm * BM * 1024 + n * 128) * 2; u.b = RG + (size_t)n * 256 * 128 * 2; u.row0 = pm * BM; u.col0 = n * 128; u.e = n; u.pad = 0; return true;
    }
};
template <bool GATHER_ = false> struct MoeOrderT {
    static constexpr bool GATHER = GATHER_; const LAS int* gtab;
    const char* A; const char* WT; size_t estride; const LAS int* tile_e; int NT, nN, G, c, esz;
    __device__ __forceinline__ bool next(int i, Unit& u) const {
        int tile, pn;
#ifndef MOE_ORDER_ALT
#define MOE_ORDER_ALT 0
#endif
        if (!MOE_ORDER_ALT && (G % (8 * nN)) == 0) { const int R = G / nN; tile = i * R + (c & 7) * (R >> 3) + (c >> 3) / nN; pn = (c >> 3) % nN; }
        else { const int L = i * G + c; tile = L / nN; pn = L % nN; }
        if (tile >= NT) return false;
        const int e = __builtin_amdgcn_readfirstlane(tile_e[tile]);
        u.a = GATHER ? A : A + (size_t)tile * BM * 1024 * esz; u.b = WT + (size_t)e * estride + (size_t)pn * BM * 1024 * esz; u.row0 = tile * BM; u.col0 = pn * BM; u.e = e; u.pad = 0; return true;
    }
};
typedef MoeOrderT<false> MoeOrder;

#define EPI_ROW(ai, m) (u.row0 + (ai) * HALF + wr * 64 + (m) * 16 + fr)
#define EPI_COL(bj) (u.col0 + (bj) * HALF + wc * 32 + 8 * fq)
struct EpiBf16 {
    bf16_t* O; const float* bias; int ldc, bias_es; float ascale;
    __device__ __forceinline__ void operator()(const Acc& acc, const Unit& u, int wr, int wc, int fr, int fq) const {
        f32x4 bv[2][2];
#pragma unroll
        for (int bj = 0; bj < 2; ++bj)
#pragma unroll
            for (int n = 0; n < 2; ++n) bv[bj][n] = bias ? *(const f32x4*)(bias + (size_t)u.e * bias_es + EPI_COL(bj) + 4 * n) : (f32x4){0.f, 0.f, 0.f, 0.f};
#pragma unroll
        for (int ai = 0; ai < 2; ++ai)
#pragma unroll
            for (int m = 0; m < 4; ++m) { bf16_t* rowp = O + (size_t)EPI_ROW(ai, m) * ldc;
#pragma unroll
                for (int bj = 0; bj < 2; ++bj) { const f32x4 v0 = acc[ai][bj][m][0] * ascale + bv[bj][0], v1 = acc[ai][bj][m][1] * ascale + bv[bj][1];
                    u32x4 w; w.x = cvt_pk_bf16(v0[0], v0[1]); w.y = cvt_pk_bf16(v0[2], v0[3]); w.z = cvt_pk_bf16(v1[0], v1[1]); w.w = cvt_pk_bf16(v1[2], v1[3]);
                    *(u32x4*)(rowp + EPI_COL(bj)) = w; } }
    }
};
template <int KIND> struct EpiNorm {
    bf16_t* O; int ldc; const float* ga; const float* gb; const float* gc; const float* gd; const float* ge; const float* cs; LAS float* S; float ascale;
    __device__ __forceinline__ void operator()(const Acc& acc, const Unit& u, int wr, int wc, int fr, int fq) const {
        const int pn = u.col0 >> 8; const int lane = fr + 16 * fq; const float as2 = ascale * ascale;
        int mode = 0; const float* gp = ga; float scale = 1.f;
        if (KIND == 0) { if (pn < 2) { mode = 1; gp = ga; scale = 0.125f * 1.4426950408889634f; } else if (pn < 4) { mode = 1; gp = gb; } else if (pn < 6) mode = 0; else if (pn == 6) { mode = 2; gp = gc; } else { mode = 3; gp = gd; } }
        if (KIND == 1) { scale = 0.10206207261596575f * 1.4426950408889634f; if (pn < 2) { mode = 1; gp = ga; } else { mode = 4; gp = gb; } }
        if (KIND == 2) { if (pn < 2) { mode = 1; gp = ga; } else mode = 0; }
        if (mode != 0) {
#pragma unroll
            for (int ai = 0; ai < 2; ++ai)
#pragma unroll
                for (int m = 0; m < 4; ++m)
#pragma unroll
                    for (int bj = 0; bj < 2; ++bj) { const f32x4 a = acc[ai][bj][m][0], b = acc[ai][bj][m][1];
                        float s = (a[0] * a[0] + a[1] * a[1]) + (a[2] * a[2] + a[3] * a[3]) + (b[0] * b[0] + b[1] * b[1]) + (b[2] * b[2] + b[3] * b[3]);
                        s += shx<16>(s); s = xadd32(s);
                        if (fq == 0) S[(ai * HALF + wr * 64 + m * 16 + fr) * 8 + bj * 4 + wc] = s; }
            asm volatile("s_waitcnt lgkmcnt(0)" ::: "memory"); __builtin_amdgcn_s_barrier(); asm volatile("" ::: "memory");
        }
        const float inv_n = (mode == 1) ? (1.f / 64.f) : (mode == 2) ? (1.f / 256.f) : (1.f / 32.f);
        const bool rope_tile = (mode == 4) || (mode == 3);
#pragma unroll
        for (int bj = 0; bj < 2; ++bj) {
            f32x4 g0 = (f32x4){1.f, 1.f, 1.f, 1.f}, g1 = g0; bool rope = false, zero = false; float invn = inv_n;
            int c8 = 8 * fq; asm volatile("" : "+v"(c8));
            if (mode == 1) { const int c = 32 * (wc & 1) + c8; g0 = *(const f32x4*)(gp + c); g1 = *(const f32x4*)(gp + c + 4); }
            else if (mode == 2) { const int c = bj * HALF + wc * 32 + c8; g0 = *(const f32x4*)(gp + c); g1 = *(const f32x4*)(gp + c + 4); }
            else if (mode == 3) { if (bj == 0) { const int c = wc * 32 + c8; g0 = *(const f32x4*)(gp + c); g1 = *(const f32x4*)(gp + c + 4); invn = 1.f / 128.f; }
                                  else if (wc == 0) { g0 = *(const f32x4*)(ge + c8); g1 = *(const f32x4*)(ge + c8 + 4); rope = true; } else zero = true; }
            else if (mode == 4) { g0 = *(const f32x4*)(gp + c8); g1 = *(const f32x4*)(gp + c8 + 4); rope = true; }
            (void)rope_tile;
#pragma unroll
            for (int ai = 0; ai < 2; ++ai)
#pragma unroll
                for (int m = 0; m < 4; ++m) { const int row = EPI_ROW(ai, m);
                    f32x4 v0 = acc[ai][bj][m][0], v1 = acc[ai][bj][m][1];
                    if (mode != 0) { const LAS float* sr = S + (ai * HALF + wr * 64 + m * 16 + fr) * 8; float tot;
                        if (mode == 1) { const f32x2 t = *(const LAS f32x2*)(sr + bj * 4 + (wc & 2)); tot = t[0] + t[1]; }
                        else if (mode == 2) { const f32x4 t0 = *(const LAS f32x4*)sr, t1 = *(const LAS f32x4*)(sr + 4); tot = (t0[0] + t0[1]) + (t0[2] + t0[3]) + (t1[0] + t1[1]) + (t1[2] + t1[3]); }
                        else if (mode == 3 && bj == 0) { const f32x4 t0 = *(const LAS f32x4*)sr; tot = (t0[0] + t0[1]) + (t0[2] + t0[3]); }
                        else tot = sr[bj * 4 + wc];
                        const float rs = rsqrtf(tot * as2 * invn + 1e-6f) * scale * ascale; v0 = v0 * rs * g0; v1 = v1 * rs * g1; } else { v0 = v0 * ascale; v1 = v1 * ascale; }
                    if (rope) {
                        const float* cr = cs + (size_t)row * 32 + 8 * (fq & 1); const f32x4 c0 = *(const f32x4*)cr, c1 = *(const f32x4*)(cr + 4), s0 = *(const f32x4*)(cr + 16), s1 = *(const f32x4*)(cr + 20);
                        f32x4 o0, o1;
#pragma unroll
                        for (int j = 0; j < 4; ++j) { const auto r0 = __builtin_amdgcn_permlane32_swap(__float_as_uint(v0[j]), __float_as_uint(v0[j]), false, false), r1 = __builtin_amdgcn_permlane32_swap(__float_as_uint(v1[j]), __float_as_uint(v1[j]), false, false);
                            const float ot0 = __uint_as_float(lane < 32 ? r0[1] : r0[0]), ot1 = __uint_as_float(lane < 32 ? r1[1] : r1[0]);
                            o0[j] = (lane < 32) ? (v0[j] * c0[j] - ot0 * s0[j]) : (ot0 * s0[j] + v0[j] * c0[j]);
                            o1[j] = (lane < 32) ? (v1[j] * c1[j] - ot1 * s1[j]) : (ot1 * s1[j] + v1[j] * c1[j]); }
                        v0 = o0; v1 = o1; }
                    if (zero) { v0 = (f32x4){0.f, 0.f, 0.f, 0.f}; v1 = v0; }
                    u32x4 w; w.x = cvt_pk_bf16(v0[0], v0[1]); w.y = cvt_pk_bf16(v0[2], v0[3]); w.z = cvt_pk_bf16(v1[0], v1[1]); w.w = cvt_pk_bf16(v1[2], v1[3]);
                    *(u32x4*)(O + (size_t)row * ldc + EPI_COL(bj)) = w; } }
    }
};
struct EpiRecIn {
    bf16_t* O; const float* bias;
    __device__ __forceinline__ void operator()(const Acc& acc, const Unit& u, int wr, int wc, int fr, int fq) const {
        const bool act = u.col0 < 1024;
        f32x4 bv[2][2];
#pragma unroll
        for (int bj = 0; bj < 2; ++bj)
#pragma unroll
            for (int n = 0; n < 2; ++n) bv[bj][n] = *(const f32x4*)(bias + EPI_COL(bj) + 4 * n);
#pragma unroll
        for (int ai = 0; ai < 2; ++ai)
#pragma unroll
            for (int m = 0; m < 4; ++m) { bf16_t* rowp = O + (size_t)EPI_ROW(ai, m) * 2048;
#pragma unroll
                for (int bj = 0; bj < 2; ++bj) { f32x4 v0 = acc[ai][bj][m][0] + bv[bj][0], v1 = acc[ai][bj][m][1] + bv[bj][1];
                    if (act) {
#pragma unroll
                        for (int j = 0; j < 4; ++j) { v0[j] = fgelu_tanh(v0[j]); v1[j] = fgelu_tanh(v1[j]); } }
                    u32x4 w; w.x = cvt_pk_bf16(v0[0], v0[1]); w.y = cvt_pk_bf16(v0[2], v0[3]); w.z = cvt_pk_bf16(v1[0], v1[1]); w.w = cvt_pk_bf16(v1[2], v1[3]);
                    *(u32x4*)(rowp + EPI_COL(bj)) = w; } }
    }
};
__device__ __forceinline__ unsigned pk4_fp8(float a, float b, float c, float d) { int w = 0; w = __builtin_amdgcn_cvt_pk_fp8_f32(a, b, w, false); w = __builtin_amdgcn_cvt_pk_fp8_f32(c, d, w, true); return (unsigned)w; }
struct EpiSwiglu {
    unsigned char* ACT; const float* b1; float ascale;
    __device__ __forceinline__ float sw(float g, float l) const { g = fminf(g, 7.f); l = fminf(fmaxf(l, -7.f), 7.f); return g * fsigmoid(1.702f * g) * (l + 1.f); }
    __device__ __forceinline__ void operator()(const Acc& acc, const Unit& u, int wr, int wc, int fr, int fq) const {
        f32x4 bv[2][2];
#pragma unroll
        for (int bj = 0; bj < 2; ++bj)
#pragma unroll
            for (int n = 0; n < 2; ++n) bv[bj][n] = *(const f32x4*)(b1 + (size_t)u.e * 2048 + EPI_COL(bj) + 4 * n);
#pragma unroll
        for (int ai = 0; ai < 2; ++ai)
#pragma unroll
            for (int m = 0; m < 4; ++m) { unsigned char* rowp = ACT + (size_t)EPI_ROW(ai, m) * 1024;
#pragma unroll
                for (int bj = 0; bj < 2; ++bj) { const f32x4 v0 = acc[ai][bj][m][0] * ascale + bv[bj][0], v1 = acc[ai][bj][m][1] * ascale + bv[bj][1];
                    *(unsigned*)(rowp + (EPI_COL(bj) >> 1)) = pk4_fp8(sw(v0[0], v0[1]), sw(v0[2], v0[3]), sw(v1[0], v1[1]), sw(v1[2], v1[3])); } }
    }
};
struct EpiResid {
    bf16_t* X; const float* g; const float* bias;
    __device__ __forceinline__ void operator()(const Acc& acc, const Unit& u, int wr, int wc, int fr, int fq) const {
        const int b = u.row0 / cfg::S;
        f32x4 bv[2][2], gv[2][2];
#pragma unroll
        for (int bj = 0; bj < 2; ++bj)
#pragma unroll
            for (int n = 0; n < 2; ++n) { bv[bj][n] = bias ? *(const f32x4*)(bias + EPI_COL(bj) + 4 * n) : (f32x4){0.f, 0.f, 0.f, 0.f}; gv[bj][n] = *(const f32x4*)(g + b * 6144 + EPI_COL(bj) + 4 * n); }
#pragma unroll
        for (int ai = 0; ai < 2; ++ai)
#pragma unroll
            for (int m = 0; m < 4; ++m) { bf16_t* rowp = X + (size_t)EPI_ROW(ai, m) * 1024;
#pragma unroll
                for (int bj = 0; bj < 2; ++bj) { u32x4* p = (u32x4*)(rowp + EPI_COL(bj)); const u32x4 xw = *p;
                    const f32x4 x0 = (f32x4){bf_lo(xw.x), bf_hi(xw.x), bf_lo(xw.y), bf_hi(xw.y)} + gv[bj][0] * (acc[ai][bj][m][0] + bv[bj][0]);
                    const f32x4 x1 = (f32x4){bf_lo(xw.z), bf_hi(xw.z), bf_lo(xw.w), bf_hi(xw.w)} + gv[bj][1] * (acc[ai][bj][m][1] + bv[bj][1]);
                    u32x4 w; w.x = cvt_pk_bf16(x0[0], x0[1]); w.y = cvt_pk_bf16(x0[2], x0[3]); w.z = cvt_pk_bf16(x1[0], x1[1]); w.w = cvt_pk_bf16(x1[2], x1[3]); *p = w; }
                if (m & 1) asm volatile("" ::: "memory"); }
    }
};
struct EpiLru {
    const bf16_t* XC; const float* ba; const float* bx; const float* lam; bf16_t* LA; bf16_t* Bb;
    __device__ __forceinline__ void operator()(const Acc& acc, const Unit& u, int wr, int wc, int fr, int fq) const {
        const int ch0 = u.col0 + wc * 32 + 8 * fq;
#pragma unroll
        for (int n = 0; n < 2; ++n) { const int ch = ch0 + 4 * n;
            const f32x4 bav = *(const f32x4*)(ba + ch), bxv = *(const f32x4*)(bx + ch), spv = *(const f32x4*)(lam + ch);
#pragma unroll
            for (int ai = 0; ai < 2; ++ai)
#pragma unroll
                for (int m = 0; m < 4; ++m) { const size_t ro = (size_t)EPI_ROW(ai, m) * 1024 + ch;
                    const u32x2 xr = *(const u32x2*)(XC + ro);
                    const float xcv[4] = {bf_lo(xr.x), bf_hi(xr.x), bf_lo(xr.y), bf_hi(xr.y)};
                    float lav[4], bvv[4];
#pragma unroll
                    for (int j = 0; j < 4; ++j) { const float r = fsigmoid(acc[ai][0][m][n][j] + bav[j]), ig = fsigmoid(acc[ai][1][m][n][j] + bxv[j]);
                        const float la = r * spv[j], a = fexp2(la); lav[j] = la; bvv[j] = __builtin_amdgcn_sqrtf(fmaxf(1.f - a * a, 0.f)) * ig * xcv[j]; }
                    u32x2 wa, wb; wa.x = cvt_pk_bf16(lav[0], lav[1]); wa.y = cvt_pk_bf16(lav[2], lav[3]); wb.x = cvt_pk_bf16(bvv[0], bvv[1]); wb.y = cvt_pk_bf16(bvv[2], bvv[3]);
                    *(u32x2*)(LA + ro) = wa; *(u32x2*)(Bb + ro) = wb; asm volatile("" ::: "memory"); } }
    }
};

constexpr size_t MiB = (size_t)1 << 20;
constexpr size_t al4k(size_t x) { return (x + 4095) & ~(size_t)4095; }
constexpr int T_ = cfg::T, S_ = cfg::S, P_ = cfg::P;
constexpr size_t O_CTL = 0, SZ_CTL = 1 * MiB;
constexpr size_t O_MOD = O_CTL + SZ_CTL, SZ_MOD = al4k((size_t)4 * 4 * 6144 * 4);
constexpr size_t O_CS = O_MOD + SZ_MOD, SZ_CS = (size_t)T_ * 32 * 4;
constexpr size_t O_HIST = O_CS + SZ_CS, SZ_HIST = 256 * 32 * 4;
constexpr size_t O_TOPI = O_HIST + SZ_HIST, SZ_TOP = (size_t)T_ * 4 * 4;
constexpr size_t O_TOPG = O_TOPI + SZ_TOP, O_POS = O_TOPG + SZ_TOP;
constexpr size_t O_SUMP = O_POS + SZ_TOP, SZ_SUM = (size_t)4 * 64 * 1024 * 4;
constexpr size_t O_SUMH = O_SUMP + SZ_SUM;
constexpr size_t O_LSE = O_SUMH + SZ_SUM, SZ_LSE = (size_t)3 * T_ * 8 * 4;
constexpr size_t O_SPV = al4k(O_LSE + SZ_LSE), SZ_SPV = 2 * 1024 * 4;
constexpr size_t O_WIN = al4k(O_SPV + SZ_SPV), SZ_WIN = (size_t)2048 * 1024;
constexpr size_t O_WUQ = O_WIN + 2 * SZ_WIN, SZ_WUQ = (size_t)768 * 256 * 2;
constexpr size_t O_WUKV = O_WUQ + 2 * SZ_WUQ, SZ_WUKV = (size_t)1024 * 128 * 2;
constexpr size_t O_WOUT = O_WUKV + 2 * SZ_WUKV, SZ_WOUT = (size_t)1024 * 1024 * 2;
constexpr size_t O_RWIN = O_WOUT + 2 * SZ_WOUT, SZ_RWIN = (size_t)2048 * 1024 * 2;
constexpr size_t O_RGATE = O_RWIN + 2 * SZ_RWIN, SZ_RGATE = (size_t)8 * 256 * 128 * 2;
constexpr size_t O_RWOUT = O_RGATE + 2 * SZ_RGATE, SZ_RWOUT = (size_t)1024 * 1024 * 2;
constexpr size_t O_W1 = O_RWOUT + 2 * SZ_RWOUT, SZ_W1E = (size_t)2048 * 1024;
constexpr size_t O_W2 = O_W1 + 128 * SZ_W1E, SZ_W2E = (size_t)1024 * 1024;
constexpr size_t O_HN = O_W2 + 128 * SZ_W2E, SZ_HN = (size_t)T_ * 1024 * 2;
constexpr size_t O_PROJ = O_HN + SZ_HN, SZ_PROJ = (size_t)T_ * 2048 * 2;
constexpr size_t O_Q2 = O_PROJ + SZ_PROJ, SZ_Q2 = (size_t)T_ * 768 * 2;
constexpr size_t O_KV2 = O_Q2 + SZ_Q2, SZ_KV2 = (size_t)T_ * 1024 * 2;
constexpr size_t O_OA = O_KV2 + SZ_KV2, SZ_OA = (size_t)3 * T_ * 512 * 2;
constexpr size_t O_ATT = O_OA + SZ_OA, SZ_ATT = (size_t)T_ * 1024 * 2;
constexpr size_t O_XC = O_ATT + SZ_ATT, SZ_XC = (size_t)T_ * 1024 * 2;
constexpr size_t O_AA = O_XC + SZ_XC, SZ_AA = (size_t)T_ * 1024 * 4;
constexpr size_t O_BB = O_AA + SZ_AA;
constexpr size_t O_XG = O_BB + SZ_AA, SZ_XG = (size_t)P_ * 1024 * 2, O_INV = O_XG, O_POSJ = O_XG + 4 * MiB;
constexpr size_t O_ACT = O_XG + SZ_XG, O_Y2 = O_ACT + SZ_XG;
constexpr size_t O_X = O_Y2 + SZ_XG, SZ_X = (size_t)T_ * 1024 * 2;
constexpr size_t O_DUMMY = O_X + SZ_X, SZ_DUMMY = (size_t)96 * MiB;
constexpr size_t WS_MK_END = O_DUMMY + SZ_DUMMY;
constexpr size_t O_NAIVE = (size_t)2048 * MiB;
static_assert(WS_MK_END <= O_NAIVE, "mk workspace");
constexpr int CW_BAR = 4096;
constexpr size_t O_ECNT = O_CTL + 512 * 1024;
constexpr int RING_BYTES = 131072, LDSX_OFF = RING_BYTES;
constexpr int LDS_BYTES = 147456;
constexpr int LX_TILE = LDSX_OFF + 64, LX_MISC = LDSX_OFF + 2048, LX_EXCH = LDSX_OFF + 6144, LX_GTAB = LX_EXCH, GTAB_UNITS = 10;

struct Args { const void* in[34]; float* out; unsigned char* ws; int ph_lo, ph_hi; };
struct Ctx { int tid, lane, wave, G, bid, vcu, gw, NGW; LAS unsigned char* lds; unsigned char* ws; };

__device__ __forceinline__ void conv_load(f32x4 (&v)[16], const float* __restrict__ W, int N, int n0, int k0, int lane) {
    const int n = n0 + 4 * (lane & 15); const float* p = W + (size_t)(k0 + 16 * (lane >> 4)) * N + n;
#pragma unroll
    for (int i = 0; i < 16; ++i) v[i] = (n < N) ? __builtin_nontemporal_load((const f32x4*)(p + (size_t)i * N)) : (f32x4){0.f, 0.f, 0.f, 0.f};
}
__device__ __forceinline__ int conv_row(int c, int perm) { if (perm == 1) { const int h = c / 96, d = c % 96; return d < 64 ? 64 * h + d : 512 + 32 * h + d - 64; } if (perm == 2) { const int h = c >> 7, d = c & 127; return d < 64 ? 64 * h + d : 512 + 64 * h + d - 64; } return c; }
__device__ __forceinline__ void conv_emit(const f32x4 (&v)[16], LAS unsigned char* T  , bf16_t* __restrict__ WT, int ldd, int n0, int k0, int lane, int perm) {
    const int kq = lane >> 4, c4 = lane & 15;
#pragma unroll
    for (int jj = 0; jj < 4; ++jj) { u32x4 lo, hi;
        lo.x = cvt_pk_bf16(v[0][jj], v[1][jj]); lo.y = cvt_pk_bf16(v[2][jj], v[3][jj]); lo.z = cvt_pk_bf16(v[4][jj], v[5][jj]); lo.w = cvt_pk_bf16(v[6][jj], v[7][jj]);
        hi.x = cvt_pk_bf16(v[8][jj], v[9][jj]); hi.y = cvt_pk_bf16(v[10][jj], v[11][jj]); hi.z = cvt_pk_bf16(v[12][jj], v[13][jj]); hi.w = cvt_pk_bf16(v[14][jj], v[15][jj]);
        LAS unsigned char* q = T + (4 * c4 + jj) * 144 + 32 * kq; *(LAS u32x4*)q = lo; *(LAS u32x4*)(q + 16) = hi; }
    asm volatile("s_waitcnt lgkmcnt(0)" ::: "memory");
#pragma unroll
    for (int s8 = 0; s8 < 8; ++s8) { const int n = 8 * s8 + (lane >> 3), ch = lane & 7; const u32x4 w = *(const LAS u32x4*)(T + n * 144 + 16 * ch);
        *(u32x4*)(WT + (size_t)conv_row(n0 + n, perm) * ldd + k0 + 8 * ch) = w; }
    asm volatile("s_waitcnt lgkmcnt(0)" ::: "memory");
}
__device__ __forceinline__ void conv8_tile(const float* __restrict__ W, int N, unsigned char* __restrict__ WT, int ldd, int n0, int k0, LAS unsigned char* T  , int lane) {
    const int kq = lane >> 4, c4 = lane & 15; const float* p = W + (size_t)(k0 + 32 * kq) * N + n0 + 4 * c4;
    f32x4 v[32];
#pragma unroll
    for (int i = 0; i < 32; ++i) v[i] = (n0 + 4 * c4 < N) ? __builtin_nontemporal_load((const f32x4*)(p + (size_t)i * N)) : (f32x4){0.f, 0.f, 0.f, 0.f};
#pragma unroll
    for (int jj = 0; jj < 4; ++jj) { u32x4 lo, hi;
        lo.x = pk4_fp8(32.f * v[0][jj], 32.f * v[1][jj], 32.f * v[2][jj], 32.f * v[3][jj]);     lo.y = pk4_fp8(32.f * v[4][jj], 32.f * v[5][jj], 32.f * v[6][jj], 32.f * v[7][jj]);
        lo.z = pk4_fp8(32.f * v[8][jj], 32.f * v[9][jj], 32.f * v[10][jj], 32.f * v[11][jj]);   lo.w = pk4_fp8(32.f * v[12][jj], 32.f * v[13][jj], 32.f * v[14][jj], 32.f * v[15][jj]);
        hi.x = pk4_fp8(32.f * v[16][jj], 32.f * v[17][jj], 32.f * v[18][jj], 32.f * v[19][jj]); hi.y = pk4_fp8(32.f * v[20][jj], 32.f * v[21][jj], 32.f * v[22][jj], 32.f * v[23][jj]);
        hi.z = pk4_fp8(32.f * v[24][jj], 32.f * v[25][jj], 32.f * v[26][jj], 32.f * v[27][jj]); hi.w = pk4_fp8(32.f * v[28][jj], 32.f * v[29][jj], 32.f * v[30][jj], 32.f * v[31][jj]);
        LAS unsigned char* q = T + (4 * c4 + jj) * 144 + 32 * kq; *(LAS u32x4*)q = lo; *(LAS u32x4*)(q + 16) = hi; }
    asm volatile("s_waitcnt lgkmcnt(0)" ::: "memory");
#pragma unroll
    for (int s8 = 0; s8 < 8; ++s8) { const int n = 8 * s8 + (lane >> 3), ch = lane & 7; const u32x4 w = *(const LAS u32x4*)(T + n * 144 + 16 * ch);
        *(u32x4*)(WT + (size_t)(n0 + n) * ldd + k0 + 16 * ch) = w; }
    asm volatile("s_waitcnt lgkmcnt(0)" ::: "memory");
}
template <class AP> __device__ __forceinline__ void p0_prologue(const Ctx& C, AP a) {
    unsigned char* ws = C.ws;
    { const float* c = (const float*)a->in[1]; const float* ada_w = (const float*)a->in[3]; const float* ada_b = (const float*)a->in[4]; float* mod = (float*)(ws + O_MOD);
      LAS float* part = (LAS float*)C.lds;
      LAS float* cact = (LAS float*)(C.lds + 32768);
      if (C.bid < 4 * 24) { for (int i = C.tid; i < 4096; i += 512) { const int b = i >> 10, k = i & 1023; const float cv = c[i]; cact[k * 4 + b] = cv / (1.f + expf(-cv)); } __syncthreads(); }
      for (int it = C.bid; it < 4 * 24; it += C.G) { const int l = it / 24, n0 = (it % 24) * 256;
          f32x4 acc[4];
#pragma unroll
          for (int b = 0; b < 4; ++b) acc[b] = (f32x4){0.f, 0.f, 0.f, 0.f};
          const float* w = ada_w + (size_t)l * 1024 * 6144 + n0 + 4 * C.lane;
#pragma unroll 1
          for (int k0 = C.wave * 128; k0 < C.wave * 128 + 128; k0 += 16) { f32x4 wv[16];
#pragma unroll
              for (int i = 0; i < 16; ++i) wv[i] = __builtin_nontemporal_load((const f32x4*)(w + (size_t)(k0 + i) * 6144));
#pragma unroll
              for (int i = 0; i < 16; ++i) { const f32x4 sv = *(const LAS f32x4*)(cact + (k0 + i) * 4);
#pragma unroll
                  for (int b = 0; b < 4; ++b) acc[b] = acc[b] + sv[b] * wv[i]; } }
#pragma unroll
          for (int b = 0; b < 4; ++b) *(LAS f32x4*)(part + (C.wave * 4 + b) * 256 + 4 * C.lane) = acc[b];
          __syncthreads();
          for (int o = C.tid; o < 1024; o += 512) { const int b = o >> 8, n = o & 255; float sacc = ada_b[l * 6144 + n0 + n];
#pragma unroll
              for (int w8 = 0; w8 < 8; ++w8) sacc += part[(w8 * 4 + b) * 256 + n];
              mod[((size_t)l * 4 + b) * 6144 + n0 + n] = sacc; }
          __syncthreads(); } }
    { const int* positions = (const int*)a->in[2]; float* cs = (float*)(ws + O_CS);
      for (int i = C.bid * 512 + C.tid; i < T_ * 16; i += C.G * 512) { const int t = i >> 4, f = i & 15; const float inv = powf(10000.f, -(float)(2 * f) / 32.f); const float ang = (float)positions[t] * inv;
          cs[t * 32 + f] = cosf(ang); cs[t * 32 + 16 + f] = sinf(ang); } }
    { const float* lam = (const float*)a->in[25]; float* spv = (float*)(ws + O_SPV);
      for (int i = C.bid * 512 + C.tid; i < 2048; i += C.G * 512) spv[i] = -8.f * 1.4426950408889634f * log1pf(expf(-lam[i])); }
    { const int lane = C.lane; LAS unsigned char* T = C.lds + 49152 + C.wave * 9216;
      const float* attn_w_in = (const float*)a->in[7]; const float* w_uq = (const float*)a->in[12]; const float* w_ukv = (const float*)a->in[13]; const float* attn_w_out = (const float*)a->in[16];
      const float* rec_w_in = (const float*)a->in[17]; const float* rec_wa = (const float*)a->in[21]; const float* rec_wx = (const float*)a->in[23]; const float* rec_w_out = (const float*)a->in[26];
      const float* w1 = (const float*)a->in[30]; const float* w2 = (const float*)a->in[32];
      constexpr int T_WIN = 32 * 16, T_WUQ = 12 * 4, T_WUKV = 16 * 2, T_WOUT = 16 * 16, T_RWIN = 32 * 16, T_RG = 2 * 2, T_RWOUT = 16 * 16, T_W1 = 32 * 16, T_W2 = 16 * 16;
      constexpr int NITEMS = 2 * (T_WUQ + T_WUKV + T_WOUT + T_RWIN + 16 * T_RG + T_RWOUT);
      struct Job { const float* W; bf16_t* WT; int N, ldd, n0, k0, perm; };
      auto decode = [&](int r, Job& jb) {
#define CONV_JOB(SRC, KK, NN, DST, NROWS, NMAT, SRC_MS, DST_MS, PERM) { constexpr int kc_ = (KK) / 64, per_ = ((NROWS) / 64) * kc_, tot_ = per_ * (NMAT); \
          if (r < tot_) { const int mat_ = r / per_, q_ = r % per_; jb.W = (SRC) + (size_t)mat_ * (SRC_MS); jb.WT = (bf16_t*)(ws + (DST) + (size_t)mat_ * (DST_MS)); jb.N = (NN); jb.ldd = (KK); jb.n0 = (q_ / kc_) * 64; jb.k0 = (q_ % kc_) * 64; jb.perm = (PERM); return; } r -= tot_; }
          CONV_JOB(w_uq, 256, 768, O_WUQ, 768, 2, (size_t)256 * 768, SZ_WUQ, 1)
          CONV_JOB(w_ukv, 128, 1024, O_WUKV, 1024, 2, (size_t)128 * 1024, SZ_WUKV, 2)
          CONV_JOB(attn_w_out, 1024, 1024, O_WOUT, 1024, 2, (size_t)1024 * 1024, SZ_WOUT, 0)
          CONV_JOB(rec_w_in, 1024, 2048, O_RWIN, 2048, 2, (size_t)1024 * 2048, SZ_RWIN, 0)
          CONV_JOB(rec_wa, 128, 128, O_RGATE, 128, 16, (size_t)128 * 128, (size_t)256 * 128 * 2, 0)
          CONV_JOB(rec_wx, 128, 128, O_RGATE + (size_t)128 * 128 * 2, 128, 16, (size_t)128 * 128, (size_t)256 * 128 * 2, 0)
          CONV_JOB(rec_w_out, 1024, 1024, O_RWOUT, 1024, 2, (size_t)1024 * 1024, SZ_RWOUT, 0)
#undef CONV_JOB
          jb.W = attn_w_out; jb.WT = (bf16_t*)(ws + O_WOUT); jb.N = 1024; jb.ldd = 1024; jb.n0 = 0; jb.k0 = 0; jb.perm = 0; };
      f32x4 va[16], vb[16]; Job ja, jn;
      int it = C.gw;
      if (it < NITEMS) { decode(it, ja); conv_load(va, ja.W, ja.N, ja.n0, ja.k0, lane); }
#pragma unroll 1
      for (; it < NITEMS; it += 2 * C.NGW) {
          const bool h1 = it + C.NGW < NITEMS;
          if (h1) { decode(it + C.NGW, jn); conv_load(vb, jn.W, jn.N, jn.n0, jn.k0, lane); }
          conv_emit(va, T, ja.WT, ja.ldd, ja.n0, ja.k0, lane, ja.perm);
          const bool h2 = it + 2 * C.NGW < NITEMS;
          if (h2) { decode(it + 2 * C.NGW, ja); conv_load(va, ja.W, ja.N, ja.n0, ja.k0, lane); }
          if (h1) conv_emit(vb, T, jn.WT, jn.ldd, jn.n0, jn.k0, lane, jn.perm);
      }
      { constexpr int IM = 32 * 8;
#pragma unroll 1
        for (int i8 = C.gw; i8 < 2 * IM; i8 += C.NGW) { const int mat = i8 / IM, q = i8 % IM;
            conv8_tile(attn_w_in + (size_t)mat * 1024 * 1952, 1952, ws + O_WIN + (size_t)mat * SZ_WIN, 1024, (q >> 3) * 64, (q & 7) * 128, T, lane); } }
    }
}

__device__ __forceinline__ void phase_norm(const Ctx& C, const float* xin  , float* out  , bool combine, bool do_norm, const float* gain, const float* modc  , const float* modl  , int shoff, int scoff, bool dummy = false, bool f8 = false  ) {
    const bf16_t* Y2 = (const bf16_t*)(C.ws + O_Y2); const int* pos = (const int*)(C.ws + O_POS); const float* topg = (const float*)(C.ws + O_TOPG); bf16_t* HN = (bf16_t*)(C.ws + (dummy ? O_DUMMY : O_HN)); const bf16_t* X = (const bf16_t*)(C.ws + O_X); bf16_t* Xo = (bf16_t*)(C.ws + (dummy ? O_DUMMY + 32 * MiB : O_X));
    const int lane = C.lane;
    for (int t = C.gw; t < T_; t += C.NGW) { const int b = t / S_;
        f32x4 v[4];
        if (xin) {
#pragma unroll
            for (int j = 0; j < 4; ++j) v[j] = *(const f32x4*)(xin + (size_t)t * 1024 + 256 * j + 4 * lane); }
        else {
#pragma unroll
            for (int j = 0; j < 4; ++j) { const u32x2 w = *(const u32x2*)(X + (size_t)t * 1024 + 256 * j + 4 * lane); v[j] = (f32x4){bf_lo(w.x), bf_hi(w.x), bf_lo(w.y), bf_hi(w.y)}; } }
        if (combine) { f32x4 y[4];
#pragma unroll
            for (int j = 0; j < 4; ++j) y[j] = (f32x4){0.f, 0.f, 0.f, 0.f};
#pragma unroll
            for (int k = 0; k < 4; ++k) { const int p = pos[t * 4 + k]; const float gk = topg[t * 4 + k];
#pragma unroll
                for (int j = 0; j < 4; ++j) { const u32x2 w = *(const u32x2*)(Y2 + (size_t)p * 1024 + 256 * j + 4 * lane);
                    y[j][0] += gk * bf_lo(w.x); y[j][1] += gk * bf_hi(w.x); y[j][2] += gk * bf_lo(w.y); y[j][3] += gk * bf_hi(w.y); } }
#pragma unroll
            for (int j = 0; j < 4; ++j) { const f32x4 g2 = *(const f32x4*)(modc + b * 6144 + 5120 + 256 * j + 4 * lane); v[j] = v[j] + g2 * y[j]; } }
        if (out) {
#pragma unroll
            for (int j = 0; j < 4; ++j) *(f32x4*)(out + (size_t)t * 1024 + 256 * j + 4 * lane) = v[j]; }
        else {
#pragma unroll
            for (int j = 0; j < 4; ++j) { u32x2 w; w.x = cvt_pk_bf16(v[j][0], v[j][1]); w.y = cvt_pk_bf16(v[j][2], v[j][3]); *(u32x2*)(Xo + (size_t)t * 1024 + 256 * j + 4 * lane) = w; } }
        if (do_norm) { float ss = 0.f;
#pragma unroll
            for (int j = 0; j < 4; ++j) ss += (v[j][0] * v[j][0] + v[j][1] * v[j][1]) + (v[j][2] * v[j][2] + v[j][3] * v[j][3]);
            const float rs = rsqrtf(wsum(ss) * (1.f / 1024.f) + 1e-6f);
#pragma unroll
            for (int j = 0; j < 4; ++j) { const int col = 256 * j + 4 * lane; const f32x4 gn = *(const f32x4*)(gain + col), sc = *(const f32x4*)(modl + b * 6144 + scoff + col), sh = *(const f32x4*)(modl + b * 6144 + shoff + col);
                const f32x4 h = v[j] * rs * gn * (1.f + sc) + sh;
                if (f8) *(unsigned*)((unsigned char*)HN + (size_t)t * 1024 + col) = pk4_fp8(h[0], h[1], h[2], h[3]);
                else { u32x2 w; w.x = cvt_pk_bf16(h[0], h[1]); w.y = cvt_pk_bf16(h[2], h[3]); *(u32x2*)(HN + (size_t)t * 1024 + col) = w; } } }
    }
}

__device__ __forceinline__ void unpack8(const u32x4 w, float (&f)[8]) { f[0] = bf_lo(w.x); f[1] = bf_hi(w.x); f[2] = bf_lo(w.y); f[3] = bf_hi(w.y); f[4] = bf_lo(w.z); f[5] = bf_hi(w.z); f[6] = bf_lo(w.w); f[7] = bf_hi(w.w); }
__device__ __forceinline__ u32x4 pack8(const float (&f)[8]) { u32x4 w; w.x = cvt_pk_bf16(f[0], f[1]); w.y = cvt_pk_bf16(f[2], f[3]); w.z = cvt_pk_bf16(f[4], f[5]); w.w = cvt_pk_bf16(f[6], f[7]); return w; }

constexpr float LOG2E = 1.4426950408889634f;
__device__ __forceinline__ void phase_postproj(const Ctx& C, const float* qg, const float* kg, const float* qag, const float* kvag, const float* mkg) {
    bf16_t* PROJ = (bf16_t*)(C.ws + O_PROJ); const float* cs = (const float*)(C.ws + O_CS); const int lane = C.lane;
    for (int t = C.gw; t < T_; t += C.NGW) { bf16_t* row = PROJ + (size_t)t * 2048;
#pragma unroll
        for (int ps = 0; ps < 2; ++ps) { bf16_t* p = row + ps * 512 + 8 * lane; float f[8]; unpack8(*(const u32x4*)p, f); float ss = 0.f;
#pragma unroll
            for (int i = 0; i < 8; ++i) ss += f[i] * f[i];
            ss += shx<1>(ss); ss += shx<2>(ss); ss += shx<4>(ss);
            const float rs = rsqrtf(ss * (1.f / 64.f) + 1e-6f) * (ps == 0 ? 0.125f * LOG2E : 1.f); const float* g = (ps == 0 ? qg : kg) + 8 * (lane & 7);
#pragma unroll
            for (int i = 0; i < 8; ++i) f[i] = f[i] * rs * g[i];
            *(u32x4*)p = pack8(f); }
        { bf16_t* p = row + 1536 + 8 * lane; float f[8]; unpack8(*(const u32x4*)p, f); float ss = 0.f;
#pragma unroll
            for (int i = 0; i < 8; ++i) ss += f[i] * f[i];
            ss += shx<1>(ss); ss += shx<2>(ss);
            { const float o4 = shx<4>(ss); if (lane < 48) ss += o4; } { const float o8 = shx<8>(ss); if (lane < 48) ss += o8; } { const float o16 = shx<16>(ss); if (lane < 32) ss += o16; }
            const float nrm = lane < 32 ? 256.f : (lane < 48 ? 128.f : 32.f);
            const float rs = rsqrtf(ss / nrm + 1e-6f);
            const float* g = lane < 32 ? (qag + 8 * lane) : (lane < 48 ? (kvag + 8 * (lane - 32)) : (mkg + 64 + 8 * ((lane - 48) & 3)));
#pragma unroll
            for (int i = 0; i < 8; ++i) f[i] = f[i] * rs * g[i];
            float o[8];
#pragma unroll
            for (int i = 0; i < 8; ++i) { const float other = shx<2>(f[i]); const int fi = ((lane & 1) << 3) + i; const float cv = cs[t * 32 + fi], sv = cs[t * 32 + 16 + fi];
                o[i] = (lane & 2) ? (other * sv + f[i] * cv) : (f[i] * cv - other * sv); }
            if (lane >= 48 && lane < 52) {
#pragma unroll
                for (int i = 0; i < 8; ++i) f[i] = o[i]; }
            if (lane < 52) *(u32x4*)p = pack8(f); }
    }
}
__device__ __forceinline__ void phase_postq(const Ctx& C, const float* mqg, const float* mkg) {
    bf16_t* Q2 = (bf16_t*)(C.ws + O_Q2); bf16_t* KV2 = (bf16_t*)(C.ws + O_KV2); const float* cs = (const float*)(C.ws + O_CS); const int lane = C.lane;
    const float qscale = 0.10206207261596575f * LOG2E;
    for (int t = C.gw; t < T_; t += C.NGW) {
        { bf16_t* p = Q2 + (size_t)t * 768 + (lane >> 3) * 96 + 8 * (lane & 7); float f[8]; unpack8(*(const u32x4*)p, f); float ss = 0.f;
#pragma unroll
            for (int i = 0; i < 8; ++i) ss += f[i] * f[i];
            ss += shx<1>(ss); ss += shx<2>(ss); ss += shx<4>(ss);
            const float rs = rsqrtf(ss * (1.f / 64.f) + 1e-6f) * qscale; const float* g = mqg + 8 * (lane & 7);
#pragma unroll
            for (int i = 0; i < 8; ++i) f[i] = f[i] * rs * g[i];
            *(u32x4*)p = pack8(f); }
        { const int l2 = lane & 31; bf16_t* p = Q2 + (size_t)t * 768 + (l2 >> 2) * 96 + 64 + 8 * (l2 & 3); float f[8]; unpack8(*(const u32x4*)p, f); float ss = 0.f;
#pragma unroll
            for (int i = 0; i < 8; ++i) ss += f[i] * f[i];
            ss += shx<1>(ss); ss += shx<2>(ss);
            const float rs = rsqrtf(ss * (1.f / 32.f) + 1e-6f) * qscale; const float* g = mqg + 64 + 8 * (l2 & 3);
#pragma unroll
            for (int i = 0; i < 8; ++i) f[i] = f[i] * rs * g[i];
            float o[8];
#pragma unroll
            for (int i = 0; i < 8; ++i) { const float other = shx<2>(f[i]); const int fi = ((lane & 1) << 3) + i; const float cv = cs[t * 32 + fi], sv = cs[t * 32 + 16 + fi];
                o[i] = (lane & 2) ? (other * sv + f[i] * cv) : (f[i] * cv - other * sv); }
            if (lane < 32) *(u32x4*)p = pack8(o); }
        { bf16_t* p = KV2 + (size_t)t * 1024 + (lane >> 3) * 128 + 8 * (lane & 7); float f[8]; unpack8(*(const u32x4*)p, f); float ss = 0.f;
#pragma unroll
            for (int i = 0; i < 8; ++i) ss += f[i] * f[i];
            ss += shx<1>(ss); ss += shx<2>(ss); ss += shx<4>(ss);
            const float rs = rsqrtf(ss * (1.f / 64.f) + 1e-6f); const float* g = mkg + 8 * (lane & 7);
#pragma unroll
            for (int i = 0; i < 8; ++i) f[i] = f[i] * rs * g[i];
            *(u32x4*)p = pack8(f); }
    }
}
__device__ __forceinline__ void phase_mixcombine(const Ctx& C) {
    const bf16_t* OA = (const bf16_t*)(C.ws + O_OA); const float* LSE = (const float*)(C.ws + O_LSE); bf16_t* ATT = (bf16_t*)(C.ws + O_ATT); const int lane = C.lane;
    for (int t = C.gw; t < T_; t += C.NGW) { const int h = lane >> 3;
        float ls[3], mx = -INFINITY;
#pragma unroll
        for (int p = 0; p < 3; ++p) { ls[p] = LSE[((size_t)p * T_ + t) * 8 + h]; mx = fmaxf(mx, ls[p]); }
        float w[3], den = 0.f;
#pragma unroll
        for (int p = 0; p < 3; ++p) { w[p] = fexp2(ls[p] - mx); den += w[p]; }
        const float inv = 1.f / den; float o[8];
#pragma unroll
        for (int i = 0; i < 8; ++i) o[i] = 0.f;
#pragma unroll
        for (int p = 0; p < 3; ++p) { float f[8]; unpack8(*(const u32x4*)(OA + ((size_t)p * T_ + t) * 512 + 8 * lane), f); const float wp = w[p] * inv;
#pragma unroll
            for (int i = 0; i < 8; ++i) o[i] += wp * f[i]; }
        *(u32x4*)(ATT + (size_t)t * 1024 + 8 * lane) = pack8(o); }
}
__device__ __forceinline__ void phase_rgate(const Ctx& C, int j, const float* cw, const float* cb, const float* ba, const float* bx) {
    const bf16_t* PROJ = (const bf16_t*)(C.ws + O_PROJ); const bf16_t* RG = (const bf16_t*)(C.ws + O_RGATE + (size_t)j * SZ_RGATE); const float* spvg = (const float*)(C.ws + O_SPV) + j * 1024;
    bf16_t* LA = (bf16_t*)(C.ws + O_AA); bf16_t* Bb = (bf16_t*)(C.ws + O_BB); float* SP = (float*)(C.ws + O_SUMP); float* SH = (float*)(C.ws + O_SUMH);
    constexpr int WROW = 272;
    LAS unsigned char* Wl = C.lds;
    LAS unsigned char* Xl = C.lds + 256 * WROW;
    LAS unsigned char* Al = Xl + 64 * WROW;
    LAS unsigned char* Bl = Al + 64 * WROW;
    const int tid = C.tid, lane = C.lane, w = C.wave;
    if (C.G % 8 != 0) return;
    const int n = C.bid & 7, g = C.bid >> 3, ng = C.G >> 3;
    for (int i = tid; i < 256 * 16; i += 512) { const int r = i >> 4, c = i & 15; *(LAS u32x4*)(Wl + r * WROW + 16 * c) = *(const u32x4*)(RG + ((size_t)n * 256 + r) * 128 + 8 * c); }
    const int crow = tid >> 3, cg = tid & 7, cch = n * 128 + 16 * cg;
    float cwv[4][16], cbv[16];
#pragma unroll
    for (int q = 0; q < 4; ++q) { const f32x4 b4 = *(const f32x4*)(cb + cch + 4 * q); cbv[4 * q] = b4[0]; cbv[4 * q + 1] = b4[1]; cbv[4 * q + 2] = b4[2]; cbv[4 * q + 3] = b4[3];
#pragma unroll
        for (int k = 0; k < 4; ++k) { const f32x4 w4 = *(const f32x4*)(cw + k * 1024 + cch + 4 * q); cwv[k][4 * q] = w4[0]; cwv[k][4 * q + 1] = w4[1]; cwv[k][4 * q + 2] = w4[2]; cwv[k][4 * q + 3] = w4[3]; } }
    const int mt = w & 3, h = w >> 2, l15 = lane & 15, kg = lane >> 4;
    float bav[4], bxv[4], spv[4];
#pragma unroll
    for (int jj = 0; jj < 4; ++jj) { const int ch = n * 128 + 16 * (4 * h + jj) + l15; bav[jj] = ba[ch]; bxv[jj] = bx[ch]; spv[jj] = spvg[ch]; }
    __syncthreads();
    for (int c = g; c < 256; c += ng) { const size_t row0 = (size_t)c * 64; const int ts0 = (int)(row0 % S_);
        { float acc[16];
#pragma unroll
          for (int i = 0; i < 16; ++i) acc[i] = cbv[i];
#pragma unroll
          for (int k = 0; k < 4; ++k) { const int dt = k - 3; if (ts0 + crow + dt >= 0) { const bf16_t* src = PROJ + (row0 + crow + dt) * 2048 + 1024 + cch; float f0[8], f1[8]; unpack8(*(const u32x4*)src, f0); unpack8(*(const u32x4*)(src + 8), f1);
#pragma unroll
                  for (int i = 0; i < 8; ++i) { acc[i] += cwv[k][i] * f0[i]; acc[8 + i] += cwv[k][8 + i] * f1[i]; } } }
          float lo[8], hi8[8];
#pragma unroll
          for (int i = 0; i < 8; ++i) { lo[i] = acc[i]; hi8[i] = acc[8 + i]; }
          *(LAS u32x4*)(Xl + crow * WROW + 32 * cg) = pack8(lo); *(LAS u32x4*)(Xl + crow * WROW + 32 * cg + 16) = pack8(hi8); }
        __syncthreads();
        f32x4 acc[8];
#pragma unroll
        for (int t = 0; t < 8; ++t) acc[t] = (f32x4){0.f, 0.f, 0.f, 0.f};
#pragma unroll
        for (int ks = 0; ks < 4; ++ks) { const bf16x8 af = *(const LAS bf16x8*)(Xl + (16 * mt + l15) * WROW + 64 * ks + 16 * kg);
#pragma unroll
            for (int t = 0; t < 8; ++t) { const int nt = (t < 4) ? (4 * h + t) : (8 + 4 * h + (t - 4)); const bf16x8 bfr = *(const LAS bf16x8*)(Wl + (16 * nt + l15) * WROW + 64 * ks + 16 * kg);
                acc[t] = __builtin_amdgcn_mfma_f32_16x16x32_bf16(af, bfr, acc[t], 0, 0, 0); } }
#pragma unroll
        for (int jj = 0; jj < 4; ++jj) { const int e = 16 * (4 * h + jj) + l15;
#pragma unroll
            for (int r = 0; r < 4; ++r) { const int row = 16 * mt + 4 * kg + r; const float xc = bf_lo((unsigned)*(const LAS unsigned short*)(Xl + row * WROW + 2 * e));
                const float rr = fsigmoid(acc[jj][r] + bav[jj]), ig = fsigmoid(acc[4 + jj][r] + bxv[jj]); const float la = rr * spv[jj], av = fexp2(la);
                const float bv = __builtin_amdgcn_sqrtf(fmaxf(1.f - av * av, 0.f)) * ig * xc;
                *(LAS unsigned short*)(Al + row * WROW + 2 * e) = (unsigned short)(cvt_pk_bf16(la, la) & 0xffffu); *(LAS unsigned short*)(Bl + row * WROW + 2 * e) = (unsigned short)(cvt_pk_bf16(bv, bv) & 0xffffu); } }
        __syncthreads();
        { const size_t go = (row0 + crow) * 1024 + cch;
          *(u32x4*)(LA + go) = *(const LAS u32x4*)(Al + crow * WROW + 32 * cg); *(u32x4*)(LA + go + 8) = *(const LAS u32x4*)(Al + crow * WROW + 32 * cg + 16);
          *(u32x4*)(Bb + go) = *(const LAS u32x4*)(Bl + crow * WROW + 32 * cg); *(u32x4*)(Bb + go + 8) = *(const LAS u32x4*)(Bl + crow * WROW + 32 * cg + 16); }
        if (tid < 128) { float Pl = 0.f, Hh = 0.f;
#pragma unroll 8
            for (int r = 0; r < 64; ++r) { const float la = bf_lo((unsigned)*(const LAS unsigned short*)(Al + r * WROW + 2 * tid)), bv = bf_lo((unsigned)*(const LAS unsigned short*)(Bl + r * WROW + 2 * tid)); Hh = fexp2(la) * Hh + bv; Pl += la; }
            const int b = (int)(row0 / S_), ck = (int)((row0 % S_) >> 6); SP[((size_t)b * 64 + ck) * 1024 + n * 128 + tid] = fexp2(Pl); SH[((size_t)b * 64 + ck) * 1024 + n * 128 + tid] = Hh; }
        __syncthreads();
    }
}

__device__ __forceinline__ void scan_sum_item(const Ctx& C, int b, int ck, int cg) {
    const bf16_t* LA = (const bf16_t*)(C.ws + O_AA); const bf16_t* Bb = (const bf16_t*)(C.ws + O_BB); float* SP = (float*)(C.ws + O_SUMP); float* SH = (float*)(C.ws + O_SUMH);
    const int ch = cg * 128 + 2 * C.lane;
    size_t off = ((size_t)b * S_ + ck * 64) * 1024 + ch; f32x2 Pl = (f32x2){0.f, 0.f}, Hh = (f32x2){0.f, 0.f};
#pragma unroll 8
    for (int s = 0; s < 64; ++s, off += 1024) { const unsigned lw = *(const unsigned*)(LA + off), bw = *(const unsigned*)(Bb + off);
        const f32x2 lv = (f32x2){bf_lo(lw), bf_hi(lw)}, av = (f32x2){fexp2(lv[0]), fexp2(lv[1])}, bv = (f32x2){bf_lo(bw), bf_hi(bw)}; Hh = av * Hh + bv; Pl = Pl + lv; }
    *(f32x2*)(SP + ((size_t)b * 64 + ck) * 1024 + ch) = (f32x2){fexp2(Pl[0]), fexp2(Pl[1])}; *(f32x2*)(SH + ((size_t)b * 64 + ck) * 1024 + ch) = Hh;
}
__device__ __forceinline__ void phase_scan_sum_own(const Ctx& C) {
    asm volatile("s_waitcnt vmcnt(0)" ::: "memory"); __syncthreads();
    for (int i = 0; ; ++i) { const int L = i * C.G + C.bid; if (L >= 512) break; const int pm = L >> 3, n = L & 7;
        if (C.wave < 4) { const int row0 = pm * 256 + C.wave * 64; scan_sum_item(C, row0 / S_, (row0 % S_) >> 6, n); } }
}
__device__ __forceinline__ void phase_scan_apply(const Ctx& C) {
    const bf16_t* LA = (const bf16_t*)(C.ws + O_AA); const bf16_t* Bb = (const bf16_t*)(C.ws + O_BB); const float* SP = (const float*)(C.ws + O_SUMP); const float* SH = (const float*)(C.ws + O_SUMH);
    const bf16_t* PROJ = (const bf16_t*)(C.ws + O_PROJ); bf16_t* ATT = (bf16_t*)(C.ws + O_ATT); const int lane = C.lane;
    for (int it = C.gw; it < 4 * 64 * 8; it += C.NGW) { const int cg = it & 7, ck = (it >> 3) & 63, b = it >> 9; const int ch = cg * 128 + 2 * lane;
        f32x2 h = (f32x2){0.f, 0.f};
#pragma unroll 8
        for (int c2 = 0; c2 < ck; ++c2) { const f32x2 pv = *(const f32x2*)(SP + ((size_t)b * 64 + c2) * 1024 + ch), hv = *(const f32x2*)(SH + ((size_t)b * 64 + c2) * 1024 + ch); h = pv * h + hv; }
        size_t row = (size_t)b * S_ + ck * 64;
#pragma unroll 8
        for (int s = 0; s < 64; ++s, ++row) { const unsigned lw = *(const unsigned*)(LA + row * 1024 + ch), bw = *(const unsigned*)(Bb + row * 1024 + ch);
            const f32x2 av = (f32x2){fexp2(bf_lo(lw)), fexp2(bf_hi(lw))}, bv = (f32x2){bf_lo(bw), bf_hi(bw)}; h = av * h + bv;
            const unsigned gw2 = *(const unsigned*)(PROJ + row * 2048 + ch);
            *(unsigned*)(ATT + row * 1024 + ch) = cvt_pk_bf16(bf_lo(gw2) * h[0], bf_hi(gw2) * h[1]); } }
}

__device__ __forceinline__ void split_bf16(const f32x4 a, const f32x4 b, bf16x8& hi, bf16x8& lo) {
    u32x4 h; h.x = cvt_pk_bf16(a[0], a[1]); h.y = cvt_pk_bf16(a[2], a[3]); h.z = cvt_pk_bf16(b[0], b[1]); h.w = cvt_pk_bf16(b[2], b[3]);
    u32x4 l; l.x = cvt_pk_bf16(a[0] - bf_lo(h.x), a[1] - bf_hi(h.x)); l.y = cvt_pk_bf16(a[2] - bf_lo(h.y), a[3] - bf_hi(h.y)); l.z = cvt_pk_bf16(b[0] - bf_lo(h.z), b[1] - bf_hi(h.z)); l.w = cvt_pk_bf16(b[2] - bf_lo(h.w), b[3] - bf_hi(h.w));
    hi = __builtin_bit_cast(bf16x8, h); lo = __builtin_bit_cast(bf16x8, l);
}
__device__ __forceinline__ void phase_router(const Ctx& C, const bf16_t* X, const float* gain, const float* modl, const float* wr, const float* br, int layer) {
    unsigned char* HN8 = C.ws + O_HN; int* topi = (int*)(C.ws + O_TOPI); float* topg = (float*)(C.ws + O_TOPG); int* ecnt = (int*)(C.ws + O_ECNT) + layer * 32; int* inv = (int*)(C.ws + O_INV); int* posj = (int*)(C.ws + O_POSJ);
    LAS int* rk = (LAS int*)(C.lds + LX_MISC + 3072); LAS int* base = (LAS int*)(C.lds + LX_MISC + 512);
    constexpr int HROW = 1028;
    LAS float* hrow = (LAS float*)C.lds;
    LAS float* part = (LAS float*)(C.lds + 16 * HROW * 4);
    LAS int* hl = (LAS int*)(C.lds + LX_MISC);
    const int lane = C.lane, e = lane & 31, kh = lane >> 5, v = C.wave, l15 = lane & 15, kg = lane >> 4;
    bf16x8 whi[2][4], wlo[2][4];
#pragma unroll
    for (int nt = 0; nt < 2; ++nt)
#pragma unroll
        for (int ks = 0; ks < 4; ++ks) { const float* p = wr + (size_t)(128 * v + 32 * ks + 8 * kg) * 32 + 16 * nt + l15;
            const f32x4 a = (f32x4){p[0], p[32], p[64], p[96]}, b = (f32x4){p[128], p[160], p[192], p[224]}; split_bf16(a, b, whi[nt][ks], wlo[nt][ks]); }
    const float bias_e = br[e];
    if (C.tid < 32) hl[C.tid] = 0;
    __syncthreads();
    for (int ck = C.bid; ck < 256; ck += C.G) {
        const int b = (ck * 64) / S_;
        f32x4 gn[4], shv[4];
#pragma unroll
        for (int j = 0; j < 4; ++j) { const int col = 256 * j + 4 * lane; gn[j] = *(const f32x4*)(gain + col) * (1.f + *(const f32x4*)(modl + b * 6144 + 4096 + col)); shv[j] = *(const f32x4*)(modl + b * 6144 + 3072 + col); }
        u32x2 xr[2][4];
#pragma unroll
        for (int q = 0; q < 2; ++q)
#pragma unroll
            for (int j = 0; j < 4; ++j) xr[q][j] = *(const u32x2*)(X + (size_t)(ck * 64 + 2 * v + q) * 1024 + 256 * j + 4 * lane);
#pragma unroll 1
        for (int pass = 0; pass < 4; ++pass) { const int tb = ck * 64 + pass * 16;
#pragma unroll
            for (int q = 0; q < 2; ++q) { const int tt = 2 * v + q, t = tb + tt; f32x4 h[4]; float ss = 0.f;
#pragma unroll
                for (int j = 0; j < 4; ++j) { const u32x2 xw = xr[q][j]; h[j] = (f32x4){bf_lo(xw.x), bf_hi(xw.x), bf_lo(xw.y), bf_hi(xw.y)}; ss += (h[j][0] * h[j][0] + h[j][1] * h[j][1]) + (h[j][2] * h[j][2] + h[j][3] * h[j][3]); }
                const float rs = rsqrtf(wsum(ss) * (1.f / 1024.f) + 1e-6f);
#pragma unroll
                for (int j = 0; j < 4; ++j) { const int col = 256 * j + 4 * lane;
                    const f32x4 hv = h[j] * rs * gn[j] + shv[j];
                    *(unsigned*)(HN8 + (size_t)t * 1024 + col) = pk4_fp8(hv[0], hv[1], hv[2], hv[3]);
                    *(LAS f32x4*)(hrow + tt * HROW + col) = hv; } }
            if (pass < 3) {
#pragma unroll
                for (int q = 0; q < 2; ++q)
#pragma unroll
                    for (int j = 0; j < 4; ++j) xr[q][j] = *(const u32x2*)(X + (size_t)(tb + 16 + 2 * v + q) * 1024 + 256 * j + 4 * lane); }
            __syncthreads();
            { f32x4 acc0 = (f32x4){0.f, 0.f, 0.f, 0.f}, acc1 = acc0;
#pragma unroll
              for (int ks = 0; ks < 4; ++ks) { const LAS float* hp = hrow + l15 * HROW + 128 * v + 32 * ks + 8 * kg; bf16x8 ahi, alo; split_bf16(*(const LAS f32x4*)hp, *(const LAS f32x4*)(hp + 4), ahi, alo);
                  acc0 = __builtin_amdgcn_mfma_f32_16x16x32_bf16(ahi, whi[0][ks], acc0, 0, 0, 0); acc1 = __builtin_amdgcn_mfma_f32_16x16x32_bf16(ahi, whi[1][ks], acc1, 0, 0, 0);
                  acc0 = __builtin_amdgcn_mfma_f32_16x16x32_bf16(ahi, wlo[0][ks], acc0, 0, 0, 0); acc1 = __builtin_amdgcn_mfma_f32_16x16x32_bf16(ahi, wlo[1][ks], acc1, 0, 0, 0);
                  acc0 = __builtin_amdgcn_mfma_f32_16x16x32_bf16(alo, whi[0][ks], acc0, 0, 0, 0); acc1 = __builtin_amdgcn_mfma_f32_16x16x32_bf16(alo, whi[1][ks], acc1, 0, 0, 0); }
#pragma unroll
              for (int r = 0; r < 4; ++r) { part[((4 * kg + r) * 8 + v) * 32 + l15] = acc0[r]; part[((4 * kg + r) * 8 + v) * 32 + 16 + l15] = acc1[r]; } }
            __syncthreads();
            { const int tt = 2 * v + kh; float lg = bias_e;
#pragma unroll
              for (int w8 = 0; w8 < 8; ++w8) lg += part[(tt * 8 + w8) * 32 + e];
              int idx[4]; float val[4];
#pragma unroll
              for (int k = 0; k < 4; ++k) { float mx = lg;
                  mx = fmaxf(mx, shx<1>(mx)); mx = fmaxf(mx, shx<2>(mx)); mx = fmaxf(mx, shx<4>(mx)); mx = fmaxf(mx, shx<8>(mx)); mx = fmaxf(mx, shx<16>(mx));
                  const unsigned long long bal = __ballot(lg == mx); const unsigned bh = (unsigned)(bal >> (32 * kh)); const int sel = __ffs((int)bh) - 1;
                  idx[k] = sel; val[k] = mx; if (e == sel) lg = -INFINITY; }
              if (e == 0) { const int t = tb + tt; float ex[4], den = 0.f;
#pragma unroll
                  for (int k = 0; k < 4; ++k) { ex[k] = expf(val[k] - val[0]); den += ex[k]; }
#pragma unroll
                  for (int k = 0; k < 4; ++k) { topi[t * 4 + k] = idx[k]; topg[t * 4 + k] = ex[k] / den; const int r = __hip_atomic_fetch_add(hl + idx[k], 1, __ATOMIC_RELAXED, __HIP_MEMORY_SCOPE_WORKGROUP); rk[(pass * 16 + tt) * 4 + k] = (idx[k] << 8) | r; } } }
        }
        __syncthreads();
        if (C.tid < 32) { base[C.tid] = __hip_atomic_fetch_add(ecnt + C.tid, hl[C.tid], __ATOMIC_RELAXED, __HIP_MEMORY_SCOPE_AGENT); hl[C.tid] = 0; }
        __syncthreads();
        if (C.tid < 256) { const int pk = rk[C.tid], ex = pk >> 8, j = base[ex] + (pk & 255); inv[ex * 16384 + j] = ck * 64 + (C.tid >> 2); posj[ck * 256 + C.tid] = j; }
        __syncthreads();
    }
}
__device__ __forceinline__ void moe_plan_lds(const Ctx& C, int layer) {
    const int* ecnt = (const int*)(C.ws + O_ECNT) + layer * 32;
    LAS int* tot = (LAS int*)(C.lds + LX_MISC + 256); LAS int* pst = tot + 32; LAS int* tile_e = (LAS int*)(C.lds + LX_TILE); LAS int* ntp = (LAS int*)(C.lds + LX_MISC + 128);
    __syncthreads();
    if (C.tid < 32) tot[C.tid] = __hip_atomic_load(ecnt + C.tid, __ATOMIC_RELAXED, __HIP_MEMORY_SCOPE_AGENT);
    __syncthreads();
    { const int e = C.tid & 31, sub = C.tid >> 5; int acc = 0;
#pragma unroll
      for (int x = 0; x < 32; x += 4) { const LAS int* tp = tot + x; const int t0 = tp[0], t1 = tp[1], t2 = tp[2], t3 = tp[3];
          acc += (x < e ? ((t0 + 255) & ~255) : 0) + (x + 1 < e ? ((t1 + 255) & ~255) : 0) + (x + 2 < e ? ((t2 + 255) & ~255) : 0) + (x + 3 < e ? ((t3 + 255) & ~255) : 0); }
      const int mine = (tot[e] + 255) >> 8, first = acc >> 8;
      if (sub == 0) { pst[e] = acc; if (e == 31) ntp[0] = first + mine; }
      for (int i = sub; i < mine; i += 16) tile_e[first + i] = e; }
    __syncthreads();
}
#ifndef ATT_DUP
#define ATT_DUP 1
#endif

__device__ __forceinline__ s16x4 tr16(LAS const unsigned char* p) { typedef short v4i16_t __attribute__((ext_vector_type(4))); return __builtin_bit_cast(s16x4, __builtin_amdgcn_ds_read_tr16_b64_v4i16((LAS v4i16_t*)p)); }

__device__ __forceinline__ float max3f(float a, float b, float c) { return fmaxf(fmaxf(a, b), c); }
#ifndef ATT_THR_V
#define ATT_THR_V 10.f
#endif
constexpr float ATT_THR = ATT_THR_V;
template <int KS, bool DIL>
__device__ __forceinline__ void att_tile(LAS const unsigned char* kb, LAS const unsigned char* vb, const bf16x8 (&qf)[KS], f32x16& o0, f32x16& o1, f32x16& negm, float& mref, float& l, int kidx0, int qidx, bool need_mask, int lane) {
    constexpr int KROW = KS * 32 + 16, VROW = 144;
    const int i32 = lane & 31, hi = lane >> 5;
    const int pr = (i32 & 0x13) | ((i32 & 4) << 1) | ((i32 & 8) >> 1);
    f32x16 p0, p1;
    LAS const unsigned char* kp = kb + pr * KROW + hi * 16;
#ifndef QK_DUP
#define QK_DUP 1
#endif
#pragma unroll 1
    for (int qd_ = 0; qd_ < QK_DUP; ++qd_) {
#pragma unroll
    for (int ks = 0; ks < KS; ++ks) {
        const bf16x8 k0f = *(LAS const bf16x8*)(kp + ks * 32), k1f = *(LAS const bf16x8*)(kp + 32 * KROW + ks * 32);
        if (ks == 0) { p0 = __builtin_amdgcn_mfma_f32_32x32x16_bf16(k0f, qf[0], negm, 0, 0, 0); p1 = __builtin_amdgcn_mfma_f32_32x32x16_bf16(k1f, qf[0], negm, 0, 0, 0); }
        else { p0 = __builtin_amdgcn_mfma_f32_32x32x16_bf16(k0f, qf[ks], p0, 0, 0, 0); p1 = __builtin_amdgcn_mfma_f32_32x32x16_bf16(k1f, qf[ks], p1, 0, 0, 0); }
    }
    asm volatile("" : "+v"(p0), "+v"(p1));
    }
    if (need_mask) {
#pragma unroll
        for (int r = 0; r < 16; ++r) { const int d0 = qidx - (kidx0 + 16 * (r >> 3) + 8 * hi + (r & 7)), d1 = d0 - 32;
            const bool v0 = DIL ? (d0 >= 0 && d0 <= 128) : (d0 >= 0), v1 = DIL ? (d1 >= 0 && d1 <= 128) : (d1 >= 0);
            p0[r] = v0 ? p0[r] : -INFINITY; p1[r] = v1 ? p1[r] : -INFINITY; } }
    float mx = max3f(p0[0], p0[1], p1[0]), mb = max3f(p0[2], p0[3], p1[1]); mx = max3f(mx, p1[2], p1[3]);
#pragma unroll
    for (int r = 4; r < 16; r += 4) { mx = max3f(mx, p0[r], p0[r + 1]); mb = max3f(mb, p0[r + 2], p0[r + 3]); mx = max3f(mx, p1[r], p1[r + 1]); mb = max3f(mb, p1[r + 2], p1[r + 3]); }
    mx = xmax32(fmaxf(mx, mb));
    if (__builtin_expect(__any(mx > ATT_THR), 0)) {
        const float dl = fmaxf(mx, 0.f), f = fexp2(-dl);
        mref += dl; l *= f;
#pragma unroll
        for (int r = 0; r < 16; ++r) { o0[r] *= f; o1[r] *= f; p0[r] -= dl; p1[r] -= dl; negm[r] = -mref; } }
    float ls0 = 0.f, ls1 = 0.f;
#pragma unroll
    for (int r = 0; r < 16; ++r) { p0[r] = fexp2(p0[r]); p1[r] = fexp2(p1[r]); ls0 += p0[r]; ls1 += p1[r]; }
    l += ls0 + ls1;
    u32x4 pw[2][2];
#pragma unroll
    for (int s = 0; s < 2; ++s) {
        pw[0][s].x = cvt_pk_bf16(p0[8 * s + 0], p0[8 * s + 1]); pw[0][s].y = cvt_pk_bf16(p0[8 * s + 2], p0[8 * s + 3]); pw[0][s].z = cvt_pk_bf16(p0[8 * s + 4], p0[8 * s + 5]); pw[0][s].w = cvt_pk_bf16(p0[8 * s + 6], p0[8 * s + 7]);
        pw[1][s].x = cvt_pk_bf16(p1[8 * s + 0], p1[8 * s + 1]); pw[1][s].y = cvt_pk_bf16(p1[8 * s + 2], p1[8 * s + 3]); pw[1][s].z = cvt_pk_bf16(p1[8 * s + 4], p1[8 * s + 5]); pw[1][s].w = cvt_pk_bf16(p1[8 * s + 6], p1[8 * s + 7]); }
    const int g = lane >> 4, i16 = lane & 15;
    LAS const unsigned char* vp = vb + (8 * (g >> 1) + (i16 >> 2)) * VROW + (16 * (g & 1) + 4 * (i16 & 3)) * 2;
#pragma unroll
    for (int sub = 0; sub < 2; ++sub)
#pragma unroll
        for (int s = 0; s < 2; ++s) { const bf16x8 pf = __builtin_bit_cast(bf16x8, pw[sub][s]);
#pragma unroll
            for (int db = 0; db < 2; ++db) { LAS const unsigned char* av = vp + (32 * sub + 16 * s) * VROW + 64 * db;
                const s16x4 lo = tr16(av), hh = tr16(av + 4 * VROW);
                const bf16x8 vf = (bf16x8){lo[0], lo[1], lo[2], lo[3], hh[0], hh[1], hh[2], hh[3]};
                if (db == 0) o0 = __builtin_amdgcn_mfma_f32_32x32x16_bf16(vf, pf, o0, 0, 0, 0); else o1 = __builtin_amdgcn_mfma_f32_32x32x16_bf16(vf, pf, o1, 0, 0, 0); } }
}
__device__ __forceinline__ void att_store(bf16_t* orow  , const f32x16& o0, const f32x16& o1, float inv, int hi) {
#pragma unroll
    for (int rr = 0; rr < 4; ++rr) { u32x2 w0, w1;
        w0.x = cvt_pk_bf16(o0[4 * rr] * inv, o0[4 * rr + 1] * inv); w0.y = cvt_pk_bf16(o0[4 * rr + 2] * inv, o0[4 * rr + 3] * inv);
        w1.x = cvt_pk_bf16(o1[4 * rr] * inv, o1[4 * rr + 1] * inv); w1.y = cvt_pk_bf16(o1[4 * rr + 2] * inv, o1[4 * rr + 3] * inv);
        *(u32x2*)(orow + 8 * rr + 4 * hi) = w0; *(u32x2*)(orow + 32 + 8 * rr + 4 * hi) = w1; }
}


struct BgConv {
    const float* w1; const float* w2; unsigned char* ws; LAS unsigned char* T;
    int pair, it, nit, step, sub;
    bool pendA, pendB; int psubA, psubB; unsigned char* pWTA; unsigned char* pWTB;
    f32x4 vA[4], vB[4];
};
__device__ __forceinline__ void bg_tile(const BgConv& S, int it, const float*& W, int& N, unsigned char*& WT, int& n0, int& k0) {
    constexpr int I1 = 32 * 8, I2 = 16 * 8, N1 = 64 * I1;
    if (it < N1) { const int mat = S.pair * 64 + it / I1, q = it % I1; W = S.w1 + (size_t)mat * 1024 * 2048; WT = S.ws + O_W1 + (size_t)mat * SZ_W1E; N = 2048; n0 = (q >> 3) * 64; k0 = (q & 7) * 128; }
    else { const int r = it - N1, mat = S.pair * 64 + r / I2, q = r % I2; W = S.w2 + (size_t)mat * 1024 * 1024; WT = S.ws + O_W2 + (size_t)mat * SZ_W2E; N = 1024; n0 = (q >> 3) * 64; k0 = (q & 7) * 128; }
}
__device__ __forceinline__ void bg_init(BgConv& S, const Ctx& C, const float* w1, const float* w2, int pair) {
    S.w1 = w1; S.w2 = w2; S.ws = C.ws; S.T = C.lds + 49152 + C.wave * 9216; S.pair = pair; S.it = C.gw; S.nit = 64 * 256 + 64 * 128; S.step = C.NGW; S.sub = 0;
    S.pendA = false; S.pendB = false; S.psubA = 0; S.psubB = 0; S.pWTA = C.ws; S.pWTB = C.ws;
}
__device__ __forceinline__ bool bg_done(const BgConv& S) { return !S.pendA && !S.pendB && S.it >= S.nit; }
__device__ __forceinline__ void bg_half(BgConv& S, f32x4 (&v)[4], bool& pend, int& psub, unsigned char*& pWT, int lane) {
    const int kq = lane >> 4, c4 = lane & 15;
    if (pend) {
#pragma unroll
        for (int jj = 0; jj < 4; ++jj) *(LAS unsigned*)(S.T + (4 * c4 + jj) * 144 + 32 * kq + 4 * psub) = pk4_fp8(32.f * v[0][jj], 32.f * v[1][jj], 32.f * v[2][jj], 32.f * v[3][jj]);
        if (psub == 7) {
            asm volatile("s_waitcnt lgkmcnt(0)" ::: "memory");
#pragma unroll
            for (int s8 = 0; s8 < 8; ++s8) { const int n = 8 * s8 + (lane >> 3), ch = lane & 7; const u32x4 w = *(const LAS u32x4*)(S.T + n * 144 + 16 * ch);
                *(u32x4*)(pWT + (size_t)n * 1024 + 16 * ch) = w; }
            asm volatile("s_waitcnt lgkmcnt(0)" ::: "memory"); }
        pend = false; }
    if (S.it < S.nit) { const float* W; int N, n0, k0; unsigned char* WT; bg_tile(S, S.it, W, N, WT, n0, k0);
        const float* p = W + (size_t)(k0 + 32 * kq + 4 * S.sub) * N + n0 + 4 * c4;
#pragma unroll
        for (int i = 0; i < 4; ++i) v[i] = __builtin_nontemporal_load((const f32x4*)(p + (size_t)i * N));
        pend = true; psub = S.sub; pWT = WT + (size_t)n0 * 1024 + k0;
        if (++S.sub == 8) { S.sub = 0; S.it += S.step; } }
}
#define BG_STEP_A() bg_half(BG, BG.vA, BG.pendA, BG.psubA, BG.pWTA, lane)
#define BG_STEP_B() bg_half(BG, BG.vB, BG.pendB, BG.psubB, BG.pWTB, lane)

__device__ __forceinline__ void mla_unit(const Ctx& C, BgConv& BG, int b, int h, int qb) {
    constexpr int KROW = 208, VROW = 144, KB = 64 * KROW, BUF = KB + 64 * VROW;
    const bf16_t* Q2 = (const bf16_t*)(C.ws + O_Q2); const bf16_t* KV2 = (const bf16_t*)(C.ws + O_KV2); const bf16_t* PROJ = (const bf16_t*)(C.ws + O_PROJ); bf16_t* ATT = (bf16_t*)(C.ws + O_ATT);
    const int tid = C.tid, lane = C.lane, w = C.wave, i32 = lane & 31, hi = lane >> 5;
    const int q0 = qb * 256; const size_t rowb = (size_t)b * S_;
    bf16x8 qf[6];
    { const bf16_t* qrow = Q2 + (rowb + q0 + 32 * w + i32) * 768 + 8 * hi;
#pragma unroll
      for (int ks = 0; ks < 4; ++ks) qf[ks] = *(const bf16x8*)(qrow + h * 64 + 16 * ks);
      qf[4] = *(const bf16x8*)(qrow + 512 + h * 32); qf[5] = *(const bf16x8*)(qrow + 512 + h * 32 + 16); }
    f32x16 o0, o1;
#pragma unroll
    for (int r = 0; r < 16; ++r) { o0[r] = 0.f; o1[r] = 0.f; }
    float m = 0.f, l = 0.f; f32x16 negm;
#pragma unroll
    for (int r = 0; r < 16; ++r) negm[r] = 0.f;
    const int NT = 4 * qb + 4, wmax = 4 * qb + (w >> 1);
    const int r8 = tid >> 3, c8 = tid & 7, r4 = (tid & 255) >> 2, c4 = tid & 3;
    const bf16_t* knp = KV2 + (rowb + r8) * 1024 + h * 64 + 8 * c8; const bf16_t* kpp = PROJ + (rowb + r4) * 2048 + 1920 + 8 * c4;
    u32x4 kA, vA, pA, kB, vB, pB;
#define MLA_LOAD(j, K, V, P) do { const int jc_ = ((j) < NT) ? (j) : NT - 1; K = *(const u32x4*)(knp + (size_t)jc_ * 64 * 1024); V = *(const u32x4*)(knp + (size_t)jc_ * 64 * 1024 + 512); P = *(const u32x4*)(kpp + (size_t)jc_ * 64 * 2048); } while (0)
#define MLA_WRITE(bo, K, V, P) do { *(LAS u32x4*)(C.lds + (bo) + r8 * KROW + 16 * c8) = K; *(LAS u32x4*)(C.lds + (bo) + KB + r8 * VROW + 16 * c8) = V; *(LAS u32x4*)(C.lds + (bo) + r4 * KROW + 128 + 16 * c4) = P; } while (0)
#define MLA_STEP(j, KF, VF, PF, KN, VN, PN, BGS) do { const int j_ = (j); const int bo_ = (j_ & 1) * BUF; \
        MLA_LOAD(j_ + 2, KF, VF, PF); BGS(); \
        if (j_ <= wmax) { _Pragma("unroll 1") for (int dup_ = 0; dup_ < ATT_DUP; ++dup_) att_tile<6, false>(C.lds + bo_, C.lds + bo_ + KB, qf, o0, o1, negm, m, l, 64 * j_, q0 + 32 * w + i32, j_ == wmax, lane); } \
        MLA_WRITE(BUF - bo_, KN, VN, PN); \
        __syncthreads(); } while (0)
    MLA_LOAD(0, kA, vA, pA); MLA_LOAD(1, kB, vB, pB);
    MLA_WRITE(0, kA, vA, pA);
    __syncthreads();
#pragma unroll 1
    for (int j = 0; j < NT; j += 2) { MLA_STEP(j, kA, vA, pA, kB, vB, pB, BG_STEP_A); MLA_STEP(j + 1, kB, vB, pB, kA, vA, pA, BG_STEP_B); }
#undef MLA_STEP
#undef MLA_LOAD
#undef MLA_WRITE
    l = xadd32(l);
    att_store(ATT + (rowb + q0 + 32 * w + i32) * 1024 + 512 + h * 64, o0, o1, 1.f / l, hi);
}
__device__ __forceinline__ void dil_unit(const Ctx& C, BgConv& BG, int p, int dd, int b, int h, int res, int n) {
    constexpr int KROW = 144, VROW = 144, KB = 64 * KROW, BUF = KB + 64 * VROW;
    const bf16_t* PROJ = (const bf16_t*)(C.ws + O_PROJ); bf16_t* OA = (bf16_t*)(C.ws + O_OA) + (size_t)p * T_ * 512; float* LSE = (float*)(C.ws + O_LSE) + (size_t)p * T_ * 8;
    const int tid = C.tid, lane = C.lane, w = C.wave, i32 = lane & 31, hi = lane >> 5;
    const size_t rowb = (size_t)b * S_;
    const int qsub = 256 * n + 32 * w + i32; const size_t qtok = rowb + (size_t)qsub * dd + res;
    bf16x8 qf[4];
    { const bf16_t* qrow = PROJ + qtok * 2048 + h * 64 + 8 * hi;
#pragma unroll
      for (int ks = 0; ks < 4; ++ks) qf[ks] = *(const bf16x8*)(qrow + 16 * ks); }
    f32x16 o0, o1;
#pragma unroll
    for (int r = 0; r < 16; ++r) { o0[r] = 0.f; o1[r] = 0.f; }
    float m = 0.f, l = 0.f; f32x16 negm;
#pragma unroll
    for (int r = 0; r < 16; ++r) negm[r] = 0.f;
    const int jbeg = (n == 0) ? 2 : 0, wlo = w >> 1, whi = (32 * w + 159) >> 6;
    const int r8 = tid >> 3, c8 = tid & 7;
    u32x4 kA, vA, kB, vB;
    const int cnt = 6 - jbeg;
#define DIL_LOAD(i, K, V) do { const int jc_ = jbeg + (((i) < cnt) ? (i) : cnt - 1); const size_t tok = rowb + (size_t)(256 * n - 128 + 64 * jc_ + r8) * dd + res; const bf16_t* src = PROJ + tok * 2048 + 512 + h * 64 + 8 * c8; K = *(const u32x4*)src; V = *(const u32x4*)(src + 512); } while (0)
#define DIL_WRITE(bo, K, V) do { *(LAS u32x4*)(C.lds + (bo) + r8 * KROW + 16 * c8) = K; *(LAS u32x4*)(C.lds + (bo) + KB + r8 * VROW + 16 * c8) = V; } while (0)
#define DIL_STEP(i, KF, VF, KN, VN, BGS) do { const int i_ = (i); const int bo_ = (i_ & 1) * BUF, j_ = jbeg + i_; \
        DIL_LOAD(i_ + 2, KF, VF); BGS(); \
        if (i_ < cnt && j_ >= wlo && j_ <= whi) { const int kb0_ = 256 * n - 128 + 64 * j_, qlo_ = 256 * n + 32 * w; _Pragma("unroll 1") for (int dup_ = 0; dup_ < ATT_DUP; ++dup_) att_tile<4, true>(C.lds + bo_, C.lds + bo_ + KB, qf, o0, o1, negm, m, l, kb0_, qsub, !(kb0_ + 63 <= qlo_ && qlo_ + 31 - kb0_ <= 128), lane); } \
        DIL_WRITE(BUF - bo_, KN, VN); \
        __syncthreads(); } while (0)
    DIL_LOAD(0, kA, vA); DIL_LOAD(1, kB, vB);
    DIL_WRITE(0, kA, vA);
    __syncthreads();
    DIL_STEP(0, kA, vA, kB, vB, BG_STEP_A); DIL_STEP(1, kB, vB, kA, vA, BG_STEP_B); DIL_STEP(2, kA, vA, kB, vB, BG_STEP_A); DIL_STEP(3, kB, vB, kA, vA, BG_STEP_B);
    if (cnt == 6) { DIL_STEP(4, kA, vA, kB, vB, BG_STEP_A); DIL_STEP(5, kB, vB, kA, vA, BG_STEP_B); }
#undef DIL_STEP
#undef DIL_LOAD
#undef DIL_WRITE
    l = xadd32(l);
    att_store(OA + qtok * 512 + h * 64, o0, o1, 1.f / l, hi);
    if (hi == 0) LSE[qtok * 8 + h] = m + log2f(l);
}
#ifndef REP_MLA
#define REP_MLA 1
#endif
#ifndef REP_DIL
#define REP_DIL 1
#endif
__device__ __forceinline__ void phase_attention(const Ctx& C, const float* w1, const float* w2, int pair) {
    BgConv BG; bg_init(BG, C, w1, w2, pair);
#pragma unroll 1
    for (int rep = 0; rep < REP_MLA; ++rep) {
    if (C.G == 256) { const int bh = C.vcu >> 3, s = C.vcu & 7; mla_unit(C, BG, bh >> 3, bh & 7, s); mla_unit(C, BG, bh >> 3, bh & 7, 15 - s); }
    else for (int u = C.bid; u < 512; u += C.G) mla_unit(C, BG, u >> 7, (u >> 4) & 7, u & 15);
    }
#pragma unroll 1
    for (int rep = 0; rep < REP_DIL; ++rep)
    for (int u = C.bid; u < 1536; u += C.G) { const int p = u >> 9, rem = u & 511, b = rem >> 7, h = (rem >> 4) & 7, blk = rem & 15;
        const int dd = (p == 0) ? 1 : (p == 1) ? 4 : 16, bpr = 16 / dd;
        dil_unit(C, BG, p, dd, b, h, blk / bpr, blk % bpr); }
    { const int lane = C.lane;
#pragma unroll 1
      while (!bg_done(BG)) { BG_STEP_A(); BG_STEP_B(); } }
}
#undef BG_STEP_A
#undef BG_STEP_B

#ifdef TIME_NORM
constexpr int N_PHASES = 42;
#else
constexpr int N_PHASES = 36;
#endif
extern __shared__ __attribute__((aligned(16))) unsigned char lds_raw[];
typedef const __attribute__((address_space(4))) Args* ArgsP;
#define PHFN static __device__ __forceinline__ void
__device__ __forceinline__ ArgsP fresh_args() { unsigned long long p = (unsigned long long)__builtin_amdgcn_kernarg_segment_ptr(); asm volatile("" : "+s"(p)); return (ArgsP)p; }
__device__ __forceinline__ Ctx make_ctx(ArgsP ap, int wv) {
    Ctx C; C.lds = (LAS unsigned char*)lds_raw; C.ws = ap->ws;
    unsigned ones = ~0u; asm volatile("" : "+s"(ones)); const int lane = (int)__builtin_amdgcn_mbcnt_hi(ones, __builtin_amdgcn_mbcnt_lo(ones, 0u));
    int bid = blockIdx.x; asm volatile("" : "+s"(bid)); int G = gridDim.x; asm volatile("" : "+s"(G));
    C.wave = wv; C.lane = lane; C.tid = wv * 64 + lane;
    C.G = G; C.bid = bid; C.vcu = (C.G % 8 == 0) ? (C.bid % 8) * (C.G / 8) + C.bid / 8 : C.bid;
    C.gw = C.bid * 8 + C.wave; C.NGW = C.G * 8; return C;
}
#define IN(i) ((const float*)ap->in[i])
#define MODL(l) ((const float*)(C.ws + O_MOD) + (size_t)(l) * 4 * 6144)
PHFN ph_prologue(int wv) { const ArgsP ap = fresh_args(); const Ctx C = make_ctx(ap, wv); p0_prologue(C, ap); }
PHFN ph_norm(int wv, int l, int mode) { const ArgsP ap = fresh_args(); const Ctx C = make_ctx(ap, wv);
    if (mode == 0) phase_norm(C, IN(0), nullptr, false, true, IN(5), MODL(0), MODL(0), 0, 1024, false, true);
    else if (mode == 1) phase_norm(C, nullptr, nullptr, true, true, IN(5) + l * 1024, MODL(l - 1), MODL(l), 0, 1024, false, (l & 1) == 0);
    else if (mode == 3) phase_norm(C, nullptr, nullptr, true, true, IN(5) + l * 1024, MODL(l - 1), MODL(l), 0, 1024, true);
    else phase_norm(C, nullptr, ap->out, true, false, IN(5), MODL(3), MODL(3), 0, 1024); }
PHFN ph_proj(int wv, int j) { const ArgsP ap = fresh_args(); const Ctx C = make_ctx(ap, wv); unsigned char* ws = C.ws;
    DenseOrder S; S.init(ws + O_HN, ws + O_WIN + j * SZ_WIN, 1024, 1024, T_, 2048, C.G, C.bid, 1); EpiNorm<0> E{(bf16_t*)(ws + O_PROJ), 2048, IN(8) + j * 64, IN(9) + j * 64, IN(10) + j * 256, IN(11) + j * 128, IN(15) + j * 96 + 64, (const float*)(ws + O_CS), (LAS float*)(C.lds + LX_EXCH), 1.f / 32.f}; gemm_phase<true>(C, GemmDims{1024, 1024, 1024}, S, E); }
PHFN ph_postproj(int wv, int j) { const ArgsP ap = fresh_args(); const Ctx C = make_ctx(ap, wv); phase_postproj(C, IN(8) + j * 64, IN(9) + j * 64, IN(10) + j * 256, IN(11) + j * 128, IN(15) + j * 96); }
PHFN ph_qkv(int wv, int j) { const ArgsP ap = fresh_args(); const Ctx C = make_ctx(ap, wv); unsigned char* ws = C.ws;
    { DenseOrder S; S.init(ws + O_PROJ + 1536 * 2, ws + O_WUQ + j * SZ_WUQ, 2048, 256, T_, 768, C.G, C.bid); EpiNorm<1> E{(bf16_t*)(ws + O_Q2), 768, IN(14) + j * 96, IN(14) + j * 96 + 64, nullptr, nullptr, nullptr, (const float*)(ws + O_CS), (LAS float*)(C.lds + LX_EXCH), 1.f}; gemm_phase(C, GemmDims{256, 2048, 256}, S, E); }
    { const ArgsP ap2 = fresh_args(); const Ctx C = make_ctx(ap2, wv); unsigned char* ws = C.ws; DenseOrder S; S.init(ws + O_PROJ + 1792 * 2, ws + O_WUKV + j * SZ_WUKV, 2048, 128, T_, 1024, C.G, C.bid); EpiNorm<2> E{(bf16_t*)(ws + O_KV2), 1024, IN(15) + j * 96, nullptr, nullptr, nullptr, nullptr, (const float*)(ws + O_CS), (LAS float*)(C.lds + LX_EXCH), 1.f}; gemm_phase(C, GemmDims{128, 2048, 128}, S, E); } }
PHFN ph_postq(int wv, int j) { const ArgsP ap = fresh_args(); const Ctx C = make_ctx(ap, wv); phase_postq(C, IN(14) + j * 96, IN(15) + j * 96); }
PHFN ph_attention(int wv, int pair) { const ArgsP ap = fresh_args(); const Ctx C = make_ctx(ap, wv); phase_attention(C, IN(30), IN(32), pair); }
PHFN ph_mixcombine(int wv) { const ArgsP ap = fresh_args(); const Ctx C = make_ctx(ap, wv); phase_mixcombine(C); }
PHFN ph_outproj(int wv, int l, int which) { const ArgsP ap = fresh_args(); const Ctx C = make_ctx(ap, wv); unsigned char* ws = C.ws; const int j = l >> 1;
    DenseOrder S; S.init(ws + O_ATT, ws + (which ? O_RWOUT + j * SZ_RWOUT : O_WOUT + j * SZ_WOUT), 1024, 1024, T_, 1024, C.G, C.bid);
    EpiResid E{(bf16_t*)(ws + O_X), MODL(l) + 2048, which ? IN(27) + j * 1024 : nullptr}; gemm_phase(C, GemmDims{1024, 1024, 1024}, S, E); }
PHFN ph_router(int wv, int l) { const ArgsP ap = fresh_args(); const Ctx C = make_ctx(ap, wv); phase_router(C, (const bf16_t*)(C.ws + O_X), IN(6) + l * 1024, MODL(l), IN(28) + (size_t)l * 1024 * 32, IN(29) + l * 32, l); }
PHFN ph_moe1(int wv, int l) { const ArgsP ap = fresh_args(); const Ctx C = make_ctx(ap, wv); unsigned char* ws = C.ws; moe_plan_lds(C, l);
    MoeOrderT<true> S; S.A = (const char*)(ws + O_HN); S.WT = (const char*)(ws + O_W1 + (size_t)l * 32 * SZ_W1E); S.estride = SZ_W1E; S.tile_e = (const LAS int*)(C.lds + LX_TILE);
    S.NT = *(const LAS int*)(C.lds + LX_MISC + 128); S.nN = 8; S.G = C.G; S.c = C.bid; S.esz = 1; S.gtab = (const LAS int*)(C.lds + LX_GTAB);
    { const int* inv = (const int*)(ws + O_INV); LAS int* gt = (LAS int*)(C.lds + LX_GTAB); const LAS int* tot = (const LAS int*)(C.lds + LX_MISC + 256); const LAS int* pst = tot + 32;
      const int r = C.tid & 255, i0 = __builtin_amdgcn_readfirstlane(C.tid >> 8); int val[GTAB_UNITS / 2];
#pragma unroll
      for (int k = 0; k < GTAB_UNITS / 2; ++k) { Unit u; const bool ok = S.next(2 * k + i0, u); const int e = ok ? u.e : 0, j = (ok ? u.row0 - pst[e] : 0) + r; val[k] = (ok && j < tot[e]) ? inv[e * 16384 + j] : 0; }
      { const int* topi = (const int*)(ws + O_TOPI); const int* posj = (const int*)(ws + O_POSJ); int* pos = (int*)(ws + O_POS);
        for (int ck = C.bid; ck < 256; ck += C.G) if (C.tid < 256) pos[ck * 256 + C.tid] = pst[topi[ck * 256 + C.tid]] + posj[ck * 256 + C.tid]; }
#pragma unroll
      for (int k = 0; k < GTAB_UNITS / 2; ++k) gt[(2 * k + i0) * 256 + r] = val[k];
      __syncthreads(); }
    EpiSwiglu E{(unsigned char*)(ws + O_ACT), IN(31) + (size_t)l * 32 * 2048, 1.f / 32.f}; gemm_phase<true>(C, GemmDims{1024, 1024, 1024}, S, E); }
PHFN ph_moe2(int wv, int l) { const ArgsP ap = fresh_args(); const Ctx C = make_ctx(ap, wv); unsigned char* ws = C.ws;
#if MODE != 1
    moe_plan_lds(C, l);
#endif

    MoeOrder S; S.A = (const char*)(ws + O_ACT); S.WT = (const char*)(ws + O_W2 + (size_t)l * 32 * SZ_W2E); S.estride = SZ_W2E; S.tile_e = (const LAS int*)(C.lds + LX_TILE);
    S.NT = *(const LAS int*)(C.lds + LX_MISC + 128); S.nN = 4; S.G = C.G; S.c = C.bid; S.esz = 1;
    EpiBf16 E{(bf16_t*)(ws + O_Y2), IN(33) + (size_t)l * 32 * 1024, 1024, 1024, 1.f / 32.f}; gemm_phase<true>(C, GemmDims{1024, 1024, 1024}, S, E); }
PHFN ph_recin(int wv, int j) { const ArgsP ap = fresh_args(); const Ctx C = make_ctx(ap, wv); unsigned char* ws = C.ws;
    DenseOrder S; S.init(ws + O_HN, ws + O_RWIN + j * SZ_RWIN, 1024, 1024, T_, 2048, C.G, C.bid); EpiRecIn E{(bf16_t*)(ws + O_PROJ), IN(18) + j * 2048}; gemm_phase(C, GemmDims{1024, 1024, 1024}, S, E); }
PHFN ph_rgate(int wv, int j) { const ArgsP ap = fresh_args(); const Ctx C = make_ctx(ap, wv); phase_rgate(C, j, IN(19) + j * 4096, IN(20) + j * 1024, IN(22) + j * 1024, IN(24) + j * 1024); }
PHFN ph_scan_apply(int wv) { const ArgsP ap = fresh_args(); const Ctx C = make_ctx(ap, wv); phase_scan_apply(C); }

#if MODE == 1
__device__ __forceinline__ int fresh_tid(int wv) { unsigned ones = ~0u; asm volatile("" : "+s"(ones)); return wv * 64 + (int)__builtin_amdgcn_mbcnt_hi(ones, __builtin_amdgcn_mbcnt_lo(ones, 0u)); }
__device__ __forceinline__ void grid_barrier(int wv) { const ArgsP q = fresh_args(); XcdBarrier b; b.bar = (unsigned*)(q->ws + O_CTL) + CW_BAR; b.x = xb_xcc_id(); b.st = (volatile LAS unsigned*)((LAS unsigned char*)lds_raw + LDSX_OFF); xcd_barrier(b, fresh_tid(wv)); }
__global__ void __launch_bounds__(512, 2) mk_fwd(Args a) {
    int wv = __builtin_amdgcn_readfirstlane(threadIdx.x >> 6); asm volatile("" : "+s"(wv));
    { LAS unsigned char* lds = (LAS unsigned char*)lds_raw;
      for (int u = threadIdx.x; u < (LDS_BYTES - LDSX_OFF) / 4; u += 512) ((LAS unsigned*)(lds + LDSX_OFF))[u] = 0u;
      __syncthreads();
      if (a.ph_hi - a.ph_lo > 1) (void)xcd_barrier_post((unsigned*)(a.ws + O_CTL) + CW_BAR, (volatile LAS unsigned*)(lds + LDSX_OFF), (int)threadIdx.x); }
    int pid = 0;
#define PHASE(call) { const ArgsP q_ = fresh_args(); const int lo_ = q_->ph_lo, hi_ = q_->ph_hi; if (pid >= lo_ && pid < hi_) { call; if (pid + 1 < hi_) grid_barrier(wv); } ++pid; }
#define PHASE_R(call, REP) { const ArgsP q_ = fresh_args(); const int lo_ = q_->ph_lo, hi_ = q_->ph_hi; if (pid >= lo_ && pid < hi_) { if ((REP) > 1) { call; grid_barrier(wv); } call; if (pid + 1 < hi_) grid_barrier(wv); } ++pid; }
#ifndef REP_PROLOGUE
#define REP_PROLOGUE 1
#endif
#ifndef REP_MOE
#define REP_MOE 1
#endif
#ifndef REP_ATTN
#define REP_ATTN 1
#endif
#ifndef REP_GEMMS
#define REP_GEMMS 1
#endif
#ifdef TIME_NORM
#define NORM_EXTRA(l) PHASE(ph_norm(wv, l, 3))
#else
#define NORM_EXTRA(l)
#endif
#ifndef REP_ELEM
#define REP_ELEM 1
#endif
#ifndef REP_ROUTER
#define REP_ROUTER REP_ELEM
#endif
#ifndef REP_SCATTER
#define REP_SCATTER REP_ELEM
#endif
#ifndef REP_MIX
#define REP_MIX REP_ELEM
#endif
#ifndef REP_CONV
#define REP_CONV REP_ELEM
#endif
#ifndef REP_SCANA
#define REP_SCANA REP_ELEM
#endif
#define MOE_PHASES(l) PHASE_R(ph_router(wv, l), REP_ROUTER) PHASE_R(ph_moe1(wv, l), REP_MOE) PHASE_R(ph_moe2(wv, l), REP_MOE)
    PHASE_R(ph_prologue(wv), REP_PROLOGUE)
#define LAYER_PAIR(lp) \
        { const int l = 2 * (lp);         \
          PHASE(ph_norm(wv, l, (lp) == 0 ? 0 : 1)) PHASE_R(ph_proj(wv, lp), REP_GEMMS) PHASE_R(ph_qkv(wv, lp), REP_GEMMS) PHASE_R(ph_attention(wv, lp), REP_ATTN) PHASE_R(ph_mixcombine(wv), REP_MIX) PHASE(ph_outproj(wv, l, 0)) \
          MOE_PHASES(l) } \
        { const int l = 2 * (lp) + 1;     \
          NORM_EXTRA(l) PHASE(ph_norm(wv, l, 1)) PHASE_R(ph_recin(wv, lp), REP_GEMMS) PHASE_R(ph_rgate(wv, lp), REP_CONV) PHASE_R(ph_scan_apply(wv), REP_SCANA) PHASE(ph_outproj(wv, l, 1)) \
          MOE_PHASES(l) }
    LAYER_PAIR(0)
    LAYER_PAIR(1)
#undef LAYER_PAIR
#ifdef EXTRA_BARRIERS
    { const ArgsP q_ = fresh_args(); if (q_->ph_hi - q_->ph_lo > 1) { _Pragma("unroll 1") for (int xb = 0; xb < EXTRA_BARRIERS; ++xb) grid_barrier(wv); } }
#endif
    PHASE(ph_norm(wv, 3, 2))
#undef PHASE
#undef PHASE_R
#undef MOE_PHASES
}
#else
template <int PH> __global__ void __launch_bounds__(512, 2) k_phase(Args a, int l, int x) {
    int wv = __builtin_amdgcn_readfirstlane(threadIdx.x >> 6); asm volatile("" : "+s"(wv));
    LAS unsigned char* lds = (LAS unsigned char*)lds_raw;
    for (int u = threadIdx.x; u < (LDS_BYTES - LDSX_OFF) / 4; u += 512) ((LAS unsigned*)(lds + LDSX_OFF))[u] = 0u;
    __syncthreads();
    if constexpr (PH == 0) ph_prologue(wv);
    if constexpr (PH == 1) ph_norm(wv, l, x);
    if constexpr (PH == 2) ph_proj(wv, l);
    if constexpr (PH == 4) ph_qkv(wv, l);
    if constexpr (PH == 6) ph_attention(wv, l);
    if constexpr (PH == 7) ph_mixcombine(wv);
    if constexpr (PH == 8) ph_outproj(wv, l, x);
    if constexpr (PH == 9) ph_router(wv, l);
    if constexpr (PH == 11) ph_moe1(wv, l);
    if constexpr (PH == 12) ph_moe2(wv, l);
    if constexpr (PH == 13) ph_recin(wv, l);
    if constexpr (PH == 14) ph_rgate(wv, l);
    if constexpr (PH == 17) ph_scan_apply(wv);
}
#endif
#undef IN
#undef MODL
}

#ifndef MODE
#define MODE 2
#endif
extern "C" void kernel_launch(void* const* d_in, const int* in_sizes, int n_in, void* d_out, int out_size, void* d_ws, size_t ws_size, hipStream_t stream) {
    (void)in_sizes; (void)n_in; (void)out_size; (void)ws_size;
#if MODE == 0
    nv::forward(d_in, (float*)d_out, d_ws, stream);
#else
    static int grid = 0;
    if (grid == 0) {
        int dev = 0, cus = 0;
        (void)hipGetDevice(&dev); (void)hipDeviceGetAttribute(&cus, hipDeviceAttributeMultiprocessorCount, dev);
#if MODE == 1
        (void)hipFuncSetAttribute((const void*)mk::mk_fwd, hipFuncAttributeMaxDynamicSharedMemorySize, mk::LDS_BYTES);
#else
#define SA(PH) (void)hipFuncSetAttribute((const void*)mk::k_phase<PH>, hipFuncAttributeMaxDynamicSharedMemorySize, mk::LDS_BYTES)
        SA(0); SA(1); SA(2); SA(4); SA(6); SA(7); SA(8); SA(9); SA(10); SA(11); SA(12); SA(13); SA(14); SA(17);
#undef SA
#endif
        grid = cus > 0 ? cus : 256;
    }
    (void)hipMemsetAsync((char*)d_ws + mk::O_CTL, 0, mk::SZ_CTL, stream);
    mk::Args a;
    memset(&a, 0, sizeof(a));
    for (int i = 0; i < 34; ++i) a.in[i] = d_in[i];
    a.out = (float*)d_out; a.ws = (unsigned char*)d_ws;
#if MODE == 1
    a.ph_lo = 0; a.ph_hi = mk::N_PHASES;
    hipLaunchKernelGGL(mk::mk_fwd, dim3(grid), dim3(512), mk::LDS_BYTES, stream, a);
#else
#define LP(PH, l, x) hipLaunchKernelGGL(mk::k_phase<PH>, dim3(grid), dim3(512), mk::LDS_BYTES, stream, a, l, x)
    LP(0, 0, 0);
    for (int lp = 0; lp < 2; ++lp) {
        { const int l = 2 * lp; LP(1, l, lp == 0 ? 0 : 1); LP(2, lp, 0); LP(4, lp, 0); LP(6, lp, 0); LP(7, 0, 0); LP(8, l, 0); LP(9, l, 0); LP(10, 0, 0); LP(11, l, 0); LP(12, l, 0); }
        { const int l = 2 * lp + 1; LP(1, l, 1); LP(13, lp, 0); LP(14, lp, 0); LP(17, 0, 0); LP(8, l, 1); LP(9, l, 0); LP(10, 0, 0); LP(11, l, 0); LP(12, l, 0); }
    }
    LP(1, 3, 2);
#undef LP
#endif
#endif
}
```

```cpp
#define MODE 1

#include <string.h>
#include <hip/hip_runtime.h>
#include <stdint.h>
#include <math.h>

namespace cfg {
constexpr int D = 1024, NB = 4, S = 4096, T = NB * S, DEPTH = 4;
constexpr int MIXIN = 1952;
constexpr int NE = 32, TOPK = 4;
constexpr int MPAIR = T * TOPK;
constexpr int NBLK = MPAIR / 256 + NE;
constexpr int P = NBLK * 256;
}
using namespace cfg;


namespace mk {
#define LAS __attribute__((address_space(3)))
#define GAS __attribute__((address_space(1)))
typedef unsigned short bf16_t;
typedef short bf16x8 __attribute__((ext_vector_type(8)));
typedef short s16x4 __attribute__((ext_vector_type(4)));
typedef float f32x2 __attribute__((ext_vector_type(2)));
typedef float f32x4 __attribute__((ext_vector_type(4)));
typedef float f32x16 __attribute__((ext_vector_type(16)));
typedef unsigned u32x2 __attribute__((ext_vector_type(2)));
typedef unsigned u32x4 __attribute__((ext_vector_type(4)));
typedef GAS unsigned gu32;
#define RLX_AGENT __ATOMIC_RELAXED, __HIP_MEMORY_SCOPE_AGENT

__device__ __forceinline__ unsigned cvt_pk_bf16(float lo, float hi) { unsigned r; asm volatile("v_cvt_pk_bf16_f32 %0, %1, %2" : "=v"(r) : "v"(lo), "v"(hi)); return r; }
__device__ __forceinline__ float bf_lo(unsigned u) { return __uint_as_float(u << 16); }
__device__ __forceinline__ float bf_hi(unsigned u) { return __uint_as_float(u & 0xffff0000u); }
template <int O> __device__ __forceinline__ float shx(float v) { static_assert(O >= 1 && O < 32, "shx"); return __int_as_float(__builtin_amdgcn_ds_swizzle(__float_as_int(v), (O << 10) | 0x1f)); }
__device__ __forceinline__ float xadd32(float v) { const auto r = __builtin_amdgcn_permlane32_swap(__float_as_uint(v), __float_as_uint(v), false, false); return __uint_as_float(r[0]) + __uint_as_float(r[1]); }
__device__ __forceinline__ float xmax32(float v) { const auto r = __builtin_amdgcn_permlane32_swap(__float_as_uint(v), __float_as_uint(v), false, false); return fmaxf(__uint_as_float(r[0]), __uint_as_float(r[1])); }
__device__ __forceinline__ float wsum(float v) { v += shx<1>(v); v += shx<2>(v); v += shx<4>(v); v += shx<8>(v); v += shx<16>(v); return xadd32(v); }
__device__ __forceinline__ float fexp2(float x) { return __builtin_amdgcn_exp2f(x); }
__device__ __forceinline__ float frcp(float x) { return __builtin_amdgcn_rcpf(x); }
__device__ __forceinline__ float fsigmoid(float z) { return frcp(1.f + fexp2(-1.4426950408889634f * z)); }
__device__ __forceinline__ float fgelu_tanh(float x) { const float u = 0.7978845608028654f * (x + 0.044715f * x * x * x); return x * frcp(1.f + fexp2(-2.8853900817779268f * u)); }

#define XB_TMO      128
#define XB_XCNT(j)  (256  + 64 * (j))
#define XB_XSUB(j)  (1280 + 64 * (j))
#define XB_XGEN(j)  (2304 + 64 * (j))
#define XB_TOP      3328
#define XB_TOPGEN   3392
#define XCD_BAR_WORDS 3456
#define XB_SPIN_CAP (1u << 18)
__device__ __forceinline__ unsigned xb_ld(unsigned* p)              { return __hip_atomic_load(p, __ATOMIC_RELAXED, __HIP_MEMORY_SCOPE_AGENT); }
__device__ __forceinline__ unsigned xb_add(unsigned* p, unsigned v) { return __hip_atomic_fetch_add(p, v, __ATOMIC_RELAXED, __HIP_MEMORY_SCOPE_AGENT); }
__device__ __forceinline__ unsigned xb_xcc_id() { return (unsigned)__builtin_amdgcn_s_getreg((3 << 11) | 20) & 0xFu; }
#define XB_SPIN(cond, bar) do { unsigned _sp = 0; while (cond) { __builtin_amdgcn_s_sleep(1); \
    if ((++_sp & 255u) == 0u) { if (xb_ld(&(bar)[XB_TMO])) break; if (_sp > XB_SPIN_CAP) { atomicAdd(&(bar)[XB_TMO], 1u); break; } } } } while (0)
struct XcdBarrier { unsigned* bar; unsigned x; volatile LAS unsigned* st; };
__device__ __forceinline__ XcdBarrier xcd_barrier_post(unsigned* bar, volatile LAS unsigned* st, int tid) {
    XcdBarrier b; b.bar = bar; b.x = xb_xcc_id(); b.st = st;
    if (tid == 0) (void)xb_add(&bar[XB_XCNT(b.x)], 1u);
    return b;
}
__device__ __forceinline__ void xcd_barrier_complete(unsigned* bar, unsigned x, unsigned& nloc, unsigned& nx) {
    const unsigned G = gridDim.x * gridDim.y * gridDim.z;
    unsigned sum, cnt, mine, sp = 0u;
    for (;;) {
        sum = 0u; cnt = 0u; mine = 0u;
#pragma unroll
        for (unsigned j = 0; j < 16; ++j) { const unsigned c = xb_ld(&bar[XB_XCNT(j)]); sum += c; cnt += (c > 0u) ? 1u : 0u; mine = (j == x) ? c : mine; }
        if (sum == G) break;
        __builtin_amdgcn_s_sleep(1);
        if ((++sp & 255u) == 0u) { if (xb_ld(&bar[XB_TMO])) break; if (sp > XB_SPIN_CAP) { atomicAdd(&bar[XB_TMO], 1u); break; } }
    }
    nloc = mine > 0u ? mine : 1u; nx = cnt > 0u ? cnt : 1u;
}
__device__ __forceinline__ void xcd_barrier(const XcdBarrier& b, int tid) {
    asm volatile("s_waitcnt vmcnt(0)" ::: "memory");
    __syncthreads();
    if (tid == 0) {
        unsigned* bar = b.bar;
        __builtin_amdgcn_s_waitcnt(0);
        unsigned nloc = b.st[0], nx = b.st[1];
        if (nloc == 0u) { xcd_barrier_complete(bar, b.x, nloc, nx); b.st[0] = nloc; b.st[1] = nx; }
        const unsigned old = xb_add(&bar[XB_XSUB(b.x)], 1u);
        const unsigned gen = old / nloc;
        if (old + 1u == (gen + 1u) * nloc) {
            __builtin_amdgcn_fence(__ATOMIC_RELEASE, "agent");
            asm volatile("s_waitcnt vmcnt(0)" ::: "memory");
            const unsigned og = xb_add(&bar[XB_TOP], 1u);
            const unsigned tg = og / nx;
            if (og + 1u == (tg + 1u) * nx) xb_add(&bar[XB_TOPGEN], 1u);
            else XB_SPIN(xb_ld(&bar[XB_TOPGEN]) == tg, bar);
            __builtin_amdgcn_fence(__ATOMIC_ACQUIRE, "agent");
            xb_add(&bar[XB_XGEN(b.x)], 1u);
            asm volatile("s_waitcnt vmcnt(0)" ::: "memory");
        } else {
            XB_SPIN(xb_ld(&bar[XB_XGEN(b.x)]) == gen, bar);
            __builtin_amdgcn_fence(__ATOMIC_ACQUIRE, "agent");
            asm volatile("s_waitcnt vmcnt(0)" ::: "memory");
        }
    }
    __syncthreads();
}

constexpr int BM = 256, BK = 64, HALF = 128, HTB = HALF * BK * 2, STAGE_BYTES = 8 * HTB;
__host__ __device__ __forceinline__ int lds_byte(int r, int c) { const int st = (r >> 4) * 2 + (c >> 5), rr = r & 15, cc = c & 31, ob = rr * 64 + cc * 2; return st * 1024 + (ob ^ (((ob >> 9) & 1) << 5)); }
__host__ __device__ __forceinline__ void stage_rc(int b, int& R, int& C) { const int st = b / 1024, sb = b % 1024, swz = sb ^ (((sb >> 9) & 1) << 5); R = (st >> 1) * 16 + swz / 64; C = (st & 1) * 32 + (swz % 64) / 2; }
__host__ __device__ __forceinline__ int perm32(int rho) { const int n = rho >> 4, i = rho & 15; return 8 * (i >> 2) + 4 * n + (i & 3); }

struct Unit { const char* a; const char* b; int row0, col0, e, pad; };
struct GemmDims { int K, lda, ldb; };
typedef f32x4 Acc[2][2][4][2];
__device__ __forceinline__ void zero_acc(Acc& acc) {
#pragma unroll
    for (int a = 0; a < 2; ++a)
#pragma unroll
        for (int b = 0; b < 2; ++b)
#pragma unroll
            for (int m = 0; m < 4; ++m)
#pragma unroll
                for (int n = 0; n < 2; ++n)
                    { f32x2 z0, z1; asm volatile("v_mov_b64 %0, 0" : "=v"(z0)); asm volatile("v_mov_b64 %0, 0" : "=v"(z1)); acc[a][b][m][n] = (f32x4){z0[0], z0[1], z1[0], z1[1]}; }
}

typedef int v8i32 __attribute__((ext_vector_type(8)));
template <bool F8 = false, class CtxT, class Epi, class Sched>
__device__ __forceinline__ void gemm_phase(const CtxT& C, const GemmDims g, const Sched& S, const Epi& E) {
    LAS unsigned char* lds = C.lds;
    const int tid = C.tid, wid = __builtin_amdgcn_readfirstlane(tid >> 6), lane = tid & 63, wr = wid >> 2, wc = wid & 3, fr = lane & 15, fq = lane >> 4;
    constexpr int ESZ = F8 ? 1 : 2;
    constexpr bool GA = Sched::GATHER;
    int nt = g.K / (F8 ? 128 : BK); asm volatile("" : "+s"(nt));
    unsigned voffA[2], voffB[2];
#pragma unroll
    for (int i = 0; i < 2; ++i) { int R, C; stage_rc(tid * 16 + i * 8192, R, C); const int Rb = (R & ~31) + perm32(R & 31);
        voffA[i] = (unsigned)(R * g.lda * ESZ + C * 2); voffB[i] = (unsigned)(Rb * g.ldb * ESZ + C * 2); }
    unsigned voffG[2][2];
    auto load_goffs = [&](int uidx) { if constexpr (GA) { int R, Cc; stage_rc(tid * 16, R, Cc); const LAS int* tp = S.gtab + uidx * 256 + R;
#pragma unroll
        for (int h = 0; h < 2; ++h)
#pragma unroll
            for (int i = 0; i < 2; ++i) voffG[h][i] = (unsigned)tp[h * 128 + i * 64] * (unsigned)(g.lda * ESZ) + (unsigned)(Cc * 2); } };
    const size_t kstep = (size_t)(BK * 2);
    const size_t hstepA = (size_t)HALF * g.lda * ESZ, hstepB = (size_t)HALF * g.ldb * ESZ;
    const unsigned ldsw = (unsigned)wid * 1024u;
    const unsigned ldsu = (unsigned)__builtin_amdgcn_readfirstlane((int)(unsigned)(unsigned long long)(lds));
    const int aoff = lds_byte(wr * 64 + fr, fq * 8), boff = lds_byte(wc * 32 + fr, fq * 8);
#define PG8_SA(b, h) (((b) * 2 + (h)) * HTB)
#define PG8_SB(b, h) ((4 + (b) * 2 + (h)) * HTB)
#define PG8_STAGE(bufoff, gbase, voff) do { _Pragma("unroll") for (int _i = 0; _i < 2; ++_i) { \
        asm volatile("s_mov_b32 m0, %2\n\ts_nop 3\n\tglobal_load_lds_dwordx4 %0, %1" :: "v"((voff)[_i]), "s"((const char*)(gbase)), "s"(ldsu + (unsigned)(bufoff) + ldsw + (unsigned)(_i * 8192)) : "memory"); } } while (0)
#define PG8_STAGE_A(bufoff, gbase, h) do { if constexpr (GA) PG8_STAGE(bufoff, gbase, voffG[h]); else PG8_STAGE(bufoff, (gbase) + (h) * hstepA, voffA); } while (0)
#define PG8_LDA(dst, b, h) do { _Pragma("unroll") for (int m = 0; m < 4; ++m) _Pragma("unroll") for (int k = 0; k < 2; ++k) dst[m][k] = *(const LAS bf16x8*)(lds + PG8_SA(b, h) + aoff + m * 2048 + k * 1024); } while (0)
#define PG8_LDB(dst, b, h) do { _Pragma("unroll") for (int n = 0; n < 2; ++n) _Pragma("unroll") for (int k = 0; k < 2; ++k) dst[n][k] = *(const LAS bf16x8*)(lds + PG8_SB(b, h) + boff + n * 2048 + k * 1024); } while (0)
#define PG8_CAT(x) __builtin_bit_cast(v8i32, (x))
#define PG8_MMA(ai, bj, At, Bt) do { __builtin_amdgcn_s_setprio(1); \
        if constexpr (F8) { _Pragma("unroll") for (int m = 0; m < 4; ++m) _Pragma("unroll") for (int n = 0; n < 2; ++n) \
            acc[ai][bj][m][n] = __builtin_amdgcn_mfma_scale_f32_16x16x128_f8f6f4(PG8_CAT(Bt[n]), PG8_CAT(At[m]), acc[ai][bj][m][n], 0, 0, 0, 0, 0, 0); } \
        else { _Pragma("unroll") for (int m = 0; m < 4; ++m) _Pragma("unroll") for (int n = 0; n < 2; ++n) _Pragma("unroll") for (int k = 0; k < 2; ++k) \
            acc[ai][bj][m][n] = __builtin_amdgcn_mfma_f32_16x16x32_bf16(Bt[n][k], At[m][k], acc[ai][bj][m][n], 0, 0, 0); } \
        __builtin_amdgcn_s_setprio(0); } while (0)
#define PG8_WAIT_V(n) asm volatile("s_waitcnt vmcnt(" #n ")" ::: "memory")
#define PG8_WAIT_L(n) asm volatile("s_waitcnt lgkmcnt(" #n ")" ::: "memory")
#define PG8_BAR __builtin_amdgcn_s_barrier()
#define PG8_SCHED __builtin_amdgcn_sched_barrier(0)
    Unit cur, nxt; int ui = 0;
    if (!S.next(0, cur)) return;
    Acc acc; zero_acc(acc);
    struct Frag2 { bf16x8 p[2]; __device__ __forceinline__ bf16x8& operator[](int k) { return p[k]; } __device__ __forceinline__ const bf16x8& operator[](int k) const { return p[k]; } };
    Frag2 At[4], B0[2], B1[2];
    const char* cA = cur.a; const char* cB = cur.b;
    load_goffs(0);
    PG8_STAGE(PG8_SB(0, 0), cB, voffB); PG8_STAGE(PG8_SB(0, 1), cB + hstepB, voffB); PG8_STAGE_A(PG8_SA(0, 0), cA, 0); PG8_STAGE_A(PG8_SA(0, 1), cA, 1);
    if (wr == 1) PG8_BAR;
    PG8_WAIT_V(2); PG8_BAR;
    PG8_STAGE(PG8_SB(1, 0), cB + kstep, voffB); PG8_STAGE_A(PG8_SA(1, 0), cA + kstep, 0); PG8_STAGE(PG8_SB(1, 1), cB + hstepB + kstep, voffB);
    PG8_WAIT_V(6); PG8_BAR;
    for (;;) {
        const bool has_next = S.next(ui + 1, nxt);
        const char* nA = has_next ? nxt.a : cA; const char* nB = has_next ? nxt.b : cB;
        for (int t = 0; t < nt; t += 2) {
            const bool last = (t == nt - 2);
            const char* a1 = cA + (size_t)(t + 1) * kstep;
            const char* a2 = last ? nA : cA + (size_t)(t + 2) * kstep; const char* b2 = last ? nB : cB + (size_t)(t + 2) * kstep;
            const char* a3 = a2 + kstep; const char* b3 = b2 + kstep;
            PG8_LDB(B0, 0, 0); PG8_LDB(B1, 0, 1); PG8_SCHED; PG8_LDA(At, 0, 0); PG8_STAGE_A(PG8_SA(1, 1), a1, 1);
            if (GA && last && has_next) load_goffs(ui + 1);
            PG8_WAIT_V(8); PG8_WAIT_L(0); PG8_BAR; PG8_MMA(0, 0, At, B0); PG8_MMA(0, 1, At, B1); PG8_BAR; PG8_SCHED;
            PG8_LDA(At, 0, 1); PG8_STAGE(PG8_SB(0, 0), b2, voffB); PG8_STAGE(PG8_SB(0, 1), b2 + hstepB, voffB); PG8_STAGE_A(PG8_SA(0, 0), a2, 0);
            PG8_WAIT_V(8); PG8_WAIT_L(0); PG8_BAR; PG8_MMA(1, 0, At, B0); PG8_MMA(1, 1, At, B1); PG8_BAR; PG8_SCHED;
            PG8_LDB(B0, 1, 0); PG8_LDB(B1, 1, 1); PG8_SCHED; PG8_LDA(At, 1, 0); PG8_STAGE_A(PG8_SA(0, 1), a2, 1);
            PG8_WAIT_V(8); PG8_WAIT_L(0); PG8_BAR; PG8_MMA(0, 0, At, B0); PG8_MMA(0, 1, At, B1); PG8_BAR; PG8_SCHED;
            PG8_LDA(At, 1, 1); PG8_STAGE(PG8_SB(1, 0), b3, voffB); PG8_STAGE(PG8_SB(1, 1), b3 + hstepB, voffB); PG8_STAGE_A(PG8_SA(1, 0), a3, 0);
            PG8_WAIT_V(8); PG8_WAIT_L(0); PG8_BAR; PG8_MMA(1, 0, At, B0); PG8_MMA(1, 1, At, B1); PG8_BAR; PG8_SCHED;
        }
        if (wr == 0) PG8_BAR;
        E(acc, cur, wr, wc, fr, fq);
        if (!has_next) break;
        zero_acc(acc);
        cur = nxt; cA = nA; cB = nB; ++ui;
        if (wr == 1) PG8_BAR;
    }
    PG8_WAIT_V(0);
    PG8_BAR;
#undef PG8_SA
#undef PG8_SB
#undef PG8_STAGE
#undef PG8_STAGE_A
#undef PG8_LDA
#undef PG8_LDB
#undef PG8_MMA
#undef PG8_CAT
#undef PG8_WAIT_V
#undef PG8_WAIT_L
#undef PG8_BAR
#undef PG8_SCHED
}

struct DenseOrder {
    static constexpr bool GATHER = false;
    const char* A; const char* Bt; int lda, ldb, nM, nN, nwg, G, c, esz;
    __device__ __forceinline__ void init(const void* A_, const void* Bt_, int lda_, int ldb_, int M, int N, int G_, int c_, int esz_ = 2) { A = (const char*)A_; Bt = (const char*)Bt_; lda = lda_; ldb = ldb_; nM = M / BM; nN = N / BM; nwg = nM * nN; G = G_; c = c_; esz = esz_; }
    __device__ __forceinline__ bool next(int i, Unit& u) const {
        const long L = (long)i * G + c; if (L >= nwg) return false;
        int wgid = (int)L; { const int q = nwg / 8, r = nwg % 8, xcd = wgid % 8, off = wgid / 8; wgid = (xcd < r ? xcd * (q + 1) : r * (q + 1) + (xcd - r) * q) + off; }
        const int nig = 8 * nN, gid = wgid / nig, fm = gid * 8, gsz = (nM - fm) < 8 ? (nM - fm) : 8;
        const int pm = fm + ((wgid % nig) % gsz), pn = (wgid % nig) / gsz;
        u.a = A + (size_t)pm * BM * lda * esz; u.b = Bt + (size_t)pn * BM * ldb * esz; u.row0 = pm * BM; u.col0 = pn * BM; u.e = 0; u.pad = 0; return true;
    }
};
struct LruOrder {
    static constexpr bool GATHER = false;
    const char* XC; const char* RG; int G, c;
    __device__ __forceinline__ bool next(int i, Unit& u) const {
        const int L = i * G + c; if (L >= 512) return false;
        const int pm = L >> 3, n = L & 7;
        u.a = XC + ((size_t)pm * BM * 1024 + n * 128) * 2; u.b = RG + (size_t)n * 256 * 128 * 2; u.row0 = pm * BM; u.col0 = n * 128; u.e = n; u.pad = 0; return true;
    }
};
template <bool GATHER_ = false> struct MoeOrderT {
    static constexpr bool GATHER = GATHER_; const LAS int* gtab;
    const char* A; const char* WT; size_t estride; const LAS int* tile_e; int NT, nN, G, c, esz;
    __device__ __forceinline__ bool next(int i, Unit& u) const {
        int tile, pn;
#ifndef MOE_ORDER_ALT
#define MOE_ORDER_ALT 0
#endif
        if (!MOE_ORDER_ALT && (G % (8 * nN)) == 0) { const int R = G / nN; tile = i * R + (c & 7) * (R >> 3) + (c >> 3) / nN; pn = (c >> 3) % nN; }
        else { const int L = i * G + c; tile = L / nN; pn = L % nN; }
        if (tile >= NT) return false;
        const int e = __builtin_amdgcn_readfirstlane(tile_e[tile]);
        u.a = GATHER ? A : A + (size_t)tile * BM * 1024 * esz; u.b = WT + (size_t)e * estride + (size_t)pn * BM * 1024 * esz; u.row0 = tile * BM; u.col0 = pn * BM; u.e = e; u.pad = i; return true;
    }
};
typedef MoeOrderT<false> MoeOrder;

#define EPI_ROW(ai, m) (u.row0 + (ai) * HALF + wr * 64 + (m) * 16 + fr)
#define EPI_COL(bj) (u.col0 + (bj) * HALF + wc * 32 + 8 * fq)
struct EpiBf16 {
    bf16_t* O; const float* bias; int ldc, bias_es; float ascale; const LAS float* btab = nullptr;
    __device__ __forceinline__ void operator()(const Acc& acc, const Unit& u, int wr, int wc, int fr, int fq) const {
        f32x4 bv[2][2];
#pragma unroll
        for (int bj = 0; bj < 2; ++bj)
#pragma unroll
            for (int n = 0; n < 2; ++n) bv[bj][n] = btab ? *(const LAS f32x4*)(btab + u.pad * 256 + bj * HALF + wc * 32 + 8 * fq + 4 * n) : bias ? *(const f32x4*)(bias + (size_t)u.e * bias_es + EPI_COL(bj) + 4 * n) : (f32x4){0.f, 0.f, 0.f, 0.f};
#pragma unroll
        for (int ai = 0; ai < 2; ++ai)
#pragma unroll
            for (int m = 0; m < 4; ++m) { bf16_t* rowp = O + (size_t)EPI_ROW(ai, m) * ldc;
#pragma unroll
                for (int bj = 0; bj < 2; ++bj) { const f32x4 v0 = acc[ai][bj][m][0] * ascale + bv[bj][0], v1 = acc[ai][bj][m][1] * ascale + bv[bj][1];
                    u32x4 w; w.x = cvt_pk_bf16(v0[0], v0[1]); w.y = cvt_pk_bf16(v0[2], v0[3]); w.z = cvt_pk_bf16(v1[0], v1[1]); w.w = cvt_pk_bf16(v1[2], v1[3]);
                    *(u32x4*)(rowp + EPI_COL(bj)) = w; } }
    }
};
template <int KIND> struct EpiNorm {
    bf16_t* O; int ldc; const float* ga; const float* gb; const float* gc; const float* gd; const float* ge; const float* cs; LAS float* S; float ascale;
    __device__ __forceinline__ void operator()(const Acc& acc, const Unit& u, int wr, int wc, int fr, int fq) const {
        const int pn = u.col0 >> 8; const int lane = fr + 16 * fq; const float as2 = ascale * ascale;
        int mode = 0; const float* gp = ga; float scale = 1.f;
        if (KIND == 0) { if (pn < 2) { mode = 1; gp = ga; scale = 0.125f * 1.4426950408889634f; } else if (pn < 4) { mode = 1; gp = gb; } else if (pn < 6) mode = 0; else if (pn == 6) { mode = 2; gp = gc; } else { mode = 3; gp = gd; } }
        if (KIND == 1) { scale = 0.10206207261596575f * 1.4426950408889634f; if (pn < 2) { mode = 1; gp = ga; } else { mode = 4; gp = gb; } }
        if (KIND == 2) { if (pn < 2) { mode = 1; gp = ga; } else mode = 0; }
        if (mode != 0) {
#pragma unroll
            for (int ai = 0; ai < 2; ++ai)
#pragma unroll
                for (int m = 0; m < 4; ++m)
#pragma unroll
                    for (int bj = 0; bj < 2; ++bj) { const f32x4 a = acc[ai][bj][m][0], b = acc[ai][bj][m][1];
                        float s = (a[0] * a[0] + a[1] * a[1]) + (a[2] * a[2] + a[3] * a[3]) + (b[0] * b[0] + b[1] * b[1]) + (b[2] * b[2] + b[3] * b[3]);
                        s += shx<16>(s); s = xadd32(s);
                        if (fq == 0) S[(ai * HALF + wr * 64 + m * 16 + fr) * 8 + bj * 4 + wc] = s; }
            asm volatile("s_waitcnt lgkmcnt(0)" ::: "memory"); __builtin_amdgcn_s_barrier(); asm volatile("" ::: "memory");
        }
        const float inv_n = (mode == 1) ? (1.f / 64.f) : (mode == 2) ? (1.f / 256.f) : (1.f / 32.f);
        const bool rope_tile = (mode == 4) || (mode == 3);
#pragma unroll
        for (int bj = 0; bj < 2; ++bj) {
            f32x4 g0 = (f32x4){1.f, 1.f, 1.f, 1.f}, g1 = g0; bool rope = false, zero = false; float invn = inv_n;
            int c8 = 8 * fq; asm volatile("" : "+v"(c8));
            if (mode == 1) { const int c = 32 * (wc & 1) + c8; g0 = *(const f32x4*)(gp + c); g1 = *(const f32x4*)(gp + c + 4); }
            else if (mode == 2) { const int c = bj * HALF + wc * 32 + c8; g0 = *(const f32x4*)(gp + c); g1 = *(const f32x4*)(gp + c + 4); }
            else if (mode == 3) { if (bj == 0) { const int c = wc * 32 + c8; g0 = *(const f32x4*)(gp + c); g1 = *(const f32x4*)(gp + c + 4); invn = 1.f / 128.f; }
                                  else if (wc == 0) { g0 = *(const f32x4*)(ge + c8); g1 = *(const f32x4*)(ge + c8 + 4); rope = true; } else zero = true; }
            else if (mode == 4) { g0 = *(const f32x4*)(gp + c8); g1 = *(const f32x4*)(gp + c8 + 4); rope = true; }
            (void)rope_tile;
#pragma unroll
            for (int ai = 0; ai < 2; ++ai)
#pragma unroll
                for (int m = 0; m < 4; ++m) { const int row = EPI_ROW(ai, m);
                    f32x4 v0 = acc[ai][bj][m][0], v1 = acc[ai][bj][m][1];
                    if (mode != 0) { const LAS float* sr = S + (ai * HALF + wr * 64 + m * 16 + fr) * 8; float tot;
                        if (mode == 1) { const f32x2 t = *(const LAS f32x2*)(sr + bj * 4 + (wc & 2)); tot = t[0] + t[1]; }
                        else if (mode == 2) { const f32x4 t0 = *(const LAS f32x4*)sr, t1 = *(const LAS f32x4*)(sr + 4); tot = (t0[0] + t0[1]) + (t0[2] + t0[3]) + (t1[0] + t1[1]) + (t1[2] + t1[3]); }
                        else if (mode == 3 && bj == 0) { const f32x4 t0 = *(const LAS f32x4*)sr; tot = (t0[0] + t0[1]) + (t0[2] + t0[3]); }
                        else tot = sr[bj * 4 + wc];
                        const float rs = rsqrtf(tot * as2 * invn + 1e-6f) * scale * ascale; v0 = v0 * rs * g0; v1 = v1 * rs * g1; } else { v0 = v0 * ascale; v1 = v1 * ascale; }
                    if (rope) {
                        const float* cr = cs + (size_t)row * 32 + 8 * (fq & 1); const f32x4 c0 = *(const f32x4*)cr, c1 = *(const f32x4*)(cr + 4), s0 = *(const f32x4*)(cr + 16), s1 = *(const f32x4*)(cr + 20);
                        f32x4 o0, o1;
#pragma unroll
                        for (int j = 0; j < 4; ++j) { const auto r0 = __builtin_amdgcn_permlane32_swap(__float_as_uint(v0[j]), __float_as_uint(v0[j]), false, false), r1 = __builtin_amdgcn_permlane32_swap(__float_as_uint(v1[j]), __float_as_uint(v1[j]), false, false);
                            const float ot0 = __uint_as_float(lane < 32 ? r0[1] : r0[0]), ot1 = __uint_as_float(lane < 32 ? r1[1] : r1[0]);
                            o0[j] = (lane < 32) ? (v0[j] * c0[j] - ot0 * s0[j]) : (ot0 * s0[j] + v0[j] * c0[j]);
                            o1[j] = (lane < 32) ? (v1[j] * c1[j] - ot1 * s1[j]) : (ot1 * s1[j] + v1[j] * c1[j]); }
                        v0 = o0; v1 = o1; }
                    if (zero) { v0 = (f32x4){0.f, 0.f, 0.f, 0.f}; v1 = v0; }
                    u32x4 w; w.x = cvt_pk_bf16(v0[0], v0[1]); w.y = cvt_pk_bf16(v0[2], v0[3]); w.z = cvt_pk_bf16(v1[0], v1[1]); w.w = cvt_pk_bf16(v1[2], v1[3]);
                    *(u32x4*)(O + (size_t)row * ldc + EPI_COL(bj)) = w; } }
    }
};
struct EpiRecIn {
    bf16_t* O; const float* bias;
    __device__ __forceinline__ void operator()(const Acc& acc, const Unit& u, int wr, int wc, int fr, int fq) const {
        const bool act = u.col0 < 1024;
        f32x4 bv[2][2];
#pragma unroll
        for (int bj = 0; bj < 2; ++bj)
#pragma unroll
            for (int n = 0; n < 2; ++n) bv[bj][n] = *(const f32x4*)(bias + EPI_COL(bj) + 4 * n);
#pragma unroll
        for (int ai = 0; ai < 2; ++ai)
#pragma unroll
            for (int m = 0; m < 4; ++m) { bf16_t* rowp = O + (size_t)EPI_ROW(ai, m) * 2048;
#pragma unroll
                for (int bj = 0; bj < 2; ++bj) { f32x4 v0 = acc[ai][bj][m][0] + bv[bj][0], v1 = acc[ai][bj][m][1] + bv[bj][1];
                    if (act) {
#pragma unroll
                        for (int j = 0; j < 4; ++j) { v0[j] = fgelu_tanh(v0[j]); v1[j] = fgelu_tanh(v1[j]); } }
                    u32x4 w; w.x = cvt_pk_bf16(v0[0], v0[1]); w.y = cvt_pk_bf16(v0[2], v0[3]); w.z = cvt_pk_bf16(v1[0], v1[1]); w.w = cvt_pk_bf16(v1[2], v1[3]);
                    *(u32x4*)(rowp + EPI_COL(bj)) = w; } }
    }
};
__device__ __forceinline__ unsigned pk4_fp8(float a, float b, float c, float d) { int w = 0; w = __builtin_amdgcn_cvt_pk_fp8_f32(a, b, w, false); w = __builtin_amdgcn_cvt_pk_fp8_f32(c, d, w, true); return (unsigned)w; }
struct EpiSwiglu {
    unsigned char* ACT; const LAS float* btab; float ascale;
    __device__ __forceinline__ float sw(float g, float l) const { g = fminf(g, 7.f); l = fminf(fmaxf(l, -7.f), 7.f); return g * fsigmoid(1.702f * g) * (l + 1.f); }
    __device__ __forceinline__ void operator()(const Acc& acc, const Unit& u, int wr, int wc, int fr, int fq) const {
        f32x4 bv[2][2];
#pragma unroll
        for (int bj = 0; bj < 2; ++bj)
#pragma unroll
            for (int n = 0; n < 2; ++n) bv[bj][n] = *(const LAS f32x4*)(btab + u.pad * 256 + bj * HALF + wc * 32 + 8 * fq + 4 * n);
#pragma unroll
        for (int ai = 0; ai < 2; ++ai)
#pragma unroll
            for (int m = 0; m < 4; ++m) { unsigned char* rowp = ACT + (size_t)EPI_ROW(ai, m) * 1024;
#pragma unroll
                for (int bj = 0; bj < 2; ++bj) { const f32x4 v0 = acc[ai][bj][m][0] * ascale + bv[bj][0], v1 = acc[ai][bj][m][1] * ascale + bv[bj][1];
                    f32x4 g = (f32x4){fminf(v0[0], 7.f), fminf(v0[2], 7.f), fminf(v1[0], 7.f), fminf(v1[2], 7.f)};
                    const f32x4 lu = (f32x4){fminf(fmaxf(v0[1], -7.f), 7.f), fminf(fmaxf(v0[3], -7.f), 7.f), fminf(fmaxf(v1[1], -7.f), 7.f), fminf(fmaxf(v1[3], -7.f), 7.f)};
                    const f32x4 t = g * (-1.702f * 1.4426950408889634f);
                    const f32x4 d = (f32x4){fexp2(t[0]), fexp2(t[1]), fexp2(t[2]), fexp2(t[3])} + 1.f;
                    const f32x4 gs = g * (f32x4){frcp(d[0]), frcp(d[1]), frcp(d[2]), frcp(d[3])};
                    const f32x4 o = gs * lu + gs;
                    *(unsigned*)(rowp + (EPI_COL(bj) >> 1)) = pk4_fp8(o[0], o[1], o[2], o[3]); } }
    }
};
struct EpiResid {
    bf16_t* X; const float* g; const float* bias;
    __device__ __forceinline__ void operator()(const Acc& acc, const Unit& u, int wr, int wc, int fr, int fq) const {
        const int b = u.row0 / cfg::S;
        f32x4 bv[2][2], gv[2][2];
#pragma unroll
        for (int bj = 0; bj < 2; ++bj)
#pragma unroll
            for (int n = 0; n < 2; ++n) { bv[bj][n] = bias ? *(const f32x4*)(bias + EPI_COL(bj) + 4 * n) : (f32x4){0.f, 0.f, 0.f, 0.f}; gv[bj][n] = *(const f32x4*)(g + b * 6144 + EPI_COL(bj) + 4 * n); }
#pragma unroll
        for (int ai = 0; ai < 2; ++ai)
#pragma unroll
            for (int m = 0; m < 4; ++m) { bf16_t* rowp = X + (size_t)EPI_ROW(ai, m) * 1024;
#pragma unroll
                for (int bj = 0; bj < 2; ++bj) { u32x4* p = (u32x4*)(rowp + EPI_COL(bj)); const u32x4 xw = *p;
                    const f32x4 x0 = (f32x4){bf_lo(xw.x), bf_hi(xw.x), bf_lo(xw.y), bf_hi(xw.y)} + gv[bj][0] * (acc[ai][bj][m][0] + bv[bj][0]);
                    const f32x4 x1 = (f32x4){bf_lo(xw.z), bf_hi(xw.z), bf_lo(xw.w), bf_hi(xw.w)} + gv[bj][1] * (acc[ai][bj][m][1] + bv[bj][1]);
                    u32x4 w; w.x = cvt_pk_bf16(x0[0], x0[1]); w.y = cvt_pk_bf16(x0[2], x0[3]); w.z = cvt_pk_bf16(x1[0], x1[1]); w.w = cvt_pk_bf16(x1[2], x1[3]); *p = w; }
                if (m & 1) asm volatile("" ::: "memory"); }
    }
};
struct EpiLru {
    const bf16_t* XC; const float* ba; const float* bx; const float* lam; bf16_t* LA; bf16_t* Bb;
    __device__ __forceinline__ void operator()(const Acc& acc, const Unit& u, int wr, int wc, int fr, int fq) const {
        const int ch0 = u.col0 + wc * 32 + 8 * fq;
#pragma unroll
        for (int n = 0; n < 2; ++n) { const int ch = ch0 + 4 * n;
            const f32x4 bav = *(const f32x4*)(ba + ch), bxv = *(const f32x4*)(bx + ch), spv = *(const f32x4*)(lam + ch);
#pragma unroll
            for (int ai = 0; ai < 2; ++ai)
#pragma unroll
                for (int m = 0; m < 4; ++m) { const size_t ro = (size_t)EPI_ROW(ai, m) * 1024 + ch;
                    const u32x2 xr = *(const u32x2*)(XC + ro);
                    const float xcv[4] = {bf_lo(xr.x), bf_hi(xr.x), bf_lo(xr.y), bf_hi(xr.y)};
                    float lav[4], bvv[4];
#pragma unroll
                    for (int j = 0; j < 4; ++j) { const float r = fsigmoid(acc[ai][0][m][n][j] + bav[j]), ig = fsigmoid(acc[ai][1][m][n][j] + bxv[j]);
                        const float la = r * spv[j], a = fexp2(la); lav[j] = la; bvv[j] = __builtin_amdgcn_sqrtf(fmaxf(1.f - a * a, 0.f)) * ig * xcv[j]; }
                    u32x2 wa, wb; wa.x = cvt_pk_bf16(lav[0], lav[1]); wa.y = cvt_pk_bf16(lav[2], lav[3]); wb.x = cvt_pk_bf16(bvv[0], bvv[1]); wb.y = cvt_pk_bf16(bvv[2], bvv[3]);
                    *(u32x2*)(LA + ro) = wa; *(u32x2*)(Bb + ro) = wb; asm volatile("" ::: "memory"); } }
    }
};

constexpr size_t MiB = (size_t)1 << 20;
constexpr size_t al4k(size_t x) { return (x + 4095) & ~(size_t)4095; }
constexpr int T_ = cfg::T, S_ = cfg::S, P_ = cfg::P;
constexpr size_t O_CTL = 0, SZ_CTL = 1 * MiB;
constexpr size_t O_MOD = O_CTL + SZ_CTL, SZ_MOD = al4k((size_t)4 * 4 * 6144 * 4);
constexpr size_t O_CS = O_MOD + SZ_MOD, SZ_CS = (size_t)T_ * 32 * 4;
constexpr size_t O_HIST = O_CS + SZ_CS, SZ_HIST = 256 * 32 * 4;
constexpr size_t O_TOPI = O_HIST + SZ_HIST, SZ_TOP = (size_t)T_ * 4 * 4;
constexpr size_t O_TOPG = O_TOPI + SZ_TOP, O_POS = O_TOPG + SZ_TOP;
constexpr size_t O_SUMP = O_POS + SZ_TOP, SZ_SUM = (size_t)4 * 64 * 1024 * 4;
constexpr size_t O_SUMH = O_SUMP + SZ_SUM;
constexpr size_t O_LSE = O_SUMH + SZ_SUM, SZ_LSE = (size_t)3 * T_ * 8 * 4;
constexpr size_t O_SPV = al4k(O_LSE + SZ_LSE), SZ_SPV = 2 * 1024 * 4;
constexpr size_t O_WIN = al4k(O_SPV + SZ_SPV), SZ_WIN = (size_t)2048 * 1024;
constexpr size_t O_WUQ = O_WIN + 2 * SZ_WIN, SZ_WUQ = (size_t)768 * 256 * 2;
constexpr size_t O_WUKV = O_WUQ + 2 * SZ_WUQ, SZ_WUKV = (size_t)1024 * 128 * 2;
constexpr size_t O_WOUT = O_WUKV + 2 * SZ_WUKV, SZ_WOUT = (size_t)1024 * 1024 * 2;
constexpr size_t O_RWIN = O_WOUT + 2 * SZ_WOUT, SZ_RWIN = (size_t)2048 * 1024 * 2;
constexpr size_t O_RGATE = O_RWIN + 2 * SZ_RWIN, SZ_RGATE = (size_t)8 * 256 * 128 * 2;
constexpr size_t O_RWOUT = O_RGATE + 2 * SZ_RGATE, SZ_RWOUT = (size_t)1024 * 1024 * 2;
constexpr size_t O_W1 = O_RWOUT + 2 * SZ_RWOUT, SZ_W1E = (size_t)2048 * 1024;
constexpr size_t O_W2 = O_W1 + 128 * SZ_W1E, SZ_W2E = (size_t)1024 * 1024;
constexpr size_t O_HN = O_W2 + 128 * SZ_W2E, SZ_HN = (size_t)T_ * 1024 * 2;
constexpr size_t O_PROJ = O_HN + SZ_HN, SZ_PROJ = (size_t)T_ * 2048 * 2;
constexpr size_t O_Q2 = O_PROJ + SZ_PROJ, SZ_Q2 = (size_t)T_ * 768 * 2;
constexpr size_t O_KV2 = O_Q2 + SZ_Q2, SZ_KV2 = (size_t)T_ * 1024 * 2;
constexpr size_t O_OA = O_KV2 + SZ_KV2, SZ_OA = (size_t)3 * T_ * 512 * 2;
constexpr size_t O_ATT = O_OA + SZ_OA, SZ_ATT = (size_t)T_ * 1024 * 2;
constexpr size_t O_XC = O_ATT + SZ_ATT, SZ_XC = (size_t)T_ * 1024 * 2;
constexpr size_t O_AA = O_XC + SZ_XC, SZ_AA = (size_t)T_ * 1024 * 4;
constexpr size_t O_BB = O_AA + SZ_AA;
constexpr size_t O_XG = O_BB + SZ_AA, SZ_XG = (size_t)P_ * 1024 * 2, O_INV = O_XG, O_POSJ = O_XG + 4 * MiB;
constexpr size_t O_ACT = O_XG + SZ_XG, O_Y2 = O_ACT + SZ_XG;
constexpr size_t O_X = O_Y2 + SZ_XG, SZ_X = (size_t)T_ * 1024 * 2;
constexpr size_t O_DUMMY = O_X + SZ_X, SZ_DUMMY = (size_t)96 * MiB;
constexpr size_t WS_MK_END = O_DUMMY + SZ_DUMMY;
constexpr size_t O_NAIVE = (size_t)2048 * MiB;
static_assert(WS_MK_END <= O_NAIVE, "mk workspace");
constexpr int CW_BAR = 4096;
constexpr size_t O_ECNT = O_CTL + 512 * 1024;
constexpr int RING_BYTES = 131072, LDSX_OFF = RING_BYTES;
constexpr int LDS_BYTES = 163840;
constexpr int LX_TILE = LDSX_OFF + 64, LX_MISC = LDSX_OFF + 2048, LX_EXCH = LDSX_OFF + 6144, LX_GTAB = LX_EXCH, GTAB_UNITS = 10, LX_BIAS = LDSX_OFF + 16384;

struct Args { const void* in[34]; float* out; unsigned char* ws; int ph_lo, ph_hi; };
struct Ctx { int tid, lane, wave, G, bid, vcu, gw, NGW; LAS unsigned char* lds; unsigned char* ws; };

__device__ __forceinline__ void conv_load(f32x4 (&v)[16], const float* __restrict__ W, int N, int n0, int k0, int lane) {
    const int n = n0 + 4 * (lane & 15); const float* p = W + (size_t)(k0 + 16 * (lane >> 4)) * N + n;
#pragma unroll
    for (int i = 0; i < 16; ++i) v[i] = (n < N) ? __builtin_nontemporal_load((const f32x4*)(p + (size_t)i * N)) : (f32x4){0.f, 0.f, 0.f, 0.f};
}
__device__ __forceinline__ int conv_row(int c, int perm) { if (perm == 1) { const int h = c / 96, d = c % 96; return d < 64 ? 64 * h + d : 512 + 32 * h + d - 64; } if (perm == 2) { const int h = c >> 7, d = c & 127; return d < 64 ? 64 * h + d : 512 + 64 * h + d - 64; } return c; }
__device__ __forceinline__ void conv_emit(const f32x4 (&v)[16], LAS unsigned char* T  , bf16_t* __restrict__ WT, int ldd, int n0, int k0, int lane, int perm) {
    const int kq = lane >> 4, c4 = lane & 15;
#pragma unroll
    for (int jj = 0; jj < 4; ++jj) { u32x4 lo, hi;
        lo.x = cvt_pk_bf16(v[0][jj], v[1][jj]); lo.y = cvt_pk_bf16(v[2][jj], v[3][jj]); lo.z = cvt_pk_bf16(v[4][jj], v[5][jj]); lo.w = cvt_pk_bf16(v[6][jj], v[7][jj]);
        hi.x = cvt_pk_bf16(v[8][jj], v[9][jj]); hi.y = cvt_pk_bf16(v[10][jj], v[11][jj]); hi.z = cvt_pk_bf16(v[12][jj], v[13][jj]); hi.w = cvt_pk_bf16(v[14][jj], v[15][jj]);
        LAS unsigned char* q = T + (4 * c4 + jj) * 144 + 32 * kq; *(LAS u32x4*)q = lo; *(LAS u32x4*)(q + 16) = hi; }
    asm volatile("s_waitcnt lgkmcnt(0)" ::: "memory");
#pragma unroll
    for (int s8 = 0; s8 < 8; ++s8) { const int n = 8 * s8 + (lane >> 3), ch = lane & 7; const u32x4 w = *(const LAS u32x4*)(T + n * 144 + 16 * ch);
        *(u32x4*)(WT + (size_t)conv_row(n0 + n, perm) * ldd + k0 + 8 * ch) = w; }
    asm volatile("s_waitcnt lgkmcnt(0)" ::: "memory");
}
__device__ __forceinline__ void conv8_tile(const float* __restrict__ W, int N, unsigned char* __restrict__ WT, int ldd, int n0, int k0, LAS unsigned char* T  , int lane) {
    const int kq = lane >> 4, c4 = lane & 15; const float* p = W + (size_t)(k0 + 32 * kq) * N + n0 + 4 * c4;
    f32x4 v[32];
#pragma unroll
    for (int i = 0; i < 32; ++i) v[i] = (n0 + 4 * c4 < N) ? __builtin_nontemporal_load((const f32x4*)(p + (size_t)i * N)) : (f32x4){0.f, 0.f, 0.f, 0.f};
#pragma unroll
    for (int jj = 0; jj < 4; ++jj) { u32x4 lo, hi;
        lo.x = pk4_fp8(32.f * v[0][jj], 32.f * v[1][jj], 32.f * v[2][jj], 32.f * v[3][jj]);     lo.y = pk4_fp8(32.f * v[4][jj], 32.f * v[5][jj], 32.f * v[6][jj], 32.f * v[7][jj]);
        lo.z = pk4_fp8(32.f * v[8][jj], 32.f * v[9][jj], 32.f * v[10][jj], 32.f * v[11][jj]);   lo.w = pk4_fp8(32.f * v[12][jj], 32.f * v[13][jj], 32.f * v[14][jj], 32.f * v[15][jj]);
        hi.x = pk4_fp8(32.f * v[16][jj], 32.f * v[17][jj], 32.f * v[18][jj], 32.f * v[19][jj]); hi.y = pk4_fp8(32.f * v[20][jj], 32.f * v[21][jj], 32.f * v[22][jj], 32.f * v[23][jj]);
        hi.z = pk4_fp8(32.f * v[24][jj], 32.f * v[25][jj], 32.f * v[26][jj], 32.f * v[27][jj]); hi.w = pk4_fp8(32.f * v[28][jj], 32.f * v[29][jj], 32.f * v[30][jj], 32.f * v[31][jj]);
        LAS unsigned char* q = T + (4 * c4 + jj) * 144 + 32 * kq; *(LAS u32x4*)q = lo; *(LAS u32x4*)(q + 16) = hi; }
    asm volatile("s_waitcnt lgkmcnt(0)" ::: "memory");
#pragma unroll
    for (int s8 = 0; s8 < 8; ++s8) { const int n = 8 * s8 + (lane >> 3), ch = lane & 7; const u32x4 w = *(const LAS u32x4*)(T + n * 144 + 16 * ch);
        *(u32x4*)(WT + (size_t)(n0 + n) * ldd + k0 + 16 * ch) = w; }
    asm volatile("s_waitcnt lgkmcnt(0)" ::: "memory");
}
template <class AP> __device__ __forceinline__ void p0_prologue(const Ctx& C, AP a) {
    unsigned char* ws = C.ws;
    { const float* c = (const float*)a->in[1]; const float* ada_w = (const float*)a->in[3]; const float* ada_b = (const float*)a->in[4]; float* mod = (float*)(ws + O_MOD);
      LAS float* part = (LAS float*)C.lds;
      LAS float* cact = (LAS float*)(C.lds + 32768);
      if (C.bid < 4 * 24) { for (int i = C.tid; i < 4096; i += 512) { const int b = i >> 10, k = i & 1023; const float cv = c[i]; cact[k * 4 + b] = cv / (1.f + expf(-cv)); } __syncthreads(); }
      for (int it = C.bid; it < 4 * 24; it += C.G) { const int l = it / 24, n0 = (it % 24) * 256;
          f32x4 acc[4];
#pragma unroll
          for (int b = 0; b < 4; ++b) acc[b] = (f32x4){0.f, 0.f, 0.f, 0.f};
          const float* w = ada_w + (size_t)l * 1024 * 6144 + n0 + 4 * C.lane;
#pragma unroll 1
          for (int k0 = C.wave * 128; k0 < C.wave * 128 + 128; k0 += 16) { f32x4 wv[16];
#pragma unroll
              for (int i = 0; i < 16; ++i) wv[i] = __builtin_nontemporal_load((const f32x4*)(w + (size_t)(k0 + i) * 6144));
#pragma unroll
              for (int i = 0; i < 16; ++i) { const f32x4 sv = *(const LAS f32x4*)(cact + (k0 + i) * 4);
#pragma unroll
                  for (int b = 0; b < 4; ++b) acc[b] = acc[b] + sv[b] * wv[i]; } }
#pragma unroll
          for (int b = 0; b < 4; ++b) *(LAS f32x4*)(part + (C.wave * 4 + b) * 256 + 4 * C.lane) = acc[b];
          __syncthreads();
          for (int o = C.tid; o < 1024; o += 512) { const int b = o >> 8, n = o & 255; float sacc = ada_b[l * 6144 + n0 + n];
#pragma unroll
              for (int w8 = 0; w8 < 8; ++w8) sacc += part[(w8 * 4 + b) * 256 + n];
              mod[((size_t)l * 4 + b) * 6144 + n0 + n] = sacc; }
          __syncthreads(); } }
    { const int* positions = (const int*)a->in[2]; float* cs = (float*)(ws + O_CS);
      for (int i = C.bid * 512 + C.tid; i < T_ * 16; i += C.G * 512) { const int t = i >> 4, f = i & 15; const float inv = powf(10000.f, -(float)(2 * f) / 32.f); const float ang = (float)positions[t] * inv;
          cs[t * 32 + f] = cosf(ang); cs[t * 32 + 16 + f] = sinf(ang); } }
    { const float* lam = (const float*)a->in[25]; float* spv = (float*)(ws + O_SPV);
      for (int i = C.bid * 512 + C.tid; i < 2048; i += C.G * 512) spv[i] = -8.f * 1.4426950408889634f * log1pf(expf(-lam[i])); }
    { const int lane = C.lane; LAS unsigned char* T = C.lds + 49152 + C.wave * 9216;
      const float* attn_w_in = (const float*)a->in[7]; const float* w_uq = (const float*)a->in[12]; const float* w_ukv = (const float*)a->in[13]; const float* attn_w_out = (const float*)a->in[16];
      const float* rec_w_in = (const float*)a->in[17]; const float* rec_wa = (const float*)a->in[21]; const float* rec_wx = (const float*)a->in[23]; const float* rec_w_out = (const float*)a->in[26];
      const float* w1 = (const float*)a->in[30]; const float* w2 = (const float*)a->in[32];
      constexpr int T_WIN = 32 * 16, T_WUQ = 12 * 4, T_WUKV = 16 * 2, T_WOUT = 16 * 16, T_RWIN = 32 * 16, T_RG = 2 * 2, T_RWOUT = 16 * 16, T_W1 = 32 * 16, T_W2 = 16 * 16;
      constexpr int NITEMS = 2 * (T_WUQ + T_WUKV + T_WOUT + T_RWIN + 16 * T_RG + T_RWOUT);
      struct Job { const float* W; bf16_t* WT; int N, ldd, n0, k0, perm; };
      auto decode = [&](int r, Job& jb) {
#define CONV_JOB(SRC, KK, NN, DST, NROWS, NMAT, SRC_MS, DST_MS, PERM) { constexpr int kc_ = (KK) / 64, per_ = ((NROWS) / 64) * kc_, tot_ = per_ * (NMAT); \
          if (r < tot_) { const int mat_ = r / per_, q_ = r % per_; jb.W = (SRC) + (size_t)mat_ * (SRC_MS); jb.WT = (bf16_t*)(ws + (DST) + (size_t)mat_ * (DST_MS)); jb.N = (NN); jb.ldd = (KK); jb.n0 = (q_ / kc_) * 64; jb.k0 = (q_ % kc_) * 64; jb.perm = (PERM); return; } r -= tot_; }
          CONV_JOB(w_uq, 256, 768, O_WUQ, 768, 2, (size_t)256 * 768, SZ_WUQ, 1)
          CONV_JOB(w_ukv, 128, 1024, O_WUKV, 1024, 2, (size_t)128 * 1024, SZ_WUKV, 2)
          CONV_JOB(attn_w_out, 1024, 1024, O_WOUT, 1024, 2, (size_t)1024 * 1024, SZ_WOUT, 0)
          CONV_JOB(rec_w_in, 1024, 2048, O_RWIN, 2048, 2, (size_t)1024 * 2048, SZ_RWIN, 0)
          CONV_JOB(rec_wa, 128, 128, O_RGATE, 128, 16, (size_t)128 * 128, (size_t)256 * 128 * 2, 0)
          CONV_JOB(rec_wx, 128, 128, O_RGATE + (size_t)128 * 128 * 2, 128, 16, (size_t)128 * 128, (size_t)256 * 128 * 2, 0)
          CONV_JOB(rec_w_out, 1024, 1024, O_RWOUT, 1024, 2, (size_t)1024 * 1024, SZ_RWOUT, 0)
#undef CONV_JOB
          jb.W = attn_w_out; jb.WT = (bf16_t*)(ws + O_WOUT); jb.N = 1024; jb.ldd = 1024; jb.n0 = 0; jb.k0 = 0; jb.perm = 0; };
      f32x4 va[16], vb[16]; Job ja, jn;
      int it = C.gw;
      if (it < NITEMS) { decode(it, ja); conv_load(va, ja.W, ja.N, ja.n0, ja.k0, lane); }
#pragma unroll 1
      for (; it < NITEMS; it += 2 * C.NGW) {
          const bool h1 = it + C.NGW < NITEMS;
          if (h1) { decode(it + C.NGW, jn); conv_load(vb, jn.W, jn.N, jn.n0, jn.k0, lane); }
          conv_emit(va, T, ja.WT, ja.ldd, ja.n0, ja.k0, lane, ja.perm);
          const bool h2 = it + 2 * C.NGW < NITEMS;
          if (h2) { decode(it + 2 * C.NGW, ja); conv_load(va, ja.W, ja.N, ja.n0, ja.k0, lane); }
          if (h1) conv_emit(vb, T, jn.WT, jn.ldd, jn.n0, jn.k0, lane, jn.perm);
      }
      { constexpr int IM = 32 * 8;
#pragma unroll 1
        for (int i8 = C.gw; i8 < 2 * IM; i8 += C.NGW) { const int mat = i8 / IM, q = i8 % IM;
            conv8_tile(attn_w_in + (size_t)mat * 1024 * 1952, 1952, ws + O_WIN + (size_t)mat * SZ_WIN, 1024, (q >> 3) * 64, (q & 7) * 128, T, lane); } }
    }
}

__device__ __forceinline__ void phase_norm(const Ctx& C, const float* xin  , float* out  , bool combine, bool do_norm, const float* gain, const float* modc  , const float* modl  , int shoff, int scoff, bool dummy = false, bool f8 = false  ) {
    const bf16_t* Y2 = (const bf16_t*)(C.ws + O_Y2); const int* pos = (const int*)(C.ws + O_POS); const float* topg = (const float*)(C.ws + O_TOPG); bf16_t* HN = (bf16_t*)(C.ws + (dummy ? O_DUMMY : O_HN)); const bf16_t* X = (const bf16_t*)(C.ws + O_X); bf16_t* Xo = (bf16_t*)(C.ws + (dummy ? O_DUMMY + 32 * MiB : O_X));
    const int lane = C.lane;
    for (int t = C.gw; t < T_; t += C.NGW) { const int b = t / S_;
        f32x4 v[4];
        if (xin) {
#pragma unroll
            for (int j = 0; j < 4; ++j) v[j] = *(const f32x4*)(xin + (size_t)t * 1024 + 256 * j + 4 * lane); }
        else {
#pragma unroll
            for (int j = 0; j < 4; ++j) { const u32x2 w = *(const u32x2*)(X + (size_t)t * 1024 + 256 * j + 4 * lane); v[j] = (f32x4){bf_lo(w.x), bf_hi(w.x), bf_lo(w.y), bf_hi(w.y)}; } }
        if (combine) { f32x4 y[4];
#pragma unroll
            for (int j = 0; j < 4; ++j) y[j] = (f32x4){0.f, 0.f, 0.f, 0.f};
#pragma unroll
            for (int k = 0; k < 4; ++k) { const int p = pos[t * 4 + k]; const float gk = topg[t * 4 + k];
#pragma unroll
                for (int j = 0; j < 4; ++j) { const u32x2 w = *(const u32x2*)(Y2 + (size_t)p * 1024 + 256 * j + 4 * lane);
                    y[j][0] += gk * bf_lo(w.x); y[j][1] += gk * bf_hi(w.x); y[j][2] += gk * bf_lo(w.y); y[j][3] += gk * bf_hi(w.y); } }
#pragma unroll
            for (int j = 0; j < 4; ++j) { const f32x4 g2 = *(const f32x4*)(modc + b * 6144 + 5120 + 256 * j + 4 * lane); v[j] = v[j] + g2 * y[j]; } }
        if (out) {
#pragma unroll
            for (int j = 0; j < 4; ++j) *(f32x4*)(out + (size_t)t * 1024 + 256 * j + 4 * lane) = v[j]; }
        else {
#pragma unroll
            for (int j = 0; j < 4; ++j) { u32x2 w; w.x = cvt_pk_bf16(v[j][0], v[j][1]); w.y = cvt_pk_bf16(v[j][2], v[j][3]); *(u32x2*)(Xo + (size_t)t * 1024 + 256 * j + 4 * lane) = w; } }
        if (do_norm) { float ss = 0.f;
#pragma unroll
            for (int j = 0; j < 4; ++j) ss += (v[j][0] * v[j][0] + v[j][1] * v[j][1]) + (v[j][2] * v[j][2] + v[j][3] * v[j][3]);
            const float rs = rsqrtf(wsum(ss) * (1.f / 1024.f) + 1e-6f);
#pragma unroll
            for (int j = 0; j < 4; ++j) { const int col = 256 * j + 4 * lane; const f32x4 gn = *(const f32x4*)(gain + col), sc = *(const f32x4*)(modl + b * 6144 + scoff + col), sh = *(const f32x4*)(modl + b * 6144 + shoff + col);
                const f32x4 h = v[j] * rs * gn * (1.f + sc) + sh;
                if (f8) *(unsigned*)((unsigned char*)HN + (size_t)t * 1024 + col) = pk4_fp8(h[0], h[1], h[2], h[3]);
                else { u32x2 w; w.x = cvt_pk_bf16(h[0], h[1]); w.y = cvt_pk_bf16(h[2], h[3]); *(u32x2*)(HN + (size_t)t * 1024 + col) = w; } } }
    }
}

__device__ __forceinline__ void unpack8(const u32x4 w, float (&f)[8]) { f[0] = bf_lo(w.x); f[1] = bf_hi(w.x); f[2] = bf_lo(w.y); f[3] = bf_hi(w.y); f[4] = bf_lo(w.z); f[5] = bf_hi(w.z); f[6] = bf_lo(w.w); f[7] = bf_hi(w.w); }
__device__ __forceinline__ u32x4 pack8(const float (&f)[8]) { u32x4 w; w.x = cvt_pk_bf16(f[0], f[1]); w.y = cvt_pk_bf16(f[2], f[3]); w.z = cvt_pk_bf16(f[4], f[5]); w.w = cvt_pk_bf16(f[6], f[7]); return w; }

constexpr float LOG2E = 1.4426950408889634f;
__device__ __forceinline__ void phase_postproj(const Ctx& C, const float* qg, const float* kg, const float* qag, const float* kvag, const float* mkg) {
    bf16_t* PROJ = (bf16_t*)(C.ws + O_PROJ); const float* cs = (const float*)(C.ws + O_CS); const int lane = C.lane;
    for (int t = C.gw; t < T_; t += C.NGW) { bf16_t* row = PROJ + (size_t)t * 2048;
#pragma unroll
        for (int ps = 0; ps < 2; ++ps) { bf16_t* p = row + ps * 512 + 8 * lane; float f[8]; unpack8(*(const u32x4*)p, f); float ss = 0.f;
#pragma unroll
            for (int i = 0; i < 8; ++i) ss += f[i] * f[i];
            ss += shx<1>(ss); ss += shx<2>(ss); ss += shx<4>(ss);
            const float rs = rsqrtf(ss * (1.f / 64.f) + 1e-6f) * (ps == 0 ? 0.125f * LOG2E : 1.f); const float* g = (ps == 0 ? qg : kg) + 8 * (lane & 7);
#pragma unroll
            for (int i = 0; i < 8; ++i) f[i] = f[i] * rs * g[i];
            *(u32x4*)p = pack8(f); }
        { bf16_t* p = row + 1536 + 8 * lane; float f[8]; unpack8(*(const u32x4*)p, f); float ss = 0.f;
#pragma unroll
            for (int i = 0; i < 8; ++i) ss += f[i] * f[i];
            ss += shx<1>(ss); ss += shx<2>(ss);
            { const float o4 = shx<4>(ss); if (lane < 48) ss += o4; } { const float o8 = shx<8>(ss); if (lane < 48) ss += o8; } { const float o16 = shx<16>(ss); if (lane < 32) ss += o16; }
            const float nrm = lane < 32 ? 256.f : (lane < 48 ? 128.f : 32.f);
            const float rs = rsqrtf(ss / nrm + 1e-6f);
            const float* g = lane < 32 ? (qag + 8 * lane) : (lane < 48 ? (kvag + 8 * (lane - 32)) : (mkg + 64 + 8 * ((lane - 48) & 3)));
#pragma unroll
            for (int i = 0; i < 8; ++i) f[i] = f[i] * rs * g[i];
            float o[8];
#pragma unroll
            for (int i = 0; i < 8; ++i) { const float other = shx<2>(f[i]); const int fi = ((lane & 1) << 3) + i; const float cv = cs[t * 32 + fi], sv = cs[t * 32 + 16 + fi];
                o[i] = (lane & 2) ? (other * sv + f[i] * cv) : (f[i] * cv - other * sv); }
            if (lane >= 48 && lane < 52) {
#pragma unroll
                for (int i = 0; i < 8; ++i) f[i] = o[i]; }
            if (lane < 52) *(u32x4*)p = pack8(f); }
    }
}
__device__ __forceinline__ void phase_postq(const Ctx& C, const float* mqg, const float* mkg) {
    bf16_t* Q2 = (bf16_t*)(C.ws + O_Q2); bf16_t* KV2 = (bf16_t*)(C.ws + O_KV2); const float* cs = (const float*)(C.ws + O_CS); const int lane = C.lane;
    const float qscale = 0.10206207261596575f * LOG2E;
    for (int t = C.gw; t < T_; t += C.NGW) {
        { bf16_t* p = Q2 + (size_t)t * 768 + (lane >> 3) * 96 + 8 * (lane & 7); float f[8]; unpack8(*(const u32x4*)p, f); float ss = 0.f;
#pragma unroll
            for (int i = 0; i < 8; ++i) ss += f[i] * f[i];
            ss += shx<1>(ss); ss += shx<2>(ss); ss += shx<4>(ss);
            const float rs = rsqrtf(ss * (1.f / 64.f) + 1e-6f) * qscale; const float* g = mqg + 8 * (lane & 7);
#pragma unroll
            for (int i = 0; i < 8; ++i) f[i] = f[i] * rs * g[i];
            *(u32x4*)p = pack8(f); }
        { const int l2 = lane & 31; bf16_t* p = Q2 + (size_t)t * 768 + (l2 >> 2) * 96 + 64 + 8 * (l2 & 3); float f[8]; unpack8(*(const u32x4*)p, f); float ss = 0.f;
#pragma unroll
            for (int i = 0; i < 8; ++i) ss += f[i] * f[i];
            ss += shx<1>(ss); ss += shx<2>(ss);
            const float rs = rsqrtf(ss * (1.f / 32.f) + 1e-6f) * qscale; const float* g = mqg + 64 + 8 * (l2 & 3);
#pragma unroll
            for (int i = 0; i < 8; ++i) f[i] = f[i] * rs * g[i];
            float o[8];
#pragma unroll
            for (int i = 0; i < 8; ++i) { const float other = shx<2>(f[i]); const int fi = ((lane & 1) << 3) + i; const float cv = cs[t * 32 + fi], sv = cs[t * 32 + 16 + fi];
                o[i] = (lane & 2) ? (other * sv + f[i] * cv) : (f[i] * cv - other * sv); }
            if (lane < 32) *(u32x4*)p = pack8(o); }
        { bf16_t* p = KV2 + (size_t)t * 1024 + (lane >> 3) * 128 + 8 * (lane & 7); float f[8]; unpack8(*(const u32x4*)p, f); float ss = 0.f;
#pragma unroll
            for (int i = 0; i < 8; ++i) ss += f[i] * f[i];
            ss += shx<1>(ss); ss += shx<2>(ss); ss += shx<4>(ss);
            const float rs = rsqrtf(ss * (1.f / 64.f) + 1e-6f); const float* g = mkg + 8 * (lane & 7);
#pragma unroll
            for (int i = 0; i < 8; ++i) f[i] = f[i] * rs * g[i];
            *(u32x4*)p = pack8(f); }
    }
}
__device__ __forceinline__ void phase_mixcombine(const Ctx& C) {
    const bf16_t* OA = (const bf16_t*)(C.ws + O_OA); const float* LSE = (const float*)(C.ws + O_LSE); bf16_t* ATT = (bf16_t*)(C.ws + O_ATT); const int lane = C.lane;
    for (int t = C.gw; t < T_; t += C.NGW) { const int h = lane >> 3;
        float ls[3], mx = -INFINITY;
#pragma unroll
        for (int p = 0; p < 3; ++p) { ls[p] = LSE[((size_t)p * T_ + t) * 8 + h]; mx = fmaxf(mx, ls[p]); }
        float w[3], den = 0.f;
#pragma unroll
        for (int p = 0; p < 3; ++p) { w[p] = fexp2(ls[p] - mx); den += w[p]; }
        const float inv = 1.f / den; float o[8];
#pragma unroll
        for (int i = 0; i < 8; ++i) o[i] = 0.f;
#pragma unroll
        for (int p = 0; p < 3; ++p) { float f[8]; unpack8(*(const u32x4*)(OA + ((size_t)p * T_ + t) * 512 + 8 * lane), f); const float wp = w[p] * inv;
#pragma unroll
            for (int i = 0; i < 8; ++i) o[i] += wp * f[i]; }
        *(u32x4*)(ATT + (size_t)t * 1024 + 8 * lane) = pack8(o); }
}
__device__ __forceinline__ void phase_rgate(const Ctx& C, int j, const float* cw, const float* cb, const float* ba, const float* bx) {
    const bf16_t* PROJ = (const bf16_t*)(C.ws + O_PROJ); const bf16_t* RG = (const bf16_t*)(C.ws + O_RGATE + (size_t)j * SZ_RGATE); const float* spvg = (const float*)(C.ws + O_SPV) + j * 1024;
    bf16_t* LA = (bf16_t*)(C.ws + O_AA); bf16_t* Bb = (bf16_t*)(C.ws + O_BB); float* SP = (float*)(C.ws + O_SUMP); float* SH = (float*)(C.ws + O_SUMH);
    constexpr int WROW = 272;
    LAS unsigned char* Wl = C.lds;
    LAS unsigned char* Xl = C.lds + 256 * WROW;
    LAS unsigned char* Al = Xl + 64 * WROW;
    LAS unsigned char* Bl = Al + 64 * WROW;
    const int tid = C.tid, lane = C.lane, w = C.wave;
    if (C.G % 8 != 0) return;
    const int n = C.bid & 7, g = C.bid >> 3, ng = C.G >> 3;
    for (int i = tid; i < 256 * 16; i += 512) { const int r = i >> 4, c = i & 15; *(LAS u32x4*)(Wl + r * WROW + 16 * c) = *(const u32x4*)(RG + ((size_t)n * 256 + r) * 128 + 8 * c); }
    const int crow = tid >> 3, cg = tid & 7, cch = n * 128 + 16 * cg;
    float cwv[4][16], cbv[16];
#pragma unroll
    for (int q = 0; q < 4; ++q) { const f32x4 b4 = *(const f32x4*)(cb + cch + 4 * q); cbv[4 * q] = b4[0]; cbv[4 * q + 1] = b4[1]; cbv[4 * q + 2] = b4[2]; cbv[4 * q + 3] = b4[3];
#pragma unroll
        for (int k = 0; k < 4; ++k) { const f32x4 w4 = *(const f32x4*)(cw + k * 1024 + cch + 4 * q); cwv[k][4 * q] = w4[0]; cwv[k][4 * q + 1] = w4[1]; cwv[k][4 * q + 2] = w4[2]; cwv[k][4 * q + 3] = w4[3]; } }
    const int mt = w & 3, h = w >> 2, l15 = lane & 15, kg = lane >> 4;
    float bav[4], bxv[4], spv[4];
#pragma unroll
    for (int jj = 0; jj < 4; ++jj) { const int ch = n * 128 + 16 * (4 * h + jj) + l15; bav[jj] = ba[ch]; bxv[jj] = bx[ch]; spv[jj] = spvg[ch]; }
    __syncthreads();
    for (int c = g; c < 256; c += ng) { const size_t row0 = (size_t)c * 64; const int ts0 = (int)(row0 % S_);
        { float acc[16];
#pragma unroll
          for (int i = 0; i < 16; ++i) acc[i] = cbv[i];
#pragma unroll
          for (int k = 0; k < 4; ++k) { const int dt = k - 3; if (ts0 + crow + dt >= 0) { const bf16_t* src = PROJ + (row0 + crow + dt) * 2048 + 1024 + cch; float f0[8], f1[8]; unpack8(*(const u32x4*)src, f0); unpack8(*(const u32x4*)(src + 8), f1);
#pragma unroll
                  for (int i = 0; i < 8; ++i) { acc[i] += cwv[k][i] * f0[i]; acc[8 + i] += cwv[k][8 + i] * f1[i]; } } }
          float lo[8], hi8[8];
#pragma unroll
          for (int i = 0; i < 8; ++i) { lo[i] = acc[i]; hi8[i] = acc[8 + i]; }
          *(LAS u32x4*)(Xl + crow * WROW + 32 * cg) = pack8(lo); *(LAS u32x4*)(Xl + crow * WROW + 32 * cg + 16) = pack8(hi8); }
        __syncthreads();
        f32x4 acc[8];
#pragma unroll
        for (int t = 0; t < 8; ++t) acc[t] = (f32x4){0.f, 0.f, 0.f, 0.f};
#pragma unroll
        for (int ks = 0; ks < 4; ++ks) { const bf16x8 af = *(const LAS bf16x8*)(Xl + (16 * mt + l15) * WROW + 64 * ks + 16 * kg);
#pragma unroll
            for (int t = 0; t < 8; ++t) { const int nt = (t < 4) ? (4 * h + t) : (8 + 4 * h + (t - 4)); const bf16x8 bfr = *(const LAS bf16x8*)(Wl + (16 * nt + l15) * WROW + 64 * ks + 16 * kg);
                acc[t] = __builtin_amdgcn_mfma_f32_16x16x32_bf16(af, bfr, acc[t], 0, 0, 0); } }
#pragma unroll
        for (int jj = 0; jj < 4; ++jj) { const int e = 16 * (4 * h + jj) + l15;
#pragma unroll
            for (int r = 0; r < 4; ++r) { const int row = 16 * mt + 4 * kg + r; const float xc = bf_lo((unsigned)*(const LAS unsigned short*)(Xl + row * WROW + 2 * e));
                const float rr = fsigmoid(acc[jj][r] + bav[jj]), ig = fsigmoid(acc[4 + jj][r] + bxv[jj]); const float la = rr * spv[jj], av = fexp2(la);
                const float bv = __builtin_amdgcn_sqrtf(fmaxf(1.f - av * av, 0.f)) * ig * xc;
                *(LAS unsigned short*)(Al + row * WROW + 2 * e) = (unsigned short)(cvt_pk_bf16(la, la) & 0xffffu); *(LAS unsigned short*)(Bl + row * WROW + 2 * e) = (unsigned short)(cvt_pk_bf16(bv, bv) & 0xffffu); } }
        __syncthreads();
        { const size_t go = (row0 + crow) * 1024 + cch;
          *(u32x4*)(LA + go) = *(const LAS u32x4*)(Al + crow * WROW + 32 * cg); *(u32x4*)(LA + go + 8) = *(const LAS u32x4*)(Al + crow * WROW + 32 * cg + 16);
          *(u32x4*)(Bb + go) = *(const LAS u32x4*)(Bl + crow * WROW + 32 * cg); *(u32x4*)(Bb + go + 8) = *(const LAS u32x4*)(Bl + crow * WROW + 32 * cg + 16); }
        if (tid < 128) { float Pl = 0.f, Hh = 0.f;
#pragma unroll 8
            for (int r = 0; r < 64; ++r) { const float la = bf_lo((unsigned)*(const LAS unsigned short*)(Al + r * WROW + 2 * tid)), bv = bf_lo((unsigned)*(const LAS unsigned short*)(Bl + r * WROW + 2 * tid)); Hh = fexp2(la) * Hh + bv; Pl += la; }
            const int b = (int)(row0 / S_), ck = (int)((row0 % S_) >> 6); SP[((size_t)b * 64 + ck) * 1024 + n * 128 + tid] = fexp2(Pl); SH[((size_t)b * 64 + ck) * 1024 + n * 128 + tid] = Hh; }
        __syncthreads();
    }
}

__device__ __forceinline__ void scan_sum_item(const Ctx& C, int b, int ck, int cg) {
    const bf16_t* LA = (const bf16_t*)(C.ws + O_AA); const bf16_t* Bb = (const bf16_t*)(C.ws + O_BB); float* SP = (float*)(C.ws + O_SUMP); float* SH = (float*)(C.ws + O_SUMH);
    const int ch = cg * 128 + 2 * C.lane;
    size_t off = ((size_t)b * S_ + ck * 64) * 1024 + ch; f32x2 Pl = (f32x2){0.f, 0.f}, Hh = (f32x2){0.f, 0.f};
#pragma unroll 8
    for (int s = 0; s < 64; ++s, off += 1024) { const unsigned lw = *(const unsigned*)(LA + off), bw = *(const unsigned*)(Bb + off);
        const f32x2 lv = (f32x2){bf_lo(lw), bf_hi(lw)}, av = (f32x2){fexp2(lv[0]), fexp2(lv[1])}, bv = (f32x2){bf_lo(bw), bf_hi(bw)}; Hh = av * Hh + bv; Pl = Pl + lv; }
    *(f32x2*)(SP + ((size_t)b * 64 + ck) * 1024 + ch) = (f32x2){fexp2(Pl[0]), fexp2(Pl[1])}; *(f32x2*)(SH + ((size_t)b * 64 + ck) * 1024 + ch) = Hh;
}
__device__ __forceinline__ void phase_scan_sum_own(const Ctx& C) {
    asm volatile("s_waitcnt vmcnt(0)" ::: "memory"); __syncthreads();
    for (int i = 0; ; ++i) { const int L = i * C.G + C.bid; if (L >= 512) break; const int pm = L >> 3, n = L & 7;
        if (C.wave < 4) { const int row0 = pm * 256 + C.wave * 64; scan_sum_item(C, row0 / S_, (row0 % S_) >> 6, n); } }
}
__device__ __forceinline__ void phase_scan_apply(const Ctx& C) {
    const bf16_t* LA = (const bf16_t*)(C.ws + O_AA); const bf16_t* Bb = (const bf16_t*)(C.ws + O_BB); const float* SP = (const float*)(C.ws + O_SUMP); const float* SH = (const float*)(C.ws + O_SUMH);
    const bf16_t* PROJ = (const bf16_t*)(C.ws + O_PROJ); bf16_t* ATT = (bf16_t*)(C.ws + O_ATT); const int lane = C.lane;
    for (int it = C.gw; it < 4 * 64 * 8; it += C.NGW) { const int cg = it & 7, ck = (it >> 3) & 63, b = it >> 9; const int ch = cg * 128 + 2 * lane;
        f32x2 h = (f32x2){0.f, 0.f};
#pragma unroll 8
        for (int c2 = 0; c2 < ck; ++c2) { const f32x2 pv = *(const f32x2*)(SP + ((size_t)b * 64 + c2) * 1024 + ch), hv = *(const f32x2*)(SH + ((size_t)b * 64 + c2) * 1024 + ch); h = pv * h + hv; }
        size_t row = (size_t)b * S_ + ck * 64;
#pragma unroll 8
        for (int s = 0; s < 64; ++s, ++row) { const unsigned lw = *(const unsigned*)(LA + row * 1024 + ch), bw = *(const unsigned*)(Bb + row * 1024 + ch);
            const f32x2 av = (f32x2){fexp2(bf_lo(lw)), fexp2(bf_hi(lw))}, bv = (f32x2){bf_lo(bw), bf_hi(bw)}; h = av * h + bv;
            const unsigned gw2 = *(const unsigned*)(PROJ + row * 2048 + ch);
            *(unsigned*)(ATT + row * 1024 + ch) = cvt_pk_bf16(bf_lo(gw2) * h[0], bf_hi(gw2) * h[1]); } }
}

__device__ __forceinline__ void split_bf16(const f32x4 a, const f32x4 b, bf16x8& hi, bf16x8& lo) {
    u32x4 h; h.x = cvt_pk_bf16(a[0], a[1]); h.y = cvt_pk_bf16(a[2], a[3]); h.z = cvt_pk_bf16(b[0], b[1]); h.w = cvt_pk_bf16(b[2], b[3]);
    u32x4 l; l.x = cvt_pk_bf16(a[0] - bf_lo(h.x), a[1] - bf_hi(h.x)); l.y = cvt_pk_bf16(a[2] - bf_lo(h.y), a[3] - bf_hi(h.y)); l.z = cvt_pk_bf16(b[0] - bf_lo(h.z), b[1] - bf_hi(h.z)); l.w = cvt_pk_bf16(b[2] - bf_lo(h.w), b[3] - bf_hi(h.w));
    hi = __builtin_bit_cast(bf16x8, h); lo = __builtin_bit_cast(bf16x8, l);
}
__device__ __forceinline__ void phase_router(const Ctx& C, const bf16_t* X, const float* gain, const float* modl, const float* wr, const float* br, int layer) {
    unsigned char* HN8 = C.ws + O_HN; int* topi = (int*)(C.ws + O_TOPI); float* topg = (float*)(C.ws + O_TOPG); int* ecnt = (int*)(C.ws + O_ECNT) + layer * 32; int* inv = (int*)(C.ws + O_INV); int* posj = (int*)(C.ws + O_POSJ);
    LAS int* rk = (LAS int*)(C.lds + LX_MISC + 3072); LAS int* base = (LAS int*)(C.lds + LX_MISC + 512);
    constexpr int HROW = 1028;
    LAS float* hrow = (LAS float*)C.lds;
    LAS float* part = (LAS float*)(C.lds + 16 * HROW * 4);
    LAS int* hl = (LAS int*)(C.lds + LX_MISC);
    const int lane = C.lane, e = lane & 31, kh = lane >> 5, v = C.wave, l15 = lane & 15, kg = lane >> 4;
    bf16x8 whi[2][4], wlo[2][4];
#pragma unroll
    for (int nt = 0; nt < 2; ++nt)
#pragma unroll
        for (int ks = 0; ks < 4; ++ks) { const float* p = wr + (size_t)(128 * v + 32 * ks + 8 * kg) * 32 + 16 * nt + l15;
            const f32x4 a = (f32x4){p[0], p[32], p[64], p[96]}, b = (f32x4){p[128], p[160], p[192], p[224]}; split_bf16(a, b, whi[nt][ks], wlo[nt][ks]); }
    const float bias_e = br[e];
    if (C.tid < 32) hl[C.tid] = 0;
    __syncthreads();
    for (int ck = C.bid; ck < 256; ck += C.G) {
        const int b = (ck * 64) / S_;
        f32x4 gn[4], shv[4];
#pragma unroll
        for (int j = 0; j < 4; ++j) { const int col = 256 * j + 4 * lane; gn[j] = *(const f32x4*)(gain + col) * (1.f + *(const f32x4*)(modl + b * 6144 + 4096 + col)); shv[j] = *(const f32x4*)(modl + b * 6144 + 3072 + col); }
        u32x2 xr[2][4];
#pragma unroll
        for (int q = 0; q < 2; ++q)
#pragma unroll
            for (int j = 0; j < 4; ++j) xr[q][j] = *(const u32x2*)(X + (size_t)(ck * 64 + 2 * v + q) * 1024 + 256 * j + 4 * lane);
#pragma unroll 1
        for (int pass = 0; pass < 4; ++pass) { const int tb = ck * 64 + pass * 16;
#pragma unroll
            for (int q = 0; q < 2; ++q) { const int tt = 2 * v + q, t = tb + tt; f32x4 h[4]; float ss = 0.f;
#pragma unroll
                for (int j = 0; j < 4; ++j) { const u32x2 xw = xr[q][j]; h[j] = (f32x4){bf_lo(xw.x), bf_hi(xw.x), bf_lo(xw.y), bf_hi(xw.y)}; ss += (h[j][0] * h[j][0] + h[j][1] * h[j][1]) + (h[j][2] * h[j][2] + h[j][3] * h[j][3]); }
                const float rs = rsqrtf(wsum(ss) * (1.f / 1024.f) + 1e-6f);
#pragma unroll
                for (int j = 0; j < 4; ++j) { const int col = 256 * j + 4 * lane;
                    const f32x4 hv = h[j] * rs * gn[j] + shv[j];
                    *(unsigned*)(HN8 + (size_t)t * 1024 + col) = pk4_fp8(hv[0], hv[1], hv[2], hv[3]);
                    *(LAS f32x4*)(hrow + tt * HROW + col) = hv; } }
            if (pass < 3) {
#pragma unroll
                for (int q = 0; q < 2; ++q)
#pragma unroll
                    for (int j = 0; j < 4; ++j) xr[q][j] = *(const u32x2*)(X + (size_t)(tb + 16 + 2 * v + q) * 1024 + 256 * j + 4 * lane); }
            __syncthreads();
            { f32x4 acc0 = (f32x4){0.f, 0.f, 0.f, 0.f}, acc1 = acc0;
#pragma unroll
              for (int ks = 0; ks < 4; ++ks) { const LAS float* hp = hrow + l15 * HROW + 128 * v + 32 * ks + 8 * kg; bf16x8 ahi, alo; split_bf16(*(const LAS f32x4*)hp, *(const LAS f32x4*)(hp + 4), ahi, alo);
                  acc0 = __builtin_amdgcn_mfma_f32_16x16x32_bf16(ahi, whi[0][ks], acc0, 0, 0, 0); acc1 = __builtin_amdgcn_mfma_f32_16x16x32_bf16(ahi, whi[1][ks], acc1, 0, 0, 0);
                  acc0 = __builtin_amdgcn_mfma_f32_16x16x32_bf16(ahi, wlo[0][ks], acc0, 0, 0, 0); acc1 = __builtin_amdgcn_mfma_f32_16x16x32_bf16(ahi, wlo[1][ks], acc1, 0, 0, 0);
                  acc0 = __builtin_amdgcn_mfma_f32_16x16x32_bf16(alo, whi[0][ks], acc0, 0, 0, 0); acc1 = __builtin_amdgcn_mfma_f32_16x16x32_bf16(alo, whi[1][ks], acc1, 0, 0, 0); }
#pragma unroll
              for (int r = 0; r < 4; ++r) { part[((4 * kg + r) * 8 + v) * 32 + l15] = acc0[r]; part[((4 * kg + r) * 8 + v) * 32 + 16 + l15] = acc1[r]; } }
            __syncthreads();
            { const int tt = 2 * v + kh; float lg = bias_e;
#pragma unroll
              for (int w8 = 0; w8 < 8; ++w8) lg += part[(tt * 8 + w8) * 32 + e];
              int idx[4]; float val[4];
#pragma unroll
              for (int k = 0; k < 4; ++k) { float mx = lg;
                  mx = fmaxf(mx, shx<1>(mx)); mx = fmaxf(mx, shx<2>(mx)); mx = fmaxf(mx, shx<4>(mx)); mx = fmaxf(mx, shx<8>(mx)); mx = fmaxf(mx, shx<16>(mx));
                  const unsigned long long bal = __ballot(lg == mx); const unsigned bh = (unsigned)(bal >> (32 * kh)); const int sel = __ffs((int)bh) - 1;
                  idx[k] = sel; val[k] = mx; if (e == sel) lg = -INFINITY; }
              if (e == 0) { const int t = tb + tt; float ex[4], den = 0.f;
#pragma unroll
                  for (int k = 0; k < 4; ++k) { ex[k] = expf(val[k] - val[0]); den += ex[k]; }
#pragma unroll
                  for (int k = 0; k < 4; ++k) { topi[t * 4 + k] = idx[k]; topg[t * 4 + k] = ex[k] / den; const int r = __hip_atomic_fetch_add(hl + idx[k], 1, __ATOMIC_RELAXED, __HIP_MEMORY_SCOPE_WORKGROUP); rk[(pass * 16 + tt) * 4 + k] = (idx[k] << 8) | r; } } }
        }
        __syncthreads();
        if (C.tid < 32) { base[C.tid] = __hip_atomic_fetch_add(ecnt + C.tid, hl[C.tid], __ATOMIC_RELAXED, __HIP_MEMORY_SCOPE_AGENT); hl[C.tid] = 0; }
        __syncthreads();
        if (C.tid < 256) { const int pk = rk[C.tid], ex = pk >> 8, j = base[ex] + (pk & 255); inv[ex * 16384 + j] = ck * 64 + (C.tid >> 2); posj[ck * 256 + C.tid] = j; }
        __syncthreads();
    }
}
__device__ __forceinline__ void moe_plan_lds(const Ctx& C, int layer) {
    const int* ecnt = (const int*)(C.ws + O_ECNT) + layer * 32;
    LAS int* tot = (LAS int*)(C.lds + LX_MISC + 256); LAS int* pst = tot + 32; LAS int* tile_e = (LAS int*)(C.lds + LX_TILE); LAS int* ntp = (LAS int*)(C.lds + LX_MISC + 128);
    __syncthreads();
    if (C.tid < 32) tot[C.tid] = __hip_atomic_load(ecnt + C.tid, __ATOMIC_RELAXED, __HIP_MEMORY_SCOPE_AGENT);
    __syncthreads();
    { const int e = C.tid & 31, sub = C.tid >> 5; int acc = 0;
#pragma unroll
      for (int x = 0; x < 32; x += 4) { const LAS int* tp = tot + x; const int t0 = tp[0], t1 = tp[1], t2 = tp[2], t3 = tp[3];
          acc += (x < e ? ((t0 + 255) & ~255) : 0) + (x + 1 < e ? ((t1 + 255) & ~255) : 0) + (x + 2 < e ? ((t2 + 255) & ~255) : 0) + (x + 3 < e ? ((t3 + 255) & ~255) : 0); }
      const int mine = (tot[e] + 255) >> 8, first = acc >> 8;
      if (sub == 0) { pst[e] = acc; if (e == 31) ntp[0] = first + mine; }
      for (int i = sub; i < mine; i += 16) tile_e[first + i] = e; }
    __syncthreads();
}
#ifndef ATT_DUP
#define ATT_DUP 1
#endif

__device__ __forceinline__ s16x4 tr16(LAS const unsigned char* p) { typedef short v4i16_t __attribute__((ext_vector_type(4))); return __builtin_bit_cast(s16x4, __builtin_amdgcn_ds_read_tr16_b64_v4i16((LAS v4i16_t*)p)); }

__device__ __forceinline__ float max3f(float a, float b, float c) { return fmaxf(fmaxf(a, b), c); }
#ifndef ATT_THR_V
#define ATT_THR_V 10.f
#endif
constexpr float ATT_THR = ATT_THR_V;
template <int KS, bool DIL>
__device__ __forceinline__ void att_tile(LAS const unsigned char* kb, LAS const unsigned char* vb, const bf16x8 (&qf)[KS], f32x16& o0, f32x16& o1, f32x16& negm, float& mref, float& l, int kidx0, int qidx, bool need_mask, int lane) {
    constexpr int KROW = KS * 32 + 16, VROW = 144;
    const int i32 = lane & 31, hi = lane >> 5;
    const int pr = (i32 & 0x13) | ((i32 & 4) << 1) | ((i32 & 8) >> 1);
    f32x16 p0, p1;
    LAS const unsigned char* kp = kb + pr * KROW + hi * 16;
#ifndef QK_DUP
#define QK_DUP 1
#endif
#pragma unroll 1
    for (int qd_ = 0; qd_ < QK_DUP; ++qd_) {
#pragma unroll
    for (int ks = 0; ks < KS; ++ks) {
        const bf16x8 k0f = *(LAS const bf16x8*)(kp + ks * 32), k1f = *(LAS const bf16x8*)(kp + 32 * KROW + ks * 32);
        if (ks == 0) { p0 = __builtin_amdgcn_mfma_f32_32x32x16_bf16(k0f, qf[0], negm, 0, 0, 0); p1 = __builtin_amdgcn_mfma_f32_32x32x16_bf16(k1f, qf[0], negm, 0, 0, 0); }
        else { p0 = __builtin_amdgcn_mfma_f32_32x32x16_bf16(k0f, qf[ks], p0, 0, 0, 0); p1 = __builtin_amdgcn_mfma_f32_32x32x16_bf16(k1f, qf[ks], p1, 0, 0, 0); }
    }
    asm volatile("" : "+v"(p0), "+v"(p1));
    }
    if (need_mask) {
#pragma unroll
        for (int r = 0; r < 16; ++r) { const int d0 = qidx - (kidx0 + 16 * (r >> 3) + 8 * hi + (r & 7)), d1 = d0 - 32;
            const bool v0 = DIL ? (d0 >= 0 && d0 <= 128) : (d0 >= 0), v1 = DIL ? (d1 >= 0 && d1 <= 128) : (d1 >= 0);
            p0[r] = v0 ? p0[r] : -INFINITY; p1[r] = v1 ? p1[r] : -INFINITY; } }
    float mx = max3f(p0[0], p0[1], p1[0]), mb = max3f(p0[2], p0[3], p1[1]); mx = max3f(mx, p1[2], p1[3]);
#pragma unroll
    for (int r = 4; r < 16; r += 4) { mx = max3f(mx, p0[r], p0[r + 1]); mb = max3f(mb, p0[r + 2], p0[r + 3]); mx = max3f(mx, p1[r], p1[r + 1]); mb = max3f(mb, p1[r + 2], p1[r + 3]); }
    mx = xmax32(fmaxf(mx, mb));
    if (__builtin_expect(__any(mx > ATT_THR), 0)) {
        const float dl = fmaxf(mx, 0.f), f = fexp2(-dl);
        mref += dl; l *= f;
#pragma unroll
        for (int r = 0; r < 16; ++r) { o0[r] *= f; o1[r] *= f; p0[r] -= dl; p1[r] -= dl; negm[r] = -mref; } }
    float ls0 = 0.f, ls1 = 0.f;
#pragma unroll
    for (int r = 0; r < 16; ++r) { p0[r] = fexp2(p0[r]); p1[r] = fexp2(p1[r]); ls0 += p0[r]; ls1 += p1[r]; }
    l += ls0 + ls1;
    u32x4 pw[2][2];
#pragma unroll
    for (int s = 0; s < 2; ++s) {
        pw[0][s].x = cvt_pk_bf16(p0[8 * s + 0], p0[8 * s + 1]); pw[0][s].y = cvt_pk_bf16(p0[8 * s + 2], p0[8 * s + 3]); pw[0][s].z = cvt_pk_bf16(p0[8 * s + 4], p0[8 * s + 5]); pw[0][s].w = cvt_pk_bf16(p0[8 * s + 6], p0[8 * s + 7]);
        pw[1][s].x = cvt_pk_bf16(p1[8 * s + 0], p1[8 * s + 1]); pw[1][s].y = cvt_pk_bf16(p1[8 * s + 2], p1[8 * s + 3]); pw[1][s].z = cvt_pk_bf16(p1[8 * s + 4], p1[8 * s + 5]); pw[1][s].w = cvt_pk_bf16(p1[8 * s + 6], p1[8 * s + 7]); }
    const int g = lane >> 4, i16 = lane & 15;
    LAS const unsigned char* vp = vb + (8 * (g >> 1) + (i16 >> 2)) * VROW + (16 * (g & 1) + 4 * (i16 & 3)) * 2;
#pragma unroll
    for (int sub = 0; sub < 2; ++sub)
#pragma unroll
        for (int s = 0; s < 2; ++s) { const bf16x8 pf = __builtin_bit_cast(bf16x8, pw[sub][s]);
#pragma unroll
            for (int db = 0; db < 2; ++db) { LAS const unsigned char* av = vp + (32 * sub + 16 * s) * VROW + 64 * db;
                const s16x4 lo = tr16(av), hh = tr16(av + 4 * VROW);
                const bf16x8 vf = (bf16x8){lo[0], lo[1], lo[2], lo[3], hh[0], hh[1], hh[2], hh[3]};
                if (db == 0) o0 = __builtin_amdgcn_mfma_f32_32x32x16_bf16(vf, pf, o0, 0, 0, 0); else o1 = __builtin_amdgcn_mfma_f32_32x32x16_bf16(vf, pf, o1, 0, 0, 0); } }
}
__device__ __forceinline__ void att_store(bf16_t* orow  , const f32x16& o0, const f32x16& o1, float inv, int hi) {
#pragma unroll
    for (int rr = 0; rr < 4; ++rr) { u32x2 w0, w1;
        w0.x = cvt_pk_bf16(o0[4 * rr] * inv, o0[4 * rr + 1] * inv); w0.y = cvt_pk_bf16(o0[4 * rr + 2] * inv, o0[4 * rr + 3] * inv);
        w1.x = cvt_pk_bf16(o1[4 * rr] * inv, o1[4 * rr + 1] * inv); w1.y = cvt_pk_bf16(o1[4 * rr + 2] * inv, o1[4 * rr + 3] * inv);
        *(u32x2*)(orow + 8 * rr + 4 * hi) = w0; *(u32x2*)(orow + 32 + 8 * rr + 4 * hi) = w1; }
}


struct BgConv {
    const float* w1; const float* w2; unsigned char* ws; LAS unsigned char* T;
    int pair, it, nit, step, sub;
    bool pendA, pendB; int psubA, psubB; unsigned char* pWTA; unsigned char* pWTB;
    f32x4 vA[4], vB[4];
};
__device__ __forceinline__ void bg_tile(const BgConv& S, int it, const float*& W, int& N, unsigned char*& WT, int& n0, int& k0) {
    constexpr int I1 = 32 * 8, I2 = 16 * 8, N1 = 64 * I1;
    if (it < N1) { const int mat = S.pair * 64 + it / I1, q = it % I1; W = S.w1 + (size_t)mat * 1024 * 2048; WT = S.ws + O_W1 + (size_t)mat * SZ_W1E; N = 2048; n0 = (q >> 3) * 64; k0 = (q & 7) * 128; }
    else { const int r = it - N1, mat = S.pair * 64 + r / I2, q = r % I2; W = S.w2 + (size_t)mat * 1024 * 1024; WT = S.ws + O_W2 + (size_t)mat * SZ_W2E; N = 1024; n0 = (q >> 3) * 64; k0 = (q & 7) * 128; }
}
__device__ __forceinline__ void bg_init(BgConv& S, const Ctx& C, const float* w1, const float* w2, int pair) {
    S.w1 = w1; S.w2 = w2; S.ws = C.ws; S.T = C.lds + 49152 + C.wave * 9216; S.pair = pair; S.it = C.gw; S.nit = 64 * 256 + 64 * 128; S.step = C.NGW; S.sub = 0;
    S.pendA = false; S.pendB = false; S.psubA = 0; S.psubB = 0; S.pWTA = C.ws; S.pWTB = C.ws;
}
__device__ __forceinline__ bool bg_done(const BgConv& S) { return !S.pendA && !S.pendB && S.it >= S.nit; }
__device__ __forceinline__ void bg_half(BgConv& S, f32x4 (&v)[4], bool& pend, int& psub, unsigned char*& pWT, int lane) {
    const int kq = lane >> 4, c4 = lane & 15;
    if (pend) {
#pragma unroll
        for (int jj = 0; jj < 4; ++jj) *(LAS unsigned*)(S.T + (4 * c4 + jj) * 144 + 32 * kq + 4 * psub) = pk4_fp8(32.f * v[0][jj], 32.f * v[1][jj], 32.f * v[2][jj], 32.f * v[3][jj]);
        if (psub == 7) {
            asm volatile("s_waitcnt lgkmcnt(0)" ::: "memory");
#pragma unroll
            for (int s8 = 0; s8 < 8; ++s8) { const int n = 8 * s8 + (lane >> 3), ch = lane & 7; const u32x4 w = *(const LAS u32x4*)(S.T + n * 144 + 16 * ch);
                *(u32x4*)(pWT + (size_t)n * 1024 + 16 * ch) = w; }
            asm volatile("s_waitcnt lgkmcnt(0)" ::: "memory"); }
        pend = false; }
    if (S.it < S.nit) { const float* W; int N, n0, k0; unsigned char* WT; bg_tile(S, S.it, W, N, WT, n0, k0);
        const float* p = W + (size_t)(k0 + 32 * kq + 4 * S.sub) * N + n0 + 4 * c4;
#pragma unroll
        for (int i = 0; i < 4; ++i) v[i] = __builtin_nontemporal_load((const f32x4*)(p + (size_t)i * N));
        pend = true; psub = S.sub; pWT = WT + (size_t)n0 * 1024 + k0;
        if (++S.sub == 8) { S.sub = 0; S.it += S.step; } }
}
#define BG_STEP_A() bg_half(BG, BG.vA, BG.pendA, BG.psubA, BG.pWTA, lane)
#define BG_STEP_B() bg_half(BG, BG.vB, BG.pendB, BG.psubB, BG.pWTB, lane)

__device__ __forceinline__ void mla_unit(const Ctx& C, BgConv& BG, int b, int h, int qb) {
    constexpr int KROW = 208, VROW = 144, KB = 64 * KROW, BUF = KB + 64 * VROW;
    const bf16_t* Q2 = (const bf16_t*)(C.ws + O_Q2); const bf16_t* KV2 = (const bf16_t*)(C.ws + O_KV2); const bf16_t* PROJ = (const bf16_t*)(C.ws + O_PROJ); bf16_t* ATT = (bf16_t*)(C.ws + O_ATT);
    const int tid = C.tid, lane = C.lane, w = C.wave, i32 = lane & 31, hi = lane >> 5;
    const int q0 = qb * 256; const size_t rowb = (size_t)b * S_;
    bf16x8 qf[6];
    { const bf16_t* qrow = Q2 + (rowb + q0 + 32 * w + i32) * 768 + 8 * hi;
#pragma unroll
      for (int ks = 0; ks < 4; ++ks) qf[ks] = *(const bf16x8*)(qrow + h * 64 + 16 * ks);
      qf[4] = *(const bf16x8*)(qrow + 512 + h * 32); qf[5] = *(const bf16x8*)(qrow + 512 + h * 32 + 16); }
    f32x16 o0, o1;
#pragma unroll
    for (int r = 0; r < 16; ++r) { o0[r] = 0.f; o1[r] = 0.f; }
    float m = 0.f, l = 0.f; f32x16 negm;
#pragma unroll
    for (int r = 0; r < 16; ++r) negm[r] = 0.f;
    const int NT = 4 * qb + 4, wmax = 4 * qb + (w >> 1);
    const int r8 = tid >> 3, c8 = tid & 7, r4 = (tid & 255) >> 2, c4 = tid & 3;
    const bf16_t* knp = KV2 + (rowb + r8) * 1024 + h * 64 + 8 * c8; const bf16_t* kpp = PROJ + (rowb + r4) * 2048 + 1920 + 8 * c4;
    u32x4 kA, vA, pA, kB, vB, pB;
#define MLA_LOAD(j, K, V, P) do { const int jc_ = ((j) < NT) ? (j) : NT - 1; K = *(const u32x4*)(knp + (size_t)jc_ * 64 * 1024); V = *(const u32x4*)(knp + (size_t)jc_ * 64 * 1024 + 512); P = *(const u32x4*)(kpp + (size_t)jc_ * 64 * 2048); } while (0)
#define MLA_WRITE(bo, K, V, P) do { *(LAS u32x4*)(C.lds + (bo) + r8 * KROW + 16 * c8) = K; *(LAS u32x4*)(C.lds + (bo) + KB + r8 * VROW + 16 * c8) = V; *(LAS u32x4*)(C.lds + (bo) + r4 * KROW + 128 + 16 * c4) = P; } while (0)
#define MLA_STEP(j, KF, VF, PF, KN, VN, PN, BGS) do { const int j_ = (j); const int bo_ = (j_ & 1) * BUF; \
        MLA_LOAD(j_ + 2, KF, VF, PF); BGS(); \
        if (j_ <= wmax) { _Pragma("unroll 1") for (int dup_ = 0; dup_ < ATT_DUP; ++dup_) att_tile<6, false>(C.lds + bo_, C.lds + bo_ + KB, qf, o0, o1, negm, m, l, 64 * j_, q0 + 32 * w + i32, j_ == wmax, lane); } \
        MLA_WRITE(BUF - bo_, KN, VN, PN); \
        __syncthreads(); } while (0)
    MLA_LOAD(0, kA, vA, pA); MLA_LOAD(1, kB, vB, pB);
    MLA_WRITE(0, kA, vA, pA);
    __syncthreads();
#pragma unroll 1
    for (int j = 0; j < NT; j += 2) { MLA_STEP(j, kA, vA, pA, kB, vB, pB, BG_STEP_A); MLA_STEP(j + 1, kB, vB, pB, kA, vA, pA, BG_STEP_B); }
#undef MLA_STEP
#undef MLA_LOAD
#undef MLA_WRITE
    l = xadd32(l);
    att_store(ATT + (rowb + q0 + 32 * w + i32) * 1024 + 512 + h * 64, o0, o1, 1.f / l, hi);
}
__device__ __forceinline__ void dil_unit(const Ctx& C, BgConv& BG, int p, int dd, int b, int h, int res, int n) {
    constexpr int KROW = 144, VROW = 144, KB = 64 * KROW, BUF = KB + 64 * VROW;
    const bf16_t* PROJ = (const bf16_t*)(C.ws + O_PROJ); bf16_t* OA = (bf16_t*)(C.ws + O_OA) + (size_t)p * T_ * 512; float* LSE = (float*)(C.ws + O_LSE) + (size_t)p * T_ * 8;
    const int tid = C.tid, lane = C.lane, w = C.wave, i32 = lane & 31, hi = lane >> 5;
    const size_t rowb = (size_t)b * S_;
    const int qsub = 256 * n + 32 * w + i32; const size_t qtok = rowb + (size_t)qsub * dd + res;
    bf16x8 qf[4];
    { const bf16_t* qrow = PROJ + qtok * 2048 + h * 64 + 8 * hi;
#pragma unroll
      for (int ks = 0; ks < 4; ++ks) qf[ks] = *(const bf16x8*)(qrow + 16 * ks); }
    f32x16 o0, o1;
#pragma unroll
    for (int r = 0; r < 16; ++r) { o0[r] = 0.f; o1[r] = 0.f; }
    float m = 0.f, l = 0.f; f32x16 negm;
#pragma unroll
    for (int r = 0; r < 16; ++r) negm[r] = 0.f;
    const int jbeg = (n == 0) ? 2 : 0, wlo = w >> 1, whi = (32 * w + 159) >> 6;
    const int r8 = tid >> 3, c8 = tid & 7;
    u32x4 kA, vA, kB, vB;
    const int cnt = 6 - jbeg;
#define DIL_LOAD(i, K, V) do { const int jc_ = jbeg + (((i) < cnt) ? (i) : cnt - 1); const size_t tok = rowb + (size_t)(256 * n - 128 + 64 * jc_ + r8) * dd + res; const bf16_t* src = PROJ + tok * 2048 + 512 + h * 64 + 8 * c8; K = *(const u32x4*)src; V = *(const u32x4*)(src + 512); } while (0)
#define DIL_WRITE(bo, K, V) do { *(LAS u32x4*)(C.lds + (bo) + r8 * KROW + 16 * c8) = K; *(LAS u32x4*)(C.lds + (bo) + KB + r8 * VROW + 16 * c8) = V; } while (0)
#define DIL_STEP(i, KF, VF, KN, VN, BGS) do { const int i_ = (i); const int bo_ = (i_ & 1) * BUF, j_ = jbeg + i_; \
        DIL_LOAD(i_ + 2, KF, VF); BGS(); \
        if (i_ < cnt && j_ >= wlo && j_ <= whi) { const int kb0_ = 256 * n - 128 + 64 * j_, qlo_ = 256 * n + 32 * w; _Pragma("unroll 1") for (int dup_ = 0; dup_ < ATT_DUP; ++dup_) att_tile<4, true>(C.lds + bo_, C.lds + bo_ + KB, qf, o0, o1, negm, m, l, kb0_, qsub, !(kb0_ + 63 <= qlo_ && qlo_ + 31 - kb0_ <= 128), lane); } \
        DIL_WRITE(BUF - bo_, KN, VN); \
        __syncthreads(); } while (0)
    DIL_LOAD(0, kA, vA); DIL_LOAD(1, kB, vB);
    DIL_WRITE(0, kA, vA);
    __syncthreads();
    DIL_STEP(0, kA, vA, kB, vB, BG_STEP_A); DIL_STEP(1, kB, vB, kA, vA, BG_STEP_B); DIL_STEP(2, kA, vA, kB, vB, BG_STEP_A); DIL_STEP(3, kB, vB, kA, vA, BG_STEP_B);
    if (cnt == 6) { DIL_STEP(4, kA, vA, kB, vB, BG_STEP_A); DIL_STEP(5, kB, vB, kA, vA, BG_STEP_B); }
#undef DIL_STEP
#undef DIL_LOAD
#undef DIL_WRITE
    l = xadd32(l);
    att_store(OA + qtok * 512 + h * 64, o0, o1, 1.f / l, hi);
    if (hi == 0) LSE[qtok * 8 + h] = m + log2f(l);
}
#ifndef REP_MLA
#define REP_MLA 1
#endif
#ifndef REP_DIL
#define REP_DIL 1
#endif
__device__ __forceinline__ void phase_attention(const Ctx& C, const float* w1, const float* w2, int pair) {
    BgConv BG; bg_init(BG, C, w1, w2, pair);
#pragma unroll 1
    for (int rep = 0; rep < REP_MLA; ++rep) {
    if (C.G == 256) { const int bh = C.vcu >> 3, s = C.vcu & 7; mla_unit(C, BG, bh >> 3, bh & 7, s); mla_unit(C, BG, bh >> 3, bh & 7, 15 - s); }
    else for (int u = C.bid; u < 512; u += C.G) mla_unit(C, BG, u >> 7, (u >> 4) & 7, u & 15);
    }
#pragma unroll 1
    for (int rep = 0; rep < REP_DIL; ++rep)
    for (int u = C.bid; u < 1536; u += C.G) { const int p = u >> 9, rem = u & 511, b = rem >> 7, h = (rem >> 4) & 7, blk = rem & 15;
        const int dd = (p == 0) ? 1 : (p == 1) ? 4 : 16, bpr = 16 / dd;
        dil_unit(C, BG, p, dd, b, h, blk / bpr, blk % bpr); }
    { const int lane = C.lane;
#pragma unroll 1
      while (!bg_done(BG)) { BG_STEP_A(); BG_STEP_B(); } }
}
#undef BG_STEP_A
#undef BG_STEP_B

#ifdef TIME_NORM
constexpr int N_PHASES = 42;
#else
constexpr int N_PHASES = 36;
#endif
extern __shared__ __attribute__((aligned(16))) unsigned char lds_raw[];
typedef const __attribute__((address_space(4))) Args* ArgsP;
#define PHFN static __device__ __forceinline__ void
__device__ __forceinline__ ArgsP fresh_args() { unsigned long long p = (unsigned long long)__builtin_amdgcn_kernarg_segment_ptr(); asm volatile("" : "+s"(p)); return (ArgsP)p; }
__device__ __forceinline__ Ctx make_ctx(ArgsP ap, int wv) {
    Ctx C; C.lds = (LAS unsigned char*)lds_raw; C.ws = ap->ws;
    unsigned ones = ~0u; asm volatile("" : "+s"(ones)); const int lane = (int)__builtin_amdgcn_mbcnt_hi(ones, __builtin_amdgcn_mbcnt_lo(ones, 0u));
    int bid = blockIdx.x; asm volatile("" : "+s"(bid)); int G = gridDim.x; asm volatile("" : "+s"(G));
    C.wave = wv; C.lane = lane; C.tid = wv * 64 + lane;
    C.G = G; C.bid = bid; C.vcu = (C.G % 8 == 0) ? (C.bid % 8) * (C.G / 8) + C.bid / 8 : C.bid;
    C.gw = C.bid * 8 + C.wave; C.NGW = C.G * 8; return C;
}
#define IN(i) ((const float*)ap->in[i])
#define MODL(l) ((const float*)(C.ws + O_MOD) + (size_t)(l) * 4 * 6144)
PHFN ph_prologue(int wv) { const ArgsP ap = fresh_args(); const Ctx C = make_ctx(ap, wv); p0_prologue(C, ap); }
PHFN ph_norm(int wv, int l, int mode) { const ArgsP ap = fresh_args(); const Ctx C = make_ctx(ap, wv);
    if (mode == 0) phase_norm(C, IN(0), nullptr, false, true, IN(5), MODL(0), MODL(0), 0, 1024, false, true);
    else if (mode == 1) phase_norm(C, nullptr, nullptr, true, true, IN(5) + l * 1024, MODL(l - 1), MODL(l), 0, 1024, false, (l & 1) == 0);
    else if (mode == 3) phase_norm(C, nullptr, nullptr, true, true, IN(5) + l * 1024, MODL(l - 1), MODL(l), 0, 1024, true);
    else phase_norm(C, nullptr, ap->out, true, false, IN(5), MODL(3), MODL(3), 0, 1024); }
PHFN ph_proj(int wv, int j) { const ArgsP ap = fresh_args(); const Ctx C = make_ctx(ap, wv); unsigned char* ws = C.ws;
    DenseOrder S; S.init(ws + O_HN, ws + O_WIN + j * SZ_WIN, 1024, 1024, T_, 2048, C.G, C.bid, 1); EpiNorm<0> E{(bf16_t*)(ws + O_PROJ), 2048, IN(8) + j * 64, IN(9) + j * 64, IN(10) + j * 256, IN(11) + j * 128, IN(15) + j * 96 + 64, (const float*)(ws + O_CS), (LAS float*)(C.lds + LX_EXCH), 1.f / 32.f}; gemm_phase<true>(C, GemmDims{1024, 1024, 1024}, S, E); }
PHFN ph_postproj(int wv, int j) { const ArgsP ap = fresh_args(); const Ctx C = make_ctx(ap, wv); phase_postproj(C, IN(8) + j * 64, IN(9) + j * 64, IN(10) + j * 256, IN(11) + j * 128, IN(15) + j * 96); }
PHFN ph_qkv(int wv, int j) { const ArgsP ap = fresh_args(); const Ctx C = make_ctx(ap, wv); unsigned char* ws = C.ws;
    { DenseOrder S; S.init(ws + O_PROJ + 1536 * 2, ws + O_WUQ + j * SZ_WUQ, 2048, 256, T_, 768, C.G, C.bid); EpiNorm<1> E{(bf16_t*)(ws + O_Q2), 768, IN(14) + j * 96, IN(14) + j * 96 + 64, nullptr, nullptr, nullptr, (const float*)(ws + O_CS), (LAS float*)(C.lds + LX_EXCH), 1.f}; gemm_phase(C, GemmDims{256, 2048, 256}, S, E); }
    { const ArgsP ap2 = fresh_args(); const Ctx C = make_ctx(ap2, wv); unsigned char* ws = C.ws; DenseOrder S; S.init(ws + O_PROJ + 1792 * 2, ws + O_WUKV + j * SZ_WUKV, 2048, 128, T_, 1024, C.G, C.bid); EpiNorm<2> E{(bf16_t*)(ws + O_KV2), 1024, IN(15) + j * 96, nullptr, nullptr, nullptr, nullptr, (const float*)(ws + O_CS), (LAS float*)(C.lds + LX_EXCH), 1.f}; gemm_phase(C, GemmDims{128, 2048, 128}, S, E); } }
PHFN ph_postq(int wv, int j) { const ArgsP ap = fresh_args(); const Ctx C = make_ctx(ap, wv); phase_postq(C, IN(14) + j * 96, IN(15) + j * 96); }
PHFN ph_attention(int wv, int pair) { const ArgsP ap = fresh_args(); const Ctx C = make_ctx(ap, wv); phase_attention(C, IN(30), IN(32), pair); }
PHFN ph_mixcombine(int wv) { const ArgsP ap = fresh_args(); const Ctx C = make_ctx(ap, wv); phase_mixcombine(C); }
PHFN ph_outproj(int wv, int l, int which) { const ArgsP ap = fresh_args(); const Ctx C = make_ctx(ap, wv); unsigned char* ws = C.ws; const int j = l >> 1;
    DenseOrder S; S.init(ws + O_ATT, ws + (which ? O_RWOUT + j * SZ_RWOUT : O_WOUT + j * SZ_WOUT), 1024, 1024, T_, 1024, C.G, C.bid);
    EpiResid E{(bf16_t*)(ws + O_X), MODL(l) + 2048, which ? IN(27) + j * 1024 : nullptr}; gemm_phase(C, GemmDims{1024, 1024, 1024}, S, E); }
PHFN ph_router(int wv, int l) { const ArgsP ap = fresh_args(); const Ctx C = make_ctx(ap, wv); phase_router(C, (const bf16_t*)(C.ws + O_X), IN(6) + l * 1024, MODL(l), IN(28) + (size_t)l * 1024 * 32, IN(29) + l * 32, l); }
PHFN ph_moe1(int wv, int l) { const ArgsP ap = fresh_args(); const Ctx C = make_ctx(ap, wv); unsigned char* ws = C.ws; moe_plan_lds(C, l);
    MoeOrderT<true> S; S.A = (const char*)(ws + O_HN); S.WT = (const char*)(ws + O_W1 + (size_t)l * 32 * SZ_W1E); S.estride = SZ_W1E; S.tile_e = (const LAS int*)(C.lds + LX_TILE);
    S.NT = *(const LAS int*)(C.lds + LX_MISC + 128); S.nN = 8; S.G = C.G; S.c = C.bid; S.esz = 1; S.gtab = (const LAS int*)(C.lds + LX_GTAB);
    { const int* inv = (const int*)(ws + O_INV); LAS int* gt = (LAS int*)(C.lds + LX_GTAB); const LAS int* tot = (const LAS int*)(C.lds + LX_MISC + 256); const LAS int* pst = tot + 32;
      const int r = C.tid & 255, i0 = __builtin_amdgcn_readfirstlane(C.tid >> 8); int val[GTAB_UNITS / 2]; float bvl[GTAB_UNITS / 2]; const float* b1 = IN(31) + (size_t)l * 32 * 2048;
#pragma unroll
      for (int k = 0; k < GTAB_UNITS / 2; ++k) { Unit u; const bool ok = S.next(2 * k + i0, u); const int e = ok ? u.e : 0, j = (ok ? u.row0 - pst[e] : 0) + r; val[k] = (ok && j < tot[e]) ? inv[e * 16384 + j] : 0;
          bvl[k] = ok ? b1[(size_t)e * 2048 + u.col0 + r] : 0.f; }
      { const int* topi = (const int*)(ws + O_TOPI); const int* posj = (const int*)(ws + O_POSJ); int* pos = (int*)(ws + O_POS);
        for (int ck = C.bid; ck < 256; ck += C.G) if (C.tid < 256) pos[ck * 256 + C.tid] = pst[topi[ck * 256 + C.tid]] + posj[ck * 256 + C.tid]; }
#pragma unroll
      for (int k = 0; k < GTAB_UNITS / 2; ++k) { gt[(2 * k + i0) * 256 + r] = val[k]; ((LAS float*)(C.lds + LX_BIAS))[(2 * k + i0) * 256 + r] = bvl[k]; }
      __syncthreads(); }
    EpiSwiglu E{(unsigned char*)(ws + O_ACT), (const LAS float*)(C.lds + LX_BIAS), 1.f / 32.f}; gemm_phase<true>(C, GemmDims{1024, 1024, 1024}, S, E); }
PHFN ph_moe2(int wv, int l) { const ArgsP ap = fresh_args(); const Ctx C = make_ctx(ap, wv); unsigned char* ws = C.ws;
#if MODE != 1
    moe_plan_lds(C, l);
#endif

    MoeOrder S; S.A = (const char*)(ws + O_ACT); S.WT = (const char*)(ws + O_W2 + (size_t)l * 32 * SZ_W2E); S.estride = SZ_W2E; S.tile_e = (const LAS int*)(C.lds + LX_TILE);
    S.NT = *(const LAS int*)(C.lds + LX_MISC + 128); S.nN = 4; S.G = C.G; S.c = C.bid; S.esz = 1;
    { const float* b2 = IN(33) + (size_t)l * 32 * 1024; const int r = C.tid & 255, i0 = __builtin_amdgcn_readfirstlane(C.tid >> 8); float bvl[GTAB_UNITS / 2];
#pragma unroll
      for (int k = 0; k < GTAB_UNITS / 2; ++k) { Unit u; const bool ok = S.next(2 * k + i0, u); bvl[k] = ok ? b2[(size_t)u.e * 1024 + u.col0 + r] : 0.f; }
#pragma unroll
      for (int k = 0; k < GTAB_UNITS / 2; ++k) ((LAS float*)(C.lds + LX_BIAS))[(2 * k + i0) * 256 + r] = bvl[k];
      __syncthreads(); }
    EpiBf16 E{(bf16_t*)(ws + O_Y2), nullptr, 1024, 1024, 1.f / 32.f, (const LAS float*)(C.lds + LX_BIAS)}; gemm_phase<true>(C, GemmDims{1024, 1024, 1024}, S, E); }
PHFN ph_recin(int wv, int j) { const ArgsP ap = fresh_args(); const Ctx C = make_ctx(ap, wv); unsigned char* ws = C.ws;
    DenseOrder S; S.init(ws + O_HN, ws + O_RWIN + j * SZ_RWIN, 1024, 1024, T_, 2048, C.G, C.bid); EpiRecIn E{(bf16_t*)(ws + O_PROJ), IN(18) + j * 2048}; gemm_phase(C, GemmDims{1024, 1024, 1024}, S, E); }
PHFN ph_rgate(int wv, int j) { const ArgsP ap = fresh_args(); const Ctx C = make_ctx(ap, wv); phase_rgate(C, j, IN(19) + j * 4096, IN(20) + j * 1024, IN(22) + j * 1024, IN(24) + j * 1024); }
PHFN ph_scan_apply(int wv) { const ArgsP ap = fresh_args(); const Ctx C = make_ctx(ap, wv); phase_scan_apply(C); }

#if MODE == 1
__device__ __forceinline__ int fresh_tid(int wv) { unsigned ones = ~0u; asm volatile("" : "+s"(ones)); return wv * 64 + (int)__builtin_amdgcn_mbcnt_hi(ones, __builtin_amdgcn_mbcnt_lo(ones, 0u)); }
__device__ __forceinline__ void grid_barrier(int wv) { const ArgsP q = fresh_args(); XcdBarrier b; b.bar = (unsigned*)(q->ws + O_CTL) + CW_BAR; b.x = xb_xcc_id(); b.st = (volatile LAS unsigned*)((LAS unsigned char*)lds_raw + LDSX_OFF); xcd_barrier(b, fresh_tid(wv)); }
__global__ void __launch_bounds__(512, 2) mk_fwd(Args a) {
    int wv = __builtin_amdgcn_readfirstlane(threadIdx.x >> 6); asm volatile("" : "+s"(wv));
    { LAS unsigned char* lds = (LAS unsigned char*)lds_raw;
      for (int u = threadIdx.x; u < (LDS_BYTES - LDSX_OFF) / 4; u += 512) ((LAS unsigned*)(lds + LDSX_OFF))[u] = 0u;
      __syncthreads();
      if (a.ph_hi - a.ph_lo > 1) (void)xcd_barrier_post((unsigned*)(a.ws + O_CTL) + CW_BAR, (volatile LAS unsigned*)(lds + LDSX_OFF), (int)threadIdx.x); }
    int pid = 0;
#define PHASE(call) { const ArgsP q_ = fresh_args(); const int lo_ = q_->ph_lo, hi_ = q_->ph_hi; if (pid >= lo_ && pid < hi_) { call; if (pid + 1 < hi_) grid_barrier(wv); } ++pid; }
#define PHASE_R(call, REP) { const ArgsP q_ = fresh_args(); const int lo_ = q_->ph_lo, hi_ = q_->ph_hi; if (pid >= lo_ && pid < hi_) { if ((REP) > 1) { call; grid_barrier(wv); } call; if (pid + 1 < hi_) grid_barrier(wv); } ++pid; }
#ifndef REP_PROLOGUE
#define REP_PROLOGUE 1
#endif
#ifndef REP_MOE
#define REP_MOE 1
#endif
#ifndef REP_ATTN
#define REP_ATTN 1
#endif
#ifndef REP_GEMMS
#define REP_GEMMS 1
#endif
#ifdef TIME_NORM
#define NORM_EXTRA(l) PHASE(ph_norm(wv, l, 3))
#else
#define NORM_EXTRA(l)
#endif
#ifndef REP_ELEM
#define REP_ELEM 1
#endif
#ifndef REP_ROUTER
#define REP_ROUTER REP_ELEM
#endif
#ifndef REP_SCATTER
#define REP_SCATTER REP_ELEM
#endif
#ifndef REP_MIX
#define REP_MIX REP_ELEM
#endif
#ifndef REP_CONV
#define REP_CONV REP_ELEM
#endif
#ifndef REP_SCANA
#define REP_SCANA REP_ELEM
#endif
#define MOE_PHASES(l) PHASE_R(ph_router(wv, l), REP_ROUTER) PHASE_R(ph_moe1(wv, l), REP_MOE) PHASE_R(ph_moe2(wv, l), REP_MOE)
    PHASE_R(ph_prologue(wv), REP_PROLOGUE)
#define LAYER_PAIR(lp) \
        { const int l = 2 * (lp);         \
          PHASE(ph_norm(wv, l, (lp) == 0 ? 0 : 1)) PHASE_R(ph_proj(wv, lp), REP_GEMMS) PHASE_R(ph_qkv(wv, lp), REP_GEMMS) PHASE_R(ph_attention(wv, lp), REP_ATTN) PHASE_R(ph_mixcombine(wv), REP_MIX) PHASE(ph_outproj(wv, l, 0)) \
          MOE_PHASES(l) } \
        { const int l = 2 * (lp) + 1;     \
          NORM_EXTRA(l) PHASE(ph_norm(wv, l, 1)) PHASE_R(ph_recin(wv, lp), REP_GEMMS) PHASE_R(ph_rgate(wv, lp), REP_CONV) PHASE_R(ph_scan_apply(wv), REP_SCANA) PHASE(ph_outproj(wv, l, 1)) \
          MOE_PHASES(l) }
    LAYER_PAIR(0)
    LAYER_PAIR(1)
#undef LAYER_PAIR
#ifdef EXTRA_BARRIERS
    { const ArgsP q_ = fresh_args(); if (q_->ph_hi - q_->ph_lo > 1) { _Pragma("unroll 1") for (int xb = 0; xb < EXTRA_BARRIERS; ++xb) grid_barrier(wv); } }
#endif
    PHASE(ph_norm(wv, 3, 2))
#undef PHASE
#undef PHASE_R
#undef MOE_PHASES
}
#else
template <int PH> __global__ void __launch_bounds__(512, 2) k_phase(Args a, int l, int x) {
    int wv = __builtin_amdgcn_readfirstlane(threadIdx.x >> 6); asm volatile("" : "+s"(wv));
    LAS unsigned char* lds = (LAS unsigned char*)lds_raw;
    for (int u = threadIdx.x; u < (LDS_BYTES - LDSX_OFF) / 4; u += 512) ((LAS unsigned*)(lds + LDSX_OFF))[u] = 0u;
    __syncthreads();
    if constexpr (PH == 0) ph_prologue(wv);
    if constexpr (PH == 1) ph_norm(wv, l, x);
    if constexpr (PH == 2) ph_proj(wv, l);
    if constexpr (PH == 4) ph_qkv(wv, l);
    if constexpr (PH == 6) ph_attention(wv, l);
    if constexpr (PH == 7) ph_mixcombine(wv);
    if constexpr (PH == 8) ph_outproj(wv, l, x);
    if constexpr (PH == 9) ph_router(wv, l);
    if constexpr (PH == 11) ph_moe1(wv, l);
    if constexpr (PH == 12) ph_moe2(wv, l);
    if constexpr (PH == 13) ph_recin(wv, l);
    if constexpr (PH == 14) ph_rgate(wv, l);
    if constexpr (PH == 17) ph_scan_apply(wv);
}
#endif
#undef IN
#undef MODL
}

#ifndef MODE
#define MODE 2
#endif
extern "C" void kernel_launch(void* const* d_in, const int* in_sizes, int n_in, void* d_out, int out_size, void* d_ws, size_t ws_size, hipStream_t stream) {
    (void)in_sizes; (void)n_in; (void)out_size; (void)ws_size;
#if MODE == 0
    nv::forward(d_in, (float*)d_out, d_ws, stream);
#else
    static int grid = 0;
    if (grid == 0) {
        int dev = 0, cus = 0;
        (void)hipGetDevice(&dev); (void)hipDeviceGetAttribute(&cus, hipDeviceAttributeMultiprocessorCount, dev);
#if MODE == 1
        (void)hipFuncSetAttribute((const void*)mk::mk_fwd, hipFuncAttributeMaxDynamicSharedMemorySize, mk::LDS_BYTES);
#else
#define SA(PH) (void)hipFuncSetAttribute((const void*)mk::k_phase<PH>, hipFuncAttributeMaxDynamicSharedMemorySize, mk::LDS_BYTES)
        SA(0); SA(1); SA(2); SA(4); SA(6); SA(7); SA(8); SA(9); SA(10); SA(11); SA(12); SA(13); SA(14); SA(17);
#undef SA
#endif
        grid = cus > 0 ? cus : 256;
    }
    (void)hipMemsetAsync((char*)d_ws + mk::O_CTL, 0, mk::SZ_CTL, stream);
    mk::Args a;
    memset(&a, 0, sizeof(a));
    for (int i = 0; i < 34; ++i) a.in[i] = d_in[i];
    a.out = (float*)d_out; a.ws = (unsigned char*)d_ws;
#if MODE == 1
    a.ph_lo = 0; a.ph_hi = mk::N_PHASES;
    hipLaunchKernelGGL(mk::mk_fwd, dim3(grid), dim3(512), mk::LDS_BYTES, stream, a);
#else
#define LP(PH, l, x) hipLaunchKernelGGL(mk::k_phase<PH>, dim3(grid), dim3(512), mk::LDS_BYTES, stream, a, l, x)
    LP(0, 0, 0);
    for (int lp = 0; lp < 2; ++lp) {
        { const int l = 2 * lp; LP(1, l, lp == 0 ? 0 : 1); LP(2, lp, 0); LP(4, lp, 0); LP(6, lp, 0); LP(7, 0, 0); LP(8, l, 0); LP(9, l, 0); LP(10, 0, 0); LP(11, l, 0); LP(12, l, 0); }
        { const int l = 2 * lp + 1; LP(1, l, 1); LP(13, lp, 0); LP(14, lp, 0); LP(17, 0, 0); LP(8, l, 1); LP(9, l, 0); LP(10, 0, 0); LP(11, l, 0); LP(12, l, 0); }
    }
    LP(1, 3, 2);
#undef LP
#endif
#endif
}
```

```cpp
#define MODE 1

#include <string.h>
#include <hip/hip_runtime.h>
#include <stdint.h>
#include <math.h>

namespace cfg {
constexpr int D = 1024, NB = 4, S = 4096, T = NB * S, DEPTH = 4;
constexpr int MIXIN = 1952;
constexpr int NE = 32, TOPK = 4;
constexpr int MPAIR = T * TOPK;
constexpr int NBLK = MPAIR / 256 + NE;
constexpr int P = NBLK * 256;
}
using namespace cfg;


namespace mk {
#define LAS __attribute__((address_space(3)))
#define GAS __attribute__((address_space(1)))
typedef unsigned short bf16_t;
typedef short bf16x8 __attribute__((ext_vector_type(8)));
typedef short s16x4 __attribute__((ext_vector_type(4)));
typedef float f32x2 __attribute__((ext_vector_type(2)));
typedef float f32x4 __attribute__((ext_vector_type(4)));
typedef float f32x16 __attribute__((ext_vector_type(16)));
typedef unsigned u32x2 __attribute__((ext_vector_type(2)));
typedef unsigned u32x4 __attribute__((ext_vector_type(4)));
typedef GAS unsigned gu32;
#define RLX_AGENT __ATOMIC_RELAXED, __HIP_MEMORY_SCOPE_AGENT

__device__ __forceinline__ unsigned cvt_pk_bf16(float lo, float hi) { unsigned r; asm volatile("v_cvt_pk_bf16_f32 %0, %1, %2" : "=v"(r) : "v"(lo), "v"(hi)); return r; }
__device__ __forceinline__ float bf_lo(unsigned u) { return __uint_as_float(u << 16); }
__device__ __forceinline__ float bf_hi(unsigned u) { return __uint_as_float(u & 0xffff0000u); }
template <int O> __device__ __forceinline__ float shx(float v) { static_assert(O >= 1 && O < 32, "shx"); return __int_as_float(__builtin_amdgcn_ds_swizzle(__float_as_int(v), (O << 10) | 0x1f)); }
__device__ __forceinline__ float xadd32(float v) { const auto r = __builtin_amdgcn_permlane32_swap(__float_as_uint(v), __float_as_uint(v), false, false); return __uint_as_float(r[0]) + __uint_as_float(r[1]); }
__device__ __forceinline__ float xmax32(float v) { const auto r = __builtin_amdgcn_permlane32_swap(__float_as_uint(v), __float_as_uint(v), false, false); return fmaxf(__uint_as_float(r[0]), __uint_as_float(r[1])); }
#define DPP_STEP(OP, N) asm("s_nop 1\n\t" OP "_dpp %0, %1, %1 row_ror:" #N " row_mask:0xf bank_mask:0xf" : "=v"(r) : "v"(v)); v = r;
__device__ __forceinline__ float rsum16(float v) { float r; DPP_STEP("v_add_f32", 1) DPP_STEP("v_add_f32", 2) DPP_STEP("v_add_f32", 4) DPP_STEP("v_add_f32", 8) return v; }
__device__ __forceinline__ float rmax16(float v) { float r; DPP_STEP("v_max_f32", 1) DPP_STEP("v_max_f32", 2) DPP_STEP("v_max_f32", 4) DPP_STEP("v_max_f32", 8) return v; }
#undef DPP_STEP
__device__ __forceinline__ float fmax_raw(float a, float b) { float r; asm("v_max_f32 %0, %1, %2" : "=v"(r) : "v"(a), "v"(b)); return r; }
__device__ __forceinline__ float wsum(float v) { v = rsum16(v); v += shx<16>(v); return xadd32(v); }
__device__ __forceinline__ float fexp2(float x) { return __builtin_amdgcn_exp2f(x); }
__device__ __forceinline__ float frcp(float x) { return __builtin_amdgcn_rcpf(x); }
__device__ __forceinline__ float fsigmoid(float z) { return frcp(1.f + fexp2(-1.4426950408889634f * z)); }
__device__ __forceinline__ float fgelu_tanh(float x) { const float u = 0.7978845608028654f * (x + 0.044715f * x * x * x); return x * frcp(1.f + fexp2(-2.8853900817779268f * u)); }

#define XB_TMO      128
#define XB_XCNT(j)  (256  + 64 * (j))
#define XB_XSUB(j)  (1280 + 64 * (j))
#define XB_XGEN(j)  (2304 + 64 * (j))
#define XB_TOP      3328
#define XB_TOPGEN   3392
#define XCD_BAR_WORDS 3456
#define XB_SPIN_CAP (1u << 18)
__device__ __forceinline__ unsigned xb_ld(unsigned* p)              { return __hip_atomic_load(p, __ATOMIC_RELAXED, __HIP_MEMORY_SCOPE_AGENT); }
__device__ __forceinline__ unsigned xb_add(unsigned* p, unsigned v) { return __hip_atomic_fetch_add(p, v, __ATOMIC_RELAXED, __HIP_MEMORY_SCOPE_AGENT); }
__device__ __forceinline__ unsigned xb_xcc_id() { return (unsigned)__builtin_amdgcn_s_getreg((3 << 11) | 20) & 0xFu; }
#define XB_SPIN(cond, bar) do { unsigned _sp = 0; while (cond) { __builtin_amdgcn_s_sleep(1); \
    if ((++_sp & 255u) == 0u) { if (xb_ld(&(bar)[XB_TMO])) break; if (_sp > XB_SPIN_CAP) { atomicAdd(&(bar)[XB_TMO], 1u); break; } } } } while (0)
struct XcdBarrier { unsigned* bar; unsigned x; volatile LAS unsigned* st; };
__device__ __forceinline__ XcdBarrier xcd_barrier_post(unsigned* bar, volatile LAS unsigned* st, int tid) {
    XcdBarrier b; b.bar = bar; b.x = xb_xcc_id(); b.st = st;
    if (tid == 0) (void)xb_add(&bar[XB_XCNT(b.x)], 1u);
    return b;
}
__device__ __forceinline__ void xcd_barrier_complete(unsigned* bar, unsigned x, unsigned& nloc, unsigned& nx) {
    const unsigned G = gridDim.x * gridDim.y * gridDim.z;
    unsigned sum, cnt, mine, sp = 0u;
    for (;;) {
        sum = 0u; cnt = 0u; mine = 0u;
#pragma unroll
        for (unsigned j = 0; j < 16; ++j) { const unsigned c = xb_ld(&bar[XB_XCNT(j)]); sum += c; cnt += (c > 0u) ? 1u : 0u; mine = (j == x) ? c : mine; }
        if (sum == G) break;
        __builtin_amdgcn_s_sleep(1);
        if ((++sp & 255u) == 0u) { if (xb_ld(&bar[XB_TMO])) break; if (sp > XB_SPIN_CAP) { atomicAdd(&bar[XB_TMO], 1u); break; } }
    }
    nloc = mine > 0u ? mine : 1u; nx = cnt > 0u ? cnt : 1u;
}
__device__ __forceinline__ void xcd_barrier(const XcdBarrier& b, int tid) {
    asm volatile("s_waitcnt vmcnt(0)" ::: "memory");
    __syncthreads();
    if (tid == 0) {
        unsigned* bar = b.bar;
        __builtin_amdgcn_s_waitcnt(0);
        unsigned nloc = b.st[0], nx = b.st[1];
        if (nloc == 0u) { xcd_barrier_complete(bar, b.x, nloc, nx); b.st[0] = nloc; b.st[1] = nx; }
        const unsigned old = xb_add(&bar[XB_XSUB(b.x)], 1u);
        const unsigned gen = old / nloc;
        if (old + 1u == (gen + 1u) * nloc) {
            __builtin_amdgcn_fence(__ATOMIC_RELEASE, "agent");
            asm volatile("s_waitcnt vmcnt(0)" ::: "memory");
            const unsigned og = xb_add(&bar[XB_TOP], 1u);
            const unsigned tg = og / nx;
            if (og + 1u == (tg + 1u) * nx) xb_add(&bar[XB_TOPGEN], 1u);
            else XB_SPIN(xb_ld(&bar[XB_TOPGEN]) == tg, bar);
            __builtin_amdgcn_fence(__ATOMIC_ACQUIRE, "agent");
            xb_add(&bar[XB_XGEN(b.x)], 1u);
            asm volatile("s_waitcnt vmcnt(0)" ::: "memory");
        } else {
            XB_SPIN(xb_ld(&bar[XB_XGEN(b.x)]) == gen, bar);
            __builtin_amdgcn_fence(__ATOMIC_ACQUIRE, "agent");
            asm volatile("s_waitcnt vmcnt(0)" ::: "memory");
        }
    }
    __syncthreads();
}

constexpr int BM = 256, BK = 64, HALF = 128, HTB = HALF * BK * 2, STAGE_BYTES = 8 * HTB;
__host__ __device__ __forceinline__ int lds_byte(int r, int c) { const int st = (r >> 4) * 2 + (c >> 5), rr = r & 15, cc = c & 31, ob = rr * 64 + cc * 2; return st * 1024 + (ob ^ (((ob >> 9) & 1) << 5)); }
__host__ __device__ __forceinline__ void stage_rc(int b, int& R, int& C) { const int st = b / 1024, sb = b % 1024, swz = sb ^ (((sb >> 9) & 1) << 5); R = (st >> 1) * 16 + swz / 64; C = (st & 1) * 32 + (swz % 64) / 2; }
__host__ __device__ __forceinline__ int perm32(int rho) { const int n = rho >> 4, i = rho & 15; return 8 * (i >> 2) + 4 * n + (i & 3); }

struct Unit { const char* a; const char* b; int row0, col0, e, pad; };
struct GemmDims { int K, lda, ldb; };
typedef f32x4 Acc[2][2][4][2];
__device__ __forceinline__ void zero_acc(Acc& acc) {
#pragma unroll
    for (int a = 0; a < 2; ++a)
#pragma unroll
        for (int b = 0; b < 2; ++b)
#pragma unroll
            for (int m = 0; m < 4; ++m)
#pragma unroll
                for (int n = 0; n < 2; ++n)
                    { f32x2 z0, z1; asm volatile("v_mov_b64 %0, 0" : "=v"(z0)); asm volatile("v_mov_b64 %0, 0" : "=v"(z1)); acc[a][b][m][n] = (f32x4){z0[0], z0[1], z1[0], z1[1]}; }
}

typedef int v8i32 __attribute__((ext_vector_type(8)));
template <bool F8 = false, class CtxT, class Epi, class Sched>
__device__ __forceinline__ void gemm_phase(const CtxT& C, const GemmDims g, const Sched& S, const Epi& E) {
    LAS unsigned char* lds = C.lds;
    const int tid = C.tid, wid = __builtin_amdgcn_readfirstlane(tid >> 6), lane = tid & 63, wr = wid >> 2, wc = wid & 3, fr = lane & 15, fq = lane >> 4;
    constexpr int ESZ = F8 ? 1 : 2;
    constexpr bool GA = Sched::GATHER;
    int nt = g.K / (F8 ? 128 : BK); asm volatile("" : "+s"(nt));
    unsigned voffA[2], voffB[2];
#pragma unroll
    for (int i = 0; i < 2; ++i) { int R, C; stage_rc(tid * 16 + i * 8192, R, C); const int Rb = (R & ~31) + perm32(R & 31);
        voffA[i] = (unsigned)(R * g.lda * ESZ + C * 2); voffB[i] = (unsigned)(Rb * g.ldb * ESZ + C * 2); }
    unsigned voffG[2][2];
    auto load_goffs = [&](int uidx) { if constexpr (GA) { int R, Cc; stage_rc(tid * 16, R, Cc); const LAS int* tp = S.gtab + uidx * 256 + R;
#pragma unroll
        for (int h = 0; h < 2; ++h)
#pragma unroll
            for (int i = 0; i < 2; ++i) voffG[h][i] = (unsigned)tp[h * 128 + i * 64] * (unsigned)(g.lda * ESZ) + (unsigned)(Cc * 2); } };
    const size_t kstep = (size_t)(BK * 2);
    const size_t hstepA = (size_t)HALF * g.lda * ESZ, hstepB = (size_t)HALF * g.ldb * ESZ;
    const unsigned ldsw = (unsigned)wid * 1024u;
    const unsigned ldsu = (unsigned)__builtin_amdgcn_readfirstlane((int)(unsigned)(unsigned long long)(lds));
    const int aoff = lds_byte(wr * 64 + fr, fq * 8), boff = lds_byte(wc * 32 + fr, fq * 8);
#define PG8_SA(b, h) (((b) * 2 + (h)) * HTB)
#define PG8_SB(b, h) ((4 + (b) * 2 + (h)) * HTB)
#define PG8_STAGE(bufoff, gbase, voff) do { _Pragma("unroll") for (int _i = 0; _i < 2; ++_i) { \
        asm volatile("s_mov_b32 m0, %2\n\ts_nop 3\n\tglobal_load_lds_dwordx4 %0, %1" :: "v"((voff)[_i]), "s"((const char*)(gbase)), "s"(ldsu + (unsigned)(bufoff) + ldsw + (unsigned)(_i * 8192)) : "memory"); } } while (0)
#define PG8_STAGE_A(bufoff, gbase, h) do { if constexpr (GA) PG8_STAGE(bufoff, gbase, voffG[h]); else PG8_STAGE(bufoff, (gbase) + (h) * hstepA, voffA); } while (0)
#define PG8_LDA(dst, b, h) do { _Pragma("unroll") for (int m = 0; m < 4; ++m) _Pragma("unroll") for (int k = 0; k < 2; ++k) dst[m][k] = *(const LAS bf16x8*)(lds + PG8_SA(b, h) + aoff + m * 2048 + k * 1024); } while (0)
#define PG8_LDB(dst, b, h) do { _Pragma("unroll") for (int n = 0; n < 2; ++n) _Pragma("unroll") for (int k = 0; k < 2; ++k) dst[n][k] = *(const LAS bf16x8*)(lds + PG8_SB(b, h) + boff + n * 2048 + k * 1024); } while (0)
#define PG8_CAT(x) __builtin_bit_cast(v8i32, (x))
#define PG8_MMA(ai, bj, At, Bt) do { __builtin_amdgcn_s_setprio(1); \
        if constexpr (F8) { _Pragma("unroll") for (int m = 0; m < 4; ++m) _Pragma("unroll") for (int n = 0; n < 2; ++n) \
            acc[ai][bj][m][n] = __builtin_amdgcn_mfma_scale_f32_16x16x128_f8f6f4(PG8_CAT(Bt[n]), PG8_CAT(At[m]), acc[ai][bj][m][n], 0, 0, 0, 0, 0, 0); } \
        else { _Pragma("unroll") for (int m = 0; m < 4; ++m) _Pragma("unroll") for (int n = 0; n < 2; ++n) _Pragma("unroll") for (int k = 0; k < 2; ++k) \
            acc[ai][bj][m][n] = __builtin_amdgcn_mfma_f32_16x16x32_bf16(Bt[n][k], At[m][k], acc[ai][bj][m][n], 0, 0, 0); } \
        __builtin_amdgcn_s_setprio(0); } while (0)
#define PG8_WAIT_V(n) asm volatile("s_waitcnt vmcnt(" #n ")" ::: "memory")
#define PG8_WAIT_L(n) asm volatile("s_waitcnt lgkmcnt(" #n ")" ::: "memory")
#define PG8_BAR __builtin_amdgcn_s_barrier()
#define PG8_SCHED __builtin_amdgcn_sched_barrier(0)
    Unit cur, nxt; int ui = 0;
    if (!S.next(0, cur)) return;
    Acc acc; zero_acc(acc);
    struct Frag2 { bf16x8 p[2]; __device__ __forceinline__ bf16x8& operator[](int k) { return p[k]; } __device__ __forceinline__ const bf16x8& operator[](int k) const { return p[k]; } };
    Frag2 At[4], B0[2], B1[2];
    const char* cA = cur.a; const char* cB = cur.b;
    load_goffs(0);
    PG8_STAGE(PG8_SB(0, 0), cB, voffB); PG8_STAGE(PG8_SB(0, 1), cB + hstepB, voffB); PG8_STAGE_A(PG8_SA(0, 0), cA, 0); PG8_STAGE_A(PG8_SA(0, 1), cA, 1);
    if (wr == 1) PG8_BAR;
    PG8_WAIT_V(2); PG8_BAR;
    PG8_STAGE(PG8_SB(1, 0), cB + kstep, voffB); PG8_STAGE_A(PG8_SA(1, 0), cA + kstep, 0); PG8_STAGE(PG8_SB(1, 1), cB + hstepB + kstep, voffB);
    PG8_WAIT_V(6); PG8_BAR;
    for (;;) {
        const bool has_next = S.next(ui + 1, nxt);
        const char* nA = has_next ? nxt.a : cA; const char* nB = has_next ? nxt.b : cB;
        for (int t = 0; t < nt; t += 2) {
            const bool last = (t == nt - 2);
            const char* a1 = cA + (size_t)(t + 1) * kstep;
            const char* a2 = last ? nA : cA + (size_t)(t + 2) * kstep; const char* b2 = last ? nB : cB + (size_t)(t + 2) * kstep;
            const char* a3 = a2 + kstep; const char* b3 = b2 + kstep;
            PG8_LDB(B0, 0, 0); PG8_LDB(B1, 0, 1); PG8_SCHED; PG8_LDA(At, 0, 0); PG8_STAGE_A(PG8_SA(1, 1), a1, 1);
            if (GA && last && has_next) load_goffs(ui + 1);
            PG8_WAIT_V(8); PG8_WAIT_L(0); PG8_BAR; PG8_MMA(0, 0, At, B0); PG8_MMA(0, 1, At, B1); PG8_BAR; PG8_SCHED;
            PG8_LDA(At, 0, 1); PG8_STAGE(PG8_SB(0, 0), b2, voffB); PG8_STAGE(PG8_SB(0, 1), b2 + hstepB, voffB); PG8_STAGE_A(PG8_SA(0, 0), a2, 0);
            PG8_WAIT_V(8); PG8_WAIT_L(0); PG8_BAR; PG8_MMA(1, 0, At, B0); PG8_MMA(1, 1, At, B1); PG8_BAR; PG8_SCHED;
            PG8_LDB(B0, 1, 0); PG8_LDB(B1, 1, 1); PG8_SCHED; PG8_LDA(At, 1, 0); PG8_STAGE_A(PG8_SA(0, 1), a2, 1);
            PG8_WAIT_V(8); PG8_WAIT_L(0); PG8_BAR; PG8_MMA(0, 0, At, B0); PG8_MMA(0, 1, At, B1); PG8_BAR; PG8_SCHED;
            PG8_LDA(At, 1, 1); PG8_STAGE(PG8_SB(1, 0), b3, voffB); PG8_STAGE(PG8_SB(1, 1), b3 + hstepB, voffB); PG8_STAGE_A(PG8_SA(1, 0), a3, 0);
            PG8_WAIT_V(8); PG8_WAIT_L(0); PG8_BAR; PG8_MMA(1, 0, At, B0); PG8_MMA(1, 1, At, B1); PG8_BAR; PG8_SCHED;
        }
        if (wr == 0) PG8_BAR;
        E(acc, cur, wr, wc, fr, fq);
        if (!has_next) break;
        zero_acc(acc);
        cur = nxt; cA = nA; cB = nB; ++ui;
        if (wr == 1) PG8_BAR;
    }
    PG8_WAIT_V(0);
    PG8_BAR;
#undef PG8_SA
#undef PG8_SB
#undef PG8_STAGE
#undef PG8_STAGE_A
#undef PG8_LDA
#undef PG8_LDB
#undef PG8_MMA
#undef PG8_CAT
#undef PG8_WAIT_V
#undef PG8_WAIT_L
#undef PG8_BAR
#undef PG8_SCHED
}

struct DenseOrder {
    static constexpr bool GATHER = false;
    const char* A; const char* Bt; int lda, ldb, nM, nN, nwg, G, c, esz;
    __device__ __forceinline__ void init(const void* A_, const void* Bt_, int lda_, int ldb_, int M, int N, int G_, int c_, int esz_ = 2) { A = (const char*)A_; Bt = (const char*)Bt_; lda = lda_; ldb = ldb_; nM = M / BM; nN = N / BM; nwg = nM * nN; G = G_; c = c_; esz = esz_; }
    __device__ __forceinline__ bool next(int i, Unit& u) const {
        const long L = (long)i * G + c; if (L >= nwg) return false;
        int wgid = (int)L; { const int q = nwg / 8, r = nwg % 8, xcd = wgid % 8, off = wgid / 8; wgid = (xcd < r ? xcd * (q + 1) : r * (q + 1) + (xcd - r) * q) + off; }
        const int nig = 8 * nN, gid = wgid / nig, fm = gid * 8, gsz = (nM - fm) < 8 ? (nM - fm) : 8;
        const int pm = fm + ((wgid % nig) % gsz), pn = (wgid % nig) / gsz;
        u.a = A + (size_t)pm * BM * lda * esz; u.b = Bt + (size_t)pn * BM * ldb * esz; u.row0 = pm * BM; u.col0 = pn * BM; u.e = 0; u.pad = 0; return true;
    }
};
struct LruOrder {
    static constexpr bool GATHER = false;
    const char* XC; const char* RG; int G, c;
    __device__ __forceinline__ bool next(int i, Unit& u) const {
        const int L = i * G + c; if (L >= 512) return false;
        const int pm = L >> 3, n = L & 7;
        u.a = XC + ((size_t)pm * BM * 1024 + n * 128) * 2; u.b = RG + (size_t)n * 256 * 128 * 2; u.row0 = pm * BM; u.col0 = n * 128; u.e = n; u.pad = 0; return true;
    }
};
template <bool GATHER_ = false> struct MoeOrderT {
    static constexpr bool GATHER = GATHER_; const LAS int* gtab;
    const char* A; const char* WT; size_t estride; const LAS int* tile_e; int NT, nN, G, c, esz;
    __device__ __forceinline__ bool next(int i, Unit& u) const {
        int tile, pn;
#ifndef MOE_ORDER_ALT
#define MOE_ORDER_ALT 0
#endif
        if (!MOE_ORDER_ALT && (G % (8 * nN)) == 0) {
            const int tpr = (G / nN) >> 3, TPX = (NT + 7) >> 3, x = c & 7, k = i * tpr + (c >> 3) / nN;
            if (k >= TPX) return false;
            tile = x * TPX + k; pn = (c >> 3) % nN; }
        else { const int L = i * G + c; tile = L / nN; pn = L % nN; }
        if (tile >= NT) return false;
        const int e = __builtin_amdgcn_readfirstlane(tile_e[tile]);
        u.a = GATHER ? A : A + (size_t)tile * BM * 1024 * esz; u.b = WT + (size_t)e * estride + (size_t)pn * BM * 1024 * esz; u.row0 = tile * BM; u.col0 = pn * BM; u.e = e; u.pad = i; return true;
    }
};
typedef MoeOrderT<false> MoeOrder;

#define EPI_ROW(ai, m) (u.row0 + (ai) * HALF + wr * 64 + (m) * 16 + fr)
#define EPI_COL(bj) (u.col0 + (bj) * HALF + wc * 32 + 8 * fq)
struct EpiBf16 {
    bf16_t* O; const float* bias; int ldc, bias_es; float ascale; const LAS float* btab = nullptr;
    __device__ __forceinline__ void operator()(const Acc& acc, const Unit& u, int wr, int wc, int fr, int fq) const {
        f32x4 bv[2][2];
#pragma unroll
        for (int bj = 0; bj < 2; ++bj)
#pragma unroll
            for (int n = 0; n < 2; ++n) bv[bj][n] = btab ? *(const LAS f32x4*)(btab + u.pad * 256 + bj * HALF + wc * 32 + 8 * fq + 4 * n) : bias ? *(const f32x4*)(bias + (size_t)u.e * bias_es + EPI_COL(bj) + 4 * n) : (f32x4){0.f, 0.f, 0.f, 0.f};
#pragma unroll
        for (int ai = 0; ai < 2; ++ai)
#pragma unroll
            for (int m = 0; m < 4; ++m) { bf16_t* rowp = O + (size_t)EPI_ROW(ai, m) * ldc;
#pragma unroll
                for (int bj = 0; bj < 2; ++bj) { const f32x4 v0 = acc[ai][bj][m][0] * ascale + bv[bj][0], v1 = acc[ai][bj][m][1] * ascale + bv[bj][1];
                    u32x4 w; w.x = cvt_pk_bf16(v0[0], v0[1]); w.y = cvt_pk_bf16(v0[2], v0[3]); w.z = cvt_pk_bf16(v1[0], v1[1]); w.w = cvt_pk_bf16(v1[2], v1[3]);
                    *(u32x4*)(rowp + EPI_COL(bj)) = w; } }
    }
};
__device__ __forceinline__ unsigned pk4_fp8(float a, float b, float c, float d) { int w = 0; w = __builtin_amdgcn_cvt_pk_fp8_f32(a, b, w, false); w = __builtin_amdgcn_cvt_pk_fp8_f32(c, d, w, true); return (unsigned)w; }
constexpr float Y8_SCALE = 16.f;
struct EpiY8 {
    unsigned char* O; float ascale; const LAS float* btab;
    __device__ __forceinline__ void operator()(const Acc& acc, const Unit& u, int wr, int wc, int fr, int fq) const {
        f32x4 bv[2][2];
#pragma unroll
        for (int bj = 0; bj < 2; ++bj)
#pragma unroll
            for (int n = 0; n < 2; ++n) bv[bj][n] = *(const LAS f32x4*)(btab + u.pad * 256 + bj * HALF + wc * 32 + 8 * fq + 4 * n) * Y8_SCALE;
        const float as = ascale * Y8_SCALE;
#pragma unroll
        for (int ai = 0; ai < 2; ++ai)
#pragma unroll
            for (int m = 0; m < 4; ++m) { unsigned char* rowp = O + (size_t)EPI_ROW(ai, m) * 1024;
#pragma unroll
                for (int bj = 0; bj < 2; ++bj) { const f32x4 v0 = acc[ai][bj][m][0] * as + bv[bj][0], v1 = acc[ai][bj][m][1] * as + bv[bj][1];
                    u32x2 w; w.x = pk4_fp8(v0[0], v0[1], v0[2], v0[3]); w.y = pk4_fp8(v1[0], v1[1], v1[2], v1[3]);
                    *(u32x2*)(rowp + EPI_COL(bj)) = w; } }
    }
};
template <int KIND> struct EpiNorm {
    bf16_t* O; int ldc; const float* ga; const float* gb; const float* gc; const float* gd; const float* ge; const float* cs; LAS float* S; float ascale;
    __device__ __forceinline__ void operator()(const Acc& acc, const Unit& u, int wr, int wc, int fr, int fq) const {
        const int pn = u.col0 >> 8; const int lane = fr + 16 * fq; const float as2 = ascale * ascale;
        int mode = 0; const float* gp = ga; float scale = 1.f;
        if (KIND == 0) { if (pn < 2) { mode = 1; gp = ga; scale = 0.125f * 1.4426950408889634f; } else if (pn < 4) { mode = 1; gp = gb; } else if (pn < 6) mode = 0; else if (pn == 6) { mode = 2; gp = gc; } else { mode = 3; gp = gd; } }
        if (KIND == 1) { scale = 0.10206207261596575f * 1.4426950408889634f; if (pn < 2) { mode = 1; gp = ga; } else { mode = 4; gp = gb; } }
        if (KIND == 2) { if (pn < 2) { mode = 1; gp = ga; } else mode = 0; }
        if (mode != 0) {
#pragma unroll
            for (int ai = 0; ai < 2; ++ai)
#pragma unroll
                for (int m = 0; m < 4; ++m)
#pragma unroll
                    for (int bj = 0; bj < 2; ++bj) { const f32x4 a = acc[ai][bj][m][0], b = acc[ai][bj][m][1];
                        float s = (a[0] * a[0] + a[1] * a[1]) + (a[2] * a[2] + a[3] * a[3]) + (b[0] * b[0] + b[1] * b[1]) + (b[2] * b[2] + b[3] * b[3]);
                        s += shx<16>(s); s = xadd32(s);
                        if (fq == 0) S[(ai * HALF + wr * 64 + m * 16 + fr) * 8 + bj * 4 + wc] = s; }
            asm volatile("s_waitcnt lgkmcnt(0)" ::: "memory"); __builtin_amdgcn_s_barrier(); asm volatile("" ::: "memory");
        }
        const float inv_n = (mode == 1) ? (1.f / 64.f) : (mode == 2) ? (1.f / 256.f) : (1.f / 32.f);
        const bool rope_tile = (mode == 4) || (mode == 3);
#pragma unroll
        for (int bj = 0; bj < 2; ++bj) {
            f32x4 g0 = (f32x4){1.f, 1.f, 1.f, 1.f}, g1 = g0; bool rope = false, zero = false; float invn = inv_n;
            int c8 = 8 * fq; asm volatile("" : "+v"(c8));
            if (mode == 1) { const int c = 32 * (wc & 1) + c8; g0 = *(const f32x4*)(gp + c); g1 = *(const f32x4*)(gp + c + 4); }
            else if (mode == 2) { const int c = bj * HALF + wc * 32 + c8; g0 = *(const f32x4*)(gp + c); g1 = *(const f32x4*)(gp + c + 4); }
            else if (mode == 3) { if (bj == 0) { const int c = wc * 32 + c8; g0 = *(const f32x4*)(gp + c); g1 = *(const f32x4*)(gp + c + 4); invn = 1.f / 128.f; }
                                  else if (wc == 0) { g0 = *(const f32x4*)(ge + c8); g1 = *(const f32x4*)(ge + c8 + 4); rope = true; } else zero = true; }
            else if (mode == 4) { g0 = *(const f32x4*)(gp + c8); g1 = *(const f32x4*)(gp + c8 + 4); rope = true; }
            (void)rope_tile;
#pragma unroll
            for (int ai = 0; ai < 2; ++ai)
#pragma unroll
                for (int m = 0; m < 4; ++m) { const int row = EPI_ROW(ai, m);
                    f32x4 v0 = acc[ai][bj][m][0], v1 = acc[ai][bj][m][1];
                    if (mode != 0) { const LAS float* sr = S + (ai * HALF + wr * 64 + m * 16 + fr) * 8; float tot;
                        if (mode == 1) { const f32x2 t = *(const LAS f32x2*)(sr + bj * 4 + (wc & 2)); tot = t[0] + t[1]; }
                        else if (mode == 2) { const f32x4 t0 = *(const LAS f32x4*)sr, t1 = *(const LAS f32x4*)(sr + 4); tot = (t0[0] + t0[1]) + (t0[2] + t0[3]) + (t1[0] + t1[1]) + (t1[2] + t1[3]); }
                        else if (mode == 3 && bj == 0) { const f32x4 t0 = *(const LAS f32x4*)sr; tot = (t0[0] + t0[1]) + (t0[2] + t0[3]); }
                        else tot = sr[bj * 4 + wc];
                        const float rs = rsqrtf(tot * as2 * invn + 1e-6f) * scale * ascale; v0 = v0 * rs * g0; v1 = v1 * rs * g1; } else { v0 = v0 * ascale; v1 = v1 * ascale; }
                    if (rope) {
                        const float* cr = cs + (size_t)row * 32 + 8 * (fq & 1); const f32x4 c0 = *(const f32x4*)cr, c1 = *(const f32x4*)(cr + 4), s0 = *(const f32x4*)(cr + 16), s1 = *(const f32x4*)(cr + 20);
                        f32x4 o0, o1;
#pragma unroll
                        for (int j = 0; j < 4; ++j) { const auto r0 = __builtin_amdgcn_permlane32_swap(__float_as_uint(v0[j]), __float_as_uint(v0[j]), false, false), r1 = __builtin_amdgcn_permlane32_swap(__float_as_uint(v1[j]), __float_as_uint(v1[j]), false, false);
                            const float ot0 = __uint_as_float(lane < 32 ? r0[1] : r0[0]), ot1 = __uint_as_float(lane < 32 ? r1[1] : r1[0]);
                            o0[j] = (lane < 32) ? (v0[j] * c0[j] - ot0 * s0[j]) : (ot0 * s0[j] + v0[j] * c0[j]);
                            o1[j] = (lane < 32) ? (v1[j] * c1[j] - ot1 * s1[j]) : (ot1 * s1[j] + v1[j] * c1[j]); }
                        v0 = o0; v1 = o1; }
                    if (zero) { v0 = (f32x4){0.f, 0.f, 0.f, 0.f}; v1 = v0; }
                    u32x4 w; w.x = cvt_pk_bf16(v0[0], v0[1]); w.y = cvt_pk_bf16(v0[2], v0[3]); w.z = cvt_pk_bf16(v1[0], v1[1]); w.w = cvt_pk_bf16(v1[2], v1[3]);
                    *(u32x4*)(O + (size_t)row * ldc + EPI_COL(bj)) = w; } }
    }
};
struct EpiRecIn {
    bf16_t* O; const float* bias;
    __device__ __forceinline__ void operator()(const Acc& acc, const Unit& u, int wr, int wc, int fr, int fq) const {
        const bool act = u.col0 < 1024;
        f32x4 bv[2][2];
#pragma unroll
        for (int bj = 0; bj < 2; ++bj)
#pragma unroll
            for (int n = 0; n < 2; ++n) bv[bj][n] = *(const f32x4*)(bias + EPI_COL(bj) + 4 * n);
#pragma unroll
        for (int ai = 0; ai < 2; ++ai)
#pragma unroll
            for (int m = 0; m < 4; ++m) { bf16_t* rowp = O + (size_t)EPI_ROW(ai, m) * 2048;
#pragma unroll
                for (int bj = 0; bj < 2; ++bj) { f32x4 v0 = acc[ai][bj][m][0] + bv[bj][0], v1 = acc[ai][bj][m][1] + bv[bj][1];
                    if (act) {
#pragma unroll
                        for (int j = 0; j < 4; ++j) { v0[j] = fgelu_tanh(v0[j]); v1[j] = fgelu_tanh(v1[j]); } }
                    u32x4 w; w.x = cvt_pk_bf16(v0[0], v0[1]); w.y = cvt_pk_bf16(v0[2], v0[3]); w.z = cvt_pk_bf16(v1[0], v1[1]); w.w = cvt_pk_bf16(v1[2], v1[3]);
                    *(u32x4*)(rowp + EPI_COL(bj)) = w; } }
    }
};
struct EpiSwiglu {
    unsigned char* ACT; const LAS float* btab; float ascale;
    __device__ __forceinline__ float sw(float g, float l) const { g = fminf(g, 7.f); l = fminf(fmaxf(l, -7.f), 7.f); return g * fsigmoid(1.702f * g) * (l + 1.f); }
    __device__ __forceinline__ void operator()(const Acc& acc, const Unit& u, int wr, int wc, int fr, int fq) const {
        f32x4 bv[2][2];
#pragma unroll
        for (int bj = 0; bj < 2; ++bj)
#pragma unroll
            for (int n = 0; n < 2; ++n) bv[bj][n] = *(const LAS f32x4*)(btab + u.pad * 256 + bj * HALF + wc * 32 + 8 * fq + 4 * n);
#pragma unroll
        for (int ai = 0; ai < 2; ++ai)
#pragma unroll
            for (int m = 0; m < 4; ++m) { unsigned char* rowp = ACT + (size_t)EPI_ROW(ai, m) * 1024;
#pragma unroll
                for (int bj = 0; bj < 2; ++bj) { const f32x4 v0 = acc[ai][bj][m][0] * ascale + bv[bj][0], v1 = acc[ai][bj][m][1] * ascale + bv[bj][1];
                    f32x4 g = (f32x4){fminf(v0[0], 7.f), fminf(v0[2], 7.f), fminf(v1[0], 7.f), fminf(v1[2], 7.f)};
                    const f32x4 lu = (f32x4){fminf(fmaxf(v0[1], -7.f), 7.f), fminf(fmaxf(v0[3], -7.f), 7.f), fminf(fmaxf(v1[1], -7.f), 7.f), fminf(fmaxf(v1[3], -7.f), 7.f)};
                    const f32x4 t = g * (-1.702f * 1.4426950408889634f);
                    const f32x4 d = (f32x4){fexp2(t[0]), fexp2(t[1]), fexp2(t[2]), fexp2(t[3])} + 1.f;
                    const f32x4 gs = g * (f32x4){frcp(d[0]), frcp(d[1]), frcp(d[2]), frcp(d[3])};
                    const f32x4 o = gs * lu + gs;
                    *(unsigned*)(rowp + (EPI_COL(bj) >> 1)) = pk4_fp8(o[0], o[1], o[2], o[3]); } }
    }
};
struct EpiResid {
    bf16_t* X; const float* g; const float* bias;
    __device__ __forceinline__ void operator()(const Acc& acc, const Unit& u, int wr, int wc, int fr, int fq) const {
        const int b = u.row0 / cfg::S;
        f32x4 bv[2][2], gv[2][2];
#pragma unroll
        for (int bj = 0; bj < 2; ++bj)
#pragma unroll
            for (int n = 0; n < 2; ++n) { bv[bj][n] = bias ? *(const f32x4*)(bias + EPI_COL(bj) + 4 * n) : (f32x4){0.f, 0.f, 0.f, 0.f}; gv[bj][n] = *(const f32x4*)(g + b * 6144 + EPI_COL(bj) + 4 * n); }
        u32x4 xw[2][4][2];
#pragma unroll
        for (int ai = 0; ai < 2; ++ai)
#pragma unroll
            for (int m = 0; m < 4; ++m)
#pragma unroll
                for (int bj = 0; bj < 2; ++bj) xw[ai][m][bj] = *(const u32x4*)(X + (size_t)EPI_ROW(ai, m) * 1024 + EPI_COL(bj));
        __builtin_amdgcn_sched_barrier(0);
#pragma unroll
        for (int ai = 0; ai < 2; ++ai)
#pragma unroll
            for (int m = 0; m < 4; ++m) { bf16_t* rowp = X + (size_t)EPI_ROW(ai, m) * 1024;
#pragma unroll
                for (int bj = 0; bj < 2; ++bj) { const u32x4 xv = xw[ai][m][bj];
                    const f32x4 x0 = (f32x4){bf_lo(xv.x), bf_hi(xv.x), bf_lo(xv.y), bf_hi(xv.y)} + gv[bj][0] * (acc[ai][bj][m][0] + bv[bj][0]);
                    const f32x4 x1 = (f32x4){bf_lo(xv.z), bf_hi(xv.z), bf_lo(xv.w), bf_hi(xv.w)} + gv[bj][1] * (acc[ai][bj][m][1] + bv[bj][1]);
                    u32x4 w; w.x = cvt_pk_bf16(x0[0], x0[1]); w.y = cvt_pk_bf16(x0[2], x0[3]); w.z = cvt_pk_bf16(x1[0], x1[1]); w.w = cvt_pk_bf16(x1[2], x1[3]); *(u32x4*)(rowp + EPI_COL(bj)) = w; } }
    }
};
struct EpiLru {
    const bf16_t* XC; const float* ba; const float* bx; const float* lam; bf16_t* LA; bf16_t* Bb;
    __device__ __forceinline__ void operator()(const Acc& acc, const Unit& u, int wr, int wc, int fr, int fq) const {
        const int ch0 = u.col0 + wc * 32 + 8 * fq;
#pragma unroll
        for (int n = 0; n < 2; ++n) { const int ch = ch0 + 4 * n;
            const f32x4 bav = *(const f32x4*)(ba + ch), bxv = *(const f32x4*)(bx + ch), spv = *(const f32x4*)(lam + ch);
#pragma unroll
            for (int ai = 0; ai < 2; ++ai)
#pragma unroll
                for (int m = 0; m < 4; ++m) { const size_t ro = (size_t)EPI_ROW(ai, m) * 1024 + ch;
                    const u32x2 xr = *(const u32x2*)(XC + ro);
                    const float xcv[4] = {bf_lo(xr.x), bf_hi(xr.x), bf_lo(xr.y), bf_hi(xr.y)};
                    float lav[4], bvv[4];
#pragma unroll
                    for (int j = 0; j < 4; ++j) { const float r = fsigmoid(acc[ai][0][m][n][j] + bav[j]), ig = fsigmoid(acc[ai][1][m][n][j] + bxv[j]);
                        const float la = r * spv[j], a = fexp2(la); lav[j] = la; bvv[j] = __builtin_amdgcn_sqrtf(fmaxf(1.f - a * a, 0.f)) * ig * xcv[j]; }
                    u32x2 wa, wb; wa.x = cvt_pk_bf16(lav[0], lav[1]); wa.y = cvt_pk_bf16(lav[2], lav[3]); wb.x = cvt_pk_bf16(bvv[0], bvv[1]); wb.y = cvt_pk_bf16(bvv[2], bvv[3]);
                    *(u32x2*)(LA + ro) = wa; *(u32x2*)(Bb + ro) = wb; asm volatile("" ::: "memory"); } }
    }
};

constexpr size_t MiB = (size_t)1 << 20;
constexpr size_t al4k(size_t x) { return (x + 4095) & ~(size_t)4095; }
constexpr int T_ = cfg::T, S_ = cfg::S, P_ = cfg::P;
constexpr size_t O_CTL = 0, SZ_CTL = 1 * MiB;
constexpr size_t O_MOD = O_CTL + SZ_CTL, SZ_MOD = al4k((size_t)4 * 4 * 6144 * 4);
constexpr size_t O_CS = O_MOD + SZ_MOD, SZ_CS = (size_t)T_ * 32 * 4;
constexpr size_t O_HIST = O_CS + SZ_CS, SZ_HIST = 256 * 32 * 4;
constexpr size_t O_TOPI = O_HIST + SZ_HIST, SZ_TOP = (size_t)T_ * 4 * 4;
constexpr size_t O_TOPG = O_TOPI + SZ_TOP, O_POS = O_TOPG + SZ_TOP;
constexpr size_t O_SUMP = O_POS + SZ_TOP, SZ_SUM = (size_t)4 * 64 * 1024 * 4;
constexpr size_t O_SUMH = O_SUMP + SZ_SUM;
constexpr size_t O_LSE = O_SUMH + SZ_SUM, SZ_LSE = (size_t)3 * T_ * 8 * 4;
constexpr size_t O_SPV = al4k(O_LSE + SZ_LSE), SZ_SPV = 2 * 1024 * 4;
constexpr size_t O_WIN = al4k(O_SPV + SZ_SPV), SZ_WIN = (size_t)2048 * 1024;
constexpr size_t O_WUQ = O_WIN + 2 * SZ_WIN, SZ_WUQ = (size_t)768 * 256 * 2;
constexpr size_t O_WUKV = O_WUQ + 2 * SZ_WUQ, SZ_WUKV = (size_t)1024 * 128 * 2;
constexpr size_t O_WOUT = O_WUKV + 2 * SZ_WUKV, SZ_WOUT = (size_t)1024 * 1024 * 2;
constexpr size_t O_RWIN = O_WOUT + 2 * SZ_WOUT, SZ_RWIN = (size_t)2048 * 1024 * 2;
constexpr size_t O_RGATE = O_RWIN + 2 * SZ_RWIN, SZ_RGATE = (size_t)8 * 256 * 128 * 2;
constexpr size_t O_RWOUT = O_RGATE + 2 * SZ_RGATE, SZ_RWOUT = (size_t)1024 * 1024 * 2;
constexpr size_t O_W1 = O_RWOUT + 2 * SZ_RWOUT, SZ_W1E = (size_t)2048 * 1024;
constexpr size_t O_W2 = O_W1 + 128 * SZ_W1E, SZ_W2E = (size_t)1024 * 1024;
constexpr size_t O_HN = O_W2 + 128 * SZ_W2E, SZ_HN = (size_t)T_ * 1024 * 2;
constexpr size_t O_PROJ = O_HN + SZ_HN, SZ_PROJ = (size_t)T_ * 2048 * 2;
constexpr size_t O_Q2 = O_PROJ + SZ_PROJ, SZ_Q2 = (size_t)T_ * 768 * 2;
constexpr size_t O_KV2 = O_Q2 + SZ_Q2, SZ_KV2 = (size_t)T_ * 1024 * 2;
constexpr size_t O_OA = O_KV2 + SZ_KV2, SZ_OA = (size_t)3 * T_ * 512 * 2;
constexpr size_t O_ATT = O_OA + SZ_OA, SZ_ATT = (size_t)T_ * 1024 * 2;
constexpr size_t O_XC = O_ATT + SZ_ATT, SZ_XC = (size_t)T_ * 1024 * 2;
constexpr size_t O_AA = O_XC + SZ_XC, SZ_AA = (size_t)T_ * 1024 * 4;
constexpr size_t O_BB = O_AA + SZ_AA;
constexpr size_t O_XG = O_BB + SZ_AA, SZ_XG = (size_t)P_ * 1024 * 2, O_INV = O_XG, O_POSJ = O_XG + 4 * MiB, O_RW = O_XG + 8 * MiB;
constexpr size_t O_ACT = O_XG + SZ_XG, O_Y2 = O_ACT + SZ_XG;
constexpr size_t O_X = O_Y2 + SZ_XG, SZ_X = (size_t)T_ * 1024 * 2;
constexpr size_t O_DUMMY = O_X + SZ_X, SZ_DUMMY = (size_t)96 * MiB;
constexpr size_t WS_MK_END = O_DUMMY + SZ_DUMMY;
constexpr size_t O_NAIVE = (size_t)2048 * MiB;
static_assert(WS_MK_END <= O_NAIVE, "mk workspace");
constexpr int CW_BAR = 4096;
constexpr size_t O_ECNT = O_CTL + 32 * 1024;
constexpr int RING_BYTES = 131072, LDSX_OFF = RING_BYTES;
constexpr int LDS_BYTES = 163840;
constexpr int LX_TILE = LDSX_OFF + 64, LX_MISC = LDSX_OFF + 2048, LX_EXCH = LDSX_OFF + 6144, LX_GTAB = LX_EXCH, GTAB_UNITS = 10, LX_BIAS = LDSX_OFF + 16384;

struct Args { const void* in[34]; float* out; unsigned char* ws; int ph_lo, ph_hi; };
struct Ctx { int tid, lane, wave, G, bid, vcu, gw, NGW; LAS unsigned char* lds; unsigned char* ws; };

__device__ __forceinline__ void conv_load(f32x4 (&v)[16], const float* __restrict__ W, int N, int n0, int k0, int lane) {
    const int n = n0 + 4 * (lane & 15); const float* p = W + (size_t)(k0 + 16 * (lane >> 4)) * N + n;
#pragma unroll
    for (int i = 0; i < 16; ++i) v[i] = (n < N) ? __builtin_nontemporal_load((const f32x4*)(p + (size_t)i * N)) : (f32x4){0.f, 0.f, 0.f, 0.f};
}
__device__ __forceinline__ int conv_row(int c, int perm) { if (perm == 1) { const int h = c / 96, d = c % 96; return d < 64 ? 64 * h + d : 512 + 32 * h + d - 64; } if (perm == 2) { const int h = c >> 7, d = c & 127; return d < 64 ? 64 * h + d : 512 + 64 * h + d - 64; } return c; }
__device__ __forceinline__ void conv_emit(const f32x4 (&v)[16], LAS unsigned char* T  , bf16_t* __restrict__ WT, int ldd, int n0, int k0, int lane, int perm) {
    const int kq = lane >> 4, c4 = lane & 15;
#pragma unroll
    for (int jj = 0; jj < 4; ++jj) { u32x4 lo, hi;
        lo.x = cvt_pk_bf16(v[0][jj], v[1][jj]); lo.y = cvt_pk_bf16(v[2][jj], v[3][jj]); lo.z = cvt_pk_bf16(v[4][jj], v[5][jj]); lo.w = cvt_pk_bf16(v[6][jj], v[7][jj]);
        hi.x = cvt_pk_bf16(v[8][jj], v[9][jj]); hi.y = cvt_pk_bf16(v[10][jj], v[11][jj]); hi.z = cvt_pk_bf16(v[12][jj], v[13][jj]); hi.w = cvt_pk_bf16(v[14][jj], v[15][jj]);
        LAS unsigned char* q = T + (4 * c4 + jj) * 144 + 32 * kq; *(LAS u32x4*)q = lo; *(LAS u32x4*)(q + 16) = hi; }
    asm volatile("s_waitcnt lgkmcnt(0)" ::: "memory");
#pragma unroll
    for (int s8 = 0; s8 < 8; ++s8) { const int n = 8 * s8 + (lane >> 3), ch = lane & 7; const u32x4 w = *(const LAS u32x4*)(T + n * 144 + 16 * ch);
        *(u32x4*)(WT + (size_t)conv_row(n0 + n, perm) * ldd + k0 + 8 * ch) = w; }
    asm volatile("s_waitcnt lgkmcnt(0)" ::: "memory");
}
__device__ __forceinline__ void conv8_tile(const float* __restrict__ W, int N, unsigned char* __restrict__ WT, int ldd, int n0, int k0, LAS unsigned char* T  , int lane) {
    const int kq = lane >> 4, c4 = lane & 15; const float* p = W + (size_t)(k0 + 32 * kq) * N + n0 + 4 * c4;
    f32x4 v[32];
#pragma unroll
    for (int i = 0; i < 32; ++i) v[i] = (n0 + 4 * c4 < N) ? __builtin_nontemporal_load((const f32x4*)(p + (size_t)i * N)) : (f32x4){0.f, 0.f, 0.f, 0.f};
#pragma unroll
    for (int jj = 0; jj < 4; ++jj) { u32x4 lo, hi;
        lo.x = pk4_fp8(32.f * v[0][jj], 32.f * v[1][jj], 32.f * v[2][jj], 32.f * v[3][jj]);     lo.y = pk4_fp8(32.f * v[4][jj], 32.f * v[5][jj], 32.f * v[6][jj], 32.f * v[7][jj]);
        lo.z = pk4_fp8(32.f * v[8][jj], 32.f * v[9][jj], 32.f * v[10][jj], 32.f * v[11][jj]);   lo.w = pk4_fp8(32.f * v[12][jj], 32.f * v[13][jj], 32.f * v[14][jj], 32.f * v[15][jj]);
        hi.x = pk4_fp8(32.f * v[16][jj], 32.f * v[17][jj], 32.f * v[18][jj], 32.f * v[19][jj]); hi.y = pk4_fp8(32.f * v[20][jj], 32.f * v[21][jj], 32.f * v[22][jj], 32.f * v[23][jj]);
        hi.z = pk4_fp8(32.f * v[24][jj], 32.f * v[25][jj], 32.f * v[26][jj], 32.f * v[27][jj]); hi.w = pk4_fp8(32.f * v[28][jj], 32.f * v[29][jj], 32.f * v[30][jj], 32.f * v[31][jj]);
        LAS unsigned char* q = T + (4 * c4 + jj) * 144 + 32 * kq; *(LAS u32x4*)q = lo; *(LAS u32x4*)(q + 16) = hi; }
    asm volatile("s_waitcnt lgkmcnt(0)" ::: "memory");
#pragma unroll
    for (int s8 = 0; s8 < 8; ++s8) { const int n = 8 * s8 + (lane >> 3), ch = lane & 7; const u32x4 w = *(const LAS u32x4*)(T + n * 144 + 16 * ch);
        *(u32x4*)(WT + (size_t)(n0 + n) * ldd + k0 + 16 * ch) = w; }
    asm volatile("s_waitcnt lgkmcnt(0)" ::: "memory");
}
__device__ __forceinline__ void split_bf16(const f32x4 a, const f32x4 b, bf16x8& hi, bf16x8& lo);
template <class AP> __device__ __forceinline__ void p0_prologue(const Ctx& C, AP a) {
    unsigned char* ws = C.ws;
    { const float* c = (const float*)a->in[1]; const float* ada_w = (const float*)a->in[3]; const float* ada_b = (const float*)a->in[4]; float* mod = (float*)(ws + O_MOD);
      LAS float* part = (LAS float*)C.lds;
      LAS float* cact = (LAS float*)(C.lds + 32768);
      if (C.bid < 4 * 24) { for (int i = C.tid; i < 4096; i += 512) { const int b = i >> 10, k = i & 1023; const float cv = c[i]; cact[k * 4 + b] = cv / (1.f + expf(-cv)); } __syncthreads(); }
      for (int it = C.bid; it < 4 * 24; it += C.G) { const int l = it / 24, n0 = (it % 24) * 256;
          f32x4 acc[4];
#pragma unroll
          for (int b = 0; b < 4; ++b) acc[b] = (f32x4){0.f, 0.f, 0.f, 0.f};
          const float* w = ada_w + (size_t)l * 1024 * 6144 + n0 + 4 * C.lane;
#pragma unroll 1
          for (int k0 = C.wave * 128; k0 < C.wave * 128 + 128; k0 += 16) { f32x4 wv[16];
#pragma unroll
              for (int i = 0; i < 16; ++i) wv[i] = __builtin_nontemporal_load((const f32x4*)(w + (size_t)(k0 + i) * 6144));
#pragma unroll
              for (int i = 0; i < 16; ++i) { const f32x4 sv = *(const LAS f32x4*)(cact + (k0 + i) * 4);
#pragma unroll
                  for (int b = 0; b < 4; ++b) acc[b] = acc[b] + sv[b] * wv[i]; } }
#pragma unroll
          for (int b = 0; b < 4; ++b) *(LAS f32x4*)(part + (C.wave * 4 + b) * 256 + 4 * C.lane) = acc[b];
          __syncthreads();
          for (int o = C.tid; o < 1024; o += 512) { const int b = o >> 8, n = o & 255; float sacc = ada_b[l * 6144 + n0 + n];
#pragma unroll
              for (int w8 = 0; w8 < 8; ++w8) sacc += part[(w8 * 4 + b) * 256 + n];
              mod[((size_t)l * 4 + b) * 6144 + n0 + n] = sacc; }
          __syncthreads(); } }
    { const float* wr_all = (const float*)a->in[28]; unsigned char* RW = ws + O_RW;
      for (int idx = ((C.G > 128) ? C.bid - 96 : C.bid) * 512 + C.tid; idx >= 0 && idx < 4 * 8 * 8 * 64; idx += ((C.G > 128) ? C.G - 96 : C.G) * 512) {     const int ln = idx & 63, f = (idx >> 6) & 7, vv = (idx >> 9) & 7, l = idx >> 12; const int nt = f >> 2, ks = f & 3, l15 = ln & 15, kg = ln >> 4;
          const float* p = wr_all + (size_t)l * 1024 * 32 + (size_t)(128 * vv + 32 * ks + 8 * kg) * 32 + 16 * nt + l15;
          bf16x8 hi, lo; split_bf16((f32x4){p[0], p[32], p[64], p[96]}, (f32x4){p[128], p[160], p[192], p[224]}, hi, lo);
          *(bf16x8*)(RW + (size_t)idx * 32) = hi; *(bf16x8*)(RW + (size_t)idx * 32 + 16) = lo; } }
    { const int* positions = (const int*)a->in[2]; float* cs = (float*)(ws + O_CS);
      for (int i = C.bid * 512 + C.tid; i < T_ * 16; i += C.G * 512) { const int t = i >> 4, f = i & 15; const float inv = powf(10000.f, -(float)(2 * f) / 32.f); const float ang = (float)positions[t] * inv;
          cs[t * 32 + f] = cosf(ang); cs[t * 32 + 16 + f] = sinf(ang); } }
    { const float* lam = (const float*)a->in[25]; float* spv = (float*)(ws + O_SPV);
      for (int i = C.bid * 512 + C.tid; i < 2048; i += C.G * 512) spv[i] = -8.f * 1.4426950408889634f * log1pf(expf(-lam[i])); }
    { const int lane = C.lane; LAS unsigned char* T = C.lds + 49152 + C.wave * 9216;
      const float* attn_w_in = (const float*)a->in[7]; const float* w_uq = (const float*)a->in[12]; const float* w_ukv = (const float*)a->in[13]; const float* attn_w_out = (const float*)a->in[16];
      const float* rec_w_in = (const float*)a->in[17]; const float* rec_wa = (const float*)a->in[21]; const float* rec_wx = (const float*)a->in[23]; const float* rec_w_out = (const float*)a->in[26];
      const float* w1 = (const float*)a->in[30]; const float* w2 = (const float*)a->in[32];
      constexpr int T_WIN = 32 * 16, T_WUQ = 12 * 4, T_WUKV = 16 * 2, T_WOUT = 16 * 16, T_RWIN = 32 * 16, T_RG = 2 * 2, T_RWOUT = 16 * 16, T_W1 = 32 * 16, T_W2 = 16 * 16;
      constexpr int NITEMS = 2 * (T_WUQ + T_WUKV + T_WOUT + T_RWIN + 16 * T_RG + T_RWOUT);
      struct Job { const float* W; bf16_t* WT; int N, ldd, n0, k0, perm; };
      auto decode = [&](int r, Job& jb) {
#define CONV_JOB(SRC, KK, NN, DST, NROWS, NMAT, SRC_MS, DST_MS, PERM) { constexpr int kc_ = (KK) / 64, per_ = ((NROWS) / 64) * kc_, tot_ = per_ * (NMAT); \
          if (r < tot_) { const int mat_ = r / per_, q_ = r % per_; jb.W = (SRC) + (size_t)mat_ * (SRC_MS); jb.WT = (bf16_t*)(ws + (DST) + (size_t)mat_ * (DST_MS)); jb.N = (NN); jb.ldd = (KK); jb.n0 = (q_ / kc_) * 64; jb.k0 = (q_ % kc_) * 64; jb.perm = (PERM); return; } r -= tot_; }
          CONV_JOB(w_uq, 256, 768, O_WUQ, 768, 2, (size_t)256 * 768, SZ_WUQ, 1)
          CONV_JOB(w_ukv, 128, 1024, O_WUKV, 1024, 2, (size_t)128 * 1024, SZ_WUKV, 2)
          CONV_JOB(attn_w_out, 1024, 1024, O_WOUT, 1024, 2, (size_t)1024 * 1024, SZ_WOUT, 0)
          CONV_JOB(rec_w_in, 1024, 2048, O_RWIN, 2048, 2, (size_t)1024 * 2048, SZ_RWIN, 0)
          CONV_JOB(rec_wa, 128, 128, O_RGATE, 128, 16, (size_t)128 * 128, (size_t)256 * 128 * 2, 0)
          CONV_JOB(rec_wx, 128, 128, O_RGATE + (size_t)128 * 128 * 2, 128, 16, (size_t)128 * 128, (size_t)256 * 128 * 2, 0)
          CONV_JOB(rec_w_out, 1024, 1024, O_RWOUT, 1024, 2, (size_t)1024 * 1024, SZ_RWOUT, 0)
#undef CONV_JOB
          jb.W = attn_w_out; jb.WT = (bf16_t*)(ws + O_WOUT); jb.N = 1024; jb.ldd = 1024; jb.n0 = 0; jb.k0 = 0; jb.perm = 0; };
      f32x4 va[16], vb[16]; Job ja, jn;
      const bool gv = C.G > 128; const int cgw = !gv ? C.gw : (C.bid < 96) ? ((C.wave < 4) ? C.bid * 4 + C.wave : (1 << 28)) : 384 + (C.bid - 96) * 8 + C.wave, cngw = !gv ? C.NGW : 384 + (C.G - 96) * 8;
      int it = cgw;
      if (it < NITEMS) { decode(it, ja); conv_load(va, ja.W, ja.N, ja.n0, ja.k0, lane); }
#pragma unroll 1
      for (; it < NITEMS; it += 2 * cngw) {
          const bool h1 = it + cngw < NITEMS;
          if (h1) { decode(it + cngw, jn); conv_load(vb, jn.W, jn.N, jn.n0, jn.k0, lane); }
          conv_emit(va, T, ja.WT, ja.ldd, ja.n0, ja.k0, lane, ja.perm);
          const bool h2 = it + 2 * cngw < NITEMS;
          if (h2) { decode(it + 2 * cngw, ja); conv_load(va, ja.W, ja.N, ja.n0, ja.k0, lane); }
          if (h1) conv_emit(vb, T, jn.WT, jn.ldd, jn.n0, jn.k0, lane, jn.perm);
      }
      { constexpr int IM = 32 * 8;
#pragma unroll 1
        for (int i8 = cgw; i8 < 2 * IM; i8 += cngw) { const int mat = i8 / IM, q = i8 % IM;
            conv8_tile(attn_w_in + (size_t)mat * 1024 * 1952, 1952, ws + O_WIN + (size_t)mat * SZ_WIN, 1024, (q >> 3) * 64, (q & 7) * 128, T, lane); } }
    }
}

__device__ __forceinline__ void phase_norm(const Ctx& C, const float* xin  , float* out  , bool combine, bool do_norm, const float* gain, const float* modc  , const float* modl  , int shoff, int scoff, bool dummy = false, bool f8 = false  ) {
    const unsigned char* Y8 = C.ws + O_Y2;     const int* pos = (const int*)(C.ws + O_POS); const float* topg = (const float*)(C.ws + O_TOPG); bf16_t* HN = (bf16_t*)(C.ws + (dummy ? O_DUMMY : O_HN)); const bf16_t* X = (const bf16_t*)(C.ws + O_X); bf16_t* Xo = (bf16_t*)(C.ws + (dummy ? O_DUMMY + 32 * MiB : O_X));
    const int lane = C.lane;
    f32x4 gsc[4], shv[4], g2v[4]; int bprev = -1;
    for (int t = C.gw; t < T_; t += C.NGW) { const int b = t / S_;
        if (b != bprev) { bprev = b;
#pragma unroll
            for (int j = 0; j < 4; ++j) { const int col = 256 * j + 4 * lane;
                if (do_norm) { gsc[j] = *(const f32x4*)(gain + col) * (1.f + *(const f32x4*)(modl + b * 6144 + scoff + col)); shv[j] = *(const f32x4*)(modl + b * 6144 + shoff + col); }
                if (combine) g2v[j] = *(const f32x4*)(modc + b * 6144 + 5120 + col); } }
        f32x4 v[4];
        if (xin) {
#pragma unroll
            for (int j = 0; j < 4; ++j) v[j] = __builtin_nontemporal_load((const f32x4*)(xin + (size_t)t * 1024 + 256 * j + 4 * lane)); }
        else {
#pragma unroll
            for (int j = 0; j < 4; ++j) { const u32x2 w = *(const u32x2*)(X + (size_t)t * 1024 + 256 * j + 4 * lane); v[j] = (f32x4){bf_lo(w.x), bf_hi(w.x), bf_lo(w.y), bf_hi(w.y)}; } }
        if (combine) { f32x4 y[4];
#pragma unroll
            for (int j = 0; j < 4; ++j) y[j] = (f32x4){0.f, 0.f, 0.f, 0.f};
            const u32x4 pp = *(const u32x4*)(pos + t * 4); const f32x4 gg = *(const f32x4*)(topg + t * 4) * (1.f / Y8_SCALE);
#pragma unroll
            for (int k = 0; k < 4; ++k) { const int p = (int)pp[k]; const float gk = gg[k];
#pragma unroll
                for (int j = 0; j < 4; ++j) { const unsigned w = *(const unsigned*)(Y8 + (size_t)p * 1024 + 256 * j + 4 * lane);
                    const f32x2 lo = __builtin_amdgcn_cvt_pk_f32_fp8((int)w, false), hi2 = __builtin_amdgcn_cvt_pk_f32_fp8((int)w, true);
                    y[j][0] += gk * lo[0]; y[j][1] += gk * lo[1]; y[j][2] += gk * hi2[0]; y[j][3] += gk * hi2[1]; } }
#pragma unroll
            for (int j = 0; j < 4; ++j) v[j] = v[j] + g2v[j] * y[j]; }
        if (out) {
#pragma unroll
            for (int j = 0; j < 4; ++j) __builtin_nontemporal_store(v[j], (f32x4*)(out + (size_t)t * 1024 + 256 * j + 4 * lane)); }
        else {
#pragma unroll
            for (int j = 0; j < 4; ++j) { u32x2 w; w.x = cvt_pk_bf16(v[j][0], v[j][1]); w.y = cvt_pk_bf16(v[j][2], v[j][3]); *(u32x2*)(Xo + (size_t)t * 1024 + 256 * j + 4 * lane) = w; } }
        if (do_norm) { float ss = 0.f;
#pragma unroll
            for (int j = 0; j < 4; ++j) ss += (v[j][0] * v[j][0] + v[j][1] * v[j][1]) + (v[j][2] * v[j][2] + v[j][3] * v[j][3]);
            const float rs = rsqrtf(wsum(ss) * (1.f / 1024.f) + 1e-6f);
#pragma unroll
            for (int j = 0; j < 4; ++j) { const int col = 256 * j + 4 * lane;
                const f32x4 h = v[j] * rs * gsc[j] + shv[j];
                if (f8) *(unsigned*)((unsigned char*)HN + (size_t)t * 1024 + col) = pk4_fp8(h[0], h[1], h[2], h[3]);
                else { u32x2 w; w.x = cvt_pk_bf16(h[0], h[1]); w.y = cvt_pk_bf16(h[2], h[3]); *(u32x2*)(HN + (size_t)t * 1024 + col) = w; } } }
    }
}

__device__ __forceinline__ void unpack8(const u32x4 w, float (&f)[8]) { f[0] = bf_lo(w.x); f[1] = bf_hi(w.x); f[2] = bf_lo(w.y); f[3] = bf_hi(w.y); f[4] = bf_lo(w.z); f[5] = bf_hi(w.z); f[6] = bf_lo(w.w); f[7] = bf_hi(w.w); }
__device__ __forceinline__ u32x4 pack8(const float (&f)[8]) { u32x4 w; w.x = cvt_pk_bf16(f[0], f[1]); w.y = cvt_pk_bf16(f[2], f[3]); w.z = cvt_pk_bf16(f[4], f[5]); w.w = cvt_pk_bf16(f[6], f[7]); return w; }

constexpr float LOG2E = 1.4426950408889634f;
__device__ __forceinline__ void phase_postproj(const Ctx& C, const float* qg, const float* kg, const float* qag, const float* kvag, const float* mkg) {
    bf16_t* PROJ = (bf16_t*)(C.ws + O_PROJ); const float* cs = (const float*)(C.ws + O_CS); const int lane = C.lane;
    for (int t = C.gw; t < T_; t += C.NGW) { bf16_t* row = PROJ + (size_t)t * 2048;
#pragma unroll
        for (int ps = 0; ps < 2; ++ps) { bf16_t* p = row + ps * 512 + 8 * lane; float f[8]; unpack8(*(const u32x4*)p, f); float ss = 0.f;
#pragma unroll
            for (int i = 0; i < 8; ++i) ss += f[i] * f[i];
            ss += shx<1>(ss); ss += shx<2>(ss); ss += shx<4>(ss);
            const float rs = rsqrtf(ss * (1.f / 64.f) + 1e-6f) * (ps == 0 ? 0.125f * LOG2E : 1.f); const float* g = (ps == 0 ? qg : kg) + 8 * (lane & 7);
#pragma unroll
            for (int i = 0; i < 8; ++i) f[i] = f[i] * rs * g[i];
            *(u32x4*)p = pack8(f); }
        { bf16_t* p = row + 1536 + 8 * lane; float f[8]; unpack8(*(const u32x4*)p, f); float ss = 0.f;
#pragma unroll
            for (int i = 0; i < 8; ++i) ss += f[i] * f[i];
            ss += shx<1>(ss); ss += shx<2>(ss);
            { const float o4 = shx<4>(ss); if (lane < 48) ss += o4; } { const float o8 = shx<8>(ss); if (lane < 48) ss += o8; } { const float o16 = shx<16>(ss); if (lane < 32) ss += o16; }
            const float nrm = lane < 32 ? 256.f : (lane < 48 ? 128.f : 32.f);
            const float rs = rsqrtf(ss / nrm + 1e-6f);
            const float* g = lane < 32 ? (qag + 8 * lane) : (lane < 48 ? (kvag + 8 * (lane - 32)) : (mkg + 64 + 8 * ((lane - 48) & 3)));
#pragma unroll
            for (int i = 0; i < 8; ++i) f[i] = f[i] * rs * g[i];
            float o[8];
#pragma unroll
            for (int i = 0; i < 8; ++i) { const float other = shx<2>(f[i]); const int fi = ((lane & 1) << 3) + i; const float cv = cs[t * 32 + fi], sv = cs[t * 32 + 16 + fi];
                o[i] = (lane & 2) ? (other * sv + f[i] * cv) : (f[i] * cv - other * sv); }
            if (lane >= 48 && lane < 52) {
#pragma unroll
                for (int i = 0; i < 8; ++i) f[i] = o[i]; }
            if (lane < 52) *(u32x4*)p = pack8(f); }
    }
}
__device__ __forceinline__ void phase_postq(const Ctx& C, const float* mqg, const float* mkg) {
    bf16_t* Q2 = (bf16_t*)(C.ws + O_Q2); bf16_t* KV2 = (bf16_t*)(C.ws + O_KV2); const float* cs = (const float*)(C.ws + O_CS); const int lane = C.lane;
    const float qscale = 0.10206207261596575f * LOG2E;
    for (int t = C.gw; t < T_; t += C.NGW) {
        { bf16_t* p = Q2 + (size_t)t * 768 + (lane >> 3) * 96 + 8 * (lane & 7); float f[8]; unpack8(*(const u32x4*)p, f); float ss = 0.f;
#pragma unroll
            for (int i = 0; i < 8; ++i) ss += f[i] * f[i];
            ss += shx<1>(ss); ss += shx<2>(ss); ss += shx<4>(ss);
            const float rs = rsqrtf(ss * (1.f / 64.f) + 1e-6f) * qscale; const float* g = mqg + 8 * (lane & 7);
#pragma unroll
            for (int i = 0; i < 8; ++i) f[i] = f[i] * rs * g[i];
            *(u32x4*)p = pack8(f); }
        { const int l2 = lane & 31; bf16_t* p = Q2 + (size_t)t * 768 + (l2 >> 2) * 96 + 64 + 8 * (l2 & 3); float f[8]; unpack8(*(const u32x4*)p, f); float ss = 0.f;
#pragma unroll
            for (int i = 0; i < 8; ++i) ss += f[i] * f[i];
            ss += shx<1>(ss); ss += shx<2>(ss);
            const float rs = rsqrtf(ss * (1.f / 32.f) + 1e-6f) * qscale; const float* g = mqg + 64 + 8 * (l2 & 3);
#pragma unroll
            for (int i = 0; i < 8; ++i) f[i] = f[i] * rs * g[i];
            float o[8];
#pragma unroll
            for (int i = 0; i < 8; ++i) { const float other = shx<2>(f[i]); const int fi = ((lane & 1) << 3) + i; const float cv = cs[t * 32 + fi], sv = cs[t * 32 + 16 + fi];
                o[i] = (lane & 2) ? (other * sv + f[i] * cv) : (f[i] * cv - other * sv); }
            if (lane < 32) *(u32x4*)p = pack8(o); }
        { bf16_t* p = KV2 + (size_t)t * 1024 + (lane >> 3) * 128 + 8 * (lane & 7); float f[8]; unpack8(*(const u32x4*)p, f); float ss = 0.f;
#pragma unroll
            for (int i = 0; i < 8; ++i) ss += f[i] * f[i];
            ss += shx<1>(ss); ss += shx<2>(ss); ss += shx<4>(ss);
            const float rs = rsqrtf(ss * (1.f / 64.f) + 1e-6f); const float* g = mkg + 8 * (lane & 7);
#pragma unroll
            for (int i = 0; i < 8; ++i) f[i] = f[i] * rs * g[i];
            *(u32x4*)p = pack8(f); }
    }
}
__device__ __forceinline__ void phase_mixcombine(const Ctx& C) {
    const bf16_t* OA = (const bf16_t*)(C.ws + O_OA); const float* LSE = (const float*)(C.ws + O_LSE); bf16_t* ATT = (bf16_t*)(C.ws + O_ATT); const int lane = C.lane;
    for (int t = C.gw; t < T_; t += C.NGW) { const int h = lane >> 3;
        float ls[3], mx = -INFINITY;
#pragma unroll
        for (int p = 0; p < 3; ++p) { ls[p] = LSE[((size_t)p * T_ + t) * 8 + h]; mx = fmaxf(mx, ls[p]); }
        float w[3], den = 0.f;
#pragma unroll
        for (int p = 0; p < 3; ++p) { w[p] = fexp2(ls[p] - mx); den += w[p]; }
        const float inv = 1.f / den; float o[8];
#pragma unroll
        for (int i = 0; i < 8; ++i) o[i] = 0.f;
#pragma unroll
        for (int p = 0; p < 3; ++p) { float f[8]; unpack8(*(const u32x4*)(OA + ((size_t)p * T_ + t) * 512 + 8 * lane), f); const float wp = w[p] * inv;
#pragma unroll
            for (int i = 0; i < 8; ++i) o[i] += wp * f[i]; }
        *(u32x4*)(ATT + (size_t)t * 1024 + 8 * lane) = pack8(o); }
}
__device__ __forceinline__ void phase_rgate(const Ctx& C, int j, const float* cw, const float* cb, const float* ba, const float* bx) {
    const bf16_t* PROJ = (const bf16_t*)(C.ws + O_PROJ); const bf16_t* RG = (const bf16_t*)(C.ws + O_RGATE + (size_t)j * SZ_RGATE); const float* spvg = (const float*)(C.ws + O_SPV) + j * 1024;
    bf16_t* LA = (bf16_t*)(C.ws + O_AA); bf16_t* Bb = (bf16_t*)(C.ws + O_BB); float* SP = (float*)(C.ws + O_SUMP); float* SH = (float*)(C.ws + O_SUMH);
    constexpr int WROW = 272;
    LAS unsigned char* Wl = C.lds;
    LAS unsigned char* Xl = C.lds + 256 * WROW;
    LAS unsigned char* Al = Xl + 64 * WROW;
    LAS unsigned char* Bl = Al + 64 * WROW;
    const int tid = C.tid, lane = C.lane, w = C.wave;
    if (C.G % 8 != 0) return;
    const int n = C.bid & 7, g = C.bid >> 3, ng = C.G >> 3;
    for (int i = tid; i < 256 * 16; i += 512) { const int r = i >> 4, c = i & 15; *(LAS u32x4*)(Wl + r * WROW + 16 * c) = *(const u32x4*)(RG + ((size_t)n * 256 + r) * 128 + 8 * c); }
    const int crow = tid >> 3, cg = tid & 7, cch = n * 128 + 16 * cg;
    float cwv[4][16], cbv[16];
#pragma unroll
    for (int q = 0; q < 4; ++q) { const f32x4 b4 = *(const f32x4*)(cb + cch + 4 * q); cbv[4 * q] = b4[0]; cbv[4 * q + 1] = b4[1]; cbv[4 * q + 2] = b4[2]; cbv[4 * q + 3] = b4[3];
#pragma unroll
        for (int k = 0; k < 4; ++k) { const f32x4 w4 = *(const f32x4*)(cw + k * 1024 + cch + 4 * q); cwv[k][4 * q] = w4[0]; cwv[k][4 * q + 1] = w4[1]; cwv[k][4 * q + 2] = w4[2]; cwv[k][4 * q + 3] = w4[3]; } }
    const int mt = w & 3, h = w >> 2, l15 = lane & 15, kg = lane >> 4;
    float bav[4], bxv[4], spv[4];
#pragma unroll
    for (int jj = 0; jj < 4; ++jj) { const int ch = n * 128 + 16 * (4 * h + jj) + l15; bav[jj] = ba[ch]; bxv[jj] = bx[ch]; spv[jj] = spvg[ch]; }
    __syncthreads();
    u32x4 xr[4][2];
    auto load_x = [&](int c) { const size_t row0 = (size_t)c * 64; const int ts0 = (int)(row0 % S_);
#pragma unroll
        for (int k = 0; k < 4; ++k) { const int dt = (ts0 + crow + k - 3 >= 0) ? k - 3 : 0; const bf16_t* src = PROJ + (row0 + crow + dt) * 2048 + 1024 + cch; xr[k][0] = *(const u32x4*)src; xr[k][1] = *(const u32x4*)(src + 8); } };
    load_x(g);
    for (int c = g; c < 256; c += ng) { const size_t row0 = (size_t)c * 64; const int ts0 = (int)(row0 % S_);
        { float acc[16];
#pragma unroll
          for (int i = 0; i < 16; ++i) acc[i] = cbv[i];
#pragma unroll
          for (int k = 0; k < 4; ++k) { const int dt = k - 3; const bool on = ts0 + crow + dt >= 0; float f0[8], f1[8]; unpack8(xr[k][0], f0); unpack8(xr[k][1], f1);
#pragma unroll
              for (int i = 0; i < 8; ++i) { acc[i] += on ? cwv[k][i] * f0[i] : 0.f; acc[8 + i] += on ? cwv[k][8 + i] * f1[i] : 0.f; } }
          float lo[8], hi8[8];
#pragma unroll
          for (int i = 0; i < 8; ++i) { lo[i] = acc[i]; hi8[i] = acc[8 + i]; }
          *(LAS u32x4*)(Xl + crow * WROW + 32 * cg) = pack8(lo); *(LAS u32x4*)(Xl + crow * WROW + 32 * cg + 16) = pack8(hi8); }
        load_x((c + ng < 256) ? c + ng : c);
        __builtin_amdgcn_sched_barrier(0);
        __syncthreads();
        f32x4 acc[8];
#pragma unroll
        for (int t = 0; t < 8; ++t) acc[t] = (f32x4){0.f, 0.f, 0.f, 0.f};
#pragma unroll
        for (int ks = 0; ks < 4; ++ks) { const bf16x8 af = *(const LAS bf16x8*)(Xl + (16 * mt + l15) * WROW + 64 * ks + 16 * kg);
#pragma unroll
            for (int t = 0; t < 8; ++t) { const int nt = (t < 4) ? (4 * h + t) : (8 + 4 * h + (t - 4)); const bf16x8 bfr = *(const LAS bf16x8*)(Wl + (16 * nt + l15) * WROW + 64 * ks + 16 * kg);
                acc[t] = __builtin_amdgcn_mfma_f32_16x16x32_bf16(af, bfr, acc[t], 0, 0, 0); } }
#pragma unroll
        for (int jj = 0; jj < 4; ++jj) { const int e = 16 * (4 * h + jj) + l15;
#pragma unroll
            for (int r = 0; r < 4; ++r) { const int row = 16 * mt + 4 * kg + r; const float xc = bf_lo((unsigned)*(const LAS unsigned short*)(Xl + row * WROW + 2 * e));
                const float rr = fsigmoid(acc[jj][r] + bav[jj]), ig = fsigmoid(acc[4 + jj][r] + bxv[jj]); const float la = rr * spv[jj], av = fexp2(la);
                const float bv = __builtin_amdgcn_sqrtf(fmaxf(1.f - av * av, 0.f)) * ig * xc;
                *(LAS unsigned short*)(Al + row * WROW + 2 * e) = (unsigned short)(cvt_pk_bf16(la, la) & 0xffffu); *(LAS unsigned short*)(Bl + row * WROW + 2 * e) = (unsigned short)(cvt_pk_bf16(bv, bv) & 0xffffu); } }
        __syncthreads();
        { const size_t go = (row0 + crow) * 1024 + cch;
          *(u32x4*)(LA + go) = *(const LAS u32x4*)(Al + crow * WROW + 32 * cg); *(u32x4*)(LA + go + 8) = *(const LAS u32x4*)(Al + crow * WROW + 32 * cg + 16);
          *(u32x4*)(Bb + go) = *(const LAS u32x4*)(Bl + crow * WROW + 32 * cg); *(u32x4*)(Bb + go + 8) = *(const LAS u32x4*)(Bl + crow * WROW + 32 * cg + 16); }
        if (tid < 128) { float Pl = 0.f, Hh = 0.f;
#pragma unroll 8
            for (int r = 0; r < 64; ++r) { const float la = bf_lo((unsigned)*(const LAS unsigned short*)(Al + r * WROW + 2 * tid)), bv = bf_lo((unsigned)*(const LAS unsigned short*)(Bl + r * WROW + 2 * tid)); Hh = fexp2(la) * Hh + bv; Pl += la; }
            const int b = (int)(row0 / S_), ck = (int)((row0 % S_) >> 6); SP[((size_t)b * 64 + ck) * 1024 + n * 128 + tid] = fexp2(Pl); SH[((size_t)b * 64 + ck) * 1024 + n * 128 + tid] = Hh; }
        __syncthreads();
    }
}

__device__ __forceinline__ void scan_sum_item(const Ctx& C, int b, int ck, int cg) {
    const bf16_t* LA = (const bf16_t*)(C.ws + O_AA); const bf16_t* Bb = (const bf16_t*)(C.ws + O_BB); float* SP = (float*)(C.ws + O_SUMP); float* SH = (float*)(C.ws + O_SUMH);
    const int ch = cg * 128 + 2 * C.lane;
    size_t off = ((size_t)b * S_ + ck * 64) * 1024 + ch; f32x2 Pl = (f32x2){0.f, 0.f}, Hh = (f32x2){0.f, 0.f};
#pragma unroll 8
    for (int s = 0; s < 64; ++s, off += 1024) { const unsigned lw = *(const unsigned*)(LA + off), bw = *(const unsigned*)(Bb + off);
        const f32x2 lv = (f32x2){bf_lo(lw), bf_hi(lw)}, av = (f32x2){fexp2(lv[0]), fexp2(lv[1])}, bv = (f32x2){bf_lo(bw), bf_hi(bw)}; Hh = av * Hh + bv; Pl = Pl + lv; }
    *(f32x2*)(SP + ((size_t)b * 64 + ck) * 1024 + ch) = (f32x2){fexp2(Pl[0]), fexp2(Pl[1])}; *(f32x2*)(SH + ((size_t)b * 64 + ck) * 1024 + ch) = Hh;
}
__device__ __forceinline__ void phase_scan_sum_own(const Ctx& C) {
    asm volatile("s_waitcnt vmcnt(0)" ::: "memory"); __syncthreads();
    for (int i = 0; ; ++i) { const int L = i * C.G + C.bid; if (L >= 512) break; const int pm = L >> 3, n = L & 7;
        if (C.wave < 4) { const int row0 = pm * 256 + C.wave * 64; scan_sum_item(C, row0 / S_, (row0 % S_) >> 6, n); } }
}
__device__ __forceinline__ void phase_scan_apply(const Ctx& C) {
    const bf16_t* LA = (const bf16_t*)(C.ws + O_AA); const bf16_t* Bb = (const bf16_t*)(C.ws + O_BB); const float* SP = (const float*)(C.ws + O_SUMP); const float* SH = (const float*)(C.ws + O_SUMH);
    const bf16_t* PROJ = (const bf16_t*)(C.ws + O_PROJ); bf16_t* ATT = (bf16_t*)(C.ws + O_ATT); const int lane = C.lane;
    for (int it = C.gw; it < 4 * 64 * 8; it += C.NGW) { const int cg = it & 7, ck = (it >> 3) & 63, b = it >> 9; const int ch = cg * 128 + 2 * lane;
        f32x2 h = (f32x2){0.f, 0.f};
        const float* sp = SP + (size_t)b * 64 * 1024 + ch; const float* sh = SH + (size_t)b * 64 * 1024 + ch;
#pragma unroll 1
        for (int c0 = 0; c0 < ck; c0 += 16) { f32x2 pv[16], hv[16];
#pragma unroll
            for (int u = 0; u < 16; ++u) { const int c2 = (c0 + u < ck) ? c0 + u : ck - 1; pv[u] = *(const f32x2*)(sp + (size_t)c2 * 1024); hv[u] = *(const f32x2*)(sh + (size_t)c2 * 1024); }
            __builtin_amdgcn_sched_barrier(0);
#pragma unroll
            for (int u = 0; u < 16; ++u) if (c0 + u < ck) h = pv[u] * h + hv[u]; }
        const size_t row0 = (size_t)b * S_ + ck * 64;
#pragma unroll 1
        for (int s0 = 0; s0 < 64; s0 += 16) { unsigned lw[16], bw[16], gw2[16];
#pragma unroll
            for (int u = 0; u < 16; ++u) { const size_t row = row0 + s0 + u; lw[u] = *(const unsigned*)(LA + row * 1024 + ch); bw[u] = *(const unsigned*)(Bb + row * 1024 + ch); gw2[u] = *(const unsigned*)(PROJ + row * 2048 + ch); }
            __builtin_amdgcn_sched_barrier(0);
#pragma unroll
            for (int u = 0; u < 16; ++u) { const f32x2 av = (f32x2){fexp2(bf_lo(lw[u])), fexp2(bf_hi(lw[u]))}, bv = (f32x2){bf_lo(bw[u]), bf_hi(bw[u])}; h = av * h + bv;
                *(unsigned*)(ATT + (row0 + s0 + u) * 1024 + ch) = cvt_pk_bf16(bf_lo(gw2[u]) * h[0], bf_hi(gw2[u]) * h[1]); } }
    }
}

__device__ __forceinline__ void split_bf16(const f32x4 a, const f32x4 b, bf16x8& hi, bf16x8& lo) {
    u32x4 h; h.x = cvt_pk_bf16(a[0], a[1]); h.y = cvt_pk_bf16(a[2], a[3]); h.z = cvt_pk_bf16(b[0], b[1]); h.w = cvt_pk_bf16(b[2], b[3]);
    u32x4 l; l.x = cvt_pk_bf16(a[0] - bf_lo(h.x), a[1] - bf_hi(h.x)); l.y = cvt_pk_bf16(a[2] - bf_lo(h.y), a[3] - bf_hi(h.y)); l.z = cvt_pk_bf16(b[0] - bf_lo(h.z), b[1] - bf_hi(h.z)); l.w = cvt_pk_bf16(b[2] - bf_lo(h.w), b[3] - bf_hi(h.w));
    hi = __builtin_bit_cast(bf16x8, h); lo = __builtin_bit_cast(bf16x8, l);
}
__device__ __forceinline__ void phase_router(const Ctx& C, const bf16_t* X, const float* gain, const float* modl, const float* wr, const float* br, int layer) {
    unsigned char* HN8 = C.ws + O_HN; int* topi = (int*)(C.ws + O_TOPI); float* topg = (float*)(C.ws + O_TOPG); int* ecnt = (int*)(C.ws + O_ECNT) + layer * 32; int* inv = (int*)(C.ws + O_INV); int* posj = (int*)(C.ws + O_POSJ);
    LAS int* rk = (LAS int*)(C.lds + LX_MISC + 3072); LAS int* base = (LAS int*)(C.lds + LX_MISC + 512);
    constexpr int HROW = 1028;
    LAS float* hrow = (LAS float*)C.lds;
    LAS float* part = (LAS float*)(C.lds + 16 * HROW * 4);
    LAS int* hl = (LAS int*)(C.lds + LX_MISC);
    const int lane = C.lane, e = lane & 31, kh = lane >> 5, v = C.wave, l15 = lane & 15, kg = lane >> 4;
    bf16x8 whi[2][4], wlo[2][4];
    { const unsigned char* rw = C.ws + O_RW + ((size_t)(layer * 8 + v) * 8 * 64 + lane) * 32;
#pragma unroll
      for (int nt = 0; nt < 2; ++nt)
#pragma unroll
          for (int ks = 0; ks < 4; ++ks) { whi[nt][ks] = *(const bf16x8*)(rw + (size_t)(nt * 4 + ks) * 64 * 32); wlo[nt][ks] = *(const bf16x8*)(rw + (size_t)(nt * 4 + ks) * 64 * 32 + 16); } }
    const float bias_e = br[e];
    if (C.tid < 32) hl[C.tid] = 0;
    __syncthreads();
    for (int ck = C.bid; ck < 256; ck += C.G) {
        const int b = (ck * 64) / S_;
        f32x4 gn[4], shv[4];
#pragma unroll
        for (int j = 0; j < 4; ++j) { const int col = 256 * j + 4 * lane; gn[j] = *(const f32x4*)(gain + col) * (1.f + *(const f32x4*)(modl + b * 6144 + 4096 + col)); shv[j] = *(const f32x4*)(modl + b * 6144 + 3072 + col); }
        u32x2 xr[2][4];
#pragma unroll
        for (int q = 0; q < 2; ++q)
#pragma unroll
            for (int j = 0; j < 4; ++j) xr[q][j] = *(const u32x2*)(X + (size_t)(ck * 64 + 2 * v + q) * 1024 + 256 * j + 4 * lane);
#pragma unroll 1
        for (int pass = 0; pass < 4; ++pass) { const int tb = ck * 64 + pass * 16;
#pragma unroll
            for (int q = 0; q < 2; ++q) { const int tt = 2 * v + q, t = tb + tt; f32x4 h[4]; float ss = 0.f;
#pragma unroll
                for (int j = 0; j < 4; ++j) { const u32x2 xw = xr[q][j]; h[j] = (f32x4){bf_lo(xw.x), bf_hi(xw.x), bf_lo(xw.y), bf_hi(xw.y)}; ss += (h[j][0] * h[j][0] + h[j][1] * h[j][1]) + (h[j][2] * h[j][2] + h[j][3] * h[j][3]); }
                const float rs = rsqrtf(wsum(ss) * (1.f / 1024.f) + 1e-6f);
#pragma unroll
                for (int j = 0; j < 4; ++j) { const int col = 256 * j + 4 * lane;
                    const f32x4 hv = h[j] * rs * gn[j] + shv[j];
                    *(unsigned*)(HN8 + (size_t)t * 1024 + col) = pk4_fp8(hv[0], hv[1], hv[2], hv[3]);
                    *(LAS f32x4*)(hrow + tt * HROW + col) = hv; } }
            if (pass < 3) {
#pragma unroll
                for (int q = 0; q < 2; ++q)
#pragma unroll
                    for (int j = 0; j < 4; ++j) xr[q][j] = *(const u32x2*)(X + (size_t)(tb + 16 + 2 * v + q) * 1024 + 256 * j + 4 * lane); }
            __syncthreads();
            { f32x4 acc0 = (f32x4){0.f, 0.f, 0.f, 0.f}, acc1 = acc0;
#pragma unroll
              for (int ks = 0; ks < 4; ++ks) { const LAS float* hp = hrow + l15 * HROW + 128 * v + 32 * ks + 8 * kg; bf16x8 ahi, alo; split_bf16(*(const LAS f32x4*)hp, *(const LAS f32x4*)(hp + 4), ahi, alo);
                  acc0 = __builtin_amdgcn_mfma_f32_16x16x32_bf16(ahi, whi[0][ks], acc0, 0, 0, 0); acc1 = __builtin_amdgcn_mfma_f32_16x16x32_bf16(ahi, whi[1][ks], acc1, 0, 0, 0);
                  acc0 = __builtin_amdgcn_mfma_f32_16x16x32_bf16(ahi, wlo[0][ks], acc0, 0, 0, 0); acc1 = __builtin_amdgcn_mfma_f32_16x16x32_bf16(ahi, wlo[1][ks], acc1, 0, 0, 0);
                  acc0 = __builtin_amdgcn_mfma_f32_16x16x32_bf16(alo, whi[0][ks], acc0, 0, 0, 0); acc1 = __builtin_amdgcn_mfma_f32_16x16x32_bf16(alo, whi[1][ks], acc1, 0, 0, 0); }
#pragma unroll
              for (int r = 0; r < 4; ++r) { part[((4 * kg + r) * 8 + v) * 32 + l15] = acc0[r]; part[((4 * kg + r) * 8 + v) * 32 + 16 + l15] = acc1[r]; } }
            __syncthreads();
            { const int tt = 2 * v + kh; float lg = bias_e;
#pragma unroll
              for (int w8 = 0; w8 < 8; ++w8) lg += part[(tt * 8 + w8) * 32 + e];
              float myv = 0.f, v0 = 0.f; int myi = 0;
#pragma unroll
              for (int k = 0; k < 4; ++k) { float mx = lg;
                  mx = rmax16(mx); mx = fmax_raw(mx, shx<16>(mx));
                  const unsigned long long bal = __ballot(lg == mx); const unsigned bh = (unsigned)(bal >> (32 * kh)); const int sel = __ffs((int)bh) - 1;
                  if (k == 0) v0 = mx;
                  if (e == k) { myv = mx; myi = sel; }
                  if (e == sel) lg = -INFINITY; }
              {
                const float ex = fexp2((myv - v0) * 1.4426950408889634f);
                float den = (e < 4) ? ex : 0.f; den += shx<1>(den); den += shx<2>(den);
                if (e < 4) { const int t = tb + tt; topi[t * 4 + e] = myi; topg[t * 4 + e] = ex * frcp(den);
                    const int r = __hip_atomic_fetch_add(hl + myi, 1, __ATOMIC_RELAXED, __HIP_MEMORY_SCOPE_WORKGROUP); rk[(pass * 16 + tt) * 4 + e] = (myi << 8) | r; } } }
        }
        __syncthreads();
        if (C.tid < 32) { base[C.tid] = __hip_atomic_fetch_add(ecnt + C.tid, hl[C.tid], __ATOMIC_RELAXED, __HIP_MEMORY_SCOPE_AGENT); hl[C.tid] = 0; }
        __syncthreads();
        if (C.tid < 256) { const int pk = rk[C.tid], ex = pk >> 8, j = base[ex] + (pk & 255); inv[ex * 16384 + j] = ck * 64 + (C.tid >> 2); posj[ck * 256 + C.tid] = j; }
        __syncthreads();
    }
}
__device__ __forceinline__ void moe_plan_lds(const Ctx& C, int layer) {
    const int* ecnt = (const int*)(C.ws + O_ECNT) + layer * 32;
    LAS int* tot = (LAS int*)(C.lds + LX_MISC + 256); LAS int* pst = tot + 32; LAS int* tile_e = (LAS int*)(C.lds + LX_TILE); LAS int* ntp = (LAS int*)(C.lds + LX_MISC + 128);
    __syncthreads();
    if (C.tid < 32) tot[C.tid] = __hip_atomic_load(ecnt + C.tid, __ATOMIC_RELAXED, __HIP_MEMORY_SCOPE_AGENT);
    __syncthreads();
    { const int e = C.tid & 31, sub = C.tid >> 5; int acc = 0;
#pragma unroll
      for (int x = 0; x < 32; x += 4) { const LAS int* tp = tot + x; const int t0 = tp[0], t1 = tp[1], t2 = tp[2], t3 = tp[3];
          acc += (x < e ? ((t0 + 255) & ~255) : 0) + (x + 1 < e ? ((t1 + 255) & ~255) : 0) + (x + 2 < e ? ((t2 + 255) & ~255) : 0) + (x + 3 < e ? ((t3 + 255) & ~255) : 0); }
      const int mine = (tot[e] + 255) >> 8, first = acc >> 8;
      if (sub == 0) { pst[e] = acc; if (e == 31) ntp[0] = first + mine; }
      for (int i = sub; i < mine; i += 16) tile_e[first + i] = e; }
    __syncthreads();
}
#ifndef ATT_DUP
#define ATT_DUP 1
#endif

__device__ __forceinline__ s16x4 tr16(LAS const unsigned char* p) { typedef short v4i16_t __attribute__((ext_vector_type(4))); return __builtin_bit_cast(s16x4, __builtin_amdgcn_ds_read_tr16_b64_v4i16((LAS v4i16_t*)p)); }

__device__ __forceinline__ float max3f(float a, float b, float c) { return fmaxf(fmaxf(a, b), c); }
#ifndef ATT_THR_V
#define ATT_THR_V 10.f
#endif
constexpr float ATT_THR = ATT_THR_V;
template <int KS, bool DIL>
__device__ __forceinline__ void att_tile(LAS const unsigned char* kb, LAS const unsigned char* vb, const bf16x8 (&qf)[KS], f32x16& o0, f32x16& o1, f32x16& negm, float& mref, float& l, int kidx0, int qidx, bool need_mask, int lane) {
    constexpr int KROW = KS * 32 + 16, VROW = 144;
    const int i32 = lane & 31, hi = lane >> 5;
    const int pr = (i32 & 0x13) | ((i32 & 4) << 1) | ((i32 & 8) >> 1);
    f32x16 p0, p1;
    LAS const unsigned char* kp = kb + pr * KROW + hi * 16;
#ifndef QK_DUP
#define QK_DUP 1
#endif
#pragma unroll 1
    for (int qd_ = 0; qd_ < QK_DUP; ++qd_) {
#pragma unroll
    for (int ks = 0; ks < KS; ++ks) {
        const bf16x8 k0f = *(LAS const bf16x8*)(kp + ks * 32), k1f = *(LAS const bf16x8*)(kp + 32 * KROW + ks * 32);
        if (ks == 0) { p0 = __builtin_amdgcn_mfma_f32_32x32x16_bf16(k0f, qf[0], negm, 0, 0, 0); p1 = __builtin_amdgcn_mfma_f32_32x32x16_bf16(k1f, qf[0], negm, 0, 0, 0); }
        else { p0 = __builtin_amdgcn_mfma_f32_32x32x16_bf16(k0f, qf[ks], p0, 0, 0, 0); p1 = __builtin_amdgcn_mfma_f32_32x32x16_bf16(k1f, qf[ks], p1, 0, 0, 0); }
    }
    asm volatile("" : "+v"(p0), "+v"(p1));
    }
    if (need_mask) {
#pragma unroll
        for (int r = 0; r < 16; ++r) { const int d0 = qidx - (kidx0 + 16 * (r >> 3) + 8 * hi + (r & 7)), d1 = d0 - 32;
            const bool v0 = DIL ? (d0 >= 0 && d0 <= 128) : (d0 >= 0), v1 = DIL ? (d1 >= 0 && d1 <= 128) : (d1 >= 0);
            p0[r] = v0 ? p0[r] : -INFINITY; p1[r] = v1 ? p1[r] : -INFINITY; } }
    float mx = max3f(p0[0], p0[1], p1[0]), mb = max3f(p0[2], p0[3], p1[1]); mx = max3f(mx, p1[2], p1[3]);
#pragma unroll
    for (int r = 4; r < 16; r += 4) { mx = max3f(mx, p0[r], p0[r + 1]); mb = max3f(mb, p0[r + 2], p0[r + 3]); mx = max3f(mx, p1[r], p1[r + 1]); mb = max3f(mb, p1[r + 2], p1[r + 3]); }
    mx = xmax32(fmaxf(mx, mb));
    if (__builtin_expect(__any(mx > ATT_THR), 0)) {
        const float dl = fmaxf(mx, 0.f), f = fexp2(-dl);
        mref += dl; l *= f;
#pragma unroll
        for (int r = 0; r < 16; ++r) { o0[r] *= f; o1[r] *= f; p0[r] -= dl; p1[r] -= dl; negm[r] = -mref; } }
    float ls0 = 0.f, ls1 = 0.f;
#pragma unroll
    for (int r = 0; r < 16; ++r) { p0[r] = fexp2(p0[r]); p1[r] = fexp2(p1[r]); ls0 += p0[r]; ls1 += p1[r]; }
    l += ls0 + ls1;
    u32x4 pw[2][2];
#pragma unroll
    for (int s = 0; s < 2; ++s) {
        pw[0][s].x = cvt_pk_bf16(p0[8 * s + 0], p0[8 * s + 1]); pw[0][s].y = cvt_pk_bf16(p0[8 * s + 2], p0[8 * s + 3]); pw[0][s].z = cvt_pk_bf16(p0[8 * s + 4], p0[8 * s + 5]); pw[0][s].w = cvt_pk_bf16(p0[8 * s + 6], p0[8 * s + 7]);
        pw[1][s].x = cvt_pk_bf16(p1[8 * s + 0], p1[8 * s + 1]); pw[1][s].y = cvt_pk_bf16(p1[8 * s + 2], p1[8 * s + 3]); pw[1][s].z = cvt_pk_bf16(p1[8 * s + 4], p1[8 * s + 5]); pw[1][s].w = cvt_pk_bf16(p1[8 * s + 6], p1[8 * s + 7]); }
    const int g = lane >> 4, i16 = lane & 15;
    LAS const unsigned char* vp = vb + (8 * (g >> 1) + (i16 >> 2)) * VROW + (16 * (g & 1) + 4 * (i16 & 3)) * 2;
#pragma unroll
    for (int sub = 0; sub < 2; ++sub)
#pragma unroll
        for (int s = 0; s < 2; ++s) { const bf16x8 pf = __builtin_bit_cast(bf16x8, pw[sub][s]);
#pragma unroll
            for (int db = 0; db < 2; ++db) { LAS const unsigned char* av = vp + (32 * sub + 16 * s) * VROW + 64 * db;
                const s16x4 lo = tr16(av), hh = tr16(av + 4 * VROW);
                const bf16x8 vf = (bf16x8){lo[0], lo[1], lo[2], lo[3], hh[0], hh[1], hh[2], hh[3]};
                if (db == 0) o0 = __builtin_amdgcn_mfma_f32_32x32x16_bf16(vf, pf, o0, 0, 0, 0); else o1 = __builtin_amdgcn_mfma_f32_32x32x16_bf16(vf, pf, o1, 0, 0, 0); } }
}
__device__ __forceinline__ void att_store(bf16_t* orow  , const f32x16& o0, const f32x16& o1, float inv, int hi) {
#pragma unroll
    for (int rr = 0; rr < 4; ++rr) { u32x2 w0, w1;
        w0.x = cvt_pk_bf16(o0[4 * rr] * inv, o0[4 * rr + 1] * inv); w0.y = cvt_pk_bf16(o0[4 * rr + 2] * inv, o0[4 * rr + 3] * inv);
        w1.x = cvt_pk_bf16(o1[4 * rr] * inv, o1[4 * rr + 1] * inv); w1.y = cvt_pk_bf16(o1[4 * rr + 2] * inv, o1[4 * rr + 3] * inv);
        *(u32x2*)(orow + 8 * rr + 4 * hi) = w0; *(u32x2*)(orow + 32 + 8 * rr + 4 * hi) = w1; }
}


struct BgConv {
    const float* w1; const float* w2; unsigned char* ws; LAS unsigned char* T;
    int pair, it, nit, step, sub;
    bool pendA, pendB; int psubA, psubB; unsigned char* pWTA; unsigned char* pWTB;
    f32x4 vA[4], vB[4];
};
__device__ __forceinline__ void bg_tile(const BgConv& S, int it, const float*& W, int& N, unsigned char*& WT, int& n0, int& k0) {
    constexpr int I1 = 32 * 8, I2 = 16 * 8, N1 = 64 * I1;
    if (it < N1) { const int mat = S.pair * 64 + it / I1, q = it % I1; W = S.w1 + (size_t)mat * 1024 * 2048; WT = S.ws + O_W1 + (size_t)mat * SZ_W1E; N = 2048; n0 = (q >> 3) * 64; k0 = (q & 7) * 128; }
    else { const int r = it - N1, mat = S.pair * 64 + r / I2, q = r % I2; W = S.w2 + (size_t)mat * 1024 * 1024; WT = S.ws + O_W2 + (size_t)mat * SZ_W2E; N = 1024; n0 = (q >> 3) * 64; k0 = (q & 7) * 128; }
}
__device__ __forceinline__ void bg_init(BgConv& S, const Ctx& C, const float* w1, const float* w2, int pair) {
    S.w1 = w1; S.w2 = w2; S.ws = C.ws; S.T = C.lds + 49152 + C.wave * 9216; S.pair = pair; S.it = C.gw; S.nit = 64 * 256 + 64 * 128; S.step = C.NGW; S.sub = 0;
    S.pendA = false; S.pendB = false; S.psubA = 0; S.psubB = 0; S.pWTA = C.ws; S.pWTB = C.ws;
}
__device__ __forceinline__ bool bg_done(const BgConv& S) { return !S.pendA && !S.pendB && S.it >= S.nit; }
__device__ __forceinline__ void bg_half(BgConv& S, f32x4 (&v)[4], bool& pend, int& psub, unsigned char*& pWT, int lane) {
    const int kq = lane >> 4, c4 = lane & 15;
    if (pend) {
#pragma unroll
        for (int jj = 0; jj < 4; ++jj) *(LAS unsigned*)(S.T + (4 * c4 + jj) * 144 + 32 * kq + 4 * psub) = pk4_fp8(32.f * v[0][jj], 32.f * v[1][jj], 32.f * v[2][jj], 32.f * v[3][jj]);
        if (psub == 7) {
            asm volatile("s_waitcnt lgkmcnt(0)" ::: "memory");
#pragma unroll
            for (int s8 = 0; s8 < 8; ++s8) { const int n = 8 * s8 + (lane >> 3), ch = lane & 7; const u32x4 w = *(const LAS u32x4*)(S.T + n * 144 + 16 * ch);
                *(u32x4*)(pWT + (size_t)n * 1024 + 16 * ch) = w; }
            asm volatile("s_waitcnt lgkmcnt(0)" ::: "memory"); }
        pend = false; }
    if (S.it < S.nit) { const float* W; int N, n0, k0; unsigned char* WT; bg_tile(S, S.nit - 1 - S.it, W, N, WT, n0, k0);
        const float* p = W + (size_t)(k0 + 32 * kq + 4 * S.sub) * N + n0 + 4 * c4;
#pragma unroll
        for (int i = 0; i < 4; ++i) v[i] = __builtin_nontemporal_load((const f32x4*)(p + (size_t)i * N));
        pend = true; psub = S.sub; pWT = WT + (size_t)n0 * 1024 + k0;
        if (++S.sub == 8) { S.sub = 0; S.it += S.step; } }
}
#define BG_STEP_A() bg_half(BG, BG.vA, BG.pendA, BG.psubA, BG.pWTA, lane)
#define BG_STEP_B() bg_half(BG, BG.vB, BG.pendB, BG.psubB, BG.pWTB, lane)

__device__ __forceinline__ void mla_unit(const Ctx& C, BgConv& BG, int b, int h, int qb) {
    constexpr int KROW = 208, VROW = 144, KB = 64 * KROW, BUF = KB + 64 * VROW;
    const bf16_t* Q2 = (const bf16_t*)(C.ws + O_Q2); const bf16_t* KV2 = (const bf16_t*)(C.ws + O_KV2); const bf16_t* PROJ = (const bf16_t*)(C.ws + O_PROJ); bf16_t* ATT = (bf16_t*)(C.ws + O_ATT);
    const int tid = C.tid, lane = C.lane, w = C.wave, i32 = lane & 31, hi = lane >> 5;
    const int q0 = qb * 256; const size_t rowb = (size_t)b * S_;
    bf16x8 qf[6];
    { const bf16_t* qrow = Q2 + (rowb + q0 + 32 * w + i32) * 768 + 8 * hi;
#pragma unroll
      for (int ks = 0; ks < 4; ++ks) qf[ks] = *(const bf16x8*)(qrow + h * 64 + 16 * ks);
      qf[4] = *(const bf16x8*)(qrow + 512 + h * 32); qf[5] = *(const bf16x8*)(qrow + 512 + h * 32 + 16); }
    f32x16 o0, o1;
#pragma unroll
    for (int r = 0; r < 16; ++r) { o0[r] = 0.f; o1[r] = 0.f; }
    float m = 0.f, l = 0.f; f32x16 negm;
#pragma unroll
    for (int r = 0; r < 16; ++r) negm[r] = 0.f;
    const int NT = 4 * qb + 4, wmax = 4 * qb + (w >> 1);
    const int r8 = tid >> 3, c8 = tid & 7, r4 = (tid & 255) >> 2, c4 = tid & 3;
    const bf16_t* knp = KV2 + (rowb + r8) * 1024 + h * 64 + 8 * c8; const bf16_t* kpp = PROJ + (rowb + r4) * 2048 + 1920 + 8 * c4;
    u32x4 kA, vA, pA, kB, vB, pB;
#define MLA_LOAD(j, K, V, P) do { const int jc_ = ((j) < NT) ? (j) : NT - 1; K = *(const u32x4*)(knp + (size_t)jc_ * 64 * 1024); V = *(const u32x4*)(knp + (size_t)jc_ * 64 * 1024 + 512); P = *(const u32x4*)(kpp + (size_t)jc_ * 64 * 2048); } while (0)
#define MLA_WRITE(bo, K, V, P) do { *(LAS u32x4*)(C.lds + (bo) + r8 * KROW + 16 * c8) = K; *(LAS u32x4*)(C.lds + (bo) + KB + r8 * VROW + 16 * c8) = V; *(LAS u32x4*)(C.lds + (bo) + r4 * KROW + 128 + 16 * c4) = P; } while (0)
#define MLA_STEP(j, KF, VF, PF, KN, VN, PN, BGS) do { const int j_ = (j); const int bo_ = (j_ & 1) * BUF; \
        MLA_LOAD(j_ + 2, KF, VF, PF); BGS(); \
        if (j_ <= wmax) { _Pragma("unroll 1") for (int dup_ = 0; dup_ < ATT_DUP; ++dup_) att_tile<6, false>(C.lds + bo_, C.lds + bo_ + KB, qf, o0, o1, negm, m, l, 64 * j_, q0 + 32 * w + i32, j_ == wmax, lane); } \
        MLA_WRITE(BUF - bo_, KN, VN, PN); \
        __syncthreads(); } while (0)
    MLA_LOAD(0, kA, vA, pA); MLA_LOAD(1, kB, vB, pB);
    MLA_WRITE(0, kA, vA, pA);
    __syncthreads();
#pragma unroll 1
    for (int j = 0; j < NT; j += 2) { MLA_STEP(j, kA, vA, pA, kB, vB, pB, BG_STEP_A); MLA_STEP(j + 1, kB, vB, pB, kA, vA, pA, BG_STEP_B); }
#undef MLA_STEP
#undef MLA_LOAD
#undef MLA_WRITE
    l = xadd32(l);
    att_store(ATT + (rowb + q0 + 32 * w + i32) * 1024 + 512 + h * 64, o0, o1, 1.f / l, hi);
}
__device__ __forceinline__ void dil_unit(const Ctx& C, BgConv& BG, int p, int dd, int b, int h, int res, int n) {
    constexpr int KROW = 144, VROW = 144, KB = 64 * KROW, BUF = KB + 64 * VROW;
    const bf16_t* PROJ = (const bf16_t*)(C.ws + O_PROJ); bf16_t* OA = (bf16_t*)(C.ws + O_OA) + (size_t)p * T_ * 512; float* LSE = (float*)(C.ws + O_LSE) + (size_t)p * T_ * 8;
    const int tid = C.tid, lane = C.lane, w = C.wave, i32 = lane & 31, hi = lane >> 5;
    const size_t rowb = (size_t)b * S_;
    const int qsub = 256 * n + 32 * w + i32; const size_t qtok = rowb + (size_t)qsub * dd + res;
    bf16x8 qf[4];
    { const bf16_t* qrow = PROJ + qtok * 2048 + h * 64 + 8 * hi;
#pragma unroll
      for (int ks = 0; ks < 4; ++ks) qf[ks] = *(const bf16x8*)(qrow + 16 * ks); }
    f32x16 o0, o1;
#pragma unroll
    for (int r = 0; r < 16; ++r) { o0[r] = 0.f; o1[r] = 0.f; }
    float m = 0.f, l = 0.f; f32x16 negm;
#pragma unroll
    for (int r = 0; r < 16; ++r) negm[r] = 0.f;
    const int jbeg = (n == 0) ? 2 : 0, wlo = w >> 1, whi = (32 * w + 159) >> 6;
    const int r8 = tid >> 3, c8 = tid & 7;
    u32x4 kA, vA, kB, vB;
    const int cnt = 6 - jbeg;
#define DIL_LOAD(i, K, V) do { const int jc_ = jbeg + (((i) < cnt) ? (i) : cnt - 1); const size_t tok = rowb + (size_t)(256 * n - 128 + 64 * jc_ + r8) * dd + res; const bf16_t* src = PROJ + tok * 2048 + 512 + h * 64 + 8 * c8; K = *(const u32x4*)src; V = *(const u32x4*)(src + 512); } while (0)
#define DIL_WRITE(bo, K, V) do { *(LAS u32x4*)(C.lds + (bo) + r8 * KROW + 16 * c8) = K; *(LAS u32x4*)(C.lds + (bo) + KB + r8 * VROW + 16 * c8) = V; } while (0)
#define DIL_STEP(i, KF, VF, KN, VN, BGS) do { const int i_ = (i); const int bo_ = (i_ & 1) * BUF, j_ = jbeg + i_; \
        DIL_LOAD(i_ + 2, KF, VF); BGS(); \
        if (i_ < cnt && j_ >= wlo && j_ <= whi) { const int kb0_ = 256 * n - 128 + 64 * j_, qlo_ = 256 * n + 32 * w; _Pragma("unroll 1") for (int dup_ = 0; dup_ < ATT_DUP; ++dup_) att_tile<4, true>(C.lds + bo_, C.lds + bo_ + KB, qf, o0, o1, negm, m, l, kb0_, qsub, !(kb0_ + 63 <= qlo_ && qlo_ + 31 - kb0_ <= 128), lane); } \
        DIL_WRITE(BUF - bo_, KN, VN); \
        __syncthreads(); } while (0)
    DIL_LOAD(0, kA, vA); DIL_LOAD(1, kB, vB);
    DIL_WRITE(0, kA, vA);
    __syncthreads();
    DIL_STEP(0, kA, vA, kB, vB, BG_STEP_A); DIL_STEP(1, kB, vB, kA, vA, BG_STEP_B); DIL_STEP(2, kA, vA, kB, vB, BG_STEP_A); DIL_STEP(3, kB, vB, kA, vA, BG_STEP_B);
    if (cnt == 6) { DIL_STEP(4, kA, vA, kB, vB, BG_STEP_A); DIL_STEP(5, kB, vB, kA, vA, BG_STEP_B); }
#undef DIL_STEP
#undef DIL_LOAD
#undef DIL_WRITE
    l = xadd32(l);
    att_store(OA + qtok * 512 + h * 64, o0, o1, 1.f / l, hi);
    if (hi == 0) LSE[qtok * 8 + h] = m + log2f(l);
}
#ifndef REP_MLA
#define REP_MLA 1
#endif
#ifndef REP_DIL
#define REP_DIL 1
#endif
__device__ __forceinline__ void phase_attention(const Ctx& C, const float* w1, const float* w2, int pair) {
    BgConv BG; bg_init(BG, C, w1, w2, pair);
#pragma unroll 1
    for (int rep = 0; rep < REP_MLA; ++rep) {
    if (C.G == 256) { const int bh = C.vcu >> 3, s = C.vcu & 7; mla_unit(C, BG, bh >> 3, bh & 7, s); mla_unit(C, BG, bh >> 3, bh & 7, 15 - s); }
    else for (int u = C.bid; u < 512; u += C.G) mla_unit(C, BG, u >> 7, (u >> 4) & 7, u & 15);
    }
#pragma unroll 1
    for (int rep = 0; rep < REP_DIL; ++rep)
    for (int u = C.bid; u < 1536; u += C.G) { const int p = u >> 9, rem = u & 511, b = rem >> 7, h = (rem >> 4) & 7, blk = rem & 15;
        const int dd = (p == 0) ? 1 : (p == 1) ? 4 : 16, bpr = 16 / dd;
        dil_unit(C, BG, p, dd, b, h, blk / bpr, blk % bpr); }
    { const int lane = C.lane;
#pragma unroll 1
      while (!bg_done(BG)) { BG_STEP_A(); BG_STEP_B(); } }
}
#undef BG_STEP_A
#undef BG_STEP_B

#ifdef TIME_NORM
constexpr int N_PHASES = 42;
#else
constexpr int N_PHASES = 36;
#endif
extern __shared__ __attribute__((aligned(16))) unsigned char lds_raw[];
typedef const __attribute__((address_space(4))) Args* ArgsP;
#define PHFN static __device__ __forceinline__ void
__device__ __forceinline__ ArgsP fresh_args() { unsigned long long p = (unsigned long long)__builtin_amdgcn_kernarg_segment_ptr(); asm volatile("" : "+s"(p)); return (ArgsP)p; }
__device__ __forceinline__ Ctx make_ctx(ArgsP ap, int wv) {
    Ctx C; C.lds = (LAS unsigned char*)lds_raw; C.ws = ap->ws;
    unsigned ones = ~0u; asm volatile("" : "+s"(ones)); const int lane = (int)__builtin_amdgcn_mbcnt_hi(ones, __builtin_amdgcn_mbcnt_lo(ones, 0u));
    int bid = blockIdx.x; asm volatile("" : "+s"(bid)); int G = gridDim.x; asm volatile("" : "+s"(G));
    C.wave = wv; C.lane = lane; C.tid = wv * 64 + lane;
    C.G = G; C.bid = bid; C.vcu = (C.G % 8 == 0) ? (C.bid % 8) * (C.G / 8) + C.bid / 8 : C.bid;
    C.gw = C.bid * 8 + C.wave; C.NGW = C.G * 8; return C;
}
#define IN(i) ((const float*)ap->in[i])
#define MODL(l) ((const float*)(C.ws + O_MOD) + (size_t)(l) * 4 * 6144)
PHFN ph_prologue(int wv) { const ArgsP ap = fresh_args(); const Ctx C = make_ctx(ap, wv); p0_prologue(C, ap); }
PHFN ph_norm(int wv, int l, int mode) { const ArgsP ap = fresh_args(); const Ctx C = make_ctx(ap, wv);
    if (mode == 0) phase_norm(C, IN(0), nullptr, false, true, IN(5), MODL(0), MODL(0), 0, 1024, false, true);
    else if (mode == 1) phase_norm(C, nullptr, nullptr, true, true, IN(5) + l * 1024, MODL(l - 1), MODL(l), 0, 1024, false, (l & 1) == 0);
    else if (mode == 3) phase_norm(C, nullptr, nullptr, true, true, IN(5) + l * 1024, MODL(l - 1), MODL(l), 0, 1024, true);
    else phase_norm(C, nullptr, ap->out, true, false, IN(5), MODL(3), MODL(3), 0, 1024); }
PHFN ph_proj(int wv, int j) { const ArgsP ap = fresh_args(); const Ctx C = make_ctx(ap, wv); unsigned char* ws = C.ws;
    DenseOrder S; S.init(ws + O_HN, ws + O_WIN + j * SZ_WIN, 1024, 1024, T_, 2048, C.G, C.bid, 1); EpiNorm<0> E{(bf16_t*)(ws + O_PROJ), 2048, IN(8) + j * 64, IN(9) + j * 64, IN(10) + j * 256, IN(11) + j * 128, IN(15) + j * 96 + 64, (const float*)(ws + O_CS), (LAS float*)(C.lds + LX_EXCH), 1.f / 32.f}; gemm_phase<true>(C, GemmDims{1024, 1024, 1024}, S, E); }
PHFN ph_postproj(int wv, int j) { const ArgsP ap = fresh_args(); const Ctx C = make_ctx(ap, wv); phase_postproj(C, IN(8) + j * 64, IN(9) + j * 64, IN(10) + j * 256, IN(11) + j * 128, IN(15) + j * 96); }
PHFN ph_qkv(int wv, int j) { const ArgsP ap = fresh_args(); const Ctx C = make_ctx(ap, wv); unsigned char* ws = C.ws;
    { DenseOrder S; S.init(ws + O_PROJ + 1536 * 2, ws + O_WUQ + j * SZ_WUQ, 2048, 256, T_, 768, C.G, C.bid); EpiNorm<1> E{(bf16_t*)(ws + O_Q2), 768, IN(14) + j * 96, IN(14) + j * 96 + 64, nullptr, nullptr, nullptr, (const float*)(ws + O_CS), (LAS float*)(C.lds + LX_EXCH), 1.f}; gemm_phase(C, GemmDims{256, 2048, 256}, S, E); }
    { const ArgsP ap2 = fresh_args(); const Ctx C = make_ctx(ap2, wv); unsigned char* ws = C.ws; DenseOrder S; S.init(ws + O_PROJ + 1792 * 2, ws + O_WUKV + j * SZ_WUKV, 2048, 128, T_, 1024, C.G, C.bid); EpiNorm<2> E{(bf16_t*)(ws + O_KV2), 1024, IN(15) + j * 96, nullptr, nullptr, nullptr, nullptr, (const float*)(ws + O_CS), (LAS float*)(C.lds + LX_EXCH), 1.f}; gemm_phase(C, GemmDims{128, 2048, 128}, S, E); } }
PHFN ph_postq(int wv, int j) { const ArgsP ap = fresh_args(); const Ctx C = make_ctx(ap, wv); phase_postq(C, IN(14) + j * 96, IN(15) + j * 96); }
PHFN ph_attention(int wv, int pair) { const ArgsP ap = fresh_args(); const Ctx C = make_ctx(ap, wv); phase_attention(C, IN(30), IN(32), pair); }
PHFN ph_mixcombine(int wv) { const ArgsP ap = fresh_args(); const Ctx C = make_ctx(ap, wv); phase_mixcombine(C); }
PHFN ph_outproj(int wv, int l, int which) { const ArgsP ap = fresh_args(); const Ctx C = make_ctx(ap, wv); unsigned char* ws = C.ws; const int j = l >> 1;
    DenseOrder S; S.init(ws + O_ATT, ws + (which ? O_RWOUT + j * SZ_RWOUT : O_WOUT + j * SZ_WOUT), 1024, 1024, T_, 1024, C.G, C.bid);
    EpiResid E{(bf16_t*)(ws + O_X), MODL(l) + 2048, which ? IN(27) + j * 1024 : nullptr}; gemm_phase(C, GemmDims{1024, 1024, 1024}, S, E); }
PHFN ph_router(int wv, int l) { const ArgsP ap = fresh_args(); const Ctx C = make_ctx(ap, wv); phase_router(C, (const bf16_t*)(C.ws + O_X), IN(6) + l * 1024, MODL(l), IN(28) + (size_t)l * 1024 * 32, IN(29) + l * 32, l); }
PHFN ph_moe1(int wv, int l) { const ArgsP ap = fresh_args(); const Ctx C = make_ctx(ap, wv); unsigned char* ws = C.ws; moe_plan_lds(C, l);
    MoeOrderT<true> S; S.A = (const char*)(ws + O_HN); S.WT = (const char*)(ws + O_W1 + (size_t)l * 32 * SZ_W1E); S.estride = SZ_W1E; S.tile_e = (const LAS int*)(C.lds + LX_TILE);
    S.NT = *(const LAS int*)(C.lds + LX_MISC + 128); S.nN = 8; S.G = C.G; S.c = C.bid; S.esz = 1; S.gtab = (const LAS int*)(C.lds + LX_GTAB);
    { const int* inv = (const int*)(ws + O_INV); LAS int* gt = (LAS int*)(C.lds + LX_GTAB); const LAS int* tot = (const LAS int*)(C.lds + LX_MISC + 256); const LAS int* pst = tot + 32;
      const int r = C.tid & 255, i0 = __builtin_amdgcn_readfirstlane(C.tid >> 8); int val[GTAB_UNITS / 2]; float bvl[GTAB_UNITS / 2]; const float* b1 = IN(31) + (size_t)l * 32 * 2048;
#pragma unroll
      for (int k = 0; k < GTAB_UNITS / 2; ++k) { Unit u; const bool ok = S.next(2 * k + i0, u); const int e = ok ? u.e : 0, j = (ok ? u.row0 - pst[e] : 0) + r; val[k] = (ok && j < tot[e]) ? inv[e * 16384 + j] : 0;
          bvl[k] = ok ? b1[(size_t)e * 2048 + u.col0 + r] : 0.f; }
      { const int* topi = (const int*)(ws + O_TOPI); const int* posj = (const int*)(ws + O_POSJ); int* pos = (int*)(ws + O_POS);
        for (int ck = C.bid; ck < 256; ck += C.G) if (C.tid < 256) pos[ck * 256 + C.tid] = pst[topi[ck * 256 + C.tid]] + posj[ck * 256 + C.tid]; }
#pragma unroll
      for (int k = 0; k < GTAB_UNITS / 2; ++k) { gt[(2 * k + i0) * 256 + r] = val[k]; ((LAS float*)(C.lds + LX_BIAS))[(2 * k + i0) * 256 + r] = bvl[k]; }
      __syncthreads(); }
    EpiSwiglu E{(unsigned char*)(ws + O_ACT), (const LAS float*)(C.lds + LX_BIAS), 1.f / 32.f}; gemm_phase<true>(C, GemmDims{1024, 1024, 1024}, S, E); }
PHFN ph_moe2(int wv, int l) { const ArgsP ap = fresh_args(); const Ctx C = make_ctx(ap, wv); unsigned char* ws = C.ws;
#if MODE != 1
    moe_plan_lds(C, l);
#endif

    MoeOrder S; S.A = (const char*)(ws + O_ACT); S.WT = (const char*)(ws + O_W2 + (size_t)l * 32 * SZ_W2E); S.estride = SZ_W2E; S.tile_e = (const LAS int*)(C.lds + LX_TILE);
    S.NT = *(const LAS int*)(C.lds + LX_MISC + 128); S.nN = 4; S.G = C.G; S.c = C.bid; S.esz = 1;
    { const float* b2 = IN(33) + (size_t)l * 32 * 1024; const int r = C.tid & 255, i0 = __builtin_amdgcn_readfirstlane(C.tid >> 8); float bvl[GTAB_UNITS / 2];
#pragma unroll
      for (int k = 0; k < GTAB_UNITS / 2; ++k) { Unit u; const bool ok = S.next(2 * k + i0, u); bvl[k] = ok ? b2[(size_t)u.e * 1024 + u.col0 + r] : 0.f; }
#pragma unroll
      for (int k = 0; k < GTAB_UNITS / 2; ++k) ((LAS float*)(C.lds + LX_BIAS))[(2 * k + i0) * 256 + r] = bvl[k];
      __syncthreads(); }
    EpiY8 E{ws + O_Y2, 1.f / 32.f, (const LAS float*)(C.lds + LX_BIAS)}; gemm_phase<true>(C, GemmDims{1024, 1024, 1024}, S, E); }
PHFN ph_recin(int wv, int j) { const ArgsP ap = fresh_args(); const Ctx C = make_ctx(ap, wv); unsigned char* ws = C.ws;
    DenseOrder S; S.init(ws + O_HN, ws + O_RWIN + j * SZ_RWIN, 1024, 1024, T_, 2048, C.G, C.bid); EpiRecIn E{(bf16_t*)(ws + O_PROJ), IN(18) + j * 2048}; gemm_phase(C, GemmDims{1024, 1024, 1024}, S, E); }
PHFN ph_rgate(int wv, int j) { const ArgsP ap = fresh_args(); const Ctx C = make_ctx(ap, wv); phase_rgate(C, j, IN(19) + j * 4096, IN(20) + j * 1024, IN(22) + j * 1024, IN(24) + j * 1024); }
PHFN ph_scan_apply(int wv) { const ArgsP ap = fresh_args(); const Ctx C = make_ctx(ap, wv); phase_scan_apply(C); }

#if MODE == 1
__device__ __forceinline__ int fresh_tid(int wv) { unsigned ones = ~0u; asm volatile("" : "+s"(ones)); return wv * 64 + (int)__builtin_amdgcn_mbcnt_hi(ones, __builtin_amdgcn_mbcnt_lo(ones, 0u)); }
__device__ __forceinline__ void grid_barrier(int wv) { const ArgsP q = fresh_args(); XcdBarrier b; b.bar = (unsigned*)(q->ws + O_CTL) + CW_BAR; b.x = xb_xcc_id(); b.st = (volatile LAS unsigned*)((LAS unsigned char*)lds_raw + LDSX_OFF); xcd_barrier(b, fresh_tid(wv)); }
__global__ void __launch_bounds__(512, 2) mk_fwd(Args a) {
    int wv = __builtin_amdgcn_readfirstlane(threadIdx.x >> 6); asm volatile("" : "+s"(wv));
    { LAS unsigned char* lds = (LAS unsigned char*)lds_raw;
      for (int u = threadIdx.x; u < (LDS_BYTES - LDSX_OFF) / 4; u += 512) ((LAS unsigned*)(lds + LDSX_OFF))[u] = 0u;
      __syncthreads();
      if (a.ph_hi - a.ph_lo > 1) (void)xcd_barrier_post((unsigned*)(a.ws + O_CTL) + CW_BAR, (volatile LAS unsigned*)(lds + LDSX_OFF), (int)threadIdx.x); }
    int pid = 0;
#define PHASE(call) { const ArgsP q_ = fresh_args(); const int lo_ = q_->ph_lo, hi_ = q_->ph_hi; if (pid >= lo_ && pid < hi_) { call; if (pid + 1 < hi_) grid_barrier(wv); } ++pid; }
#define PHASE_R(call, REP) { const ArgsP q_ = fresh_args(); const int lo_ = q_->ph_lo, hi_ = q_->ph_hi; if (pid >= lo_ && pid < hi_) { if ((REP) > 1) { call; grid_barrier(wv); } call; if (pid + 1 < hi_) grid_barrier(wv); } ++pid; }
#ifndef REP_PROLOGUE
#define REP_PROLOGUE 1
#endif
#ifndef REP_MOE
#define REP_MOE 1
#endif
#ifndef REP_ATTN
#define REP_ATTN 1
#endif
#ifndef REP_GEMMS
#define REP_GEMMS 1
#endif
#ifdef TIME_NORM
#define NORM_EXTRA(l) PHASE(ph_norm(wv, l, 3))
#else
#define NORM_EXTRA(l)
#endif
#ifndef REP_ELEM
#define REP_ELEM 1
#endif
#ifndef REP_ROUTER
#define REP_ROUTER REP_ELEM
#endif
#ifndef REP_SCATTER
#define REP_SCATTER REP_ELEM
#endif
#ifndef REP_MIX
#define REP_MIX REP_ELEM
#endif
#ifndef REP_CONV
#define REP_CONV REP_ELEM
#endif
#ifndef REP_SCANA
#define REP_SCANA REP_ELEM
#endif
#define MOE_PHASES(l) PHASE_R(ph_router(wv, l), REP_ROUTER) PHASE_R(ph_moe1(wv, l), REP_MOE) PHASE_R(ph_moe2(wv, l), REP_MOE)
    PHASE_R(ph_prologue(wv), REP_PROLOGUE)
#define LAYER_PAIR(lp) \
        { const int l = 2 * (lp);         \
          PHASE(ph_norm(wv, l, (lp) == 0 ? 0 : 1)) PHASE_R(ph_proj(wv, lp), REP_GEMMS) PHASE_R(ph_qkv(wv, lp), REP_GEMMS) PHASE_R(ph_attention(wv, lp), REP_ATTN) PHASE_R(ph_mixcombine(wv), REP_MIX) PHASE(ph_outproj(wv, l, 0)) \
          MOE_PHASES(l) } \
        { const int l = 2 * (lp) + 1;     \
          NORM_EXTRA(l) PHASE(ph_norm(wv, l, 1)) PHASE_R(ph_recin(wv, lp), REP_GEMMS) PHASE_R(ph_rgate(wv, lp), REP_CONV) PHASE_R(ph_scan_apply(wv), REP_SCANA) PHASE(ph_outproj(wv, l, 1)) \
          MOE_PHASES(l) }
    LAYER_PAIR(0)
    LAYER_PAIR(1)
#undef LAYER_PAIR
#ifdef EXTRA_BARRIERS
    { const ArgsP q_ = fresh_args(); if (q_->ph_hi - q_->ph_lo > 1) { _Pragma("unroll 1") for (int xb = 0; xb < EXTRA_BARRIERS; ++xb) grid_barrier(wv); } }
#endif
    PHASE(ph_norm(wv, 3, 2))
#undef PHASE
#undef PHASE_R
#undef MOE_PHASES
}
#else
template <int PH> __global__ void __launch_bounds__(512, 2) k_phase(Args a, int l, int x) {
    int wv = __builtin_amdgcn_readfirstlane(threadIdx.x >> 6); asm volatile("" : "+s"(wv));
    LAS unsigned char* lds = (LAS unsigned char*)lds_raw;
    for (int u = threadIdx.x; u < (LDS_BYTES - LDSX_OFF) / 4; u += 512) ((LAS unsigned*)(lds + LDSX_OFF))[u] = 0u;
    __syncthreads();
    if constexpr (PH == 0) ph_prologue(wv);
    if constexpr (PH == 1) ph_norm(wv, l, x);
    if constexpr (PH == 2) ph_proj(wv, l);
    if constexpr (PH == 4) ph_qkv(wv, l);
    if constexpr (PH == 6) ph_attention(wv, l);
    if constexpr (PH == 7) ph_mixcombine(wv);
    if constexpr (PH == 8) ph_outproj(wv, l, x);
    if constexpr (PH == 9) ph_router(wv, l);
    if constexpr (PH == 11) ph_moe1(wv, l);
    if constexpr (PH == 12) ph_moe2(wv, l);
    if constexpr (PH == 13) ph_recin(wv, l);
    if constexpr (PH == 14) ph_rgate(wv, l);
    if constexpr (PH == 17) ph_scan_apply(wv);
}
#endif
#undef IN
#undef MODL
}

#ifndef MODE
#define MODE 2
#endif
extern "C" void kernel_launch(void* const* d_in, const int* in_sizes, int n_in, void* d_out, int out_size, void* d_ws, size_t ws_size, hipStream_t stream) {
    (void)in_sizes; (void)n_in; (void)out_size; (void)ws_size;
#if MODE == 0
    nv::forward(d_in, (float*)d_out, d_ws, stream);
#else
    static int grid = 0;
    if (grid == 0) {
        int dev = 0, cus = 0;
        (void)hipGetDevice(&dev); (void)hipDeviceGetAttribute(&cus, hipDeviceAttributeMultiprocessorCount, dev);
#if MODE == 1
        (void)hipFuncSetAttribute((const void*)mk::mk_fwd, hipFuncAttributeMaxDynamicSharedMemorySize, mk::LDS_BYTES);
#else
#define SA(PH) (void)hipFuncSetAttribute((const void*)mk::k_phase<PH>, hipFuncAttributeMaxDynamicSharedMemorySize, mk::LDS_BYTES)
        SA(0); SA(1); SA(2); SA(4); SA(6); SA(7); SA(8); SA(9); SA(10); SA(11); SA(12); SA(13); SA(14); SA(17);
#undef SA
#endif
        grid = cus > 0 ? cus : 256;
    }
    (void)hipMemsetAsync((char*)d_ws + mk::O_CTL, 0, 64 * 1024, stream);
    mk::Args a;
    memset(&a, 0, sizeof(a));
    for (int i = 0; i < 34; ++i) a.in[i] = d_in[i];
    a.out = (float*)d_out; a.ws = (unsigned char*)d_ws;
#if MODE == 1
    a.ph_lo = 0; a.ph_hi = mk::N_PHASES;
    hipLaunchKernelGGL(mk::mk_fwd, dim3(grid), dim3(512), mk::LDS_BYTES, stream, a);
#else
#define LP(PH, l, x) hipLaunchKernelGGL(mk::k_phase<PH>, dim3(grid), dim3(512), mk::LDS_BYTES, stream, a, l, x)
    LP(0, 0, 0);
    for (int lp = 0; lp < 2; ++lp) {
        { const int l = 2 * lp; LP(1, l, lp == 0 ? 0 : 1); LP(2, lp, 0); LP(4, lp, 0); LP(6, lp, 0); LP(7, 0, 0); LP(8, l, 0); LP(9, l, 0); LP(10, 0, 0); LP(11, l, 0); LP(12, l, 0); }
        { const int l = 2 * lp + 1; LP(1, l, 1); LP(13, lp, 0); LP(14, lp, 0); LP(17, 0, 0); LP(8, l, 1); LP(9, l, 0); LP(10, 0, 0); LP(11, l, 0); LP(12, l, 0); }
    }
    LP(1, 3, 2);
#undef LP
#endif
#endif
}
```

```cpp
#define MODE 1

#include <string.h>
#include <hip/hip_runtime.h>
#include <stdint.h>
#include <math.h>

namespace cfg {
constexpr int D = 1024, NB = 4, S = 4096, T = NB * S, DEPTH = 4;
constexpr int MIXIN = 1952;
constexpr int NE = 32, TOPK = 4;
constexpr int MPAIR = T * TOPK;
constexpr int NBLK = MPAIR / 256 + NE;
constexpr int P = NBLK * 256;
}
using namespace cfg;


namespace mk {
#define LAS __attribute__((address_space(3)))
#define GAS __attribute__((address_space(1)))
typedef unsigned short bf16_t;
typedef short bf16x8 __attribute__((ext_vector_type(8)));
typedef short s16x4 __attribute__((ext_vector_type(4)));
typedef float f32x2 __attribute__((ext_vector_type(2)));
typedef float f32x4 __attribute__((ext_vector_type(4)));
typedef float f32x16 __attribute__((ext_vector_type(16)));
typedef unsigned u32x2 __attribute__((ext_vector_type(2)));
typedef unsigned u32x4 __attribute__((ext_vector_type(4)));
typedef GAS unsigned gu32;
#define RLX_AGENT __ATOMIC_RELAXED, __HIP_MEMORY_SCOPE_AGENT

__device__ __forceinline__ unsigned cvt_pk_bf16(float lo, float hi) { unsigned r; asm volatile("v_cvt_pk_bf16_f32 %0, %1, %2" : "=v"(r) : "v"(lo), "v"(hi)); return r; }
__device__ __forceinline__ float bf_lo(unsigned u) { return __uint_as_float(u << 16); }
__device__ __forceinline__ float bf_hi(unsigned u) { return __uint_as_float(u & 0xffff0000u); }
template <int O> __device__ __forceinline__ float shx(float v) { static_assert(O >= 1 && O < 32, "shx"); return __int_as_float(__builtin_amdgcn_ds_swizzle(__float_as_int(v), (O << 10) | 0x1f)); }
__device__ __forceinline__ float xadd32(float v) { const auto r = __builtin_amdgcn_permlane32_swap(__float_as_uint(v), __float_as_uint(v), false, false); return __uint_as_float(r[0]) + __uint_as_float(r[1]); }
__device__ __forceinline__ float xmax32(float v) { const auto r = __builtin_amdgcn_permlane32_swap(__float_as_uint(v), __float_as_uint(v), false, false); return fmaxf(__uint_as_float(r[0]), __uint_as_float(r[1])); }
#define DPP_STEP(OP, N) asm("s_nop 1\n\t" OP "_dpp %0, %1, %1 row_ror:" #N " row_mask:0xf bank_mask:0xf" : "=v"(r) : "v"(v)); v = r;
__device__ __forceinline__ float rsum16(float v) { float r; DPP_STEP("v_add_f32", 1) DPP_STEP("v_add_f32", 2) DPP_STEP("v_add_f32", 4) DPP_STEP("v_add_f32", 8) return v; }
__device__ __forceinline__ float rmax16(float v) { float r; DPP_STEP("v_max_f32", 1) DPP_STEP("v_max_f32", 2) DPP_STEP("v_max_f32", 4) DPP_STEP("v_max_f32", 8) return v; }
#undef DPP_STEP
__device__ __forceinline__ float fmax_raw(float a, float b) { float r; asm("v_max_f32 %0, %1, %2" : "=v"(r) : "v"(a), "v"(b)); return r; }
__device__ __forceinline__ float wsum(float v) { v = rsum16(v); v += shx<16>(v); return xadd32(v); }
__device__ __forceinline__ float fexp2(float x) { return __builtin_amdgcn_exp2f(x); }
__device__ __forceinline__ float frcp(float x) { return __builtin_amdgcn_rcpf(x); }
__device__ __forceinline__ float fsigmoid(float z) { return frcp(1.f + fexp2(-1.4426950408889634f * z)); }
__device__ __forceinline__ float fgelu_tanh(float x) { const float u = 0.7978845608028654f * (x + 0.044715f * x * x * x); return x * frcp(1.f + fexp2(-2.8853900817779268f * u)); }

#define XB_TMO      128
#define XB_XCNT(j)  (256  + 64 * (j))
#define XB_XSUB(j)  (1280 + 64 * (j))
#define XB_XGEN(j)  (2304 + 64 * (j))
#define XB_TOP      3328
#define XB_TOPGEN   3392
#define XCD_BAR_WORDS 3456
#define XB_SPIN_CAP (1u << 18)
__device__ __forceinline__ unsigned xb_ld(unsigned* p)              { return __hip_atomic_load(p, __ATOMIC_RELAXED, __HIP_MEMORY_SCOPE_AGENT); }
__device__ __forceinline__ unsigned xb_add(unsigned* p, unsigned v) { return __hip_atomic_fetch_add(p, v, __ATOMIC_RELAXED, __HIP_MEMORY_SCOPE_AGENT); }
__device__ __forceinline__ unsigned xb_xcc_id() { return (unsigned)__builtin_amdgcn_s_getreg((3 << 11) | 20) & 0xFu; }
#define XB_SPIN(cond, bar) do { unsigned _sp = 0; while (cond) { __builtin_amdgcn_s_sleep(1); \
    if ((++_sp & 255u) == 0u) { if (xb_ld(&(bar)[XB_TMO])) break; if (_sp > XB_SPIN_CAP) { atomicAdd(&(bar)[XB_TMO], 1u); break; } } } } while (0)
struct XcdBarrier { unsigned* bar; unsigned x; volatile LAS unsigned* st; };
__device__ __forceinline__ XcdBarrier xcd_barrier_post(unsigned* bar, volatile LAS unsigned* st, int tid) {
    XcdBarrier b; b.bar = bar; b.x = xb_xcc_id(); b.st = st;
    if (tid == 0) (void)xb_add(&bar[XB_XCNT(b.x)], 1u);
    return b;
}
__device__ __forceinline__ void xcd_barrier_complete(unsigned* bar, unsigned x, unsigned& nloc, unsigned& nx) {
    const unsigned G = gridDim.x * gridDim.y * gridDim.z;
    unsigned sum, cnt, mine, sp = 0u;
    for (;;) {
        sum = 0u; cnt = 0u; mine = 0u;
#pragma unroll
        for (unsigned j = 0; j < 16; ++j) { const unsigned c = xb_ld(&bar[XB_XCNT(j)]); sum += c; cnt += (c > 0u) ? 1u : 0u; mine = (j == x) ? c : mine; }
        if (sum == G) break;
        __builtin_amdgcn_s_sleep(1);
        if ((++sp & 255u) == 0u) { if (xb_ld(&bar[XB_TMO])) break; if (sp > XB_SPIN_CAP) { atomicAdd(&bar[XB_TMO], 1u); break; } }
    }
    nloc = mine > 0u ? mine : 1u; nx = cnt > 0u ? cnt : 1u;
}
__device__ __forceinline__ void xcd_barrier(const XcdBarrier& b, int tid) {
    asm volatile("s_waitcnt vmcnt(0)" ::: "memory");
    __syncthreads();
    if (tid == 0) {
        unsigned* bar = b.bar;
        __builtin_amdgcn_s_waitcnt(0);
        unsigned nloc = b.st[0], nx = b.st[1];
        if (nloc == 0u) { xcd_barrier_complete(bar, b.x, nloc, nx); b.st[0] = nloc; b.st[1] = nx; }
        const unsigned old = xb_add(&bar[XB_XSUB(b.x)], 1u);
        const unsigned gen = old / nloc;
        if (old + 1u == (gen + 1u) * nloc) {
            __builtin_amdgcn_fence(__ATOMIC_RELEASE, "agent");
            asm volatile("s_waitcnt vmcnt(0)" ::: "memory");
            const unsigned og = xb_add(&bar[XB_TOP], 1u);
            const unsigned tg = og / nx;
            if (og + 1u == (tg + 1u) * nx) xb_add(&bar[XB_TOPGEN], 1u);
            else XB_SPIN(xb_ld(&bar[XB_TOPGEN]) == tg, bar);
            __builtin_amdgcn_fence(__ATOMIC_ACQUIRE, "agent");
            xb_add(&bar[XB_XGEN(b.x)], 1u);
            asm volatile("s_waitcnt vmcnt(0)" ::: "memory");
        } else {
            XB_SPIN(xb_ld(&bar[XB_XGEN(b.x)]) == gen, bar);
            __builtin_amdgcn_fence(__ATOMIC_ACQUIRE, "agent");
            asm volatile("s_waitcnt vmcnt(0)" ::: "memory");
        }
    }
    __syncthreads();
}

constexpr int BM = 256, BK = 64, HALF = 128, HTB = HALF * BK * 2, STAGE_BYTES = 8 * HTB;
__host__ __device__ __forceinline__ int lds_byte(int r, int c) { const int st = (r >> 4) * 2 + (c >> 5), rr = r & 15, cc = c & 31, ob = rr * 64 + cc * 2; return st * 1024 + (ob ^ (((ob >> 9) & 1) << 5)); }
__host__ __device__ __forceinline__ void stage_rc(int b, int& R, int& C) { const int st = b / 1024, sb = b % 1024, swz = sb ^ (((sb >> 9) & 1) << 5); R = (st >> 1) * 16 + swz / 64; C = (st & 1) * 32 + (swz % 64) / 2; }
__host__ __device__ __forceinline__ int perm32(int rho) { const int n = rho >> 4, i = rho & 15; return 8 * (i >> 2) + 4 * n + (i & 3); }

struct Unit { const char* a; const char* b; int row0, col0, e, pad; };
struct GemmDims { int K, lda, ldb; };
typedef f32x4 Acc[2][2][4][2];
__device__ __forceinline__ void zero_acc(Acc& acc) {
#pragma unroll
    for (int a = 0; a < 2; ++a)
#pragma unroll
        for (int b = 0; b < 2; ++b)
#pragma unroll
            for (int m = 0; m < 4; ++m)
#pragma unroll
                for (int n = 0; n < 2; ++n)
                    { f32x2 z0, z1; asm volatile("v_mov_b64 %0, 0" : "=v"(z0)); asm volatile("v_mov_b64 %0, 0" : "=v"(z1)); acc[a][b][m][n] = (f32x4){z0[0], z0[1], z1[0], z1[1]}; }
}

typedef int v8i32 __attribute__((ext_vector_type(8)));
template <bool F8 = false, class CtxT, class Epi, class Sched>
__device__ __forceinline__ void gemm_phase(const CtxT& C, const GemmDims g, const Sched& S, const Epi& E) {
    LAS unsigned char* lds = C.lds;
    const int tid = C.tid, wid = __builtin_amdgcn_readfirstlane(tid >> 6), lane = tid & 63, wr = wid >> 2, wc = wid & 3, fr = lane & 15, fq = lane >> 4;
    constexpr int ESZ = F8 ? 1 : 2;
    constexpr bool GA = Sched::GATHER;
    int nt = g.K / (F8 ? 128 : BK); asm volatile("" : "+s"(nt));
    unsigned voffA[2], voffB[2];
#pragma unroll
    for (int i = 0; i < 2; ++i) { int R, C; stage_rc(tid * 16 + i * 8192, R, C); const int Rb = (R & ~31) + perm32(R & 31);
        voffA[i] = (unsigned)(R * g.lda * ESZ + C * 2); voffB[i] = (unsigned)(Rb * g.ldb * ESZ + C * 2); }
    unsigned voffG[2][2];
    auto load_goffs = [&](int uidx) { if constexpr (GA) { int R, Cc; stage_rc(tid * 16, R, Cc); const LAS int* tp = S.gtab + uidx * 256 + R;
#pragma unroll
        for (int h = 0; h < 2; ++h)
#pragma unroll
            for (int i = 0; i < 2; ++i) voffG[h][i] = (unsigned)tp[h * 128 + i * 64] * (unsigned)(g.lda * ESZ) + (unsigned)(Cc * 2); } };
    const size_t kstep = (size_t)(BK * 2);
    const size_t hstepA = (size_t)HALF * g.lda * ESZ, hstepB = (size_t)HALF * g.ldb * ESZ;
    const unsigned ldsw = (unsigned)wid * 1024u;
    const unsigned ldsu = (unsigned)__builtin_amdgcn_readfirstlane((int)(unsigned)(unsigned long long)(lds));
    const int aoff = lds_byte(wr * 64 + fr, fq * 8), boff = lds_byte(wc * 32 + fr, fq * 8);
#define PG8_SA(b, h) (((b) * 2 + (h)) * HTB)
#define PG8_SB(b, h) ((4 + (b) * 2 + (h)) * HTB)
#define PG8_STAGE(bufoff, gbase, voff) do { _Pragma("unroll") for (int _i = 0; _i < 2; ++_i) { \
        asm volatile("s_mov_b32 m0, %2\n\ts_nop 3\n\tglobal_load_lds_dwordx4 %0, %1" :: "v"((voff)[_i]), "s"((const char*)(gbase)), "s"(ldsu + (unsigned)(bufoff) + ldsw + (unsigned)(_i * 8192)) : "memory"); } } while (0)
#define PG8_STAGE_A(bufoff, gbase, h) do { if constexpr (GA) PG8_STAGE(bufoff, gbase, voffG[h]); else PG8_STAGE(bufoff, (gbase) + (h) * hstepA, voffA); } while (0)
#define PG8_LDA(dst, b, h) do { _Pragma("unroll") for (int m = 0; m < 4; ++m) _Pragma("unroll") for (int k = 0; k < 2; ++k) dst[m][k] = *(const LAS bf16x8*)(lds + PG8_SA(b, h) + aoff + m * 2048 + k * 1024); } while (0)
#define PG8_LDB(dst, b, h) do { _Pragma("unroll") for (int n = 0; n < 2; ++n) _Pragma("unroll") for (int k = 0; k < 2; ++k) dst[n][k] = *(const LAS bf16x8*)(lds + PG8_SB(b, h) + boff + n * 2048 + k * 1024); } while (0)
#define PG8_CAT(x) __builtin_bit_cast(v8i32, (x))
#define PG8_MMA(ai, bj, At, Bt) do { __builtin_amdgcn_s_setprio(1); \
        if constexpr (F8) { _Pragma("unroll") for (int m = 0; m < 4; ++m) _Pragma("unroll") for (int n = 0; n < 2; ++n) \
            acc[ai][bj][m][n] = __builtin_amdgcn_mfma_scale_f32_16x16x128_f8f6f4(PG8_CAT(Bt[n]), PG8_CAT(At[m]), acc[ai][bj][m][n], 0, 0, 0, 0, 0, 0); } \
        else { _Pragma("unroll") for (int m = 0; m < 4; ++m) _Pragma("unroll") for (int n = 0; n < 2; ++n) _Pragma("unroll") for (int k = 0; k < 2; ++k) \
            acc[ai][bj][m][n] = __builtin_amdgcn_mfma_f32_16x16x32_bf16(Bt[n][k], At[m][k], acc[ai][bj][m][n], 0, 0, 0); } \
        __builtin_amdgcn_s_setprio(0); } while (0)
#define PG8_WAIT_V(n) asm volatile("s_waitcnt vmcnt(" #n ")" ::: "memory")
#define PG8_WAIT_L(n) asm volatile("s_waitcnt lgkmcnt(" #n ")" ::: "memory")
#define PG8_BAR __builtin_amdgcn_s_barrier()
#define PG8_SCHED __builtin_amdgcn_sched_barrier(0)
    Unit cur, nxt; int ui = 0;
    if (!S.next(0, cur)) return;
    Acc acc; zero_acc(acc);
    struct Frag2 { bf16x8 p[2]; __device__ __forceinline__ bf16x8& operator[](int k) { return p[k]; } __device__ __forceinline__ const bf16x8& operator[](int k) const { return p[k]; } };
    Frag2 At[4], B0[2], B1[2];
    const char* cA = cur.a; const char* cB = cur.b;
    load_goffs(0);
    PG8_STAGE(PG8_SB(0, 0), cB, voffB); PG8_STAGE(PG8_SB(0, 1), cB + hstepB, voffB); PG8_STAGE_A(PG8_SA(0, 0), cA, 0); PG8_STAGE_A(PG8_SA(0, 1), cA, 1);
    if (wr == 1) PG8_BAR;
    PG8_WAIT_V(2); PG8_BAR;
    PG8_STAGE(PG8_SB(1, 0), cB + kstep, voffB); PG8_STAGE_A(PG8_SA(1, 0), cA + kstep, 0); PG8_STAGE(PG8_SB(1, 1), cB + hstepB + kstep, voffB);
    PG8_WAIT_V(6); PG8_BAR;
    for (;;) {
        const bool has_next = S.next(ui + 1, nxt);
        const char* nA = has_next ? nxt.a : cA; const char* nB = has_next ? nxt.b : cB;
        for (int t = 0; t < nt; t += 2) {
            const bool last = (t == nt - 2);
            const char* a1 = cA + (size_t)(t + 1) * kstep;
            const char* a2 = last ? nA : cA + (size_t)(t + 2) * kstep; const char* b2 = last ? nB : cB + (size_t)(t + 2) * kstep;
            const char* a3 = a2 + kstep; const char* b3 = b2 + kstep;
            PG8_LDB(B0, 0, 0); PG8_LDB(B1, 0, 1); PG8_SCHED; PG8_LDA(At, 0, 0); PG8_STAGE_A(PG8_SA(1, 1), a1, 1);
            if (GA && last && has_next) load_goffs(ui + 1);
            PG8_WAIT_V(8); PG8_WAIT_L(0); PG8_BAR; PG8_MMA(0, 0, At, B0); PG8_MMA(0, 1, At, B1); PG8_BAR; PG8_SCHED;
            PG8_LDA(At, 0, 1); PG8_STAGE(PG8_SB(0, 0), b2, voffB); PG8_STAGE(PG8_SB(0, 1), b2 + hstepB, voffB); PG8_STAGE_A(PG8_SA(0, 0), a2, 0);
            PG8_WAIT_V(8); PG8_WAIT_L(0); PG8_BAR; PG8_MMA(1, 0, At, B0); PG8_MMA(1, 1, At, B1); PG8_BAR; PG8_SCHED;
            PG8_LDB(B0, 1, 0); PG8_LDB(B1, 1, 1); PG8_SCHED; PG8_LDA(At, 1, 0); PG8_STAGE_A(PG8_SA(0, 1), a2, 1);
            PG8_WAIT_V(8); PG8_WAIT_L(0); PG8_BAR; PG8_MMA(0, 0, At, B0); PG8_MMA(0, 1, At, B1); PG8_BAR; PG8_SCHED;
            PG8_LDA(At, 1, 1); PG8_STAGE(PG8_SB(1, 0), b3, voffB); PG8_STAGE(PG8_SB(1, 1), b3 + hstepB, voffB); PG8_STAGE_A(PG8_SA(1, 0), a3, 0);
            PG8_WAIT_V(8); PG8_WAIT_L(0); PG8_BAR; PG8_MMA(1, 0, At, B0); PG8_MMA(1, 1, At, B1); PG8_BAR; PG8_SCHED;
        }
        if (wr == 0) PG8_BAR;
        E(acc, cur, wr, wc, fr, fq);
        if (!has_next) break;
        zero_acc(acc);
        cur = nxt; cA = nA; cB = nB; ++ui;
        if (wr == 1) PG8_BAR;
    }
    PG8_WAIT_V(0);
    PG8_BAR;
#undef PG8_SA
#undef PG8_SB
#undef PG8_STAGE
#undef PG8_STAGE_A
#undef PG8_LDA
#undef PG8_LDB
#undef PG8_MMA
#undef PG8_CAT
#undef PG8_WAIT_V
#undef PG8_WAIT_L
#undef PG8_BAR
#undef PG8_SCHED
}

struct DenseOrder {
    static constexpr bool GATHER = false;
    const char* A; const char* Bt; int lda, ldb, nM, nN, nwg, G, c, esz;
    __device__ __forceinline__ void init(const void* A_, const void* Bt_, int lda_, int ldb_, int M, int N, int G_, int c_, int esz_ = 2) { A = (const char*)A_; Bt = (const char*)Bt_; lda = lda_; ldb = ldb_; nM = M / BM; nN = N / BM; nwg = nM * nN; G = G_; c = c_; esz = esz_; }
    __device__ __forceinline__ bool next(int i, Unit& u) const {
        const long L = (long)i * G + c; if (L >= nwg) return false;
        int wgid = (int)L; { const int q = nwg / 8, r = nwg % 8, xcd = wgid % 8, off = wgid / 8; wgid = (xcd < r ? xcd * (q + 1) : r * (q + 1) + (xcd - r) * q) + off; }
        const int nig = 8 * nN, gid = wgid / nig, fm = gid * 8, gsz = (nM - fm) < 8 ? (nM - fm) : 8;
        const int pm = fm + ((wgid % nig) % gsz), pn = (wgid % nig) / gsz;
        u.a = A + (size_t)pm * BM * lda * esz; u.b = Bt + (size_t)pn * BM * ldb * esz; u.row0 = pm * BM; u.col0 = pn * BM; u.e = 0; u.pad = 0; return true;
    }
};
struct LruOrder {
    static constexpr bool GATHER = false;
    const char* XC; const char* RG; int G, c;
    __device__ __forceinline__ bool next(int i, Unit& u) const {
        const int L = i * G + c; if (L >= 512) return false;
        const int pm = L >> 3, n = L & 7;
        u.a = XC + ((size_t)pm * BM * 1024 + n * 128) * 2; u.b = RG + (size_t)n * 256 * 128 * 2; u.row0 = pm * BM; u.col0 = n * 128; u.e = n; u.pad = 0; return true;
    }
};
template <bool GATHER_ = false> struct MoeOrderT {
    static constexpr bool GATHER = GATHER_; const LAS int* gtab;
    const char* A; const char* WT; size_t estride; const LAS int* tile_e; int NT, nN, G, c, esz;
    __device__ __forceinline__ bool next(int i, Unit& u) const {
        int tile, pn;
#ifndef MOE_ORDER_ALT
#define MOE_ORDER_ALT 0
#endif
        if (!MOE_ORDER_ALT && (G % (8 * nN)) == 0) {
            const int tpr = (G / nN) >> 3, TPX = (NT + 7) >> 3, x = c & 7, k = i * tpr + (c >> 3) / nN;
            if (k >= TPX) return false;
            tile = x * TPX + k; pn = (c >> 3) % nN; }
        else { const int L = i * G + c; tile = L / nN; pn = L % nN; }
        if (tile >= NT) return false;
        const int e = __builtin_amdgcn_readfirstlane(tile_e[tile]);
        u.a = GATHER ? A : A + (size_t)tile * BM * 1024 * esz; u.b = WT + (size_t)e * estride + (size_t)pn * BM * 1024 * esz; u.row0 = tile * BM; u.col0 = pn * BM; u.e = e; u.pad = i; return true;
    }
};
typedef MoeOrderT<false> MoeOrder;

#define EPI_ROW(ai, m) (u.row0 + (ai) * HALF + wr * 64 + (m) * 16 + fr)
#define EPI_COL(bj) (u.col0 + (bj) * HALF + wc * 32 + 8 * fq)
struct EpiBf16 {
    bf16_t* O; const float* bias; int ldc, bias_es; float ascale; const LAS float* btab = nullptr;
    __device__ __forceinline__ void operator()(const Acc& acc, const Unit& u, int wr, int wc, int fr, int fq) const {
        f32x4 bv[2][2];
#pragma unroll
        for (int bj = 0; bj < 2; ++bj)
#pragma unroll
            for (int n = 0; n < 2; ++n) bv[bj][n] = btab ? *(const LAS f32x4*)(btab + u.pad * 256 + bj * HALF + wc * 32 + 8 * fq + 4 * n) : bias ? *(const f32x4*)(bias + (size_t)u.e * bias_es + EPI_COL(bj) + 4 * n) : (f32x4){0.f, 0.f, 0.f, 0.f};
#pragma unroll
        for (int ai = 0; ai < 2; ++ai)
#pragma unroll
            for (int m = 0; m < 4; ++m) { bf16_t* rowp = O + (size_t)EPI_ROW(ai, m) * ldc;
#pragma unroll
                for (int bj = 0; bj < 2; ++bj) { const f32x4 v0 = acc[ai][bj][m][0] * ascale + bv[bj][0], v1 = acc[ai][bj][m][1] * ascale + bv[bj][1];
                    u32x4 w; w.x = cvt_pk_bf16(v0[0], v0[1]); w.y = cvt_pk_bf16(v0[2], v0[3]); w.z = cvt_pk_bf16(v1[0], v1[1]); w.w = cvt_pk_bf16(v1[2], v1[3]);
                    *(u32x4*)(rowp + EPI_COL(bj)) = w; } }
    }
};
__device__ __forceinline__ unsigned pk4_fp8(float a, float b, float c, float d) { int w = 0; w = __builtin_amdgcn_cvt_pk_fp8_f32(a, b, w, false); w = __builtin_amdgcn_cvt_pk_fp8_f32(c, d, w, true); return (unsigned)w; }
constexpr float Y8_SCALE = 16.f;
struct EpiY8 {
    unsigned char* O; float ascale; const LAS float* btab;
    __device__ __forceinline__ void operator()(const Acc& acc, const Unit& u, int wr, int wc, int fr, int fq) const {
        f32x4 bv[2][2];
#pragma unroll
        for (int bj = 0; bj < 2; ++bj)
#pragma unroll
            for (int n = 0; n < 2; ++n) bv[bj][n] = *(const LAS f32x4*)(btab + u.pad * 256 + bj * HALF + wc * 32 + 8 * fq + 4 * n) * Y8_SCALE;
        const float as = ascale * Y8_SCALE;
#pragma unroll
        for (int ai = 0; ai < 2; ++ai)
#pragma unroll
            for (int m = 0; m < 4; ++m) { unsigned char* rowp = O + (size_t)EPI_ROW(ai, m) * 1024;
#pragma unroll
                for (int bj = 0; bj < 2; ++bj) { const f32x4 v0 = acc[ai][bj][m][0] * as + bv[bj][0], v1 = acc[ai][bj][m][1] * as + bv[bj][1];
                    u32x2 w; w.x = pk4_fp8(v0[0], v0[1], v0[2], v0[3]); w.y = pk4_fp8(v1[0], v1[1], v1[2], v1[3]);
                    *(u32x2*)(rowp + EPI_COL(bj)) = w; } }
    }
};
template <int KIND> struct EpiNorm {
    bf16_t* O; int ldc; const float* ga; const float* gb; const float* gc; const float* gd; const float* ge; const float* cs; LAS float* S; float ascale;
    __device__ __forceinline__ void operator()(const Acc& acc, const Unit& u, int wr, int wc, int fr, int fq) const {
        const int pn = u.col0 >> 8; const int lane = fr + 16 * fq; const float as2 = ascale * ascale;
        int mode = 0; const float* gp = ga; float scale = 1.f;
        if (KIND == 0) { if (pn < 2) { mode = 1; gp = ga; scale = 0.125f * 1.4426950408889634f; } else if (pn < 4) { mode = 1; gp = gb; } else if (pn < 6) mode = 0; else if (pn == 6) { mode = 2; gp = gc; } else { mode = 3; gp = gd; } }
        if (KIND == 1) { scale = 0.10206207261596575f * 1.4426950408889634f; if (pn < 2) { mode = 1; gp = ga; } else { mode = 4; gp = gb; } }
        if (KIND == 2) { if (pn < 2) { mode = 1; gp = ga; } else mode = 0; }
        if (mode != 0) {
#pragma unroll
            for (int ai = 0; ai < 2; ++ai)
#pragma unroll
                for (int m = 0; m < 4; ++m)
#pragma unroll
                    for (int bj = 0; bj < 2; ++bj) { const f32x4 a = acc[ai][bj][m][0], b = acc[ai][bj][m][1];
                        float s = (a[0] * a[0] + a[1] * a[1]) + (a[2] * a[2] + a[3] * a[3]) + (b[0] * b[0] + b[1] * b[1]) + (b[2] * b[2] + b[3] * b[3]);
                        s += shx<16>(s); s = xadd32(s);
                        if (fq == 0) S[(ai * HALF + wr * 64 + m * 16 + fr) * 8 + bj * 4 + wc] = s; }
            asm volatile("s_waitcnt lgkmcnt(0)" ::: "memory"); __builtin_amdgcn_s_barrier(); asm volatile("" ::: "memory");
        }
        const float inv_n = (mode == 1) ? (1.f / 64.f) : (mode == 2) ? (1.f / 256.f) : (1.f / 32.f);
        const bool rope_tile = (mode == 4) || (mode == 3);
#pragma unroll
        for (int bj = 0; bj < 2; ++bj) {
            f32x4 g0 = (f32x4){1.f, 1.f, 1.f, 1.f}, g1 = g0; bool rope = false, zero = false; float invn = inv_n;
            int c8 = 8 * fq; asm volatile("" : "+v"(c8));
            if (mode == 1) { const int c = 32 * (wc & 1) + c8; g0 = *(const f32x4*)(gp + c); g1 = *(const f32x4*)(gp + c + 4); }
            else if (mode == 2) { const int c = bj * HALF + wc * 32 + c8; g0 = *(const f32x4*)(gp + c); g1 = *(const f32x4*)(gp + c + 4); }
            else if (mode == 3) { if (bj == 0) { const int c = wc * 32 + c8; g0 = *(const f32x4*)(gp + c); g1 = *(const f32x4*)(gp + c + 4); invn = 1.f / 128.f; }
                                  else if (wc == 0) { g0 = *(const f32x4*)(ge + c8); g1 = *(const f32x4*)(ge + c8 + 4); rope = true; } else zero = true; }
            else if (mode == 4) { g0 = *(const f32x4*)(gp + c8); g1 = *(const f32x4*)(gp + c8 + 4); rope = true; }
            (void)rope_tile;
#pragma unroll
            for (int ai = 0; ai < 2; ++ai)
#pragma unroll
                for (int m = 0; m < 4; ++m) { const int row = EPI_ROW(ai, m);
                    f32x4 v0 = acc[ai][bj][m][0], v1 = acc[ai][bj][m][1];
                    if (mode != 0) { const LAS float* sr = S + (ai * HALF + wr * 64 + m * 16 + fr) * 8; float tot;
                        if (mode == 1) { const f32x2 t = *(const LAS f32x2*)(sr + bj * 4 + (wc & 2)); tot = t[0] + t[1]; }
                        else if (mode == 2) { const f32x4 t0 = *(const LAS f32x4*)sr, t1 = *(const LAS f32x4*)(sr + 4); tot = (t0[0] + t0[1]) + (t0[2] + t0[3]) + (t1[0] + t1[1]) + (t1[2] + t1[3]); }
                        else if (mode == 3 && bj == 0) { const f32x4 t0 = *(const LAS f32x4*)sr; tot = (t0[0] + t0[1]) + (t0[2] + t0[3]); }
                        else tot = sr[bj * 4 + wc];
                        const float rs = rsqrtf(tot * as2 * invn + 1e-6f) * scale * ascale; v0 = v0 * rs * g0; v1 = v1 * rs * g1; } else { v0 = v0 * ascale; v1 = v1 * ascale; }
                    if (rope) {
                        const float* cr = cs + (size_t)row * 32 + 8 * (fq & 1); const f32x4 c0 = *(const f32x4*)cr, c1 = *(const f32x4*)(cr + 4), s0 = *(const f32x4*)(cr + 16), s1 = *(const f32x4*)(cr + 20);
                        f32x4 o0, o1;
#pragma unroll
                        for (int j = 0; j < 4; ++j) { const auto r0 = __builtin_amdgcn_permlane32_swap(__float_as_uint(v0[j]), __float_as_uint(v0[j]), false, false), r1 = __builtin_amdgcn_permlane32_swap(__float_as_uint(v1[j]), __float_as_uint(v1[j]), false, false);
                            const float ot0 = __uint_as_float(lane < 32 ? r0[1] : r0[0]), ot1 = __uint_as_float(lane < 32 ? r1[1] : r1[0]);
                            o0[j] = (lane < 32) ? (v0[j] * c0[j] - ot0 * s0[j]) : (ot0 * s0[j] + v0[j] * c0[j]);
                            o1[j] = (lane < 32) ? (v1[j] * c1[j] - ot1 * s1[j]) : (ot1 * s1[j] + v1[j] * c1[j]); }
                        v0 = o0; v1 = o1; }
                    if (zero) { v0 = (f32x4){0.f, 0.f, 0.f, 0.f}; v1 = v0; }
                    u32x4 w; w.x = cvt_pk_bf16(v0[0], v0[1]); w.y = cvt_pk_bf16(v0[2], v0[3]); w.z = cvt_pk_bf16(v1[0], v1[1]); w.w = cvt_pk_bf16(v1[2], v1[3]);
                    *(u32x4*)(O + (size_t)row * ldc + EPI_COL(bj)) = w; } }
    }
};
struct EpiRecIn {
    bf16_t* O; const float* bias;
    __device__ __forceinline__ void operator()(const Acc& acc, const Unit& u, int wr, int wc, int fr, int fq) const {
        const bool act = u.col0 < 1024;
        f32x4 bv[2][2];
#pragma unroll
        for (int bj = 0; bj < 2; ++bj)
#pragma unroll
            for (int n = 0; n < 2; ++n) bv[bj][n] = *(const f32x4*)(bias + EPI_COL(bj) + 4 * n);
#pragma unroll
        for (int ai = 0; ai < 2; ++ai)
#pragma unroll
            for (int m = 0; m < 4; ++m) { bf16_t* rowp = O + (size_t)EPI_ROW(ai, m) * 2048;
#pragma unroll
                for (int bj = 0; bj < 2; ++bj) { f32x4 v0 = acc[ai][bj][m][0] + bv[bj][0], v1 = acc[ai][bj][m][1] + bv[bj][1];
                    if (act) {
#pragma unroll
                        for (int j = 0; j < 4; ++j) { v0[j] = fgelu_tanh(v0[j]); v1[j] = fgelu_tanh(v1[j]); } }
                    u32x4 w; w.x = cvt_pk_bf16(v0[0], v0[1]); w.y = cvt_pk_bf16(v0[2], v0[3]); w.z = cvt_pk_bf16(v1[0], v1[1]); w.w = cvt_pk_bf16(v1[2], v1[3]);
                    *(u32x4*)(rowp + EPI_COL(bj)) = w; } }
    }
};
struct EpiSwiglu {
    unsigned char* ACT; const LAS float* btab; float ascale;
    __device__ __forceinline__ float sw(float g, float l) const { g = fminf(g, 7.f); l = fminf(fmaxf(l, -7.f), 7.f); return g * fsigmoid(1.702f * g) * (l + 1.f); }
    __device__ __forceinline__ void operator()(const Acc& acc, const Unit& u, int wr, int wc, int fr, int fq) const {
        f32x4 bv[2][2];
#pragma unroll
        for (int bj = 0; bj < 2; ++bj)
#pragma unroll
            for (int n = 0; n < 2; ++n) bv[bj][n] = *(const LAS f32x4*)(btab + u.pad * 256 + bj * HALF + wc * 32 + 8 * fq + 4 * n);
#pragma unroll
        for (int ai = 0; ai < 2; ++ai)
#pragma unroll
            for (int m = 0; m < 4; ++m) { unsigned char* rowp = ACT + (size_t)EPI_ROW(ai, m) * 1024;
#pragma unroll
                for (int bj = 0; bj < 2; ++bj) { const f32x4 v0 = acc[ai][bj][m][0] * ascale + bv[bj][0], v1 = acc[ai][bj][m][1] * ascale + bv[bj][1];
                    f32x4 g = (f32x4){fminf(v0[0], 7.f), fminf(v0[2], 7.f), fminf(v1[0], 7.f), fminf(v1[2], 7.f)};
                    const f32x4 lu = (f32x4){fminf(fmaxf(v0[1], -7.f), 7.f), fminf(fmaxf(v0[3], -7.f), 7.f), fminf(fmaxf(v1[1], -7.f), 7.f), fminf(fmaxf(v1[3], -7.f), 7.f)};
                    const f32x4 t = g * (-1.702f * 1.4426950408889634f);
                    const f32x4 d = (f32x4){fexp2(t[0]), fexp2(t[1]), fexp2(t[2]), fexp2(t[3])} + 1.f;
                    const f32x4 gs = g * (f32x4){frcp(d[0]), frcp(d[1]), frcp(d[2]), frcp(d[3])};
                    const f32x4 o = gs * lu + gs;
                    *(unsigned*)(rowp + (EPI_COL(bj) >> 1)) = pk4_fp8(o[0], o[1], o[2], o[3]); } }
    }
};
struct EpiResid {
    bf16_t* X; const float* g; const float* bias;
    __device__ __forceinline__ void operator()(const Acc& acc, const Unit& u, int wr, int wc, int fr, int fq) const {
        const int b = u.row0 / cfg::S;
        f32x4 bv[2][2], gv[2][2];
#pragma unroll
        for (int bj = 0; bj < 2; ++bj)
#pragma unroll
            for (int n = 0; n < 2; ++n) { bv[bj][n] = bias ? *(const f32x4*)(bias + EPI_COL(bj) + 4 * n) : (f32x4){0.f, 0.f, 0.f, 0.f}; gv[bj][n] = *(const f32x4*)(g + b * 6144 + EPI_COL(bj) + 4 * n); }
        u32x4 xw[2][4][2];
#pragma unroll
        for (int ai = 0; ai < 2; ++ai)
#pragma unroll
            for (int m = 0; m < 4; ++m)
#pragma unroll
                for (int bj = 0; bj < 2; ++bj) xw[ai][m][bj] = *(const u32x4*)(X + (size_t)EPI_ROW(ai, m) * 1024 + EPI_COL(bj));
        __builtin_amdgcn_sched_barrier(0);
#pragma unroll
        for (int ai = 0; ai < 2; ++ai)
#pragma unroll
            for (int m = 0; m < 4; ++m) { bf16_t* rowp = X + (size_t)EPI_ROW(ai, m) * 1024;
#pragma unroll
                for (int bj = 0; bj < 2; ++bj) { const u32x4 xv = xw[ai][m][bj];
                    const f32x4 x0 = (f32x4){bf_lo(xv.x), bf_hi(xv.x), bf_lo(xv.y), bf_hi(xv.y)} + gv[bj][0] * (acc[ai][bj][m][0] + bv[bj][0]);
                    const f32x4 x1 = (f32x4){bf_lo(xv.z), bf_hi(xv.z), bf_lo(xv.w), bf_hi(xv.w)} + gv[bj][1] * (acc[ai][bj][m][1] + bv[bj][1]);
                    u32x4 w; w.x = cvt_pk_bf16(x0[0], x0[1]); w.y = cvt_pk_bf16(x0[2], x0[3]); w.z = cvt_pk_bf16(x1[0], x1[1]); w.w = cvt_pk_bf16(x1[2], x1[3]); *(u32x4*)(rowp + EPI_COL(bj)) = w; } }
    }
};
struct EpiLru {
    const bf16_t* XC; const float* ba; const float* bx; const float* lam; bf16_t* LA; bf16_t* Bb;
    __device__ __forceinline__ void operator()(const Acc& acc, const Unit& u, int wr, int wc, int fr, int fq) const {
        const int ch0 = u.col0 + wc * 32 + 8 * fq;
#pragma unroll
        for (int n = 0; n < 2; ++n) { const int ch = ch0 + 4 * n;
            const f32x4 bav = *(const f32x4*)(ba + ch), bxv = *(const f32x4*)(bx + ch), spv = *(const f32x4*)(lam + ch);
#pragma unroll
            for (int ai = 0; ai < 2; ++ai)
#pragma unroll
                for (int m = 0; m < 4; ++m) { const size_t ro = (size_t)EPI_ROW(ai, m) * 1024 + ch;
                    const u32x2 xr = *(const u32x2*)(XC + ro);
                    const float xcv[4] = {bf_lo(xr.x), bf_hi(xr.x), bf_lo(xr.y), bf_hi(xr.y)};
                    float lav[4], bvv[4];
#pragma unroll
                    for (int j = 0; j < 4; ++j) { const float r = fsigmoid(acc[ai][0][m][n][j] + bav[j]), ig = fsigmoid(acc[ai][1][m][n][j] + bxv[j]);
                        const float la = r * spv[j], a = fexp2(la); lav[j] = la; bvv[j] = __builtin_amdgcn_sqrtf(fmaxf(1.f - a * a, 0.f)) * ig * xcv[j]; }
                    u32x2 wa, wb; wa.x = cvt_pk_bf16(lav[0], lav[1]); wa.y = cvt_pk_bf16(lav[2], lav[3]); wb.x = cvt_pk_bf16(bvv[0], bvv[1]); wb.y = cvt_pk_bf16(bvv[2], bvv[3]);
                    *(u32x2*)(LA + ro) = wa; *(u32x2*)(Bb + ro) = wb; asm volatile("" ::: "memory"); } }
    }
};

constexpr size_t MiB = (size_t)1 << 20;
constexpr size_t al4k(size_t x) { return (x + 4095) & ~(size_t)4095; }
constexpr int T_ = cfg::T, S_ = cfg::S, P_ = cfg::P;
constexpr size_t O_CTL = 0, SZ_CTL = 1 * MiB;
constexpr size_t O_MOD = O_CTL + SZ_CTL, SZ_MOD = al4k((size_t)4 * 4 * 6144 * 4);
constexpr size_t O_CS = O_MOD + SZ_MOD, SZ_CS = (size_t)T_ * 32 * 4;
constexpr size_t O_HIST = O_CS + SZ_CS, SZ_HIST = 256 * 32 * 4;
constexpr size_t O_TOPI = O_HIST + SZ_HIST, SZ_TOP = (size_t)T_ * 4 * 4;
constexpr size_t O_TOPG = O_TOPI + SZ_TOP, O_POS = O_TOPG + SZ_TOP;
constexpr size_t O_SUMP = O_POS + SZ_TOP, SZ_SUM = (size_t)4 * 64 * 1024 * 4;
constexpr size_t O_SUMH = O_SUMP + SZ_SUM;
constexpr size_t O_LSE = O_SUMH + SZ_SUM, SZ_LSE = (size_t)3 * T_ * 8 * 4;
constexpr size_t O_SPV = al4k(O_LSE + SZ_LSE), SZ_SPV = 2 * 1024 * 4;
constexpr size_t O_WIN = al4k(O_SPV + SZ_SPV), SZ_WIN = (size_t)2048 * 1024;
constexpr size_t O_WUQ = O_WIN + 2 * SZ_WIN, SZ_WUQ = (size_t)768 * 256 * 2;
constexpr size_t O_WUKV = O_WUQ + 2 * SZ_WUQ, SZ_WUKV = (size_t)1024 * 128 * 2;
constexpr size_t O_WOUT = O_WUKV + 2 * SZ_WUKV, SZ_WOUT = (size_t)1024 * 1024 * 2;
constexpr size_t O_RWIN = O_WOUT + 2 * SZ_WOUT, SZ_RWIN = (size_t)2048 * 1024 * 2;
constexpr size_t O_RGATE = O_RWIN + 2 * SZ_RWIN, SZ_RGATE = (size_t)8 * 256 * 128 * 2;
constexpr size_t O_RWOUT = O_RGATE + 2 * SZ_RGATE, SZ_RWOUT = (size_t)1024 * 1024 * 2;
constexpr size_t O_W1 = O_RWOUT + 2 * SZ_RWOUT, SZ_W1E = (size_t)2048 * 1024;
constexpr size_t O_W2 = O_W1 + 128 * SZ_W1E, SZ_W2E = (size_t)1024 * 1024;
constexpr size_t O_HN = O_W2 + 128 * SZ_W2E, SZ_HN = (size_t)T_ * 1024 * 2;
constexpr size_t O_PROJ = O_HN + SZ_HN, SZ_PROJ = (size_t)T_ * 2048 * 2;
constexpr size_t O_Q2 = O_PROJ + SZ_PROJ, SZ_Q2 = (size_t)T_ * 768 * 2;
constexpr size_t O_KV2 = O_Q2 + SZ_Q2, SZ_KV2 = (size_t)T_ * 1024 * 2;
constexpr size_t O_OA = O_KV2 + SZ_KV2, SZ_OA = (size_t)3 * T_ * 512 * 2;
constexpr size_t O_ATT = O_OA + SZ_OA, SZ_ATT = (size_t)T_ * 1024 * 2;
constexpr size_t O_XC = O_ATT + SZ_ATT, SZ_XC = (size_t)T_ * 1024 * 2;
constexpr size_t O_AA = O_XC + SZ_XC, SZ_AA = (size_t)T_ * 1024 * 4;
constexpr size_t O_BB = O_AA + SZ_AA;
constexpr size_t O_XG = O_BB + SZ_AA, SZ_XG = (size_t)P_ * 1024 * 2, O_INV = O_XG, O_POSJ = O_XG + 4 * MiB, O_RW = O_XG + 8 * MiB;
constexpr size_t O_ACT = O_XG + SZ_XG, O_Y2 = O_ACT + SZ_XG;
constexpr size_t O_X = O_Y2 + SZ_XG, SZ_X = (size_t)T_ * 1024 * 2;
constexpr size_t O_DUMMY = O_X + SZ_X, SZ_DUMMY = (size_t)96 * MiB;
constexpr size_t WS_MK_END = O_DUMMY + SZ_DUMMY;
constexpr size_t O_NAIVE = (size_t)2048 * MiB;
static_assert(WS_MK_END <= O_NAIVE, "mk workspace");
constexpr int CW_BAR = 4096;
constexpr size_t O_ECNT = O_CTL + 32 * 1024;
constexpr int RING_BYTES = 131072, LDSX_OFF = RING_BYTES;
constexpr int LDS_BYTES = 163840;
constexpr int LX_TILE = LDSX_OFF + 64, LX_MISC = LDSX_OFF + 2048, LX_EXCH = LDSX_OFF + 6144, LX_GTAB = LX_EXCH, GTAB_UNITS = 10, LX_BIAS = LDSX_OFF + 16384;

struct Args { const void* in[34]; float* out; unsigned char* ws; int ph_lo, ph_hi; };
struct Ctx { int tid, lane, wave, G, bid, vcu, gw, NGW; LAS unsigned char* lds; unsigned char* ws; };

__device__ __forceinline__ void conv_load(f32x4 (&v)[16], const float* __restrict__ W, int N, int n0, int k0, int lane) {
    const int n = n0 + 4 * (lane & 15); const float* p = W + (size_t)(k0 + 16 * (lane >> 4)) * N + n;
#pragma unroll
    for (int i = 0; i < 16; ++i) v[i] = (n < N) ? __builtin_nontemporal_load((const f32x4*)(p + (size_t)i * N)) : (f32x4){0.f, 0.f, 0.f, 0.f};
}
__device__ __forceinline__ int conv_row(int c, int perm) { if (perm == 1) { const int h = c / 96, d = c % 96; return d < 64 ? 64 * h + d : 512 + 32 * h + d - 64; } if (perm == 2) { const int h = c >> 7, d = c & 127; return d < 64 ? 64 * h + d : 512 + 64 * h + d - 64; } return c; }
__device__ __forceinline__ void conv_emit(const f32x4 (&v)[16], LAS unsigned char* T  , bf16_t* __restrict__ WT, int ldd, int n0, int k0, int lane, int perm) {
    const int kq = lane >> 4, c4 = lane & 15;
#pragma unroll
    for (int jj = 0; jj < 4; ++jj) { u32x4 lo, hi;
        lo.x = cvt_pk_bf16(v[0][jj], v[1][jj]); lo.y = cvt_pk_bf16(v[2][jj], v[3][jj]); lo.z = cvt_pk_bf16(v[4][jj], v[5][jj]); lo.w = cvt_pk_bf16(v[6][jj], v[7][jj]);
        hi.x = cvt_pk_bf16(v[8][jj], v[9][jj]); hi.y = cvt_pk_bf16(v[10][jj], v[11][jj]); hi.z = cvt_pk_bf16(v[12][jj], v[13][jj]); hi.w = cvt_pk_bf16(v[14][jj], v[15][jj]);
        LAS unsigned char* q = T + (4 * c4 + jj) * 144 + 32 * kq; *(LAS u32x4*)q = lo; *(LAS u32x4*)(q + 16) = hi; }
    asm volatile("s_waitcnt lgkmcnt(0)" ::: "memory");
#pragma unroll
    for (int s8 = 0; s8 < 8; ++s8) { const int n = 8 * s8 + (lane >> 3), ch = lane & 7; const u32x4 w = *(const LAS u32x4*)(T + n * 144 + 16 * ch);
        *(u32x4*)(WT + (size_t)conv_row(n0 + n, perm) * ldd + k0 + 8 * ch) = w; }
    asm volatile("s_waitcnt lgkmcnt(0)" ::: "memory");
}
__device__ __forceinline__ void conv8_tile(const float* __restrict__ W, int N, unsigned char* __restrict__ WT, int ldd, int n0, int k0, LAS unsigned char* T  , int lane) {
    const int kq = lane >> 4, c4 = lane & 15; const float* p = W + (size_t)(k0 + 32 * kq) * N + n0 + 4 * c4;
    f32x4 v[32];
#pragma unroll
    for (int i = 0; i < 32; ++i) v[i] = (n0 + 4 * c4 < N) ? __builtin_nontemporal_load((const f32x4*)(p + (size_t)i * N)) : (f32x4){0.f, 0.f, 0.f, 0.f};
#pragma unroll
    for (int jj = 0; jj < 4; ++jj) { u32x4 lo, hi;
        lo.x = pk4_fp8(32.f * v[0][jj], 32.f * v[1][jj], 32.f * v[2][jj], 32.f * v[3][jj]);     lo.y = pk4_fp8(32.f * v[4][jj], 32.f * v[5][jj], 32.f * v[6][jj], 32.f * v[7][jj]);
        lo.z = pk4_fp8(32.f * v[8][jj], 32.f * v[9][jj], 32.f * v[10][jj], 32.f * v[11][jj]);   lo.w = pk4_fp8(32.f * v[12][jj], 32.f * v[13][jj], 32.f * v[14][jj], 32.f * v[15][jj]);
        hi.x = pk4_fp8(32.f * v[16][jj], 32.f * v[17][jj], 32.f * v[18][jj], 32.f * v[19][jj]); hi.y = pk4_fp8(32.f * v[20][jj], 32.f * v[21][jj], 32.f * v[22][jj], 32.f * v[23][jj]);
        hi.z = pk4_fp8(32.f * v[24][jj], 32.f * v[25][jj], 32.f * v[26][jj], 32.f * v[27][jj]); hi.w = pk4_fp8(32.f * v[28][jj], 32.f * v[29][jj], 32.f * v[30][jj], 32.f * v[31][jj]);
        LAS unsigned char* q = T + (4 * c4 + jj) * 144 + 32 * kq; *(LAS u32x4*)q = lo; *(LAS u32x4*)(q + 16) = hi; }
    asm volatile("s_waitcnt lgkmcnt(0)" ::: "memory");
#pragma unroll
    for (int s8 = 0; s8 < 8; ++s8) { const int n = 8 * s8 + (lane >> 3), ch = lane & 7; const u32x4 w = *(const LAS u32x4*)(T + n * 144 + 16 * ch);
        *(u32x4*)(WT + (size_t)(n0 + n) * ldd + k0 + 16 * ch) = w; }
    asm volatile("s_waitcnt lgkmcnt(0)" ::: "memory");
}
__device__ __forceinline__ void split_bf16(const f32x4 a, const f32x4 b, bf16x8& hi, bf16x8& lo);
template <class AP> __device__ __forceinline__ void p0_prologue(const Ctx& C, AP a) {
    unsigned char* ws = C.ws;
    { const float* c = (const float*)a->in[1]; const float* ada_w = (const float*)a->in[3]; const float* ada_b = (const float*)a->in[4]; float* mod = (float*)(ws + O_MOD);
      LAS float* part = (LAS float*)C.lds;
      LAS float* cact = (LAS float*)(C.lds + 32768);
      if (C.bid < 4 * 24) { for (int i = C.tid; i < 4096; i += 512) { const int b = i >> 10, k = i & 1023; const float cv = c[i]; cact[k * 4 + b] = cv / (1.f + expf(-cv)); } __syncthreads(); }
      for (int it = C.bid; it < 4 * 24; it += C.G) { const int l = it / 24, n0 = (it % 24) * 256;
          f32x4 acc[4];
#pragma unroll
          for (int b = 0; b < 4; ++b) acc[b] = (f32x4){0.f, 0.f, 0.f, 0.f};
          const float* w = ada_w + (size_t)l * 1024 * 6144 + n0 + 4 * C.lane;
#pragma unroll 1
          for (int k0 = C.wave * 128; k0 < C.wave * 128 + 128; k0 += 16) { f32x4 wv[16];
#pragma unroll
              for (int i = 0; i < 16; ++i) wv[i] = __builtin_nontemporal_load((const f32x4*)(w + (size_t)(k0 + i) * 6144));
#pragma unroll
              for (int i = 0; i < 16; ++i) { const f32x4 sv = *(const LAS f32x4*)(cact + (k0 + i) * 4);
#pragma unroll
                  for (int b = 0; b < 4; ++b) acc[b] = acc[b] + sv[b] * wv[i]; } }
#pragma unroll
          for (int b = 0; b < 4; ++b) *(LAS f32x4*)(part + (C.wave * 4 + b) * 256 + 4 * C.lane) = acc[b];
          __syncthreads();
          for (int o = C.tid; o < 1024; o += 512) { const int b = o >> 8, n = o & 255; float sacc = ada_b[l * 6144 + n0 + n];
#pragma unroll
              for (int w8 = 0; w8 < 8; ++w8) sacc += part[(w8 * 4 + b) * 256 + n];
              mod[((size_t)l * 4 + b) * 6144 + n0 + n] = sacc; }
          __syncthreads(); } }
    { const float* wr_all = (const float*)a->in[28]; unsigned char* RW = ws + O_RW;
      for (int idx = ((C.G > 128) ? C.bid - 96 : C.bid) * 512 + C.tid; idx >= 0 && idx < 4 * 8 * 8 * 64; idx += ((C.G > 128) ? C.G - 96 : C.G) * 512) {     const int ln = idx & 63, f = (idx >> 6) & 7, vv = (idx >> 9) & 7, l = idx >> 12; const int nt = f >> 2, ks = f & 3, l15 = ln & 15, kg = ln >> 4;
          const float* p = wr_all + (size_t)l * 1024 * 32 + (size_t)(128 * vv + 32 * ks + 8 * kg) * 32 + 16 * nt + l15;
          bf16x8 hi, lo; split_bf16((f32x4){p[0], p[32], p[64], p[96]}, (f32x4){p[128], p[160], p[192], p[224]}, hi, lo);
          *(bf16x8*)(RW + (size_t)idx * 32) = hi; *(bf16x8*)(RW + (size_t)idx * 32 + 16) = lo; } }
    { const int* positions = (const int*)a->in[2]; float* cs = (float*)(ws + O_CS);
      for (int i = C.bid * 512 + C.tid; i < T_ * 16; i += C.G * 512) { const int t = i >> 4, f = i & 15; const float inv = powf(10000.f, -(float)(2 * f) / 32.f); const float ang = (float)positions[t] * inv;
          cs[t * 32 + f] = cosf(ang); cs[t * 32 + 16 + f] = sinf(ang); } }
    { const float* lam = (const float*)a->in[25]; float* spv = (float*)(ws + O_SPV);
      for (int i = C.bid * 512 + C.tid; i < 2048; i += C.G * 512) spv[i] = -8.f * 1.4426950408889634f * log1pf(expf(-lam[i])); }
    { const int lane = C.lane; LAS unsigned char* T = C.lds + 49152 + C.wave * 9216;
      const float* attn_w_in = (const float*)a->in[7]; const float* w_uq = (const float*)a->in[12]; const float* w_ukv = (const float*)a->in[13]; const float* attn_w_out = (const float*)a->in[16];
      const float* rec_w_in = (const float*)a->in[17]; const float* rec_wa = (const float*)a->in[21]; const float* rec_wx = (const float*)a->in[23]; const float* rec_w_out = (const float*)a->in[26];
      const float* w1 = (const float*)a->in[30]; const float* w2 = (const float*)a->in[32];
      constexpr int T_WIN = 32 * 16, T_WUQ = 12 * 4, T_WUKV = 16 * 2, T_WOUT = 16 * 16, T_RWIN = 32 * 16, T_RG = 2 * 2, T_RWOUT = 16 * 16, T_W1 = 32 * 16, T_W2 = 16 * 16;
      constexpr int NITEMS = 2 * (T_WUQ + T_WUKV + T_WOUT + T_RWIN + 16 * T_RG + T_RWOUT);
      struct Job { const float* W; bf16_t* WT; int N, ldd, n0, k0, perm; };
      auto decode = [&](int r, Job& jb) {
#define CONV_JOB(SRC, KK, NN, DST, NROWS, NMAT, SRC_MS, DST_MS, PERM) { constexpr int kc_ = (KK) / 64, per_ = ((NROWS) / 64) * kc_, tot_ = per_ * (NMAT); \
          if (r < tot_) { const int mat_ = r / per_, q_ = r % per_; jb.W = (SRC) + (size_t)mat_ * (SRC_MS); jb.WT = (bf16_t*)(ws + (DST) + (size_t)mat_ * (DST_MS)); jb.N = (NN); jb.ldd = (KK); jb.n0 = (q_ / kc_) * 64; jb.k0 = (q_ % kc_) * 64; jb.perm = (PERM); return; } r -= tot_; }
          CONV_JOB(w_uq, 256, 768, O_WUQ, 768, 2, (size_t)256 * 768, SZ_WUQ, 1)
          CONV_JOB(w_ukv, 128, 1024, O_WUKV, 1024, 2, (size_t)128 * 1024, SZ_WUKV, 2)
          CONV_JOB(attn_w_out, 1024, 1024, O_WOUT, 1024, 2, (size_t)1024 * 1024, SZ_WOUT, 0)
          CONV_JOB(rec_w_in, 1024, 2048, O_RWIN, 2048, 2, (size_t)1024 * 2048, SZ_RWIN, 0)
          CONV_JOB(rec_wa, 128, 128, O_RGATE, 128, 16, (size_t)128 * 128, (size_t)256 * 128 * 2, 0)
          CONV_JOB(rec_wx, 128, 128, O_RGATE + (size_t)128 * 128 * 2, 128, 16, (size_t)128 * 128, (size_t)256 * 128 * 2, 0)
          CONV_JOB(rec_w_out, 1024, 1024, O_RWOUT, 1024, 2, (size_t)1024 * 1024, SZ_RWOUT, 0)
#undef CONV_JOB
          jb.W = attn_w_out; jb.WT = (bf16_t*)(ws + O_WOUT); jb.N = 1024; jb.ldd = 1024; jb.n0 = 0; jb.k0 = 0; jb.perm = 0; };
      f32x4 va[16], vb[16]; Job ja, jn;
      const bool gv = C.G > 128; const int cgw = !gv ? C.gw : (C.bid < 96) ? ((C.wave < 4) ? C.bid * 4 + C.wave : (1 << 28)) : 384 + (C.bid - 96) * 8 + C.wave, cngw = !gv ? C.NGW : 384 + (C.G - 96) * 8;
      int it = cgw;
      if (it < NITEMS) { decode(it, ja); conv_load(va, ja.W, ja.N, ja.n0, ja.k0, lane); }
#pragma unroll 1
      for (; it < NITEMS; it += 2 * cngw) {
          const bool h1 = it + cngw < NITEMS;
          if (h1) { decode(it + cngw, jn); conv_load(vb, jn.W, jn.N, jn.n0, jn.k0, lane); }
          conv_emit(va, T, ja.WT, ja.ldd, ja.n0, ja.k0, lane, ja.perm);
          const bool h2 = it + 2 * cngw < NITEMS;
          if (h2) { decode(it + 2 * cngw, ja); conv_load(va, ja.W, ja.N, ja.n0, ja.k0, lane); }
          if (h1) conv_emit(vb, T, jn.WT, jn.ldd, jn.n0, jn.k0, lane, jn.perm);
      }
      { constexpr int IM = 32 * 8;
#pragma unroll 1
        for (int i8 = cgw; i8 < 2 * IM; i8 += cngw) { const int mat = i8 / IM, q = i8 % IM;
            conv8_tile(attn_w_in + (size_t)mat * 1024 * 1952, 1952, ws + O_WIN + (size_t)mat * SZ_WIN, 1024, (q >> 3) * 64, (q & 7) * 128, T, lane); } }
    }
}

__device__ __forceinline__ void phase_norm(const Ctx& C, const float* xin  , float* out  , bool combine, bool do_norm, const float* gain, const float* modc  , const float* modl  , int shoff, int scoff, bool dummy = false, bool f8 = false  ) {
    const unsigned char* Y8 = C.ws + O_Y2;     const int* pos = (const int*)(C.ws + O_POS); const float* topg = (const float*)(C.ws + O_TOPG); bf16_t* HN = (bf16_t*)(C.ws + (dummy ? O_DUMMY : O_HN)); const bf16_t* X = (const bf16_t*)(C.ws + O_X); bf16_t* Xo = (bf16_t*)(C.ws + (dummy ? O_DUMMY + 32 * MiB : O_X));
    const int lane = C.lane;
    f32x4 gsc[4], shv[4], g2v[4]; int bprev = -1;
    for (int t = C.gw; t < T_; t += C.NGW) { const int b = t / S_;
        if (b != bprev) { bprev = b;
#pragma unroll
            for (int j = 0; j < 4; ++j) { const int col = 256 * j + 4 * lane;
                if (do_norm) { gsc[j] = *(const f32x4*)(gain + col) * (1.f + *(const f32x4*)(modl + b * 6144 + scoff + col)); shv[j] = *(const f32x4*)(modl + b * 6144 + shoff + col); }
                if (combine) g2v[j] = *(const f32x4*)(modc + b * 6144 + 5120 + col); } }
        f32x4 v[4];
        if (xin) {
#pragma unroll
            for (int j = 0; j < 4; ++j) v[j] = __builtin_nontemporal_load((const f32x4*)(xin + (size_t)t * 1024 + 256 * j + 4 * lane)); }
        else {
#pragma unroll
            for (int j = 0; j < 4; ++j) { const u32x2 w = *(const u32x2*)(X + (size_t)t * 1024 + 256 * j + 4 * lane); v[j] = (f32x4){bf_lo(w.x), bf_hi(w.x), bf_lo(w.y), bf_hi(w.y)}; } }
        if (combine) { f32x4 y[4];
#pragma unroll
            for (int j = 0; j < 4; ++j) y[j] = (f32x4){0.f, 0.f, 0.f, 0.f};
            const u32x4 pp = *(const u32x4*)(pos + t * 4); const f32x4 gg = *(const f32x4*)(topg + t * 4) * (1.f / Y8_SCALE);
#pragma unroll
            for (int k = 0; k < 4; ++k) { const int p = (int)pp[k]; const float gk = gg[k];
#pragma unroll
                for (int j = 0; j < 4; ++j) { const unsigned w = *(const unsigned*)(Y8 + (size_t)p * 1024 + 256 * j + 4 * lane);
                    const f32x2 lo = __builtin_amdgcn_cvt_pk_f32_fp8((int)w, false), hi2 = __builtin_amdgcn_cvt_pk_f32_fp8((int)w, true);
                    y[j][0] += gk * lo[0]; y[j][1] += gk * lo[1]; y[j][2] += gk * hi2[0]; y[j][3] += gk * hi2[1]; } }
#pragma unroll
            for (int j = 0; j < 4; ++j) v[j] = v[j] + g2v[j] * y[j]; }
        if (out) {
#pragma unroll
            for (int j = 0; j < 4; ++j) __builtin_nontemporal_store(v[j], (f32x4*)(out + (size_t)t * 1024 + 256 * j + 4 * lane)); }
        else {
#pragma unroll
            for (int j = 0; j < 4; ++j) { u32x2 w; w.x = cvt_pk_bf16(v[j][0], v[j][1]); w.y = cvt_pk_bf16(v[j][2], v[j][3]); *(u32x2*)(Xo + (size_t)t * 1024 + 256 * j + 4 * lane) = w; } }
        if (do_norm) { float ss = 0.f;
#pragma unroll
            for (int j = 0; j < 4; ++j) ss += (v[j][0] * v[j][0] + v[j][1] * v[j][1]) + (v[j][2] * v[j][2] + v[j][3] * v[j][3]);
            const float rs = rsqrtf(wsum(ss) * (1.f / 1024.f) + 1e-6f);
#pragma unroll
            for (int j = 0; j < 4; ++j) { const int col = 256 * j + 4 * lane;
                const f32x4 h = v[j] * rs * gsc[j] + shv[j];
                if (f8) *(unsigned*)((unsigned char*)HN + (size_t)t * 1024 + col) = pk4_fp8(h[0], h[1], h[2], h[3]);
                else { u32x2 w; w.x = cvt_pk_bf16(h[0], h[1]); w.y = cvt_pk_bf16(h[2], h[3]); *(u32x2*)(HN + (size_t)t * 1024 + col) = w; } } }
    }
}

__device__ __forceinline__ void unpack8(const u32x4 w, float (&f)[8]) { f[0] = bf_lo(w.x); f[1] = bf_hi(w.x); f[2] = bf_lo(w.y); f[3] = bf_hi(w.y); f[4] = bf_lo(w.z); f[5] = bf_hi(w.z); f[6] = bf_lo(w.w); f[7] = bf_hi(w.w); }
__device__ __forceinline__ u32x4 pack8(const float (&f)[8]) { u32x4 w; w.x = cvt_pk_bf16(f[0], f[1]); w.y = cvt_pk_bf16(f[2], f[3]); w.z = cvt_pk_bf16(f[4], f[5]); w.w = cvt_pk_bf16(f[6], f[7]); return w; }

constexpr float LOG2E = 1.4426950408889634f;
__device__ __forceinline__ void phase_postproj(const Ctx& C, const float* qg, const float* kg, const float* qag, const float* kvag, const float* mkg) {
    bf16_t* PROJ = (bf16_t*)(C.ws + O_PROJ); const float* cs = (const float*)(C.ws + O_CS); const int lane = C.lane;
    for (int t = C.gw; t < T_; t += C.NGW) { bf16_t* row = PROJ + (size_t)t * 2048;
#pragma unroll
        for (int ps = 0; ps < 2; ++ps) { bf16_t* p = row + ps * 512 + 8 * lane; float f[8]; unpack8(*(const u32x4*)p, f); float ss = 0.f;
#pragma unroll
            for (int i = 0; i < 8; ++i) ss += f[i] * f[i];
            ss += shx<1>(ss); ss += shx<2>(ss); ss += shx<4>(ss);
            const float rs = rsqrtf(ss * (1.f / 64.f) + 1e-6f) * (ps == 0 ? 0.125f * LOG2E : 1.f); const float* g = (ps == 0 ? qg : kg) + 8 * (lane & 7);
#pragma unroll
            for (int i = 0; i < 8; ++i) f[i] = f[i] * rs * g[i];
            *(u32x4*)p = pack8(f); }
        { bf16_t* p = row + 1536 + 8 * lane; float f[8]; unpack8(*(const u32x4*)p, f); float ss = 0.f;
#pragma unroll
            for (int i = 0; i < 8; ++i) ss += f[i] * f[i];
            ss += shx<1>(ss); ss += shx<2>(ss);
            { const float o4 = shx<4>(ss); if (lane < 48) ss += o4; } { const float o8 = shx<8>(ss); if (lane < 48) ss += o8; } { const float o16 = shx<16>(ss); if (lane < 32) ss += o16; }
            const float nrm = lane < 32 ? 256.f : (lane < 48 ? 128.f : 32.f);
            const float rs = rsqrtf(ss / nrm + 1e-6f);
            const float* g = lane < 32 ? (qag + 8 * lane) : (lane < 48 ? (kvag + 8 * (lane - 32)) : (mkg + 64 + 8 * ((lane - 48) & 3)));
#pragma unroll
            for (int i = 0; i < 8; ++i) f[i] = f[i] * rs * g[i];
            float o[8];
#pragma unroll
            for (int i = 0; i < 8; ++i) { const float other = shx<2>(f[i]); const int fi = ((lane & 1) << 3) + i; const float cv = cs[t * 32 + fi], sv = cs[t * 32 + 16 + fi];
                o[i] = (lane & 2) ? (other * sv + f[i] * cv) : (f[i] * cv - other * sv); }
            if (lane >= 48 && lane < 52) {
#pragma unroll
                for (int i = 0; i < 8; ++i) f[i] = o[i]; }
            if (lane < 52) *(u32x4*)p = pack8(f); }
    }
}
__device__ __forceinline__ void phase_postq(const Ctx& C, const float* mqg, const float* mkg) {
    bf16_t* Q2 = (bf16_t*)(C.ws + O_Q2); bf16_t* KV2 = (bf16_t*)(C.ws + O_KV2); const float* cs = (const float*)(C.ws + O_CS); const int lane = C.lane;
    const float qscale = 0.10206207261596575f * LOG2E;
    for (int t = C.gw; t < T_; t += C.NGW) {
        { bf16_t* p = Q2 + (size_t)t * 768 + (lane >> 3) * 96 + 8 * (lane & 7); float f[8]; unpack8(*(const u32x4*)p, f); float ss = 0.f;
#pragma unroll
            for (int i = 0; i < 8; ++i) ss += f[i] * f[i];
            ss += shx<1>(ss); ss += shx<2>(ss); ss += shx<4>(ss);
            const float rs = rsqrtf(ss * (1.f / 64.f) + 1e-6f) * qscale; const float* g = mqg + 8 * (lane & 7);
#pragma unroll
            for (int i = 0; i < 8; ++i) f[i] = f[i] * rs * g[i];
            *(u32x4*)p = pack8(f); }
        { const int l2 = lane & 31; bf16_t* p = Q2 + (size_t)t * 768 + (l2 >> 2) * 96 + 64 + 8 * (l2 & 3); float f[8]; unpack8(*(const u32x4*)p, f); float ss = 0.f;
#pragma unroll
            for (int i = 0; i < 8; ++i) ss += f[i] * f[i];
            ss += shx<1>(ss); ss += shx<2>(ss);
            const float rs = rsqrtf(ss * (1.f / 32.f) + 1e-6f) * qscale; const float* g = mqg + 64 + 8 * (l2 & 3);
#pragma unroll
            for (int i = 0; i < 8; ++i) f[i] = f[i] * rs * g[i];
            float o[8];
#pragma unroll
            for (int i = 0; i < 8; ++i) { const float other = shx<2>(f[i]); const int fi = ((lane & 1) << 3) + i; const float cv = cs[t * 32 + fi], sv = cs[t * 32 + 16 + fi];
                o[i] = (lane & 2) ? (other * sv + f[i] * cv) : (f[i] * cv - other * sv); }
            if (lane < 32) *(u32x4*)p = pack8(o); }
        { bf16_t* p = KV2 + (size_t)t * 1024 + (lane >> 3) * 128 + 8 * (lane & 7); float f[8]; unpack8(*(const u32x4*)p, f); float ss = 0.f;
#pragma unroll
            for (int i = 0; i < 8; ++i) ss += f[i] * f[i];
            ss += shx<1>(ss); ss += shx<2>(ss); ss += shx<4>(ss);
            const float rs = rsqrtf(ss * (1.f / 64.f) + 1e-6f); const float* g = mkg + 8 * (lane & 7);
#pragma unroll
            for (int i = 0; i < 8; ++i) f[i] = f[i] * rs * g[i];
            *(u32x4*)p = pack8(f); }
    }
}
__device__ __forceinline__ void phase_mixcombine(const Ctx& C) {
    const bf16_t* OA = (const bf16_t*)(C.ws + O_OA); const float* LSE = (const float*)(C.ws + O_LSE); bf16_t* ATT = (bf16_t*)(C.ws + O_ATT); const int lane = C.lane;
    for (int t = C.gw; t < T_; t += C.NGW) { const int h = lane >> 3;
        float ls[3], mx = -INFINITY;
#pragma unroll
        for (int p = 0; p < 3; ++p) { ls[p] = LSE[((size_t)p * T_ + t) * 8 + h]; mx = fmaxf(mx, ls[p]); }
        float w[3], den = 0.f;
#pragma unroll
        for (int p = 0; p < 3; ++p) { w[p] = fexp2(ls[p] - mx); den += w[p]; }
        const float inv = 1.f / den; float o[8];
#pragma unroll
        for (int i = 0; i < 8; ++i) o[i] = 0.f;
#pragma unroll
        for (int p = 0; p < 3; ++p) { float f[8]; unpack8(*(const u32x4*)(OA + ((size_t)p * T_ + t) * 512 + 8 * lane), f); const float wp = w[p] * inv;
#pragma unroll
            for (int i = 0; i < 8; ++i) o[i] += wp * f[i]; }
        *(u32x4*)(ATT + (size_t)t * 1024 + 8 * lane) = pack8(o); }
}
__device__ __forceinline__ void phase_rgate(const Ctx& C, int j, const float* cw, const float* cb, const float* ba, const float* bx) {
    const bf16_t* PROJ = (const bf16_t*)(C.ws + O_PROJ); const bf16_t* RG = (const bf16_t*)(C.ws + O_RGATE + (size_t)j * SZ_RGATE); const float* spvg = (const float*)(C.ws + O_SPV) + j * 1024;
    bf16_t* LA = (bf16_t*)(C.ws + O_AA); bf16_t* Bb = (bf16_t*)(C.ws + O_BB); float* SP = (float*)(C.ws + O_SUMP); float* SH = (float*)(C.ws + O_SUMH);
    constexpr int WROW = 272;
    LAS unsigned char* Wl = C.lds;
    LAS unsigned char* Xl = C.lds + 256 * WROW;
    LAS unsigned char* Al = Xl + 64 * WROW;
    LAS unsigned char* Bl = Al + 64 * WROW;
    const int tid = C.tid, lane = C.lane, w = C.wave;
    if (C.G % 8 != 0) return;
    const int n = C.bid & 7, g = C.bid >> 3, ng = C.G >> 3;
    for (int i = tid; i < 256 * 16; i += 512) { const int r = i >> 4, c = i & 15; *(LAS u32x4*)(Wl + r * WROW + 16 * c) = *(const u32x4*)(RG + ((size_t)n * 256 + r) * 128 + 8 * c); }
    const int crow = tid >> 3, cg = tid & 7, cch = n * 128 + 16 * cg;
    float cwv[4][16], cbv[16];
#pragma unroll
    for (int q = 0; q < 4; ++q) { const f32x4 b4 = *(const f32x4*)(cb + cch + 4 * q); cbv[4 * q] = b4[0]; cbv[4 * q + 1] = b4[1]; cbv[4 * q + 2] = b4[2]; cbv[4 * q + 3] = b4[3];
#pragma unroll
        for (int k = 0; k < 4; ++k) { const f32x4 w4 = *(const f32x4*)(cw + k * 1024 + cch + 4 * q); cwv[k][4 * q] = w4[0]; cwv[k][4 * q + 1] = w4[1]; cwv[k][4 * q + 2] = w4[2]; cwv[k][4 * q + 3] = w4[3]; } }
    const int mt = w & 3, h = w >> 2, l15 = lane & 15, kg = lane >> 4;
    float bav[4], bxv[4], spv[4];
#pragma unroll
    for (int jj = 0; jj < 4; ++jj) { const int ch = n * 128 + 16 * (4 * h + jj) + l15; bav[jj] = ba[ch]; bxv[jj] = bx[ch]; spv[jj] = spvg[ch]; }
    __syncthreads();
    u32x4 xr[4][2];
    auto load_x = [&](int c) { const size_t row0 = (size_t)c * 64; const int ts0 = (int)(row0 % S_);
#pragma unroll
        for (int k = 0; k < 4; ++k) { const int dt = (ts0 + crow + k - 3 >= 0) ? k - 3 : 0; const bf16_t* src = PROJ + (row0 + crow + dt) * 2048 + 1024 + cch; xr[k][0] = *(const u32x4*)src; xr[k][1] = *(const u32x4*)(src + 8); } };
    load_x(g);
    for (int c = g; c < 256; c += ng) { const size_t row0 = (size_t)c * 64; const int ts0 = (int)(row0 % S_);
        { float acc[16];
#pragma unroll
          for (int i = 0; i < 16; ++i) acc[i] = cbv[i];
#pragma unroll
          for (int k = 0; k < 4; ++k) { const int dt = k - 3; const bool on = ts0 + crow + dt >= 0; float f0[8], f1[8]; unpack8(xr[k][0], f0); unpack8(xr[k][1], f1);
#pragma unroll
              for (int i = 0; i < 8; ++i) { acc[i] += on ? cwv[k][i] * f0[i] : 0.f; acc[8 + i] += on ? cwv[k][8 + i] * f1[i] : 0.f; } }
          float lo[8], hi8[8];
#pragma unroll
          for (int i = 0; i < 8; ++i) { lo[i] = acc[i]; hi8[i] = acc[8 + i]; }
          *(LAS u32x4*)(Xl + crow * WROW + 32 * cg) = pack8(lo); *(LAS u32x4*)(Xl + crow * WROW + 32 * cg + 16) = pack8(hi8); }
        load_x((c + ng < 256) ? c + ng : c);
        __builtin_amdgcn_sched_barrier(0);
        __syncthreads();
        f32x4 acc[8];
#pragma unroll
        for (int t = 0; t < 8; ++t) acc[t] = (f32x4){0.f, 0.f, 0.f, 0.f};
#pragma unroll
        for (int ks = 0; ks < 4; ++ks) { const bf16x8 af = *(const LAS bf16x8*)(Xl + (16 * mt + l15) * WROW + 64 * ks + 16 * kg);
#pragma unroll
            for (int t = 0; t < 8; ++t) { const int nt = (t < 4) ? (4 * h + t) : (8 + 4 * h + (t - 4)); const bf16x8 bfr = *(const LAS bf16x8*)(Wl + (16 * nt + l15) * WROW + 64 * ks + 16 * kg);
                acc[t] = __builtin_amdgcn_mfma_f32_16x16x32_bf16(af, bfr, acc[t], 0, 0, 0); } }
#pragma unroll
        for (int jj = 0; jj < 4; ++jj) { const int e = 16 * (4 * h + jj) + l15;
#pragma unroll
            for (int r = 0; r < 4; ++r) { const int row = 16 * mt + 4 * kg + r; const float xc = bf_lo((unsigned)*(const LAS unsigned short*)(Xl + row * WROW + 2 * e));
                const float rr = fsigmoid(acc[jj][r] + bav[jj]), ig = fsigmoid(acc[4 + jj][r] + bxv[jj]); const float la = rr * spv[jj], av = fexp2(la);
                const float bv = __builtin_amdgcn_sqrtf(fmaxf(1.f - av * av, 0.f)) * ig * xc;
                *(LAS unsigned short*)(Al + row * WROW + 2 * e) = (unsigned short)(cvt_pk_bf16(la, la) & 0xffffu); *(LAS unsigned short*)(Bl + row * WROW + 2 * e) = (unsigned short)(cvt_pk_bf16(bv, bv) & 0xffffu); } }
        __syncthreads();
        { const size_t go = (row0 + crow) * 1024 + cch;
          *(u32x4*)(LA + go) = *(const LAS u32x4*)(Al + crow * WROW + 32 * cg); *(u32x4*)(LA + go + 8) = *(const LAS u32x4*)(Al + crow * WROW + 32 * cg + 16);
          *(u32x4*)(Bb + go) = *(const LAS u32x4*)(Bl + crow * WROW + 32 * cg); *(u32x4*)(Bb + go + 8) = *(const LAS u32x4*)(Bl + crow * WROW + 32 * cg + 16); }
        if (tid < 128) { float Pl = 0.f, Hh = 0.f;
#pragma unroll 8
            for (int r = 0; r < 64; ++r) { const float la = bf_lo((unsigned)*(const LAS unsigned short*)(Al + r * WROW + 2 * tid)), bv = bf_lo((unsigned)*(const LAS unsigned short*)(Bl + r * WROW + 2 * tid)); Hh = fexp2(la) * Hh + bv; Pl += la; }
            const int b = (int)(row0 / S_), ck = (int)((row0 % S_) >> 6); SP[((size_t)b * 64 + ck) * 1024 + n * 128 + tid] = fexp2(Pl); SH[((size_t)b * 64 + ck) * 1024 + n * 128 + tid] = Hh; }
        __syncthreads();
    }
}

__device__ __forceinline__ void scan_sum_item(const Ctx& C, int b, int ck, int cg) {
    const bf16_t* LA = (const bf16_t*)(C.ws + O_AA); const bf16_t* Bb = (const bf16_t*)(C.ws + O_BB); float* SP = (float*)(C.ws + O_SUMP); float* SH = (float*)(C.ws + O_SUMH);
    const int ch = cg * 128 + 2 * C.lane;
    size_t off = ((size_t)b * S_ + ck * 64) * 1024 + ch; f32x2 Pl = (f32x2){0.f, 0.f}, Hh = (f32x2){0.f, 0.f};
#pragma unroll 8
    for (int s = 0; s < 64; ++s, off += 1024) { const unsigned lw = *(const unsigned*)(LA + off), bw = *(const unsigned*)(Bb + off);
        const f32x2 lv = (f32x2){bf_lo(lw), bf_hi(lw)}, av = (f32x2){fexp2(lv[0]), fexp2(lv[1])}, bv = (f32x2){bf_lo(bw), bf_hi(bw)}; Hh = av * Hh + bv; Pl = Pl + lv; }
    *(f32x2*)(SP + ((size_t)b * 64 + ck) * 1024 + ch) = (f32x2){fexp2(Pl[0]), fexp2(Pl[1])}; *(f32x2*)(SH + ((size_t)b * 64 + ck) * 1024 + ch) = Hh;
}
__device__ __forceinline__ void phase_scan_sum_own(const Ctx& C) {
    asm volatile("s_waitcnt vmcnt(0)" ::: "memory"); __syncthreads();
    for (int i = 0; ; ++i) { const int L = i * C.G + C.bid; if (L >= 512) break; const int pm = L >> 3, n = L & 7;
        if (C.wave < 4) { const int row0 = pm * 256 + C.wave * 64; scan_sum_item(C, row0 / S_, (row0 % S_) >> 6, n); } }
}
__device__ __forceinline__ void phase_scan_apply(const Ctx& C) {
    const bf16_t* LA = (const bf16_t*)(C.ws + O_AA); const bf16_t* Bb = (const bf16_t*)(C.ws + O_BB); const float* SP = (const float*)(C.ws + O_SUMP); const float* SH = (const float*)(C.ws + O_SUMH);
    const bf16_t* PROJ = (const bf16_t*)(C.ws + O_PROJ); bf16_t* ATT = (bf16_t*)(C.ws + O_ATT); const int lane = C.lane;
    for (int it = C.gw; it < 4 * 64 * 8; it += C.NGW) { const int cg = it & 7, ck = (it >> 3) & 63, b = it >> 9; const int ch = cg * 128 + 2 * lane;
        f32x2 h = (f32x2){0.f, 0.f};
        const float* sp = SP + (size_t)b * 64 * 1024 + ch; const float* sh = SH + (size_t)b * 64 * 1024 + ch;
#pragma unroll 1
        for (int c0 = 0; c0 < ck; c0 += 16) { f32x2 pv[16], hv[16];
#pragma unroll
            for (int u = 0; u < 16; ++u) { const int c2 = (c0 + u < ck) ? c0 + u : ck - 1; pv[u] = *(const f32x2*)(sp + (size_t)c2 * 1024); hv[u] = *(const f32x2*)(sh + (size_t)c2 * 1024); }
            __builtin_amdgcn_sched_barrier(0);
#pragma unroll
            for (int u = 0; u < 16; ++u) if (c0 + u < ck) h = pv[u] * h + hv[u]; }
        const size_t row0 = (size_t)b * S_ + ck * 64;
#pragma unroll 1
        for (int s0 = 0; s0 < 64; s0 += 16) { unsigned lw[16], bw[16], gw2[16];
#pragma unroll
            for (int u = 0; u < 16; ++u) { const size_t row = row0 + s0 + u; lw[u] = *(const unsigned*)(LA + row * 1024 + ch); bw[u] = *(const unsigned*)(Bb + row * 1024 + ch); gw2[u] = *(const unsigned*)(PROJ + row * 2048 + ch); }
            __builtin_amdgcn_sched_barrier(0);
#pragma unroll
            for (int u = 0; u < 16; ++u) { const f32x2 av = (f32x2){fexp2(bf_lo(lw[u])), fexp2(bf_hi(lw[u]))}, bv = (f32x2){bf_lo(bw[u]), bf_hi(bw[u])}; h = av * h + bv;
                *(unsigned*)(ATT + (row0 + s0 + u) * 1024 + ch) = cvt_pk_bf16(bf_lo(gw2[u]) * h[0], bf_hi(gw2[u]) * h[1]); } }
    }
}

__device__ __forceinline__ void split_bf16(const f32x4 a, const f32x4 b, bf16x8& hi, bf16x8& lo) {
    u32x4 h; h.x = cvt_pk_bf16(a[0], a[1]); h.y = cvt_pk_bf16(a[2], a[3]); h.z = cvt_pk_bf16(b[0], b[1]); h.w = cvt_pk_bf16(b[2], b[3]);
    u32x4 l; l.x = cvt_pk_bf16(a[0] - bf_lo(h.x), a[1] - bf_hi(h.x)); l.y = cvt_pk_bf16(a[2] - bf_lo(h.y), a[3] - bf_hi(h.y)); l.z = cvt_pk_bf16(b[0] - bf_lo(h.z), b[1] - bf_hi(h.z)); l.w = cvt_pk_bf16(b[2] - bf_lo(h.w), b[3] - bf_hi(h.w));
    hi = __builtin_bit_cast(bf16x8, h); lo = __builtin_bit_cast(bf16x8, l);
}
__device__ __forceinline__ void phase_router(const Ctx& C, const bf16_t* X, const float* gain, const float* modl, const float* wr, const float* br, int layer) {
    unsigned char* HN8 = C.ws + O_HN; int* topi = (int*)(C.ws + O_TOPI); float* topg = (float*)(C.ws + O_TOPG); int* ecnt = (int*)(C.ws + O_ECNT) + layer * 32; int* inv = (int*)(C.ws + O_INV); int* posj = (int*)(C.ws + O_POSJ);
    LAS int* rk = (LAS int*)(C.lds + LX_MISC + 3072); LAS int* base = (LAS int*)(C.lds + LX_MISC + 512);
    constexpr int HROW = 1028;
    LAS float* hrow = (LAS float*)C.lds;
    LAS float* part = (LAS float*)(C.lds + 16 * HROW * 4);
    LAS int* hl = (LAS int*)(C.lds + LX_MISC);
    const int lane = C.lane, e = lane & 31, kh = lane >> 5, v = C.wave, l15 = lane & 15, kg = lane >> 4;
    bf16x8 whi[2][4], wlo[2][4];
    { const unsigned char* rw = C.ws + O_RW + ((size_t)(layer * 8 + v) * 8 * 64 + lane) * 32;
#pragma unroll
      for (int nt = 0; nt < 2; ++nt)
#pragma unroll
          for (int ks = 0; ks < 4; ++ks) { whi[nt][ks] = *(const bf16x8*)(rw + (size_t)(nt * 4 + ks) * 64 * 32); wlo[nt][ks] = *(const bf16x8*)(rw + (size_t)(nt * 4 + ks) * 64 * 32 + 16); } }
    const float bias_e = br[e];
    if (C.tid < 32) hl[C.tid] = 0;
    __syncthreads();
    for (int ck = C.bid; ck < 256; ck += C.G) {
        const int b = (ck * 64) / S_;
        f32x4 gn[4], shv[4];
#pragma unroll
        for (int j = 0; j < 4; ++j) { const int col = 256 * j + 4 * lane; gn[j] = *(const f32x4*)(gain + col) * (1.f + *(const f32x4*)(modl + b * 6144 + 4096 + col)); shv[j] = *(const f32x4*)(modl + b * 6144 + 3072 + col); }
        u32x2 xr[2][4];
#pragma unroll
        for (int q = 0; q < 2; ++q)
#pragma unroll
            for (int j = 0; j < 4; ++j) xr[q][j] = *(const u32x2*)(X + (size_t)(ck * 64 + 2 * v + q) * 1024 + 256 * j + 4 * lane);
#pragma unroll 1
        for (int pass = 0; pass < 4; ++pass) { const int tb = ck * 64 + pass * 16;
#pragma unroll
            for (int q = 0; q < 2; ++q) { const int tt = 2 * v + q, t = tb + tt; f32x4 h[4]; float ss = 0.f;
#pragma unroll
                for (int j = 0; j < 4; ++j) { const u32x2 xw = xr[q][j]; h[j] = (f32x4){bf_lo(xw.x), bf_hi(xw.x), bf_lo(xw.y), bf_hi(xw.y)}; ss += (h[j][0] * h[j][0] + h[j][1] * h[j][1]) + (h[j][2] * h[j][2] + h[j][3] * h[j][3]); }
                const float rs = rsqrtf(wsum(ss) * (1.f / 1024.f) + 1e-6f);
#pragma unroll
                for (int j = 0; j < 4; ++j) { const int col = 256 * j + 4 * lane;
                    const f32x4 hv = h[j] * rs * gn[j] + shv[j];
                    *(unsigned*)(HN8 + (size_t)t * 1024 + col) = pk4_fp8(hv[0], hv[1], hv[2], hv[3]);
                    *(LAS f32x4*)(hrow + tt * HROW + col) = hv; } }
            if (pass < 3) {
#pragma unroll
                for (int q = 0; q < 2; ++q)
#pragma unroll
                    for (int j = 0; j < 4; ++j) xr[q][j] = *(const u32x2*)(X + (size_t)(tb + 16 + 2 * v + q) * 1024 + 256 * j + 4 * lane); }
            __syncthreads();
            { f32x4 acc0 = (f32x4){0.f, 0.f, 0.f, 0.f}, acc1 = acc0;
#pragma unroll
              for (int ks = 0; ks < 4; ++ks) { const LAS float* hp = hrow + l15 * HROW + 128 * v + 32 * ks + 8 * kg; bf16x8 ahi, alo; split_bf16(*(const LAS f32x4*)hp, *(const LAS f32x4*)(hp + 4), ahi, alo);
                  acc0 = __builtin_amdgcn_mfma_f32_16x16x32_bf16(ahi, whi[0][ks], acc0, 0, 0, 0); acc1 = __builtin_amdgcn_mfma_f32_16x16x32_bf16(ahi, whi[1][ks], acc1, 0, 0, 0);
                  acc0 = __builtin_amdgcn_mfma_f32_16x16x32_bf16(ahi, wlo[0][ks], acc0, 0, 0, 0); acc1 = __builtin_amdgcn_mfma_f32_16x16x32_bf16(ahi, wlo[1][ks], acc1, 0, 0, 0);
                  acc0 = __builtin_amdgcn_mfma_f32_16x16x32_bf16(alo, whi[0][ks], acc0, 0, 0, 0); acc1 = __builtin_amdgcn_mfma_f32_16x16x32_bf16(alo, whi[1][ks], acc1, 0, 0, 0); }
#pragma unroll
              for (int r = 0; r < 4; ++r) { part[((4 * kg + r) * 8 + v) * 32 + l15] = acc0[r]; part[((4 * kg + r) * 8 + v) * 32 + 16 + l15] = acc1[r]; } }
            __syncthreads();
            { const int tt = 2 * v + kh; float lg = bias_e;
#pragma unroll
              for (int w8 = 0; w8 < 8; ++w8) lg += part[(tt * 8 + w8) * 32 + e];
              float myv = 0.f, v0 = 0.f; int myi = 0;
#pragma unroll
              for (int k = 0; k < 4; ++k) { float mx = lg;
                  mx = rmax16(mx); mx = fmax_raw(mx, shx<16>(mx));
                  const unsigned long long bal = __ballot(lg == mx); const unsigned bh = (unsigned)(bal >> (32 * kh)); const int sel = __ffs((int)bh) - 1;
                  if (k == 0) v0 = mx;
                  if (e == k) { myv = mx; myi = sel; }
                  if (e == sel) lg = -INFINITY; }
              {
                const float ex = fexp2((myv - v0) * 1.4426950408889634f);
                float den = (e < 4) ? ex : 0.f; den += shx<1>(den); den += shx<2>(den);
                if (e < 4) { const int t = tb + tt; topi[t * 4 + e] = myi; topg[t * 4 + e] = ex * frcp(den);
                    const int r = __hip_atomic_fetch_add(hl + myi, 1, __ATOMIC_RELAXED, __HIP_MEMORY_SCOPE_WORKGROUP); rk[(pass * 16 + tt) * 4 + e] = (myi << 8) | r; } } }
        }
        __syncthreads();
        if (C.tid < 32) { base[C.tid] = __hip_atomic_fetch_add(ecnt + C.tid, hl[C.tid], __ATOMIC_RELAXED, __HIP_MEMORY_SCOPE_AGENT); hl[C.tid] = 0; }
        __syncthreads();
        if (C.tid < 256) { const int pk = rk[C.tid], ex = pk >> 8, j = base[ex] + (pk & 255); inv[ex * 16384 + j] = ck * 64 + (C.tid >> 2); posj[ck * 256 + C.tid] = j; }
        __syncthreads();
    }
}
__device__ __forceinline__ void moe_plan_lds(const Ctx& C, int layer) {
    const int* ecnt = (const int*)(C.ws + O_ECNT) + layer * 32;
    LAS int* tot = (LAS int*)(C.lds + LX_MISC + 256); LAS int* pst = tot + 32; LAS int* tile_e = (LAS int*)(C.lds + LX_TILE); LAS int* ntp = (LAS int*)(C.lds + LX_MISC + 128);
    __syncthreads();
    if (C.tid < 32) tot[C.tid] = __hip_atomic_load(ecnt + C.tid, __ATOMIC_RELAXED, __HIP_MEMORY_SCOPE_AGENT);
    __syncthreads();
    { const int e = C.tid & 31, sub = C.tid >> 5; int acc = 0;
#pragma unroll
      for (int x = 0; x < 32; x += 4) { const LAS int* tp = tot + x; const int t0 = tp[0], t1 = tp[1], t2 = tp[2], t3 = tp[3];
          acc += (x < e ? ((t0 + 255) & ~255) : 0) + (x + 1 < e ? ((t1 + 255) & ~255) : 0) + (x + 2 < e ? ((t2 + 255) & ~255) : 0) + (x + 3 < e ? ((t3 + 255) & ~255) : 0); }
      const int mine = (tot[e] + 255) >> 8, first = acc >> 8;
      if (sub == 0) { pst[e] = acc; if (e == 31) ntp[0] = first + mine; }
      for (int i = sub; i < mine; i += 16) tile_e[first + i] = e; }
    __syncthreads();
}
#ifndef ATT_DUP
#define ATT_DUP 1
#endif

__device__ __forceinline__ s16x4 tr16(LAS const unsigned char* p) { typedef short v4i16_t __attribute__((ext_vector_type(4))); return __builtin_bit_cast(s16x4, __builtin_amdgcn_ds_read_tr16_b64_v4i16((LAS v4i16_t*)p)); }

__device__ __forceinline__ float max3f(float a, float b, float c) { return fmaxf(fmaxf(a, b), c); }
#ifndef ATT_THR_V
#define ATT_THR_V 10.f
#endif
constexpr float ATT_THR = ATT_THR_V;
template <int KS, bool DIL>
__device__ __forceinline__ void att_tile(LAS const unsigned char* kb, LAS const unsigned char* vb, const bf16x8 (&qf)[KS], f32x16& o0, f32x16& o1, f32x16& negm, float& mref, float& l, int kidx0, int qidx, bool need_mask, int lane) {
    constexpr int KROW = KS * 32 + 16, VROW = 144;
    const int i32 = lane & 31, hi = lane >> 5;
    const int pr = (i32 & 0x13) | ((i32 & 4) << 1) | ((i32 & 8) >> 1);
    f32x16 p0, p1;
    LAS const unsigned char* kp = kb + pr * KROW + hi * 16;
#ifndef QK_DUP
#define QK_DUP 1
#endif
#pragma unroll 1
    for (int qd_ = 0; qd_ < QK_DUP; ++qd_) {
#pragma unroll
    for (int ks = 0; ks < KS; ++ks) {
        const bf16x8 k0f = *(LAS const bf16x8*)(kp + ks * 32), k1f = *(LAS const bf16x8*)(kp + 32 * KROW + ks * 32);
        if (ks == 0) { p0 = __builtin_amdgcn_mfma_f32_32x32x16_bf16(k0f, qf[0], negm, 0, 0, 0); p1 = __builtin_amdgcn_mfma_f32_32x32x16_bf16(k1f, qf[0], negm, 0, 0, 0); }
        else { p0 = __builtin_amdgcn_mfma_f32_32x32x16_bf16(k0f, qf[ks], p0, 0, 0, 0); p1 = __builtin_amdgcn_mfma_f32_32x32x16_bf16(k1f, qf[ks], p1, 0, 0, 0); }
    }
    asm volatile("" : "+v"(p0), "+v"(p1));
    }
    if (need_mask) {
#pragma unroll
        for (int r = 0; r < 16; ++r) { const int d0 = qidx - (kidx0 + 16 * (r >> 3) + 8 * hi + (r & 7)), d1 = d0 - 32;
            const bool v0 = DIL ? (d0 >= 0 && d0 <= 128) : (d0 >= 0), v1 = DIL ? (d1 >= 0 && d1 <= 128) : (d1 >= 0);
            p0[r] = v0 ? p0[r] : -INFINITY; p1[r] = v1 ? p1[r] : -INFINITY; } }
    float mx = max3f(p0[0], p0[1], p1[0]), mb = max3f(p0[2], p0[3], p1[1]); mx = max3f(mx, p1[2], p1[3]);
#pragma unroll
    for (int r = 4; r < 16; r += 4) { mx = max3f(mx, p0[r], p0[r + 1]); mb = max3f(mb, p0[r + 2], p0[r + 3]); mx = max3f(mx, p1[r], p1[r + 1]); mb = max3f(mb, p1[r + 2], p1[r + 3]); }
    mx = xmax32(fmaxf(mx, mb));
    if (__builtin_expect(__any(mx > ATT_THR), 0)) {
        const float dl = fmaxf(mx, 0.f), f = fexp2(-dl);
        mref += dl; l *= f;
#pragma unroll
        for (int r = 0; r < 16; ++r) { o0[r] *= f; o1[r] *= f; p0[r] -= dl; p1[r] -= dl; negm[r] = -mref; } }
    float ls0 = 0.f, ls1 = 0.f;
#pragma unroll
    for (int r = 0; r < 16; ++r) { p0[r] = fexp2(p0[r]); p1[r] = fexp2(p1[r]); ls0 += p0[r]; ls1 += p1[r]; }
    l += ls0 + ls1;
    u32x4 pw[2][2];
#pragma unroll
    for (int s = 0; s < 2; ++s) {
        pw[0][s].x = cvt_pk_bf16(p0[8 * s + 0], p0[8 * s + 1]); pw[0][s].y = cvt_pk_bf16(p0[8 * s + 2], p0[8 * s + 3]); pw[0][s].z = cvt_pk_bf16(p0[8 * s + 4], p0[8 * s + 5]); pw[0][s].w = cvt_pk_bf16(p0[8 * s + 6], p0[8 * s + 7]);
        pw[1][s].x = cvt_pk_bf16(p1[8 * s + 0], p1[8 * s + 1]); pw[1][s].y = cvt_pk_bf16(p1[8 * s + 2], p1[8 * s + 3]); pw[1][s].z = cvt_pk_bf16(p1[8 * s + 4], p1[8 * s + 5]); pw[1][s].w = cvt_pk_bf16(p1[8 * s + 6], p1[8 * s + 7]); }
    const int g = lane >> 4, i16 = lane & 15;
    LAS const unsigned char* vp = vb + (8 * (g >> 1) + (i16 >> 2)) * VROW + (16 * (g & 1) + 4 * (i16 & 3)) * 2;
#pragma unroll
    for (int sub = 0; sub < 2; ++sub)
#pragma unroll
        for (int s = 0; s < 2; ++s) { const bf16x8 pf = __builtin_bit_cast(bf16x8, pw[sub][s]);
#pragma unroll
            for (int db = 0; db < 2; ++db) { LAS const unsigned char* av = vp + (32 * sub + 16 * s) * VROW + 64 * db;
                const s16x4 lo = tr16(av), hh = tr16(av + 4 * VROW);
                const bf16x8 vf = (bf16x8){lo[0], lo[1], lo[2], lo[3], hh[0], hh[1], hh[2], hh[3]};
                if (db == 0) o0 = __builtin_amdgcn_mfma_f32_32x32x16_bf16(vf, pf, o0, 0, 0, 0); else o1 = __builtin_amdgcn_mfma_f32_32x32x16_bf16(vf, pf, o1, 0, 0, 0); } }
}
__device__ __forceinline__ void att_store(bf16_t* orow  , const f32x16& o0, const f32x16& o1, float inv, int hi) {
#pragma unroll
    for (int rr = 0; rr < 4; ++rr) { u32x2 w0, w1;
        w0.x = cvt_pk_bf16(o0[4 * rr] * inv, o0[4 * rr + 1] * inv); w0.y = cvt_pk_bf16(o0[4 * rr + 2] * inv, o0[4 * rr + 3] * inv);
        w1.x = cvt_pk_bf16(o1[4 * rr] * inv, o1[4 * rr + 1] * inv); w1.y = cvt_pk_bf16(o1[4 * rr + 2] * inv, o1[4 * rr + 3] * inv);
        *(u32x2*)(orow + 8 * rr + 4 * hi) = w0; *(u32x2*)(orow + 32 + 8 * rr + 4 * hi) = w1; }
}


struct BgConv {
    const float* w1; const float* w2; unsigned char* ws; LAS unsigned char* T;
    int pair, it, nit, step, sub;
    bool pendA, pendB; int psubA, psubB; unsigned char* pWTA; unsigned char* pWTB;
    f32x4 vA[4], vB[4];
};
__device__ __forceinline__ void bg_tile(const BgConv& S, int it, const float*& W, int& N, unsigned char*& WT, int& n0, int& k0) {
    constexpr int I1 = 32 * 8, I2 = 16 * 8, S1 = 32 * I1, S2 = 32 * I2;
    int mat, q; bool is1;
    if (it < S1) { is1 = true; mat = 32 + it / I1; q = it % I1; }
    else if (it < S1 + S2) { const int r = it - S1; is1 = false; mat = 32 + r / I2; q = r % I2; }
    else if (it < S1 + 2 * S2) { const int r = it - S1 - S2; is1 = false; mat = r / I2; q = r % I2; }
    else { const int r = it - S1 - 2 * S2; is1 = true; mat = r / I1; q = r % I1; }
    mat += S.pair * 64;
    if (is1) { W = S.w1 + (size_t)mat * 1024 * 2048; WT = S.ws + O_W1 + (size_t)mat * SZ_W1E; N = 2048; n0 = (q >> 3) * 64; k0 = (q & 7) * 128; }
    else { W = S.w2 + (size_t)mat * 1024 * 1024; WT = S.ws + O_W2 + (size_t)mat * SZ_W2E; N = 1024; n0 = (q >> 3) * 64; k0 = (q & 7) * 128; }
}
__device__ __forceinline__ void bg_init(BgConv& S, const Ctx& C, const float* w1, const float* w2, int pair) {
    S.w1 = w1; S.w2 = w2; S.ws = C.ws; S.T = C.lds + 49152 + C.wave * 9216; S.pair = pair; S.it = C.gw; S.nit = 64 * 256 + 64 * 128; S.step = C.NGW; S.sub = 0;
    S.pendA = false; S.pendB = false; S.psubA = 0; S.psubB = 0; S.pWTA = C.ws; S.pWTB = C.ws;
}
__device__ __forceinline__ bool bg_done(const BgConv& S) { return !S.pendA && !S.pendB && S.it >= S.nit; }
__device__ __forceinline__ void bg_half(BgConv& S, f32x4 (&v)[4], bool& pend, int& psub, unsigned char*& pWT, int lane) {
    const int kq = lane >> 4, c4 = lane & 15;
    if (pend) {
#pragma unroll
        for (int jj = 0; jj < 4; ++jj) *(LAS unsigned*)(S.T + (4 * c4 + jj) * 144 + 32 * kq + 4 * psub) = pk4_fp8(32.f * v[0][jj], 32.f * v[1][jj], 32.f * v[2][jj], 32.f * v[3][jj]);
        if (psub == 7) {
            asm volatile("s_waitcnt lgkmcnt(0)" ::: "memory");
#pragma unroll
            for (int s8 = 0; s8 < 8; ++s8) { const int n = 8 * s8 + (lane >> 3), ch = lane & 7; const u32x4 w = *(const LAS u32x4*)(S.T + n * 144 + 16 * ch);
                *(u32x4*)(pWT + (size_t)n * 1024 + 16 * ch) = w; }
            asm volatile("s_waitcnt lgkmcnt(0)" ::: "memory"); }
        pend = false; }
    if (S.it < S.nit) { const float* W; int N, n0, k0; unsigned char* WT; bg_tile(S, S.it, W, N, WT, n0, k0);
        const float* p = W + (size_t)(k0 + 32 * kq + 4 * S.sub) * N + n0 + 4 * c4;
#pragma unroll
        for (int i = 0; i < 4; ++i) v[i] = __builtin_nontemporal_load((const f32x4*)(p + (size_t)i * N));
        pend = true; psub = S.sub; pWT = WT + (size_t)n0 * 1024 + k0;
        if (++S.sub == 8) { S.sub = 0; S.it += S.step; } }
}
#define BG_STEP_A() bg_half(BG, BG.vA, BG.pendA, BG.psubA, BG.pWTA, lane)
#define BG_STEP_B() bg_half(BG, BG.vB, BG.pendB, BG.psubB, BG.pWTB, lane)

__device__ __forceinline__ void mla_unit(const Ctx& C, BgConv& BG, int b, int h, int qb) {
    constexpr int KROW = 208, VROW = 144, KB = 64 * KROW, BUF = KB + 64 * VROW;
    const bf16_t* Q2 = (const bf16_t*)(C.ws + O_Q2); const bf16_t* KV2 = (const bf16_t*)(C.ws + O_KV2); const bf16_t* PROJ = (const bf16_t*)(C.ws + O_PROJ); bf16_t* ATT = (bf16_t*)(C.ws + O_ATT);
    const int tid = C.tid, lane = C.lane, w = C.wave, i32 = lane & 31, hi = lane >> 5;
    const int q0 = qb * 256; const size_t rowb = (size_t)b * S_;
    bf16x8 qf[6];
    { const bf16_t* qrow = Q2 + (rowb + q0 + 32 * w + i32) * 768 + 8 * hi;
#pragma unroll
      for (int ks = 0; ks < 4; ++ks) qf[ks] = *(const bf16x8*)(qrow + h * 64 + 16 * ks);
      qf[4] = *(const bf16x8*)(qrow + 512 + h * 32); qf[5] = *(const bf16x8*)(qrow + 512 + h * 32 + 16); }
    f32x16 o0, o1;
#pragma unroll
    for (int r = 0; r < 16; ++r) { o0[r] = 0.f; o1[r] = 0.f; }
    float m = 0.f, l = 0.f; f32x16 negm;
#pragma unroll
    for (int r = 0; r < 16; ++r) negm[r] = 0.f;
    const int NT = 4 * qb + 4, wmax = 4 * qb + (w >> 1);
    const int r8 = tid >> 3, c8 = tid & 7, r4 = (tid & 255) >> 2, c4 = tid & 3;
    const bf16_t* knp = KV2 + (rowb + r8) * 1024 + h * 64 + 8 * c8; const bf16_t* kpp = PROJ + (rowb + r4) * 2048 + 1920 + 8 * c4;
    u32x4 kA, vA, pA, kB, vB, pB;
#define MLA_LOAD(j, K, V, P) do { const int jc_ = ((j) < NT) ? (j) : NT - 1; K = *(const u32x4*)(knp + (size_t)jc_ * 64 * 1024); V = *(const u32x4*)(knp + (size_t)jc_ * 64 * 1024 + 512); P = *(const u32x4*)(kpp + (size_t)jc_ * 64 * 2048); } while (0)
#define MLA_WRITE(bo, K, V, P) do { *(LAS u32x4*)(C.lds + (bo) + r8 * KROW + 16 * c8) = K; *(LAS u32x4*)(C.lds + (bo) + KB + r8 * VROW + 16 * c8) = V; *(LAS u32x4*)(C.lds + (bo) + r4 * KROW + 128 + 16 * c4) = P; } while (0)
#define MLA_STEP(j, KF, VF, PF, KN, VN, PN, BGS) do { const int j_ = (j); const int bo_ = (j_ & 1) * BUF; \
        MLA_LOAD(j_ + 2, KF, VF, PF); BGS(); \
        if (j_ <= wmax) { _Pragma("unroll 1") for (int dup_ = 0; dup_ < ATT_DUP; ++dup_) att_tile<6, false>(C.lds + bo_, C.lds + bo_ + KB, qf, o0, o1, negm, m, l, 64 * j_, q0 + 32 * w + i32, j_ == wmax, lane); } \
        MLA_WRITE(BUF - bo_, KN, VN, PN); \
        __syncthreads(); } while (0)
    MLA_LOAD(0, kA, vA, pA); MLA_LOAD(1, kB, vB, pB);
    MLA_WRITE(0, kA, vA, pA);
    __syncthreads();
#pragma unroll 1
    for (int j = 0; j < NT; j += 2) { MLA_STEP(j, kA, vA, pA, kB, vB, pB, BG_STEP_A); MLA_STEP(j + 1, kB, vB, pB, kA, vA, pA, BG_STEP_B); }
#undef MLA_STEP
#undef MLA_LOAD
#undef MLA_WRITE
    l = xadd32(l);
    att_store(ATT + (rowb + q0 + 32 * w + i32) * 1024 + 512 + h * 64, o0, o1, 1.f / l, hi);
}
__device__ __forceinline__ void dil_unit(const Ctx& C, BgConv& BG, int p, int dd, int b, int h, int res, int n) {
    constexpr int KROW = 144, VROW = 144, KB = 64 * KROW, BUF = KB + 64 * VROW;
    const bf16_t* PROJ = (const bf16_t*)(C.ws + O_PROJ); bf16_t* OA = (bf16_t*)(C.ws + O_OA) + (size_t)p * T_ * 512; float* LSE = (float*)(C.ws + O_LSE) + (size_t)p * T_ * 8;
    const int tid = C.tid, lane = C.lane, w = C.wave, i32 = lane & 31, hi = lane >> 5;
    const size_t rowb = (size_t)b * S_;
    const int qsub = 256 * n + 32 * w + i32; const size_t qtok = rowb + (size_t)qsub * dd + res;
    bf16x8 qf[4];
    { const bf16_t* qrow = PROJ + qtok * 2048 + h * 64 + 8 * hi;
#pragma unroll
      for (int ks = 0; ks < 4; ++ks) qf[ks] = *(const bf16x8*)(qrow + 16 * ks); }
    f32x16 o0, o1;
#pragma unroll
    for (int r = 0; r < 16; ++r) { o0[r] = 0.f; o1[r] = 0.f; }
    float m = 0.f, l = 0.f; f32x16 negm;
#pragma unroll
    for (int r = 0; r < 16; ++r) negm[r] = 0.f;
    const int jbeg = (n == 0) ? 2 : 0, wlo = w >> 1, whi = (32 * w + 159) >> 6;
    const int r8 = tid >> 3, c8 = tid & 7;
    u32x4 kA, vA, kB, vB;
    const int cnt = 6 - jbeg;
#define DIL_LOAD(i, K, V) do { const int jc_ = jbeg + (((i) < cnt) ? (i) : cnt - 1); const size_t tok = rowb + (size_t)(256 * n - 128 + 64 * jc_ + r8) * dd + res; const bf16_t* src = PROJ + tok * 2048 + 512 + h * 64 + 8 * c8; K = *(const u32x4*)src; V = *(const u32x4*)(src + 512); } while (0)
#define DIL_WRITE(bo, K, V) do { *(LAS u32x4*)(C.lds + (bo) + r8 * KROW + 16 * c8) = K; *(LAS u32x4*)(C.lds + (bo) + KB + r8 * VROW + 16 * c8) = V; } while (0)
#define DIL_STEP(i, KF, VF, KN, VN, BGS) do { const int i_ = (i); const int bo_ = (i_ & 1) * BUF, j_ = jbeg + i_; \
        DIL_LOAD(i_ + 2, KF, VF); BGS(); \
        if (i_ < cnt && j_ >= wlo && j_ <= whi) { const int kb0_ = 256 * n - 128 + 64 * j_, qlo_ = 256 * n + 32 * w; _Pragma("unroll 1") for (int dup_ = 0; dup_ < ATT_DUP; ++dup_) att_tile<4, true>(C.lds + bo_, C.lds + bo_ + KB, qf, o0, o1, negm, m, l, kb0_, qsub, !(kb0_ + 63 <= qlo_ && qlo_ + 31 - kb0_ <= 128), lane); } \
        DIL_WRITE(BUF - bo_, KN, VN); \
        __syncthreads(); } while (0)
    DIL_LOAD(0, kA, vA); DIL_LOAD(1, kB, vB);
    DIL_WRITE(0, kA, vA);
    __syncthreads();
    DIL_STEP(0, kA, vA, kB, vB, BG_STEP_A); DIL_STEP(1, kB, vB, kA, vA, BG_STEP_B); DIL_STEP(2, kA, vA, kB, vB, BG_STEP_A); DIL_STEP(3, kB, vB, kA, vA, BG_STEP_B);
    if (cnt == 6) { DIL_STEP(4, kA, vA, kB, vB, BG_STEP_A); DIL_STEP(5, kB, vB, kA, vA, BG_STEP_B); }
#undef DIL_STEP
#undef DIL_LOAD
#undef DIL_WRITE
    l = xadd32(l);
    att_store(OA + qtok * 512 + h * 64, o0, o1, 1.f / l, hi);
    if (hi == 0) LSE[qtok * 8 + h] = m + log2f(l);
}
#ifndef REP_MLA
#define REP_MLA 1
#endif
#ifndef REP_DIL
#define REP_DIL 1
#endif
__device__ __forceinline__ void phase_attention(const Ctx& C, const float* w1, const float* w2, int pair) {
    BgConv BG; bg_init(BG, C, w1, w2, pair);
#pragma unroll 1
    for (int rep = 0; rep < REP_MLA; ++rep) {
    if (C.G == 256) { const int bh = C.vcu >> 3, s = C.vcu & 7; mla_unit(C, BG, bh >> 3, bh & 7, s); mla_unit(C, BG, bh >> 3, bh & 7, 15 - s); }
    else for (int u = C.bid; u < 512; u += C.G) mla_unit(C, BG, u >> 7, (u >> 4) & 7, u & 15);
    }
#pragma unroll 1
    for (int rep = 0; rep < REP_DIL; ++rep)
    for (int u = C.bid; u < 1536; u += C.G) { const int p = u >> 9, rem = u & 511, b = rem >> 7, h = (rem >> 4) & 7, blk = rem & 15;
        const int dd = (p == 0) ? 1 : (p == 1) ? 4 : 16, bpr = 16 / dd;
        dil_unit(C, BG, p, dd, b, h, blk / bpr, blk % bpr); }
    { const int lane = C.lane;
#pragma unroll 1
      while (!bg_done(BG)) { BG_STEP_A(); BG_STEP_B(); } }
}
#undef BG_STEP_A
#undef BG_STEP_B

#ifdef TIME_NORM
constexpr int N_PHASES = 42;
#else
constexpr int N_PHASES = 36;
#endif
extern __shared__ __attribute__((aligned(16))) unsigned char lds_raw[];
typedef const __attribute__((address_space(4))) Args* ArgsP;
#define PHFN static __device__ __forceinline__ void
__device__ __forceinline__ ArgsP fresh_args() { unsigned long long p = (unsigned long long)__builtin_amdgcn_kernarg_segment_ptr(); asm volatile("" : "+s"(p)); return (ArgsP)p; }
__device__ __forceinline__ Ctx make_ctx(ArgsP ap, int wv) {
    Ctx C; C.lds = (LAS unsigned char*)lds_raw; C.ws = ap->ws;
    unsigned ones = ~0u; asm volatile("" : "+s"(ones)); const int lane = (int)__builtin_amdgcn_mbcnt_hi(ones, __builtin_amdgcn_mbcnt_lo(ones, 0u));
    int bid = blockIdx.x; asm volatile("" : "+s"(bid)); int G = gridDim.x; asm volatile("" : "+s"(G));
    C.wave = wv; C.lane = lane; C.tid = wv * 64 + lane;
    C.G = G; C.bid = bid; C.vcu = (C.G % 8 == 0) ? (C.bid % 8) * (C.G / 8) + C.bid / 8 : C.bid;
    C.gw = C.bid * 8 + C.wave; C.NGW = C.G * 8; return C;
}
#define IN(i) ((const float*)ap->in[i])
#define MODL(l) ((const float*)(C.ws + O_MOD) + (size_t)(l) * 4 * 6144)
PHFN ph_prologue(int wv) { const ArgsP ap = fresh_args(); const Ctx C = make_ctx(ap, wv); p0_prologue(C, ap); }
PHFN ph_norm(int wv, int l, int mode) { const ArgsP ap = fresh_args(); const Ctx C = make_ctx(ap, wv);
    if (mode == 0) phase_norm(C, IN(0), nullptr, false, true, IN(5), MODL(0), MODL(0), 0, 1024, false, true);
    else if (mode == 1) phase_norm(C, nullptr, nullptr, true, true, IN(5) + l * 1024, MODL(l - 1), MODL(l), 0, 1024, false, (l & 1) == 0);
    else if (mode == 3) phase_norm(C, nullptr, nullptr, true, true, IN(5) + l * 1024, MODL(l - 1), MODL(l), 0, 1024, true);
    else phase_norm(C, nullptr, ap->out, true, false, IN(5), MODL(3), MODL(3), 0, 1024); }
PHFN ph_proj(int wv, int j) { const ArgsP ap = fresh_args(); const Ctx C = make_ctx(ap, wv); unsigned char* ws = C.ws;
    DenseOrder S; S.init(ws + O_HN, ws + O_WIN + j * SZ_WIN, 1024, 1024, T_, 2048, C.G, C.bid, 1); EpiNorm<0> E{(bf16_t*)(ws + O_PROJ), 2048, IN(8) + j * 64, IN(9) + j * 64, IN(10) + j * 256, IN(11) + j * 128, IN(15) + j * 96 + 64, (const float*)(ws + O_CS), (LAS float*)(C.lds + LX_EXCH), 1.f / 32.f}; gemm_phase<true>(C, GemmDims{1024, 1024, 1024}, S, E); }
PHFN ph_postproj(int wv, int j) { const ArgsP ap = fresh_args(); const Ctx C = make_ctx(ap, wv); phase_postproj(C, IN(8) + j * 64, IN(9) + j * 64, IN(10) + j * 256, IN(11) + j * 128, IN(15) + j * 96); }
PHFN ph_qkv(int wv, int j) { const ArgsP ap = fresh_args(); const Ctx C = make_ctx(ap, wv); unsigned char* ws = C.ws;
    { DenseOrder S; S.init(ws + O_PROJ + 1536 * 2, ws + O_WUQ + j * SZ_WUQ, 2048, 256, T_, 768, C.G, C.bid); EpiNorm<1> E{(bf16_t*)(ws + O_Q2), 768, IN(14) + j * 96, IN(14) + j * 96 + 64, nullptr, nullptr, nullptr, (const float*)(ws + O_CS), (LAS float*)(C.lds + LX_EXCH), 1.f}; gemm_phase(C, GemmDims{256, 2048, 256}, S, E); }
    { const ArgsP ap2 = fresh_args(); const Ctx C = make_ctx(ap2, wv); unsigned char* ws = C.ws; DenseOrder S; S.init(ws + O_PROJ + 1792 * 2, ws + O_WUKV + j * SZ_WUKV, 2048, 128, T_, 1024, C.G, C.bid); EpiNorm<2> E{(bf16_t*)(ws + O_KV2), 1024, IN(15) + j * 96, nullptr, nullptr, nullptr, nullptr, (const float*)(ws + O_CS), (LAS float*)(C.lds + LX_EXCH), 1.f}; gemm_phase(C, GemmDims{128, 2048, 128}, S, E); } }
PHFN ph_postq(int wv, int j) { const ArgsP ap = fresh_args(); const Ctx C = make_ctx(ap, wv); phase_postq(C, IN(14) + j * 96, IN(15) + j * 96); }
PHFN ph_attention(int wv, int pair) { const ArgsP ap = fresh_args(); const Ctx C = make_ctx(ap, wv); phase_attention(C, IN(30), IN(32), pair); }
PHFN ph_mixcombine(int wv) { const ArgsP ap = fresh_args(); const Ctx C = make_ctx(ap, wv); phase_mixcombine(C); }
PHFN ph_outproj(int wv, int l, int which) { const ArgsP ap = fresh_args(); const Ctx C = make_ctx(ap, wv); unsigned char* ws = C.ws; const int j = l >> 1;
    DenseOrder S; S.init(ws + O_ATT, ws + (which ? O_RWOUT + j * SZ_RWOUT : O_WOUT + j * SZ_WOUT), 1024, 1024, T_, 1024, C.G, C.bid);
    EpiResid E{(bf16_t*)(ws + O_X), MODL(l) + 2048, which ? IN(27) + j * 1024 : nullptr}; gemm_phase(C, GemmDims{1024, 1024, 1024}, S, E); }
PHFN ph_router(int wv, int l) { const ArgsP ap = fresh_args(); const Ctx C = make_ctx(ap, wv); phase_router(C, (const bf16_t*)(C.ws + O_X), IN(6) + l * 1024, MODL(l), IN(28) + (size_t)l * 1024 * 32, IN(29) + l * 32, l); }
PHFN ph_moe1(int wv, int l) { const ArgsP ap = fresh_args(); const Ctx C = make_ctx(ap, wv); unsigned char* ws = C.ws; moe_plan_lds(C, l);
    MoeOrderT<true> S; S.A = (const char*)(ws + O_HN); S.WT = (const char*)(ws + O_W1 + (size_t)l * 32 * SZ_W1E); S.estride = SZ_W1E; S.tile_e = (const LAS int*)(C.lds + LX_TILE);
    S.NT = *(const LAS int*)(C.lds + LX_MISC + 128); S.nN = 8; S.G = C.G; S.c = C.bid; S.esz = 1; S.gtab = (const LAS int*)(C.lds + LX_GTAB);
    { const int* inv = (const int*)(ws + O_INV); LAS int* gt = (LAS int*)(C.lds + LX_GTAB); const LAS int* tot = (const LAS int*)(C.lds + LX_MISC + 256); const LAS int* pst = tot + 32;
      const int r = C.tid & 255, i0 = __builtin_amdgcn_readfirstlane(C.tid >> 8); int val[GTAB_UNITS / 2]; float bvl[GTAB_UNITS / 2]; const float* b1 = IN(31) + (size_t)l * 32 * 2048;
#pragma unroll
      for (int k = 0; k < GTAB_UNITS / 2; ++k) { Unit u; const bool ok = S.next(2 * k + i0, u); const int e = ok ? u.e : 0, j = (ok ? u.row0 - pst[e] : 0) + r; val[k] = (ok && j < tot[e]) ? inv[e * 16384 + j] : 0;
          bvl[k] = ok ? b1[(size_t)e * 2048 + u.col0 + r] : 0.f; }
      MoeOrder S2; S2.A = nullptr; S2.WT = nullptr; S2.estride = 0; S2.tile_e = S.tile_e; S2.NT = S.NT; S2.nN = 4; S2.G = C.G; S2.c = C.bid; S2.esz = 1; float b2v[3]; const float* b2 = IN(33) + (size_t)l * 32 * 1024;
#pragma unroll
      for (int k = 0; k < 3; ++k) { Unit u2; const bool ok2 = S2.next(2 * k + i0, u2); b2v[k] = ok2 ? b2[(size_t)u2.e * 1024 + u2.col0 + r] : 0.f; }
      { const int* topi = (const int*)(ws + O_TOPI); const int* posj = (const int*)(ws + O_POSJ); int* pos = (int*)(ws + O_POS);
        for (int ck = C.bid; ck < 256; ck += C.G) if (C.tid < 256) pos[ck * 256 + C.tid] = pst[topi[ck * 256 + C.tid]] + posj[ck * 256 + C.tid]; }
#pragma unroll
      for (int k = 0; k < GTAB_UNITS / 2; ++k) { gt[(2 * k + i0) * 256 + r] = val[k]; ((LAS float*)(C.lds + LX_BIAS))[(2 * k + i0) * 256 + r] = bvl[k]; }
#pragma unroll
      for (int k = 0; k < 3; ++k) ((LAS float*)(C.lds + LX_BIAS + GTAB_UNITS * 1024))[(2 * k + i0) * 256 + r] = b2v[k];
      __syncthreads(); }
    EpiSwiglu E{(unsigned char*)(ws + O_ACT), (const LAS float*)(C.lds + LX_BIAS), 1.f / 32.f}; gemm_phase<true>(C, GemmDims{1024, 1024, 1024}, S, E); }
PHFN ph_moe2(int wv, int l) { const ArgsP ap = fresh_args(); const Ctx C = make_ctx(ap, wv); unsigned char* ws = C.ws;
#if MODE != 1
    moe_plan_lds(C, l);
#endif

    MoeOrder S; S.A = (const char*)(ws + O_ACT); S.WT = (const char*)(ws + O_W2 + (size_t)l * 32 * SZ_W2E); S.estride = SZ_W2E; S.tile_e = (const LAS int*)(C.lds + LX_TILE);
    S.NT = *(const LAS int*)(C.lds + LX_MISC + 128); S.nN = 4; S.G = C.G; S.c = C.bid; S.esz = 1;
#if MODE != 1
    { const float* b2 = IN(33) + (size_t)l * 32 * 1024; const int r = C.tid & 255, i0 = __builtin_amdgcn_readfirstlane(C.tid >> 8); float bvl[3];
#pragma unroll
      for (int k = 0; k < 3; ++k) { Unit u; const bool ok = S.next(2 * k + i0, u); bvl[k] = ok ? b2[(size_t)u.e * 1024 + u.col0 + r] : 0.f; }
#pragma unroll
      for (int k = 0; k < 3; ++k) ((LAS float*)(C.lds + LX_BIAS + GTAB_UNITS * 1024))[(2 * k + i0) * 256 + r] = bvl[k];
      __syncthreads(); }
#endif
    EpiY8 E{ws + O_Y2, 1.f / 32.f, (const LAS float*)(C.lds + LX_BIAS + GTAB_UNITS * 1024)}; gemm_phase<true>(C, GemmDims{1024, 1024, 1024}, S, E); }
PHFN ph_recin(int wv, int j) { const ArgsP ap = fresh_args(); const Ctx C = make_ctx(ap, wv); unsigned char* ws = C.ws;
    DenseOrder S; S.init(ws + O_HN, ws + O_RWIN + j * SZ_RWIN, 1024, 1024, T_, 2048, C.G, C.bid); EpiRecIn E{(bf16_t*)(ws + O_PROJ), IN(18) + j * 2048}; gemm_phase(C, GemmDims{1024, 1024, 1024}, S, E); }
PHFN ph_rgate(int wv, int j) { const ArgsP ap = fresh_args(); const Ctx C = make_ctx(ap, wv); phase_rgate(C, j, IN(19) + j * 4096, IN(20) + j * 1024, IN(22) + j * 1024, IN(24) + j * 1024); }
PHFN ph_scan_apply(int wv) { const ArgsP ap = fresh_args(); const Ctx C = make_ctx(ap, wv); phase_scan_apply(C); }

#if MODE == 1
__device__ __forceinline__ int fresh_tid(int wv) { unsigned ones = ~0u; asm volatile("" : "+s"(ones)); return wv * 64 + (int)__builtin_amdgcn_mbcnt_hi(ones, __builtin_amdgcn_mbcnt_lo(ones, 0u)); }
__device__ __forceinline__ void grid_barrier(int wv) { const ArgsP q = fresh_args(); XcdBarrier b; b.bar = (unsigned*)(q->ws + O_CTL) + CW_BAR; b.x = xb_xcc_id(); b.st = (volatile LAS unsigned*)((LAS unsigned char*)lds_raw + LDSX_OFF); xcd_barrier(b, fresh_tid(wv)); }
__global__ void __launch_bounds__(512, 2) mk_fwd(Args a) {
    int wv = __builtin_amdgcn_readfirstlane(threadIdx.x >> 6); asm volatile("" : "+s"(wv));
    { LAS unsigned char* lds = (LAS unsigned char*)lds_raw;
      for (int u = threadIdx.x; u < (LDS_BYTES - LDSX_OFF) / 4; u += 512) ((LAS unsigned*)(lds + LDSX_OFF))[u] = 0u;
      __syncthreads();
      if (a.ph_hi - a.ph_lo > 1) (void)xcd_barrier_post((unsigned*)(a.ws + O_CTL) + CW_BAR, (volatile LAS unsigned*)(lds + LDSX_OFF), (int)threadIdx.x); }
    int pid = 0;
#define PHASE(call) { const ArgsP q_ = fresh_args(); const int lo_ = q_->ph_lo, hi_ = q_->ph_hi; if (pid >= lo_ && pid < hi_) { call; if (pid + 1 < hi_) grid_barrier(wv); } ++pid; }
#define PHASE_R(call, REP) { const ArgsP q_ = fresh_args(); const int lo_ = q_->ph_lo, hi_ = q_->ph_hi; if (pid >= lo_ && pid < hi_) { if ((REP) > 1) { call; grid_barrier(wv); } call; if (pid + 1 < hi_) grid_barrier(wv); } ++pid; }
#ifndef REP_PROLOGUE
#define REP_PROLOGUE 1
#endif
#ifndef REP_MOE
#define REP_MOE 1
#endif
#ifndef REP_ATTN
#define REP_ATTN 1
#endif
#ifndef REP_GEMMS
#define REP_GEMMS 1
#endif
#ifdef TIME_NORM
#define NORM_EXTRA(l) PHASE(ph_norm(wv, l, 3))
#else
#define NORM_EXTRA(l)
#endif
#ifndef REP_ELEM
#define REP_ELEM 1
#endif
#ifndef REP_ROUTER
#define REP_ROUTER REP_ELEM
#endif
#ifndef REP_SCATTER
#define REP_SCATTER REP_ELEM
#endif
#ifndef REP_MIX
#define REP_MIX REP_ELEM
#endif
#ifndef REP_CONV
#define REP_CONV REP_ELEM
#endif
#ifndef REP_SCANA
#define REP_SCANA REP_ELEM
#endif
#define MOE_PHASES(l) PHASE_R(ph_router(wv, l), REP_ROUTER) PHASE_R(ph_moe1(wv, l), REP_MOE) PHASE_R(ph_moe2(wv, l), REP_MOE)
    PHASE_R(ph_prologue(wv), REP_PROLOGUE)
#define LAYER_PAIR(lp) \
        { const int l = 2 * (lp);         \
          PHASE(ph_norm(wv, l, (lp) == 0 ? 0 : 1)) PHASE_R(ph_proj(wv, lp), REP_GEMMS) PHASE_R(ph_qkv(wv, lp), REP_GEMMS) PHASE_R(ph_attention(wv, lp), REP_ATTN) PHASE_R(ph_mixcombine(wv), REP_MIX) PHASE(ph_outproj(wv, l, 0)) \
          MOE_PHASES(l) } \
        { const int l = 2 * (lp) + 1;     \
          NORM_EXTRA(l) PHASE(ph_norm(wv, l, 1)) PHASE_R(ph_recin(wv, lp), REP_GEMMS) PHASE_R(ph_rgate(wv, lp), REP_CONV) PHASE_R(ph_scan_apply(wv), REP_SCANA) PHASE(ph_outproj(wv, l, 1)) \
          MOE_PHASES(l) }
    LAYER_PAIR(0)
    LAYER_PAIR(1)
#undef LAYER_PAIR
#ifdef EXTRA_BARRIERS
    { const ArgsP q_ = fresh_args(); if (q_->ph_hi - q_->ph_lo > 1) { _Pragma("unroll 1") for (int xb = 0; xb < EXTRA_BARRIERS; ++xb) grid_barrier(wv); } }
#endif
    PHASE(ph_norm(wv, 3, 2))
#undef PHASE
#undef PHASE_R
#undef MOE_PHASES
}
#else
template <int PH> __global__ void __launch_bounds__(512, 2) k_phase(Args a, int l, int x) {
    int wv = __builtin_amdgcn_readfirstlane(threadIdx.x >> 6); asm volatile("" : "+s"(wv));
    LAS unsigned char* lds = (LAS unsigned char*)lds_raw;
    for (int u = threadIdx.x; u < (LDS_BYTES - LDSX_OFF) / 4; u += 512) ((LAS unsigned*)(lds + LDSX_OFF))[u] = 0u;
    __syncthreads();
    if constexpr (PH == 0) ph_prologue(wv);
    if constexpr (PH == 1) ph_norm(wv, l, x);
    if constexpr (PH == 2) ph_proj(wv, l);
    if constexpr (PH == 4) ph_qkv(wv, l);
    if constexpr (PH == 6) ph_attention(wv, l);
    if constexpr (PH == 7) ph_mixcombine(wv);
    if constexpr (PH == 8) ph_outproj(wv, l, x);
    if constexpr (PH == 9) ph_router(wv, l);
    if constexpr (PH == 11) ph_moe1(wv, l);
    if constexpr (PH == 12) ph_moe2(wv, l);
    if constexpr (PH == 13) ph_recin(wv, l);
    if constexpr (PH == 14) ph_rgate(wv, l);
    if constexpr (PH == 17) ph_scan_apply(wv);
}
#endif
#undef IN
#undef MODL
}

#ifndef MODE
#define MODE 2
#endif
extern "C" void kernel_launch(void* const* d_in, const int* in_sizes, int n_in, void* d_out, int out_size, void* d_ws, size_t ws_size, hipStream_t stream) {
    (void)in_sizes; (void)n_in; (void)out_size; (void)ws_size;
#if MODE == 0
    nv::forward(d_in, (float*)d_out, d_ws, stream);
#else
    static int grid = 0;
    if (grid == 0) {
        int dev = 0, cus = 0;
        (void)hipGetDevice(&dev); (void)hipDeviceGetAttribute(&cus, hipDeviceAttributeMultiprocessorCount, dev);
#if MODE == 1
        (void)hipFuncSetAttribute((const void*)mk::mk_fwd, hipFuncAttributeMaxDynamicSharedMemorySize, mk::LDS_BYTES);
#else
#define SA(PH) (void)hipFuncSetAttribute((const void*)mk::k_phase<PH>, hipFuncAttributeMaxDynamicSharedMemorySize, mk::LDS_BYTES)
        SA(0); SA(1); SA(2); SA(4); SA(6); SA(7); SA(8); SA(9); SA(10); SA(11); SA(12); SA(13); SA(14); SA(17);
#undef SA
#endif
        grid = cus > 0 ? cus : 256;
    }
    (void)hipMemsetAsync((char*)d_ws + mk::O_CTL, 0, 64 * 1024, stream);
    mk::Args a;
    memset(&a, 0, sizeof(a));
    for (int i = 0; i < 34; ++i) a.in[i] = d_in[i];
    a.out = (float*)d_out; a.ws = (unsigned char*)d_ws;
#if MODE == 1
    a.ph_lo = 0; a.ph_hi = mk::N_PHASES;
    hipLaunchKernelGGL(mk::mk_fwd, dim3(grid), dim3(512), mk::LDS_BYTES, stream, a);
#else
#define LP(PH, l, x) hipLaunchKernelGGL(mk::k_phase<PH>, dim3(grid), dim3(512), mk::LDS_BYTES, stream, a, l, x)
    LP(0, 0, 0);
    for (int lp = 0; lp < 2; ++lp) {
        { const int l = 2 * lp; LP(1, l, lp == 0 ? 0 : 1); LP(2, lp, 0); LP(4, lp, 0); LP(6, lp, 0); LP(7, 0, 0); LP(8, l, 0); LP(9, l, 0); LP(10, 0, 0); LP(11, l, 0); LP(12, l, 0); }
        { const int l = 2 * lp + 1; LP(1, l, 1); LP(13, lp, 0); LP(14, lp, 0); LP(17, 0, 0); LP(8, l, 1); LP(9, l, 0); LP(10, 0, 0); LP(11, l, 0); LP(12, l, 0); }
    }
    LP(1, 3, 2);
#undef LP
#endif
#endif
}
```

```cpp
#define MODE 1

#include <string.h>
#include <hip/hip_runtime.h>
#include <stdint.h>
#include <math.h>

namespace cfg {
constexpr int D = 1024, NB = 4, S = 4096, T = NB * S, DEPTH = 4;
constexpr int MIXIN = 1952;
constexpr int NE = 32, TOPK = 4;
constexpr int MPAIR = T * TOPK;
constexpr int NBLK = MPAIR / 256 + NE;
constexpr int P = NBLK * 256;
}
using namespace cfg;


namespace mk {
#define LAS __attribute__((address_space(3)))
#define GAS __attribute__((address_space(1)))
typedef unsigned short bf16_t;
typedef short bf16x8 __attribute__((ext_vector_type(8)));
typedef short s16x4 __attribute__((ext_vector_type(4)));
typedef float f32x2 __attribute__((ext_vector_type(2)));
typedef float f32x4 __attribute__((ext_vector_type(4)));
typedef float f32x16 __attribute__((ext_vector_type(16)));
typedef unsigned u32x2 __attribute__((ext_vector_type(2)));
typedef unsigned u32x4 __attribute__((ext_vector_type(4)));
typedef GAS unsigned gu32;
#define RLX_AGENT __ATOMIC_RELAXED, __HIP_MEMORY_SCOPE_AGENT

__device__ __forceinline__ unsigned cvt_pk_bf16(float lo, float hi) { unsigned r; asm volatile("v_cvt_pk_bf16_f32 %0, %1, %2" : "=v"(r) : "v"(lo), "v"(hi)); return r; }
__device__ __forceinline__ float bf_lo(unsigned u) { return __uint_as_float(u << 16); }
__device__ __forceinline__ float bf_hi(unsigned u) { return __uint_as_float(u & 0xffff0000u); }
template <int O> __device__ __forceinline__ float shx(float v) { static_assert(O >= 1 && O < 32, "shx"); return __int_as_float(__builtin_amdgcn_ds_swizzle(__float_as_int(v), (O << 10) | 0x1f)); }
__device__ __forceinline__ float xadd32(float v) { const auto r = __builtin_amdgcn_permlane32_swap(__float_as_uint(v), __float_as_uint(v), false, false); return __uint_as_float(r[0]) + __uint_as_float(r[1]); }
__device__ __forceinline__ float xmax32(float v) { const auto r = __builtin_amdgcn_permlane32_swap(__float_as_uint(v), __float_as_uint(v), false, false); return fmaxf(__uint_as_float(r[0]), __uint_as_float(r[1])); }
#define DPP_STEP(OP, N) asm("s_nop 1\n\t" OP "_dpp %0, %1, %1 row_ror:" #N " row_mask:0xf bank_mask:0xf" : "=v"(r) : "v"(v)); v = r;
__device__ __forceinline__ float rsum16(float v) { float r; DPP_STEP("v_add_f32", 1) DPP_STEP("v_add_f32", 2) DPP_STEP("v_add_f32", 4) DPP_STEP("v_add_f32", 8) return v; }
__device__ __forceinline__ float rmax16(float v) { float r; DPP_STEP("v_max_f32", 1) DPP_STEP("v_max_f32", 2) DPP_STEP("v_max_f32", 4) DPP_STEP("v_max_f32", 8) return v; }
#undef DPP_STEP
__device__ __forceinline__ float fmax_raw(float a, float b) { float r; asm("v_max_f32 %0, %1, %2" : "=v"(r) : "v"(a), "v"(b)); return r; }
__device__ __forceinline__ float wsum(float v) { v = rsum16(v); v += shx<16>(v); return xadd32(v); }
__device__ __forceinline__ float fexp2(float x) { return __builtin_amdgcn_exp2f(x); }
__device__ __forceinline__ float frcp(float x) { return __builtin_amdgcn_rcpf(x); }
__device__ __forceinline__ float fsigmoid(float z) { return frcp(1.f + fexp2(-1.4426950408889634f * z)); }
__device__ __forceinline__ float fgelu_tanh(float x) { const float u = 0.7978845608028654f * (x + 0.044715f * x * x * x); return x * frcp(1.f + fexp2(-2.8853900817779268f * u)); }

#define XB_TMO      128
#define XB_XCNT(j)  (256  + 64 * (j))
#define XB_XSUB(j)  (1280 + 64 * (j))
#define XB_XGEN(j)  (2304 + 64 * (j))
#define XB_TOP      3328
#define XB_TOPGEN   3392
#define XCD_BAR_WORDS 3456
#define XB_SPIN_CAP (1u << 18)
__device__ __forceinline__ unsigned xb_ld(unsigned* p)              { return __hip_atomic_load(p, __ATOMIC_RELAXED, __HIP_MEMORY_SCOPE_AGENT); }
__device__ __forceinline__ unsigned xb_add(unsigned* p, unsigned v) { return __hip_atomic_fetch_add(p, v, __ATOMIC_RELAXED, __HIP_MEMORY_SCOPE_AGENT); }
__device__ __forceinline__ unsigned xb_xcc_id() { return (unsigned)__builtin_amdgcn_s_getreg((3 << 11) | 20) & 0xFu; }
#define XB_SPIN(cond, bar) do { unsigned _sp = 0; while (cond) { __builtin_amdgcn_s_sleep(1); \
    if ((++_sp & 255u) == 0u) { if (xb_ld(&(bar)[XB_TMO])) break; if (_sp > XB_SPIN_CAP) { atomicAdd(&(bar)[XB_TMO], 1u); break; } } } } while (0)
struct XcdBarrier { unsigned* bar; unsigned x; volatile LAS unsigned* st; };
__device__ __forceinline__ XcdBarrier xcd_barrier_post(unsigned* bar, volatile LAS unsigned* st, int tid) {
    XcdBarrier b; b.bar = bar; b.x = xb_xcc_id(); b.st = st;
    if (tid == 0) (void)xb_add(&bar[XB_XCNT(b.x)], 1u);
    return b;
}
__device__ __forceinline__ void xcd_barrier_complete(unsigned* bar, unsigned x, unsigned& nloc, unsigned& nx) {
    const unsigned G = gridDim.x * gridDim.y * gridDim.z;
    unsigned sum, cnt, mine, sp = 0u;
    for (;;) {
        sum = 0u; cnt = 0u; mine = 0u;
#pragma unroll
        for (unsigned j = 0; j < 16; ++j) { const unsigned c = xb_ld(&bar[XB_XCNT(j)]); sum += c; cnt += (c > 0u) ? 1u : 0u; mine = (j == x) ? c : mine; }
        if (sum == G) break;
        __builtin_amdgcn_s_sleep(1);
        if ((++sp & 255u) == 0u) { if (xb_ld(&bar[XB_TMO])) break; if (sp > XB_SPIN_CAP) { atomicAdd(&bar[XB_TMO], 1u); break; } }
    }
    nloc = mine > 0u ? mine : 1u; nx = cnt > 0u ? cnt : 1u;
}
__device__ __forceinline__ void xcd_barrier(const XcdBarrier& b, int tid) {
    asm volatile("s_waitcnt vmcnt(0)" ::: "memory");
    __syncthreads();
    if (tid == 0) {
        unsigned* bar = b.bar;
        __builtin_amdgcn_s_waitcnt(0);
        unsigned nloc = b.st[0], nx = b.st[1];
        if (nloc == 0u) { xcd_barrier_complete(bar, b.x, nloc, nx); b.st[0] = nloc; b.st[1] = nx; }
        const unsigned old = xb_add(&bar[XB_XSUB(b.x)], 1u);
        const unsigned gen = old / nloc;
        if (old + 1u == (gen + 1u) * nloc) {
            __builtin_amdgcn_fence(__ATOMIC_RELEASE, "agent");
            asm volatile("s_waitcnt vmcnt(0)" ::: "memory");
            const unsigned og = xb_add(&bar[XB_TOP], 1u);
            const unsigned tg = og / nx;
            if (og + 1u == (tg + 1u) * nx) xb_add(&bar[XB_TOPGEN], 1u);
            else XB_SPIN(xb_ld(&bar[XB_TOPGEN]) == tg, bar);
            __builtin_amdgcn_fence(__ATOMIC_ACQUIRE, "agent");
            xb_add(&bar[XB_XGEN(b.x)], 1u);
            asm volatile("s_waitcnt vmcnt(0)" ::: "memory");
        } else {
            XB_SPIN(xb_ld(&bar[XB_XGEN(b.x)]) == gen, bar);
            __builtin_amdgcn_fence(__ATOMIC_ACQUIRE, "agent");
            asm volatile("s_waitcnt vmcnt(0)" ::: "memory");
        }
    }
    __syncthreads();
}

constexpr int BM = 256, BK = 64, HALF = 128, HTB = HALF * BK * 2, STAGE_BYTES = 8 * HTB;
__host__ __device__ __forceinline__ int lds_byte(int r, int c) { const int st = (r >> 4) * 2 + (c >> 5), rr = r & 15, cc = c & 31, ob = rr * 64 + cc * 2; return st * 1024 + (ob ^ (((ob >> 9) & 1) << 5)); }
__host__ __device__ __forceinline__ void stage_rc(int b, int& R, int& C) { const int st = b / 1024, sb = b % 1024, swz = sb ^ (((sb >> 9) & 1) << 5); R = (st >> 1) * 16 + swz / 64; C = (st & 1) * 32 + (swz % 64) / 2; }
__host__ __device__ __forceinline__ int perm32(int rho) { const int n = rho >> 4, i = rho & 15; return 8 * (i >> 2) + 4 * n + (i & 3); }

struct Unit { const char* a; const char* b; int row0, col0, e, pad; };
struct GemmDims { int K, lda, ldb; };
typedef f32x4 Acc[2][2][4][2];
__device__ __forceinline__ void zero_acc(Acc& acc) {
#pragma unroll
    for (int a = 0; a < 2; ++a)
#pragma unroll
        for (int b = 0; b < 2; ++b)
#pragma unroll
            for (int m = 0; m < 4; ++m)
#pragma unroll
                for (int n = 0; n < 2; ++n)
                    { f32x2 z0, z1; asm volatile("v_mov_b64 %0, 0" : "=v"(z0)); asm volatile("v_mov_b64 %0, 0" : "=v"(z1)); acc[a][b][m][n] = (f32x4){z0[0], z0[1], z1[0], z1[1]}; }
}

typedef int v8i32 __attribute__((ext_vector_type(8)));
template <bool F8 = false, class CtxT, class Epi, class Sched>
__device__ __forceinline__ void gemm_phase(const CtxT& C, const GemmDims g, const Sched& S, const Epi& E) {
    LAS unsigned char* lds = C.lds;
    const int tid = C.tid, wid = __builtin_amdgcn_readfirstlane(tid >> 6), lane = tid & 63, wr = wid >> 2, wc = wid & 3, fr = lane & 15, fq = lane >> 4;
    constexpr int ESZ = F8 ? 1 : 2;
    constexpr bool GA = Sched::GATHER;
    int nt = g.K / (F8 ? 128 : BK); asm volatile("" : "+s"(nt));
    unsigned voffA[2], voffB[2];
#pragma unroll
    for (int i = 0; i < 2; ++i) { int R, C; stage_rc(tid * 16 + i * 8192, R, C); const int Rb = (R & ~31) + perm32(R & 31);
        voffA[i] = (unsigned)(R * g.lda * ESZ + C * 2); voffB[i] = (unsigned)(Rb * g.ldb * ESZ + C * 2); }
    unsigned voffG[2][2];
    auto load_goffs = [&](int uidx) { if constexpr (GA) { int R, Cc; stage_rc(tid * 16, R, Cc); const LAS int* tp = S.gtab + uidx * 256 + R;
#pragma unroll
        for (int h = 0; h < 2; ++h)
#pragma unroll
            for (int i = 0; i < 2; ++i) voffG[h][i] = (unsigned)tp[h * 128 + i * 64] * (unsigned)(g.lda * ESZ) + (unsigned)(Cc * 2); } };
    const size_t kstep = (size_t)(BK * 2);
    const size_t hstepA = (size_t)HALF * g.lda * ESZ, hstepB = (size_t)HALF * g.ldb * ESZ;
    const unsigned ldsw = (unsigned)wid * 1024u;
    const unsigned ldsu = (unsigned)__builtin_amdgcn_readfirstlane((int)(unsigned)(unsigned long long)(lds));
    const int aoff = lds_byte(wr * 64 + fr, fq * 8), boff = lds_byte(wc * 32 + fr, fq * 8);
#define PG8_SA(b, h) (((b) * 2 + (h)) * HTB)
#define PG8_SB(b, h) ((4 + (b) * 2 + (h)) * HTB)
#define PG8_STAGE(bufoff, gbase, voff) do { _Pragma("unroll") for (int _i = 0; _i < 2; ++_i) { \
        asm volatile("s_mov_b32 m0, %2\n\ts_nop 3\n\tglobal_load_lds_dwordx4 %0, %1" :: "v"((voff)[_i]), "s"((const char*)(gbase)), "s"(ldsu + (unsigned)(bufoff) + ldsw + (unsigned)(_i * 8192)) : "memory"); } } while (0)
#define PG8_STAGE_A(bufoff, gbase, h) do { if constexpr (GA) PG8_STAGE(bufoff, gbase, voffG[h]); else PG8_STAGE(bufoff, (gbase) + (h) * hstepA, voffA); } while (0)
#define PG8_LDA(dst, b, h) do { _Pragma("unroll") for (int m = 0; m < 4; ++m) _Pragma("unroll") for (int k = 0; k < 2; ++k) dst[m][k] = *(const LAS bf16x8*)(lds + PG8_SA(b, h) + aoff + m * 2048 + k * 1024); } while (0)
#define PG8_LDB(dst, b, h) do { _Pragma("unroll") for (int n = 0; n < 2; ++n) _Pragma("unroll") for (int k = 0; k < 2; ++k) dst[n][k] = *(const LAS bf16x8*)(lds + PG8_SB(b, h) + boff + n * 2048 + k * 1024); } while (0)
#define PG8_CAT(x) __builtin_bit_cast(v8i32, (x))
#define PG8_MMA(ai, bj, At, Bt) do { __builtin_amdgcn_s_setprio(1); \
        if constexpr (F8) { _Pragma("unroll") for (int m = 0; m < 4; ++m) _Pragma("unroll") for (int n = 0; n < 2; ++n) \
            acc[ai][bj][m][n] = __builtin_amdgcn_mfma_scale_f32_16x16x128_f8f6f4(PG8_CAT(Bt[n]), PG8_CAT(At[m]), acc[ai][bj][m][n], 0, 0, 0, 0, 0, 0); } \
        else { _Pragma("unroll") for (int m = 0; m < 4; ++m) _Pragma("unroll") for (int n = 0; n < 2; ++n) _Pragma("unroll") for (int k = 0; k < 2; ++k) \
            acc[ai][bj][m][n] = __builtin_amdgcn_mfma_f32_16x16x32_bf16(Bt[n][k], At[m][k], acc[ai][bj][m][n], 0, 0, 0); } \
        __builtin_amdgcn_s_setprio(0); } while (0)
#define PG8_WAIT_V(n) asm volatile("s_waitcnt vmcnt(" #n ")" ::: "memory")
#define PG8_WAIT_L(n) asm volatile("s_waitcnt lgkmcnt(" #n ")" ::: "memory")
#define PG8_BAR __builtin_amdgcn_s_barrier()
#define PG8_SCHED __builtin_amdgcn_sched_barrier(0)
    Unit cur, nxt; int ui = 0;
    if (!S.next(0, cur)) return;
    Acc acc; zero_acc(acc);
    struct Frag2 { bf16x8 p[2]; __device__ __forceinline__ bf16x8& operator[](int k) { return p[k]; } __device__ __forceinline__ const bf16x8& operator[](int k) const { return p[k]; } };
    Frag2 At[4], B0[2], B1[2];
    const char* cA = cur.a; const char* cB = cur.b;
    load_goffs(0);
    PG8_STAGE(PG8_SB(0, 0), cB, voffB); PG8_STAGE(PG8_SB(0, 1), cB + hstepB, voffB); PG8_STAGE_A(PG8_SA(0, 0), cA, 0); PG8_STAGE_A(PG8_SA(0, 1), cA, 1);
    if (wr == 1) PG8_BAR;
    PG8_WAIT_V(2); PG8_BAR;
    PG8_STAGE(PG8_SB(1, 0), cB + kstep, voffB); PG8_STAGE_A(PG8_SA(1, 0), cA + kstep, 0); PG8_STAGE(PG8_SB(1, 1), cB + hstepB + kstep, voffB);
    PG8_WAIT_V(6); PG8_BAR;
    for (;;) {
        const bool has_next = S.next(ui + 1, nxt);
        const char* nA = has_next ? nxt.a : cA; const char* nB = has_next ? nxt.b : cB;
        for (int t = 0; t < nt; t += 2) {
            const bool last = (t == nt - 2);
            const char* a1 = cA + (size_t)(t + 1) * kstep;
            const char* a2 = last ? nA : cA + (size_t)(t + 2) * kstep; const char* b2 = last ? nB : cB + (size_t)(t + 2) * kstep;
            const char* a3 = a2 + kstep; const char* b3 = b2 + kstep;
            PG8_LDB(B0, 0, 0); PG8_LDB(B1, 0, 1); PG8_SCHED; PG8_LDA(At, 0, 0); PG8_STAGE_A(PG8_SA(1, 1), a1, 1);
            if (GA && last && has_next) load_goffs(ui + 1);
            PG8_WAIT_V(8); PG8_WAIT_L(0); PG8_BAR; PG8_MMA(0, 0, At, B0); PG8_MMA(0, 1, At, B1); PG8_BAR; PG8_SCHED;
            PG8_LDA(At, 0, 1); PG8_STAGE(PG8_SB(0, 0), b2, voffB); PG8_STAGE(PG8_SB(0, 1), b2 + hstepB, voffB); PG8_STAGE_A(PG8_SA(0, 0), a2, 0);
            PG8_WAIT_V(8); PG8_WAIT_L(0); PG8_BAR; PG8_MMA(1, 0, At, B0); PG8_MMA(1, 1, At, B1); PG8_BAR; PG8_SCHED;
            PG8_LDB(B0, 1, 0); PG8_LDB(B1, 1, 1); PG8_SCHED; PG8_LDA(At, 1, 0); PG8_STAGE_A(PG8_SA(0, 1), a2, 1);
            PG8_WAIT_V(8); PG8_WAIT_L(0); PG8_BAR; PG8_MMA(0, 0, At, B0); PG8_MMA(0, 1, At, B1); PG8_BAR; PG8_SCHED;
            PG8_LDA(At, 1, 1); PG8_STAGE(PG8_SB(1, 0), b3, voffB); PG8_STAGE(PG8_SB(1, 1), b3 + hstepB, voffB); PG8_STAGE_A(PG8_SA(1, 0), a3, 0);
            PG8_WAIT_V(8); PG8_WAIT_L(0); PG8_BAR; PG8_MMA(1, 0, At, B0); PG8_MMA(1, 1, At, B1); PG8_BAR; PG8_SCHED;
        }
        if (wr == 0) PG8_BAR;
        E(acc, cur, wr, wc, fr, fq);
        if (!has_next) break;
        zero_acc(acc);
        cur = nxt; cA = nA; cB = nB; ++ui;
        if (wr == 1) PG8_BAR;
    }
    PG8_WAIT_V(0);
    PG8_BAR;
#undef PG8_SA
#undef PG8_SB
#undef PG8_STAGE
#undef PG8_STAGE_A
#undef PG8_LDA
#undef PG8_LDB
#undef PG8_MMA
#undef PG8_CAT
#undef PG8_WAIT_V
#undef PG8_WAIT_L
#undef PG8_BAR
#undef PG8_SCHED
}

struct DenseOrder {
    static constexpr bool GATHER = false;
    const char* A; const char* Bt; int lda, ldb, nM, nN, nwg, G, c, esz;
    __device__ __forceinline__ void init(const void* A_, const void* Bt_, int lda_, int ldb_, int M, int N, int G_, int c_, int esz_ = 2) { A = (const char*)A_; Bt = (const char*)Bt_; lda = lda_; ldb = ldb_; nM = M / BM; nN = N / BM; nwg = nM * nN; G = G_; c = c_; esz = esz_; }
    __device__ __forceinline__ bool next(int i, Unit& u) const {
        const long L = (long)i * G + c; if (L >= nwg) return false;
        int wgid = (int)L; { const int q = nwg / 8, r = nwg % 8, xcd = wgid % 8, off = wgid / 8; wgid = (xcd < r ? xcd * (q + 1) : r * (q + 1) + (xcd - r) * q) + off; }
        const int nig = 8 * nN, gid = wgid / nig, fm = gid * 8, gsz = (nM - fm) < 8 ? (nM - fm) : 8;
        const int pm = fm + ((wgid % nig) % gsz), pn = (wgid % nig) / gsz;
        u.a = A + (size_t)pm * BM * lda * esz; u.b = Bt + (size_t)pn * BM * ldb * esz; u.row0 = pm * BM; u.col0 = pn * BM; u.e = 0; u.pad = i; return true;
    }
};
struct LruOrder {
    static constexpr bool GATHER = false;
    const char* XC; const char* RG; int G, c;
    __device__ __forceinline__ bool next(int i, Unit& u) const {
        const int L = i * G + c; if (L >= 512) return false;
        const int pm = L >> 3, n = L & 7;
        u.a = XC + ((size_t)pm * BM * 1024 + n * 128) * 2; u.b = RG + (size_t)n * 256 * 128 * 2; u.row0 = pm * BM; u.col0 = n * 128; u.e = n; u.pad = 0; return true;
    }
};
template <bool GATHER_ = false> struct MoeOrderT {
    static constexpr bool GATHER = GATHER_; const LAS int* gtab;
    const char* A; const char* WT; size_t estride; const LAS int* tile_e; int NT, nN, G, c, esz;
    __device__ __forceinline__ bool next(int i, Unit& u) const {
        int tile, pn;
#ifndef MOE_ORDER_ALT
#define MOE_ORDER_ALT 0
#endif
        if (!MOE_ORDER_ALT && (G % (8 * nN)) == 0) {
            const int tpr = (G / nN) >> 3, TPX = (NT + 7) >> 3, x = c & 7, k = i * tpr + (c >> 3) / nN;
            if (k >= TPX) return false;
            tile = x * TPX + k; pn = (c >> 3) % nN; }
        else { const int L = i * G + c; tile = L / nN; pn = L % nN; }
        if (tile >= NT) return false;
        const int e = __builtin_amdgcn_readfirstlane(tile_e[tile]);
        u.a = GATHER ? A : A + (size_t)tile * BM * 1024 * esz; u.b = WT + (size_t)e * estride + (size_t)pn * BM * 1024 * esz; u.row0 = tile * BM; u.col0 = pn * BM; u.e = e; u.pad = i; return true;
    }
};
typedef MoeOrderT<false> MoeOrder;

#define EPI_ROW(ai, m) (u.row0 + (ai) * HALF + wr * 64 + (m) * 16 + fr)
#define EPI_COL(bj) (u.col0 + (bj) * HALF + wc * 32 + 8 * fq)
struct EpiBf16 {
    bf16_t* O; const float* bias; int ldc, bias_es; float ascale; const LAS float* btab = nullptr;
    __device__ __forceinline__ void operator()(const Acc& acc, const Unit& u, int wr, int wc, int fr, int fq) const {
        f32x4 bv[2][2];
#pragma unroll
        for (int bj = 0; bj < 2; ++bj)
#pragma unroll
            for (int n = 0; n < 2; ++n) bv[bj][n] = btab ? *(const LAS f32x4*)(btab + u.pad * 256 + bj * HALF + wc * 32 + 8 * fq + 4 * n) : bias ? *(const f32x4*)(bias + (size_t)u.e * bias_es + EPI_COL(bj) + 4 * n) : (f32x4){0.f, 0.f, 0.f, 0.f};
#pragma unroll
        for (int ai = 0; ai < 2; ++ai)
#pragma unroll
            for (int m = 0; m < 4; ++m) { bf16_t* rowp = O + (size_t)EPI_ROW(ai, m) * ldc;
#pragma unroll
                for (int bj = 0; bj < 2; ++bj) { const f32x4 v0 = acc[ai][bj][m][0] * ascale + bv[bj][0], v1 = acc[ai][bj][m][1] * ascale + bv[bj][1];
                    u32x4 w; w.x = cvt_pk_bf16(v0[0], v0[1]); w.y = cvt_pk_bf16(v0[2], v0[3]); w.z = cvt_pk_bf16(v1[0], v1[1]); w.w = cvt_pk_bf16(v1[2], v1[3]);
                    *(u32x4*)(rowp + EPI_COL(bj)) = w; } }
    }
};
__device__ __forceinline__ unsigned pk4_fp8(float a, float b, float c, float d) { int w = 0; w = __builtin_amdgcn_cvt_pk_fp8_f32(a, b, w, false); w = __builtin_amdgcn_cvt_pk_fp8_f32(c, d, w, true); return (unsigned)w; }
constexpr float Y8_SCALE = 16.f;
struct EpiY8 {
    unsigned char* O; float ascale; const LAS float* btab;
    __device__ __forceinline__ void operator()(const Acc& acc, const Unit& u, int wr, int wc, int fr, int fq) const {
        f32x4 bv[2][2];
#pragma unroll
        for (int bj = 0; bj < 2; ++bj)
#pragma unroll
            for (int n = 0; n < 2; ++n) bv[bj][n] = *(const LAS f32x4*)(btab + u.pad * 256 + bj * HALF + wc * 32 + 8 * fq + 4 * n) * Y8_SCALE;
        const float as = ascale * Y8_SCALE;
#pragma unroll
        for (int ai = 0; ai < 2; ++ai)
#pragma unroll
            for (int m = 0; m < 4; ++m) { unsigned char* rowp = O + (size_t)EPI_ROW(ai, m) * 1024;
#pragma unroll
                for (int bj = 0; bj < 2; ++bj) { const f32x4 v0 = acc[ai][bj][m][0] * as + bv[bj][0], v1 = acc[ai][bj][m][1] * as + bv[bj][1];
                    u32x2 w; w.x = pk4_fp8(v0[0], v0[1], v0[2], v0[3]); w.y = pk4_fp8(v1[0], v1[1], v1[2], v1[3]);
                    *(u32x2*)(rowp + EPI_COL(bj)) = w; } }
    }
};
template <int KIND> struct EpiNorm {
    bf16_t* O; int ldc; const float* ga; const float* gb; const float* gc; const float* gd; const float* ge; const float* cs; LAS float* S; float ascale;
    __device__ __forceinline__ void operator()(const Acc& acc, const Unit& u, int wr, int wc, int fr, int fq) const {
        const int pn = u.col0 >> 8; const int lane = fr + 16 * fq; const float as2 = ascale * ascale;
        int mode = 0; const float* gp = ga; float scale = 1.f;
        if (KIND == 0) { if (pn < 2) { mode = 1; gp = ga; scale = 0.125f * 1.4426950408889634f; } else if (pn < 4) { mode = 1; gp = gb; } else if (pn < 6) mode = 0; else if (pn == 6) { mode = 2; gp = gc; } else { mode = 3; gp = gd; } }
        if (KIND == 1) { scale = 0.10206207261596575f * 1.4426950408889634f; if (pn < 2) { mode = 1; gp = ga; } else { mode = 4; gp = gb; } }
        if (KIND == 2) { if (pn < 2) { mode = 1; gp = ga; } else mode = 0; }
        if (mode != 0) {
#pragma unroll
            for (int ai = 0; ai < 2; ++ai)
#pragma unroll
                for (int m = 0; m < 4; ++m)
#pragma unroll
                    for (int bj = 0; bj < 2; ++bj) { const f32x4 a = acc[ai][bj][m][0], b = acc[ai][bj][m][1];
                        float s = (a[0] * a[0] + a[1] * a[1]) + (a[2] * a[2] + a[3] * a[3]) + (b[0] * b[0] + b[1] * b[1]) + (b[2] * b[2] + b[3] * b[3]);
                        s += shx<16>(s); s = xadd32(s);
                        if (fq == 0) S[(ai * HALF + wr * 64 + m * 16 + fr) * 8 + bj * 4 + wc] = s; }
            asm volatile("s_waitcnt lgkmcnt(0)" ::: "memory"); __builtin_amdgcn_s_barrier(); asm volatile("" ::: "memory");
        }
        const float inv_n = (mode == 1) ? (1.f / 64.f) : (mode == 2) ? (1.f / 256.f) : (1.f / 32.f);
        const bool rope_tile = (mode == 4) || (mode == 3);
#pragma unroll
        for (int bj = 0; bj < 2; ++bj) {
            f32x4 g0 = (f32x4){1.f, 1.f, 1.f, 1.f}, g1 = g0; bool rope = false, zero = false; float invn = inv_n;
            int c8 = 8 * fq; asm volatile("" : "+v"(c8));
            if (mode == 1) { const int c = 32 * (wc & 1) + c8; g0 = *(const f32x4*)(gp + c); g1 = *(const f32x4*)(gp + c + 4); }
            else if (mode == 2) { const int c = bj * HALF + wc * 32 + c8; g0 = *(const f32x4*)(gp + c); g1 = *(const f32x4*)(gp + c + 4); }
            else if (mode == 3) { if (bj == 0) { const int c = wc * 32 + c8; g0 = *(const f32x4*)(gp + c); g1 = *(const f32x4*)(gp + c + 4); invn = 1.f / 128.f; }
                                  else if (wc == 0) { g0 = *(const f32x4*)(ge + c8); g1 = *(const f32x4*)(ge + c8 + 4); rope = true; } else zero = true; }
            else if (mode == 4) { g0 = *(const f32x4*)(gp + c8); g1 = *(const f32x4*)(gp + c8 + 4); rope = true; }
            (void)rope_tile;
#pragma unroll
            for (int ai = 0; ai < 2; ++ai)
#pragma unroll
                for (int m = 0; m < 4; ++m) { const int row = EPI_ROW(ai, m);
                    f32x4 v0 = acc[ai][bj][m][0], v1 = acc[ai][bj][m][1];
                    if (mode != 0) { const LAS float* sr = S + (ai * HALF + wr * 64 + m * 16 + fr) * 8; float tot;
                        if (mode == 1) { const f32x2 t = *(const LAS f32x2*)(sr + bj * 4 + (wc & 2)); tot = t[0] + t[1]; }
                        else if (mode == 2) { const f32x4 t0 = *(const LAS f32x4*)sr, t1 = *(const LAS f32x4*)(sr + 4); tot = (t0[0] + t0[1]) + (t0[2] + t0[3]) + (t1[0] + t1[1]) + (t1[2] + t1[3]); }
                        else if (mode == 3 && bj == 0) { const f32x4 t0 = *(const LAS f32x4*)sr; tot = (t0[0] + t0[1]) + (t0[2] + t0[3]); }
                        else tot = sr[bj * 4 + wc];
                        const float rs = rsqrtf(tot * as2 * invn + 1e-6f) * scale * ascale; v0 = v0 * rs * g0; v1 = v1 * rs * g1; } else { v0 = v0 * ascale; v1 = v1 * ascale; }
                    if (rope) {
                        const float* cr = cs + (size_t)row * 32 + 8 * (fq & 1); const f32x4 c0 = *(const f32x4*)cr, c1 = *(const f32x4*)(cr + 4), s0 = *(const f32x4*)(cr + 16), s1 = *(const f32x4*)(cr + 20);
                        f32x4 o0, o1;
#pragma unroll
                        for (int j = 0; j < 4; ++j) { const auto r0 = __builtin_amdgcn_permlane32_swap(__float_as_uint(v0[j]), __float_as_uint(v0[j]), false, false), r1 = __builtin_amdgcn_permlane32_swap(__float_as_uint(v1[j]), __float_as_uint(v1[j]), false, false);
                            const float ot0 = __uint_as_float(lane < 32 ? r0[1] : r0[0]), ot1 = __uint_as_float(lane < 32 ? r1[1] : r1[0]);
                            o0[j] = (lane < 32) ? (v0[j] * c0[j] - ot0 * s0[j]) : (ot0 * s0[j] + v0[j] * c0[j]);
                            o1[j] = (lane < 32) ? (v1[j] * c1[j] - ot1 * s1[j]) : (ot1 * s1[j] + v1[j] * c1[j]); }
                        v0 = o0; v1 = o1; }
                    if (zero) { v0 = (f32x4){0.f, 0.f, 0.f, 0.f}; v1 = v0; }
                    u32x4 w; w.x = cvt_pk_bf16(v0[0], v0[1]); w.y = cvt_pk_bf16(v0[2], v0[3]); w.z = cvt_pk_bf16(v1[0], v1[1]); w.w = cvt_pk_bf16(v1[2], v1[3]);
                    *(u32x4*)(O + (size_t)row * ldc + EPI_COL(bj)) = w; } }
    }
};
struct EpiRecIn {
    bf16_t* O; const float* bias; const LAS float* btab = nullptr;
    __device__ __forceinline__ void operator()(const Acc& acc, const Unit& u, int wr, int wc, int fr, int fq) const {
        const bool act = u.col0 < 1024;
        f32x4 bv[2][2];
#pragma unroll
        for (int bj = 0; bj < 2; ++bj)
#pragma unroll
            for (int n = 0; n < 2; ++n) bv[bj][n] = btab ? *(const LAS f32x4*)(btab + u.pad * 256 + bj * HALF + wc * 32 + 8 * fq + 4 * n) : *(const f32x4*)(bias + EPI_COL(bj) + 4 * n);
#pragma unroll
        for (int ai = 0; ai < 2; ++ai)
#pragma unroll
            for (int m = 0; m < 4; ++m) { bf16_t* rowp = O + (size_t)EPI_ROW(ai, m) * 2048;
#pragma unroll
                for (int bj = 0; bj < 2; ++bj) { f32x4 v0 = acc[ai][bj][m][0] + bv[bj][0], v1 = acc[ai][bj][m][1] + bv[bj][1];
                    if (act) {
                        const f32x4 t0 = v0 * (1.f + 0.044715f * (v0 * v0)) * (-2.8853900817779268f * 0.7978845608028654f), t1 = v1 * (1.f + 0.044715f * (v1 * v1)) * (-2.8853900817779268f * 0.7978845608028654f);
                        const f32x4 d0 = (f32x4){fexp2(t0[0]), fexp2(t0[1]), fexp2(t0[2]), fexp2(t0[3])} + 1.f, d1 = (f32x4){fexp2(t1[0]), fexp2(t1[1]), fexp2(t1[2]), fexp2(t1[3])} + 1.f;
                        v0 = v0 * (f32x4){frcp(d0[0]), frcp(d0[1]), frcp(d0[2]), frcp(d0[3])}; v1 = v1 * (f32x4){frcp(d1[0]), frcp(d1[1]), frcp(d1[2]), frcp(d1[3])}; }
                    u32x4 w; w.x = cvt_pk_bf16(v0[0], v0[1]); w.y = cvt_pk_bf16(v0[2], v0[3]); w.z = cvt_pk_bf16(v1[0], v1[1]); w.w = cvt_pk_bf16(v1[2], v1[3]);
                    *(u32x4*)(rowp + EPI_COL(bj)) = w; } }
    }
};
struct EpiSwiglu {
    unsigned char* ACT; const LAS float* btab; float ascale;
    __device__ __forceinline__ float sw(float g, float l) const { g = fminf(g, 7.f); l = fminf(fmaxf(l, -7.f), 7.f); return g * fsigmoid(1.702f * g) * (l + 1.f); }
    __device__ __forceinline__ void operator()(const Acc& acc, const Unit& u, int wr, int wc, int fr, int fq) const {
        f32x4 bv[2][2];
#pragma unroll
        for (int bj = 0; bj < 2; ++bj)
#pragma unroll
            for (int n = 0; n < 2; ++n) bv[bj][n] = *(const LAS f32x4*)(btab + u.pad * 256 + bj * HALF + wc * 32 + 8 * fq + 4 * n);
#pragma unroll
        for (int ai = 0; ai < 2; ++ai)
#pragma unroll
            for (int m = 0; m < 4; ++m) { unsigned char* rowp = ACT + (size_t)EPI_ROW(ai, m) * 1024;
#pragma unroll
                for (int bj = 0; bj < 2; ++bj) { const f32x4 v0 = acc[ai][bj][m][0] * ascale + bv[bj][0], v1 = acc[ai][bj][m][1] * ascale + bv[bj][1];
                    f32x4 g = (f32x4){fminf(v0[0], 7.f), fminf(v0[2], 7.f), fminf(v1[0], 7.f), fminf(v1[2], 7.f)};
                    const f32x4 lu = (f32x4){fminf(fmaxf(v0[1], -7.f), 7.f), fminf(fmaxf(v0[3], -7.f), 7.f), fminf(fmaxf(v1[1], -7.f), 7.f), fminf(fmaxf(v1[3], -7.f), 7.f)};
                    const f32x4 t = g * (-1.702f * 1.4426950408889634f);
                    const f32x4 d = (f32x4){fexp2(t[0]), fexp2(t[1]), fexp2(t[2]), fexp2(t[3])} + 1.f;
                    const f32x4 gs = g * (f32x4){frcp(d[0]), frcp(d[1]), frcp(d[2]), frcp(d[3])};
                    const f32x4 o = gs * lu + gs;
                    *(unsigned*)(rowp + (EPI_COL(bj) >> 1)) = pk4_fp8(o[0], o[1], o[2], o[3]); } }
    }
};
struct EpiResid {
    bf16_t* X; const float* g; const float* bias;
    __device__ __forceinline__ void operator()(const Acc& acc, const Unit& u, int wr, int wc, int fr, int fq) const {
        const int b = u.row0 / cfg::S;
        f32x4 bv[2][2], gv[2][2];
#pragma unroll
        for (int bj = 0; bj < 2; ++bj)
#pragma unroll
            for (int n = 0; n < 2; ++n) { bv[bj][n] = bias ? *(const f32x4*)(bias + EPI_COL(bj) + 4 * n) : (f32x4){0.f, 0.f, 0.f, 0.f}; gv[bj][n] = *(const f32x4*)(g + b * 6144 + EPI_COL(bj) + 4 * n); }
        u32x4 xw[2][4][2];
#pragma unroll
        for (int ai = 0; ai < 2; ++ai)
#pragma unroll
            for (int m = 0; m < 4; ++m)
#pragma unroll
                for (int bj = 0; bj < 2; ++bj) xw[ai][m][bj] = *(const u32x4*)(X + (size_t)EPI_ROW(ai, m) * 1024 + EPI_COL(bj));
        __builtin_amdgcn_sched_barrier(0);
#pragma unroll
        for (int ai = 0; ai < 2; ++ai)
#pragma unroll
            for (int m = 0; m < 4; ++m) { bf16_t* rowp = X + (size_t)EPI_ROW(ai, m) * 1024;
#pragma unroll
                for (int bj = 0; bj < 2; ++bj) { const u32x4 xv = xw[ai][m][bj];
                    const f32x4 x0 = (f32x4){bf_lo(xv.x), bf_hi(xv.x), bf_lo(xv.y), bf_hi(xv.y)} + gv[bj][0] * (acc[ai][bj][m][0] + bv[bj][0]);
                    const f32x4 x1 = (f32x4){bf_lo(xv.z), bf_hi(xv.z), bf_lo(xv.w), bf_hi(xv.w)} + gv[bj][1] * (acc[ai][bj][m][1] + bv[bj][1]);
                    u32x4 w; w.x = cvt_pk_bf16(x0[0], x0[1]); w.y = cvt_pk_bf16(x0[2], x0[3]); w.z = cvt_pk_bf16(x1[0], x1[1]); w.w = cvt_pk_bf16(x1[2], x1[3]); *(u32x4*)(rowp + EPI_COL(bj)) = w; } }
    }
};
struct EpiLru {
    const bf16_t* XC; const float* ba; const float* bx; const float* lam; bf16_t* LA; bf16_t* Bb;
    __device__ __forceinline__ void operator()(const Acc& acc, const Unit& u, int wr, int wc, int fr, int fq) const {
        const int ch0 = u.col0 + wc * 32 + 8 * fq;
#pragma unroll
        for (int n = 0; n < 2; ++n) { const int ch = ch0 + 4 * n;
            const f32x4 bav = *(const f32x4*)(ba + ch), bxv = *(const f32x4*)(bx + ch), spv = *(const f32x4*)(lam + ch);
#pragma unroll
            for (int ai = 0; ai < 2; ++ai)
#pragma unroll
                for (int m = 0; m < 4; ++m) { const size_t ro = (size_t)EPI_ROW(ai, m) * 1024 + ch;
                    const u32x2 xr = *(const u32x2*)(XC + ro);
                    const float xcv[4] = {bf_lo(xr.x), bf_hi(xr.x), bf_lo(xr.y), bf_hi(xr.y)};
                    float lav[4], bvv[4];
#pragma unroll
                    for (int j = 0; j < 4; ++j) { const float r = fsigmoid(acc[ai][0][m][n][j] + bav[j]), ig = fsigmoid(acc[ai][1][m][n][j] + bxv[j]);
                        const float la = r * spv[j], a = fexp2(la); lav[j] = la; bvv[j] = __builtin_amdgcn_sqrtf(fmaxf(1.f - a * a, 0.f)) * ig * xcv[j]; }
                    u32x2 wa, wb; wa.x = cvt_pk_bf16(lav[0], lav[1]); wa.y = cvt_pk_bf16(lav[2], lav[3]); wb.x = cvt_pk_bf16(bvv[0], bvv[1]); wb.y = cvt_pk_bf16(bvv[2], bvv[3]);
                    *(u32x2*)(LA + ro) = wa; *(u32x2*)(Bb + ro) = wb; asm volatile("" ::: "memory"); } }
    }
};

constexpr size_t MiB = (size_t)1 << 20;
constexpr size_t al4k(size_t x) { return (x + 4095) & ~(size_t)4095; }
constexpr int T_ = cfg::T, S_ = cfg::S, P_ = cfg::P;
constexpr size_t O_CTL = 0, SZ_CTL = 1 * MiB;
constexpr size_t O_MOD = O_CTL + SZ_CTL, SZ_MOD = al4k((size_t)4 * 4 * 6144 * 4);
constexpr size_t O_CS = O_MOD + SZ_MOD, SZ_CS = (size_t)T_ * 32 * 4;
constexpr size_t O_HIST = O_CS + SZ_CS, SZ_HIST = 256 * 32 * 4;
constexpr size_t O_TOPI = O_HIST + SZ_HIST, SZ_TOP = (size_t)T_ * 4 * 4;
constexpr size_t O_TOPG = O_TOPI + SZ_TOP, O_POS = O_TOPG + SZ_TOP;
constexpr size_t O_SUMP = O_POS + SZ_TOP, SZ_SUM = (size_t)4 * 64 * 1024 * 4;
constexpr size_t O_SUMH = O_SUMP + SZ_SUM;
constexpr size_t O_LSE = O_SUMH + SZ_SUM, SZ_LSE = (size_t)3 * T_ * 8 * 4;
constexpr size_t O_SPV = al4k(O_LSE + SZ_LSE), SZ_SPV = 2 * 1024 * 4;
constexpr size_t O_WIN = al4k(O_SPV + SZ_SPV), SZ_WIN = (size_t)2048 * 1024;
constexpr size_t O_WUQ = O_WIN + 2 * SZ_WIN, SZ_WUQ = (size_t)768 * 256 * 2;
constexpr size_t O_WUKV = O_WUQ + 2 * SZ_WUQ, SZ_WUKV = (size_t)1024 * 128 * 2;
constexpr size_t O_WOUT = O_WUKV + 2 * SZ_WUKV, SZ_WOUT = (size_t)1024 * 1024 * 2;
constexpr size_t O_RWIN = O_WOUT + 2 * SZ_WOUT, SZ_RWIN = (size_t)2048 * 1024 * 2;
constexpr size_t O_RGATE = O_RWIN + 2 * SZ_RWIN, SZ_RGATE = (size_t)8 * 256 * 128 * 2;
constexpr size_t O_RWOUT = O_RGATE + 2 * SZ_RGATE, SZ_RWOUT = (size_t)1024 * 1024 * 2;
constexpr size_t O_W1 = O_RWOUT + 2 * SZ_RWOUT, SZ_W1E = (size_t)2048 * 1024;
constexpr size_t O_W2 = O_W1 + 128 * SZ_W1E, SZ_W2E = (size_t)1024 * 1024;
constexpr size_t O_HN = O_W2 + 128 * SZ_W2E, SZ_HN = (size_t)T_ * 1024 * 2;
constexpr size_t O_PROJ = O_HN + SZ_HN, SZ_PROJ = (size_t)T_ * 2048 * 2;
constexpr size_t O_Q2 = O_PROJ + SZ_PROJ, SZ_Q2 = (size_t)T_ * 768 * 2;
constexpr size_t O_KV2 = O_Q2 + SZ_Q2, SZ_KV2 = (size_t)T_ * 1024 * 2;
constexpr size_t O_OA = O_KV2 + SZ_KV2, SZ_OA = (size_t)3 * T_ * 512 * 2;
constexpr size_t O_ATT = O_OA + SZ_OA, SZ_ATT = (size_t)T_ * 1024 * 2;
constexpr size_t O_XC = O_ATT + SZ_ATT, SZ_XC = (size_t)T_ * 1024 * 2;
constexpr size_t O_AA = O_XC + SZ_XC, SZ_AA = (size_t)T_ * 1024 * 4;
constexpr size_t O_BB = O_AA + SZ_AA;
constexpr size_t O_XG = O_BB + SZ_AA, SZ_XG = (size_t)P_ * 1024 * 2, O_INV = O_XG, O_POSJ = O_XG + 4 * MiB, O_RW = O_XG + 8 * MiB;
constexpr size_t O_ACT = O_XG + SZ_XG, O_Y2 = O_ACT + SZ_XG;
constexpr size_t O_X = O_Y2 + SZ_XG, SZ_X = (size_t)T_ * 1024 * 2;
constexpr size_t O_DUMMY = O_X + SZ_X, SZ_DUMMY = (size_t)96 * MiB;
constexpr size_t WS_MK_END = O_DUMMY + SZ_DUMMY;
constexpr size_t O_NAIVE = (size_t)2048 * MiB;
static_assert(WS_MK_END <= O_NAIVE, "mk workspace");
constexpr int CW_BAR = 4096;
constexpr size_t O_ECNT = O_CTL + 32 * 1024;
constexpr int RING_BYTES = 131072, LDSX_OFF = RING_BYTES;
constexpr int LDS_BYTES = 163840;
constexpr int LX_TILE = LDSX_OFF + 64, LX_MISC = LDSX_OFF + 2048, LX_EXCH = LDSX_OFF + 6144, LX_GTAB = LX_EXCH, GTAB_UNITS = 10, LX_BIAS = LDSX_OFF + 16384;

struct Args { const void* in[34]; float* out; unsigned char* ws; int ph_lo, ph_hi; };
struct Ctx { int tid, lane, wave, G, bid, vcu, gw, NGW; LAS unsigned char* lds; unsigned char* ws; };

__device__ __forceinline__ void conv_load(f32x4 (&v)[16], const float* __restrict__ W, int N, int n0, int k0, int lane) {
    const int n = n0 + 4 * (lane & 15); const float* p = W + (size_t)(k0 + 16 * (lane >> 4)) * N + n;
#pragma unroll
    for (int i = 0; i < 16; ++i) v[i] = (n < N) ? __builtin_nontemporal_load((const f32x4*)(p + (size_t)i * N)) : (f32x4){0.f, 0.f, 0.f, 0.f};
}
__device__ __forceinline__ int conv_row(int c, int perm) { if (perm == 1) { const int h = c / 96, d = c % 96; return d < 64 ? 64 * h + d : 512 + 32 * h + d - 64; } if (perm == 2) { const int h = c >> 7, d = c & 127; return d < 64 ? 64 * h + d : 512 + 64 * h + d - 64; } return c; }
__device__ __forceinline__ void conv_emit(const f32x4 (&v)[16], LAS unsigned char* T  , bf16_t* __restrict__ WT, int ldd, int n0, int k0, int lane, int perm) {
    const int kq = lane >> 4, c4 = lane & 15;
#pragma unroll
    for (int jj = 0; jj < 4; ++jj) { u32x4 lo, hi;
        lo.x = cvt_pk_bf16(v[0][jj], v[1][jj]); lo.y = cvt_pk_bf16(v[2][jj], v[3][jj]); lo.z = cvt_pk_bf16(v[4][jj], v[5][jj]); lo.w = cvt_pk_bf16(v[6][jj], v[7][jj]);
        hi.x = cvt_pk_bf16(v[8][jj], v[9][jj]); hi.y = cvt_pk_bf16(v[10][jj], v[11][jj]); hi.z = cvt_pk_bf16(v[12][jj], v[13][jj]); hi.w = cvt_pk_bf16(v[14][jj], v[15][jj]);
        LAS unsigned char* q = T + (4 * c4 + jj) * 144 + 32 * kq; *(LAS u32x4*)q = lo; *(LAS u32x4*)(q + 16) = hi; }
    asm volatile("s_waitcnt lgkmcnt(0)" ::: "memory");
#pragma unroll
    for (int s8 = 0; s8 < 8; ++s8) { const int n = 8 * s8 + (lane >> 3), ch = lane & 7; const u32x4 w = *(const LAS u32x4*)(T + n * 144 + 16 * ch);
        *(u32x4*)(WT + (size_t)conv_row(n0 + n, perm) * ldd + k0 + 8 * ch) = w; }
    asm volatile("s_waitcnt lgkmcnt(0)" ::: "memory");
}
__device__ __forceinline__ void conv8_tile(const float* __restrict__ W, int N, unsigned char* __restrict__ WT, int ldd, int n0, int k0, LAS unsigned char* T  , int lane) {
    const int kq = lane >> 4, c4 = lane & 15; const float* p = W + (size_t)(k0 + 32 * kq) * N + n0 + 4 * c4;
    f32x4 v[32];
#pragma unroll
    for (int i = 0; i < 32; ++i) v[i] = (n0 + 4 * c4 < N) ? __builtin_nontemporal_load((const f32x4*)(p + (size_t)i * N)) : (f32x4){0.f, 0.f, 0.f, 0.f};
#pragma unroll
    for (int jj = 0; jj < 4; ++jj) { u32x4 lo, hi;
        lo.x = pk4_fp8(32.f * v[0][jj], 32.f * v[1][jj], 32.f * v[2][jj], 32.f * v[3][jj]);     lo.y = pk4_fp8(32.f * v[4][jj], 32.f * v[5][jj], 32.f * v[6][jj], 32.f * v[7][jj]);
        lo.z = pk4_fp8(32.f * v[8][jj], 32.f * v[9][jj], 32.f * v[10][jj], 32.f * v[11][jj]);   lo.w = pk4_fp8(32.f * v[12][jj], 32.f * v[13][jj], 32.f * v[14][jj], 32.f * v[15][jj]);
        hi.x = pk4_fp8(32.f * v[16][jj], 32.f * v[17][jj], 32.f * v[18][jj], 32.f * v[19][jj]); hi.y = pk4_fp8(32.f * v[20][jj], 32.f * v[21][jj], 32.f * v[22][jj], 32.f * v[23][jj]);
        hi.z = pk4_fp8(32.f * v[24][jj], 32.f * v[25][jj], 32.f * v[26][jj], 32.f * v[27][jj]); hi.w = pk4_fp8(32.f * v[28][jj], 32.f * v[29][jj], 32.f * v[30][jj], 32.f * v[31][jj]);
        LAS unsigned char* q = T + (4 * c4 + jj) * 144 + 32 * kq; *(LAS u32x4*)q = lo; *(LAS u32x4*)(q + 16) = hi; }
    asm volatile("s_waitcnt lgkmcnt(0)" ::: "memory");
#pragma unroll
    for (int s8 = 0; s8 < 8; ++s8) { const int n = 8 * s8 + (lane >> 3), ch = lane & 7; const u32x4 w = *(const LAS u32x4*)(T + n * 144 + 16 * ch);
        *(u32x4*)(WT + (size_t)(n0 + n) * ldd + k0 + 16 * ch) = w; }
    asm volatile("s_waitcnt lgkmcnt(0)" ::: "memory");
}
__device__ __forceinline__ void split_bf16(const f32x4 a, const f32x4 b, bf16x8& hi, bf16x8& lo);
template <class AP> __device__ __forceinline__ void p0_prologue(const Ctx& C, AP a) {
    unsigned char* ws = C.ws;
    { const float* c = (const float*)a->in[1]; const float* ada_w = (const float*)a->in[3]; const float* ada_b = (const float*)a->in[4]; float* mod = (float*)(ws + O_MOD);
      LAS float* part = (LAS float*)C.lds;
      LAS float* cact = (LAS float*)(C.lds + 32768);
      if (C.bid < 4 * 24) { for (int i = C.tid; i < 4096; i += 512) { const int b = i >> 10, k = i & 1023; const float cv = c[i]; cact[k * 4 + b] = cv / (1.f + expf(-cv)); } __syncthreads(); }
      for (int it = C.bid; it < 4 * 24; it += C.G) { const int l = it / 24, n0 = (it % 24) * 256;
          f32x4 acc[4];
#pragma unroll
          for (int b = 0; b < 4; ++b) acc[b] = (f32x4){0.f, 0.f, 0.f, 0.f};
          const float* w = ada_w + (size_t)l * 1024 * 6144 + n0 + 4 * C.lane;
#pragma unroll 1
          for (int k0 = C.wave * 128; k0 < C.wave * 128 + 128; k0 += 16) { f32x4 wv[16];
#pragma unroll
              for (int i = 0; i < 16; ++i) wv[i] = __builtin_nontemporal_load((const f32x4*)(w + (size_t)(k0 + i) * 6144));
#pragma unroll
              for (int i = 0; i < 16; ++i) { const f32x4 sv = *(const LAS f32x4*)(cact + (k0 + i) * 4);
#pragma unroll
                  for (int b = 0; b < 4; ++b) acc[b] = acc[b] + sv[b] * wv[i]; } }
#pragma unroll
          for (int b = 0; b < 4; ++b) *(LAS f32x4*)(part + (C.wave * 4 + b) * 256 + 4 * C.lane) = acc[b];
          __syncthreads();
          for (int o = C.tid; o < 1024; o += 512) { const int b = o >> 8, n = o & 255; float sacc = ada_b[l * 6144 + n0 + n];
#pragma unroll
              for (int w8 = 0; w8 < 8; ++w8) sacc += part[(w8 * 4 + b) * 256 + n];
              mod[((size_t)l * 4 + b) * 6144 + n0 + n] = sacc; }
          __syncthreads(); } }
    { const float* wr_all = (const float*)a->in[28]; unsigned char* RW = ws + O_RW;
      for (int idx = C.bid * 512 + C.tid; idx < 4 * 8 * 8 * 64; idx += C.G * 512) { const int ln = idx & 63, f = (idx >> 6) & 7, vv = (idx >> 9) & 7, l = idx >> 12; const int nt = f >> 2, ks = f & 3, l15 = ln & 15, kg = ln >> 4;
          const float* p = wr_all + (size_t)l * 1024 * 32 + (size_t)(128 * vv + 32 * ks + 8 * kg) * 32 + 16 * nt + l15;
          bf16x8 hi, lo; split_bf16((f32x4){p[0], p[32], p[64], p[96]}, (f32x4){p[128], p[160], p[192], p[224]}, hi, lo);
          *(bf16x8*)(RW + (size_t)idx * 32) = hi; *(bf16x8*)(RW + (size_t)idx * 32 + 16) = lo; } }
    { const int* positions = (const int*)a->in[2]; float* cs = (float*)(ws + O_CS);
      for (int i = C.bid * 512 + C.tid; i < T_ * 16; i += C.G * 512) { const int t = i >> 4, f = i & 15; const float inv = powf(10000.f, -(float)(2 * f) / 32.f); const float ang = (float)positions[t] * inv;
          cs[t * 32 + f] = cosf(ang); cs[t * 32 + 16 + f] = sinf(ang); } }
    { const float* lam = (const float*)a->in[25]; float* spv = (float*)(ws + O_SPV);
      for (int i = C.bid * 512 + C.tid; i < 2048; i += C.G * 512) spv[i] = -8.f * 1.4426950408889634f * log1pf(expf(-lam[i])); }
    { const int lane = C.lane; LAS unsigned char* T = C.lds + 49152 + C.wave * 9216;
      const float* attn_w_in = (const float*)a->in[7]; const float* w_uq = (const float*)a->in[12]; const float* w_ukv = (const float*)a->in[13]; const float* attn_w_out = (const float*)a->in[16];
      const float* rec_w_in = (const float*)a->in[17]; const float* rec_wa = (const float*)a->in[21]; const float* rec_wx = (const float*)a->in[23]; const float* rec_w_out = (const float*)a->in[26];
      const float* w1 = (const float*)a->in[30]; const float* w2 = (const float*)a->in[32];
      constexpr int T_WIN = 32 * 16, T_WUQ = 12 * 4, T_WUKV = 16 * 2, T_WOUT = 16 * 16, T_RWIN = 32 * 16, T_RG = 2 * 2, T_RWOUT = 16 * 16, T_W1 = 32 * 16, T_W2 = 16 * 16;
      constexpr int NITEMS = 2 * (T_WUQ + T_WUKV + T_WOUT + T_RWIN + 16 * T_RG + T_RWOUT);
      struct Job { const float* W; bf16_t* WT; int N, ldd, n0, k0, perm; };
      auto decode = [&](int r, Job& jb) {
#define CONV_JOB(SRC, KK, NN, DST, NROWS, NMAT, SRC_MS, DST_MS, PERM) { constexpr int kc_ = (KK) / 64, per_ = ((NROWS) / 64) * kc_, tot_ = per_ * (NMAT); \
          if (r < tot_) { const int mat_ = r / per_, q_ = r % per_; jb.W = (SRC) + (size_t)mat_ * (SRC_MS); jb.WT = (bf16_t*)(ws + (DST) + (size_t)mat_ * (DST_MS)); jb.N = (NN); jb.ldd = (KK); jb.n0 = (q_ / kc_) * 64; jb.k0 = (q_ % kc_) * 64; jb.perm = (PERM); return; } r -= tot_; }
          CONV_JOB(w_uq, 256, 768, O_WUQ, 768, 2, (size_t)256 * 768, SZ_WUQ, 1)
          CONV_JOB(w_ukv, 128, 1024, O_WUKV, 1024, 2, (size_t)128 * 1024, SZ_WUKV, 2)
          CONV_JOB(attn_w_out, 1024, 1024, O_WOUT, 1024, 2, (size_t)1024 * 1024, SZ_WOUT, 0)
          CONV_JOB(rec_w_in, 1024, 2048, O_RWIN, 2048, 2, (size_t)1024 * 2048, SZ_RWIN, 0)
          CONV_JOB(rec_wa, 128, 128, O_RGATE, 128, 16, (size_t)128 * 128, (size_t)256 * 128 * 2, 0)
          CONV_JOB(rec_wx, 128, 128, O_RGATE + (size_t)128 * 128 * 2, 128, 16, (size_t)128 * 128, (size_t)256 * 128 * 2, 0)
          CONV_JOB(rec_w_out, 1024, 1024, O_RWOUT, 1024, 2, (size_t)1024 * 1024, SZ_RWOUT, 0)
#undef CONV_JOB
          jb.W = attn_w_out; jb.WT = (bf16_t*)(ws + O_WOUT); jb.N = 1024; jb.ldd = 1024; jb.n0 = 0; jb.k0 = 0; jb.perm = 0; };
      f32x4 va[16], vb[16]; Job ja, jn;
      int it = C.gw;
      if (it < NITEMS) { decode(it, ja); conv_load(va, ja.W, ja.N, ja.n0, ja.k0, lane); }
#pragma unroll 1
      for (; it < NITEMS; it += 2 * C.NGW) {
          const bool h1 = it + C.NGW < NITEMS;
          if (h1) { decode(it + C.NGW, jn); conv_load(vb, jn.W, jn.N, jn.n0, jn.k0, lane); }
          conv_emit(va, T, ja.WT, ja.ldd, ja.n0, ja.k0, lane, ja.perm);
          const bool h2 = it + 2 * C.NGW < NITEMS;
          if (h2) { decode(it + 2 * C.NGW, ja); conv_load(va, ja.W, ja.N, ja.n0, ja.k0, lane); }
          if (h1) conv_emit(vb, T, jn.WT, jn.ldd, jn.n0, jn.k0, lane, jn.perm);
      }
      { constexpr int IM = 32 * 8;
#pragma unroll 1
        for (int i8 = C.gw; i8 < 2 * IM; i8 += C.NGW) { const int mat = i8 / IM, q = i8 % IM;
            conv8_tile(attn_w_in + (size_t)mat * 1024 * 1952, 1952, ws + O_WIN + (size_t)mat * SZ_WIN, 1024, (q >> 3) * 64, (q & 7) * 128, T, lane); } }
    }
}

__device__ __forceinline__ void phase_norm(const Ctx& C, const float* xin  , float* out  , bool combine, bool do_norm, const float* gain, const float* modc  , const float* modl  , int shoff, int scoff, bool dummy = false, bool f8 = false  ) {
    const unsigned char* Y8 = C.ws + O_Y2;     const int* pos = (const int*)(C.ws + O_POS); const float* topg = (const float*)(C.ws + O_TOPG); bf16_t* HN = (bf16_t*)(C.ws + (dummy ? O_DUMMY : O_HN)); const bf16_t* X = (const bf16_t*)(C.ws + O_X); bf16_t* Xo = (bf16_t*)(C.ws + (dummy ? O_DUMMY + 32 * MiB : O_X));
    const int lane = C.lane;
    f32x4 gsc[4], shv[4], g2v[4]; int bprev = -1;
    for (int t = C.gw; t < T_; t += C.NGW) { const int b = t / S_;
        if (b != bprev) { bprev = b;
#pragma unroll
            for (int j = 0; j < 4; ++j) { const int col = 256 * j + 4 * lane;
                if (do_norm) { gsc[j] = *(const f32x4*)(gain + col) * (1.f + *(const f32x4*)(modl + b * 6144 + scoff + col)); shv[j] = *(const f32x4*)(modl + b * 6144 + shoff + col); }
                if (combine) g2v[j] = *(const f32x4*)(modc + b * 6144 + 5120 + col); } }
        f32x4 v[4];
        if (xin) {
#pragma unroll
            for (int j = 0; j < 4; ++j) v[j] = __builtin_nontemporal_load((const f32x4*)(xin + (size_t)t * 1024 + 256 * j + 4 * lane)); }
        else {
#pragma unroll
            for (int j = 0; j < 4; ++j) { const u32x2 w = *(const u32x2*)(X + (size_t)t * 1024 + 256 * j + 4 * lane); v[j] = (f32x4){bf_lo(w.x), bf_hi(w.x), bf_lo(w.y), bf_hi(w.y)}; } }
        if (combine) { f32x4 y[4];
#pragma unroll
            for (int j = 0; j < 4; ++j) y[j] = (f32x4){0.f, 0.f, 0.f, 0.f};
            const u32x4 pp = *(const u32x4*)(pos + t * 4); const f32x4 gg = *(const f32x4*)(topg + t * 4) * (1.f / Y8_SCALE);
#pragma unroll
            for (int k = 0; k < 4; ++k) { const int p = (int)pp[k]; const float gk = gg[k];
#pragma unroll
                for (int j = 0; j < 4; ++j) { const unsigned w = *(const unsigned*)(Y8 + (size_t)p * 1024 + 256 * j + 4 * lane);
                    const f32x2 lo = __builtin_amdgcn_cvt_pk_f32_fp8((int)w, false), hi2 = __builtin_amdgcn_cvt_pk_f32_fp8((int)w, true);
                    y[j][0] += gk * lo[0]; y[j][1] += gk * lo[1]; y[j][2] += gk * hi2[0]; y[j][3] += gk * hi2[1]; } }
#pragma unroll
            for (int j = 0; j < 4; ++j) v[j] = v[j] + g2v[j] * y[j]; }
        if (out) {
#pragma unroll
            for (int j = 0; j < 4; ++j) __builtin_nontemporal_store(v[j], (f32x4*)(out + (size_t)t * 1024 + 256 * j + 4 * lane)); }
        else {
#pragma unroll
            for (int j = 0; j < 4; ++j) { u32x2 w; w.x = cvt_pk_bf16(v[j][0], v[j][1]); w.y = cvt_pk_bf16(v[j][2], v[j][3]); *(u32x2*)(Xo + (size_t)t * 1024 + 256 * j + 4 * lane) = w; } }
        if (do_norm) { float ss = 0.f;
#pragma unroll
            for (int j = 0; j < 4; ++j) ss += (v[j][0] * v[j][0] + v[j][1] * v[j][1]) + (v[j][2] * v[j][2] + v[j][3] * v[j][3]);
            const float rs = rsqrtf(wsum(ss) * (1.f / 1024.f) + 1e-6f);
#pragma unroll
            for (int j = 0; j < 4; ++j) { const int col = 256 * j + 4 * lane;
                const f32x4 h = v[j] * rs * gsc[j] + shv[j];
                if (f8) *(unsigned*)((unsigned char*)HN + (size_t)t * 1024 + col) = pk4_fp8(h[0], h[1], h[2], h[3]);
                else { u32x2 w; w.x = cvt_pk_bf16(h[0], h[1]); w.y = cvt_pk_bf16(h[2], h[3]); *(u32x2*)(HN + (size_t)t * 1024 + col) = w; } } }
    }
}

__device__ __forceinline__ void unpack8(const u32x4 w, float (&f)[8]) { f[0] = bf_lo(w.x); f[1] = bf_hi(w.x); f[2] = bf_lo(w.y); f[3] = bf_hi(w.y); f[4] = bf_lo(w.z); f[5] = bf_hi(w.z); f[6] = bf_lo(w.w); f[7] = bf_hi(w.w); }
__device__ __forceinline__ u32x4 pack8(const float (&f)[8]) { u32x4 w; w.x = cvt_pk_bf16(f[0], f[1]); w.y = cvt_pk_bf16(f[2], f[3]); w.z = cvt_pk_bf16(f[4], f[5]); w.w = cvt_pk_bf16(f[6], f[7]); return w; }

constexpr float LOG2E = 1.4426950408889634f;
__device__ __forceinline__ void phase_postproj(const Ctx& C, const float* qg, const float* kg, const float* qag, const float* kvag, const float* mkg) {
    bf16_t* PROJ = (bf16_t*)(C.ws + O_PROJ); const float* cs = (const float*)(C.ws + O_CS); const int lane = C.lane;
    for (int t = C.gw; t < T_; t += C.NGW) { bf16_t* row = PROJ + (size_t)t * 2048;
#pragma unroll
        for (int ps = 0; ps < 2; ++ps) { bf16_t* p = row + ps * 512 + 8 * lane; float f[8]; unpack8(*(const u32x4*)p, f); float ss = 0.f;
#pragma unroll
            for (int i = 0; i < 8; ++i) ss += f[i] * f[i];
            ss += shx<1>(ss); ss += shx<2>(ss); ss += shx<4>(ss);
            const float rs = rsqrtf(ss * (1.f / 64.f) + 1e-6f) * (ps == 0 ? 0.125f * LOG2E : 1.f); const float* g = (ps == 0 ? qg : kg) + 8 * (lane & 7);
#pragma unroll
            for (int i = 0; i < 8; ++i) f[i] = f[i] * rs * g[i];
            *(u32x4*)p = pack8(f); }
        { bf16_t* p = row + 1536 + 8 * lane; float f[8]; unpack8(*(const u32x4*)p, f); float ss = 0.f;
#pragma unroll
            for (int i = 0; i < 8; ++i) ss += f[i] * f[i];
            ss += shx<1>(ss); ss += shx<2>(ss);
            { const float o4 = shx<4>(ss); if (lane < 48) ss += o4; } { const float o8 = shx<8>(ss); if (lane < 48) ss += o8; } { const float o16 = shx<16>(ss); if (lane < 32) ss += o16; }
            const float nrm = lane < 32 ? 256.f : (lane < 48 ? 128.f : 32.f);
            const float rs = rsqrtf(ss / nrm + 1e-6f);
            const float* g = lane < 32 ? (qag + 8 * lane) : (lane < 48 ? (kvag + 8 * (lane - 32)) : (mkg + 64 + 8 * ((lane - 48) & 3)));
#pragma unroll
            for (int i = 0; i < 8; ++i) f[i] = f[i] * rs * g[i];
            float o[8];
#pragma unroll
            for (int i = 0; i < 8; ++i) { const float other = shx<2>(f[i]); const int fi = ((lane & 1) << 3) + i; const float cv = cs[t * 32 + fi], sv = cs[t * 32 + 16 + fi];
                o[i] = (lane & 2) ? (other * sv + f[i] * cv) : (f[i] * cv - other * sv); }
            if (lane >= 48 && lane < 52) {
#pragma unroll
                for (int i = 0; i < 8; ++i) f[i] = o[i]; }
            if (lane < 52) *(u32x4*)p = pack8(f); }
    }
}
__device__ __forceinline__ void phase_postq(const Ctx& C, const float* mqg, const float* mkg) {
    bf16_t* Q2 = (bf16_t*)(C.ws + O_Q2); bf16_t* KV2 = (bf16_t*)(C.ws + O_KV2); const float* cs = (const float*)(C.ws + O_CS); const int lane = C.lane;
    const float qscale = 0.10206207261596575f * LOG2E;
    for (int t = C.gw; t < T_; t += C.NGW) {
        { bf16_t* p = Q2 + (size_t)t * 768 + (lane >> 3) * 96 + 8 * (lane & 7); float f[8]; unpack8(*(const u32x4*)p, f); float ss = 0.f;
#pragma unroll
            for (int i = 0; i < 8; ++i) ss += f[i] * f[i];
            ss += shx<1>(ss); ss += shx<2>(ss); ss += shx<4>(ss);
            const float rs = rsqrtf(ss * (1.f / 64.f) + 1e-6f) * qscale; const float* g = mqg + 8 * (lane & 7);
#pragma unroll
            for (int i = 0; i < 8; ++i) f[i] = f[i] * rs * g[i];
            *(u32x4*)p = pack8(f); }
        { const int l2 = lane & 31; bf16_t* p = Q2 + (size_t)t * 768 + (l2 >> 2) * 96 + 64 + 8 * (l2 & 3); float f[8]; unpack8(*(const u32x4*)p, f); float ss = 0.f;
#pragma unroll
            for (int i = 0; i < 8; ++i) ss += f[i] * f[i];
            ss += shx<1>(ss); ss += shx<2>(ss);
            const float rs = rsqrtf(ss * (1.f / 32.f) + 1e-6f) * qscale; const float* g = mqg + 64 + 8 * (l2 & 3);
#pragma unroll
            for (int i = 0; i < 8; ++i) f[i] = f[i] * rs * g[i];
            float o[8];
#pragma unroll
            for (int i = 0; i < 8; ++i) { const float other = shx<2>(f[i]); const int fi = ((lane & 1) << 3) + i; const float cv = cs[t * 32 + fi], sv = cs[t * 32 + 16 + fi];
                o[i] = (lane & 2) ? (other * sv + f[i] * cv) : (f[i] * cv - other * sv); }
            if (lane < 32) *(u32x4*)p = pack8(o); }
        { bf16_t* p = KV2 + (size_t)t * 1024 + (lane >> 3) * 128 + 8 * (lane & 7); float f[8]; unpack8(*(const u32x4*)p, f); float ss = 0.f;
#pragma unroll
            for (int i = 0; i < 8; ++i) ss += f[i] * f[i];
            ss += shx<1>(ss); ss += shx<2>(ss); ss += shx<4>(ss);
            const float rs = rsqrtf(ss * (1.f / 64.f) + 1e-6f); const float* g = mkg + 8 * (lane & 7);
#pragma unroll
            for (int i = 0; i < 8; ++i) f[i] = f[i] * rs * g[i];
            *(u32x4*)p = pack8(f); }
    }
}
__device__ __forceinline__ void phase_mixcombine(const Ctx& C) {
    const bf16_t* OA = (const bf16_t*)(C.ws + O_OA); const float* LSE = (const float*)(C.ws + O_LSE); bf16_t* ATT = (bf16_t*)(C.ws + O_ATT); const int lane = C.lane;
    for (int t = C.gw; t < T_; t += C.NGW) { const int h = lane >> 3;
        float ls[3], mx = -INFINITY;
#pragma unroll
        for (int p = 0; p < 3; ++p) { ls[p] = LSE[((size_t)p * T_ + t) * 8 + h]; mx = fmaxf(mx, ls[p]); }
        float w[3], den = 0.f;
#pragma unroll
        for (int p = 0; p < 3; ++p) { w[p] = fexp2(ls[p] - mx); den += w[p]; }
        const float inv = 1.f / den; float o[8];
#pragma unroll
        for (int i = 0; i < 8; ++i) o[i] = 0.f;
#pragma unroll
        for (int p = 0; p < 3; ++p) { float f[8]; unpack8(*(const u32x4*)(OA + ((size_t)p * T_ + t) * 512 + 8 * lane), f); const float wp = w[p] * inv;
#pragma unroll
            for (int i = 0; i < 8; ++i) o[i] += wp * f[i]; }
        *(u32x4*)(ATT + (size_t)t * 1024 + 8 * lane) = pack8(o); }
}
__device__ __forceinline__ void phase_rgate(const Ctx& C, int j, const float* cw, const float* cb, const float* ba, const float* bx) {
    const bf16_t* PROJ = (const bf16_t*)(C.ws + O_PROJ); const bf16_t* RG = (const bf16_t*)(C.ws + O_RGATE + (size_t)j * SZ_RGATE); const float* spvg = (const float*)(C.ws + O_SPV) + j * 1024;
    bf16_t* LA = (bf16_t*)(C.ws + O_AA); bf16_t* Bb = (bf16_t*)(C.ws + O_BB); float* SP = (float*)(C.ws + O_SUMP); float* SH = (float*)(C.ws + O_SUMH);
    constexpr int WROW = 272;
    LAS unsigned char* Wl = C.lds;
    LAS unsigned char* Xl = C.lds + 256 * WROW;
    LAS unsigned char* Al = Xl + 64 * WROW;
    LAS unsigned char* Bl = Al + 64 * WROW;
    const int tid = C.tid, lane = C.lane, w = C.wave;
    if (C.G % 8 != 0) return;
    const int n = C.bid & 7, g = C.bid >> 3, ng = C.G >> 3;
    for (int i = tid; i < 256 * 16; i += 512) { const int r = i >> 4, c = i & 15; *(LAS u32x4*)(Wl + r * WROW + 16 * c) = *(const u32x4*)(RG + ((size_t)n * 256 + r) * 128 + 8 * c); }
    const int crow = tid >> 3, cg = tid & 7, cch = n * 128 + 16 * cg;
    float cwv[4][16], cbv[16];
#pragma unroll
    for (int q = 0; q < 4; ++q) { const f32x4 b4 = *(const f32x4*)(cb + cch + 4 * q); cbv[4 * q] = b4[0]; cbv[4 * q + 1] = b4[1]; cbv[4 * q + 2] = b4[2]; cbv[4 * q + 3] = b4[3];
#pragma unroll
        for (int k = 0; k < 4; ++k) { const f32x4 w4 = *(const f32x4*)(cw + k * 1024 + cch + 4 * q); cwv[k][4 * q] = w4[0]; cwv[k][4 * q + 1] = w4[1]; cwv[k][4 * q + 2] = w4[2]; cwv[k][4 * q + 3] = w4[3]; } }
    const int mt = w & 3, h = w >> 2, l15 = lane & 15, kg = lane >> 4;
    float bav[4], bxv[4], spv[4];
#pragma unroll
    for (int jj = 0; jj < 4; ++jj) { const int ch = n * 128 + 16 * (4 * h + jj) + l15; bav[jj] = ba[ch]; bxv[jj] = bx[ch]; spv[jj] = spvg[ch]; }
    __syncthreads();
    u32x4 xr[4][2];
    auto load_x = [&](int c) { const size_t row0 = (size_t)c * 64; const int ts0 = (int)(row0 % S_);
#pragma unroll
        for (int k = 0; k < 4; ++k) { const int dt = (ts0 + crow + k - 3 >= 0) ? k - 3 : 0; const bf16_t* src = PROJ + (row0 + crow + dt) * 2048 + 1024 + cch; xr[k][0] = *(const u32x4*)src; xr[k][1] = *(const u32x4*)(src + 8); } };
    load_x(g);
    for (int c = g; c < 256; c += ng) { const size_t row0 = (size_t)c * 64; const int ts0 = (int)(row0 % S_);
        { float acc[16];
#pragma unroll
          for (int i = 0; i < 16; ++i) acc[i] = cbv[i];
#pragma unroll
          for (int k = 0; k < 4; ++k) { const int dt = k - 3; const bool on = ts0 + crow + dt >= 0; float f0[8], f1[8]; unpack8(xr[k][0], f0); unpack8(xr[k][1], f1);
#pragma unroll
              for (int i = 0; i < 8; ++i) { acc[i] += on ? cwv[k][i] * f0[i] : 0.f; acc[8 + i] += on ? cwv[k][8 + i] * f1[i] : 0.f; } }
          float lo[8], hi8[8];
#pragma unroll
          for (int i = 0; i < 8; ++i) { lo[i] = acc[i]; hi8[i] = acc[8 + i]; }
          *(LAS u32x4*)(Xl + crow * WROW + 32 * cg) = pack8(lo); *(LAS u32x4*)(Xl + crow * WROW + 32 * cg + 16) = pack8(hi8); }
        load_x((c + ng < 256) ? c + ng : c);
        __builtin_amdgcn_sched_barrier(0);
        __syncthreads();
        f32x4 acc[8];
#pragma unroll
        for (int t = 0; t < 8; ++t) acc[t] = (f32x4){0.f, 0.f, 0.f, 0.f};
#pragma unroll
        for (int ks = 0; ks < 4; ++ks) { const bf16x8 af = *(const LAS bf16x8*)(Xl + (16 * mt + l15) * WROW + 64 * ks + 16 * kg);
#pragma unroll
            for (int t = 0; t < 8; ++t) { const int nt = (t < 4) ? (4 * h + t) : (8 + 4 * h + (t - 4)); const bf16x8 bfr = *(const LAS bf16x8*)(Wl + (16 * nt + l15) * WROW + 64 * ks + 16 * kg);
                acc[t] = __builtin_amdgcn_mfma_f32_16x16x32_bf16(af, bfr, acc[t], 0, 0, 0); } }
#pragma unroll
        for (int jj = 0; jj < 4; ++jj) { const int e = 16 * (4 * h + jj) + l15;
#pragma unroll
            for (int r = 0; r < 4; ++r) { const int row = 16 * mt + 4 * kg + r; const float xc = bf_lo((unsigned)*(const LAS unsigned short*)(Xl + row * WROW + 2 * e));
                const float rr = fsigmoid(acc[jj][r] + bav[jj]), ig = fsigmoid(acc[4 + jj][r] + bxv[jj]); const float la = rr * spv[jj], av = fexp2(la);
                const float bv = __builtin_amdgcn_sqrtf(fmaxf(1.f - av * av, 0.f)) * ig * xc;
                *(LAS unsigned short*)(Al + row * WROW + 2 * e) = (unsigned short)(cvt_pk_bf16(la, la) & 0xffffu); *(LAS unsigned short*)(Bl + row * WROW + 2 * e) = (unsigned short)(cvt_pk_bf16(bv, bv) & 0xffffu); } }
        __syncthreads();
        { const size_t go = (row0 + crow) * 1024 + cch;
          *(u32x4*)(LA + go) = *(const LAS u32x4*)(Al + crow * WROW + 32 * cg); *(u32x4*)(LA + go + 8) = *(const LAS u32x4*)(Al + crow * WROW + 32 * cg + 16);
          *(u32x4*)(Bb + go) = *(const LAS u32x4*)(Bl + crow * WROW + 32 * cg); *(u32x4*)(Bb + go + 8) = *(const LAS u32x4*)(Bl + crow * WROW + 32 * cg + 16); }
        if (tid < 128) { float Pl = 0.f, Hh = 0.f;
#pragma unroll 8
            for (int r = 0; r < 64; ++r) { const float la = bf_lo((unsigned)*(const LAS unsigned short*)(Al + r * WROW + 2 * tid)), bv = bf_lo((unsigned)*(const LAS unsigned short*)(Bl + r * WROW + 2 * tid)); Hh = fexp2(la) * Hh + bv; Pl += la; }
            const int b = (int)(row0 / S_), ck = (int)((row0 % S_) >> 6); SP[((size_t)b * 64 + ck) * 1024 + n * 128 + tid] = fexp2(Pl); SH[((size_t)b * 64 + ck) * 1024 + n * 128 + tid] = Hh; }
        __syncthreads();
    }
}

__device__ __forceinline__ void scan_sum_item(const Ctx& C, int b, int ck, int cg) {
    const bf16_t* LA = (const bf16_t*)(C.ws + O_AA); const bf16_t* Bb = (const bf16_t*)(C.ws + O_BB); float* SP = (float*)(C.ws + O_SUMP); float* SH = (float*)(C.ws + O_SUMH);
    const int ch = cg * 128 + 2 * C.lane;
    size_t off = ((size_t)b * S_ + ck * 64) * 1024 + ch; f32x2 Pl = (f32x2){0.f, 0.f}, Hh = (f32x2){0.f, 0.f};
#pragma unroll 8
    for (int s = 0; s < 64; ++s, off += 1024) { const unsigned lw = *(const unsigned*)(LA + off), bw = *(const unsigned*)(Bb + off);
        const f32x2 lv = (f32x2){bf_lo(lw), bf_hi(lw)}, av = (f32x2){fexp2(lv[0]), fexp2(lv[1])}, bv = (f32x2){bf_lo(bw), bf_hi(bw)}; Hh = av * Hh + bv; Pl = Pl + lv; }
    *(f32x2*)(SP + ((size_t)b * 64 + ck) * 1024 + ch) = (f32x2){fexp2(Pl[0]), fexp2(Pl[1])}; *(f32x2*)(SH + ((size_t)b * 64 + ck) * 1024 + ch) = Hh;
}
__device__ __forceinline__ void phase_scan_sum_own(const Ctx& C) {
    asm volatile("s_waitcnt vmcnt(0)" ::: "memory"); __syncthreads();
    for (int i = 0; ; ++i) { const int L = i * C.G + C.bid; if (L >= 512) break; const int pm = L >> 3, n = L & 7;
        if (C.wave < 4) { const int row0 = pm * 256 + C.wave * 64; scan_sum_item(C, row0 / S_, (row0 % S_) >> 6, n); } }
}
__device__ __forceinline__ void phase_scan_apply(const Ctx& C) {
    const bf16_t* LA = (const bf16_t*)(C.ws + O_AA); const bf16_t* Bb = (const bf16_t*)(C.ws + O_BB); const float* SP = (const float*)(C.ws + O_SUMP); const float* SH = (const float*)(C.ws + O_SUMH);
    const bf16_t* PROJ = (const bf16_t*)(C.ws + O_PROJ); bf16_t* ATT = (bf16_t*)(C.ws + O_ATT); const int lane = C.lane;
    for (int it = C.gw; it < 4 * 64 * 8; it += C.NGW) { const int cg = it & 7, ck = (it >> 3) & 63, b = it >> 9; const int ch = cg * 128 + 2 * lane;
        f32x2 h = (f32x2){0.f, 0.f};
        const float* sp = SP + (size_t)b * 64 * 1024 + ch; const float* sh = SH + (size_t)b * 64 * 1024 + ch;
#pragma unroll 1
        for (int c0 = 0; c0 < ck; c0 += 16) { f32x2 pv[16], hv[16];
#pragma unroll
            for (int u = 0; u < 16; ++u) { const int c2 = (c0 + u < ck) ? c0 + u : ck - 1; pv[u] = *(const f32x2*)(sp + (size_t)c2 * 1024); hv[u] = *(const f32x2*)(sh + (size_t)c2 * 1024); }
            __builtin_amdgcn_sched_barrier(0);
#pragma unroll
            for (int u = 0; u < 16; ++u) if (c0 + u < ck) h = pv[u] * h + hv[u]; }
        const size_t row0 = (size_t)b * S_ + ck * 64;
#pragma unroll 1
        for (int s0 = 0; s0 < 64; s0 += 16) { unsigned lw[16], bw[16], gw2[16];
#pragma unroll
            for (int u = 0; u < 16; ++u) { const size_t row = row0 + s0 + u; lw[u] = *(const unsigned*)(LA + row * 1024 + ch); bw[u] = *(const unsigned*)(Bb + row * 1024 + ch); gw2[u] = *(const unsigned*)(PROJ + row * 2048 + ch); }
            __builtin_amdgcn_sched_barrier(0);
#pragma unroll
            for (int u = 0; u < 16; ++u) { const f32x2 av = (f32x2){fexp2(bf_lo(lw[u])), fexp2(bf_hi(lw[u]))}, bv = (f32x2){bf_lo(bw[u]), bf_hi(bw[u])}; h = av * h + bv;
                *(unsigned*)(ATT + (row0 + s0 + u) * 1024 + ch) = cvt_pk_bf16(bf_lo(gw2[u]) * h[0], bf_hi(gw2[u]) * h[1]); } }
    }
}

__device__ __forceinline__ void split_bf16(const f32x4 a, const f32x4 b, bf16x8& hi, bf16x8& lo) {
    u32x4 h; h.x = cvt_pk_bf16(a[0], a[1]); h.y = cvt_pk_bf16(a[2], a[3]); h.z = cvt_pk_bf16(b[0], b[1]); h.w = cvt_pk_bf16(b[2], b[3]);
    u32x4 l; l.x = cvt_pk_bf16(a[0] - bf_lo(h.x), a[1] - bf_hi(h.x)); l.y = cvt_pk_bf16(a[2] - bf_lo(h.y), a[3] - bf_hi(h.y)); l.z = cvt_pk_bf16(b[0] - bf_lo(h.z), b[1] - bf_hi(h.z)); l.w = cvt_pk_bf16(b[2] - bf_lo(h.w), b[3] - bf_hi(h.w));
    hi = __builtin_bit_cast(bf16x8, h); lo = __builtin_bit_cast(bf16x8, l);
}
__device__ __forceinline__ void phase_router(const Ctx& C, const bf16_t* X, const float* gain, const float* modl, const float* wr, const float* br, int layer) {
    unsigned char* HN8 = C.ws + O_HN; int* topi = (int*)(C.ws + O_TOPI); float* topg = (float*)(C.ws + O_TOPG); int* ecnt = (int*)(C.ws + O_ECNT) + layer * 32; int* inv = (int*)(C.ws + O_INV); int* posj = (int*)(C.ws + O_POSJ);
    LAS int* rk = (LAS int*)(C.lds + LX_MISC + 3072); LAS int* base = (LAS int*)(C.lds + LX_MISC + 512);
    constexpr int HROW = 1028;
    LAS float* hrow = (LAS float*)C.lds;
    LAS float* part = (LAS float*)(C.lds + 16 * HROW * 4);
    LAS int* hl = (LAS int*)(C.lds + LX_MISC);
    const int lane = C.lane, e = lane & 31, kh = lane >> 5, v = C.wave, l15 = lane & 15, kg = lane >> 4;
    bf16x8 whi[2][4], wlo[2][4];
    { const unsigned char* rw = C.ws + O_RW + ((size_t)(layer * 8 + v) * 8 * 64 + lane) * 32;
#pragma unroll
      for (int nt = 0; nt < 2; ++nt)
#pragma unroll
          for (int ks = 0; ks < 4; ++ks) { whi[nt][ks] = *(const bf16x8*)(rw + (size_t)(nt * 4 + ks) * 64 * 32); wlo[nt][ks] = *(const bf16x8*)(rw + (size_t)(nt * 4 + ks) * 64 * 32 + 16); } }
    const float bias_e = br[e];
    if (C.tid < 32) hl[C.tid] = 0;
    __syncthreads();
    for (int ck = C.bid; ck < 256; ck += C.G) {
        const int b = (ck * 64) / S_;
        f32x4 gn[4], shv[4];
#pragma unroll
        for (int j = 0; j < 4; ++j) { const int col = 256 * j + 4 * lane; gn[j] = *(const f32x4*)(gain + col) * (1.f + *(const f32x4*)(modl + b * 6144 + 4096 + col)); shv[j] = *(const f32x4*)(modl + b * 6144 + 3072 + col); }
        u32x2 xr[2][4];
#pragma unroll
        for (int q = 0; q < 2; ++q)
#pragma unroll
            for (int j = 0; j < 4; ++j) xr[q][j] = *(const u32x2*)(X + (size_t)(ck * 64 + 2 * v + q) * 1024 + 256 * j + 4 * lane);
#pragma unroll 1
        for (int pass = 0; pass < 4; ++pass) { const int tb = ck * 64 + pass * 16;
#pragma unroll
            for (int q = 0; q < 2; ++q) { const int tt = 2 * v + q, t = tb + tt; f32x4 h[4]; float ss = 0.f;
#pragma unroll
                for (int j = 0; j < 4; ++j) { const u32x2 xw = xr[q][j]; h[j] = (f32x4){bf_lo(xw.x), bf_hi(xw.x), bf_lo(xw.y), bf_hi(xw.y)}; ss += (h[j][0] * h[j][0] + h[j][1] * h[j][1]) + (h[j][2] * h[j][2] + h[j][3] * h[j][3]); }
                const float rs = rsqrtf(wsum(ss) * (1.f / 1024.f) + 1e-6f);
#pragma unroll
                for (int j = 0; j < 4; ++j) { const int col = 256 * j + 4 * lane;
                    const f32x4 hv = h[j] * rs * gn[j] + shv[j];
                    *(unsigned*)(HN8 + (size_t)t * 1024 + col) = pk4_fp8(hv[0], hv[1], hv[2], hv[3]);
                    *(LAS f32x4*)(hrow + tt * HROW + col) = hv; } }
            if (pass < 3) {
#pragma unroll
                for (int q = 0; q < 2; ++q)
#pragma unroll
                    for (int j = 0; j < 4; ++j) xr[q][j] = *(const u32x2*)(X + (size_t)(tb + 16 + 2 * v + q) * 1024 + 256 * j + 4 * lane); }
            __syncthreads();
            { f32x4 acc0 = (f32x4){0.f, 0.f, 0.f, 0.f}, acc1 = acc0;
#pragma unroll
              for (int ks = 0; ks < 4; ++ks) { const LAS float* hp = hrow + l15 * HROW + 128 * v + 32 * ks + 8 * kg; bf16x8 ahi, alo; split_bf16(*(const LAS f32x4*)hp, *(const LAS f32x4*)(hp + 4), ahi, alo);
                  acc0 = __builtin_amdgcn_mfma_f32_16x16x32_bf16(ahi, whi[0][ks], acc0, 0, 0, 0); acc1 = __builtin_amdgcn_mfma_f32_16x16x32_bf16(ahi, whi[1][ks], acc1, 0, 0, 0);
                  acc0 = __builtin_amdgcn_mfma_f32_16x16x32_bf16(ahi, wlo[0][ks], acc0, 0, 0, 0); acc1 = __builtin_amdgcn_mfma_f32_16x16x32_bf16(ahi, wlo[1][ks], acc1, 0, 0, 0);
                  acc0 = __builtin_amdgcn_mfma_f32_16x16x32_bf16(alo, whi[0][ks], acc0, 0, 0, 0); acc1 = __builtin_amdgcn_mfma_f32_16x16x32_bf16(alo, whi[1][ks], acc1, 0, 0, 0); }
#pragma unroll
              for (int r = 0; r < 4; ++r) { part[((4 * kg + r) * 8 + v) * 32 + l15] = acc0[r]; part[((4 * kg + r) * 8 + v) * 32 + 16 + l15] = acc1[r]; } }
            __syncthreads();
            { const int tt = 2 * v + kh; float lg = bias_e;
#pragma unroll
              for (int w8 = 0; w8 < 8; ++w8) lg += part[(tt * 8 + w8) * 32 + e];
              float myv = 0.f, v0 = 0.f; int myi = 0;
#pragma unroll
              for (int k = 0; k < 4; ++k) { float mx = lg;
                  mx = rmax16(mx); mx = fmax_raw(mx, shx<16>(mx));
                  const unsigned long long bal = __ballot(lg == mx); const unsigned bh = (unsigned)(bal >> (32 * kh)); const int sel = __ffs((int)bh) - 1;
                  if (k == 0) v0 = mx;
                  if (e == k) { myv = mx; myi = sel; }
                  if (e == sel) lg = -INFINITY; }
              {
                const float ex = fexp2((myv - v0) * 1.4426950408889634f);
                float den = (e < 4) ? ex : 0.f; den += shx<1>(den); den += shx<2>(den);
                if (e < 4) { const int t = tb + tt; topi[t * 4 + e] = myi; topg[t * 4 + e] = ex * frcp(den);
                    const int r = __hip_atomic_fetch_add(hl + myi, 1, __ATOMIC_RELAXED, __HIP_MEMORY_SCOPE_WORKGROUP); rk[(pass * 16 + tt) * 4 + e] = (myi << 8) | r; } } }
        }
        __syncthreads();
        if (C.tid < 32) { base[C.tid] = __hip_atomic_fetch_add(ecnt + C.tid, hl[C.tid], __ATOMIC_RELAXED, __HIP_MEMORY_SCOPE_AGENT); hl[C.tid] = 0; }
        __syncthreads();
        if (C.tid < 256) { const int pk = rk[C.tid], ex = pk >> 8, j = base[ex] + (pk & 255); inv[ex * 16384 + j] = ck * 64 + (C.tid >> 2); posj[ck * 256 + C.tid] = j; }
        __syncthreads();
    }
}
__device__ __forceinline__ void moe_plan_lds(const Ctx& C, int layer) {
    const int* ecnt = (const int*)(C.ws + O_ECNT) + layer * 32;
    LAS int* tot = (LAS int*)(C.lds + LX_MISC + 256); LAS int* pst = tot + 32; LAS int* tile_e = (LAS int*)(C.lds + LX_TILE); LAS int* ntp = (LAS int*)(C.lds + LX_MISC + 128);
    __syncthreads();
    if (C.tid < 32) tot[C.tid] = __hip_atomic_load(ecnt + C.tid, __ATOMIC_RELAXED, __HIP_MEMORY_SCOPE_AGENT);
    __syncthreads();
    { const int e = C.tid & 31, sub = C.tid >> 5; int acc = 0;
#pragma unroll
      for (int x = 0; x < 32; x += 4) { const LAS int* tp = tot + x; const int t0 = tp[0], t1 = tp[1], t2 = tp[2], t3 = tp[3];
          acc += (x < e ? ((t0 + 255) & ~255) : 0) + (x + 1 < e ? ((t1 + 255) & ~255) : 0) + (x + 2 < e ? ((t2 + 255) & ~255) : 0) + (x + 3 < e ? ((t3 + 255) & ~255) : 0); }
      const int mine = (tot[e] + 255) >> 8, first = acc >> 8;
      if (sub == 0) { pst[e] = acc; if (e == 31) ntp[0] = first + mine; }
      for (int i = sub; i < mine; i += 16) tile_e[first + i] = e; }
    __syncthreads();
}
#ifndef ATT_DUP
#define ATT_DUP 1
#endif

__device__ __forceinline__ s16x4 tr16(LAS const unsigned char* p) { typedef short v4i16_t __attribute__((ext_vector_type(4))); return __builtin_bit_cast(s16x4, __builtin_amdgcn_ds_read_tr16_b64_v4i16((LAS v4i16_t*)p)); }

__device__ __forceinline__ float max3f(float a, float b, float c) { return fmaxf(fmaxf(a, b), c); }
#ifndef ATT_THR_V
#define ATT_THR_V 10.f
#endif
constexpr float ATT_THR = ATT_THR_V;
template <int KS, bool DIL>
__device__ __forceinline__ void att_tile(LAS const unsigned char* kb, LAS const unsigned char* vb, const bf16x8 (&qf)[KS], f32x16& o0, f32x16& o1, f32x16& negm, float& mref, float& l, int kidx0, int qidx, bool need_mask, int lane) {
    constexpr int KROW = KS * 32 + 16, VROW = 144;
    const int i32 = lane & 31, hi = lane >> 5;
    const int pr = (i32 & 0x13) | ((i32 & 4) << 1) | ((i32 & 8) >> 1);
    f32x16 p0, p1;
    LAS const unsigned char* kp = kb + pr * KROW + hi * 16;
#ifndef QK_DUP
#define QK_DUP 1
#endif
#pragma unroll 1
    for (int qd_ = 0; qd_ < QK_DUP; ++qd_) {
#pragma unroll
    for (int ks = 0; ks < KS; ++ks) {
        const bf16x8 k0f = *(LAS const bf16x8*)(kp + ks * 32), k1f = *(LAS const bf16x8*)(kp + 32 * KROW + ks * 32);
        if (ks == 0) { p0 = __builtin_amdgcn_mfma_f32_32x32x16_bf16(k0f, qf[0], negm, 0, 0, 0); p1 = __builtin_amdgcn_mfma_f32_32x32x16_bf16(k1f, qf[0], negm, 0, 0, 0); }
        else { p0 = __builtin_amdgcn_mfma_f32_32x32x16_bf16(k0f, qf[ks], p0, 0, 0, 0); p1 = __builtin_amdgcn_mfma_f32_32x32x16_bf16(k1f, qf[ks], p1, 0, 0, 0); }
    }
    asm volatile("" : "+v"(p0), "+v"(p1));
    }
    if (need_mask) {
#pragma unroll
        for (int r = 0; r < 16; ++r) { const int d0 = qidx - (kidx0 + 16 * (r >> 3) + 8 * hi + (r & 7)), d1 = d0 - 32;
            const bool v0 = DIL ? (d0 >= 0 && d0 <= 128) : (d0 >= 0), v1 = DIL ? (d1 >= 0 && d1 <= 128) : (d1 >= 0);
            p0[r] = v0 ? p0[r] : -INFINITY; p1[r] = v1 ? p1[r] : -INFINITY; } }
    float mx = max3f(p0[0], p0[1], p1[0]), mb = max3f(p0[2], p0[3], p1[1]); mx = max3f(mx, p1[2], p1[3]);
#pragma unroll
    for (int r = 4; r < 16; r += 4) { mx = max3f(mx, p0[r], p0[r + 1]); mb = max3f(mb, p0[r + 2], p0[r + 3]); mx = max3f(mx, p1[r], p1[r + 1]); mb = max3f(mb, p1[r + 2], p1[r + 3]); }
    mx = xmax32(fmaxf(mx, mb));
    if (__builtin_expect(__any(mx > ATT_THR), 0)) {
        const float dl = fmaxf(mx, 0.f), f = fexp2(-dl);
        mref += dl; l *= f;
#pragma unroll
        for (int r = 0; r < 16; ++r) { o0[r] *= f; o1[r] *= f; p0[r] -= dl; p1[r] -= dl; negm[r] = -mref; } }
    float ls0 = 0.f, ls1 = 0.f;
#pragma unroll
    for (int r = 0; r < 16; ++r) { p0[r] = fexp2(p0[r]); p1[r] = fexp2(p1[r]); ls0 += p0[r]; ls1 += p1[r]; }
    l += ls0 + ls1;
    u32x4 pw[2][2];
#pragma unroll
    for (int s = 0; s < 2; ++s) {
        pw[0][s].x = cvt_pk_bf16(p0[8 * s + 0], p0[8 * s + 1]); pw[0][s].y = cvt_pk_bf16(p0[8 * s + 2], p0[8 * s + 3]); pw[0][s].z = cvt_pk_bf16(p0[8 * s + 4], p0[8 * s + 5]); pw[0][s].w = cvt_pk_bf16(p0[8 * s + 6], p0[8 * s + 7]);
        pw[1][s].x = cvt_pk_bf16(p1[8 * s + 0], p1[8 * s + 1]); pw[1][s].y = cvt_pk_bf16(p1[8 * s + 2], p1[8 * s + 3]); pw[1][s].z = cvt_pk_bf16(p1[8 * s + 4], p1[8 * s + 5]); pw[1][s].w = cvt_pk_bf16(p1[8 * s + 6], p1[8 * s + 7]); }
    const int g = lane >> 4, i16 = lane & 15;
    LAS const unsigned char* vp = vb + (8 * (g >> 1) + (i16 >> 2)) * VROW + (16 * (g & 1) + 4 * (i16 & 3)) * 2;
#pragma unroll
    for (int sub = 0; sub < 2; ++sub)
#pragma unroll
        for (int s = 0; s < 2; ++s) { const bf16x8 pf = __builtin_bit_cast(bf16x8, pw[sub][s]);
#pragma unroll
            for (int db = 0; db < 2; ++db) { LAS const unsigned char* av = vp + (32 * sub + 16 * s) * VROW + 64 * db;
                const s16x4 lo = tr16(av), hh = tr16(av + 4 * VROW);
                const bf16x8 vf = (bf16x8){lo[0], lo[1], lo[2], lo[3], hh[0], hh[1], hh[2], hh[3]};
                if (db == 0) o0 = __builtin_amdgcn_mfma_f32_32x32x16_bf16(vf, pf, o0, 0, 0, 0); else o1 = __builtin_amdgcn_mfma_f32_32x32x16_bf16(vf, pf, o1, 0, 0, 0); } }
}
__device__ __forceinline__ void att_store(bf16_t* orow  , const f32x16& o0, const f32x16& o1, float inv, int hi) {
#pragma unroll
    for (int rr = 0; rr < 4; ++rr) { u32x2 w0, w1;
        w0.x = cvt_pk_bf16(o0[4 * rr] * inv, o0[4 * rr + 1] * inv); w0.y = cvt_pk_bf16(o0[4 * rr + 2] * inv, o0[4 * rr + 3] * inv);
        w1.x = cvt_pk_bf16(o1[4 * rr] * inv, o1[4 * rr + 1] * inv); w1.y = cvt_pk_bf16(o1[4 * rr + 2] * inv, o1[4 * rr + 3] * inv);
        *(u32x2*)(orow + 8 * rr + 4 * hi) = w0; *(u32x2*)(orow + 32 + 8 * rr + 4 * hi) = w1; }
}


struct BgConv {
    const float* w1; const float* w2; unsigned char* ws; LAS unsigned char* T;
    int pair, it, nit, step, sub;
    bool pendA, pendB; int psubA, psubB; unsigned char* pWTA; unsigned char* pWTB;
    f32x4 vA[4], vB[4];
};
__device__ __forceinline__ void bg_tile(const BgConv& S, int it, const float*& W, int& N, unsigned char*& WT, int& n0, int& k0) {
    constexpr int I1 = 32 * 8, I2 = 16 * 8, N1 = 64 * I1;
    if (it < N1) { const int mat = S.pair * 64 + it / I1, q = it % I1; W = S.w1 + (size_t)mat * 1024 * 2048; WT = S.ws + O_W1 + (size_t)mat * SZ_W1E; N = 2048; n0 = (q >> 3) * 64; k0 = (q & 7) * 128; }
    else { const int r = it - N1, mat = S.pair * 64 + r / I2, q = r % I2; W = S.w2 + (size_t)mat * 1024 * 1024; WT = S.ws + O_W2 + (size_t)mat * SZ_W2E; N = 1024; n0 = (q >> 3) * 64; k0 = (q & 7) * 128; }
}
__device__ __forceinline__ void bg_init(BgConv& S, const Ctx& C, const float* w1, const float* w2, int pair) {
    S.w1 = w1; S.w2 = w2; S.ws = C.ws; S.T = C.lds + 49152 + C.wave * 9216; S.pair = pair; S.it = C.gw; S.nit = 64 * 256 + 64 * 128; S.step = C.NGW; S.sub = 0;
    S.pendA = false; S.pendB = false; S.psubA = 0; S.psubB = 0; S.pWTA = C.ws; S.pWTB = C.ws;
}
__device__ __forceinline__ bool bg_done(const BgConv& S) { return !S.pendA && !S.pendB && S.it >= S.nit; }
__device__ __forceinline__ void bg_half(BgConv& S, f32x4 (&v)[4], bool& pend, int& psub, unsigned char*& pWT, int lane) {
    const int kq = lane >> 4, c4 = lane & 15;
    if (pend) {
#pragma unroll
        for (int jj = 0; jj < 4; ++jj) *(LAS unsigned*)(S.T + (4 * c4 + jj) * 144 + 32 * kq + 4 * psub) = pk4_fp8(32.f * v[0][jj], 32.f * v[1][jj], 32.f * v[2][jj], 32.f * v[3][jj]);
        if (psub == 7) {
            asm volatile("s_waitcnt lgkmcnt(0)" ::: "memory");
#pragma unroll
            for (int s8 = 0; s8 < 8; ++s8) { const int n = 8 * s8 + (lane >> 3), ch = lane & 7; const u32x4 w = *(const LAS u32x4*)(S.T + n * 144 + 16 * ch);
                *(u32x4*)(pWT + (size_t)n * 1024 + 16 * ch) = w; }
            asm volatile("s_waitcnt lgkmcnt(0)" ::: "memory"); }
        pend = false; }
    if (S.it < S.nit) { const float* W; int N, n0, k0; unsigned char* WT; bg_tile(S, S.nit - 1 - S.it, W, N, WT, n0, k0);
        const float* p = W + (size_t)(k0 + 32 * kq + 4 * S.sub) * N + n0 + 4 * c4;
#pragma unroll
        for (int i = 0; i < 4; ++i) v[i] = __builtin_nontemporal_load((const f32x4*)(p + (size_t)i * N));
        pend = true; psub = S.sub; pWT = WT + (size_t)n0 * 1024 + k0;
        if (++S.sub == 8) { S.sub = 0; S.it += S.step; } }
}
#define BG_STEP_A() bg_half(BG, BG.vA, BG.pendA, BG.psubA, BG.pWTA, lane)
#define BG_STEP_B() bg_half(BG, BG.vB, BG.pendB, BG.psubB, BG.pWTB, lane)

__device__ __forceinline__ void mla_unit(const Ctx& C, BgConv& BG, int b, int h, int qb) {
    constexpr int KROW = 208, VROW = 144, KB = 64 * KROW, BUF = KB + 64 * VROW;
    const bf16_t* Q2 = (const bf16_t*)(C.ws + O_Q2); const bf16_t* KV2 = (const bf16_t*)(C.ws + O_KV2); const bf16_t* PROJ = (const bf16_t*)(C.ws + O_PROJ); bf16_t* ATT = (bf16_t*)(C.ws + O_ATT);
    const int tid = C.tid, lane = C.lane, w = C.wave, i32 = lane & 31, hi = lane >> 5;
    const int q0 = qb * 256; const size_t rowb = (size_t)b * S_;
    bf16x8 qf[6];
    { const bf16_t* qrow = Q2 + (rowb + q0 + 32 * w + i32) * 768 + 8 * hi;
#pragma unroll
      for (int ks = 0; ks < 4; ++ks) qf[ks] = *(const bf16x8*)(qrow + h * 64 + 16 * ks);
      qf[4] = *(const bf16x8*)(qrow + 512 + h * 32); qf[5] = *(const bf16x8*)(qrow + 512 + h * 32 + 16); }
    f32x16 o0, o1;
#pragma unroll
    for (int r = 0; r < 16; ++r) { o0[r] = 0.f; o1[r] = 0.f; }
    float m = 0.f, l = 0.f; f32x16 negm;
#pragma unroll
    for (int r = 0; r < 16; ++r) negm[r] = 0.f;
    const int NT = 4 * qb + 4, wmax = 4 * qb + (w >> 1);
    const int r8 = tid >> 3, c8 = tid & 7, r4 = (tid & 255) >> 2, c4 = tid & 3;
    const bf16_t* knp = KV2 + (rowb + r8) * 1024 + h * 64 + 8 * c8; const bf16_t* kpp = PROJ + (rowb + r4) * 2048 + 1920 + 8 * c4;
    u32x4 kA, vA, pA, kB, vB, pB;
#define MLA_LOAD(j, K, V, P) do { const int jc_ = ((j) < NT) ? (j) : NT - 1; K = *(const u32x4*)(knp + (size_t)jc_ * 64 * 1024); V = *(const u32x4*)(knp + (size_t)jc_ * 64 * 1024 + 512); P = *(const u32x4*)(kpp + (size_t)jc_ * 64 * 2048); } while (0)
#define MLA_WRITE(bo, K, V, P) do { *(LAS u32x4*)(C.lds + (bo) + r8 * KROW + 16 * c8) = K; *(LAS u32x4*)(C.lds + (bo) + KB + r8 * VROW + 16 * c8) = V; *(LAS u32x4*)(C.lds + (bo) + r4 * KROW + 128 + 16 * c4) = P; } while (0)
#define MLA_STEP(j, KF, VF, PF, KN, VN, PN, BGS) do { const int j_ = (j); const int bo_ = (j_ & 1) * BUF; \
        MLA_LOAD(j_ + 2, KF, VF, PF); BGS(); \
        if (j_ <= wmax) { _Pragma("unroll 1") for (int dup_ = 0; dup_ < ATT_DUP; ++dup_) att_tile<6, false>(C.lds + bo_, C.lds + bo_ + KB, qf, o0, o1, negm, m, l, 64 * j_, q0 + 32 * w + i32, j_ == wmax, lane); } \
        MLA_WRITE(BUF - bo_, KN, VN, PN); \
        __syncthreads(); } while (0)
    MLA_LOAD(0, kA, vA, pA); MLA_LOAD(1, kB, vB, pB);
    MLA_WRITE(0, kA, vA, pA);
    __syncthreads();
#pragma unroll 1
    for (int j = 0; j < NT; j += 2) { MLA_STEP(j, kA, vA, pA, kB, vB, pB, BG_STEP_A); MLA_STEP(j + 1, kB, vB, pB, kA, vA, pA, BG_STEP_B); }
#undef MLA_STEP
#undef MLA_LOAD
#undef MLA_WRITE
    l = xadd32(l);
    att_store(ATT + (rowb + q0 + 32 * w + i32) * 1024 + 512 + h * 64, o0, o1, 1.f / l, hi);
}
__device__ __forceinline__ void dil_unit(const Ctx& C, BgConv& BG, int p, int dd, int b, int h, int res, int n) {
    constexpr int KROW = 144, VROW = 144, KB = 64 * KROW, BUF = KB + 64 * VROW;
    const bf16_t* PROJ = (const bf16_t*)(C.ws + O_PROJ); bf16_t* OA = (bf16_t*)(C.ws + O_OA) + (size_t)p * T_ * 512; float* LSE = (float*)(C.ws + O_LSE) + (size_t)p * T_ * 8;
    const int tid = C.tid, lane = C.lane, w = C.wave, i32 = lane & 31, hi = lane >> 5;
    const size_t rowb = (size_t)b * S_;
    const int qsub = 256 * n + 32 * w + i32; const size_t qtok = rowb + (size_t)qsub * dd + res;
    bf16x8 qf[4];
    { const bf16_t* qrow = PROJ + qtok * 2048 + h * 64 + 8 * hi;
#pragma unroll
      for (int ks = 0; ks < 4; ++ks) qf[ks] = *(const bf16x8*)(qrow + 16 * ks); }
    f32x16 o0, o1;
#pragma unroll
    for (int r = 0; r < 16; ++r) { o0[r] = 0.f; o1[r] = 0.f; }
    float m = 0.f, l = 0.f; f32x16 negm;
#pragma unroll
    for (int r = 0; r < 16; ++r) negm[r] = 0.f;
    const int jbeg = (n == 0) ? 2 : 0, wlo = w >> 1, whi = (32 * w + 159) >> 6;
    const int r8 = tid >> 3, c8 = tid & 7;
    u32x4 kA, vA, kB, vB;
    const int cnt = 6 - jbeg;
#define DIL_LOAD(i, K, V) do { const int jc_ = jbeg + (((i) < cnt) ? (i) : cnt - 1); const size_t tok = rowb + (size_t)(256 * n - 128 + 64 * jc_ + r8) * dd + res; const bf16_t* src = PROJ + tok * 2048 + 512 + h * 64 + 8 * c8; K = *(const u32x4*)src; V = *(const u32x4*)(src + 512); } while (0)
#define DIL_WRITE(bo, K, V) do { *(LAS u32x4*)(C.lds + (bo) + r8 * KROW + 16 * c8) = K; *(LAS u32x4*)(C.lds + (bo) + KB + r8 * VROW + 16 * c8) = V; } while (0)
#define DIL_STEP(i, KF, VF, KN, VN, BGS) do { const int i_ = (i); const int bo_ = (i_ & 1) * BUF, j_ = jbeg + i_; \
        DIL_LOAD(i_ + 2, KF, VF); BGS(); \
        if (i_ < cnt && j_ >= wlo && j_ <= whi) { const int kb0_ = 256 * n - 128 + 64 * j_, qlo_ = 256 * n + 32 * w; _Pragma("unroll 1") for (int dup_ = 0; dup_ < ATT_DUP; ++dup_) att_tile<4, true>(C.lds + bo_, C.lds + bo_ + KB, qf, o0, o1, negm, m, l, kb0_, qsub, !(kb0_ + 63 <= qlo_ && qlo_ + 31 - kb0_ <= 128), lane); } \
        DIL_WRITE(BUF - bo_, KN, VN); \
        __syncthreads(); } while (0)
    DIL_LOAD(0, kA, vA); DIL_LOAD(1, kB, vB);
    DIL_WRITE(0, kA, vA);
    __syncthreads();
    DIL_STEP(0, kA, vA, kB, vB, BG_STEP_A); DIL_STEP(1, kB, vB, kA, vA, BG_STEP_B); DIL_STEP(2, kA, vA, kB, vB, BG_STEP_A); DIL_STEP(3, kB, vB, kA, vA, BG_STEP_B);
    if (cnt == 6) { DIL_STEP(4, kA, vA, kB, vB, BG_STEP_A); DIL_STEP(5, kB, vB, kA, vA, BG_STEP_B); }
#undef DIL_STEP
#undef DIL_LOAD
#undef DIL_WRITE
    l = xadd32(l);
    att_store(OA + qtok * 512 + h * 64, o0, o1, 1.f / l, hi);
    if (hi == 0) LSE[qtok * 8 + h] = m + log2f(l);
}
#ifndef REP_MLA
#define REP_MLA 1
#endif
#ifndef REP_DIL
#define REP_DIL 1
#endif
__device__ __forceinline__ void phase_attention(const Ctx& C, const float* w1, const float* w2, int pair) {
    BgConv BG; bg_init(BG, C, w1, w2, pair);
#pragma unroll 1
    for (int rep = 0; rep < REP_MLA; ++rep) {
    if (C.G == 256) { const int bh = C.vcu >> 3, s = C.vcu & 7; mla_unit(C, BG, bh >> 3, bh & 7, s); mla_unit(C, BG, bh >> 3, bh & 7, 15 - s); }
    else for (int u = C.bid; u < 512; u += C.G) mla_unit(C, BG, u >> 7, (u >> 4) & 7, u & 15);
    }
#pragma unroll 1
    for (int rep = 0; rep < REP_DIL; ++rep)
    for (int u = C.bid; u < 1536; u += C.G) { const int p = u >> 9, rem = u & 511, b = rem >> 7, h = (rem >> 4) & 7, blk = rem & 15;
        const int dd = (p == 0) ? 1 : (p == 1) ? 4 : 16, bpr = 16 / dd;
        dil_unit(C, BG, p, dd, b, h, blk / bpr, blk % bpr); }
    { const int lane = C.lane;
#pragma unroll 1
      while (!bg_done(BG)) { BG_STEP_A(); BG_STEP_B(); } }
}
#undef BG_STEP_A
#undef BG_STEP_B

#ifdef TIME_NORM
constexpr int N_PHASES = 42;
#else
constexpr int N_PHASES = 36;
#endif
extern __shared__ __attribute__((aligned(16))) unsigned char lds_raw[];
typedef const __attribute__((address_space(4))) Args* ArgsP;
#define PHFN static __device__ __forceinline__ void
__device__ __forceinline__ ArgsP fresh_args() { unsigned long long p = (unsigned long long)__builtin_amdgcn_kernarg_segment_ptr(); asm volatile("" : "+s"(p)); return (ArgsP)p; }
__device__ __forceinline__ Ctx make_ctx(ArgsP ap, int wv) {
    Ctx C; C.lds = (LAS unsigned char*)lds_raw; C.ws = ap->ws;
    unsigned ones = ~0u; asm volatile("" : "+s"(ones)); const int lane = (int)__builtin_amdgcn_mbcnt_hi(ones, __builtin_amdgcn_mbcnt_lo(ones, 0u));
    int bid = blockIdx.x; asm volatile("" : "+s"(bid)); int G = gridDim.x; asm volatile("" : "+s"(G));
    C.wave = wv; C.lane = lane; C.tid = wv * 64 + lane;
    C.G = G; C.bid = bid; C.vcu = (C.G % 8 == 0) ? (C.bid % 8) * (C.G / 8) + C.bid / 8 : C.bid;
    C.gw = C.bid * 8 + C.wave; C.NGW = C.G * 8; return C;
}
#define IN(i) ((const float*)ap->in[i])
#define MODL(l) ((const float*)(C.ws + O_MOD) + (size_t)(l) * 4 * 6144)
PHFN ph_prologue(int wv) { const ArgsP ap = fresh_args(); const Ctx C = make_ctx(ap, wv); p0_prologue(C, ap); }
PHFN ph_norm(int wv, int l, int mode) { const ArgsP ap = fresh_args(); const Ctx C = make_ctx(ap, wv);
    if (mode == 0) phase_norm(C, IN(0), nullptr, false, true, IN(5), MODL(0), MODL(0), 0, 1024, false, true);
    else if (mode == 1) phase_norm(C, nullptr, nullptr, true, true, IN(5) + l * 1024, MODL(l - 1), MODL(l), 0, 1024, false, (l & 1) == 0);
    else if (mode == 3) phase_norm(C, nullptr, nullptr, true, true, IN(5) + l * 1024, MODL(l - 1), MODL(l), 0, 1024, true);
    else phase_norm(C, nullptr, ap->out, true, false, IN(5), MODL(3), MODL(3), 0, 1024); }
PHFN ph_proj(int wv, int j) { const ArgsP ap = fresh_args(); const Ctx C = make_ctx(ap, wv); unsigned char* ws = C.ws;
    DenseOrder S; S.init(ws + O_HN, ws + O_WIN + j * SZ_WIN, 1024, 1024, T_, 2048, C.G, C.bid, 1); EpiNorm<0> E{(bf16_t*)(ws + O_PROJ), 2048, IN(8) + j * 64, IN(9) + j * 64, IN(10) + j * 256, IN(11) + j * 128, IN(15) + j * 96 + 64, (const float*)(ws + O_CS), (LAS float*)(C.lds + LX_EXCH), 1.f / 32.f}; gemm_phase<true>(C, GemmDims{1024, 1024, 1024}, S, E); }
PHFN ph_postproj(int wv, int j) { const ArgsP ap = fresh_args(); const Ctx C = make_ctx(ap, wv); phase_postproj(C, IN(8) + j * 64, IN(9) + j * 64, IN(10) + j * 256, IN(11) + j * 128, IN(15) + j * 96); }
PHFN ph_qkv(int wv, int j) { const ArgsP ap = fresh_args(); const Ctx C = make_ctx(ap, wv); unsigned char* ws = C.ws;
    { DenseOrder S; S.init(ws + O_PROJ + 1536 * 2, ws + O_WUQ + j * SZ_WUQ, 2048, 256, T_, 768, C.G, C.bid); EpiNorm<1> E{(bf16_t*)(ws + O_Q2), 768, IN(14) + j * 96, IN(14) + j * 96 + 64, nullptr, nullptr, nullptr, (const float*)(ws + O_CS), (LAS float*)(C.lds + LX_EXCH), 1.f}; gemm_phase(C, GemmDims{256, 2048, 256}, S, E); }
    { const ArgsP ap2 = fresh_args(); const Ctx C = make_ctx(ap2, wv); unsigned char* ws = C.ws; DenseOrder S; S.init(ws + O_PROJ + 1792 * 2, ws + O_WUKV + j * SZ_WUKV, 2048, 128, T_, 1024, C.G, C.bid); EpiNorm<2> E{(bf16_t*)(ws + O_KV2), 1024, IN(15) + j * 96, nullptr, nullptr, nullptr, nullptr, (const float*)(ws + O_CS), (LAS float*)(C.lds + LX_EXCH), 1.f}; gemm_phase(C, GemmDims{128, 2048, 128}, S, E); } }
PHFN ph_postq(int wv, int j) { const ArgsP ap = fresh_args(); const Ctx C = make_ctx(ap, wv); phase_postq(C, IN(14) + j * 96, IN(15) + j * 96); }
PHFN ph_attention(int wv, int pair) { const ArgsP ap = fresh_args(); const Ctx C = make_ctx(ap, wv); phase_attention(C, IN(30), IN(32), pair); }
PHFN ph_mixcombine(int wv) { const ArgsP ap = fresh_args(); const Ctx C = make_ctx(ap, wv); phase_mixcombine(C); }
PHFN ph_outproj(int wv, int l, int which) { const ArgsP ap = fresh_args(); const Ctx C = make_ctx(ap, wv); unsigned char* ws = C.ws; const int j = l >> 1;
    DenseOrder S; S.init(ws + O_ATT, ws + (which ? O_RWOUT + j * SZ_RWOUT : O_WOUT + j * SZ_WOUT), 1024, 1024, T_, 1024, C.G, C.bid);
    EpiResid E{(bf16_t*)(ws + O_X), MODL(l) + 2048, which ? IN(27) + j * 1024 : nullptr}; gemm_phase(C, GemmDims{1024, 1024, 1024}, S, E); }
PHFN ph_router(int wv, int l) { const ArgsP ap = fresh_args(); const Ctx C = make_ctx(ap, wv); phase_router(C, (const bf16_t*)(C.ws + O_X), IN(6) + l * 1024, MODL(l), IN(28) + (size_t)l * 1024 * 32, IN(29) + l * 32, l); }
PHFN ph_moe1(int wv, int l) { const ArgsP ap = fresh_args(); const Ctx C = make_ctx(ap, wv); unsigned char* ws = C.ws; moe_plan_lds(C, l);
    MoeOrderT<true> S; S.A = (const char*)(ws + O_HN); S.WT = (const char*)(ws + O_W1 + (size_t)l * 32 * SZ_W1E); S.estride = SZ_W1E; S.tile_e = (const LAS int*)(C.lds + LX_TILE);
    S.NT = *(const LAS int*)(C.lds + LX_MISC + 128); S.nN = 8; S.G = C.G; S.c = C.bid; S.esz = 1; S.gtab = (const LAS int*)(C.lds + LX_GTAB);
    { const int* inv = (const int*)(ws + O_INV); LAS int* gt = (LAS int*)(C.lds + LX_GTAB); const LAS int* tot = (const LAS int*)(C.lds + LX_MISC + 256); const LAS int* pst = tot + 32;
      const int r = C.tid & 255, i0 = __builtin_amdgcn_readfirstlane(C.tid >> 8); int val[GTAB_UNITS / 2]; float bvl[GTAB_UNITS / 2]; const float* b1 = IN(31) + (size_t)l * 32 * 2048;
#pragma unroll
      for (int k = 0; k < GTAB_UNITS / 2; ++k) { Unit u; const bool ok = S.next(2 * k + i0, u); const int e = ok ? u.e : 0, j = (ok ? u.row0 - pst[e] : 0) + r; val[k] = (ok && j < tot[e]) ? inv[e * 16384 + j] : 0;
          bvl[k] = ok ? b1[(size_t)e * 2048 + u.col0 + r] : 0.f; }
      { const int* topi = (const int*)(ws + O_TOPI); const int* posj = (const int*)(ws + O_POSJ); int* pos = (int*)(ws + O_POS);
        for (int ck = C.bid; ck < 256; ck += C.G) if (C.tid < 256) pos[ck * 256 + C.tid] = pst[topi[ck * 256 + C.tid]] + posj[ck * 256 + C.tid]; }
#pragma unroll
      for (int k = 0; k < GTAB_UNITS / 2; ++k) { gt[(2 * k + i0) * 256 + r] = val[k]; ((LAS float*)(C.lds + LX_BIAS))[(2 * k + i0) * 256 + r] = bvl[k]; }
      __syncthreads(); }
    EpiSwiglu E{(unsigned char*)(ws + O_ACT), (const LAS float*)(C.lds + LX_BIAS), 1.f / 32.f}; gemm_phase<true>(C, GemmDims{1024, 1024, 1024}, S, E); }
PHFN ph_moe2(int wv, int l) { const ArgsP ap = fresh_args(); const Ctx C = make_ctx(ap, wv); unsigned char* ws = C.ws;
#if MODE != 1
    moe_plan_lds(C, l);
#endif

    MoeOrder S; S.A = (const char*)(ws + O_ACT); S.WT = (const char*)(ws + O_W2 + (size_t)l * 32 * SZ_W2E); S.estride = SZ_W2E; S.tile_e = (const LAS int*)(C.lds + LX_TILE);
    S.NT = *(const LAS int*)(C.lds + LX_MISC + 128); S.nN = 4; S.G = C.G; S.c = C.bid; S.esz = 1;
    { const float* b2 = IN(33) + (size_t)l * 32 * 1024; const int r = C.tid & 255, i0 = __builtin_amdgcn_readfirstlane(C.tid >> 8); float bvl[GTAB_UNITS / 2];
#pragma unroll
      for (int k = 0; k < GTAB_UNITS / 2; ++k) { Unit u; const bool ok = S.next(2 * k + i0, u); bvl[k] = ok ? b2[(size_t)u.e * 1024 + u.col0 + r] : 0.f; }
#pragma unroll
      for (int k = 0; k < GTAB_UNITS / 2; ++k) ((LAS float*)(C.lds + LX_BIAS))[(2 * k + i0) * 256 + r] = bvl[k];
      __syncthreads(); }
    EpiY8 E{ws + O_Y2, 1.f / 32.f, (const LAS float*)(C.lds + LX_BIAS)}; gemm_phase<true>(C, GemmDims{1024, 1024, 1024}, S, E); }
PHFN ph_recin(int wv, int j) { const ArgsP ap = fresh_args(); const Ctx C = make_ctx(ap, wv); unsigned char* ws = C.ws;
    DenseOrder S; S.init(ws + O_HN, ws + O_RWIN + j * SZ_RWIN, 1024, 1024, T_, 2048, C.G, C.bid);
    { const float* bias = IN(18) + j * 2048; LAS float* bt = (LAS float*)(C.lds + LX_BIAS); const int r = C.tid & 255, i0 = __builtin_amdgcn_readfirstlane(C.tid >> 8);
      float bvl[2];
#pragma unroll
      for (int k = 0; k < 2; ++k) { Unit u; const bool ok = S.next(2 * k + i0, u); bvl[k] = ok ? bias[u.col0 + r] : 0.f; }
#pragma unroll
      for (int k = 0; k < 2; ++k) bt[(2 * k + i0) * 256 + r] = bvl[k];
      __syncthreads(); }
    EpiRecIn E{(bf16_t*)(ws + O_PROJ), IN(18) + j * 2048, (const LAS float*)(C.lds + LX_BIAS)}; gemm_phase(C, GemmDims{1024, 1024, 1024}, S, E); }
PHFN ph_rgate(int wv, int j) { const ArgsP ap = fresh_args(); const Ctx C = make_ctx(ap, wv); phase_rgate(C, j, IN(19) + j * 4096, IN(20) + j * 1024, IN(22) + j * 1024, IN(24) + j * 1024); }
PHFN ph_scan_apply(int wv) { const ArgsP ap = fresh_args(); const Ctx C = make_ctx(ap, wv); phase_scan_apply(C); }

#if MODE == 1
__device__ __forceinline__ int fresh_tid(int wv) { unsigned ones = ~0u; asm volatile("" : "+s"(ones)); return wv * 64 + (int)__builtin_amdgcn_mbcnt_hi(ones, __builtin_amdgcn_mbcnt_lo(ones, 0u)); }
__device__ __forceinline__ void grid_barrier(int wv) { const ArgsP q = fresh_args(); XcdBarrier b; b.bar = (unsigned*)(q->ws + O_CTL) + CW_BAR; b.x = xb_xcc_id(); b.st = (volatile LAS unsigned*)((LAS unsigned char*)lds_raw + LDSX_OFF); xcd_barrier(b, fresh_tid(wv)); }
__global__ void __launch_bounds__(512, 2) mk_fwd(Args a) {
    int wv = __builtin_amdgcn_readfirstlane(threadIdx.x >> 6); asm volatile("" : "+s"(wv));
    { LAS unsigned char* lds = (LAS unsigned char*)lds_raw;
      for (int u = threadIdx.x; u < (LDS_BYTES - LDSX_OFF) / 4; u += 512) ((LAS unsigned*)(lds + LDSX_OFF))[u] = 0u;
      __syncthreads();
      if (a.ph_hi - a.ph_lo > 1) (void)xcd_barrier_post((unsigned*)(a.ws + O_CTL) + CW_BAR, (volatile LAS unsigned*)(lds + LDSX_OFF), (int)threadIdx.x); }
    int pid = 0;
#define PHASE(call) { const ArgsP q_ = fresh_args(); const int lo_ = q_->ph_lo, hi_ = q_->ph_hi; if (pid >= lo_ && pid < hi_) { call; if (pid + 1 < hi_) grid_barrier(wv); } ++pid; }
#define PHASE_R(call, REP) { const ArgsP q_ = fresh_args(); const int lo_ = q_->ph_lo, hi_ = q_->ph_hi; if (pid >= lo_ && pid < hi_) { if ((REP) > 1) { call; grid_barrier(wv); } call; if (pid + 1 < hi_) grid_barrier(wv); } ++pid; }
#ifndef REP_PROLOGUE
#define REP_PROLOGUE 1
#endif
#ifndef REP_MOE
#define REP_MOE 1
#endif
#ifndef REP_ATTN
#define REP_ATTN 1
#endif
#ifndef REP_GEMMS
#define REP_GEMMS 1
#endif
#ifdef TIME_NORM
#define NORM_EXTRA(l) PHASE(ph_norm(wv, l, 3))
#else
#define NORM_EXTRA(l)
#endif
#ifndef REP_ELEM
#define REP_ELEM 1
#endif
#ifndef REP_ROUTER
#define REP_ROUTER REP_ELEM
#endif
#ifndef REP_SCATTER
#define REP_SCATTER REP_ELEM
#endif
#ifndef REP_MIX
#define REP_MIX REP_ELEM
#endif
#ifndef REP_CONV
#define REP_CONV REP_ELEM
#endif
#ifndef REP_SCANA
#define REP_SCANA REP_ELEM
#endif
#define MOE_PHASES(l) PHASE_R(ph_router(wv, l), REP_ROUTER) PHASE_R(ph_moe1(wv, l), REP_MOE) PHASE_R(ph_moe2(wv, l), REP_MOE)
    PHASE_R(ph_prologue(wv), REP_PROLOGUE)
#define LAYER_PAIR(lp) \
        { const int l = 2 * (lp);         \
          PHASE(ph_norm(wv, l, (lp) == 0 ? 0 : 1)) PHASE_R(ph_proj(wv, lp), REP_GEMMS) PHASE_R(ph_qkv(wv, lp), REP_GEMMS) PHASE_R(ph_attention(wv, lp), REP_ATTN) PHASE_R(ph_mixcombine(wv), REP_MIX) PHASE(ph_outproj(wv, l, 0)) \
          MOE_PHASES(l) } \
        { const int l = 2 * (lp) + 1;     \
          NORM_EXTRA(l) PHASE(ph_norm(wv, l, 1)) PHASE_R(ph_recin(wv, lp), REP_GEMMS) PHASE_R(ph_rgate(wv, lp), REP_CONV) PHASE_R(ph_scan_apply(wv), REP_SCANA) PHASE(ph_outproj(wv, l, 1)) \
          MOE_PHASES(l) }
    LAYER_PAIR(0)
    LAYER_PAIR(1)
#undef LAYER_PAIR
#ifdef EXTRA_BARRIERS
    { const ArgsP q_ = fresh_args(); if (q_->ph_hi - q_->ph_lo > 1) { _Pragma("unroll 1") for (int xb = 0; xb < EXTRA_BARRIERS; ++xb) grid_barrier(wv); } }
#endif
    PHASE(ph_norm(wv, 3, 2))
#undef PHASE
#undef PHASE_R
#undef MOE_PHASES
}
#else
template <int PH> __global__ void __launch_bounds__(512, 2) k_phase(Args a, int l, int x) {
    int wv = __builtin_amdgcn_readfirstlane(threadIdx.x >> 6); asm volatile("" : "+s"(wv));
    LAS unsigned char* lds = (LAS unsigned char*)lds_raw;
    for (int u = threadIdx.x; u < (LDS_BYTES - LDSX_OFF) / 4; u += 512) ((LAS unsigned*)(lds + LDSX_OFF))[u] = 0u;
    __syncthreads();
    if constexpr (PH == 0) ph_prologue(wv);
    if constexpr (PH == 1) ph_norm(wv, l, x);
    if constexpr (PH == 2) ph_proj(wv, l);
    if constexpr (PH == 4) ph_qkv(wv, l);
    if constexpr (PH == 6) ph_attention(wv, l);
    if constexpr (PH == 7) ph_mixcombine(wv);
    if constexpr (PH == 8) ph_outproj(wv, l, x);
    if constexpr (PH == 9) ph_router(wv, l);
    if constexpr (PH == 11) ph_moe1(wv, l);
    if constexpr (PH == 12) ph_moe2(wv, l);
    if constexpr (PH == 13) ph_recin(wv, l);
    if constexpr (PH == 14) ph_rgate(wv, l);
    if constexpr (PH == 17) ph_scan_apply(wv);
}
#endif
#undef IN
#undef MODL
}

#ifndef MODE
#define MODE 2
#endif
extern "C" void kernel_launch(void* const* d_in, const int* in_sizes, int n_in, void* d_out, int out_size, void* d_ws, size_t ws_size, hipStream_t stream) {
    (void)in_sizes; (void)n_in; (void)out_size; (void)ws_size;
#if MODE == 0
    nv::forward(d_in, (float*)d_out, d_ws, stream);
#else
    static int grid = 0;
    if (grid == 0) {
        int dev = 0, cus = 0;
        (void)hipGetDevice(&dev); (void)hipDeviceGetAttribute(&cus, hipDeviceAttributeMultiprocessorCount, dev);
#if MODE == 1
        (void)hipFuncSetAttribute((const void*)mk::mk_fwd, hipFuncAttributeMaxDynamicSharedMemorySize, mk::LDS_BYTES);
#else
#define SA(PH) (void)hipFuncSetAttribute((const void*)mk::k_phase<PH>, hipFuncAttributeMaxDynamicSharedMemorySize, mk::LDS_BYTES)
        SA(0); SA(1); SA(2); SA(4); SA(6); SA(7); SA(8); SA(9); SA(10); SA(11); SA(12); SA(13); SA(14); SA(17);
#undef SA
#endif
        grid = cus > 0 ? cus : 256;
    }
    (void)hipMemsetAsync((char*)d_ws + mk::O_CTL, 0, 64 * 1024, stream);
    mk::Args a;
    memset(&a, 0, sizeof(a));
    for (int i = 0; i < 34; ++i) a.in[i] = d_in[i];
    a.out = (float*)d_out; a.ws = (unsigned char*)d_ws;
#if MODE == 1
    a.ph_lo = 0; a.ph_hi = mk::N_PHASES;
    hipLaunchKernelGGL(mk::mk_fwd, dim3(grid), dim3(512), mk::LDS_BYTES, stream, a);
#else
#define LP(PH, l, x) hipLaunchKernelGGL(mk::k_phase<PH>, dim3(grid), dim3(512), mk::LDS_BYTES, stream, a, l, x)
    LP(0, 0, 0);
    for (int lp = 0; lp < 2; ++lp) {
        { const int l = 2 * lp; LP(1, l, lp == 0 ? 0 : 1); LP(2, lp, 0); LP(4, lp, 0); LP(6, lp, 0); LP(7, 0, 0); LP(8, l, 0); LP(9, l, 0); LP(10, 0, 0); LP(11, l, 0); LP(12, l, 0); }
        { const int l = 2 * lp + 1; LP(1, l, 1); LP(13, lp, 0); LP(14, lp, 0); LP(17, 0, 0); LP(8, l, 1); LP(9, l, 0); LP(10, 0, 0); LP(11, l, 0); LP(12, l, 0); }
    }
    LP(1, 3, 2);
#undef LP
#endif
#endif
}
```

```cpp
#define MODE 1

#include <string.h>
#include <hip/hip_runtime.h>
#include <stdint.h>
#include <math.h>

namespace cfg {
constexpr int D = 1024, NB = 4, S = 4096, T = NB * S, DEPTH = 4;
constexpr int MIXIN = 1952;
constexpr int NE = 32, TOPK = 4;
constexpr int MPAIR = T * TOPK;
constexpr int NBLK = MPAIR / 256 + NE;
constexpr int P = NBLK * 256;
}
using namespace cfg;


namespace mk {
#define LAS __attribute__((address_space(3)))
#define GAS __attribute__((address_space(1)))
typedef unsigned short bf16_t;
typedef short bf16x8 __attribute__((ext_vector_type(8)));
typedef short s16x4 __attribute__((ext_vector_type(4)));
typedef float f32x2 __attribute__((ext_vector_type(2)));
typedef float f32x4 __attribute__((ext_vector_type(4)));
typedef float f32x16 __attribute__((ext_vector_type(16)));
typedef unsigned u32x2 __attribute__((ext_vector_type(2)));
typedef unsigned u32x4 __attribute__((ext_vector_type(4)));
typedef GAS unsigned gu32;
#define RLX_AGENT __ATOMIC_RELAXED, __HIP_MEMORY_SCOPE_AGENT

__device__ __forceinline__ unsigned cvt_pk_bf16(float lo, float hi) { unsigned r; asm volatile("v_cvt_pk_bf16_f32 %0, %1, %2" : "=v"(r) : "v"(lo), "v"(hi)); return r; }
__device__ __forceinline__ float bf_lo(unsigned u) { return __uint_as_float(u << 16); }
__device__ __forceinline__ float bf_hi(unsigned u) { return __uint_as_float(u & 0xffff0000u); }
template <int O> __device__ __forceinline__ float shx(float v) { static_assert(O >= 1 && O < 32, "shx"); return __int_as_float(__builtin_amdgcn_ds_swizzle(__float_as_int(v), (O << 10) | 0x1f)); }
__device__ __forceinline__ float xadd32(float v) { const auto r = __builtin_amdgcn_permlane32_swap(__float_as_uint(v), __float_as_uint(v), false, false); return __uint_as_float(r[0]) + __uint_as_float(r[1]); }
__device__ __forceinline__ float xmax32(float v) { const auto r = __builtin_amdgcn_permlane32_swap(__float_as_uint(v), __float_as_uint(v), false, false); return fmaxf(__uint_as_float(r[0]), __uint_as_float(r[1])); }
#define DPP_STEP(OP, N) asm("s_nop 1\n\t" OP "_dpp %0, %1, %1 row_ror:" #N " row_mask:0xf bank_mask:0xf" : "=v"(r) : "v"(v)); v = r;
__device__ __forceinline__ float rsum16(float v) { float r; DPP_STEP("v_add_f32", 1) DPP_STEP("v_add_f32", 2) DPP_STEP("v_add_f32", 4) DPP_STEP("v_add_f32", 8) return v; }
__device__ __forceinline__ float rmax16(float v) { float r; DPP_STEP("v_max_f32", 1) DPP_STEP("v_max_f32", 2) DPP_STEP("v_max_f32", 4) DPP_STEP("v_max_f32", 8) return v; }
#undef DPP_STEP
__device__ __forceinline__ float fmax_raw(float a, float b) { float r; asm("v_max_f32 %0, %1, %2" : "=v"(r) : "v"(a), "v"(b)); return r; }
__device__ __forceinline__ float wsum(float v) { v = rsum16(v); v += shx<16>(v); return xadd32(v); }
__device__ __forceinline__ float fexp2(float x) { return __builtin_amdgcn_exp2f(x); }
__device__ __forceinline__ float frcp(float x) { return __builtin_amdgcn_rcpf(x); }
__device__ __forceinline__ float fsigmoid(float z) { return frcp(1.f + fexp2(-1.4426950408889634f * z)); }
__device__ __forceinline__ float fgelu_tanh(float x) { const float u = 0.7978845608028654f * (x + 0.044715f * x * x * x); return x * frcp(1.f + fexp2(-2.8853900817779268f * u)); }

#define XB_TMO      128
#define XB_XCNT(j)  (256  + 64 * (j))
#define XB_XSUB(j)  (1280 + 64 * (j))
#define XB_XGEN(j)  (2304 + 64 * (j))
#define XB_TOP      3328
#define XB_TOPGEN   3392
#define XCD_BAR_WORDS 3456
#define XB_SPIN_CAP (1u << 18)
__device__ __forceinline__ unsigned xb_ld(unsigned* p)              { return __hip_atomic_load(p, __ATOMIC_RELAXED, __HIP_MEMORY_SCOPE_AGENT); }
__device__ __forceinline__ unsigned xb_add(unsigned* p, unsigned v) { return __hip_atomic_fetch_add(p, v, __ATOMIC_RELAXED, __HIP_MEMORY_SCOPE_AGENT); }
__device__ __forceinline__ unsigned xb_xcc_id() { return (unsigned)__builtin_amdgcn_s_getreg((3 << 11) | 20) & 0xFu; }
#define XB_SPIN(cond, bar) do { unsigned _sp = 0; while (cond) { __builtin_amdgcn_s_sleep(1); \
    if ((++_sp & 255u) == 0u) { if (xb_ld(&(bar)[XB_TMO])) break; if (_sp > XB_SPIN_CAP) { atomicAdd(&(bar)[XB_TMO], 1u); break; } } } } while (0)
struct XcdBarrier { unsigned* bar; unsigned x; volatile LAS unsigned* st; };
__device__ __forceinline__ XcdBarrier xcd_barrier_post(unsigned* bar, volatile LAS unsigned* st, int tid) {
    XcdBarrier b; b.bar = bar; b.x = xb_xcc_id(); b.st = st;
    if (tid == 0) (void)xb_add(&bar[XB_XCNT(b.x)], 1u);
    return b;
}
__device__ __forceinline__ void xcd_barrier_complete(unsigned* bar, unsigned x, unsigned& nloc, unsigned& nx) {
    const unsigned G = gridDim.x * gridDim.y * gridDim.z;
    unsigned sum, cnt, mine, sp = 0u;
    for (;;) {
        sum = 0u; cnt = 0u; mine = 0u;
#pragma unroll
        for (unsigned j = 0; j < 16; ++j) { const unsigned c = xb_ld(&bar[XB_XCNT(j)]); sum += c; cnt += (c > 0u) ? 1u : 0u; mine = (j == x) ? c : mine; }
        if (sum == G) break;
        __builtin_amdgcn_s_sleep(1);
        if ((++sp & 255u) == 0u) { if (xb_ld(&bar[XB_TMO])) break; if (sp > XB_SPIN_CAP) { atomicAdd(&bar[XB_TMO], 1u); break; } }
    }
    nloc = mine > 0u ? mine : 1u; nx = cnt > 0u ? cnt : 1u;
}
__device__ __forceinline__ void xcd_barrier(const XcdBarrier& b, int tid) {
    asm volatile("s_waitcnt vmcnt(0)" ::: "memory");
    __syncthreads();
    if (tid == 0) {
        unsigned* bar = b.bar;
        __builtin_amdgcn_s_waitcnt(0);
        unsigned nloc = b.st[0], nx = b.st[1];
        if (nloc == 0u) { xcd_barrier_complete(bar, b.x, nloc, nx); b.st[0] = nloc; b.st[1] = nx; }
        const unsigned old = xb_add(&bar[XB_XSUB(b.x)], 1u);
        const unsigned gen = old / nloc;
        if (old + 1u == (gen + 1u) * nloc) {
            __builtin_amdgcn_fence(__ATOMIC_RELEASE, "agent");
            asm volatile("s_waitcnt vmcnt(0)" ::: "memory");
            const unsigned og = xb_add(&bar[XB_TOP], 1u);
            const unsigned tg = og / nx;
            if (og + 1u == (tg + 1u) * nx) xb_add(&bar[XB_TOPGEN], 1u);
            else XB_SPIN(xb_ld(&bar[XB_TOPGEN]) == tg, bar);
            __builtin_amdgcn_fence(__ATOMIC_ACQUIRE, "agent");
            xb_add(&bar[XB_XGEN(b.x)], 1u);
            asm volatile("s_waitcnt vmcnt(0)" ::: "memory");
        } else {
            XB_SPIN(xb_ld(&bar[XB_XGEN(b.x)]) == gen, bar);
            __builtin_amdgcn_fence(__ATOMIC_ACQUIRE, "agent");
            asm volatile("s_waitcnt vmcnt(0)" ::: "memory");
        }
    }
    __syncthreads();
}

constexpr int BM = 256, BK = 64, HALF = 128, HTB = HALF * BK * 2, STAGE_BYTES = 8 * HTB;
__host__ __device__ __forceinline__ int lds_byte(int r, int c) { const int st = (r >> 4) * 2 + (c >> 5), rr = r & 15, cc = c & 31, ob = rr * 64 + cc * 2; return st * 1024 + (ob ^ (((ob >> 9) & 1) << 5)); }
__host__ __device__ __forceinline__ void stage_rc(int b, int& R, int& C) { const int st = b / 1024, sb = b % 1024, swz = sb ^ (((sb >> 9) & 1) << 5); R = (st >> 1) * 16 + swz / 64; C = (st & 1) * 32 + (swz % 64) / 2; }
__host__ __device__ __forceinline__ int perm32(int rho) { const int n = rho >> 4, i = rho & 15; return 8 * (i >> 2) + 4 * n + (i & 3); }

struct Unit { const char* a; const char* b; int row0, col0, e, pad; };
struct GemmDims { int K, lda, ldb; };
typedef f32x4 Acc[2][2][4][2];
__device__ __forceinline__ void zero_acc(Acc& acc) {
#pragma unroll
    for (int a = 0; a < 2; ++a)
#pragma unroll
        for (int b = 0; b < 2; ++b)
#pragma unroll
            for (int m = 0; m < 4; ++m)
#pragma unroll
                for (int n = 0; n < 2; ++n)
                    { f32x2 z0, z1; asm volatile("v_mov_b64 %0, 0" : "=v"(z0)); asm volatile("v_mov_b64 %0, 0" : "=v"(z1)); acc[a][b][m][n] = (f32x4){z0[0], z0[1], z1[0], z1[1]}; }
}

typedef int v8i32 __attribute__((ext_vector_type(8)));
template <bool F8 = false, class CtxT, class Epi, class Sched>
__device__ __forceinline__ void gemm_phase(const CtxT& C, const GemmDims g, const Sched& S, const Epi& E) {
    LAS unsigned char* lds = C.lds;
    const int tid = C.tid, wid = __builtin_amdgcn_readfirstlane(tid >> 6), lane = tid & 63, wr = wid >> 2, wc = wid & 3, fr = lane & 15, fq = lane >> 4;
    constexpr int ESZ = F8 ? 1 : 2;
    constexpr bool GA = Sched::GATHER;
    int nt = g.K / (F8 ? 128 : BK); asm volatile("" : "+s"(nt));
    unsigned voffA[2], voffB[2];
#pragma unroll
    for (int i = 0; i < 2; ++i) { int R, C; stage_rc(tid * 16 + i * 8192, R, C); const int Rb = (R & ~31) + perm32(R & 31);
        voffA[i] = (unsigned)(R * g.lda * ESZ + C * 2); voffB[i] = (unsigned)(Rb * g.ldb * ESZ + C * 2); }
    unsigned voffG[2][2];
    auto load_goffs = [&](int uidx) { if constexpr (GA) { int R, Cc; stage_rc(tid * 16, R, Cc); const LAS int* tp = S.gtab + uidx * 256 + R;
#pragma unroll
        for (int h = 0; h < 2; ++h)
#pragma unroll
            for (int i = 0; i < 2; ++i) voffG[h][i] = (unsigned)tp[h * 128 + i * 64] * (unsigned)(g.lda * ESZ) + (unsigned)(Cc * 2); } };
    const size_t kstep = (size_t)(BK * 2);
    const size_t hstepA = (size_t)HALF * g.lda * ESZ, hstepB = (size_t)HALF * g.ldb * ESZ;
    const unsigned ldsw = (unsigned)wid * 1024u;
    const unsigned ldsu = (unsigned)__builtin_amdgcn_readfirstlane((int)(unsigned)(unsigned long long)(lds));
    const int aoff = lds_byte(wr * 64 + fr, fq * 8), boff = lds_byte(wc * 32 + fr, fq * 8);
#define PG8_SA(b, h) (((b) * 2 + (h)) * HTB)
#define PG8_SB(b, h) ((4 + (b) * 2 + (h)) * HTB)
#define PG8_STAGE(bufoff, gbase, voff) do { _Pragma("unroll") for (int _i = 0; _i < 2; ++_i) { \
        asm volatile("s_mov_b32 m0, %2\n\ts_nop 3\n\tglobal_load_lds_dwordx4 %0, %1" :: "v"((voff)[_i]), "s"((const char*)(gbase)), "s"(ldsu + (unsigned)(bufoff) + ldsw + (unsigned)(_i * 8192)) : "memory"); } } while (0)
#define PG8_STAGE_A(bufoff, gbase, h) do { if constexpr (GA) PG8_STAGE(bufoff, gbase, voffG[h]); else PG8_STAGE(bufoff, (gbase) + (h) * hstepA, voffA); } while (0)
#define PG8_LDA(dst, b, h) do { _Pragma("unroll") for (int m = 0; m < 4; ++m) _Pragma("unroll") for (int k = 0; k < 2; ++k) dst[m][k] = *(const LAS bf16x8*)(lds + PG8_SA(b, h) + aoff + m * 2048 + k * 1024); } while (0)
#define PG8_LDB(dst, b, h) do { _Pragma("unroll") for (int n = 0; n < 2; ++n) _Pragma("unroll") for (int k = 0; k < 2; ++k) dst[n][k] = *(const LAS bf16x8*)(lds + PG8_SB(b, h) + boff + n * 2048 + k * 1024); } while (0)
#define PG8_CAT(x) __builtin_bit_cast(v8i32, (x))
#define PG8_MMA(ai, bj, At, Bt) do { __builtin_amdgcn_s_setprio(1); \
        if constexpr (F8) { _Pragma("unroll") for (int m = 0; m < 4; ++m) _Pragma("unroll") for (int n = 0; n < 2; ++n) \
            acc[ai][bj][m][n] = __builtin_amdgcn_mfma_scale_f32_16x16x128_f8f6f4(PG8_CAT(Bt[n]), PG8_CAT(At[m]), acc[ai][bj][m][n], 0, 0, 0, 0, 0, 0); } \
        else { _Pragma("unroll") for (int m = 0; m < 4; ++m) _Pragma("unroll") for (int n = 0; n < 2; ++n) _Pragma("unroll") for (int k = 0; k < 2; ++k) \
            acc[ai][bj][m][n] = __builtin_amdgcn_mfma_f32_16x16x32_bf16(Bt[n][k], At[m][k], acc[ai][bj][m][n], 0, 0, 0); } \
        __builtin_amdgcn_s_setprio(0); } while (0)
#define PG8_WAIT_V(n) asm volatile("s_waitcnt vmcnt(" #n ")" ::: "memory")
#define PG8_WAIT_L(n) asm volatile("s_waitcnt lgkmcnt(" #n ")" ::: "memory")
#define PG8_BAR __builtin_amdgcn_s_barrier()
#define PG8_SCHED __builtin_amdgcn_sched_barrier(0)
    Unit cur, nxt; int ui = 0;
    if (!S.next(0, cur)) return;
    Acc acc; zero_acc(acc);
    struct Frag2 { bf16x8 p[2]; __device__ __forceinline__ bf16x8& operator[](int k) { return p[k]; } __device__ __forceinline__ const bf16x8& operator[](int k) const { return p[k]; } };
    Frag2 At[4], B0[2], B1[2];
    const char* cA = cur.a; const char* cB = cur.b;
    load_goffs(0);
    PG8_STAGE(PG8_SB(0, 0), cB, voffB); PG8_STAGE(PG8_SB(0, 1), cB + hstepB, voffB); PG8_STAGE_A(PG8_SA(0, 0), cA, 0); PG8_STAGE_A(PG8_SA(0, 1), cA, 1);
    if (wr == 1) PG8_BAR;
    PG8_WAIT_V(2); PG8_BAR;
    PG8_STAGE(PG8_SB(1, 0), cB + kstep, voffB); PG8_STAGE_A(PG8_SA(1, 0), cA + kstep, 0); PG8_STAGE(PG8_SB(1, 1), cB + hstepB + kstep, voffB);
    PG8_WAIT_V(6); PG8_BAR;
    for (;;) {
        const bool has_next = S.next(ui + 1, nxt);
        const char* nA = has_next ? nxt.a : cA; const char* nB = has_next ? nxt.b : cB;
        for (int t = 0; t < nt; t += 2) {
            const bool last = (t == nt - 2);
            const char* a1 = cA + (size_t)(t + 1) * kstep;
            const char* a2 = last ? nA : cA + (size_t)(t + 2) * kstep; const char* b2 = last ? nB : cB + (size_t)(t + 2) * kstep;
            const char* a3 = a2 + kstep; const char* b3 = b2 + kstep;
            PG8_LDB(B0, 0, 0); PG8_LDB(B1, 0, 1); PG8_SCHED; PG8_LDA(At, 0, 0); PG8_STAGE_A(PG8_SA(1, 1), a1, 1);
            if (GA && last && has_next) load_goffs(ui + 1);
            PG8_WAIT_V(8); PG8_WAIT_L(0); PG8_BAR; PG8_MMA(0, 0, At, B0); PG8_MMA(0, 1, At, B1); PG8_BAR; PG8_SCHED;
            PG8_LDA(At, 0, 1); PG8_STAGE(PG8_SB(0, 0), b2, voffB); PG8_STAGE(PG8_SB(0, 1), b2 + hstepB, voffB); PG8_STAGE_A(PG8_SA(0, 0), a2, 0);
            PG8_WAIT_V(8); PG8_WAIT_L(0); PG8_BAR; PG8_MMA(1, 0, At, B0); PG8_MMA(1, 1, At, B1); PG8_BAR; PG8_SCHED;
            PG8_LDB(B0, 1, 0); PG8_LDB(B1, 1, 1); PG8_SCHED; PG8_LDA(At, 1, 0); PG8_STAGE_A(PG8_SA(0, 1), a2, 1);
            PG8_WAIT_V(8); PG8_WAIT_L(0); PG8_BAR; PG8_MMA(0, 0, At, B0); PG8_MMA(0, 1, At, B1); PG8_BAR; PG8_SCHED;
            PG8_LDA(At, 1, 1); PG8_STAGE(PG8_SB(1, 0), b3, voffB); PG8_STAGE(PG8_SB(1, 1), b3 + hstepB, voffB); PG8_STAGE_A(PG8_SA(1, 0), a3, 0);
            PG8_WAIT_V(8); PG8_WAIT_L(0); PG8_BAR; PG8_MMA(1, 0, At, B0); PG8_MMA(1, 1, At, B1); PG8_BAR; PG8_SCHED;
        }
        if (wr == 0) PG8_BAR;
        E(acc, cur, wr, wc, fr, fq);
        if (!has_next) break;
        zero_acc(acc);
        cur = nxt; cA = nA; cB = nB; ++ui;
        if (wr == 1) PG8_BAR;
    }
    PG8_WAIT_V(0);
    PG8_BAR;
#undef PG8_SA
#undef PG8_SB
#undef PG8_STAGE
#undef PG8_STAGE_A
#undef PG8_LDA
#undef PG8_LDB
#undef PG8_MMA
#undef PG8_CAT
#undef PG8_WAIT_V
#undef PG8_WAIT_L
#undef PG8_BAR
#undef PG8_SCHED
}

struct DenseOrder {
    static constexpr bool GATHER = false;
    const char* A; const char* Bt; int lda, ldb, nM, nN, nwg, G, c, esz;
    __device__ __forceinline__ void init(const void* A_, const void* Bt_, int lda_, int ldb_, int M, int N, int G_, int c_, int esz_ = 2) { A = (const char*)A_; Bt = (const char*)Bt_; lda = lda_; ldb = ldb_; nM = M / BM; nN = N / BM; nwg = nM * nN; G = G_; c = c_; esz = esz_; }
    __device__ __forceinline__ bool next(int i, Unit& u) const {
        const long L = (long)i * G + c; if (L >= nwg) return false;
        int wgid = (int)L; { const int q = nwg / 8, r = nwg % 8, xcd = wgid % 8, off = wgid / 8; wgid = (xcd < r ? xcd * (q + 1) : r * (q + 1) + (xcd - r) * q) + off; }
        const int nig = 8 * nN, gid = wgid / nig, fm = gid * 8, gsz = (nM - fm) < 8 ? (nM - fm) : 8;
        const int pm = fm + ((wgid % nig) % gsz), pn = (wgid % nig) / gsz;
        u.a = A + (size_t)pm * BM * lda * esz; u.b = Bt + (size_t)pn * BM * ldb * esz; u.row0 = pm * BM; u.col0 = pn * BM; u.e = 0; u.pad = i; return true;
    }
};
struct LruOrder {
    static constexpr bool GATHER = false;
    const char* XC; const char* RG; int G, c;
    __device__ __forceinline__ bool next(int i, Unit& u) const {
        const int L = i * G + c; if (L >= 512) return false;
        const int pm = L >> 3, n = L & 7;
        u.a = XC + ((size_t)pm * BM * 1024 + n * 128) * 2; u.b = RG + (size_t)n * 256 * 128 * 2; u.row0 = pm * BM; u.col0 = n * 128; u.e = n; u.pad = 0; return true;
    }
};
template <bool GATHER_ = false> struct MoeOrderT {
    static constexpr bool GATHER = GATHER_; const LAS int* gtab;
    const char* A; const char* WT; size_t estride; const LAS int* tile_e; int NT, nN, G, c, esz;
    __device__ __forceinline__ bool next(int i, Unit& u) const {
        int tile, pn;
#ifndef MOE_ORDER_ALT
#define MOE_ORDER_ALT 0
#endif
        if (!MOE_ORDER_ALT && (G % (8 * nN)) == 0) {
            const int tpr = (G / nN) >> 3, TPX = (NT + 7) >> 3, x = c & 7, k = i * tpr + (c >> 3) / nN;
            if (k >= TPX) return false;
            tile = x * TPX + k; pn = (c >> 3) % nN; }
        else { const int L = i * G + c; tile = L / nN; pn = L % nN; }
        if (tile >= NT) return false;
        const int e = __builtin_amdgcn_readfirstlane(tile_e[tile]);
        u.a = GATHER ? A : A + (size_t)tile * BM * 1024 * esz; u.b = WT + (size_t)e * estride + (size_t)pn * BM * 1024 * esz; u.row0 = tile * BM; u.col0 = pn * BM; u.e = e; u.pad = i; return true;
    }
};
typedef MoeOrderT<false> MoeOrder;

#define EPI_ROW(ai, m) (u.row0 + (ai) * HALF + wr * 64 + (m) * 16 + fr)
#define EPI_COL(bj) (u.col0 + (bj) * HALF + wc * 32 + 8 * fq)
struct EpiBf16 {
    bf16_t* O; const float* bias; int ldc, bias_es; float ascale; const LAS float* btab = nullptr;
    __device__ __forceinline__ void operator()(const Acc& acc, const Unit& u, int wr, int wc, int fr, int fq) const {
        f32x4 bv[2][2];
#pragma unroll
        for (int bj = 0; bj < 2; ++bj)
#pragma unroll
            for (int n = 0; n < 2; ++n) bv[bj][n] = btab ? *(const LAS f32x4*)(btab + u.pad * 256 + bj * HALF + wc * 32 + 8 * fq + 4 * n) : bias ? *(const f32x4*)(bias + (size_t)u.e * bias_es + EPI_COL(bj) + 4 * n) : (f32x4){0.f, 0.f, 0.f, 0.f};
#pragma unroll
        for (int ai = 0; ai < 2; ++ai)
#pragma unroll
            for (int m = 0; m < 4; ++m) { bf16_t* rowp = O + (size_t)EPI_ROW(ai, m) * ldc;
#pragma unroll
                for (int bj = 0; bj < 2; ++bj) { const f32x4 v0 = acc[ai][bj][m][0] * ascale + bv[bj][0], v1 = acc[ai][bj][m][1] * ascale + bv[bj][1];
                    u32x4 w; w.x = cvt_pk_bf16(v0[0], v0[1]); w.y = cvt_pk_bf16(v0[2], v0[3]); w.z = cvt_pk_bf16(v1[0], v1[1]); w.w = cvt_pk_bf16(v1[2], v1[3]);
                    *(u32x4*)(rowp + EPI_COL(bj)) = w; } }
    }
};
__device__ __forceinline__ unsigned pk4_fp8(float a, float b, float c, float d) { int w = 0; w = __builtin_amdgcn_cvt_pk_fp8_f32(a, b, w, false); w = __builtin_amdgcn_cvt_pk_fp8_f32(c, d, w, true); return (unsigned)w; }
constexpr float Y8_SCALE = 16.f;
struct EpiY8 {
    unsigned char* O; float ascale; const LAS float* btab;
    __device__ __forceinline__ void operator()(const Acc& acc, const Unit& u, int wr, int wc, int fr, int fq) const {
        f32x4 bv[2][2];
#pragma unroll
        for (int bj = 0; bj < 2; ++bj)
#pragma unroll
            for (int n = 0; n < 2; ++n) bv[bj][n] = *(const LAS f32x4*)(btab + u.pad * 256 + bj * HALF + wc * 32 + 8 * fq + 4 * n) * Y8_SCALE;
        const float as = ascale * Y8_SCALE;
#pragma unroll
        for (int ai = 0; ai < 2; ++ai)
#pragma unroll
            for (int m = 0; m < 4; ++m) { unsigned char* rowp = O + (size_t)EPI_ROW(ai, m) * 1024;
#pragma unroll
                for (int bj = 0; bj < 2; ++bj) { const f32x4 v0 = acc[ai][bj][m][0] * as + bv[bj][0], v1 = acc[ai][bj][m][1] * as + bv[bj][1];
                    u32x2 w; w.x = pk4_fp8(v0[0], v0[1], v0[2], v0[3]); w.y = pk4_fp8(v1[0], v1[1], v1[2], v1[3]);
                    *(u32x2*)(rowp + EPI_COL(bj)) = w; } }
    }
};
template <int KIND> struct EpiNorm {
    bf16_t* O; int ldc; const float* ga; const float* gb; const float* gc; const float* gd; const float* ge; const float* cs; LAS float* S; float ascale;
    __device__ __forceinline__ void operator()(const Acc& acc, const Unit& u, int wr, int wc, int fr, int fq) const {
        const int pn = u.col0 >> 8; const int lane = fr + 16 * fq; const float as2 = ascale * ascale;
        int mode = 0; const float* gp = ga; float scale = 1.f;
        if (KIND == 0) { if (pn < 2) { mode = 1; gp = ga; scale = 0.125f * 1.4426950408889634f; } else if (pn < 4) { mode = 1; gp = gb; } else if (pn < 6) mode = 0; else if (pn == 6) { mode = 2; gp = gc; } else { mode = 3; gp = gd; } }
        if (KIND == 1) { scale = 0.10206207261596575f * 1.4426950408889634f; if (pn < 2) { mode = 1; gp = ga; } else { mode = 4; gp = gb; } }
        if (KIND == 2) { if (pn < 2) { mode = 1; gp = ga; } else mode = 0; }
        if (mode != 0) {
#pragma unroll
            for (int ai = 0; ai < 2; ++ai)
#pragma unroll
                for (int m = 0; m < 4; ++m)
#pragma unroll
                    for (int bj = 0; bj < 2; ++bj) { const f32x4 a = acc[ai][bj][m][0], b = acc[ai][bj][m][1];
                        float s = (a[0] * a[0] + a[1] * a[1]) + (a[2] * a[2] + a[3] * a[3]) + (b[0] * b[0] + b[1] * b[1]) + (b[2] * b[2] + b[3] * b[3]);
                        s += shx<16>(s); s = xadd32(s);
                        if (fq == 0) S[(ai * HALF + wr * 64 + m * 16 + fr) * 8 + bj * 4 + wc] = s; }
            asm volatile("s_waitcnt lgkmcnt(0)" ::: "memory"); __builtin_amdgcn_s_barrier(); asm volatile("" ::: "memory");
        }
        const float inv_n = (mode == 1) ? (1.f / 64.f) : (mode == 2) ? (1.f / 256.f) : (1.f / 32.f);
        const bool rope_tile = (mode == 4) || (mode == 3);
#pragma unroll
        for (int bj = 0; bj < 2; ++bj) {
            f32x4 g0 = (f32x4){1.f, 1.f, 1.f, 1.f}, g1 = g0; bool rope = false, zero = false; float invn = inv_n;
            int c8 = 8 * fq; asm volatile("" : "+v"(c8));
            if (mode == 1) { const int c = 32 * (wc & 1) + c8; g0 = *(const f32x4*)(gp + c); g1 = *(const f32x4*)(gp + c + 4); }
            else if (mode == 2) { const int c = bj * HALF + wc * 32 + c8; g0 = *(const f32x4*)(gp + c); g1 = *(const f32x4*)(gp + c + 4); }
            else if (mode == 3) { if (bj == 0) { const int c = wc * 32 + c8; g0 = *(const f32x4*)(gp + c); g1 = *(const f32x4*)(gp + c + 4); invn = 1.f / 128.f; }
                                  else if (wc == 0) { g0 = *(const f32x4*)(ge + c8); g1 = *(const f32x4*)(ge + c8 + 4); rope = true; } else zero = true; }
            else if (mode == 4) { g0 = *(const f32x4*)(gp + c8); g1 = *(const f32x4*)(gp + c8 + 4); rope = true; }
            (void)rope_tile;
#pragma unroll
            for (int ai = 0; ai < 2; ++ai)
#pragma unroll
                for (int m = 0; m < 4; ++m) { const int row = EPI_ROW(ai, m);
                    f32x4 v0 = acc[ai][bj][m][0], v1 = acc[ai][bj][m][1];
                    if (mode != 0) { const LAS float* sr = S + (ai * HALF + wr * 64 + m * 16 + fr) * 8; float tot;
                        if (mode == 1) { const f32x2 t = *(const LAS f32x2*)(sr + bj * 4 + (wc & 2)); tot = t[0] + t[1]; }
                        else if (mode == 2) { const f32x4 t0 = *(const LAS f32x4*)sr, t1 = *(const LAS f32x4*)(sr + 4); tot = (t0[0] + t0[1]) + (t0[2] + t0[3]) + (t1[0] + t1[1]) + (t1[2] + t1[3]); }
                        else if (mode == 3 && bj == 0) { const f32x4 t0 = *(const LAS f32x4*)sr; tot = (t0[0] + t0[1]) + (t0[2] + t0[3]); }
                        else tot = sr[bj * 4 + wc];
                        const float rs = rsqrtf(tot * as2 * invn + 1e-6f) * scale * ascale; v0 = v0 * rs * g0; v1 = v1 * rs * g1; } else { v0 = v0 * ascale; v1 = v1 * ascale; }
                    if (rope) {
                        const float* cr = cs + (size_t)row * 32 + 8 * (fq & 1); const f32x4 c0 = *(const f32x4*)cr, c1 = *(const f32x4*)(cr + 4), s0 = *(const f32x4*)(cr + 16), s1 = *(const f32x4*)(cr + 20);
                        f32x4 o0, o1;
#pragma unroll
                        for (int j = 0; j < 4; ++j) { const auto r0 = __builtin_amdgcn_permlane32_swap(__float_as_uint(v0[j]), __float_as_uint(v0[j]), false, false), r1 = __builtin_amdgcn_permlane32_swap(__float_as_uint(v1[j]), __float_as_uint(v1[j]), false, false);
                            const float ot0 = __uint_as_float(lane < 32 ? r0[1] : r0[0]), ot1 = __uint_as_float(lane < 32 ? r1[1] : r1[0]);
                            o0[j] = (lane < 32) ? (v0[j] * c0[j] - ot0 * s0[j]) : (ot0 * s0[j] + v0[j] * c0[j]);
                            o1[j] = (lane < 32) ? (v1[j] * c1[j] - ot1 * s1[j]) : (ot1 * s1[j] + v1[j] * c1[j]); }
                        v0 = o0; v1 = o1; }
                    if (zero) { v0 = (f32x4){0.f, 0.f, 0.f, 0.f}; v1 = v0; }
                    u32x4 w; w.x = cvt_pk_bf16(v0[0], v0[1]); w.y = cvt_pk_bf16(v0[2], v0[3]); w.z = cvt_pk_bf16(v1[0], v1[1]); w.w = cvt_pk_bf16(v1[2], v1[3]);
                    *(u32x4*)(O + (size_t)row * ldc + EPI_COL(bj)) = w; } }
    }
};
struct EpiRecIn {
    bf16_t* O; const float* bias; const LAS float* btab = nullptr;
    __device__ __forceinline__ void operator()(const Acc& acc, const Unit& u, int wr, int wc, int fr, int fq) const {
        const bool act = u.col0 < 1024;
        f32x4 bv[2][2];
#pragma unroll
        for (int bj = 0; bj < 2; ++bj)
#pragma unroll
            for (int n = 0; n < 2; ++n) bv[bj][n] = btab ? *(const LAS f32x4*)(btab + u.pad * 256 + bj * HALF + wc * 32 + 8 * fq + 4 * n) : *(const f32x4*)(bias + EPI_COL(bj) + 4 * n);
#pragma unroll
        for (int ai = 0; ai < 2; ++ai)
#pragma unroll
            for (int m = 0; m < 4; ++m) { bf16_t* rowp = O + (size_t)EPI_ROW(ai, m) * 2048;
#pragma unroll
                for (int bj = 0; bj < 2; ++bj) { f32x4 v0 = acc[ai][bj][m][0] + bv[bj][0], v1 = acc[ai][bj][m][1] + bv[bj][1];
                    if (act) {
                        const f32x4 t0 = v0 * (1.f + 0.044715f * (v0 * v0)) * (-2.8853900817779268f * 0.7978845608028654f), t1 = v1 * (1.f + 0.044715f * (v1 * v1)) * (-2.8853900817779268f * 0.7978845608028654f);
                        const f32x4 d0 = (f32x4){fexp2(t0[0]), fexp2(t0[1]), fexp2(t0[2]), fexp2(t0[3])} + 1.f, d1 = (f32x4){fexp2(t1[0]), fexp2(t1[1]), fexp2(t1[2]), fexp2(t1[3])} + 1.f;
                        v0 = v0 * (f32x4){frcp(d0[0]), frcp(d0[1]), frcp(d0[2]), frcp(d0[3])}; v1 = v1 * (f32x4){frcp(d1[0]), frcp(d1[1]), frcp(d1[2]), frcp(d1[3])}; }
                    u32x4 w; w.x = cvt_pk_bf16(v0[0], v0[1]); w.y = cvt_pk_bf16(v0[2], v0[3]); w.z = cvt_pk_bf16(v1[0], v1[1]); w.w = cvt_pk_bf16(v1[2], v1[3]);
                    *(u32x4*)(rowp + EPI_COL(bj)) = w; } }
    }
};
struct EpiSwiglu {
    unsigned char* ACT; const LAS float* btab; float ascale;
    __device__ __forceinline__ float sw(float g, float l) const { g = fminf(g, 7.f); l = fminf(fmaxf(l, -7.f), 7.f); return g * fsigmoid(1.702f * g) * (l + 1.f); }
    __device__ __forceinline__ void operator()(const Acc& acc, const Unit& u, int wr, int wc, int fr, int fq) const {
        f32x4 bv[2][2];
#pragma unroll
        for (int bj = 0; bj < 2; ++bj)
#pragma unroll
            for (int n = 0; n < 2; ++n) bv[bj][n] = *(const LAS f32x4*)(btab + u.pad * 256 + bj * HALF + wc * 32 + 8 * fq + 4 * n);
#pragma unroll
        for (int ai = 0; ai < 2; ++ai)
#pragma unroll
            for (int m = 0; m < 4; ++m) { unsigned char* rowp = ACT + (size_t)EPI_ROW(ai, m) * 1024;
#pragma unroll
                for (int bj = 0; bj < 2; ++bj) { const f32x4 v0 = acc[ai][bj][m][0] * ascale + bv[bj][0], v1 = acc[ai][bj][m][1] * ascale + bv[bj][1];
                    f32x4 g = (f32x4){fminf(v0[0], 7.f), fminf(v0[2], 7.f), fminf(v1[0], 7.f), fminf(v1[2], 7.f)};
                    const f32x4 lu = (f32x4){fminf(fmaxf(v0[1], -7.f), 7.f), fminf(fmaxf(v0[3], -7.f), 7.f), fminf(fmaxf(v1[1], -7.f), 7.f), fminf(fmaxf(v1[3], -7.f), 7.f)};
                    const f32x4 t = g * (-1.702f * 1.4426950408889634f);
                    const f32x4 d = (f32x4){fexp2(t[0]), fexp2(t[1]), fexp2(t[2]), fexp2(t[3])} + 1.f;
                    const f32x4 gs = g * (f32x4){frcp(d[0]), frcp(d[1]), frcp(d[2]), frcp(d[3])};
                    const f32x4 o = gs * lu + gs;
                    *(unsigned*)(rowp + (EPI_COL(bj) >> 1)) = pk4_fp8(o[0], o[1], o[2], o[3]); } }
    }
};
struct EpiResid {
    bf16_t* X; const float* g; const float* bias;
    __device__ __forceinline__ void operator()(const Acc& acc, const Unit& u, int wr, int wc, int fr, int fq) const {
        const int b = u.row0 / cfg::S;
        f32x4 bv[2][2], gv[2][2];
#pragma unroll
        for (int bj = 0; bj < 2; ++bj)
#pragma unroll
            for (int n = 0; n < 2; ++n) { bv[bj][n] = bias ? *(const f32x4*)(bias + EPI_COL(bj) + 4 * n) : (f32x4){0.f, 0.f, 0.f, 0.f}; gv[bj][n] = *(const f32x4*)(g + b * 6144 + EPI_COL(bj) + 4 * n); }
        u32x4 xw[2][4][2];
#pragma unroll
        for (int ai = 0; ai < 2; ++ai)
#pragma unroll
            for (int m = 0; m < 4; ++m)
#pragma unroll
                for (int bj = 0; bj < 2; ++bj) xw[ai][m][bj] = *(const u32x4*)(X + (size_t)EPI_ROW(ai, m) * 1024 + EPI_COL(bj));
        __builtin_amdgcn_sched_barrier(0);
#pragma unroll
        for (int ai = 0; ai < 2; ++ai)
#pragma unroll
            for (int m = 0; m < 4; ++m) { bf16_t* rowp = X + (size_t)EPI_ROW(ai, m) * 1024;
#pragma unroll
                for (int bj = 0; bj < 2; ++bj) { const u32x4 xv = xw[ai][m][bj];
                    const f32x4 x0 = (f32x4){bf_lo(xv.x), bf_hi(xv.x), bf_lo(xv.y), bf_hi(xv.y)} + gv[bj][0] * (acc[ai][bj][m][0] + bv[bj][0]);
                    const f32x4 x1 = (f32x4){bf_lo(xv.z), bf_hi(xv.z), bf_lo(xv.w), bf_hi(xv.w)} + gv[bj][1] * (acc[ai][bj][m][1] + bv[bj][1]);
                    u32x4 w; w.x = cvt_pk_bf16(x0[0], x0[1]); w.y = cvt_pk_bf16(x0[2], x0[3]); w.z = cvt_pk_bf16(x1[0], x1[1]); w.w = cvt_pk_bf16(x1[2], x1[3]); *(u32x4*)(rowp + EPI_COL(bj)) = w; } }
    }
};
struct EpiLru {
    const bf16_t* XC; const float* ba; const float* bx; const float* lam; bf16_t* LA; bf16_t* Bb;
    __device__ __forceinline__ void operator()(const Acc& acc, const Unit& u, int wr, int wc, int fr, int fq) const {
        const int ch0 = u.col0 + wc * 32 + 8 * fq;
#pragma unroll
        for (int n = 0; n < 2; ++n) { const int ch = ch0 + 4 * n;
            const f32x4 bav = *(const f32x4*)(ba + ch), bxv = *(const f32x4*)(bx + ch), spv = *(const f32x4*)(lam + ch);
#pragma unroll
            for (int ai = 0; ai < 2; ++ai)
#pragma unroll
                for (int m = 0; m < 4; ++m) { const size_t ro = (size_t)EPI_ROW(ai, m) * 1024 + ch;
                    const u32x2 xr = *(const u32x2*)(XC + ro);
                    const float xcv[4] = {bf_lo(xr.x), bf_hi(xr.x), bf_lo(xr.y), bf_hi(xr.y)};
                    float lav[4], bvv[4];
#pragma unroll
                    for (int j = 0; j < 4; ++j) { const float r = fsigmoid(acc[ai][0][m][n][j] + bav[j]), ig = fsigmoid(acc[ai][1][m][n][j] + bxv[j]);
                        const float la = r * spv[j], a = fexp2(la); lav[j] = la; bvv[j] = __builtin_amdgcn_sqrtf(fmaxf(1.f - a * a, 0.f)) * ig * xcv[j]; }
                    u32x2 wa, wb; wa.x = cvt_pk_bf16(lav[0], lav[1]); wa.y = cvt_pk_bf16(lav[2], lav[3]); wb.x = cvt_pk_bf16(bvv[0], bvv[1]); wb.y = cvt_pk_bf16(bvv[2], bvv[3]);
                    *(u32x2*)(LA + ro) = wa; *(u32x2*)(Bb + ro) = wb; asm volatile("" ::: "memory"); } }
    }
};

constexpr size_t MiB = (size_t)1 << 20;
constexpr size_t al4k(size_t x) { return (x + 4095) & ~(size_t)4095; }
constexpr int T_ = cfg::T, S_ = cfg::S, P_ = cfg::P;
constexpr size_t O_CTL = 0, SZ_CTL = 1 * MiB;
constexpr size_t O_MOD = O_CTL + SZ_CTL, SZ_MOD = al4k((size_t)4 * 4 * 6144 * 4);
constexpr size_t O_CS = O_MOD + SZ_MOD, SZ_CS = (size_t)T_ * 32 * 4;
constexpr size_t O_HIST = O_CS + SZ_CS, SZ_HIST = 256 * 32 * 4;
constexpr size_t O_TOPI = O_HIST + SZ_HIST, SZ_TOP = (size_t)T_ * 4 * 4;
constexpr size_t O_TOPG = O_TOPI + SZ_TOP, O_POS = O_TOPG + SZ_TOP;
constexpr size_t O_SUMP = O_POS + SZ_TOP, SZ_SUM = (size_t)4 * 64 * 1024 * 4;
constexpr size_t O_SUMH = O_SUMP + SZ_SUM;
constexpr size_t O_LSE = O_SUMH + SZ_SUM, SZ_LSE = (size_t)3 * T_ * 8 * 4;
constexpr size_t O_SPV = al4k(O_LSE + SZ_LSE), SZ_SPV = 2 * 1024 * 4;
constexpr size_t O_WIN = al4k(O_SPV + SZ_SPV), SZ_WIN = (size_t)2048 * 1024;
constexpr size_t O_WUQ = O_WIN + 2 * SZ_WIN, SZ_WUQ = (size_t)768 * 256 * 2;
constexpr size_t O_WUKV = O_WUQ + 2 * SZ_WUQ, SZ_WUKV = (size_t)1024 * 128 * 2;
constexpr size_t O_WOUT = O_WUKV + 2 * SZ_WUKV, SZ_WOUT = (size_t)1024 * 1024 * 2;
constexpr size_t O_RWIN = O_WOUT + 2 * SZ_WOUT, SZ_RWIN = (size_t)2048 * 1024 * 2;
constexpr size_t O_RGATE = O_RWIN + 2 * SZ_RWIN, SZ_RGATE = (size_t)8 * 256 * 128 * 2;
constexpr size_t O_RWOUT = O_RGATE + 2 * SZ_RGATE, SZ_RWOUT = (size_t)1024 * 1024 * 2;
constexpr size_t O_W1 = O_RWOUT + 2 * SZ_RWOUT, SZ_W1E = (size_t)2048 * 1024;
constexpr size_t O_W2 = O_W1 + 128 * SZ_W1E, SZ_W2E = (size_t)1024 * 1024;
constexpr size_t O_HN = O_W2 + 128 * SZ_W2E, SZ_HN = (size_t)T_ * 1024 * 2;
constexpr size_t O_PROJ = O_HN + SZ_HN, SZ_PROJ = (size_t)T_ * 2048 * 2;
constexpr size_t O_Q2 = O_PROJ + SZ_PROJ, SZ_Q2 = (size_t)T_ * 768 * 2;
constexpr size_t O_KV2 = O_Q2 + SZ_Q2, SZ_KV2 = (size_t)T_ * 1024 * 2;
constexpr size_t O_OA = O_KV2 + SZ_KV2, SZ_OA = (size_t)3 * T_ * 512 * 2;
constexpr size_t O_ATT = O_OA + SZ_OA, SZ_ATT = (size_t)T_ * 1024 * 2;
constexpr size_t O_XC = O_ATT + SZ_ATT, SZ_XC = (size_t)T_ * 1024 * 2;
constexpr size_t O_AA = O_XC + SZ_XC, SZ_AA = (size_t)T_ * 1024 * 4;
constexpr size_t O_BB = O_AA + SZ_AA;
constexpr size_t O_XG = O_BB + SZ_AA, SZ_XG = (size_t)P_ * 1024 * 2, O_INV = O_XG, O_POSJ = O_XG + 4 * MiB, O_RW = O_XG + 8 * MiB;
constexpr size_t O_ACT = O_XG + SZ_XG, O_Y2 = O_ACT + SZ_XG;
constexpr size_t O_X = O_Y2 + SZ_XG, SZ_X = (size_t)T_ * 1024 * 2;
constexpr size_t O_DUMMY = O_X + SZ_X, SZ_DUMMY = (size_t)96 * MiB;
constexpr size_t WS_MK_END = O_DUMMY + SZ_DUMMY;
constexpr size_t O_NAIVE = (size_t)2048 * MiB;
static_assert(WS_MK_END <= O_NAIVE, "mk workspace");
constexpr int CW_BAR = 4096;
constexpr size_t O_ECNT = O_CTL + 32 * 1024;
constexpr int RING_BYTES = 131072, LDSX_OFF = RING_BYTES;
constexpr int LDS_BYTES = 163840;
constexpr int LX_TILE = LDSX_OFF + 64, LX_MISC = LDSX_OFF + 2048, LX_EXCH = LDSX_OFF + 6144, LX_GTAB = LX_EXCH, GTAB_UNITS = 10, LX_BIAS = LDSX_OFF + 16384;

struct Args { const void* in[34]; float* out; unsigned char* ws; int ph_lo, ph_hi; };
struct Ctx { int tid, lane, wave, G, bid, vcu, gw, NGW; LAS unsigned char* lds; unsigned char* ws; };

__device__ __forceinline__ void conv_load(f32x4 (&v)[16], const float* __restrict__ W, int N, int n0, int k0, int lane) {
    const int n = n0 + 4 * (lane & 15); const float* p = W + (size_t)(k0 + 16 * (lane >> 4)) * N + n;
#pragma unroll
    for (int i = 0; i < 16; ++i) v[i] = (n < N) ? __builtin_nontemporal_load((const f32x4*)(p + (size_t)i * N)) : (f32x4){0.f, 0.f, 0.f, 0.f};
}
__device__ __forceinline__ int conv_row(int c, int perm) { if (perm == 1) { const int h = c / 96, d = c % 96; return d < 64 ? 64 * h + d : 512 + 32 * h + d - 64; } if (perm == 2) { const int h = c >> 7, d = c & 127; return d < 64 ? 64 * h + d : 512 + 64 * h + d - 64; } return c; }
__device__ __forceinline__ void conv_emit(const f32x4 (&v)[16], LAS unsigned char* T  , bf16_t* __restrict__ WT, int ldd, int n0, int k0, int lane, int perm) {
    const int kq = lane >> 4, c4 = lane & 15;
#pragma unroll
    for (int jj = 0; jj < 4; ++jj) { u32x4 lo, hi;
        lo.x = cvt_pk_bf16(v[0][jj], v[1][jj]); lo.y = cvt_pk_bf16(v[2][jj], v[3][jj]); lo.z = cvt_pk_bf16(v[4][jj], v[5][jj]); lo.w = cvt_pk_bf16(v[6][jj], v[7][jj]);
        hi.x = cvt_pk_bf16(v[8][jj], v[9][jj]); hi.y = cvt_pk_bf16(v[10][jj], v[11][jj]); hi.z = cvt_pk_bf16(v[12][jj], v[13][jj]); hi.w = cvt_pk_bf16(v[14][jj], v[15][jj]);
        LAS unsigned char* q = T + (4 * c4 + jj) * 144 + 32 * kq; *(LAS u32x4*)q = lo; *(LAS u32x4*)(q + 16) = hi; }
    asm volatile("s_waitcnt lgkmcnt(0)" ::: "memory");
#pragma unroll
    for (int s8 = 0; s8 < 8; ++s8) { const int n = 8 * s8 + (lane >> 3), ch = lane & 7; const u32x4 w = *(const LAS u32x4*)(T + n * 144 + 16 * ch);
        *(u32x4*)(WT + (size_t)conv_row(n0 + n, perm) * ldd + k0 + 8 * ch) = w; }
    asm volatile("s_waitcnt lgkmcnt(0)" ::: "memory");
}
__device__ __forceinline__ void conv8_tile(const float* __restrict__ W, int N, unsigned char* __restrict__ WT, int ldd, int n0, int k0, LAS unsigned char* T  , int lane) {
    const int kq = lane >> 4, c4 = lane & 15; const float* p = W + (size_t)(k0 + 32 * kq) * N + n0 + 4 * c4;
    f32x4 v[32];
#pragma unroll
    for (int i = 0; i < 32; ++i) v[i] = (n0 + 4 * c4 < N) ? __builtin_nontemporal_load((const f32x4*)(p + (size_t)i * N)) : (f32x4){0.f, 0.f, 0.f, 0.f};
#pragma unroll
    for (int jj = 0; jj < 4; ++jj) { u32x4 lo, hi;
        lo.x = pk4_fp8(32.f * v[0][jj], 32.f * v[1][jj], 32.f * v[2][jj], 32.f * v[3][jj]);     lo.y = pk4_fp8(32.f * v[4][jj], 32.f * v[5][jj], 32.f * v[6][jj], 32.f * v[7][jj]);
        lo.z = pk4_fp8(32.f * v[8][jj], 32.f * v[9][jj], 32.f * v[10][jj], 32.f * v[11][jj]);   lo.w = pk4_fp8(32.f * v[12][jj], 32.f * v[13][jj], 32.f * v[14][jj], 32.f * v[15][jj]);
        hi.x = pk4_fp8(32.f * v[16][jj], 32.f * v[17][jj], 32.f * v[18][jj], 32.f * v[19][jj]); hi.y = pk4_fp8(32.f * v[20][jj], 32.f * v[21][jj], 32.f * v[22][jj], 32.f * v[23][jj]);
        hi.z = pk4_fp8(32.f * v[24][jj], 32.f * v[25][jj], 32.f * v[26][jj], 32.f * v[27][jj]); hi.w = pk4_fp8(32.f * v[28][jj], 32.f * v[29][jj], 32.f * v[30][jj], 32.f * v[31][jj]);
        LAS unsigned char* q = T + (4 * c4 + jj) * 144 + 32 * kq; *(LAS u32x4*)q = lo; *(LAS u32x4*)(q + 16) = hi; }
    asm volatile("s_waitcnt lgkmcnt(0)" ::: "memory");
#pragma unroll
    for (int s8 = 0; s8 < 8; ++s8) { const int n = 8 * s8 + (lane >> 3), ch = lane & 7; const u32x4 w = *(const LAS u32x4*)(T + n * 144 + 16 * ch);
        *(u32x4*)(WT + (size_t)(n0 + n) * ldd + k0 + 16 * ch) = w; }
    asm volatile("s_waitcnt lgkmcnt(0)" ::: "memory");
}
__device__ __forceinline__ void split_bf16(const f32x4 a, const f32x4 b, bf16x8& hi, bf16x8& lo);
template <class AP> __device__ __forceinline__ void p0_prologue(const Ctx& C, AP a) {
    unsigned char* ws = C.ws;
    { const float* c = (const float*)a->in[1]; const float* ada_w = (const float*)a->in[3]; const float* ada_b = (const float*)a->in[4]; float* mod = (float*)(ws + O_MOD);
      LAS float* part = (LAS float*)C.lds;
      LAS float* cact = (LAS float*)(C.lds + 32768);
      if (C.bid < 4 * 24) { for (int i = C.tid; i < 4096; i += 512) { const int b = i >> 10, k = i & 1023; const float cv = c[i]; cact[k * 4 + b] = cv / (1.f + expf(-cv)); } __syncthreads(); }
      for (int it = C.bid; it < 4 * 24; it += C.G) { const int l = it / 24, n0 = (it % 24) * 256;
          f32x4 acc[4];
#pragma unroll
          for (int b = 0; b < 4; ++b) acc[b] = (f32x4){0.f, 0.f, 0.f, 0.f};
          const float* w = ada_w + (size_t)l * 1024 * 6144 + n0 + 4 * C.lane;
#pragma unroll 1
          for (int k0 = C.wave * 128; k0 < C.wave * 128 + 128; k0 += 16) { f32x4 wv[16];
#pragma unroll
              for (int i = 0; i < 16; ++i) wv[i] = __builtin_nontemporal_load((const f32x4*)(w + (size_t)(k0 + i) * 6144));
#pragma unroll
              for (int i = 0; i < 16; ++i) { const f32x4 sv = *(const LAS f32x4*)(cact + (k0 + i) * 4);
#pragma unroll
                  for (int b = 0; b < 4; ++b) acc[b] = acc[b] + sv[b] * wv[i]; } }
#pragma unroll
          for (int b = 0; b < 4; ++b) *(LAS f32x4*)(part + (C.wave * 4 + b) * 256 + 4 * C.lane) = acc[b];
          __syncthreads();
          for (int o = C.tid; o < 1024; o += 512) { const int b = o >> 8, n = o & 255; float sacc = ada_b[l * 6144 + n0 + n];
#pragma unroll
              for (int w8 = 0; w8 < 8; ++w8) sacc += part[(w8 * 4 + b) * 256 + n];
              mod[((size_t)l * 4 + b) * 6144 + n0 + n] = sacc; }
          __syncthreads(); } }
    { const float* wr_all = (const float*)a->in[28]; unsigned char* RW = ws + O_RW;
      for (int idx = ((C.G > 128) ? C.bid - 96 : C.bid) * 512 + C.tid; idx >= 0 && idx < 4 * 8 * 8 * 64; idx += ((C.G > 128) ? C.G - 96 : C.G) * 512) {     const int ln = idx & 63, f = (idx >> 6) & 7, vv = (idx >> 9) & 7, l = idx >> 12; const int nt = f >> 2, ks = f & 3, l15 = ln & 15, kg = ln >> 4;
          const float* p = wr_all + (size_t)l * 1024 * 32 + (size_t)(128 * vv + 32 * ks + 8 * kg) * 32 + 16 * nt + l15;
          bf16x8 hi, lo; split_bf16((f32x4){p[0], p[32], p[64], p[96]}, (f32x4){p[128], p[160], p[192], p[224]}, hi, lo);
          *(bf16x8*)(RW + (size_t)idx * 32) = hi; *(bf16x8*)(RW + (size_t)idx * 32 + 16) = lo; } }
    { const int* positions = (const int*)a->in[2]; float* cs = (float*)(ws + O_CS);
      for (int i = C.bid * 512 + C.tid; i < T_ * 16; i += C.G * 512) { const int t = i >> 4, f = i & 15; const float inv = powf(10000.f, -(float)(2 * f) / 32.f); const float ang = (float)positions[t] * inv;
          cs[t * 32 + f] = cosf(ang); cs[t * 32 + 16 + f] = sinf(ang); } }
    { const float* lam = (const float*)a->in[25]; float* spv = (float*)(ws + O_SPV);
      for (int i = C.bid * 512 + C.tid; i < 2048; i += C.G * 512) spv[i] = -8.f * 1.4426950408889634f * log1pf(expf(-lam[i])); }
    { const int lane = C.lane; LAS unsigned char* T = C.lds + 49152 + C.wave * 9216;
      const float* attn_w_in = (const float*)a->in[7]; const float* w_uq = (const float*)a->in[12]; const float* w_ukv = (const float*)a->in[13]; const float* attn_w_out = (const float*)a->in[16];
      const float* rec_w_in = (const float*)a->in[17]; const float* rec_wa = (const float*)a->in[21]; const float* rec_wx = (const float*)a->in[23]; const float* rec_w_out = (const float*)a->in[26];
      const float* w1 = (const float*)a->in[30]; const float* w2 = (const float*)a->in[32];
      constexpr int T_WIN = 32 * 16, T_WUQ = 12 * 4, T_WUKV = 16 * 2, T_WOUT = 16 * 16, T_RWIN = 32 * 16, T_RG = 2 * 2, T_RWOUT = 16 * 16, T_W1 = 32 * 16, T_W2 = 16 * 16;
      constexpr int NITEMS = 2 * (T_WUQ + T_WUKV + T_WOUT + T_RWIN + 16 * T_RG + T_RWOUT);
      struct Job { const float* W; bf16_t* WT; int N, ldd, n0, k0, perm; };
      auto decode = [&](int r, Job& jb) {
#define CONV_JOB(SRC, KK, NN, DST, NROWS, NMAT, SRC_MS, DST_MS, PERM) { constexpr int kc_ = (KK) / 64, per_ = ((NROWS) / 64) * kc_, tot_ = per_ * (NMAT); \
          if (r < tot_) { const int mat_ = r / per_, q_ = r % per_; jb.W = (SRC) + (size_t)mat_ * (SRC_MS); jb.WT = (bf16_t*)(ws + (DST) + (size_t)mat_ * (DST_MS)); jb.N = (NN); jb.ldd = (KK); jb.n0 = (q_ / kc_) * 64; jb.k0 = (q_ % kc_) * 64; jb.perm = (PERM); return; } r -= tot_; }
          CONV_JOB(w_uq, 256, 768, O_WUQ, 768, 2, (size_t)256 * 768, SZ_WUQ, 1)
          CONV_JOB(w_ukv, 128, 1024, O_WUKV, 1024, 2, (size_t)128 * 1024, SZ_WUKV, 2)
          CONV_JOB(attn_w_out, 1024, 1024, O_WOUT, 1024, 2, (size_t)1024 * 1024, SZ_WOUT, 0)
          CONV_JOB(rec_w_in, 1024, 2048, O_RWIN, 2048, 2, (size_t)1024 * 2048, SZ_RWIN, 0)
          CONV_JOB(rec_wa, 128, 128, O_RGATE, 128, 16, (size_t)128 * 128, (size_t)256 * 128 * 2, 0)
          CONV_JOB(rec_wx, 128, 128, O_RGATE + (size_t)128 * 128 * 2, 128, 16, (size_t)128 * 128, (size_t)256 * 128 * 2, 0)
          CONV_JOB(rec_w_out, 1024, 1024, O_RWOUT, 1024, 2, (size_t)1024 * 1024, SZ_RWOUT, 0)
#undef CONV_JOB
          jb.W = attn_w_out; jb.WT = (bf16_t*)(ws + O_WOUT); jb.N = 1024; jb.ldd = 1024; jb.n0 = 0; jb.k0 = 0; jb.perm = 0; };
      f32x4 va[16], vb[16]; Job ja, jn;
      const bool gv = C.G > 128; const int cgw = !gv ? C.gw : (C.bid < 96) ? ((C.wave < 4) ? C.bid * 4 + C.wave : (1 << 28)) : 384 + (C.bid - 96) * 8 + C.wave, cngw = !gv ? C.NGW : 384 + (C.G - 96) * 8;
      int it = cgw;
      if (it < NITEMS) { decode(it, ja); conv_load(va, ja.W, ja.N, ja.n0, ja.k0, lane); }
#pragma unroll 1
      for (; it < NITEMS; it += 2 * cngw) {
          const bool h1 = it + cngw < NITEMS;
          if (h1) { decode(it + cngw, jn); conv_load(vb, jn.W, jn.N, jn.n0, jn.k0, lane); }
          conv_emit(va, T, ja.WT, ja.ldd, ja.n0, ja.k0, lane, ja.perm);
          const bool h2 = it + 2 * cngw < NITEMS;
          if (h2) { decode(it + 2 * cngw, ja); conv_load(va, ja.W, ja.N, ja.n0, ja.k0, lane); }
          if (h1) conv_emit(vb, T, jn.WT, jn.ldd, jn.n0, jn.k0, lane, jn.perm);
      }
      { constexpr int IM = 32 * 8;
#pragma unroll 1
        for (int i8 = cgw; i8 < 2 * IM; i8 += cngw) { const int mat = i8 / IM, q = i8 % IM;
            conv8_tile(attn_w_in + (size_t)mat * 1024 * 1952, 1952, ws + O_WIN + (size_t)mat * SZ_WIN, 1024, (q >> 3) * 64, (q & 7) * 128, T, lane); } }
    }
}

__device__ __forceinline__ void phase_norm(const Ctx& C, const float* xin  , float* out  , bool combine, bool do_norm, const float* gain, const float* modc  , const float* modl  , int shoff, int scoff, bool dummy = false, bool f8 = false  ) {
    const unsigned char* Y8 = C.ws + O_Y2;     const int* pos = (const int*)(C.ws + O_POS); const float* topg = (const float*)(C.ws + O_TOPG); bf16_t* HN = (bf16_t*)(C.ws + (dummy ? O_DUMMY : O_HN)); const bf16_t* X = (const bf16_t*)(C.ws + O_X); bf16_t* Xo = (bf16_t*)(C.ws + (dummy ? O_DUMMY + 32 * MiB : O_X));
    const int lane = C.lane;
    f32x4 gsc[4], shv[4], g2v[4]; int bprev = -1;
    for (int t = C.gw; t < T_; t += C.NGW) { const int b = t / S_;
        if (b != bprev) { bprev = b;
#pragma unroll
            for (int j = 0; j < 4; ++j) { const int col = 256 * j + 4 * lane;
                if (do_norm) { gsc[j] = *(const f32x4*)(gain + col) * (1.f + *(const f32x4*)(modl + b * 6144 + scoff + col)); shv[j] = *(const f32x4*)(modl + b * 6144 + shoff + col); }
                if (combine) g2v[j] = *(const f32x4*)(modc + b * 6144 + 5120 + col); } }
        f32x4 v[4];
        if (xin) {
#pragma unroll
            for (int j = 0; j < 4; ++j) v[j] = __builtin_nontemporal_load((const f32x4*)(xin + (size_t)t * 1024 + 256 * j + 4 * lane)); }
        else {
#pragma unroll
            for (int j = 0; j < 4; ++j) { const u32x2 w = *(const u32x2*)(X + (size_t)t * 1024 + 256 * j + 4 * lane); v[j] = (f32x4){bf_lo(w.x), bf_hi(w.x), bf_lo(w.y), bf_hi(w.y)}; } }
        if (combine) { f32x4 y[4];
#pragma unroll
            for (int j = 0; j < 4; ++j) y[j] = (f32x4){0.f, 0.f, 0.f, 0.f};
            const u32x4 pp = *(const u32x4*)(pos + t * 4); const f32x4 gg = *(const f32x4*)(topg + t * 4) * (1.f / Y8_SCALE);
#pragma unroll
            for (int k = 0; k < 4; ++k) { const int p = (int)pp[k]; const float gk = gg[k];
#pragma unroll
                for (int j = 0; j < 4; ++j) { const unsigned w = *(const unsigned*)(Y8 + (size_t)p * 1024 + 256 * j + 4 * lane);
                    const f32x2 lo = __builtin_amdgcn_cvt_pk_f32_fp8((int)w, false), hi2 = __builtin_amdgcn_cvt_pk_f32_fp8((int)w, true);
                    y[j][0] += gk * lo[0]; y[j][1] += gk * lo[1]; y[j][2] += gk * hi2[0]; y[j][3] += gk * hi2[1]; } }
#pragma unroll
            for (int j = 0; j < 4; ++j) v[j] = v[j] + g2v[j] * y[j]; }
        if (out) {
#pragma unroll
            for (int j = 0; j < 4; ++j) __builtin_nontemporal_store(v[j], (f32x4*)(out + (size_t)t * 1024 + 256 * j + 4 * lane)); }
        else {
#pragma unroll
            for (int j = 0; j < 4; ++j) { u32x2 w; w.x = cvt_pk_bf16(v[j][0], v[j][1]); w.y = cvt_pk_bf16(v[j][2], v[j][3]); *(u32x2*)(Xo + (size_t)t * 1024 + 256 * j + 4 * lane) = w; } }
        if (do_norm) { float ss = 0.f;
#pragma unroll
            for (int j = 0; j < 4; ++j) ss += (v[j][0] * v[j][0] + v[j][1] * v[j][1]) + (v[j][2] * v[j][2] + v[j][3] * v[j][3]);
            const float rs = rsqrtf(wsum(ss) * (1.f / 1024.f) + 1e-6f);
#pragma unroll
            for (int j = 0; j < 4; ++j) { const int col = 256 * j + 4 * lane;
                const f32x4 h = v[j] * rs * gsc[j] + shv[j];
                if (f8) *(unsigned*)((unsigned char*)HN + (size_t)t * 1024 + col) = pk4_fp8(h[0], h[1], h[2], h[3]);
                else { u32x2 w; w.x = cvt_pk_bf16(h[0], h[1]); w.y = cvt_pk_bf16(h[2], h[3]); *(u32x2*)(HN + (size_t)t * 1024 + col) = w; } } }
    }
}

__device__ __forceinline__ void unpack8(const u32x4 w, float (&f)[8]) { f[0] = bf_lo(w.x); f[1] = bf_hi(w.x); f[2] = bf_lo(w.y); f[3] = bf_hi(w.y); f[4] = bf_lo(w.z); f[5] = bf_hi(w.z); f[6] = bf_lo(w.w); f[7] = bf_hi(w.w); }
__device__ __forceinline__ u32x4 pack8(const float (&f)[8]) { u32x4 w; w.x = cvt_pk_bf16(f[0], f[1]); w.y = cvt_pk_bf16(f[2], f[3]); w.z = cvt_pk_bf16(f[4], f[5]); w.w = cvt_pk_bf16(f[6], f[7]); return w; }

constexpr float LOG2E = 1.4426950408889634f;
__device__ __forceinline__ void phase_postproj(const Ctx& C, const float* qg, const float* kg, const float* qag, const float* kvag, const float* mkg) {
    bf16_t* PROJ = (bf16_t*)(C.ws + O_PROJ); const float* cs = (const float*)(C.ws + O_CS); const int lane = C.lane;
    for (int t = C.gw; t < T_; t += C.NGW) { bf16_t* row = PROJ + (size_t)t * 2048;
#pragma unroll
        for (int ps = 0; ps < 2; ++ps) { bf16_t* p = row + ps * 512 + 8 * lane; float f[8]; unpack8(*(const u32x4*)p, f); float ss = 0.f;
#pragma unroll
            for (int i = 0; i < 8; ++i) ss += f[i] * f[i];
            ss += shx<1>(ss); ss += shx<2>(ss); ss += shx<4>(ss);
            const float rs = rsqrtf(ss * (1.f / 64.f) + 1e-6f) * (ps == 0 ? 0.125f * LOG2E : 1.f); const float* g = (ps == 0 ? qg : kg) + 8 * (lane & 7);
#pragma unroll
            for (int i = 0; i < 8; ++i) f[i] = f[i] * rs * g[i];
            *(u32x4*)p = pack8(f); }
        { bf16_t* p = row + 1536 + 8 * lane; float f[8]; unpack8(*(const u32x4*)p, f); float ss = 0.f;
#pragma unroll
            for (int i = 0; i < 8; ++i) ss += f[i] * f[i];
            ss += shx<1>(ss); ss += shx<2>(ss);
            { const float o4 = shx<4>(ss); if (lane < 48) ss += o4; } { const float o8 = shx<8>(ss); if (lane < 48) ss += o8; } { const float o16 = shx<16>(ss); if (lane < 32) ss += o16; }
            const float nrm = lane < 32 ? 256.f : (lane < 48 ? 128.f : 32.f);
            const float rs = rsqrtf(ss / nrm + 1e-6f);
            const float* g = lane < 32 ? (qag + 8 * lane) : (lane < 48 ? (kvag + 8 * (lane - 32)) : (mkg + 64 + 8 * ((lane - 48) & 3)));
#pragma unroll
            for (int i = 0; i < 8; ++i) f[i] = f[i] * rs * g[i];
            float o[8];
#pragma unroll
            for (int i = 0; i < 8; ++i) { const float other = shx<2>(f[i]); const int fi = ((lane & 1) << 3) + i; const float cv = cs[t * 32 + fi], sv = cs[t * 32 + 16 + fi];
                o[i] = (lane & 2) ? (other * sv + f[i] * cv) : (f[i] * cv - other * sv); }
            if (lane >= 48 && lane < 52) {
#pragma unroll
                for (int i = 0; i < 8; ++i) f[i] = o[i]; }
            if (lane < 52) *(u32x4*)p = pack8(f); }
    }
}
__device__ __forceinline__ void phase_postq(const Ctx& C, const float* mqg, const float* mkg) {
    bf16_t* Q2 = (bf16_t*)(C.ws + O_Q2); bf16_t* KV2 = (bf16_t*)(C.ws + O_KV2); const float* cs = (const float*)(C.ws + O_CS); const int lane = C.lane;
    const float qscale = 0.10206207261596575f * LOG2E;
    for (int t = C.gw; t < T_; t += C.NGW) {
        { bf16_t* p = Q2 + (size_t)t * 768 + (lane >> 3) * 96 + 8 * (lane & 7); float f[8]; unpack8(*(const u32x4*)p, f); float ss = 0.f;
#pragma unroll
            for (int i = 0; i < 8; ++i) ss += f[i] * f[i];
            ss += shx<1>(ss); ss += shx<2>(ss); ss += shx<4>(ss);
            const float rs = rsqrtf(ss * (1.f / 64.f) + 1e-6f) * qscale; const float* g = mqg + 8 * (lane & 7);
#pragma unroll
            for (int i = 0; i < 8; ++i) f[i] = f[i] * rs * g[i];
            *(u32x4*)p = pack8(f); }
        { const int l2 = lane & 31; bf16_t* p = Q2 + (size_t)t * 768 + (l2 >> 2) * 96 + 64 + 8 * (l2 & 3); float f[8]; unpack8(*(const u32x4*)p, f); float ss = 0.f;
#pragma unroll
            for (int i = 0; i < 8; ++i) ss += f[i] * f[i];
            ss += shx<1>(ss); ss += shx<2>(ss);
            const float rs = rsqrtf(ss * (1.f / 32.f) + 1e-6f) * qscale; const float* g = mqg + 64 + 8 * (l2 & 3);
#pragma unroll
            for (int i = 0; i < 8; ++i) f[i] = f[i] * rs * g[i];
            float o[8];
#pragma unroll
            for (int i = 0; i < 8; ++i) { const float other = shx<2>(f[i]); const int fi = ((lane & 1) << 3) + i; const float cv = cs[t * 32 + fi], sv = cs[t * 32 + 16 + fi];
                o[i] = (lane & 2) ? (other * sv + f[i] * cv) : (f[i] * cv - other * sv); }
            if (lane < 32) *(u32x4*)p = pack8(o); }
        { bf16_t* p = KV2 + (size_t)t * 1024 + (lane >> 3) * 128 + 8 * (lane & 7); float f[8]; unpack8(*(const u32x4*)p, f); float ss = 0.f;
#pragma unroll
            for (int i = 0; i < 8; ++i) ss += f[i] * f[i];
            ss += shx<1>(ss); ss += shx<2>(ss); ss += shx<4>(ss);
            const float rs = rsqrtf(ss * (1.f / 64.f) + 1e-6f); const float* g = mkg + 8 * (lane & 7);
#pragma unroll
            for (int i = 0; i < 8; ++i) f[i] = f[i] * rs * g[i];
            *(u32x4*)p = pack8(f); }
    }
}
__device__ __forceinline__ void phase_mixcombine(const Ctx& C) {
    const bf16_t* OA = (const bf16_t*)(C.ws + O_OA); const float* LSE = (const float*)(C.ws + O_LSE); bf16_t* ATT = (bf16_t*)(C.ws + O_ATT); const int lane = C.lane;
    for (int t = C.gw; t < T_; t += C.NGW) { const int h = lane >> 3;
        float ls[3], mx = -INFINITY;
#pragma unroll
        for (int p = 0; p < 3; ++p) { ls[p] = LSE[((size_t)p * T_ + t) * 8 + h]; mx = fmaxf(mx, ls[p]); }
        float w[3], den = 0.f;
#pragma unroll
        for (int p = 0; p < 3; ++p) { w[p] = fexp2(ls[p] - mx); den += w[p]; }
        const float inv = 1.f / den; float o[8];
#pragma unroll
        for (int i = 0; i < 8; ++i) o[i] = 0.f;
#pragma unroll
        for (int p = 0; p < 3; ++p) { float f[8]; unpack8(*(const u32x4*)(OA + ((size_t)p * T_ + t) * 512 + 8 * lane), f); const float wp = w[p] * inv;
#pragma unroll
            for (int i = 0; i < 8; ++i) o[i] += wp * f[i]; }
        *(u32x4*)(ATT + (size_t)t * 1024 + 8 * lane) = pack8(o); }
}
__device__ __forceinline__ void phase_rgate(const Ctx& C, int j, const float* cw, const float* cb, const float* ba, const float* bx) {
    const bf16_t* PROJ = (const bf16_t*)(C.ws + O_PROJ); const bf16_t* RG = (const bf16_t*)(C.ws + O_RGATE + (size_t)j * SZ_RGATE); const float* spvg = (const float*)(C.ws + O_SPV) + j * 1024;
    bf16_t* LA = (bf16_t*)(C.ws + O_AA); bf16_t* Bb = (bf16_t*)(C.ws + O_BB); float* SP = (float*)(C.ws + O_SUMP); float* SH = (float*)(C.ws + O_SUMH);
    constexpr int WROW = 272;
    LAS unsigned char* Wl = C.lds;
    LAS unsigned char* Xl = C.lds + 256 * WROW;
    LAS unsigned char* Al = Xl + 64 * WROW;
    LAS unsigned char* Bl = Al + 64 * WROW;
    const int tid = C.tid, lane = C.lane, w = C.wave;
    if (C.G % 8 != 0) return;
    const int n = C.bid & 7, g = C.bid >> 3, ng = C.G >> 3;
    for (int i = tid; i < 256 * 16; i += 512) { const int r = i >> 4, c = i & 15; *(LAS u32x4*)(Wl + r * WROW + 16 * c) = *(const u32x4*)(RG + ((size_t)n * 256 + r) * 128 + 8 * c); }
    const int crow = tid >> 3, cg = tid & 7, cch = n * 128 + 16 * cg;
    float cwv[4][16], cbv[16];
#pragma unroll
    for (int q = 0; q < 4; ++q) { const f32x4 b4 = *(const f32x4*)(cb + cch + 4 * q); cbv[4 * q] = b4[0]; cbv[4 * q + 1] = b4[1]; cbv[4 * q + 2] = b4[2]; cbv[4 * q + 3] = b4[3];
#pragma unroll
        for (int k = 0; k < 4; ++k) { const f32x4 w4 = *(const f32x4*)(cw + k * 1024 + cch + 4 * q); cwv[k][4 * q] = w4[0]; cwv[k][4 * q + 1] = w4[1]; cwv[k][4 * q + 2] = w4[2]; cwv[k][4 * q + 3] = w4[3]; } }
    const int mt = w & 3, h = w >> 2, l15 = lane & 15, kg = lane >> 4;
    float bav[4], bxv[4], spv[4];
#pragma unroll
    for (int jj = 0; jj < 4; ++jj) { const int ch = n * 128 + 16 * (4 * h + jj) + l15; bav[jj] = ba[ch]; bxv[jj] = bx[ch]; spv[jj] = spvg[ch]; }
    __syncthreads();
    u32x4 xr[4][2];
    auto load_x = [&](int c) { const size_t row0 = (size_t)c * 64; const int ts0 = (int)(row0 % S_);
#pragma unroll
        for (int k = 0; k < 4; ++k) { const int dt = (ts0 + crow + k - 3 >= 0) ? k - 3 : 0; const bf16_t* src = PROJ + (row0 + crow + dt) * 2048 + 1024 + cch; xr[k][0] = *(const u32x4*)src; xr[k][1] = *(const u32x4*)(src + 8); } };
    load_x(g);
    for (int c = g; c < 256; c += ng) { const size_t row0 = (size_t)c * 64; const int ts0 = (int)(row0 % S_);
        { float acc[16];
#pragma unroll
          for (int i = 0; i < 16; ++i) acc[i] = cbv[i];
#pragma unroll
          for (int k = 0; k < 4; ++k) { const int dt = k - 3; const bool on = ts0 + crow + dt >= 0; float f0[8], f1[8]; unpack8(xr[k][0], f0); unpack8(xr[k][1], f1);
#pragma unroll
              for (int i = 0; i < 8; ++i) { acc[i] += on ? cwv[k][i] * f0[i] : 0.f; acc[8 + i] += on ? cwv[k][8 + i] * f1[i] : 0.f; } }
          float lo[8], hi8[8];
#pragma unroll
          for (int i = 0; i < 8; ++i) { lo[i] = acc[i]; hi8[i] = acc[8 + i]; }
          *(LAS u32x4*)(Xl + crow * WROW + 32 * cg) = pack8(lo); *(LAS u32x4*)(Xl + crow * WROW + 32 * cg + 16) = pack8(hi8); }
        load_x((c + ng < 256) ? c + ng : c);
        __builtin_amdgcn_sched_barrier(0);
        __syncthreads();
        f32x4 acc[8];
#pragma unroll
        for (int t = 0; t < 8; ++t) acc[t] = (f32x4){0.f, 0.f, 0.f, 0.f};
#pragma unroll
        for (int ks = 0; ks < 4; ++ks) { const bf16x8 af = *(const LAS bf16x8*)(Xl + (16 * mt + l15) * WROW + 64 * ks + 16 * kg);
#pragma unroll
            for (int t = 0; t < 8; ++t) { const int nt = (t < 4) ? (4 * h + t) : (8 + 4 * h + (t - 4)); const bf16x8 bfr = *(const LAS bf16x8*)(Wl + (16 * nt + l15) * WROW + 64 * ks + 16 * kg);
                acc[t] = __builtin_amdgcn_mfma_f32_16x16x32_bf16(af, bfr, acc[t], 0, 0, 0); } }
#pragma unroll
        for (int jj = 0; jj < 4; ++jj) { const int e = 16 * (4 * h + jj) + l15;
#pragma unroll
            for (int r = 0; r < 4; ++r) { const int row = 16 * mt + 4 * kg + r; const float xc = bf_lo((unsigned)*(const LAS unsigned short*)(Xl + row * WROW + 2 * e));
                const float rr = fsigmoid(acc[jj][r] + bav[jj]), ig = fsigmoid(acc[4 + jj][r] + bxv[jj]); const float la = rr * spv[jj], av = fexp2(la);
                const float bv = __builtin_amdgcn_sqrtf(fmaxf(1.f - av * av, 0.f)) * ig * xc;
                *(LAS unsigned short*)(Al + row * WROW + 2 * e) = (unsigned short)(cvt_pk_bf16(la, la) & 0xffffu); *(LAS unsigned short*)(Bl + row * WROW + 2 * e) = (unsigned short)(cvt_pk_bf16(bv, bv) & 0xffffu); } }
        __syncthreads();
        { const size_t go = (row0 + crow) * 1024 + cch;
          *(u32x4*)(LA + go) = *(const LAS u32x4*)(Al + crow * WROW + 32 * cg); *(u32x4*)(LA + go + 8) = *(const LAS u32x4*)(Al + crow * WROW + 32 * cg + 16);
          *(u32x4*)(Bb + go) = *(const LAS u32x4*)(Bl + crow * WROW + 32 * cg); *(u32x4*)(Bb + go + 8) = *(const LAS u32x4*)(Bl + crow * WROW + 32 * cg + 16); }
        if (tid < 128) { float Pl = 0.f, Hh = 0.f;
#pragma unroll 8
            for (int r = 0; r < 64; ++r) { const float la = bf_lo((unsigned)*(const LAS unsigned short*)(Al + r * WROW + 2 * tid)), bv = bf_lo((unsigned)*(const LAS unsigned short*)(Bl + r * WROW + 2 * tid)); Hh = fexp2(la) * Hh + bv; Pl += la; }
            const int b = (int)(row0 / S_), ck = (int)((row0 % S_) >> 6); SP[((size_t)b * 64 + ck) * 1024 + n * 128 + tid] = fexp2(Pl); SH[((size_t)b * 64 + ck) * 1024 + n * 128 + tid] = Hh; }
        __syncthreads();
    }
}

__device__ __forceinline__ void scan_sum_item(const Ctx& C, int b, int ck, int cg) {
    const bf16_t* LA = (const bf16_t*)(C.ws + O_AA); const bf16_t* Bb = (const bf16_t*)(C.ws + O_BB); float* SP = (float*)(C.ws + O_SUMP); float* SH = (float*)(C.ws + O_SUMH);
    const int ch = cg * 128 + 2 * C.lane;
    size_t off = ((size_t)b * S_ + ck * 64) * 1024 + ch; f32x2 Pl = (f32x2){0.f, 0.f}, Hh = (f32x2){0.f, 0.f};
#pragma unroll 8
    for (int s = 0; s < 64; ++s, off += 1024) { const unsigned lw = *(const unsigned*)(LA + off), bw = *(const unsigned*)(Bb + off);
        const f32x2 lv = (f32x2){bf_lo(lw), bf_hi(lw)}, av = (f32x2){fexp2(lv[0]), fexp2(lv[1])}, bv = (f32x2){bf_lo(bw), bf_hi(bw)}; Hh = av * Hh + bv; Pl = Pl + lv; }
    *(f32x2*)(SP + ((size_t)b * 64 + ck) * 1024 + ch) = (f32x2){fexp2(Pl[0]), fexp2(Pl[1])}; *(f32x2*)(SH + ((size_t)b * 64 + ck) * 1024 + ch) = Hh;
}
__device__ __forceinline__ void phase_scan_sum_own(const Ctx& C) {
    asm volatile("s_waitcnt vmcnt(0)" ::: "memory"); __syncthreads();
    for (int i = 0; ; ++i) { const int L = i * C.G + C.bid; if (L >= 512) break; const int pm = L >> 3, n = L & 7;
        if (C.wave < 4) { const int row0 = pm * 256 + C.wave * 64; scan_sum_item(C, row0 / S_, (row0 % S_) >> 6, n); } }
}
__device__ __forceinline__ void phase_scan_apply(const Ctx& C) {
    const bf16_t* LA = (const bf16_t*)(C.ws + O_AA); const bf16_t* Bb = (const bf16_t*)(C.ws + O_BB); const float* SP = (const float*)(C.ws + O_SUMP); const float* SH = (const float*)(C.ws + O_SUMH);
    const bf16_t* PROJ = (const bf16_t*)(C.ws + O_PROJ); bf16_t* ATT = (bf16_t*)(C.ws + O_ATT); const int lane = C.lane;
    for (int it = C.gw; it < 4 * 64 * 8; it += C.NGW) { const int cg = it & 7, ck = (it >> 3) & 63, b = it >> 9; const int ch = cg * 128 + 2 * lane;
        f32x2 h = (f32x2){0.f, 0.f};
        const float* sp = SP + (size_t)b * 64 * 1024 + ch; const float* sh = SH + (size_t)b * 64 * 1024 + ch;
#pragma unroll 1
        for (int c0 = 0; c0 < ck; c0 += 16) { f32x2 pv[16], hv[16];
#pragma unroll
            for (int u = 0; u < 16; ++u) { const int c2 = (c0 + u < ck) ? c0 + u : ck - 1; pv[u] = *(const f32x2*)(sp + (size_t)c2 * 1024); hv[u] = *(const f32x2*)(sh + (size_t)c2 * 1024); }
            __builtin_amdgcn_sched_barrier(0);
#pragma unroll
            for (int u = 0; u < 16; ++u) if (c0 + u < ck) h = pv[u] * h + hv[u]; }
        const size_t row0 = (size_t)b * S_ + ck * 64;
#pragma unroll 1
        for (int s0 = 0; s0 < 64; s0 += 16) { unsigned lw[16], bw[16], gw2[16];
#pragma unroll
            for (int u = 0; u < 16; ++u) { const size_t row = row0 + s0 + u; lw[u] = *(const unsigned*)(LA + row * 1024 + ch); bw[u] = *(const unsigned*)(Bb + row * 1024 + ch); gw2[u] = *(const unsigned*)(PROJ + row * 2048 + ch); }
            __builtin_amdgcn_sched_barrier(0);
#pragma unroll
            for (int u = 0; u < 16; ++u) { const f32x2 av = (f32x2){fexp2(bf_lo(lw[u])), fexp2(bf_hi(lw[u]))}, bv = (f32x2){bf_lo(bw[u]), bf_hi(bw[u])}; h = av * h + bv;
                *(unsigned*)(ATT + (row0 + s0 + u) * 1024 + ch) = cvt_pk_bf16(bf_lo(gw2[u]) * h[0], bf_hi(gw2[u]) * h[1]); } }
    }
}

__device__ __forceinline__ void split_bf16(const f32x4 a, const f32x4 b, bf16x8& hi, bf16x8& lo) {
    u32x4 h; h.x = cvt_pk_bf16(a[0], a[1]); h.y = cvt_pk_bf16(a[2], a[3]); h.z = cvt_pk_bf16(b[0], b[1]); h.w = cvt_pk_bf16(b[2], b[3]);
    u32x4 l; l.x = cvt_pk_bf16(a[0] - bf_lo(h.x), a[1] - bf_hi(h.x)); l.y = cvt_pk_bf16(a[2] - bf_lo(h.y), a[3] - bf_hi(h.y)); l.z = cvt_pk_bf16(b[0] - bf_lo(h.z), b[1] - bf_hi(h.z)); l.w = cvt_pk_bf16(b[2] - bf_lo(h.w), b[3] - bf_hi(h.w));
    hi = __builtin_bit_cast(bf16x8, h); lo = __builtin_bit_cast(bf16x8, l);
}
__device__ __forceinline__ void phase_router(const Ctx& C, const bf16_t* X, const float* gain, const float* modl, const float* wr, const float* br, int layer) {
    unsigned char* HN8 = C.ws + O_HN; int* topi = (int*)(C.ws + O_TOPI); float* topg = (float*)(C.ws + O_TOPG); int* ecnt = (int*)(C.ws + O_ECNT) + layer * 32; int* inv = (int*)(C.ws + O_INV); int* posj = (int*)(C.ws + O_POSJ);
    LAS int* rk = (LAS int*)(C.lds + LX_MISC + 3072); LAS int* base = (LAS int*)(C.lds + LX_MISC + 512);
    constexpr int HROW = 1028;
    LAS float* hrow = (LAS float*)C.lds;
    LAS float* part = (LAS float*)(C.lds + 16 * HROW * 4);
    LAS int* hl = (LAS int*)(C.lds + LX_MISC);
    const int lane = C.lane, e = lane & 31, kh = lane >> 5, v = C.wave, l15 = lane & 15, kg = lane >> 4;
    bf16x8 whi[2][4], wlo[2][4];
    { const unsigned char* rw = C.ws + O_RW + ((size_t)(layer * 8 + v) * 8 * 64 + lane) * 32;
#pragma unroll
      for (int nt = 0; nt < 2; ++nt)
#pragma unroll
          for (int ks = 0; ks < 4; ++ks) { whi[nt][ks] = *(const bf16x8*)(rw + (size_t)(nt * 4 + ks) * 64 * 32); wlo[nt][ks] = *(const bf16x8*)(rw + (size_t)(nt * 4 + ks) * 64 * 32 + 16); } }
    const float bias_e = br[e];
    if (C.tid < 32) hl[C.tid] = 0;
    __syncthreads();
    for (int ck = C.bid; ck < 256; ck += C.G) {
        const int b = (ck * 64) / S_;
        f32x4 gn[4], shv[4];
#pragma unroll
        for (int j = 0; j < 4; ++j) { const int col = 256 * j + 4 * lane; gn[j] = *(const f32x4*)(gain + col) * (1.f + *(const f32x4*)(modl + b * 6144 + 4096 + col)); shv[j] = *(const f32x4*)(modl + b * 6144 + 3072 + col); }
        u32x2 xr[2][4];
#pragma unroll
        for (int q = 0; q < 2; ++q)
#pragma unroll
            for (int j = 0; j < 4; ++j) xr[q][j] = *(const u32x2*)(X + (size_t)(ck * 64 + 2 * v + q) * 1024 + 256 * j + 4 * lane);
#pragma unroll 1
        for (int pass = 0; pass < 4; ++pass) { const int tb = ck * 64 + pass * 16;
#pragma unroll
            for (int q = 0; q < 2; ++q) { const int tt = 2 * v + q, t = tb + tt; f32x4 h[4]; float ss = 0.f;
#pragma unroll
                for (int j = 0; j < 4; ++j) { const u32x2 xw = xr[q][j]; h[j] = (f32x4){bf_lo(xw.x), bf_hi(xw.x), bf_lo(xw.y), bf_hi(xw.y)}; ss += (h[j][0] * h[j][0] + h[j][1] * h[j][1]) + (h[j][2] * h[j][2] + h[j][3] * h[j][3]); }
                const float rs = rsqrtf(wsum(ss) * (1.f / 1024.f) + 1e-6f);
#pragma unroll
                for (int j = 0; j < 4; ++j) { const int col = 256 * j + 4 * lane;
                    const f32x4 hv = h[j] * rs * gn[j] + shv[j];
                    *(unsigned*)(HN8 + (size_t)t * 1024 + col) = pk4_fp8(hv[0], hv[1], hv[2], hv[3]);
                    *(LAS f32x4*)(hrow + tt * HROW + col) = hv; } }
            if (pass < 3) {
#pragma unroll
                for (int q = 0; q < 2; ++q)
#pragma unroll
                    for (int j = 0; j < 4; ++j) xr[q][j] = *(const u32x2*)(X + (size_t)(tb + 16 + 2 * v + q) * 1024 + 256 * j + 4 * lane); }
            __syncthreads();
            { f32x4 acc0 = (f32x4){0.f, 0.f, 0.f, 0.f}, acc1 = acc0;
#pragma unroll
              for (int ks = 0; ks < 4; ++ks) { const LAS float* hp = hrow + l15 * HROW + 128 * v + 32 * ks + 8 * kg; bf16x8 ahi, alo; split_bf16(*(const LAS f32x4*)hp, *(const LAS f32x4*)(hp + 4), ahi, alo);
                  acc0 = __builtin_amdgcn_mfma_f32_16x16x32_bf16(ahi, whi[0][ks], acc0, 0, 0, 0); acc1 = __builtin_amdgcn_mfma_f32_16x16x32_bf16(ahi, whi[1][ks], acc1, 0, 0, 0);
                  acc0 = __builtin_amdgcn_mfma_f32_16x16x32_bf16(ahi, wlo[0][ks], acc0, 0, 0, 0); acc1 = __builtin_amdgcn_mfma_f32_16x16x32_bf16(ahi, wlo[1][ks], acc1, 0, 0, 0);
                  acc0 = __builtin_amdgcn_mfma_f32_16x16x32_bf16(alo, whi[0][ks], acc0, 0, 0, 0); acc1 = __builtin_amdgcn_mfma_f32_16x16x32_bf16(alo, whi[1][ks], acc1, 0, 0, 0); }
#pragma unroll
              for (int r = 0; r < 4; ++r) { part[((4 * kg + r) * 8 + v) * 32 + l15] = acc0[r]; part[((4 * kg + r) * 8 + v) * 32 + 16 + l15] = acc1[r]; } }
            __syncthreads();
            { const int tt = 2 * v + kh; float lg = bias_e;
#pragma unroll
              for (int w8 = 0; w8 < 8; ++w8) lg += part[(tt * 8 + w8) * 32 + e];
              float myv = 0.f, v0 = 0.f; int myi = 0;
#pragma unroll
              for (int k = 0; k < 4; ++k) { float mx = lg;
                  mx = rmax16(mx); mx = fmax_raw(mx, shx<16>(mx));
                  const unsigned long long bal = __ballot(lg == mx); const unsigned bh = (unsigned)(bal >> (32 * kh)); const int sel = __ffs((int)bh) - 1;
                  if (k == 0) v0 = mx;
                  if (e == k) { myv = mx; myi = sel; }
                  if (e == sel) lg = -INFINITY; }
              {
                const float ex = fexp2((myv - v0) * 1.4426950408889634f);
                float den = (e < 4) ? ex : 0.f; den += shx<1>(den); den += shx<2>(den);
                if (e < 4) { const int t = tb + tt; topi[t * 4 + e] = myi; topg[t * 4 + e] = ex * frcp(den);
                    const int r = __hip_atomic_fetch_add(hl + myi, 1, __ATOMIC_RELAXED, __HIP_MEMORY_SCOPE_WORKGROUP); rk[(pass * 16 + tt) * 4 + e] = (myi << 8) | r; } } }
        }
        __syncthreads();
        if (C.tid < 32) { base[C.tid] = __hip_atomic_fetch_add(ecnt + C.tid, hl[C.tid], __ATOMIC_RELAXED, __HIP_MEMORY_SCOPE_AGENT); hl[C.tid] = 0; }
        __syncthreads();
        if (C.tid < 256) { const int pk = rk[C.tid], ex = pk >> 8, j = base[ex] + (pk & 255); inv[ex * 16384 + j] = ck * 64 + (C.tid >> 2); posj[ck * 256 + C.tid] = j; }
        __syncthreads();
    }
}
__device__ __forceinline__ void moe_plan_lds(const Ctx& C, int layer) {
    const int* ecnt = (const int*)(C.ws + O_ECNT) + layer * 32;
    LAS int* tot = (LAS int*)(C.lds + LX_MISC + 256); LAS int* pst = tot + 32; LAS int* tile_e = (LAS int*)(C.lds + LX_TILE); LAS int* ntp = (LAS int*)(C.lds + LX_MISC + 128);
    __syncthreads();
    if (C.tid < 32) tot[C.tid] = __hip_atomic_load(ecnt + C.tid, __ATOMIC_RELAXED, __HIP_MEMORY_SCOPE_AGENT);
    __syncthreads();
    { const int e = C.tid & 31, sub = C.tid >> 5; int acc = 0;
#pragma unroll
      for (int x = 0; x < 32; x += 4) { const LAS int* tp = tot + x; const int t0 = tp[0], t1 = tp[1], t2 = tp[2], t3 = tp[3];
          acc += (x < e ? ((t0 + 255) & ~255) : 0) + (x + 1 < e ? ((t1 + 255) & ~255) : 0) + (x + 2 < e ? ((t2 + 255) & ~255) : 0) + (x + 3 < e ? ((t3 + 255) & ~255) : 0); }
      const int mine = (tot[e] + 255) >> 8, first = acc >> 8;
      if (sub == 0) { pst[e] = acc; if (e == 31) ntp[0] = first + mine; }
      for (int i = sub; i < mine; i += 16) tile_e[first + i] = e; }
    __syncthreads();
}
#ifndef ATT_DUP
#define ATT_DUP 1
#endif

__device__ __forceinline__ s16x4 tr16(LAS const unsigned char* p) { typedef short v4i16_t __attribute__((ext_vector_type(4))); return __builtin_bit_cast(s16x4, __builtin_amdgcn_ds_read_tr16_b64_v4i16((LAS v4i16_t*)p)); }

__device__ __forceinline__ float max3f(float a, float b, float c) { return fmaxf(fmaxf(a, b), c); }
#ifndef ATT_THR_V
#define ATT_THR_V 10.f
#endif
constexpr float ATT_THR = ATT_THR_V;
template <int KS, bool DIL>
__device__ __forceinline__ void att_tile(LAS const unsigned char* kb, LAS const unsigned char* vb, const bf16x8 (&qf)[KS], f32x16& o0, f32x16& o1, f32x16& negm, float& mref, float& l, int kidx0, int qidx, bool need_mask, int lane) {
    constexpr int KROW = KS * 32 + 16, VROW = 144;
    const int i32 = lane & 31, hi = lane >> 5;
    const int pr = (i32 & 0x13) | ((i32 & 4) << 1) | ((i32 & 8) >> 1);
    f32x16 p0, p1;
    LAS const unsigned char* kp = kb + pr * KROW + hi * 16;
#ifndef QK_DUP
#define QK_DUP 1
#endif
#pragma unroll 1
    for (int qd_ = 0; qd_ < QK_DUP; ++qd_) {
#pragma unroll
    for (int ks = 0; ks < KS; ++ks) {
        const bf16x8 k0f = *(LAS const bf16x8*)(kp + ks * 32), k1f = *(LAS const bf16x8*)(kp + 32 * KROW + ks * 32);
        if (ks == 0) { p0 = __builtin_amdgcn_mfma_f32_32x32x16_bf16(k0f, qf[0], negm, 0, 0, 0); p1 = __builtin_amdgcn_mfma_f32_32x32x16_bf16(k1f, qf[0], negm, 0, 0, 0); }
        else { p0 = __builtin_amdgcn_mfma_f32_32x32x16_bf16(k0f, qf[ks], p0, 0, 0, 0); p1 = __builtin_amdgcn_mfma_f32_32x32x16_bf16(k1f, qf[ks], p1, 0, 0, 0); }
    }
    asm volatile("" : "+v"(p0), "+v"(p1));
    }
    if (need_mask) {
#pragma unroll
        for (int r = 0; r < 16; ++r) { const int d0 = qidx - (kidx0 + 16 * (r >> 3) + 8 * hi + (r & 7)), d1 = d0 - 32;
            const bool v0 = DIL ? (d0 >= 0 && d0 <= 128) : (d0 >= 0), v1 = DIL ? (d1 >= 0 && d1 <= 128) : (d1 >= 0);
            p0[r] = v0 ? p0[r] : -INFINITY; p1[r] = v1 ? p1[r] : -INFINITY; } }
    float mx = max3f(p0[0], p0[1], p1[0]), mb = max3f(p0[2], p0[3], p1[1]); mx = max3f(mx, p1[2], p1[3]);
#pragma unroll
    for (int r = 4; r < 16; r += 4) { mx = max3f(mx, p0[r], p0[r + 1]); mb = max3f(mb, p0[r + 2], p0[r + 3]); mx = max3f(mx, p1[r], p1[r + 1]); mb = max3f(mb, p1[r + 2], p1[r + 3]); }
    mx = xmax32(fmaxf(mx, mb));
    if (__builtin_expect(__any(mx > ATT_THR), 0)) {
        const float dl = fmaxf(mx, 0.f), f = fexp2(-dl);
        mref += dl; l *= f;
#pragma unroll
        for (int r = 0; r < 16; ++r) { o0[r] *= f; o1[r] *= f; p0[r] -= dl; p1[r] -= dl; negm[r] = -mref; } }
    float ls0 = 0.f, ls1 = 0.f;
#pragma unroll
    for (int r = 0; r < 16; ++r) { p0[r] = fexp2(p0[r]); p1[r] = fexp2(p1[r]); ls0 += p0[r]; ls1 += p1[r]; }
    l += ls0 + ls1;
    u32x4 pw[2][2];
#pragma unroll
    for (int s = 0; s < 2; ++s) {
        pw[0][s].x = cvt_pk_bf16(p0[8 * s + 0], p0[8 * s + 1]); pw[0][s].y = cvt_pk_bf16(p0[8 * s + 2], p0[8 * s + 3]); pw[0][s].z = cvt_pk_bf16(p0[8 * s + 4], p0[8 * s + 5]); pw[0][s].w = cvt_pk_bf16(p0[8 * s + 6], p0[8 * s + 7]);
        pw[1][s].x = cvt_pk_bf16(p1[8 * s + 0], p1[8 * s + 1]); pw[1][s].y = cvt_pk_bf16(p1[8 * s + 2], p1[8 * s + 3]); pw[1][s].z = cvt_pk_bf16(p1[8 * s + 4], p1[8 * s + 5]); pw[1][s].w = cvt_pk_bf16(p1[8 * s + 6], p1[8 * s + 7]); }
    const int g = lane >> 4, i16 = lane & 15;
    LAS const unsigned char* vp = vb + (8 * (g >> 1) + (i16 >> 2)) * VROW + (16 * (g & 1) + 4 * (i16 & 3)) * 2;
#pragma unroll
    for (int sub = 0; sub < 2; ++sub)
#pragma unroll
        for (int s = 0; s < 2; ++s) { const bf16x8 pf = __builtin_bit_cast(bf16x8, pw[sub][s]);
#pragma unroll
            for (int db = 0; db < 2; ++db) { LAS const unsigned char* av = vp + (32 * sub + 16 * s) * VROW + 64 * db;
                const s16x4 lo = tr16(av), hh = tr16(av + 4 * VROW);
                const bf16x8 vf = (bf16x8){lo[0], lo[1], lo[2], lo[3], hh[0], hh[1], hh[2], hh[3]};
                if (db == 0) o0 = __builtin_amdgcn_mfma_f32_32x32x16_bf16(vf, pf, o0, 0, 0, 0); else o1 = __builtin_amdgcn_mfma_f32_32x32x16_bf16(vf, pf, o1, 0, 0, 0); } }
}
__device__ __forceinline__ void att_store(bf16_t* orow  , const f32x16& o0, const f32x16& o1, float inv, int hi) {
#pragma unroll
    for (int rr = 0; rr < 4; ++rr) { u32x2 w0, w1;
        w0.x = cvt_pk_bf16(o0[4 * rr] * inv, o0[4 * rr + 1] * inv); w0.y = cvt_pk_bf16(o0[4 * rr + 2] * inv, o0[4 * rr + 3] * inv);
        w1.x = cvt_pk_bf16(o1[4 * rr] * inv, o1[4 * rr + 1] * inv); w1.y = cvt_pk_bf16(o1[4 * rr + 2] * inv, o1[4 * rr + 3] * inv);
        *(u32x2*)(orow + 8 * rr + 4 * hi) = w0; *(u32x2*)(orow + 32 + 8 * rr + 4 * hi) = w1; }
}


struct BgConv {
    const float* w1; const float* w2; unsigned char* ws; LAS unsigned char* T;
    int pair, it, nit, step, sub;
    bool pendA, pendB; int psubA, psubB; unsigned char* pWTA; unsigned char* pWTB;
    f32x4 vA[4], vB[4];
};
__device__ __forceinline__ void bg_tile(const BgConv& S, int it, const float*& W, int& N, unsigned char*& WT, int& n0, int& k0) {
    constexpr int I1 = 32 * 8, I2 = 16 * 8, S1 = 32 * I1, S2 = 32 * I2;
    int mat, q; bool is1;
    if (it < S1) { is1 = true; mat = 32 + it / I1; q = it % I1; }
    else if (it < S1 + S2) { const int r = it - S1; is1 = false; mat = 32 + r / I2; q = r % I2; }
    else if (it < S1 + 2 * S2) { const int r = it - S1 - S2; is1 = false; mat = r / I2; q = r % I2; }
    else { const int r = it - S1 - 2 * S2; is1 = true; mat = r / I1; q = r % I1; }
    mat += S.pair * 64;
    if (is1) { W = S.w1 + (size_t)mat * 1024 * 2048; WT = S.ws + O_W1 + (size_t)mat * SZ_W1E; N = 2048; n0 = (q >> 3) * 64; k0 = (q & 7) * 128; }
    else { W = S.w2 + (size_t)mat * 1024 * 1024; WT = S.ws + O_W2 + (size_t)mat * SZ_W2E; N = 1024; n0 = (q >> 3) * 64; k0 = (q & 7) * 128; }
}
__device__ __forceinline__ void bg_init(BgConv& S, const Ctx& C, const float* w1, const float* w2, int pair) {
    S.w1 = w1; S.w2 = w2; S.ws = C.ws; S.T = C.lds + 49152 + C.wave * 9216; S.pair = pair; S.it = C.gw; S.nit = 64 * 256 + 64 * 128; S.step = C.NGW; S.sub = 0;
    S.pendA = false; S.pendB = false; S.psubA = 0; S.psubB = 0; S.pWTA = C.ws; S.pWTB = C.ws;
}
__device__ __forceinline__ bool bg_done(const BgConv& S) { return !S.pendA && !S.pendB && S.it >= S.nit; }
__device__ __forceinline__ void bg_half(BgConv& S, f32x4 (&v)[4], bool& pend, int& psub, unsigned char*& pWT, int lane) {
    const int kq = lane >> 4, c4 = lane & 15;
    if (pend) {
#pragma unroll
        for (int jj = 0; jj < 4; ++jj) *(LAS unsigned*)(S.T + (4 * c4 + jj) * 144 + 32 * kq + 4 * psub) = pk4_fp8(32.f * v[0][jj], 32.f * v[1][jj], 32.f * v[2][jj], 32.f * v[3][jj]);
        if (psub == 7) {
            asm volatile("s_waitcnt lgkmcnt(0)" ::: "memory");
#pragma unroll
            for (int s8 = 0; s8 < 8; ++s8) { const int n = 8 * s8 + (lane >> 3), ch = lane & 7; const u32x4 w = *(const LAS u32x4*)(S.T + n * 144 + 16 * ch);
                *(u32x4*)(pWT + (size_t)n * 1024 + 16 * ch) = w; }
            asm volatile("s_waitcnt lgkmcnt(0)" ::: "memory"); }
        pend = false; }
    if (S.it < S.nit) { const float* W; int N, n0, k0; unsigned char* WT; bg_tile(S, S.it, W, N, WT, n0, k0);
        const float* p = W + (size_t)(k0 + 32 * kq + 4 * S.sub) * N + n0 + 4 * c4;
#pragma unroll
        for (int i = 0; i < 4; ++i) v[i] = __builtin_nontemporal_load((const f32x4*)(p + (size_t)i * N));
        pend = true; psub = S.sub; pWT = WT + (size_t)n0 * 1024 + k0;
        if (++S.sub == 8) { S.sub = 0; S.it += S.step; } }
}
#define BG_STEP_A() bg_half(BG, BG.vA, BG.pendA, BG.psubA, BG.pWTA, lane)
#define BG_STEP_B() bg_half(BG, BG.vB, BG.pendB, BG.psubB, BG.pWTB, lane)

__device__ __forceinline__ void mla_unit(const Ctx& C, BgConv& BG, int b, int h, int qb) {
    constexpr int KROW = 208, VROW = 144, KB = 64 * KROW, BUF = KB + 64 * VROW;
    const bf16_t* Q2 = (const bf16_t*)(C.ws + O_Q2); const bf16_t* KV2 = (const bf16_t*)(C.ws + O_KV2); const bf16_t* PROJ = (const bf16_t*)(C.ws + O_PROJ); bf16_t* ATT = (bf16_t*)(C.ws + O_ATT);
    const int tid = C.tid, lane = C.lane, w = C.wave, i32 = lane & 31, hi = lane >> 5;
    const int q0 = qb * 256; const size_t rowb = (size_t)b * S_;
    bf16x8 qf[6];
    { const bf16_t* qrow = Q2 + (rowb + q0 + 32 * w + i32) * 768 + 8 * hi;
#pragma unroll
      for (int ks = 0; ks < 4; ++ks) qf[ks] = *(const bf16x8*)(qrow + h * 64 + 16 * ks);
      qf[4] = *(const bf16x8*)(qrow + 512 + h * 32); qf[5] = *(const bf16x8*)(qrow + 512 + h * 32 + 16); }
    f32x16 o0, o1;
#pragma unroll
    for (int r = 0; r < 16; ++r) { o0[r] = 0.f; o1[r] = 0.f; }
    float m = 0.f, l = 0.f; f32x16 negm;
#pragma unroll
    for (int r = 0; r < 16; ++r) negm[r] = 0.f;
    const int NT = 4 * qb + 4, wmax = 4 * qb + (w >> 1);
    const int r8 = tid >> 3, c8 = tid & 7, r4 = (tid & 255) >> 2, c4 = tid & 3;
    const bf16_t* knp = KV2 + (rowb + r8) * 1024 + h * 64 + 8 * c8; const bf16_t* kpp = PROJ + (rowb + r4) * 2048 + 1920 + 8 * c4;
    u32x4 kA, vA, pA, kB, vB, pB;
#define MLA_LOAD(j, K, V, P) do { const int jc_ = ((j) < NT) ? (j) : NT - 1; K = *(const u32x4*)(knp + (size_t)jc_ * 64 * 1024); V = *(const u32x4*)(knp + (size_t)jc_ * 64 * 1024 + 512); P = *(const u32x4*)(kpp + (size_t)jc_ * 64 * 2048); } while (0)
#define MLA_WRITE(bo, K, V, P) do { *(LAS u32x4*)(C.lds + (bo) + r8 * KROW + 16 * c8) = K; *(LAS u32x4*)(C.lds + (bo) + KB + r8 * VROW + 16 * c8) = V; *(LAS u32x4*)(C.lds + (bo) + r4 * KROW + 128 + 16 * c4) = P; } while (0)
#define MLA_STEP(j, KF, VF, PF, KN, VN, PN, BGS) do { const int j_ = (j); const int bo_ = (j_ & 1) * BUF; \
        MLA_LOAD(j_ + 2, KF, VF, PF); BGS(); \
        if (j_ <= wmax) { _Pragma("unroll 1") for (int dup_ = 0; dup_ < ATT_DUP; ++dup_) att_tile<6, false>(C.lds + bo_, C.lds + bo_ + KB, qf, o0, o1, negm, m, l, 64 * j_, q0 + 32 * w + i32, j_ == wmax, lane); } \
        MLA_WRITE(BUF - bo_, KN, VN, PN); \
        __syncthreads(); } while (0)
    MLA_LOAD(0, kA, vA, pA); MLA_LOAD(1, kB, vB, pB);
    MLA_WRITE(0, kA, vA, pA);
    __syncthreads();
#pragma unroll 1
    for (int j = 0; j < NT; j += 2) { MLA_STEP(j, kA, vA, pA, kB, vB, pB, BG_STEP_A); MLA_STEP(j + 1, kB, vB, pB, kA, vA, pA, BG_STEP_B); }
#undef MLA_STEP
#undef MLA_LOAD
#undef MLA_WRITE
    l = xadd32(l);
    att_store(ATT + (rowb + q0 + 32 * w + i32) * 1024 + 512 + h * 64, o0, o1, 1.f / l, hi);
}
__device__ __forceinline__ void dil_unit(const Ctx& C, BgConv& BG, int p, int dd, int b, int h, int res, int n) {
    constexpr int KROW = 144, VROW = 144, KB = 64 * KROW, BUF = KB + 64 * VROW;
    const bf16_t* PROJ = (const bf16_t*)(C.ws + O_PROJ); bf16_t* OA = (bf16_t*)(C.ws + O_OA) + (size_t)p * T_ * 512; float* LSE = (float*)(C.ws + O_LSE) + (size_t)p * T_ * 8;
    const int tid = C.tid, lane = C.lane, w = C.wave, i32 = lane & 31, hi = lane >> 5;
    const size_t rowb = (size_t)b * S_;
    const int qsub = 256 * n + 32 * w + i32; const size_t qtok = rowb + (size_t)qsub * dd + res;
    bf16x8 qf[4];
    { const bf16_t* qrow = PROJ + qtok * 2048 + h * 64 + 8 * hi;
#pragma unroll
      for (int ks = 0; ks < 4; ++ks) qf[ks] = *(const bf16x8*)(qrow + 16 * ks); }
    f32x16 o0, o1;
#pragma unroll
    for (int r = 0; r < 16; ++r) { o0[r] = 0.f; o1[r] = 0.f; }
    float m = 0.f, l = 0.f; f32x16 negm;
#pragma unroll
    for (int r = 0; r < 16; ++r) negm[r] = 0.f;
    const int jbeg = (n == 0) ? 2 : 0, wlo = w >> 1, whi = (32 * w + 159) >> 6;
    const int r8 = tid >> 3, c8 = tid & 7;
    u32x4 kA, vA, kB, vB;
    const int cnt = 6 - jbeg;
#define DIL_LOAD(i, K, V) do { const int jc_ = jbeg + (((i) < cnt) ? (i) : cnt - 1); const size_t tok = rowb + (size_t)(256 * n - 128 + 64 * jc_ + r8) * dd + res; const bf16_t* src = PROJ + tok * 2048 + 512 + h * 64 + 8 * c8; K = *(const u32x4*)src; V = *(const u32x4*)(src + 512); } while (0)
#define DIL_WRITE(bo, K, V) do { *(LAS u32x4*)(C.lds + (bo) + r8 * KROW + 16 * c8) = K; *(LAS u32x4*)(C.lds + (bo) + KB + r8 * VROW + 16 * c8) = V; } while (0)
#define DIL_STEP(i, KF, VF, KN, VN, BGS) do { const int i_ = (i); const int bo_ = (i_ & 1) * BUF, j_ = jbeg + i_; \
        DIL_LOAD(i_ + 2, KF, VF); BGS(); \
        if (i_ < cnt && j_ >= wlo && j_ <= whi) { const int kb0_ = 256 * n - 128 + 64 * j_, qlo_ = 256 * n + 32 * w; _Pragma("unroll 1") for (int dup_ = 0; dup_ < ATT_DUP; ++dup_) att_tile<4, true>(C.lds + bo_, C.lds + bo_ + KB, qf, o0, o1, negm, m, l, kb0_, qsub, !(kb0_ + 63 <= qlo_ && qlo_ + 31 - kb0_ <= 128), lane); } \
        DIL_WRITE(BUF - bo_, KN, VN); \
        __syncthreads(); } while (0)
    DIL_LOAD(0, kA, vA); DIL_LOAD(1, kB, vB);
    DIL_WRITE(0, kA, vA);
    __syncthreads();
    DIL_STEP(0, kA, vA, kB, vB, BG_STEP_A); DIL_STEP(1, kB, vB, kA, vA, BG_STEP_B); DIL_STEP(2, kA, vA, kB, vB, BG_STEP_A); DIL_STEP(3, kB, vB, kA, vA, BG_STEP_B);
    if (cnt == 6) { DIL_STEP(4, kA, vA, kB, vB, BG_STEP_A); DIL_STEP(5, kB, vB, kA, vA, BG_STEP_B); }
#undef DIL_STEP
#undef DIL_LOAD
#undef DIL_WRITE
    l = xadd32(l);
    att_store(OA + qtok * 512 + h * 64, o0, o1, 1.f / l, hi);
    if (hi == 0) LSE[qtok * 8 + h] = m + log2f(l);
}
#ifndef REP_MLA
#define REP_MLA 1
#endif
#ifndef REP_DIL
#define REP_DIL 1
#endif
__device__ __forceinline__ void phase_attention(const Ctx& C, const float* w1, const float* w2, int pair) {
    BgConv BG; bg_init(BG, C, w1, w2, pair);
#pragma unroll 1
    for (int rep = 0; rep < REP_MLA; ++rep) {
    if (C.G == 256) { const int bh = C.vcu >> 3, s = C.vcu & 7; mla_unit(C, BG, bh >> 3, bh & 7, s); mla_unit(C, BG, bh >> 3, bh & 7, 15 - s); }
    else for (int u = C.bid; u < 512; u += C.G) mla_unit(C, BG, u >> 7, (u >> 4) & 7, u & 15);
    }
#pragma unroll 1
    for (int rep = 0; rep < REP_DIL; ++rep)
    for (int u = C.bid; u < 1536; u += C.G) { const int p = u >> 9, rem = u & 511, b = rem >> 7, h = (rem >> 4) & 7, blk = rem & 15;
        const int dd = (p == 0) ? 1 : (p == 1) ? 4 : 16, bpr = 16 / dd;
        dil_unit(C, BG, p, dd, b, h, blk / bpr, blk % bpr); }
    { const int lane = C.lane;
#pragma unroll 1
      while (!bg_done(BG)) { BG_STEP_A(); BG_STEP_B(); } }
}
#undef BG_STEP_A
#undef BG_STEP_B

#ifdef TIME_NORM
constexpr int N_PHASES = 42;
#else
constexpr int N_PHASES = 36;
#endif
extern __shared__ __attribute__((aligned(16))) unsigned char lds_raw[];
typedef const __attribute__((address_space(4))) Args* ArgsP;
#define PHFN static __device__ __forceinline__ void
__device__ __forceinline__ ArgsP fresh_args() { unsigned long long p = (unsigned long long)__builtin_amdgcn_kernarg_segment_ptr(); asm volatile("" : "+s"(p)); return (ArgsP)p; }
__device__ __forceinline__ Ctx make_ctx(ArgsP ap, int wv) {
    Ctx C; C.lds = (LAS unsigned char*)lds_raw; C.ws = ap->ws;
    unsigned ones = ~0u; asm volatile("" : "+s"(ones)); const int lane = (int)__builtin_amdgcn_mbcnt_hi(ones, __builtin_amdgcn_mbcnt_lo(ones, 0u));
    int bid = blockIdx.x; asm volatile("" : "+s"(bid)); int G = gridDim.x; asm volatile("" : "+s"(G));
    C.wave = wv; C.lane = lane; C.tid = wv * 64 + lane;
    C.G = G; C.bid = bid; C.vcu = (C.G % 8 == 0) ? (C.bid % 8) * (C.G / 8) + C.bid / 8 : C.bid;
    C.gw = C.bid * 8 + C.wave; C.NGW = C.G * 8; return C;
}
#define IN(i) ((const float*)ap->in[i])
#define MODL(l) ((const float*)(C.ws + O_MOD) + (size_t)(l) * 4 * 6144)
PHFN ph_prologue(int wv) { const ArgsP ap = fresh_args(); const Ctx C = make_ctx(ap, wv); p0_prologue(C, ap); }
PHFN ph_norm(int wv, int l, int mode) { const ArgsP ap = fresh_args(); const Ctx C = make_ctx(ap, wv);
    if (mode == 0) phase_norm(C, IN(0), nullptr, false, true, IN(5), MODL(0), MODL(0), 0, 1024, false, true);
    else if (mode == 1) phase_norm(C, nullptr, nullptr, true, true, IN(5) + l * 1024, MODL(l - 1), MODL(l), 0, 1024, false, (l & 1) == 0);
    else if (mode == 3) phase_norm(C, nullptr, nullptr, true, true, IN(5) + l * 1024, MODL(l - 1), MODL(l), 0, 1024, true);
    else phase_norm(C, nullptr, ap->out, true, false, IN(5), MODL(3), MODL(3), 0, 1024); }
PHFN ph_proj(int wv, int j) { const ArgsP ap = fresh_args(); const Ctx C = make_ctx(ap, wv); unsigned char* ws = C.ws;
    DenseOrder S; S.init(ws + O_HN, ws + O_WIN + j * SZ_WIN, 1024, 1024, T_, 2048, C.G, C.bid, 1); EpiNorm<0> E{(bf16_t*)(ws + O_PROJ), 2048, IN(8) + j * 64, IN(9) + j * 64, IN(10) + j * 256, IN(11) + j * 128, IN(15) + j * 96 + 64, (const float*)(ws + O_CS), (LAS float*)(C.lds + LX_EXCH), 1.f / 32.f}; gemm_phase<true>(C, GemmDims{1024, 1024, 1024}, S, E); }
PHFN ph_postproj(int wv, int j) { const ArgsP ap = fresh_args(); const Ctx C = make_ctx(ap, wv); phase_postproj(C, IN(8) + j * 64, IN(9) + j * 64, IN(10) + j * 256, IN(11) + j * 128, IN(15) + j * 96); }
PHFN ph_qkv(int wv, int j) { const ArgsP ap = fresh_args(); const Ctx C = make_ctx(ap, wv); unsigned char* ws = C.ws;
    { DenseOrder S; S.init(ws + O_PROJ + 1536 * 2, ws + O_WUQ + j * SZ_WUQ, 2048, 256, T_, 768, C.G, C.bid); EpiNorm<1> E{(bf16_t*)(ws + O_Q2), 768, IN(14) + j * 96, IN(14) + j * 96 + 64, nullptr, nullptr, nullptr, (const float*)(ws + O_CS), (LAS float*)(C.lds + LX_EXCH), 1.f}; gemm_phase(C, GemmDims{256, 2048, 256}, S, E); }
    { const ArgsP ap2 = fresh_args(); const Ctx C = make_ctx(ap2, wv); unsigned char* ws = C.ws; DenseOrder S; S.init(ws + O_PROJ + 1792 * 2, ws + O_WUKV + j * SZ_WUKV, 2048, 128, T_, 1024, C.G, C.bid); EpiNorm<2> E{(bf16_t*)(ws + O_KV2), 1024, IN(15) + j * 96, nullptr, nullptr, nullptr, nullptr, (const float*)(ws + O_CS), (LAS float*)(C.lds + LX_EXCH), 1.f}; gemm_phase(C, GemmDims{128, 2048, 128}, S, E); } }
PHFN ph_postq(int wv, int j) { const ArgsP ap = fresh_args(); const Ctx C = make_ctx(ap, wv); phase_postq(C, IN(14) + j * 96, IN(15) + j * 96); }
PHFN ph_attention(int wv, int pair) { const ArgsP ap = fresh_args(); const Ctx C = make_ctx(ap, wv); phase_attention(C, IN(30), IN(32), pair); }
PHFN ph_mixcombine(int wv) { const ArgsP ap = fresh_args(); const Ctx C = make_ctx(ap, wv); phase_mixcombine(C); }
PHFN ph_outproj(int wv, int l, int which) { const ArgsP ap = fresh_args(); const Ctx C = make_ctx(ap, wv); unsigned char* ws = C.ws; const int j = l >> 1;
    DenseOrder S; S.init(ws + O_ATT, ws + (which ? O_RWOUT + j * SZ_RWOUT : O_WOUT + j * SZ_WOUT), 1024, 1024, T_, 1024, C.G, C.bid);
    EpiResid E{(bf16_t*)(ws + O_X), MODL(l) + 2048, which ? IN(27) + j * 1024 : nullptr}; gemm_phase(C, GemmDims{1024, 1024, 1024}, S, E); }
PHFN ph_router(int wv, int l) { const ArgsP ap = fresh_args(); const Ctx C = make_ctx(ap, wv); phase_router(C, (const bf16_t*)(C.ws + O_X), IN(6) + l * 1024, MODL(l), IN(28) + (size_t)l * 1024 * 32, IN(29) + l * 32, l); }
PHFN ph_moe1(int wv, int l) { const ArgsP ap = fresh_args(); const Ctx C = make_ctx(ap, wv); unsigned char* ws = C.ws; moe_plan_lds(C, l);
    MoeOrderT<true> S; S.A = (const char*)(ws + O_HN); S.WT = (const char*)(ws + O_W1 + (size_t)l * 32 * SZ_W1E); S.estride = SZ_W1E; S.tile_e = (const LAS int*)(C.lds + LX_TILE);
    S.NT = *(const LAS int*)(C.lds + LX_MISC + 128); S.nN = 8; S.G = C.G; S.c = C.bid; S.esz = 1; S.gtab = (const LAS int*)(C.lds + LX_GTAB);
    { const int* inv = (const int*)(ws + O_INV); LAS int* gt = (LAS int*)(C.lds + LX_GTAB); const LAS int* tot = (const LAS int*)(C.lds + LX_MISC + 256); const LAS int* pst = tot + 32;
      const int r = C.tid & 255, i0 = __builtin_amdgcn_readfirstlane(C.tid >> 8); int val[GTAB_UNITS / 2]; float bvl[GTAB_UNITS / 2]; const float* b1 = IN(31) + (size_t)l * 32 * 2048;
#pragma unroll
      for (int k = 0; k < GTAB_UNITS / 2; ++k) { Unit u; const bool ok = S.next(2 * k + i0, u); const int e = ok ? u.e : 0, j = (ok ? u.row0 - pst[e] : 0) + r; val[k] = (ok && j < tot[e]) ? inv[e * 16384 + j] : 0;
          bvl[k] = ok ? b1[(size_t)e * 2048 + u.col0 + r] : 0.f; }
      MoeOrder S2; S2.A = nullptr; S2.WT = nullptr; S2.estride = 0; S2.tile_e = S.tile_e; S2.NT = S.NT; S2.nN = 4; S2.G = C.G; S2.c = C.bid; S2.esz = 1; float b2v[3]; const float* b2 = IN(33) + (size_t)l * 32 * 1024;
#pragma unroll
      for (int k = 0; k < 3; ++k) { Unit u2; const bool ok2 = S2.next(2 * k + i0, u2); b2v[k] = ok2 ? b2[(size_t)u2.e * 1024 + u2.col0 + r] : 0.f; }
      { const int* topi = (const int*)(ws + O_TOPI); const int* posj = (const int*)(ws + O_POSJ); int* pos = (int*)(ws + O_POS);
        for (int ck = C.bid; ck < 256; ck += C.G) if (C.tid < 256) pos[ck * 256 + C.tid] = pst[topi[ck * 256 + C.tid]] + posj[ck * 256 + C.tid]; }
#pragma unroll
      for (int k = 0; k < GTAB_UNITS / 2; ++k) { gt[(2 * k + i0) * 256 + r] = val[k]; ((LAS float*)(C.lds + LX_BIAS))[(2 * k + i0) * 256 + r] = bvl[k]; }
#pragma unroll
      for (int k = 0; k < 3; ++k) ((LAS float*)(C.lds + LX_BIAS + GTAB_UNITS * 1024))[(2 * k + i0) * 256 + r] = b2v[k];
      __syncthreads(); }
    EpiSwiglu E{(unsigned char*)(ws + O_ACT), (const LAS float*)(C.lds + LX_BIAS), 1.f / 32.f}; gemm_phase<true>(C, GemmDims{1024, 1024, 1024}, S, E); }
PHFN ph_moe2(int wv, int l) { const ArgsP ap = fresh_args(); const Ctx C = make_ctx(ap, wv); unsigned char* ws = C.ws;
#if MODE != 1
    moe_plan_lds(C, l);
#endif

    MoeOrder S; S.A = (const char*)(ws + O_ACT); S.WT = (const char*)(ws + O_W2 + (size_t)l * 32 * SZ_W2E); S.estride = SZ_W2E; S.tile_e = (const LAS int*)(C.lds + LX_TILE);
    S.NT = *(const LAS int*)(C.lds + LX_MISC + 128); S.nN = 4; S.G = C.G; S.c = C.bid; S.esz = 1;
    EpiY8 E{ws + O_Y2, 1.f / 32.f, (const LAS float*)(C.lds + LX_BIAS + GTAB_UNITS * 1024)}; gemm_phase<true>(C, GemmDims{1024, 1024, 1024}, S, E); }
PHFN ph_recin(int wv, int j) { const ArgsP ap = fresh_args(); const Ctx C = make_ctx(ap, wv); unsigned char* ws = C.ws;
    DenseOrder S; S.init(ws + O_HN, ws + O_RWIN + j * SZ_RWIN, 1024, 1024, T_, 2048, C.G, C.bid);
    { const float* bias = IN(18) + j * 2048; LAS float* bt = (LAS float*)(C.lds + LX_BIAS); const int r = C.tid & 255, i0 = __builtin_amdgcn_readfirstlane(C.tid >> 8);
      float bvl[2];
#pragma unroll
      for (int k = 0; k < 2; ++k) { Unit u; const bool ok = S.next(2 * k + i0, u); bvl[k] = ok ? bias[u.col0 + r] : 0.f; }
#pragma unroll
      for (int k = 0; k < 2; ++k) bt[(2 * k + i0) * 256 + r] = bvl[k];
      __syncthreads(); }
    EpiRecIn E{(bf16_t*)(ws + O_PROJ), IN(18) + j * 2048, (const LAS float*)(C.lds + LX_BIAS)}; gemm_phase(C, GemmDims{1024, 1024, 1024}, S, E); }
PHFN ph_rgate(int wv, int j) { const ArgsP ap = fresh_args(); const Ctx C = make_ctx(ap, wv); phase_rgate(C, j, IN(19) + j * 4096, IN(20) + j * 1024, IN(22) + j * 1024, IN(24) + j * 1024); }
PHFN ph_scan_apply(int wv) { const ArgsP ap = fresh_args(); const Ctx C = make_ctx(ap, wv); phase_scan_apply(C); }

#if MODE == 1
__device__ __forceinline__ int fresh_tid(int wv) { unsigned ones = ~0u; asm volatile("" : "+s"(ones)); return wv * 64 + (int)__builtin_amdgcn_mbcnt_hi(ones, __builtin_amdgcn_mbcnt_lo(ones, 0u)); }
__device__ __forceinline__ void grid_barrier(int wv) { const ArgsP q = fresh_args(); XcdBarrier b; b.bar = (unsigned*)(q->ws + O_CTL) + CW_BAR; b.x = xb_xcc_id(); b.st = (volatile LAS unsigned*)((LAS unsigned char*)lds_raw + LDSX_OFF); xcd_barrier(b, fresh_tid(wv)); }
__global__ void __launch_bounds__(512, 2) mk_fwd(Args a) {
    int wv = __builtin_amdgcn_readfirstlane(threadIdx.x >> 6); asm volatile("" : "+s"(wv));
    { LAS unsigned char* lds = (LAS unsigned char*)lds_raw;
      for (int u = threadIdx.x; u < (LDS_BYTES - LDSX_OFF) / 4; u += 512) ((LAS unsigned*)(lds + LDSX_OFF))[u] = 0u;
      __syncthreads();
      if (a.ph_hi - a.ph_lo > 1) (void)xcd_barrier_post((unsigned*)(a.ws + O_CTL) + CW_BAR, (volatile LAS unsigned*)(lds + LDSX_OFF), (int)threadIdx.x); }
    int pid = 0;
#define PHASE(call) { const ArgsP q_ = fresh_args(); const int lo_ = q_->ph_lo, hi_ = q_->ph_hi; if (pid >= lo_ && pid < hi_) { call; if (pid + 1 < hi_) grid_barrier(wv); } ++pid; }
#define PHASE_R(call, REP) { const ArgsP q_ = fresh_args(); const int lo_ = q_->ph_lo, hi_ = q_->ph_hi; if (pid >= lo_ && pid < hi_) { if ((REP) > 1) { call; grid_barrier(wv); } call; if (pid + 1 < hi_) grid_barrier(wv); } ++pid; }
#ifndef REP_PROLOGUE
#define REP_PROLOGUE 1
#endif
#ifndef REP_MOE
#define REP_MOE 1
#endif
#ifndef REP_ATTN
#define REP_ATTN 1
#endif
#ifndef REP_GEMMS
#define REP_GEMMS 1
#endif
#ifdef TIME_NORM
#define NORM_EXTRA(l) PHASE(ph_norm(wv, l, 3))
#else
#define NORM_EXTRA(l)
#endif
#ifndef REP_ELEM
#define REP_ELEM 1
#endif
#ifndef REP_ROUTER
#define REP_ROUTER REP_ELEM
#endif
#ifndef REP_SCATTER
#define REP_SCATTER REP_ELEM
#endif
#ifndef REP_MIX
#define REP_MIX REP_ELEM
#endif
#ifndef REP_CONV
#define REP_CONV REP_ELEM
#endif
#ifndef REP_SCANA
#define REP_SCANA REP_ELEM
#endif
#define MOE_PHASES(l) PHASE_R(ph_router(wv, l), REP_ROUTER) PHASE_R(ph_moe1(wv, l), REP_MOE) PHASE_R(ph_moe2(wv, l), REP_MOE)
    PHASE_R(ph_prologue(wv), REP_PROLOGUE)
#define LAYER_PAIR(lp) \
        { const int l = 2 * (lp);         \
          PHASE(ph_norm(wv, l, (lp) == 0 ? 0 : 1)) PHASE_R(ph_proj(wv, lp), REP_GEMMS) PHASE_R(ph_qkv(wv, lp), REP_GEMMS) PHASE_R(ph_attention(wv, lp), REP_ATTN) PHASE_R(ph_mixcombine(wv), REP_MIX) PHASE(ph_outproj(wv, l, 0)) \
          MOE_PHASES(l) } \
        { const int l = 2 * (lp) + 1;     \
          NORM_EXTRA(l) PHASE(ph_norm(wv, l, 1)) PHASE_R(ph_recin(wv, lp), REP_GEMMS) PHASE_R(ph_rgate(wv, lp), REP_CONV) PHASE_R(ph_scan_apply(wv), REP_SCANA) PHASE(ph_outproj(wv, l, 1)) \
          MOE_PHASES(l) }
    LAYER_PAIR(0)
    LAYER_PAIR(1)
#undef LAYER_PAIR
#ifdef EXTRA_BARRIERS
    { const ArgsP q_ = fresh_args(); if (q_->ph_hi - q_->ph_lo > 1) { _Pragma("unroll 1") for (int xb = 0; xb < EXTRA_BARRIERS; ++xb) grid_barrier(wv); } }
#endif
    PHASE(ph_norm(wv, 3, 2))
#undef PHASE
#undef PHASE_R
#undef MOE_PHASES
}
#else
template <int PH> __global__ void __launch_bounds__(512, 2) k_phase(Args a, int l, int x) {
    int wv = __builtin_amdgcn_readfirstlane(threadIdx.x >> 6); asm volatile("" : "+s"(wv));
    LAS unsigned char* lds = (LAS unsigned char*)lds_raw;
    for (int u = threadIdx.x; u < (LDS_BYTES - LDSX_OFF) / 4; u += 512) ((LAS unsigned*)(lds + LDSX_OFF))[u] = 0u;
    __syncthreads();
    if constexpr (PH == 0) ph_prologue(wv);
    if constexpr (PH == 1) ph_norm(wv, l, x);
    if constexpr (PH == 2) ph_proj(wv, l);
    if constexpr (PH == 4) ph_qkv(wv, l);
    if constexpr (PH == 6) ph_attention(wv, l);
    if constexpr (PH == 7) ph_mixcombine(wv);
    if constexpr (PH == 8) ph_outproj(wv, l, x);
    if constexpr (PH == 9) ph_router(wv, l);
    if constexpr (PH == 11) ph_moe1(wv, l);
    if constexpr (PH == 12) ph_moe2(wv, l);
    if constexpr (PH == 13) ph_recin(wv, l);
    if constexpr (PH == 14) ph_rgate(wv, l);
    if constexpr (PH == 17) ph_scan_apply(wv);
}
#endif
#undef IN
#undef MODL
}

#ifndef MODE
#define MODE 2
#endif
extern "C" void kernel_launch(void* const* d_in, const int* in_sizes, int n_in, void* d_out, int out_size, void* d_ws, size_t ws_size, hipStream_t stream) {
    (void)in_sizes; (void)n_in; (void)out_size; (void)ws_size;
#if MODE == 0
    nv::forward(d_in, (float*)d_out, d_ws, stream);
#else
    static int grid = 0;
    if (grid == 0) {
        int dev = 0, cus = 0;
        (void)hipGetDevice(&dev); (void)hipDeviceGetAttribute(&cus, hipDeviceAttributeMultiprocessorCount, dev);
#if MODE == 1
        (void)hipFuncSetAttribute((const void*)mk::mk_fwd, hipFuncAttributeMaxDynamicSharedMemorySize, mk::LDS_BYTES);
#else
#define SA(PH) (void)hipFuncSetAttribute((const void*)mk::k_phase<PH>, hipFuncAttributeMaxDynamicSharedMemorySize, mk::LDS_BYTES)
        SA(0); SA(1); SA(2); SA(4); SA(6); SA(7); SA(8); SA(9); SA(10); SA(11); SA(12); SA(13); SA(14); SA(17);
#undef SA
#endif
        grid = cus > 0 ? cus : 256;
    }
    (void)hipMemsetAsync((char*)d_ws + mk::O_CTL, 0, 64 * 1024, stream);
    mk::Args a;
    memset(&a, 0, sizeof(a));
    for (int i = 0; i < 34; ++i) a.in[i] = d_in[i];
    a.out = (float*)d_out; a.ws = (unsigned char*)d_ws;
#if MODE == 1
    a.ph_lo = 0; a.ph_hi = mk::N_PHASES;
    hipLaunchKernelGGL(mk::mk_fwd, dim3(grid), dim3(512), mk::LDS_BYTES, stream, a);
#else
#define LP(PH, l, x) hipLaunchKernelGGL(mk::k_phase<PH>, dim3(grid), dim3(512), mk::LDS_BYTES, stream, a, l, x)
    LP(0, 0, 0);
    for (int lp = 0; lp < 2; ++lp) {
        { const int l = 2 * lp; LP(1, l, lp == 0 ? 0 : 1); LP(2, lp, 0); LP(4, lp, 0); LP(6, lp, 0); LP(7, 0, 0); LP(8, l, 0); LP(9, l, 0); LP(10, 0, 0); LP(11, l, 0); LP(12, l, 0); }
        { const int l = 2 * lp + 1; LP(1, l, 1); LP(13, lp, 0); LP(14, lp, 0); LP(17, 0, 0); LP(8, l, 1); LP(9, l, 0); LP(10, 0, 0); LP(11, l, 0); LP(12, l, 0); }
    }
    LP(1, 3, 2);
#undef LP
#endif
#endif
}
```
